# Optimizing an MI355X kernel written in HIP

```python
import math
import jax, jax.numpy as jnp
from jax import lax
import numpy as np

D_MODEL = 1024
BATCH = 16
SEQ = 4096
DEPTH = 4

HEAD_DIM = 64
BLOCK_Q = 128
ROPE_THETA = 500000.0
ROPE_DIMS = HEAD_DIM // 4
EPS = 1e-6
SGU_GROUPS = 4
SGU_WIDTH = SGU_GROUPS * HEAD_DIM
SGU_CHUNK = 128
SB_HEADS = 4
SB_WIDTH = SB_HEADS * HEAD_DIM
NSA_HEADS = 4
NSA_WIDTH = NSA_HEADS * HEAD_DIM
NSA_KV = 6 * HEAD_DIM
CMP_LEN = 32
CMP_STRIDE = 16
CMP_HIDDEN = 256
SEL_LEN = 64
SEL_TOPN = 16
WINDOW = 512
FORCE_SCORE = 1e4
N_BRANCH = 3
IN_WIDTHS = (2 * SGU_WIDTH, SB_WIDTH, SB_WIDTH, SB_WIDTH, NSA_WIDTH, NSA_KV, 3 * NSA_HEADS, N_BRANCH * D_MODEL)
C_IN = sum(IN_WIDTHS)
IN_SPLITS = tuple(int(v) for v in np.cumsum(IN_WIDTHS)[:-1])
D_FF = 2752
N_EXPERTS = 8
TOP_K = 2
D_FF_EXPERT = 3584
MOE_TOKEN_BLOCK = 512

kernel_name = "hybrid_sgu_stickbreak_nsa_moe"


def rmsnorm(x, g):
    xf = x.astype(jnp.float32)
    y = xf * lax.rsqrt(jnp.mean(xf * xf, axis=-1, keepdims=True) + EPS)
    return (y * g.astype(jnp.float32)).astype(x.dtype)


def rope_tables(s):
    inv_freq = ROPE_THETA ** (-jnp.arange(0, ROPE_DIMS, 2, dtype=jnp.float32) / ROPE_DIMS)
    ang = jnp.arange(s, dtype=jnp.float32)[:, None] * inv_freq[None, :]
    return jnp.cos(ang), jnp.sin(ang)


def rope_partial(x, cos, sin):
    half = ROPE_DIMS // 2
    xr = x[..., :ROPE_DIMS].astype(jnp.float32)
    x1, x2 = xr[..., :half], xr[..., half:]
    c, s = cos[None, :, None, :], sin[None, :, None, :]
    rot = jnp.concatenate([x1 * c - x2 * s, x2 * c + x1 * s], axis=-1).astype(x.dtype)
    return jnp.concatenate([rot, x[..., ROPE_DIMS:]], axis=-1)


def masked_softmax(s, mask, axis=-1):
    s = jnp.where(mask, s, -jnp.inf)
    m = jnp.max(s, axis=axis, keepdims=True)
    m = jnp.where(jnp.isfinite(m), m, 0.0)
    p = jnp.exp(s - m)
    d = jnp.sum(p, axis=axis, keepdims=True)
    return p / jnp.where(d > 0, d, 1.0)


def to_blocks(t, nb):
    return jnp.moveaxis(t.reshape(t.shape[0], nb, BLOCK_Q, *t.shape[2:]), 1, 0)


def from_blocks(t):
    t = jnp.moveaxis(t, 0, 1)
    return t.reshape(t.shape[0], t.shape[1] * t.shape[2], *t.shape[3:])


def sgu_mixer(z, norm_g, w_s, b_s):
    b, s, _ = z.shape
    z = jax.nn.gelu(z)
    u, v = jnp.split(z, 2, axis=-1)
    v = rmsnorm(v, norm_g)
    v = v.reshape(b, s // SGU_CHUNK, SGU_CHUNK, SGU_GROUPS, HEAD_DIM)
    w = jnp.where(jnp.tril(jnp.ones((SGU_CHUNK, SGU_CHUNK), bool)), w_s, 0.0).astype(v.dtype)
    mix = jnp.einsum('gts,bcsgd->bctgd', w, v) + b_s.T[:, :, None].astype(v.dtype)
    return u * mix.reshape(b, s, SGU_WIDTH)


def stick_breaking(q, k, v):
    b, s, h, d = q.shape
    nb = s // BLOCK_Q
    scale = d ** -0.5
    kpos = jnp.arange(s)

    def block(args):
        qi, i = args
        qpos = i * BLOCK_Q + jnp.arange(BLOCK_Q)
        mask = kpos[None, :] < qpos[:, None]
        z = jnp.einsum('bthd,bshd->bhts', qi, k).astype(jnp.float32) * scale
        log_beta = jax.nn.log_sigmoid(z)
        log_1m = jnp.where(mask, jax.nn.log_sigmoid(-z), 0.0)
        between = lax.cumsum(log_1m, axis=3, reverse=True) - log_1m
        a = jnp.where(mask, jnp.exp(log_beta + between), 0.0)
        return jnp.einsum('bhts,bshd->bthd', a.astype(v.dtype), v)

    out = lax.map(block, (to_blocks(q, nb), jnp.arange(nb)))
    return from_blocks(out).reshape(b, s, h * d)


def compress(t, pos_emb, w1, w2):
    b, s, d = t.shape
    m = (s - CMP_LEN) // CMP_STRIDE + 1
    idx = jnp.arange(m)[:, None] * CMP_STRIDE + jnp.arange(CMP_LEN)[None, :]
    blocks = t[:, idx] + pos_emb.astype(t.dtype)
    hid = jax.nn.gelu(blocks.reshape(b, m, CMP_LEN * d) @ w1)
    return hid @ w2


def nsa(q, k_cmp, v_cmp, k_slc, v_slc, k_win, v_win, gates, cmp_pos, cmp_w1, cmp_w2):
    b, s, h, d = q.shape
    nb = s // BLOCK_Q
    scale = d ** -0.5
    kc = compress(k_cmp, cmp_pos[0], cmp_w1[0], cmp_w2[0])
    vc = compress(v_cmp, cmp_pos[1], cmp_w1[1], cmp_w2[1])
    m = kc.shape[1]
    cmp_end = jnp.arange(m) * CMP_STRIDE + CMP_LEN - 1
    ns = s // SEL_LEN
    n_top = min(SEL_TOPN, ns)
    ks_blocks = k_slc.reshape(b, ns, SEL_LEN, d)
    vs_blocks = v_slc.reshape(b, ns, SEL_LEN, d)
    cs = (jnp.arange(m) * CMP_STRIDE)[:, None]
    ss = (jnp.arange(ns) * SEL_LEN)[None, :]
    overlap = jnp.clip(jnp.minimum(cs + CMP_LEN, ss + SEL_LEN) - jnp.maximum(cs, ss), 0).astype(jnp.float32) / CMP_LEN
    blk_ids = jnp.arange(ns)
    kw_pad = jnp.pad(k_win, ((0, 0), (WINDOW, 0), (0, 0)))
    vw_pad = jnp.pad(v_win, ((0, 0), (WINDOW, 0), (0, 0)))
    gather = jax.vmap(lambda blk, ix: blk[ix])

    def block(args):
        qi, gi, i = args
        qpos = i * BLOCK_Q + jnp.arange(BLOCK_Q)
        s_cmp = jnp.einsum('bthd,bmd->bhtm', qi, kc).astype(jnp.float32) * scale
        p_cmp = masked_softmax(s_cmp, cmp_end[None, :] <= qpos[:, None])
        o_cmp = jnp.einsum('bhtm,bmd->bthd', p_cmp.astype(vc.dtype), vc)
        imp = jnp.einsum('bhtm,mj->btj', p_cmp, overlap)
        valid = (blk_ids * SEL_LEN)[None, :] <= qpos[:, None]
        forced = (blk_ids[None, :] == 0) | (blk_ids[None, :] == (qpos // SEL_LEN)[:, None])
        score = jnp.where(valid, imp + jnp.where(forced, FORCE_SCORE, 0.0), -jnp.inf)
        top_val, top_idx = lax.top_k(score, n_top)
        sel_ok = jnp.isfinite(top_val)
        kg = gather(ks_blocks, top_idx)
        vg = gather(vs_blocks, top_idx)
        s_slc = jnp.einsum('bthd,btkld->bhtkl', qi, kg).astype(jnp.float32) * scale
        tok_pos = top_idx[..., None] * SEL_LEN + jnp.arange(SEL_LEN)
        m_slc = sel_ok[..., None] & (tok_pos <= qpos[None, :, None, None])
        p_slc = masked_softmax(s_slc.reshape(b, h, BLOCK_Q, n_top * SEL_LEN),
                               m_slc.reshape(b, 1, BLOCK_Q, n_top * SEL_LEN))
        o_slc = jnp.einsum('bhtkl,btkld->bthd', p_slc.reshape(s_slc.shape).astype(vg.dtype), vg)
        kw = lax.dynamic_slice_in_dim(kw_pad, i * BLOCK_Q, WINDOW + BLOCK_Q, axis=1)
        vw = lax.dynamic_slice_in_dim(vw_pad, i * BLOCK_Q, WINDOW + BLOCK_Q, axis=1)
        kwpos = i * BLOCK_Q - WINDOW + jnp.arange(WINDOW + BLOCK_Q)
        m_win = (kwpos[None, :] <= qpos[:, None]) & (kwpos[None, :] > qpos[:, None] - WINDOW) & (kwpos[None, :] >= 0)
        s_win = jnp.einsum('bthd,bsd->bhts', qi, kw).astype(jnp.float32) * scale
        p_win = masked_softmax(s_win, m_win)
        o_win = jnp.einsum('bhts,bsd->bthd', p_win.astype(vw.dtype), vw)
        return gi[..., 0:1] * o_cmp + gi[..., 1:2] * o_slc + gi[..., 2:3] * o_win

    out = lax.map(block, (to_blocks(q, nb), to_blocks(gates, nb), jnp.arange(nb)))
    return from_blocks(out).reshape(b, s, h * d)


def hybrid_mixer(hn, w_in, sgu_norm_g, sgu_w, sgu_b, cmp_pos, cmp_w1, cmp_w2, w_branch, w_out, cos, sin):
    b, s, _ = hn.shape
    proj = hn @ w_in
    a_in, sb_q, sb_k, sb_v, c_q, c_kv, c_g, br_g = jnp.split(proj, IN_SPLITS, axis=-1)
    heads = lambda t, n: t.reshape(b, s, n, HEAD_DIM)
    y_a = sgu_mixer(a_in, sgu_norm_g, sgu_w, sgu_b)
    y_b = stick_breaking(heads(sb_q, SB_HEADS), heads(sb_k, SB_HEADS), heads(sb_v, SB_HEADS))
    q = rope_partial(heads(c_q, NSA_HEADS), cos, sin)
    k_cmp, v_cmp, k_slc, v_slc, k_win, v_win = jnp.split(c_kv, 6, axis=-1)
    rk = lambda t: rope_partial(t[:, :, None, :], cos, sin)[:, :, 0, :]
    nsa_g = jax.nn.sigmoid(c_g.astype(jnp.float32)).reshape(b, s, NSA_HEADS, 3).astype(hn.dtype)
    y_c = nsa(q, rk(k_cmp), v_cmp, rk(k_slc), v_slc, rk(k_win), v_win, nsa_g, cmp_pos, cmp_w1, cmp_w2)
    g = jax.nn.sigmoid(br_g.astype(jnp.float32)).reshape(b, s, N_BRANCH, D_MODEL).astype(hn.dtype)
    merged = (g[:, :, 0] * (y_a @ w_branch[0]) + g[:, :, 1] * (y_b @ w_branch[1])
              + g[:, :, 2] * (y_c @ w_branch[2]))
    return merged @ w_out


def swiglu(h, w_gate, w_up, w_down):
    return (jax.nn.silu(h @ w_gate) * (h @ w_up)) @ w_down


def moe_swiglu(h, router_w, w_gate, w_up, w_down):
    b, s, d = h.shape
    n = b * s
    chunk = MOE_TOKEN_BLOCK if n % MOE_TOKEN_BLOCK == 0 else BLOCK_Q
    logits = (h @ router_w).astype(jnp.float32)
    top_val, top_idx = lax.top_k(logits, TOP_K)
    wts = jax.nn.softmax(top_val, axis=-1)
    gate = jnp.sum(jax.nn.one_hot(top_idx, N_EXPERTS, dtype=jnp.float32) * wts[..., None], axis=-2)

    def run(args):
        xc, gc = args
        a = jnp.einsum('nd,edf->nef', xc, w_gate)
        u = jnp.einsum('nd,edf->nef', xc, w_up)
        hid = jax.nn.silu(a) * u * gc[..., None].astype(xc.dtype)
        return jnp.einsum('nef,efd->nd', hid, w_down)

    out = lax.map(run, (h.reshape(n // chunk, chunk, d), gate.reshape(n // chunk, chunk, N_EXPERTS)))
    return out.reshape(b, s, d)


def setup_inputs(seed: int = 0) -> dict:
    key = jax.random.key(seed)
    ks = jax.random.split(key, 24)
    n_dense = (DEPTH + 1) // 2
    n_moe = DEPTH // 2
    nrm = lambda k, shape, sc: jax.random.normal(k, shape, jnp.float32) * sc
    return {
        "x": nrm(ks[0], (BATCH, SEQ, D_MODEL), 1.0),
        "norm1_g": 1.0 + nrm(ks[1], (DEPTH, D_MODEL), 0.02),
        "w_in": nrm(ks[2], (DEPTH, D_MODEL, C_IN), D_MODEL ** -0.5),
        "sgu_norm_g": 1.0 + nrm(ks[3], (DEPTH, SGU_WIDTH), 0.02),
        "sgu_w": nrm(ks[4], (DEPTH, SGU_GROUPS, SGU_CHUNK, SGU_CHUNK), SGU_CHUNK ** -0.5),
        "sgu_b": 1.0 + nrm(ks[5], (DEPTH, SGU_GROUPS, SGU_CHUNK), 0.1),
        "cmp_pos": nrm(ks[6], (DEPTH, 2, CMP_LEN, HEAD_DIM), 0.02),
        "cmp_w1": nrm(ks[7], (DEPTH, 2, CMP_LEN * HEAD_DIM, CMP_HIDDEN), (CMP_LEN * HEAD_DIM) ** -0.5),
        "cmp_w2": nrm(ks[8], (DEPTH, 2, CMP_HIDDEN, HEAD_DIM), CMP_HIDDEN ** -0.5),
        "w_branch": nrm(ks[9], (DEPTH, N_BRANCH, SB_WIDTH, D_MODEL), SB_WIDTH ** -0.5),
        "w_out": nrm(ks[10], (DEPTH, D_MODEL, D_MODEL), D_MODEL ** -0.5),
        "norm2_g": 1.0 + nrm(ks[11], (DEPTH, D_MODEL), 0.02),
        "ffn_w_gate": nrm(ks[12], (n_dense, D_MODEL, D_FF), D_MODEL ** -0.5),
        "ffn_w_up": nrm(ks[13], (n_dense, D_MODEL, D_FF), D_MODEL ** -0.5),
        "ffn_w_down": nrm(ks[14], (n_dense, D_FF, D_MODEL), D_FF ** -0.5),
        "router_w": nrm(ks[15], (n_moe, D_MODEL, N_EXPERTS), D_MODEL ** -0.5),
        "moe_w_gate": nrm(ks[16], (n_moe, N_EXPERTS, D_MODEL, D_FF_EXPERT), D_MODEL ** -0.5),
        "moe_w_up": nrm(ks[17], (n_moe, N_EXPERTS, D_MODEL, D_FF_EXPERT), D_MODEL ** -0.5),
        "moe_w_down": nrm(ks[18], (n_moe, N_EXPERTS, D_FF_EXPERT, D_MODEL), D_FF_EXPERT ** -0.5),
        "final_norm_g": 1.0 + nrm(ks[19], (D_MODEL,), 0.02),
    }


def reference(x, norm1_g, w_in, sgu_norm_g, sgu_w, sgu_b, cmp_pos, cmp_w1, cmp_w2, w_branch, w_out,
              norm2_g, ffn_w_gate, ffn_w_up, ffn_w_down, router_w, moe_w_gate, moe_w_up, moe_w_down,
              final_norm_g):
    cos, sin = rope_tables(x.shape[1])
    h = x
    for layer in range(DEPTH):
        hn = rmsnorm(h, norm1_g[layer])
        h = h + hybrid_mixer(hn, w_in[layer], sgu_norm_g[layer], sgu_w[layer], sgu_b[layer], cmp_pos[layer],
                             cmp_w1[layer], cmp_w2[layer], w_branch[layer], w_out[layer], cos, sin)
        hn = rmsnorm(h, norm2_g[layer])
        j = layer // 2
        if layer % 2 == 0:
            h = h + swiglu(hn, ffn_w_gate[j], ffn_w_up[j], ffn_w_down[j])
        else:
            h = h + moe_swiglu(hn, router_w[j], moe_w_gate[j], moe_w_up[j], moe_w_down[j])
    return rmsnorm(h, final_norm_g)
```

```cpp
#define MK_STEPS_PER_LAUNCH 1000
#define PG8_WGM 4
#define FFN_CHUNKS 1
#include <hip/hip_runtime.h>
#include <cstdio>
#include <cstdint>
#include <cmath>
#ifndef PG8_WGM
#define PG8_WGM 8
#endif
namespace pg8 {
#define PG8_LAS __attribute__((address_space(3)))
typedef unsigned short bf16_t;
typedef short bf16x8 __attribute__((ext_vector_type(8)));
typedef float f32x4 __attribute__((ext_vector_type(4)));
typedef unsigned u32x4 __attribute__((ext_vector_type(4)));
constexpr int BM = 256, BK = 64, HALF = 128, HTB = HALF * BK * 2  , STAGE_BYTES = 8 * HTB, NXCD = 8, WGM = PG8_WGM;

__host__ __device__ __forceinline__ int lds_byte(int r, int c) { const int st = (r >> 4) * 2 + (c >> 5), rr = r & 15, cc = c & 31, ob = rr * 64 + cc * 2; return st * 1024 + (ob ^ (((ob >> 9) & 1) << 5)); }
__host__ __device__ __forceinline__ void stage_rc(int b, int& R, int& C) { const int st = b / 1024, sb = b % 1024, swz = sb ^ (((sb >> 9) & 1) << 5); R = (st >> 1) * 16 + swz / 64; C = (st & 1) * 32 + (swz % 64) / 2; }
__host__ __device__ __forceinline__ int perm32(int rho) { const int n = rho >> 4, i = rho & 15; return 8 * (i >> 2) + 4 * n + (i & 3); }

struct Unit { int pm, pn; };
struct Gemm { const bf16_t* A; const bf16_t* Bt; int M, N, K; int zv; int rot; int tiled; };

struct StaticOrder {
    int nM, nN, nwg, G, c;
    __host__ __device__ void init(int M, int N, int G_, int c_) { nM = M / BM; nN = N / BM; nwg = nM * nN; G = G_; c = c_; }
    __host__ __device__ bool next(int i, Unit& u) const {
        const long L = (long)i * G + c; if (L >= nwg) return false;
        int wgid = (int)L; { const int q = nwg / NXCD, r = nwg % NXCD, xcd = wgid % NXCD, off = wgid / NXCD; wgid = (xcd < r ? xcd * (q + 1) : r * (q + 1) + (xcd - r) * q) + off; }
        const int nig = WGM * nN, gid = wgid / nig, fm = gid * WGM, gsz = (nM - fm) < WGM ? (nM - fm) : WGM;
        u.pm = fm + ((wgid % nig) % gsz); u.pn = (wgid % nig) / gsz; return true;
    }
    __device__ __forceinline__ void a_ready(const Unit&) const {}
    __device__ __forceinline__ void done(const Unit&) const {}
};

__device__ __forceinline__ unsigned cvt_pk_bf16(float lo, float hi) { unsigned r; asm volatile("v_cvt_pk_bf16_f32 %0, %1, %2" : "=v"(r) : "v"(lo), "v"(hi)); return r; }
typedef float f32x2 __attribute__((ext_vector_type(2)));

__device__ __forceinline__ float fast_sigmoid(float x) { return __builtin_amdgcn_rcpf(1.0f + __builtin_amdgcn_exp2f(-1.4426950408889634f * x)); }
__device__ __forceinline__ float gelu_tanh(float x) {
    const float u2 = 1.5957691216057308f * (x + 0.044715f * x * x * x);
    return x * fast_sigmoid(u2);
}
__device__ __forceinline__ float bf_lo(unsigned u) { return __builtin_bit_cast(float, u << 16); }
__device__ __forceinline__ float bf_hi(unsigned u) { return __builtin_bit_cast(float, u & 0xffff0000u); }

#ifdef PG8_NT_OUT
#define PG8_STORE_OUT(p, v) __builtin_nontemporal_store((v), (p))
#else
#define PG8_STORE_OUT(p, v) (*(p) = (v))
#endif
struct EpiProj {
    static constexpr bool PERM = true, AFTER_DRAIN = false, MID = false; static constexpr int MID_TILES = 1; __device__ __forceinline__ void set_scale0() {}
    bf16_t* P1; bf16_t* G;
    __device__ __forceinline__ void operator()(const f32x4 (&acc)[2][2][4][2], const Unit& u, int wr, int wc, int fr, int fq) const {
        const int row0 = u.pm * BM + wr * 64 + fr;
        bf16_t* base; int ldc, colt, act0, act1;
        if (u.pn < 8) { base = P1; ldc = 2048; colt = u.pn * BM; act0 = (u.pn < 2) ? 1 : 0; act1 = (u.pn == 7) ? 2 : act0; }
        else { base = G; ldc = 3072; colt = (u.pn - 8) * BM; act0 = 2; act1 = 2; }
        const int col0 = colt + wc * 32 + 8 * fq;
#pragma unroll
        for (int ai = 0; ai < 2; ++ai)
#pragma unroll
            for (int m = 0; m < 4; ++m) { bf16_t* rowp = base + (size_t)(row0 + ai * HALF + m * 16) * ldc + col0;
#pragma unroll
                for (int bj = 0; bj < 2; ++bj) { f32x4 v0 = acc[ai][bj][m][0], v1 = acc[ai][bj][m][1]; const int act = bj ? act1 : act0;
                    if (act == 1) {
#pragma unroll
                        for (int e = 0; e < 4; ++e) { v0[e] = gelu_tanh(v0[e]); v1[e] = gelu_tanh(v1[e]); } }
                    else if (act == 2) {
#pragma unroll
                        for (int e = 0; e < 4; ++e) { v0[e] = fast_sigmoid(v0[e]); v1[e] = fast_sigmoid(v1[e]); } }
                    u32x4 w; w.x = cvt_pk_bf16(v0[0], v0[1]); w.y = cvt_pk_bf16(v0[2], v0[3]); w.z = cvt_pk_bf16(v1[0], v1[1]); w.w = cvt_pk_bf16(v1[2], v1[3]);
                    *(u32x4*)(rowp + bj * HALF) = w; } }
    }
};
struct EpiMerge {
    static constexpr bool PERM = true, AFTER_DRAIN = false, MID = false; static constexpr int MID_TILES = 1; __device__ __forceinline__ void set_scale0() {}
    const bf16_t* G; bf16_t* MG; int nmt;
    __device__ __forceinline__ void operator()(const f32x4 (&acc)[2][2][4][2], const Unit& u, int wr, int wc, int fr, int fq) const {
        const int i = u.pn >> 2, pn = u.pn & 3, pm = u.pm - i * nmt;
        const int row0 = pm * BM + wr * 64 + fr, col0 = pn * BM + wc * 32 + 8 * fq;
#pragma unroll
        for (int ai = 0; ai < 2; ++ai)
#pragma unroll
            for (int mp = 0; mp < 2; ++mp) {
                u32x4 g[4], o[4];
#pragma unroll
                for (int q = 0; q < 4; ++q) { const int m = 2 * mp + (q >> 1), bj = q & 1; const size_t row = (size_t)(row0 + ai * HALF + m * 16); const int col = col0 + bj * HALF;
                    g[q] = *(const u32x4*)(G + row * 3072 + i * 1024 + col);
                    if (i > 0) o[q] = *(const u32x4*)(MG + row * 1024 + col); else o[q] = (u32x4){0u, 0u, 0u, 0u}; }
#pragma unroll
                for (int q = 0; q < 4; ++q) { const int m = 2 * mp + (q >> 1), bj = q & 1; const size_t row = (size_t)(row0 + ai * HALF + m * 16); const int col = col0 + bj * HALF;
                    f32x4 v0 = acc[ai][bj][m][0], v1 = acc[ai][bj][m][1];
#ifdef ABL_BRANCH
                    if (i == ABL_BRANCH) { v0 = v0 * (float)ABL_SCALE; v1 = v1 * (float)ABL_SCALE; }
#endif
                    v0[0] = v0[0] * bf_lo(g[q].x) + bf_lo(o[q].x); v0[1] = v0[1] * bf_hi(g[q].x) + bf_hi(o[q].x); v0[2] = v0[2] * bf_lo(g[q].y) + bf_lo(o[q].y); v0[3] = v0[3] * bf_hi(g[q].y) + bf_hi(o[q].y);
                    v1[0] = v1[0] * bf_lo(g[q].z) + bf_lo(o[q].z); v1[1] = v1[1] * bf_hi(g[q].z) + bf_hi(o[q].z); v1[2] = v1[2] * bf_lo(g[q].w) + bf_lo(o[q].w); v1[3] = v1[3] * bf_hi(g[q].w) + bf_hi(o[q].w);
                    u32x4 w; w.x = cvt_pk_bf16(v0[0], v0[1]); w.y = cvt_pk_bf16(v0[2], v0[3]); w.z = cvt_pk_bf16(v1[0], v1[1]); w.w = cvt_pk_bf16(v1[2], v1[3]);
                    *(u32x4*)(MG + row * 1024 + col) = w; } }
    }
};
struct EpiResid {
    static constexpr bool PERM = false, AFTER_DRAIN = false, MID = false; static constexpr int MID_TILES = 1; __device__ __forceinline__ void set_scale0() { scale = 0.f; base = out; }
    const float* base; float* out; int ldc; float scale;
    __device__ __forceinline__ void operator()(const f32x4 (&acc)[2][2][4][2], const Unit& u, int wr, int wc, int fr, int fq) const {
        const int row0 = u.pm * BM + wr * 64 + fr, col0 = u.pn * BM + wc * 32 + 4 * fq;
#pragma unroll
        for (int ai = 0; ai < 2; ++ai)
#pragma unroll
            for (int mp = 0; mp < 2; ++mp) {
                f32x4 b[8];
#pragma unroll
                for (int q = 0; q < 8; ++q) { const int m = 2 * mp + (q >> 2), bj = (q >> 1) & 1, n = q & 1;
                    b[q] = *(const f32x4*)(base + (size_t)(row0 + ai * HALF + m * 16) * ldc + col0 + bj * HALF + n * 16); }
#pragma unroll
                for (int q = 0; q < 8; ++q) { const int m = 2 * mp + (q >> 2), bj = (q >> 1) & 1, n = q & 1;
                    *(f32x4*)(out + (size_t)(row0 + ai * HALF + m * 16) * ldc + col0 + bj * HALF + n * 16) = b[q] + acc[ai][bj][m][n] * scale; } }
    }
};
struct EpiF32 {
    static constexpr bool PERM = false, AFTER_DRAIN = false, MID = false; static constexpr int MID_TILES = 1; __device__ __forceinline__ void set_scale0() {}
    float* O; int ldc, nN;
    __device__ __forceinline__ void operator()(const f32x4 (&acc)[2][2][4][2], const Unit& u, int wr, int wc, int fr, int fq) const {
        const int row0 = u.pm * BM + wr * 64 + fr, col0 = (u.pn % nN) * BM + wc * 32 + 4 * fq;
#pragma unroll
        for (int ai = 0; ai < 2; ++ai)
#pragma unroll
            for (int m = 0; m < 4; ++m) { const size_t off = (size_t)(row0 + ai * HALF + m * 16) * ldc + col0;
#pragma unroll
                for (int bj = 0; bj < 2; ++bj)
#pragma unroll
                    for (int n = 0; n < 2; ++n) *(f32x4*)(O + off + bj * HALF + n * 16) = acc[ai][bj][m][n]; }
    }
};
#ifdef EMU_FP8_HID
__device__ __forceinline__ float Q8H(float x) { const int p = __builtin_amdgcn_cvt_pk_fp8_f32(x * 8.f, x * 8.f, 0, false); return __builtin_amdgcn_cvt_f32_fp8(p, 0) * 0.125f; }
#else
__device__ __forceinline__ float Q8H(float x) { return x; }
#endif
struct EpiSwiGLU {
    static constexpr bool PERM = true, AFTER_DRAIN = false, MID = false; static constexpr int MID_TILES = 1; __device__ __forceinline__ void set_scale0() {}
    bf16_t* H; int ldh; const float* rowscale; int nN; int rowmask = 0x7fffffff;
    __device__ __forceinline__ void operator()(const f32x4 (&acc)[2][2][4][2], const Unit& u, int wr, int wc, int fr, int fq) const {
        const int row0 = u.pm * BM + wr * 64 + fr, col0 = (u.pn % nN) * HALF + wc * 32 + 8 * fq;
        float scv[8];
#pragma unroll
        for (int q = 0; q < 8; ++q) scv[q] = rowscale ? rowscale[row0 + (q >> 2) * HALF + (q & 3) * 16] : 1.0f;
#pragma unroll
        for (int ai = 0; ai < 2; ++ai)
#pragma unroll
            for (int m = 0; m < 4; ++m) { const int row = row0 + ai * HALF + m * 16; const float sc = scv[ai * 4 + m];
                float h[8];
#pragma unroll
                for (int n = 0; n < 2; ++n)
#pragma unroll
                    for (int e = 0; e < 4; ++e) { const float g = acc[ai][0][m][n][e], up = acc[ai][1][m][n][e]; h[n * 4 + e] = Q8H(g * fast_sigmoid(g) * up * sc); }
                u32x4 w; w.x = cvt_pk_bf16(h[0], h[1]); w.y = cvt_pk_bf16(h[2], h[3]); w.z = cvt_pk_bf16(h[4], h[5]); w.w = cvt_pk_bf16(h[6], h[7]);
                PG8_STORE_OUT((u32x4*)(H + (size_t)(row & rowmask) * ldh + col0), w); }
    }
};
struct EpiScatter {
    static constexpr bool PERM = false, AFTER_DRAIN = false, MID = false; static constexpr int MID_TILES = 1; __device__ __forceinline__ void set_scale0() { scale = 0.f; }
    float* out; const int* tok; int nN; float scale;
    __device__ __forceinline__ void operator()(const f32x4 (&acc)[2][2][4][2], const Unit& u, int wr, int wc, int fr, int fq) const {
        const int row0 = u.pm * BM + wr * 64 + fr, col0 = (u.pn % nN) * BM + wc * 32 + 4 * fq;
        int tk[8];
#pragma unroll
        for (int q = 0; q < 8; ++q) tk[q] = tok[row0 + (q >> 2) * HALF + (q & 3) * 16];
#pragma unroll
        for (int ai = 0; ai < 2; ++ai)
#pragma unroll
            for (int mp = 0; mp < 2; ++mp) {
                f32x4 b[8];
#pragma unroll
                for (int q = 0; q < 8; ++q) { const int m = 2 * mp + (q >> 2), bj = (q >> 1) & 1, n = q & 1; const int t = tk[ai * 4 + m];
                    b[q] = *(const f32x4*)(out + (size_t)(t < 0 ? 0 : t) * 1024 + col0 + bj * HALF + n * 16); }
#pragma unroll
                for (int q = 0; q < 8; ++q) { const int m = 2 * mp + (q >> 2), bj = (q >> 1) & 1, n = q & 1; const int t = tk[ai * 4 + m];
#ifdef ABL_MOE
                    if (false)
#else
                    if (t >= 0)
#endif
                        *(f32x4*)(out + (size_t)t * 1024 + col0 + bj * HALF + n * 16) = b[q] + acc[ai][bj][m][n] * scale; } }
    }
};
struct GroupedOrder {
    StaticOrder so; const PG8_LAS int* tile_e; int nN;
    __device__ __forceinline__ bool next(int i, Unit& u) const { if (!so.next(i, u)) return false; u.pn += tile_e[u.pm] * nN; return true; }
    __device__ __forceinline__ void a_ready(const Unit&) const {}
    __device__ __forceinline__ void done(const Unit&) const {}
};
struct ProbeOrder {
    StaticOrder so; int pm_mask;
    __device__ __forceinline__ bool next(int i, Unit& u) const { if (!so.next(i, u)) return false; u.pm &= pm_mask; return true; }
    __device__ __forceinline__ void a_ready(const Unit&) const {}
    __device__ __forceinline__ void done(const Unit&) const {}
};
struct MergeOrder {
    StaticOrder so; int nmt;
    __device__ __forceinline__ bool next(int i, Unit& u) const { const int b = i % 3; if (!so.next(i / 3, u)) return false; u.pm += b * nmt; u.pn += b * 4; return true; }
    __device__ __forceinline__ void a_ready(const Unit&) const {}
    __device__ __forceinline__ void done(const Unit&) const {}
};
template <class Epi, class Sched, bool ALIGN_EPI = false, bool SP2 = false>
__device__ __forceinline__ void gemm_phase(PG8_LAS unsigned char* lds, const Gemm g, const Sched& S, const Epi& E) {
    const int tid = g.zv  , wid = __builtin_amdgcn_readfirstlane(tid >> 6), lane = tid & 63, wr = wid >> 2, wc = wid & 3, fr = lane & 15, fq = lane >> 4;
    const int K = g.K, nt = K / BK;
    unsigned voffA[2], voffB[2];
#pragma unroll
    for (int i = 0; i < 2; ++i) { int R, C; stage_rc(tid * 16 + i * 8192, R, C); const int Rb = Epi::PERM ? ((R & ~31) + perm32(R & 31)) : R;
        const int pitch = g.tiled ? BK : K;
        voffA[i] = (unsigned)(R * pitch + C) * 2u; voffB[i] = (unsigned)(Rb * pitch + C) * 2u; }
    const size_t kstep = g.tiled ? (size_t)(BM * BK * 2) : (size_t)(BK * 2);
    const size_t hstep = g.tiled ? (size_t)(HALF * BK * 2) : (size_t)HALF * K * 2;
    const size_t tstep = (size_t)BM * K * 2;
    const unsigned ldsw = (unsigned)wid * 1024u;
    const int aoff = lds_byte(wr * 64 + fr, fq * 8), boff = lds_byte(wc * 32 + fr, fq * 8);
#define PG8_SA(b, h) (((b) * 2 + (h)) * HTB)
#define PG8_SB(b, h) ((4 + (b) * 2 + (h)) * HTB)
#define PG8_STAGE(bufoff, gbase, voff) do { _Pragma("unroll") for (int _i = 0; _i < 2; ++_i) \
        __builtin_amdgcn_global_load_lds((const unsigned*)((const char*)(gbase) + (voff)[_i]), (PG8_LAS unsigned*)(lds + (bufoff) + ldsw + _i * 8192), 16, 0, 0); } while (0)
#define PG8_LDA(dst, b, h) do { _Pragma("unroll") for (int m = 0; m < 4; ++m) _Pragma("unroll") for (int k = 0; k < 2; ++k) dst[m][k] = *(const PG8_LAS bf16x8*)(lds + PG8_SA(b, h) + aoff + m * 2048 + k * 1024); } while (0)
#define PG8_LDB(dst, b, h) do { _Pragma("unroll") for (int n = 0; n < 2; ++n) _Pragma("unroll") for (int k = 0; k < 2; ++k) dst[n][k] = *(const PG8_LAS bf16x8*)(lds + PG8_SB(b, h) + boff + n * 2048 + k * 1024); } while (0)
#define PG8_MMA(ai, bj, At, Bt) do { __builtin_amdgcn_s_setprio(1); _Pragma("unroll") for (int m = 0; m < 4; ++m) _Pragma("unroll") for (int n = 0; n < 2; ++n) _Pragma("unroll") for (int k = 0; k < 2; ++k) \
        acc[ai][bj][m][n] = __builtin_amdgcn_mfma_f32_16x16x32_bf16(Bt[n][k], At[m][k], acc[ai][bj][m][n], 0, 0, 0); __builtin_amdgcn_s_setprio(0); } while (0)
#define PG8_WAIT_V(n) asm volatile("s_waitcnt vmcnt(" #n ")" ::: "memory")
#define PG8_WAIT_L(n) asm volatile("s_waitcnt lgkmcnt(" #n ")" ::: "memory")
#define PG8_BAR __builtin_amdgcn_s_barrier()
#define PG8_SCHED __builtin_amdgcn_sched_barrier(0)
    Unit cur, nxt; int ui = 0;
    if (!S.next(0, cur)) return;
    f32x4 acc[2][2][4][2];
#pragma unroll
    for (int a = 0; a < 2; ++a)
#pragma unroll
        for (int b = 0; b < 2; ++b)
#pragma unroll
            for (int m = 0; m < 4; ++m)
#pragma unroll
                for (int n = 0; n < 2; ++n) acc[a][b][m][n] = (f32x4){0.f, 0.f, 0.f, 0.f};
    bf16x8 At[4][2], B0[2][2], B1[2][2];
    const char* cA = (const char*)g.A + (size_t)cur.pm * tstep; const char* cB = (const char*)g.Bt + (size_t)cur.pn * tstep;
    const int rot = g.rot; const size_t rofs = (size_t)rot * kstep; const char* pA = cA + rofs; const char* pB = cB + rofs;
#define PG8_KT(x) ((size_t)(((x) + rot >= nt) ? (x) + rot - nt : (x) + rot))
    S.a_ready(cur);
    if constexpr (SP2) {
        PG8_STAGE(PG8_SB(0, 0), pB, voffB); PG8_STAGE(PG8_SB(0, 1), pB + hstep, voffB); PG8_STAGE(PG8_SA(0, 0), pA, voffA); PG8_STAGE(PG8_SA(0, 1), pA + hstep, voffA);
        if (wr == 1) PG8_BAR;
        PG8_WAIT_V(2); PG8_BAR;
        PG8_STAGE(PG8_SB(1, 0), pB + kstep, voffB); PG8_STAGE(PG8_SA(1, 0), pA + kstep, voffA); PG8_STAGE(PG8_SB(1, 1), pB + hstep + kstep, voffB);
        PG8_WAIT_V(6); PG8_BAR;
    } else {
        PG8_STAGE(PG8_SB(0, 0), pB, voffB); PG8_STAGE(PG8_SA(0, 0), pA, voffA); PG8_STAGE(PG8_SB(0, 1), pB + hstep, voffB); PG8_STAGE(PG8_SA(0, 1), pA + hstep, voffA);
        if (wr == 1) PG8_BAR;
        PG8_WAIT_V(4); PG8_BAR;
        PG8_STAGE(PG8_SB(1, 0), pB + kstep, voffB); PG8_STAGE(PG8_SA(1, 0), pA + kstep, voffA); PG8_STAGE(PG8_SB(1, 1), pB + hstep + kstep, voffB);
        PG8_WAIT_V(6); PG8_BAR;
    }
    for (;;) {
        const bool has_next = S.next(ui + 1, nxt);
        const char* nA = has_next ? (const char*)g.A + (size_t)nxt.pm * tstep : cA; const char* nB = has_next ? (const char*)g.Bt + (size_t)nxt.pn * tstep : cB;
        for (int t = 0; t < nt; t += 2) {
            if constexpr (Epi::MID) { if (t != 0 && (t & (Epi::MID_TILES - 1)) == 0) E.mid(acc, cur, t / Epi::MID_TILES, wr, wc, fr, fq); }
            const bool last = (t == nt - 2);
            const char* a1 = cA + PG8_KT(t + 1) * kstep;
            const char* a2 = last ? nA + rofs : cA + PG8_KT(t + 2) * kstep; const char* b2 = last ? nB + rofs : cB + PG8_KT(t + 2) * kstep;
            const char* a3 = a2 + kstep; const char* b3 = b2 + kstep;
            if (last && has_next) S.a_ready(nxt);
            if constexpr (SP2) {
            PG8_LDB(B0, 0, 0); PG8_LDB(B1, 0, 1); PG8_SCHED; PG8_LDA(At, 0, 0); PG8_STAGE(PG8_SA(1, 1), a1 + hstep, voffA);
            PG8_WAIT_V(8); PG8_WAIT_L(0); PG8_BAR; PG8_MMA(0, 0, At, B0); PG8_MMA(0, 1, At, B1); PG8_BAR; PG8_SCHED;
            PG8_LDA(At, 0, 1); PG8_STAGE(PG8_SB(0, 0), b2, voffB); PG8_STAGE(PG8_SB(0, 1), b2 + hstep, voffB); PG8_STAGE(PG8_SA(0, 0), a2, voffA);
            PG8_WAIT_V(8); PG8_WAIT_L(0); PG8_BAR; PG8_MMA(1, 0, At, B0); PG8_MMA(1, 1, At, B1); PG8_BAR; PG8_SCHED;
            PG8_LDB(B0, 1, 0); PG8_LDB(B1, 1, 1); PG8_SCHED; PG8_LDA(At, 1, 0); PG8_STAGE(PG8_SA(0, 1), a2 + hstep, voffA);
            PG8_WAIT_V(8); PG8_WAIT_L(0); PG8_BAR; PG8_MMA(0, 0, At, B0); PG8_MMA(0, 1, At, B1); PG8_BAR; PG8_SCHED;
            PG8_LDA(At, 1, 1); PG8_STAGE(PG8_SB(1, 0), b3, voffB); PG8_STAGE(PG8_SB(1, 1), b3 + hstep, voffB); PG8_STAGE(PG8_SA(1, 0), a3, voffA);
            PG8_WAIT_V(8); PG8_WAIT_L(0); PG8_BAR; PG8_MMA(1, 0, At, B0); PG8_MMA(1, 1, At, B1); PG8_BAR; PG8_SCHED;
            } else {
            PG8_LDB(B0, 0, 0); PG8_SCHED; PG8_LDA(At, 0, 0); PG8_STAGE(PG8_SA(1, 1), a1 + hstep, voffA);
            PG8_WAIT_L(8); PG8_BAR; PG8_WAIT_L(0); PG8_MMA(0, 0, At, B0); PG8_BAR; PG8_SCHED;
            PG8_LDB(B1, 0, 1); PG8_STAGE(PG8_SB(0, 0), b2, voffB);
            PG8_BAR; PG8_WAIT_L(0); PG8_MMA(0, 1, At, B1); PG8_BAR;
            PG8_LDA(At, 0, 1); PG8_STAGE(PG8_SA(0, 0), a2, voffA);
            PG8_BAR; PG8_WAIT_L(0); PG8_MMA(1, 0, At, B0); PG8_BAR; PG8_SCHED;
            PG8_STAGE(PG8_SB(0, 1), b2 + hstep, voffB);
            PG8_WAIT_V(6); PG8_BAR; PG8_MMA(1, 1, At, B1); PG8_BAR;
            PG8_LDB(B0, 1, 0); PG8_SCHED; PG8_LDA(At, 1, 0); PG8_STAGE(PG8_SA(0, 1), a2 + hstep, voffA);
            PG8_WAIT_L(8); PG8_BAR; PG8_WAIT_L(0); PG8_MMA(0, 0, At, B0); PG8_BAR; PG8_SCHED;
            PG8_LDB(B1, 1, 1); PG8_STAGE(PG8_SB(1, 0), b3, voffB);
            PG8_BAR; PG8_WAIT_L(0); PG8_MMA(0, 1, At, B1); PG8_BAR;
            PG8_LDA(At, 1, 1); PG8_STAGE(PG8_SA(1, 0), a3, voffA);
            PG8_BAR; PG8_WAIT_L(0); PG8_MMA(1, 0, At, B0); PG8_BAR; PG8_SCHED;
            PG8_STAGE(PG8_SB(1, 1), b3 + hstep, voffB);
            PG8_WAIT_V(6); PG8_BAR; PG8_MMA(1, 1, At, B1); PG8_BAR;
            }
        }
        if constexpr (ALIGN_EPI) { if (wr == 0) PG8_BAR; }
        if constexpr (!Epi::AFTER_DRAIN) { E(acc, cur, wr, wc, fr, fq); S.done(cur); }
        if (!has_next) break;
#pragma unroll
        for (int a = 0; a < 2; ++a)
#pragma unroll
            for (int b = 0; b < 2; ++b)
#pragma unroll
                for (int m = 0; m < 4; ++m)
#pragma unroll
                    for (int n = 0; n < 2; ++n) acc[a][b][m][n] = (f32x4){0.f, 0.f, 0.f, 0.f};
        cur = nxt; cA = nA; cB = nB; ++ui;
        if constexpr (ALIGN_EPI) { if (wr == 1) PG8_BAR; }
    }
    PG8_WAIT_V(0);
    if constexpr (!ALIGN_EPI) { if (wr == 0) PG8_BAR; }
    PG8_BAR;
    if constexpr (Epi::AFTER_DRAIN) { E.fused(acc, cur, wr, wc, fr, fq, lds, wid, lane); S.done(cur); }
#undef PG8_KT
#undef PG8_SA
#undef PG8_SB
#undef PG8_STAGE
#undef PG8_LDA
#undef PG8_LDB
#undef PG8_MMA
#undef PG8_WAIT_V
#undef PG8_WAIT_L
#undef PG8_BAR
#undef PG8_SCHED
}
}

constexpr int NWAVES = 8;
constexpr int DM = 1024, BATCH = 16, SEQ = 4096, DEPTH = 4, MTOK = BATCH * SEQ;
constexpr int NCHUNK = 2, MC = MTOK / NCHUNK, BC = BATCH / NCHUNK;
constexpr int CIN = 5004, NPROJ = 5120, P1W = 2048, GWID = 3072;
constexpr int DFF = 2752, DFFP = 2816, NFF1 = 2 * DFFP;
constexpr int NEXP = 8, DFE = 3584, NMOE1 = 2 * DFE;
constexpr int SLOTS = MC + 2048;
constexpr float EPS = 1e-6f;
constexpr int C_U = 0, C_V = 256, C_SBQ = 512, C_SBK = 768, C_SBV = 1024, C_CQ = 1280, C_KCMP = 1536, C_VCMP = 1600, C_KSLC = 1664, C_VSLC = 1728, C_KWIN = 1792, C_VWIN = 1856, C_CG = 1920;

constexpr size_t MiB = 1u << 20;
constexpr size_t WS_CTL = 0, CTL_ZERO_BYTES = 1 * MiB;
constexpr size_t WS_ROPE = 1 * MiB;
constexpr size_t WS_BIAS1 = 1 * MiB + 512 * 1024;
constexpr size_t WS_WIN = 2 * MiB;
constexpr size_t WS_WBR = 12 * MiB;
constexpr size_t WS_WOUT = 14 * MiB;
constexpr size_t WS_WC1 = 16 * MiB;
constexpr size_t WS_WF1 = 18 * MiB;
constexpr size_t WS_WF2 = 130 * MiB;
constexpr size_t WS_HN = 186 * MiB;
constexpr size_t WS_SCR = 314 * MiB;
constexpr size_t WS_P1 = WS_SCR;
constexpr size_t WS_G = WS_P1 + 128 * MiB;
constexpr size_t WS_Y = WS_G + 192 * MiB;
constexpr size_t WS_MG = WS_Y + 48 * MiB;
constexpr size_t WS_KVC = WS_MG + 64 * MiB;
constexpr size_t WS_UL = WS_KVC + 8 * MiB;
constexpr size_t WS_KC = WS_UL + 8 * MiB;
constexpr size_t WS_VT = WS_KC + 1 * MiB;
constexpr size_t WS_KCT = WS_VT + 24 * MiB;
constexpr size_t WS_MIX_END = WS_KCT + 1 * MiB;
constexpr size_t WS_HID = WS_SCR;
constexpr size_t WS_ROUTE = WS_SCR;
constexpr size_t WS_TOKMAP = WS_SCR + 1 * MiB;
constexpr size_t WS_WSLOT = WS_SCR + 2 * MiB;
constexpr size_t WS_XG = WS_SCR + 4 * MiB;
constexpr size_t WS_HIDM = WS_XG + 68 * MiB;
constexpr size_t WS_END = 800 * MiB;
static_assert(WS_MIX_END <= WS_END && WS_HID + (size_t)MTOK * DFFP * 2 <= WS_END && WS_HIDM + (size_t)SLOTS * DFE * 2 <= WS_END, "d_ws map");
static_assert(WS_WF1 + (size_t)NEXP * NMOE1 * DM * 2 <= WS_WF2 && WS_WF2 + (size_t)NEXP * DM * DFE * 2 <= WS_HN, "weight map");
static_assert((size_t)4 * SLOTS * 4 <= 1 * MiB, "tokmap");
constexpr int CW_BAR = 4096;
constexpr int CW_CNT = 131072;
constexpr int CW_CUR = 131072 + 256;
constexpr int MAX_BAR_REGIONS = 32;
constexpr int RING_OFF = 0, RING_BYTES = 131072;
constexpr int LDSCTL_OFF = RING_BYTES, MISC_OFF = LDSCTL_OFF + 320;
constexpr int TAB_OFF = LDSCTL_OFF + 1024;
constexpr int LDS_BYTES = 147456;

#define GAS __attribute__((address_space(1)))
#define LAS __attribute__((address_space(3)))
typedef unsigned short bf16;
typedef unsigned v4u __attribute__((ext_vector_type(4)));
typedef unsigned v2u __attribute__((ext_vector_type(2)));
typedef float f32x4 __attribute__((ext_vector_type(4)));
typedef int v4i __attribute__((ext_vector_type(4)));
typedef __bf16 bf16x2_t __attribute__((ext_vector_type(2)));
#define LDS_WAIT() asm volatile("s_waitcnt lgkmcnt(0)" ::: "memory")
#define VM_WAIT() asm volatile("s_waitcnt vmcnt(0)" ::: "memory")
__device__ __forceinline__ unsigned f2bf(float f) { unsigned u = __builtin_bit_cast(unsigned, f); return (u + 0x7fffu + ((u >> 16) & 1u)) >> 16; }
__device__ __forceinline__ unsigned pk2(float lo, float hi) { return f2bf(lo) | (f2bf(hi) << 16); }
__device__ __forceinline__ float bflo(unsigned u) { return __builtin_bit_cast(float, u << 16); }
__device__ __forceinline__ float bfhi(unsigned u) { return __builtin_bit_cast(float, u & 0xffff0000u); }
__device__ __forceinline__ float bf1(bf16 h) { return __builtin_bit_cast(float, (unsigned)h << 16); }
__device__ __forceinline__ float dot2bf(unsigned a, unsigned b, float c) { return __builtin_amdgcn_fdot2_f32_bf16(__builtin_bit_cast(bf16x2_t, a), __builtin_bit_cast(bf16x2_t, b), c, false); }
#ifdef EMU_FP8
__device__ __forceinline__ float q8r(float x, float s) { const int p = __builtin_amdgcn_cvt_pk_fp8_f32(x * s, x * s, 0, false); return __builtin_amdgcn_cvt_f32_fp8(p, 0) * (1.0f / s); }
#else
__device__ __forceinline__ float q8r(float x, float) { return x; }
#endif
__device__ __forceinline__ float fexp(float x) { return __builtin_amdgcn_exp2f(1.4426950408889634f * x); }
template <int X> __device__ __forceinline__ float swz_xor(float v) { return __builtin_bit_cast(float, __builtin_amdgcn_ds_swizzle(__builtin_bit_cast(int, v), (X << 10) | 0x1f)); }
__device__ __forceinline__ float wave_sum(float v, int lane) {
#pragma unroll
    for (int o = 1; o < 64; o <<= 1) v += __builtin_bit_cast(float, __builtin_amdgcn_ds_bpermute((lane ^ o) << 2, __builtin_bit_cast(int, v)));
    return v;
}
__device__ __forceinline__ float rdlane(float v, int l) { return __builtin_bit_cast(float, __builtin_amdgcn_readlane(__builtin_bit_cast(int, v), l)); }
__device__ __forceinline__ int bperm(int srclane, int v) { return __builtin_amdgcn_ds_bpermute(srclane << 2, v); }
__constant__ double ROPE_INVF[8] = {1.0, 0.19392274474868576, 0.037606030930863933, 0.0072926647372171093, 0.0014142135623730950, 0.00027424817567620730, 5.3182958969449883e-05, 1.0313385377212460e-05};
#define XB_TMO      128
#define XB_XCNT(j)  (256  + 64 * (j))
#define XB_XSUB(j)  (1280 + 64 * (j))
#define XB_XGEN(j)  (2304 + 64 * (j))
#define XB_TOP      3328
#define XB_TOPGEN   3392
#define XCD_BAR_WORDS 3456
#define XB_SPIN_CAP (1u << 18)

__device__ __forceinline__ unsigned xb_ld(unsigned* p)              { return __hip_atomic_load(p, __ATOMIC_RELAXED, __HIP_MEMORY_SCOPE_AGENT); }
__device__ __forceinline__ unsigned xb_add(unsigned* p, unsigned v) { return __hip_atomic_fetch_add(p, v, __ATOMIC_RELAXED, __HIP_MEMORY_SCOPE_AGENT); }
__device__ __forceinline__ unsigned xb_xcc_id() { return (unsigned)__builtin_amdgcn_s_getreg((3 << 11) | 20) & 0xFu; }
#define XB_SPIN(cond, bar) do { unsigned _sp = 0; while (cond) { __builtin_amdgcn_s_sleep(1); \
    if ((++_sp & 255u) == 0u) { if (xb_ld(&(bar)[XB_TMO])) break; if (_sp > XB_SPIN_CAP) { atomicAdd(&(bar)[XB_TMO], 1u); break; } } } } while (0)

__device__ __forceinline__ bool xb_thread0_w(unsigned w, unsigned z) { return w == 0u && __builtin_amdgcn_mbcnt_hi(~0u, __builtin_amdgcn_mbcnt_lo(~0u, z)) == 0u; }
struct XcdBarrier {
    unsigned* bar; unsigned x; unsigned w, z;
    volatile LAS unsigned* st;
};

__device__ __forceinline__ XcdBarrier xcd_barrier_post(unsigned* bar, volatile LAS unsigned* st) {
    XcdBarrier b; b.bar = bar; b.x = xb_xcc_id(); b.st = st; b.w = (unsigned)__builtin_amdgcn_readfirstlane((int)(threadIdx.x >> 6)); b.z = 0u;
    if (xb_thread0_w(b.w, b.z)) (void)xb_add(&bar[XB_XCNT(b.x)], 1u);
    return b;
}
__device__ __forceinline__ void xcd_barrier_complete(unsigned* bar, unsigned x, unsigned& nloc, unsigned& nx) {
    const unsigned G = gridDim.x * gridDim.y * gridDim.z;
    unsigned sum, cnt, mine, sp = 0u;
    for (;;) {
        sum = 0u; cnt = 0u; mine = 0u;
#pragma unroll
        for (unsigned j = 0; j < 16; ++j) { const unsigned c = xb_ld(&bar[XB_XCNT(j)]); sum += c; cnt += (c > 0u) ? 1u : 0u; mine = (j == x) ? c : mine; }
        if (sum == G) break;
        __builtin_amdgcn_s_sleep(1);
        if ((++sp & 255u) == 0u) { if (xb_ld(&bar[XB_TMO])) break; if (sp > XB_SPIN_CAP) { atomicAdd(&bar[XB_TMO], 1u); break; } }
    }
    nloc = mine > 0u ? mine : 1u; nx = cnt > 0u ? cnt : 1u;
}

__device__ __forceinline__ void xcd_barrier(const XcdBarrier& b) {
    asm volatile("s_waitcnt vmcnt(0)" ::: "memory");
    __syncthreads();
    if (xb_thread0_w(b.w, b.z)) {
        unsigned* bar = b.bar;
        __builtin_amdgcn_s_waitcnt(0);
        unsigned nloc = b.st[0], nx = b.st[1];
        if (nloc == 0u) { xcd_barrier_complete(bar, b.x, nloc, nx); b.st[0] = nloc; b.st[1] = nx; }
        const unsigned old = xb_add(&bar[XB_XSUB(b.x)], 1u);
        const unsigned gen = old / nloc;
        if (old + 1u == (gen + 1u) * nloc) {
            __builtin_amdgcn_fence(__ATOMIC_RELEASE, "agent");
            asm volatile("s_waitcnt vmcnt(0)" ::: "memory");
            const unsigned og = xb_add(&bar[XB_TOP], 1u);
            const unsigned tg = og / nx;
            if (og + 1u == (tg + 1u) * nx) xb_add(&bar[XB_TOPGEN], 1u);
            else XB_SPIN(xb_ld(&bar[XB_TOPGEN]) == tg, bar);
            __builtin_amdgcn_fence(__ATOMIC_ACQUIRE, "agent");
            xb_add(&bar[XB_XGEN(b.x)], 1u);
            asm volatile("s_waitcnt vmcnt(0)" ::: "memory");
        } else {
            XB_SPIN(xb_ld(&bar[XB_XGEN(b.x)]) == gen, bar);
            __builtin_amdgcn_fence(__ATOMIC_ACQUIRE, "agent");
            asm volatile("s_waitcnt vmcnt(0)" ::: "memory");
        }
    }
    __syncthreads();
}

struct Frame {
    LAS unsigned char* lds;
    unsigned* ctl;
    int tid, lane, wave, vcu, G, bx, zv, zs, rep;
    unsigned char* ws;
    const float* const* in;
    float* out;
};
#define WSP(T, off) ((T*)(F.ws + (off)))
__device__ __forceinline__ size_t toff(int row, int k, int K) { return (size_t)(row >> 8) * 256 * K + (size_t)(k >> 6) * (256 * 64) + (size_t)(row & 255) * 64 + (k & 63); }

#ifndef TILED_FFN1
#define TILED_FFN1 0
#endif
#ifndef Q8_W1
#define Q8_W1 0.f
#define Q8_W2 0.f
#define Q8_HN 0.f
#define Q8_HID 0.f
#endif
__device__ __forceinline__ int map_row(int kind, int off, int n) { return kind == 0 ? n + off : (kind == 1 ? (n < 1932 ? n : n + 116) : ((n >> 7) * 256 + (n & 127) + off)); }
__device__ __forceinline__ void tr_item(const float* W, int ldw, int N, int ks, int n0, bf16* WT, int ldt, int kd, int kind, int off, LAS unsigned char* scr, int lane, float q8s = 0.f, int tiled = 0) {
    const int nq = (lane & 15) * 4, kq = lane >> 4;
    f32x4 x[16];
#pragma unroll
    for (int i = 0; i < 16; ++i) x[i] = (n0 + nq < N) ? *(const f32x4*)(W + (size_t)(ks + 4 * i + kq) * ldw + n0 + nq) : (f32x4){0.f, 0.f, 0.f, 0.f};
#pragma unroll
    for (int i = 0; i < 16; ++i) { const int k = 4 * i + kq;
#pragma unroll
        for (int c = 0; c < 4; ++c) { float wv = x[i][c]; if (q8s > 0.f) wv = q8r(wv, q8s); *(LAS bf16*)(scr + (nq + c) * 136 + k * 2) = (bf16)f2bf(wv); } }
    LDS_WAIT(); asm volatile("" ::: "memory");
    if (n0 + lane < N) { const LAS v2u* s = (const LAS v2u*)(scr + lane * 136); const int mr = map_row(kind, off, n0 + lane); bf16* dst = tiled ? WT + toff(mr, kd, ldt) : WT + (size_t)mr * ldt + kd;
#pragma unroll
        for (int q = 0; q < 8; ++q) { const v2u a = s[2 * q], b = s[2 * q + 1]; *(v4u*)(dst + 8 * q) = (v4u){a.x, a.y, b.x, b.y}; } }
    LDS_WAIT(); asm volatile("" ::: "memory");
}
__device__ __forceinline__ void conv(Frame& F, const float* W, size_t sW, int nb, int ldw, int N, int ks0, int K, bf16* WT, size_t sWT, int ldt, int kd0, int kind, int off, float q8s = 0.f, int tiled = 0) {
    LAS unsigned char* scr = F.lds + RING_OFF + F.wave * 16384;
    const int gw = F.vcu * NWAVES + F.wave, NGW = F.G * NWAVES;
    const int nblk = (N + 63) / 64, per = (K / 64) * nblk, total = per * nb;
    for (int it = gw; it < total; it += NGW) { const int b = it / per, r = it % per, kb = r / nblk, nbk = r % nblk;
        tr_item(W + (size_t)b * sW, ldw, N, ks0 + 64 * kb, 64 * nbk, WT + (size_t)b * sWT, ldt, kd0 + 64 * kb, kind, off, scr, F.lane, q8s, tiled); }
}
__device__ __forceinline__ void zero_block(Frame& F, bf16* WT, int ldt, int r0, int rows, int c0, int cols, int tiled = 0) {
    const int gt = (F.vcu * NWAVES + F.wave) * 64 + F.lane, NT = F.G * NWAVES * 64, cpr = cols / 8;
    for (int i = gt; i < rows * cpr; i += NT) { const int r = i / cpr, c = i % cpr; const unsigned z = (unsigned)F.zv; *(v4u*)(tiled ? WT + toff(r0 + r, c0 + 8 * c, ldt) : WT + (size_t)(r0 + r) * ldt + c0 + 8 * c) = (v4u){z, z, z, z}; }
}
__device__ __forceinline__ void p_convert(Frame& F, int layer) {
    const int j = layer >> 1;
    conv(F, F.in[2] + (size_t)layer * DM * CIN, 0, 1, CIN, CIN, 0, DM, WSP(bf16, WS_WIN), 0, DM, 0, 1, 0);
    zero_block(F, WSP(bf16, WS_WIN), DM, 1932, 116, 0, DM);
    conv(F, F.in[9] + (size_t)layer * 3 * 256 * DM, (size_t)256 * DM, 3, DM, DM, 0, 256, WSP(bf16, WS_WBR), (size_t)DM * 256, 256, 0, 0, 0);
    conv(F, F.in[10] + (size_t)layer * DM * DM, 0, 1, DM, DM, 0, DM, WSP(bf16, WS_WOUT), 0, DM, 0, 0, 0);
    conv(F, F.in[7] + (size_t)layer * 2 * 2048 * 256, (size_t)2048 * 256, 2, 256, 256, 0, 1024, WSP(bf16, WS_WC1), (size_t)512 * 1024, 1024, 0, 0, 0);
    conv(F, F.in[7] + (size_t)layer * 2 * 2048 * 256, (size_t)2048 * 256, 2, 256, 256, 1024, 1024, WSP(bf16, WS_WC1), (size_t)512 * 1024, 1024, 0, 0, 256);
    if ((layer & 1) == 0) {
        conv(F, F.in[12] + (size_t)j * DM * DFF, 0, 1, DFF, DFF, 0, DM, WSP(bf16, WS_WF1), 0, DM, 0, 2, 0, Q8_W1, TILED_FFN1);
        conv(F, F.in[13] + (size_t)j * DM * DFF, 0, 1, DFF, DFF, 0, DM, WSP(bf16, WS_WF1), 0, DM, 0, 2, 128, Q8_W1, TILED_FFN1);
        zero_block(F, WSP(bf16, WS_WF1), DM, 21 * 256 + 64, 64, 0, DM, TILED_FFN1);
        zero_block(F, WSP(bf16, WS_WF1), DM, 21 * 256 + 128 + 64, 64, 0, DM, TILED_FFN1);
        conv(F, F.in[14] + (size_t)j * DFF * DM, 0, 1, DM, DM, 0, DFF, WSP(bf16, WS_WF2), 0, DFFP, 0, 0, 0, Q8_W2);
        zero_block(F, WSP(bf16, WS_WF2), DFFP, 0, DM, DFF, DFFP - DFF);
    } else {
        conv(F, F.in[16] + (size_t)j * NEXP * DM * DFE, (size_t)DM * DFE, NEXP, DFE, DFE, 0, DM, WSP(bf16, WS_WF1), (size_t)NMOE1 * DM, DM, 0, 2, 0, Q8_W1);
        conv(F, F.in[17] + (size_t)j * NEXP * DM * DFE, (size_t)DM * DFE, NEXP, DFE, DFE, 0, DM, WSP(bf16, WS_WF1), (size_t)NMOE1 * DM, DM, 0, 2, 128, Q8_W1);
        conv(F, F.in[18] + (size_t)j * NEXP * DFE * DM, (size_t)DFE * DM, NEXP, DM, DM, 0, DFE, WSP(bf16, WS_WF2), (size_t)DM * DFE, DFE, 0, 0, 0, Q8_W2);
    }
    if (F.bx < 8) {
        __syncthreads();
        const int kv = F.bx >> 2, jj = (F.bx & 3) * 64 + F.lane;
        const float* pos = F.in[6] + (size_t)(layer * 2 + kv) * 2048; const float* w1 = F.in[7] + (size_t)(layer * 2 + kv) * 2048 * 256;
        float a = 0.f;
        float a1 = 0.f, a2 = 0.f, a3 = 0.f;
#pragma unroll 8
        for (int k = 0; k < 256; k += 4) { const int kk = F.wave * 256 + k;
            a += pos[kk] * w1[(size_t)kk * 256 + jj]; a1 += pos[kk + 1] * w1[(size_t)(kk + 1) * 256 + jj]; a2 += pos[kk + 2] * w1[(size_t)(kk + 2) * 256 + jj]; a3 += pos[kk + 3] * w1[(size_t)(kk + 3) * 256 + jj]; }
        a = (a + a1) + (a2 + a3);
        LAS float* red = (LAS float*)(F.lds + RING_OFF);
        red[F.wave * 64 + F.lane] = a;
        __syncthreads();
        if (F.wave == 0) { float s = 0.f;
#pragma unroll
            for (int w = 0; w < 8; ++w) s += red[w * 64 + F.lane];
            WSP(float, WS_BIAS1)[kv * 256 + jj] = s; }
        __syncthreads();
    }
    if (layer == 0) {
        const int gt = (F.vcu * NWAVES + F.wave) * 64 + F.lane, NT = F.G * NWAVES * 64;
        for (int idx = gt; idx < SEQ * 8; idx += NT) { const int pos = idx >> 3, i = idx & 7;
            const double invf = ROPE_INVF[i];
            double rev = (double)pos * invf * 0.15915494309189535; rev -= __builtin_floor(rev);
            WSP(float, WS_ROPE)[idx] = __builtin_amdgcn_cosf((float)rev); WSP(float, WS_ROPE)[SEQ * 8 + idx] = __builtin_amdgcn_sinf((float)rev); }
    }
}

template <int MODE> __device__ __forceinline__ void p_norm(Frame& F, const float* src, const float* g, const float* rw, int jmoe, float q8s = 0.f, int tiled = 0) {
    const int gw = F.vcu * NWAVES + F.wave, NGW = F.G * NWAVES, lane = F.lane;
    LAS int* hist = (LAS int*)(F.lds + TAB_OFF) + 192;
    if (MODE == 1) {
        if (F.tid < 32) hist[F.tid] = 0;
        const int gt = gw * 64 + lane, NT = NGW * 64; int* tm = WSP(int, WS_TOKMAP);
        for (int i = gt; i < 4 * SLOTS; i += NT) tm[i] = -1;
        __syncthreads();
    }
    f32x4 gv[4];
#pragma unroll
    for (int jx = 0; jx < 4; ++jx) gv[jx] = ((const f32x4*)g)[lane + 64 * jx];
    for (int m0 = gw; m0 < MTOK; m0 += 2 * NGW) {
        f32x4 v[2][4]; float ss[2];
#pragma unroll
        for (int u = 0; u < 2; ++u) { const int m = m0 + u * NGW; const f32x4* xr = (const f32x4*)(src + (size_t)(m < MTOK ? m : m0) * DM) + lane;
#pragma unroll
            for (int jx = 0; jx < 4; ++jx) v[u][jx] = xr[64 * jx]; }
#pragma unroll
        for (int u = 0; u < 2; ++u) { float s = 0.f;
#pragma unroll
            for (int jx = 0; jx < 4; ++jx) s += (v[u][jx].x * v[u][jx].x + v[u][jx].y * v[u][jx].y) + (v[u][jx].z * v[u][jx].z + v[u][jx].w * v[u][jx].w);
            ss[u] = s; }
#pragma unroll
        for (int o = 1; o < 64; o <<= 1) {
#pragma unroll
            for (int u = 0; u < 2; ++u) ss[u] += __builtin_bit_cast(float, __builtin_amdgcn_ds_bpermute((lane ^ o) << 2, __builtin_bit_cast(int, ss[u]))); }
#pragma unroll
        for (int u = 0; u < 2; ++u) { const int m = m0 + u * NGW; if (m >= MTOK) continue;
            const float rstd = 1.0f / sqrtf(ss[u] * (1.f / DM) + EPS);
#pragma unroll
            for (int jx = 0; jx < 4; ++jx) v[u][jx] = v[u][jx] * rstd * gv[jx];
            if (MODE == 2) {
                f32x4* o = (f32x4*)(F.out + (size_t)m * DM) + lane;
#pragma unroll
                for (int jx = 0; jx < 4; ++jx) o[64 * jx] = v[u][jx];
            } else {
                unsigned long long* o8 = (unsigned long long*)(WSP(bf16, WS_HN) + (size_t)m * DM) + lane;
#pragma unroll
                for (int jx = 0; jx < 4; ++jx) { f32x4 w = v[u][jx];
                    if (tiled) { *(unsigned long long*)(WSP(bf16, WS_HN) + toff(m, 4 * lane + 256 * jx, DM)) = (unsigned long long)pk2(w.x, w.y) | ((unsigned long long)pk2(w.z, w.w) << 32); continue; } if (q8s > 0.f) { w.x = q8r(w.x, q8s); w.y = q8r(w.y, q8s); w.z = q8r(w.z, q8s); w.w = q8r(w.w, q8s); }
                    o8[64 * jx] = (unsigned long long)pk2(w.x, w.y) | ((unsigned long long)pk2(w.z, w.w) << 32); }
            }
            if (MODE == 1) {
                float lg[8];
#pragma unroll
                for (int e = 0; e < 8; ++e) lg[e] = 0.f;
#pragma unroll
                for (int jx = 0; jx < 4; ++jx) { const f32x4* wr = (const f32x4*)(rw + (size_t)(4 * lane + 256 * jx) * 8);
#pragma unroll
                    for (int r = 0; r < 4; ++r) { const f32x4 a = wr[2 * r], b = wr[2 * r + 1]; const float xv = v[u][jx][r];
                        lg[0] += xv * a.x; lg[1] += xv * a.y; lg[2] += xv * a.z; lg[3] += xv * a.w; lg[4] += xv * b.x; lg[5] += xv * b.y; lg[6] += xv * b.z; lg[7] += xv * b.w; } }
                float h4[4], h2[2], h1;
                { const bool up = lane & 1;
#pragma unroll
                  for (int i = 0; i < 4; ++i) { const float keep = up ? lg[4 + i] : lg[i], send = up ? lg[i] : lg[4 + i]; h4[i] = keep + __builtin_bit_cast(float, bperm(lane ^ 1, __builtin_bit_cast(int, send))); } }
                { const bool up = lane & 2;
#pragma unroll
                  for (int i = 0; i < 2; ++i) { const float keep = up ? h4[2 + i] : h4[i], send = up ? h4[i] : h4[2 + i]; h2[i] = keep + __builtin_bit_cast(float, bperm(lane ^ 2, __builtin_bit_cast(int, send))); } }
                { const bool up = lane & 4; const float keep = up ? h2[1] : h2[0], send = up ? h2[0] : h2[1]; h1 = keep + __builtin_bit_cast(float, bperm(lane ^ 4, __builtin_bit_cast(int, send))); }
                h1 += __builtin_bit_cast(float, bperm(lane ^ 8, __builtin_bit_cast(int, h1))); h1 += __builtin_bit_cast(float, bperm(lane ^ 16, __builtin_bit_cast(int, h1))); h1 += __builtin_bit_cast(float, bperm(lane ^ 32, __builtin_bit_cast(int, h1)));
                lg[0] = rdlane(h1, 0); lg[1] = rdlane(h1, 4); lg[2] = rdlane(h1, 2); lg[3] = rdlane(h1, 6); lg[4] = rdlane(h1, 1); lg[5] = rdlane(h1, 5); lg[6] = rdlane(h1, 3); lg[7] = rdlane(h1, 7);
                int e0 = 0; float v0 = lg[0];
#pragma unroll
                for (int e = 1; e < 8; ++e) if (lg[e] > v0) { v0 = lg[e]; e0 = e; }
                int e1 = -1; float v1 = -INFINITY;
#pragma unroll
                for (int e = 0; e < 8; ++e) if (e != e0 && lg[e] > v1) { v1 = lg[e]; e1 = e; }
                const float w0 = 1.0f / (1.0f + fexp(v1 - v0)), w1 = 1.0f - w0;
                if (lane == 0) { WSP(v4i, WS_ROUTE)[m] = (v4i){e0, e1, __builtin_bit_cast(int, w0), __builtin_bit_cast(int, w1)};
                    const int c = m / MC; atomicAdd((int*)&hist[(c * 2 + 0) * 8 + e0], 1); atomicAdd((int*)&hist[(c * 2 + 1) * 8 + e1], 1); }
            }
        }
    }
    if (MODE == 1) {
        __syncthreads();
        if (F.tid < 32) { const int h = hist[F.tid]; if (h) atomicAdd(F.ctl + CW_CNT + jmoe * 32 + F.tid, (unsigned)h); }
    }
}

__device__ __forceinline__ void p_prep(Frame& F) {
    const int gw = F.vcu * NWAVES + F.wave, NGW = F.G * NWAVES, lane = F.lane;
    bf16* P1 = WSP(bf16, WS_P1); bf16* KVC = WSP(bf16, WS_KVC); const float* rope = WSP(float, WS_ROPE);
    for (int row = gw; row < MC; row += NGW) {
        bf16* p = P1 + (size_t)row * P1W; const int pos = row & (SEQ - 1);
        if (lane < 56) { const int vec = lane >> 3, i = lane & 7; const int cb = vec < 4 ? C_CQ + vec * 64 : (vec == 4 ? C_KCMP : (vec == 5 ? C_KSLC : C_KWIN));
            const float x1 = bf1(p[cb + i]), x2 = bf1(p[cb + i + 8]); const float c = rope[pos * 8 + i], s = rope[SEQ * 8 + pos * 8 + i];
            const bf16 o1 = (bf16)f2bf(x1 * c - x2 * s), o2 = (bf16)f2bf(x2 * c + x1 * s);
            p[cb + i] = o1; p[cb + i + 8] = o2;
            if (vec == 4) { KVC[(size_t)row * 64 + i] = o1; KVC[(size_t)row * 64 + i + 8] = o2; } }
        if (lane < 48) KVC[(size_t)row * 64 + 16 + lane] = p[C_KCMP + 16 + lane];
        KVC[(size_t)MC * 64 + (size_t)row * 64 + lane] = p[C_VCMP + lane];
    }
    bf16* VT = WSP(bf16, WS_VT);
    for (int it = gw; it < 6 * BC * 64; it += NGW) { const int which = it / (BC * 64), r = it % (BC * 64), b = r >> 6, blk = r & 63;
        const v4u* src = (const v4u*)(P1 + ((size_t)b * SEQ + blk * 64 + lane) * P1W + (which == 0 ? C_VSLC : (which == 1 ? C_VWIN : C_SBV + (which - 2) * 64)));
        bf16* dst = VT + ((size_t)(which * BC + b) * 64) * SEQ + blk * 64 + lane;
        v4u xs[8];
#pragma unroll
        for (int i = 0; i < 8; ++i) xs[i] = src[i];
#pragma unroll
        for (int i = 0; i < 8; ++i) { const v4u x = xs[i];
            dst[(size_t)(8 * i + 0) * SEQ] = (bf16)(x.x & 0xffffu); dst[(size_t)(8 * i + 1) * SEQ] = (bf16)(x.x >> 16);
            dst[(size_t)(8 * i + 2) * SEQ] = (bf16)(x.y & 0xffffu); dst[(size_t)(8 * i + 3) * SEQ] = (bf16)(x.y >> 16);
            dst[(size_t)(8 * i + 4) * SEQ] = (bf16)(x.z & 0xffffu); dst[(size_t)(8 * i + 5) * SEQ] = (bf16)(x.z >> 16);
            dst[(size_t)(8 * i + 6) * SEQ] = (bf16)(x.w & 0xffffu); dst[(size_t)(8 * i + 7) * SEQ] = (bf16)(x.w >> 16); }
    }
}
__device__ __forceinline__ void p_sgu(Frame& F, int layer) {
    LAS float* vn = (LAS float*)(F.lds + RING_OFF);
    const bf16* P1 = WSP(bf16, WS_P1); bf16* Ya = WSP(bf16, WS_Y);
    const float* gain = F.in[3] + (size_t)layer * 256; const float* sw = F.in[4] + (size_t)layer * 4 * 128 * 128; const float* sb = F.in[5] + (size_t)layer * 4 * 128;
    const int lane = F.lane, wave = F.wave;
    for (int item = F.vcu; item < MC / 128; item += F.G) {
        const size_t r0 = (size_t)item * 128;
        __syncthreads();
        for (int rr = 0; rr < 16; ++rr) { const int r = wave * 16 + rr; const v2u raw = *(const v2u*)(P1 + (r0 + r) * P1W + C_V + 4 * lane);
            const float a = bflo(raw.x), b = bfhi(raw.x), c = bflo(raw.y), d = bfhi(raw.y);
            const float rstd = 1.0f / sqrtf(wave_sum((a * a + b * b) + (c * c + d * d), lane) * (1.f / 256.f) + EPS);
            const f32x4 gg = ((const f32x4*)gain)[lane];
            *(LAS f32x4*)(vn + r * 256 + 4 * lane) = (f32x4){a * rstd * gg.x, b * rstd * gg.y, c * rstd * gg.z, d * rstd * gg.w}; }
        __syncthreads();
        const int g = wave & 3, half = wave >> 2;
        for (int i = 0; i < 64; ++i) { const int t = 2 * i + half;
            const float* wrow = sw + ((size_t)g * 128 + t) * 128;
            const float w_lo = wrow[lane], w_hi = wrow[64 + lane];
            float acc = 0.f;
            for (int s = 0; s <= t; ++s) { const float w = (s < 64) ? rdlane(w_lo, s) : rdlane(w_hi, s - 64); acc += w * vn[s * 256 + g * 64 + lane]; }
            const float u = bf1(P1[(r0 + t) * P1W + C_U + g * 64 + lane]);
#ifdef ABL_SGUMIX
            acc = 0.f;
#endif
            Ya[(r0 + t) * 256 + g * 64 + lane] = (bf16)f2bf(u * (acc + sb[g * 128 + t])); }
    }
    __syncthreads();
}

__device__ __forceinline__ void p_cmpfin(Frame& F, int layer) {
    const int gw = F.vcu * NWAVES + F.wave, NGW = F.G * NWAVES, lane = F.lane;
    const float* UL = WSP(float, WS_UL); const float* bias = WSP(float, WS_BIAS1); bf16* KC = WSP(bf16, WS_KC);
    for (int it = gw; it < 2 * BC * 255; it += NGW) { const int kv = it / (BC * 255), r = it % (BC * 255), b = r / 255, m = r % 255;
        const float* w2 = F.in[8] + (size_t)(layer * 2 + kv) * 256 * 64;
        const float* U = UL + (size_t)(kv * 2048 + b * 256 + m) * 512; const float* L = U + 512 + 256;
        float hv[4];
#pragma unroll
        for (int q = 0; q < 4; ++q) hv[q] = pg8::gelu_tanh(U[64 * q + lane] + L[64 * q + lane] + bias[kv * 256 + 64 * q + lane]);
        float acc = 0.f;
#pragma unroll
        for (int q = 0; q < 4; ++q)
#pragma unroll 8
            for (int jj = 0; jj < 64; ++jj) acc += rdlane(hv[q], jj) * w2[(size_t)(64 * q + jj) * 64 + lane];
        KC[((size_t)(kv * BC + b) * 256 + m) * 64 + lane] = (bf16)f2bf(acc);
        if (kv == 1) { WSP(bf16, WS_KCT)[((size_t)b * 64 + lane) * 256 + m] = (bf16)f2bf(acc); if (m == 254) WSP(bf16, WS_KCT)[((size_t)b * 64 + lane) * 256 + 255] = (bf16)0; }
        else if (m == 254) KC[((size_t)b * 256 + 255) * 64 + lane] = (bf16)0; }
}

__device__ __forceinline__ void p_stick(Frame& F) {
    const int gw = F.vcu * NWAVES + F.wave, NGW = F.G * NWAVES, lane = F.lane;
    const bf16* P1 = WSP(bf16, WS_P1); bf16* Yb = WSP(bf16, WS_Y) + (size_t)MC * 256;
    for (int item = gw; item < BC * 4 * 64; item += NGW) { const int tb = item & 63, h = (item >> 6) & 3, b = item >> 8;
        const int t = tb * 64 + lane; const size_t row = (size_t)b * SEQ + t;
        unsigned q[32];
        { const v4u* qp = (const v4u*)(P1 + row * P1W + C_SBQ + h * 64);
#pragma unroll
          for (int i = 0; i < 8; ++i) { const v4u x = qp[i]; q[4 * i] = x.x; q[4 * i + 1] = x.y; q[4 * i + 2] = x.z; q[4 * i + 3] = x.w; } }
        float o[64];
#pragma unroll
        for (int d = 0; d < 64; ++d) o[d] = 0.f;
        float R = 0.f;
        const bf16* kb = P1 + (size_t)b * SEQ * P1W + C_SBK + h * 64; const bf16* vb = P1 + (size_t)b * SEQ * P1W + C_SBV + h * 64;
        for (int s = t - 1; s >= 0; --s) {
            if (R < -100.f) break;
            const v4u* kp = (const v4u*)(kb + (size_t)s * P1W); const v4u* vp = (const v4u*)(vb + (size_t)s * P1W);
            float z0 = 0.f, z1 = 0.f;
#pragma unroll
            for (int i = 0; i < 8; ++i) { const v4u k = kp[i]; z0 = dot2bf(k.x, q[4 * i], z0); z1 = dot2bf(k.y, q[4 * i + 1], z1); z0 = dot2bf(k.z, q[4 * i + 2], z0); z1 = dot2bf(k.w, q[4 * i + 3], z1); }
            const float z = (z0 + z1) * 0.125f;
            const float tt = 0.6931471805599453f * __builtin_amdgcn_logf(1.0f + fexp(-__builtin_fabsf(z)));
            const float lb = fminf(z, 0.f) - tt, l1m = fminf(-z, 0.f) - tt;
            const float a = fexp(lb + R); R += l1m;
#pragma unroll
            for (int i = 0; i < 8; ++i) { const v4u v = vp[i];
                o[8 * i] += a * bflo(v.x); o[8 * i + 1] += a * bfhi(v.x); o[8 * i + 2] += a * bflo(v.y); o[8 * i + 3] += a * bfhi(v.y);
                o[8 * i + 4] += a * bflo(v.z); o[8 * i + 5] += a * bfhi(v.z); o[8 * i + 6] += a * bflo(v.w); o[8 * i + 7] += a * bfhi(v.w); }
        }
        v4u* op = (v4u*)(Yb + row * 256 + h * 64);
#pragma unroll
        for (int i = 0; i < 8; ++i) op[i] = (v4u){pk2(o[8 * i], o[8 * i + 1]), pk2(o[8 * i + 2], o[8 * i + 3]), pk2(o[8 * i + 4], o[8 * i + 5]), pk2(o[8 * i + 6], o[8 * i + 7])};
    }
}

struct Soft { float mx, l; };
__device__ __forceinline__ float dotq(const LAS v4u* ql, const bf16* kp_) {
    const v4u* kp = (const v4u*)kp_; float z0 = 0.f, z1 = 0.f;
#pragma unroll
    for (int i = 0; i < 8; ++i) { const v4u k = kp[i]; const v4u q = ql[i]; z0 = dot2bf(k.x, q.x, z0); z1 = dot2bf(k.y, q.y, z1); z0 = dot2bf(k.z, q.z, z0); z1 = dot2bf(k.w, q.w, z1); }
    return (z0 + z1) * 0.125f;
}
__device__ __forceinline__ void axpy_row(float p, const bf16* vp_, float (&o)[64]) {
    const v4u* vp = (const v4u*)vp_;
#pragma unroll
    for (int i = 0; i < 8; ++i) { const v4u v = vp[i];
        o[8 * i] += p * bflo(v.x); o[8 * i + 1] += p * bfhi(v.x); o[8 * i + 2] += p * bflo(v.y); o[8 * i + 3] += p * bfhi(v.y);
        o[8 * i + 4] += p * bflo(v.z); o[8 * i + 5] += p * bfhi(v.z); o[8 * i + 6] += p * bflo(v.w); o[8 * i + 7] += p * bfhi(v.w); }
}
__device__ __forceinline__ void nsa_step(const LAS v4u* ql, const bf16* kp_, const bf16* vp_, Soft& S, float (&o)[64]) {
    const float s = dotq(ql, kp_);
    if (s > S.mx) { const float sc = fexp(S.mx - s); S.l *= sc;
#pragma unroll
        for (int d = 0; d < 64; ++d) o[d] *= sc;
        S.mx = s; }
    const float p = fexp(s - S.mx); S.l += p;
    asm volatile("" ::: "memory");
    axpy_row(p, vp_, o);
}
__device__ __forceinline__ void nsa_accum(bf16* yrow, bool first, float sc, const float (&o)[64]) {
    v4u* op = (v4u*)yrow;
#pragma unroll
    for (int i = 0; i < 8; ++i) { v4u old = (v4u){0u, 0u, 0u, 0u}; if (!first) old = op[i];
        op[i] = (v4u){pk2(bflo(old.x) + sc * o[8 * i], bfhi(old.x) + sc * o[8 * i + 1]), pk2(bflo(old.y) + sc * o[8 * i + 2], bfhi(old.y) + sc * o[8 * i + 3]),
                      pk2(bflo(old.z) + sc * o[8 * i + 4], bfhi(old.z) + sc * o[8 * i + 5]), pk2(bflo(old.w) + sc * o[8 * i + 6], bfhi(old.w) + sc * o[8 * i + 7])}; }
}
__device__ __forceinline__ void p_nsa(Frame& F) {
    const int gw = F.vcu * NWAVES + F.wave, NGW = F.G * NWAVES, lane = F.lane;
    const bf16* P1 = WSP(bf16, WS_P1); const bf16* KC = WSP(bf16, WS_KC); bf16* Yc = WSP(bf16, WS_Y) + (size_t)2 * MC * 256;
    LAS float* imp = (LAS float*)(F.lds + RING_OFF + F.wave * 4096);
    LAS v4u* ql = (LAS v4u*)(F.lds + RING_OFF + 32768 + F.wave * 9216 + lane * 144);
    const int qi = lane >> 2, h = lane & 3;
    for (int item = gw; item < BC * 256; item += NGW) { const int b = item >> 8, tg = item & 255;
        const int t = tg * 16 + qi; const size_t row = (size_t)b * SEQ + t; const bf16* prow = P1 + row * P1W;
        { const v4u* qp = (const v4u*)(prow + C_CQ + h * 64);
#pragma unroll
          for (int i = 0; i < 8; ++i) ql[i] = qp[i]; }
        const float g0 = bf1(prow[C_CG + h * 3]), g1 = bf1(prow[C_CG + h * 3 + 1]), g2 = bf1(prow[C_CG + h * 3 + 2]);
        bf16* yrow = Yc + row * 256 + h * 64;
        float o[64];
        for (int i = lane; i < 1024; i += 64) imp[i] = 0.f;
        const int nv = t >= 31 ? ((t - 31) >> 4) + 1 : 0; const int nvmax = (tg * 16 + 15 >= 31) ? ((tg * 16 + 15 - 31) >> 4) + 1 : 0;
        const bf16* kc = KC + (size_t)(0 * BC + b) * 256 * 64; const bf16* vc = KC + (size_t)(1 * BC + b) * 256 * 64;
        { float mx = -INFINITY, l = 0.f;
          for (int m = 0; m < nvmax; ++m) { const float s = dotq(ql, kc + m * 64); if (m < nv) { if (s > mx) { l *= fexp(mx - s); mx = s; } l += fexp(s - mx); } }
          const float rl = l > 0.f ? 1.0f / l : 0.f;
#pragma unroll
          for (int d = 0; d < 64; ++d) o[d] = 0.f;
          for (int m = 0; m < nvmax; ++m) { const float s = dotq(ql, kc + m * 64); const float p = (m < nv) ? fexp(s - mx) * rl : 0.f;
              asm volatile("" ::: "memory");
              axpy_row(p, vc + m * 64, o);
              float P = p + __builtin_bit_cast(float, bperm(lane ^ 1, __builtin_bit_cast(int, p))); P += __builtin_bit_cast(float, bperm(lane ^ 2, __builtin_bit_cast(int, P)));
              if (h == 0) { const int j0 = m >> 2; const bool edge = (m & 3) == 3; imp[qi * 64 + j0] += edge ? 0.5f * P : P; if (edge) imp[qi * 64 + j0 + 1] += 0.5f * P; } }
          nsa_accum(yrow, true, g0, o); }
        unsigned long long mask = 0ull;
        { const int cur = t >> 6, nvb = cur + 1;
          if (h == 0) {
              if (nvb <= 16) mask = (1ull << nvb) - 1ull;
              else { mask = 1ull | (1ull << cur);
                  for (int r = 0; r < 14; ++r) { int best = -1; float bv = -1.f;
                      for (int j = 1; j < cur; ++j) { const float v = imp[qi * 64 + j]; if (!((mask >> j) & 1ull) && v > bv) { bv = v; best = j; } }
                      mask |= 1ull << best; } } }
          const unsigned mlo = (unsigned)bperm(lane & ~3, (int)(unsigned)mask), mhi = (unsigned)bperm(lane & ~3, (int)(unsigned)(mask >> 32));
          mask = ((unsigned long long)mhi << 32) | mlo; }
        { Soft S{-INFINITY, 0.f};
#pragma unroll
          for (int d = 0; d < 64; ++d) o[d] = 0.f;
          const bf16* kb = P1 + (size_t)b * SEQ * P1W + C_KSLC; const bf16* vb = P1 + (size_t)b * SEQ * P1W + C_VSLC;
          unsigned long long mm = mask;
          while (mm) { const int j = __builtin_ctzll(mm); mm &= mm - 1ull;
              for (int kk = 0; kk < 64; ++kk) { const int sp = j * 64 + kk; if (sp > t) break; nsa_step(ql, kb + (size_t)sp * P1W, vb + (size_t)sp * P1W, S, o); } }
          nsa_accum(yrow, false, g1 / S.l, o); }
        { Soft S{-INFINITY, 0.f};
#pragma unroll
          for (int d = 0; d < 64; ++d) o[d] = 0.f;
          const bf16* kb = P1 + (size_t)b * SEQ * P1W + C_KWIN; const bf16* vb = P1 + (size_t)b * SEQ * P1W + C_VWIN;
          for (int i = 0; i < 512; ++i) { const int sp = t - 511 + i; if (sp >= 0) nsa_step(ql, kb + (size_t)sp * P1W, vb + (size_t)sp * P1W, S, o); }
          nsa_accum(yrow, false, g2 / S.l, o); }
    }
}

__device__ __forceinline__ int moe_table(Frame& F, int jmoe, int c, int r) {
    LAS int* tab = (LAS int*)(F.lds + TAB_OFF);
    __syncthreads();
    if (F.tid == 0) { int base = 0, T = 0;
        for (int e = 0; e < 8; ++e) { const int cnt = (int)__hip_atomic_load(F.ctl + CW_CNT + jmoe * 32 + (c * 2 + r) * 8 + e, __ATOMIC_RELAXED, __HIP_MEMORY_SCOPE_AGENT);
            const int nt = (cnt + 255) >> 8; tab[160 + e] = base; for (int i = 0; i < nt && T + i < 160; ++i) tab[T + i] = e; T += nt; base += nt * 256; }
        tab[168] = T < 136 ? T : 136; }
    __syncthreads();
    return tab[168];
}
__device__ __forceinline__ void p_gather(Frame& F, int jmoe, int c, int r) {
    moe_table(F, jmoe, c, r);
    const LAS int* tab = (const LAS int*)(F.lds + TAB_OFF);
    const int gw = F.vcu * NWAVES + F.wave, NGW = F.G * NWAVES, lane = F.lane;
    const v4i* route = WSP(v4i, WS_ROUTE); int* tokmap = WSP(int, WS_TOKMAP) + (c * 2 + r) * SLOTS; float* wslot = WSP(float, WS_WSLOT) + (c * 2 + r) * SLOTS;
    const bf16* HN = WSP(bf16, WS_HN); bf16* XG = WSP(bf16, WS_XG);
    unsigned* cur = F.ctl + CW_CUR + jmoe * 32 + (c * 2 + r) * 8;
    for (int tg = gw; tg < MC / 16; tg += NGW) {
        const int m = c * MC + tg * 16 + (lane & 15); const v4i rt = route[m];
        const int e = lane < 16 ? (r ? rt.y : rt.x) : -1; const float w = __builtin_bit_cast(float, r ? rt.w : rt.z);
        int pos = 0;
#pragma unroll
        for (int ee = 0; ee < 8; ++ee) { const unsigned long long bal = __builtin_amdgcn_ballot_w64(e == ee);
            if (bal) { unsigned basep = 0; if (lane == 0) basep = atomicAdd(cur + ee, (unsigned)__builtin_popcountll(bal));
                basep = (unsigned)__builtin_amdgcn_readfirstlane((int)basep);
                if (e == ee) pos = (int)basep + __builtin_popcountll(bal & ((1ull << lane) - 1ull)); } }
        int slot = 0;
        if (lane < 16) { slot = tab[160 + e] + pos; tokmap[slot] = m; wslot[slot] = w; }
#pragma unroll
        for (int i0 = 0; i0 < 16; i0 += 4) { v4u x[8];
#pragma unroll
            for (int i = 0; i < 4; ++i) { const int mi = __builtin_amdgcn_readlane(m, i0 + i); const v4u* src = (const v4u*)(HN + (size_t)mi * DM); x[2 * i] = src[lane]; x[2 * i + 1] = src[64 + lane]; }
#pragma unroll
            for (int i = 0; i < 4; ++i) { const int si = __builtin_amdgcn_readlane(slot, i0 + i); v4u* dst = (v4u*)(XG + (size_t)si * DM); dst[lane] = x[2 * i]; dst[64 + lane] = x[2 * i + 1]; } }
    }
}

typedef float f32x16 __attribute__((ext_vector_type(16)));
typedef short bf16x8v __attribute__((ext_vector_type(8)));
typedef float f32x2v __attribute__((ext_vector_type(2)));
constexpr int NSA_K = 0, NSA_V = 8192, NSA_BUF = 17408, NSA_IMP = 34816, NSA_CARRY = 51200, NSA_SEL = 68608, NSA_WSF = 69120;
constexpr float NSA_C2 = 0.125f * 1.4426950408889634f;
__device__ __forceinline__ unsigned cvtpk(float lo, float hi) { f32x2v v = {lo, hi}; bf16x2_t b = __builtin_convertvector(v, bf16x2_t); return __builtin_bit_cast(unsigned, b); }
__device__ __forceinline__ float partner32(float v, int lane) { return __builtin_bit_cast(float, __builtin_amdgcn_ds_bpermute((lane ^ 32) << 2, __builtin_bit_cast(int, v))); }
__device__ __forceinline__ void nsa_load(v4u& kx, v4u& vx, const bf16* Kg, int kp, const bf16* Vg, int vp, int tid) {
    kx = *(const v4u*)(Kg + (size_t)(tid & 63) * kp + (tid >> 6) * 8); vx = *(const v4u*)(Vg + (size_t)(tid >> 3) * vp + (tid & 7) * 8);
}
__device__ __forceinline__ void nsa_store(LAS unsigned char* lds, const v4u& kx, const v4u& vx, int tid) {
    *(LAS v4u*)(lds + NSA_K + (tid >> 6) * 1024 + (tid & 63) * 16) = kx; *(LAS v4u*)(lds + NSA_V + (tid >> 3) * 144 + (tid & 7) * 16) = vx;
}
__device__ __forceinline__ void nsa_qk(const LAS unsigned char* lds, const bf16x8v (&qr)[4], f32x16& p0, f32x16& p1, int r32, int hi) {
#pragma unroll
    for (int i = 0; i < 16; ++i) { p0[i] = 0.f; p1[i] = 0.f; }
#pragma unroll
    for (int d0 = 0; d0 < 4; ++d0) {
        const bf16x8v k0 = *(const LAS bf16x8v*)(lds + NSA_K + (2 * d0 + hi) * 1024 + r32 * 16);
        const bf16x8v k1 = *(const LAS bf16x8v*)(lds + NSA_K + (2 * d0 + hi) * 1024 + 512 + r32 * 16);
        p0 = __builtin_amdgcn_mfma_f32_32x32x16_bf16(k0, qr[d0], p0, 0, 0, 0);
        p1 = __builtin_amdgcn_mfma_f32_32x32x16_bf16(k1, qr[d0], p1, 0, 0, 0);
    }
#pragma unroll
    for (int i = 0; i < 16; ++i) { p0[i] *= NSA_C2; p1[i] *= NSA_C2; }
}
__device__ __forceinline__ void nsa_mask(f32x16& p0, f32x16& p1, int hi, int hiL, int loL, bool rowok, bool full  ) {
    if (full) {
#pragma unroll
        for (int i = 0; i < 16; ++i) { p0[i] = rowok ? p0[i] : -INFINITY; p1[i] = rowok ? p1[i] : -INFINITY; }
        return; }
#pragma unroll
    for (int i = 0; i < 16; ++i) { const int kk = (i & 3) + 8 * (i >> 2) + 4 * hi;
        if (!(rowok && kk <= hiL && kk > loL)) p0[i] = -INFINITY;
        if (!(rowok && kk + 32 <= hiL && kk + 32 > loL)) p1[i] = -INFINITY; }
}
__device__ __forceinline__ float nsa_max32(const f32x16& p0, const f32x16& p1) {
    float a = fmaxf(fmaxf(p0[0], p0[1]), p1[0]), b = fmaxf(fmaxf(p0[2], p0[3]), p1[1]); a = fmaxf(fmaxf(a, p1[2]), p1[3]);
#pragma unroll
    for (int i = 4; i < 16; i += 4) { a = fmaxf(fmaxf(a, p0[i]), p0[i + 1]); b = fmaxf(fmaxf(b, p0[i + 2]), p0[i + 3]); a = fmaxf(fmaxf(a, p1[i]), p1[i + 1]); b = fmaxf(fmaxf(b, p1[i + 2]), p1[i + 3]); }
    return fmaxf(a, b);
}
__device__ __forceinline__ void nsa_pv(const LAS unsigned char* lds, const f32x16& p0, const f32x16& p1, f32x16 (&o)[2], int r32, int hi) {
    bf16x8v pa[4];
#pragma unroll
    for (int s = 0; s < 2; ++s) {
        const v4u a = (v4u){cvtpk(p0[8 * s], p0[8 * s + 1]), cvtpk(p0[8 * s + 2], p0[8 * s + 3]), cvtpk(p0[8 * s + 4], p0[8 * s + 5]), cvtpk(p0[8 * s + 6], p0[8 * s + 7])};
        const v4u b = (v4u){cvtpk(p1[8 * s], p1[8 * s + 1]), cvtpk(p1[8 * s + 2], p1[8 * s + 3]), cvtpk(p1[8 * s + 4], p1[8 * s + 5]), cvtpk(p1[8 * s + 6], p1[8 * s + 7])};
        pa[s] = __builtin_bit_cast(bf16x8v, a); pa[2 + s] = __builtin_bit_cast(bf16x8v, b); }
#pragma unroll
    for (int db = 0; db < 2; ++db) { const LAS unsigned char* vrow = lds + NSA_V + (32 * db + r32) * 144;
#pragma unroll
        for (int ks = 0; ks < 4; ++ks) {
            const int kb = (ks >> 1) * 32 + (ks & 1) * 16 + 4 * hi;
            const v2u lo = *(const LAS v2u*)(vrow + kb * 2), hh = *(const LAS v2u*)(vrow + (kb + 8) * 2);
            const v4u vv = (v4u){lo.x, lo.y, hh.x, hh.y};
            o[db] = __builtin_amdgcn_mfma_f32_32x32x16_bf16(pa[ks], __builtin_bit_cast(bf16x8v, vv), o[db], 0, 0, 0); } }
}
__device__ __forceinline__ void nsa_rowscale(f32x16 (&o)[2], LAS float* wsf, float f, int r32, int hi) {
    if (hi == 0) wsf[r32] = f;
#pragma unroll
    for (int g = 0; g < 4; ++g) { const f32x4 w = *(const LAS f32x4*)(wsf + 8 * g + 4 * hi);
#pragma unroll
        for (int e = 0; e < 4; ++e) { o[0][4 * g + e] *= w[e]; o[1][4 * g + e] *= w[e]; } }
}
__device__ __forceinline__ void nsa_rowaccum(bf16* dst, bool first, const f32x16 (&o)[2], LAS float* wsf, float f, int r32, int hi) {
    if (hi == 0) wsf[r32] = f;
    bf16 old[32];
#pragma unroll
    for (int i = 0; i < 16; ++i) { const bf16* p = dst + (i >> 2) * 512 + (i & 3) * 64; old[2 * i] = first ? (bf16)0 : p[0]; old[2 * i + 1] = first ? (bf16)0 : p[32]; }
#pragma unroll
    for (int g = 0; g < 4; ++g) { const f32x4 w = *(const LAS f32x4*)(wsf + 8 * g + 4 * hi);
#pragma unroll
        for (int e = 0; e < 4; ++e) { bf16* p = dst + g * 512 + e * 64; const int i = 4 * g + e;
            p[0] = (bf16)f2bf(o[0][i] * w[e] + bf1(old[2 * i])); p[32] = (bf16)f2bf(o[1][i] * w[e] + bf1(old[2 * i + 1])); } }
}
__device__ __forceinline__ void nsa_softmax_pv(const LAS unsigned char* lds, f32x16& p0, f32x16& p1, float& m, float& l, f32x16 (&o)[2], LAS float* wsf, int lane, int r32, int hi) {
    float mt = nsa_max32(p0, p1); mt = fmaxf(mt, partner32(mt, lane));
    const float mn = fmaxf(m, mt);
    if (__builtin_amdgcn_ballot_w64(mn > m) != 0ull) { const float f = __builtin_amdgcn_exp2f(m - mn); l *= f; nsa_rowscale(o, wsf, f, r32, hi); m = mn; }
    float s = 0.f;
#pragma unroll
    for (int i = 0; i < 16; ++i) { p0[i] = __builtin_amdgcn_exp2f(p0[i] - m); p1[i] = __builtin_amdgcn_exp2f(p1[i] - m); s += p0[i] + p1[i]; }
    l += s;
    nsa_pv(lds, p0, p1, o, r32, hi);
}
__device__ __forceinline__ void p_nsa2(Frame& F) {
    const int tid = F.tid, lane = F.lane, wave = F.wave, r32 = lane & 31, hi = lane >> 5;
    LAS unsigned char* lds = F.lds + RING_OFF;
    LAS float* imp = (LAS float*)(lds + NSA_IMP); LAS float* carry = (LAS float*)(lds + NSA_CARRY);
    LAS unsigned long long* selm = (LAS unsigned long long*)(lds + NSA_SEL); LAS float* wsf = (LAS float*)(lds + NSA_WSF) + wave * 32;
    const bf16* P1 = WSP(bf16, WS_P1); const bf16* KC = WSP(bf16, WS_KC); const bf16* KCT = WSP(bf16, WS_KCT); const bf16* VT = WSP(bf16, WS_VT);
    bf16* Yc = WSP(bf16, WS_Y) + (size_t)2 * MC * 256;
    const int ql = r32 >> 2, h = r32 & 3, tq = 8 * wave + ql;
    int par = 0;
    for (int it = 0; it < 2; ++it) {
        for (int pair = F.vcu; pair < BC * 32; pair += F.G) {
            const int b = pair >> 5, sx = pair & 31, qb = it ? 63 - sx : sx;
            const int t = qb * 64 + tq; const size_t row = (size_t)b * SEQ + t; const bf16* prow = P1 + row * P1W;
            bf16x8v qr[4];
#pragma unroll
            for (int d0 = 0; d0 < 4; ++d0) qr[d0] = *(const bf16x8v*)(prow + C_CQ + h * 64 + d0 * 16 + hi * 8);
            const float g0 = bf1(prow[C_CG + h * 3]), g1 = bf1(prow[C_CG + h * 3 + 1]), g2 = bf1(prow[C_CG + h * 3 + 2]);
            f32x16 o[2], p0, p1;
            bf16* ydst = Yc + ((size_t)b * SEQ + qb * 64 + 8 * wave + hi) * 256 + r32;
            __syncthreads();
            for (int i = tid; i < 64 * 64; i += 512) imp[i] = 0.f;
            for (int i = tid; i < 64 * 68; i += 512) carry[i] = 0.f;
            const int nct = (4 * qb + 3 + 63) >> 6;
            const int mlim = t >= 31 ? ((t - 31) >> 4) : -1;
            const bf16* kcb = KC + (size_t)b * 256 * 64; const bf16* vcb = KCT + (size_t)b * 64 * 256;
            float m = -1e30f, l = 0.f;
            v4u kx, vx;
            nsa_load(kx, vx, kcb, 64, vcb, 256, tid);
            for (int ti = 0; ti < nct; ++ti) {
                LAS unsigned char* tb = lds + par * NSA_BUF; par ^= 1;
                nsa_store(tb, kx, vx, tid); __syncthreads();
                { const int tn = ti + 1 < nct ? ti + 1 : 0; nsa_load(kx, vx, kcb + (size_t)tn * 64 * 64, 64, vcb + tn * 64, 256, tid); }
                nsa_qk(tb, qr, p0, p1, r32, hi); nsa_mask(p0, p1, hi, mlim - 64 * ti, -1, true, false);
                float mt = nsa_max32(p0, p1); mt = fmaxf(mt, partner32(mt, lane));
                const float mn = fmaxf(m, mt); l *= __builtin_amdgcn_exp2f(m - mn); m = mn;
                float s = 0.f;
#pragma unroll
                for (int i = 0; i < 16; ++i) s += __builtin_amdgcn_exp2f(p0[i] - m) + __builtin_amdgcn_exp2f(p1[i] - m);
                l += s; }
            { const float lt = l + partner32(l, lane); const float rl = lt > 0.f ? 1.0f / lt : 0.f;
#pragma unroll
              for (int i = 0; i < 16; ++i) { o[0][i] = 0.f; o[1][i] = 0.f; }
              for (int ti = 0; ti < nct; ++ti) {
                  LAS unsigned char* tb = lds + par * NSA_BUF; par ^= 1;
                  nsa_store(tb, kx, vx, tid); __syncthreads();
                  if (ti + 1 < nct) nsa_load(kx, vx, kcb + (size_t)(ti + 1) * 64 * 64, 64, vcb + (ti + 1) * 64, 256, tid);
                  nsa_qk(tb, qr, p0, p1, r32, hi); nsa_mask(p0, p1, hi, mlim - 64 * ti, -1, true, false);
#pragma unroll
                  for (int i = 0; i < 16; ++i) { p0[i] = __builtin_amdgcn_exp2f(p0[i] - m) * rl; p1[i] = __builtin_amdgcn_exp2f(p1[i] - m) * rl; }
#pragma unroll
                  for (int kt = 0; kt < 2; ++kt)
#pragma unroll
                      for (int g = 0; g < 4; ++g) { const f32x16& pp = kt ? p1 : p0;
                          float A = pp[4 * g] + pp[4 * g + 1] + pp[4 * g + 2] + 0.5f * pp[4 * g + 3], B = 0.5f * pp[4 * g + 3];
                          A += __builtin_bit_cast(float, bperm(lane ^ 1, __builtin_bit_cast(int, A))); A += __builtin_bit_cast(float, bperm(lane ^ 2, __builtin_bit_cast(int, A)));
                          B += __builtin_bit_cast(float, bperm(lane ^ 1, __builtin_bit_cast(int, B))); B += __builtin_bit_cast(float, bperm(lane ^ 2, __builtin_bit_cast(int, B)));
                          if (h == 0) { const int j = 16 * ti + 8 * kt + 2 * g + hi; imp[tq * 64 + j] = A; carry[tq * 68 + j + 1] = B; } }
                  nsa_pv(tb, p0, p1, o, r32, hi); }
              nsa_rowaccum(ydst, true, o, wsf, g0, r32, hi); }
            __syncthreads();
            { const int q = tid >> 3, sub = tid & 7; unsigned long long mask;
              if (qb + 1 <= 16) mask = (1ull << (qb + 1)) - 1ull;
              else { mask = 1ull | (1ull << qb);
                  unsigned long long key[8];
#pragma unroll
                  for (int i = 0; i < 8; ++i) { const int j = sub * 8 + i; const float v = imp[q * 64 + j] + carry[q * 68 + j];
                      key[i] = (j >= 1 && j < qb) ? (((unsigned long long)__builtin_bit_cast(unsigned, v) << 32) | (unsigned)(63 - j)) : 0ull; }
                  for (int r = 0; r < 14; ++r) { unsigned long long best = key[0];
#pragma unroll
                      for (int i = 1; i < 8; ++i) best = key[i] > best ? key[i] : best;
#pragma unroll
                      for (int x = 1; x < 8; x <<= 1) { const unsigned lo = (unsigned)bperm(lane ^ x, (int)(unsigned)best), hh = (unsigned)bperm(lane ^ x, (int)(unsigned)(best >> 32));
                          const unsigned long long other = ((unsigned long long)hh << 32) | lo; best = other > best ? other : best; }
                      const int jb = 63 - (int)(best & 63ull); mask |= 1ull << jb;
#pragma unroll
                      for (int i = 0; i < 8; ++i) if (sub * 8 + i == jb) key[i] = 0ull; } }
              if (sub == 0) selm[q] = mask; }
            __syncthreads();
            const unsigned long long mysel = selm[tq];
            { const bf16* kb = P1 + (size_t)b * SEQ * P1W + C_KSLC; const bf16* vb = VT + (size_t)(0 * BC + b) * 64 * SEQ;
              m = -1e30f; l = 0.f;
#pragma unroll
              for (int i = 0; i < 16; ++i) { o[0][i] = 0.f; o[1][i] = 0.f; }
              nsa_load(kx, vx, kb, P1W, vb, SEQ, tid);
              for (int j = 0; j <= qb; ++j) {
                  LAS unsigned char* tb = lds + par * NSA_BUF; par ^= 1;
                  nsa_store(tb, kx, vx, tid); __syncthreads();
                  if (j < qb) nsa_load(kx, vx, kb + (size_t)(j + 1) * 64 * P1W, P1W, vb + (j + 1) * 64, SEQ, tid);
                  const bool rowsel = ((mysel >> j) & 1ull) != 0ull;
                  if (__builtin_amdgcn_ballot_w64(rowsel) != 0ull) {
                      nsa_qk(tb, qr, p0, p1, r32, hi); nsa_mask(p0, p1, hi, j == qb ? tq : 63, -1, rowsel, j < qb);
                      nsa_softmax_pv(tb, p0, p1, m, l, o, wsf, lane, r32, hi); } }
              const float lt = l + partner32(l, lane);
              nsa_rowaccum(ydst, false, o, wsf, lt > 0.f ? g1 / lt : 0.f, r32, hi); }
            { const bf16* kb = P1 + (size_t)b * SEQ * P1W + C_KWIN; const bf16* vb = VT + (size_t)(1 * BC + b) * 64 * SEQ;
              m = -1e30f; l = 0.f;
#pragma unroll
              for (int i = 0; i < 16; ++i) { o[0][i] = 0.f; o[1][i] = 0.f; }
              const int j0 = qb >= 8 ? qb - 8 : 0;
              nsa_load(kx, vx, kb + (size_t)j0 * 64 * P1W, P1W, vb + j0 * 64, SEQ, tid);
              for (int j = j0; j <= qb; ++j) {
                  LAS unsigned char* tb = lds + par * NSA_BUF; par ^= 1;
                  nsa_store(tb, kx, vx, tid); __syncthreads();
                  if (j < qb) nsa_load(kx, vx, kb + (size_t)(j + 1) * 64 * P1W, P1W, vb + (j + 1) * 64, SEQ, tid);
                  nsa_qk(tb, qr, p0, p1, r32, hi); nsa_mask(p0, p1, hi, j == qb ? tq : 63, j == qb - 8 ? tq : -1, true, j < qb && j != qb - 8);
                  nsa_softmax_pv(tb, p0, p1, m, l, o, wsf, lane, r32, hi); }
              const float lt = l + partner32(l, lane);
              nsa_rowaccum(ydst, false, o, wsf, lt > 0.f ? g2 / lt : 0.f, r32, hi); }
        }
    }
    __syncthreads();
}

constexpr int SB_HEAD_LDS = 17408;
constexpr int SB_FLAG = 4 * SB_HEAD_LDS;
constexpr float SB_LOG2E = 1.4426950408889634f, SB_STOP = -100.0f * 1.4426950408889634f;
__device__ __forceinline__ void p_stick2(Frame& F) {
    const int tid = F.tid, lane = F.lane, wave = F.wave, r32 = lane & 31, hi = lane >> 5, h = wave & 3, qh = wave >> 2;
    LAS unsigned char* lds = F.lds + RING_OFF; LAS unsigned char* hl = lds + h * SB_HEAD_LDS; LAS int* flag = (LAS int*)(lds + SB_FLAG);
    const bf16* P1 = WSP(bf16, WS_P1); const bf16* VT = WSP(bf16, WS_VT) + (size_t)2 * BC * 64 * SEQ;
    bf16* Yb = WSP(bf16, WS_Y) + (size_t)MC * 256;
    const int tq = 32 * qh + r32;
    for (int it = 0; it < 2; ++it)
        for (int pair = F.vcu; pair < BC * 32; pair += F.G) {
            const int b = pair >> 5, sx = pair & 31, qb = it ? 63 - sx : sx;
            const size_t row = (size_t)b * SEQ + qb * 64 + tq;
            bf16x8v qr[4];
#pragma unroll
            for (int d0 = 0; d0 < 4; ++d0) qr[d0] = *(const bf16x8v*)(P1 + row * P1W + C_SBQ + h * 64 + d0 * 16 + hi * 8);
            f32x16 o[2], p0, p1;
#pragma unroll
            for (int i = 0; i < 16; ++i) { o[0][i] = 0.f; o[1][i] = 0.f; }
            float R = 0.f;
            const int skey = tid & 63, sc = tid >> 6, sd = tid >> 3, skc = tid & 7;
            v4u kx[4], vx[4];
#define SB_LOAD(jj) do { const bf16* kg_ = P1 + ((size_t)b * SEQ + (jj) * 64 + skey) * P1W + C_SBK + sc * 8; \
                _Pragma("unroll") for (int hh = 0; hh < 4; ++hh) { kx[hh] = *(const v4u*)(kg_ + hh * 64); vx[hh] = *(const v4u*)(VT + ((size_t)(hh * BC + b) * 64 + sd) * SEQ + (jj) * 64 + skc * 8); } } while (0)
            SB_LOAD(qb);
            for (int j = qb; j >= 0; --j) {
                __syncthreads();
                if (j < qb) { int live = 0;
#pragma unroll
                    for (int w = 0; w < 8; ++w) live |= flag[w];
                    if (!live) break; }
#pragma unroll
                for (int hh = 0; hh < 4; ++hh) { *(LAS v4u*)(lds + hh * SB_HEAD_LDS + sc * 1024 + skey * 16) = kx[hh]; *(LAS v4u*)(lds + hh * SB_HEAD_LDS + NSA_V + sd * 144 + skc * 16) = vx[hh]; }
                __syncthreads();
                if (j > 0) SB_LOAD(j - 1);
                nsa_qk(hl, qr, p0, p1, r32, hi);
                const int lim = (j == qb) ? tq : 64;
                float Town[8], Tp[8];
#pragma unroll
                for (int kt = 0; kt < 2; ++kt) { f32x16& pp = kt ? p1 : p0;
#pragma unroll
                    for (int g = 0; g < 4; ++g) { float L[4];
#pragma unroll
                        for (int e = 0; e < 4; ++e) { const int kk = 32 * kt + 8 * g + 4 * hi + e; const float z = pp[4 * g + e];
                            const float tt = __builtin_amdgcn_logf(1.0f + __builtin_amdgcn_exp2f(-__builtin_fabsf(z)));
                            const float lb = fminf(z, 0.f) - tt; const bool ok = kk < lim;
                            L[e] = ok ? lb - z : 0.f; pp[4 * g + e] = ok ? lb : -INFINITY; }
                        const float E2 = L[3], E1 = E2 + L[2], E0 = E1 + L[1];
                        pp[4 * g + 2] += E2; pp[4 * g + 1] += E1; pp[4 * g] += E0;
                        Town[4 * kt + g] = E0 + L[0]; } }
#pragma unroll
                for (int k = 0; k < 8; ++k) Tp[k] = partner32(Town[k], lane);
                float suf = R;
#pragma unroll
                for (int k = 7; k >= 0; --k) { const float add = suf + (hi == 0 ? Tp[k] : 0.f); f32x16& pp = (k >> 2) ? p1 : p0; const int g = k & 3;
#pragma unroll
                    for (int e = 0; e < 4; ++e) pp[4 * g + e] = __builtin_amdgcn_exp2f(pp[4 * g + e] + add);
                    suf += Town[k] + Tp[k]; }
                R = suf;
                nsa_pv(hl, p0, p1, o, r32, hi);
                const bool alive = R >= SB_STOP;
                const unsigned long long bal = __builtin_amdgcn_ballot_w64(alive);
                if (lane == 0) flag[wave] = bal != 0ull ? 1 : 0;
            }
            { bf16* dst = Yb + ((size_t)b * SEQ + qb * 64 + 32 * qh + 4 * hi) * 256 + h * 64 + r32;
#pragma unroll
              for (int i = 0; i < 16; ++i) { dst[((i & 3) + 8 * (i >> 2)) * 256] = (bf16)f2bf(o[0][i]); dst[((i & 3) + 8 * (i >> 2)) * 256 + 32] = (bf16)f2bf(o[1][i]); } }
        }
#undef SB_LOAD
    __syncthreads();
}

__device__ __forceinline__ void p_sgu2(Frame& F, int layer) {
    LAS unsigned char* vnT = F.lds + RING_OFF;
    const bf16* P1 = WSP(bf16, WS_P1); bf16* Ya = WSP(bf16, WS_Y);
    const float* gain = F.in[3] + (size_t)layer * 256; const float* sw = F.in[4] + (size_t)layer * 4 * 128 * 128; const float* sb = F.in[5] + (size_t)layer * 4 * 128;
    const int lane = F.lane, wave = F.wave, r32 = lane & 31, hi = lane >> 5, g = wave & 3, db = wave >> 2;
    for (int item = F.vcu; item < MC / 128; item += F.G) {
        const size_t r0 = (size_t)item * 128;
        __syncthreads();
        { const f32x4 gg = ((const f32x4*)gain)[lane];
          for (int rr = 0; rr < 16; rr += 2) { const int r = wave * 16 + rr;
              const v2u ra = *(const v2u*)(P1 + (r0 + r) * P1W + C_V + 4 * lane), rb = *(const v2u*)(P1 + (r0 + r + 1) * P1W + C_V + 4 * lane);
              const float a0 = bflo(ra.x), a1 = bfhi(ra.x), a2 = bflo(ra.y), a3 = bfhi(ra.y), b0 = bflo(rb.x), b1 = bfhi(rb.x), b2 = bflo(rb.y), b3 = bfhi(rb.y);
              const float sa = 1.0f / sqrtf(wave_sum((a0 * a0 + a1 * a1) + (a2 * a2 + a3 * a3), lane) * (1.f / 256.f) + EPS);
              const float sb_ = 1.0f / sqrtf(wave_sum((b0 * b0 + b1 * b1) + (b2 * b2 + b3 * b3), lane) * (1.f / 256.f) + EPS);
              LAS unsigned* q = (LAS unsigned*)(vnT + (4 * lane) * 272 + r * 2);
              q[0] = pk2(a0 * sa * gg.x, b0 * sb_ * gg.x); q[68] = pk2(a1 * sa * gg.y, b1 * sb_ * gg.y); q[136] = pk2(a2 * sa * gg.z, b2 * sb_ * gg.z); q[204] = pk2(a3 * sa * gg.w, b3 * sb_ * gg.w); } }
        __syncthreads();
        const int ch = g * 64 + db * 32 + r32;
        for (int tb = 0; tb < 4; ++tb) {
            f32x16 acc;
#pragma unroll
            for (int i = 0; i < 16; ++i) acc[i] = 0.f;
            const int t = 32 * tb + r32; const float* wrow = sw + ((size_t)g * 128 + t) * 128;
            for (int ks = 0; ks < 2 * tb + 2; ++ks) {
                const int s0 = 16 * ks + 8 * hi;
                const f32x4 w0 = *(const f32x4*)(wrow + s0), w1 = *(const f32x4*)(wrow + s0 + 4);
                const v4u a = (v4u){pk2(s0 <= t ? w0.x : 0.f, s0 + 1 <= t ? w0.y : 0.f), pk2(s0 + 2 <= t ? w0.z : 0.f, s0 + 3 <= t ? w0.w : 0.f),
                                    pk2(s0 + 4 <= t ? w1.x : 0.f, s0 + 5 <= t ? w1.y : 0.f), pk2(s0 + 6 <= t ? w1.z : 0.f, s0 + 7 <= t ? w1.w : 0.f)};
                const bf16x8v bfr = *(const LAS bf16x8v*)(vnT + ch * 272 + s0 * 2);
                acc = __builtin_amdgcn_mfma_f32_32x32x16_bf16(__builtin_bit_cast(bf16x8v, a), bfr, acc, 0, 0, 0); }
            float uu[16], bb[16];
#pragma unroll
            for (int i = 0; i < 16; ++i) { const int tt = 32 * tb + (i & 3) + 8 * (i >> 2) + 4 * hi; uu[i] = bf1(P1[(r0 + tt) * P1W + C_U + ch]); bb[i] = sb[g * 128 + tt]; }
#pragma unroll
            for (int i = 0; i < 16; ++i) { const int tt = 32 * tb + (i & 3) + 8 * (i >> 2) + 4 * hi;
                Ya[(r0 + tt) * 256 + ch] = (bf16)f2bf(uu[i] * (acc[i] + bb[i])); }
        }
    }
    __syncthreads();
}

struct Args { const float* in[20]; float* out; unsigned char* ws; int lo, hi, li, rep; };
#ifndef TILED_FFN1
#define TILED_FFN1 0
#endif
#ifndef PG8_ALIGN_EPI
#define PG8_ALIGN_EPI true
#endif
#ifndef PG8_SP2
#define PG8_SP2 true
#endif
#ifndef FFN_CHUNKS
#define FFN_CHUNKS 2
#endif
#ifndef REP_GEMM
#define REP_GEMM 1
#endif
#ifndef REP_STICK
#define REP_STICK 1
#endif
#ifndef REP_NSA
#define REP_NSA 1
#endif
#ifndef REP_SGU
#define REP_SGU 1
#endif
#ifndef REP_NORM
#define REP_NORM 1
#endif
template <class Epi, class Sched> __device__ __forceinline__ void run_gemm(Frame& F, const bf16* A, const bf16* Bt, int M, int N, int K, const Sched& S, Epi E, bool rotate = true, int tiled = 0) {
    const int nt_ = K / 64;
#ifdef PG8_KROT
    const int rot_ = rotate ? 2 * (((F.bx & 7) * (nt_ / 2)) / 8) : 0;
#else
    const int rot_ = 0;
#endif
    pg8::Gemm g{A, Bt, M, N, K + F.zs, F.tid, rot_ + F.zs, tiled + F.zs};
    if (F.rep) E.set_scale0();
    pg8::gemm_phase<Epi, Sched, PG8_ALIGN_EPI, PG8_SP2>(F.lds + RING_OFF, g, S, E);
}
__global__ void __launch_bounds__(NWAVES * 64, 2) mk_fwd(Args args) {
    extern __shared__ __attribute__((aligned(16))) unsigned char lds[];
    Frame F0;
    F0.lds = (LAS unsigned char*)lds;
    F0.tid = threadIdx.x; F0.lane = F0.tid & 63; F0.wave = __builtin_amdgcn_readfirstlane(F0.tid >> 6);
    F0.G = gridDim.x; F0.bx = blockIdx.x; F0.vcu = (F0.G % 8 == 0) ? (F0.bx % 8) * (F0.G / 8) + F0.bx / 8 : F0.bx; F0.zv = 0; F0.zs = 0;
    F0.rep = args.rep; F0.ws = args.ws; F0.ctl = (unsigned*)(args.ws + WS_CTL); F0.in = args.in; F0.out = args.out;
    for (int u = F0.tid; u < (LDS_BYTES - LDSCTL_OFF) / 4; u += NWAVES * 64) ((LAS unsigned*)(F0.lds + LDSCTL_OFF))[u] = 0u;
    __syncthreads();
    const int lo = args.lo, hi = args.hi;
    XcdBarrier bar; bar.bar = F0.ctl + CW_BAR + args.li * XCD_BAR_WORDS; bar.x = 0; bar.st = nullptr; bar.w = 0; bar.z = 0;
    if (hi - lo > 1) bar = xcd_barrier_post(F0.ctl + CW_BAR + args.li * XCD_BAR_WORDS, (volatile LAS unsigned*)(F0.lds + MISC_OFF) + 8);
    int step = 0;
#define STEP_BEGIN if (step >= lo && step < hi) { Frame F = F0; { int zv_, zs_; asm volatile("v_mov_b32 %0, 0" : "=v"(zv_)); asm volatile("s_mov_b32 %0, 0" : "=s"(zs_)); \
        F.zv = zv_; F.zs = zs_; F.lane = (int)__builtin_amdgcn_mbcnt_hi(~0u, __builtin_amdgcn_mbcnt_lo(~0u, (unsigned)zv_)); F.wave = F0.wave + zs_; F.tid = F.wave * 64 + F.lane; F.bx = F.bx + zs_; \
        F.vcu = F0.vcu + zs_; F.G = F0.G + zs_; F.lds = (LAS unsigned char*)lds + zs_; F.ws = F0.ws + zs_; F.ctl = F0.ctl + zs_; F.in = F0.in + zs_; F.out = F0.out + zs_; }
#ifdef PROBE_XBAR
#define STEP_END   if (step + 1 < hi) { unsigned zb_; asm volatile("v_mov_b32 %0, 0" : "=v"(zb_)); bar.z = zb_; xcd_barrier(bar); xcd_barrier(bar); } } ++step;
#else
#define STEP_END   if (step + 1 < hi) { unsigned zb_; asm volatile("v_mov_b32 %0, 0" : "=v"(zb_)); bar.z = zb_; xcd_barrier(bar); } } ++step;
#endif

    for (int layer = 0; layer < DEPTH; ++layer) {
        const int jj = layer >> 1;
        STEP_BEGIN
            p_convert(F, layer);
            p_norm<0>(F, layer == 0 ? F.in[0] : F.out, F.in[1] + (size_t)layer * DM, nullptr, 0);
        STEP_END
        for (int c = 0; c < NCHUNK; ++c) {
            STEP_BEGIN
                pg8::StaticOrder S; S.init(MC, NPROJ, F.G, F.bx);
                pg8::EpiProj E{WSP(bf16, WS_P1), WSP(bf16, WS_G)};
                run_gemm(F, WSP(bf16, WS_HN) + (size_t)c * MC * DM, WSP(bf16, WS_WIN), MC, NPROJ, DM, S, E);
            STEP_END
            STEP_BEGIN
                p_prep(F);
            STEP_END
            STEP_BEGIN
                LAS int* tab = (LAS int*)(F.lds + TAB_OFF);
                __syncthreads(); if (F.tid < 16) tab[F.tid] = F.tid >> 3; __syncthreads();
                pg8::GroupedOrder S; S.so.init(2 * 2048, 512, F.G, F.bx); S.tile_e = tab; S.nN = 2;
                pg8::EpiF32 E{WSP(float, WS_UL), 512, 2};
                run_gemm(F, WSP(bf16, WS_KVC), WSP(bf16, WS_WC1), 2 * 2048, 512, DM, S, E);
                p_sgu2(F, layer);
                p_stick2(F);
            STEP_END
            STEP_BEGIN
                p_cmpfin(F, layer);
            STEP_END
            STEP_BEGIN
#ifdef OLD_NSA
                p_nsa(F);
#else
                p_nsa2(F);
#endif
            STEP_END
            STEP_BEGIN
                pg8::MergeOrder S; S.so.init(MC, DM, F.G, F.bx); S.nmt = MC / 256;
                pg8::EpiMerge E{WSP(bf16, WS_G), WSP(bf16, WS_MG), MC / 256};
                run_gemm(F, WSP(bf16, WS_Y), WSP(bf16, WS_WBR), 3 * MC, 3 * DM, 256, S, E);
            STEP_END
            STEP_BEGIN
                pg8::StaticOrder S; S.init(MC, DM, F.G, F.bx);
                const float* base = (layer == 0 ? F.in[0] : F.out) + (size_t)c * MC * DM;
                pg8::EpiResid E{base, F.out + (size_t)c * MC * DM, DM, 1.0f};
                run_gemm(F, WSP(bf16, WS_MG), WSP(bf16, WS_WOUT), MC, DM, DM, S, E);
            STEP_END
        }
        if ((layer & 1) == 0) {
            STEP_BEGIN
                p_norm<0>(F, F.out, F.in[11] + (size_t)layer * DM, nullptr, 0, Q8_HN, TILED_FFN1);
            STEP_END
            for (int c = 0; c < FFN_CHUNKS; ++c) {
                constexpr int MF = MTOK / FFN_CHUNKS;
                STEP_BEGIN
                    pg8::StaticOrder S; S.init(MF, NFF1, F.G, F.bx);
                    pg8::EpiSwiGLU E{WSP(bf16, WS_HID), DFFP, nullptr, NFF1 / 256};
                    run_gemm(F, WSP(bf16, WS_HN) + (size_t)c * MF * DM, WSP(bf16, WS_WF1), MF, NFF1, DM, S, E, true, TILED_FFN1);
                STEP_END
                STEP_BEGIN
                    pg8::StaticOrder S; S.init(MF, DM, F.G, F.bx);
                    pg8::EpiResid E{F.out + (size_t)c * MF * DM, F.out + (size_t)c * MF * DM, DM, 1.0f};
                    run_gemm(F, WSP(bf16, WS_HID), WSP(bf16, WS_WF2), MF, DM, DFFP, S, E);
                STEP_END
            }
        } else {
            STEP_BEGIN
                p_norm<1>(F, F.out, F.in[11] + (size_t)layer * DM, F.in[15] + (size_t)jj * DM * NEXP, jj, Q8_HN);
            STEP_END
#ifdef ABL_DENSE_MOE
            for (int e = 0; e < NEXP; ++e) {
                STEP_BEGIN
                    pg8::StaticOrder S; S.init(MTOK, NMOE1, F.G, F.bx);
                    pg8::EpiSwiGLU E{WSP(bf16, WS_SCR + 8 * MiB), DFE, WSP(float, WS_SCR + 4 * MiB) + (size_t)e * MTOK, NMOE1 / 256};
                    run_gemm(F, WSP(bf16, WS_HN), WSP(bf16, WS_WF1) + (size_t)e * NMOE1 * DM, MTOK, NMOE1, DM, S, E);
                STEP_END
                STEP_BEGIN
                    pg8::StaticOrder S; S.init(MTOK, DM, F.G, F.bx);
                    pg8::EpiResid E{F.out, F.out, DM, 1.0f};
                    run_gemm(F, WSP(bf16, WS_SCR + 8 * MiB), WSP(bf16, WS_WF2) + (size_t)e * DM * DFE, MTOK, DM, DFE, S, E);
                STEP_END
            }
#else
            STEP_BEGIN
                p_gather(F, jj, 0, 0);
            STEP_END
            for (int c = 0; c < NCHUNK; ++c)
                for (int r = 0; r < 2; ++r) {
                    STEP_BEGIN
                        const int T = moe_table(F, jj, c, r);
                        pg8::GroupedOrder S; S.so.init(T * 256, NMOE1, F.G, F.bx); S.tile_e = (LAS int*)(F.lds + TAB_OFF); S.nN = NMOE1 / 256;
                        pg8::EpiSwiGLU E{WSP(bf16, WS_HIDM), DFE, WSP(float, WS_WSLOT) + (c * 2 + r) * SLOTS, NMOE1 / 256};
                        run_gemm(F, WSP(bf16, WS_XG), WSP(bf16, WS_WF1), T * 256, NMOE1, DM, S, E, false);
                    STEP_END
                    STEP_BEGIN
                        const int T = moe_table(F, jj, c, r);
                        pg8::GroupedOrder S; S.so.init(T * 256, DM, F.G, F.bx); S.tile_e = (LAS int*)(F.lds + TAB_OFF); S.nN = DM / 256;
                        pg8::EpiScatter E{F.out, WSP(int, WS_TOKMAP) + (c * 2 + r) * SLOTS, DM / 256, 1.0f};
                        run_gemm(F, WSP(bf16, WS_HIDM), WSP(bf16, WS_WF2), T * 256, DM, DFE, S, E, false);
                        if (!F.rep && c * 2 + r < 3) p_gather(F, jj, (c * 2 + r + 1) >> 1, (c * 2 + r + 1) & 1);
                    STEP_END
                }
#endif
        }
    }
    STEP_BEGIN
        p_norm<2>(F, F.out, F.in[19], nullptr, 0);
    STEP_END
#undef STEP_BEGIN
#undef STEP_END
}

#ifndef MK_STEPS_PER_LAUNCH
#define MK_STEPS_PER_LAUNCH 1
#endif
extern "C" void kernel_launch(void* const* d_in, const int* in_sizes, int n_in, void* d_out, int out_size, void* d_ws, size_t ws_size, hipStream_t stream) {
    static int grid = 0;
    if (grid == 0) {
        if (n_in != 20 || in_sizes[0] != MTOK * DM || out_size != MTOK * DM || ws_size < WS_END) { fprintf(stderr, "kernel_launch: unexpected shapes (n_in %d, in0 %d, out %d, ws %zu)\n", n_in, n_in > 0 ? in_sizes[0] : -1, out_size, ws_size); grid = -1; return; }
        int dev = 0, cus = 0, per_cu = 0;
        if (hipGetDevice(&dev) != hipSuccess || hipDeviceGetAttribute(&cus, hipDeviceAttributeMultiprocessorCount, dev) != hipSuccess) { grid = -1; return; }
        if (hipFuncSetAttribute((const void*)mk_fwd, hipFuncAttributeMaxDynamicSharedMemorySize, LDS_BYTES) != hipSuccess) { fprintf(stderr, "kernel_launch: hipFuncSetAttribute failed\n"); grid = -1; return; }
        if (hipOccupancyMaxActiveBlocksPerMultiprocessor(&per_cu, (const void*)mk_fwd, NWAVES * 64, LDS_BYTES) != hipSuccess || per_cu < 1) fprintf(stderr, "kernel_launch: occupancy query reports %d\n", per_cu);
        (void)hipGetLastError();
        grid = cus;
    }
    if (grid < 0) return;
    if (hipMemsetAsync((char*)d_ws + WS_CTL, 0, CTL_ZERO_BYTES, stream) != hipSuccess) return;
    Args a{};
    for (int i = 0; i < 20; ++i) a.in[i] = (const float*)d_in[i];
    a.out = (float*)d_out; a.ws = (unsigned char*)d_ws; a.rep = 0;
    #ifdef ABL_DENSE_MOE
    constexpr int NSTEPS = 2 * (1 + NCHUNK * 8 + 3) + 2 * (1 + NCHUNK * 8 + 1 + NEXP * 2) + 1;
#else
    constexpr int NSTEPS = 2 * (1 + NCHUNK * 7 + 1 + 2 * FFN_CHUNKS) + 2 * (1 + NCHUNK * 7 + 2 + NCHUNK * 2 * 2) + 1;
#endif
    int li = 0;
#ifdef REPMASK
    static int kinds[256]; int ns = 0;
    for (int layer = 0; layer < DEPTH; ++layer) { kinds[ns++] = 0;
        for (int c = 0; c < NCHUNK; ++c) for (int q = 1; q <= 8; ++q) if (q != 5) kinds[ns++] = q;
        if ((layer & 1) == 0) { kinds[ns++] = 9; for (int c = 0; c < FFN_CHUNKS; ++c) { kinds[ns++] = 10; kinds[ns++] = 11; } }
        else { kinds[ns++] = 12; kinds[ns++] = 17; for (int c = 0; c < NCHUNK * 2; ++c) { kinds[ns++] = 14; kinds[ns++] = 13; } } }
    kinds[ns++] = 16;
    for (int s = 0; s < NSTEPS; ++s) { const int reps = ((REPMASK >> kinds[s]) & 1) ? 2 : 1;
        for (int r = 0; r < reps; ++r) { a.lo = s; a.hi = s + 1; a.li = 0; a.rep = r;
            hipLaunchKernelGGL(mk_fwd, dim3(grid), dim3(NWAVES * 64), LDS_BYTES, stream, a); } }
    (void)li;
#else
    for (int s = 0; s < NSTEPS; s += MK_STEPS_PER_LAUNCH) {
        a.lo = s; a.hi = (s + MK_STEPS_PER_LAUNCH < NSTEPS) ? s + MK_STEPS_PER_LAUNCH : NSTEPS; a.li = (MK_STEPS_PER_LAUNCH > 1) ? li : 0; ++li;
        hipLaunchKernelGGL(mk_fwd, dim3(grid), dim3(NWAVES * 64), LDS_BYTES, stream, a);
        if (hipPeekAtLastError() != hipSuccess) { fprintf(stderr, "kernel_launch: launch failed\n"); break; }
    }
#endif
}
```

```cpp
#define MK_STEPS_PER_LAUNCH 1000
#define PG8_WGM 4
#define FFN_CHUNKS 1
#include <hip/hip_runtime.h>
#include <cstdio>
#include <cstdint>
#include <cmath>
#ifndef PG8_WGM
#define PG8_WGM 8
#endif
namespace pg8 {
#define PG8_LAS __attribute__((address_space(3)))
typedef unsigned short bf16_t;
typedef short bf16x8 __attribute__((ext_vector_type(8)));
typedef float f32x4 __attribute__((ext_vector_type(4)));
typedef unsigned u32x4 __attribute__((ext_vector_type(4)));
constexpr int BM = 256, BK = 64, HALF = 128, HTB = HALF * BK * 2  , STAGE_BYTES = 8 * HTB, NXCD = 8, WGM = PG8_WGM;

__host__ __device__ __forceinline__ int lds_byte(int r, int c) { const int st = (r >> 4) * 2 + (c >> 5), rr = r & 15, cc = c & 31, ob = rr * 64 + cc * 2; return st * 1024 + (ob ^ (((ob >> 9) & 1) << 5)); }
__host__ __device__ __forceinline__ void stage_rc(int b, int& R, int& C) { const int st = b / 1024, sb = b % 1024, swz = sb ^ (((sb >> 9) & 1) << 5); R = (st >> 1) * 16 + swz / 64; C = (st & 1) * 32 + (swz % 64) / 2; }
__host__ __device__ __forceinline__ int perm32(int rho) { const int n = rho >> 4, i = rho & 15; return 8 * (i >> 2) + 4 * n + (i & 3); }

struct Unit { int pm, pn; };
struct Gemm { const bf16_t* A; const bf16_t* Bt; int M, N, K; int zv; int rot; int tiled; };

struct StaticOrder {
    int nM, nN, nwg, G, c, wgm;
    __host__ __device__ void init(int M, int N, int G_, int c_, int wgm_ = WGM) { nM = M / BM; nN = N / BM; nwg = nM * nN; G = G_; c = c_; wgm = wgm_; }
    __host__ __device__ bool next(int i, Unit& u) const {
        const long L = (long)i * G + c; if (L >= nwg) return false;
        int wgid = (int)L; { const int q = nwg / NXCD, r = nwg % NXCD, xcd = wgid % NXCD, off = wgid / NXCD; wgid = (xcd < r ? xcd * (q + 1) : r * (q + 1) + (xcd - r) * q) + off; }
        const int nig = wgm * nN, gid = wgid / nig, fm = gid * wgm, gsz = (nM - fm) < wgm ? (nM - fm) : wgm;
        u.pm = fm + ((wgid % nig) % gsz); u.pn = (wgid % nig) / gsz; return true;
    }
    __device__ __forceinline__ void a_ready(const Unit&) const {}
    __device__ __forceinline__ void done(const Unit&) const {}
};

__device__ __forceinline__ unsigned cvt_pk_bf16(float lo, float hi) { unsigned r; asm volatile("v_cvt_pk_bf16_f32 %0, %1, %2" : "=v"(r) : "v"(lo), "v"(hi)); return r; }
typedef float f32x2 __attribute__((ext_vector_type(2)));

__device__ __forceinline__ float fast_sigmoid(float x) { return __builtin_amdgcn_rcpf(1.0f + __builtin_amdgcn_exp2f(-1.4426950408889634f * x)); }
__device__ __forceinline__ float gelu_tanh(float x) {
    const float u2 = 1.5957691216057308f * (x + 0.044715f * x * x * x);
    return x * fast_sigmoid(u2);
}
__device__ __forceinline__ float bf_lo(unsigned u) { return __builtin_bit_cast(float, u << 16); }
__device__ __forceinline__ float bf_hi(unsigned u) { return __builtin_bit_cast(float, u & 0xffff0000u); }

#ifdef PG8_NT_OUT
#define PG8_STORE_OUT(p, v) __builtin_nontemporal_store((v), (p))
#else
#define PG8_STORE_OUT(p, v) (*(p) = (v))
#endif
struct EpiProj {
    static constexpr bool PERM = true, AFTER_DRAIN = false, MID = false; static constexpr int MID_TILES = 1; __device__ __forceinline__ void set_scale0() {}
    bf16_t* P1; bf16_t* G;
    __device__ __forceinline__ void operator()(const f32x4 (&acc)[2][2][4][2], const Unit& u, int wr, int wc, int fr, int fq) const {
        const int row0 = u.pm * BM + wr * 64 + fr;
        bf16_t* base; int ldc, colt, act0, act1;
        if (u.pn < 8) { base = P1; ldc = 2048; colt = u.pn * BM; act0 = (u.pn < 2) ? 1 : 0; act1 = (u.pn == 7) ? 2 : act0; }
        else { base = G; ldc = 3072; colt = (u.pn - 8) * BM; act0 = 2; act1 = 2; }
        const int col0 = colt + wc * 32 + 8 * fq;
#pragma unroll
        for (int ai = 0; ai < 2; ++ai)
#pragma unroll
            for (int m = 0; m < 4; ++m) { bf16_t* rowp = base + (size_t)(row0 + ai * HALF + m * 16) * ldc + col0;
#pragma unroll
                for (int bj = 0; bj < 2; ++bj) { f32x4 v0 = acc[ai][bj][m][0], v1 = acc[ai][bj][m][1]; const int act = bj ? act1 : act0;
                    if (act == 1) {
#pragma unroll
                        for (int e = 0; e < 4; ++e) { v0[e] = gelu_tanh(v0[e]); v1[e] = gelu_tanh(v1[e]); } }
                    else if (act == 2) {
#pragma unroll
                        for (int e = 0; e < 4; ++e) { v0[e] = fast_sigmoid(v0[e]); v1[e] = fast_sigmoid(v1[e]); } }
                    u32x4 w; w.x = cvt_pk_bf16(v0[0], v0[1]); w.y = cvt_pk_bf16(v0[2], v0[3]); w.z = cvt_pk_bf16(v1[0], v1[1]); w.w = cvt_pk_bf16(v1[2], v1[3]);
                    *(u32x4*)(rowp + bj * HALF) = w; } }
    }
};
struct EpiMerge {
    static constexpr bool PERM = true, AFTER_DRAIN = false, MID = false; static constexpr int MID_TILES = 1; __device__ __forceinline__ void set_scale0() {}
    const bf16_t* G; bf16_t* MG; int nmt;
    __device__ __forceinline__ void operator()(const f32x4 (&acc)[2][2][4][2], const Unit& u, int wr, int wc, int fr, int fq) const {
        const int i = u.pn >> 2, pn = u.pn & 3, pm = u.pm - i * nmt;
        const int row0 = pm * BM + wr * 64 + fr, col0 = pn * BM + wc * 32 + 8 * fq;
#pragma unroll
        for (int ai = 0; ai < 2; ++ai)
#pragma unroll
            for (int mp = 0; mp < 2; ++mp) {
                u32x4 g[4], o[4];
#pragma unroll
                for (int q = 0; q < 4; ++q) { const int m = 2 * mp + (q >> 1), bj = q & 1; const size_t row = (size_t)(row0 + ai * HALF + m * 16); const int col = col0 + bj * HALF;
                    g[q] = *(const u32x4*)(G + row * 3072 + i * 1024 + col);
                    if (i > 0) o[q] = *(const u32x4*)(MG + row * 1024 + col); else o[q] = (u32x4){0u, 0u, 0u, 0u}; }
#pragma unroll
                for (int q = 0; q < 4; ++q) { const int m = 2 * mp + (q >> 1), bj = q & 1; const size_t row = (size_t)(row0 + ai * HALF + m * 16); const int col = col0 + bj * HALF;
                    f32x4 v0 = acc[ai][bj][m][0], v1 = acc[ai][bj][m][1];
#ifdef ABL_BRANCH
                    if (i == ABL_BRANCH) { v0 = v0 * (float)ABL_SCALE; v1 = v1 * (float)ABL_SCALE; }
#endif
                    v0[0] = v0[0] * bf_lo(g[q].x) + bf_lo(o[q].x); v0[1] = v0[1] * bf_hi(g[q].x) + bf_hi(o[q].x); v0[2] = v0[2] * bf_lo(g[q].y) + bf_lo(o[q].y); v0[3] = v0[3] * bf_hi(g[q].y) + bf_hi(o[q].y);
                    v1[0] = v1[0] * bf_lo(g[q].z) + bf_lo(o[q].z); v1[1] = v1[1] * bf_hi(g[q].z) + bf_hi(o[q].z); v1[2] = v1[2] * bf_lo(g[q].w) + bf_lo(o[q].w); v1[3] = v1[3] * bf_hi(g[q].w) + bf_hi(o[q].w);
                    u32x4 w; w.x = cvt_pk_bf16(v0[0], v0[1]); w.y = cvt_pk_bf16(v0[2], v0[3]); w.z = cvt_pk_bf16(v1[0], v1[1]); w.w = cvt_pk_bf16(v1[2], v1[3]);
                    *(u32x4*)(MG + row * 1024 + col) = w; } }
    }
};
struct EpiResid {
    static constexpr bool PERM = false, AFTER_DRAIN = false, MID = false; static constexpr int MID_TILES = 1; __device__ __forceinline__ void set_scale0() { scale = 0.f; base = out; }
    const float* base; float* out; int ldc; float scale;
    __device__ __forceinline__ void operator()(const f32x4 (&acc)[2][2][4][2], const Unit& u, int wr, int wc, int fr, int fq) const {
        const int row0 = u.pm * BM + wr * 64 + fr, col0 = u.pn * BM + wc * 32 + 4 * fq;
#pragma unroll
        for (int ai = 0; ai < 2; ++ai)
#pragma unroll
            for (int mp = 0; mp < 2; ++mp) {
                f32x4 b[8];
#pragma unroll
                for (int q = 0; q < 8; ++q) { const int m = 2 * mp + (q >> 2), bj = (q >> 1) & 1, n = q & 1;
                    b[q] = *(const f32x4*)(base + (size_t)(row0 + ai * HALF + m * 16) * ldc + col0 + bj * HALF + n * 16); }
#pragma unroll
                for (int q = 0; q < 8; ++q) { const int m = 2 * mp + (q >> 2), bj = (q >> 1) & 1, n = q & 1;
                    *(f32x4*)(out + (size_t)(row0 + ai * HALF + m * 16) * ldc + col0 + bj * HALF + n * 16) = b[q] + acc[ai][bj][m][n] * scale; } }
    }
};
struct EpiF32 {
    static constexpr bool PERM = false, AFTER_DRAIN = false, MID = false; static constexpr int MID_TILES = 1; __device__ __forceinline__ void set_scale0() {}
    float* O; int ldc, nN;
    __device__ __forceinline__ void operator()(const f32x4 (&acc)[2][2][4][2], const Unit& u, int wr, int wc, int fr, int fq) const {
        const int row0 = u.pm * BM + wr * 64 + fr, col0 = (u.pn % nN) * BM + wc * 32 + 4 * fq;
#pragma unroll
        for (int ai = 0; ai < 2; ++ai)
#pragma unroll
            for (int m = 0; m < 4; ++m) { const size_t off = (size_t)(row0 + ai * HALF + m * 16) * ldc + col0;
#pragma unroll
                for (int bj = 0; bj < 2; ++bj)
#pragma unroll
                    for (int n = 0; n < 2; ++n) *(f32x4*)(O + off + bj * HALF + n * 16) = acc[ai][bj][m][n]; }
    }
};
#ifdef EMU_FP8_HID
__device__ __forceinline__ float Q8H(float x) { const int p = __builtin_amdgcn_cvt_pk_fp8_f32(x * 8.f, x * 8.f, 0, false); return __builtin_amdgcn_cvt_f32_fp8(p, 0) * 0.125f; }
#else
__device__ __forceinline__ float Q8H(float x) { return x; }
#endif
struct EpiSwiGLU {
    static constexpr bool PERM = true, AFTER_DRAIN = false, MID = false; static constexpr int MID_TILES = 1; __device__ __forceinline__ void set_scale0() {}
    bf16_t* H; int ldh; const float* rowscale; int nN; int rowmask = 0x7fffffff;
    __device__ __forceinline__ void operator()(const f32x4 (&acc)[2][2][4][2], const Unit& u, int wr, int wc, int fr, int fq) const {
        const int row0 = u.pm * BM + wr * 64 + fr, col0 = (u.pn % nN) * HALF + wc * 32 + 8 * fq;
        float scv[8];
#pragma unroll
        for (int q = 0; q < 8; ++q) scv[q] = rowscale ? rowscale[row0 + (q >> 2) * HALF + (q & 3) * 16] : 1.0f;
#pragma unroll
        for (int ai = 0; ai < 2; ++ai)
#pragma unroll
            for (int m = 0; m < 4; ++m) { const int row = row0 + ai * HALF + m * 16; const float sc = scv[ai * 4 + m];
                float h[8];
#pragma unroll
                for (int n = 0; n < 2; ++n)
#pragma unroll
                    for (int e = 0; e < 4; ++e) { const float g = acc[ai][0][m][n][e], up = acc[ai][1][m][n][e]; h[n * 4 + e] = Q8H(g * fast_sigmoid(g) * up * sc); }
                u32x4 w; w.x = cvt_pk_bf16(h[0], h[1]); w.y = cvt_pk_bf16(h[2], h[3]); w.z = cvt_pk_bf16(h[4], h[5]); w.w = cvt_pk_bf16(h[6], h[7]);
                PG8_STORE_OUT((u32x4*)(H + (size_t)(row & rowmask) * ldh + col0), w); }
    }
};
struct EpiScatter {
    static constexpr bool PERM = false, AFTER_DRAIN = false, MID = false; static constexpr int MID_TILES = 1; __device__ __forceinline__ void set_scale0() { scale = 0.f; }
    float* out; const int* tok; int nN; float scale;
    __device__ __forceinline__ void operator()(const f32x4 (&acc)[2][2][4][2], const Unit& u, int wr, int wc, int fr, int fq) const {
        const int row0 = u.pm * BM + wr * 64 + fr, col0 = (u.pn % nN) * BM + wc * 32 + 4 * fq;
        int tk[8];
#pragma unroll
        for (int q = 0; q < 8; ++q) tk[q] = tok[row0 + (q >> 2) * HALF + (q & 3) * 16];
#pragma unroll
        for (int ai = 0; ai < 2; ++ai)
#pragma unroll
            for (int mp = 0; mp < 2; ++mp) {
                f32x4 b[8];
#pragma unroll
                for (int q = 0; q < 8; ++q) { const int m = 2 * mp + (q >> 2), bj = (q >> 1) & 1, n = q & 1; const int t = tk[ai * 4 + m];
                    b[q] = *(const f32x4*)(out + (size_t)(t < 0 ? 0 : t) * 1024 + col0 + bj * HALF + n * 16); }
#pragma unroll
                for (int q = 0; q < 8; ++q) { const int m = 2 * mp + (q >> 2), bj = (q >> 1) & 1, n = q & 1; const int t = tk[ai * 4 + m];
#ifdef ABL_MOE
                    if (false)
#else
                    if (t >= 0)
#endif
                        *(f32x4*)(out + (size_t)t * 1024 + col0 + bj * HALF + n * 16) = b[q] + acc[ai][bj][m][n] * scale; } }
    }
};
struct GroupedOrder {
    StaticOrder so; const PG8_LAS int* tile_e; int nN;
    __device__ __forceinline__ bool next(int i, Unit& u) const { if (!so.next(i, u)) return false; u.pn += tile_e[u.pm] * nN; return true; }
    __device__ __forceinline__ void a_ready(const Unit&) const {}
    __device__ __forceinline__ void done(const Unit&) const {}
};
struct ProbeOrder {
    StaticOrder so; int pm_mask;
    __device__ __forceinline__ bool next(int i, Unit& u) const { if (!so.next(i, u)) return false; u.pm &= pm_mask; return true; }
    __device__ __forceinline__ void a_ready(const Unit&) const {}
    __device__ __forceinline__ void done(const Unit&) const {}
};
struct MergeOrder {
    StaticOrder so; int nmt;
    __device__ __forceinline__ bool next(int i, Unit& u) const { const int b = i % 3; if (!so.next(i / 3, u)) return false; u.pm += b * nmt; u.pn += b * 4; return true; }
    __device__ __forceinline__ void a_ready(const Unit&) const {}
    __device__ __forceinline__ void done(const Unit&) const {}
};
template <class Epi, class Sched, bool ALIGN_EPI = false, bool SP2 = false>
__device__ __forceinline__ void gemm_phase(PG8_LAS unsigned char* lds, const Gemm g, const Sched& S, const Epi& E) {
    const int tid = g.zv  , wid = __builtin_amdgcn_readfirstlane(tid >> 6), lane = tid & 63, wr = wid >> 2, wc = wid & 3, fr = lane & 15, fq = lane >> 4;
    const int K = g.K, nt = K / BK;
    unsigned voffA[2], voffB[2];
#pragma unroll
    for (int i = 0; i < 2; ++i) { int R, C; stage_rc(tid * 16 + i * 8192, R, C); const int Rb = Epi::PERM ? ((R & ~31) + perm32(R & 31)) : R;
        const int pitch = g.tiled ? BK : K;
        voffA[i] = (unsigned)(R * pitch + C) * 2u; voffB[i] = (unsigned)(Rb * pitch + C) * 2u; }
    const size_t kstep = g.tiled ? (size_t)(BM * BK * 2) : (size_t)(BK * 2);
    const size_t hstep = g.tiled ? (size_t)(HALF * BK * 2) : (size_t)HALF * K * 2;
    const size_t tstep = (size_t)BM * K * 2;
    const unsigned ldsw = (unsigned)wid * 1024u;
    const int aoff = lds_byte(wr * 64 + fr, fq * 8), boff = lds_byte(wc * 32 + fr, fq * 8);
#define PG8_SA(b, h) (((b) * 2 + (h)) * HTB)
#define PG8_SB(b, h) ((4 + (b) * 2 + (h)) * HTB)
#define PG8_STAGE(bufoff, gbase, voff) do { _Pragma("unroll") for (int _i = 0; _i < 2; ++_i) \
        __builtin_amdgcn_global_load_lds((const unsigned*)((const char*)(gbase) + (voff)[_i]), (PG8_LAS unsigned*)(lds + (bufoff) + ldsw + _i * 8192), 16, 0, 0); } while (0)
#define PG8_LDA(dst, b, h) do { _Pragma("unroll") for (int m = 0; m < 4; ++m) _Pragma("unroll") for (int k = 0; k < 2; ++k) dst[m][k] = *(const PG8_LAS bf16x8*)(lds + PG8_SA(b, h) + aoff + m * 2048 + k * 1024); } while (0)
#define PG8_LDB(dst, b, h) do { _Pragma("unroll") for (int n = 0; n < 2; ++n) _Pragma("unroll") for (int k = 0; k < 2; ++k) dst[n][k] = *(const PG8_LAS bf16x8*)(lds + PG8_SB(b, h) + boff + n * 2048 + k * 1024); } while (0)
#define PG8_MMA(ai, bj, At, Bt) do { __builtin_amdgcn_s_setprio(1); _Pragma("unroll") for (int m = 0; m < 4; ++m) _Pragma("unroll") for (int n = 0; n < 2; ++n) _Pragma("unroll") for (int k = 0; k < 2; ++k) \
        acc[ai][bj][m][n] = __builtin_amdgcn_mfma_f32_16x16x32_bf16(Bt[n][k], At[m][k], acc[ai][bj][m][n], 0, 0, 0); __builtin_amdgcn_s_setprio(0); } while (0)
#define PG8_WAIT_V(n) asm volatile("s_waitcnt vmcnt(" #n ")" ::: "memory")
#define PG8_WAIT_L(n) asm volatile("s_waitcnt lgkmcnt(" #n ")" ::: "memory")
#define PG8_BAR __builtin_amdgcn_s_barrier()
#define PG8_SCHED __builtin_amdgcn_sched_barrier(0)
    Unit cur, nxt; int ui = 0;
    if (!S.next(0, cur)) return;
    f32x4 acc[2][2][4][2];
#pragma unroll
    for (int a = 0; a < 2; ++a)
#pragma unroll
        for (int b = 0; b < 2; ++b)
#pragma unroll
            for (int m = 0; m < 4; ++m)
#pragma unroll
                for (int n = 0; n < 2; ++n) acc[a][b][m][n] = (f32x4){0.f, 0.f, 0.f, 0.f};
    bf16x8 At[4][2], B0[2][2], B1[2][2];
    const char* cA = (const char*)g.A + (size_t)cur.pm * tstep; const char* cB = (const char*)g.Bt + (size_t)cur.pn * tstep;
    const int rot = g.rot; const size_t rofs = (size_t)rot * kstep; const char* pA = cA + rofs; const char* pB = cB + rofs;
#define PG8_KT(x) ((size_t)(((x) + rot >= nt) ? (x) + rot - nt : (x) + rot))
    S.a_ready(cur);
    if constexpr (SP2) {
        PG8_STAGE(PG8_SB(0, 0), pB, voffB); PG8_STAGE(PG8_SB(0, 1), pB + hstep, voffB); PG8_STAGE(PG8_SA(0, 0), pA, voffA); PG8_STAGE(PG8_SA(0, 1), pA + hstep, voffA);
        if (wr == 1) PG8_BAR;
        PG8_WAIT_V(2); PG8_BAR;
        PG8_STAGE(PG8_SB(1, 0), pB + kstep, voffB); PG8_STAGE(PG8_SA(1, 0), pA + kstep, voffA); PG8_STAGE(PG8_SB(1, 1), pB + hstep + kstep, voffB);
        PG8_WAIT_V(6); PG8_BAR;
    } else {
        PG8_STAGE(PG8_SB(0, 0), pB, voffB); PG8_STAGE(PG8_SA(0, 0), pA, voffA); PG8_STAGE(PG8_SB(0, 1), pB + hstep, voffB); PG8_STAGE(PG8_SA(0, 1), pA + hstep, voffA);
        if (wr == 1) PG8_BAR;
        PG8_WAIT_V(4); PG8_BAR;
        PG8_STAGE(PG8_SB(1, 0), pB + kstep, voffB); PG8_STAGE(PG8_SA(1, 0), pA + kstep, voffA); PG8_STAGE(PG8_SB(1, 1), pB + hstep + kstep, voffB);
        PG8_WAIT_V(6); PG8_BAR;
    }
    for (;;) {
        const bool has_next = S.next(ui + 1, nxt);
        const char* nA = has_next ? (const char*)g.A + (size_t)nxt.pm * tstep : cA; const char* nB = has_next ? (const char*)g.Bt + (size_t)nxt.pn * tstep : cB;
        for (int t = 0; t < nt; t += 2) {
            if constexpr (Epi::MID) { if (t != 0 && (t & (Epi::MID_TILES - 1)) == 0) E.mid(acc, cur, t / Epi::MID_TILES, wr, wc, fr, fq); }
            const bool last = (t == nt - 2);
            const char* a1 = cA + PG8_KT(t + 1) * kstep;
            const char* a2 = last ? nA + rofs : cA + PG8_KT(t + 2) * kstep; const char* b2 = last ? nB + rofs : cB + PG8_KT(t + 2) * kstep;
            const char* a3 = a2 + kstep; const char* b3 = b2 + kstep;
            if (last && has_next) S.a_ready(nxt);
            if constexpr (SP2) {
            PG8_LDB(B0, 0, 0); PG8_LDB(B1, 0, 1); PG8_SCHED; PG8_LDA(At, 0, 0); PG8_STAGE(PG8_SA(1, 1), a1 + hstep, voffA);
            PG8_WAIT_V(8); PG8_WAIT_L(0); PG8_BAR; PG8_MMA(0, 0, At, B0); PG8_MMA(0, 1, At, B1); PG8_BAR; PG8_SCHED;
            PG8_LDA(At, 0, 1); PG8_STAGE(PG8_SB(0, 0), b2, voffB); PG8_STAGE(PG8_SB(0, 1), b2 + hstep, voffB); PG8_STAGE(PG8_SA(0, 0), a2, voffA);
            PG8_WAIT_V(8); PG8_WAIT_L(0); PG8_BAR; PG8_MMA(1, 0, At, B0); PG8_MMA(1, 1, At, B1); PG8_BAR; PG8_SCHED;
            PG8_LDB(B0, 1, 0); PG8_LDB(B1, 1, 1); PG8_SCHED; PG8_LDA(At, 1, 0); PG8_STAGE(PG8_SA(0, 1), a2 + hstep, voffA);
            PG8_WAIT_V(8); PG8_WAIT_L(0); PG8_BAR; PG8_MMA(0, 0, At, B0); PG8_MMA(0, 1, At, B1); PG8_BAR; PG8_SCHED;
            PG8_LDA(At, 1, 1); PG8_STAGE(PG8_SB(1, 0), b3, voffB); PG8_STAGE(PG8_SB(1, 1), b3 + hstep, voffB); PG8_STAGE(PG8_SA(1, 0), a3, voffA);
            PG8_WAIT_V(8); PG8_WAIT_L(0); PG8_BAR; PG8_MMA(1, 0, At, B0); PG8_MMA(1, 1, At, B1); PG8_BAR; PG8_SCHED;
            } else {
            PG8_LDB(B0, 0, 0); PG8_SCHED; PG8_LDA(At, 0, 0); PG8_STAGE(PG8_SA(1, 1), a1 + hstep, voffA);
            PG8_WAIT_L(8); PG8_BAR; PG8_WAIT_L(0); PG8_MMA(0, 0, At, B0); PG8_BAR; PG8_SCHED;
            PG8_LDB(B1, 0, 1); PG8_STAGE(PG8_SB(0, 0), b2, voffB);
            PG8_BAR; PG8_WAIT_L(0); PG8_MMA(0, 1, At, B1); PG8_BAR;
            PG8_LDA(At, 0, 1); PG8_STAGE(PG8_SA(0, 0), a2, voffA);
            PG8_BAR; PG8_WAIT_L(0); PG8_MMA(1, 0, At, B0); PG8_BAR; PG8_SCHED;
            PG8_STAGE(PG8_SB(0, 1), b2 + hstep, voffB);
            PG8_WAIT_V(6); PG8_BAR; PG8_MMA(1, 1, At, B1); PG8_BAR;
            PG8_LDB(B0, 1, 0); PG8_SCHED; PG8_LDA(At, 1, 0); PG8_STAGE(PG8_SA(0, 1), a2 + hstep, voffA);
            PG8_WAIT_L(8); PG8_BAR; PG8_WAIT_L(0); PG8_MMA(0, 0, At, B0); PG8_BAR; PG8_SCHED;
            PG8_LDB(B1, 1, 1); PG8_STAGE(PG8_SB(1, 0), b3, voffB);
            PG8_BAR; PG8_WAIT_L(0); PG8_MMA(0, 1, At, B1); PG8_BAR;
            PG8_LDA(At, 1, 1); PG8_STAGE(PG8_SA(1, 0), a3, voffA);
            PG8_BAR; PG8_WAIT_L(0); PG8_MMA(1, 0, At, B0); PG8_BAR; PG8_SCHED;
            PG8_STAGE(PG8_SB(1, 1), b3 + hstep, voffB);
            PG8_WAIT_V(6); PG8_BAR; PG8_MMA(1, 1, At, B1); PG8_BAR;
            }
        }
        if constexpr (ALIGN_EPI) { if (wr == 0) PG8_BAR; }
        if constexpr (!Epi::AFTER_DRAIN) { E(acc, cur, wr, wc, fr, fq); S.done(cur); }
        if (!has_next) break;
#pragma unroll
        for (int a = 0; a < 2; ++a)
#pragma unroll
            for (int b = 0; b < 2; ++b)
#pragma unroll
                for (int m = 0; m < 4; ++m)
#pragma unroll
                    for (int n = 0; n < 2; ++n) acc[a][b][m][n] = (f32x4){0.f, 0.f, 0.f, 0.f};
        cur = nxt; cA = nA; cB = nB; ++ui;
        if constexpr (ALIGN_EPI) { if (wr == 1) PG8_BAR; }
    }
    PG8_WAIT_V(0);
    if constexpr (!ALIGN_EPI) { if (wr == 0) PG8_BAR; }
    PG8_BAR;
    if constexpr (Epi::AFTER_DRAIN) { E.fused(acc, cur, wr, wc, fr, fq, lds, wid, lane); S.done(cur); }
#undef PG8_KT
#undef PG8_SA
#undef PG8_SB
#undef PG8_STAGE
#undef PG8_LDA
#undef PG8_LDB
#undef PG8_MMA
#undef PG8_WAIT_V
#undef PG8_WAIT_L
#undef PG8_BAR
#undef PG8_SCHED
}
}

constexpr int NWAVES = 8;
constexpr int DM = 1024, BATCH = 16, SEQ = 4096, DEPTH = 4, MTOK = BATCH * SEQ;
constexpr int NCHUNK = 2, MC = MTOK / NCHUNK, BC = BATCH / NCHUNK;
constexpr int CIN = 5004, NPROJ = 5120, P1W = 2048, GWID = 3072;
constexpr int DFF = 2752, DFFP = 2816, NFF1 = 2 * DFFP;
constexpr int NEXP = 8, DFE = 3584, NMOE1 = 2 * DFE;
constexpr int SLOTS = MC + 2048;
constexpr float EPS = 1e-6f;
constexpr int C_U = 0, C_V = 256, C_SBQ = 512, C_SBK = 768, C_SBV = 1024, C_CQ = 1280, C_KCMP = 1536, C_VCMP = 1600, C_KSLC = 1664, C_VSLC = 1728, C_KWIN = 1792, C_VWIN = 1856, C_CG = 1920;

constexpr size_t MiB = 1u << 20;
constexpr size_t WS_CTL = 0, CTL_ZERO_BYTES = 1 * MiB;
constexpr size_t WS_ROPE = 1 * MiB;
constexpr size_t WS_BIAS1 = 1 * MiB + 512 * 1024;
constexpr size_t WS_WIN = 2 * MiB;
constexpr size_t WS_WBR = 12 * MiB;
constexpr size_t WS_WOUT = 14 * MiB;
constexpr size_t WS_WC1 = 16 * MiB;
constexpr size_t WS_WF1 = 18 * MiB;
constexpr size_t WS_WF2 = 130 * MiB;
constexpr size_t WS_HN = 186 * MiB;
constexpr size_t WS_SCR = 314 * MiB;
constexpr size_t WS_P1 = WS_SCR;
constexpr size_t WS_G = WS_P1 + 128 * MiB;
constexpr size_t WS_Y = WS_G + 192 * MiB;
constexpr size_t WS_MG = WS_Y + 48 * MiB;
constexpr size_t WS_KVC = WS_MG + 64 * MiB;
constexpr size_t WS_UL = WS_KVC + 8 * MiB;
constexpr size_t WS_KC = WS_UL + 8 * MiB;
constexpr size_t WS_VT = WS_KC + 1 * MiB;
constexpr size_t WS_KCT = WS_VT + 24 * MiB;
constexpr size_t WS_MIX_END = WS_KCT + 1 * MiB;
constexpr size_t WS_HID = WS_SCR;
constexpr size_t WS_ROUTE = WS_SCR;
constexpr size_t WS_TOKMAP = WS_SCR + 1 * MiB;
constexpr size_t WS_WSLOT = WS_SCR + 2 * MiB;
constexpr size_t WS_XG = WS_SCR + 4 * MiB;
constexpr size_t WS_HIDM = WS_XG + 68 * MiB;
constexpr size_t WS_END = 800 * MiB;
static_assert(WS_MIX_END <= WS_END && WS_HID + (size_t)MTOK * DFFP * 2 <= WS_END && WS_HIDM + (size_t)SLOTS * DFE * 2 <= WS_END, "d_ws map");
static_assert(WS_WF1 + (size_t)NEXP * NMOE1 * DM * 2 <= WS_WF2 && WS_WF2 + (size_t)NEXP * DM * DFE * 2 <= WS_HN, "weight map");
static_assert((size_t)4 * SLOTS * 4 <= 1 * MiB, "tokmap");
constexpr int CW_BAR = 4096;
constexpr int CW_CNT = 131072;
constexpr int CW_CUR = 131072 + 256;
constexpr int MAX_BAR_REGIONS = 32;
constexpr int RING_OFF = 0, RING_BYTES = 131072;
constexpr int LDSCTL_OFF = RING_BYTES, MISC_OFF = LDSCTL_OFF + 320;
constexpr int TAB_OFF = LDSCTL_OFF + 1024;
constexpr int LDS_BYTES = 147456;

#define GAS __attribute__((address_space(1)))
#define LAS __attribute__((address_space(3)))
typedef unsigned short bf16;
typedef unsigned v4u __attribute__((ext_vector_type(4)));
typedef unsigned v2u __attribute__((ext_vector_type(2)));
typedef float f32x4 __attribute__((ext_vector_type(4)));
typedef int v4i __attribute__((ext_vector_type(4)));
typedef __bf16 bf16x2_t __attribute__((ext_vector_type(2)));
#define LDS_WAIT() asm volatile("s_waitcnt lgkmcnt(0)" ::: "memory")
#define VM_WAIT() asm volatile("s_waitcnt vmcnt(0)" ::: "memory")
__device__ __forceinline__ unsigned f2bf(float f) { unsigned u = __builtin_bit_cast(unsigned, f); return (u + 0x7fffu + ((u >> 16) & 1u)) >> 16; }
__device__ __forceinline__ unsigned pk2(float lo, float hi) { return f2bf(lo) | (f2bf(hi) << 16); }
__device__ __forceinline__ float bflo(unsigned u) { return __builtin_bit_cast(float, u << 16); }
__device__ __forceinline__ float bfhi(unsigned u) { return __builtin_bit_cast(float, u & 0xffff0000u); }
__device__ __forceinline__ float bf1(bf16 h) { return __builtin_bit_cast(float, (unsigned)h << 16); }
__device__ __forceinline__ float dot2bf(unsigned a, unsigned b, float c) { return __builtin_amdgcn_fdot2_f32_bf16(__builtin_bit_cast(bf16x2_t, a), __builtin_bit_cast(bf16x2_t, b), c, false); }
#ifdef EMU_FP8
__device__ __forceinline__ float q8r(float x, float s) { const int p = __builtin_amdgcn_cvt_pk_fp8_f32(x * s, x * s, 0, false); return __builtin_amdgcn_cvt_f32_fp8(p, 0) * (1.0f / s); }
#else
__device__ __forceinline__ float q8r(float x, float) { return x; }
#endif
__device__ __forceinline__ float fexp(float x) { return __builtin_amdgcn_exp2f(1.4426950408889634f * x); }
template <int X> __device__ __forceinline__ float swz_xor(float v) { return __builtin_bit_cast(float, __builtin_amdgcn_ds_swizzle(__builtin_bit_cast(int, v), (X << 10) | 0x1f)); }
__device__ __forceinline__ float wave_sum(float v, int lane) {
#pragma unroll
    for (int o = 1; o < 64; o <<= 1) v += __builtin_bit_cast(float, __builtin_amdgcn_ds_bpermute((lane ^ o) << 2, __builtin_bit_cast(int, v)));
    return v;
}
__device__ __forceinline__ float rdlane(float v, int l) { return __builtin_bit_cast(float, __builtin_amdgcn_readlane(__builtin_bit_cast(int, v), l)); }
__device__ __forceinline__ int bperm(int srclane, int v) { return __builtin_amdgcn_ds_bpermute(srclane << 2, v); }
__constant__ double ROPE_INVF[8] = {1.0, 0.19392274474868576, 0.037606030930863933, 0.0072926647372171093, 0.0014142135623730950, 0.00027424817567620730, 5.3182958969449883e-05, 1.0313385377212460e-05};
#define XB_TMO      128
#define XB_XCNT(j)  (256  + 64 * (j))
#define XB_XSUB(j)  (1280 + 64 * (j))
#define XB_XGEN(j)  (2304 + 64 * (j))
#define XB_TOP      3328
#define XB_TOPGEN   3392
#define XCD_BAR_WORDS 3456
#define XB_SPIN_CAP (1u << 18)

__device__ __forceinline__ unsigned xb_ld(unsigned* p)              { return __hip_atomic_load(p, __ATOMIC_RELAXED, __HIP_MEMORY_SCOPE_AGENT); }
__device__ __forceinline__ unsigned xb_add(unsigned* p, unsigned v) { return __hip_atomic_fetch_add(p, v, __ATOMIC_RELAXED, __HIP_MEMORY_SCOPE_AGENT); }
__device__ __forceinline__ unsigned xb_xcc_id() { return (unsigned)__builtin_amdgcn_s_getreg((3 << 11) | 20) & 0xFu; }
#define XB_SPIN(cond, bar) do { unsigned _sp = 0; while (cond) { __builtin_amdgcn_s_sleep(1); \
    if ((++_sp & 255u) == 0u) { if (xb_ld(&(bar)[XB_TMO])) break; if (_sp > XB_SPIN_CAP) { atomicAdd(&(bar)[XB_TMO], 1u); break; } } } } while (0)

__device__ __forceinline__ bool xb_thread0_w(unsigned w, unsigned z) { return w == 0u && __builtin_amdgcn_mbcnt_hi(~0u, __builtin_amdgcn_mbcnt_lo(~0u, z)) == 0u; }
struct XcdBarrier {
    unsigned* bar; unsigned x; unsigned w, z;
    volatile LAS unsigned* st;
};

__device__ __forceinline__ XcdBarrier xcd_barrier_post(unsigned* bar, volatile LAS unsigned* st) {
    XcdBarrier b; b.bar = bar; b.x = xb_xcc_id(); b.st = st; b.w = (unsigned)__builtin_amdgcn_readfirstlane((int)(threadIdx.x >> 6)); b.z = 0u;
    if (xb_thread0_w(b.w, b.z)) (void)xb_add(&bar[XB_XCNT(b.x)], 1u);
    return b;
}
__device__ __forceinline__ void xcd_barrier_complete(unsigned* bar, unsigned x, unsigned& nloc, unsigned& nx) {
    const unsigned G = gridDim.x * gridDim.y * gridDim.z;
    unsigned sum, cnt, mine, sp = 0u;
    for (;;) {
        sum = 0u; cnt = 0u; mine = 0u;
#pragma unroll
        for (unsigned j = 0; j < 16; ++j) { const unsigned c = xb_ld(&bar[XB_XCNT(j)]); sum += c; cnt += (c > 0u) ? 1u : 0u; mine = (j == x) ? c : mine; }
        if (sum == G) break;
        __builtin_amdgcn_s_sleep(1);
        if ((++sp & 255u) == 0u) { if (xb_ld(&bar[XB_TMO])) break; if (sp > XB_SPIN_CAP) { atomicAdd(&bar[XB_TMO], 1u); break; } }
    }
    nloc = mine > 0u ? mine : 1u; nx = cnt > 0u ? cnt : 1u;
}

__device__ __forceinline__ void xcd_barrier(const XcdBarrier& b) {
    asm volatile("s_waitcnt vmcnt(0)" ::: "memory");
    __syncthreads();
    if (xb_thread0_w(b.w, b.z)) {
        unsigned* bar = b.bar;
        __builtin_amdgcn_s_waitcnt(0);
        unsigned nloc = b.st[0], nx = b.st[1];
        if (nloc == 0u) { xcd_barrier_complete(bar, b.x, nloc, nx); b.st[0] = nloc; b.st[1] = nx; }
        const unsigned old = xb_add(&bar[XB_XSUB(b.x)], 1u);
        const unsigned gen = old / nloc;
        if (old + 1u == (gen + 1u) * nloc) {
            __builtin_amdgcn_fence(__ATOMIC_RELEASE, "agent");
            asm volatile("s_waitcnt vmcnt(0)" ::: "memory");
            const unsigned og = xb_add(&bar[XB_TOP], 1u);
            const unsigned tg = og / nx;
            if (og + 1u == (tg + 1u) * nx) xb_add(&bar[XB_TOPGEN], 1u);
            else XB_SPIN(xb_ld(&bar[XB_TOPGEN]) == tg, bar);
            __builtin_amdgcn_fence(__ATOMIC_ACQUIRE, "agent");
            xb_add(&bar[XB_XGEN(b.x)], 1u);
            asm volatile("s_waitcnt vmcnt(0)" ::: "memory");
        } else {
            XB_SPIN(xb_ld(&bar[XB_XGEN(b.x)]) == gen, bar);
            __builtin_amdgcn_fence(__ATOMIC_ACQUIRE, "agent");
            asm volatile("s_waitcnt vmcnt(0)" ::: "memory");
        }
    }
    __syncthreads();
}

struct Frame {
    LAS unsigned char* lds;
    unsigned* ctl;
    int tid, lane, wave, vcu, G, bx, zv, zs, rep;
    unsigned char* ws;
    const float* const* in;
    float* out;
};
#define WSP(T, off) ((T*)(F.ws + (off)))
__device__ __forceinline__ size_t toff(int row, int k, int K) { return (size_t)(row >> 8) * 256 * K + (size_t)(k >> 6) * (256 * 64) + (size_t)(row & 255) * 64 + (k & 63); }

#ifndef TILED_FFN1
#define TILED_FFN1 0
#endif
#ifndef Q8_W1
#define Q8_W1 0.f
#define Q8_W2 0.f
#define Q8_HN 0.f
#define Q8_HID 0.f
#endif
__device__ __forceinline__ int map_row(int kind, int off, int n) { return kind == 0 ? n + off : (kind == 1 ? (n < 1932 ? n : n + 116) : ((n >> 7) * 256 + (n & 127) + off)); }
__device__ __forceinline__ void tr_item(const float* W, int ldw, int N, int ks, int n0, bf16* WT, int ldt, int kd, int kind, int off, LAS unsigned char* scr, int lane, float q8s = 0.f, int tiled = 0) {
    const int nq = (lane & 15) * 4, kq = lane >> 4;
    f32x4 x[16];
#pragma unroll
    for (int i = 0; i < 16; ++i) x[i] = (n0 + nq < N) ? *(const f32x4*)(W + (size_t)(ks + 4 * i + kq) * ldw + n0 + nq) : (f32x4){0.f, 0.f, 0.f, 0.f};
#pragma unroll
    for (int i = 0; i < 16; ++i) { const int k = 4 * i + kq;
#pragma unroll
        for (int c = 0; c < 4; ++c) { float wv = x[i][c]; if (q8s > 0.f) wv = q8r(wv, q8s); *(LAS bf16*)(scr + (nq + c) * 136 + k * 2) = (bf16)f2bf(wv); } }
    LDS_WAIT(); asm volatile("" ::: "memory");
    if (n0 + lane < N) { const LAS v2u* s = (const LAS v2u*)(scr + lane * 136); const int mr = map_row(kind, off, n0 + lane); bf16* dst = tiled ? WT + toff(mr, kd, ldt) : WT + (size_t)mr * ldt + kd;
#pragma unroll
        for (int q = 0; q < 8; ++q) { const v2u a = s[2 * q], b = s[2 * q + 1]; *(v4u*)(dst + 8 * q) = (v4u){a.x, a.y, b.x, b.y}; } }
    LDS_WAIT(); asm volatile("" ::: "memory");
}
__device__ __forceinline__ void conv(Frame& F, const float* W, size_t sW, int nb, int ldw, int N, int ks0, int K, bf16* WT, size_t sWT, int ldt, int kd0, int kind, int off, float q8s = 0.f, int tiled = 0) {
    LAS unsigned char* scr = F.lds + RING_OFF + F.wave * 16384;
    const int gw = F.vcu * NWAVES + F.wave, NGW = F.G * NWAVES;
    const int nblk = (N + 63) / 64, per = (K / 64) * nblk, total = per * nb;
    for (int it = gw; it < total; it += NGW) { const int b = it / per, r = it % per, kb = r / nblk, nbk = r % nblk;
        tr_item(W + (size_t)b * sW, ldw, N, ks0 + 64 * kb, 64 * nbk, WT + (size_t)b * sWT, ldt, kd0 + 64 * kb, kind, off, scr, F.lane, q8s, tiled); }
}
__device__ __forceinline__ void zero_block(Frame& F, bf16* WT, int ldt, int r0, int rows, int c0, int cols, int tiled = 0) {
    const int gt = (F.vcu * NWAVES + F.wave) * 64 + F.lane, NT = F.G * NWAVES * 64, cpr = cols / 8;
    for (int i = gt; i < rows * cpr; i += NT) { const int r = i / cpr, c = i % cpr; const unsigned z = (unsigned)F.zv; *(v4u*)(tiled ? WT + toff(r0 + r, c0 + 8 * c, ldt) : WT + (size_t)(r0 + r) * ldt + c0 + 8 * c) = (v4u){z, z, z, z}; }
}
__device__ __forceinline__ void p_convert(Frame& F, int layer) {
    const int j = layer >> 1;
    conv(F, F.in[2] + (size_t)layer * DM * CIN, 0, 1, CIN, CIN, 0, DM, WSP(bf16, WS_WIN), 0, DM, 0, 1, 0);
    zero_block(F, WSP(bf16, WS_WIN), DM, 1932, 116, 0, DM);
    conv(F, F.in[9] + (size_t)layer * 3 * 256 * DM, (size_t)256 * DM, 3, DM, DM, 0, 256, WSP(bf16, WS_WBR), (size_t)DM * 256, 256, 0, 0, 0);
    conv(F, F.in[10] + (size_t)layer * DM * DM, 0, 1, DM, DM, 0, DM, WSP(bf16, WS_WOUT), 0, DM, 0, 0, 0);
    conv(F, F.in[7] + (size_t)layer * 2 * 2048 * 256, (size_t)2048 * 256, 2, 256, 256, 0, 1024, WSP(bf16, WS_WC1), (size_t)512 * 1024, 1024, 0, 0, 0);
    conv(F, F.in[7] + (size_t)layer * 2 * 2048 * 256, (size_t)2048 * 256, 2, 256, 256, 1024, 1024, WSP(bf16, WS_WC1), (size_t)512 * 1024, 1024, 0, 0, 256);
    if ((layer & 1) == 0) {
        conv(F, F.in[12] + (size_t)j * DM * DFF, 0, 1, DFF, DFF, 0, DM, WSP(bf16, WS_WF1), 0, DM, 0, 2, 0, Q8_W1, TILED_FFN1);
        conv(F, F.in[13] + (size_t)j * DM * DFF, 0, 1, DFF, DFF, 0, DM, WSP(bf16, WS_WF1), 0, DM, 0, 2, 128, Q8_W1, TILED_FFN1);
        zero_block(F, WSP(bf16, WS_WF1), DM, 21 * 256 + 64, 64, 0, DM, TILED_FFN1);
        zero_block(F, WSP(bf16, WS_WF1), DM, 21 * 256 + 128 + 64, 64, 0, DM, TILED_FFN1);
        conv(F, F.in[14] + (size_t)j * DFF * DM, 0, 1, DM, DM, 0, DFF, WSP(bf16, WS_WF2), 0, DFFP, 0, 0, 0, Q8_W2);
        zero_block(F, WSP(bf16, WS_WF2), DFFP, 0, DM, DFF, DFFP - DFF);
    } else {
        conv(F, F.in[16] + (size_t)j * NEXP * DM * DFE, (size_t)DM * DFE, NEXP, DFE, DFE, 0, DM, WSP(bf16, WS_WF1), (size_t)NMOE1 * DM, DM, 0, 2, 0, Q8_W1);
        conv(F, F.in[17] + (size_t)j * NEXP * DM * DFE, (size_t)DM * DFE, NEXP, DFE, DFE, 0, DM, WSP(bf16, WS_WF1), (size_t)NMOE1 * DM, DM, 0, 2, 128, Q8_W1);
        conv(F, F.in[18] + (size_t)j * NEXP * DFE * DM, (size_t)DFE * DM, NEXP, DM, DM, 0, DFE, WSP(bf16, WS_WF2), (size_t)DM * DFE, DFE, 0, 0, 0, Q8_W2);
    }
    if (F.bx < 8) {
        __syncthreads();
        const int kv = F.bx >> 2, jj = (F.bx & 3) * 64 + F.lane;
        const float* pos = F.in[6] + (size_t)(layer * 2 + kv) * 2048; const float* w1 = F.in[7] + (size_t)(layer * 2 + kv) * 2048 * 256;
        float a = 0.f;
        float a1 = 0.f, a2 = 0.f, a3 = 0.f;
#pragma unroll 8
        for (int k = 0; k < 256; k += 4) { const int kk = F.wave * 256 + k;
            a += pos[kk] * w1[(size_t)kk * 256 + jj]; a1 += pos[kk + 1] * w1[(size_t)(kk + 1) * 256 + jj]; a2 += pos[kk + 2] * w1[(size_t)(kk + 2) * 256 + jj]; a3 += pos[kk + 3] * w1[(size_t)(kk + 3) * 256 + jj]; }
        a = (a + a1) + (a2 + a3);
        LAS float* red = (LAS float*)(F.lds + RING_OFF);
        red[F.wave * 64 + F.lane] = a;
        __syncthreads();
        if (F.wave == 0) { float s = 0.f;
#pragma unroll
            for (int w = 0; w < 8; ++w) s += red[w * 64 + F.lane];
            WSP(float, WS_BIAS1)[kv * 256 + jj] = s; }
        __syncthreads();
    }
    if (layer == 0) {
        const int gt = (F.vcu * NWAVES + F.wave) * 64 + F.lane, NT = F.G * NWAVES * 64;
        for (int idx = gt; idx < SEQ * 8; idx += NT) { const int pos = idx >> 3, i = idx & 7;
            const double invf = ROPE_INVF[i];
            double rev = (double)pos * invf * 0.15915494309189535; rev -= __builtin_floor(rev);
            WSP(float, WS_ROPE)[idx] = __builtin_amdgcn_cosf((float)rev); WSP(float, WS_ROPE)[SEQ * 8 + idx] = __builtin_amdgcn_sinf((float)rev); }
    }
}

template <int MODE> __device__ __forceinline__ void p_norm(Frame& F, const float* src, const float* g, const float* rw, int jmoe, float q8s = 0.f, int tiled = 0) {
    const int gw = F.vcu * NWAVES + F.wave, NGW = F.G * NWAVES, lane = F.lane;
    LAS int* hist = (LAS int*)(F.lds + TAB_OFF) + 192;
    if (MODE == 1) {
        if (F.tid < 32) hist[F.tid] = 0;
        const int gt = gw * 64 + lane, NT = NGW * 64; int* tm = WSP(int, WS_TOKMAP);
        for (int i = gt; i < 4 * SLOTS; i += NT) tm[i] = -1;
        for (int i = F.tid; i < DM * NEXP / 4; i += NWAVES * 64) *(LAS f32x4*)(F.lds + RING_OFF + 16 * i) = ((const f32x4*)rw)[i];
        __syncthreads();
    }
    f32x4 gv[4];
#pragma unroll
    for (int jx = 0; jx < 4; ++jx) gv[jx] = ((const f32x4*)g)[lane + 64 * jx];
    constexpr int ROWS = (MODE == 1) ? 2 : 4;
    for (int m0 = gw; m0 < MTOK; m0 += ROWS * NGW) {
        f32x4 v[ROWS][4]; float ss[ROWS];
#pragma unroll
        for (int u = 0; u < ROWS; ++u) { const int m = m0 + u * NGW; const f32x4* xr = (const f32x4*)(src + (size_t)(m < MTOK ? m : m0) * DM) + lane;
#pragma unroll
            for (int jx = 0; jx < 4; ++jx) v[u][jx] = xr[64 * jx]; }
#pragma unroll
        for (int u = 0; u < ROWS; ++u) { float s = 0.f;
#pragma unroll
            for (int jx = 0; jx < 4; ++jx) s += (v[u][jx].x * v[u][jx].x + v[u][jx].y * v[u][jx].y) + (v[u][jx].z * v[u][jx].z + v[u][jx].w * v[u][jx].w);
            ss[u] = s; }
#pragma unroll
        for (int o = 1; o < 64; o <<= 1) {
#pragma unroll
            for (int u = 0; u < ROWS; ++u) ss[u] += __builtin_bit_cast(float, __builtin_amdgcn_ds_bpermute((lane ^ o) << 2, __builtin_bit_cast(int, ss[u]))); }
        float lgall[MODE == 1 ? ROWS : 1][8];
        if (MODE == 1) {
            float rs[ROWS];
#pragma unroll
            for (int u = 0; u < ROWS; ++u) { rs[u] = 1.0f / sqrtf(ss[u] * (1.f / DM) + EPS);
#pragma unroll
                for (int e = 0; e < 8; ++e) lgall[u][e] = 0.f; }
#pragma unroll
            for (int jx = 0; jx < 4; ++jx) { const LAS f32x4* wr = (const LAS f32x4*)(F.lds + RING_OFF + (size_t)(4 * lane + 256 * jx) * 32);
#pragma unroll
                for (int r = 0; r < 4; ++r) { const f32x4 a = wr[2 * r], b = wr[2 * r + 1];
#pragma unroll
                    for (int u = 0; u < ROWS; ++u) { const float xv = v[u][jx][r] * rs[u] * gv[jx][r];
                        lgall[u][0] += xv * a.x; lgall[u][1] += xv * a.y; lgall[u][2] += xv * a.z; lgall[u][3] += xv * a.w; lgall[u][4] += xv * b.x; lgall[u][5] += xv * b.y; lgall[u][6] += xv * b.z; lgall[u][7] += xv * b.w; } } }
        }
#pragma unroll
        for (int u = 0; u < ROWS; ++u) { const int m = m0 + u * NGW; if (m >= MTOK) continue;
            const float rstd = 1.0f / sqrtf(ss[u] * (1.f / DM) + EPS);
#pragma unroll
            for (int jx = 0; jx < 4; ++jx) v[u][jx] = v[u][jx] * rstd * gv[jx];
            if (MODE == 2) {
                f32x4* o = (f32x4*)(F.out + (size_t)m * DM) + lane;
#pragma unroll
                for (int jx = 0; jx < 4; ++jx) o[64 * jx] = v[u][jx];
            } else {
                unsigned long long* o8 = (unsigned long long*)(WSP(bf16, WS_HN) + (size_t)m * DM) + lane;
#pragma unroll
                for (int jx = 0; jx < 4; ++jx) { f32x4 w = v[u][jx];
                    if (tiled) { *(unsigned long long*)(WSP(bf16, WS_HN) + toff(m, 4 * lane + 256 * jx, DM)) = (unsigned long long)pk2(w.x, w.y) | ((unsigned long long)pk2(w.z, w.w) << 32); continue; } if (q8s > 0.f) { w.x = q8r(w.x, q8s); w.y = q8r(w.y, q8s); w.z = q8r(w.z, q8s); w.w = q8r(w.w, q8s); }
                    o8[64 * jx] = (unsigned long long)pk2(w.x, w.y) | ((unsigned long long)pk2(w.z, w.w) << 32); }
            }
            if (MODE == 1) {
                float lg[8];
#pragma unroll
                for (int e = 0; e < 8; ++e) lg[e] = lgall[u][e];
                float h4[4], h2[2], h1;
                { const bool up = lane & 1;
#pragma unroll
                  for (int i = 0; i < 4; ++i) { const float keep = up ? lg[4 + i] : lg[i], send = up ? lg[i] : lg[4 + i]; h4[i] = keep + __builtin_bit_cast(float, bperm(lane ^ 1, __builtin_bit_cast(int, send))); } }
                { const bool up = lane & 2;
#pragma unroll
                  for (int i = 0; i < 2; ++i) { const float keep = up ? h4[2 + i] : h4[i], send = up ? h4[i] : h4[2 + i]; h2[i] = keep + __builtin_bit_cast(float, bperm(lane ^ 2, __builtin_bit_cast(int, send))); } }
                { const bool up = lane & 4; const float keep = up ? h2[1] : h2[0], send = up ? h2[0] : h2[1]; h1 = keep + __builtin_bit_cast(float, bperm(lane ^ 4, __builtin_bit_cast(int, send))); }
                h1 += __builtin_bit_cast(float, bperm(lane ^ 8, __builtin_bit_cast(int, h1))); h1 += __builtin_bit_cast(float, bperm(lane ^ 16, __builtin_bit_cast(int, h1))); h1 += __builtin_bit_cast(float, bperm(lane ^ 32, __builtin_bit_cast(int, h1)));
                lg[0] = rdlane(h1, 0); lg[1] = rdlane(h1, 4); lg[2] = rdlane(h1, 2); lg[3] = rdlane(h1, 6); lg[4] = rdlane(h1, 1); lg[5] = rdlane(h1, 5); lg[6] = rdlane(h1, 3); lg[7] = rdlane(h1, 7);
                int e0 = 0; float v0 = lg[0];
#pragma unroll
                for (int e = 1; e < 8; ++e) if (lg[e] > v0) { v0 = lg[e]; e0 = e; }
                int e1 = -1; float v1 = -INFINITY;
#pragma unroll
                for (int e = 0; e < 8; ++e) if (e != e0 && lg[e] > v1) { v1 = lg[e]; e1 = e; }
                const float w0 = 1.0f / (1.0f + fexp(v1 - v0)), w1 = 1.0f - w0;
                if (lane == 0) { WSP(v4i, WS_ROUTE)[m] = (v4i){e0, e1, __builtin_bit_cast(int, w0), __builtin_bit_cast(int, w1)};
                    const int c = m / MC; if (!F.rep) { atomicAdd((int*)&hist[(c * 2 + 0) * 8 + e0], 1); atomicAdd((int*)&hist[(c * 2 + 1) * 8 + e1], 1); } }
            }
        }
    }
    if (MODE == 1) {
        __syncthreads();
        if (F.tid < 32) { const int h = hist[F.tid]; if (h) atomicAdd(F.ctl + CW_CNT + jmoe * 32 + F.tid, (unsigned)h); }
    }
}

__device__ __forceinline__ void p_prep(Frame& F) {
    const int gw = F.vcu * NWAVES + F.wave, NGW = F.G * NWAVES, lane = F.lane;
    bf16* P1 = WSP(bf16, WS_P1); bf16* KVC = WSP(bf16, WS_KVC); const float* rope = WSP(float, WS_ROPE);
    const int vec = lane >> 3, ri = lane & 7; const int cb = vec < 4 ? C_CQ + vec * 64 : (vec == 4 ? C_KCMP : (vec == 5 ? C_KSLC : C_KWIN));
    for (int row0 = gw; row0 < MC; row0 += 4 * NGW) {
        float x1[4], x2[4], cc[4], ss[4]; bf16 kc48[4], vc64[4];
#pragma unroll
        for (int k = 0; k < 4; ++k) { const int row = row0 + k * NGW < MC ? row0 + k * NGW : row0; const bf16* p = P1 + (size_t)row * P1W; const int pos = row & (SEQ - 1);
            const int cl = lane < 56 ? cb + ri : C_CQ;
            x1[k] = bf1(p[cl]); x2[k] = bf1(p[cl + 8]); cc[k] = rope[pos * 8 + ri]; ss[k] = rope[SEQ * 8 + pos * 8 + ri];
            if (F.rep) { cc[k] = 1.f; ss[k] = 0.f; }
            kc48[k] = p[C_KCMP + 16 + (lane < 48 ? lane : 0)]; vc64[k] = p[C_VCMP + lane]; }
#pragma unroll
        for (int k = 0; k < 4; ++k) { const int row = row0 + k * NGW; if (row >= MC) continue; bf16* p = P1 + (size_t)row * P1W;
            if (lane < 56) { const bf16 o1 = (bf16)f2bf(x1[k] * cc[k] - x2[k] * ss[k]), o2 = (bf16)f2bf(x2[k] * cc[k] + x1[k] * ss[k]);
                p[cb + ri] = o1; p[cb + ri + 8] = o2;
                if (vec == 4) { KVC[(size_t)row * 64 + ri] = o1; KVC[(size_t)row * 64 + ri + 8] = o2; } }
            if (lane < 48) KVC[(size_t)row * 64 + 16 + lane] = kc48[k];
            KVC[(size_t)MC * 64 + (size_t)row * 64 + lane] = vc64[k]; }
    }
    bf16* VT = WSP(bf16, WS_VT);
    for (int it = gw; it < 6 * BC * 64; it += NGW) { const int which = it / (BC * 64), r = it % (BC * 64), b = r >> 6, blk = r & 63;
        const v4u* src = (const v4u*)(P1 + ((size_t)b * SEQ + blk * 64 + lane) * P1W + (which == 0 ? C_VSLC : (which == 1 ? C_VWIN : C_SBV + (which - 2) * 64)));
        bf16* dst = VT + ((size_t)(which * BC + b) * 64) * SEQ + blk * 64 + lane;
        v4u xs[8];
#pragma unroll
        for (int i = 0; i < 8; ++i) xs[i] = src[i];
#pragma unroll
        for (int i = 0; i < 8; ++i) { const v4u x = xs[i];
            dst[(size_t)(8 * i + 0) * SEQ] = (bf16)(x.x & 0xffffu); dst[(size_t)(8 * i + 1) * SEQ] = (bf16)(x.x >> 16);
            dst[(size_t)(8 * i + 2) * SEQ] = (bf16)(x.y & 0xffffu); dst[(size_t)(8 * i + 3) * SEQ] = (bf16)(x.y >> 16);
            dst[(size_t)(8 * i + 4) * SEQ] = (bf16)(x.z & 0xffffu); dst[(size_t)(8 * i + 5) * SEQ] = (bf16)(x.z >> 16);
            dst[(size_t)(8 * i + 6) * SEQ] = (bf16)(x.w & 0xffffu); dst[(size_t)(8 * i + 7) * SEQ] = (bf16)(x.w >> 16); }
    }
}
__device__ __forceinline__ void p_sgu(Frame& F, int layer) {
    LAS float* vn = (LAS float*)(F.lds + RING_OFF);
    const bf16* P1 = WSP(bf16, WS_P1); bf16* Ya = WSP(bf16, WS_Y);
    const float* gain = F.in[3] + (size_t)layer * 256; const float* sw = F.in[4] + (size_t)layer * 4 * 128 * 128; const float* sb = F.in[5] + (size_t)layer * 4 * 128;
    const int lane = F.lane, wave = F.wave;
    for (int item = F.vcu; item < MC / 128; item += F.G) {
        const size_t r0 = (size_t)item * 128;
        __syncthreads();
        for (int rr = 0; rr < 16; ++rr) { const int r = wave * 16 + rr; const v2u raw = *(const v2u*)(P1 + (r0 + r) * P1W + C_V + 4 * lane);
            const float a = bflo(raw.x), b = bfhi(raw.x), c = bflo(raw.y), d = bfhi(raw.y);
            const float rstd = 1.0f / sqrtf(wave_sum((a * a + b * b) + (c * c + d * d), lane) * (1.f / 256.f) + EPS);
            const f32x4 gg = ((const f32x4*)gain)[lane];
            *(LAS f32x4*)(vn + r * 256 + 4 * lane) = (f32x4){a * rstd * gg.x, b * rstd * gg.y, c * rstd * gg.z, d * rstd * gg.w}; }
        __syncthreads();
        const int g = wave & 3, half = wave >> 2;
        for (int i = 0; i < 64; ++i) { const int t = 2 * i + half;
            const float* wrow = sw + ((size_t)g * 128 + t) * 128;
            const float w_lo = wrow[lane], w_hi = wrow[64 + lane];
            float acc = 0.f;
            for (int s = 0; s <= t; ++s) { const float w = (s < 64) ? rdlane(w_lo, s) : rdlane(w_hi, s - 64); acc += w * vn[s * 256 + g * 64 + lane]; }
            const float u = bf1(P1[(r0 + t) * P1W + C_U + g * 64 + lane]);
#ifdef ABL_SGUMIX
            acc = 0.f;
#endif
            Ya[(r0 + t) * 256 + g * 64 + lane] = (bf16)f2bf(u * (acc + sb[g * 128 + t])); }
    }
    __syncthreads();
}

__device__ __forceinline__ void p_cmpfin(Frame& F, int layer) {
    const int gw = F.vcu * NWAVES + F.wave, NGW = F.G * NWAVES, lane = F.lane;
    const float* UL = WSP(float, WS_UL); const float* bias = WSP(float, WS_BIAS1); bf16* KC = WSP(bf16, WS_KC);
    LAS float* w2l = (LAS float*)(F.lds + RING_OFF);
    __syncthreads();
    { const f32x4* src = (const f32x4*)(F.in[8] + (size_t)layer * 2 * 256 * 64);
#pragma unroll 4
      for (int i = F.tid; i < 2 * 256 * 64 / 4; i += NWAVES * 64) *(LAS f32x4*)(w2l + 4 * i) = src[i]; }
    __syncthreads();
    for (int it = gw; it < 2 * BC * 255; it += NGW) { const int kv = it / (BC * 255), r = it % (BC * 255), b = r / 255, m = r % 255;
        const LAS float* w2 = w2l + kv * 256 * 64;
        const float* U = UL + (size_t)(kv * 2048 + b * 256 + m) * 512; const float* L = U + 512 + 256;
        float hv[4];
#pragma unroll
        for (int q = 0; q < 4; ++q) hv[q] = pg8::gelu_tanh(U[64 * q + lane] + L[64 * q + lane] + bias[kv * 256 + 64 * q + lane]);
        float acc0 = 0.f, acc1 = 0.f;
#pragma unroll
        for (int q = 0; q < 4; ++q)
#pragma unroll 8
            for (int jj = 0; jj < 64; jj += 2) { acc0 += rdlane(hv[q], jj) * w2[(64 * q + jj) * 64 + lane]; acc1 += rdlane(hv[q], jj + 1) * w2[(64 * q + jj + 1) * 64 + lane]; }
        const float acc = acc0 + acc1;
        KC[((size_t)(kv * BC + b) * 256 + m) * 64 + lane] = (bf16)f2bf(acc);
        if (kv == 1) { WSP(bf16, WS_KCT)[((size_t)b * 64 + lane) * 256 + m] = (bf16)f2bf(acc); if (m == 254) WSP(bf16, WS_KCT)[((size_t)b * 64 + lane) * 256 + 255] = (bf16)0; }
        else if (m == 254) KC[((size_t)b * 256 + 255) * 64 + lane] = (bf16)0; }
    __syncthreads();
}

__device__ __forceinline__ void p_stick(Frame& F) {
    const int gw = F.vcu * NWAVES + F.wave, NGW = F.G * NWAVES, lane = F.lane;
    const bf16* P1 = WSP(bf16, WS_P1); bf16* Yb = WSP(bf16, WS_Y) + (size_t)MC * 256;
    for (int item = gw; item < BC * 4 * 64; item += NGW) { const int tb = item & 63, h = (item >> 6) & 3, b = item >> 8;
        const int t = tb * 64 + lane; const size_t row = (size_t)b * SEQ + t;
        unsigned q[32];
        { const v4u* qp = (const v4u*)(P1 + row * P1W + C_SBQ + h * 64);
#pragma unroll
          for (int i = 0; i < 8; ++i) { const v4u x = qp[i]; q[4 * i] = x.x; q[4 * i + 1] = x.y; q[4 * i + 2] = x.z; q[4 * i + 3] = x.w; } }
        float o[64];
#pragma unroll
        for (int d = 0; d < 64; ++d) o[d] = 0.f;
        float R = 0.f;
        const bf16* kb = P1 + (size_t)b * SEQ * P1W + C_SBK + h * 64; const bf16* vb = P1 + (size_t)b * SEQ * P1W + C_SBV + h * 64;
        for (int s = t - 1; s >= 0; --s) {
            if (R < -100.f) break;
            const v4u* kp = (const v4u*)(kb + (size_t)s * P1W); const v4u* vp = (const v4u*)(vb + (size_t)s * P1W);
            float z0 = 0.f, z1 = 0.f;
#pragma unroll
            for (int i = 0; i < 8; ++i) { const v4u k = kp[i]; z0 = dot2bf(k.x, q[4 * i], z0); z1 = dot2bf(k.y, q[4 * i + 1], z1); z0 = dot2bf(k.z, q[4 * i + 2], z0); z1 = dot2bf(k.w, q[4 * i + 3], z1); }
            const float z = (z0 + z1) * 0.125f;
            const float tt = 0.6931471805599453f * __builtin_amdgcn_logf(1.0f + fexp(-__builtin_fabsf(z)));
            const float lb = fminf(z, 0.f) - tt, l1m = fminf(-z, 0.f) - tt;
            const float a = fexp(lb + R); R += l1m;
#pragma unroll
            for (int i = 0; i < 8; ++i) { const v4u v = vp[i];
                o[8 * i] += a * bflo(v.x); o[8 * i + 1] += a * bfhi(v.x); o[8 * i + 2] += a * bflo(v.y); o[8 * i + 3] += a * bfhi(v.y);
                o[8 * i + 4] += a * bflo(v.z); o[8 * i + 5] += a * bfhi(v.z); o[8 * i + 6] += a * bflo(v.w); o[8 * i + 7] += a * bfhi(v.w); }
        }
        v4u* op = (v4u*)(Yb + row * 256 + h * 64);
#pragma unroll
        for (int i = 0; i < 8; ++i) op[i] = (v4u){pk2(o[8 * i], o[8 * i + 1]), pk2(o[8 * i + 2], o[8 * i + 3]), pk2(o[8 * i + 4], o[8 * i + 5]), pk2(o[8 * i + 6], o[8 * i + 7])};
    }
}

struct Soft { float mx, l; };
__device__ __forceinline__ float dotq(const LAS v4u* ql, const bf16* kp_) {
    const v4u* kp = (const v4u*)kp_; float z0 = 0.f, z1 = 0.f;
#pragma unroll
    for (int i = 0; i < 8; ++i) { const v4u k = kp[i]; const v4u q = ql[i]; z0 = dot2bf(k.x, q.x, z0); z1 = dot2bf(k.y, q.y, z1); z0 = dot2bf(k.z, q.z, z0); z1 = dot2bf(k.w, q.w, z1); }
    return (z0 + z1) * 0.125f;
}
__device__ __forceinline__ void axpy_row(float p, const bf16* vp_, float (&o)[64]) {
    const v4u* vp = (const v4u*)vp_;
#pragma unroll
    for (int i = 0; i < 8; ++i) { const v4u v = vp[i];
        o[8 * i] += p * bflo(v.x); o[8 * i + 1] += p * bfhi(v.x); o[8 * i + 2] += p * bflo(v.y); o[8 * i + 3] += p * bfhi(v.y);
        o[8 * i + 4] += p * bflo(v.z); o[8 * i + 5] += p * bfhi(v.z); o[8 * i + 6] += p * bflo(v.w); o[8 * i + 7] += p * bfhi(v.w); }
}
__device__ __forceinline__ void nsa_step(const LAS v4u* ql, const bf16* kp_, const bf16* vp_, Soft& S, float (&o)[64]) {
    const float s = dotq(ql, kp_);
    if (s > S.mx) { const float sc = fexp(S.mx - s); S.l *= sc;
#pragma unroll
        for (int d = 0; d < 64; ++d) o[d] *= sc;
        S.mx = s; }
    const float p = fexp(s - S.mx); S.l += p;
    asm volatile("" ::: "memory");
    axpy_row(p, vp_, o);
}
__device__ __forceinline__ void nsa_accum(bf16* yrow, bool first, float sc, const float (&o)[64]) {
    v4u* op = (v4u*)yrow;
#pragma unroll
    for (int i = 0; i < 8; ++i) { v4u old = (v4u){0u, 0u, 0u, 0u}; if (!first) old = op[i];
        op[i] = (v4u){pk2(bflo(old.x) + sc * o[8 * i], bfhi(old.x) + sc * o[8 * i + 1]), pk2(bflo(old.y) + sc * o[8 * i + 2], bfhi(old.y) + sc * o[8 * i + 3]),
                      pk2(bflo(old.z) + sc * o[8 * i + 4], bfhi(old.z) + sc * o[8 * i + 5]), pk2(bflo(old.w) + sc * o[8 * i + 6], bfhi(old.w) + sc * o[8 * i + 7])}; }
}
__device__ __forceinline__ void p_nsa(Frame& F) {
    const int gw = F.vcu * NWAVES + F.wave, NGW = F.G * NWAVES, lane = F.lane;
    const bf16* P1 = WSP(bf16, WS_P1); const bf16* KC = WSP(bf16, WS_KC); bf16* Yc = WSP(bf16, WS_Y) + (size_t)2 * MC * 256;
    LAS float* imp = (LAS float*)(F.lds + RING_OFF + F.wave * 4096);
    LAS v4u* ql = (LAS v4u*)(F.lds + RING_OFF + 32768 + F.wave * 9216 + lane * 144);
    const int qi = lane >> 2, h = lane & 3;
    for (int item = gw; item < BC * 256; item += NGW) { const int b = item >> 8, tg = item & 255;
        const int t = tg * 16 + qi; const size_t row = (size_t)b * SEQ + t; const bf16* prow = P1 + row * P1W;
        { const v4u* qp = (const v4u*)(prow + C_CQ + h * 64);
#pragma unroll
          for (int i = 0; i < 8; ++i) ql[i] = qp[i]; }
        const float g0 = bf1(prow[C_CG + h * 3]), g1 = bf1(prow[C_CG + h * 3 + 1]), g2 = bf1(prow[C_CG + h * 3 + 2]);
        bf16* yrow = Yc + row * 256 + h * 64;
        float o[64];
        for (int i = lane; i < 1024; i += 64) imp[i] = 0.f;
        const int nv = t >= 31 ? ((t - 31) >> 4) + 1 : 0; const int nvmax = (tg * 16 + 15 >= 31) ? ((tg * 16 + 15 - 31) >> 4) + 1 : 0;
        const bf16* kc = KC + (size_t)(0 * BC + b) * 256 * 64; const bf16* vc = KC + (size_t)(1 * BC + b) * 256 * 64;
        { float mx = -INFINITY, l = 0.f;
          for (int m = 0; m < nvmax; ++m) { const float s = dotq(ql, kc + m * 64); if (m < nv) { if (s > mx) { l *= fexp(mx - s); mx = s; } l += fexp(s - mx); } }
          const float rl = l > 0.f ? 1.0f / l : 0.f;
#pragma unroll
          for (int d = 0; d < 64; ++d) o[d] = 0.f;
          for (int m = 0; m < nvmax; ++m) { const float s = dotq(ql, kc + m * 64); const float p = (m < nv) ? fexp(s - mx) * rl : 0.f;
              asm volatile("" ::: "memory");
              axpy_row(p, vc + m * 64, o);
              float P = p + __builtin_bit_cast(float, bperm(lane ^ 1, __builtin_bit_cast(int, p))); P += __builtin_bit_cast(float, bperm(lane ^ 2, __builtin_bit_cast(int, P)));
              if (h == 0) { const int j0 = m >> 2; const bool edge = (m & 3) == 3; imp[qi * 64 + j0] += edge ? 0.5f * P : P; if (edge) imp[qi * 64 + j0 + 1] += 0.5f * P; } }
          nsa_accum(yrow, true, g0, o); }
        unsigned long long mask = 0ull;
        { const int cur = t >> 6, nvb = cur + 1;
          if (h == 0) {
              if (nvb <= 16) mask = (1ull << nvb) - 1ull;
              else { mask = 1ull | (1ull << cur);
                  for (int r = 0; r < 14; ++r) { int best = -1; float bv = -1.f;
                      for (int j = 1; j < cur; ++j) { const float v = imp[qi * 64 + j]; if (!((mask >> j) & 1ull) && v > bv) { bv = v; best = j; } }
                      mask |= 1ull << best; } } }
          const unsigned mlo = (unsigned)bperm(lane & ~3, (int)(unsigned)mask), mhi = (unsigned)bperm(lane & ~3, (int)(unsigned)(mask >> 32));
          mask = ((unsigned long long)mhi << 32) | mlo; }
        { Soft S{-INFINITY, 0.f};
#pragma unroll
          for (int d = 0; d < 64; ++d) o[d] = 0.f;
          const bf16* kb = P1 + (size_t)b * SEQ * P1W + C_KSLC; const bf16* vb = P1 + (size_t)b * SEQ * P1W + C_VSLC;
          unsigned long long mm = mask;
          while (mm) { const int j = __builtin_ctzll(mm); mm &= mm - 1ull;
              for (int kk = 0; kk < 64; ++kk) { const int sp = j * 64 + kk; if (sp > t) break; nsa_step(ql, kb + (size_t)sp * P1W, vb + (size_t)sp * P1W, S, o); } }
          nsa_accum(yrow, false, g1 / S.l, o); }
        { Soft S{-INFINITY, 0.f};
#pragma unroll
          for (int d = 0; d < 64; ++d) o[d] = 0.f;
          const bf16* kb = P1 + (size_t)b * SEQ * P1W + C_KWIN; const bf16* vb = P1 + (size_t)b * SEQ * P1W + C_VWIN;
          for (int i = 0; i < 512; ++i) { const int sp = t - 511 + i; if (sp >= 0) nsa_step(ql, kb + (size_t)sp * P1W, vb + (size_t)sp * P1W, S, o); }
          nsa_accum(yrow, false, g2 / S.l, o); }
    }
}

__device__ __forceinline__ int moe_table(Frame& F, int jmoe, int c, int r) {
    LAS int* tab = (LAS int*)(F.lds + TAB_OFF);
    __syncthreads();
    if (F.tid < 8) tab[176 + F.tid] = (int)__hip_atomic_load(F.ctl + CW_CNT + jmoe * 32 + (c * 2 + r) * 8 + F.tid, __ATOMIC_RELAXED, __HIP_MEMORY_SCOPE_AGENT);
    __syncthreads();
    if (F.tid == 0) { int base = 0, T = 0;
        for (int e = 0; e < 8; ++e) { const int cnt = tab[176 + e];
            const int nt = (cnt + 255) >> 8; tab[160 + e] = base; for (int i = 0; i < nt && T + i < 160; ++i) tab[T + i] = e; T += nt; base += nt * 256; }
        tab[168] = T < 136 ? T : 136; }
    __syncthreads();
    return tab[168];
}
__device__ __forceinline__ void p_gather(Frame& F, int jmoe, int c, int r) {
    moe_table(F, jmoe, c, r);
    const LAS int* tab = (const LAS int*)(F.lds + TAB_OFF);
    const int gw = F.vcu * NWAVES + F.wave, NGW = F.G * NWAVES, lane = F.lane;
    const v4i* route = WSP(v4i, WS_ROUTE); int* tokmap = WSP(int, WS_TOKMAP) + (c * 2 + r) * SLOTS; float* wslot = WSP(float, WS_WSLOT) + (c * 2 + r) * SLOTS;
    const bf16* HN = WSP(bf16, WS_HN); bf16* XG = WSP(bf16, WS_XG);
    unsigned* cur = F.ctl + CW_CUR + jmoe * 32 + (c * 2 + r) * 8;
    for (int tg = gw; tg < MC / 16; tg += NGW) {
        const int m = c * MC + tg * 16 + (lane & 15); const v4i rt = route[m];
        const int e = lane < 16 ? (r ? rt.y : rt.x) : -1; const float w = __builtin_bit_cast(float, r ? rt.w : rt.z);
        int pos = 0;
#pragma unroll
        for (int ee = 0; ee < 8; ++ee) { const unsigned long long bal = __builtin_amdgcn_ballot_w64(e == ee);
            if (bal) { unsigned basep = 0; if (lane == 0) basep = atomicAdd(cur + ee, (unsigned)__builtin_popcountll(bal));
                basep = (unsigned)__builtin_amdgcn_readfirstlane((int)basep);
                if (e == ee) pos = (int)basep + __builtin_popcountll(bal & ((1ull << lane) - 1ull)); } }
        int slot = 0;
        if (lane < 16) { slot = tab[160 + e] + pos; tokmap[slot] = m; wslot[slot] = w; }
#pragma unroll
        for (int i0 = 0; i0 < 16; i0 += 4) { v4u x[8];
#pragma unroll
            for (int i = 0; i < 4; ++i) { const int mi = __builtin_amdgcn_readlane(m, i0 + i); const v4u* src = (const v4u*)(HN + (size_t)mi * DM); x[2 * i] = src[lane]; x[2 * i + 1] = src[64 + lane]; }
#pragma unroll
            for (int i = 0; i < 4; ++i) { const int si = __builtin_amdgcn_readlane(slot, i0 + i); v4u* dst = (v4u*)(XG + (size_t)si * DM); dst[lane] = x[2 * i]; dst[64 + lane] = x[2 * i + 1]; } }
    }
}

typedef float f32x16 __attribute__((ext_vector_type(16)));
typedef short bf16x8v __attribute__((ext_vector_type(8)));
typedef float f32x2v __attribute__((ext_vector_type(2)));
constexpr int NSA_K = 0, NSA_V = 8192, NSA_BUF = 17408, NSA_STAGE = 2 * NSA_BUF, NSA_IMP = 69632, NSA_CARRY = 86016, NSA_SEL = 103424, NSA_WSF = 103936;
constexpr float NSA_C2 = 0.125f * 1.4426950408889634f;
__device__ __forceinline__ unsigned cvtpk(float lo, float hi) { f32x2v v = {lo, hi}; bf16x2_t b = __builtin_convertvector(v, bf16x2_t); return __builtin_bit_cast(unsigned, b); }
__device__ __forceinline__ float partner32(float v, int lane) { return __builtin_bit_cast(float, __builtin_amdgcn_ds_bpermute((lane ^ 32) << 2, __builtin_bit_cast(int, v))); }
__device__ __forceinline__ void nsa_load(v4u& kx, v4u& vx, const bf16* Kg, int kp, const bf16* Vg, int vp, int tid) {
    kx = *(const v4u*)(Kg + (size_t)(tid & 63) * kp + (tid >> 6) * 8); vx = *(const v4u*)(Vg + (size_t)(tid >> 3) * vp + (tid & 7) * 8);
}
__device__ __forceinline__ void nsa_store(LAS unsigned char* lds, const v4u& kx, const v4u& vx, int tid) {
    *(LAS v4u*)(lds + NSA_K + (tid >> 6) * 1024 + (tid & 63) * 16) = kx; *(LAS v4u*)(lds + NSA_V + (tid >> 3) * 144 + (tid & 7) * 16) = vx;
}
__device__ __forceinline__ void nsa_qk(const LAS unsigned char* lds, const bf16x8v (&qr)[4], f32x16& p0, f32x16& p1, int r32, int hi) {
#pragma unroll
    for (int i = 0; i < 16; ++i) { p0[i] = 0.f; p1[i] = 0.f; }
#pragma unroll
    for (int d0 = 0; d0 < 4; ++d0) {
        const bf16x8v k0 = *(const LAS bf16x8v*)(lds + NSA_K + (2 * d0 + hi) * 1024 + r32 * 16);
        const bf16x8v k1 = *(const LAS bf16x8v*)(lds + NSA_K + (2 * d0 + hi) * 1024 + 512 + r32 * 16);
        p0 = __builtin_amdgcn_mfma_f32_32x32x16_bf16(k0, qr[d0], p0, 0, 0, 0);
        p1 = __builtin_amdgcn_mfma_f32_32x32x16_bf16(k1, qr[d0], p1, 0, 0, 0);
    }
#pragma unroll
    for (int i = 0; i < 16; ++i) { p0[i] *= NSA_C2; p1[i] *= NSA_C2; }
}
__device__ __forceinline__ void nsa_mask(f32x16& p0, f32x16& p1, int hi, int hiL, int loL, bool rowok, bool full  ) {
    if (full) {
#pragma unroll
        for (int i = 0; i < 16; ++i) { p0[i] = rowok ? p0[i] : -INFINITY; p1[i] = rowok ? p1[i] : -INFINITY; }
        return; }
#pragma unroll
    for (int i = 0; i < 16; ++i) { const int kk = (i & 3) + 8 * (i >> 2) + 4 * hi;
        if (!(rowok && kk <= hiL && kk > loL)) p0[i] = -INFINITY;
        if (!(rowok && kk + 32 <= hiL && kk + 32 > loL)) p1[i] = -INFINITY; }
}
__device__ __forceinline__ float nsa_max32(const f32x16& p0, const f32x16& p1) {
    float a = fmaxf(fmaxf(p0[0], p0[1]), p1[0]), b = fmaxf(fmaxf(p0[2], p0[3]), p1[1]); a = fmaxf(fmaxf(a, p1[2]), p1[3]);
#pragma unroll
    for (int i = 4; i < 16; i += 4) { a = fmaxf(fmaxf(a, p0[i]), p0[i + 1]); b = fmaxf(fmaxf(b, p0[i + 2]), p0[i + 3]); a = fmaxf(fmaxf(a, p1[i]), p1[i + 1]); b = fmaxf(fmaxf(b, p1[i + 2]), p1[i + 3]); }
    return fmaxf(a, b);
}
__device__ __forceinline__ void nsa_pv(const LAS unsigned char* lds, const f32x16& p0, const f32x16& p1, f32x16 (&o)[2], int r32, int hi) {
    bf16x8v pa[4];
#pragma unroll
    for (int s = 0; s < 2; ++s) {
        const v4u a = (v4u){cvtpk(p0[8 * s], p0[8 * s + 1]), cvtpk(p0[8 * s + 2], p0[8 * s + 3]), cvtpk(p0[8 * s + 4], p0[8 * s + 5]), cvtpk(p0[8 * s + 6], p0[8 * s + 7])};
        const v4u b = (v4u){cvtpk(p1[8 * s], p1[8 * s + 1]), cvtpk(p1[8 * s + 2], p1[8 * s + 3]), cvtpk(p1[8 * s + 4], p1[8 * s + 5]), cvtpk(p1[8 * s + 6], p1[8 * s + 7])};
        pa[s] = __builtin_bit_cast(bf16x8v, a); pa[2 + s] = __builtin_bit_cast(bf16x8v, b); }
#pragma unroll
    for (int db = 0; db < 2; ++db) { const LAS unsigned char* vrow = lds + NSA_V + (32 * db + r32) * 144;
#pragma unroll
        for (int ks = 0; ks < 4; ++ks) {
            const int kb = (ks >> 1) * 32 + (ks & 1) * 16 + 4 * hi;
            const v2u lo = *(const LAS v2u*)(vrow + kb * 2), hh = *(const LAS v2u*)(vrow + (kb + 8) * 2);
            const v4u vv = (v4u){lo.x, lo.y, hh.x, hh.y};
            o[db] = __builtin_amdgcn_mfma_f32_32x32x16_bf16(pa[ks], __builtin_bit_cast(bf16x8v, vv), o[db], 0, 0, 0); } }
}
__device__ __forceinline__ void nsa_rowscale(f32x16 (&o)[2], LAS float* wsf, float f, int r32, int hi) {
    if (hi == 0) wsf[r32] = f;
#pragma unroll
    for (int g = 0; g < 4; ++g) { const f32x4 w = *(const LAS f32x4*)(wsf + 8 * g + 4 * hi);
#pragma unroll
        for (int e = 0; e < 4; ++e) { o[0][4 * g + e] *= w[e]; o[1][4 * g + e] *= w[e]; } }
}
__device__ __forceinline__ void nsa_rowaccum(bf16* dst, bool first, const f32x16 (&o)[2], LAS float* wsf, float f, int r32, int hi) {
    if (hi == 0) wsf[r32] = f;
    bf16 old[32];
#pragma unroll
    for (int i = 0; i < 16; ++i) { const bf16* p = dst + (i >> 2) * 512 + (i & 3) * 64; old[2 * i] = first ? (bf16)0 : p[0]; old[2 * i + 1] = first ? (bf16)0 : p[32]; }
#pragma unroll
    for (int g = 0; g < 4; ++g) { const f32x4 w = *(const LAS f32x4*)(wsf + 8 * g + 4 * hi);
#pragma unroll
        for (int e = 0; e < 4; ++e) { bf16* p = dst + g * 512 + e * 64; const int i = 4 * g + e;
            p[0] = (bf16)f2bf(o[0][i] * w[e] + bf1(old[2 * i])); p[32] = (bf16)f2bf(o[1][i] * w[e] + bf1(old[2 * i + 1])); } }
}
__device__ __forceinline__ void nsa_softmax_pv(const LAS unsigned char* lds, f32x16& p0, f32x16& p1, float& m, float& l, f32x16 (&o)[2], LAS float* wsf, int lane, int r32, int hi) {
    float mt = nsa_max32(p0, p1); mt = fmaxf(mt, partner32(mt, lane));
    const float mn = fmaxf(m, mt);
    if (__builtin_amdgcn_ballot_w64(mn > m) != 0ull) { const float f = __builtin_amdgcn_exp2f(m - mn); l *= f; nsa_rowscale(o, wsf, f, r32, hi); m = mn; }
    float s = 0.f;
#pragma unroll
    for (int i = 0; i < 16; ++i) { p0[i] = __builtin_amdgcn_exp2f(p0[i] - m); p1[i] = __builtin_amdgcn_exp2f(p1[i] - m); s += p0[i] + p1[i]; }
    l += s;
    nsa_pv(lds, p0, p1, o, r32, hi);
}
__device__ __forceinline__ void p_nsa2(Frame& F) {
    const int tid = F.tid, lane = F.lane, wave = F.wave, r32 = lane & 31, hi = lane >> 5;
    LAS unsigned char* lds = F.lds + RING_OFF;
    LAS float* imp = (LAS float*)(lds + NSA_IMP); LAS float* carry = (LAS float*)(lds + NSA_CARRY);
    LAS unsigned long long* selm = (LAS unsigned long long*)(lds + NSA_SEL); LAS float* wsf = (LAS float*)(lds + NSA_WSF) + wave * 32;
    const bf16* P1 = WSP(bf16, WS_P1); const bf16* KC = WSP(bf16, WS_KC); const bf16* KCT = WSP(bf16, WS_KCT); const bf16* VT = WSP(bf16, WS_VT);
    bf16* Yc = WSP(bf16, WS_Y) + (size_t)2 * MC * 256;
    const int ql = r32 >> 2, h = r32 & 3, tq = 8 * wave + ql;
    int par = 0;
    for (int it = 0; it < 2; ++it) {
        for (int pair = F.vcu; pair < BC * 32; pair += F.G) {
            const int b = pair >> 5, sx = pair & 31, qb = it ? 63 - sx : sx;
            const int t = qb * 64 + tq; const size_t row = (size_t)b * SEQ + t; const bf16* prow = P1 + row * P1W;
            bf16x8v qr[4];
#pragma unroll
            for (int d0 = 0; d0 < 4; ++d0) qr[d0] = *(const bf16x8v*)(prow + C_CQ + h * 64 + d0 * 16 + hi * 8);
            const float g0 = bf1(prow[C_CG + h * 3]), g1 = bf1(prow[C_CG + h * 3 + 1]), g2 = bf1(prow[C_CG + h * 3 + 2]);
            f32x16 o[2], p0, p1;
            bf16* ydst = Yc + ((size_t)b * SEQ + qb * 64 + 8 * wave + hi) * 256 + r32;
            __syncthreads();
            for (int i = tid; i < 64 * 64; i += 512) imp[i] = 0.f;
            for (int i = tid; i < 64 * 68; i += 512) carry[i] = 0.f;
            const int nct = (4 * qb + 3 + 63) >> 6;
            const int mlim = t >= 31 ? ((t - 31) >> 4) : -1;
            const bf16* kcb = KC + (size_t)b * 256 * 64; const bf16* vcb = KCT + (size_t)b * 64 * 256;
            float m = -1e30f, l = 0.f;
            v4u kx, vx;
            nsa_load(kx, vx, kcb, 64, vcb, 256, tid);
            for (int ti = 0; ti < nct; ++ti) {
                LAS unsigned char* tb = lds + par * NSA_STAGE; par ^= 1;
                nsa_store(tb, kx, vx, tid); __syncthreads();
                { const int tn = ti + 1 < nct ? ti + 1 : 0; nsa_load(kx, vx, kcb + (size_t)tn * 64 * 64, 64, vcb + tn * 64, 256, tid); }
                nsa_qk(tb, qr, p0, p1, r32, hi); nsa_mask(p0, p1, hi, mlim - 64 * ti, -1, true, false);
                float mt = nsa_max32(p0, p1); mt = fmaxf(mt, partner32(mt, lane));
                const float mn = fmaxf(m, mt); l *= __builtin_amdgcn_exp2f(m - mn); m = mn;
                float s = 0.f;
#pragma unroll
                for (int i = 0; i < 16; ++i) s += __builtin_amdgcn_exp2f(p0[i] - m) + __builtin_amdgcn_exp2f(p1[i] - m);
                l += s; }
            { const float lt = l + partner32(l, lane); const float rl = lt > 0.f ? 1.0f / lt : 0.f;
#pragma unroll
              for (int i = 0; i < 16; ++i) { o[0][i] = 0.f; o[1][i] = 0.f; }
              for (int ti = 0; ti < nct; ++ti) {
                  LAS unsigned char* tb = lds + par * NSA_STAGE; par ^= 1;
                  nsa_store(tb, kx, vx, tid); __syncthreads();
                  if (ti + 1 < nct) nsa_load(kx, vx, kcb + (size_t)(ti + 1) * 64 * 64, 64, vcb + (ti + 1) * 64, 256, tid);
                  nsa_qk(tb, qr, p0, p1, r32, hi); nsa_mask(p0, p1, hi, mlim - 64 * ti, -1, true, false);
#pragma unroll
                  for (int i = 0; i < 16; ++i) { p0[i] = __builtin_amdgcn_exp2f(p0[i] - m) * rl; p1[i] = __builtin_amdgcn_exp2f(p1[i] - m) * rl; }
#pragma unroll
                  for (int kt = 0; kt < 2; ++kt)
#pragma unroll
                      for (int g = 0; g < 4; ++g) { const f32x16& pp = kt ? p1 : p0;
                          float A = pp[4 * g] + pp[4 * g + 1] + pp[4 * g + 2] + 0.5f * pp[4 * g + 3], B = 0.5f * pp[4 * g + 3];
                          A += __builtin_bit_cast(float, bperm(lane ^ 1, __builtin_bit_cast(int, A))); A += __builtin_bit_cast(float, bperm(lane ^ 2, __builtin_bit_cast(int, A)));
                          B += __builtin_bit_cast(float, bperm(lane ^ 1, __builtin_bit_cast(int, B))); B += __builtin_bit_cast(float, bperm(lane ^ 2, __builtin_bit_cast(int, B)));
                          if (h == 0) { const int j = 16 * ti + 8 * kt + 2 * g + hi; imp[tq * 64 + j] = A; carry[tq * 68 + j + 1] = B; } }
                  nsa_pv(tb, p0, p1, o, r32, hi); }
              nsa_rowaccum(ydst, true, o, wsf, g0, r32, hi); }
            __syncthreads();
            { const int q = tid >> 3, sub = tid & 7; unsigned long long mask;
              if (qb + 1 <= 16) mask = (1ull << (qb + 1)) - 1ull;
              else { mask = 1ull | (1ull << qb);
                  unsigned long long key[8];
#pragma unroll
                  for (int i = 0; i < 8; ++i) { const int j = sub * 8 + i; const float v = imp[q * 64 + j] + carry[q * 68 + j];
                      key[i] = (j >= 1 && j < qb) ? (((unsigned long long)__builtin_bit_cast(unsigned, v) << 32) | (unsigned)(63 - j)) : 0ull; }
                  for (int r = 0; r < 14; ++r) { unsigned long long best = key[0];
#pragma unroll
                      for (int i = 1; i < 8; ++i) best = key[i] > best ? key[i] : best;
#pragma unroll
                      for (int x = 1; x < 8; x <<= 1) { const unsigned lo = (unsigned)bperm(lane ^ x, (int)(unsigned)best), hh = (unsigned)bperm(lane ^ x, (int)(unsigned)(best >> 32));
                          const unsigned long long other = ((unsigned long long)hh << 32) | lo; best = other > best ? other : best; }
                      const int jb = 63 - (int)(best & 63ull); mask |= 1ull << jb;
#pragma unroll
                      for (int i = 0; i < 8; ++i) if (sub * 8 + i == jb) key[i] = 0ull; } }
              if (sub == 0) selm[q] = mask; }
            __syncthreads();
            const unsigned long long mysel = selm[tq];
            { const bf16* kb = P1 + (size_t)b * SEQ * P1W + C_KSLC; const bf16* vb = VT + (size_t)(0 * BC + b) * 64 * SEQ;
              m = -1e30f; l = 0.f;
#pragma unroll
              for (int i = 0; i < 16; ++i) { o[0][i] = 0.f; o[1][i] = 0.f; }
              v4u kx2, vx2;
              nsa_load(kx, vx, kb, P1W, vb, SEQ, tid); if (qb >= 1) nsa_load(kx2, vx2, kb + (size_t)64 * P1W, P1W, vb + 64, SEQ, tid);
              for (int j = 0; j <= qb; j += 2) {
                  const bool two = j + 1 <= qb;
                  LAS unsigned char* tb = lds + par * NSA_STAGE; par ^= 1;
                  nsa_store(tb, kx, vx, tid); if (two) nsa_store(tb + NSA_BUF, kx2, vx2, tid);
                  __syncthreads();
                  if (j + 2 <= qb) nsa_load(kx, vx, kb + (size_t)(j + 2) * 64 * P1W, P1W, vb + (j + 2) * 64, SEQ, tid);
                  if (j + 3 <= qb) nsa_load(kx2, vx2, kb + (size_t)(j + 3) * 64 * P1W, P1W, vb + (j + 3) * 64, SEQ, tid);
                  { const bool rowsel = ((mysel >> j) & 1ull) != 0ull;
                    if (__builtin_amdgcn_ballot_w64(rowsel) != 0ull) {
                        nsa_qk(tb, qr, p0, p1, r32, hi); nsa_mask(p0, p1, hi, j == qb ? tq : 63, -1, rowsel, j < qb);
                        nsa_softmax_pv(tb, p0, p1, m, l, o, wsf, lane, r32, hi); } }
                  if (two) { const bool rowsel = ((mysel >> (j + 1)) & 1ull) != 0ull;
                    if (__builtin_amdgcn_ballot_w64(rowsel) != 0ull) {
                        nsa_qk(tb + NSA_BUF, qr, p0, p1, r32, hi); nsa_mask(p0, p1, hi, j + 1 == qb ? tq : 63, -1, rowsel, j + 1 < qb);
                        nsa_softmax_pv(tb + NSA_BUF, p0, p1, m, l, o, wsf, lane, r32, hi); } } }
              const float lt = l + partner32(l, lane);
              nsa_rowaccum(ydst, false, o, wsf, lt > 0.f ? g1 / lt : 0.f, r32, hi); }
            { const bf16* kb = P1 + (size_t)b * SEQ * P1W + C_KWIN; const bf16* vb = VT + (size_t)(1 * BC + b) * 64 * SEQ;
              m = -1e30f; l = 0.f;
#pragma unroll
              for (int i = 0; i < 16; ++i) { o[0][i] = 0.f; o[1][i] = 0.f; }
              const int j0 = qb >= 8 ? qb - 8 : 0;
              nsa_load(kx, vx, kb + (size_t)j0 * 64 * P1W, P1W, vb + j0 * 64, SEQ, tid);
              for (int j = j0; j <= qb; ++j) {
                  LAS unsigned char* tb = lds + par * NSA_STAGE; par ^= 1;
                  nsa_store(tb, kx, vx, tid); __syncthreads();
                  if (j < qb) nsa_load(kx, vx, kb + (size_t)(j + 1) * 64 * P1W, P1W, vb + (j + 1) * 64, SEQ, tid);
                  nsa_qk(tb, qr, p0, p1, r32, hi); nsa_mask(p0, p1, hi, j == qb ? tq : 63, j == qb - 8 ? tq : -1, true, j < qb && j != qb - 8);
                  nsa_softmax_pv(tb, p0, p1, m, l, o, wsf, lane, r32, hi); }
              const float lt = l + partner32(l, lane);
              nsa_rowaccum(ydst, false, o, wsf, lt > 0.f ? g2 / lt : 0.f, r32, hi); }
        }
    }
    __syncthreads();
}

constexpr int SB_HEAD_LDS = 17408;
constexpr int SB_FLAG = 4 * SB_HEAD_LDS;
constexpr float SB_LOG2E = 1.4426950408889634f, SB_STOP = -100.0f * 1.4426950408889634f;
__device__ __forceinline__ void p_stick2(Frame& F) {
    const int tid = F.tid, lane = F.lane, wave = F.wave, r32 = lane & 31, hi = lane >> 5, h = wave & 3, qh = wave >> 2;
    LAS unsigned char* lds = F.lds + RING_OFF; LAS unsigned char* hl = lds + h * SB_HEAD_LDS; LAS int* flag = (LAS int*)(lds + SB_FLAG);
    const bf16* P1 = WSP(bf16, WS_P1); const bf16* VT = WSP(bf16, WS_VT) + (size_t)2 * BC * 64 * SEQ;
    bf16* Yb = WSP(bf16, WS_Y) + (size_t)MC * 256;
    const int tq = 32 * qh + r32;
    for (int it = 0; it < 2; ++it)
        for (int pair = F.vcu; pair < BC * 32; pair += F.G) {
            const int b = pair >> 5, sx = pair & 31, qb = it ? 63 - sx : sx;
            const size_t row = (size_t)b * SEQ + qb * 64 + tq;
            bf16x8v qr[4];
#pragma unroll
            for (int d0 = 0; d0 < 4; ++d0) qr[d0] = *(const bf16x8v*)(P1 + row * P1W + C_SBQ + h * 64 + d0 * 16 + hi * 8);
            f32x16 o[2], p0, p1;
#pragma unroll
            for (int i = 0; i < 16; ++i) { o[0][i] = 0.f; o[1][i] = 0.f; }
            float R = 0.f;
            const int skey = tid & 63, sc = tid >> 6, sd = tid >> 3, skc = tid & 7;
            v4u kx[4], vx[4];
#define SB_LOAD(jj) do { const bf16* kg_ = P1 + ((size_t)b * SEQ + (jj) * 64 + skey) * P1W + C_SBK + sc * 8; \
                _Pragma("unroll") for (int hh = 0; hh < 4; ++hh) { kx[hh] = *(const v4u*)(kg_ + hh * 64); vx[hh] = *(const v4u*)(VT + ((size_t)(hh * BC + b) * 64 + sd) * SEQ + (jj) * 64 + skc * 8); } } while (0)
            SB_LOAD(qb);
            for (int j = qb; j >= 0; --j) {
                __syncthreads();
                if (j < qb) { int live = 0;
#pragma unroll
                    for (int w = 0; w < 8; ++w) live |= flag[w];
                    if (!live) break; }
#pragma unroll
                for (int hh = 0; hh < 4; ++hh) { *(LAS v4u*)(lds + hh * SB_HEAD_LDS + sc * 1024 + skey * 16) = kx[hh]; *(LAS v4u*)(lds + hh * SB_HEAD_LDS + NSA_V + sd * 144 + skc * 16) = vx[hh]; }
                __syncthreads();
                if (j > 0) SB_LOAD(j - 1);
                nsa_qk(hl, qr, p0, p1, r32, hi);
                const int lim = (j == qb) ? tq : 64;
                float Town[8], Tp[8];
#pragma unroll
                for (int kt = 0; kt < 2; ++kt) { f32x16& pp = kt ? p1 : p0;
#pragma unroll
                    for (int g = 0; g < 4; ++g) { float L[4];
#pragma unroll
                        for (int e = 0; e < 4; ++e) { const int kk = 32 * kt + 8 * g + 4 * hi + e; const float z = pp[4 * g + e];
                            const float tt = __builtin_amdgcn_logf(1.0f + __builtin_amdgcn_exp2f(-__builtin_fabsf(z)));
                            const float lb = fminf(z, 0.f) - tt; const bool ok = kk < lim;
                            L[e] = ok ? lb - z : 0.f; pp[4 * g + e] = ok ? lb : -INFINITY; }
                        const float E2 = L[3], E1 = E2 + L[2], E0 = E1 + L[1];
                        pp[4 * g + 2] += E2; pp[4 * g + 1] += E1; pp[4 * g] += E0;
                        Town[4 * kt + g] = E0 + L[0]; } }
#pragma unroll
                for (int k = 0; k < 8; ++k) Tp[k] = partner32(Town[k], lane);
                float suf = R;
#pragma unroll
                for (int k = 7; k >= 0; --k) { const float add = suf + (hi == 0 ? Tp[k] : 0.f); f32x16& pp = (k >> 2) ? p1 : p0; const int g = k & 3;
#pragma unroll
                    for (int e = 0; e < 4; ++e) pp[4 * g + e] = __builtin_amdgcn_exp2f(pp[4 * g + e] + add);
                    suf += Town[k] + Tp[k]; }
                R = suf;
                nsa_pv(hl, p0, p1, o, r32, hi);
                const bool alive = R >= SB_STOP;
                const unsigned long long bal = __builtin_amdgcn_ballot_w64(alive);
                if (lane == 0) flag[wave] = bal != 0ull ? 1 : 0;
            }
            { bf16* dst = Yb + ((size_t)b * SEQ + qb * 64 + 32 * qh + 4 * hi) * 256 + h * 64 + r32;
#pragma unroll
              for (int i = 0; i < 16; ++i) { dst[((i & 3) + 8 * (i >> 2)) * 256] = (bf16)f2bf(o[0][i]); dst[((i & 3) + 8 * (i >> 2)) * 256 + 32] = (bf16)f2bf(o[1][i]); } }
        }
#undef SB_LOAD
    __syncthreads();
}

__device__ __forceinline__ void p_sgu2(Frame& F, int layer) {
    LAS unsigned char* vnT = F.lds + RING_OFF;
    const bf16* P1 = WSP(bf16, WS_P1); bf16* Ya = WSP(bf16, WS_Y);
    const float* gain = F.in[3] + (size_t)layer * 256; const float* sw = F.in[4] + (size_t)layer * 4 * 128 * 128; const float* sb = F.in[5] + (size_t)layer * 4 * 128;
    const int lane = F.lane, wave = F.wave, r32 = lane & 31, hi = lane >> 5, g = wave & 3, db = wave >> 2;
    for (int item = F.vcu; item < MC / 128; item += F.G) {
        const size_t r0 = (size_t)item * 128;
        __syncthreads();
        { const f32x4 gg = ((const f32x4*)gain)[lane];
          for (int rr = 0; rr < 16; rr += 2) { const int r = wave * 16 + rr;
              const v2u ra = *(const v2u*)(P1 + (r0 + r) * P1W + C_V + 4 * lane), rb = *(const v2u*)(P1 + (r0 + r + 1) * P1W + C_V + 4 * lane);
              const float a0 = bflo(ra.x), a1 = bfhi(ra.x), a2 = bflo(ra.y), a3 = bfhi(ra.y), b0 = bflo(rb.x), b1 = bfhi(rb.x), b2 = bflo(rb.y), b3 = bfhi(rb.y);
              const float sa = 1.0f / sqrtf(wave_sum((a0 * a0 + a1 * a1) + (a2 * a2 + a3 * a3), lane) * (1.f / 256.f) + EPS);
              const float sb_ = 1.0f / sqrtf(wave_sum((b0 * b0 + b1 * b1) + (b2 * b2 + b3 * b3), lane) * (1.f / 256.f) + EPS);
              LAS unsigned* q = (LAS unsigned*)(vnT + (4 * lane) * 272 + r * 2);
              q[0] = pk2(a0 * sa * gg.x, b0 * sb_ * gg.x); q[68] = pk2(a1 * sa * gg.y, b1 * sb_ * gg.y); q[136] = pk2(a2 * sa * gg.z, b2 * sb_ * gg.z); q[204] = pk2(a3 * sa * gg.w, b3 * sb_ * gg.w); } }
        __syncthreads();
        const int ch = g * 64 + db * 32 + r32;
        for (int tb = 0; tb < 4; ++tb) {
            f32x16 acc;
#pragma unroll
            for (int i = 0; i < 16; ++i) acc[i] = 0.f;
            const int t = 32 * tb + r32; const float* wrow = sw + ((size_t)g * 128 + t) * 128;
            f32x4 wq[8][2];
#pragma unroll
            for (int ks = 0; ks < 8; ++ks) if (ks < 2 * tb + 2) { wq[ks][0] = *(const f32x4*)(wrow + 16 * ks + 8 * hi); wq[ks][1] = *(const f32x4*)(wrow + 16 * ks + 8 * hi + 4); }
#pragma unroll
            for (int ks = 0; ks < 8; ++ks) if (ks < 2 * tb + 2) {
                const int s0 = 16 * ks + 8 * hi;
                const f32x4 w0 = wq[ks][0], w1 = wq[ks][1];
                const v4u a = (v4u){pk2(s0 <= t ? w0.x : 0.f, s0 + 1 <= t ? w0.y : 0.f), pk2(s0 + 2 <= t ? w0.z : 0.f, s0 + 3 <= t ? w0.w : 0.f),
                                    pk2(s0 + 4 <= t ? w1.x : 0.f, s0 + 5 <= t ? w1.y : 0.f), pk2(s0 + 6 <= t ? w1.z : 0.f, s0 + 7 <= t ? w1.w : 0.f)};
                const bf16x8v bfr = *(const LAS bf16x8v*)(vnT + ch * 272 + s0 * 2);
                acc = __builtin_amdgcn_mfma_f32_32x32x16_bf16(__builtin_bit_cast(bf16x8v, a), bfr, acc, 0, 0, 0); }
            float uu[16], bb[16];
#pragma unroll
            for (int i = 0; i < 16; ++i) { const int tt = 32 * tb + (i & 3) + 8 * (i >> 2) + 4 * hi; uu[i] = bf1(P1[(r0 + tt) * P1W + C_U + ch]); bb[i] = sb[g * 128 + tt]; }
#pragma unroll
            for (int i = 0; i < 16; ++i) { const int tt = 32 * tb + (i & 3) + 8 * (i >> 2) + 4 * hi;
                Ya[(r0 + tt) * 256 + ch] = (bf16)f2bf(uu[i] * (acc[i] + bb[i])); }
        }
    }
    __syncthreads();
}

struct Args { const float* in[20]; float* out; unsigned char* ws; int lo, hi, li, rep; };
#ifndef TILED_FFN1
#define TILED_FFN1 0
#endif
#ifndef PG8_ALIGN_EPI
#define PG8_ALIGN_EPI true
#endif
#ifndef PG8_SP2
#define PG8_SP2 true
#endif
#ifndef WGM_MOE1
#define WGM_MOE1 PG8_WGM
#endif
#ifndef WGM_MOE2
#define WGM_MOE2 PG8_WGM
#endif
#ifndef FFN_CHUNKS
#define FFN_CHUNKS 2
#endif
#ifndef REP_GEMM
#define REP_GEMM 1
#endif
#ifndef REP_STICK
#define REP_STICK 1
#endif
#ifndef REP_NSA
#define REP_NSA 1
#endif
#ifndef REP_SGU
#define REP_SGU 1
#endif
#ifndef REP_NORM
#define REP_NORM 1
#endif
template <class Epi, class Sched> __device__ __forceinline__ void run_gemm(Frame& F, const bf16* A, const bf16* Bt, int M, int N, int K, const Sched& S, Epi E, bool rotate = true, int tiled = 0) {
    const int nt_ = K / 64;
#ifdef PG8_KROT
    const int rot_ = rotate ? 2 * (((F.bx & 7) * (nt_ / 2)) / 8) : 0;
#else
    const int rot_ = 0;
#endif
    pg8::Gemm g{A, Bt, M, N, K + F.zs, F.tid, rot_ + F.zs, tiled + F.zs};
    if (F.rep) E.set_scale0();
    pg8::gemm_phase<Epi, Sched, PG8_ALIGN_EPI, PG8_SP2>(F.lds + RING_OFF, g, S, E);
}
__global__ void __launch_bounds__(NWAVES * 64, 2) mk_fwd(Args args) {
    extern __shared__ __attribute__((aligned(16))) unsigned char lds[];
    Frame F0;
    F0.lds = (LAS unsigned char*)lds;
    F0.tid = threadIdx.x; F0.lane = F0.tid & 63; F0.wave = __builtin_amdgcn_readfirstlane(F0.tid >> 6);
    F0.G = gridDim.x; F0.bx = blockIdx.x; F0.vcu = (F0.G % 8 == 0) ? (F0.bx % 8) * (F0.G / 8) + F0.bx / 8 : F0.bx; F0.zv = 0; F0.zs = 0;
    F0.rep = args.rep; F0.ws = args.ws; F0.ctl = (unsigned*)(args.ws + WS_CTL); F0.in = args.in; F0.out = args.out;
    for (int u = F0.tid; u < (LDS_BYTES - LDSCTL_OFF) / 4; u += NWAVES * 64) ((LAS unsigned*)(F0.lds + LDSCTL_OFF))[u] = 0u;
    __syncthreads();
    const int lo = args.lo, hi = args.hi;
    XcdBarrier bar; bar.bar = F0.ctl + CW_BAR + args.li * XCD_BAR_WORDS; bar.x = 0; bar.st = nullptr; bar.w = 0; bar.z = 0;
    if (hi - lo > 1) bar = xcd_barrier_post(F0.ctl + CW_BAR + args.li * XCD_BAR_WORDS, (volatile LAS unsigned*)(F0.lds + MISC_OFF) + 8);
    int step = 0;
#define STEP_BEGIN if (step >= lo && step < hi) { Frame F = F0; { int zv_, zs_; asm volatile("v_mov_b32 %0, 0" : "=v"(zv_)); asm volatile("s_mov_b32 %0, 0" : "=s"(zs_)); \
        F.zv = zv_; F.zs = zs_; F.lane = (int)__builtin_amdgcn_mbcnt_hi(~0u, __builtin_amdgcn_mbcnt_lo(~0u, (unsigned)zv_)); F.wave = F0.wave + zs_; F.tid = F.wave * 64 + F.lane; F.bx = F.bx + zs_; \
        F.vcu = F0.vcu + zs_; F.G = F0.G + zs_; F.lds = (LAS unsigned char*)lds + zs_; F.ws = F0.ws + zs_; F.ctl = F0.ctl + zs_; F.in = F0.in + zs_; F.out = F0.out + zs_; }
#ifdef PROBE_XBAR
#define STEP_END   if (step + 1 < hi) { unsigned zb_; asm volatile("v_mov_b32 %0, 0" : "=v"(zb_)); bar.z = zb_; xcd_barrier(bar); xcd_barrier(bar); } } ++step;
#else
#define STEP_END   if (step + 1 < hi) { unsigned zb_; asm volatile("v_mov_b32 %0, 0" : "=v"(zb_)); bar.z = zb_; xcd_barrier(bar); } } ++step;
#endif

    for (int layer = 0; layer < DEPTH; ++layer) {
        const int jj = layer >> 1;
        STEP_BEGIN
            p_convert(F, layer);
            p_norm<0>(F, layer == 0 ? F.in[0] : F.out, F.in[1] + (size_t)layer * DM, nullptr, 0);
        STEP_END
        for (int c = 0; c < NCHUNK; ++c) {
            STEP_BEGIN
                pg8::StaticOrder S; S.init(MC, NPROJ, F.G, F.bx);
                pg8::EpiProj E{WSP(bf16, WS_P1), WSP(bf16, WS_G)};
                run_gemm(F, WSP(bf16, WS_HN) + (size_t)c * MC * DM, WSP(bf16, WS_WIN), MC, NPROJ, DM, S, E);
            STEP_END
            STEP_BEGIN
                p_prep(F);
            STEP_END
            STEP_BEGIN
                LAS int* tab = (LAS int*)(F.lds + TAB_OFF);
                __syncthreads(); if (F.tid < 16) tab[F.tid] = F.tid >> 3; __syncthreads();
                pg8::GroupedOrder S; S.so.init(2 * 2048, 512, F.G, F.bx); S.tile_e = tab; S.nN = 2;
                pg8::EpiF32 E{WSP(float, WS_UL), 512, 2};
                run_gemm(F, WSP(bf16, WS_KVC), WSP(bf16, WS_WC1), 2 * 2048, 512, DM, S, E);
                p_sgu2(F, layer);
                p_stick2(F);
            STEP_END
            STEP_BEGIN
                p_cmpfin(F, layer);
            STEP_END
            STEP_BEGIN
#ifdef OLD_NSA
                p_nsa(F);
#else
                p_nsa2(F);
#endif
            STEP_END
            STEP_BEGIN
                pg8::MergeOrder S; S.so.init(MC, DM, F.G, F.bx); S.nmt = MC / 256;
                pg8::EpiMerge E{WSP(bf16, WS_G), WSP(bf16, WS_MG), MC / 256};
                run_gemm(F, WSP(bf16, WS_Y), WSP(bf16, WS_WBR), 3 * MC, 3 * DM, 256, S, E);
            STEP_END
            STEP_BEGIN
                pg8::StaticOrder S; S.init(MC, DM, F.G, F.bx);
                const float* base = (layer == 0 ? F.in[0] : F.out) + (size_t)c * MC * DM;
                pg8::EpiResid E{base, F.out + (size_t)c * MC * DM, DM, 1.0f};
                run_gemm(F, WSP(bf16, WS_MG), WSP(bf16, WS_WOUT), MC, DM, DM, S, E);
            STEP_END
        }
        if ((layer & 1) == 0) {
            STEP_BEGIN
                p_norm<0>(F, F.out, F.in[11] + (size_t)layer * DM, nullptr, 0, Q8_HN, TILED_FFN1);
            STEP_END
            for (int c = 0; c < FFN_CHUNKS; ++c) {
                constexpr int MF = MTOK / FFN_CHUNKS;
                STEP_BEGIN
                    pg8::StaticOrder S; S.init(MF, NFF1, F.G, F.bx);
                    pg8::EpiSwiGLU E{WSP(bf16, WS_HID), DFFP, nullptr, NFF1 / 256};
                    run_gemm(F, WSP(bf16, WS_HN) + (size_t)c * MF * DM, WSP(bf16, WS_WF1), MF, NFF1, DM, S, E, true, TILED_FFN1);
                STEP_END
                STEP_BEGIN
                    pg8::StaticOrder S; S.init(MF, DM, F.G, F.bx);
                    pg8::EpiResid E{F.out + (size_t)c * MF * DM, F.out + (size_t)c * MF * DM, DM, 1.0f};
                    run_gemm(F, WSP(bf16, WS_HID), WSP(bf16, WS_WF2), MF, DM, DFFP, S, E);
                STEP_END
            }
        } else {
            STEP_BEGIN
                p_norm<1>(F, F.out, F.in[11] + (size_t)layer * DM, F.in[15] + (size_t)jj * DM * NEXP, jj, Q8_HN);
            STEP_END
#ifdef ABL_DENSE_MOE
            for (int e = 0; e < NEXP; ++e) {
                STEP_BEGIN
                    pg8::StaticOrder S; S.init(MTOK, NMOE1, F.G, F.bx);
                    pg8::EpiSwiGLU E{WSP(bf16, WS_SCR + 8 * MiB), DFE, WSP(float, WS_SCR + 4 * MiB) + (size_t)e * MTOK, NMOE1 / 256};
                    run_gemm(F, WSP(bf16, WS_HN), WSP(bf16, WS_WF1) + (size_t)e * NMOE1 * DM, MTOK, NMOE1, DM, S, E);
                STEP_END
                STEP_BEGIN
                    pg8::StaticOrder S; S.init(MTOK, DM, F.G, F.bx);
                    pg8::EpiResid E{F.out, F.out, DM, 1.0f};
                    run_gemm(F, WSP(bf16, WS_SCR + 8 * MiB), WSP(bf16, WS_WF2) + (size_t)e * DM * DFE, MTOK, DM, DFE, S, E);
                STEP_END
            }
#else
            STEP_BEGIN
                p_gather(F, jj, 0, 0);
            STEP_END
            for (int c = 0; c < NCHUNK; ++c)
                for (int r = 0; r < 2; ++r) {
                    STEP_BEGIN
                        const int T = moe_table(F, jj, c, r);
                        pg8::GroupedOrder S; S.so.init(T * 256, NMOE1, F.G, F.bx, WGM_MOE1); S.tile_e = (LAS int*)(F.lds + TAB_OFF); S.nN = NMOE1 / 256;
                        pg8::EpiSwiGLU E{WSP(bf16, WS_HIDM), DFE, WSP(float, WS_WSLOT) + (c * 2 + r) * SLOTS, NMOE1 / 256};
                        run_gemm(F, WSP(bf16, WS_XG), WSP(bf16, WS_WF1), T * 256, NMOE1, DM, S, E, false);
                    STEP_END
                    STEP_BEGIN
                        const int T = moe_table(F, jj, c, r);
                        pg8::GroupedOrder S; S.so.init(T * 256, DM, F.G, F.bx, WGM_MOE2); S.tile_e = (LAS int*)(F.lds + TAB_OFF); S.nN = DM / 256;
                        pg8::EpiScatter E{F.out, WSP(int, WS_TOKMAP) + (c * 2 + r) * SLOTS, DM / 256, 1.0f};
                        run_gemm(F, WSP(bf16, WS_HIDM), WSP(bf16, WS_WF2), T * 256, DM, DFE, S, E, false);
                        if (!F.rep && c * 2 + r < 3) p_gather(F, jj, (c * 2 + r + 1) >> 1, (c * 2 + r + 1) & 1);
                    STEP_END
                }
#endif
        }
    }
    STEP_BEGIN
        p_norm<2>(F, F.out, F.in[19], nullptr, 0);
    STEP_END
#undef STEP_BEGIN
#undef STEP_END
}

#ifndef MK_STEPS_PER_LAUNCH
#define MK_STEPS_PER_LAUNCH 1
#endif
extern "C" void kernel_launch(void* const* d_in, const int* in_sizes, int n_in, void* d_out, int out_size, void* d_ws, size_t ws_size, hipStream_t stream) {
    static int grid = 0;
    if (grid == 0) {
        if (n_in != 20 || in_sizes[0] != MTOK * DM || out_size != MTOK * DM || ws_size < WS_END) { fprintf(stderr, "kernel_launch: unexpected shapes (n_in %d, in0 %d, out %d, ws %zu)\n", n_in, n_in > 0 ? in_sizes[0] : -1, out_size, ws_size); grid = -1; return; }
        int dev = 0, cus = 0, per_cu = 0;
        if (hipGetDevice(&dev) != hipSuccess || hipDeviceGetAttribute(&cus, hipDeviceAttributeMultiprocessorCount, dev) != hipSuccess) { grid = -1; return; }
        if (hipFuncSetAttribute((const void*)mk_fwd, hipFuncAttributeMaxDynamicSharedMemorySize, LDS_BYTES) != hipSuccess) { fprintf(stderr, "kernel_launch: hipFuncSetAttribute failed\n"); grid = -1; return; }
        if (hipOccupancyMaxActiveBlocksPerMultiprocessor(&per_cu, (const void*)mk_fwd, NWAVES * 64, LDS_BYTES) != hipSuccess || per_cu < 1) fprintf(stderr, "kernel_launch: occupancy query reports %d\n", per_cu);
        (void)hipGetLastError();
        grid = cus;
    }
    if (grid < 0) return;
    if (hipMemsetAsync((char*)d_ws + WS_CTL, 0, CTL_ZERO_BYTES, stream) != hipSuccess) return;
    Args a{};
    for (int i = 0; i < 20; ++i) a.in[i] = (const float*)d_in[i];
    a.out = (float*)d_out; a.ws = (unsigned char*)d_ws; a.rep = 0;
    #ifdef ABL_DENSE_MOE
    constexpr int NSTEPS = 2 * (1 + NCHUNK * 8 + 3) + 2 * (1 + NCHUNK * 8 + 1 + NEXP * 2) + 1;
#else
    constexpr int NSTEPS = 2 * (1 + NCHUNK * 7 + 1 + 2 * FFN_CHUNKS) + 2 * (1 + NCHUNK * 7 + 2 + NCHUNK * 2 * 2) + 1;
#endif
    int li = 0;
#ifdef REPMASK
    static int kinds[256]; int ns = 0;
    for (int layer = 0; layer < DEPTH; ++layer) { kinds[ns++] = 0;
        for (int c = 0; c < NCHUNK; ++c) for (int q = 1; q <= 8; ++q) if (q != 5) kinds[ns++] = q;
        if ((layer & 1) == 0) { kinds[ns++] = 9; for (int c = 0; c < FFN_CHUNKS; ++c) { kinds[ns++] = 10; kinds[ns++] = 11; } }
        else { kinds[ns++] = 12; kinds[ns++] = 17; for (int c = 0; c < NCHUNK * 2; ++c) { kinds[ns++] = 14; kinds[ns++] = 13; } } }
    kinds[ns++] = 16;
    for (int s = 0; s < NSTEPS; ++s) { const int reps = ((REPMASK >> kinds[s]) & 1) ? 2 : 1;
        for (int r = 0; r < reps; ++r) { a.lo = s; a.hi = s + 1; a.li = 0; a.rep = r;
            hipLaunchKernelGGL(mk_fwd, dim3(grid), dim3(NWAVES * 64), LDS_BYTES, stream, a); } }
    (void)li;
#else
    for (int s = 0; s < NSTEPS; s += MK_STEPS_PER_LAUNCH) {
        a.lo = s; a.hi = (s + MK_STEPS_PER_LAUNCH < NSTEPS) ? s + MK_STEPS_PER_LAUNCH : NSTEPS; a.li = (MK_STEPS_PER_LAUNCH > 1) ? li : 0; ++li;
        hipLaunchKernelGGL(mk_fwd, dim3(grid), dim3(NWAVES * 64), LDS_BYTES, stream, a);
        if (hipPeekAtLastError() != hipSuccess) { fprintf(stderr, "kernel_launch: launch failed\n"); break; }
    }
#endif
}
```

```cpp
#define MK_STEPS_PER_LAUNCH 1000
#define PG8_WGM 4
#define FFN_CHUNKS 1
#include <hip/hip_runtime.h>
#include <cstdio>
#include <cstdint>
#include <cmath>
#ifndef PG8_WGM
#define PG8_WGM 8
#endif
namespace pg8 {
#define PG8_LAS __attribute__((address_space(3)))
typedef unsigned short bf16_t;
typedef short bf16x8 __attribute__((ext_vector_type(8)));
typedef float f32x4 __attribute__((ext_vector_type(4)));
typedef unsigned u32x4 __attribute__((ext_vector_type(4)));
constexpr int BM = 256, BK = 64, HALF = 128, HTB = HALF * BK * 2  , STAGE_BYTES = 8 * HTB, NXCD = 8, WGM = PG8_WGM;

__host__ __device__ __forceinline__ int lds_byte(int r, int c) { const int st = (r >> 4) * 2 + (c >> 5), rr = r & 15, cc = c & 31, ob = rr * 64 + cc * 2; return st * 1024 + (ob ^ (((ob >> 9) & 1) << 5)); }
__host__ __device__ __forceinline__ void stage_rc(int b, int& R, int& C) { const int st = b / 1024, sb = b % 1024, swz = sb ^ (((sb >> 9) & 1) << 5); R = (st >> 1) * 16 + swz / 64; C = (st & 1) * 32 + (swz % 64) / 2; }
__host__ __device__ __forceinline__ int perm32(int rho) { const int n = rho >> 4, i = rho & 15; return 8 * (i >> 2) + 4 * n + (i & 3); }

struct Unit { int pm, pn; };
struct Gemm { const bf16_t* A; const bf16_t* Bt; int M, N, K; int zv; int rot; int tiled; };

struct StaticOrder {
    int nM, nN, nwg, G, c, wgm;
    __host__ __device__ void init(int M, int N, int G_, int c_, int wgm_ = WGM) { nM = M / BM; nN = N / BM; nwg = nM * nN; G = G_; c = c_; wgm = wgm_; }
    __host__ __device__ bool next(int i, Unit& u) const {
        const long L = (long)i * G + c; if (L >= nwg) return false;
        int wgid = (int)L; { const int q = nwg / NXCD, r = nwg % NXCD, xcd = wgid % NXCD, off = wgid / NXCD; wgid = (xcd < r ? xcd * (q + 1) : r * (q + 1) + (xcd - r) * q) + off; }
        const int nig = wgm * nN, gid = wgid / nig, fm = gid * wgm, gsz = (nM - fm) < wgm ? (nM - fm) : wgm;
        u.pm = fm + ((wgid % nig) % gsz); u.pn = (wgid % nig) / gsz; return true;
    }
    __device__ __forceinline__ void a_ready(const Unit&) const {}
    __device__ __forceinline__ void done(const Unit&) const {}
};

__device__ __forceinline__ unsigned cvt_pk_bf16(float lo, float hi) { unsigned r; asm volatile("v_cvt_pk_bf16_f32 %0, %1, %2" : "=v"(r) : "v"(lo), "v"(hi)); return r; }
typedef float f32x2 __attribute__((ext_vector_type(2)));

__device__ __forceinline__ float fast_sigmoid(float x) { return __builtin_amdgcn_rcpf(1.0f + __builtin_amdgcn_exp2f(-1.4426950408889634f * x)); }
__device__ __forceinline__ float gelu_tanh(float x) {
    const float u2 = 1.5957691216057308f * (x + 0.044715f * x * x * x);
    return x * fast_sigmoid(u2);
}
__device__ __forceinline__ float bf_lo(unsigned u) { return __builtin_bit_cast(float, u << 16); }
__device__ __forceinline__ float bf_hi(unsigned u) { return __builtin_bit_cast(float, u & 0xffff0000u); }

#ifdef PG8_NT_OUT
#define PG8_STORE_OUT(p, v) __builtin_nontemporal_store((v), (p))
#else
#define PG8_STORE_OUT(p, v) (*(p) = (v))
#endif
struct EpiProj {
    static constexpr bool PERM = true, AFTER_DRAIN = false, MID = false; static constexpr int MID_TILES = 1; __device__ __forceinline__ void set_scale0() {}
    bf16_t* P1; bf16_t* G;
    __device__ __forceinline__ void operator()(const f32x4 (&acc)[2][2][4][2], const Unit& u, int wr, int wc, int fr, int fq) const {
        const int row0 = u.pm * BM + wr * 64 + fr;
        bf16_t* base; int ldc, colt, act0, act1;
        if (u.pn < 8) { base = P1; ldc = 2048; colt = u.pn * BM; act0 = (u.pn < 2) ? 1 : 0; act1 = (u.pn == 7) ? 2 : act0; }
        else { base = G; ldc = 3072; colt = (u.pn - 8) * BM; act0 = 2; act1 = 2; }
        const int col0 = colt + wc * 32 + 8 * fq;
#pragma unroll
        for (int ai = 0; ai < 2; ++ai)
#pragma unroll
            for (int m = 0; m < 4; ++m) { bf16_t* rowp = base + (size_t)(row0 + ai * HALF + m * 16) * ldc + col0;
#pragma unroll
                for (int bj = 0; bj < 2; ++bj) { f32x4 v0 = acc[ai][bj][m][0], v1 = acc[ai][bj][m][1]; const int act = bj ? act1 : act0;
                    if (act == 1) {
#pragma unroll
                        for (int e = 0; e < 4; ++e) { v0[e] = gelu_tanh(v0[e]); v1[e] = gelu_tanh(v1[e]); } }
                    else if (act == 2) {
#pragma unroll
                        for (int e = 0; e < 4; ++e) { v0[e] = fast_sigmoid(v0[e]); v1[e] = fast_sigmoid(v1[e]); } }
                    u32x4 w; w.x = cvt_pk_bf16(v0[0], v0[1]); w.y = cvt_pk_bf16(v0[2], v0[3]); w.z = cvt_pk_bf16(v1[0], v1[1]); w.w = cvt_pk_bf16(v1[2], v1[3]);
                    *(u32x4*)(rowp + bj * HALF) = w; } }
    }
};
struct EpiMerge {
    static constexpr bool PERM = true, AFTER_DRAIN = false, MID = false; static constexpr int MID_TILES = 1; __device__ __forceinline__ void set_scale0() {}
    const bf16_t* G; bf16_t* MG; int nmt;
    __device__ __forceinline__ void operator()(const f32x4 (&acc)[2][2][4][2], const Unit& u, int wr, int wc, int fr, int fq) const {
        const int i = u.pn >> 2, pn = u.pn & 3, pm = u.pm - i * nmt;
        const int row0 = pm * BM + wr * 64 + fr, col0 = pn * BM + wc * 32 + 8 * fq;
#pragma unroll
        for (int ai = 0; ai < 2; ++ai)
#pragma unroll
            for (int mp = 0; mp < 2; ++mp) {
                u32x4 g[4], o[4];
#pragma unroll
                for (int q = 0; q < 4; ++q) { const int m = 2 * mp + (q >> 1), bj = q & 1; const size_t row = (size_t)(row0 + ai * HALF + m * 16); const int col = col0 + bj * HALF;
                    g[q] = *(const u32x4*)(G + row * 3072 + i * 1024 + col);
                    if (i > 0) o[q] = *(const u32x4*)(MG + row * 1024 + col); else o[q] = (u32x4){0u, 0u, 0u, 0u}; }
#pragma unroll
                for (int q = 0; q < 4; ++q) { const int m = 2 * mp + (q >> 1), bj = q & 1; const size_t row = (size_t)(row0 + ai * HALF + m * 16); const int col = col0 + bj * HALF;
                    f32x4 v0 = acc[ai][bj][m][0], v1 = acc[ai][bj][m][1];
#ifdef ABL_BRANCH
                    if (i == ABL_BRANCH) { v0 = v0 * (float)ABL_SCALE; v1 = v1 * (float)ABL_SCALE; }
#endif
                    v0[0] = v0[0] * bf_lo(g[q].x) + bf_lo(o[q].x); v0[1] = v0[1] * bf_hi(g[q].x) + bf_hi(o[q].x); v0[2] = v0[2] * bf_lo(g[q].y) + bf_lo(o[q].y); v0[3] = v0[3] * bf_hi(g[q].y) + bf_hi(o[q].y);
                    v1[0] = v1[0] * bf_lo(g[q].z) + bf_lo(o[q].z); v1[1] = v1[1] * bf_hi(g[q].z) + bf_hi(o[q].z); v1[2] = v1[2] * bf_lo(g[q].w) + bf_lo(o[q].w); v1[3] = v1[3] * bf_hi(g[q].w) + bf_hi(o[q].w);
                    u32x4 w; w.x = cvt_pk_bf16(v0[0], v0[1]); w.y = cvt_pk_bf16(v0[2], v0[3]); w.z = cvt_pk_bf16(v1[0], v1[1]); w.w = cvt_pk_bf16(v1[2], v1[3]);
                    *(u32x4*)(MG + row * 1024 + col) = w; } }
    }
};
struct EpiResid {
    static constexpr bool PERM = false, AFTER_DRAIN = false, MID = false; static constexpr int MID_TILES = 1; __device__ __forceinline__ void set_scale0() { scale = 0.f; base = out; }
    const float* base; float* out; int ldc; float scale;
    __device__ __forceinline__ void operator()(const f32x4 (&acc)[2][2][4][2], const Unit& u, int wr, int wc, int fr, int fq) const {
        const int row0 = u.pm * BM + wr * 64 + fr, col0 = u.pn * BM + wc * 32 + 4 * fq;
#pragma unroll
        for (int ai = 0; ai < 2; ++ai)
#pragma unroll
            for (int mp = 0; mp < 2; ++mp) {
                f32x4 b[8];
#pragma unroll
                for (int q = 0; q < 8; ++q) { const int m = 2 * mp + (q >> 2), bj = (q >> 1) & 1, n = q & 1;
                    b[q] = *(const f32x4*)(base + (size_t)(row0 + ai * HALF + m * 16) * ldc + col0 + bj * HALF + n * 16); }
#pragma unroll
                for (int q = 0; q < 8; ++q) { const int m = 2 * mp + (q >> 2), bj = (q >> 1) & 1, n = q & 1;
                    *(f32x4*)(out + (size_t)(row0 + ai * HALF + m * 16) * ldc + col0 + bj * HALF + n * 16) = b[q] + acc[ai][bj][m][n] * scale; } }
    }
};
struct EpiF32 {
    static constexpr bool PERM = false, AFTER_DRAIN = false, MID = false; static constexpr int MID_TILES = 1; __device__ __forceinline__ void set_scale0() {}
    float* O; int ldc, nN;
    __device__ __forceinline__ void operator()(const f32x4 (&acc)[2][2][4][2], const Unit& u, int wr, int wc, int fr, int fq) const {
        const int row0 = u.pm * BM + wr * 64 + fr, col0 = (u.pn % nN) * BM + wc * 32 + 4 * fq;
#pragma unroll
        for (int ai = 0; ai < 2; ++ai)
#pragma unroll
            for (int m = 0; m < 4; ++m) { const size_t off = (size_t)(row0 + ai * HALF + m * 16) * ldc + col0;
#pragma unroll
                for (int bj = 0; bj < 2; ++bj)
#pragma unroll
                    for (int n = 0; n < 2; ++n) *(f32x4*)(O + off + bj * HALF + n * 16) = acc[ai][bj][m][n]; }
    }
};
#ifdef EMU_FP8_HID
__device__ __forceinline__ float Q8H(float x) { const int p = __builtin_amdgcn_cvt_pk_fp8_f32(x * 8.f, x * 8.f, 0, false); return __builtin_amdgcn_cvt_f32_fp8(p, 0) * 0.125f; }
#else
__device__ __forceinline__ float Q8H(float x) { return x; }
#endif
struct EpiSwiGLU {
    static constexpr bool PERM = true, AFTER_DRAIN = false, MID = false; static constexpr int MID_TILES = 1; __device__ __forceinline__ void set_scale0() {}
    bf16_t* H; int ldh; const float* rowscale; int nN; int rowmask = 0x7fffffff;
    __device__ __forceinline__ void operator()(const f32x4 (&acc)[2][2][4][2], const Unit& u, int wr, int wc, int fr, int fq) const {
        const int row0 = u.pm * BM + wr * 64 + fr, col0 = (u.pn % nN) * HALF + wc * 32 + 8 * fq;
        float scv[8];
#pragma unroll
        for (int q = 0; q < 8; ++q) scv[q] = rowscale ? rowscale[row0 + (q >> 2) * HALF + (q & 3) * 16] : 1.0f;
#pragma unroll
        for (int ai = 0; ai < 2; ++ai)
#pragma unroll
            for (int m = 0; m < 4; ++m) { const int row = row0 + ai * HALF + m * 16; const float sc = scv[ai * 4 + m];
                float h[8];
#pragma unroll
                for (int n = 0; n < 2; ++n)
#pragma unroll
                    for (int e = 0; e < 4; ++e) { const float g = acc[ai][0][m][n][e], up = acc[ai][1][m][n][e]; h[n * 4 + e] = Q8H(g * fast_sigmoid(g) * up * sc); }
                u32x4 w; w.x = cvt_pk_bf16(h[0], h[1]); w.y = cvt_pk_bf16(h[2], h[3]); w.z = cvt_pk_bf16(h[4], h[5]); w.w = cvt_pk_bf16(h[6], h[7]);
                PG8_STORE_OUT((u32x4*)(H + (size_t)(row & rowmask) * ldh + col0), w); }
    }
};
struct EpiScatter {
    static constexpr bool PERM = false, AFTER_DRAIN = false, MID = false; static constexpr int MID_TILES = 1; __device__ __forceinline__ void set_scale0() { scale = 0.f; }
    float* out; const int* tok; int nN; float scale;
    __device__ __forceinline__ void operator()(const f32x4 (&acc)[2][2][4][2], const Unit& u, int wr, int wc, int fr, int fq) const {
        const int row0 = u.pm * BM + wr * 64 + fr, col0 = (u.pn % nN) * BM + wc * 32 + 4 * fq;
        int tk[8];
#pragma unroll
        for (int q = 0; q < 8; ++q) tk[q] = tok[row0 + (q >> 2) * HALF + (q & 3) * 16];
#pragma unroll
        for (int ai = 0; ai < 2; ++ai)
#pragma unroll
            for (int mp = 0; mp < 2; ++mp) {
                f32x4 b[8];
#pragma unroll
                for (int q = 0; q < 8; ++q) { const int m = 2 * mp + (q >> 2), bj = (q >> 1) & 1, n = q & 1; const int t = tk[ai * 4 + m];
                    b[q] = *(const f32x4*)(out + (size_t)(t < 0 ? 0 : t) * 1024 + col0 + bj * HALF + n * 16); }
#pragma unroll
                for (int q = 0; q < 8; ++q) { const int m = 2 * mp + (q >> 2), bj = (q >> 1) & 1, n = q & 1; const int t = tk[ai * 4 + m];
#ifdef ABL_MOE
                    if (false)
#else
                    if (t >= 0)
#endif
                        *(f32x4*)(out + (size_t)t * 1024 + col0 + bj * HALF + n * 16) = b[q] + acc[ai][bj][m][n] * scale; } }
    }
};
struct GroupedOrder {
    StaticOrder so; const PG8_LAS int* tile_e; int nN;
    __device__ __forceinline__ bool next(int i, Unit& u) const { if (!so.next(i, u)) return false; u.pn += tile_e[u.pm] * nN; return true; }
    __device__ __forceinline__ void a_ready(const Unit&) const {}
    __device__ __forceinline__ void done(const Unit&) const {}
};
struct OffsetOrder {
    StaticOrder so; int pn_off;
    __device__ __forceinline__ bool next(int i, Unit& u) const { if (!so.next(i, u)) return false; u.pn += pn_off; return true; }
    __device__ __forceinline__ void a_ready(const Unit&) const {}
    __device__ __forceinline__ void done(const Unit&) const {}
};
struct ProbeOrder {
    StaticOrder so; int pm_mask;
    __device__ __forceinline__ bool next(int i, Unit& u) const { if (!so.next(i, u)) return false; u.pm &= pm_mask; return true; }
    __device__ __forceinline__ void a_ready(const Unit&) const {}
    __device__ __forceinline__ void done(const Unit&) const {}
};
struct MergeOrder {
    StaticOrder so; int nmt;
    __device__ __forceinline__ bool next(int i, Unit& u) const { const int b = i % 3; if (!so.next(i / 3, u)) return false; u.pm += b * nmt; u.pn += b * 4; return true; }
    __device__ __forceinline__ void a_ready(const Unit&) const {}
    __device__ __forceinline__ void done(const Unit&) const {}
};
template <class Epi, class Sched, bool ALIGN_EPI = false, bool SP2 = false>
__device__ __forceinline__ void gemm_phase(PG8_LAS unsigned char* lds, const Gemm g, const Sched& S, const Epi& E) {
    const int tid = g.zv  , wid = __builtin_amdgcn_readfirstlane(tid >> 6), lane = tid & 63, wr = wid >> 2, wc = wid & 3, fr = lane & 15, fq = lane >> 4;
    const int K = g.K, nt = K / BK;
    unsigned voffA[2], voffB[2];
#pragma unroll
    for (int i = 0; i < 2; ++i) { int R, C; stage_rc(tid * 16 + i * 8192, R, C); const int Rb = Epi::PERM ? ((R & ~31) + perm32(R & 31)) : R;
        const int pitch = g.tiled ? BK : K;
        voffA[i] = (unsigned)(R * pitch + C) * 2u; voffB[i] = (unsigned)(Rb * pitch + C) * 2u; }
    const size_t kstep = g.tiled ? (size_t)(BM * BK * 2) : (size_t)(BK * 2);
    const size_t hstep = g.tiled ? (size_t)(HALF * BK * 2) : (size_t)HALF * K * 2;
    const size_t tstep = (size_t)BM * K * 2;
    const unsigned ldsw = (unsigned)wid * 1024u;
    const int aoff = lds_byte(wr * 64 + fr, fq * 8), boff = lds_byte(wc * 32 + fr, fq * 8);
#define PG8_SA(b, h) (((b) * 2 + (h)) * HTB)
#define PG8_SB(b, h) ((4 + (b) * 2 + (h)) * HTB)
#define PG8_STAGE(bufoff, gbase, voff) do { _Pragma("unroll") for (int _i = 0; _i < 2; ++_i) \
        __builtin_amdgcn_global_load_lds((const unsigned*)((const char*)(gbase) + (voff)[_i]), (PG8_LAS unsigned*)(lds + (bufoff) + ldsw + _i * 8192), 16, 0, 0); } while (0)
#define PG8_LDA(dst, b, h) do { _Pragma("unroll") for (int m = 0; m < 4; ++m) _Pragma("unroll") for (int k = 0; k < 2; ++k) dst[m][k] = *(const PG8_LAS bf16x8*)(lds + PG8_SA(b, h) + aoff + m * 2048 + k * 1024); } while (0)
#define PG8_LDB(dst, b, h) do { _Pragma("unroll") for (int n = 0; n < 2; ++n) _Pragma("unroll") for (int k = 0; k < 2; ++k) dst[n][k] = *(const PG8_LAS bf16x8*)(lds + PG8_SB(b, h) + boff + n * 2048 + k * 1024); } while (0)
#define PG8_MMA(ai, bj, At, Bt) do { __builtin_amdgcn_s_setprio(1); _Pragma("unroll") for (int m = 0; m < 4; ++m) _Pragma("unroll") for (int n = 0; n < 2; ++n) _Pragma("unroll") for (int k = 0; k < 2; ++k) \
        acc[ai][bj][m][n] = __builtin_amdgcn_mfma_f32_16x16x32_bf16(Bt[n][k], At[m][k], acc[ai][bj][m][n], 0, 0, 0); __builtin_amdgcn_s_setprio(0); } while (0)
#define PG8_WAIT_V(n) asm volatile("s_waitcnt vmcnt(" #n ")" ::: "memory")
#define PG8_WAIT_L(n) asm volatile("s_waitcnt lgkmcnt(" #n ")" ::: "memory")
#define PG8_BAR __builtin_amdgcn_s_barrier()
#define PG8_SCHED __builtin_amdgcn_sched_barrier(0)
    Unit cur, nxt; int ui = 0;
    if (!S.next(0, cur)) return;
    f32x4 acc[2][2][4][2];
#pragma unroll
    for (int a = 0; a < 2; ++a)
#pragma unroll
        for (int b = 0; b < 2; ++b)
#pragma unroll
            for (int m = 0; m < 4; ++m)
#pragma unroll
                for (int n = 0; n < 2; ++n) acc[a][b][m][n] = (f32x4){0.f, 0.f, 0.f, 0.f};
    bf16x8 At[4][2], B0[2][2], B1[2][2];
    const char* cA = (const char*)g.A + (size_t)cur.pm * tstep; const char* cB = (const char*)g.Bt + (size_t)cur.pn * tstep;
    const int rot = g.rot; const size_t rofs = (size_t)rot * kstep; const char* pA = cA + rofs; const char* pB = cB + rofs;
#define PG8_KT(x) ((size_t)(((x) + rot >= nt) ? (x) + rot - nt : (x) + rot))
    S.a_ready(cur);
    if constexpr (SP2) {
        PG8_STAGE(PG8_SB(0, 0), pB, voffB); PG8_STAGE(PG8_SB(0, 1), pB + hstep, voffB); PG8_STAGE(PG8_SA(0, 0), pA, voffA); PG8_STAGE(PG8_SA(0, 1), pA + hstep, voffA);
        if (wr == 1) PG8_BAR;
        PG8_WAIT_V(2); PG8_BAR;
        PG8_STAGE(PG8_SB(1, 0), pB + kstep, voffB); PG8_STAGE(PG8_SA(1, 0), pA + kstep, voffA); PG8_STAGE(PG8_SB(1, 1), pB + hstep + kstep, voffB);
        PG8_WAIT_V(6); PG8_BAR;
    } else {
        PG8_STAGE(PG8_SB(0, 0), pB, voffB); PG8_STAGE(PG8_SA(0, 0), pA, voffA); PG8_STAGE(PG8_SB(0, 1), pB + hstep, voffB); PG8_STAGE(PG8_SA(0, 1), pA + hstep, voffA);
        if (wr == 1) PG8_BAR;
        PG8_WAIT_V(4); PG8_BAR;
        PG8_STAGE(PG8_SB(1, 0), pB + kstep, voffB); PG8_STAGE(PG8_SA(1, 0), pA + kstep, voffA); PG8_STAGE(PG8_SB(1, 1), pB + hstep + kstep, voffB);
        PG8_WAIT_V(6); PG8_BAR;
    }
    for (;;) {
        const bool has_next = S.next(ui + 1, nxt);
        const char* nA = has_next ? (const char*)g.A + (size_t)nxt.pm * tstep : cA; const char* nB = has_next ? (const char*)g.Bt + (size_t)nxt.pn * tstep : cB;
        for (int t = 0; t < nt; t += 2) {
            if constexpr (Epi::MID) { if (t != 0 && (t & (Epi::MID_TILES - 1)) == 0) E.mid(acc, cur, t / Epi::MID_TILES, wr, wc, fr, fq); }
            const bool last = (t == nt - 2);
            const char* a1 = cA + PG8_KT(t + 1) * kstep;
            const char* a2 = last ? nA + rofs : cA + PG8_KT(t + 2) * kstep; const char* b2 = last ? nB + rofs : cB + PG8_KT(t + 2) * kstep;
            const char* a3 = a2 + kstep; const char* b3 = b2 + kstep;
            if (last && has_next) S.a_ready(nxt);
            if constexpr (SP2) {
            PG8_LDB(B0, 0, 0); PG8_LDB(B1, 0, 1); PG8_SCHED; PG8_LDA(At, 0, 0); PG8_STAGE(PG8_SA(1, 1), a1 + hstep, voffA);
            PG8_WAIT_V(8); PG8_WAIT_L(0); PG8_BAR; PG8_MMA(0, 0, At, B0); PG8_MMA(0, 1, At, B1); PG8_BAR; PG8_SCHED;
            PG8_LDA(At, 0, 1); PG8_STAGE(PG8_SB(0, 0), b2, voffB); PG8_STAGE(PG8_SB(0, 1), b2 + hstep, voffB); PG8_STAGE(PG8_SA(0, 0), a2, voffA);
            PG8_WAIT_V(8); PG8_WAIT_L(0); PG8_BAR; PG8_MMA(1, 0, At, B0); PG8_MMA(1, 1, At, B1); PG8_BAR; PG8_SCHED;
            PG8_LDB(B0, 1, 0); PG8_LDB(B1, 1, 1); PG8_SCHED; PG8_LDA(At, 1, 0); PG8_STAGE(PG8_SA(0, 1), a2 + hstep, voffA);
            PG8_WAIT_V(8); PG8_WAIT_L(0); PG8_BAR; PG8_MMA(0, 0, At, B0); PG8_MMA(0, 1, At, B1); PG8_BAR; PG8_SCHED;
            PG8_LDA(At, 1, 1); PG8_STAGE(PG8_SB(1, 0), b3, voffB); PG8_STAGE(PG8_SB(1, 1), b3 + hstep, voffB); PG8_STAGE(PG8_SA(1, 0), a3, voffA);
            PG8_WAIT_V(8); PG8_WAIT_L(0); PG8_BAR; PG8_MMA(1, 0, At, B0); PG8_MMA(1, 1, At, B1); PG8_BAR; PG8_SCHED;
            } else {
            PG8_LDB(B0, 0, 0); PG8_SCHED; PG8_LDA(At, 0, 0); PG8_STAGE(PG8_SA(1, 1), a1 + hstep, voffA);
            PG8_WAIT_L(8); PG8_BAR; PG8_WAIT_L(0); PG8_MMA(0, 0, At, B0); PG8_BAR; PG8_SCHED;
            PG8_LDB(B1, 0, 1); PG8_STAGE(PG8_SB(0, 0), b2, voffB);
            PG8_BAR; PG8_WAIT_L(0); PG8_MMA(0, 1, At, B1); PG8_BAR;
            PG8_LDA(At, 0, 1); PG8_STAGE(PG8_SA(0, 0), a2, voffA);
            PG8_BAR; PG8_WAIT_L(0); PG8_MMA(1, 0, At, B0); PG8_BAR; PG8_SCHED;
            PG8_STAGE(PG8_SB(0, 1), b2 + hstep, voffB);
            PG8_WAIT_V(6); PG8_BAR; PG8_MMA(1, 1, At, B1); PG8_BAR;
            PG8_LDB(B0, 1, 0); PG8_SCHED; PG8_LDA(At, 1, 0); PG8_STAGE(PG8_SA(0, 1), a2 + hstep, voffA);
            PG8_WAIT_L(8); PG8_BAR; PG8_WAIT_L(0); PG8_MMA(0, 0, At, B0); PG8_BAR; PG8_SCHED;
            PG8_LDB(B1, 1, 1); PG8_STAGE(PG8_SB(1, 0), b3, voffB);
            PG8_BAR; PG8_WAIT_L(0); PG8_MMA(0, 1, At, B1); PG8_BAR;
            PG8_LDA(At, 1, 1); PG8_STAGE(PG8_SA(1, 0), a3, voffA);
            PG8_BAR; PG8_WAIT_L(0); PG8_MMA(1, 0, At, B0); PG8_BAR; PG8_SCHED;
            PG8_STAGE(PG8_SB(1, 1), b3 + hstep, voffB);
            PG8_WAIT_V(6); PG8_BAR; PG8_MMA(1, 1, At, B1); PG8_BAR;
            }
        }
        if constexpr (ALIGN_EPI) { if (wr == 0) PG8_BAR; }
        if constexpr (!Epi::AFTER_DRAIN) { E(acc, cur, wr, wc, fr, fq); S.done(cur); }
        if (!has_next) break;
#pragma unroll
        for (int a = 0; a < 2; ++a)
#pragma unroll
            for (int b = 0; b < 2; ++b)
#pragma unroll
                for (int m = 0; m < 4; ++m)
#pragma unroll
                    for (int n = 0; n < 2; ++n) acc[a][b][m][n] = (f32x4){0.f, 0.f, 0.f, 0.f};
        cur = nxt; cA = nA; cB = nB; ++ui;
        if constexpr (ALIGN_EPI) { if (wr == 1) PG8_BAR; }
    }
    PG8_WAIT_V(0);
    if constexpr (!ALIGN_EPI) { if (wr == 0) PG8_BAR; }
    PG8_BAR;
    if constexpr (Epi::AFTER_DRAIN) { E.fused(acc, cur, wr, wc, fr, fq, lds, wid, lane); S.done(cur); }
#undef PG8_KT
#undef PG8_SA
#undef PG8_SB
#undef PG8_STAGE
#undef PG8_LDA
#undef PG8_LDB
#undef PG8_MMA
#undef PG8_WAIT_V
#undef PG8_WAIT_L
#undef PG8_BAR
#undef PG8_SCHED
}
}

constexpr int NWAVES = 8;
constexpr int DM = 1024, BATCH = 16, SEQ = 4096, DEPTH = 4, MTOK = BATCH * SEQ;
constexpr int NCHUNK = 2, MC = MTOK / NCHUNK, BC = BATCH / NCHUNK;
constexpr int CIN = 5004, NPROJ = 5120, P1W = 2048, GWID = 3072;
constexpr int DFF = 2752, DFFP = 2816, NFF1 = 2 * DFFP;
constexpr int NEXP = 8, DFE = 3584, NMOE1 = 2 * DFE;
constexpr int SLOTS = MC + 2048;
constexpr float EPS = 1e-6f;
constexpr int C_U = 0, C_V = 256, C_SBQ = 512, C_SBK = 768, C_SBV = 1024, C_CQ = 1280, C_KCMP = 1536, C_VCMP = 1600, C_KSLC = 1664, C_VSLC = 1728, C_KWIN = 1792, C_VWIN = 1856, C_CG = 1920;

constexpr size_t MiB = 1u << 20;
constexpr size_t WS_CTL = 0, CTL_ZERO_BYTES = 1 * MiB;
constexpr size_t WS_ROPE = 1 * MiB;
constexpr size_t WS_BIAS1 = 1 * MiB + 512 * 1024;
constexpr size_t WS_WIN = 2 * MiB;
constexpr size_t WS_WBR = 12 * MiB;
constexpr size_t WS_WOUT = 14 * MiB;
constexpr size_t WS_WC1 = 16 * MiB;
constexpr size_t WS_WF1 = 18 * MiB;
constexpr size_t WS_WF2 = 130 * MiB;
constexpr size_t WS_HN = 186 * MiB;
constexpr size_t WS_SCR = 314 * MiB;
constexpr size_t WS_P1 = WS_SCR;
constexpr size_t WS_G = WS_P1 + 128 * MiB;
constexpr size_t WS_Y = WS_G + 192 * MiB;
constexpr size_t WS_MG = WS_Y + 48 * MiB;
constexpr size_t WS_KVC = WS_MG + 64 * MiB;
constexpr size_t WS_UL = WS_KVC + 8 * MiB;
constexpr size_t WS_KC = WS_UL + 8 * MiB;
constexpr size_t WS_VT = WS_KC + 1 * MiB;
constexpr size_t WS_KCT = WS_VT + 24 * MiB;
constexpr size_t WS_MIX_END = WS_KCT + 1 * MiB;
constexpr size_t WS_HID = WS_SCR;
constexpr size_t WS_ROUTE = WS_SCR;
constexpr size_t WS_TOKMAP = WS_SCR + 1 * MiB;
constexpr size_t WS_WSLOT = WS_SCR + 2 * MiB;
constexpr size_t WS_XG = WS_SCR + 4 * MiB;
constexpr size_t WS_HIDM = WS_XG + 68 * MiB;
constexpr size_t WS_END = 800 * MiB;
static_assert(WS_MIX_END <= WS_END && WS_HID + (size_t)MTOK * DFFP * 2 <= WS_END && WS_HIDM + (size_t)SLOTS * DFE * 2 <= WS_END, "d_ws map");
static_assert(WS_WF1 + (size_t)NEXP * NMOE1 * DM * 2 <= WS_WF2 && WS_WF2 + (size_t)NEXP * DM * DFE * 2 <= WS_HN, "weight map");
static_assert((size_t)4 * SLOTS * 4 <= 1 * MiB, "tokmap");
constexpr int CW_BAR = 4096;
constexpr int CW_CNT = 131072;
constexpr int CW_CUR = 131072 + 256;
constexpr int MAX_BAR_REGIONS = 32;
constexpr int RING_OFF = 0, RING_BYTES = 131072;
constexpr int LDSCTL_OFF = RING_BYTES, MISC_OFF = LDSCTL_OFF + 320;
constexpr int TAB_OFF = LDSCTL_OFF + 1024;
constexpr int LDS_BYTES = 147456;

#define GAS __attribute__((address_space(1)))
#define LAS __attribute__((address_space(3)))
typedef unsigned short bf16;
typedef unsigned v4u __attribute__((ext_vector_type(4)));
typedef unsigned v2u __attribute__((ext_vector_type(2)));
typedef float f32x4 __attribute__((ext_vector_type(4)));
typedef int v4i __attribute__((ext_vector_type(4)));
typedef __bf16 bf16x2_t __attribute__((ext_vector_type(2)));
#define LDS_WAIT() asm volatile("s_waitcnt lgkmcnt(0)" ::: "memory")
#define VM_WAIT() asm volatile("s_waitcnt vmcnt(0)" ::: "memory")
__device__ __forceinline__ unsigned f2bf(float f) { unsigned u = __builtin_bit_cast(unsigned, f); return (u + 0x7fffu + ((u >> 16) & 1u)) >> 16; }
__device__ __forceinline__ unsigned pk2(float lo, float hi) { return f2bf(lo) | (f2bf(hi) << 16); }
__device__ __forceinline__ float bflo(unsigned u) { return __builtin_bit_cast(float, u << 16); }
__device__ __forceinline__ float bfhi(unsigned u) { return __builtin_bit_cast(float, u & 0xffff0000u); }
__device__ __forceinline__ float bf1(bf16 h) { return __builtin_bit_cast(float, (unsigned)h << 16); }
__device__ __forceinline__ float dot2bf(unsigned a, unsigned b, float c) { return __builtin_amdgcn_fdot2_f32_bf16(__builtin_bit_cast(bf16x2_t, a), __builtin_bit_cast(bf16x2_t, b), c, false); }
#ifdef EMU_FP8
__device__ __forceinline__ float q8r(float x, float s) { const int p = __builtin_amdgcn_cvt_pk_fp8_f32(x * s, x * s, 0, false); return __builtin_amdgcn_cvt_f32_fp8(p, 0) * (1.0f / s); }
#else
__device__ __forceinline__ float q8r(float x, float) { return x; }
#endif
__device__ __forceinline__ float fexp(float x) { return __builtin_amdgcn_exp2f(1.4426950408889634f * x); }
template <int X> __device__ __forceinline__ float swz_xor(float v) { return __builtin_bit_cast(float, __builtin_amdgcn_ds_swizzle(__builtin_bit_cast(int, v), (X << 10) | 0x1f)); }
__device__ __forceinline__ float wave_sum(float v, int lane) {
#pragma unroll
    for (int o = 1; o < 64; o <<= 1) v += __builtin_bit_cast(float, __builtin_amdgcn_ds_bpermute((lane ^ o) << 2, __builtin_bit_cast(int, v)));
    return v;
}
__device__ __forceinline__ float rdlane(float v, int l) { return __builtin_bit_cast(float, __builtin_amdgcn_readlane(__builtin_bit_cast(int, v), l)); }
__device__ __forceinline__ int bperm(int srclane, int v) { return __builtin_amdgcn_ds_bpermute(srclane << 2, v); }
__constant__ double ROPE_INVF[8] = {1.0, 0.19392274474868576, 0.037606030930863933, 0.0072926647372171093, 0.0014142135623730950, 0.00027424817567620730, 5.3182958969449883e-05, 1.0313385377212460e-05};
#define XB_TMO      128
#define XB_XCNT(j)  (256  + 64 * (j))
#define XB_XSUB(j)  (1280 + 64 * (j))
#define XB_XGEN(j)  (2304 + 64 * (j))
#define XB_TOP      3328
#define XB_TOPGEN   3392
#define XCD_BAR_WORDS 3456
#define XB_SPIN_CAP (1u << 18)

__device__ __forceinline__ unsigned xb_ld(unsigned* p)              { return __hip_atomic_load(p, __ATOMIC_RELAXED, __HIP_MEMORY_SCOPE_AGENT); }
__device__ __forceinline__ unsigned xb_add(unsigned* p, unsigned v) { return __hip_atomic_fetch_add(p, v, __ATOMIC_RELAXED, __HIP_MEMORY_SCOPE_AGENT); }
__device__ __forceinline__ unsigned xb_xcc_id() { return (unsigned)__builtin_amdgcn_s_getreg((3 << 11) | 20) & 0xFu; }
#define XB_SPIN(cond, bar) do { unsigned _sp = 0; while (cond) { __builtin_amdgcn_s_sleep(1); \
    if ((++_sp & 255u) == 0u) { if (xb_ld(&(bar)[XB_TMO])) break; if (_sp > XB_SPIN_CAP) { atomicAdd(&(bar)[XB_TMO], 1u); break; } } } } while (0)

__device__ __forceinline__ bool xb_thread0_w(unsigned w, unsigned z) { return w == 0u && __builtin_amdgcn_mbcnt_hi(~0u, __builtin_amdgcn_mbcnt_lo(~0u, z)) == 0u; }
struct XcdBarrier {
    unsigned* bar; unsigned x; unsigned w, z;
    volatile LAS unsigned* st;
};

__device__ __forceinline__ XcdBarrier xcd_barrier_post(unsigned* bar, volatile LAS unsigned* st) {
    XcdBarrier b; b.bar = bar; b.x = xb_xcc_id(); b.st = st; b.w = (unsigned)__builtin_amdgcn_readfirstlane((int)(threadIdx.x >> 6)); b.z = 0u;
    if (xb_thread0_w(b.w, b.z)) (void)xb_add(&bar[XB_XCNT(b.x)], 1u);
    return b;
}
__device__ __forceinline__ void xcd_barrier_complete(unsigned* bar, unsigned x, unsigned& nloc, unsigned& nx) {
    const unsigned G = gridDim.x * gridDim.y * gridDim.z;
    unsigned sum, cnt, mine, sp = 0u;
    for (;;) {
        sum = 0u; cnt = 0u; mine = 0u;
#pragma unroll
        for (unsigned j = 0; j < 16; ++j) { const unsigned c = xb_ld(&bar[XB_XCNT(j)]); sum += c; cnt += (c > 0u) ? 1u : 0u; mine = (j == x) ? c : mine; }
        if (sum == G) break;
        __builtin_amdgcn_s_sleep(1);
        if ((++sp & 255u) == 0u) { if (xb_ld(&bar[XB_TMO])) break; if (sp > XB_SPIN_CAP) { atomicAdd(&bar[XB_TMO], 1u); break; } }
    }
    nloc = mine > 0u ? mine : 1u; nx = cnt > 0u ? cnt : 1u;
}

__device__ __forceinline__ void xcd_barrier(const XcdBarrier& b) {
    asm volatile("s_waitcnt vmcnt(0)" ::: "memory");
    __syncthreads();
    if (xb_thread0_w(b.w, b.z)) {
        unsigned* bar = b.bar;
        __builtin_amdgcn_s_waitcnt(0);
        unsigned nloc = b.st[0], nx = b.st[1];
        if (nloc == 0u) { xcd_barrier_complete(bar, b.x, nloc, nx); b.st[0] = nloc; b.st[1] = nx; }
        const unsigned old = xb_add(&bar[XB_XSUB(b.x)], 1u);
        const unsigned gen = old / nloc;
        if (old + 1u == (gen + 1u) * nloc) {
            __builtin_amdgcn_fence(__ATOMIC_RELEASE, "agent");
            asm volatile("s_waitcnt vmcnt(0)" ::: "memory");
            const unsigned og = xb_add(&bar[XB_TOP], 1u);
            const unsigned tg = og / nx;
            if (og + 1u == (tg + 1u) * nx) xb_add(&bar[XB_TOPGEN], 1u);
            else XB_SPIN(xb_ld(&bar[XB_TOPGEN]) == tg, bar);
            __builtin_amdgcn_fence(__ATOMIC_ACQUIRE, "agent");
            xb_add(&bar[XB_XGEN(b.x)], 1u);
            asm volatile("s_waitcnt vmcnt(0)" ::: "memory");
        } else {
            XB_SPIN(xb_ld(&bar[XB_XGEN(b.x)]) == gen, bar);
            __builtin_amdgcn_fence(__ATOMIC_ACQUIRE, "agent");
            asm volatile("s_waitcnt vmcnt(0)" ::: "memory");
        }
    }
    __syncthreads();
}

struct Frame {
    LAS unsigned char* lds;
    unsigned* ctl;
    int tid, lane, wave, vcu, G, bx, zv, zs, rep;
    unsigned char* ws;
    const float* const* in;
    float* out;
};
#define WSP(T, off) ((T*)(F.ws + (off)))
__device__ __forceinline__ size_t toff(int row, int k, int K) { return (size_t)(row >> 8) * 256 * K + (size_t)(k >> 6) * (256 * 64) + (size_t)(row & 255) * 64 + (k & 63); }

#ifndef TILED_FFN1
#define TILED_FFN1 0
#endif
#ifndef Q8_W1
#define Q8_W1 0.f
#define Q8_W2 0.f
#define Q8_HN 0.f
#define Q8_HID 0.f
#endif
__device__ __forceinline__ int map_row(int kind, int off, int n) { return kind == 0 ? n + off : (kind == 1 ? (n < 1932 ? n : n + 116) : ((n >> 7) * 256 + (n & 127) + off)); }
__device__ __forceinline__ void tr_item(const float* W, int ldw, int N, int ks, int n0, bf16* WT, int ldt, int kd, int kind, int off, LAS unsigned char* scr, int lane, float q8s = 0.f, int tiled = 0) {
    const int nq = (lane & 15) * 4, kq = lane >> 4;
    f32x4 x[16];
#pragma unroll
    for (int i = 0; i < 16; ++i) x[i] = (n0 + nq < N) ? *(const f32x4*)(W + (size_t)(ks + 4 * i + kq) * ldw + n0 + nq) : (f32x4){0.f, 0.f, 0.f, 0.f};
#pragma unroll
    for (int i = 0; i < 16; ++i) { const int k = 4 * i + kq;
#pragma unroll
        for (int c = 0; c < 4; ++c) { float wv = x[i][c]; if (q8s > 0.f) wv = q8r(wv, q8s); *(LAS bf16*)(scr + (nq + c) * 136 + k * 2) = (bf16)f2bf(wv); } }
    LDS_WAIT(); asm volatile("" ::: "memory");
    if (n0 + lane < N) { const LAS v2u* s = (const LAS v2u*)(scr + lane * 136); const int mr = map_row(kind, off, n0 + lane); bf16* dst = tiled ? WT + toff(mr, kd, ldt) : WT + (size_t)mr * ldt + kd;
#pragma unroll
        for (int q = 0; q < 8; ++q) { const v2u a = s[2 * q], b = s[2 * q + 1]; *(v4u*)(dst + 8 * q) = (v4u){a.x, a.y, b.x, b.y}; } }
    LDS_WAIT(); asm volatile("" ::: "memory");
}
__device__ __forceinline__ void conv(Frame& F, const float* W, size_t sW, int nb, int ldw, int N, int ks0, int K, bf16* WT, size_t sWT, int ldt, int kd0, int kind, int off, float q8s = 0.f, int tiled = 0) {
    LAS unsigned char* scr = F.lds + RING_OFF + F.wave * 16384;
    const int gw = F.vcu * NWAVES + F.wave, NGW = F.G * NWAVES;
    const int nblk = (N + 63) / 64, per = (K / 64) * nblk, total = per * nb;
    for (int it = gw; it < total; it += NGW) { const int b = it / per, r = it % per, kb = r / nblk, nbk = r % nblk;
        tr_item(W + (size_t)b * sW, ldw, N, ks0 + 64 * kb, 64 * nbk, WT + (size_t)b * sWT, ldt, kd0 + 64 * kb, kind, off, scr, F.lane, q8s, tiled); }
}
__device__ __forceinline__ void zero_block(Frame& F, bf16* WT, int ldt, int r0, int rows, int c0, int cols, int tiled = 0) {
    const int gt = (F.vcu * NWAVES + F.wave) * 64 + F.lane, NT = F.G * NWAVES * 64, cpr = cols / 8;
    for (int i = gt; i < rows * cpr; i += NT) { const int r = i / cpr, c = i % cpr; const unsigned z = (unsigned)F.zv; *(v4u*)(tiled ? WT + toff(r0 + r, c0 + 8 * c, ldt) : WT + (size_t)(r0 + r) * ldt + c0 + 8 * c) = (v4u){z, z, z, z}; }
}
__device__ __forceinline__ void p_convert(Frame& F, int layer) {
    const int j = layer >> 1;
    conv(F, F.in[2] + (size_t)layer * DM * CIN, 0, 1, CIN, CIN, 0, DM, WSP(bf16, WS_WIN), 0, DM, 0, 1, 0);
    zero_block(F, WSP(bf16, WS_WIN), DM, 1932, 116, 0, DM);
    conv(F, F.in[9] + (size_t)layer * 3 * 256 * DM, (size_t)256 * DM, 3, DM, DM, 0, 256, WSP(bf16, WS_WBR), (size_t)DM * 256, 256, 0, 0, 0);
    conv(F, F.in[10] + (size_t)layer * DM * DM, 0, 1, DM, DM, 0, DM, WSP(bf16, WS_WOUT), 0, DM, 0, 0, 0);
    conv(F, F.in[7] + (size_t)layer * 2 * 2048 * 256, (size_t)2048 * 256, 2, 256, 256, 0, 1024, WSP(bf16, WS_WC1), (size_t)512 * 1024, 1024, 0, 0, 0);
    conv(F, F.in[7] + (size_t)layer * 2 * 2048 * 256, (size_t)2048 * 256, 2, 256, 256, 1024, 1024, WSP(bf16, WS_WC1), (size_t)512 * 1024, 1024, 0, 0, 256);
    if ((layer & 1) == 0) {
        conv(F, F.in[12] + (size_t)j * DM * DFF, 0, 1, DFF, DFF, 0, DM, WSP(bf16, WS_WF1), 0, DM, 0, 2, 0, Q8_W1, TILED_FFN1);
        conv(F, F.in[13] + (size_t)j * DM * DFF, 0, 1, DFF, DFF, 0, DM, WSP(bf16, WS_WF1), 0, DM, 0, 2, 128, Q8_W1, TILED_FFN1);
        zero_block(F, WSP(bf16, WS_WF1), DM, 21 * 256 + 64, 64, 0, DM, TILED_FFN1);
        zero_block(F, WSP(bf16, WS_WF1), DM, 21 * 256 + 128 + 64, 64, 0, DM, TILED_FFN1);
        conv(F, F.in[14] + (size_t)j * DFF * DM, 0, 1, DM, DM, 0, DFF, WSP(bf16, WS_WF2), 0, DFFP, 0, 0, 0, Q8_W2);
        zero_block(F, WSP(bf16, WS_WF2), DFFP, 0, DM, DFF, DFFP - DFF);
    } else {
        conv(F, F.in[16] + (size_t)j * NEXP * DM * DFE, (size_t)DM * DFE, NEXP, DFE, DFE, 0, DM, WSP(bf16, WS_WF1), (size_t)NMOE1 * DM, DM, 0, 2, 0, Q8_W1);
        conv(F, F.in[17] + (size_t)j * NEXP * DM * DFE, (size_t)DM * DFE, NEXP, DFE, DFE, 0, DM, WSP(bf16, WS_WF1), (size_t)NMOE1 * DM, DM, 0, 2, 128, Q8_W1);
        conv(F, F.in[18] + (size_t)j * NEXP * DFE * DM, (size_t)DFE * DM, NEXP, DM, DM, 0, DFE, WSP(bf16, WS_WF2), (size_t)DM * DFE, DFE, 0, 0, 0, Q8_W2);
    }
    if (F.bx < 8) {
        __syncthreads();
        const int kv = F.bx >> 2, jj = (F.bx & 3) * 64 + F.lane;
        const float* pos = F.in[6] + (size_t)(layer * 2 + kv) * 2048; const float* w1 = F.in[7] + (size_t)(layer * 2 + kv) * 2048 * 256;
        float a = 0.f;
        float a1 = 0.f, a2 = 0.f, a3 = 0.f;
#pragma unroll 8
        for (int k = 0; k < 256; k += 4) { const int kk = F.wave * 256 + k;
            a += pos[kk] * w1[(size_t)kk * 256 + jj]; a1 += pos[kk + 1] * w1[(size_t)(kk + 1) * 256 + jj]; a2 += pos[kk + 2] * w1[(size_t)(kk + 2) * 256 + jj]; a3 += pos[kk + 3] * w1[(size_t)(kk + 3) * 256 + jj]; }
        a = (a + a1) + (a2 + a3);
        LAS float* red = (LAS float*)(F.lds + RING_OFF);
        red[F.wave * 64 + F.lane] = a;
        __syncthreads();
        if (F.wave == 0) { float s = 0.f;
#pragma unroll
            for (int w = 0; w < 8; ++w) s += red[w * 64 + F.lane];
            WSP(float, WS_BIAS1)[kv * 256 + jj] = s; }
        __syncthreads();
    }
    if (layer == 0) {
        const int gt = (F.vcu * NWAVES + F.wave) * 64 + F.lane, NT = F.G * NWAVES * 64;
        for (int idx = gt; idx < SEQ * 8; idx += NT) { const int pos = idx >> 3, i = idx & 7;
            const double invf = ROPE_INVF[i];
            double rev = (double)pos * invf * 0.15915494309189535; rev -= __builtin_floor(rev);
            WSP(float, WS_ROPE)[idx] = __builtin_amdgcn_cosf((float)rev); WSP(float, WS_ROPE)[SEQ * 8 + idx] = __builtin_amdgcn_sinf((float)rev); }
    }
}

template <int MODE> __device__ __forceinline__ void p_norm(Frame& F, const float* src, const float* g, const float* rw, int jmoe, float q8s = 0.f, int tiled = 0) {
    const int gw = F.vcu * NWAVES + F.wave, NGW = F.G * NWAVES, lane = F.lane;
    LAS int* hist = (LAS int*)(F.lds + TAB_OFF) + 192;
    if (MODE == 1) {
        if (F.tid < 32) hist[F.tid] = 0;
        const int gt = gw * 64 + lane, NT = NGW * 64; int* tm = WSP(int, WS_TOKMAP);
        for (int i = gt; i < 4 * SLOTS; i += NT) tm[i] = -1;
        for (int i = F.tid; i < DM * NEXP / 4; i += NWAVES * 64) *(LAS f32x4*)(F.lds + RING_OFF + 16 * i) = ((const f32x4*)rw)[i];
        __syncthreads();
    }
    f32x4 gv[4];
#pragma unroll
    for (int jx = 0; jx < 4; ++jx) gv[jx] = ((const f32x4*)g)[lane + 64 * jx];
    constexpr int ROWS = (MODE == 1) ? 2 : 4;
    for (int m0 = gw; m0 < MTOK; m0 += ROWS * NGW) {
        f32x4 v[ROWS][4]; float ss[ROWS];
#pragma unroll
        for (int u = 0; u < ROWS; ++u) { const int m = m0 + u * NGW; const f32x4* xr = (const f32x4*)(src + (size_t)(m < MTOK ? m : m0) * DM) + lane;
#pragma unroll
            for (int jx = 0; jx < 4; ++jx) v[u][jx] = xr[64 * jx]; }
#pragma unroll
        for (int u = 0; u < ROWS; ++u) { float s = 0.f;
#pragma unroll
            for (int jx = 0; jx < 4; ++jx) s += (v[u][jx].x * v[u][jx].x + v[u][jx].y * v[u][jx].y) + (v[u][jx].z * v[u][jx].z + v[u][jx].w * v[u][jx].w);
            ss[u] = s; }
#pragma unroll
        for (int o = 1; o < 64; o <<= 1) {
#pragma unroll
            for (int u = 0; u < ROWS; ++u) ss[u] += __builtin_bit_cast(float, __builtin_amdgcn_ds_bpermute((lane ^ o) << 2, __builtin_bit_cast(int, ss[u]))); }
        float lgall[MODE == 1 ? ROWS : 1][8];
        if (MODE == 1) {
            float rs[ROWS];
#pragma unroll
            for (int u = 0; u < ROWS; ++u) { rs[u] = 1.0f / sqrtf(ss[u] * (1.f / DM) + EPS);
#pragma unroll
                for (int e = 0; e < 8; ++e) lgall[u][e] = 0.f; }
#pragma unroll
            for (int jx = 0; jx < 4; ++jx) { const LAS f32x4* wr = (const LAS f32x4*)(F.lds + RING_OFF + (size_t)(4 * lane + 256 * jx) * 32);
#pragma unroll
                for (int r = 0; r < 4; ++r) { const f32x4 a = wr[2 * r], b = wr[2 * r + 1];
#pragma unroll
                    for (int u = 0; u < ROWS; ++u) { const float xv = v[u][jx][r] * rs[u] * gv[jx][r];
                        lgall[u][0] += xv * a.x; lgall[u][1] += xv * a.y; lgall[u][2] += xv * a.z; lgall[u][3] += xv * a.w; lgall[u][4] += xv * b.x; lgall[u][5] += xv * b.y; lgall[u][6] += xv * b.z; lgall[u][7] += xv * b.w; } } }
        }
#pragma unroll
        for (int u = 0; u < ROWS; ++u) { const int m = m0 + u * NGW; if (m >= MTOK) continue;
            const float rstd = 1.0f / sqrtf(ss[u] * (1.f / DM) + EPS);
#pragma unroll
            for (int jx = 0; jx < 4; ++jx) v[u][jx] = v[u][jx] * rstd * gv[jx];
            if (MODE == 2) {
                f32x4* o = (f32x4*)(F.out + (size_t)m * DM) + lane;
#pragma unroll
                for (int jx = 0; jx < 4; ++jx) o[64 * jx] = v[u][jx];
            } else {
                unsigned long long* o8 = (unsigned long long*)(WSP(bf16, WS_HN) + (size_t)m * DM) + lane;
#pragma unroll
                for (int jx = 0; jx < 4; ++jx) { f32x4 w = v[u][jx];
                    if (tiled) { *(unsigned long long*)(WSP(bf16, WS_HN) + toff(m, 4 * lane + 256 * jx, DM)) = (unsigned long long)pk2(w.x, w.y) | ((unsigned long long)pk2(w.z, w.w) << 32); continue; } if (q8s > 0.f) { w.x = q8r(w.x, q8s); w.y = q8r(w.y, q8s); w.z = q8r(w.z, q8s); w.w = q8r(w.w, q8s); }
                    o8[64 * jx] = (unsigned long long)pk2(w.x, w.y) | ((unsigned long long)pk2(w.z, w.w) << 32); }
            }
            if (MODE == 1) {
                float lg[8];
#pragma unroll
                for (int e = 0; e < 8; ++e) lg[e] = lgall[u][e];
                float h4[4], h2[2], h1;
                { const bool up = lane & 1;
#pragma unroll
                  for (int i = 0; i < 4; ++i) { const float keep = up ? lg[4 + i] : lg[i], send = up ? lg[i] : lg[4 + i]; h4[i] = keep + __builtin_bit_cast(float, bperm(lane ^ 1, __builtin_bit_cast(int, send))); } }
                { const bool up = lane & 2;
#pragma unroll
                  for (int i = 0; i < 2; ++i) { const float keep = up ? h4[2 + i] : h4[i], send = up ? h4[i] : h4[2 + i]; h2[i] = keep + __builtin_bit_cast(float, bperm(lane ^ 2, __builtin_bit_cast(int, send))); } }
                { const bool up = lane & 4; const float keep = up ? h2[1] : h2[0], send = up ? h2[0] : h2[1]; h1 = keep + __builtin_bit_cast(float, bperm(lane ^ 4, __builtin_bit_cast(int, send))); }
                h1 += __builtin_bit_cast(float, bperm(lane ^ 8, __builtin_bit_cast(int, h1))); h1 += __builtin_bit_cast(float, bperm(lane ^ 16, __builtin_bit_cast(int, h1))); h1 += __builtin_bit_cast(float, bperm(lane ^ 32, __builtin_bit_cast(int, h1)));
                lg[0] = rdlane(h1, 0); lg[1] = rdlane(h1, 4); lg[2] = rdlane(h1, 2); lg[3] = rdlane(h1, 6); lg[4] = rdlane(h1, 1); lg[5] = rdlane(h1, 5); lg[6] = rdlane(h1, 3); lg[7] = rdlane(h1, 7);
                int e0 = 0; float v0 = lg[0];
#pragma unroll
                for (int e = 1; e < 8; ++e) if (lg[e] > v0) { v0 = lg[e]; e0 = e; }
                int e1 = -1; float v1 = -INFINITY;
#pragma unroll
                for (int e = 0; e < 8; ++e) if (e != e0 && lg[e] > v1) { v1 = lg[e]; e1 = e; }
                const float w0 = 1.0f / (1.0f + fexp(v1 - v0)), w1 = 1.0f - w0;
                if (lane == 0) { WSP(v4i, WS_ROUTE)[m] = (v4i){e0, e1, __builtin_bit_cast(int, w0), __builtin_bit_cast(int, w1)};
                    const int c = m / MC; if (!F.rep) { atomicAdd((int*)&hist[(c * 2 + 0) * 8 + e0], 1); atomicAdd((int*)&hist[(c * 2 + 1) * 8 + e1], 1); } }
            }
        }
    }
    if (MODE == 1) {
        __syncthreads();
        if (F.tid < 32) { const int h = hist[F.tid]; if (h) atomicAdd(F.ctl + CW_CNT + jmoe * 32 + F.tid, (unsigned)h); }
    }
}

__device__ __forceinline__ void p_prep(Frame& F) {
    const int gw = F.vcu * NWAVES + F.wave, NGW = F.G * NWAVES, lane = F.lane;
    bf16* P1 = WSP(bf16, WS_P1); bf16* KVC = WSP(bf16, WS_KVC); const float* rope = WSP(float, WS_ROPE);
    const int vec = lane >> 3, ri = lane & 7; const int cb = vec < 4 ? C_CQ + vec * 64 : (vec == 4 ? C_KCMP : (vec == 5 ? C_KSLC : C_KWIN));
    for (int row0 = gw; row0 < MC; row0 += 4 * NGW) {
        float x1[4], x2[4], cc[4], ss[4]; bf16 kc48[4], vc64[4];
#pragma unroll
        for (int k = 0; k < 4; ++k) { const int row = row0 + k * NGW < MC ? row0 + k * NGW : row0; const bf16* p = P1 + (size_t)row * P1W; const int pos = row & (SEQ - 1);
            const int cl = lane < 56 ? cb + ri : C_CQ;
            x1[k] = bf1(p[cl]); x2[k] = bf1(p[cl + 8]); cc[k] = rope[pos * 8 + ri]; ss[k] = rope[SEQ * 8 + pos * 8 + ri];
            if (F.rep) { cc[k] = 1.f; ss[k] = 0.f; }
            kc48[k] = p[C_KCMP + 16 + (lane < 48 ? lane : 0)]; vc64[k] = p[C_VCMP + lane]; }
#pragma unroll
        for (int k = 0; k < 4; ++k) { const int row = row0 + k * NGW; if (row >= MC) continue; bf16* p = P1 + (size_t)row * P1W;
            if (lane < 56) { const bf16 o1 = (bf16)f2bf(x1[k] * cc[k] - x2[k] * ss[k]), o2 = (bf16)f2bf(x2[k] * cc[k] + x1[k] * ss[k]);
                p[cb + ri] = o1; p[cb + ri + 8] = o2;
                if (vec == 4) { KVC[(size_t)row * 64 + ri] = o1; KVC[(size_t)row * 64 + ri + 8] = o2; } }
            if (lane < 48) KVC[(size_t)row * 64 + 16 + lane] = kc48[k];
            KVC[(size_t)MC * 64 + (size_t)row * 64 + lane] = vc64[k]; }
    }
    bf16* VT = WSP(bf16, WS_VT);
    for (int it = gw; it < 6 * BC * 64; it += NGW) { const int which = it / (BC * 64), r = it % (BC * 64), b = r >> 6, blk = r & 63;
        const v4u* src = (const v4u*)(P1 + ((size_t)b * SEQ + blk * 64 + lane) * P1W + (which == 0 ? C_VSLC : (which == 1 ? C_VWIN : C_SBV + (which - 2) * 64)));
        bf16* dst = VT + ((size_t)(which * BC + b) * 64) * SEQ + blk * 64 + lane;
        v4u xs[8];
#pragma unroll
        for (int i = 0; i < 8; ++i) xs[i] = src[i];
#pragma unroll
        for (int i = 0; i < 8; ++i) { const v4u x = xs[i];
            dst[(size_t)(8 * i + 0) * SEQ] = (bf16)(x.x & 0xffffu); dst[(size_t)(8 * i + 1) * SEQ] = (bf16)(x.x >> 16);
            dst[(size_t)(8 * i + 2) * SEQ] = (bf16)(x.y & 0xffffu); dst[(size_t)(8 * i + 3) * SEQ] = (bf16)(x.y >> 16);
            dst[(size_t)(8 * i + 4) * SEQ] = (bf16)(x.z & 0xffffu); dst[(size_t)(8 * i + 5) * SEQ] = (bf16)(x.z >> 16);
            dst[(size_t)(8 * i + 6) * SEQ] = (bf16)(x.w & 0xffffu); dst[(size_t)(8 * i + 7) * SEQ] = (bf16)(x.w >> 16); }
    }
}
__device__ __forceinline__ void p_sgu(Frame& F, int layer) {
    LAS float* vn = (LAS float*)(F.lds + RING_OFF);
    const bf16* P1 = WSP(bf16, WS_P1); bf16* Ya = WSP(bf16, WS_Y);
    const float* gain = F.in[3] + (size_t)layer * 256; const float* sw = F.in[4] + (size_t)layer * 4 * 128 * 128; const float* sb = F.in[5] + (size_t)layer * 4 * 128;
    const int lane = F.lane, wave = F.wave;
    for (int item = F.vcu; item < MC / 128; item += F.G) {
        const size_t r0 = (size_t)item * 128;
        __syncthreads();
        for (int rr = 0; rr < 16; ++rr) { const int r = wave * 16 + rr; const v2u raw = *(const v2u*)(P1 + (r0 + r) * P1W + C_V + 4 * lane);
            const float a = bflo(raw.x), b = bfhi(raw.x), c = bflo(raw.y), d = bfhi(raw.y);
            const float rstd = 1.0f / sqrtf(wave_sum((a * a + b * b) + (c * c + d * d), lane) * (1.f / 256.f) + EPS);
            const f32x4 gg = ((const f32x4*)gain)[lane];
            *(LAS f32x4*)(vn + r * 256 + 4 * lane) = (f32x4){a * rstd * gg.x, b * rstd * gg.y, c * rstd * gg.z, d * rstd * gg.w}; }
        __syncthreads();
        const int g = wave & 3, half = wave >> 2;
        for (int i = 0; i < 64; ++i) { const int t = 2 * i + half;
            const float* wrow = sw + ((size_t)g * 128 + t) * 128;
            const float w_lo = wrow[lane], w_hi = wrow[64 + lane];
            float acc = 0.f;
            for (int s = 0; s <= t; ++s) { const float w = (s < 64) ? rdlane(w_lo, s) : rdlane(w_hi, s - 64); acc += w * vn[s * 256 + g * 64 + lane]; }
            const float u = bf1(P1[(r0 + t) * P1W + C_U + g * 64 + lane]);
#ifdef ABL_SGUMIX
            acc = 0.f;
#endif
            Ya[(r0 + t) * 256 + g * 64 + lane] = (bf16)f2bf(u * (acc + sb[g * 128 + t])); }
    }
    __syncthreads();
}

__device__ __forceinline__ void p_cmpfin(Frame& F, int layer) {
    const int gw = F.vcu * NWAVES + F.wave, NGW = F.G * NWAVES, lane = F.lane;
    const float* UL = WSP(float, WS_UL); const float* bias = WSP(float, WS_BIAS1); bf16* KC = WSP(bf16, WS_KC);
    LAS float* w2l = (LAS float*)(F.lds + RING_OFF);
    __syncthreads();
    { const f32x4* src = (const f32x4*)(F.in[8] + (size_t)layer * 2 * 256 * 64);
#pragma unroll 4
      for (int i = F.tid; i < 2 * 256 * 64 / 4; i += NWAVES * 64) *(LAS f32x4*)(w2l + 4 * i) = src[i]; }
    __syncthreads();
    for (int it = gw; it < 2 * BC * 255; it += NGW) { const int kv = it / (BC * 255), r = it % (BC * 255), b = r / 255, m = r % 255;
        const LAS float* w2 = w2l + kv * 256 * 64;
        const float* U = UL + (size_t)(kv * 2048 + b * 256 + m) * 512; const float* L = U + 512 + 256;
        float hv[4];
#pragma unroll
        for (int q = 0; q < 4; ++q) hv[q] = pg8::gelu_tanh(U[64 * q + lane] + L[64 * q + lane] + bias[kv * 256 + 64 * q + lane]);
        float acc0 = 0.f, acc1 = 0.f;
#pragma unroll
        for (int q = 0; q < 4; ++q)
#pragma unroll 8
            for (int jj = 0; jj < 64; jj += 2) { acc0 += rdlane(hv[q], jj) * w2[(64 * q + jj) * 64 + lane]; acc1 += rdlane(hv[q], jj + 1) * w2[(64 * q + jj + 1) * 64 + lane]; }
        const float acc = acc0 + acc1;
        KC[((size_t)(kv * BC + b) * 256 + m) * 64 + lane] = (bf16)f2bf(acc);
        if (kv == 1) { WSP(bf16, WS_KCT)[((size_t)b * 64 + lane) * 256 + m] = (bf16)f2bf(acc); if (m == 254) WSP(bf16, WS_KCT)[((size_t)b * 64 + lane) * 256 + 255] = (bf16)0; }
        else if (m == 254) KC[((size_t)b * 256 + 255) * 64 + lane] = (bf16)0; }
    __syncthreads();
}

__device__ __forceinline__ void p_stick(Frame& F) {
    const int gw = F.vcu * NWAVES + F.wave, NGW = F.G * NWAVES, lane = F.lane;
    const bf16* P1 = WSP(bf16, WS_P1); bf16* Yb = WSP(bf16, WS_Y) + (size_t)MC * 256;
    for (int item = gw; item < BC * 4 * 64; item += NGW) { const int tb = item & 63, h = (item >> 6) & 3, b = item >> 8;
        const int t = tb * 64 + lane; const size_t row = (size_t)b * SEQ + t;
        unsigned q[32];
        { const v4u* qp = (const v4u*)(P1 + row * P1W + C_SBQ + h * 64);
#pragma unroll
          for (int i = 0; i < 8; ++i) { const v4u x = qp[i]; q[4 * i] = x.x; q[4 * i + 1] = x.y; q[4 * i + 2] = x.z; q[4 * i + 3] = x.w; } }
        float o[64];
#pragma unroll
        for (int d = 0; d < 64; ++d) o[d] = 0.f;
        float R = 0.f;
        const bf16* kb = P1 + (size_t)b * SEQ * P1W + C_SBK + h * 64; const bf16* vb = P1 + (size_t)b * SEQ * P1W + C_SBV + h * 64;
        for (int s = t - 1; s >= 0; --s) {
            if (R < -100.f) break;
            const v4u* kp = (const v4u*)(kb + (size_t)s * P1W); const v4u* vp = (const v4u*)(vb + (size_t)s * P1W);
            float z0 = 0.f, z1 = 0.f;
#pragma unroll
            for (int i = 0; i < 8; ++i) { const v4u k = kp[i]; z0 = dot2bf(k.x, q[4 * i], z0); z1 = dot2bf(k.y, q[4 * i + 1], z1); z0 = dot2bf(k.z, q[4 * i + 2], z0); z1 = dot2bf(k.w, q[4 * i + 3], z1); }
            const float z = (z0 + z1) * 0.125f;
            const float tt = 0.6931471805599453f * __builtin_amdgcn_logf(1.0f + fexp(-__builtin_fabsf(z)));
            const float lb = fminf(z, 0.f) - tt, l1m = fminf(-z, 0.f) - tt;
            const float a = fexp(lb + R); R += l1m;
#pragma unroll
            for (int i = 0; i < 8; ++i) { const v4u v = vp[i];
                o[8 * i] += a * bflo(v.x); o[8 * i + 1] += a * bfhi(v.x); o[8 * i + 2] += a * bflo(v.y); o[8 * i + 3] += a * bfhi(v.y);
                o[8 * i + 4] += a * bflo(v.z); o[8 * i + 5] += a * bfhi(v.z); o[8 * i + 6] += a * bflo(v.w); o[8 * i + 7] += a * bfhi(v.w); }
        }
        v4u* op = (v4u*)(Yb + row * 256 + h * 64);
#pragma unroll
        for (int i = 0; i < 8; ++i) op[i] = (v4u){pk2(o[8 * i], o[8 * i + 1]), pk2(o[8 * i + 2], o[8 * i + 3]), pk2(o[8 * i + 4], o[8 * i + 5]), pk2(o[8 * i + 6], o[8 * i + 7])};
    }
}

struct Soft { float mx, l; };
__device__ __forceinline__ float dotq(const LAS v4u* ql, const bf16* kp_) {
    const v4u* kp = (const v4u*)kp_; float z0 = 0.f, z1 = 0.f;
#pragma unroll
    for (int i = 0; i < 8; ++i) { const v4u k = kp[i]; const v4u q = ql[i]; z0 = dot2bf(k.x, q.x, z0); z1 = dot2bf(k.y, q.y, z1); z0 = dot2bf(k.z, q.z, z0); z1 = dot2bf(k.w, q.w, z1); }
    return (z0 + z1) * 0.125f;
}
__device__ __forceinline__ void axpy_row(float p, const bf16* vp_, float (&o)[64]) {
    const v4u* vp = (const v4u*)vp_;
#pragma unroll
    for (int i = 0; i < 8; ++i) { const v4u v = vp[i];
        o[8 * i] += p * bflo(v.x); o[8 * i + 1] += p * bfhi(v.x); o[8 * i + 2] += p * bflo(v.y); o[8 * i + 3] += p * bfhi(v.y);
        o[8 * i + 4] += p * bflo(v.z); o[8 * i + 5] += p * bfhi(v.z); o[8 * i + 6] += p * bflo(v.w); o[8 * i + 7] += p * bfhi(v.w); }
}
__device__ __forceinline__ void nsa_step(const LAS v4u* ql, const bf16* kp_, const bf16* vp_, Soft& S, float (&o)[64]) {
    const float s = dotq(ql, kp_);
    if (s > S.mx) { const float sc = fexp(S.mx - s); S.l *= sc;
#pragma unroll
        for (int d = 0; d < 64; ++d) o[d] *= sc;
        S.mx = s; }
    const float p = fexp(s - S.mx); S.l += p;
    asm volatile("" ::: "memory");
    axpy_row(p, vp_, o);
}
__device__ __forceinline__ void nsa_accum(bf16* yrow, bool first, float sc, const float (&o)[64]) {
    v4u* op = (v4u*)yrow;
#pragma unroll
    for (int i = 0; i < 8; ++i) { v4u old = (v4u){0u, 0u, 0u, 0u}; if (!first) old = op[i];
        op[i] = (v4u){pk2(bflo(old.x) + sc * o[8 * i], bfhi(old.x) + sc * o[8 * i + 1]), pk2(bflo(old.y) + sc * o[8 * i + 2], bfhi(old.y) + sc * o[8 * i + 3]),
                      pk2(bflo(old.z) + sc * o[8 * i + 4], bfhi(old.z) + sc * o[8 * i + 5]), pk2(bflo(old.w) + sc * o[8 * i + 6], bfhi(old.w) + sc * o[8 * i + 7])}; }
}
__device__ __forceinline__ void p_nsa(Frame& F) {
    const int gw = F.vcu * NWAVES + F.wave, NGW = F.G * NWAVES, lane = F.lane;
    const bf16* P1 = WSP(bf16, WS_P1); const bf16* KC = WSP(bf16, WS_KC); bf16* Yc = WSP(bf16, WS_Y) + (size_t)2 * MC * 256;
    LAS float* imp = (LAS float*)(F.lds + RING_OFF + F.wave * 4096);
    LAS v4u* ql = (LAS v4u*)(F.lds + RING_OFF + 32768 + F.wave * 9216 + lane * 144);
    const int qi = lane >> 2, h = lane & 3;
    for (int item = gw; item < BC * 256; item += NGW) { const int b = item >> 8, tg = item & 255;
        const int t = tg * 16 + qi; const size_t row = (size_t)b * SEQ + t; const bf16* prow = P1 + row * P1W;
        { const v4u* qp = (const v4u*)(prow + C_CQ + h * 64);
#pragma unroll
          for (int i = 0; i < 8; ++i) ql[i] = qp[i]; }
        const float g0 = bf1(prow[C_CG + h * 3]), g1 = bf1(prow[C_CG + h * 3 + 1]), g2 = bf1(prow[C_CG + h * 3 + 2]);
        bf16* yrow = Yc + row * 256 + h * 64;
        float o[64];
        for (int i = lane; i < 1024; i += 64) imp[i] = 0.f;
        const int nv = t >= 31 ? ((t - 31) >> 4) + 1 : 0; const int nvmax = (tg * 16 + 15 >= 31) ? ((tg * 16 + 15 - 31) >> 4) + 1 : 0;
        const bf16* kc = KC + (size_t)(0 * BC + b) * 256 * 64; const bf16* vc = KC + (size_t)(1 * BC + b) * 256 * 64;
        { float mx = -INFINITY, l = 0.f;
          for (int m = 0; m < nvmax; ++m) { const float s = dotq(ql, kc + m * 64); if (m < nv) { if (s > mx) { l *= fexp(mx - s); mx = s; } l += fexp(s - mx); } }
          const float rl = l > 0.f ? 1.0f / l : 0.f;
#pragma unroll
          for (int d = 0; d < 64; ++d) o[d] = 0.f;
          for (int m = 0; m < nvmax; ++m) { const float s = dotq(ql, kc + m * 64); const float p = (m < nv) ? fexp(s - mx) * rl : 0.f;
              asm volatile("" ::: "memory");
              axpy_row(p, vc + m * 64, o);
              float P = p + __builtin_bit_cast(float, bperm(lane ^ 1, __builtin_bit_cast(int, p))); P += __builtin_bit_cast(float, bperm(lane ^ 2, __builtin_bit_cast(int, P)));
              if (h == 0) { const int j0 = m >> 2; const bool edge = (m & 3) == 3; imp[qi * 64 + j0] += edge ? 0.5f * P : P; if (edge) imp[qi * 64 + j0 + 1] += 0.5f * P; } }
          nsa_accum(yrow, true, g0, o); }
        unsigned long long mask = 0ull;
        { const int cur = t >> 6, nvb = cur + 1;
          if (h == 0) {
              if (nvb <= 16) mask = (1ull << nvb) - 1ull;
              else { mask = 1ull | (1ull << cur);
                  for (int r = 0; r < 14; ++r) { int best = -1; float bv = -1.f;
                      for (int j = 1; j < cur; ++j) { const float v = imp[qi * 64 + j]; if (!((mask >> j) & 1ull) && v > bv) { bv = v; best = j; } }
                      mask |= 1ull << best; } } }
          const unsigned mlo = (unsigned)bperm(lane & ~3, (int)(unsigned)mask), mhi = (unsigned)bperm(lane & ~3, (int)(unsigned)(mask >> 32));
          mask = ((unsigned long long)mhi << 32) | mlo; }
        { Soft S{-INFINITY, 0.f};
#pragma unroll
          for (int d = 0; d < 64; ++d) o[d] = 0.f;
          const bf16* kb = P1 + (size_t)b * SEQ * P1W + C_KSLC; const bf16* vb = P1 + (size_t)b * SEQ * P1W + C_VSLC;
          unsigned long long mm = mask;
          while (mm) { const int j = __builtin_ctzll(mm); mm &= mm - 1ull;
              for (int kk = 0; kk < 64; ++kk) { const int sp = j * 64 + kk; if (sp > t) break; nsa_step(ql, kb + (size_t)sp * P1W, vb + (size_t)sp * P1W, S, o); } }
          nsa_accum(yrow, false, g1 / S.l, o); }
        { Soft S{-INFINITY, 0.f};
#pragma unroll
          for (int d = 0; d < 64; ++d) o[d] = 0.f;
          const bf16* kb = P1 + (size_t)b * SEQ * P1W + C_KWIN; const bf16* vb = P1 + (size_t)b * SEQ * P1W + C_VWIN;
          for (int i = 0; i < 512; ++i) { const int sp = t - 511 + i; if (sp >= 0) nsa_step(ql, kb + (size_t)sp * P1W, vb + (size_t)sp * P1W, S, o); }
          nsa_accum(yrow, false, g2 / S.l, o); }
    }
}

__device__ __forceinline__ int moe_table(Frame& F, int jmoe, int c, int r) {
    LAS int* tab = (LAS int*)(F.lds + TAB_OFF);
    __syncthreads();
    if (F.tid < 8) tab[176 + F.tid] = (int)__hip_atomic_load(F.ctl + CW_CNT + jmoe * 32 + (c * 2 + r) * 8 + F.tid, __ATOMIC_RELAXED, __HIP_MEMORY_SCOPE_AGENT);
    __syncthreads();
    if (F.tid == 0) { int base = 0, T = 0;
        for (int e = 0; e < 8; ++e) { const int cnt = tab[176 + e];
            const int nt = (cnt + 255) >> 8; tab[160 + e] = base; for (int i = 0; i < nt && T + i < 160; ++i) tab[T + i] = e; T += nt; base += nt * 256; }
        tab[168] = T < 136 ? T : 136; }
    __syncthreads();
    return tab[168];
}
__device__ __forceinline__ void p_gather(Frame& F, int jmoe, int c, int r, int nbusy = 0) {
    if (F.bx < nbusy) return;
    moe_table(F, jmoe, c, r);
    const LAS int* tab = (const LAS int*)(F.lds + TAB_OFF);
    const int gw = (F.bx - nbusy) * NWAVES + F.wave, NGW = (F.G - nbusy) * NWAVES, lane = F.lane;
    const v4i* route = WSP(v4i, WS_ROUTE); int* tokmap = WSP(int, WS_TOKMAP) + (c * 2 + r) * SLOTS; float* wslot = WSP(float, WS_WSLOT) + (c * 2 + r) * SLOTS;
    const bf16* HN = WSP(bf16, WS_HN); bf16* XG = WSP(bf16, WS_XG);
    unsigned* cur = F.ctl + CW_CUR + jmoe * 32 + (c * 2 + r) * 8;
    for (int tg = gw; tg < MC / 16; tg += NGW) {
        const int m = c * MC + tg * 16 + (lane & 15); const v4i rt = route[m];
        const int e = lane < 16 ? (r ? rt.y : rt.x) : -1; const float w = __builtin_bit_cast(float, r ? rt.w : rt.z);
        unsigned long long bal[8]; int mycnt = 0;
#pragma unroll
        for (int ee = 0; ee < 8; ++ee) { bal[ee] = __builtin_amdgcn_ballot_w64(e == ee); if (lane == ee) mycnt = __builtin_popcountll(bal[ee]); }
        unsigned basep = 0; if (lane < 8 && mycnt > 0) basep = atomicAdd(cur + lane, (unsigned)mycnt);
        const int mybase = bperm(e < 0 ? 0 : e, (int)basep);
        int pos = 0;
#pragma unroll
        for (int ee = 0; ee < 8; ++ee) if (e == ee) pos = mybase + __builtin_popcountll(bal[ee] & ((1ull << lane) - 1ull));
        int slot = 0;
        if (lane < 16) { slot = tab[160 + e] + pos; tokmap[slot] = m; wslot[slot] = w; }
#pragma unroll
        for (int i0 = 0; i0 < 16; i0 += 4) { v4u x[8];
#pragma unroll
            for (int i = 0; i < 4; ++i) { const int mi = __builtin_amdgcn_readlane(m, i0 + i); const v4u* src = (const v4u*)(HN + (size_t)mi * DM); x[2 * i] = src[lane]; x[2 * i + 1] = src[64 + lane]; }
#pragma unroll
            for (int i = 0; i < 4; ++i) { const int si = __builtin_amdgcn_readlane(slot, i0 + i); v4u* dst = (v4u*)(XG + (size_t)si * DM); dst[lane] = x[2 * i]; dst[64 + lane] = x[2 * i + 1]; } }
    }
}

typedef float f32x16 __attribute__((ext_vector_type(16)));
typedef short bf16x8v __attribute__((ext_vector_type(8)));
typedef float f32x2v __attribute__((ext_vector_type(2)));
constexpr int NSA_K = 0, NSA_V = 8192, NSA_BUF = 17408, NSA_STAGE = 2 * NSA_BUF, NSA_IMP = 69632, NSA_CARRY = 86016, NSA_SEL = 103424, NSA_WSF = 103936;
constexpr float NSA_C2 = 0.125f * 1.4426950408889634f;
__device__ __forceinline__ unsigned cvtpk(float lo, float hi) { f32x2v v = {lo, hi}; bf16x2_t b = __builtin_convertvector(v, bf16x2_t); return __builtin_bit_cast(unsigned, b); }
__device__ __forceinline__ float partner32(float v, int lane) { return __builtin_bit_cast(float, __builtin_amdgcn_ds_bpermute((lane ^ 32) << 2, __builtin_bit_cast(int, v))); }
__device__ __forceinline__ void nsa_load(v4u& kx, v4u& vx, const bf16* Kg, int kp, const bf16* Vg, int vp, int tid) {
    kx = *(const v4u*)(Kg + (size_t)(tid & 63) * kp + (tid >> 6) * 8); vx = *(const v4u*)(Vg + (size_t)(tid >> 3) * vp + (tid & 7) * 8);
}
__device__ __forceinline__ void nsa_store(LAS unsigned char* lds, const v4u& kx, const v4u& vx, int tid) {
    *(LAS v4u*)(lds + NSA_K + (tid >> 6) * 1024 + (tid & 63) * 16) = kx; *(LAS v4u*)(lds + NSA_V + (tid >> 3) * 144 + (tid & 7) * 16) = vx;
}
__device__ __forceinline__ void nsa_qk(const LAS unsigned char* lds, const bf16x8v (&qr)[4], f32x16& p0, f32x16& p1, int r32, int hi) {
#pragma unroll
    for (int i = 0; i < 16; ++i) { p0[i] = 0.f; p1[i] = 0.f; }
#pragma unroll
    for (int d0 = 0; d0 < 4; ++d0) {
        const bf16x8v k0 = *(const LAS bf16x8v*)(lds + NSA_K + (2 * d0 + hi) * 1024 + r32 * 16);
        const bf16x8v k1 = *(const LAS bf16x8v*)(lds + NSA_K + (2 * d0 + hi) * 1024 + 512 + r32 * 16);
        p0 = __builtin_amdgcn_mfma_f32_32x32x16_bf16(k0, qr[d0], p0, 0, 0, 0);
        p1 = __builtin_amdgcn_mfma_f32_32x32x16_bf16(k1, qr[d0], p1, 0, 0, 0);
    }
#pragma unroll
    for (int i = 0; i < 16; ++i) { p0[i] *= NSA_C2; p1[i] *= NSA_C2; }
}
__device__ __forceinline__ void nsa_mask(f32x16& p0, f32x16& p1, int hi, int hiL, int loL, bool rowok, bool full  ) {
    if (full) {
#pragma unroll
        for (int i = 0; i < 16; ++i) { p0[i] = rowok ? p0[i] : -INFINITY; p1[i] = rowok ? p1[i] : -INFINITY; }
        return; }
#pragma unroll
    for (int i = 0; i < 16; ++i) { const int kk = (i & 3) + 8 * (i >> 2) + 4 * hi;
        if (!(rowok && kk <= hiL && kk > loL)) p0[i] = -INFINITY;
        if (!(rowok && kk + 32 <= hiL && kk + 32 > loL)) p1[i] = -INFINITY; }
}
__device__ __forceinline__ float nsa_max32(const f32x16& p0, const f32x16& p1) {
    float a = fmaxf(fmaxf(p0[0], p0[1]), p1[0]), b = fmaxf(fmaxf(p0[2], p0[3]), p1[1]); a = fmaxf(fmaxf(a, p1[2]), p1[3]);
#pragma unroll
    for (int i = 4; i < 16; i += 4) { a = fmaxf(fmaxf(a, p0[i]), p0[i + 1]); b = fmaxf(fmaxf(b, p0[i + 2]), p0[i + 3]); a = fmaxf(fmaxf(a, p1[i]), p1[i + 1]); b = fmaxf(fmaxf(b, p1[i + 2]), p1[i + 3]); }
    return fmaxf(a, b);
}
__device__ __forceinline__ void nsa_pv(const LAS unsigned char* lds, const f32x16& p0, const f32x16& p1, f32x16 (&o)[2], int r32, int hi) {
    bf16x8v pa[4];
#pragma unroll
    for (int s = 0; s < 2; ++s) {
        const v4u a = (v4u){cvtpk(p0[8 * s], p0[8 * s + 1]), cvtpk(p0[8 * s + 2], p0[8 * s + 3]), cvtpk(p0[8 * s + 4], p0[8 * s + 5]), cvtpk(p0[8 * s + 6], p0[8 * s + 7])};
        const v4u b = (v4u){cvtpk(p1[8 * s], p1[8 * s + 1]), cvtpk(p1[8 * s + 2], p1[8 * s + 3]), cvtpk(p1[8 * s + 4], p1[8 * s + 5]), cvtpk(p1[8 * s + 6], p1[8 * s + 7])};
        pa[s] = __builtin_bit_cast(bf16x8v, a); pa[2 + s] = __builtin_bit_cast(bf16x8v, b); }
#pragma unroll
    for (int db = 0; db < 2; ++db) { const LAS unsigned char* vrow = lds + NSA_V + (32 * db + r32) * 144;
#pragma unroll
        for (int ks = 0; ks < 4; ++ks) {
            const int kb = (ks >> 1) * 32 + (ks & 1) * 16 + 4 * hi;
            const v2u lo = *(const LAS v2u*)(vrow + kb * 2), hh = *(const LAS v2u*)(vrow + (kb + 8) * 2);
            const v4u vv = (v4u){lo.x, lo.y, hh.x, hh.y};
            o[db] = __builtin_amdgcn_mfma_f32_32x32x16_bf16(pa[ks], __builtin_bit_cast(bf16x8v, vv), o[db], 0, 0, 0); } }
}
__device__ __forceinline__ void nsa_rowscale(f32x16 (&o)[2], LAS float* wsf, float f, int r32, int hi) {
    if (hi == 0) wsf[r32] = f;
#pragma unroll
    for (int g = 0; g < 4; ++g) { const f32x4 w = *(const LAS f32x4*)(wsf + 8 * g + 4 * hi);
#pragma unroll
        for (int e = 0; e < 4; ++e) { o[0][4 * g + e] *= w[e]; o[1][4 * g + e] *= w[e]; } }
}
__device__ __forceinline__ void nsa_rowaccum(bf16* dst, bool first, const f32x16 (&o)[2], LAS float* wsf, float f, int r32, int hi) {
    if (hi == 0) wsf[r32] = f;
    bf16 old[32];
#pragma unroll
    for (int i = 0; i < 16; ++i) { const bf16* p = dst + (i >> 2) * 512 + (i & 3) * 64; old[2 * i] = first ? (bf16)0 : p[0]; old[2 * i + 1] = first ? (bf16)0 : p[32]; }
#pragma unroll
    for (int g = 0; g < 4; ++g) { const f32x4 w = *(const LAS f32x4*)(wsf + 8 * g + 4 * hi);
#pragma unroll
        for (int e = 0; e < 4; ++e) { bf16* p = dst + g * 512 + e * 64; const int i = 4 * g + e;
            p[0] = (bf16)f2bf(o[0][i] * w[e] + bf1(old[2 * i])); p[32] = (bf16)f2bf(o[1][i] * w[e] + bf1(old[2 * i + 1])); } }
}
__device__ __forceinline__ void nsa_softmax_pv(const LAS unsigned char* lds, f32x16& p0, f32x16& p1, float& m, float& l, f32x16 (&o)[2], LAS float* wsf, int lane, int r32, int hi) {
    float mt = nsa_max32(p0, p1); mt = fmaxf(mt, partner32(mt, lane));
    const float mn = fmaxf(m, mt);
    if (__builtin_amdgcn_ballot_w64(mn > m) != 0ull) { const float f = __builtin_amdgcn_exp2f(m - mn); l *= f; nsa_rowscale(o, wsf, f, r32, hi); m = mn; }
    float s = 0.f;
#pragma unroll
    for (int i = 0; i < 16; ++i) { p0[i] = __builtin_amdgcn_exp2f(p0[i] - m); p1[i] = __builtin_amdgcn_exp2f(p1[i] - m); s += p0[i] + p1[i]; }
    l += s;
    nsa_pv(lds, p0, p1, o, r32, hi);
}
__device__ __forceinline__ void p_nsa2(Frame& F) {
    const int tid = F.tid, lane = F.lane, wave = F.wave, r32 = lane & 31, hi = lane >> 5;
    LAS unsigned char* lds = F.lds + RING_OFF;
    LAS float* imp = (LAS float*)(lds + NSA_IMP); LAS float* carry = (LAS float*)(lds + NSA_CARRY);
    LAS unsigned long long* selm = (LAS unsigned long long*)(lds + NSA_SEL); LAS float* wsf = (LAS float*)(lds + NSA_WSF) + wave * 32;
    const bf16* P1 = WSP(bf16, WS_P1); const bf16* KC = WSP(bf16, WS_KC); const bf16* KCT = WSP(bf16, WS_KCT); const bf16* VT = WSP(bf16, WS_VT);
    bf16* Yc = WSP(bf16, WS_Y) + (size_t)2 * MC * 256;
    const int ql = r32 >> 2, h = r32 & 3, tq = 8 * wave + ql;
    int par = 0;
    for (int it = 0; it < 2; ++it) {
        for (int pair = F.vcu; pair < BC * 32; pair += F.G) {
            const int b = pair >> 5, sx = pair & 31, qb = it ? 63 - sx : sx;
            const int t = qb * 64 + tq; const size_t row = (size_t)b * SEQ + t; const bf16* prow = P1 + row * P1W;
            bf16x8v qr[4];
#pragma unroll
            for (int d0 = 0; d0 < 4; ++d0) qr[d0] = *(const bf16x8v*)(prow + C_CQ + h * 64 + d0 * 16 + hi * 8);
            const float g0 = bf1(prow[C_CG + h * 3]), g1 = bf1(prow[C_CG + h * 3 + 1]), g2 = bf1(prow[C_CG + h * 3 + 2]);
            f32x16 o[2], p0, p1;
            bf16* ydst = Yc + ((size_t)b * SEQ + qb * 64 + 8 * wave + hi) * 256 + r32;
            __syncthreads();
            for (int i = tid; i < 64 * 64; i += 512) imp[i] = 0.f;
            for (int i = tid; i < 64 * 68; i += 512) carry[i] = 0.f;
            const int nct = (4 * qb + 3 + 63) >> 6;
            const int mlim = t >= 31 ? ((t - 31) >> 4) : -1;
            const bf16* kcb = KC + (size_t)b * 256 * 64; const bf16* vcb = KCT + (size_t)b * 64 * 256;
            float m = -1e30f, l = 0.f;
            v4u kx, vx;
            nsa_load(kx, vx, kcb, 64, vcb, 256, tid);
            for (int ti = 0; ti < nct; ++ti) {
                LAS unsigned char* tb = lds + par * NSA_STAGE; par ^= 1;
                nsa_store(tb, kx, vx, tid); __syncthreads();
                { const int tn = ti + 1 < nct ? ti + 1 : 0; nsa_load(kx, vx, kcb + (size_t)tn * 64 * 64, 64, vcb + tn * 64, 256, tid); }
                nsa_qk(tb, qr, p0, p1, r32, hi); nsa_mask(p0, p1, hi, mlim - 64 * ti, -1, true, false);
                float mt = nsa_max32(p0, p1); mt = fmaxf(mt, partner32(mt, lane));
                const float mn = fmaxf(m, mt); l *= __builtin_amdgcn_exp2f(m - mn); m = mn;
                float s = 0.f;
#pragma unroll
                for (int i = 0; i < 16; ++i) s += __builtin_amdgcn_exp2f(p0[i] - m) + __builtin_amdgcn_exp2f(p1[i] - m);
                l += s; }
            { const float lt = l + partner32(l, lane); const float rl = lt > 0.f ? 1.0f / lt : 0.f;
#pragma unroll
              for (int i = 0; i < 16; ++i) { o[0][i] = 0.f; o[1][i] = 0.f; }
              for (int ti = 0; ti < nct; ++ti) {
                  LAS unsigned char* tb = lds + par * NSA_STAGE; par ^= 1;
                  nsa_store(tb, kx, vx, tid); __syncthreads();
                  if (ti + 1 < nct) nsa_load(kx, vx, kcb + (size_t)(ti + 1) * 64 * 64, 64, vcb + (ti + 1) * 64, 256, tid);
                  nsa_qk(tb, qr, p0, p1, r32, hi); nsa_mask(p0, p1, hi, mlim - 64 * ti, -1, true, false);
#pragma unroll
                  for (int i = 0; i < 16; ++i) { p0[i] = __builtin_amdgcn_exp2f(p0[i] - m) * rl; p1[i] = __builtin_amdgcn_exp2f(p1[i] - m) * rl; }
#pragma unroll
                  for (int kt = 0; kt < 2; ++kt)
#pragma unroll
                      for (int g = 0; g < 4; ++g) { const f32x16& pp = kt ? p1 : p0;
                          float A = pp[4 * g] + pp[4 * g + 1] + pp[4 * g + 2] + 0.5f * pp[4 * g + 3], B = 0.5f * pp[4 * g + 3];
                          A += __builtin_bit_cast(float, bperm(lane ^ 1, __builtin_bit_cast(int, A))); A += __builtin_bit_cast(float, bperm(lane ^ 2, __builtin_bit_cast(int, A)));
                          B += __builtin_bit_cast(float, bperm(lane ^ 1, __builtin_bit_cast(int, B))); B += __builtin_bit_cast(float, bperm(lane ^ 2, __builtin_bit_cast(int, B)));
                          if (h == 0) { const int j = 16 * ti + 8 * kt + 2 * g + hi; imp[tq * 64 + j] = A; carry[tq * 68 + j + 1] = B; } }
                  nsa_pv(tb, p0, p1, o, r32, hi); }
              nsa_rowaccum(ydst, true, o, wsf, g0, r32, hi); }
            __syncthreads();
            { const int q = tid >> 3, sub = tid & 7; unsigned long long mask;
              if (qb + 1 <= 16) mask = (1ull << (qb + 1)) - 1ull;
              else { mask = 1ull | (1ull << qb);
                  unsigned long long key[8];
#pragma unroll
                  for (int i = 0; i < 8; ++i) { const int j = sub * 8 + i; const float v = imp[q * 64 + j] + carry[q * 68 + j];
                      key[i] = (j >= 1 && j < qb) ? (((unsigned long long)__builtin_bit_cast(unsigned, v) << 32) | (unsigned)(63 - j)) : 0ull; }
                  for (int r = 0; r < 14; ++r) { unsigned long long best = key[0];
#pragma unroll
                      for (int i = 1; i < 8; ++i) best = key[i] > best ? key[i] : best;
#pragma unroll
                      for (int x = 1; x < 8; x <<= 1) { const unsigned lo = (unsigned)bperm(lane ^ x, (int)(unsigned)best), hh = (unsigned)bperm(lane ^ x, (int)(unsigned)(best >> 32));
                          const unsigned long long other = ((unsigned long long)hh << 32) | lo; best = other > best ? other : best; }
                      const int jb = 63 - (int)(best & 63ull); mask |= 1ull << jb;
#pragma unroll
                      for (int i = 0; i < 8; ++i) if (sub * 8 + i == jb) key[i] = 0ull; } }
              if (sub == 0) selm[q] = mask; }
            __syncthreads();
            const unsigned long long mysel = selm[tq];
            { const bf16* kb = P1 + (size_t)b * SEQ * P1W + C_KSLC; const bf16* vb = VT + (size_t)(0 * BC + b) * 64 * SEQ;
              m = -1e30f; l = 0.f;
#pragma unroll
              for (int i = 0; i < 16; ++i) { o[0][i] = 0.f; o[1][i] = 0.f; }
              v4u kx2, vx2;
              nsa_load(kx, vx, kb, P1W, vb, SEQ, tid); if (qb >= 1) nsa_load(kx2, vx2, kb + (size_t)64 * P1W, P1W, vb + 64, SEQ, tid);
              for (int j = 0; j <= qb; j += 2) {
                  const bool two = j + 1 <= qb;
                  LAS unsigned char* tb = lds + par * NSA_STAGE; par ^= 1;
                  nsa_store(tb, kx, vx, tid); if (two) nsa_store(tb + NSA_BUF, kx2, vx2, tid);
                  __syncthreads();
                  if (j + 2 <= qb) nsa_load(kx, vx, kb + (size_t)(j + 2) * 64 * P1W, P1W, vb + (j + 2) * 64, SEQ, tid);
                  if (j + 3 <= qb) nsa_load(kx2, vx2, kb + (size_t)(j + 3) * 64 * P1W, P1W, vb + (j + 3) * 64, SEQ, tid);
                  { const bool rowsel = ((mysel >> j) & 1ull) != 0ull;
                    if (__builtin_amdgcn_ballot_w64(rowsel) != 0ull) {
                        nsa_qk(tb, qr, p0, p1, r32, hi); nsa_mask(p0, p1, hi, j == qb ? tq : 63, -1, rowsel, j < qb);
                        nsa_softmax_pv(tb, p0, p1, m, l, o, wsf, lane, r32, hi); } }
                  if (two) { const bool rowsel = ((mysel >> (j + 1)) & 1ull) != 0ull;
                    if (__builtin_amdgcn_ballot_w64(rowsel) != 0ull) {
                        nsa_qk(tb + NSA_BUF, qr, p0, p1, r32, hi); nsa_mask(p0, p1, hi, j + 1 == qb ? tq : 63, -1, rowsel, j + 1 < qb);
                        nsa_softmax_pv(tb + NSA_BUF, p0, p1, m, l, o, wsf, lane, r32, hi); } } }
              const float lt = l + partner32(l, lane);
              nsa_rowaccum(ydst, false, o, wsf, lt > 0.f ? g1 / lt : 0.f, r32, hi); }
            { const bf16* kb = P1 + (size_t)b * SEQ * P1W + C_KWIN; const bf16* vb = VT + (size_t)(1 * BC + b) * 64 * SEQ;
              m = -1e30f; l = 0.f;
#pragma unroll
              for (int i = 0; i < 16; ++i) { o[0][i] = 0.f; o[1][i] = 0.f; }
              const int j0 = qb >= 8 ? qb - 8 : 0;
              nsa_load(kx, vx, kb + (size_t)j0 * 64 * P1W, P1W, vb + j0 * 64, SEQ, tid);
              for (int j = j0; j <= qb; ++j) {
                  LAS unsigned char* tb = lds + par * NSA_STAGE; par ^= 1;
                  nsa_store(tb, kx, vx, tid); __syncthreads();
                  if (j < qb) nsa_load(kx, vx, kb + (size_t)(j + 1) * 64 * P1W, P1W, vb + (j + 1) * 64, SEQ, tid);
                  nsa_qk(tb, qr, p0, p1, r32, hi); nsa_mask(p0, p1, hi, j == qb ? tq : 63, j == qb - 8 ? tq : -1, true, j < qb && j != qb - 8);
                  nsa_softmax_pv(tb, p0, p1, m, l, o, wsf, lane, r32, hi); }
              const float lt = l + partner32(l, lane);
              nsa_rowaccum(ydst, false, o, wsf, lt > 0.f ? g2 / lt : 0.f, r32, hi); }
        }
    }
    __syncthreads();
}

constexpr int SB_HEAD_LDS = 17408;
constexpr int SB_FLAG = 4 * SB_HEAD_LDS;
constexpr float SB_LOG2E = 1.4426950408889634f, SB_STOP = -100.0f * 1.4426950408889634f;
__device__ __forceinline__ void p_stick2(Frame& F) {
    const int tid = F.tid, lane = F.lane, wave = F.wave, r32 = lane & 31, hi = lane >> 5, h = wave & 3, qh = wave >> 2;
    LAS unsigned char* lds = F.lds + RING_OFF; LAS unsigned char* hl = lds + h * SB_HEAD_LDS; LAS int* flag = (LAS int*)(lds + SB_FLAG);
    const bf16* P1 = WSP(bf16, WS_P1); const bf16* VT = WSP(bf16, WS_VT) + (size_t)2 * BC * 64 * SEQ;
    bf16* Yb = WSP(bf16, WS_Y) + (size_t)MC * 256;
    const int tq = 32 * qh + r32;
    for (int it = 0; it < 2; ++it)
        for (int pair = F.vcu; pair < BC * 32; pair += F.G) {
            const int b = pair >> 5, sx = pair & 31, qb = it ? 63 - sx : sx;
            const size_t row = (size_t)b * SEQ + qb * 64 + tq;
            bf16x8v qr[4];
#pragma unroll
            for (int d0 = 0; d0 < 4; ++d0) qr[d0] = *(const bf16x8v*)(P1 + row * P1W + C_SBQ + h * 64 + d0 * 16 + hi * 8);
            f32x16 o[2], p0, p1;
#pragma unroll
            for (int i = 0; i < 16; ++i) { o[0][i] = 0.f; o[1][i] = 0.f; }
            float R = 0.f;
            const int skey = tid & 63, sc = tid >> 6, sd = tid >> 3, skc = tid & 7;
            v4u kx[4], vx[4];
#define SB_LOAD(jj) do { const bf16* kg_ = P1 + ((size_t)b * SEQ + (jj) * 64 + skey) * P1W + C_SBK + sc * 8; \
                _Pragma("unroll") for (int hh = 0; hh < 4; ++hh) { kx[hh] = *(const v4u*)(kg_ + hh * 64); vx[hh] = *(const v4u*)(VT + ((size_t)(hh * BC + b) * 64 + sd) * SEQ + (jj) * 64 + skc * 8); } } while (0)
            SB_LOAD(qb);
            for (int j = qb; j >= 0; --j) {
                __syncthreads();
                if (j < qb) { int live = 0;
#pragma unroll
                    for (int w = 0; w < 8; ++w) live |= flag[w];
                    if (!live) break; }
#pragma unroll
                for (int hh = 0; hh < 4; ++hh) { *(LAS v4u*)(lds + hh * SB_HEAD_LDS + sc * 1024 + skey * 16) = kx[hh]; *(LAS v4u*)(lds + hh * SB_HEAD_LDS + NSA_V + sd * 144 + skc * 16) = vx[hh]; }
                __syncthreads();
                if (j > 0) SB_LOAD(j - 1);
                nsa_qk(hl, qr, p0, p1, r32, hi);
                const int lim = (j == qb) ? tq : 64;
                float Town[8], Tp[8];
#pragma unroll
                for (int kt = 0; kt < 2; ++kt) { f32x16& pp = kt ? p1 : p0;
#pragma unroll
                    for (int g = 0; g < 4; ++g) { float L[4];
#pragma unroll
                        for (int e = 0; e < 4; ++e) { const int kk = 32 * kt + 8 * g + 4 * hi + e; const float z = pp[4 * g + e];
                            const float tt = __builtin_amdgcn_logf(1.0f + __builtin_amdgcn_exp2f(-__builtin_fabsf(z)));
                            const float lb = fminf(z, 0.f) - tt; const bool ok = kk < lim;
                            L[e] = ok ? lb - z : 0.f; pp[4 * g + e] = ok ? lb : -INFINITY; }
                        const float E2 = L[3], E1 = E2 + L[2], E0 = E1 + L[1];
                        pp[4 * g + 2] += E2; pp[4 * g + 1] += E1; pp[4 * g] += E0;
                        Town[4 * kt + g] = E0 + L[0]; } }
#pragma unroll
                for (int k = 0; k < 8; ++k) Tp[k] = partner32(Town[k], lane);
                float suf = R;
#pragma unroll
                for (int k = 7; k >= 0; --k) { const float add = suf + (hi == 0 ? Tp[k] : 0.f); f32x16& pp = (k >> 2) ? p1 : p0; const int g = k & 3;
#pragma unroll
                    for (int e = 0; e < 4; ++e) pp[4 * g + e] = __builtin_amdgcn_exp2f(pp[4 * g + e] + add);
                    suf += Town[k] + Tp[k]; }
                R = suf;
                nsa_pv(hl, p0, p1, o, r32, hi);
                const bool alive = R >= SB_STOP;
                const unsigned long long bal = __builtin_amdgcn_ballot_w64(alive);
                if (lane == 0) flag[wave] = bal != 0ull ? 1 : 0;
            }
            { bf16* dst = Yb + ((size_t)b * SEQ + qb * 64 + 32 * qh + 4 * hi) * 256 + h * 64 + r32;
#pragma unroll
              for (int i = 0; i < 16; ++i) { dst[((i & 3) + 8 * (i >> 2)) * 256] = (bf16)f2bf(o[0][i]); dst[((i & 3) + 8 * (i >> 2)) * 256 + 32] = (bf16)f2bf(o[1][i]); } }
        }
#undef SB_LOAD
    __syncthreads();
}

__device__ __forceinline__ void p_sgu2(Frame& F, int layer) {
    LAS unsigned char* vnT = F.lds + RING_OFF;
    const bf16* P1 = WSP(bf16, WS_P1); bf16* Ya = WSP(bf16, WS_Y);
    const float* gain = F.in[3] + (size_t)layer * 256; const float* sw = F.in[4] + (size_t)layer * 4 * 128 * 128; const float* sb = F.in[5] + (size_t)layer * 4 * 128;
    const int lane = F.lane, wave = F.wave, r32 = lane & 31, hi = lane >> 5, g = wave & 3, db = wave >> 2;
    for (int item = F.vcu; item < MC / 128; item += F.G) {
        const size_t r0 = (size_t)item * 128;
        __syncthreads();
        { const f32x4 gg = ((const f32x4*)gain)[lane];
          for (int rr = 0; rr < 16; rr += 2) { const int r = wave * 16 + rr;
              const v2u ra = *(const v2u*)(P1 + (r0 + r) * P1W + C_V + 4 * lane), rb = *(const v2u*)(P1 + (r0 + r + 1) * P1W + C_V + 4 * lane);
              const float a0 = bflo(ra.x), a1 = bfhi(ra.x), a2 = bflo(ra.y), a3 = bfhi(ra.y), b0 = bflo(rb.x), b1 = bfhi(rb.x), b2 = bflo(rb.y), b3 = bfhi(rb.y);
              const float sa = 1.0f / sqrtf(wave_sum((a0 * a0 + a1 * a1) + (a2 * a2 + a3 * a3), lane) * (1.f / 256.f) + EPS);
              const float sb_ = 1.0f / sqrtf(wave_sum((b0 * b0 + b1 * b1) + (b2 * b2 + b3 * b3), lane) * (1.f / 256.f) + EPS);
              LAS unsigned* q = (LAS unsigned*)(vnT + (4 * lane) * 272 + r * 2);
              q[0] = pk2(a0 * sa * gg.x, b0 * sb_ * gg.x); q[68] = pk2(a1 * sa * gg.y, b1 * sb_ * gg.y); q[136] = pk2(a2 * sa * gg.z, b2 * sb_ * gg.z); q[204] = pk2(a3 * sa * gg.w, b3 * sb_ * gg.w); } }
        __syncthreads();
        const int ch = g * 64 + db * 32 + r32;
        for (int tb = 0; tb < 4; ++tb) {
            f32x16 acc;
#pragma unroll
            for (int i = 0; i < 16; ++i) acc[i] = 0.f;
            const int t = 32 * tb + r32; const float* wrow = sw + ((size_t)g * 128 + t) * 128;
            f32x4 wq[8][2];
#pragma unroll
            for (int ks = 0; ks < 8; ++ks) if (ks < 2 * tb + 2) { wq[ks][0] = *(const f32x4*)(wrow + 16 * ks + 8 * hi); wq[ks][1] = *(const f32x4*)(wrow + 16 * ks + 8 * hi + 4); }
#pragma unroll
            for (int ks = 0; ks < 8; ++ks) if (ks < 2 * tb + 2) {
                const int s0 = 16 * ks + 8 * hi;
                const f32x4 w0 = wq[ks][0], w1 = wq[ks][1];
                const v4u a = (v4u){pk2(s0 <= t ? w0.x : 0.f, s0 + 1 <= t ? w0.y : 0.f), pk2(s0 + 2 <= t ? w0.z : 0.f, s0 + 3 <= t ? w0.w : 0.f),
                                    pk2(s0 + 4 <= t ? w1.x : 0.f, s0 + 5 <= t ? w1.y : 0.f), pk2(s0 + 6 <= t ? w1.z : 0.f, s0 + 7 <= t ? w1.w : 0.f)};
                const bf16x8v bfr = *(const LAS bf16x8v*)(vnT + ch * 272 + s0 * 2);
                acc = __builtin_amdgcn_mfma_f32_32x32x16_bf16(__builtin_bit_cast(bf16x8v, a), bfr, acc, 0, 0, 0); }
            float uu[16], bb[16];
#pragma unroll
            for (int i = 0; i < 16; ++i) { const int tt = 32 * tb + (i & 3) + 8 * (i >> 2) + 4 * hi; uu[i] = bf1(P1[(r0 + tt) * P1W + C_U + ch]); bb[i] = sb[g * 128 + tt]; }
#pragma unroll
            for (int i = 0; i < 16; ++i) { const int tt = 32 * tb + (i & 3) + 8 * (i >> 2) + 4 * hi;
                Ya[(r0 + tt) * 256 + ch] = (bf16)f2bf(uu[i] * (acc[i] + bb[i])); }
        }
    }
    __syncthreads();
}

struct Args { const float* in[20]; float* out; unsigned char* ws; int lo, hi, li, rep; };
#ifndef TILED_FFN1
#define TILED_FFN1 0
#endif
#ifndef PG8_ALIGN_EPI
#define PG8_ALIGN_EPI true
#endif
#ifndef PG8_SP2
#define PG8_SP2 true
#endif
#ifndef WGM_PROJ
#define WGM_PROJ PG8_WGM
#endif
#ifndef WGM_FFN1
#define WGM_FFN1 PG8_WGM
#endif
#ifndef WGM_FFN2
#define WGM_FFN2 PG8_WGM
#endif
#ifndef WGM_MOE1
#define WGM_MOE1 PG8_WGM
#endif
#ifndef WGM_MOE2
#define WGM_MOE2 PG8_WGM
#endif
#ifndef FFN_CHUNKS
#define FFN_CHUNKS 2
#endif
#ifndef REP_GEMM
#define REP_GEMM 1
#endif
#ifndef REP_STICK
#define REP_STICK 1
#endif
#ifndef REP_NSA
#define REP_NSA 1
#endif
#ifndef REP_SGU
#define REP_SGU 1
#endif
#ifndef REP_NORM
#define REP_NORM 1
#endif
template <class Epi, class Sched> __device__ __forceinline__ void run_gemm(Frame& F, const bf16* A, const bf16* Bt, int M, int N, int K, const Sched& S, Epi E, bool rotate = true, int tiled = 0) {
    const int nt_ = K / 64;
#ifdef PG8_KROT
    const int rot_ = rotate ? 2 * (((F.bx & 7) * (nt_ / 2)) / 8) : 0;
#else
    const int rot_ = 0;
#endif
    pg8::Gemm g{A, Bt, M, N, K + F.zs, F.tid, rot_ + F.zs, tiled + F.zs};
    if (F.rep) E.set_scale0();
    pg8::gemm_phase<Epi, Sched, PG8_ALIGN_EPI, PG8_SP2>(F.lds + RING_OFF, g, S, E);
}
__global__ void __launch_bounds__(NWAVES * 64, 2) mk_fwd(Args args) {
    extern __shared__ __attribute__((aligned(16))) unsigned char lds[];
    Frame F0;
    F0.lds = (LAS unsigned char*)lds;
    F0.tid = threadIdx.x; F0.lane = F0.tid & 63; F0.wave = __builtin_amdgcn_readfirstlane(F0.tid >> 6);
    F0.G = gridDim.x; F0.bx = blockIdx.x; F0.vcu = (F0.G % 8 == 0) ? (F0.bx % 8) * (F0.G / 8) + F0.bx / 8 : F0.bx; F0.zv = 0; F0.zs = 0;
    F0.rep = args.rep; F0.ws = args.ws; F0.ctl = (unsigned*)(args.ws + WS_CTL); F0.in = args.in; F0.out = args.out;
    for (int u = F0.tid; u < (LDS_BYTES - LDSCTL_OFF) / 4; u += NWAVES * 64) ((LAS unsigned*)(F0.lds + LDSCTL_OFF))[u] = 0u;
    __syncthreads();
    const int lo = args.lo, hi = args.hi;
    XcdBarrier bar; bar.bar = F0.ctl + CW_BAR + args.li * XCD_BAR_WORDS; bar.x = 0; bar.st = nullptr; bar.w = 0; bar.z = 0;
    if (hi - lo > 1) bar = xcd_barrier_post(F0.ctl + CW_BAR + args.li * XCD_BAR_WORDS, (volatile LAS unsigned*)(F0.lds + MISC_OFF) + 8);
    int step = 0;
#define STEP_BEGIN if (step >= lo && step < hi) { Frame F = F0; { int zv_, zs_; asm volatile("v_mov_b32 %0, 0" : "=v"(zv_)); asm volatile("s_mov_b32 %0, 0" : "=s"(zs_)); \
        F.zv = zv_; F.zs = zs_; F.lane = (int)__builtin_amdgcn_mbcnt_hi(~0u, __builtin_amdgcn_mbcnt_lo(~0u, (unsigned)zv_)); F.wave = F0.wave + zs_; F.tid = F.wave * 64 + F.lane; F.bx = F.bx + zs_; \
        F.vcu = F0.vcu + zs_; F.G = F0.G + zs_; F.lds = (LAS unsigned char*)lds + zs_; F.ws = F0.ws + zs_; F.ctl = F0.ctl + zs_; F.in = F0.in + zs_; F.out = F0.out + zs_; }
#ifdef PROBE_XBAR
#define STEP_END   if (step + 1 < hi) { unsigned zb_; asm volatile("v_mov_b32 %0, 0" : "=v"(zb_)); bar.z = zb_; xcd_barrier(bar); xcd_barrier(bar); } } ++step;
#else
#define STEP_END   if (step + 1 < hi) { unsigned zb_; asm volatile("v_mov_b32 %0, 0" : "=v"(zb_)); bar.z = zb_; xcd_barrier(bar); } } ++step;
#endif

    for (int layer = 0; layer < DEPTH; ++layer) {
        const int jj = layer >> 1;
        STEP_BEGIN
            p_convert(F, layer);
            p_norm<0>(F, layer == 0 ? F.in[0] : F.out, F.in[1] + (size_t)layer * DM, nullptr, 0);
        STEP_END
        for (int c = 0; c < NCHUNK; ++c) {
            STEP_BEGIN
                pg8::StaticOrder S; S.init(MC, NPROJ, F.G, F.bx, WGM_PROJ);
                pg8::EpiProj E{WSP(bf16, WS_P1), WSP(bf16, WS_G)};
                run_gemm(F, WSP(bf16, WS_HN) + (size_t)c * MC * DM, WSP(bf16, WS_WIN), MC, NPROJ, DM, S, E);
            STEP_END
            STEP_BEGIN
                p_prep(F);
            STEP_END
            STEP_BEGIN
                LAS int* tab = (LAS int*)(F.lds + TAB_OFF);
                __syncthreads(); if (F.tid < 16) tab[F.tid] = F.tid >> 3; __syncthreads();
                pg8::GroupedOrder S; S.so.init(2 * 2048, 512, F.G, F.bx); S.tile_e = tab; S.nN = 2;
                pg8::EpiF32 E{WSP(float, WS_UL), 512, 2};
                run_gemm(F, WSP(bf16, WS_KVC), WSP(bf16, WS_WC1), 2 * 2048, 512, DM, S, E);
                p_sgu2(F, layer);
                p_stick2(F);
            STEP_END
            STEP_BEGIN
                p_cmpfin(F, layer);
            STEP_END
            STEP_BEGIN
#ifdef OLD_NSA
                p_nsa(F);
#else
                p_nsa2(F);
#endif
            STEP_END
            STEP_BEGIN
                pg8::MergeOrder S; S.so.init(MC, DM, F.G, F.bx); S.nmt = MC / 256;
                pg8::EpiMerge E{WSP(bf16, WS_G), WSP(bf16, WS_MG), MC / 256};
                run_gemm(F, WSP(bf16, WS_Y), WSP(bf16, WS_WBR), 3 * MC, 3 * DM, 256, S, E);
            STEP_END
            STEP_BEGIN
                pg8::StaticOrder S; S.init(MC, DM, F.G, F.bx);
                const float* base = (layer == 0 ? F.in[0] : F.out) + (size_t)c * MC * DM;
                pg8::EpiResid E{base, F.out + (size_t)c * MC * DM, DM, 1.0f};
                run_gemm(F, WSP(bf16, WS_MG), WSP(bf16, WS_WOUT), MC, DM, DM, S, E);
            STEP_END
        }
        if ((layer & 1) == 0) {
            STEP_BEGIN
                p_norm<0>(F, F.out, F.in[11] + (size_t)layer * DM, nullptr, 0, Q8_HN, TILED_FFN1);
            STEP_END
            for (int c = 0; c < FFN_CHUNKS; ++c) {
                constexpr int MF = MTOK / FFN_CHUNKS;
                STEP_BEGIN
                    pg8::StaticOrder S; S.init(MF, NFF1, F.G, F.bx, WGM_FFN1);
                    pg8::EpiSwiGLU E{WSP(bf16, WS_HID), DFFP, nullptr, NFF1 / 256};
                    run_gemm(F, WSP(bf16, WS_HN) + (size_t)c * MF * DM, WSP(bf16, WS_WF1), MF, NFF1, DM, S, E, true, TILED_FFN1);
                STEP_END
                STEP_BEGIN
                    pg8::StaticOrder S; S.init(MF, DM, F.G, F.bx, WGM_FFN2);
                    pg8::EpiResid E{F.out + (size_t)c * MF * DM, F.out + (size_t)c * MF * DM, DM, 1.0f};
                    run_gemm(F, WSP(bf16, WS_HID), WSP(bf16, WS_WF2), MF, DM, DFFP, S, E);
                STEP_END
            }
        } else {
            STEP_BEGIN
                p_norm<1>(F, F.out, F.in[11] + (size_t)layer * DM, F.in[15] + (size_t)jj * DM * NEXP, jj, Q8_HN);
            STEP_END
#ifdef ABL_DENSE_MOE
            for (int e = 0; e < NEXP; ++e) {
                STEP_BEGIN
                    pg8::StaticOrder S; S.init(MTOK, NMOE1, F.G, F.bx);
                    pg8::EpiSwiGLU E{WSP(bf16, WS_SCR + 8 * MiB), DFE, WSP(float, WS_SCR + 4 * MiB) + (size_t)e * MTOK, NMOE1 / 256};
                    run_gemm(F, WSP(bf16, WS_HN), WSP(bf16, WS_WF1) + (size_t)e * NMOE1 * DM, MTOK, NMOE1, DM, S, E);
                STEP_END
                STEP_BEGIN
                    pg8::StaticOrder S; S.init(MTOK, DM, F.G, F.bx);
                    pg8::EpiResid E{F.out, F.out, DM, 1.0f};
                    run_gemm(F, WSP(bf16, WS_SCR + 8 * MiB), WSP(bf16, WS_WF2) + (size_t)e * DM * DFE, MTOK, DM, DFE, S, E);
                STEP_END
            }
#else
            STEP_BEGIN
                p_gather(F, jj, 0, 0);
            STEP_END
            for (int c = 0; c < NCHUNK; ++c)
                for (int r = 0; r < 2; ++r) {
                    STEP_BEGIN
                        const int T = moe_table(F, jj, c, r);
                        pg8::GroupedOrder S; S.so.init(T * 256, NMOE1, F.G, F.bx, WGM_MOE1); S.tile_e = (LAS int*)(F.lds + TAB_OFF); S.nN = NMOE1 / 256;
                        pg8::EpiSwiGLU E{WSP(bf16, WS_HIDM), DFE, WSP(float, WS_WSLOT) + (c * 2 + r) * SLOTS, NMOE1 / 256};
                        run_gemm(F, WSP(bf16, WS_XG), WSP(bf16, WS_WF1), T * 256, NMOE1, DM, S, E, false);
                    STEP_END
                    STEP_BEGIN
                        const int T = moe_table(F, jj, c, r);
                        pg8::GroupedOrder S; S.so.init(T * 256, DM, F.G, F.bx, WGM_MOE2); S.tile_e = (LAS int*)(F.lds + TAB_OFF); S.nN = DM / 256;
                        pg8::EpiScatter E{F.out, WSP(int, WS_TOKMAP) + (c * 2 + r) * SLOTS, DM / 256, 1.0f};
                        run_gemm(F, WSP(bf16, WS_HIDM), WSP(bf16, WS_WF2), T * 256, DM, DFE, S, E, false);
                        if (!F.rep && c * 2 + r < 3) p_gather(F, jj, (c * 2 + r + 1) >> 1, (c * 2 + r + 1) & 1, (T * (DM / 256)) % F.G);
                    STEP_END
                }
#endif
        }
    }
    STEP_BEGIN
        p_norm<2>(F, F.out, F.in[19], nullptr, 0);
    STEP_END
#undef STEP_BEGIN
#undef STEP_END
}

#ifndef MK_STEPS_PER_LAUNCH
#define MK_STEPS_PER_LAUNCH 1
#endif
extern "C" void kernel_launch(void* const* d_in, const int* in_sizes, int n_in, void* d_out, int out_size, void* d_ws, size_t ws_size, hipStream_t stream) {
    static int grid = 0;
    if (grid == 0) {
        if (n_in != 20 || in_sizes[0] != MTOK * DM || out_size != MTOK * DM || ws_size < WS_END) { fprintf(stderr, "kernel_launch: unexpected shapes (n_in %d, in0 %d, out %d, ws %zu)\n", n_in, n_in > 0 ? in_sizes[0] : -1, out_size, ws_size); grid = -1; return; }
        int dev = 0, cus = 0, per_cu = 0;
        if (hipGetDevice(&dev) != hipSuccess || hipDeviceGetAttribute(&cus, hipDeviceAttributeMultiprocessorCount, dev) != hipSuccess) { grid = -1; return; }
        if (hipFuncSetAttribute((const void*)mk_fwd, hipFuncAttributeMaxDynamicSharedMemorySize, LDS_BYTES) != hipSuccess) { fprintf(stderr, "kernel_launch: hipFuncSetAttribute failed\n"); grid = -1; return; }
        if (hipOccupancyMaxActiveBlocksPerMultiprocessor(&per_cu, (const void*)mk_fwd, NWAVES * 64, LDS_BYTES) != hipSuccess || per_cu < 1) fprintf(stderr, "kernel_launch: occupancy query reports %d\n", per_cu);
        (void)hipGetLastError();
        grid = cus;
    }
    if (grid < 0) return;
    if (hipMemsetAsync((char*)d_ws + WS_CTL, 0, CTL_ZERO_BYTES, stream) != hipSuccess) return;
    Args a{};
    for (int i = 0; i < 20; ++i) a.in[i] = (const float*)d_in[i];
    a.out = (float*)d_out; a.ws = (unsigned char*)d_ws; a.rep = 0;
    #ifdef ABL_DENSE_MOE
    constexpr int NSTEPS = 2 * (1 + NCHUNK * 8 + 3) + 2 * (1 + NCHUNK * 8 + 1 + NEXP * 2) + 1;
#else
    constexpr int NSTEPS = 2 * (1 + NCHUNK * 7 + 1 + 2 * FFN_CHUNKS) + 2 * (1 + NCHUNK * 7 + 2 + NCHUNK * 2 * 2) + 1;
#endif
    int li = 0;
#ifdef REPMASK
    static int kinds[256]; int ns = 0;
    for (int layer = 0; layer < DEPTH; ++layer) { kinds[ns++] = 0;
        for (int c = 0; c < NCHUNK; ++c) for (int q = 1; q <= 8; ++q) if (q != 5) kinds[ns++] = q;
        if ((layer & 1) == 0) { kinds[ns++] = 9; for (int c = 0; c < FFN_CHUNKS; ++c) { kinds[ns++] = 10; kinds[ns++] = 11; } }
        else { kinds[ns++] = 12; kinds[ns++] = 17; for (int c = 0; c < NCHUNK * 2; ++c) { kinds[ns++] = 14; kinds[ns++] = 13; } } }
    kinds[ns++] = 16;
    for (int s = 0; s < NSTEPS; ++s) { const int reps = ((REPMASK >> kinds[s]) & 1) ? 2 : 1;
        for (int r = 0; r < reps; ++r) { a.lo = s; a.hi = s + 1; a.li = 0; a.rep = r;
            hipLaunchKernelGGL(mk_fwd, dim3(grid), dim3(NWAVES * 64), LDS_BYTES, stream, a); } }
    (void)li;
#else
    for (int s = 0; s < NSTEPS; s += MK_STEPS_PER_LAUNCH) {
        a.lo = s; a.hi = (s + MK_STEPS_PER_LAUNCH < NSTEPS) ? s + MK_STEPS_PER_LAUNCH : NSTEPS; a.li = (MK_STEPS_PER_LAUNCH > 1) ? li : 0; ++li;
        hipLaunchKernelGGL(mk_fwd, dim3(grid), dim3(NWAVES * 64), LDS_BYTES, stream, a);
        if (hipPeekAtLastError() != hipSuccess) { fprintf(stderr, "kernel_launch: launch failed\n"); break; }
    }
#endif
}
```

```cpp
#define MK_STEPS_PER_LAUNCH 1000
#define PG8_WGM 4
#define FFN_CHUNKS 1
#include <hip/hip_runtime.h>
#include <cstdio>
#include <cstdint>
#include <cmath>
#ifndef PG8_WGM
#define PG8_WGM 8
#endif
namespace pg8 {
#define PG8_LAS __attribute__((address_space(3)))
typedef unsigned short bf16_t;
typedef short bf16x8 __attribute__((ext_vector_type(8)));
typedef float f32x4 __attribute__((ext_vector_type(4)));
typedef unsigned u32x4 __attribute__((ext_vector_type(4)));
constexpr int BM = 256, BK = 64, HALF = 128, HTB = HALF * BK * 2  , STAGE_BYTES = 8 * HTB, NXCD = 8, WGM = PG8_WGM;

__host__ __device__ __forceinline__ int lds_byte(int r, int c) { const int st = (r >> 4) * 2 + (c >> 5), rr = r & 15, cc = c & 31, ob = rr * 64 + cc * 2; return st * 1024 + (ob ^ (((ob >> 9) & 1) << 5)); }
__host__ __device__ __forceinline__ void stage_rc(int b, int& R, int& C) { const int st = b / 1024, sb = b % 1024, swz = sb ^ (((sb >> 9) & 1) << 5); R = (st >> 1) * 16 + swz / 64; C = (st & 1) * 32 + (swz % 64) / 2; }
__host__ __device__ __forceinline__ int perm32(int rho) { const int n = rho >> 4, i = rho & 15; return 8 * (i >> 2) + 4 * n + (i & 3); }

struct Unit { int pm, pn; };
struct Gemm { const bf16_t* A; const bf16_t* Bt; int M, N, K; int zv; int rot; int tiled; };

struct StaticOrder {
    int nM, nN, nwg, G, c, wgm;
    __host__ __device__ void init(int M, int N, int G_, int c_, int wgm_ = WGM) { nM = M / BM; nN = N / BM; nwg = nM * nN; G = G_; c = c_; wgm = wgm_; }
    __host__ __device__ bool next(int i, Unit& u) const {
        const long L = (long)i * G + c; if (L >= nwg) return false;
        int wgid = (int)L; { const int q = nwg / NXCD, r = nwg % NXCD, xcd = wgid % NXCD, off = wgid / NXCD; wgid = (xcd < r ? xcd * (q + 1) : r * (q + 1) + (xcd - r) * q) + off; }
        const int nig = wgm * nN, gid = wgid / nig, fm = gid * wgm, gsz = (nM - fm) < wgm ? (nM - fm) : wgm;
        u.pm = fm + ((wgid % nig) % gsz); u.pn = (wgid % nig) / gsz; return true;
    }
    __device__ __forceinline__ void a_ready(const Unit&) const {}
    __device__ __forceinline__ void done(const Unit&) const {}
};

__device__ __forceinline__ unsigned cvt_pk_bf16(float lo, float hi) { unsigned r; asm volatile("v_cvt_pk_bf16_f32 %0, %1, %2" : "=v"(r) : "v"(lo), "v"(hi)); return r; }
typedef float f32x2 __attribute__((ext_vector_type(2)));

__device__ __forceinline__ float fast_sigmoid(float x) { return __builtin_amdgcn_rcpf(1.0f + __builtin_amdgcn_exp2f(-1.4426950408889634f * x)); }
__device__ __forceinline__ float gelu_tanh(float x) {
    const float u2 = 1.5957691216057308f * (x + 0.044715f * x * x * x);
    return x * fast_sigmoid(u2);
}
__device__ __forceinline__ float bf_lo(unsigned u) { return __builtin_bit_cast(float, u << 16); }
__device__ __forceinline__ float bf_hi(unsigned u) { return __builtin_bit_cast(float, u & 0xffff0000u); }

#ifdef PG8_NT_OUT
#define PG8_STORE_OUT(p, v) __builtin_nontemporal_store((v), (p))
#else
#define PG8_STORE_OUT(p, v) (*(p) = (v))
#endif
struct EpiProj {
    static constexpr bool PERM = true, AFTER_DRAIN = false, MID = false; static constexpr int MID_TILES = 1; __device__ __forceinline__ void set_scale0() {}
    bf16_t* P1; bf16_t* G;
    __device__ __forceinline__ void operator()(const f32x4 (&acc)[2][2][4][2], const Unit& u, int wr, int wc, int fr, int fq) const {
        const int row0 = u.pm * BM + wr * 64 + fr;
        bf16_t* base; int ldc, colt, act0, act1;
        if (u.pn < 8) { base = P1; ldc = 2048; colt = u.pn * BM; act0 = (u.pn < 2) ? 1 : 0; act1 = (u.pn == 7) ? 2 : act0; }
        else { base = G; ldc = 3072; colt = (u.pn - 8) * BM; act0 = 2; act1 = 2; }
        const int col0 = colt + wc * 32 + 8 * fq;
#pragma unroll
        for (int ai = 0; ai < 2; ++ai)
#pragma unroll
            for (int m = 0; m < 4; ++m) { bf16_t* rowp = base + (size_t)(row0 + ai * HALF + m * 16) * ldc + col0;
#pragma unroll
                for (int bj = 0; bj < 2; ++bj) { f32x4 v0 = acc[ai][bj][m][0], v1 = acc[ai][bj][m][1]; const int act = bj ? act1 : act0;
                    if (act == 1) {
#pragma unroll
                        for (int e = 0; e < 4; ++e) { v0[e] = gelu_tanh(v0[e]); v1[e] = gelu_tanh(v1[e]); } }
                    else if (act == 2) {
#pragma unroll
                        for (int e = 0; e < 4; ++e) { v0[e] = fast_sigmoid(v0[e]); v1[e] = fast_sigmoid(v1[e]); } }
                    u32x4 w; w.x = cvt_pk_bf16(v0[0], v0[1]); w.y = cvt_pk_bf16(v0[2], v0[3]); w.z = cvt_pk_bf16(v1[0], v1[1]); w.w = cvt_pk_bf16(v1[2], v1[3]);
                    *(u32x4*)(rowp + bj * HALF) = w; } }
    }
};
struct EpiMerge {
    static constexpr bool PERM = true, AFTER_DRAIN = false, MID = false; static constexpr int MID_TILES = 1; __device__ __forceinline__ void set_scale0() {}
    const bf16_t* G; bf16_t* MG; int nmt;
    __device__ __forceinline__ void operator()(const f32x4 (&acc)[2][2][4][2], const Unit& u, int wr, int wc, int fr, int fq) const {
        const int i = u.pn >> 2, pn = u.pn & 3, pm = u.pm - i * nmt;
        const int row0 = pm * BM + wr * 64 + fr, col0 = pn * BM + wc * 32 + 8 * fq;
#pragma unroll
        for (int ai = 0; ai < 2; ++ai)
#pragma unroll
            for (int mp = 0; mp < 2; ++mp) {
                u32x4 g[4], o[4];
#pragma unroll
                for (int q = 0; q < 4; ++q) { const int m = 2 * mp + (q >> 1), bj = q & 1; const size_t row = (size_t)(row0 + ai * HALF + m * 16); const int col = col0 + bj * HALF;
                    g[q] = *(const u32x4*)(G + row * 3072 + i * 1024 + col);
                    if (i > 0) o[q] = *(const u32x4*)(MG + row * 1024 + col); else o[q] = (u32x4){0u, 0u, 0u, 0u}; }
#pragma unroll
                for (int q = 0; q < 4; ++q) { const int m = 2 * mp + (q >> 1), bj = q & 1; const size_t row = (size_t)(row0 + ai * HALF + m * 16); const int col = col0 + bj * HALF;
                    f32x4 v0 = acc[ai][bj][m][0], v1 = acc[ai][bj][m][1];
#ifdef ABL_BRANCH
                    if (i == ABL_BRANCH) { v0 = v0 * (float)ABL_SCALE; v1 = v1 * (float)ABL_SCALE; }
#endif
                    v0[0] = v0[0] * bf_lo(g[q].x) + bf_lo(o[q].x); v0[1] = v0[1] * bf_hi(g[q].x) + bf_hi(o[q].x); v0[2] = v0[2] * bf_lo(g[q].y) + bf_lo(o[q].y); v0[3] = v0[3] * bf_hi(g[q].y) + bf_hi(o[q].y);
                    v1[0] = v1[0] * bf_lo(g[q].z) + bf_lo(o[q].z); v1[1] = v1[1] * bf_hi(g[q].z) + bf_hi(o[q].z); v1[2] = v1[2] * bf_lo(g[q].w) + bf_lo(o[q].w); v1[3] = v1[3] * bf_hi(g[q].w) + bf_hi(o[q].w);
                    u32x4 w; w.x = cvt_pk_bf16(v0[0], v0[1]); w.y = cvt_pk_bf16(v0[2], v0[3]); w.z = cvt_pk_bf16(v1[0], v1[1]); w.w = cvt_pk_bf16(v1[2], v1[3]);
                    *(u32x4*)(MG + row * 1024 + col) = w; } }
    }
};
struct EpiResid {
    static constexpr bool PERM = false, AFTER_DRAIN = false, MID = false; static constexpr int MID_TILES = 1; __device__ __forceinline__ void set_scale0() { scale = 0.f; base = out; }
    const float* base; float* out; int ldc; float scale;
    __device__ __forceinline__ void operator()(const f32x4 (&acc)[2][2][4][2], const Unit& u, int wr, int wc, int fr, int fq) const {
        const int row0 = u.pm * BM + wr * 64 + fr, col0 = u.pn * BM + wc * 32 + 4 * fq;
#pragma unroll
        for (int ai = 0; ai < 2; ++ai)
#pragma unroll
            for (int mp = 0; mp < 2; ++mp) {
                f32x4 b[8];
#pragma unroll
                for (int q = 0; q < 8; ++q) { const int m = 2 * mp + (q >> 2), bj = (q >> 1) & 1, n = q & 1;
                    b[q] = *(const f32x4*)(base + (size_t)(row0 + ai * HALF + m * 16) * ldc + col0 + bj * HALF + n * 16); }
#pragma unroll
                for (int q = 0; q < 8; ++q) { const int m = 2 * mp + (q >> 2), bj = (q >> 1) & 1, n = q & 1;
                    *(f32x4*)(out + (size_t)(row0 + ai * HALF + m * 16) * ldc + col0 + bj * HALF + n * 16) = b[q] + acc[ai][bj][m][n] * scale; } }
    }
};
struct EpiF32 {
    static constexpr bool PERM = false, AFTER_DRAIN = false, MID = false; static constexpr int MID_TILES = 1; __device__ __forceinline__ void set_scale0() {}
    float* O; int ldc, nN;
    __device__ __forceinline__ void operator()(const f32x4 (&acc)[2][2][4][2], const Unit& u, int wr, int wc, int fr, int fq) const {
        const int row0 = u.pm * BM + wr * 64 + fr, col0 = (u.pn % nN) * BM + wc * 32 + 4 * fq;
#pragma unroll
        for (int ai = 0; ai < 2; ++ai)
#pragma unroll
            for (int m = 0; m < 4; ++m) { const size_t off = (size_t)(row0 + ai * HALF + m * 16) * ldc + col0;
#pragma unroll
                for (int bj = 0; bj < 2; ++bj)
#pragma unroll
                    for (int n = 0; n < 2; ++n) *(f32x4*)(O + off + bj * HALF + n * 16) = acc[ai][bj][m][n]; }
    }
};
#ifdef EMU_FP8_HID
__device__ __forceinline__ float Q8H(float x) { const int p = __builtin_amdgcn_cvt_pk_fp8_f32(x * 8.f, x * 8.f, 0, false); return __builtin_amdgcn_cvt_f32_fp8(p, 0) * 0.125f; }
#else
__device__ __forceinline__ float Q8H(float x) { return x; }
#endif
struct EpiSwiGLU {
    static constexpr bool PERM = true, AFTER_DRAIN = false, MID = false; static constexpr int MID_TILES = 1; __device__ __forceinline__ void set_scale0() {}
    bf16_t* H; int ldh; const float* rowscale; int nN; int rowmask = 0x7fffffff;
    __device__ __forceinline__ void operator()(const f32x4 (&acc)[2][2][4][2], const Unit& u, int wr, int wc, int fr, int fq) const {
        const int row0 = u.pm * BM + wr * 64 + fr, col0 = (u.pn % nN) * HALF + wc * 32 + 8 * fq;
        float scv[8];
#pragma unroll
        for (int q = 0; q < 8; ++q) scv[q] = rowscale ? rowscale[row0 + (q >> 2) * HALF + (q & 3) * 16] : 1.0f;
#pragma unroll
        for (int ai = 0; ai < 2; ++ai)
#pragma unroll
            for (int m = 0; m < 4; ++m) { const int row = row0 + ai * HALF + m * 16; const float sc = scv[ai * 4 + m];
                float h[8];
#pragma unroll
                for (int n = 0; n < 2; ++n)
#pragma unroll
                    for (int e = 0; e < 4; ++e) { const float g = acc[ai][0][m][n][e], up = acc[ai][1][m][n][e]; h[n * 4 + e] = Q8H(g * fast_sigmoid(g) * up * sc); }
                u32x4 w; w.x = cvt_pk_bf16(h[0], h[1]); w.y = cvt_pk_bf16(h[2], h[3]); w.z = cvt_pk_bf16(h[4], h[5]); w.w = cvt_pk_bf16(h[6], h[7]);
                PG8_STORE_OUT((u32x4*)(H + (size_t)(row & rowmask) * ldh + col0), w); }
    }
};
struct EpiScatter {
    static constexpr bool PERM = false, AFTER_DRAIN = false, MID = false; static constexpr int MID_TILES = 1; __device__ __forceinline__ void set_scale0() { scale = 0.f; }
    float* out; const int* tok; int nN; float scale;
    __device__ __forceinline__ void operator()(const f32x4 (&acc)[2][2][4][2], const Unit& u, int wr, int wc, int fr, int fq) const {
        const int row0 = u.pm * BM + wr * 64 + fr, col0 = (u.pn % nN) * BM + wc * 32 + 4 * fq;
        int tk[8];
#pragma unroll
        for (int q = 0; q < 8; ++q) tk[q] = tok[row0 + (q >> 2) * HALF + (q & 3) * 16];
#pragma unroll
        for (int ai = 0; ai < 2; ++ai)
#pragma unroll
            for (int mp = 0; mp < 2; ++mp) {
                f32x4 b[8];
#pragma unroll
                for (int q = 0; q < 8; ++q) { const int m = 2 * mp + (q >> 2), bj = (q >> 1) & 1, n = q & 1; const int t = tk[ai * 4 + m];
                    b[q] = *(const f32x4*)(out + (size_t)(t < 0 ? 0 : t) * 1024 + col0 + bj * HALF + n * 16); }
#pragma unroll
                for (int q = 0; q < 8; ++q) { const int m = 2 * mp + (q >> 2), bj = (q >> 1) & 1, n = q & 1; const int t = tk[ai * 4 + m];
#ifdef ABL_MOE
                    if (false)
#else
                    if (t >= 0)
#endif
                        *(f32x4*)(out + (size_t)t * 1024 + col0 + bj * HALF + n * 16) = b[q] + acc[ai][bj][m][n] * scale; } }
    }
};
struct GroupedOrder {
    StaticOrder so; const PG8_LAS int* tile_e; int nN;
    __device__ __forceinline__ bool next(int i, Unit& u) const { if (!so.next(i, u)) return false; u.pn += tile_e[u.pm] * nN; return true; }
    __device__ __forceinline__ void a_ready(const Unit&) const {}
    __device__ __forceinline__ void done(const Unit&) const {}
};
struct OffsetOrder {
    StaticOrder so; int pn_off;
    __device__ __forceinline__ bool next(int i, Unit& u) const { if (!so.next(i, u)) return false; u.pn += pn_off; return true; }
    __device__ __forceinline__ void a_ready(const Unit&) const {}
    __device__ __forceinline__ void done(const Unit&) const {}
};
struct ProbeOrder {
    StaticOrder so; int pm_mask;
    __device__ __forceinline__ bool next(int i, Unit& u) const { if (!so.next(i, u)) return false; u.pm &= pm_mask; return true; }
    __device__ __forceinline__ void a_ready(const Unit&) const {}
    __device__ __forceinline__ void done(const Unit&) const {}
};
struct MergeOrder {
    StaticOrder so; int nmt;
    __device__ __forceinline__ bool next(int i, Unit& u) const { const int b = i % 3; if (!so.next(i / 3, u)) return false; u.pm += b * nmt; u.pn += b * 4; return true; }
    __device__ __forceinline__ void a_ready(const Unit&) const {}
    __device__ __forceinline__ void done(const Unit&) const {}
};
template <class Epi, class Sched, bool ALIGN_EPI = false, bool SP2 = false>
__device__ __forceinline__ void gemm_phase(PG8_LAS unsigned char* lds, const Gemm g, const Sched& S, const Epi& E) {
    const int tid = g.zv  , wid = __builtin_amdgcn_readfirstlane(tid >> 6), lane = tid & 63, wr = wid >> 2, wc = wid & 3, fr = lane & 15, fq = lane >> 4;
    const int K = g.K, nt = K / BK;
    unsigned voffA[2], voffB[2];
#pragma unroll
    for (int i = 0; i < 2; ++i) { int R, C; stage_rc(tid * 16 + i * 8192, R, C); const int Rb = Epi::PERM ? ((R & ~31) + perm32(R & 31)) : R;
        const int pitch = g.tiled ? BK : K;
        voffA[i] = (unsigned)(R * pitch + C) * 2u; voffB[i] = (unsigned)(Rb * pitch + C) * 2u; }
    const size_t kstep = g.tiled ? (size_t)(BM * BK * 2) : (size_t)(BK * 2);
    const size_t hstep = g.tiled ? (size_t)(HALF * BK * 2) : (size_t)HALF * K * 2;
    const size_t tstep = (size_t)BM * K * 2;
    const unsigned ldsw = (unsigned)wid * 1024u;
    const int aoff = lds_byte(wr * 64 + fr, fq * 8), boff = lds_byte(wc * 32 + fr, fq * 8);
#define PG8_SA(b, h) (((b) * 2 + (h)) * HTB)
#define PG8_SB(b, h) ((4 + (b) * 2 + (h)) * HTB)
#define PG8_STAGE(bufoff, gbase, voff) do { _Pragma("unroll") for (int _i = 0; _i < 2; ++_i) \
        __builtin_amdgcn_global_load_lds((const unsigned*)((const char*)(gbase) + (voff)[_i]), (PG8_LAS unsigned*)(lds + (bufoff) + ldsw + _i * 8192), 16, 0, 0); } while (0)
#define PG8_LDA(dst, b, h) do { _Pragma("unroll") for (int m = 0; m < 4; ++m) _Pragma("unroll") for (int k = 0; k < 2; ++k) dst[m][k] = *(const PG8_LAS bf16x8*)(lds + PG8_SA(b, h) + aoff + m * 2048 + k * 1024); } while (0)
#define PG8_LDB(dst, b, h) do { _Pragma("unroll") for (int n = 0; n < 2; ++n) _Pragma("unroll") for (int k = 0; k < 2; ++k) dst[n][k] = *(const PG8_LAS bf16x8*)(lds + PG8_SB(b, h) + boff + n * 2048 + k * 1024); } while (0)
#define PG8_MMA(ai, bj, At, Bt) do { __builtin_amdgcn_s_setprio(1); _Pragma("unroll") for (int m = 0; m < 4; ++m) _Pragma("unroll") for (int n = 0; n < 2; ++n) _Pragma("unroll") for (int k = 0; k < 2; ++k) \
        acc[ai][bj][m][n] = __builtin_amdgcn_mfma_f32_16x16x32_bf16(Bt[n][k], At[m][k], acc[ai][bj][m][n], 0, 0, 0); __builtin_amdgcn_s_setprio(0); } while (0)
#define PG8_WAIT_V(n) asm volatile("s_waitcnt vmcnt(" #n ")" ::: "memory")
#define PG8_WAIT_L(n) asm volatile("s_waitcnt lgkmcnt(" #n ")" ::: "memory")
#define PG8_BAR __builtin_amdgcn_s_barrier()
#define PG8_SCHED __builtin_amdgcn_sched_barrier(0)
    Unit cur, nxt; int ui = 0;
    if (!S.next(0, cur)) return;
    f32x4 acc[2][2][4][2];
#pragma unroll
    for (int a = 0; a < 2; ++a)
#pragma unroll
        for (int b = 0; b < 2; ++b)
#pragma unroll
            for (int m = 0; m < 4; ++m)
#pragma unroll
                for (int n = 0; n < 2; ++n) acc[a][b][m][n] = (f32x4){0.f, 0.f, 0.f, 0.f};
    bf16x8 At[4][2], B0[2][2], B1[2][2];
    const char* cA = (const char*)g.A + (size_t)cur.pm * tstep; const char* cB = (const char*)g.Bt + (size_t)cur.pn * tstep;
    const int rot = g.rot; const size_t rofs = (size_t)rot * kstep; const char* pA = cA + rofs; const char* pB = cB + rofs;
#define PG8_KT(x) ((size_t)(((x) + rot >= nt) ? (x) + rot - nt : (x) + rot))
    S.a_ready(cur);
    if constexpr (SP2) {
        PG8_STAGE(PG8_SB(0, 0), pB, voffB); PG8_STAGE(PG8_SB(0, 1), pB + hstep, voffB); PG8_STAGE(PG8_SA(0, 0), pA, voffA); PG8_STAGE(PG8_SA(0, 1), pA + hstep, voffA);
        if (wr == 1) PG8_BAR;
        PG8_WAIT_V(2); PG8_BAR;
        PG8_STAGE(PG8_SB(1, 0), pB + kstep, voffB); PG8_STAGE(PG8_SA(1, 0), pA + kstep, voffA); PG8_STAGE(PG8_SB(1, 1), pB + hstep + kstep, voffB);
        PG8_WAIT_V(6); PG8_BAR;
    } else {
        PG8_STAGE(PG8_SB(0, 0), pB, voffB); PG8_STAGE(PG8_SA(0, 0), pA, voffA); PG8_STAGE(PG8_SB(0, 1), pB + hstep, voffB); PG8_STAGE(PG8_SA(0, 1), pA + hstep, voffA);
        if (wr == 1) PG8_BAR;
        PG8_WAIT_V(4); PG8_BAR;
        PG8_STAGE(PG8_SB(1, 0), pB + kstep, voffB); PG8_STAGE(PG8_SA(1, 0), pA + kstep, voffA); PG8_STAGE(PG8_SB(1, 1), pB + hstep + kstep, voffB);
        PG8_WAIT_V(6); PG8_BAR;
    }
    for (;;) {
        const bool has_next = S.next(ui + 1, nxt);
        const char* nA = has_next ? (const char*)g.A + (size_t)nxt.pm * tstep : cA; const char* nB = has_next ? (const char*)g.Bt + (size_t)nxt.pn * tstep : cB;
        for (int t = 0; t < nt; t += 2) {
            if constexpr (Epi::MID) { if (t != 0 && (t & (Epi::MID_TILES - 1)) == 0) E.mid(acc, cur, t / Epi::MID_TILES, wr, wc, fr, fq); }
            const bool last = (t == nt - 2);
            const char* a1 = cA + PG8_KT(t + 1) * kstep;
            const char* a2 = last ? nA + rofs : cA + PG8_KT(t + 2) * kstep; const char* b2 = last ? nB + rofs : cB + PG8_KT(t + 2) * kstep;
            const char* a3 = a2 + kstep; const char* b3 = b2 + kstep;
            if (last && has_next) S.a_ready(nxt);
            if constexpr (SP2) {
            PG8_LDB(B0, 0, 0); PG8_LDB(B1, 0, 1); PG8_SCHED; PG8_LDA(At, 0, 0); PG8_STAGE(PG8_SA(1, 1), a1 + hstep, voffA);
            PG8_WAIT_V(8); PG8_WAIT_L(0); PG8_BAR; PG8_MMA(0, 0, At, B0); PG8_MMA(0, 1, At, B1); PG8_BAR; PG8_SCHED;
            PG8_LDA(At, 0, 1); PG8_STAGE(PG8_SB(0, 0), b2, voffB); PG8_STAGE(PG8_SB(0, 1), b2 + hstep, voffB); PG8_STAGE(PG8_SA(0, 0), a2, voffA);
            PG8_WAIT_V(8); PG8_WAIT_L(0); PG8_BAR; PG8_MMA(1, 0, At, B0); PG8_MMA(1, 1, At, B1); PG8_BAR; PG8_SCHED;
            PG8_LDB(B0, 1, 0); PG8_LDB(B1, 1, 1); PG8_SCHED; PG8_LDA(At, 1, 0); PG8_STAGE(PG8_SA(0, 1), a2 + hstep, voffA);
            PG8_WAIT_V(8); PG8_WAIT_L(0); PG8_BAR; PG8_MMA(0, 0, At, B0); PG8_MMA(0, 1, At, B1); PG8_BAR; PG8_SCHED;
            PG8_LDA(At, 1, 1); PG8_STAGE(PG8_SB(1, 0), b3, voffB); PG8_STAGE(PG8_SB(1, 1), b3 + hstep, voffB); PG8_STAGE(PG8_SA(1, 0), a3, voffA);
            PG8_WAIT_V(8); PG8_WAIT_L(0); PG8_BAR; PG8_MMA(1, 0, At, B0); PG8_MMA(1, 1, At, B1); PG8_BAR; PG8_SCHED;
            } else {
            PG8_LDB(B0, 0, 0); PG8_SCHED; PG8_LDA(At, 0, 0); PG8_STAGE(PG8_SA(1, 1), a1 + hstep, voffA);
            PG8_WAIT_L(8); PG8_BAR; PG8_WAIT_L(0); PG8_MMA(0, 0, At, B0); PG8_BAR; PG8_SCHED;
            PG8_LDB(B1, 0, 1); PG8_STAGE(PG8_SB(0, 0), b2, voffB);
            PG8_BAR; PG8_WAIT_L(0); PG8_MMA(0, 1, At, B1); PG8_BAR;
            PG8_LDA(At, 0, 1); PG8_STAGE(PG8_SA(0, 0), a2, voffA);
            PG8_BAR; PG8_WAIT_L(0); PG8_MMA(1, 0, At, B0); PG8_BAR; PG8_SCHED;
            PG8_STAGE(PG8_SB(0, 1), b2 + hstep, voffB);
            PG8_WAIT_V(6); PG8_BAR; PG8_MMA(1, 1, At, B1); PG8_BAR;
            PG8_LDB(B0, 1, 0); PG8_SCHED; PG8_LDA(At, 1, 0); PG8_STAGE(PG8_SA(0, 1), a2 + hstep, voffA);
            PG8_WAIT_L(8); PG8_BAR; PG8_WAIT_L(0); PG8_MMA(0, 0, At, B0); PG8_BAR; PG8_SCHED;
            PG8_LDB(B1, 1, 1); PG8_STAGE(PG8_SB(1, 0), b3, voffB);
            PG8_BAR; PG8_WAIT_L(0); PG8_MMA(0, 1, At, B1); PG8_BAR;
            PG8_LDA(At, 1, 1); PG8_STAGE(PG8_SA(1, 0), a3, voffA);
            PG8_BAR; PG8_WAIT_L(0); PG8_MMA(1, 0, At, B0); PG8_BAR; PG8_SCHED;
            PG8_STAGE(PG8_SB(1, 1), b3 + hstep, voffB);
            PG8_WAIT_V(6); PG8_BAR; PG8_MMA(1, 1, At, B1); PG8_BAR;
            }
        }
        if constexpr (ALIGN_EPI) { if (wr == 0) PG8_BAR; }
        if constexpr (!Epi::AFTER_DRAIN) { E(acc, cur, wr, wc, fr, fq); S.done(cur); }
        if (!has_next) break;
#pragma unroll
        for (int a = 0; a < 2; ++a)
#pragma unroll
            for (int b = 0; b < 2; ++b)
#pragma unroll
                for (int m = 0; m < 4; ++m)
#pragma unroll
                    for (int n = 0; n < 2; ++n) acc[a][b][m][n] = (f32x4){0.f, 0.f, 0.f, 0.f};
        cur = nxt; cA = nA; cB = nB; ++ui;
        if constexpr (ALIGN_EPI) { if (wr == 1) PG8_BAR; }
    }
    PG8_WAIT_V(0);
    if constexpr (!ALIGN_EPI) { if (wr == 0) PG8_BAR; }
    PG8_BAR;
    if constexpr (Epi::AFTER_DRAIN) { E.fused(acc, cur, wr, wc, fr, fq, lds, wid, lane); S.done(cur); }
#undef PG8_KT
#undef PG8_SA
#undef PG8_SB
#undef PG8_STAGE
#undef PG8_LDA
#undef PG8_LDB
#undef PG8_MMA
#undef PG8_WAIT_V
#undef PG8_WAIT_L
#undef PG8_BAR
#undef PG8_SCHED
}
}

constexpr int NWAVES = 8;
constexpr int DM = 1024, BATCH = 16, SEQ = 4096, DEPTH = 4, MTOK = BATCH * SEQ;
constexpr int NCHUNK = 2, MC = MTOK / NCHUNK, BC = BATCH / NCHUNK;
constexpr int CIN = 5004, NPROJ = 5120, P1W = 2048, GWID = 3072;
constexpr int DFF = 2752, DFFP = 2816, NFF1 = 2 * DFFP;
constexpr int NEXP = 8, DFE = 3584, NMOE1 = 2 * DFE;
constexpr int SLOTS = MC + 2048;
constexpr float EPS = 1e-6f;
constexpr int C_U = 0, C_V = 256, C_SBQ = 512, C_SBK = 768, C_SBV = 1024, C_CQ = 1280, C_KCMP = 1536, C_VCMP = 1600, C_KSLC = 1664, C_VSLC = 1728, C_KWIN = 1792, C_VWIN = 1856, C_CG = 1920;

constexpr size_t MiB = 1u << 20;
constexpr size_t WS_CTL = 0, CTL_ZERO_BYTES = 1 * MiB;
constexpr size_t WS_ROPE = 1 * MiB;
constexpr size_t WS_BIAS1 = 1 * MiB + 512 * 1024;
constexpr size_t WS_WIN = 2 * MiB;
constexpr size_t WS_WBR = 12 * MiB;
constexpr size_t WS_WOUT = 14 * MiB;
constexpr size_t WS_WC1 = 16 * MiB;
constexpr size_t WS_WF1 = 18 * MiB;
constexpr size_t WS_WF2 = 130 * MiB;
constexpr size_t WS_HN = 186 * MiB;
constexpr size_t WS_SCR = 314 * MiB;
constexpr size_t WS_P1 = WS_SCR;
constexpr size_t WS_G = WS_P1 + 128 * MiB;
constexpr size_t WS_Y = WS_G + 192 * MiB;
constexpr size_t WS_MG = WS_Y + 48 * MiB;
constexpr size_t WS_KVC = WS_MG + 64 * MiB;
constexpr size_t WS_UL = WS_KVC + 8 * MiB;
constexpr size_t WS_KC = WS_UL + 8 * MiB;
constexpr size_t WS_VT = WS_KC + 1 * MiB;
constexpr size_t WS_KCT = WS_VT + 24 * MiB;
constexpr size_t WS_MIX_END = WS_KCT + 1 * MiB;
constexpr size_t WS_HID = WS_SCR;
constexpr size_t WS_ROUTE = WS_SCR;
constexpr size_t WS_TOKMAP = WS_SCR + 1 * MiB;
constexpr size_t WS_WSLOT = WS_SCR + 2 * MiB;
constexpr size_t WS_XG = WS_SCR + 4 * MiB;
constexpr size_t WS_HIDM = WS_XG + 68 * MiB;
constexpr size_t WS_END = 800 * MiB;
static_assert(WS_MIX_END <= WS_END && WS_HID + (size_t)MTOK * DFFP * 2 <= WS_END && WS_HIDM + (size_t)SLOTS * DFE * 2 <= WS_END, "d_ws map");
static_assert(WS_WF1 + (size_t)NEXP * NMOE1 * DM * 2 <= WS_WF2 && WS_WF2 + (size_t)NEXP * DM * DFE * 2 <= WS_HN, "weight map");
static_assert((size_t)4 * SLOTS * 4 <= 1 * MiB, "tokmap");
constexpr int CW_BAR = 4096;
constexpr int CW_CNT = 131072;
constexpr int CW_CUR = 131072 + 256;
constexpr int MAX_BAR_REGIONS = 32;
constexpr int RING_OFF = 0, RING_BYTES = 131072;
constexpr int LDSCTL_OFF = RING_BYTES, MISC_OFF = LDSCTL_OFF + 320;
constexpr int TAB_OFF = LDSCTL_OFF + 1024;
constexpr int LDS_BYTES = 147456;

#define GAS __attribute__((address_space(1)))
#define LAS __attribute__((address_space(3)))
typedef unsigned short bf16;
typedef unsigned v4u __attribute__((ext_vector_type(4)));
typedef unsigned v2u __attribute__((ext_vector_type(2)));
typedef float f32x4 __attribute__((ext_vector_type(4)));
typedef int v4i __attribute__((ext_vector_type(4)));
typedef __bf16 bf16x2_t __attribute__((ext_vector_type(2)));
#define LDS_WAIT() asm volatile("s_waitcnt lgkmcnt(0)" ::: "memory")
#define VM_WAIT() asm volatile("s_waitcnt vmcnt(0)" ::: "memory")
__device__ __forceinline__ unsigned f2bf(float f) { unsigned u = __builtin_bit_cast(unsigned, f); return (u + 0x7fffu + ((u >> 16) & 1u)) >> 16; }
__device__ __forceinline__ unsigned pk2(float lo, float hi) { return f2bf(lo) | (f2bf(hi) << 16); }
__device__ __forceinline__ float bflo(unsigned u) { return __builtin_bit_cast(float, u << 16); }
__device__ __forceinline__ float bfhi(unsigned u) { return __builtin_bit_cast(float, u & 0xffff0000u); }
__device__ __forceinline__ float bf1(bf16 h) { return __builtin_bit_cast(float, (unsigned)h << 16); }
__device__ __forceinline__ float dot2bf(unsigned a, unsigned b, float c) { return __builtin_amdgcn_fdot2_f32_bf16(__builtin_bit_cast(bf16x2_t, a), __builtin_bit_cast(bf16x2_t, b), c, false); }
#ifdef EMU_FP8
__device__ __forceinline__ float q8r(float x, float s) { const int p = __builtin_amdgcn_cvt_pk_fp8_f32(x * s, x * s, 0, false); return __builtin_amdgcn_cvt_f32_fp8(p, 0) * (1.0f / s); }
#else
__device__ __forceinline__ float q8r(float x, float) { return x; }
#endif
__device__ __forceinline__ float fexp(float x) { return __builtin_amdgcn_exp2f(1.4426950408889634f * x); }
template <int X> __device__ __forceinline__ float swz_xor(float v) { return __builtin_bit_cast(float, __builtin_amdgcn_ds_swizzle(__builtin_bit_cast(int, v), (X << 10) | 0x1f)); }
__device__ __forceinline__ float wave_sum(float v, int lane) {
#pragma unroll
    for (int o = 1; o < 64; o <<= 1) v += __builtin_bit_cast(float, __builtin_amdgcn_ds_bpermute((lane ^ o) << 2, __builtin_bit_cast(int, v)));
    return v;
}
__device__ __forceinline__ float rdlane(float v, int l) { return __builtin_bit_cast(float, __builtin_amdgcn_readlane(__builtin_bit_cast(int, v), l)); }
__device__ __forceinline__ int bperm(int srclane, int v) { return __builtin_amdgcn_ds_bpermute(srclane << 2, v); }
__constant__ double ROPE_INVF[8] = {1.0, 0.19392274474868576, 0.037606030930863933, 0.0072926647372171093, 0.0014142135623730950, 0.00027424817567620730, 5.3182958969449883e-05, 1.0313385377212460e-05};
#define XB_TMO      128
#define XB_XCNT(j)  (256  + 64 * (j))
#define XB_XSUB(j)  (1280 + 64 * (j))
#define XB_XGEN(j)  (2304 + 64 * (j))
#define XB_TOP      3328
#define XB_TOPGEN   3392
#define XCD_BAR_WORDS 3456
#define XB_SPIN_CAP (1u << 18)

__device__ __forceinline__ unsigned xb_ld(unsigned* p)              { return __hip_atomic_load(p, __ATOMIC_RELAXED, __HIP_MEMORY_SCOPE_AGENT); }
__device__ __forceinline__ unsigned xb_add(unsigned* p, unsigned v) { return __hip_atomic_fetch_add(p, v, __ATOMIC_RELAXED, __HIP_MEMORY_SCOPE_AGENT); }
__device__ __forceinline__ unsigned xb_xcc_id() { return (unsigned)__builtin_amdgcn_s_getreg((3 << 11) | 20) & 0xFu; }
#define XB_SPIN(cond, bar) do { unsigned _sp = 0; while (cond) { __builtin_amdgcn_s_sleep(1); \
    if ((++_sp & 255u) == 0u) { if (xb_ld(&(bar)[XB_TMO])) break; if (_sp > XB_SPIN_CAP) { atomicAdd(&(bar)[XB_TMO], 1u); break; } } } } while (0)

__device__ __forceinline__ bool xb_thread0_w(unsigned w, unsigned z) { return w == 0u && __builtin_amdgcn_mbcnt_hi(~0u, __builtin_amdgcn_mbcnt_lo(~0u, z)) == 0u; }
struct XcdBarrier {
    unsigned* bar; unsigned x; unsigned w, z;
    volatile LAS unsigned* st;
};

__device__ __forceinline__ XcdBarrier xcd_barrier_post(unsigned* bar, volatile LAS unsigned* st) {
    XcdBarrier b; b.bar = bar; b.x = xb_xcc_id(); b.st = st; b.w = (unsigned)__builtin_amdgcn_readfirstlane((int)(threadIdx.x >> 6)); b.z = 0u;
    if (xb_thread0_w(b.w, b.z)) (void)xb_add(&bar[XB_XCNT(b.x)], 1u);
    return b;
}
__device__ __forceinline__ void xcd_barrier_complete(unsigned* bar, unsigned x, unsigned& nloc, unsigned& nx) {
    const unsigned G = gridDim.x * gridDim.y * gridDim.z;
    unsigned sum, cnt, mine, sp = 0u;
    for (;;) {
        sum = 0u; cnt = 0u; mine = 0u;
#pragma unroll
        for (unsigned j = 0; j < 16; ++j) { const unsigned c = xb_ld(&bar[XB_XCNT(j)]); sum += c; cnt += (c > 0u) ? 1u : 0u; mine = (j == x) ? c : mine; }
        if (sum == G) break;
        __builtin_amdgcn_s_sleep(1);
        if ((++sp & 255u) == 0u) { if (xb_ld(&bar[XB_TMO])) break; if (sp > XB_SPIN_CAP) { atomicAdd(&bar[XB_TMO], 1u); break; } }
    }
    nloc = mine > 0u ? mine : 1u; nx = cnt > 0u ? cnt : 1u;
}

__device__ __forceinline__ void xcd_barrier(const XcdBarrier& b) {
    asm volatile("s_waitcnt vmcnt(0)" ::: "memory");
    __syncthreads();
    if (xb_thread0_w(b.w, b.z)) {
        unsigned* bar = b.bar;
        __builtin_amdgcn_s_waitcnt(0);
        unsigned nloc = b.st[0], nx = b.st[1];
        if (nloc == 0u) { xcd_barrier_complete(bar, b.x, nloc, nx); b.st[0] = nloc; b.st[1] = nx; }
        const unsigned old = xb_add(&bar[XB_XSUB(b.x)], 1u);
        const unsigned gen = old / nloc;
        if (old + 1u == (gen + 1u) * nloc) {
            __builtin_amdgcn_fence(__ATOMIC_RELEASE, "agent");
            asm volatile("s_waitcnt vmcnt(0)" ::: "memory");
            const unsigned og = xb_add(&bar[XB_TOP], 1u);
            const unsigned tg = og / nx;
            if (og + 1u == (tg + 1u) * nx) xb_add(&bar[XB_TOPGEN], 1u);
            else XB_SPIN(xb_ld(&bar[XB_TOPGEN]) == tg, bar);
            __builtin_amdgcn_fence(__ATOMIC_ACQUIRE, "agent");
            xb_add(&bar[XB_XGEN(b.x)], 1u);
            asm volatile("s_waitcnt vmcnt(0)" ::: "memory");
        } else {
            XB_SPIN(xb_ld(&bar[XB_XGEN(b.x)]) == gen, bar);
            __builtin_amdgcn_fence(__ATOMIC_ACQUIRE, "agent");
            asm volatile("s_waitcnt vmcnt(0)" ::: "memory");
        }
    }
    __syncthreads();
}

struct Frame {
    LAS unsigned char* lds;
    unsigned* ctl;
    int tid, lane, wave, vcu, G, bx, zv, zs, rep;
    unsigned char* ws;
    const float* const* in;
    float* out;
};
#define WSP(T, off) ((T*)(F.ws + (off)))
__device__ __forceinline__ size_t toff(int row, int k, int K) { return (size_t)(row >> 8) * 256 * K + (size_t)(k >> 6) * (256 * 64) + (size_t)(row & 255) * 64 + (k & 63); }

#ifndef TILED_FFN1
#define TILED_FFN1 0
#endif
#ifndef Q8_W1
#define Q8_W1 0.f
#define Q8_W2 0.f
#define Q8_HN 0.f
#define Q8_HID 0.f
#endif
__device__ __forceinline__ int map_row(int kind, int off, int n) { return kind == 0 ? n + off : (kind == 1 ? (n < 1932 ? n : n + 116) : ((n >> 7) * 256 + (n & 127) + off)); }
__device__ __forceinline__ void tr_item(const float* W, int ldw, int N, int ks, int n0, bf16* WT, int ldt, int kd, int kind, int off, LAS unsigned char* scr, int lane, float q8s = 0.f, int tiled = 0) {
    const int nq = (lane & 15) * 4, kq = lane >> 4;
    f32x4 x[16];
#pragma unroll
    for (int i = 0; i < 16; ++i) x[i] = (n0 + nq < N) ? *(const f32x4*)(W + (size_t)(ks + 4 * i + kq) * ldw + n0 + nq) : (f32x4){0.f, 0.f, 0.f, 0.f};
#pragma unroll
    for (int i = 0; i < 16; ++i) { const int k = 4 * i + kq;
#pragma unroll
        for (int c = 0; c < 4; ++c) { float wv = x[i][c]; if (q8s > 0.f) wv = q8r(wv, q8s); *(LAS bf16*)(scr + (nq + c) * 136 + k * 2) = (bf16)f2bf(wv); } }
    LDS_WAIT(); asm volatile("" ::: "memory");
    if (n0 + lane < N) { const LAS v2u* s = (const LAS v2u*)(scr + lane * 136); const int mr = map_row(kind, off, n0 + lane); bf16* dst = tiled ? WT + toff(mr, kd, ldt) : WT + (size_t)mr * ldt + kd;
#pragma unroll
        for (int q = 0; q < 8; ++q) { const v2u a = s[2 * q], b = s[2 * q + 1]; *(v4u*)(dst + 8 * q) = (v4u){a.x, a.y, b.x, b.y}; } }
    LDS_WAIT(); asm volatile("" ::: "memory");
}
__device__ __forceinline__ void conv(Frame& F, const float* W, size_t sW, int nb, int ldw, int N, int ks0, int K, bf16* WT, size_t sWT, int ldt, int kd0, int kind, int off, float q8s = 0.f, int tiled = 0) {
    LAS unsigned char* scr = F.lds + RING_OFF + F.wave * 16384;
    const int gw = F.vcu * NWAVES + F.wave, NGW = F.G * NWAVES;
    const int nblk = (N + 63) / 64, per = (K / 64) * nblk, total = per * nb;
    for (int it = gw; it < total; it += NGW) { const int b = it / per, r = it % per, kb = r / nblk, nbk = r % nblk;
        tr_item(W + (size_t)b * sW, ldw, N, ks0 + 64 * kb, 64 * nbk, WT + (size_t)b * sWT, ldt, kd0 + 64 * kb, kind, off, scr, F.lane, q8s, tiled); }
}
__device__ __forceinline__ void zero_block(Frame& F, bf16* WT, int ldt, int r0, int rows, int c0, int cols, int tiled = 0) {
    const int gt = (F.vcu * NWAVES + F.wave) * 64 + F.lane, NT = F.G * NWAVES * 64, cpr = cols / 8;
    for (int i = gt; i < rows * cpr; i += NT) { const int r = i / cpr, c = i % cpr; const unsigned z = (unsigned)F.zv; *(v4u*)(tiled ? WT + toff(r0 + r, c0 + 8 * c, ldt) : WT + (size_t)(r0 + r) * ldt + c0 + 8 * c) = (v4u){z, z, z, z}; }
}
__device__ __forceinline__ void p_convert(Frame& F, int layer) {
    const int j = layer >> 1;
    conv(F, F.in[2] + (size_t)layer * DM * CIN, 0, 1, CIN, CIN, 0, DM, WSP(bf16, WS_WIN), 0, DM, 0, 1, 0);
    zero_block(F, WSP(bf16, WS_WIN), DM, 1932, 116, 0, DM);
    conv(F, F.in[9] + (size_t)layer * 3 * 256 * DM, (size_t)256 * DM, 3, DM, DM, 0, 256, WSP(bf16, WS_WBR), (size_t)DM * 256, 256, 0, 0, 0);
    conv(F, F.in[10] + (size_t)layer * DM * DM, 0, 1, DM, DM, 0, DM, WSP(bf16, WS_WOUT), 0, DM, 0, 0, 0);
    conv(F, F.in[7] + (size_t)layer * 2 * 2048 * 256, (size_t)2048 * 256, 2, 256, 256, 0, 1024, WSP(bf16, WS_WC1), (size_t)512 * 1024, 1024, 0, 0, 0);
    conv(F, F.in[7] + (size_t)layer * 2 * 2048 * 256, (size_t)2048 * 256, 2, 256, 256, 1024, 1024, WSP(bf16, WS_WC1), (size_t)512 * 1024, 1024, 0, 0, 256);
    if ((layer & 1) == 0) {
        conv(F, F.in[12] + (size_t)j * DM * DFF, 0, 1, DFF, DFF, 0, DM, WSP(bf16, WS_WF1), 0, DM, 0, 2, 0, Q8_W1, TILED_FFN1);
        conv(F, F.in[13] + (size_t)j * DM * DFF, 0, 1, DFF, DFF, 0, DM, WSP(bf16, WS_WF1), 0, DM, 0, 2, 128, Q8_W1, TILED_FFN1);
        zero_block(F, WSP(bf16, WS_WF1), DM, 21 * 256 + 64, 64, 0, DM, TILED_FFN1);
        zero_block(F, WSP(bf16, WS_WF1), DM, 21 * 256 + 128 + 64, 64, 0, DM, TILED_FFN1);
        conv(F, F.in[14] + (size_t)j * DFF * DM, 0, 1, DM, DM, 0, DFF, WSP(bf16, WS_WF2), 0, DFFP, 0, 0, 0, Q8_W2);
        zero_block(F, WSP(bf16, WS_WF2), DFFP, 0, DM, DFF, DFFP - DFF);
    } else {
        conv(F, F.in[16] + (size_t)j * NEXP * DM * DFE, (size_t)DM * DFE, NEXP, DFE, DFE, 0, DM, WSP(bf16, WS_WF1), (size_t)NMOE1 * DM, DM, 0, 2, 0, Q8_W1);
        conv(F, F.in[17] + (size_t)j * NEXP * DM * DFE, (size_t)DM * DFE, NEXP, DFE, DFE, 0, DM, WSP(bf16, WS_WF1), (size_t)NMOE1 * DM, DM, 0, 2, 128, Q8_W1);
        conv(F, F.in[18] + (size_t)j * NEXP * DFE * DM, (size_t)DFE * DM, NEXP, DM, DM, 0, DFE, WSP(bf16, WS_WF2), (size_t)DM * DFE, DFE, 0, 0, 0, Q8_W2);
    }
    if (F.bx < 8) {
        __syncthreads();
        const int kv = F.bx >> 2, jj = (F.bx & 3) * 64 + F.lane;
        const float* pos = F.in[6] + (size_t)(layer * 2 + kv) * 2048; const float* w1 = F.in[7] + (size_t)(layer * 2 + kv) * 2048 * 256;
        float a = 0.f;
        float a1 = 0.f, a2 = 0.f, a3 = 0.f;
#pragma unroll 8
        for (int k = 0; k < 256; k += 4) { const int kk = F.wave * 256 + k;
            a += pos[kk] * w1[(size_t)kk * 256 + jj]; a1 += pos[kk + 1] * w1[(size_t)(kk + 1) * 256 + jj]; a2 += pos[kk + 2] * w1[(size_t)(kk + 2) * 256 + jj]; a3 += pos[kk + 3] * w1[(size_t)(kk + 3) * 256 + jj]; }
        a = (a + a1) + (a2 + a3);
        LAS float* red = (LAS float*)(F.lds + RING_OFF);
        red[F.wave * 64 + F.lane] = a;
        __syncthreads();
        if (F.wave == 0) { float s = 0.f;
#pragma unroll
            for (int w = 0; w < 8; ++w) s += red[w * 64 + F.lane];
            WSP(float, WS_BIAS1)[kv * 256 + jj] = s; }
        __syncthreads();
    }
    if (layer == 0) {
        const int gt = (F.vcu * NWAVES + F.wave) * 64 + F.lane, NT = F.G * NWAVES * 64;
        for (int idx = gt; idx < SEQ * 8; idx += NT) { const int pos = idx >> 3, i = idx & 7;
            const double invf = ROPE_INVF[i];
            double rev = (double)pos * invf * 0.15915494309189535; rev -= __builtin_floor(rev);
            WSP(float, WS_ROPE)[idx] = __builtin_amdgcn_cosf((float)rev); WSP(float, WS_ROPE)[SEQ * 8 + idx] = __builtin_amdgcn_sinf((float)rev); }
    }
}

template <int MODE> __device__ __forceinline__ void p_norm(Frame& F, const float* src, const float* g, const float* rw, int jmoe, float q8s = 0.f, int tiled = 0) {
    const int gw = F.vcu * NWAVES + F.wave, NGW = F.G * NWAVES, lane = F.lane;
    LAS int* hist = (LAS int*)(F.lds + TAB_OFF) + 192;
    if (MODE == 1) {
        if (F.tid < 32) hist[F.tid] = 0;
        const int gt = gw * 64 + lane, NT = NGW * 64; int* tm = WSP(int, WS_TOKMAP);
        for (int i = gt; i < 4 * SLOTS; i += NT) tm[i] = -1;
        for (int i = F.tid; i < DM * NEXP / 4; i += NWAVES * 64) *(LAS f32x4*)(F.lds + RING_OFF + 16 * i) = ((const f32x4*)rw)[i];
        __syncthreads();
    }
    f32x4 gv[4];
#pragma unroll
    for (int jx = 0; jx < 4; ++jx) gv[jx] = ((const f32x4*)g)[lane + 64 * jx];
    constexpr int ROWS = (MODE == 1) ? 2 : 4;
    for (int m0 = gw; m0 < MTOK; m0 += ROWS * NGW) {
        f32x4 v[ROWS][4]; float ss[ROWS];
#pragma unroll
        for (int u = 0; u < ROWS; ++u) { const int m = m0 + u * NGW; const f32x4* xr = (const f32x4*)(src + (size_t)(m < MTOK ? m : m0) * DM) + lane;
#pragma unroll
            for (int jx = 0; jx < 4; ++jx) v[u][jx] = xr[64 * jx]; }
#pragma unroll
        for (int u = 0; u < ROWS; ++u) { float s = 0.f;
#pragma unroll
            for (int jx = 0; jx < 4; ++jx) s += (v[u][jx].x * v[u][jx].x + v[u][jx].y * v[u][jx].y) + (v[u][jx].z * v[u][jx].z + v[u][jx].w * v[u][jx].w);
            ss[u] = s; }
#pragma unroll
        for (int o = 1; o < 64; o <<= 1) {
#pragma unroll
            for (int u = 0; u < ROWS; ++u) ss[u] += __builtin_bit_cast(float, __builtin_amdgcn_ds_bpermute((lane ^ o) << 2, __builtin_bit_cast(int, ss[u]))); }
        float lgall[MODE == 1 ? ROWS : 1][8];
        if (MODE == 1) {
            float rs[ROWS];
#pragma unroll
            for (int u = 0; u < ROWS; ++u) { rs[u] = 1.0f / sqrtf(ss[u] * (1.f / DM) + EPS);
#pragma unroll
                for (int e = 0; e < 8; ++e) lgall[u][e] = 0.f; }
#pragma unroll
            for (int jx = 0; jx < 4; ++jx) { const LAS f32x4* wr = (const LAS f32x4*)(F.lds + RING_OFF + (size_t)(4 * lane + 256 * jx) * 32);
#pragma unroll
                for (int r = 0; r < 4; ++r) { const f32x4 a = wr[2 * r], b = wr[2 * r + 1];
#pragma unroll
                    for (int u = 0; u < ROWS; ++u) { const float xv = v[u][jx][r] * rs[u] * gv[jx][r];
                        lgall[u][0] += xv * a.x; lgall[u][1] += xv * a.y; lgall[u][2] += xv * a.z; lgall[u][3] += xv * a.w; lgall[u][4] += xv * b.x; lgall[u][5] += xv * b.y; lgall[u][6] += xv * b.z; lgall[u][7] += xv * b.w; } } }
        }
#pragma unroll
        for (int u = 0; u < ROWS; ++u) { const int m = m0 + u * NGW; if (m >= MTOK) continue;
            const float rstd = 1.0f / sqrtf(ss[u] * (1.f / DM) + EPS);
#pragma unroll
            for (int jx = 0; jx < 4; ++jx) v[u][jx] = v[u][jx] * rstd * gv[jx];
            if (MODE == 2) {
                f32x4* o = (f32x4*)(F.out + (size_t)m * DM) + lane;
#pragma unroll
                for (int jx = 0; jx < 4; ++jx) o[64 * jx] = v[u][jx];
            } else {
                unsigned long long* o8 = (unsigned long long*)(WSP(bf16, WS_HN) + (size_t)m * DM) + lane;
#pragma unroll
                for (int jx = 0; jx < 4; ++jx) { f32x4 w = v[u][jx];
                    if (tiled) { *(unsigned long long*)(WSP(bf16, WS_HN) + toff(m, 4 * lane + 256 * jx, DM)) = (unsigned long long)pk2(w.x, w.y) | ((unsigned long long)pk2(w.z, w.w) << 32); continue; } if (q8s > 0.f) { w.x = q8r(w.x, q8s); w.y = q8r(w.y, q8s); w.z = q8r(w.z, q8s); w.w = q8r(w.w, q8s); }
                    o8[64 * jx] = (unsigned long long)pk2(w.x, w.y) | ((unsigned long long)pk2(w.z, w.w) << 32); }
            }
            if (MODE == 1) {
                float lg[8];
#pragma unroll
                for (int e = 0; e < 8; ++e) lg[e] = lgall[u][e];
                float h4[4], h2[2], h1;
                { const bool up = lane & 1;
#pragma unroll
                  for (int i = 0; i < 4; ++i) { const float keep = up ? lg[4 + i] : lg[i], send = up ? lg[i] : lg[4 + i]; h4[i] = keep + __builtin_bit_cast(float, bperm(lane ^ 1, __builtin_bit_cast(int, send))); } }
                { const bool up = lane & 2;
#pragma unroll
                  for (int i = 0; i < 2; ++i) { const float keep = up ? h4[2 + i] : h4[i], send = up ? h4[i] : h4[2 + i]; h2[i] = keep + __builtin_bit_cast(float, bperm(lane ^ 2, __builtin_bit_cast(int, send))); } }
                { const bool up = lane & 4; const float keep = up ? h2[1] : h2[0], send = up ? h2[0] : h2[1]; h1 = keep + __builtin_bit_cast(float, bperm(lane ^ 4, __builtin_bit_cast(int, send))); }
                h1 += __builtin_bit_cast(float, bperm(lane ^ 8, __builtin_bit_cast(int, h1))); h1 += __builtin_bit_cast(float, bperm(lane ^ 16, __builtin_bit_cast(int, h1))); h1 += __builtin_bit_cast(float, bperm(lane ^ 32, __builtin_bit_cast(int, h1)));
                lg[0] = rdlane(h1, 0); lg[1] = rdlane(h1, 4); lg[2] = rdlane(h1, 2); lg[3] = rdlane(h1, 6); lg[4] = rdlane(h1, 1); lg[5] = rdlane(h1, 5); lg[6] = rdlane(h1, 3); lg[7] = rdlane(h1, 7);
                int e0 = 0; float v0 = lg[0];
#pragma unroll
                for (int e = 1; e < 8; ++e) if (lg[e] > v0) { v0 = lg[e]; e0 = e; }
                int e1 = -1; float v1 = -INFINITY;
#pragma unroll
                for (int e = 0; e < 8; ++e) if (e != e0 && lg[e] > v1) { v1 = lg[e]; e1 = e; }
                const float w0 = 1.0f / (1.0f + fexp(v1 - v0)), w1 = 1.0f - w0;
                if (lane == 0) { WSP(v4i, WS_ROUTE)[m] = (v4i){e0, e1, __builtin_bit_cast(int, w0), __builtin_bit_cast(int, w1)};
                    const int c = m / MC; if (!F.rep) { atomicAdd((int*)&hist[(c * 2 + 0) * 8 + e0], 1); atomicAdd((int*)&hist[(c * 2 + 1) * 8 + e1], 1); } }
            }
        }
    }
    if (MODE == 1) {
        __syncthreads();
        if (F.tid < 32) { const int h = hist[F.tid]; if (h) atomicAdd(F.ctl + CW_CNT + jmoe * 32 + F.tid, (unsigned)h); }
    }
}

__device__ __forceinline__ void p_prep(Frame& F) {
    const int gw = F.vcu * NWAVES + F.wave, NGW = F.G * NWAVES, lane = F.lane;
    bf16* P1 = WSP(bf16, WS_P1); bf16* KVC = WSP(bf16, WS_KVC); const float* rope = WSP(float, WS_ROPE);
    const int vec = lane >> 3, ri = lane & 7; const int cb = vec < 4 ? C_CQ + vec * 64 : (vec == 4 ? C_KCMP : (vec == 5 ? C_KSLC : C_KWIN));
    for (int row0 = gw; row0 < MC; row0 += 4 * NGW) {
        float x1[4], x2[4], cc[4], ss[4]; bf16 kc48[4], vc64[4];
#pragma unroll
        for (int k = 0; k < 4; ++k) { const int row = row0 + k * NGW < MC ? row0 + k * NGW : row0; const bf16* p = P1 + (size_t)row * P1W; const int pos = row & (SEQ - 1);
            const int cl = lane < 56 ? cb + ri : C_CQ;
            x1[k] = bf1(p[cl]); x2[k] = bf1(p[cl + 8]); cc[k] = rope[pos * 8 + ri]; ss[k] = rope[SEQ * 8 + pos * 8 + ri];
            if (F.rep) { cc[k] = 1.f; ss[k] = 0.f; }
            kc48[k] = p[C_KCMP + 16 + (lane < 48 ? lane : 0)]; vc64[k] = p[C_VCMP + lane]; }
#pragma unroll
        for (int k = 0; k < 4; ++k) { const int row = row0 + k * NGW; if (row >= MC) continue; bf16* p = P1 + (size_t)row * P1W;
            if (lane < 56) { const bf16 o1 = (bf16)f2bf(x1[k] * cc[k] - x2[k] * ss[k]), o2 = (bf16)f2bf(x2[k] * cc[k] + x1[k] * ss[k]);
                p[cb + ri] = o1; p[cb + ri + 8] = o2;
                if (vec == 4) { KVC[(size_t)row * 64 + ri] = o1; KVC[(size_t)row * 64 + ri + 8] = o2; } }
            if (lane < 48) KVC[(size_t)row * 64 + 16 + lane] = kc48[k];
            KVC[(size_t)MC * 64 + (size_t)row * 64 + lane] = vc64[k]; }
    }
    bf16* VT = WSP(bf16, WS_VT);
    for (int it = gw; it < 6 * BC * 64; it += NGW) { const int which = it / (BC * 64), r = it % (BC * 64), b = r >> 6, blk = r & 63;
        const v4u* src = (const v4u*)(P1 + ((size_t)b * SEQ + blk * 64 + lane) * P1W + (which == 0 ? C_VSLC : (which == 1 ? C_VWIN : C_SBV + (which - 2) * 64)));
        bf16* dst = VT + ((size_t)(which * BC + b) * 64) * SEQ + blk * 64 + lane;
        v4u xs[8];
#pragma unroll
        for (int i = 0; i < 8; ++i) xs[i] = src[i];
#pragma unroll
        for (int i = 0; i < 8; ++i) { const v4u x = xs[i];
            dst[(size_t)(8 * i + 0) * SEQ] = (bf16)(x.x & 0xffffu); dst[(size_t)(8 * i + 1) * SEQ] = (bf16)(x.x >> 16);
            dst[(size_t)(8 * i + 2) * SEQ] = (bf16)(x.y & 0xffffu); dst[(size_t)(8 * i + 3) * SEQ] = (bf16)(x.y >> 16);
            dst[(size_t)(8 * i + 4) * SEQ] = (bf16)(x.z & 0xffffu); dst[(size_t)(8 * i + 5) * SEQ] = (bf16)(x.z >> 16);
            dst[(size_t)(8 * i + 6) * SEQ] = (bf16)(x.w & 0xffffu); dst[(size_t)(8 * i + 7) * SEQ] = (bf16)(x.w >> 16); }
    }
}
__device__ __forceinline__ void p_sgu(Frame& F, int layer) {
    LAS float* vn = (LAS float*)(F.lds + RING_OFF);
    const bf16* P1 = WSP(bf16, WS_P1); bf16* Ya = WSP(bf16, WS_Y);
    const float* gain = F.in[3] + (size_t)layer * 256; const float* sw = F.in[4] + (size_t)layer * 4 * 128 * 128; const float* sb = F.in[5] + (size_t)layer * 4 * 128;
    const int lane = F.lane, wave = F.wave;
    for (int item = F.vcu; item < MC / 128; item += F.G) {
        const size_t r0 = (size_t)item * 128;
        __syncthreads();
        for (int rr = 0; rr < 16; ++rr) { const int r = wave * 16 + rr; const v2u raw = *(const v2u*)(P1 + (r0 + r) * P1W + C_V + 4 * lane);
            const float a = bflo(raw.x), b = bfhi(raw.x), c = bflo(raw.y), d = bfhi(raw.y);
            const float rstd = 1.0f / sqrtf(wave_sum((a * a + b * b) + (c * c + d * d), lane) * (1.f / 256.f) + EPS);
            const f32x4 gg = ((const f32x4*)gain)[lane];
            *(LAS f32x4*)(vn + r * 256 + 4 * lane) = (f32x4){a * rstd * gg.x, b * rstd * gg.y, c * rstd * gg.z, d * rstd * gg.w}; }
        __syncthreads();
        const int g = wave & 3, half = wave >> 2;
        for (int i = 0; i < 64; ++i) { const int t = 2 * i + half;
            const float* wrow = sw + ((size_t)g * 128 + t) * 128;
            const float w_lo = wrow[lane], w_hi = wrow[64 + lane];
            float acc = 0.f;
            for (int s = 0; s <= t; ++s) { const float w = (s < 64) ? rdlane(w_lo, s) : rdlane(w_hi, s - 64); acc += w * vn[s * 256 + g * 64 + lane]; }
            const float u = bf1(P1[(r0 + t) * P1W + C_U + g * 64 + lane]);
#ifdef ABL_SGUMIX
            acc = 0.f;
#endif
            Ya[(r0 + t) * 256 + g * 64 + lane] = (bf16)f2bf(u * (acc + sb[g * 128 + t])); }
    }
    __syncthreads();
}

__device__ __forceinline__ void p_cmpfin(Frame& F, int layer) {
    const int gw = F.vcu * NWAVES + F.wave, NGW = F.G * NWAVES, lane = F.lane;
    const float* UL = WSP(float, WS_UL); const float* bias = WSP(float, WS_BIAS1); bf16* KC = WSP(bf16, WS_KC);
    LAS float* w2l = (LAS float*)(F.lds + RING_OFF);
    __syncthreads();
    { const f32x4* src = (const f32x4*)(F.in[8] + (size_t)layer * 2 * 256 * 64);
#pragma unroll 4
      for (int i = F.tid; i < 2 * 256 * 64 / 4; i += NWAVES * 64) *(LAS f32x4*)(w2l + 4 * i) = src[i]; }
    __syncthreads();
    for (int it = gw; it < 2 * BC * 255; it += NGW) { const int kv = it / (BC * 255), r = it % (BC * 255), b = r / 255, m = r % 255;
        const LAS float* w2 = w2l + kv * 256 * 64;
        const float* U = UL + (size_t)(kv * 2048 + b * 256 + m) * 512; const float* L = U + 512 + 256;
        float hv[4];
#pragma unroll
        for (int q = 0; q < 4; ++q) hv[q] = pg8::gelu_tanh(U[64 * q + lane] + L[64 * q + lane] + bias[kv * 256 + 64 * q + lane]);
        float acc0 = 0.f, acc1 = 0.f;
#pragma unroll
        for (int q = 0; q < 4; ++q)
#pragma unroll 8
            for (int jj = 0; jj < 64; jj += 2) { acc0 += rdlane(hv[q], jj) * w2[(64 * q + jj) * 64 + lane]; acc1 += rdlane(hv[q], jj + 1) * w2[(64 * q + jj + 1) * 64 + lane]; }
        const float acc = acc0 + acc1;
        KC[((size_t)(kv * BC + b) * 256 + m) * 64 + lane] = (bf16)f2bf(acc);
        if (kv == 1) { WSP(bf16, WS_KCT)[((size_t)b * 64 + lane) * 256 + m] = (bf16)f2bf(acc); if (m == 254) WSP(bf16, WS_KCT)[((size_t)b * 64 + lane) * 256 + 255] = (bf16)0; }
        else if (m == 254) KC[((size_t)b * 256 + 255) * 64 + lane] = (bf16)0; }
    __syncthreads();
}

__device__ __forceinline__ void p_stick(Frame& F) {
    const int gw = F.vcu * NWAVES + F.wave, NGW = F.G * NWAVES, lane = F.lane;
    const bf16* P1 = WSP(bf16, WS_P1); bf16* Yb = WSP(bf16, WS_Y) + (size_t)MC * 256;
    for (int item = gw; item < BC * 4 * 64; item += NGW) { const int tb = item & 63, h = (item >> 6) & 3, b = item >> 8;
        const int t = tb * 64 + lane; const size_t row = (size_t)b * SEQ + t;
        unsigned q[32];
        { const v4u* qp = (const v4u*)(P1 + row * P1W + C_SBQ + h * 64);
#pragma unroll
          for (int i = 0; i < 8; ++i) { const v4u x = qp[i]; q[4 * i] = x.x; q[4 * i + 1] = x.y; q[4 * i + 2] = x.z; q[4 * i + 3] = x.w; } }
        float o[64];
#pragma unroll
        for (int d = 0; d < 64; ++d) o[d] = 0.f;
        float R = 0.f;
        const bf16* kb = P1 + (size_t)b * SEQ * P1W + C_SBK + h * 64; const bf16* vb = P1 + (size_t)b * SEQ * P1W + C_SBV + h * 64;
        for (int s = t - 1; s >= 0; --s) {
            if (R < -100.f) break;
            const v4u* kp = (const v4u*)(kb + (size_t)s * P1W); const v4u* vp = (const v4u*)(vb + (size_t)s * P1W);
            float z0 = 0.f, z1 = 0.f;
#pragma unroll
            for (int i = 0; i < 8; ++i) { const v4u k = kp[i]; z0 = dot2bf(k.x, q[4 * i], z0); z1 = dot2bf(k.y, q[4 * i + 1], z1); z0 = dot2bf(k.z, q[4 * i + 2], z0); z1 = dot2bf(k.w, q[4 * i + 3], z1); }
            const float z = (z0 + z1) * 0.125f;
            const float tt = 0.6931471805599453f * __builtin_amdgcn_logf(1.0f + fexp(-__builtin_fabsf(z)));
            const float lb = fminf(z, 0.f) - tt, l1m = fminf(-z, 0.f) - tt;
            const float a = fexp(lb + R); R += l1m;
#pragma unroll
            for (int i = 0; i < 8; ++i) { const v4u v = vp[i];
                o[8 * i] += a * bflo(v.x); o[8 * i + 1] += a * bfhi(v.x); o[8 * i + 2] += a * bflo(v.y); o[8 * i + 3] += a * bfhi(v.y);
                o[8 * i + 4] += a * bflo(v.z); o[8 * i + 5] += a * bfhi(v.z); o[8 * i + 6] += a * bflo(v.w); o[8 * i + 7] += a * bfhi(v.w); }
        }
        v4u* op = (v4u*)(Yb + row * 256 + h * 64);
#pragma unroll
        for (int i = 0; i < 8; ++i) op[i] = (v4u){pk2(o[8 * i], o[8 * i + 1]), pk2(o[8 * i + 2], o[8 * i + 3]), pk2(o[8 * i + 4], o[8 * i + 5]), pk2(o[8 * i + 6], o[8 * i + 7])};
    }
}

struct Soft { float mx, l; };
__device__ __forceinline__ float dotq(const LAS v4u* ql, const bf16* kp_) {
    const v4u* kp = (const v4u*)kp_; float z0 = 0.f, z1 = 0.f;
#pragma unroll
    for (int i = 0; i < 8; ++i) { const v4u k = kp[i]; const v4u q = ql[i]; z0 = dot2bf(k.x, q.x, z0); z1 = dot2bf(k.y, q.y, z1); z0 = dot2bf(k.z, q.z, z0); z1 = dot2bf(k.w, q.w, z1); }
    return (z0 + z1) * 0.125f;
}
__device__ __forceinline__ void axpy_row(float p, const bf16* vp_, float (&o)[64]) {
    const v4u* vp = (const v4u*)vp_;
#pragma unroll
    for (int i = 0; i < 8; ++i) { const v4u v = vp[i];
        o[8 * i] += p * bflo(v.x); o[8 * i + 1] += p * bfhi(v.x); o[8 * i + 2] += p * bflo(v.y); o[8 * i + 3] += p * bfhi(v.y);
        o[8 * i + 4] += p * bflo(v.z); o[8 * i + 5] += p * bfhi(v.z); o[8 * i + 6] += p * bflo(v.w); o[8 * i + 7] += p * bfhi(v.w); }
}
__device__ __forceinline__ void nsa_step(const LAS v4u* ql, const bf16* kp_, const bf16* vp_, Soft& S, float (&o)[64]) {
    const float s = dotq(ql, kp_);
    if (s > S.mx) { const float sc = fexp(S.mx - s); S.l *= sc;
#pragma unroll
        for (int d = 0; d < 64; ++d) o[d] *= sc;
        S.mx = s; }
    const float p = fexp(s - S.mx); S.l += p;
    asm volatile("" ::: "memory");
    axpy_row(p, vp_, o);
}
__device__ __forceinline__ void nsa_accum(bf16* yrow, bool first, float sc, const float (&o)[64]) {
    v4u* op = (v4u*)yrow;
#pragma unroll
    for (int i = 0; i < 8; ++i) { v4u old = (v4u){0u, 0u, 0u, 0u}; if (!first) old = op[i];
        op[i] = (v4u){pk2(bflo(old.x) + sc * o[8 * i], bfhi(old.x) + sc * o[8 * i + 1]), pk2(bflo(old.y) + sc * o[8 * i + 2], bfhi(old.y) + sc * o[8 * i + 3]),
                      pk2(bflo(old.z) + sc * o[8 * i + 4], bfhi(old.z) + sc * o[8 * i + 5]), pk2(bflo(old.w) + sc * o[8 * i + 6], bfhi(old.w) + sc * o[8 * i + 7])}; }
}
__device__ __forceinline__ void p_nsa(Frame& F) {
    const int gw = F.vcu * NWAVES + F.wave, NGW = F.G * NWAVES, lane = F.lane;
    const bf16* P1 = WSP(bf16, WS_P1); const bf16* KC = WSP(bf16, WS_KC); bf16* Yc = WSP(bf16, WS_Y) + (size_t)2 * MC * 256;
    LAS float* imp = (LAS float*)(F.lds + RING_OFF + F.wave * 4096);
    LAS v4u* ql = (LAS v4u*)(F.lds + RING_OFF + 32768 + F.wave * 9216 + lane * 144);
    const int qi = lane >> 2, h = lane & 3;
    for (int item = gw; item < BC * 256; item += NGW) { const int b = item >> 8, tg = item & 255;
        const int t = tg * 16 + qi; const size_t row = (size_t)b * SEQ + t; const bf16* prow = P1 + row * P1W;
        { const v4u* qp = (const v4u*)(prow + C_CQ + h * 64);
#pragma unroll
          for (int i = 0; i < 8; ++i) ql[i] = qp[i]; }
        const float g0 = bf1(prow[C_CG + h * 3]), g1 = bf1(prow[C_CG + h * 3 + 1]), g2 = bf1(prow[C_CG + h * 3 + 2]);
        bf16* yrow = Yc + row * 256 + h * 64;
        float o[64];
        for (int i = lane; i < 1024; i += 64) imp[i] = 0.f;
        const int nv = t >= 31 ? ((t - 31) >> 4) + 1 : 0; const int nvmax = (tg * 16 + 15 >= 31) ? ((tg * 16 + 15 - 31) >> 4) + 1 : 0;
        const bf16* kc = KC + (size_t)(0 * BC + b) * 256 * 64; const bf16* vc = KC + (size_t)(1 * BC + b) * 256 * 64;
        { float mx = -INFINITY, l = 0.f;
          for (int m = 0; m < nvmax; ++m) { const float s = dotq(ql, kc + m * 64); if (m < nv) { if (s > mx) { l *= fexp(mx - s); mx = s; } l += fexp(s - mx); } }
          const float rl = l > 0.f ? 1.0f / l : 0.f;
#pragma unroll
          for (int d = 0; d < 64; ++d) o[d] = 0.f;
          for (int m = 0; m < nvmax; ++m) { const float s = dotq(ql, kc + m * 64); const float p = (m < nv) ? fexp(s - mx) * rl : 0.f;
              asm volatile("" ::: "memory");
              axpy_row(p, vc + m * 64, o);
              float P = p + __builtin_bit_cast(float, bperm(lane ^ 1, __builtin_bit_cast(int, p))); P += __builtin_bit_cast(float, bperm(lane ^ 2, __builtin_bit_cast(int, P)));
              if (h == 0) { const int j0 = m >> 2; const bool edge = (m & 3) == 3; imp[qi * 64 + j0] += edge ? 0.5f * P : P; if (edge) imp[qi * 64 + j0 + 1] += 0.5f * P; } }
          nsa_accum(yrow, true, g0, o); }
        unsigned long long mask = 0ull;
        { const int cur = t >> 6, nvb = cur + 1;
          if (h == 0) {
              if (nvb <= 16) mask = (1ull << nvb) - 1ull;
              else { mask = 1ull | (1ull << cur);
                  for (int r = 0; r < 14; ++r) { int best = -1; float bv = -1.f;
                      for (int j = 1; j < cur; ++j) { const float v = imp[qi * 64 + j]; if (!((mask >> j) & 1ull) && v > bv) { bv = v; best = j; } }
                      mask |= 1ull << best; } } }
          const unsigned mlo = (unsigned)bperm(lane & ~3, (int)(unsigned)mask), mhi = (unsigned)bperm(lane & ~3, (int)(unsigned)(mask >> 32));
          mask = ((unsigned long long)mhi << 32) | mlo; }
        { Soft S{-INFINITY, 0.f};
#pragma unroll
          for (int d = 0; d < 64; ++d) o[d] = 0.f;
          const bf16* kb = P1 + (size_t)b * SEQ * P1W + C_KSLC; const bf16* vb = P1 + (size_t)b * SEQ * P1W + C_VSLC;
          unsigned long long mm = mask;
          while (mm) { const int j = __builtin_ctzll(mm); mm &= mm - 1ull;
              for (int kk = 0; kk < 64; ++kk) { const int sp = j * 64 + kk; if (sp > t) break; nsa_step(ql, kb + (size_t)sp * P1W, vb + (size_t)sp * P1W, S, o); } }
          nsa_accum(yrow, false, g1 / S.l, o); }
        { Soft S{-INFINITY, 0.f};
#pragma unroll
          for (int d = 0; d < 64; ++d) o[d] = 0.f;
          const bf16* kb = P1 + (size_t)b * SEQ * P1W + C_KWIN; const bf16* vb = P1 + (size_t)b * SEQ * P1W + C_VWIN;
          for (int i = 0; i < 512; ++i) { const int sp = t - 511 + i; if (sp >= 0) nsa_step(ql, kb + (size_t)sp * P1W, vb + (size_t)sp * P1W, S, o); }
          nsa_accum(yrow, false, g2 / S.l, o); }
    }
}

__device__ __forceinline__ int moe_table(Frame& F, int jmoe, int c, int r) {
    LAS int* tab = (LAS int*)(F.lds + TAB_OFF);
    __syncthreads();
    if (F.tid < 8) tab[176 + F.tid] = (int)__hip_atomic_load(F.ctl + CW_CNT + jmoe * 32 + (c * 2 + r) * 8 + F.tid, __ATOMIC_RELAXED, __HIP_MEMORY_SCOPE_AGENT);
    __syncthreads();
    if (F.tid == 0) { int base = 0, T = 0;
        for (int e = 0; e < 8; ++e) { const int cnt = tab[176 + e];
            const int nt = (cnt + 255) >> 8; tab[160 + e] = base; for (int i = 0; i < nt && T + i < 160; ++i) tab[T + i] = e; T += nt; base += nt * 256; }
        tab[168] = T < 136 ? T : 136; }
    __syncthreads();
    return tab[168];
}
__device__ __forceinline__ void p_gather(Frame& F, int jmoe, int c, int r, int nbusy = 0) {
    if (F.bx < nbusy) return;
    moe_table(F, jmoe, c, r);
    const LAS int* tab = (const LAS int*)(F.lds + TAB_OFF);
    const int gw = (F.bx - nbusy) * NWAVES + F.wave, NGW = (F.G - nbusy) * NWAVES, lane = F.lane;
    const v4i* route = WSP(v4i, WS_ROUTE); int* tokmap = WSP(int, WS_TOKMAP) + (c * 2 + r) * SLOTS; float* wslot = WSP(float, WS_WSLOT) + (c * 2 + r) * SLOTS;
    const bf16* HN = WSP(bf16, WS_HN); bf16* XG = WSP(bf16, WS_XG);
    unsigned* cur = F.ctl + CW_CUR + jmoe * 32 + (c * 2 + r) * 8;
    for (int tg = gw; tg < MC / 16; tg += NGW) {
        const int m = c * MC + tg * 16 + (lane & 15); const v4i rt = route[m];
        const int e = lane < 16 ? (r ? rt.y : rt.x) : -1; const float w = __builtin_bit_cast(float, r ? rt.w : rt.z);
        unsigned long long bal[8]; int mycnt = 0;
#pragma unroll
        for (int ee = 0; ee < 8; ++ee) { bal[ee] = __builtin_amdgcn_ballot_w64(e == ee); if (lane == ee) mycnt = __builtin_popcountll(bal[ee]); }
        unsigned basep = 0; if (lane < 8 && mycnt > 0) basep = atomicAdd(cur + lane, (unsigned)mycnt);
        const int mybase = bperm(e < 0 ? 0 : e, (int)basep);
        int pos = 0;
#pragma unroll
        for (int ee = 0; ee < 8; ++ee) if (e == ee) pos = mybase + __builtin_popcountll(bal[ee] & ((1ull << lane) - 1ull));
        int slot = 0;
        if (lane < 16) { slot = tab[160 + e] + pos; tokmap[slot] = m; wslot[slot] = w; }
#pragma unroll
        for (int i0 = 0; i0 < 16; i0 += 4) { v4u x[8];
#pragma unroll
            for (int i = 0; i < 4; ++i) { const int mi = __builtin_amdgcn_readlane(m, i0 + i); const v4u* src = (const v4u*)(HN + (size_t)mi * DM); x[2 * i] = src[lane]; x[2 * i + 1] = src[64 + lane]; }
#pragma unroll
            for (int i = 0; i < 4; ++i) { const int si = __builtin_amdgcn_readlane(slot, i0 + i); v4u* dst = (v4u*)(XG + (size_t)si * DM); dst[lane] = x[2 * i]; dst[64 + lane] = x[2 * i + 1]; } }
    }
}

typedef float f32x16 __attribute__((ext_vector_type(16)));
typedef short bf16x8v __attribute__((ext_vector_type(8)));
typedef float f32x2v __attribute__((ext_vector_type(2)));
constexpr int NSA_K = 0, NSA_V = 8192, NSA_BUF = 17408, NSA_STAGE = 2 * NSA_BUF, NSA_IMP = 69632, NSA_CARRY = 86016, NSA_SEL = 103424, NSA_WSF = 103936;
constexpr float NSA_C2 = 0.125f * 1.4426950408889634f;
__device__ __forceinline__ unsigned cvtpk(float lo, float hi) { f32x2v v = {lo, hi}; bf16x2_t b = __builtin_convertvector(v, bf16x2_t); return __builtin_bit_cast(unsigned, b); }
__device__ __forceinline__ float partner32(float v, int lane) { return __builtin_bit_cast(float, __builtin_amdgcn_ds_bpermute((lane ^ 32) << 2, __builtin_bit_cast(int, v))); }
__device__ __forceinline__ void nsa_load(v4u& kx, v4u& vx, const bf16* Kg, int kp, const bf16* Vg, int vp, int tid) {
    kx = *(const v4u*)(Kg + (size_t)(tid & 63) * kp + (tid >> 6) * 8); vx = *(const v4u*)(Vg + (size_t)(tid >> 3) * vp + (tid & 7) * 8);
}
__device__ __forceinline__ void nsa_store(LAS unsigned char* lds, const v4u& kx, const v4u& vx, int tid) {
    *(LAS v4u*)(lds + NSA_K + (tid >> 6) * 1024 + (tid & 63) * 16) = kx; *(LAS v4u*)(lds + NSA_V + (tid >> 3) * 144 + (tid & 7) * 16) = vx;
}
__device__ __forceinline__ void nsa_qk(const LAS unsigned char* lds, const bf16x8v (&qr)[4], f32x16& p0, f32x16& p1, int r32, int hi) {
#pragma unroll
    for (int i = 0; i < 16; ++i) { p0[i] = 0.f; p1[i] = 0.f; }
#pragma unroll
    for (int d0 = 0; d0 < 4; ++d0) {
        const bf16x8v k0 = *(const LAS bf16x8v*)(lds + NSA_K + (2 * d0 + hi) * 1024 + r32 * 16);
        const bf16x8v k1 = *(const LAS bf16x8v*)(lds + NSA_K + (2 * d0 + hi) * 1024 + 512 + r32 * 16);
        p0 = __builtin_amdgcn_mfma_f32_32x32x16_bf16(k0, qr[d0], p0, 0, 0, 0);
        p1 = __builtin_amdgcn_mfma_f32_32x32x16_bf16(k1, qr[d0], p1, 0, 0, 0);
    }
#pragma unroll
    for (int i = 0; i < 16; ++i) { p0[i] *= NSA_C2; p1[i] *= NSA_C2; }
}
__device__ __forceinline__ void nsa_mask(f32x16& p0, f32x16& p1, int hi, int hiL, int loL, bool rowok, bool full  ) {
    if (full) {
#pragma unroll
        for (int i = 0; i < 16; ++i) { p0[i] = rowok ? p0[i] : -INFINITY; p1[i] = rowok ? p1[i] : -INFINITY; }
        return; }
#pragma unroll
    for (int i = 0; i < 16; ++i) { const int kk = (i & 3) + 8 * (i >> 2) + 4 * hi;
        if (!(rowok && kk <= hiL && kk > loL)) p0[i] = -INFINITY;
        if (!(rowok && kk + 32 <= hiL && kk + 32 > loL)) p1[i] = -INFINITY; }
}
__device__ __forceinline__ float nsa_max32(const f32x16& p0, const f32x16& p1) {
    float a = fmaxf(fmaxf(p0[0], p0[1]), p1[0]), b = fmaxf(fmaxf(p0[2], p0[3]), p1[1]); a = fmaxf(fmaxf(a, p1[2]), p1[3]);
#pragma unroll
    for (int i = 4; i < 16; i += 4) { a = fmaxf(fmaxf(a, p0[i]), p0[i + 1]); b = fmaxf(fmaxf(b, p0[i + 2]), p0[i + 3]); a = fmaxf(fmaxf(a, p1[i]), p1[i + 1]); b = fmaxf(fmaxf(b, p1[i + 2]), p1[i + 3]); }
    return fmaxf(a, b);
}
__device__ __forceinline__ void nsa_pv(const LAS unsigned char* lds, const f32x16& p0, const f32x16& p1, f32x16 (&o)[2], int r32, int hi) {
    bf16x8v pa[4];
#pragma unroll
    for (int s = 0; s < 2; ++s) {
        const v4u a = (v4u){cvtpk(p0[8 * s], p0[8 * s + 1]), cvtpk(p0[8 * s + 2], p0[8 * s + 3]), cvtpk(p0[8 * s + 4], p0[8 * s + 5]), cvtpk(p0[8 * s + 6], p0[8 * s + 7])};
        const v4u b = (v4u){cvtpk(p1[8 * s], p1[8 * s + 1]), cvtpk(p1[8 * s + 2], p1[8 * s + 3]), cvtpk(p1[8 * s + 4], p1[8 * s + 5]), cvtpk(p1[8 * s + 6], p1[8 * s + 7])};
        pa[s] = __builtin_bit_cast(bf16x8v, a); pa[2 + s] = __builtin_bit_cast(bf16x8v, b); }
#pragma unroll
    for (int db = 0; db < 2; ++db) { const LAS unsigned char* vrow = lds + NSA_V + (32 * db + r32) * 144;
#pragma unroll
        for (int ks = 0; ks < 4; ++ks) {
            const int kb = (ks >> 1) * 32 + (ks & 1) * 16 + 4 * hi;
            const v2u lo = *(const LAS v2u*)(vrow + kb * 2), hh = *(const LAS v2u*)(vrow + (kb + 8) * 2);
            const v4u vv = (v4u){lo.x, lo.y, hh.x, hh.y};
            o[db] = __builtin_amdgcn_mfma_f32_32x32x16_bf16(pa[ks], __builtin_bit_cast(bf16x8v, vv), o[db], 0, 0, 0); } }
}
__device__ __forceinline__ void nsa_rowscale(f32x16 (&o)[2], LAS float* wsf, float f, int r32, int hi) {
    if (hi == 0) wsf[r32] = f;
#pragma unroll
    for (int g = 0; g < 4; ++g) { const f32x4 w = *(const LAS f32x4*)(wsf + 8 * g + 4 * hi);
#pragma unroll
        for (int e = 0; e < 4; ++e) { o[0][4 * g + e] *= w[e]; o[1][4 * g + e] *= w[e]; } }
}
__device__ __forceinline__ void nsa_rowaccum(bf16* dst, bool first, const f32x16 (&o)[2], LAS float* wsf, float f, int r32, int hi) {
    if (hi == 0) wsf[r32] = f;
    bf16 old[32];
#pragma unroll
    for (int i = 0; i < 16; ++i) { const bf16* p = dst + (i >> 2) * 512 + (i & 3) * 64; old[2 * i] = first ? (bf16)0 : p[0]; old[2 * i + 1] = first ? (bf16)0 : p[32]; }
#pragma unroll
    for (int g = 0; g < 4; ++g) { const f32x4 w = *(const LAS f32x4*)(wsf + 8 * g + 4 * hi);
#pragma unroll
        for (int e = 0; e < 4; ++e) { bf16* p = dst + g * 512 + e * 64; const int i = 4 * g + e;
            p[0] = (bf16)f2bf(o[0][i] * w[e] + bf1(old[2 * i])); p[32] = (bf16)f2bf(o[1][i] * w[e] + bf1(old[2 * i + 1])); } }
}
__device__ __forceinline__ void nsa_softmax_pv(const LAS unsigned char* lds, f32x16& p0, f32x16& p1, float& m, float& l, f32x16 (&o)[2], LAS float* wsf, int lane, int r32, int hi) {
    float mt = nsa_max32(p0, p1); mt = fmaxf(mt, partner32(mt, lane));
    const float mn = fmaxf(m, mt);
    if (__builtin_amdgcn_ballot_w64(mn > m) != 0ull) { const float f = __builtin_amdgcn_exp2f(m - mn); l *= f; nsa_rowscale(o, wsf, f, r32, hi); m = mn; }
    float s = 0.f;
#pragma unroll
    for (int i = 0; i < 16; ++i) { p0[i] = __builtin_amdgcn_exp2f(p0[i] - m); p1[i] = __builtin_amdgcn_exp2f(p1[i] - m); s += p0[i] + p1[i]; }
    l += s;
    nsa_pv(lds, p0, p1, o, r32, hi);
}
__device__ __forceinline__ void p_nsa2(Frame& F) {
    const int tid = F.tid, lane = F.lane, wave = F.wave, r32 = lane & 31, hi = lane >> 5;
    LAS unsigned char* lds = F.lds + RING_OFF;
    LAS float* imp = (LAS float*)(lds + NSA_IMP); LAS float* carry = (LAS float*)(lds + NSA_CARRY);
    LAS unsigned long long* selm = (LAS unsigned long long*)(lds + NSA_SEL); LAS float* wsf = (LAS float*)(lds + NSA_WSF) + wave * 32;
    const bf16* P1 = WSP(bf16, WS_P1); const bf16* KC = WSP(bf16, WS_KC); const bf16* KCT = WSP(bf16, WS_KCT); const bf16* VT = WSP(bf16, WS_VT);
    bf16* Yc = WSP(bf16, WS_Y) + (size_t)2 * MC * 256;
    const int ql = r32 >> 2, h = r32 & 3, tq = 8 * wave + ql;
    int par = 0;
    for (int it = 0; it < 2; ++it) {
        for (int pair = F.vcu; pair < BC * 32; pair += F.G) {
            const int b = pair >> 5, sx = pair & 31, qb = it ? 63 - sx : sx;
            const int t = qb * 64 + tq; const size_t row = (size_t)b * SEQ + t; const bf16* prow = P1 + row * P1W;
            bf16x8v qr[4];
#pragma unroll
            for (int d0 = 0; d0 < 4; ++d0) qr[d0] = *(const bf16x8v*)(prow + C_CQ + h * 64 + d0 * 16 + hi * 8);
            const float g0 = bf1(prow[C_CG + h * 3]), g1 = bf1(prow[C_CG + h * 3 + 1]), g2 = bf1(prow[C_CG + h * 3 + 2]);
            f32x16 o[2], p0, p1;
            bf16* ydst = Yc + ((size_t)b * SEQ + qb * 64 + 8 * wave + hi) * 256 + r32;
            __syncthreads();
            for (int i = tid; i < 64 * 64; i += 512) imp[i] = 0.f;
            for (int i = tid; i < 64 * 68; i += 512) carry[i] = 0.f;
            const int nct = (4 * qb + 3 + 63) >> 6;
            const int mlim = t >= 31 ? ((t - 31) >> 4) : -1;
            const bf16* kcb = KC + (size_t)b * 256 * 64; const bf16* vcb = KCT + (size_t)b * 64 * 256;
            float m = -1e30f, l = 0.f;
            v4u kx, vx;
            nsa_load(kx, vx, kcb, 64, vcb, 256, tid);
            for (int ti = 0; ti < nct; ++ti) {
                LAS unsigned char* tb = lds + par * NSA_STAGE; par ^= 1;
                nsa_store(tb, kx, vx, tid); __syncthreads();
                { const int tn = ti + 1 < nct ? ti + 1 : 0; nsa_load(kx, vx, kcb + (size_t)tn * 64 * 64, 64, vcb + tn * 64, 256, tid); }
                nsa_qk(tb, qr, p0, p1, r32, hi); nsa_mask(p0, p1, hi, mlim - 64 * ti, -1, true, false);
                float mt = nsa_max32(p0, p1); mt = fmaxf(mt, partner32(mt, lane));
                const float mn = fmaxf(m, mt); l *= __builtin_amdgcn_exp2f(m - mn); m = mn;
                float s = 0.f;
#pragma unroll
                for (int i = 0; i < 16; ++i) s += __builtin_amdgcn_exp2f(p0[i] - m) + __builtin_amdgcn_exp2f(p1[i] - m);
                l += s; }
            { const float lt = l + partner32(l, lane); const float rl = lt > 0.f ? 1.0f / lt : 0.f;
#pragma unroll
              for (int i = 0; i < 16; ++i) { o[0][i] = 0.f; o[1][i] = 0.f; }
              for (int ti = 0; ti < nct; ++ti) {
                  LAS unsigned char* tb = lds + par * NSA_STAGE; par ^= 1;
                  nsa_store(tb, kx, vx, tid); __syncthreads();
                  if (ti + 1 < nct) nsa_load(kx, vx, kcb + (size_t)(ti + 1) * 64 * 64, 64, vcb + (ti + 1) * 64, 256, tid);
                  nsa_qk(tb, qr, p0, p1, r32, hi); nsa_mask(p0, p1, hi, mlim - 64 * ti, -1, true, false);
#pragma unroll
                  for (int i = 0; i < 16; ++i) { p0[i] = __builtin_amdgcn_exp2f(p0[i] - m) * rl; p1[i] = __builtin_amdgcn_exp2f(p1[i] - m) * rl; }
#pragma unroll
                  for (int kt = 0; kt < 2; ++kt)
#pragma unroll
                      for (int g = 0; g < 4; ++g) { const f32x16& pp = kt ? p1 : p0;
                          float A = pp[4 * g] + pp[4 * g + 1] + pp[4 * g + 2] + 0.5f * pp[4 * g + 3], B = 0.5f * pp[4 * g + 3];
                          A += __builtin_bit_cast(float, bperm(lane ^ 1, __builtin_bit_cast(int, A))); A += __builtin_bit_cast(float, bperm(lane ^ 2, __builtin_bit_cast(int, A)));
                          B += __builtin_bit_cast(float, bperm(lane ^ 1, __builtin_bit_cast(int, B))); B += __builtin_bit_cast(float, bperm(lane ^ 2, __builtin_bit_cast(int, B)));
                          if (h == 0) { const int j = 16 * ti + 8 * kt + 2 * g + hi; imp[tq * 64 + j] = A; carry[tq * 68 + j + 1] = B; } }
                  nsa_pv(tb, p0, p1, o, r32, hi); }
              nsa_rowaccum(ydst, true, o, wsf, g0, r32, hi); }
            __syncthreads();
            { const int q = tid >> 3, sub = tid & 7; unsigned long long mask;
              if (qb + 1 <= 16) mask = (1ull << (qb + 1)) - 1ull;
              else { mask = 1ull | (1ull << qb);
                  unsigned long long key[8];
#pragma unroll
                  for (int i = 0; i < 8; ++i) { const int j = sub * 8 + i; const float v = imp[q * 64 + j] + carry[q * 68 + j];
                      key[i] = (j >= 1 && j < qb) ? (((unsigned long long)__builtin_bit_cast(unsigned, v) << 32) | (unsigned)(63 - j)) : 0ull; }
                  for (int r = 0; r < 14; ++r) { unsigned long long best = key[0];
#pragma unroll
                      for (int i = 1; i < 8; ++i) best = key[i] > best ? key[i] : best;
#pragma unroll
                      for (int x = 1; x < 8; x <<= 1) { const unsigned lo = (unsigned)bperm(lane ^ x, (int)(unsigned)best), hh = (unsigned)bperm(lane ^ x, (int)(unsigned)(best >> 32));
                          const unsigned long long other = ((unsigned long long)hh << 32) | lo; best = other > best ? other : best; }
                      const int jb = 63 - (int)(best & 63ull); mask |= 1ull << jb;
#pragma unroll
                      for (int i = 0; i < 8; ++i) if (sub * 8 + i == jb) key[i] = 0ull; } }
              if (sub == 0) selm[q] = mask; }
            __syncthreads();
            const unsigned long long mysel = selm[tq];
            { const bf16* kb = P1 + (size_t)b * SEQ * P1W + C_KSLC; const bf16* vb = VT + (size_t)(0 * BC + b) * 64 * SEQ;
              m = -1e30f; l = 0.f;
#pragma unroll
              for (int i = 0; i < 16; ++i) { o[0][i] = 0.f; o[1][i] = 0.f; }
              v4u kx2, vx2;
              nsa_load(kx, vx, kb, P1W, vb, SEQ, tid); if (qb >= 1) nsa_load(kx2, vx2, kb + (size_t)64 * P1W, P1W, vb + 64, SEQ, tid);
              for (int j = 0; j <= qb; j += 2) {
                  const bool two = j + 1 <= qb;
                  LAS unsigned char* tb = lds + par * NSA_STAGE; par ^= 1;
                  nsa_store(tb, kx, vx, tid); if (two) nsa_store(tb + NSA_BUF, kx2, vx2, tid);
                  __syncthreads();
                  if (j + 2 <= qb) nsa_load(kx, vx, kb + (size_t)(j + 2) * 64 * P1W, P1W, vb + (j + 2) * 64, SEQ, tid);
                  if (j + 3 <= qb) nsa_load(kx2, vx2, kb + (size_t)(j + 3) * 64 * P1W, P1W, vb + (j + 3) * 64, SEQ, tid);
                  { const bool rowsel = ((mysel >> j) & 1ull) != 0ull;
                    if (__builtin_amdgcn_ballot_w64(rowsel) != 0ull) {
                        nsa_qk(tb, qr, p0, p1, r32, hi); nsa_mask(p0, p1, hi, j == qb ? tq : 63, -1, rowsel, j < qb);
                        nsa_softmax_pv(tb, p0, p1, m, l, o, wsf, lane, r32, hi); } }
                  if (two) { const bool rowsel = ((mysel >> (j + 1)) & 1ull) != 0ull;
                    if (__builtin_amdgcn_ballot_w64(rowsel) != 0ull) {
                        nsa_qk(tb + NSA_BUF, qr, p0, p1, r32, hi); nsa_mask(p0, p1, hi, j + 1 == qb ? tq : 63, -1, rowsel, j + 1 < qb);
                        nsa_softmax_pv(tb + NSA_BUF, p0, p1, m, l, o, wsf, lane, r32, hi); } } }
              const float lt = l + partner32(l, lane);
              nsa_rowaccum(ydst, false, o, wsf, lt > 0.f ? g1 / lt : 0.f, r32, hi); }
            { const bf16* kb = P1 + (size_t)b * SEQ * P1W + C_KWIN; const bf16* vb = VT + (size_t)(1 * BC + b) * 64 * SEQ;
              m = -1e30f; l = 0.f;
#pragma unroll
              for (int i = 0; i < 16; ++i) { o[0][i] = 0.f; o[1][i] = 0.f; }
              const int j0 = qb >= 8 ? qb - 8 : 0;
              nsa_load(kx, vx, kb + (size_t)j0 * 64 * P1W, P1W, vb + j0 * 64, SEQ, tid);
              for (int j = j0; j <= qb; ++j) {
                  LAS unsigned char* tb = lds + par * NSA_STAGE; par ^= 1;
                  nsa_store(tb, kx, vx, tid); __syncthreads();
                  if (j < qb) nsa_load(kx, vx, kb + (size_t)(j + 1) * 64 * P1W, P1W, vb + (j + 1) * 64, SEQ, tid);
                  nsa_qk(tb, qr, p0, p1, r32, hi); nsa_mask(p0, p1, hi, j == qb ? tq : 63, j == qb - 8 ? tq : -1, true, j < qb && j != qb - 8);
                  nsa_softmax_pv(tb, p0, p1, m, l, o, wsf, lane, r32, hi); }
              const float lt = l + partner32(l, lane);
              nsa_rowaccum(ydst, false, o, wsf, lt > 0.f ? g2 / lt : 0.f, r32, hi); }
        }
    }
    __syncthreads();
}

constexpr int SB_HEAD_LDS = 17408;
constexpr int SB_FLAG = 4 * SB_HEAD_LDS;
constexpr float SB_LOG2E = 1.4426950408889634f, SB_STOP = -100.0f * 1.4426950408889634f;
__device__ __forceinline__ void p_stick2(Frame& F, int nbusy) {
    const int tid = F.tid, lane = F.lane, wave = F.wave, r32 = lane & 31, hi = lane >> 5, h = wave & 3, qh = wave >> 2;
    LAS unsigned char* lds = F.lds + RING_OFF; LAS unsigned char* hl = lds + h * SB_HEAD_LDS; LAS int* flag = (LAS int*)(lds + SB_FLAG);
    const bf16* P1 = WSP(bf16, WS_P1); const bf16* VT = WSP(bf16, WS_VT) + (size_t)2 * BC * 64 * SEQ;
    bf16* Yb = WSP(bf16, WS_Y) + (size_t)MC * 256;
    const int tq = 32 * qh + r32;
    if (F.bx >= nbusy)
        for (int item = F.bx - nbusy; item < BC * 64; item += F.G - nbusy) {
            const int b = item >> 6, qb = item & 63;
            const size_t row = (size_t)b * SEQ + qb * 64 + tq;
            bf16x8v qr[4];
#pragma unroll
            for (int d0 = 0; d0 < 4; ++d0) qr[d0] = *(const bf16x8v*)(P1 + row * P1W + C_SBQ + h * 64 + d0 * 16 + hi * 8);
            f32x16 o[2], p0, p1;
#pragma unroll
            for (int i = 0; i < 16; ++i) { o[0][i] = 0.f; o[1][i] = 0.f; }
            float R = 0.f;
            const int skey = tid & 63, sc = tid >> 6, sd = tid >> 3, skc = tid & 7;
            v4u kx[4], vx[4];
#define SB_LOAD(jj) do { const bf16* kg_ = P1 + ((size_t)b * SEQ + (jj) * 64 + skey) * P1W + C_SBK + sc * 8; \
                _Pragma("unroll") for (int hh = 0; hh < 4; ++hh) { kx[hh] = *(const v4u*)(kg_ + hh * 64); vx[hh] = *(const v4u*)(VT + ((size_t)(hh * BC + b) * 64 + sd) * SEQ + (jj) * 64 + skc * 8); } } while (0)
            SB_LOAD(qb);
            for (int j = qb; j >= 0; --j) {
                __syncthreads();
                if (j < qb) { int live = 0;
#pragma unroll
                    for (int w = 0; w < 8; ++w) live |= flag[w];
                    if (!live) break; }
#pragma unroll
                for (int hh = 0; hh < 4; ++hh) { *(LAS v4u*)(lds + hh * SB_HEAD_LDS + sc * 1024 + skey * 16) = kx[hh]; *(LAS v4u*)(lds + hh * SB_HEAD_LDS + NSA_V + sd * 144 + skc * 16) = vx[hh]; }
                __syncthreads();
                if (j > 0) SB_LOAD(j - 1);
                nsa_qk(hl, qr, p0, p1, r32, hi);
                const int lim = (j == qb) ? tq : 64;
                float Town[8], Tp[8];
#pragma unroll
                for (int kt = 0; kt < 2; ++kt) { f32x16& pp = kt ? p1 : p0;
#pragma unroll
                    for (int g = 0; g < 4; ++g) { float L[4];
#pragma unroll
                        for (int e = 0; e < 4; ++e) { const int kk = 32 * kt + 8 * g + 4 * hi + e; const float z = pp[4 * g + e];
                            const float tt = __builtin_amdgcn_logf(1.0f + __builtin_amdgcn_exp2f(-__builtin_fabsf(z)));
                            const float lb = fminf(z, 0.f) - tt; const bool ok = kk < lim;
                            L[e] = ok ? lb - z : 0.f; pp[4 * g + e] = ok ? lb : -INFINITY; }
                        const float E2 = L[3], E1 = E2 + L[2], E0 = E1 + L[1];
                        pp[4 * g + 2] += E2; pp[4 * g + 1] += E1; pp[4 * g] += E0;
                        Town[4 * kt + g] = E0 + L[0]; } }
#pragma unroll
                for (int k = 0; k < 8; ++k) Tp[k] = partner32(Town[k], lane);
                float suf = R;
#pragma unroll
                for (int k = 7; k >= 0; --k) { const float add = suf + (hi == 0 ? Tp[k] : 0.f); f32x16& pp = (k >> 2) ? p1 : p0; const int g = k & 3;
#pragma unroll
                    for (int e = 0; e < 4; ++e) pp[4 * g + e] = __builtin_amdgcn_exp2f(pp[4 * g + e] + add);
                    suf += Town[k] + Tp[k]; }
                R = suf;
                nsa_pv(hl, p0, p1, o, r32, hi);
                const bool alive = R >= SB_STOP;
                const unsigned long long bal = __builtin_amdgcn_ballot_w64(alive);
                if (lane == 0) flag[wave] = bal != 0ull ? 1 : 0;
            }
            { bf16* dst = Yb + ((size_t)b * SEQ + qb * 64 + 32 * qh + 4 * hi) * 256 + h * 64 + r32;
#pragma unroll
              for (int i = 0; i < 16; ++i) { dst[((i & 3) + 8 * (i >> 2)) * 256] = (bf16)f2bf(o[0][i]); dst[((i & 3) + 8 * (i >> 2)) * 256 + 32] = (bf16)f2bf(o[1][i]); } }
        }
#undef SB_LOAD
    __syncthreads();
}

__device__ __forceinline__ void p_sgu2(Frame& F, int layer) {
    LAS unsigned char* vnT = F.lds + RING_OFF;
    const bf16* P1 = WSP(bf16, WS_P1); bf16* Ya = WSP(bf16, WS_Y);
    const float* gain = F.in[3] + (size_t)layer * 256; const float* sw = F.in[4] + (size_t)layer * 4 * 128 * 128; const float* sb = F.in[5] + (size_t)layer * 4 * 128;
    const int lane = F.lane, wave = F.wave, r32 = lane & 31, hi = lane >> 5, g = wave & 3, db = wave >> 2;
    for (int item = F.vcu; item < MC / 128; item += F.G) {
        const size_t r0 = (size_t)item * 128;
        __syncthreads();
        { const f32x4 gg = ((const f32x4*)gain)[lane];
          for (int rr = 0; rr < 16; rr += 2) { const int r = wave * 16 + rr;
              const v2u ra = *(const v2u*)(P1 + (r0 + r) * P1W + C_V + 4 * lane), rb = *(const v2u*)(P1 + (r0 + r + 1) * P1W + C_V + 4 * lane);
              const float a0 = bflo(ra.x), a1 = bfhi(ra.x), a2 = bflo(ra.y), a3 = bfhi(ra.y), b0 = bflo(rb.x), b1 = bfhi(rb.x), b2 = bflo(rb.y), b3 = bfhi(rb.y);
              const float sa = 1.0f / sqrtf(wave_sum((a0 * a0 + a1 * a1) + (a2 * a2 + a3 * a3), lane) * (1.f / 256.f) + EPS);
              const float sb_ = 1.0f / sqrtf(wave_sum((b0 * b0 + b1 * b1) + (b2 * b2 + b3 * b3), lane) * (1.f / 256.f) + EPS);
              LAS unsigned* q = (LAS unsigned*)(vnT + (4 * lane) * 272 + r * 2);
              q[0] = pk2(a0 * sa * gg.x, b0 * sb_ * gg.x); q[68] = pk2(a1 * sa * gg.y, b1 * sb_ * gg.y); q[136] = pk2(a2 * sa * gg.z, b2 * sb_ * gg.z); q[204] = pk2(a3 * sa * gg.w, b3 * sb_ * gg.w); } }
        __syncthreads();
        const int ch = g * 64 + db * 32 + r32;
        for (int tb = 0; tb < 4; ++tb) {
            f32x16 acc;
#pragma unroll
            for (int i = 0; i < 16; ++i) acc[i] = 0.f;
            const int t = 32 * tb + r32; const float* wrow = sw + ((size_t)g * 128 + t) * 128;
            f32x4 wq[8][2];
#pragma unroll
            for (int ks = 0; ks < 8; ++ks) if (ks < 2 * tb + 2) { wq[ks][0] = *(const f32x4*)(wrow + 16 * ks + 8 * hi); wq[ks][1] = *(const f32x4*)(wrow + 16 * ks + 8 * hi + 4); }
#pragma unroll
            for (int ks = 0; ks < 8; ++ks) if (ks < 2 * tb + 2) {
                const int s0 = 16 * ks + 8 * hi;
                const f32x4 w0 = wq[ks][0], w1 = wq[ks][1];
                const v4u a = (v4u){pk2(s0 <= t ? w0.x : 0.f, s0 + 1 <= t ? w0.y : 0.f), pk2(s0 + 2 <= t ? w0.z : 0.f, s0 + 3 <= t ? w0.w : 0.f),
                                    pk2(s0 + 4 <= t ? w1.x : 0.f, s0 + 5 <= t ? w1.y : 0.f), pk2(s0 + 6 <= t ? w1.z : 0.f, s0 + 7 <= t ? w1.w : 0.f)};
                const bf16x8v bfr = *(const LAS bf16x8v*)(vnT + ch * 272 + s0 * 2);
                acc = __builtin_amdgcn_mfma_f32_32x32x16_bf16(__builtin_bit_cast(bf16x8v, a), bfr, acc, 0, 0, 0); }
            float uu[16], bb[16];
#pragma unroll
            for (int i = 0; i < 16; ++i) { const int tt = 32 * tb + (i & 3) + 8 * (i >> 2) + 4 * hi; uu[i] = bf1(P1[(r0 + tt) * P1W + C_U + ch]); bb[i] = sb[g * 128 + tt]; }
#pragma unroll
            for (int i = 0; i < 16; ++i) { const int tt = 32 * tb + (i & 3) + 8 * (i >> 2) + 4 * hi;
                Ya[(r0 + tt) * 256 + ch] = (bf16)f2bf(uu[i] * (acc[i] + bb[i])); }
        }
    }
    __syncthreads();
}

struct Args { const float* in[20]; float* out; unsigned char* ws; int lo, hi, li, rep; };
#ifndef TILED_FFN1
#define TILED_FFN1 0
#endif
#ifndef PG8_ALIGN_EPI
#define PG8_ALIGN_EPI true
#endif
#ifndef PG8_SP2
#define PG8_SP2 true
#endif
#ifndef WGM_PROJ
#define WGM_PROJ PG8_WGM
#endif
#ifndef WGM_FFN1
#define WGM_FFN1 PG8_WGM
#endif
#ifndef WGM_FFN2
#define WGM_FFN2 PG8_WGM
#endif
#ifndef WGM_MOE1
#define WGM_MOE1 PG8_WGM
#endif
#ifndef WGM_MOE2
#define WGM_MOE2 PG8_WGM
#endif
#ifndef FFN_CHUNKS
#define FFN_CHUNKS 2
#endif
#ifndef REP_GEMM
#define REP_GEMM 1
#endif
#ifndef REP_STICK
#define REP_STICK 1
#endif
#ifndef REP_NSA
#define REP_NSA 1
#endif
#ifndef REP_SGU
#define REP_SGU 1
#endif
#ifndef REP_NORM
#define REP_NORM 1
#endif
template <class Epi, class Sched> __device__ __forceinline__ void run_gemm(Frame& F, const bf16* A, const bf16* Bt, int M, int N, int K, const Sched& S, Epi E, bool rotate = true, int tiled = 0) {
    const int nt_ = K / 64;
#ifdef PG8_KROT
    const int rot_ = rotate ? 2 * (((F.bx & 7) * (nt_ / 2)) / 8) : 0;
#else
    const int rot_ = 0;
#endif
    pg8::Gemm g{A, Bt, M, N, K + F.zs, F.tid, rot_ + F.zs, tiled + F.zs};
    if (F.rep) E.set_scale0();
    pg8::gemm_phase<Epi, Sched, PG8_ALIGN_EPI, PG8_SP2>(F.lds + RING_OFF, g, S, E);
}
__global__ void __launch_bounds__(NWAVES * 64, 2) mk_fwd(Args args) {
    extern __shared__ __attribute__((aligned(16))) unsigned char lds[];
    Frame F0;
    F0.lds = (LAS unsigned char*)lds;
    F0.tid = threadIdx.x; F0.lane = F0.tid & 63; F0.wave = __builtin_amdgcn_readfirstlane(F0.tid >> 6);
    F0.G = gridDim.x; F0.bx = blockIdx.x; F0.vcu = (F0.G % 8 == 0) ? (F0.bx % 8) * (F0.G / 8) + F0.bx / 8 : F0.bx; F0.zv = 0; F0.zs = 0;
    F0.rep = args.rep; F0.ws = args.ws; F0.ctl = (unsigned*)(args.ws + WS_CTL); F0.in = args.in; F0.out = args.out;
    for (int u = F0.tid; u < (LDS_BYTES - LDSCTL_OFF) / 4; u += NWAVES * 64) ((LAS unsigned*)(F0.lds + LDSCTL_OFF))[u] = 0u;
    __syncthreads();
    const int lo = args.lo, hi = args.hi;
    XcdBarrier bar; bar.bar = F0.ctl + CW_BAR + args.li * XCD_BAR_WORDS; bar.x = 0; bar.st = nullptr; bar.w = 0; bar.z = 0;
    if (hi - lo > 1) bar = xcd_barrier_post(F0.ctl + CW_BAR + args.li * XCD_BAR_WORDS, (volatile LAS unsigned*)(F0.lds + MISC_OFF) + 8);
    int step = 0;
#define STEP_BEGIN if (step >= lo && step < hi) { Frame F = F0; { int zv_, zs_; asm volatile("v_mov_b32 %0, 0" : "=v"(zv_)); asm volatile("s_mov_b32 %0, 0" : "=s"(zs_)); \
        F.zv = zv_; F.zs = zs_; F.lane = (int)__builtin_amdgcn_mbcnt_hi(~0u, __builtin_amdgcn_mbcnt_lo(~0u, (unsigned)zv_)); F.wave = F0.wave + zs_; F.tid = F.wave * 64 + F.lane; F.bx = F.bx + zs_; \
        F.vcu = F0.vcu + zs_; F.G = F0.G + zs_; F.lds = (LAS unsigned char*)lds + zs_; F.ws = F0.ws + zs_; F.ctl = F0.ctl + zs_; F.in = F0.in + zs_; F.out = F0.out + zs_; }
#ifdef PROBE_XBAR
#define STEP_END   if (step + 1 < hi) { unsigned zb_; asm volatile("v_mov_b32 %0, 0" : "=v"(zb_)); bar.z = zb_; xcd_barrier(bar); xcd_barrier(bar); } } ++step;
#else
#define STEP_END   if (step + 1 < hi) { unsigned zb_; asm volatile("v_mov_b32 %0, 0" : "=v"(zb_)); bar.z = zb_; xcd_barrier(bar); } } ++step;
#endif

    for (int layer = 0; layer < DEPTH; ++layer) {
        const int jj = layer >> 1;
        STEP_BEGIN
            p_convert(F, layer);
            p_norm<0>(F, layer == 0 ? F.in[0] : F.out, F.in[1] + (size_t)layer * DM, nullptr, 0);
        STEP_END
        for (int c = 0; c < NCHUNK; ++c) {
            STEP_BEGIN
                pg8::StaticOrder S; S.init(MC, NPROJ, F.G, F.bx, WGM_PROJ);
                pg8::EpiProj E{WSP(bf16, WS_P1), WSP(bf16, WS_G)};
                run_gemm(F, WSP(bf16, WS_HN) + (size_t)c * MC * DM, WSP(bf16, WS_WIN), MC, NPROJ, DM, S, E);
            STEP_END
            STEP_BEGIN
                p_prep(F);
            STEP_END
            STEP_BEGIN
                LAS int* tab = (LAS int*)(F.lds + TAB_OFF);
                __syncthreads(); if (F.tid < 16) tab[F.tid] = F.tid >> 3; __syncthreads();
                pg8::GroupedOrder S; S.so.init(2 * 2048, 512, F.G, F.bx); S.tile_e = tab; S.nN = 2;
                pg8::EpiF32 E{WSP(float, WS_UL), 512, 2};
                run_gemm(F, WSP(bf16, WS_KVC), WSP(bf16, WS_WC1), 2 * 2048, 512, DM, S, E);
                p_sgu2(F, layer);
                p_stick2(F, F.G > 64 ? 32 : 0);
            STEP_END
            STEP_BEGIN
                p_cmpfin(F, layer);
            STEP_END
            STEP_BEGIN
#ifdef OLD_NSA
                p_nsa(F);
#else
                p_nsa2(F);
#endif
            STEP_END
            STEP_BEGIN
                pg8::MergeOrder S; S.so.init(MC, DM, F.G, F.bx); S.nmt = MC / 256;
                pg8::EpiMerge E{WSP(bf16, WS_G), WSP(bf16, WS_MG), MC / 256};
                run_gemm(F, WSP(bf16, WS_Y), WSP(bf16, WS_WBR), 3 * MC, 3 * DM, 256, S, E);
            STEP_END
            STEP_BEGIN
                pg8::StaticOrder S; S.init(MC, DM, F.G, F.bx);
                const float* base = (layer == 0 ? F.in[0] : F.out) + (size_t)c * MC * DM;
                pg8::EpiResid E{base, F.out + (size_t)c * MC * DM, DM, 1.0f};
                run_gemm(F, WSP(bf16, WS_MG), WSP(bf16, WS_WOUT), MC, DM, DM, S, E);
            STEP_END
        }
        if ((layer & 1) == 0) {
            STEP_BEGIN
                p_norm<0>(F, F.out, F.in[11] + (size_t)layer * DM, nullptr, 0, Q8_HN, TILED_FFN1);
            STEP_END
            for (int c = 0; c < FFN_CHUNKS; ++c) {
                constexpr int MF = MTOK / FFN_CHUNKS;
                STEP_BEGIN
                    pg8::StaticOrder S; S.init(MF, NFF1, F.G, F.bx, WGM_FFN1);
                    pg8::EpiSwiGLU E{WSP(bf16, WS_HID), DFFP, nullptr, NFF1 / 256};
                    run_gemm(F, WSP(bf16, WS_HN) + (size_t)c * MF * DM, WSP(bf16, WS_WF1), MF, NFF1, DM, S, E, true, TILED_FFN1);
                STEP_END
                STEP_BEGIN
                    pg8::StaticOrder S; S.init(MF, DM, F.G, F.bx, WGM_FFN2);
                    pg8::EpiResid E{F.out + (size_t)c * MF * DM, F.out + (size_t)c * MF * DM, DM, 1.0f};
                    run_gemm(F, WSP(bf16, WS_HID), WSP(bf16, WS_WF2), MF, DM, DFFP, S, E);
                STEP_END
            }
        } else {
            STEP_BEGIN
                p_norm<1>(F, F.out, F.in[11] + (size_t)layer * DM, F.in[15] + (size_t)jj * DM * NEXP, jj, Q8_HN);
            STEP_END
#ifdef ABL_DENSE_MOE
            for (int e = 0; e < NEXP; ++e) {
                STEP_BEGIN
                    pg8::StaticOrder S; S.init(MTOK, NMOE1, F.G, F.bx);
                    pg8::EpiSwiGLU E{WSP(bf16, WS_SCR + 8 * MiB), DFE, WSP(float, WS_SCR + 4 * MiB) + (size_t)e * MTOK, NMOE1 / 256};
                    run_gemm(F, WSP(bf16, WS_HN), WSP(bf16, WS_WF1) + (size_t)e * NMOE1 * DM, MTOK, NMOE1, DM, S, E);
                STEP_END
                STEP_BEGIN
                    pg8::StaticOrder S; S.init(MTOK, DM, F.G, F.bx);
                    pg8::EpiResid E{F.out, F.out, DM, 1.0f};
                    run_gemm(F, WSP(bf16, WS_SCR + 8 * MiB), WSP(bf16, WS_WF2) + (size_t)e * DM * DFE, MTOK, DM, DFE, S, E);
                STEP_END
            }
#else
            STEP_BEGIN
                p_gather(F, jj, 0, 0);
            STEP_END
            for (int c = 0; c < NCHUNK; ++c)
                for (int r = 0; r < 2; ++r) {
                    STEP_BEGIN
                        const int T = moe_table(F, jj, c, r);
                        pg8::GroupedOrder S; S.so.init(T * 256, NMOE1, F.G, F.bx, WGM_MOE1); S.tile_e = (LAS int*)(F.lds + TAB_OFF); S.nN = NMOE1 / 256;
                        pg8::EpiSwiGLU E{WSP(bf16, WS_HIDM), DFE, WSP(float, WS_WSLOT) + (c * 2 + r) * SLOTS, NMOE1 / 256};
                        run_gemm(F, WSP(bf16, WS_XG), WSP(bf16, WS_WF1), T * 256, NMOE1, DM, S, E, false);
                    STEP_END
                    STEP_BEGIN
                        const int T = moe_table(F, jj, c, r);
                        pg8::GroupedOrder S; S.so.init(T * 256, DM, F.G, F.bx, WGM_MOE2); S.tile_e = (LAS int*)(F.lds + TAB_OFF); S.nN = DM / 256;
                        pg8::EpiScatter E{F.out, WSP(int, WS_TOKMAP) + (c * 2 + r) * SLOTS, DM / 256, 1.0f};
                        run_gemm(F, WSP(bf16, WS_HIDM), WSP(bf16, WS_WF2), T * 256, DM, DFE, S, E, false);
                        if (!F.rep && c * 2 + r < 3) p_gather(F, jj, (c * 2 + r + 1) >> 1, (c * 2 + r + 1) & 1, (T * (DM / 256)) % F.G);
                    STEP_END
                }
#endif
        }
    }
    STEP_BEGIN
        p_norm<2>(F, F.out, F.in[19], nullptr, 0);
    STEP_END
#undef STEP_BEGIN
#undef STEP_END
}

#ifndef MK_STEPS_PER_LAUNCH
#define MK_STEPS_PER_LAUNCH 1
#endif
extern "C" void kernel_launch(void* const* d_in, const int* in_sizes, int n_in, void* d_out, int out_size, void* d_ws, size_t ws_size, hipStream_t stream) {
    static int grid = 0;
    if (grid == 0) {
        if (n_in != 20 || in_sizes[0] != MTOK * DM || out_size != MTOK * DM || ws_size < WS_END) { fprintf(stderr, "kernel_launch: unexpected shapes (n_in %d, in0 %d, out %d, ws %zu)\n", n_in, n_in > 0 ? in_sizes[0] : -1, out_size, ws_size); grid = -1; return; }
        int dev = 0, cus = 0, per_cu = 0;
        if (hipGetDevice(&dev) != hipSuccess || hipDeviceGetAttribute(&cus, hipDeviceAttributeMultiprocessorCount, dev) != hipSuccess) { grid = -1; return; }
        if (hipFuncSetAttribute((const void*)mk_fwd, hipFuncAttributeMaxDynamicSharedMemorySize, LDS_BYTES) != hipSuccess) { fprintf(stderr, "kernel_launch: hipFuncSetAttribute failed\n"); grid = -1; return; }
        if (hipOccupancyMaxActiveBlocksPerMultiprocessor(&per_cu, (const void*)mk_fwd, NWAVES * 64, LDS_BYTES) != hipSuccess || per_cu < 1) fprintf(stderr, "kernel_launch: occupancy query reports %d\n", per_cu);
        (void)hipGetLastError();
        grid = cus;
    }
    if (grid < 0) return;
    if (hipMemsetAsync((char*)d_ws + WS_CTL, 0, CTL_ZERO_BYTES, stream) != hipSuccess) return;
    Args a{};
    for (int i = 0; i < 20; ++i) a.in[i] = (const float*)d_in[i];
    a.out = (float*)d_out; a.ws = (unsigned char*)d_ws; a.rep = 0;
    #ifdef ABL_DENSE_MOE
    constexpr int NSTEPS = 2 * (1 + NCHUNK * 8 + 3) + 2 * (1 + NCHUNK * 8 + 1 + NEXP * 2) + 1;
#else
    constexpr int NSTEPS = 2 * (1 + NCHUNK * 7 + 1 + 2 * FFN_CHUNKS) + 2 * (1 + NCHUNK * 7 + 2 + NCHUNK * 2 * 2) + 1;
#endif
    int li = 0;
#ifdef REPMASK
    static int kinds[256]; int ns = 0;
    for (int layer = 0; layer < DEPTH; ++layer) { kinds[ns++] = 0;
        for (int c = 0; c < NCHUNK; ++c) for (int q = 1; q <= 8; ++q) if (q != 5) kinds[ns++] = q;
        if ((layer & 1) == 0) { kinds[ns++] = 9; for (int c = 0; c < FFN_CHUNKS; ++c) { kinds[ns++] = 10; kinds[ns++] = 11; } }
        else { kinds[ns++] = 12; kinds[ns++] = 17; for (int c = 0; c < NCHUNK * 2; ++c) { kinds[ns++] = 14; kinds[ns++] = 13; } } }
    kinds[ns++] = 16;
    for (int s = 0; s < NSTEPS; ++s) { const int reps = ((REPMASK >> kinds[s]) & 1) ? 2 : 1;
        for (int r = 0; r < reps; ++r) { a.lo = s; a.hi = s + 1; a.li = 0; a.rep = r;
            hipLaunchKernelGGL(mk_fwd, dim3(grid), dim3(NWAVES * 64), LDS_BYTES, stream, a); } }
    (void)li;
#else
    for (int s = 0; s < NSTEPS; s += MK_STEPS_PER_LAUNCH) {
        a.lo = s; a.hi = (s + MK_STEPS_PER_LAUNCH < NSTEPS) ? s + MK_STEPS_PER_LAUNCH : NSTEPS; a.li = (MK_STEPS_PER_LAUNCH > 1) ? li : 0; ++li;
        hipLaunchKernelGGL(mk_fwd, dim3(grid), dim3(NWAVES * 64), LDS_BYTES, stream, a);
        if (hipPeekAtLastError() != hipSuccess) { fprintf(stderr, "kernel_launch: launch failed\n"); break; }
    }
#endif
}
```

```cpp
#define MK_STEPS_PER_LAUNCH 1000
#define PG8_WGM 4
#define FFN_CHUNKS 1
#include <hip/hip_runtime.h>
#include <cstdio>
#include <cstdint>
#include <cmath>
#ifndef PG8_WGM
#define PG8_WGM 8
#endif
namespace pg8 {
#define PG8_LAS __attribute__((address_space(3)))
typedef unsigned short bf16_t;
typedef short bf16x8 __attribute__((ext_vector_type(8)));
typedef float f32x4 __attribute__((ext_vector_type(4)));
typedef unsigned u32x4 __attribute__((ext_vector_type(4)));
constexpr int BM = 256, BK = 64, HALF = 128, HTB = HALF * BK * 2  , STAGE_BYTES = 8 * HTB, NXCD = 8, WGM = PG8_WGM;

__host__ __device__ __forceinline__ int lds_byte(int r, int c) { const int st = (r >> 4) * 2 + (c >> 5), rr = r & 15, cc = c & 31, ob = rr * 64 + cc * 2; return st * 1024 + (ob ^ (((ob >> 9) & 1) << 5)); }
__host__ __device__ __forceinline__ void stage_rc(int b, int& R, int& C) { const int st = b / 1024, sb = b % 1024, swz = sb ^ (((sb >> 9) & 1) << 5); R = (st >> 1) * 16 + swz / 64; C = (st & 1) * 32 + (swz % 64) / 2; }
__host__ __device__ __forceinline__ int perm32(int rho) { const int n = rho >> 4, i = rho & 15; return 8 * (i >> 2) + 4 * n + (i & 3); }

struct Unit { int pm, pn; };
struct Gemm { const bf16_t* A; const bf16_t* Bt; int M, N, K; int zv; int rot; int tiled; };

struct StaticOrder {
    int nM, nN, nwg, G, c, wgm;
    __host__ __device__ void init(int M, int N, int G_, int c_, int wgm_ = WGM) { nM = M / BM; nN = N / BM; nwg = nM * nN; G = G_; c = c_; wgm = wgm_; }
    __host__ __device__ bool next(int i, Unit& u) const {
        const long L = (long)i * G + c; if (L >= nwg) return false;
        int wgid = (int)L; { const int q = nwg / NXCD, r = nwg % NXCD, xcd = wgid % NXCD, off = wgid / NXCD; wgid = (xcd < r ? xcd * (q + 1) : r * (q + 1) + (xcd - r) * q) + off; }
        const int nig = wgm * nN, gid = wgid / nig, fm = gid * wgm, gsz = (nM - fm) < wgm ? (nM - fm) : wgm;
        u.pm = fm + ((wgid % nig) % gsz); u.pn = (wgid % nig) / gsz; return true;
    }
    __device__ __forceinline__ void a_ready(const Unit&) const {}
    __device__ __forceinline__ void done(const Unit&) const {}
};

__device__ __forceinline__ unsigned cvt_pk_bf16(float lo, float hi) { unsigned r; asm volatile("v_cvt_pk_bf16_f32 %0, %1, %2" : "=v"(r) : "v"(lo), "v"(hi)); return r; }
typedef float f32x2 __attribute__((ext_vector_type(2)));

__device__ __forceinline__ float fast_sigmoid(float x) { return __builtin_amdgcn_rcpf(1.0f + __builtin_amdgcn_exp2f(-1.4426950408889634f * x)); }
__device__ __forceinline__ float gelu_tanh(float x) {
    const float u2 = 1.5957691216057308f * (x + 0.044715f * x * x * x);
    return x * fast_sigmoid(u2);
}
__device__ __forceinline__ float bf_lo(unsigned u) { return __builtin_bit_cast(float, u << 16); }
__device__ __forceinline__ float bf_hi(unsigned u) { return __builtin_bit_cast(float, u & 0xffff0000u); }

#ifdef PG8_NT_OUT
#define PG8_STORE_OUT(p, v) __builtin_nontemporal_store((v), (p))
#else
#define PG8_STORE_OUT(p, v) (*(p) = (v))
#endif
struct EpiProj {
    static constexpr bool PERM = true, AFTER_DRAIN = false, MID = false; static constexpr int MID_TILES = 1; __device__ __forceinline__ void set_scale0() {}
    bf16_t* P1; bf16_t* G;
    __device__ __forceinline__ void operator()(const f32x4 (&acc)[2][2][4][2], const Unit& u, int wr, int wc, int fr, int fq) const {
        const int row0 = u.pm * BM + wr * 64 + fr;
        bf16_t* base; int ldc, colt, act0, act1;
        if (u.pn < 8) { base = P1; ldc = 2048; colt = u.pn * BM; act0 = (u.pn < 2) ? 1 : 0; act1 = (u.pn == 7) ? 2 : act0; }
        else { base = G; ldc = 3072; colt = (u.pn - 8) * BM; act0 = 2; act1 = 2; }
        const int col0 = colt + wc * 32 + 8 * fq;
#pragma unroll
        for (int ai = 0; ai < 2; ++ai)
#pragma unroll
            for (int m = 0; m < 4; ++m) { bf16_t* rowp = base + (size_t)(row0 + ai * HALF + m * 16) * ldc + col0;
#pragma unroll
                for (int bj = 0; bj < 2; ++bj) { f32x4 v0 = acc[ai][bj][m][0], v1 = acc[ai][bj][m][1]; const int act = bj ? act1 : act0;
                    if (act == 1) {
#pragma unroll
                        for (int e = 0; e < 4; ++e) { v0[e] = gelu_tanh(v0[e]); v1[e] = gelu_tanh(v1[e]); } }
                    else if (act == 2) {
#pragma unroll
                        for (int e = 0; e < 4; ++e) { v0[e] = fast_sigmoid(v0[e]); v1[e] = fast_sigmoid(v1[e]); } }
                    u32x4 w; w.x = cvt_pk_bf16(v0[0], v0[1]); w.y = cvt_pk_bf16(v0[2], v0[3]); w.z = cvt_pk_bf16(v1[0], v1[1]); w.w = cvt_pk_bf16(v1[2], v1[3]);
                    *(u32x4*)(rowp + bj * HALF) = w; } }
    }
};
struct EpiMerge {
    static constexpr bool PERM = true, AFTER_DRAIN = false, MID = false; static constexpr int MID_TILES = 1; __device__ __forceinline__ void set_scale0() {}
    const bf16_t* G; bf16_t* MG; int nmt;
    __device__ __forceinline__ void operator()(const f32x4 (&acc)[2][2][4][2], const Unit& u, int wr, int wc, int fr, int fq) const {
        const int i = u.pn >> 2, pn = u.pn & 3, pm = u.pm - i * nmt;
        const int row0 = pm * BM + wr * 64 + fr, col0 = pn * BM + wc * 32 + 8 * fq;
#pragma unroll
        for (int ai = 0; ai < 2; ++ai)
#pragma unroll
            for (int mp = 0; mp < 2; ++mp) {
                u32x4 g[4], o[4];
#pragma unroll
                for (int q = 0; q < 4; ++q) { const int m = 2 * mp + (q >> 1), bj = q & 1; const size_t row = (size_t)(row0 + ai * HALF + m * 16); const int col = col0 + bj * HALF;
                    g[q] = *(const u32x4*)(G + row * 3072 + i * 1024 + col);
                    if (i > 0) o[q] = *(const u32x4*)(MG + row * 1024 + col); else o[q] = (u32x4){0u, 0u, 0u, 0u}; }
#pragma unroll
                for (int q = 0; q < 4; ++q) { const int m = 2 * mp + (q >> 1), bj = q & 1; const size_t row = (size_t)(row0 + ai * HALF + m * 16); const int col = col0 + bj * HALF;
                    f32x4 v0 = acc[ai][bj][m][0], v1 = acc[ai][bj][m][1];
#ifdef ABL_BRANCH
                    if (i == ABL_BRANCH) { v0 = v0 * (float)ABL_SCALE; v1 = v1 * (float)ABL_SCALE; }
#endif
                    v0[0] = v0[0] * bf_lo(g[q].x) + bf_lo(o[q].x); v0[1] = v0[1] * bf_hi(g[q].x) + bf_hi(o[q].x); v0[2] = v0[2] * bf_lo(g[q].y) + bf_lo(o[q].y); v0[3] = v0[3] * bf_hi(g[q].y) + bf_hi(o[q].y);
                    v1[0] = v1[0] * bf_lo(g[q].z) + bf_lo(o[q].z); v1[1] = v1[1] * bf_hi(g[q].z) + bf_hi(o[q].z); v1[2] = v1[2] * bf_lo(g[q].w) + bf_lo(o[q].w); v1[3] = v1[3] * bf_hi(g[q].w) + bf_hi(o[q].w);
                    u32x4 w; w.x = cvt_pk_bf16(v0[0], v0[1]); w.y = cvt_pk_bf16(v0[2], v0[3]); w.z = cvt_pk_bf16(v1[0], v1[1]); w.w = cvt_pk_bf16(v1[2], v1[3]);
                    *(u32x4*)(MG + row * 1024 + col) = w; } }
    }
};
struct EpiResid {
    static constexpr bool PERM = false, AFTER_DRAIN = false, MID = false; static constexpr int MID_TILES = 1; __device__ __forceinline__ void set_scale0() { scale = 0.f; base = out; }
    const float* base; float* out; int ldc; float scale;
    __device__ __forceinline__ void operator()(const f32x4 (&acc)[2][2][4][2], const Unit& u, int wr, int wc, int fr, int fq) const {
        const int row0 = u.pm * BM + wr * 64 + fr, col0 = u.pn * BM + wc * 32 + 4 * fq;
#pragma unroll
        for (int ai = 0; ai < 2; ++ai)
#pragma unroll
            for (int mp = 0; mp < 2; ++mp) {
                f32x4 b[8];
#pragma unroll
                for (int q = 0; q < 8; ++q) { const int m = 2 * mp + (q >> 2), bj = (q >> 1) & 1, n = q & 1;
                    b[q] = *(const f32x4*)(base + (size_t)(row0 + ai * HALF + m * 16) * ldc + col0 + bj * HALF + n * 16); }
#pragma unroll
                for (int q = 0; q < 8; ++q) { const int m = 2 * mp + (q >> 2), bj = (q >> 1) & 1, n = q & 1;
                    *(f32x4*)(out + (size_t)(row0 + ai * HALF + m * 16) * ldc + col0 + bj * HALF + n * 16) = b[q] + acc[ai][bj][m][n] * scale; } }
    }
};
struct EpiF32 {
    static constexpr bool PERM = false, AFTER_DRAIN = false, MID = false; static constexpr int MID_TILES = 1; __device__ __forceinline__ void set_scale0() {}
    float* O; int ldc, nN;
    __device__ __forceinline__ void operator()(const f32x4 (&acc)[2][2][4][2], const Unit& u, int wr, int wc, int fr, int fq) const {
        const int row0 = u.pm * BM + wr * 64 + fr, col0 = (u.pn % nN) * BM + wc * 32 + 4 * fq;
#pragma unroll
        for (int ai = 0; ai < 2; ++ai)
#pragma unroll
            for (int m = 0; m < 4; ++m) { const size_t off = (size_t)(row0 + ai * HALF + m * 16) * ldc + col0;
#pragma unroll
                for (int bj = 0; bj < 2; ++bj)
#pragma unroll
                    for (int n = 0; n < 2; ++n) *(f32x4*)(O + off + bj * HALF + n * 16) = acc[ai][bj][m][n]; }
    }
};
#ifdef EMU_FP8_HID
__device__ __forceinline__ float Q8H(float x) { const int p = __builtin_amdgcn_cvt_pk_fp8_f32(x * 8.f, x * 8.f, 0, false); return __builtin_amdgcn_cvt_f32_fp8(p, 0) * 0.125f; }
#else
__device__ __forceinline__ float Q8H(float x) { return x; }
#endif
struct EpiSwiGLU {
    static constexpr bool PERM = true, AFTER_DRAIN = false, MID = false; static constexpr int MID_TILES = 1; __device__ __forceinline__ void set_scale0() {}
    bf16_t* H; int ldh; const float* rowscale; int nN; int rowmask = 0x7fffffff;
    __device__ __forceinline__ void operator()(const f32x4 (&acc)[2][2][4][2], const Unit& u, int wr, int wc, int fr, int fq) const {
        const int row0 = u.pm * BM + wr * 64 + fr, col0 = (u.pn % nN) * HALF + wc * 32 + 8 * fq;
        float scv[8];
#pragma unroll
        for (int q = 0; q < 8; ++q) scv[q] = rowscale ? rowscale[row0 + (q >> 2) * HALF + (q & 3) * 16] : 1.0f;
#pragma unroll
        for (int ai = 0; ai < 2; ++ai)
#pragma unroll
            for (int m = 0; m < 4; ++m) { const int row = row0 + ai * HALF + m * 16; const float sc = scv[ai * 4 + m];
                float h[8];
#pragma unroll
                for (int n = 0; n < 2; ++n)
#pragma unroll
                    for (int e = 0; e < 4; ++e) { const float g = acc[ai][0][m][n][e], up = acc[ai][1][m][n][e]; h[n * 4 + e] = Q8H(g * fast_sigmoid(g) * up * sc); }
                u32x4 w; w.x = cvt_pk_bf16(h[0], h[1]); w.y = cvt_pk_bf16(h[2], h[3]); w.z = cvt_pk_bf16(h[4], h[5]); w.w = cvt_pk_bf16(h[6], h[7]);
                PG8_STORE_OUT((u32x4*)(H + (size_t)(row & rowmask) * ldh + col0), w); }
    }
};
struct EpiScatter {
    static constexpr bool PERM = false, AFTER_DRAIN = false, MID = false; static constexpr int MID_TILES = 1; __device__ __forceinline__ void set_scale0() { scale = 0.f; }
    float* out; const int* tok; int nN; float scale;
    __device__ __forceinline__ void operator()(const f32x4 (&acc)[2][2][4][2], const Unit& u, int wr, int wc, int fr, int fq) const {
        const int row0 = u.pm * BM + wr * 64 + fr, col0 = (u.pn % nN) * BM + wc * 32 + 4 * fq;
        int tk[8];
#pragma unroll
        for (int q = 0; q < 8; ++q) tk[q] = tok[row0 + (q >> 2) * HALF + (q & 3) * 16];
#pragma unroll
        for (int ai = 0; ai < 2; ++ai)
#pragma unroll
            for (int mp = 0; mp < 2; ++mp) {
                f32x4 b[8];
#pragma unroll
                for (int q = 0; q < 8; ++q) { const int m = 2 * mp + (q >> 2), bj = (q >> 1) & 1, n = q & 1; const int t = tk[ai * 4 + m];
                    b[q] = *(const f32x4*)(out + (size_t)(t < 0 ? 0 : t) * 1024 + col0 + bj * HALF + n * 16); }
#pragma unroll
                for (int q = 0; q < 8; ++q) { const int m = 2 * mp + (q >> 2), bj = (q >> 1) & 1, n = q & 1; const int t = tk[ai * 4 + m];
#ifdef ABL_MOE
                    if (false)
#else
                    if (t >= 0)
#endif
                        *(f32x4*)(out + (size_t)t * 1024 + col0 + bj * HALF + n * 16) = b[q] + acc[ai][bj][m][n] * scale; } }
    }
};
struct GroupedOrder {
    StaticOrder so; const PG8_LAS int* tile_e; int nN;
    __device__ __forceinline__ bool next(int i, Unit& u) const { if (!so.next(i, u)) return false; u.pn += tile_e[u.pm] * nN; return true; }
    __device__ __forceinline__ void a_ready(const Unit&) const {}
    __device__ __forceinline__ void done(const Unit&) const {}
};
struct OffsetOrder {
    StaticOrder so; int pn_off;
    __device__ __forceinline__ bool next(int i, Unit& u) const { if (!so.next(i, u)) return false; u.pn += pn_off; return true; }
    __device__ __forceinline__ void a_ready(const Unit&) const {}
    __device__ __forceinline__ void done(const Unit&) const {}
};
struct ProbeOrder {
    StaticOrder so; int pm_mask;
    __device__ __forceinline__ bool next(int i, Unit& u) const { if (!so.next(i, u)) return false; u.pm &= pm_mask; return true; }
    __device__ __forceinline__ void a_ready(const Unit&) const {}
    __device__ __forceinline__ void done(const Unit&) const {}
};
struct MergeOrder {
    StaticOrder so; int nmt;
    __device__ __forceinline__ bool next(int i, Unit& u) const { const int b = i % 3; if (!so.next(i / 3, u)) return false; u.pm += b * nmt; u.pn += b * 4; return true; }
    __device__ __forceinline__ void a_ready(const Unit&) const {}
    __device__ __forceinline__ void done(const Unit&) const {}
};
template <class Epi, class Sched, bool ALIGN_EPI = false, bool SP2 = false>
__device__ __forceinline__ void gemm_phase(PG8_LAS unsigned char* lds, const Gemm g, const Sched& S, const Epi& E) {
    const int tid = g.zv  , wid = __builtin_amdgcn_readfirstlane(tid >> 6), lane = tid & 63, wr = wid >> 2, wc = wid & 3, fr = lane & 15, fq = lane >> 4;
    const int K = g.K, nt = K / BK;
    unsigned voffA[2], voffB[2];
#pragma unroll
    for (int i = 0; i < 2; ++i) { int R, C; stage_rc(tid * 16 + i * 8192, R, C); const int Rb = Epi::PERM ? ((R & ~31) + perm32(R & 31)) : R;
        const int pitch = g.tiled ? BK : K;
        voffA[i] = (unsigned)(R * pitch + C) * 2u; voffB[i] = (unsigned)(Rb * pitch + C) * 2u; }
    const size_t kstep = g.tiled ? (size_t)(BM * BK * 2) : (size_t)(BK * 2);
    const size_t hstep = g.tiled ? (size_t)(HALF * BK * 2) : (size_t)HALF * K * 2;
    const size_t tstep = (size_t)BM * K * 2;
    const unsigned ldsw = (unsigned)wid * 1024u;
    const int aoff = lds_byte(wr * 64 + fr, fq * 8), boff = lds_byte(wc * 32 + fr, fq * 8);
#define PG8_SA(b, h) (((b) * 2 + (h)) * HTB)
#define PG8_SB(b, h) ((4 + (b) * 2 + (h)) * HTB)
#define PG8_STAGE(bufoff, gbase, voff) do { _Pragma("unroll") for (int _i = 0; _i < 2; ++_i) \
        __builtin_amdgcn_global_load_lds((const unsigned*)((const char*)(gbase) + (voff)[_i]), (PG8_LAS unsigned*)(lds + (bufoff) + ldsw + _i * 8192), 16, 0, 0); } while (0)
#define PG8_LDA(dst, b, h) do { _Pragma("unroll") for (int m = 0; m < 4; ++m) _Pragma("unroll") for (int k = 0; k < 2; ++k) dst[m][k] = *(const PG8_LAS bf16x8*)(lds + PG8_SA(b, h) + aoff + m * 2048 + k * 1024); } while (0)
#define PG8_LDB(dst, b, h) do { _Pragma("unroll") for (int n = 0; n < 2; ++n) _Pragma("unroll") for (int k = 0; k < 2; ++k) dst[n][k] = *(const PG8_LAS bf16x8*)(lds + PG8_SB(b, h) + boff + n * 2048 + k * 1024); } while (0)
#define PG8_MMA(ai, bj, At, Bt) do { __builtin_amdgcn_s_setprio(1); _Pragma("unroll") for (int m = 0; m < 4; ++m) _Pragma("unroll") for (int n = 0; n < 2; ++n) _Pragma("unroll") for (int k = 0; k < 2; ++k) \
        acc[ai][bj][m][n] = __builtin_amdgcn_mfma_f32_16x16x32_bf16(Bt[n][k], At[m][k], acc[ai][bj][m][n], 0, 0, 0); __builtin_amdgcn_s_setprio(0); } while (0)
#define PG8_WAIT_V(n) asm volatile("s_waitcnt vmcnt(" #n ")" ::: "memory")
#define PG8_WAIT_L(n) asm volatile("s_waitcnt lgkmcnt(" #n ")" ::: "memory")
#define PG8_BAR __builtin_amdgcn_s_barrier()
#define PG8_SCHED __builtin_amdgcn_sched_barrier(0)
    Unit cur, nxt; int ui = 0;
    if (!S.next(0, cur)) return;
    f32x4 acc[2][2][4][2];
#pragma unroll
    for (int a = 0; a < 2; ++a)
#pragma unroll
        for (int b = 0; b < 2; ++b)
#pragma unroll
            for (int m = 0; m < 4; ++m)
#pragma unroll
                for (int n = 0; n < 2; ++n) acc[a][b][m][n] = (f32x4){0.f, 0.f, 0.f, 0.f};
    bf16x8 At[4][2], B0[2][2], B1[2][2];
    const char* cA = (const char*)g.A + (size_t)cur.pm * tstep; const char* cB = (const char*)g.Bt + (size_t)cur.pn * tstep;
    const int rot = g.rot; const size_t rofs = (size_t)rot * kstep; const char* pA = cA + rofs; const char* pB = cB + rofs;
#define PG8_KT(x) ((size_t)(((x) + rot >= nt) ? (x) + rot - nt : (x) + rot))
    S.a_ready(cur);
    if constexpr (SP2) {
        PG8_STAGE(PG8_SB(0, 0), pB, voffB); PG8_STAGE(PG8_SB(0, 1), pB + hstep, voffB); PG8_STAGE(PG8_SA(0, 0), pA, voffA); PG8_STAGE(PG8_SA(0, 1), pA + hstep, voffA);
        if (wr == 1) PG8_BAR;
        PG8_WAIT_V(2); PG8_BAR;
        PG8_STAGE(PG8_SB(1, 0), pB + kstep, voffB); PG8_STAGE(PG8_SA(1, 0), pA + kstep, voffA); PG8_STAGE(PG8_SB(1, 1), pB + hstep + kstep, voffB);
        PG8_WAIT_V(6); PG8_BAR;
    } else {
        PG8_STAGE(PG8_SB(0, 0), pB, voffB); PG8_STAGE(PG8_SA(0, 0), pA, voffA); PG8_STAGE(PG8_SB(0, 1), pB + hstep, voffB); PG8_STAGE(PG8_SA(0, 1), pA + hstep, voffA);
        if (wr == 1) PG8_BAR;
        PG8_WAIT_V(4); PG8_BAR;
        PG8_STAGE(PG8_SB(1, 0), pB + kstep, voffB); PG8_STAGE(PG8_SA(1, 0), pA + kstep, voffA); PG8_STAGE(PG8_SB(1, 1), pB + hstep + kstep, voffB);
        PG8_WAIT_V(6); PG8_BAR;
    }
    for (;;) {
        const bool has_next = S.next(ui + 1, nxt);
        const char* nA = has_next ? (const char*)g.A + (size_t)nxt.pm * tstep : cA; const char* nB = has_next ? (const char*)g.Bt + (size_t)nxt.pn * tstep : cB;
        for (int t = 0; t < nt; t += 2) {
            if constexpr (Epi::MID) { if (t != 0 && (t & (Epi::MID_TILES - 1)) == 0) E.mid(acc, cur, t / Epi::MID_TILES, wr, wc, fr, fq); }
            const bool last = (t == nt - 2);
            const char* a1 = cA + PG8_KT(t + 1) * kstep;
            const char* a2 = last ? nA + rofs : cA + PG8_KT(t + 2) * kstep; const char* b2 = last ? nB + rofs : cB + PG8_KT(t + 2) * kstep;
            const char* a3 = a2 + kstep; const char* b3 = b2 + kstep;
            if (last && has_next) S.a_ready(nxt);
            if constexpr (SP2) {
            PG8_LDB(B0, 0, 0); PG8_LDB(B1, 0, 1); PG8_SCHED; PG8_LDA(At, 0, 0); PG8_STAGE(PG8_SA(1, 1), a1 + hstep, voffA);
            PG8_WAIT_V(8); PG8_WAIT_L(0); PG8_BAR; PG8_MMA(0, 0, At, B0); PG8_MMA(0, 1, At, B1); PG8_BAR; PG8_SCHED;
            PG8_LDA(At, 0, 1); PG8_STAGE(PG8_SB(0, 0), b2, voffB); PG8_STAGE(PG8_SB(0, 1), b2 + hstep, voffB); PG8_STAGE(PG8_SA(0, 0), a2, voffA);
            PG8_WAIT_V(8); PG8_WAIT_L(0); PG8_BAR; PG8_MMA(1, 0, At, B0); PG8_MMA(1, 1, At, B1); PG8_BAR; PG8_SCHED;
            PG8_LDB(B0, 1, 0); PG8_LDB(B1, 1, 1); PG8_SCHED; PG8_LDA(At, 1, 0); PG8_STAGE(PG8_SA(0, 1), a2 + hstep, voffA);
            PG8_WAIT_V(8); PG8_WAIT_L(0); PG8_BAR; PG8_MMA(0, 0, At, B0); PG8_MMA(0, 1, At, B1); PG8_BAR; PG8_SCHED;
            PG8_LDA(At, 1, 1); PG8_STAGE(PG8_SB(1, 0), b3, voffB); PG8_STAGE(PG8_SB(1, 1), b3 + hstep, voffB); PG8_STAGE(PG8_SA(1, 0), a3, voffA);
            PG8_WAIT_V(8); PG8_WAIT_L(0); PG8_BAR; PG8_MMA(1, 0, At, B0); PG8_MMA(1, 1, At, B1); PG8_BAR; PG8_SCHED;
            } else {
            PG8_LDB(B0, 0, 0); PG8_SCHED; PG8_LDA(At, 0, 0); PG8_STAGE(PG8_SA(1, 1), a1 + hstep, voffA);
            PG8_WAIT_L(8); PG8_BAR; PG8_WAIT_L(0); PG8_MMA(0, 0, At, B0); PG8_BAR; PG8_SCHED;
            PG8_LDB(B1, 0, 1); PG8_STAGE(PG8_SB(0, 0), b2, voffB);
            PG8_BAR; PG8_WAIT_L(0); PG8_MMA(0, 1, At, B1); PG8_BAR;
            PG8_LDA(At, 0, 1); PG8_STAGE(PG8_SA(0, 0), a2, voffA);
            PG8_BAR; PG8_WAIT_L(0); PG8_MMA(1, 0, At, B0); PG8_BAR; PG8_SCHED;
            PG8_STAGE(PG8_SB(0, 1), b2 + hstep, voffB);
            PG8_WAIT_V(6); PG8_BAR; PG8_MMA(1, 1, At, B1); PG8_BAR;
            PG8_LDB(B0, 1, 0); PG8_SCHED; PG8_LDA(At, 1, 0); PG8_STAGE(PG8_SA(0, 1), a2 + hstep, voffA);
            PG8_WAIT_L(8); PG8_BAR; PG8_WAIT_L(0); PG8_MMA(0, 0, At, B0); PG8_BAR; PG8_SCHED;
            PG8_LDB(B1, 1, 1); PG8_STAGE(PG8_SB(1, 0), b3, voffB);
            PG8_BAR; PG8_WAIT_L(0); PG8_MMA(0, 1, At, B1); PG8_BAR;
            PG8_LDA(At, 1, 1); PG8_STAGE(PG8_SA(1, 0), a3, voffA);
            PG8_BAR; PG8_WAIT_L(0); PG8_MMA(1, 0, At, B0); PG8_BAR; PG8_SCHED;
            PG8_STAGE(PG8_SB(1, 1), b3 + hstep, voffB);
            PG8_WAIT_V(6); PG8_BAR; PG8_MMA(1, 1, At, B1); PG8_BAR;
            }
        }
        if constexpr (ALIGN_EPI) { if (wr == 0) PG8_BAR; }
        if constexpr (!Epi::AFTER_DRAIN) { E(acc, cur, wr, wc, fr, fq); S.done(cur); }
        if (!has_next) break;
#pragma unroll
        for (int a = 0; a < 2; ++a)
#pragma unroll
            for (int b = 0; b < 2; ++b)
#pragma unroll
                for (int m = 0; m < 4; ++m)
#pragma unroll
                    for (int n = 0; n < 2; ++n) acc[a][b][m][n] = (f32x4){0.f, 0.f, 0.f, 0.f};
        cur = nxt; cA = nA; cB = nB; ++ui;
        if constexpr (ALIGN_EPI) { if (wr == 1) PG8_BAR; }
    }
    PG8_WAIT_V(0);
    if constexpr (!ALIGN_EPI) { if (wr == 0) PG8_BAR; }
    PG8_BAR;
    if constexpr (Epi::AFTER_DRAIN) { E.fused(acc, cur, wr, wc, fr, fq, lds, wid, lane); S.done(cur); }
#undef PG8_KT
#undef PG8_SA
#undef PG8_SB
#undef PG8_STAGE
#undef PG8_LDA
#undef PG8_LDB
#undef PG8_MMA
#undef PG8_WAIT_V
#undef PG8_WAIT_L
#undef PG8_BAR
#undef PG8_SCHED
}
}

constexpr int NWAVES = 8;
constexpr int DM = 1024, BATCH = 16, SEQ = 4096, DEPTH = 4, MTOK = BATCH * SEQ;
constexpr int NCHUNK = 2, MC = MTOK / NCHUNK, BC = BATCH / NCHUNK;
constexpr int CIN = 5004, NPROJ = 5120, P1W = 2048, GWID = 3072;
constexpr int DFF = 2752, DFFP = 2816, NFF1 = 2 * DFFP;
constexpr int NEXP = 8, DFE = 3584, NMOE1 = 2 * DFE;
constexpr int SLOTS = MC + 2048;
constexpr float EPS = 1e-6f;
constexpr int C_U = 0, C_V = 256, C_SBQ = 512, C_SBK = 768, C_SBV = 1024, C_CQ = 1280, C_KCMP = 1536, C_VCMP = 1600, C_KSLC = 1664, C_VSLC = 1728, C_KWIN = 1792, C_VWIN = 1856, C_CG = 1920;

constexpr size_t MiB = 1u << 20;
constexpr size_t WS_CTL = 0, CTL_ZERO_BYTES = 1 * MiB;
constexpr size_t WS_ROPE = 1 * MiB;
constexpr size_t WS_BIAS1 = 1 * MiB + 512 * 1024;
constexpr size_t WS_WIN = 2 * MiB;
constexpr size_t WS_WBR = 12 * MiB;
constexpr size_t WS_WOUT = 14 * MiB;
constexpr size_t WS_WC1 = 16 * MiB;
constexpr size_t WS_WF1 = 18 * MiB;
constexpr size_t WS_WF2 = 130 * MiB;
constexpr size_t WS_HN = 186 * MiB;
constexpr size_t WS_SCR = 314 * MiB;
constexpr size_t WS_P1 = WS_SCR;
constexpr size_t WS_G = WS_P1 + 128 * MiB;
constexpr size_t WS_Y = WS_G + 192 * MiB;
constexpr size_t WS_MG = WS_Y + 48 * MiB;
constexpr size_t WS_KVC = WS_MG + 64 * MiB;
constexpr size_t WS_UL = WS_KVC + 8 * MiB;
constexpr size_t WS_KC = WS_UL + 8 * MiB;
constexpr size_t WS_VT = WS_KC + 1 * MiB;
constexpr size_t WS_KCT = WS_VT + 24 * MiB;
constexpr size_t WS_MIX_END = WS_KCT + 1 * MiB;
constexpr size_t WS_HID = WS_SCR;
constexpr size_t WS_ROUTE = WS_SCR;
constexpr size_t WS_TOKMAP = WS_SCR + 1 * MiB;
constexpr size_t WS_WSLOT = WS_SCR + 2 * MiB;
constexpr size_t WS_XG = WS_SCR + 4 * MiB;
constexpr size_t WS_HIDM = WS_XG + 68 * MiB;
constexpr size_t WS_END = 800 * MiB;
static_assert(WS_MIX_END <= WS_END && WS_HID + (size_t)MTOK * DFFP * 2 <= WS_END && WS_HIDM + (size_t)SLOTS * DFE * 2 <= WS_END, "d_ws map");
static_assert(WS_WF1 + (size_t)NEXP * NMOE1 * DM * 2 <= WS_WF2 && WS_WF2 + (size_t)NEXP * DM * DFE * 2 <= WS_HN, "weight map");
static_assert((size_t)4 * SLOTS * 4 <= 1 * MiB, "tokmap");
constexpr int CW_BAR = 4096;
constexpr int CW_CNT = 131072;
constexpr int CW_CUR = 131072 + 256;
constexpr int MAX_BAR_REGIONS = 32;
constexpr int RING_OFF = 0, RING_BYTES = 131072;
constexpr int LDSCTL_OFF = RING_BYTES, MISC_OFF = LDSCTL_OFF + 320;
constexpr int TAB_OFF = LDSCTL_OFF + 1024;
constexpr int LDS_BYTES = 147456;

#define GAS __attribute__((address_space(1)))
#define LAS __attribute__((address_space(3)))
typedef unsigned short bf16;
typedef unsigned v4u __attribute__((ext_vector_type(4)));
typedef unsigned v2u __attribute__((ext_vector_type(2)));
typedef float f32x4 __attribute__((ext_vector_type(4)));
typedef int v4i __attribute__((ext_vector_type(4)));
typedef __bf16 bf16x2_t __attribute__((ext_vector_type(2)));
#define LDS_WAIT() asm volatile("s_waitcnt lgkmcnt(0)" ::: "memory")
#define VM_WAIT() asm volatile("s_waitcnt vmcnt(0)" ::: "memory")
__device__ __forceinline__ unsigned f2bf(float f) { unsigned u = __builtin_bit_cast(unsigned, f); return (u + 0x7fffu + ((u >> 16) & 1u)) >> 16; }
__device__ __forceinline__ unsigned pk2(float lo, float hi) { return f2bf(lo) | (f2bf(hi) << 16); }
__device__ __forceinline__ float bflo(unsigned u) { return __builtin_bit_cast(float, u << 16); }
__device__ __forceinline__ float bfhi(unsigned u) { return __builtin_bit_cast(float, u & 0xffff0000u); }
__device__ __forceinline__ float bf1(bf16 h) { return __builtin_bit_cast(float, (unsigned)h << 16); }
__device__ __forceinline__ float dot2bf(unsigned a, unsigned b, float c) { return __builtin_amdgcn_fdot2_f32_bf16(__builtin_bit_cast(bf16x2_t, a), __builtin_bit_cast(bf16x2_t, b), c, false); }
#ifdef EMU_FP8
__device__ __forceinline__ float q8r(float x, float s) { const int p = __builtin_amdgcn_cvt_pk_fp8_f32(x * s, x * s, 0, false); return __builtin_amdgcn_cvt_f32_fp8(p, 0) * (1.0f / s); }
#else
__device__ __forceinline__ float q8r(float x, float) { return x; }
#endif
__device__ __forceinline__ float fexp(float x) { return __builtin_amdgcn_exp2f(1.4426950408889634f * x); }
template <int X> __device__ __forceinline__ float swz_xor(float v) { return __builtin_bit_cast(float, __builtin_amdgcn_ds_swizzle(__builtin_bit_cast(int, v), (X << 10) | 0x1f)); }
__device__ __forceinline__ float wave_sum(float v, int lane) {
#pragma unroll
    for (int o = 1; o < 64; o <<= 1) v += __builtin_bit_cast(float, __builtin_amdgcn_ds_bpermute((lane ^ o) << 2, __builtin_bit_cast(int, v)));
    return v;
}
__device__ __forceinline__ float rdlane(float v, int l) { return __builtin_bit_cast(float, __builtin_amdgcn_readlane(__builtin_bit_cast(int, v), l)); }
__device__ __forceinline__ int bperm(int srclane, int v) { return __builtin_amdgcn_ds_bpermute(srclane << 2, v); }
__constant__ double ROPE_INVF[8] = {1.0, 0.19392274474868576, 0.037606030930863933, 0.0072926647372171093, 0.0014142135623730950, 0.00027424817567620730, 5.3182958969449883e-05, 1.0313385377212460e-05};
#define XB_TMO      128
#define XB_XCNT(j)  (256  + 64 * (j))
#define XB_XSUB(j)  (1280 + 64 * (j))
#define XB_XGEN(j)  (2304 + 64 * (j))
#define XB_TOP      3328
#define XB_TOPGEN   3392
#define XCD_BAR_WORDS 3456
#define XB_SPIN_CAP (1u << 18)

__device__ __forceinline__ unsigned xb_ld(unsigned* p)              { return __hip_atomic_load(p, __ATOMIC_RELAXED, __HIP_MEMORY_SCOPE_AGENT); }
__device__ __forceinline__ unsigned xb_add(unsigned* p, unsigned v) { return __hip_atomic_fetch_add(p, v, __ATOMIC_RELAXED, __HIP_MEMORY_SCOPE_AGENT); }
__device__ __forceinline__ unsigned xb_xcc_id() { return (unsigned)__builtin_amdgcn_s_getreg((3 << 11) | 20) & 0xFu; }
#define XB_SPIN(cond, bar) do { unsigned _sp = 0; while (cond) { __builtin_amdgcn_s_sleep(1); \
    if ((++_sp & 255u) == 0u) { if (xb_ld(&(bar)[XB_TMO])) break; if (_sp > XB_SPIN_CAP) { atomicAdd(&(bar)[XB_TMO], 1u); break; } } } } while (0)

__device__ __forceinline__ bool xb_thread0_w(unsigned w, unsigned z) { return w == 0u && __builtin_amdgcn_mbcnt_hi(~0u, __builtin_amdgcn_mbcnt_lo(~0u, z)) == 0u; }
struct XcdBarrier {
    unsigned* bar; unsigned x; unsigned w, z;
    volatile LAS unsigned* st;
};

__device__ __forceinline__ XcdBarrier xcd_barrier_post(unsigned* bar, volatile LAS unsigned* st) {
    XcdBarrier b; b.bar = bar; b.x = xb_xcc_id(); b.st = st; b.w = (unsigned)__builtin_amdgcn_readfirstlane((int)(threadIdx.x >> 6)); b.z = 0u;
    if (xb_thread0_w(b.w, b.z)) (void)xb_add(&bar[XB_XCNT(b.x)], 1u);
    return b;
}
__device__ __forceinline__ void xcd_barrier_complete(unsigned* bar, unsigned x, unsigned& nloc, unsigned& nx) {
    const unsigned G = gridDim.x * gridDim.y * gridDim.z;
    unsigned sum, cnt, mine, sp = 0u;
    for (;;) {
        sum = 0u; cnt = 0u; mine = 0u;
#pragma unroll
        for (unsigned j = 0; j < 16; ++j) { const unsigned c = xb_ld(&bar[XB_XCNT(j)]); sum += c; cnt += (c > 0u) ? 1u : 0u; mine = (j == x) ? c : mine; }
        if (sum == G) break;
        __builtin_amdgcn_s_sleep(1);
        if ((++sp & 255u) == 0u) { if (xb_ld(&bar[XB_TMO])) break; if (sp > XB_SPIN_CAP) { atomicAdd(&bar[XB_TMO], 1u); break; } }
    }
    nloc = mine > 0u ? mine : 1u; nx = cnt > 0u ? cnt : 1u;
}

__device__ __forceinline__ void xcd_barrier(const XcdBarrier& b) {
    asm volatile("s_waitcnt vmcnt(0)" ::: "memory");
    __syncthreads();
    if (xb_thread0_w(b.w, b.z)) {
        unsigned* bar = b.bar;
        __builtin_amdgcn_s_waitcnt(0);
        unsigned nloc = b.st[0], nx = b.st[1];
        if (nloc == 0u) { xcd_barrier_complete(bar, b.x, nloc, nx); b.st[0] = nloc; b.st[1] = nx; }
        const unsigned old = xb_add(&bar[XB_XSUB(b.x)], 1u);
        const unsigned gen = old / nloc;
        if (old + 1u == (gen + 1u) * nloc) {
            __builtin_amdgcn_fence(__ATOMIC_RELEASE, "agent");
            asm volatile("s_waitcnt vmcnt(0)" ::: "memory");
            const unsigned og = xb_add(&bar[XB_TOP], 1u);
            const unsigned tg = og / nx;
            if (og + 1u == (tg + 1u) * nx) xb_add(&bar[XB_TOPGEN], 1u);
            else XB_SPIN(xb_ld(&bar[XB_TOPGEN]) == tg, bar);
            __builtin_amdgcn_fence(__ATOMIC_ACQUIRE, "agent");
            xb_add(&bar[XB_XGEN(b.x)], 1u);
            asm volatile("s_waitcnt vmcnt(0)" ::: "memory");
        } else {
            XB_SPIN(xb_ld(&bar[XB_XGEN(b.x)]) == gen, bar);
            __builtin_amdgcn_fence(__ATOMIC_ACQUIRE, "agent");
            asm volatile("s_waitcnt vmcnt(0)" ::: "memory");
        }
    }
    __syncthreads();
}

struct Frame {
    LAS unsigned char* lds;
    unsigned* ctl;
    int tid, lane, wave, vcu, G, bx, zv, zs, rep;
    unsigned char* ws;
    const float* const* in;
    float* out;
};
#define WSP(T, off) ((T*)(F.ws + (off)))
__device__ __forceinline__ size_t toff(int row, int k, int K) { return (size_t)(row >> 8) * 256 * K + (size_t)(k >> 6) * (256 * 64) + (size_t)(row & 255) * 64 + (k & 63); }

#ifndef TILED_FFN1
#define TILED_FFN1 0
#endif
#ifndef Q8_W1
#define Q8_W1 0.f
#define Q8_W2 0.f
#define Q8_HN 0.f
#define Q8_HID 0.f
#endif
__device__ __forceinline__ int map_row(int kind, int off, int n) { return kind == 0 ? n + off : (kind == 1 ? (n < 1932 ? n : n + 116) : ((n >> 7) * 256 + (n & 127) + off)); }
__device__ __forceinline__ void tr_item(const float* W, int ldw, int N, int ks, int n0, bf16* WT, int ldt, int kd, int kind, int off, LAS unsigned char* scr, int lane, float q8s = 0.f, int tiled = 0) {
    const int nq = (lane & 15) * 4, kq = lane >> 4;
    f32x4 x[16];
#pragma unroll
    for (int i = 0; i < 16; ++i) x[i] = (n0 + nq < N) ? *(const f32x4*)(W + (size_t)(ks + 4 * i + kq) * ldw + n0 + nq) : (f32x4){0.f, 0.f, 0.f, 0.f};
#pragma unroll
    for (int i = 0; i < 16; ++i) { const int k = 4 * i + kq;
#pragma unroll
        for (int c = 0; c < 4; ++c) { float wv = x[i][c]; if (q8s > 0.f) wv = q8r(wv, q8s); *(LAS bf16*)(scr + (nq + c) * 136 + k * 2) = (bf16)f2bf(wv); } }
    LDS_WAIT(); asm volatile("" ::: "memory");
    if (n0 + lane < N) { const LAS v2u* s = (const LAS v2u*)(scr + lane * 136); const int mr = map_row(kind, off, n0 + lane); bf16* dst = tiled ? WT + toff(mr, kd, ldt) : WT + (size_t)mr * ldt + kd;
#pragma unroll
        for (int q = 0; q < 8; ++q) { const v2u a = s[2 * q], b = s[2 * q + 1]; *(v4u*)(dst + 8 * q) = (v4u){a.x, a.y, b.x, b.y}; } }
    LDS_WAIT(); asm volatile("" ::: "memory");
}
__device__ __forceinline__ void conv(Frame& F, const float* W, size_t sW, int nb, int ldw, int N, int ks0, int K, bf16* WT, size_t sWT, int ldt, int kd0, int kind, int off, float q8s = 0.f, int tiled = 0) {
    LAS unsigned char* scr = F.lds + RING_OFF + F.wave * 16384;
    const int gw = F.vcu * NWAVES + F.wave, NGW = F.G * NWAVES;
    const int nblk = (N + 63) / 64, per = (K / 64) * nblk, total = per * nb;
    for (int it = gw; it < total; it += NGW) { const int b = it / per, r = it % per, kb = r / nblk, nbk = r % nblk;
        tr_item(W + (size_t)b * sW, ldw, N, ks0 + 64 * kb, 64 * nbk, WT + (size_t)b * sWT, ldt, kd0 + 64 * kb, kind, off, scr, F.lane, q8s, tiled); }
}
__device__ __forceinline__ void zero_block(Frame& F, bf16* WT, int ldt, int r0, int rows, int c0, int cols, int tiled = 0) {
    const int gt = (F.vcu * NWAVES + F.wave) * 64 + F.lane, NT = F.G * NWAVES * 64, cpr = cols / 8;
    for (int i = gt; i < rows * cpr; i += NT) { const int r = i / cpr, c = i % cpr; const unsigned z = (unsigned)F.zv; *(v4u*)(tiled ? WT + toff(r0 + r, c0 + 8 * c, ldt) : WT + (size_t)(r0 + r) * ldt + c0 + 8 * c) = (v4u){z, z, z, z}; }
}
__device__ __forceinline__ void p_convert(Frame& F, int layer) {
    const int j = layer >> 1;
    conv(F, F.in[2] + (size_t)layer * DM * CIN, 0, 1, CIN, CIN, 0, DM, WSP(bf16, WS_WIN), 0, DM, 0, 1, 0);
    zero_block(F, WSP(bf16, WS_WIN), DM, 1932, 116, 0, DM);
    conv(F, F.in[9] + (size_t)layer * 3 * 256 * DM, (size_t)256 * DM, 3, DM, DM, 0, 256, WSP(bf16, WS_WBR), (size_t)DM * 256, 256, 0, 0, 0);
    conv(F, F.in[10] + (size_t)layer * DM * DM, 0, 1, DM, DM, 0, DM, WSP(bf16, WS_WOUT), 0, DM, 0, 0, 0);
    conv(F, F.in[7] + (size_t)layer * 2 * 2048 * 256, (size_t)2048 * 256, 2, 256, 256, 0, 1024, WSP(bf16, WS_WC1), (size_t)512 * 1024, 1024, 0, 0, 0);
    conv(F, F.in[7] + (size_t)layer * 2 * 2048 * 256, (size_t)2048 * 256, 2, 256, 256, 1024, 1024, WSP(bf16, WS_WC1), (size_t)512 * 1024, 1024, 0, 0, 256);
    if ((layer & 1) == 0) {
        conv(F, F.in[12] + (size_t)j * DM * DFF, 0, 1, DFF, DFF, 0, DM, WSP(bf16, WS_WF1), 0, DM, 0, 2, 0, Q8_W1, TILED_FFN1);
        conv(F, F.in[13] + (size_t)j * DM * DFF, 0, 1, DFF, DFF, 0, DM, WSP(bf16, WS_WF1), 0, DM, 0, 2, 128, Q8_W1, TILED_FFN1);
        zero_block(F, WSP(bf16, WS_WF1), DM, 21 * 256 + 64, 64, 0, DM, TILED_FFN1);
        zero_block(F, WSP(bf16, WS_WF1), DM, 21 * 256 + 128 + 64, 64, 0, DM, TILED_FFN1);
        conv(F, F.in[14] + (size_t)j * DFF * DM, 0, 1, DM, DM, 0, DFF, WSP(bf16, WS_WF2), 0, DFFP, 0, 0, 0, Q8_W2);
        zero_block(F, WSP(bf16, WS_WF2), DFFP, 0, DM, DFF, DFFP - DFF);
    } else {
        conv(F, F.in[16] + (size_t)j * NEXP * DM * DFE, (size_t)DM * DFE, NEXP, DFE, DFE, 0, DM, WSP(bf16, WS_WF1), (size_t)NMOE1 * DM, DM, 0, 2, 0, Q8_W1);
        conv(F, F.in[17] + (size_t)j * NEXP * DM * DFE, (size_t)DM * DFE, NEXP, DFE, DFE, 0, DM, WSP(bf16, WS_WF1), (size_t)NMOE1 * DM, DM, 0, 2, 128, Q8_W1);
        conv(F, F.in[18] + (size_t)j * NEXP * DFE * DM, (size_t)DFE * DM, NEXP, DM, DM, 0, DFE, WSP(bf16, WS_WF2), (size_t)DM * DFE, DFE, 0, 0, 0, Q8_W2);
    }
    if (F.bx < 8) {
        __syncthreads();
        const int kv = F.bx >> 2, jj = (F.bx & 3) * 64 + F.lane;
        const float* pos = F.in[6] + (size_t)(layer * 2 + kv) * 2048; const float* w1 = F.in[7] + (size_t)(layer * 2 + kv) * 2048 * 256;
        float a = 0.f;
        float a1 = 0.f, a2 = 0.f, a3 = 0.f;
#pragma unroll 8
        for (int k = 0; k < 256; k += 4) { const int kk = F.wave * 256 + k;
            a += pos[kk] * w1[(size_t)kk * 256 + jj]; a1 += pos[kk + 1] * w1[(size_t)(kk + 1) * 256 + jj]; a2 += pos[kk + 2] * w1[(size_t)(kk + 2) * 256 + jj]; a3 += pos[kk + 3] * w1[(size_t)(kk + 3) * 256 + jj]; }
        a = (a + a1) + (a2 + a3);
        LAS float* red = (LAS float*)(F.lds + RING_OFF);
        red[F.wave * 64 + F.lane] = a;
        __syncthreads();
        if (F.wave == 0) { float s = 0.f;
#pragma unroll
            for (int w = 0; w < 8; ++w) s += red[w * 64 + F.lane];
            WSP(float, WS_BIAS1)[kv * 256 + jj] = s; }
        __syncthreads();
    }
    if (layer == 0) {
        const int gt = (F.vcu * NWAVES + F.wave) * 64 + F.lane, NT = F.G * NWAVES * 64;
        for (int idx = gt; idx < SEQ * 8; idx += NT) { const int pos = idx >> 3, i = idx & 7;
            const double invf = ROPE_INVF[i];
            double rev = (double)pos * invf * 0.15915494309189535; rev -= __builtin_floor(rev);
            WSP(float, WS_ROPE)[idx] = __builtin_amdgcn_cosf((float)rev); WSP(float, WS_ROPE)[SEQ * 8 + idx] = __builtin_amdgcn_sinf((float)rev); }
    }
}

template <int MODE> __device__ __forceinline__ void p_norm(Frame& F, const float* src, const float* g, const float* rw, int jmoe, float q8s = 0.f, int tiled = 0) {
    const int gw = F.vcu * NWAVES + F.wave, NGW = F.G * NWAVES, lane = F.lane;
    LAS int* hist = (LAS int*)(F.lds + TAB_OFF) + 192;
    if (MODE == 1) {
        if (F.tid < 32) hist[F.tid] = 0;
        const int gt = gw * 64 + lane, NT = NGW * 64; int* tm = WSP(int, WS_TOKMAP);
        for (int i = gt; i < 4 * SLOTS; i += NT) tm[i] = -1;
        for (int i = F.tid; i < DM * NEXP / 4; i += NWAVES * 64) *(LAS f32x4*)(F.lds + RING_OFF + 16 * i) = ((const f32x4*)rw)[i];
        __syncthreads();
    }
    f32x4 gv[4];
#pragma unroll
    for (int jx = 0; jx < 4; ++jx) gv[jx] = ((const f32x4*)g)[lane + 64 * jx];
    constexpr int ROWS = (MODE == 1) ? 2 : 4;
    for (int m0 = gw; m0 < MTOK; m0 += ROWS * NGW) {
        f32x4 v[ROWS][4]; float ss[ROWS];
#pragma unroll
        for (int u = 0; u < ROWS; ++u) { const int m = m0 + u * NGW; const f32x4* xr = (const f32x4*)(src + (size_t)(m < MTOK ? m : m0) * DM) + lane;
#pragma unroll
            for (int jx = 0; jx < 4; ++jx) v[u][jx] = xr[64 * jx]; }
#pragma unroll
        for (int u = 0; u < ROWS; ++u) { float s = 0.f;
#pragma unroll
            for (int jx = 0; jx < 4; ++jx) s += (v[u][jx].x * v[u][jx].x + v[u][jx].y * v[u][jx].y) + (v[u][jx].z * v[u][jx].z + v[u][jx].w * v[u][jx].w);
            ss[u] = s; }
#pragma unroll
        for (int o = 1; o < 64; o <<= 1) {
#pragma unroll
            for (int u = 0; u < ROWS; ++u) ss[u] += __builtin_bit_cast(float, __builtin_amdgcn_ds_bpermute((lane ^ o) << 2, __builtin_bit_cast(int, ss[u]))); }
        float lgall[MODE == 1 ? ROWS : 1][8];
        if (MODE == 1) {
            float rs[ROWS];
#pragma unroll
            for (int u = 0; u < ROWS; ++u) { rs[u] = 1.0f / sqrtf(ss[u] * (1.f / DM) + EPS);
#pragma unroll
                for (int e = 0; e < 8; ++e) lgall[u][e] = 0.f; }
#pragma unroll
            for (int jx = 0; jx < 4; ++jx) { const LAS f32x4* wr = (const LAS f32x4*)(F.lds + RING_OFF + (size_t)(4 * lane + 256 * jx) * 32);
#pragma unroll
                for (int r = 0; r < 4; ++r) { const f32x4 a = wr[2 * r], b = wr[2 * r + 1];
#pragma unroll
                    for (int u = 0; u < ROWS; ++u) { const float xv = v[u][jx][r] * rs[u] * gv[jx][r];
                        lgall[u][0] += xv * a.x; lgall[u][1] += xv * a.y; lgall[u][2] += xv * a.z; lgall[u][3] += xv * a.w; lgall[u][4] += xv * b.x; lgall[u][5] += xv * b.y; lgall[u][6] += xv * b.z; lgall[u][7] += xv * b.w; } } }
        }
#pragma unroll
        for (int u = 0; u < ROWS; ++u) { const int m = m0 + u * NGW; if (m >= MTOK) continue;
            const float rstd = 1.0f / sqrtf(ss[u] * (1.f / DM) + EPS);
#pragma unroll
            for (int jx = 0; jx < 4; ++jx) v[u][jx] = v[u][jx] * rstd * gv[jx];
            if (MODE == 2) {
                f32x4* o = (f32x4*)(F.out + (size_t)m * DM) + lane;
#pragma unroll
                for (int jx = 0; jx < 4; ++jx) o[64 * jx] = v[u][jx];
            } else {
                unsigned long long* o8 = (unsigned long long*)(WSP(bf16, WS_HN) + (size_t)m * DM) + lane;
#pragma unroll
                for (int jx = 0; jx < 4; ++jx) { f32x4 w = v[u][jx];
                    if (tiled) { *(unsigned long long*)(WSP(bf16, WS_HN) + toff(m, 4 * lane + 256 * jx, DM)) = (unsigned long long)pk2(w.x, w.y) | ((unsigned long long)pk2(w.z, w.w) << 32); continue; } if (q8s > 0.f) { w.x = q8r(w.x, q8s); w.y = q8r(w.y, q8s); w.z = q8r(w.z, q8s); w.w = q8r(w.w, q8s); }
                    o8[64 * jx] = (unsigned long long)pk2(w.x, w.y) | ((unsigned long long)pk2(w.z, w.w) << 32); }
            }
            if (MODE == 1) {
                float lg[8];
#pragma unroll
                for (int e = 0; e < 8; ++e) lg[e] = lgall[u][e];
                float h4[4], h2[2], h1;
                { const bool up = lane & 1;
#pragma unroll
                  for (int i = 0; i < 4; ++i) { const float keep = up ? lg[4 + i] : lg[i], send = up ? lg[i] : lg[4 + i]; h4[i] = keep + __builtin_bit_cast(float, bperm(lane ^ 1, __builtin_bit_cast(int, send))); } }
                { const bool up = lane & 2;
#pragma unroll
                  for (int i = 0; i < 2; ++i) { const float keep = up ? h4[2 + i] : h4[i], send = up ? h4[i] : h4[2 + i]; h2[i] = keep + __builtin_bit_cast(float, bperm(lane ^ 2, __builtin_bit_cast(int, send))); } }
                { const bool up = lane & 4; const float keep = up ? h2[1] : h2[0], send = up ? h2[0] : h2[1]; h1 = keep + __builtin_bit_cast(float, bperm(lane ^ 4, __builtin_bit_cast(int, send))); }
                h1 += __builtin_bit_cast(float, bperm(lane ^ 8, __builtin_bit_cast(int, h1))); h1 += __builtin_bit_cast(float, bperm(lane ^ 16, __builtin_bit_cast(int, h1))); h1 += __builtin_bit_cast(float, bperm(lane ^ 32, __builtin_bit_cast(int, h1)));
                lg[0] = rdlane(h1, 0); lg[1] = rdlane(h1, 4); lg[2] = rdlane(h1, 2); lg[3] = rdlane(h1, 6); lg[4] = rdlane(h1, 1); lg[5] = rdlane(h1, 5); lg[6] = rdlane(h1, 3); lg[7] = rdlane(h1, 7);
                int e0 = 0; float v0 = lg[0];
#pragma unroll
                for (int e = 1; e < 8; ++e) if (lg[e] > v0) { v0 = lg[e]; e0 = e; }
                int e1 = -1; float v1 = -INFINITY;
#pragma unroll
                for (int e = 0; e < 8; ++e) if (e != e0 && lg[e] > v1) { v1 = lg[e]; e1 = e; }
                const float w0 = 1.0f / (1.0f + fexp(v1 - v0)), w1 = 1.0f - w0;
                if (lane == 0) { WSP(v4i, WS_ROUTE)[m] = (v4i){e0, e1, __builtin_bit_cast(int, w0), __builtin_bit_cast(int, w1)};
                    const int c = m / MC; if (!F.rep) { atomicAdd((int*)&hist[(c * 2 + 0) * 8 + e0], 1); atomicAdd((int*)&hist[(c * 2 + 1) * 8 + e1], 1); } }
            }
        }
    }
    if (MODE == 1) {
        __syncthreads();
        if (F.tid < 32) { const int h = hist[F.tid]; if (h) atomicAdd(F.ctl + CW_CNT + jmoe * 32 + F.tid, (unsigned)h); }
    }
}

__device__ __forceinline__ void p_prep(Frame& F) {
    const int gw = F.vcu * NWAVES + F.wave, NGW = F.G * NWAVES, lane = F.lane;
    bf16* P1 = WSP(bf16, WS_P1); bf16* KVC = WSP(bf16, WS_KVC); const float* rope = WSP(float, WS_ROPE);
    const int vec = lane >> 3, ri = lane & 7; const int cb = vec < 4 ? C_CQ + vec * 64 : (vec == 4 ? C_KCMP : (vec == 5 ? C_KSLC : C_KWIN));
    for (int row0 = gw; row0 < MC; row0 += 4 * NGW) {
        float x1[4], x2[4], cc[4], ss[4]; bf16 kc48[4], vc64[4];
#pragma unroll
        for (int k = 0; k < 4; ++k) { const int row = row0 + k * NGW < MC ? row0 + k * NGW : row0; const bf16* p = P1 + (size_t)row * P1W; const int pos = row & (SEQ - 1);
            const int cl = lane < 56 ? cb + ri : C_CQ;
            x1[k] = bf1(p[cl]); x2[k] = bf1(p[cl + 8]); cc[k] = rope[pos * 8 + ri]; ss[k] = rope[SEQ * 8 + pos * 8 + ri];
            if (F.rep) { cc[k] = 1.f; ss[k] = 0.f; }
            kc48[k] = p[C_KCMP + 16 + (lane < 48 ? lane : 0)]; vc64[k] = p[C_VCMP + lane]; }
#pragma unroll
        for (int k = 0; k < 4; ++k) { const int row = row0 + k * NGW; if (row >= MC) continue; bf16* p = P1 + (size_t)row * P1W;
            if (lane < 56) { const bf16 o1 = (bf16)f2bf(x1[k] * cc[k] - x2[k] * ss[k]), o2 = (bf16)f2bf(x2[k] * cc[k] + x1[k] * ss[k]);
                p[cb + ri] = o1; p[cb + ri + 8] = o2;
                if (vec == 4) { KVC[(size_t)row * 64 + ri] = o1; KVC[(size_t)row * 64 + ri + 8] = o2; } }
            if (lane < 48) KVC[(size_t)row * 64 + 16 + lane] = kc48[k];
            KVC[(size_t)MC * 64 + (size_t)row * 64 + lane] = vc64[k]; }
    }
    bf16* VT = WSP(bf16, WS_VT);
    for (int it = gw; it < 6 * BC * 64; it += NGW) { const int which = it / (BC * 64), r = it % (BC * 64), b = r >> 6, blk = r & 63;
        const v4u* src = (const v4u*)(P1 + ((size_t)b * SEQ + blk * 64 + lane) * P1W + (which == 0 ? C_VSLC : (which == 1 ? C_VWIN : C_SBV + (which - 2) * 64)));
        bf16* dst = VT + ((size_t)(which * BC + b) * 64) * SEQ + blk * 64 + lane;
        v4u xs[8];
#pragma unroll
        for (int i = 0; i < 8; ++i) xs[i] = src[i];
#pragma unroll
        for (int i = 0; i < 8; ++i) { const v4u x = xs[i];
            dst[(size_t)(8 * i + 0) * SEQ] = (bf16)(x.x & 0xffffu); dst[(size_t)(8 * i + 1) * SEQ] = (bf16)(x.x >> 16);
            dst[(size_t)(8 * i + 2) * SEQ] = (bf16)(x.y & 0xffffu); dst[(size_t)(8 * i + 3) * SEQ] = (bf16)(x.y >> 16);
            dst[(size_t)(8 * i + 4) * SEQ] = (bf16)(x.z & 0xffffu); dst[(size_t)(8 * i + 5) * SEQ] = (bf16)(x.z >> 16);
            dst[(size_t)(8 * i + 6) * SEQ] = (bf16)(x.w & 0xffffu); dst[(size_t)(8 * i + 7) * SEQ] = (bf16)(x.w >> 16); }
    }
}
__device__ __forceinline__ void p_sgu(Frame& F, int layer) {
    LAS float* vn = (LAS float*)(F.lds + RING_OFF);
    const bf16* P1 = WSP(bf16, WS_P1); bf16* Ya = WSP(bf16, WS_Y);
    const float* gain = F.in[3] + (size_t)layer * 256; const float* sw = F.in[4] + (size_t)layer * 4 * 128 * 128; const float* sb = F.in[5] + (size_t)layer * 4 * 128;
    const int lane = F.lane, wave = F.wave;
    for (int item = F.vcu; item < MC / 128; item += F.G) {
        const size_t r0 = (size_t)item * 128;
        __syncthreads();
        for (int rr = 0; rr < 16; ++rr) { const int r = wave * 16 + rr; const v2u raw = *(const v2u*)(P1 + (r0 + r) * P1W + C_V + 4 * lane);
            const float a = bflo(raw.x), b = bfhi(raw.x), c = bflo(raw.y), d = bfhi(raw.y);
            const float rstd = 1.0f / sqrtf(wave_sum((a * a + b * b) + (c * c + d * d), lane) * (1.f / 256.f) + EPS);
            const f32x4 gg = ((const f32x4*)gain)[lane];
            *(LAS f32x4*)(vn + r * 256 + 4 * lane) = (f32x4){a * rstd * gg.x, b * rstd * gg.y, c * rstd * gg.z, d * rstd * gg.w}; }
        __syncthreads();
        const int g = wave & 3, half = wave >> 2;
        for (int i = 0; i < 64; ++i) { const int t = 2 * i + half;
            const float* wrow = sw + ((size_t)g * 128 + t) * 128;
            const float w_lo = wrow[lane], w_hi = wrow[64 + lane];
            float acc = 0.f;
            for (int s = 0; s <= t; ++s) { const float w = (s < 64) ? rdlane(w_lo, s) : rdlane(w_hi, s - 64); acc += w * vn[s * 256 + g * 64 + lane]; }
            const float u = bf1(P1[(r0 + t) * P1W + C_U + g * 64 + lane]);
#ifdef ABL_SGUMIX
            acc = 0.f;
#endif
            Ya[(r0 + t) * 256 + g * 64 + lane] = (bf16)f2bf(u * (acc + sb[g * 128 + t])); }
    }
    __syncthreads();
}

__device__ __forceinline__ void p_cmpfin(Frame& F, int layer) {
    const int gw = F.vcu * NWAVES + F.wave, NGW = F.G * NWAVES, lane = F.lane;
    const float* UL = WSP(float, WS_UL); const float* bias = WSP(float, WS_BIAS1); bf16* KC = WSP(bf16, WS_KC);
    LAS float* w2l = (LAS float*)(F.lds + RING_OFF);
    __syncthreads();
    { const f32x4* src = (const f32x4*)(F.in[8] + (size_t)layer * 2 * 256 * 64);
#pragma unroll 4
      for (int i = F.tid; i < 2 * 256 * 64 / 4; i += NWAVES * 64) *(LAS f32x4*)(w2l + 4 * i) = src[i]; }
    __syncthreads();
    for (int it = gw; it < 2 * BC * 255; it += NGW) { const int kv = it / (BC * 255), r = it % (BC * 255), b = r / 255, m = r % 255;
        const LAS float* w2 = w2l + kv * 256 * 64;
        const float* U = UL + (size_t)(kv * 2048 + b * 256 + m) * 512; const float* L = U + 512 + 256;
        float hv[4];
#pragma unroll
        for (int q = 0; q < 4; ++q) hv[q] = pg8::gelu_tanh(U[64 * q + lane] + L[64 * q + lane] + bias[kv * 256 + 64 * q + lane]);
        float acc0 = 0.f, acc1 = 0.f;
#pragma unroll
        for (int q = 0; q < 4; ++q)
#pragma unroll 8
            for (int jj = 0; jj < 64; jj += 2) { acc0 += rdlane(hv[q], jj) * w2[(64 * q + jj) * 64 + lane]; acc1 += rdlane(hv[q], jj + 1) * w2[(64 * q + jj + 1) * 64 + lane]; }
        const float acc = acc0 + acc1;
        KC[((size_t)(kv * BC + b) * 256 + m) * 64 + lane] = (bf16)f2bf(acc);
        if (kv == 1) { WSP(bf16, WS_KCT)[((size_t)b * 64 + lane) * 256 + m] = (bf16)f2bf(acc); if (m == 254) WSP(bf16, WS_KCT)[((size_t)b * 64 + lane) * 256 + 255] = (bf16)0; }
        else if (m == 254) KC[((size_t)b * 256 + 255) * 64 + lane] = (bf16)0; }
    __syncthreads();
}

__device__ __forceinline__ void p_stick(Frame& F) {
    const int gw = F.vcu * NWAVES + F.wave, NGW = F.G * NWAVES, lane = F.lane;
    const bf16* P1 = WSP(bf16, WS_P1); bf16* Yb = WSP(bf16, WS_Y) + (size_t)MC * 256;
    for (int item = gw; item < BC * 4 * 64; item += NGW) { const int tb = item & 63, h = (item >> 6) & 3, b = item >> 8;
        const int t = tb * 64 + lane; const size_t row = (size_t)b * SEQ + t;
        unsigned q[32];
        { const v4u* qp = (const v4u*)(P1 + row * P1W + C_SBQ + h * 64);
#pragma unroll
          for (int i = 0; i < 8; ++i) { const v4u x = qp[i]; q[4 * i] = x.x; q[4 * i + 1] = x.y; q[4 * i + 2] = x.z; q[4 * i + 3] = x.w; } }
        float o[64];
#pragma unroll
        for (int d = 0; d < 64; ++d) o[d] = 0.f;
        float R = 0.f;
        const bf16* kb = P1 + (size_t)b * SEQ * P1W + C_SBK + h * 64; const bf16* vb = P1 + (size_t)b * SEQ * P1W + C_SBV + h * 64;
        for (int s = t - 1; s >= 0; --s) {
            if (R < -100.f) break;
            const v4u* kp = (const v4u*)(kb + (size_t)s * P1W); const v4u* vp = (const v4u*)(vb + (size_t)s * P1W);
            float z0 = 0.f, z1 = 0.f;
#pragma unroll
            for (int i = 0; i < 8; ++i) { const v4u k = kp[i]; z0 = dot2bf(k.x, q[4 * i], z0); z1 = dot2bf(k.y, q[4 * i + 1], z1); z0 = dot2bf(k.z, q[4 * i + 2], z0); z1 = dot2bf(k.w, q[4 * i + 3], z1); }
            const float z = (z0 + z1) * 0.125f;
            const float tt = 0.6931471805599453f * __builtin_amdgcn_logf(1.0f + fexp(-__builtin_fabsf(z)));
            const float lb = fminf(z, 0.f) - tt, l1m = fminf(-z, 0.f) - tt;
            const float a = fexp(lb + R); R += l1m;
#pragma unroll
            for (int i = 0; i < 8; ++i) { const v4u v = vp[i];
                o[8 * i] += a * bflo(v.x); o[8 * i + 1] += a * bfhi(v.x); o[8 * i + 2] += a * bflo(v.y); o[8 * i + 3] += a * bfhi(v.y);
                o[8 * i + 4] += a * bflo(v.z); o[8 * i + 5] += a * bfhi(v.z); o[8 * i + 6] += a * bflo(v.w); o[8 * i + 7] += a * bfhi(v.w); }
        }
        v4u* op = (v4u*)(Yb + row * 256 + h * 64);
#pragma unroll
        for (int i = 0; i < 8; ++i) op[i] = (v4u){pk2(o[8 * i], o[8 * i + 1]), pk2(o[8 * i + 2], o[8 * i + 3]), pk2(o[8 * i + 4], o[8 * i + 5]), pk2(o[8 * i + 6], o[8 * i + 7])};
    }
}

struct Soft { float mx, l; };
__device__ __forceinline__ float dotq(const LAS v4u* ql, const bf16* kp_) {
    const v4u* kp = (const v4u*)kp_; float z0 = 0.f, z1 = 0.f;
#pragma unroll
    for (int i = 0; i < 8; ++i) { const v4u k = kp[i]; const v4u q = ql[i]; z0 = dot2bf(k.x, q.x, z0); z1 = dot2bf(k.y, q.y, z1); z0 = dot2bf(k.z, q.z, z0); z1 = dot2bf(k.w, q.w, z1); }
    return (z0 + z1) * 0.125f;
}
__device__ __forceinline__ void axpy_row(float p, const bf16* vp_, float (&o)[64]) {
    const v4u* vp = (const v4u*)vp_;
#pragma unroll
    for (int i = 0; i < 8; ++i) { const v4u v = vp[i];
        o[8 * i] += p * bflo(v.x); o[8 * i + 1] += p * bfhi(v.x); o[8 * i + 2] += p * bflo(v.y); o[8 * i + 3] += p * bfhi(v.y);
        o[8 * i + 4] += p * bflo(v.z); o[8 * i + 5] += p * bfhi(v.z); o[8 * i + 6] += p * bflo(v.w); o[8 * i + 7] += p * bfhi(v.w); }
}
__device__ __forceinline__ void nsa_step(const LAS v4u* ql, const bf16* kp_, const bf16* vp_, Soft& S, float (&o)[64]) {
    const float s = dotq(ql, kp_);
    if (s > S.mx) { const float sc = fexp(S.mx - s); S.l *= sc;
#pragma unroll
        for (int d = 0; d < 64; ++d) o[d] *= sc;
        S.mx = s; }
    const float p = fexp(s - S.mx); S.l += p;
    asm volatile("" ::: "memory");
    axpy_row(p, vp_, o);
}
__device__ __forceinline__ void nsa_accum(bf16* yrow, bool first, float sc, const float (&o)[64]) {
    v4u* op = (v4u*)yrow;
#pragma unroll
    for (int i = 0; i < 8; ++i) { v4u old = (v4u){0u, 0u, 0u, 0u}; if (!first) old = op[i];
        op[i] = (v4u){pk2(bflo(old.x) + sc * o[8 * i], bfhi(old.x) + sc * o[8 * i + 1]), pk2(bflo(old.y) + sc * o[8 * i + 2], bfhi(old.y) + sc * o[8 * i + 3]),
                      pk2(bflo(old.z) + sc * o[8 * i + 4], bfhi(old.z) + sc * o[8 * i + 5]), pk2(bflo(old.w) + sc * o[8 * i + 6], bfhi(old.w) + sc * o[8 * i + 7])}; }
}
__device__ __forceinline__ void p_nsa(Frame& F) {
    const int gw = F.vcu * NWAVES + F.wave, NGW = F.G * NWAVES, lane = F.lane;
    const bf16* P1 = WSP(bf16, WS_P1); const bf16* KC = WSP(bf16, WS_KC); bf16* Yc = WSP(bf16, WS_Y) + (size_t)2 * MC * 256;
    LAS float* imp = (LAS float*)(F.lds + RING_OFF + F.wave * 4096);
    LAS v4u* ql = (LAS v4u*)(F.lds + RING_OFF + 32768 + F.wave * 9216 + lane * 144);
    const int qi = lane >> 2, h = lane & 3;
    for (int item = gw; item < BC * 256; item += NGW) { const int b = item >> 8, tg = item & 255;
        const int t = tg * 16 + qi; const size_t row = (size_t)b * SEQ + t; const bf16* prow = P1 + row * P1W;
        { const v4u* qp = (const v4u*)(prow + C_CQ + h * 64);
#pragma unroll
          for (int i = 0; i < 8; ++i) ql[i] = qp[i]; }
        const float g0 = bf1(prow[C_CG + h * 3]), g1 = bf1(prow[C_CG + h * 3 + 1]), g2 = bf1(prow[C_CG + h * 3 + 2]);
        bf16* yrow = Yc + row * 256 + h * 64;
        float o[64];
        for (int i = lane; i < 1024; i += 64) imp[i] = 0.f;
        const int nv = t >= 31 ? ((t - 31) >> 4) + 1 : 0; const int nvmax = (tg * 16 + 15 >= 31) ? ((tg * 16 + 15 - 31) >> 4) + 1 : 0;
        const bf16* kc = KC + (size_t)(0 * BC + b) * 256 * 64; const bf16* vc = KC + (size_t)(1 * BC + b) * 256 * 64;
        { float mx = -INFINITY, l = 0.f;
          for (int m = 0; m < nvmax; ++m) { const float s = dotq(ql, kc + m * 64); if (m < nv) { if (s > mx) { l *= fexp(mx - s); mx = s; } l += fexp(s - mx); } }
          const float rl = l > 0.f ? 1.0f / l : 0.f;
#pragma unroll
          for (int d = 0; d < 64; ++d) o[d] = 0.f;
          for (int m = 0; m < nvmax; ++m) { const float s = dotq(ql, kc + m * 64); const float p = (m < nv) ? fexp(s - mx) * rl : 0.f;
              asm volatile("" ::: "memory");
              axpy_row(p, vc + m * 64, o);
              float P = p + __builtin_bit_cast(float, bperm(lane ^ 1, __builtin_bit_cast(int, p))); P += __builtin_bit_cast(float, bperm(lane ^ 2, __builtin_bit_cast(int, P)));
              if (h == 0) { const int j0 = m >> 2; const bool edge = (m & 3) == 3; imp[qi * 64 + j0] += edge ? 0.5f * P : P; if (edge) imp[qi * 64 + j0 + 1] += 0.5f * P; } }
          nsa_accum(yrow, true, g0, o); }
        unsigned long long mask = 0ull;
        { const int cur = t >> 6, nvb = cur + 1;
          if (h == 0) {
              if (nvb <= 16) mask = (1ull << nvb) - 1ull;
              else { mask = 1ull | (1ull << cur);
                  for (int r = 0; r < 14; ++r) { int best = -1; float bv = -1.f;
                      for (int j = 1; j < cur; ++j) { const float v = imp[qi * 64 + j]; if (!((mask >> j) & 1ull) && v > bv) { bv = v; best = j; } }
                      mask |= 1ull << best; } } }
          const unsigned mlo = (unsigned)bperm(lane & ~3, (int)(unsigned)mask), mhi = (unsigned)bperm(lane & ~3, (int)(unsigned)(mask >> 32));
          mask = ((unsigned long long)mhi << 32) | mlo; }
        { Soft S{-INFINITY, 0.f};
#pragma unroll
          for (int d = 0; d < 64; ++d) o[d] = 0.f;
          const bf16* kb = P1 + (size_t)b * SEQ * P1W + C_KSLC; const bf16* vb = P1 + (size_t)b * SEQ * P1W + C_VSLC;
          unsigned long long mm = mask;
          while (mm) { const int j = __builtin_ctzll(mm); mm &= mm - 1ull;
              for (int kk = 0; kk < 64; ++kk) { const int sp = j * 64 + kk; if (sp > t) break; nsa_step(ql, kb + (size_t)sp * P1W, vb + (size_t)sp * P1W, S, o); } }
          nsa_accum(yrow, false, g1 / S.l, o); }
        { Soft S{-INFINITY, 0.f};
#pragma unroll
          for (int d = 0; d < 64; ++d) o[d] = 0.f;
          const bf16* kb = P1 + (size_t)b * SEQ * P1W + C_KWIN; const bf16* vb = P1 + (size_t)b * SEQ * P1W + C_VWIN;
          for (int i = 0; i < 512; ++i) { const int sp = t - 511 + i; if (sp >= 0) nsa_step(ql, kb + (size_t)sp * P1W, vb + (size_t)sp * P1W, S, o); }
          nsa_accum(yrow, false, g2 / S.l, o); }
    }
}

__device__ __forceinline__ int moe_table(Frame& F, int jmoe, int c, int r) {
    LAS int* tab = (LAS int*)(F.lds + TAB_OFF);
    __syncthreads();
    if (F.tid < 8) tab[176 + F.tid] = (int)__hip_atomic_load(F.ctl + CW_CNT + jmoe * 32 + (c * 2 + r) * 8 + F.tid, __ATOMIC_RELAXED, __HIP_MEMORY_SCOPE_AGENT);
    __syncthreads();
    if (F.tid == 0) { int base = 0, T = 0;
        for (int e = 0; e < 8; ++e) { const int cnt = tab[176 + e];
            const int nt = (cnt + 255) >> 8; tab[160 + e] = base; for (int i = 0; i < nt && T + i < 160; ++i) tab[T + i] = e; T += nt; base += nt * 256; }
        tab[168] = T < 136 ? T : 136; }
    __syncthreads();
    return tab[168];
}
__device__ __forceinline__ void p_gather(Frame& F, int jmoe, int c, int r, int nbusy = 0) {
    if (F.bx < nbusy) return;
    moe_table(F, jmoe, c, r);
    LAS int* tab = (LAS int*)(F.lds + TAB_OFF); LAS int* cntw = tab + 256; LAS int* basew = tab + 320;
    const int lane = F.lane, wave = F.wave;
    const v4i* route = WSP(v4i, WS_ROUTE); int* tokmap = WSP(int, WS_TOKMAP) + (c * 2 + r) * SLOTS; float* wslot = WSP(float, WS_WSLOT) + (c * 2 + r) * SLOTS;
    const bf16* HN = WSP(bf16, WS_HN); bf16* XG = WSP(bf16, WS_XG);
    unsigned* cur = F.ctl + CW_CUR + jmoe * 32 + (c * 2 + r) * 8;
    for (int ch = F.bx - nbusy; ch < MC / 128; ch += F.G - nbusy) {
        const int m = c * MC + ch * 128 + wave * 16 + (lane & 15); const v4i rt = route[m];
        const int e = lane < 16 ? (r ? rt.y : rt.x) : -1; const float w = __builtin_bit_cast(float, r ? rt.w : rt.z);
        unsigned long long bal[8]; int mycnt = 0;
#pragma unroll
        for (int ee = 0; ee < 8; ++ee) { bal[ee] = __builtin_amdgcn_ballot_w64(e == ee); if (lane == ee) mycnt = __builtin_popcountll(bal[ee]); }
        __syncthreads();
        if (lane < 8) cntw[wave * 8 + lane] = mycnt;
        __syncthreads();
        if (wave == 0 && lane < 8) { int tot = 0;
#pragma unroll
            for (int w8 = 0; w8 < 8; ++w8) tot += cntw[w8 * 8 + lane];
            int base = tot > 0 ? (int)atomicAdd(cur + lane, (unsigned)tot) : 0;
#pragma unroll
            for (int w8 = 0; w8 < 8; ++w8) { basew[w8 * 8 + lane] = base; base += cntw[w8 * 8 + lane]; } }
        __syncthreads();
        int pos = 0;
#pragma unroll
        for (int ee = 0; ee < 8; ++ee) if (e == ee) pos = basew[wave * 8 + ee] + __builtin_popcountll(bal[ee] & ((1ull << lane) - 1ull));
        int slot = 0;
        if (lane < 16) { slot = tab[160 + e] + pos; tokmap[slot] = m; wslot[slot] = w; }
#pragma unroll
        for (int i0 = 0; i0 < 16; i0 += 4) { v4u x[8];
#pragma unroll
            for (int i = 0; i < 4; ++i) { const int mi = __builtin_amdgcn_readlane(m, i0 + i); const v4u* src = (const v4u*)(HN + (size_t)mi * DM); x[2 * i] = src[lane]; x[2 * i + 1] = src[64 + lane]; }
#pragma unroll
            for (int i = 0; i < 4; ++i) { const int si = __builtin_amdgcn_readlane(slot, i0 + i); v4u* dst = (v4u*)(XG + (size_t)si * DM); dst[lane] = x[2 * i]; dst[64 + lane] = x[2 * i + 1]; } }
    }
}

typedef float f32x16 __attribute__((ext_vector_type(16)));
typedef short bf16x8v __attribute__((ext_vector_type(8)));
typedef float f32x2v __attribute__((ext_vector_type(2)));
constexpr int NSA_K = 0, NSA_V = 8192, NSA_BUF = 17408, NSA_STAGE = 2 * NSA_BUF, NSA_IMP = 69632, NSA_CARRY = 86016, NSA_SEL = 103424, NSA_WSF = 103936;
constexpr float NSA_C2 = 0.125f * 1.4426950408889634f;
__device__ __forceinline__ unsigned cvtpk(float lo, float hi) { f32x2v v = {lo, hi}; bf16x2_t b = __builtin_convertvector(v, bf16x2_t); return __builtin_bit_cast(unsigned, b); }
__device__ __forceinline__ float partner32(float v, int lane) { return __builtin_bit_cast(float, __builtin_amdgcn_ds_bpermute((lane ^ 32) << 2, __builtin_bit_cast(int, v))); }
__device__ __forceinline__ void nsa_load(v4u& kx, v4u& vx, const bf16* Kg, int kp, const bf16* Vg, int vp, int tid) {
    kx = *(const v4u*)(Kg + (size_t)(tid & 63) * kp + (tid >> 6) * 8); vx = *(const v4u*)(Vg + (size_t)(tid >> 3) * vp + (tid & 7) * 8);
}
__device__ __forceinline__ void nsa_store(LAS unsigned char* lds, const v4u& kx, const v4u& vx, int tid) {
    *(LAS v4u*)(lds + NSA_K + (tid >> 6) * 1024 + (tid & 63) * 16) = kx; *(LAS v4u*)(lds + NSA_V + (tid >> 3) * 144 + (tid & 7) * 16) = vx;
}
__device__ __forceinline__ void nsa_qk(const LAS unsigned char* lds, const bf16x8v (&qr)[4], f32x16& p0, f32x16& p1, int r32, int hi) {
#pragma unroll
    for (int i = 0; i < 16; ++i) { p0[i] = 0.f; p1[i] = 0.f; }
#pragma unroll
    for (int d0 = 0; d0 < 4; ++d0) {
        const bf16x8v k0 = *(const LAS bf16x8v*)(lds + NSA_K + (2 * d0 + hi) * 1024 + r32 * 16);
        const bf16x8v k1 = *(const LAS bf16x8v*)(lds + NSA_K + (2 * d0 + hi) * 1024 + 512 + r32 * 16);
        p0 = __builtin_amdgcn_mfma_f32_32x32x16_bf16(k0, qr[d0], p0, 0, 0, 0);
        p1 = __builtin_amdgcn_mfma_f32_32x32x16_bf16(k1, qr[d0], p1, 0, 0, 0);
    }
#pragma unroll
    for (int i = 0; i < 16; ++i) { p0[i] *= NSA_C2; p1[i] *= NSA_C2; }
}
__device__ __forceinline__ void nsa_mask(f32x16& p0, f32x16& p1, int hi, int hiL, int loL, bool rowok, bool full  ) {
    if (full) {
#pragma unroll
        for (int i = 0; i < 16; ++i) { p0[i] = rowok ? p0[i] : -INFINITY; p1[i] = rowok ? p1[i] : -INFINITY; }
        return; }
#pragma unroll
    for (int i = 0; i < 16; ++i) { const int kk = (i & 3) + 8 * (i >> 2) + 4 * hi;
        if (!(rowok && kk <= hiL && kk > loL)) p0[i] = -INFINITY;
        if (!(rowok && kk + 32 <= hiL && kk + 32 > loL)) p1[i] = -INFINITY; }
}
__device__ __forceinline__ float nsa_max32(const f32x16& p0, const f32x16& p1) {
    float a = fmaxf(fmaxf(p0[0], p0[1]), p1[0]), b = fmaxf(fmaxf(p0[2], p0[3]), p1[1]); a = fmaxf(fmaxf(a, p1[2]), p1[3]);
#pragma unroll
    for (int i = 4; i < 16; i += 4) { a = fmaxf(fmaxf(a, p0[i]), p0[i + 1]); b = fmaxf(fmaxf(b, p0[i + 2]), p0[i + 3]); a = fmaxf(fmaxf(a, p1[i]), p1[i + 1]); b = fmaxf(fmaxf(b, p1[i + 2]), p1[i + 3]); }
    return fmaxf(a, b);
}
__device__ __forceinline__ void nsa_pv(const LAS unsigned char* lds, const f32x16& p0, const f32x16& p1, f32x16 (&o)[2], int r32, int hi) {
    bf16x8v pa[4];
#pragma unroll
    for (int s = 0; s < 2; ++s) {
        const v4u a = (v4u){cvtpk(p0[8 * s], p0[8 * s + 1]), cvtpk(p0[8 * s + 2], p0[8 * s + 3]), cvtpk(p0[8 * s + 4], p0[8 * s + 5]), cvtpk(p0[8 * s + 6], p0[8 * s + 7])};
        const v4u b = (v4u){cvtpk(p1[8 * s], p1[8 * s + 1]), cvtpk(p1[8 * s + 2], p1[8 * s + 3]), cvtpk(p1[8 * s + 4], p1[8 * s + 5]), cvtpk(p1[8 * s + 6], p1[8 * s + 7])};
        pa[s] = __builtin_bit_cast(bf16x8v, a); pa[2 + s] = __builtin_bit_cast(bf16x8v, b); }
#pragma unroll
    for (int db = 0; db < 2; ++db) { const LAS unsigned char* vrow = lds + NSA_V + (32 * db + r32) * 144;
#pragma unroll
        for (int ks = 0; ks < 4; ++ks) {
            const int kb = (ks >> 1) * 32 + (ks & 1) * 16 + 4 * hi;
            const v2u lo = *(const LAS v2u*)(vrow + kb * 2), hh = *(const LAS v2u*)(vrow + (kb + 8) * 2);
            const v4u vv = (v4u){lo.x, lo.y, hh.x, hh.y};
            o[db] = __builtin_amdgcn_mfma_f32_32x32x16_bf16(pa[ks], __builtin_bit_cast(bf16x8v, vv), o[db], 0, 0, 0); } }
}
__device__ __forceinline__ void nsa_rowscale(f32x16 (&o)[2], LAS float* wsf, float f, int r32, int hi) {
    if (hi == 0) wsf[r32] = f;
#pragma unroll
    for (int g = 0; g < 4; ++g) { const f32x4 w = *(const LAS f32x4*)(wsf + 8 * g + 4 * hi);
#pragma unroll
        for (int e = 0; e < 4; ++e) { o[0][4 * g + e] *= w[e]; o[1][4 * g + e] *= w[e]; } }
}
__device__ __forceinline__ void nsa_rowaccum(bf16* dst, bool first, const f32x16 (&o)[2], LAS float* wsf, float f, int r32, int hi) {
    if (hi == 0) wsf[r32] = f;
    bf16 old[32];
#pragma unroll
    for (int i = 0; i < 16; ++i) { const bf16* p = dst + (i >> 2) * 512 + (i & 3) * 64; old[2 * i] = first ? (bf16)0 : p[0]; old[2 * i + 1] = first ? (bf16)0 : p[32]; }
#pragma unroll
    for (int g = 0; g < 4; ++g) { const f32x4 w = *(const LAS f32x4*)(wsf + 8 * g + 4 * hi);
#pragma unroll
        for (int e = 0; e < 4; ++e) { bf16* p = dst + g * 512 + e * 64; const int i = 4 * g + e;
            p[0] = (bf16)f2bf(o[0][i] * w[e] + bf1(old[2 * i])); p[32] = (bf16)f2bf(o[1][i] * w[e] + bf1(old[2 * i + 1])); } }
}
__device__ __forceinline__ void nsa_softmax_pv(const LAS unsigned char* lds, f32x16& p0, f32x16& p1, float& m, float& l, f32x16 (&o)[2], LAS float* wsf, int lane, int r32, int hi) {
    float mt = nsa_max32(p0, p1); mt = fmaxf(mt, partner32(mt, lane));
    const float mn = fmaxf(m, mt);
    if (__builtin_amdgcn_ballot_w64(mn > m) != 0ull) { const float f = __builtin_amdgcn_exp2f(m - mn); l *= f; nsa_rowscale(o, wsf, f, r32, hi); m = mn; }
    float s = 0.f;
#pragma unroll
    for (int i = 0; i < 16; ++i) { p0[i] = __builtin_amdgcn_exp2f(p0[i] - m); p1[i] = __builtin_amdgcn_exp2f(p1[i] - m); s += p0[i] + p1[i]; }
    l += s;
    nsa_pv(lds, p0, p1, o, r32, hi);
}
__device__ __forceinline__ void p_nsa2(Frame& F) {
    const int tid = F.tid, lane = F.lane, wave = F.wave, r32 = lane & 31, hi = lane >> 5;
    LAS unsigned char* lds = F.lds + RING_OFF;
    LAS float* imp = (LAS float*)(lds + NSA_IMP); LAS float* carry = (LAS float*)(lds + NSA_CARRY);
    LAS unsigned long long* selm = (LAS unsigned long long*)(lds + NSA_SEL); LAS float* wsf = (LAS float*)(lds + NSA_WSF) + wave * 32;
    const bf16* P1 = WSP(bf16, WS_P1); const bf16* KC = WSP(bf16, WS_KC); const bf16* KCT = WSP(bf16, WS_KCT); const bf16* VT = WSP(bf16, WS_VT);
    bf16* Yc = WSP(bf16, WS_Y) + (size_t)2 * MC * 256;
    const int ql = r32 >> 2, h = r32 & 3, tq = 8 * wave + ql;
    int par = 0;
    for (int it = 0; it < 2; ++it) {
        for (int pair = F.vcu; pair < BC * 32; pair += F.G) {
            const int b = pair >> 5, sx = pair & 31, qb = it ? 63 - sx : sx;
            const int t = qb * 64 + tq; const size_t row = (size_t)b * SEQ + t; const bf16* prow = P1 + row * P1W;
            bf16x8v qr[4];
#pragma unroll
            for (int d0 = 0; d0 < 4; ++d0) qr[d0] = *(const bf16x8v*)(prow + C_CQ + h * 64 + d0 * 16 + hi * 8);
            const float g0 = bf1(prow[C_CG + h * 3]), g1 = bf1(prow[C_CG + h * 3 + 1]), g2 = bf1(prow[C_CG + h * 3 + 2]);
            f32x16 o[2], p0, p1;
            bf16* ydst = Yc + ((size_t)b * SEQ + qb * 64 + 8 * wave + hi) * 256 + r32;
            __syncthreads();
            for (int i = tid; i < 64 * 64; i += 512) imp[i] = 0.f;
            for (int i = tid; i < 64 * 68; i += 512) carry[i] = 0.f;
            const int nct = (4 * qb + 3 + 63) >> 6;
            const int mlim = t >= 31 ? ((t - 31) >> 4) : -1;
            const bf16* kcb = KC + (size_t)b * 256 * 64; const bf16* vcb = KCT + (size_t)b * 64 * 256;
            float m = -1e30f, l = 0.f;
            v4u kx, vx;
            nsa_load(kx, vx, kcb, 64, vcb, 256, tid);
            for (int ti = 0; ti < nct; ++ti) {
                LAS unsigned char* tb = lds + par * NSA_STAGE; par ^= 1;
                nsa_store(tb, kx, vx, tid); __syncthreads();
                { const int tn = ti + 1 < nct ? ti + 1 : 0; nsa_load(kx, vx, kcb + (size_t)tn * 64 * 64, 64, vcb + tn * 64, 256, tid); }
                nsa_qk(tb, qr, p0, p1, r32, hi); nsa_mask(p0, p1, hi, mlim - 64 * ti, -1, true, false);
                float mt = nsa_max32(p0, p1); mt = fmaxf(mt, partner32(mt, lane));
                const float mn = fmaxf(m, mt); l *= __builtin_amdgcn_exp2f(m - mn); m = mn;
                float s = 0.f;
#pragma unroll
                for (int i = 0; i < 16; ++i) s += __builtin_amdgcn_exp2f(p0[i] - m) + __builtin_amdgcn_exp2f(p1[i] - m);
                l += s; }
            { const float lt = l + partner32(l, lane); const float rl = lt > 0.f ? 1.0f / lt : 0.f;
#pragma unroll
              for (int i = 0; i < 16; ++i) { o[0][i] = 0.f; o[1][i] = 0.f; }
              for (int ti = 0; ti < nct; ++ti) {
                  LAS unsigned char* tb = lds + par * NSA_STAGE; par ^= 1;
                  nsa_store(tb, kx, vx, tid); __syncthreads();
                  if (ti + 1 < nct) nsa_load(kx, vx, kcb + (size_t)(ti + 1) * 64 * 64, 64, vcb + (ti + 1) * 64, 256, tid);
                  nsa_qk(tb, qr, p0, p1, r32, hi); nsa_mask(p0, p1, hi, mlim - 64 * ti, -1, true, false);
#pragma unroll
                  for (int i = 0; i < 16; ++i) { p0[i] = __builtin_amdgcn_exp2f(p0[i] - m) * rl; p1[i] = __builtin_amdgcn_exp2f(p1[i] - m) * rl; }
#pragma unroll
                  for (int kt = 0; kt < 2; ++kt)
#pragma unroll
                      for (int g = 0; g < 4; ++g) { const f32x16& pp = kt ? p1 : p0;
                          float A = pp[4 * g] + pp[4 * g + 1] + pp[4 * g + 2] + 0.5f * pp[4 * g + 3], B = 0.5f * pp[4 * g + 3];
                          A += __builtin_bit_cast(float, bperm(lane ^ 1, __builtin_bit_cast(int, A))); A += __builtin_bit_cast(float, bperm(lane ^ 2, __builtin_bit_cast(int, A)));
                          B += __builtin_bit_cast(float, bperm(lane ^ 1, __builtin_bit_cast(int, B))); B += __builtin_bit_cast(float, bperm(lane ^ 2, __builtin_bit_cast(int, B)));
                          if (h == 0) { const int j = 16 * ti + 8 * kt + 2 * g + hi; imp[tq * 64 + j] = A; carry[tq * 68 + j + 1] = B; } }
                  nsa_pv(tb, p0, p1, o, r32, hi); }
              nsa_rowaccum(ydst, true, o, wsf, g0, r32, hi); }
            __syncthreads();
            { const int q = tid >> 3, sub = tid & 7; unsigned long long mask;
              if (qb + 1 <= 16) mask = (1ull << (qb + 1)) - 1ull;
              else { mask = 1ull | (1ull << qb);
                  unsigned long long key[8];
#pragma unroll
                  for (int i = 0; i < 8; ++i) { const int j = sub * 8 + i; const float v = imp[q * 64 + j] + carry[q * 68 + j];
                      key[i] = (j >= 1 && j < qb) ? (((unsigned long long)__builtin_bit_cast(unsigned, v) << 32) | (unsigned)(63 - j)) : 0ull; }
                  for (int r = 0; r < 14; ++r) { unsigned long long best = key[0];
#pragma unroll
                      for (int i = 1; i < 8; ++i) best = key[i] > best ? key[i] : best;
#pragma unroll
                      for (int x = 1; x < 8; x <<= 1) { const unsigned lo = (unsigned)bperm(lane ^ x, (int)(unsigned)best), hh = (unsigned)bperm(lane ^ x, (int)(unsigned)(best >> 32));
                          const unsigned long long other = ((unsigned long long)hh << 32) | lo; best = other > best ? other : best; }
                      const int jb = 63 - (int)(best & 63ull); mask |= 1ull << jb;
#pragma unroll
                      for (int i = 0; i < 8; ++i) if (sub * 8 + i == jb) key[i] = 0ull; } }
              if (sub == 0) selm[q] = mask; }
            __syncthreads();
            const unsigned long long mysel = selm[tq];
            { const bf16* kb = P1 + (size_t)b * SEQ * P1W + C_KSLC; const bf16* vb = VT + (size_t)(0 * BC + b) * 64 * SEQ;
              m = -1e30f; l = 0.f;
#pragma unroll
              for (int i = 0; i < 16; ++i) { o[0][i] = 0.f; o[1][i] = 0.f; }
              v4u kx2, vx2;
              nsa_load(kx, vx, kb, P1W, vb, SEQ, tid); if (qb >= 1) nsa_load(kx2, vx2, kb + (size_t)64 * P1W, P1W, vb + 64, SEQ, tid);
              for (int j = 0; j <= qb; j += 2) {
                  const bool two = j + 1 <= qb;
                  LAS unsigned char* tb = lds + par * NSA_STAGE; par ^= 1;
                  nsa_store(tb, kx, vx, tid); if (two) nsa_store(tb + NSA_BUF, kx2, vx2, tid);
                  __syncthreads();
                  if (j + 2 <= qb) nsa_load(kx, vx, kb + (size_t)(j + 2) * 64 * P1W, P1W, vb + (j + 2) * 64, SEQ, tid);
                  if (j + 3 <= qb) nsa_load(kx2, vx2, kb + (size_t)(j + 3) * 64 * P1W, P1W, vb + (j + 3) * 64, SEQ, tid);
                  { const bool rowsel = ((mysel >> j) & 1ull) != 0ull;
                    if (__builtin_amdgcn_ballot_w64(rowsel) != 0ull) {
                        nsa_qk(tb, qr, p0, p1, r32, hi); nsa_mask(p0, p1, hi, j == qb ? tq : 63, -1, rowsel, j < qb);
                        nsa_softmax_pv(tb, p0, p1, m, l, o, wsf, lane, r32, hi); } }
                  if (two) { const bool rowsel = ((mysel >> (j + 1)) & 1ull) != 0ull;
                    if (__builtin_amdgcn_ballot_w64(rowsel) != 0ull) {
                        nsa_qk(tb + NSA_BUF, qr, p0, p1, r32, hi); nsa_mask(p0, p1, hi, j + 1 == qb ? tq : 63, -1, rowsel, j + 1 < qb);
                        nsa_softmax_pv(tb + NSA_BUF, p0, p1, m, l, o, wsf, lane, r32, hi); } } }
              const float lt = l + partner32(l, lane);
              nsa_rowaccum(ydst, false, o, wsf, lt > 0.f ? g1 / lt : 0.f, r32, hi); }
            { const bf16* kb = P1 + (size_t)b * SEQ * P1W + C_KWIN; const bf16* vb = VT + (size_t)(1 * BC + b) * 64 * SEQ;
              m = -1e30f; l = 0.f;
#pragma unroll
              for (int i = 0; i < 16; ++i) { o[0][i] = 0.f; o[1][i] = 0.f; }
              const int j0 = qb >= 8 ? qb - 8 : 0;
              nsa_load(kx, vx, kb + (size_t)j0 * 64 * P1W, P1W, vb + j0 * 64, SEQ, tid);
              for (int j = j0; j <= qb; ++j) {
                  LAS unsigned char* tb = lds + par * NSA_STAGE; par ^= 1;
                  nsa_store(tb, kx, vx, tid); __syncthreads();
                  if (j < qb) nsa_load(kx, vx, kb + (size_t)(j + 1) * 64 * P1W, P1W, vb + (j + 1) * 64, SEQ, tid);
                  nsa_qk(tb, qr, p0, p1, r32, hi); nsa_mask(p0, p1, hi, j == qb ? tq : 63, j == qb - 8 ? tq : -1, true, j < qb && j != qb - 8);
                  nsa_softmax_pv(tb, p0, p1, m, l, o, wsf, lane, r32, hi); }
              const float lt = l + partner32(l, lane);
              nsa_rowaccum(ydst, false, o, wsf, lt > 0.f ? g2 / lt : 0.f, r32, hi); }
        }
    }
    __syncthreads();
}

constexpr int SB_HEAD_LDS = 17408;
constexpr int SB_FLAG = 4 * SB_HEAD_LDS;
constexpr float SB_LOG2E = 1.4426950408889634f, SB_STOP = -100.0f * 1.4426950408889634f;
__device__ __forceinline__ void p_stick2(Frame& F, int nbusy) {
    const int tid = F.tid, lane = F.lane, wave = F.wave, r32 = lane & 31, hi = lane >> 5, h = wave & 3, qh = wave >> 2;
    LAS unsigned char* lds = F.lds + RING_OFF; LAS unsigned char* hl = lds + h * SB_HEAD_LDS; LAS int* flag = (LAS int*)(lds + SB_FLAG);
    const bf16* P1 = WSP(bf16, WS_P1); const bf16* VT = WSP(bf16, WS_VT) + (size_t)2 * BC * 64 * SEQ;
    bf16* Yb = WSP(bf16, WS_Y) + (size_t)MC * 256;
    const int tq = 32 * qh + r32;
    if (F.bx >= nbusy)
        for (int item = F.bx - nbusy; item < BC * 64; item += F.G - nbusy) {
            const int b = item >> 6, qb = item & 63;
            const size_t row = (size_t)b * SEQ + qb * 64 + tq;
            bf16x8v qr[4];
#pragma unroll
            for (int d0 = 0; d0 < 4; ++d0) qr[d0] = *(const bf16x8v*)(P1 + row * P1W + C_SBQ + h * 64 + d0 * 16 + hi * 8);
            f32x16 o[2], p0, p1;
#pragma unroll
            for (int i = 0; i < 16; ++i) { o[0][i] = 0.f; o[1][i] = 0.f; }
            float R = 0.f;
            const int skey = tid & 63, sc = tid >> 6, sd = tid >> 3, skc = tid & 7;
            v4u kx[4], vx[4];
#define SB_LOAD(jj) do { const bf16* kg_ = P1 + ((size_t)b * SEQ + (jj) * 64 + skey) * P1W + C_SBK + sc * 8; \
                _Pragma("unroll") for (int hh = 0; hh < 4; ++hh) { kx[hh] = *(const v4u*)(kg_ + hh * 64); vx[hh] = *(const v4u*)(VT + ((size_t)(hh * BC + b) * 64 + sd) * SEQ + (jj) * 64 + skc * 8); } } while (0)
            SB_LOAD(qb);
            for (int j = qb; j >= 0; --j) {
                __syncthreads();
                if (j < qb) { int live = 0;
#pragma unroll
                    for (int w = 0; w < 8; ++w) live |= flag[w];
                    if (!live) break; }
#pragma unroll
                for (int hh = 0; hh < 4; ++hh) { *(LAS v4u*)(lds + hh * SB_HEAD_LDS + sc * 1024 + skey * 16) = kx[hh]; *(LAS v4u*)(lds + hh * SB_HEAD_LDS + NSA_V + sd * 144 + skc * 16) = vx[hh]; }
                __syncthreads();
                if (j > 0) SB_LOAD(j - 1);
                nsa_qk(hl, qr, p0, p1, r32, hi);
                const int lim = (j == qb) ? tq : 64;
                float Town[8], Tp[8];
#pragma unroll
                for (int kt = 0; kt < 2; ++kt) { f32x16& pp = kt ? p1 : p0;
#pragma unroll
                    for (int g = 0; g < 4; ++g) { float L[4];
#pragma unroll
                        for (int e = 0; e < 4; ++e) { const int kk = 32 * kt + 8 * g + 4 * hi + e; const float z = pp[4 * g + e];
                            const float tt = __builtin_amdgcn_logf(1.0f + __builtin_amdgcn_exp2f(-__builtin_fabsf(z)));
                            const float lb = fminf(z, 0.f) - tt; const bool ok = kk < lim;
                            L[e] = ok ? lb - z : 0.f; pp[4 * g + e] = ok ? lb : -INFINITY; }
                        const float E2 = L[3], E1 = E2 + L[2], E0 = E1 + L[1];
                        pp[4 * g + 2] += E2; pp[4 * g + 1] += E1; pp[4 * g] += E0;
                        Town[4 * kt + g] = E0 + L[0]; } }
#pragma unroll
                for (int k = 0; k < 8; ++k) Tp[k] = partner32(Town[k], lane);
                float suf = R;
#pragma unroll
                for (int k = 7; k >= 0; --k) { const float add = suf + (hi == 0 ? Tp[k] : 0.f); f32x16& pp = (k >> 2) ? p1 : p0; const int g = k & 3;
#pragma unroll
                    for (int e = 0; e < 4; ++e) pp[4 * g + e] = __builtin_amdgcn_exp2f(pp[4 * g + e] + add);
                    suf += Town[k] + Tp[k]; }
                R = suf;
                nsa_pv(hl, p0, p1, o, r32, hi);
                const bool alive = R >= SB_STOP;
                const unsigned long long bal = __builtin_amdgcn_ballot_w64(alive);
                if (lane == 0) flag[wave] = bal != 0ull ? 1 : 0;
            }
            { bf16* dst = Yb + ((size_t)b * SEQ + qb * 64 + 32 * qh + 4 * hi) * 256 + h * 64 + r32;
#pragma unroll
              for (int i = 0; i < 16; ++i) { dst[((i & 3) + 8 * (i >> 2)) * 256] = (bf16)f2bf(o[0][i]); dst[((i & 3) + 8 * (i >> 2)) * 256 + 32] = (bf16)f2bf(o[1][i]); } }
        }
#undef SB_LOAD
    __syncthreads();
}

__device__ __forceinline__ void p_sgu2(Frame& F, int layer) {
    LAS unsigned char* vnT = F.lds + RING_OFF;
    const bf16* P1 = WSP(bf16, WS_P1); bf16* Ya = WSP(bf16, WS_Y);
    const float* gain = F.in[3] + (size_t)layer * 256; const float* sw = F.in[4] + (size_t)layer * 4 * 128 * 128; const float* sb = F.in[5] + (size_t)layer * 4 * 128;
    const int lane = F.lane, wave = F.wave, r32 = lane & 31, hi = lane >> 5, g = wave & 3, db = wave >> 2;
    for (int item = F.vcu; item < MC / 128; item += F.G) {
        const size_t r0 = (size_t)item * 128;
        __syncthreads();
        { const f32x4 gg = ((const f32x4*)gain)[lane];
          for (int rr = 0; rr < 16; rr += 2) { const int r = wave * 16 + rr;
              const v2u ra = *(const v2u*)(P1 + (r0 + r) * P1W + C_V + 4 * lane), rb = *(const v2u*)(P1 + (r0 + r + 1) * P1W + C_V + 4 * lane);
              const float a0 = bflo(ra.x), a1 = bfhi(ra.x), a2 = bflo(ra.y), a3 = bfhi(ra.y), b0 = bflo(rb.x), b1 = bfhi(rb.x), b2 = bflo(rb.y), b3 = bfhi(rb.y);
              const float sa = 1.0f / sqrtf(wave_sum((a0 * a0 + a1 * a1) + (a2 * a2 + a3 * a3), lane) * (1.f / 256.f) + EPS);
              const float sb_ = 1.0f / sqrtf(wave_sum((b0 * b0 + b1 * b1) + (b2 * b2 + b3 * b3), lane) * (1.f / 256.f) + EPS);
              LAS unsigned* q = (LAS unsigned*)(vnT + (4 * lane) * 272 + r * 2);
              q[0] = pk2(a0 * sa * gg.x, b0 * sb_ * gg.x); q[68] = pk2(a1 * sa * gg.y, b1 * sb_ * gg.y); q[136] = pk2(a2 * sa * gg.z, b2 * sb_ * gg.z); q[204] = pk2(a3 * sa * gg.w, b3 * sb_ * gg.w); } }
        __syncthreads();
        const int ch = g * 64 + db * 32 + r32;
        for (int tb = 0; tb < 4; ++tb) {
            f32x16 acc;
#pragma unroll
            for (int i = 0; i < 16; ++i) acc[i] = 0.f;
            const int t = 32 * tb + r32; const float* wrow = sw + ((size_t)g * 128 + t) * 128;
            f32x4 wq[8][2];
#pragma unroll
            for (int ks = 0; ks < 8; ++ks) if (ks < 2 * tb + 2) { wq[ks][0] = *(const f32x4*)(wrow + 16 * ks + 8 * hi); wq[ks][1] = *(const f32x4*)(wrow + 16 * ks + 8 * hi + 4); }
#pragma unroll
            for (int ks = 0; ks < 8; ++ks) if (ks < 2 * tb + 2) {
                const int s0 = 16 * ks + 8 * hi;
                const f32x4 w0 = wq[ks][0], w1 = wq[ks][1];
                const v4u a = (v4u){pk2(s0 <= t ? w0.x : 0.f, s0 + 1 <= t ? w0.y : 0.f), pk2(s0 + 2 <= t ? w0.z : 0.f, s0 + 3 <= t ? w0.w : 0.f),
                                    pk2(s0 + 4 <= t ? w1.x : 0.f, s0 + 5 <= t ? w1.y : 0.f), pk2(s0 + 6 <= t ? w1.z : 0.f, s0 + 7 <= t ? w1.w : 0.f)};
                const bf16x8v bfr = *(const LAS bf16x8v*)(vnT + ch * 272 + s0 * 2);
                acc = __builtin_amdgcn_mfma_f32_32x32x16_bf16(__builtin_bit_cast(bf16x8v, a), bfr, acc, 0, 0, 0); }
            float uu[16], bb[16];
#pragma unroll
            for (int i = 0; i < 16; ++i) { const int tt = 32 * tb + (i & 3) + 8 * (i >> 2) + 4 * hi; uu[i] = bf1(P1[(r0 + tt) * P1W + C_U + ch]); bb[i] = sb[g * 128 + tt]; }
#pragma unroll
            for (int i = 0; i < 16; ++i) { const int tt = 32 * tb + (i & 3) + 8 * (i >> 2) + 4 * hi;
                Ya[(r0 + tt) * 256 + ch] = (bf16)f2bf(uu[i] * (acc[i] + bb[i])); }
        }
    }
    __syncthreads();
}

struct Args { const float* in[20]; float* out; unsigned char* ws; int lo, hi, li, rep; };
#ifndef TILED_FFN1
#define TILED_FFN1 0
#endif
#ifndef PG8_ALIGN_EPI
#define PG8_ALIGN_EPI true
#endif
#ifndef PG8_SP2
#define PG8_SP2 true
#endif
#ifndef WGM_PROJ
#define WGM_PROJ PG8_WGM
#endif
#ifndef WGM_FFN1
#define WGM_FFN1 PG8_WGM
#endif
#ifndef WGM_FFN2
#define WGM_FFN2 PG8_WGM
#endif
#ifndef WGM_MOE1
#define WGM_MOE1 PG8_WGM
#endif
#ifndef WGM_MOE2
#define WGM_MOE2 PG8_WGM
#endif
#ifndef FFN_CHUNKS
#define FFN_CHUNKS 2
#endif
#ifndef REP_GEMM
#define REP_GEMM 1
#endif
#ifndef REP_STICK
#define REP_STICK 1
#endif
#ifndef REP_NSA
#define REP_NSA 1
#endif
#ifndef REP_SGU
#define REP_SGU 1
#endif
#ifndef REP_NORM
#define REP_NORM 1
#endif
template <class Epi, class Sched> __device__ __forceinline__ void run_gemm(Frame& F, const bf16* A, const bf16* Bt, int M, int N, int K, const Sched& S, Epi E, bool rotate = true, int tiled = 0) {
    const int nt_ = K / 64;
#ifdef PG8_KROT
    const int rot_ = rotate ? 2 * (((F.bx & 7) * (nt_ / 2)) / 8) : 0;
#else
    const int rot_ = 0;
#endif
    pg8::Gemm g{A, Bt, M, N, K + F.zs, F.tid, rot_ + F.zs, tiled + F.zs};
    if (F.rep) E.set_scale0();
    pg8::gemm_phase<Epi, Sched, PG8_ALIGN_EPI, PG8_SP2>(F.lds + RING_OFF, g, S, E);
}
__global__ void __launch_bounds__(NWAVES * 64, 2) mk_fwd(Args args) {
    extern __shared__ __attribute__((aligned(16))) unsigned char lds[];
    Frame F0;
    F0.lds = (LAS unsigned char*)lds;
    F0.tid = threadIdx.x; F0.lane = F0.tid & 63; F0.wave = __builtin_amdgcn_readfirstlane(F0.tid >> 6);
    F0.G = gridDim.x; F0.bx = blockIdx.x; F0.vcu = (F0.G % 8 == 0) ? (F0.bx % 8) * (F0.G / 8) + F0.bx / 8 : F0.bx; F0.zv = 0; F0.zs = 0;
    F0.rep = args.rep; F0.ws = args.ws; F0.ctl = (unsigned*)(args.ws + WS_CTL); F0.in = args.in; F0.out = args.out;
    for (int u = F0.tid; u < (LDS_BYTES - LDSCTL_OFF) / 4; u += NWAVES * 64) ((LAS unsigned*)(F0.lds + LDSCTL_OFF))[u] = 0u;
    __syncthreads();
    const int lo = args.lo, hi = args.hi;
    XcdBarrier bar; bar.bar = F0.ctl + CW_BAR + args.li * XCD_BAR_WORDS; bar.x = 0; bar.st = nullptr; bar.w = 0; bar.z = 0;
    if (hi - lo > 1) bar = xcd_barrier_post(F0.ctl + CW_BAR + args.li * XCD_BAR_WORDS, (volatile LAS unsigned*)(F0.lds + MISC_OFF) + 8);
    int step = 0;
#define STEP_BEGIN if (step >= lo && step < hi) { Frame F = F0; { int zv_, zs_; asm volatile("v_mov_b32 %0, 0" : "=v"(zv_)); asm volatile("s_mov_b32 %0, 0" : "=s"(zs_)); \
        F.zv = zv_; F.zs = zs_; F.lane = (int)__builtin_amdgcn_mbcnt_hi(~0u, __builtin_amdgcn_mbcnt_lo(~0u, (unsigned)zv_)); F.wave = F0.wave + zs_; F.tid = F.wave * 64 + F.lane; F.bx = F.bx + zs_; \
        F.vcu = F0.vcu + zs_; F.G = F0.G + zs_; F.lds = (LAS unsigned char*)lds + zs_; F.ws = F0.ws + zs_; F.ctl = F0.ctl + zs_; F.in = F0.in + zs_; F.out = F0.out + zs_; }
#ifdef PROBE_XBAR
#define STEP_END   if (step + 1 < hi) { unsigned zb_; asm volatile("v_mov_b32 %0, 0" : "=v"(zb_)); bar.z = zb_; xcd_barrier(bar); xcd_barrier(bar); } } ++step;
#else
#define STEP_END   if (step + 1 < hi) { unsigned zb_; asm volatile("v_mov_b32 %0, 0" : "=v"(zb_)); bar.z = zb_; xcd_barrier(bar); } } ++step;
#endif

    for (int layer = 0; layer < DEPTH; ++layer) {
        const int jj = layer >> 1;
        STEP_BEGIN
            p_convert(F, layer);
            p_norm<0>(F, layer == 0 ? F.in[0] : F.out, F.in[1] + (size_t)layer * DM, nullptr, 0);
        STEP_END
        for (int c = 0; c < NCHUNK; ++c) {
            STEP_BEGIN
                pg8::StaticOrder S; S.init(MC, NPROJ, F.G, F.bx, WGM_PROJ);
                pg8::EpiProj E{WSP(bf16, WS_P1), WSP(bf16, WS_G)};
                run_gemm(F, WSP(bf16, WS_HN) + (size_t)c * MC * DM, WSP(bf16, WS_WIN), MC, NPROJ, DM, S, E);
            STEP_END
            STEP_BEGIN
                p_prep(F);
            STEP_END
            STEP_BEGIN
                LAS int* tab = (LAS int*)(F.lds + TAB_OFF);
                __syncthreads(); if (F.tid < 16) tab[F.tid] = F.tid >> 3; __syncthreads();
                pg8::GroupedOrder S; S.so.init(2 * 2048, 512, F.G, F.bx); S.tile_e = tab; S.nN = 2;
                pg8::EpiF32 E{WSP(float, WS_UL), 512, 2};
                run_gemm(F, WSP(bf16, WS_KVC), WSP(bf16, WS_WC1), 2 * 2048, 512, DM, S, E);
                p_sgu2(F, layer);
                p_stick2(F, F.G > 64 ? 32 : 0);
            STEP_END
            STEP_BEGIN
                p_cmpfin(F, layer);
            STEP_END
            STEP_BEGIN
#ifdef OLD_NSA
                p_nsa(F);
#else
                p_nsa2(F);
#endif
            STEP_END
            STEP_BEGIN
                pg8::MergeOrder S; S.so.init(MC, DM, F.G, F.bx); S.nmt = MC / 256;
                pg8::EpiMerge E{WSP(bf16, WS_G), WSP(bf16, WS_MG), MC / 256};
                run_gemm(F, WSP(bf16, WS_Y), WSP(bf16, WS_WBR), 3 * MC, 3 * DM, 256, S, E);
            STEP_END
            STEP_BEGIN
                pg8::StaticOrder S; S.init(MC, DM, F.G, F.bx);
                const float* base = (layer == 0 ? F.in[0] : F.out) + (size_t)c * MC * DM;
                pg8::EpiResid E{base, F.out + (size_t)c * MC * DM, DM, 1.0f};
                run_gemm(F, WSP(bf16, WS_MG), WSP(bf16, WS_WOUT), MC, DM, DM, S, E);
            STEP_END
        }
        if ((layer & 1) == 0) {
            STEP_BEGIN
                p_norm<0>(F, F.out, F.in[11] + (size_t)layer * DM, nullptr, 0, Q8_HN, TILED_FFN1);
            STEP_END
            for (int c = 0; c < FFN_CHUNKS; ++c) {
                constexpr int MF = MTOK / FFN_CHUNKS;
                STEP_BEGIN
                    pg8::StaticOrder S; S.init(MF, NFF1, F.G, F.bx, WGM_FFN1);
                    pg8::EpiSwiGLU E{WSP(bf16, WS_HID), DFFP, nullptr, NFF1 / 256};
                    run_gemm(F, WSP(bf16, WS_HN) + (size_t)c * MF * DM, WSP(bf16, WS_WF1), MF, NFF1, DM, S, E, true, TILED_FFN1);
                STEP_END
                STEP_BEGIN
                    pg8::StaticOrder S; S.init(MF, DM, F.G, F.bx, WGM_FFN2);
                    pg8::EpiResid E{F.out + (size_t)c * MF * DM, F.out + (size_t)c * MF * DM, DM, 1.0f};
                    run_gemm(F, WSP(bf16, WS_HID), WSP(bf16, WS_WF2), MF, DM, DFFP, S, E);
                STEP_END
            }
        } else {
            STEP_BEGIN
                p_norm<1>(F, F.out, F.in[11] + (size_t)layer * DM, F.in[15] + (size_t)jj * DM * NEXP, jj, Q8_HN);
            STEP_END
#ifdef ABL_DENSE_MOE
            for (int e = 0; e < NEXP; ++e) {
                STEP_BEGIN
                    pg8::StaticOrder S; S.init(MTOK, NMOE1, F.G, F.bx);
                    pg8::EpiSwiGLU E{WSP(bf16, WS_SCR + 8 * MiB), DFE, WSP(float, WS_SCR + 4 * MiB) + (size_t)e * MTOK, NMOE1 / 256};
                    run_gemm(F, WSP(bf16, WS_HN), WSP(bf16, WS_WF1) + (size_t)e * NMOE1 * DM, MTOK, NMOE1, DM, S, E);
                STEP_END
                STEP_BEGIN
                    pg8::StaticOrder S; S.init(MTOK, DM, F.G, F.bx);
                    pg8::EpiResid E{F.out, F.out, DM, 1.0f};
                    run_gemm(F, WSP(bf16, WS_SCR + 8 * MiB), WSP(bf16, WS_WF2) + (size_t)e * DM * DFE, MTOK, DM, DFE, S, E);
                STEP_END
            }
#else
            STEP_BEGIN
                p_gather(F, jj, 0, 0);
            STEP_END
            for (int c = 0; c < NCHUNK; ++c)
                for (int r = 0; r < 2; ++r) {
                    STEP_BEGIN
                        const int T = moe_table(F, jj, c, r);
                        pg8::GroupedOrder S; S.so.init(T * 256, NMOE1, F.G, F.bx, WGM_MOE1); S.tile_e = (LAS int*)(F.lds + TAB_OFF); S.nN = NMOE1 / 256;
                        pg8::EpiSwiGLU E{WSP(bf16, WS_HIDM), DFE, WSP(float, WS_WSLOT) + (c * 2 + r) * SLOTS, NMOE1 / 256};
                        run_gemm(F, WSP(bf16, WS_XG), WSP(bf16, WS_WF1), T * 256, NMOE1, DM, S, E, false);
                    STEP_END
                    STEP_BEGIN
                        const int T = moe_table(F, jj, c, r);
                        pg8::GroupedOrder S; S.so.init(T * 256, DM, F.G, F.bx, WGM_MOE2); S.tile_e = (LAS int*)(F.lds + TAB_OFF); S.nN = DM / 256;
                        pg8::EpiScatter E{F.out, WSP(int, WS_TOKMAP) + (c * 2 + r) * SLOTS, DM / 256, 1.0f};
                        run_gemm(F, WSP(bf16, WS_HIDM), WSP(bf16, WS_WF2), T * 256, DM, DFE, S, E, false);
                        if (!F.rep && c * 2 + r < 3) p_gather(F, jj, (c * 2 + r + 1) >> 1, (c * 2 + r + 1) & 1, (T * (DM / 256)) % F.G);
                    STEP_END
                }
#endif
        }
    }
    STEP_BEGIN
        p_norm<2>(F, F.out, F.in[19], nullptr, 0);
    STEP_END
#undef STEP_BEGIN
#undef STEP_END
}

#ifndef MK_STEPS_PER_LAUNCH
#define MK_STEPS_PER_LAUNCH 1
#endif
extern "C" void kernel_launch(void* const* d_in, const int* in_sizes, int n_in, void* d_out, int out_size, void* d_ws, size_t ws_size, hipStream_t stream) {
    static int grid = 0;
    if (grid == 0) {
        if (n_in != 20 || in_sizes[0] != MTOK * DM || out_size != MTOK * DM || ws_size < WS_END) { fprintf(stderr, "kernel_launch: unexpected shapes (n_in %d, in0 %d, out %d, ws %zu)\n", n_in, n_in > 0 ? in_sizes[0] : -1, out_size, ws_size); grid = -1; return; }
        int dev = 0, cus = 0, per_cu = 0;
        if (hipGetDevice(&dev) != hipSuccess || hipDeviceGetAttribute(&cus, hipDeviceAttributeMultiprocessorCount, dev) != hipSuccess) { grid = -1; return; }
        if (hipFuncSetAttribute((const void*)mk_fwd, hipFuncAttributeMaxDynamicSharedMemorySize, LDS_BYTES) != hipSuccess) { fprintf(stderr, "kernel_launch: hipFuncSetAttribute failed\n"); grid = -1; return; }
        if (hipOccupancyMaxActiveBlocksPerMultiprocessor(&per_cu, (const void*)mk_fwd, NWAVES * 64, LDS_BYTES) != hipSuccess || per_cu < 1) fprintf(stderr, "kernel_launch: occupancy query reports %d\n", per_cu);
        (void)hipGetLastError();
        grid = cus;
    }
    if (grid < 0) return;
    if (hipMemsetAsync((char*)d_ws + WS_CTL, 0, CTL_ZERO_BYTES, stream) != hipSuccess) return;
    Args a{};
    for (int i = 0; i < 20; ++i) a.in[i] = (const float*)d_in[i];
    a.out = (float*)d_out; a.ws = (unsigned char*)d_ws; a.rep = 0;
    #ifdef ABL_DENSE_MOE
    constexpr int NSTEPS = 2 * (1 + NCHUNK * 8 + 3) + 2 * (1 + NCHUNK * 8 + 1 + NEXP * 2) + 1;
#else
    constexpr int NSTEPS = 2 * (1 + NCHUNK * 7 + 1 + 2 * FFN_CHUNKS) + 2 * (1 + NCHUNK * 7 + 2 + NCHUNK * 2 * 2) + 1;
#endif
    int li = 0;
#ifdef REPMASK
    static int kinds[256]; int ns = 0;
    for (int layer = 0; layer < DEPTH; ++layer) { kinds[ns++] = 0;
        for (int c = 0; c < NCHUNK; ++c) for (int q = 1; q <= 8; ++q) if (q != 5) kinds[ns++] = q;
        if ((layer & 1) == 0) { kinds[ns++] = 9; for (int c = 0; c < FFN_CHUNKS; ++c) { kinds[ns++] = 10; kinds[ns++] = 11; } }
        else { kinds[ns++] = 12; kinds[ns++] = 17; for (int c = 0; c < NCHUNK * 2; ++c) { kinds[ns++] = 14; kinds[ns++] = 13; } } }
    kinds[ns++] = 16;
    for (int s = 0; s < NSTEPS; ++s) { const int reps = ((REPMASK >> kinds[s]) & 1) ? 2 : 1;
        for (int r = 0; r < reps; ++r) { a.lo = s; a.hi = s + 1; a.li = 0; a.rep = r;
            hipLaunchKernelGGL(mk_fwd, dim3(grid), dim3(NWAVES * 64), LDS_BYTES, stream, a); } }
    (void)li;
#else
    for (int s = 0; s < NSTEPS; s += MK_STEPS_PER_LAUNCH) {
        a.lo = s; a.hi = (s + MK_STEPS_PER_LAUNCH < NSTEPS) ? s + MK_STEPS_PER_LAUNCH : NSTEPS; a.li = (MK_STEPS_PER_LAUNCH > 1) ? li : 0; ++li;
        hipLaunchKernelGGL(mk_fwd, dim3(grid), dim3(NWAVES * 64), LDS_BYTES, stream, a);
        if (hipPeekAtLastError() != hipSuccess) { fprintf(stderr, "kernel_launch: launch failed\n"); break; }
    }
#endif
}
```

```cpp
#define MK_STEPS_PER_LAUNCH 1000
#define PG8_WGM 4
#define FFN_CHUNKS 1
#include <hip/hip_runtime.h>
#include <cstdio>
#include <cstdint>
#include <cmath>
#ifndef PG8_WGM
#define PG8_WGM 8
#endif
namespace pg8 {
#define PG8_LAS __attribute__((address_space(3)))
typedef unsigned short bf16_t;
typedef short bf16x8 __attribute__((ext_vector_type(8)));
typedef float f32x4 __attribute__((ext_vector_type(4)));
typedef unsigned u32x4 __attribute__((ext_vector_type(4)));
constexpr int BM = 256, BK = 64, HALF = 128, HTB = HALF * BK * 2  , STAGE_BYTES = 8 * HTB, NXCD = 8, WGM = PG8_WGM;

__host__ __device__ __forceinline__ int lds_byte(int r, int c) { const int st = (r >> 4) * 2 + (c >> 5), rr = r & 15, cc = c & 31, ob = rr * 64 + cc * 2; return st * 1024 + (ob ^ (((ob >> 9) & 1) << 5)); }
__host__ __device__ __forceinline__ void stage_rc(int b, int& R, int& C) { const int st = b / 1024, sb = b % 1024, swz = sb ^ (((sb >> 9) & 1) << 5); R = (st >> 1) * 16 + swz / 64; C = (st & 1) * 32 + (swz % 64) / 2; }
__host__ __device__ __forceinline__ int perm32(int rho) { const int n = rho >> 4, i = rho & 15; return 8 * (i >> 2) + 4 * n + (i & 3); }

struct Unit { int pm, pn; };
struct Gemm { const bf16_t* A; const bf16_t* Bt; int M, N, K; int zv; int rot; int tiled; };

struct StaticOrder {
    int nM, nN, nwg, G, c, wgm;
    __host__ __device__ void init(int M, int N, int G_, int c_, int wgm_ = WGM) { nM = M / BM; nN = N / BM; nwg = nM * nN; G = G_; c = c_; wgm = wgm_; }
    __host__ __device__ bool next(int i, Unit& u) const {
        const long L = (long)i * G + c; if (L >= nwg) return false;
        int wgid = (int)L; { const int q = nwg / NXCD, r = nwg % NXCD, xcd = wgid % NXCD, off = wgid / NXCD; wgid = (xcd < r ? xcd * (q + 1) : r * (q + 1) + (xcd - r) * q) + off; }
        const int nig = wgm * nN, gid = wgid / nig, fm = gid * wgm, gsz = (nM - fm) < wgm ? (nM - fm) : wgm;
        u.pm = fm + ((wgid % nig) % gsz); u.pn = (wgid % nig) / gsz; return true;
    }
    __device__ __forceinline__ void a_ready(const Unit&) const {}
    __device__ __forceinline__ void done(const Unit&) const {}
};

__device__ __forceinline__ unsigned cvt_pk_bf16(float lo, float hi) { unsigned r; asm volatile("v_cvt_pk_bf16_f32 %0, %1, %2" : "=v"(r) : "v"(lo), "v"(hi)); return r; }
typedef float f32x2 __attribute__((ext_vector_type(2)));

__device__ __forceinline__ float fast_sigmoid(float x) { return __builtin_amdgcn_rcpf(1.0f + __builtin_amdgcn_exp2f(-1.4426950408889634f * x)); }
__device__ __forceinline__ float gelu_tanh(float x) {
    const float u2 = 1.5957691216057308f * (x + 0.044715f * x * x * x);
    return x * fast_sigmoid(u2);
}
__device__ __forceinline__ float bf_lo(unsigned u) { return __builtin_bit_cast(float, u << 16); }
__device__ __forceinline__ float bf_hi(unsigned u) { return __builtin_bit_cast(float, u & 0xffff0000u); }

#ifdef PG8_NT_OUT
#define PG8_STORE_OUT(p, v) __builtin_nontemporal_store((v), (p))
#else
#define PG8_STORE_OUT(p, v) (*(p) = (v))
#endif
struct EpiProj {
    static constexpr bool PERM = true, AFTER_DRAIN = false, MID = false; static constexpr int MID_TILES = 1; __device__ __forceinline__ void set_scale0() {}
    bf16_t* P1; bf16_t* G;
    __device__ __forceinline__ void operator()(const f32x4 (&acc)[2][2][4][2], const Unit& u, int wr, int wc, int fr, int fq) const {
        const int row0 = u.pm * BM + wr * 64 + fr;
        bf16_t* base; int ldc, colt, act0, act1;
        if (u.pn < 8) { base = P1; ldc = 2048; colt = u.pn * BM; act0 = (u.pn < 2) ? 1 : 0; act1 = (u.pn == 7) ? 2 : act0; }
        else { base = G; ldc = 3072; colt = (u.pn - 8) * BM; act0 = 2; act1 = 2; }
        const int col0 = colt + wc * 32 + 8 * fq;
#pragma unroll
        for (int ai = 0; ai < 2; ++ai)
#pragma unroll
            for (int m = 0; m < 4; ++m) { bf16_t* rowp = base + (size_t)(row0 + ai * HALF + m * 16) * ldc + col0;
#pragma unroll
                for (int bj = 0; bj < 2; ++bj) { f32x4 v0 = acc[ai][bj][m][0], v1 = acc[ai][bj][m][1]; const int act = bj ? act1 : act0;
                    if (act == 1) {
#pragma unroll
                        for (int e = 0; e < 4; ++e) { v0[e] = gelu_tanh(v0[e]); v1[e] = gelu_tanh(v1[e]); } }
                    else if (act == 2) {
#pragma unroll
                        for (int e = 0; e < 4; ++e) { v0[e] = fast_sigmoid(v0[e]); v1[e] = fast_sigmoid(v1[e]); } }
                    u32x4 w; w.x = cvt_pk_bf16(v0[0], v0[1]); w.y = cvt_pk_bf16(v0[2], v0[3]); w.z = cvt_pk_bf16(v1[0], v1[1]); w.w = cvt_pk_bf16(v1[2], v1[3]);
                    *(u32x4*)(rowp + bj * HALF) = w; } }
    }
};
struct EpiMerge {
    static constexpr bool PERM = true, AFTER_DRAIN = false, MID = false; static constexpr int MID_TILES = 1; __device__ __forceinline__ void set_scale0() {}
    const bf16_t* G; bf16_t* MG; int nmt;
    __device__ __forceinline__ void operator()(const f32x4 (&acc)[2][2][4][2], const Unit& u, int wr, int wc, int fr, int fq) const {
        const int i = u.pn >> 2, pn = u.pn & 3, pm = u.pm - i * nmt;
        const int row0 = pm * BM + wr * 64 + fr, col0 = pn * BM + wc * 32 + 8 * fq;
#pragma unroll
        for (int ai = 0; ai < 2; ++ai)
#pragma unroll
            for (int mp = 0; mp < 2; ++mp) {
                u32x4 g[4], o[4];
#pragma unroll
                for (int q = 0; q < 4; ++q) { const int m = 2 * mp + (q >> 1), bj = q & 1; const size_t row = (size_t)(row0 + ai * HALF + m * 16); const int col = col0 + bj * HALF;
                    g[q] = *(const u32x4*)(G + row * 3072 + i * 1024 + col);
                    if (i > 0) o[q] = *(const u32x4*)(MG + row * 1024 + col); else o[q] = (u32x4){0u, 0u, 0u, 0u}; }
#pragma unroll
                for (int q = 0; q < 4; ++q) { const int m = 2 * mp + (q >> 1), bj = q & 1; const size_t row = (size_t)(row0 + ai * HALF + m * 16); const int col = col0 + bj * HALF;
                    f32x4 v0 = acc[ai][bj][m][0], v1 = acc[ai][bj][m][1];
#ifdef ABL_BRANCH
                    if (i == ABL_BRANCH) { v0 = v0 * (float)ABL_SCALE; v1 = v1 * (float)ABL_SCALE; }
#endif
                    v0[0] = v0[0] * bf_lo(g[q].x) + bf_lo(o[q].x); v0[1] = v0[1] * bf_hi(g[q].x) + bf_hi(o[q].x); v0[2] = v0[2] * bf_lo(g[q].y) + bf_lo(o[q].y); v0[3] = v0[3] * bf_hi(g[q].y) + bf_hi(o[q].y);
                    v1[0] = v1[0] * bf_lo(g[q].z) + bf_lo(o[q].z); v1[1] = v1[1] * bf_hi(g[q].z) + bf_hi(o[q].z); v1[2] = v1[2] * bf_lo(g[q].w) + bf_lo(o[q].w); v1[3] = v1[3] * bf_hi(g[q].w) + bf_hi(o[q].w);
                    u32x4 w; w.x = cvt_pk_bf16(v0[0], v0[1]); w.y = cvt_pk_bf16(v0[2], v0[3]); w.z = cvt_pk_bf16(v1[0], v1[1]); w.w = cvt_pk_bf16(v1[2], v1[3]);
                    *(u32x4*)(MG + row * 1024 + col) = w; } }
    }
};
struct EpiResid {
    static constexpr bool PERM = false, AFTER_DRAIN = false, MID = false; static constexpr int MID_TILES = 1; __device__ __forceinline__ void set_scale0() { scale = 0.f; base = out; }
    const float* base; float* out; int ldc; float scale;
    __device__ __forceinline__ void operator()(const f32x4 (&acc)[2][2][4][2], const Unit& u, int wr, int wc, int fr, int fq) const {
        const int row0 = u.pm * BM + wr * 64 + fr, col0 = u.pn * BM + wc * 32 + 4 * fq;
#pragma unroll
        for (int ai = 0; ai < 2; ++ai)
#pragma unroll
            for (int mp = 0; mp < 2; ++mp) {
                f32x4 b[8];
#pragma unroll
                for (int q = 0; q < 8; ++q) { const int m = 2 * mp + (q >> 2), bj = (q >> 1) & 1, n = q & 1;
                    b[q] = *(const f32x4*)(base + (size_t)(row0 + ai * HALF + m * 16) * ldc + col0 + bj * HALF + n * 16); }
#pragma unroll
                for (int q = 0; q < 8; ++q) { const int m = 2 * mp + (q >> 2), bj = (q >> 1) & 1, n = q & 1;
                    *(f32x4*)(out + (size_t)(row0 + ai * HALF + m * 16) * ldc + col0 + bj * HALF + n * 16) = b[q] + acc[ai][bj][m][n] * scale; } }
    }
};
struct EpiF32 {
    static constexpr bool PERM = false, AFTER_DRAIN = false, MID = false; static constexpr int MID_TILES = 1; __device__ __forceinline__ void set_scale0() {}
    float* O; int ldc, nN;
    __device__ __forceinline__ void operator()(const f32x4 (&acc)[2][2][4][2], const Unit& u, int wr, int wc, int fr, int fq) const {
        const int row0 = u.pm * BM + wr * 64 + fr, col0 = (u.pn % nN) * BM + wc * 32 + 4 * fq;
#pragma unroll
        for (int ai = 0; ai < 2; ++ai)
#pragma unroll
            for (int m = 0; m < 4; ++m) { const size_t off = (size_t)(row0 + ai * HALF + m * 16) * ldc + col0;
#pragma unroll
                for (int bj = 0; bj < 2; ++bj)
#pragma unroll
                    for (int n = 0; n < 2; ++n) *(f32x4*)(O + off + bj * HALF + n * 16) = acc[ai][bj][m][n]; }
    }
};
#ifdef EMU_FP8_HID
__device__ __forceinline__ float Q8H(float x) { const int p = __builtin_amdgcn_cvt_pk_fp8_f32(x * 8.f, x * 8.f, 0, false); return __builtin_amdgcn_cvt_f32_fp8(p, 0) * 0.125f; }
#else
__device__ __forceinline__ float Q8H(float x) { return x; }
#endif
struct EpiSwiGLU {
    static constexpr bool PERM = true, AFTER_DRAIN = false, MID = false; static constexpr int MID_TILES = 1; __device__ __forceinline__ void set_scale0() {}
    bf16_t* H; int ldh; const float* rowscale; int nN; int rowmask = 0x7fffffff;
    __device__ __forceinline__ void operator()(const f32x4 (&acc)[2][2][4][2], const Unit& u, int wr, int wc, int fr, int fq) const {
        const int row0 = u.pm * BM + wr * 64 + fr, col0 = (u.pn % nN) * HALF + wc * 32 + 8 * fq;
        float scv[8];
#pragma unroll
        for (int q = 0; q < 8; ++q) scv[q] = rowscale ? rowscale[row0 + (q >> 2) * HALF + (q & 3) * 16] : 1.0f;
#pragma unroll
        for (int ai = 0; ai < 2; ++ai)
#pragma unroll
            for (int m = 0; m < 4; ++m) { const int row = row0 + ai * HALF + m * 16; const float sc = scv[ai * 4 + m];
                float h[8];
#pragma unroll
                for (int n = 0; n < 2; ++n)
#pragma unroll
                    for (int e = 0; e < 4; ++e) { const float g = acc[ai][0][m][n][e], up = acc[ai][1][m][n][e]; h[n * 4 + e] = Q8H(g * fast_sigmoid(g) * up * sc); }
                u32x4 w; w.x = cvt_pk_bf16(h[0], h[1]); w.y = cvt_pk_bf16(h[2], h[3]); w.z = cvt_pk_bf16(h[4], h[5]); w.w = cvt_pk_bf16(h[6], h[7]);
                PG8_STORE_OUT((u32x4*)(H + (size_t)(row & rowmask) * ldh + col0), w); }
    }
};
struct EpiScatter {
    static constexpr bool PERM = false, AFTER_DRAIN = false, MID = false; static constexpr int MID_TILES = 1; __device__ __forceinline__ void set_scale0() { scale = 0.f; }
    float* out; const int* tok; int nN; float scale;
    __device__ __forceinline__ void operator()(const f32x4 (&acc)[2][2][4][2], const Unit& u, int wr, int wc, int fr, int fq) const {
        const int row0 = u.pm * BM + wr * 64 + fr, col0 = (u.pn % nN) * BM + wc * 32 + 4 * fq;
        int tk[8];
#pragma unroll
        for (int q = 0; q < 8; ++q) tk[q] = tok[row0 + (q >> 2) * HALF + (q & 3) * 16];
#pragma unroll
        for (int ai = 0; ai < 2; ++ai)
#pragma unroll
            for (int mp = 0; mp < 2; ++mp) {
                f32x4 b[8];
#pragma unroll
                for (int q = 0; q < 8; ++q) { const int m = 2 * mp + (q >> 2), bj = (q >> 1) & 1, n = q & 1; const int t = tk[ai * 4 + m];
                    b[q] = *(const f32x4*)(out + (size_t)(t < 0 ? 0 : t) * 1024 + col0 + bj * HALF + n * 16); }
#pragma unroll
                for (int q = 0; q < 8; ++q) { const int m = 2 * mp + (q >> 2), bj = (q >> 1) & 1, n = q & 1; const int t = tk[ai * 4 + m];
#ifdef ABL_MOE
                    if (false)
#else
                    if (t >= 0)
#endif
                        *(f32x4*)(out + (size_t)t * 1024 + col0 + bj * HALF + n * 16) = b[q] + acc[ai][bj][m][n] * scale; } }
    }
};
struct GroupedOrder {
    StaticOrder so; const PG8_LAS int* tile_e; int nN;
    __device__ __forceinline__ bool next(int i, Unit& u) const { if (!so.next(i, u)) return false; u.pn += tile_e[u.pm] * nN; return true; }
    __device__ __forceinline__ void a_ready(const Unit&) const {}
    __device__ __forceinline__ void done(const Unit&) const {}
};
struct OffsetOrder {
    StaticOrder so; int pn_off;
    __device__ __forceinline__ bool next(int i, Unit& u) const { if (!so.next(i, u)) return false; u.pn += pn_off; return true; }
    __device__ __forceinline__ void a_ready(const Unit&) const {}
    __device__ __forceinline__ void done(const Unit&) const {}
};
struct ProbeOrder {
    StaticOrder so; int pm_mask;
    __device__ __forceinline__ bool next(int i, Unit& u) const { if (!so.next(i, u)) return false; u.pm &= pm_mask; return true; }
    __device__ __forceinline__ void a_ready(const Unit&) const {}
    __device__ __forceinline__ void done(const Unit&) const {}
};
struct MergeOrder {
    StaticOrder so; int nmt;
    __device__ __forceinline__ bool next(int i, Unit& u) const { const int b = i % 3; if (!so.next(i / 3, u)) return false; u.pm += b * nmt; u.pn += b * 4; return true; }
    __device__ __forceinline__ void a_ready(const Unit&) const {}
    __device__ __forceinline__ void done(const Unit&) const {}
};
template <class Epi, class Sched, bool ALIGN_EPI = false, bool SP2 = false>
__device__ __forceinline__ void gemm_phase(PG8_LAS unsigned char* lds, const Gemm g, const Sched& S, const Epi& E) {
    const int tid = g.zv  , wid = __builtin_amdgcn_readfirstlane(tid >> 6), lane = tid & 63, wr = wid >> 2, wc = wid & 3, fr = lane & 15, fq = lane >> 4;
    const int K = g.K, nt = K / BK;
    unsigned voffA[2], voffB[2];
#pragma unroll
    for (int i = 0; i < 2; ++i) { int R, C; stage_rc(tid * 16 + i * 8192, R, C); const int Rb = Epi::PERM ? ((R & ~31) + perm32(R & 31)) : R;
        const int pitch = g.tiled ? BK : K;
        voffA[i] = (unsigned)(R * pitch + C) * 2u; voffB[i] = (unsigned)(Rb * pitch + C) * 2u; }
    const size_t kstep = g.tiled ? (size_t)(BM * BK * 2) : (size_t)(BK * 2);
    const size_t hstep = g.tiled ? (size_t)(HALF * BK * 2) : (size_t)HALF * K * 2;
    const size_t tstep = (size_t)BM * K * 2;
    const unsigned ldsw = (unsigned)wid * 1024u;
    const int aoff = lds_byte(wr * 64 + fr, fq * 8), boff = lds_byte(wc * 32 + fr, fq * 8);
#define PG8_SA(b, h) (((b) * 2 + (h)) * HTB)
#define PG8_SB(b, h) ((4 + (b) * 2 + (h)) * HTB)
#define PG8_STAGE(bufoff, gbase, voff) do { _Pragma("unroll") for (int _i = 0; _i < 2; ++_i) \
        __builtin_amdgcn_global_load_lds((const unsigned*)((const char*)(gbase) + (voff)[_i]), (PG8_LAS unsigned*)(lds + (bufoff) + ldsw + _i * 8192), 16, 0, 0); } while (0)
#define PG8_LDA(dst, b, h) do { _Pragma("unroll") for (int m = 0; m < 4; ++m) _Pragma("unroll") for (int k = 0; k < 2; ++k) dst[m][k] = *(const PG8_LAS bf16x8*)(lds + PG8_SA(b, h) + aoff + m * 2048 + k * 1024); } while (0)
#define PG8_LDB(dst, b, h) do { _Pragma("unroll") for (int n = 0; n < 2; ++n) _Pragma("unroll") for (int k = 0; k < 2; ++k) dst[n][k] = *(const PG8_LAS bf16x8*)(lds + PG8_SB(b, h) + boff + n * 2048 + k * 1024); } while (0)
#define PG8_MMA(ai, bj, At, Bt) do { __builtin_amdgcn_s_setprio(1); _Pragma("unroll") for (int m = 0; m < 4; ++m) _Pragma("unroll") for (int n = 0; n < 2; ++n) _Pragma("unroll") for (int k = 0; k < 2; ++k) \
        acc[ai][bj][m][n] = __builtin_amdgcn_mfma_f32_16x16x32_bf16(Bt[n][k], At[m][k], acc[ai][bj][m][n], 0, 0, 0); __builtin_amdgcn_s_setprio(0); } while (0)
#define PG8_WAIT_V(n) asm volatile("s_waitcnt vmcnt(" #n ")" ::: "memory")
#define PG8_WAIT_L(n) asm volatile("s_waitcnt lgkmcnt(" #n ")" ::: "memory")
#define PG8_BAR __builtin_amdgcn_s_barrier()
#define PG8_SCHED __builtin_amdgcn_sched_barrier(0)
    Unit cur, nxt; int ui = 0;
    if (!S.next(0, cur)) return;
    f32x4 acc[2][2][4][2];
#pragma unroll
    for (int a = 0; a < 2; ++a)
#pragma unroll
        for (int b = 0; b < 2; ++b)
#pragma unroll
            for (int m = 0; m < 4; ++m)
#pragma unroll
                for (int n = 0; n < 2; ++n) acc[a][b][m][n] = (f32x4){0.f, 0.f, 0.f, 0.f};
    bf16x8 At[4][2], B0[2][2], B1[2][2];
    const char* cA = (const char*)g.A + (size_t)cur.pm * tstep; const char* cB = (const char*)g.Bt + (size_t)cur.pn * tstep;
    const int rot = g.rot; const size_t rofs = (size_t)rot * kstep; const char* pA = cA + rofs; const char* pB = cB + rofs;
#define PG8_KT(x) ((size_t)(((x) + rot >= nt) ? (x) + rot - nt : (x) + rot))
    S.a_ready(cur);
    if constexpr (SP2) {
        PG8_STAGE(PG8_SB(0, 0), pB, voffB); PG8_STAGE(PG8_SB(0, 1), pB + hstep, voffB); PG8_STAGE(PG8_SA(0, 0), pA, voffA); PG8_STAGE(PG8_SA(0, 1), pA + hstep, voffA);
        if (wr == 1) PG8_BAR;
        PG8_WAIT_V(2); PG8_BAR;
        PG8_STAGE(PG8_SB(1, 0), pB + kstep, voffB); PG8_STAGE(PG8_SA(1, 0), pA + kstep, voffA); PG8_STAGE(PG8_SB(1, 1), pB + hstep + kstep, voffB);
        PG8_WAIT_V(6); PG8_BAR;
    } else {
        PG8_STAGE(PG8_SB(0, 0), pB, voffB); PG8_STAGE(PG8_SA(0, 0), pA, voffA); PG8_STAGE(PG8_SB(0, 1), pB + hstep, voffB); PG8_STAGE(PG8_SA(0, 1), pA + hstep, voffA);
        if (wr == 1) PG8_BAR;
        PG8_WAIT_V(4); PG8_BAR;
        PG8_STAGE(PG8_SB(1, 0), pB + kstep, voffB); PG8_STAGE(PG8_SA(1, 0), pA + kstep, voffA); PG8_STAGE(PG8_SB(1, 1), pB + hstep + kstep, voffB);
        PG8_WAIT_V(6); PG8_BAR;
    }
    for (;;) {
        const bool has_next = S.next(ui + 1, nxt);
        const char* nA = has_next ? (const char*)g.A + (size_t)nxt.pm * tstep : cA; const char* nB = has_next ? (const char*)g.Bt + (size_t)nxt.pn * tstep : cB;
        for (int t = 0; t < nt; t += 2) {
            if constexpr (Epi::MID) { if (t != 0 && (t & (Epi::MID_TILES - 1)) == 0) E.mid(acc, cur, t / Epi::MID_TILES, wr, wc, fr, fq); }
            const bool last = (t == nt - 2);
            const char* a1 = cA + PG8_KT(t + 1) * kstep;
            const char* a2 = last ? nA + rofs : cA + PG8_KT(t + 2) * kstep; const char* b2 = last ? nB + rofs : cB + PG8_KT(t + 2) * kstep;
            const char* a3 = a2 + kstep; const char* b3 = b2 + kstep;
            if (last && has_next) S.a_ready(nxt);
            if constexpr (SP2) {
            PG8_LDB(B0, 0, 0); PG8_LDB(B1, 0, 1); PG8_SCHED; PG8_LDA(At, 0, 0); PG8_STAGE(PG8_SA(1, 1), a1 + hstep, voffA);
            PG8_WAIT_V(8); PG8_WAIT_L(0); PG8_BAR; PG8_MMA(0, 0, At, B0); PG8_MMA(0, 1, At, B1); PG8_BAR; PG8_SCHED;
            PG8_LDA(At, 0, 1); PG8_STAGE(PG8_SB(0, 0), b2, voffB); PG8_STAGE(PG8_SB(0, 1), b2 + hstep, voffB); PG8_STAGE(PG8_SA(0, 0), a2, voffA);
            PG8_WAIT_V(8); PG8_WAIT_L(0); PG8_BAR; PG8_MMA(1, 0, At, B0); PG8_MMA(1, 1, At, B1); PG8_BAR; PG8_SCHED;
            PG8_LDB(B0, 1, 0); PG8_LDB(B1, 1, 1); PG8_SCHED; PG8_LDA(At, 1, 0); PG8_STAGE(PG8_SA(0, 1), a2 + hstep, voffA);
            PG8_WAIT_V(8); PG8_WAIT_L(0); PG8_BAR; PG8_MMA(0, 0, At, B0); PG8_MMA(0, 1, At, B1); PG8_BAR; PG8_SCHED;
            PG8_LDA(At, 1, 1); PG8_STAGE(PG8_SB(1, 0), b3, voffB); PG8_STAGE(PG8_SB(1, 1), b3 + hstep, voffB); PG8_STAGE(PG8_SA(1, 0), a3, voffA);
            PG8_WAIT_V(8); PG8_WAIT_L(0); PG8_BAR; PG8_MMA(1, 0, At, B0); PG8_MMA(1, 1, At, B1); PG8_BAR; PG8_SCHED;
            } else {
            PG8_LDB(B0, 0, 0); PG8_SCHED; PG8_LDA(At, 0, 0); PG8_STAGE(PG8_SA(1, 1), a1 + hstep, voffA);
            PG8_WAIT_L(8); PG8_BAR; PG8_WAIT_L(0); PG8_MMA(0, 0, At, B0); PG8_BAR; PG8_SCHED;
            PG8_LDB(B1, 0, 1); PG8_STAGE(PG8_SB(0, 0), b2, voffB);
            PG8_BAR; PG8_WAIT_L(0); PG8_MMA(0, 1, At, B1); PG8_BAR;
            PG8_LDA(At, 0, 1); PG8_STAGE(PG8_SA(0, 0), a2, voffA);
            PG8_BAR; PG8_WAIT_L(0); PG8_MMA(1, 0, At, B0); PG8_BAR; PG8_SCHED;
            PG8_STAGE(PG8_SB(0, 1), b2 + hstep, voffB);
            PG8_WAIT_V(6); PG8_BAR; PG8_MMA(1, 1, At, B1); PG8_BAR;
            PG8_LDB(B0, 1, 0); PG8_SCHED; PG8_LDA(At, 1, 0); PG8_STAGE(PG8_SA(0, 1), a2 + hstep, voffA);
            PG8_WAIT_L(8); PG8_BAR; PG8_WAIT_L(0); PG8_MMA(0, 0, At, B0); PG8_BAR; PG8_SCHED;
            PG8_LDB(B1, 1, 1); PG8_STAGE(PG8_SB(1, 0), b3, voffB);
            PG8_BAR; PG8_WAIT_L(0); PG8_MMA(0, 1, At, B1); PG8_BAR;
            PG8_LDA(At, 1, 1); PG8_STAGE(PG8_SA(1, 0), a3, voffA);
            PG8_BAR; PG8_WAIT_L(0); PG8_MMA(1, 0, At, B0); PG8_BAR; PG8_SCHED;
            PG8_STAGE(PG8_SB(1, 1), b3 + hstep, voffB);
            PG8_WAIT_V(6); PG8_BAR; PG8_MMA(1, 1, At, B1); PG8_BAR;
            }
        }
        if constexpr (ALIGN_EPI) { if (wr == 0) PG8_BAR; }
        if constexpr (!Epi::AFTER_DRAIN) { E(acc, cur, wr, wc, fr, fq); S.done(cur); }
        if (!has_next) break;
#pragma unroll
        for (int a = 0; a < 2; ++a)
#pragma unroll
            for (int b = 0; b < 2; ++b)
#pragma unroll
                for (int m = 0; m < 4; ++m)
#pragma unroll
                    for (int n = 0; n < 2; ++n) acc[a][b][m][n] = (f32x4){0.f, 0.f, 0.f, 0.f};
        cur = nxt; cA = nA; cB = nB; ++ui;
        if constexpr (ALIGN_EPI) { if (wr == 1) PG8_BAR; }
    }
    PG8_WAIT_V(0);
    if constexpr (!ALIGN_EPI) { if (wr == 0) PG8_BAR; }
    PG8_BAR;
    if constexpr (Epi::AFTER_DRAIN) { E.fused(acc, cur, wr, wc, fr, fq, lds, wid, lane); S.done(cur); }
#undef PG8_KT
#undef PG8_SA
#undef PG8_SB
#undef PG8_STAGE
#undef PG8_LDA
#undef PG8_LDB
#undef PG8_MMA
#undef PG8_WAIT_V
#undef PG8_WAIT_L
#undef PG8_BAR
#undef PG8_SCHED
}
}

constexpr int NWAVES = 8;
constexpr int DM = 1024, BATCH = 16, SEQ = 4096, DEPTH = 4, MTOK = BATCH * SEQ;
constexpr int NCHUNK = 2, MC = MTOK / NCHUNK, BC = BATCH / NCHUNK;
constexpr int CIN = 5004, NPROJ = 5120, P1W = 2048, GWID = 3072;
constexpr int DFF = 2752, DFFP = 2816, NFF1 = 2 * DFFP;
constexpr int NEXP = 8, DFE = 3584, NMOE1 = 2 * DFE;
constexpr int SLOTS = MC + 2048;
constexpr float EPS = 1e-6f;
constexpr int C_U = 0, C_V = 256, C_SBQ = 512, C_SBK = 768, C_SBV = 1024, C_CQ = 1280, C_KCMP = 1536, C_VCMP = 1600, C_KSLC = 1664, C_VSLC = 1728, C_KWIN = 1792, C_VWIN = 1856, C_CG = 1920;

constexpr size_t MiB = 1u << 20;
constexpr size_t WS_CTL = 0, CTL_ZERO_BYTES = 1 * MiB;
constexpr size_t WS_ROPE = 1 * MiB;
constexpr size_t WS_BIAS1 = 1 * MiB + 512 * 1024;
constexpr size_t WS_WIN = 2 * MiB;
constexpr size_t WS_WBR = 12 * MiB;
constexpr size_t WS_WOUT = 14 * MiB;
constexpr size_t WS_WC1 = 16 * MiB;
constexpr size_t WS_WF1 = 18 * MiB;
constexpr size_t WS_WF2 = 130 * MiB;
constexpr size_t WS_HN = 186 * MiB;
constexpr size_t WS_SCR = 314 * MiB;
constexpr size_t WS_P1 = WS_SCR;
constexpr size_t WS_G = WS_P1 + 128 * MiB;
constexpr size_t WS_Y = WS_G + 192 * MiB;
constexpr size_t WS_MG = WS_Y + 48 * MiB;
constexpr size_t WS_KVC = WS_MG + 64 * MiB;
constexpr size_t WS_UL = WS_KVC + 8 * MiB;
constexpr size_t WS_KC = WS_UL + 8 * MiB;
constexpr size_t WS_VT = WS_KC + 1 * MiB;
constexpr size_t WS_KCT = WS_VT + 24 * MiB;
constexpr size_t WS_MIX_END = WS_KCT + 1 * MiB;
constexpr size_t WS_HID = WS_SCR;
constexpr size_t WS_ROUTE = WS_SCR;
constexpr size_t WS_TOKMAP = WS_SCR + 1 * MiB;
constexpr size_t WS_WSLOT = WS_SCR + 2 * MiB;
constexpr size_t WS_XG = WS_SCR + 4 * MiB;
constexpr size_t WS_HIDM = WS_XG + 68 * MiB;
constexpr size_t WS_END = 800 * MiB;
static_assert(WS_MIX_END <= WS_END && WS_HID + (size_t)MTOK * DFFP * 2 <= WS_END && WS_HIDM + (size_t)SLOTS * DFE * 2 <= WS_END, "d_ws map");
static_assert(WS_WF1 + (size_t)NEXP * NMOE1 * DM * 2 <= WS_WF2 && WS_WF2 + (size_t)NEXP * DM * DFE * 2 <= WS_HN, "weight map");
static_assert((size_t)4 * SLOTS * 4 <= 1 * MiB, "tokmap");
constexpr int CW_BAR = 4096;
constexpr int CW_CNT = 131072;
constexpr int CW_CUR = 131072 + 256;
constexpr int MAX_BAR_REGIONS = 32;
constexpr int RING_OFF = 0, RING_BYTES = 131072;
constexpr int LDSCTL_OFF = RING_BYTES, MISC_OFF = LDSCTL_OFF + 320;
constexpr int TAB_OFF = LDSCTL_OFF + 1024;
constexpr int LDS_BYTES = 147456;

#define GAS __attribute__((address_space(1)))
#define LAS __attribute__((address_space(3)))
typedef unsigned short bf16;
typedef unsigned v4u __attribute__((ext_vector_type(4)));
typedef unsigned v2u __attribute__((ext_vector_type(2)));
typedef float f32x4 __attribute__((ext_vector_type(4)));
typedef int v4i __attribute__((ext_vector_type(4)));
typedef __bf16 bf16x2_t __attribute__((ext_vector_type(2)));
#define LDS_WAIT() asm volatile("s_waitcnt lgkmcnt(0)" ::: "memory")
#define VM_WAIT() asm volatile("s_waitcnt vmcnt(0)" ::: "memory")
__device__ __forceinline__ unsigned f2bf(float f) { unsigned u = __builtin_bit_cast(unsigned, f); return (u + 0x7fffu + ((u >> 16) & 1u)) >> 16; }
__device__ __forceinline__ unsigned pk2(float lo, float hi) { return f2bf(lo) | (f2bf(hi) << 16); }
__device__ __forceinline__ float bflo(unsigned u) { return __builtin_bit_cast(float, u << 16); }
__device__ __forceinline__ float bfhi(unsigned u) { return __builtin_bit_cast(float, u & 0xffff0000u); }
__device__ __forceinline__ float bf1(bf16 h) { return __builtin_bit_cast(float, (unsigned)h << 16); }
__device__ __forceinline__ float dot2bf(unsigned a, unsigned b, float c) { return __builtin_amdgcn_fdot2_f32_bf16(__builtin_bit_cast(bf16x2_t, a), __builtin_bit_cast(bf16x2_t, b), c, false); }
#ifdef EMU_FP8
__device__ __forceinline__ float q8r(float x, float s) { const int p = __builtin_amdgcn_cvt_pk_fp8_f32(x * s, x * s, 0, false); return __builtin_amdgcn_cvt_f32_fp8(p, 0) * (1.0f / s); }
#else
__device__ __forceinline__ float q8r(float x, float) { return x; }
#endif
__device__ __forceinline__ float fexp(float x) { return __builtin_amdgcn_exp2f(1.4426950408889634f * x); }
template <int X> __device__ __forceinline__ float swz_xor(float v) { return __builtin_bit_cast(float, __builtin_amdgcn_ds_swizzle(__builtin_bit_cast(int, v), (X << 10) | 0x1f)); }
__device__ __forceinline__ float wave_sum(float v, int lane) {
#pragma unroll
    for (int o = 1; o < 64; o <<= 1) v += __builtin_bit_cast(float, __builtin_amdgcn_ds_bpermute((lane ^ o) << 2, __builtin_bit_cast(int, v)));
    return v;
}
__device__ __forceinline__ float rdlane(float v, int l) { return __builtin_bit_cast(float, __builtin_amdgcn_readlane(__builtin_bit_cast(int, v), l)); }
__device__ __forceinline__ int bperm(int srclane, int v) { return __builtin_amdgcn_ds_bpermute(srclane << 2, v); }
__constant__ double ROPE_INVF[8] = {1.0, 0.19392274474868576, 0.037606030930863933, 0.0072926647372171093, 0.0014142135623730950, 0.00027424817567620730, 5.3182958969449883e-05, 1.0313385377212460e-05};
#define XB_TMO      128
#define XB_XCNT(j)  (256  + 64 * (j))
#define XB_XSUB(j)  (1280 + 64 * (j))
#define XB_XGEN(j)  (2304 + 64 * (j))
#define XB_TOP      3328
#define XB_TOPGEN   3392
#define XCD_BAR_WORDS 3456
#define XB_SPIN_CAP (1u << 18)

__device__ __forceinline__ unsigned xb_ld(unsigned* p)              { return __hip_atomic_load(p, __ATOMIC_RELAXED, __HIP_MEMORY_SCOPE_AGENT); }
__device__ __forceinline__ unsigned xb_add(unsigned* p, unsigned v) { return __hip_atomic_fetch_add(p, v, __ATOMIC_RELAXED, __HIP_MEMORY_SCOPE_AGENT); }
__device__ __forceinline__ unsigned xb_xcc_id() { return (unsigned)__builtin_amdgcn_s_getreg((3 << 11) | 20) & 0xFu; }
#define XB_SPIN(cond, bar) do { unsigned _sp = 0; while (cond) { __builtin_amdgcn_s_sleep(1); \
    if ((++_sp & 255u) == 0u) { if (xb_ld(&(bar)[XB_TMO])) break; if (_sp > XB_SPIN_CAP) { atomicAdd(&(bar)[XB_TMO], 1u); break; } } } } while (0)

__device__ __forceinline__ bool xb_thread0_w(unsigned w, unsigned z) { return w == 0u && __builtin_amdgcn_mbcnt_hi(~0u, __builtin_amdgcn_mbcnt_lo(~0u, z)) == 0u; }
struct XcdBarrier {
    unsigned* bar; unsigned x; unsigned w, z;
    volatile LAS unsigned* st;
};

__device__ __forceinline__ XcdBarrier xcd_barrier_post(unsigned* bar, volatile LAS unsigned* st) {
    XcdBarrier b; b.bar = bar; b.x = xb_xcc_id(); b.st = st; b.w = (unsigned)__builtin_amdgcn_readfirstlane((int)(threadIdx.x >> 6)); b.z = 0u;
    if (xb_thread0_w(b.w, b.z)) (void)xb_add(&bar[XB_XCNT(b.x)], 1u);
    return b;
}
__device__ __forceinline__ void xcd_barrier_complete(unsigned* bar, unsigned x, unsigned& nloc, unsigned& nx) {
    const unsigned G = gridDim.x * gridDim.y * gridDim.z;
    unsigned sum, cnt, mine, sp = 0u;
    for (;;) {
        sum = 0u; cnt = 0u; mine = 0u;
#pragma unroll
        for (unsigned j = 0; j < 16; ++j) { const unsigned c = xb_ld(&bar[XB_XCNT(j)]); sum += c; cnt += (c > 0u) ? 1u : 0u; mine = (j == x) ? c : mine; }
        if (sum == G) break;
        __builtin_amdgcn_s_sleep(1);
        if ((++sp & 255u) == 0u) { if (xb_ld(&bar[XB_TMO])) break; if (sp > XB_SPIN_CAP) { atomicAdd(&bar[XB_TMO], 1u); break; } }
    }
    nloc = mine > 0u ? mine : 1u; nx = cnt > 0u ? cnt : 1u;
}

__device__ __forceinline__ void xcd_barrier(const XcdBarrier& b) {
    asm volatile("s_waitcnt vmcnt(0)" ::: "memory");
    __syncthreads();
    if (xb_thread0_w(b.w, b.z)) {
        unsigned* bar = b.bar;
        __builtin_amdgcn_s_waitcnt(0);
        unsigned nloc = b.st[0], nx = b.st[1];
        if (nloc == 0u) { xcd_barrier_complete(bar, b.x, nloc, nx); b.st[0] = nloc; b.st[1] = nx; }
        const unsigned old = xb_add(&bar[XB_XSUB(b.x)], 1u);
        const unsigned gen = old / nloc;
        if (old + 1u == (gen + 1u) * nloc) {
            __builtin_amdgcn_fence(__ATOMIC_RELEASE, "agent");
            asm volatile("s_waitcnt vmcnt(0)" ::: "memory");
            const unsigned og = xb_add(&bar[XB_TOP], 1u);
            const unsigned tg = og / nx;
            if (og + 1u == (tg + 1u) * nx) xb_add(&bar[XB_TOPGEN], 1u);
            else XB_SPIN(xb_ld(&bar[XB_TOPGEN]) == tg, bar);
            __builtin_amdgcn_fence(__ATOMIC_ACQUIRE, "agent");
            xb_add(&bar[XB_XGEN(b.x)], 1u);
            asm volatile("s_waitcnt vmcnt(0)" ::: "memory");
        } else {
            XB_SPIN(xb_ld(&bar[XB_XGEN(b.x)]) == gen, bar);
            __builtin_amdgcn_fence(__ATOMIC_ACQUIRE, "agent");
            asm volatile("s_waitcnt vmcnt(0)" ::: "memory");
        }
    }
    __syncthreads();
}

struct Frame {
    LAS unsigned char* lds;
    unsigned* ctl;
    int tid, lane, wave, vcu, G, bx, zv, zs, rep;
    unsigned char* ws;
    const float* const* in;
    float* out;
};
#define WSP(T, off) ((T*)(F.ws + (off)))
__device__ __forceinline__ size_t toff(int row, int k, int K) { return (size_t)(row >> 8) * 256 * K + (size_t)(k >> 6) * (256 * 64) + (size_t)(row & 255) * 64 + (k & 63); }

#ifndef TILED_FFN1
#define TILED_FFN1 0
#endif
#ifndef Q8_W1
#define Q8_W1 0.f
#define Q8_W2 0.f
#define Q8_HN 0.f
#define Q8_HID 0.f
#endif
__device__ __forceinline__ int map_row(int kind, int off, int n) { return kind == 0 ? n + off : (kind == 1 ? (n < 1932 ? n : n + 116) : ((n >> 7) * 256 + (n & 127) + off)); }
__device__ __forceinline__ void tr_item(const float* W, int ldw, int N, int ks, int n0, bf16* WT, int ldt, int kd, int kind, int off, LAS unsigned char* scr, int lane, float q8s = 0.f, int tiled = 0) {
    const int nq = (lane & 15) * 4, kq = lane >> 4;
    f32x4 x[16];
#pragma unroll
    for (int i = 0; i < 16; ++i) x[i] = (n0 + nq < N) ? *(const f32x4*)(W + (size_t)(ks + 4 * i + kq) * ldw + n0 + nq) : (f32x4){0.f, 0.f, 0.f, 0.f};
#pragma unroll
    for (int i = 0; i < 16; ++i) { const int k = 4 * i + kq;
#pragma unroll
        for (int c = 0; c < 4; ++c) { float wv = x[i][c]; if (q8s > 0.f) wv = q8r(wv, q8s); *(LAS bf16*)(scr + (nq + c) * 136 + k * 2) = (bf16)f2bf(wv); } }
    LDS_WAIT(); asm volatile("" ::: "memory");
    if (n0 + lane < N) { const LAS v2u* s = (const LAS v2u*)(scr + lane * 136); const int mr = map_row(kind, off, n0 + lane); bf16* dst = tiled ? WT + toff(mr, kd, ldt) : WT + (size_t)mr * ldt + kd;
#pragma unroll
        for (int q = 0; q < 8; ++q) { const v2u a = s[2 * q], b = s[2 * q + 1]; *(v4u*)(dst + 8 * q) = (v4u){a.x, a.y, b.x, b.y}; } }
    LDS_WAIT(); asm volatile("" ::: "memory");
}
__device__ __forceinline__ void conv(Frame& F, const float* W, size_t sW, int nb, int ldw, int N, int ks0, int K, bf16* WT, size_t sWT, int ldt, int kd0, int kind, int off, float q8s = 0.f, int tiled = 0) {
    LAS unsigned char* scr = F.lds + RING_OFF + F.wave * 16384;
    const int gw = F.vcu * NWAVES + F.wave, NGW = F.G * NWAVES;
    const int nblk = (N + 63) / 64, per = (K / 64) * nblk, total = per * nb;
    for (int it = gw; it < total; it += NGW) { const int b = it / per, r = it % per, kb = r / nblk, nbk = r % nblk;
        tr_item(W + (size_t)b * sW, ldw, N, ks0 + 64 * kb, 64 * nbk, WT + (size_t)b * sWT, ldt, kd0 + 64 * kb, kind, off, scr, F.lane, q8s, tiled); }
}
__device__ __forceinline__ void zero_block(Frame& F, bf16* WT, int ldt, int r0, int rows, int c0, int cols, int tiled = 0) {
    const int gt = (F.vcu * NWAVES + F.wave) * 64 + F.lane, NT = F.G * NWAVES * 64, cpr = cols / 8;
    for (int i = gt; i < rows * cpr; i += NT) { const int r = i / cpr, c = i % cpr; const unsigned z = (unsigned)F.zv; *(v4u*)(tiled ? WT + toff(r0 + r, c0 + 8 * c, ldt) : WT + (size_t)(r0 + r) * ldt + c0 + 8 * c) = (v4u){z, z, z, z}; }
}
__device__ __forceinline__ void p_convert(Frame& F, int layer) {
    const int j = layer >> 1;
    conv(F, F.in[2] + (size_t)layer * DM * CIN, 0, 1, CIN, CIN, 0, DM, WSP(bf16, WS_WIN), 0, DM, 0, 1, 0);
    zero_block(F, WSP(bf16, WS_WIN), DM, 1932, 116, 0, DM);
    conv(F, F.in[9] + (size_t)layer * 3 * 256 * DM, (size_t)256 * DM, 3, DM, DM, 0, 256, WSP(bf16, WS_WBR), (size_t)DM * 256, 256, 0, 0, 0);
    conv(F, F.in[10] + (size_t)layer * DM * DM, 0, 1, DM, DM, 0, DM, WSP(bf16, WS_WOUT), 0, DM, 0, 0, 0);
    conv(F, F.in[7] + (size_t)layer * 2 * 2048 * 256, (size_t)2048 * 256, 2, 256, 256, 0, 1024, WSP(bf16, WS_WC1), (size_t)512 * 1024, 1024, 0, 0, 0);
    conv(F, F.in[7] + (size_t)layer * 2 * 2048 * 256, (size_t)2048 * 256, 2, 256, 256, 1024, 1024, WSP(bf16, WS_WC1), (size_t)512 * 1024, 1024, 0, 0, 256);
    if ((layer & 1) == 0) {
        conv(F, F.in[12] + (size_t)j * DM * DFF, 0, 1, DFF, DFF, 0, DM, WSP(bf16, WS_WF1), 0, DM, 0, 2, 0, Q8_W1, TILED_FFN1);
        conv(F, F.in[13] + (size_t)j * DM * DFF, 0, 1, DFF, DFF, 0, DM, WSP(bf16, WS_WF1), 0, DM, 0, 2, 128, Q8_W1, TILED_FFN1);
        zero_block(F, WSP(bf16, WS_WF1), DM, 21 * 256 + 64, 64, 0, DM, TILED_FFN1);
        zero_block(F, WSP(bf16, WS_WF1), DM, 21 * 256 + 128 + 64, 64, 0, DM, TILED_FFN1);
        conv(F, F.in[14] + (size_t)j * DFF * DM, 0, 1, DM, DM, 0, DFF, WSP(bf16, WS_WF2), 0, DFFP, 0, 0, 0, Q8_W2);
        zero_block(F, WSP(bf16, WS_WF2), DFFP, 0, DM, DFF, DFFP - DFF);
    } else {
        conv(F, F.in[16] + (size_t)j * NEXP * DM * DFE, (size_t)DM * DFE, NEXP, DFE, DFE, 0, DM, WSP(bf16, WS_WF1), (size_t)NMOE1 * DM, DM, 0, 2, 0, Q8_W1);
        conv(F, F.in[17] + (size_t)j * NEXP * DM * DFE, (size_t)DM * DFE, NEXP, DFE, DFE, 0, DM, WSP(bf16, WS_WF1), (size_t)NMOE1 * DM, DM, 0, 2, 128, Q8_W1);
        conv(F, F.in[18] + (size_t)j * NEXP * DFE * DM, (size_t)DFE * DM, NEXP, DM, DM, 0, DFE, WSP(bf16, WS_WF2), (size_t)DM * DFE, DFE, 0, 0, 0, Q8_W2);
    }
    if (F.bx < 8) {
        __syncthreads();
        const int kv = F.bx >> 2, jj = (F.bx & 3) * 64 + F.lane;
        const float* pos = F.in[6] + (size_t)(layer * 2 + kv) * 2048; const float* w1 = F.in[7] + (size_t)(layer * 2 + kv) * 2048 * 256;
        float a = 0.f;
        float a1 = 0.f, a2 = 0.f, a3 = 0.f;
#pragma unroll 8
        for (int k = 0; k < 256; k += 4) { const int kk = F.wave * 256 + k;
            a += pos[kk] * w1[(size_t)kk * 256 + jj]; a1 += pos[kk + 1] * w1[(size_t)(kk + 1) * 256 + jj]; a2 += pos[kk + 2] * w1[(size_t)(kk + 2) * 256 + jj]; a3 += pos[kk + 3] * w1[(size_t)(kk + 3) * 256 + jj]; }
        a = (a + a1) + (a2 + a3);
        LAS float* red = (LAS float*)(F.lds + RING_OFF);
        red[F.wave * 64 + F.lane] = a;
        __syncthreads();
        if (F.wave == 0) { float s = 0.f;
#pragma unroll
            for (int w = 0; w < 8; ++w) s += red[w * 64 + F.lane];
            WSP(float, WS_BIAS1)[kv * 256 + jj] = s; }
        __syncthreads();
    }
    if (layer == 0) {
        const int gt = (F.vcu * NWAVES + F.wave) * 64 + F.lane, NT = F.G * NWAVES * 64;
        for (int idx = gt; idx < SEQ * 8; idx += NT) { const int pos = idx >> 3, i = idx & 7;
            const double invf = ROPE_INVF[i];
            double rev = (double)pos * invf * 0.15915494309189535; rev -= __builtin_floor(rev);
            WSP(float, WS_ROPE)[idx] = __builtin_amdgcn_cosf((float)rev); WSP(float, WS_ROPE)[SEQ * 8 + idx] = __builtin_amdgcn_sinf((float)rev); }
    }
}

template <int MODE> __device__ __forceinline__ void p_norm(Frame& F, const float* src, const float* g, const float* rw, int jmoe, float q8s = 0.f, int tiled = 0) {
    const int gw = F.vcu * NWAVES + F.wave, NGW = F.G * NWAVES, lane = F.lane;
    LAS int* hist = (LAS int*)(F.lds + TAB_OFF) + 192;
    if (MODE == 1) {
        if (F.tid < 32) hist[F.tid] = 0;
        const int gt = gw * 64 + lane, NT = NGW * 64; int* tm = WSP(int, WS_TOKMAP);
        for (int i = gt; i < 4 * SLOTS; i += NT) tm[i] = -1;
        for (int i = F.tid; i < DM * NEXP / 4; i += NWAVES * 64) *(LAS f32x4*)(F.lds + RING_OFF + 16 * i) = ((const f32x4*)rw)[i];
        __syncthreads();
    }
    f32x4 gv[4];
#pragma unroll
    for (int jx = 0; jx < 4; ++jx) gv[jx] = ((const f32x4*)g)[lane + 64 * jx];
    constexpr int ROWS = (MODE == 1) ? 2 : 4;
    for (int m0 = gw; m0 < MTOK; m0 += ROWS * NGW) {
        f32x4 v[ROWS][4]; float ss[ROWS];
#pragma unroll
        for (int u = 0; u < ROWS; ++u) { const int m = m0 + u * NGW; const f32x4* xr = (const f32x4*)(src + (size_t)(m < MTOK ? m : m0) * DM) + lane;
#pragma unroll
            for (int jx = 0; jx < 4; ++jx) v[u][jx] = xr[64 * jx]; }
#pragma unroll
        for (int u = 0; u < ROWS; ++u) { float s = 0.f;
#pragma unroll
            for (int jx = 0; jx < 4; ++jx) s += (v[u][jx].x * v[u][jx].x + v[u][jx].y * v[u][jx].y) + (v[u][jx].z * v[u][jx].z + v[u][jx].w * v[u][jx].w);
            ss[u] = s; }
#pragma unroll
        for (int o = 1; o < 64; o <<= 1) {
#pragma unroll
            for (int u = 0; u < ROWS; ++u) ss[u] += __builtin_bit_cast(float, __builtin_amdgcn_ds_bpermute((lane ^ o) << 2, __builtin_bit_cast(int, ss[u]))); }
        float lgall[MODE == 1 ? ROWS : 1][8];
        if (MODE == 1) {
            float rs[ROWS];
#pragma unroll
            for (int u = 0; u < ROWS; ++u) { rs[u] = 1.0f / sqrtf(ss[u] * (1.f / DM) + EPS);
#pragma unroll
                for (int e = 0; e < 8; ++e) lgall[u][e] = 0.f; }
#pragma unroll
            for (int jx = 0; jx < 4; ++jx) { const LAS f32x4* wr = (const LAS f32x4*)(F.lds + RING_OFF + (size_t)(4 * lane + 256 * jx) * 32);
#pragma unroll
                for (int r = 0; r < 4; ++r) { const f32x4 a = wr[2 * r], b = wr[2 * r + 1];
#pragma unroll
                    for (int u = 0; u < ROWS; ++u) { const float xv = v[u][jx][r] * rs[u] * gv[jx][r];
                        lgall[u][0] += xv * a.x; lgall[u][1] += xv * a.y; lgall[u][2] += xv * a.z; lgall[u][3] += xv * a.w; lgall[u][4] += xv * b.x; lgall[u][5] += xv * b.y; lgall[u][6] += xv * b.z; lgall[u][7] += xv * b.w; } } }
        }
#pragma unroll
        for (int u = 0; u < ROWS; ++u) { const int m = m0 + u * NGW; if (m >= MTOK) continue;
            const float rstd = 1.0f / sqrtf(ss[u] * (1.f / DM) + EPS);
#pragma unroll
            for (int jx = 0; jx < 4; ++jx) v[u][jx] = v[u][jx] * rstd * gv[jx];
            if (MODE == 2) {
                f32x4* o = (f32x4*)(F.out + (size_t)m * DM) + lane;
#pragma unroll
                for (int jx = 0; jx < 4; ++jx) o[64 * jx] = v[u][jx];
            } else {
                unsigned long long* o8 = (unsigned long long*)(WSP(bf16, WS_HN) + (size_t)m * DM) + lane;
#pragma unroll
                for (int jx = 0; jx < 4; ++jx) { f32x4 w = v[u][jx];
                    if (tiled) { *(unsigned long long*)(WSP(bf16, WS_HN) + toff(m, 4 * lane + 256 * jx, DM)) = (unsigned long long)pk2(w.x, w.y) | ((unsigned long long)pk2(w.z, w.w) << 32); continue; } if (q8s > 0.f) { w.x = q8r(w.x, q8s); w.y = q8r(w.y, q8s); w.z = q8r(w.z, q8s); w.w = q8r(w.w, q8s); }
                    o8[64 * jx] = (unsigned long long)pk2(w.x, w.y) | ((unsigned long long)pk2(w.z, w.w) << 32); }
            }
            if (MODE == 1) {
                float lg[8];
#pragma unroll
                for (int e = 0; e < 8; ++e) lg[e] = lgall[u][e];
                float h4[4], h2[2], h1;
                { const bool up = lane & 1;
#pragma unroll
                  for (int i = 0; i < 4; ++i) { const float keep = up ? lg[4 + i] : lg[i], send = up ? lg[i] : lg[4 + i]; h4[i] = keep + __builtin_bit_cast(float, bperm(lane ^ 1, __builtin_bit_cast(int, send))); } }
                { const bool up = lane & 2;
#pragma unroll
                  for (int i = 0; i < 2; ++i) { const float keep = up ? h4[2 + i] : h4[i], send = up ? h4[i] : h4[2 + i]; h2[i] = keep + __builtin_bit_cast(float, bperm(lane ^ 2, __builtin_bit_cast(int, send))); } }
                { const bool up = lane & 4; const float keep = up ? h2[1] : h2[0], send = up ? h2[0] : h2[1]; h1 = keep + __builtin_bit_cast(float, bperm(lane ^ 4, __builtin_bit_cast(int, send))); }
                h1 += __builtin_bit_cast(float, bperm(lane ^ 8, __builtin_bit_cast(int, h1))); h1 += __builtin_bit_cast(float, bperm(lane ^ 16, __builtin_bit_cast(int, h1))); h1 += __builtin_bit_cast(float, bperm(lane ^ 32, __builtin_bit_cast(int, h1)));
                lg[0] = rdlane(h1, 0); lg[1] = rdlane(h1, 4); lg[2] = rdlane(h1, 2); lg[3] = rdlane(h1, 6); lg[4] = rdlane(h1, 1); lg[5] = rdlane(h1, 5); lg[6] = rdlane(h1, 3); lg[7] = rdlane(h1, 7);
                int e0 = 0; float v0 = lg[0];
#pragma unroll
                for (int e = 1; e < 8; ++e) if (lg[e] > v0) { v0 = lg[e]; e0 = e; }
                int e1 = -1; float v1 = -INFINITY;
#pragma unroll
                for (int e = 0; e < 8; ++e) if (e != e0 && lg[e] > v1) { v1 = lg[e]; e1 = e; }
                const float w0 = 1.0f / (1.0f + fexp(v1 - v0)), w1 = 1.0f - w0;
                if (lane == 0) { WSP(v4i, WS_ROUTE)[m] = (v4i){e0, e1, __builtin_bit_cast(int, w0), __builtin_bit_cast(int, w1)};
                    const int c = m / MC; if (!F.rep) { atomicAdd((int*)&hist[(c * 2 + 0) * 8 + e0], 1); atomicAdd((int*)&hist[(c * 2 + 1) * 8 + e1], 1); } }
            }
        }
    }
    if (MODE == 1) {
        __syncthreads();
        if (F.tid < 32) { const int h = hist[F.tid]; if (h) atomicAdd(F.ctl + CW_CNT + jmoe * 32 + F.tid, (unsigned)h); }
    }
}

__device__ __forceinline__ void p_prep(Frame& F) {
    const int gw = F.vcu * NWAVES + F.wave, NGW = F.G * NWAVES, lane = F.lane;
    bf16* P1 = WSP(bf16, WS_P1); bf16* KVC = WSP(bf16, WS_KVC); const float* rope = WSP(float, WS_ROPE);
    const int vec = lane >> 3, ri = lane & 7; const int cb = vec < 4 ? C_CQ + vec * 64 : (vec == 4 ? C_KCMP : (vec == 5 ? C_KSLC : C_KWIN));
    for (int row0 = gw; row0 < MC; row0 += 4 * NGW) {
        float x1[4], x2[4], cc[4], ss[4]; bf16 kc48[4], vc64[4];
#pragma unroll
        for (int k = 0; k < 4; ++k) { const int row = row0 + k * NGW < MC ? row0 + k * NGW : row0; const bf16* p = P1 + (size_t)row * P1W; const int pos = row & (SEQ - 1);
            const int cl = lane < 56 ? cb + ri : C_CQ;
            x1[k] = bf1(p[cl]); x2[k] = bf1(p[cl + 8]); cc[k] = rope[pos * 8 + ri]; ss[k] = rope[SEQ * 8 + pos * 8 + ri];
            if (F.rep) { cc[k] = 1.f; ss[k] = 0.f; }
            kc48[k] = p[C_KCMP + 16 + (lane < 48 ? lane : 0)]; vc64[k] = p[C_VCMP + lane]; }
#pragma unroll
        for (int k = 0; k < 4; ++k) { const int row = row0 + k * NGW; if (row >= MC) continue; bf16* p = P1 + (size_t)row * P1W;
            if (lane < 56) { const bf16 o1 = (bf16)f2bf(x1[k] * cc[k] - x2[k] * ss[k]), o2 = (bf16)f2bf(x2[k] * cc[k] + x1[k] * ss[k]);
                p[cb + ri] = o1; p[cb + ri + 8] = o2;
                if (vec == 4) { KVC[(size_t)row * 64 + ri] = o1; KVC[(size_t)row * 64 + ri + 8] = o2; } }
            if (lane < 48) KVC[(size_t)row * 64 + 16 + lane] = kc48[k];
            KVC[(size_t)MC * 64 + (size_t)row * 64 + lane] = vc64[k]; }
    }
    bf16* VT = WSP(bf16, WS_VT);
    for (int it = gw; it < 6 * BC * 64; it += NGW) { const int which = it / (BC * 64), r = it % (BC * 64), b = r >> 6, blk = r & 63;
        const v4u* src = (const v4u*)(P1 + ((size_t)b * SEQ + blk * 64 + lane) * P1W + (which == 0 ? C_VSLC : (which == 1 ? C_VWIN : C_SBV + (which - 2) * 64)));
        bf16* dst = VT + ((size_t)(which * BC + b) * 64) * SEQ + blk * 64 + lane;
        v4u xs[8];
#pragma unroll
        for (int i = 0; i < 8; ++i) xs[i] = src[i];
#pragma unroll
        for (int i = 0; i < 8; ++i) { const v4u x = xs[i];
            dst[(size_t)(8 * i + 0) * SEQ] = (bf16)(x.x & 0xffffu); dst[(size_t)(8 * i + 1) * SEQ] = (bf16)(x.x >> 16);
            dst[(size_t)(8 * i + 2) * SEQ] = (bf16)(x.y & 0xffffu); dst[(size_t)(8 * i + 3) * SEQ] = (bf16)(x.y >> 16);
            dst[(size_t)(8 * i + 4) * SEQ] = (bf16)(x.z & 0xffffu); dst[(size_t)(8 * i + 5) * SEQ] = (bf16)(x.z >> 16);
            dst[(size_t)(8 * i + 6) * SEQ] = (bf16)(x.w & 0xffffu); dst[(size_t)(8 * i + 7) * SEQ] = (bf16)(x.w >> 16); }
    }
}
__device__ __forceinline__ void p_sgu(Frame& F, int layer) {
    LAS float* vn = (LAS float*)(F.lds + RING_OFF);
    const bf16* P1 = WSP(bf16, WS_P1); bf16* Ya = WSP(bf16, WS_Y);
    const float* gain = F.in[3] + (size_t)layer * 256; const float* sw = F.in[4] + (size_t)layer * 4 * 128 * 128; const float* sb = F.in[5] + (size_t)layer * 4 * 128;
    const int lane = F.lane, wave = F.wave;
    for (int item = F.vcu; item < MC / 128; item += F.G) {
        const size_t r0 = (size_t)item * 128;
        __syncthreads();
        for (int rr = 0; rr < 16; ++rr) { const int r = wave * 16 + rr; const v2u raw = *(const v2u*)(P1 + (r0 + r) * P1W + C_V + 4 * lane);
            const float a = bflo(raw.x), b = bfhi(raw.x), c = bflo(raw.y), d = bfhi(raw.y);
            const float rstd = 1.0f / sqrtf(wave_sum((a * a + b * b) + (c * c + d * d), lane) * (1.f / 256.f) + EPS);
            const f32x4 gg = ((const f32x4*)gain)[lane];
            *(LAS f32x4*)(vn + r * 256 + 4 * lane) = (f32x4){a * rstd * gg.x, b * rstd * gg.y, c * rstd * gg.z, d * rstd * gg.w}; }
        __syncthreads();
        const int g = wave & 3, half = wave >> 2;
        for (int i = 0; i < 64; ++i) { const int t = 2 * i + half;
            const float* wrow = sw + ((size_t)g * 128 + t) * 128;
            const float w_lo = wrow[lane], w_hi = wrow[64 + lane];
            float acc = 0.f;
            for (int s = 0; s <= t; ++s) { const float w = (s < 64) ? rdlane(w_lo, s) : rdlane(w_hi, s - 64); acc += w * vn[s * 256 + g * 64 + lane]; }
            const float u = bf1(P1[(r0 + t) * P1W + C_U + g * 64 + lane]);
#ifdef ABL_SGUMIX
            acc = 0.f;
#endif
            Ya[(r0 + t) * 256 + g * 64 + lane] = (bf16)f2bf(u * (acc + sb[g * 128 + t])); }
    }
    __syncthreads();
}

__device__ __forceinline__ void p_cmpfin(Frame& F, int layer) {
    const int gw = F.vcu * NWAVES + F.wave, NGW = F.G * NWAVES, lane = F.lane;
    const float* UL = WSP(float, WS_UL); const float* bias = WSP(float, WS_BIAS1); bf16* KC = WSP(bf16, WS_KC);
    LAS float* w2l = (LAS float*)(F.lds + RING_OFF);
    __syncthreads();
    { const f32x4* src = (const f32x4*)(F.in[8] + (size_t)layer * 2 * 256 * 64);
#pragma unroll 4
      for (int i = F.tid; i < 2 * 256 * 64 / 4; i += NWAVES * 64) *(LAS f32x4*)(w2l + 4 * i) = src[i]; }
    __syncthreads();
    for (int it = gw; it < 2 * BC * 255; it += NGW) { const int kv = it / (BC * 255), r = it % (BC * 255), b = r / 255, m = r % 255;
        const LAS float* w2 = w2l + kv * 256 * 64;
        const float* U = UL + (size_t)(kv * 2048 + b * 256 + m) * 512; const float* L = U + 512 + 256;
        float hv[4];
#pragma unroll
        for (int q = 0; q < 4; ++q) hv[q] = pg8::gelu_tanh(U[64 * q + lane] + L[64 * q + lane] + bias[kv * 256 + 64 * q + lane]);
        float acc0 = 0.f, acc1 = 0.f;
#pragma unroll
        for (int q = 0; q < 4; ++q)
#pragma unroll 8
            for (int jj = 0; jj < 64; jj += 2) { acc0 += rdlane(hv[q], jj) * w2[(64 * q + jj) * 64 + lane]; acc1 += rdlane(hv[q], jj + 1) * w2[(64 * q + jj + 1) * 64 + lane]; }
        const float acc = acc0 + acc1;
        KC[((size_t)(kv * BC + b) * 256 + m) * 64 + lane] = (bf16)f2bf(acc);
        if (kv == 1) { WSP(bf16, WS_KCT)[((size_t)b * 64 + lane) * 256 + m] = (bf16)f2bf(acc); if (m == 254) WSP(bf16, WS_KCT)[((size_t)b * 64 + lane) * 256 + 255] = (bf16)0; }
        else if (m == 254) KC[((size_t)b * 256 + 255) * 64 + lane] = (bf16)0; }
    __syncthreads();
}

__device__ __forceinline__ void p_stick(Frame& F) {
    const int gw = F.vcu * NWAVES + F.wave, NGW = F.G * NWAVES, lane = F.lane;
    const bf16* P1 = WSP(bf16, WS_P1); bf16* Yb = WSP(bf16, WS_Y) + (size_t)MC * 256;
    for (int item = gw; item < BC * 4 * 64; item += NGW) { const int tb = item & 63, h = (item >> 6) & 3, b = item >> 8;
        const int t = tb * 64 + lane; const size_t row = (size_t)b * SEQ + t;
        unsigned q[32];
        { const v4u* qp = (const v4u*)(P1 + row * P1W + C_SBQ + h * 64);
#pragma unroll
          for (int i = 0; i < 8; ++i) { const v4u x = qp[i]; q[4 * i] = x.x; q[4 * i + 1] = x.y; q[4 * i + 2] = x.z; q[4 * i + 3] = x.w; } }
        float o[64];
#pragma unroll
        for (int d = 0; d < 64; ++d) o[d] = 0.f;
        float R = 0.f;
        const bf16* kb = P1 + (size_t)b * SEQ * P1W + C_SBK + h * 64; const bf16* vb = P1 + (size_t)b * SEQ * P1W + C_SBV + h * 64;
        for (int s = t - 1; s >= 0; --s) {
            if (R < -100.f) break;
            const v4u* kp = (const v4u*)(kb + (size_t)s * P1W); const v4u* vp = (const v4u*)(vb + (size_t)s * P1W);
            float z0 = 0.f, z1 = 0.f;
#pragma unroll
            for (int i = 0; i < 8; ++i) { const v4u k = kp[i]; z0 = dot2bf(k.x, q[4 * i], z0); z1 = dot2bf(k.y, q[4 * i + 1], z1); z0 = dot2bf(k.z, q[4 * i + 2], z0); z1 = dot2bf(k.w, q[4 * i + 3], z1); }
            const float z = (z0 + z1) * 0.125f;
            const float tt = 0.6931471805599453f * __builtin_amdgcn_logf(1.0f + fexp(-__builtin_fabsf(z)));
            const float lb = fminf(z, 0.f) - tt, l1m = fminf(-z, 0.f) - tt;
            const float a = fexp(lb + R); R += l1m;
#pragma unroll
            for (int i = 0; i < 8; ++i) { const v4u v = vp[i];
                o[8 * i] += a * bflo(v.x); o[8 * i + 1] += a * bfhi(v.x); o[8 * i + 2] += a * bflo(v.y); o[8 * i + 3] += a * bfhi(v.y);
                o[8 * i + 4] += a * bflo(v.z); o[8 * i + 5] += a * bfhi(v.z); o[8 * i + 6] += a * bflo(v.w); o[8 * i + 7] += a * bfhi(v.w); }
        }
        v4u* op = (v4u*)(Yb + row * 256 + h * 64);
#pragma unroll
        for (int i = 0; i < 8; ++i) op[i] = (v4u){pk2(o[8 * i], o[8 * i + 1]), pk2(o[8 * i + 2], o[8 * i + 3]), pk2(o[8 * i + 4], o[8 * i + 5]), pk2(o[8 * i + 6], o[8 * i + 7])};
    }
}

struct Soft { float mx, l; };
__device__ __forceinline__ float dotq(const LAS v4u* ql, const bf16* kp_) {
    const v4u* kp = (const v4u*)kp_; float z0 = 0.f, z1 = 0.f;
#pragma unroll
    for (int i = 0; i < 8; ++i) { const v4u k = kp[i]; const v4u q = ql[i]; z0 = dot2bf(k.x, q.x, z0); z1 = dot2bf(k.y, q.y, z1); z0 = dot2bf(k.z, q.z, z0); z1 = dot2bf(k.w, q.w, z1); }
    return (z0 + z1) * 0.125f;
}
__device__ __forceinline__ void axpy_row(float p, const bf16* vp_, float (&o)[64]) {
    const v4u* vp = (const v4u*)vp_;
#pragma unroll
    for (int i = 0; i < 8; ++i) { const v4u v = vp[i];
        o[8 * i] += p * bflo(v.x); o[8 * i + 1] += p * bfhi(v.x); o[8 * i + 2] += p * bflo(v.y); o[8 * i + 3] += p * bfhi(v.y);
        o[8 * i + 4] += p * bflo(v.z); o[8 * i + 5] += p * bfhi(v.z); o[8 * i + 6] += p * bflo(v.w); o[8 * i + 7] += p * bfhi(v.w); }
}
__device__ __forceinline__ void nsa_step(const LAS v4u* ql, const bf16* kp_, const bf16* vp_, Soft& S, float (&o)[64]) {
    const float s = dotq(ql, kp_);
    if (s > S.mx) { const float sc = fexp(S.mx - s); S.l *= sc;
#pragma unroll
        for (int d = 0; d < 64; ++d) o[d] *= sc;
        S.mx = s; }
    const float p = fexp(s - S.mx); S.l += p;
    asm volatile("" ::: "memory");
    axpy_row(p, vp_, o);
}
__device__ __forceinline__ void nsa_accum(bf16* yrow, bool first, float sc, const float (&o)[64]) {
    v4u* op = (v4u*)yrow;
#pragma unroll
    for (int i = 0; i < 8; ++i) { v4u old = (v4u){0u, 0u, 0u, 0u}; if (!first) old = op[i];
        op[i] = (v4u){pk2(bflo(old.x) + sc * o[8 * i], bfhi(old.x) + sc * o[8 * i + 1]), pk2(bflo(old.y) + sc * o[8 * i + 2], bfhi(old.y) + sc * o[8 * i + 3]),
                      pk2(bflo(old.z) + sc * o[8 * i + 4], bfhi(old.z) + sc * o[8 * i + 5]), pk2(bflo(old.w) + sc * o[8 * i + 6], bfhi(old.w) + sc * o[8 * i + 7])}; }
}
__device__ __forceinline__ void p_nsa(Frame& F) {
    const int gw = F.vcu * NWAVES + F.wave, NGW = F.G * NWAVES, lane = F.lane;
    const bf16* P1 = WSP(bf16, WS_P1); const bf16* KC = WSP(bf16, WS_KC); bf16* Yc = WSP(bf16, WS_Y) + (size_t)2 * MC * 256;
    LAS float* imp = (LAS float*)(F.lds + RING_OFF + F.wave * 4096);
    LAS v4u* ql = (LAS v4u*)(F.lds + RING_OFF + 32768 + F.wave * 9216 + lane * 144);
    const int qi = lane >> 2, h = lane & 3;
    for (int item = gw; item < BC * 256; item += NGW) { const int b = item >> 8, tg = item & 255;
        const int t = tg * 16 + qi; const size_t row = (size_t)b * SEQ + t; const bf16* prow = P1 + row * P1W;
        { const v4u* qp = (const v4u*)(prow + C_CQ + h * 64);
#pragma unroll
          for (int i = 0; i < 8; ++i) ql[i] = qp[i]; }
        const float g0 = bf1(prow[C_CG + h * 3]), g1 = bf1(prow[C_CG + h * 3 + 1]), g2 = bf1(prow[C_CG + h * 3 + 2]);
        bf16* yrow = Yc + row * 256 + h * 64;
        float o[64];
        for (int i = lane; i < 1024; i += 64) imp[i] = 0.f;
        const int nv = t >= 31 ? ((t - 31) >> 4) + 1 : 0; const int nvmax = (tg * 16 + 15 >= 31) ? ((tg * 16 + 15 - 31) >> 4) + 1 : 0;
        const bf16* kc = KC + (size_t)(0 * BC + b) * 256 * 64; const bf16* vc = KC + (size_t)(1 * BC + b) * 256 * 64;
        { float mx = -INFINITY, l = 0.f;
          for (int m = 0; m < nvmax; ++m) { const float s = dotq(ql, kc + m * 64); if (m < nv) { if (s > mx) { l *= fexp(mx - s); mx = s; } l += fexp(s - mx); } }
          const float rl = l > 0.f ? 1.0f / l : 0.f;
#pragma unroll
          for (int d = 0; d < 64; ++d) o[d] = 0.f;
          for (int m = 0; m < nvmax; ++m) { const float s = dotq(ql, kc + m * 64); const float p = (m < nv) ? fexp(s - mx) * rl : 0.f;
              asm volatile("" ::: "memory");
              axpy_row(p, vc + m * 64, o);
              float P = p + __builtin_bit_cast(float, bperm(lane ^ 1, __builtin_bit_cast(int, p))); P += __builtin_bit_cast(float, bperm(lane ^ 2, __builtin_bit_cast(int, P)));
              if (h == 0) { const int j0 = m >> 2; const bool edge = (m & 3) == 3; imp[qi * 64 + j0] += edge ? 0.5f * P : P; if (edge) imp[qi * 64 + j0 + 1] += 0.5f * P; } }
          nsa_accum(yrow, true, g0, o); }
        unsigned long long mask = 0ull;
        { const int cur = t >> 6, nvb = cur + 1;
          if (h == 0) {
              if (nvb <= 16) mask = (1ull << nvb) - 1ull;
              else { mask = 1ull | (1ull << cur);
                  for (int r = 0; r < 14; ++r) { int best = -1; float bv = -1.f;
                      for (int j = 1; j < cur; ++j) { const float v = imp[qi * 64 + j]; if (!((mask >> j) & 1ull) && v > bv) { bv = v; best = j; } }
                      mask |= 1ull << best; } } }
          const unsigned mlo = (unsigned)bperm(lane & ~3, (int)(unsigned)mask), mhi = (unsigned)bperm(lane & ~3, (int)(unsigned)(mask >> 32));
          mask = ((unsigned long long)mhi << 32) | mlo; }
        { Soft S{-INFINITY, 0.f};
#pragma unroll
          for (int d = 0; d < 64; ++d) o[d] = 0.f;
          const bf16* kb = P1 + (size_t)b * SEQ * P1W + C_KSLC; const bf16* vb = P1 + (size_t)b * SEQ * P1W + C_VSLC;
          unsigned long long mm = mask;
          while (mm) { const int j = __builtin_ctzll(mm); mm &= mm - 1ull;
              for (int kk = 0; kk < 64; ++kk) { const int sp = j * 64 + kk; if (sp > t) break; nsa_step(ql, kb + (size_t)sp * P1W, vb + (size_t)sp * P1W, S, o); } }
          nsa_accum(yrow, false, g1 / S.l, o); }
        { Soft S{-INFINITY, 0.f};
#pragma unroll
          for (int d = 0; d < 64; ++d) o[d] = 0.f;
          const bf16* kb = P1 + (size_t)b * SEQ * P1W + C_KWIN; const bf16* vb = P1 + (size_t)b * SEQ * P1W + C_VWIN;
          for (int i = 0; i < 512; ++i) { const int sp = t - 511 + i; if (sp >= 0) nsa_step(ql, kb + (size_t)sp * P1W, vb + (size_t)sp * P1W, S, o); }
          nsa_accum(yrow, false, g2 / S.l, o); }
    }
}

__device__ __forceinline__ int moe_table(Frame& F, int jmoe, int c, int r) {
    LAS int* tab = (LAS int*)(F.lds + TAB_OFF);
    __syncthreads();
    if (F.tid < 8) tab[176 + F.tid] = (int)__hip_atomic_load(F.ctl + CW_CNT + jmoe * 32 + (c * 2 + r) * 8 + F.tid, __ATOMIC_RELAXED, __HIP_MEMORY_SCOPE_AGENT);
    __syncthreads();
    if (F.tid == 0) { int base = 0, T = 0;
        for (int e = 0; e < 8; ++e) { const int cnt = tab[176 + e];
            const int nt = (cnt + 255) >> 8; tab[160 + e] = base; for (int i = 0; i < nt && T + i < 160; ++i) tab[T + i] = e; T += nt; base += nt * 256; }
        tab[168] = T < 136 ? T : 136; }
    __syncthreads();
    return tab[168];
}
__device__ __forceinline__ void p_gather(Frame& F, int jmoe, int c, int r, int nbusy = 0) {
    if (F.bx < nbusy) return;
    moe_table(F, jmoe, c, r);
    LAS int* tab = (LAS int*)(F.lds + TAB_OFF); LAS int* cntw = tab + 256; LAS int* basew = tab + 320;
    const int lane = F.lane, wave = F.wave;
    const v4i* route = WSP(v4i, WS_ROUTE); int* tokmap = WSP(int, WS_TOKMAP) + (c * 2 + r) * SLOTS; float* wslot = WSP(float, WS_WSLOT) + (c * 2 + r) * SLOTS;
    const bf16* HN = WSP(bf16, WS_HN); bf16* XG = WSP(bf16, WS_XG);
    unsigned* cur = F.ctl + CW_CUR + jmoe * 32 + (c * 2 + r) * 8;
    for (int ch = F.bx - nbusy; ch < MC / 128; ch += F.G - nbusy) {
        const int m = c * MC + ch * 128 + wave * 16 + (lane & 15); const v4i rt = route[m];
        const int e = lane < 16 ? (r ? rt.y : rt.x) : -1; const float w = __builtin_bit_cast(float, r ? rt.w : rt.z);
        unsigned long long bal[8]; int mycnt = 0;
#pragma unroll
        for (int ee = 0; ee < 8; ++ee) { bal[ee] = __builtin_amdgcn_ballot_w64(e == ee); if (lane == ee) mycnt = __builtin_popcountll(bal[ee]); }
        __syncthreads();
        if (lane < 8) cntw[wave * 8 + lane] = mycnt;
        __syncthreads();
        if (wave == 0 && lane < 8) { int tot = 0;
#pragma unroll
            for (int w8 = 0; w8 < 8; ++w8) tot += cntw[w8 * 8 + lane];
            int base = tot > 0 ? (int)atomicAdd(cur + lane, (unsigned)tot) : 0;
#pragma unroll
            for (int w8 = 0; w8 < 8; ++w8) { basew[w8 * 8 + lane] = base; base += cntw[w8 * 8 + lane]; } }
        __syncthreads();
        int pos = 0;
#pragma unroll
        for (int ee = 0; ee < 8; ++ee) if (e == ee) pos = basew[wave * 8 + ee] + __builtin_popcountll(bal[ee] & ((1ull << lane) - 1ull));
        int slot = 0;
        if (lane < 16) { slot = tab[160 + e] + pos; tokmap[slot] = m; wslot[slot] = w; }
#pragma unroll
        for (int i0 = 0; i0 < 16; i0 += 4) { v4u x[8];
#pragma unroll
            for (int i = 0; i < 4; ++i) { const int mi = __builtin_amdgcn_readlane(m, i0 + i); const v4u* src = (const v4u*)(HN + (size_t)mi * DM); x[2 * i] = src[lane]; x[2 * i + 1] = src[64 + lane]; }
#pragma unroll
            for (int i = 0; i < 4; ++i) { const int si = __builtin_amdgcn_readlane(slot, i0 + i); v4u* dst = (v4u*)(XG + (size_t)si * DM); dst[lane] = x[2 * i]; dst[64 + lane] = x[2 * i + 1]; } }
    }
}

typedef float f32x16 __attribute__((ext_vector_type(16)));
typedef short bf16x8v __attribute__((ext_vector_type(8)));
typedef float f32x2v __attribute__((ext_vector_type(2)));
constexpr int NSA_K = 0, NSA_V = 8192, NSA_BUF = 17408, NSA_STAGE = 2 * NSA_BUF, NSA_IMP = 69632, NSA_CARRY = 86016, NSA_SEL = 103424, NSA_WSF = 103936;
constexpr int NSA_VP = 136;
constexpr float NSA_C2 = 0.125f * 1.4426950408889634f;
__device__ __forceinline__ unsigned cvtpk(float lo, float hi) { f32x2v v = {lo, hi}; bf16x2_t b = __builtin_convertvector(v, bf16x2_t); return __builtin_bit_cast(unsigned, b); }
__device__ __forceinline__ float partner32(float v, int lane) { return __builtin_bit_cast(float, __builtin_amdgcn_ds_bpermute((lane ^ 32) << 2, __builtin_bit_cast(int, v))); }
__device__ __forceinline__ void nsa_load(v4u& kx, v4u& vx, const bf16* Kg, int kp, const bf16* Vg, int vp, int tid) {
    kx = *(const v4u*)(Kg + (size_t)(tid & 63) * kp + (tid >> 6) * 8); vx = *(const v4u*)(Vg + (size_t)(tid >> 3) * vp + (tid & 7) * 8);
}
__device__ __forceinline__ void nsa_store(LAS unsigned char* lds, const v4u& kx, const v4u& vx, int tid) {
    *(LAS v4u*)(lds + NSA_K + (tid >> 6) * 1024 + (tid & 63) * 16) = kx; { LAS v2u* vd = (LAS v2u*)(lds + NSA_V + (tid >> 3) * NSA_VP + (tid & 7) * 16); vd[0] = (v2u){vx.x, vx.y}; vd[1] = (v2u){vx.z, vx.w}; }
}
__device__ __forceinline__ void nsa_qk(const LAS unsigned char* lds, const bf16x8v (&qr)[4], f32x16& p0, f32x16& p1, int r32, int hi) {
#pragma unroll
    for (int i = 0; i < 16; ++i) { p0[i] = 0.f; p1[i] = 0.f; }
#pragma unroll
    for (int d0 = 0; d0 < 4; ++d0) {
        const bf16x8v k0 = *(const LAS bf16x8v*)(lds + NSA_K + (2 * d0 + hi) * 1024 + r32 * 16);
        const bf16x8v k1 = *(const LAS bf16x8v*)(lds + NSA_K + (2 * d0 + hi) * 1024 + 512 + r32 * 16);
        p0 = __builtin_amdgcn_mfma_f32_32x32x16_bf16(k0, qr[d0], p0, 0, 0, 0);
        p1 = __builtin_amdgcn_mfma_f32_32x32x16_bf16(k1, qr[d0], p1, 0, 0, 0);
    }
}
__device__ __forceinline__ void nsa_mask(f32x16& p0, f32x16& p1, int hi, int hiL, int loL) {
#pragma unroll
    for (int i = 0; i < 16; ++i) { const int kk = (i & 3) + 8 * (i >> 2) + 4 * hi;
        if (!(kk <= hiL && kk > loL)) p0[i] = -INFINITY;
        if (!(kk + 32 <= hiL && kk + 32 > loL)) p1[i] = -INFINITY; }
}
__device__ __forceinline__ float nsa_max32(const f32x16& p0, const f32x16& p1) {
    float a = fmaxf(fmaxf(p0[0], p0[1]), p1[0]), b = fmaxf(fmaxf(p0[2], p0[3]), p1[1]); a = fmaxf(fmaxf(a, p1[2]), p1[3]);
#pragma unroll
    for (int i = 4; i < 16; i += 4) { a = fmaxf(fmaxf(a, p0[i]), p0[i + 1]); b = fmaxf(fmaxf(b, p0[i + 2]), p0[i + 3]); a = fmaxf(fmaxf(a, p1[i]), p1[i + 1]); b = fmaxf(fmaxf(b, p1[i + 2]), p1[i + 3]); }
    return fmaxf(a, b);
}
__device__ __forceinline__ void nsa_pv(const LAS unsigned char* lds, const f32x16& p0, const f32x16& p1, f32x16 (&o)[2], int r32, int hi) {
    bf16x8v pa[4];
#pragma unroll
    for (int s = 0; s < 2; ++s) {
        const v4u a = (v4u){cvtpk(p0[8 * s], p0[8 * s + 1]), cvtpk(p0[8 * s + 2], p0[8 * s + 3]), cvtpk(p0[8 * s + 4], p0[8 * s + 5]), cvtpk(p0[8 * s + 6], p0[8 * s + 7])};
        const v4u b = (v4u){cvtpk(p1[8 * s], p1[8 * s + 1]), cvtpk(p1[8 * s + 2], p1[8 * s + 3]), cvtpk(p1[8 * s + 4], p1[8 * s + 5]), cvtpk(p1[8 * s + 6], p1[8 * s + 7])};
        pa[s] = __builtin_bit_cast(bf16x8v, a); pa[2 + s] = __builtin_bit_cast(bf16x8v, b); }
#pragma unroll
    for (int db = 0; db < 2; ++db) { const LAS unsigned char* vrow = lds + NSA_V + (32 * db + r32) * NSA_VP;
#pragma unroll
        for (int ks = 0; ks < 4; ++ks) {
            const int kb = (ks >> 1) * 32 + (ks & 1) * 16 + 4 * hi;
            const v2u lo = *(const LAS v2u*)(vrow + kb * 2), hh = *(const LAS v2u*)(vrow + (kb + 8) * 2);
            const v4u vv = (v4u){lo.x, lo.y, hh.x, hh.y};
            o[db] = __builtin_amdgcn_mfma_f32_32x32x16_bf16(pa[ks], __builtin_bit_cast(bf16x8v, vv), o[db], 0, 0, 0); } }
}
__device__ __forceinline__ void nsa_rowscale(f32x16 (&o)[2], LAS float* wsf, float f, int r32, int hi) {
    if (hi == 0) wsf[r32] = f;
#pragma unroll
    for (int g = 0; g < 4; ++g) { const f32x4 w = *(const LAS f32x4*)(wsf + 8 * g + 4 * hi);
#pragma unroll
        for (int e = 0; e < 4; ++e) { o[0][4 * g + e] *= w[e]; o[1][4 * g + e] *= w[e]; } }
}
__device__ __forceinline__ void nsa_rowaccum(bf16* dst, bool first, const f32x16 (&o)[2], LAS float* wsf, float f, int r32, int hi) {
    if (hi == 0) wsf[r32] = f;
    bf16 old[32];
#pragma unroll
    for (int i = 0; i < 16; ++i) { const bf16* p = dst + (i >> 2) * 512 + (i & 3) * 64; old[2 * i] = first ? (bf16)0 : p[0]; old[2 * i + 1] = first ? (bf16)0 : p[32]; }
#pragma unroll
    for (int g = 0; g < 4; ++g) { const f32x4 w = *(const LAS f32x4*)(wsf + 8 * g + 4 * hi);
#pragma unroll
        for (int e = 0; e < 4; ++e) { bf16* p = dst + g * 512 + e * 64; const int i = 4 * g + e;
            p[0] = (bf16)f2bf(o[0][i] * w[e] + bf1(old[2 * i])); p[32] = (bf16)f2bf(o[1][i] * w[e] + bf1(old[2 * i + 1])); } }
}
__device__ __forceinline__ void nsa_softmax_pv(const LAS unsigned char* lds, f32x16& p0, f32x16& p1, float& m, float& l, f32x16 (&o)[2], LAS float* wsf, int lane, int r32, int hi, bool rowok) {
    float mt = nsa_max32(p0, p1); mt = rowok ? mt : -INFINITY; mt = fmaxf(mt, partner32(mt, lane));
    const float mn = fmaxf(m, mt);
    if (__builtin_amdgcn_ballot_w64(mn > m) != 0ull) { const float f = __builtin_amdgcn_exp2f((m - mn) * NSA_C2); l *= f; nsa_rowscale(o, wsf, f, r32, hi); m = mn; }
    const float off = rowok ? -m * NSA_C2 : -INFINITY;
    float s = 0.f;
#pragma unroll
    for (int i = 0; i < 16; ++i) { p0[i] = __builtin_amdgcn_exp2f(__builtin_fmaf(p0[i], NSA_C2, off)); p1[i] = __builtin_amdgcn_exp2f(__builtin_fmaf(p1[i], NSA_C2, off)); s += p0[i] + p1[i]; }
    l += s;
    nsa_pv(lds, p0, p1, o, r32, hi);
}
__device__ __forceinline__ void p_nsa2(Frame& F) {
    const int tid = F.tid, lane = F.lane, wave = F.wave, r32 = lane & 31, hi = lane >> 5;
    LAS unsigned char* lds = F.lds + RING_OFF;
    LAS float* imp = (LAS float*)(lds + NSA_IMP); LAS float* carry = (LAS float*)(lds + NSA_CARRY);
    LAS unsigned long long* selm = (LAS unsigned long long*)(lds + NSA_SEL); LAS float* wsf = (LAS float*)(lds + NSA_WSF) + wave * 32;
    const bf16* P1 = WSP(bf16, WS_P1); const bf16* KC = WSP(bf16, WS_KC); const bf16* KCT = WSP(bf16, WS_KCT); const bf16* VT = WSP(bf16, WS_VT);
    bf16* Yc = WSP(bf16, WS_Y) + (size_t)2 * MC * 256;
    const int ql = r32 >> 2, h = r32 & 3, tq = 8 * wave + ql;
    int par = 0;
    for (int it = 0; it < 2; ++it) {
        for (int pair = F.vcu; pair < BC * 32; pair += F.G) {
            const int b = pair >> 5, sx = pair & 31, qb = it ? 63 - sx : sx;
            const int t = qb * 64 + tq; const size_t row = (size_t)b * SEQ + t; const bf16* prow = P1 + row * P1W;
            bf16x8v qr[4];
#pragma unroll
            for (int d0 = 0; d0 < 4; ++d0) qr[d0] = *(const bf16x8v*)(prow + C_CQ + h * 64 + d0 * 16 + hi * 8);
            const float g0 = bf1(prow[C_CG + h * 3]), g1 = bf1(prow[C_CG + h * 3 + 1]), g2 = bf1(prow[C_CG + h * 3 + 2]);
            f32x16 o[2], p0, p1;
            bf16* ydst = Yc + ((size_t)b * SEQ + qb * 64 + 8 * wave + hi) * 256 + r32;
            __syncthreads();
            for (int i = tid; i < 64 * 64; i += 512) imp[i] = 0.f;
            for (int i = tid; i < 64 * 68; i += 512) carry[i] = 0.f;
            const int nct = (4 * qb + 3 + 63) >> 6;
            const int mlim = t >= 31 ? ((t - 31) >> 4) : -1;
            const bf16* kcb = KC + (size_t)b * 256 * 64; const bf16* vcb = KCT + (size_t)b * 64 * 256;
            float m = -1e30f, l = 0.f;
            v4u kx, vx;
            nsa_load(kx, vx, kcb, 64, vcb, 256, tid);
            for (int ti = 0; ti < nct; ++ti) {
                LAS unsigned char* tb = lds + par * NSA_STAGE; par ^= 1;
                nsa_store(tb, kx, vx, tid); __syncthreads();
                { const int tn = ti + 1 < nct ? ti + 1 : 0; nsa_load(kx, vx, kcb + (size_t)tn * 64 * 64, 64, vcb + tn * 64, 256, tid); }
                nsa_qk(tb, qr, p0, p1, r32, hi); nsa_mask(p0, p1, hi, mlim - 64 * ti, -1);
                float mt = nsa_max32(p0, p1); mt = fmaxf(mt, partner32(mt, lane));
                const float mn = fmaxf(m, mt); l *= __builtin_amdgcn_exp2f((m - mn) * NSA_C2); m = mn;
                const float off = -m * NSA_C2; float s = 0.f;
#pragma unroll
                for (int i = 0; i < 16; ++i) s += __builtin_amdgcn_exp2f(__builtin_fmaf(p0[i], NSA_C2, off)) + __builtin_amdgcn_exp2f(__builtin_fmaf(p1[i], NSA_C2, off));
                l += s; }
            { const float lt = l + partner32(l, lane); const float rl = lt > 0.f ? 1.0f / lt : 0.f;
#pragma unroll
              for (int i = 0; i < 16; ++i) { o[0][i] = 0.f; o[1][i] = 0.f; }
              for (int ti = 0; ti < nct; ++ti) {
                  LAS unsigned char* tb = lds + par * NSA_STAGE; par ^= 1;
                  nsa_store(tb, kx, vx, tid); __syncthreads();
                  if (ti + 1 < nct) nsa_load(kx, vx, kcb + (size_t)(ti + 1) * 64 * 64, 64, vcb + (ti + 1) * 64, 256, tid);
                  nsa_qk(tb, qr, p0, p1, r32, hi); nsa_mask(p0, p1, hi, mlim - 64 * ti, -1);
                  { const float off = -m * NSA_C2;
#pragma unroll
                    for (int i = 0; i < 16; ++i) { p0[i] = __builtin_amdgcn_exp2f(__builtin_fmaf(p0[i], NSA_C2, off)) * rl; p1[i] = __builtin_amdgcn_exp2f(__builtin_fmaf(p1[i], NSA_C2, off)) * rl; } }
#pragma unroll
                  for (int kt = 0; kt < 2; ++kt)
#pragma unroll
                      for (int g = 0; g < 4; ++g) { const f32x16& pp = kt ? p1 : p0;
                          float A = pp[4 * g] + pp[4 * g + 1] + pp[4 * g + 2] + 0.5f * pp[4 * g + 3], B = 0.5f * pp[4 * g + 3];
                          A += __builtin_bit_cast(float, bperm(lane ^ 1, __builtin_bit_cast(int, A))); A += __builtin_bit_cast(float, bperm(lane ^ 2, __builtin_bit_cast(int, A)));
                          B += __builtin_bit_cast(float, bperm(lane ^ 1, __builtin_bit_cast(int, B))); B += __builtin_bit_cast(float, bperm(lane ^ 2, __builtin_bit_cast(int, B)));
                          if (h == 0) { const int j = 16 * ti + 8 * kt + 2 * g + hi; imp[tq * 64 + j] = A; carry[tq * 68 + j + 1] = B; } }
                  nsa_pv(tb, p0, p1, o, r32, hi); }
              nsa_rowaccum(ydst, true, o, wsf, g0, r32, hi); }
            __syncthreads();
            { const int q = tid >> 3, sub = tid & 7; unsigned long long mask;
              if (qb + 1 <= 16) mask = (1ull << (qb + 1)) - 1ull;
              else { mask = 1ull | (1ull << qb);
                  unsigned long long key[8];
#pragma unroll
                  for (int i = 0; i < 8; ++i) { const int j = sub * 8 + i; const float v = imp[q * 64 + j] + carry[q * 68 + j];
                      key[i] = (j >= 1 && j < qb) ? (((unsigned long long)__builtin_bit_cast(unsigned, v) << 32) | (unsigned)(63 - j)) : 0ull; }
                  for (int r = 0; r < 14; ++r) { unsigned long long best = key[0];
#pragma unroll
                      for (int i = 1; i < 8; ++i) best = key[i] > best ? key[i] : best;
#pragma unroll
                      for (int x = 1; x < 8; x <<= 1) { const unsigned lo = (unsigned)bperm(lane ^ x, (int)(unsigned)best), hh = (unsigned)bperm(lane ^ x, (int)(unsigned)(best >> 32));
                          const unsigned long long other = ((unsigned long long)hh << 32) | lo; best = other > best ? other : best; }
                      const int jb = 63 - (int)(best & 63ull); mask |= 1ull << jb;
#pragma unroll
                      for (int i = 0; i < 8; ++i) if (sub * 8 + i == jb) key[i] = 0ull; } }
              if (sub == 0) selm[q] = mask; }
            __syncthreads();
            const unsigned long long mysel = selm[tq];
            { const bf16* kb = P1 + (size_t)b * SEQ * P1W + C_KSLC; const bf16* vb = VT + (size_t)(0 * BC + b) * 64 * SEQ;
              m = -1e30f; l = 0.f;
#pragma unroll
              for (int i = 0; i < 16; ++i) { o[0][i] = 0.f; o[1][i] = 0.f; }
              v4u kx2, vx2;
              nsa_load(kx, vx, kb, P1W, vb, SEQ, tid); if (qb >= 1) nsa_load(kx2, vx2, kb + (size_t)64 * P1W, P1W, vb + 64, SEQ, tid);
              for (int j = 0; j <= qb; j += 2) {
                  const bool two = j + 1 <= qb;
                  LAS unsigned char* tb = lds + par * NSA_STAGE; par ^= 1;
                  nsa_store(tb, kx, vx, tid); if (two) nsa_store(tb + NSA_BUF, kx2, vx2, tid);
                  __syncthreads();
                  if (j + 2 <= qb) nsa_load(kx, vx, kb + (size_t)(j + 2) * 64 * P1W, P1W, vb + (j + 2) * 64, SEQ, tid);
                  if (j + 3 <= qb) nsa_load(kx2, vx2, kb + (size_t)(j + 3) * 64 * P1W, P1W, vb + (j + 3) * 64, SEQ, tid);
                  { const bool rowsel = ((mysel >> j) & 1ull) != 0ull;
                    if (__builtin_amdgcn_ballot_w64(rowsel) != 0ull) {
                        nsa_qk(tb, qr, p0, p1, r32, hi); if (j == qb) nsa_mask(p0, p1, hi, tq, -1);
                        nsa_softmax_pv(tb, p0, p1, m, l, o, wsf, lane, r32, hi, rowsel); } }
                  if (two) { const bool rowsel = ((mysel >> (j + 1)) & 1ull) != 0ull;
                    if (__builtin_amdgcn_ballot_w64(rowsel) != 0ull) {
                        nsa_qk(tb + NSA_BUF, qr, p0, p1, r32, hi); if (j + 1 == qb) nsa_mask(p0, p1, hi, tq, -1);
                        nsa_softmax_pv(tb + NSA_BUF, p0, p1, m, l, o, wsf, lane, r32, hi, rowsel); } } }
              const float lt = l + partner32(l, lane);
              nsa_rowaccum(ydst, false, o, wsf, lt > 0.f ? g1 / lt : 0.f, r32, hi); }
            { const bf16* kb = P1 + (size_t)b * SEQ * P1W + C_KWIN; const bf16* vb = VT + (size_t)(1 * BC + b) * 64 * SEQ;
              m = -1e30f; l = 0.f;
#pragma unroll
              for (int i = 0; i < 16; ++i) { o[0][i] = 0.f; o[1][i] = 0.f; }
              const int j0 = qb >= 8 ? qb - 8 : 0;
              nsa_load(kx, vx, kb + (size_t)j0 * 64 * P1W, P1W, vb + j0 * 64, SEQ, tid);
              for (int j = j0; j <= qb; ++j) {
                  LAS unsigned char* tb = lds + par * NSA_STAGE; par ^= 1;
                  nsa_store(tb, kx, vx, tid); __syncthreads();
                  if (j < qb) nsa_load(kx, vx, kb + (size_t)(j + 1) * 64 * P1W, P1W, vb + (j + 1) * 64, SEQ, tid);
                  nsa_qk(tb, qr, p0, p1, r32, hi); if (j == qb || j == qb - 8) nsa_mask(p0, p1, hi, j == qb ? tq : 63, j == qb - 8 ? tq : -1);
                  nsa_softmax_pv(tb, p0, p1, m, l, o, wsf, lane, r32, hi, true); }
              const float lt = l + partner32(l, lane);
              nsa_rowaccum(ydst, false, o, wsf, lt > 0.f ? g2 / lt : 0.f, r32, hi); }
        }
    }
    __syncthreads();
}

constexpr int SB_HEAD_LDS = 17408;
constexpr int SB_FLAG = 4 * SB_HEAD_LDS;
constexpr float SB_LOG2E = 1.4426950408889634f, SB_STOP = -100.0f * 1.4426950408889634f;
__device__ __forceinline__ void p_stick2(Frame& F, int nbusy) {
    const int tid = F.tid, lane = F.lane, wave = F.wave, r32 = lane & 31, hi = lane >> 5, h = wave & 3, qh = wave >> 2;
    LAS unsigned char* lds = F.lds + RING_OFF; LAS unsigned char* hl = lds + h * SB_HEAD_LDS; LAS int* flag = (LAS int*)(lds + SB_FLAG);
    const bf16* P1 = WSP(bf16, WS_P1); const bf16* VT = WSP(bf16, WS_VT) + (size_t)2 * BC * 64 * SEQ;
    bf16* Yb = WSP(bf16, WS_Y) + (size_t)MC * 256;
    const int tq = 32 * qh + r32;
    if (F.bx >= nbusy)
        for (int item = F.bx - nbusy; item < BC * 64; item += F.G - nbusy) {
            const int b = item >> 6, qb = item & 63;
            const size_t row = (size_t)b * SEQ + qb * 64 + tq;
            bf16x8v qr[4];
#pragma unroll
            for (int d0 = 0; d0 < 4; ++d0) qr[d0] = *(const bf16x8v*)(P1 + row * P1W + C_SBQ + h * 64 + d0 * 16 + hi * 8);
            f32x16 o[2], p0, p1;
#pragma unroll
            for (int i = 0; i < 16; ++i) { o[0][i] = 0.f; o[1][i] = 0.f; }
            float R = 0.f;
            const int skey = tid & 63, sc = tid >> 6, sd = tid >> 3, skc = tid & 7;
            v4u kx[4], vx[4];
#define SB_LOAD(jj) do { const bf16* kg_ = P1 + ((size_t)b * SEQ + (jj) * 64 + skey) * P1W + C_SBK + sc * 8; \
                _Pragma("unroll") for (int hh = 0; hh < 4; ++hh) { kx[hh] = *(const v4u*)(kg_ + hh * 64); vx[hh] = *(const v4u*)(VT + ((size_t)(hh * BC + b) * 64 + sd) * SEQ + (jj) * 64 + skc * 8); } } while (0)
            SB_LOAD(qb);
            for (int j = qb; j >= 0; --j) {
                __syncthreads();
                if (j < qb) { int live = 0;
#pragma unroll
                    for (int w = 0; w < 8; ++w) live |= flag[w];
                    if (!live) break; }
#pragma unroll
                for (int hh = 0; hh < 4; ++hh) { *(LAS v4u*)(lds + hh * SB_HEAD_LDS + sc * 1024 + skey * 16) = kx[hh]; { LAS v2u* vd = (LAS v2u*)(lds + hh * SB_HEAD_LDS + NSA_V + sd * NSA_VP + skc * 16); vd[0] = (v2u){vx[hh].x, vx[hh].y}; vd[1] = (v2u){vx[hh].z, vx[hh].w}; } }
                __syncthreads();
                if (j > 0) SB_LOAD(j - 1);
                nsa_qk(hl, qr, p0, p1, r32, hi);
#pragma unroll
                for (int i = 0; i < 16; ++i) { p0[i] *= NSA_C2; p1[i] *= NSA_C2; }
                const int lim = (j == qb) ? tq : 64;
                float Town[8], Tp[8];
#pragma unroll
                for (int kt = 0; kt < 2; ++kt) { f32x16& pp = kt ? p1 : p0;
#pragma unroll
                    for (int g = 0; g < 4; ++g) { float L[4];
#pragma unroll
                        for (int e = 0; e < 4; ++e) { const int kk = 32 * kt + 8 * g + 4 * hi + e; const float z = pp[4 * g + e];
                            const float tt = __builtin_amdgcn_logf(1.0f + __builtin_amdgcn_exp2f(-__builtin_fabsf(z)));
                            const float lb = fminf(z, 0.f) - tt; const bool ok = kk < lim;
                            L[e] = ok ? lb - z : 0.f; pp[4 * g + e] = ok ? lb : -INFINITY; }
                        const float E2 = L[3], E1 = E2 + L[2], E0 = E1 + L[1];
                        pp[4 * g + 2] += E2; pp[4 * g + 1] += E1; pp[4 * g] += E0;
                        Town[4 * kt + g] = E0 + L[0]; } }
#pragma unroll
                for (int k = 0; k < 8; ++k) Tp[k] = partner32(Town[k], lane);
                float suf = R;
#pragma unroll
                for (int k = 7; k >= 0; --k) { const float add = suf + (hi == 0 ? Tp[k] : 0.f); f32x16& pp = (k >> 2) ? p1 : p0; const int g = k & 3;
#pragma unroll
                    for (int e = 0; e < 4; ++e) pp[4 * g + e] = __builtin_amdgcn_exp2f(pp[4 * g + e] + add);
                    suf += Town[k] + Tp[k]; }
                R = suf;
                nsa_pv(hl, p0, p1, o, r32, hi);
                const bool alive = R >= SB_STOP;
                const unsigned long long bal = __builtin_amdgcn_ballot_w64(alive);
                if (lane == 0) flag[wave] = bal != 0ull ? 1 : 0;
            }
            { bf16* dst = Yb + ((size_t)b * SEQ + qb * 64 + 32 * qh + 4 * hi) * 256 + h * 64 + r32;
#pragma unroll
              for (int i = 0; i < 16; ++i) { dst[((i & 3) + 8 * (i >> 2)) * 256] = (bf16)f2bf(o[0][i]); dst[((i & 3) + 8 * (i >> 2)) * 256 + 32] = (bf16)f2bf(o[1][i]); } }
        }
#undef SB_LOAD
    __syncthreads();
}

__device__ __forceinline__ void p_sgu2(Frame& F, int layer) {
    LAS unsigned char* vnT = F.lds + RING_OFF;
    const bf16* P1 = WSP(bf16, WS_P1); bf16* Ya = WSP(bf16, WS_Y);
    const float* gain = F.in[3] + (size_t)layer * 256; const float* sw = F.in[4] + (size_t)layer * 4 * 128 * 128; const float* sb = F.in[5] + (size_t)layer * 4 * 128;
    const int lane = F.lane, wave = F.wave, r32 = lane & 31, hi = lane >> 5, g = wave & 3, db = wave >> 2;
    for (int item = F.vcu; item < MC / 128; item += F.G) {
        const size_t r0 = (size_t)item * 128;
        __syncthreads();
        { const f32x4 gg = ((const f32x4*)gain)[lane];
          for (int rr = 0; rr < 16; rr += 2) { const int r = wave * 16 + rr;
              const v2u ra = *(const v2u*)(P1 + (r0 + r) * P1W + C_V + 4 * lane), rb = *(const v2u*)(P1 + (r0 + r + 1) * P1W + C_V + 4 * lane);
              const float a0 = bflo(ra.x), a1 = bfhi(ra.x), a2 = bflo(ra.y), a3 = bfhi(ra.y), b0 = bflo(rb.x), b1 = bfhi(rb.x), b2 = bflo(rb.y), b3 = bfhi(rb.y);
              const float sa = 1.0f / sqrtf(wave_sum((a0 * a0 + a1 * a1) + (a2 * a2 + a3 * a3), lane) * (1.f / 256.f) + EPS);
              const float sb_ = 1.0f / sqrtf(wave_sum((b0 * b0 + b1 * b1) + (b2 * b2 + b3 * b3), lane) * (1.f / 256.f) + EPS);
              LAS unsigned* q = (LAS unsigned*)(vnT + (4 * lane) * 272 + r * 2);
              q[0] = pk2(a0 * sa * gg.x, b0 * sb_ * gg.x); q[68] = pk2(a1 * sa * gg.y, b1 * sb_ * gg.y); q[136] = pk2(a2 * sa * gg.z, b2 * sb_ * gg.z); q[204] = pk2(a3 * sa * gg.w, b3 * sb_ * gg.w); } }
        __syncthreads();
        const int ch = g * 64 + db * 32 + r32;
        for (int tb = 0; tb < 4; ++tb) {
            f32x16 acc;
#pragma unroll
            for (int i = 0; i < 16; ++i) acc[i] = 0.f;
            const int t = 32 * tb + r32; const float* wrow = sw + ((size_t)g * 128 + t) * 128;
            f32x4 wq[8][2];
#pragma unroll
            for (int ks = 0; ks < 8; ++ks) if (ks < 2 * tb + 2) { wq[ks][0] = *(const f32x4*)(wrow + 16 * ks + 8 * hi); wq[ks][1] = *(const f32x4*)(wrow + 16 * ks + 8 * hi + 4); }
#pragma unroll
            for (int ks = 0; ks < 8; ++ks) if (ks < 2 * tb + 2) {
                const int s0 = 16 * ks + 8 * hi;
                const f32x4 w0 = wq[ks][0], w1 = wq[ks][1];
                const v4u a = (v4u){pk2(s0 <= t ? w0.x : 0.f, s0 + 1 <= t ? w0.y : 0.f), pk2(s0 + 2 <= t ? w0.z : 0.f, s0 + 3 <= t ? w0.w : 0.f),
                                    pk2(s0 + 4 <= t ? w1.x : 0.f, s0 + 5 <= t ? w1.y : 0.f), pk2(s0 + 6 <= t ? w1.z : 0.f, s0 + 7 <= t ? w1.w : 0.f)};
                const bf16x8v bfr = *(const LAS bf16x8v*)(vnT + ch * 272 + s0 * 2);
                acc = __builtin_amdgcn_mfma_f32_32x32x16_bf16(__builtin_bit_cast(bf16x8v, a), bfr, acc, 0, 0, 0); }
            float uu[16], bb[16];
#pragma unroll
            for (int i = 0; i < 16; ++i) { const int tt = 32 * tb + (i & 3) + 8 * (i >> 2) + 4 * hi; uu[i] = bf1(P1[(r0 + tt) * P1W + C_U + ch]); bb[i] = sb[g * 128 + tt]; }
#pragma unroll
            for (int i = 0; i < 16; ++i) { const int tt = 32 * tb + (i & 3) + 8 * (i >> 2) + 4 * hi;
                Ya[(r0 + tt) * 256 + ch] = (bf16)f2bf(uu[i] * (acc[i] + bb[i])); }
        }
    }
    __syncthreads();
}

struct Args { const float* in[20]; float* out; unsigned char* ws; int lo, hi, li, rep; };
#ifndef TILED_FFN1
#define TILED_FFN1 0
#endif
#ifndef PG8_ALIGN_EPI
#define PG8_ALIGN_EPI true
#endif
#ifndef PG8_SP2
#define PG8_SP2 true
#endif
#ifndef WGM_PROJ
#define WGM_PROJ PG8_WGM
#endif
#ifndef WGM_FFN1
#define WGM_FFN1 PG8_WGM
#endif
#ifndef WGM_FFN2
#define WGM_FFN2 PG8_WGM
#endif
#ifndef WGM_MOE1
#define WGM_MOE1 PG8_WGM
#endif
#ifndef WGM_MOE2
#define WGM_MOE2 PG8_WGM
#endif
#ifndef FFN_CHUNKS
#define FFN_CHUNKS 2
#endif
#ifndef REP_GEMM
#define REP_GEMM 1
#endif
#ifndef REP_STICK
#define REP_STICK 1
#endif
#ifndef REP_NSA
#define REP_NSA 1
#endif
#ifndef REP_SGU
#define REP_SGU 1
#endif
#ifndef REP_NORM
#define REP_NORM 1
#endif
template <class Epi, class Sched> __device__ __forceinline__ void run_gemm(Frame& F, const bf16* A, const bf16* Bt, int M, int N, int K, const Sched& S, Epi E, bool rotate = true, int tiled = 0) {
    const int nt_ = K / 64;
#ifdef PG8_KROT
    const int rot_ = rotate ? 2 * (((F.bx & 7) * (nt_ / 2)) / 8) : 0;
#else
    const int rot_ = 0;
#endif
    pg8::Gemm g{A, Bt, M, N, K + F.zs, F.tid, rot_ + F.zs, tiled + F.zs};
    if (F.rep) E.set_scale0();
    pg8::gemm_phase<Epi, Sched, PG8_ALIGN_EPI, PG8_SP2>(F.lds + RING_OFF, g, S, E);
}
__global__ void __launch_bounds__(NWAVES * 64, 2) mk_fwd(Args args) {
    extern __shared__ __attribute__((aligned(16))) unsigned char lds[];
    Frame F0;
    F0.lds = (LAS unsigned char*)lds;
    F0.tid = threadIdx.x; F0.lane = F0.tid & 63; F0.wave = __builtin_amdgcn_readfirstlane(F0.tid >> 6);
    F0.G = gridDim.x; F0.bx = blockIdx.x; F0.vcu = (F0.G % 8 == 0) ? (F0.bx % 8) * (F0.G / 8) + F0.bx / 8 : F0.bx; F0.zv = 0; F0.zs = 0;
    F0.rep = args.rep; F0.ws = args.ws; F0.ctl = (unsigned*)(args.ws + WS_CTL); F0.in = args.in; F0.out = args.out;
    for (int u = F0.tid; u < (LDS_BYTES - LDSCTL_OFF) / 4; u += NWAVES * 64) ((LAS unsigned*)(F0.lds + LDSCTL_OFF))[u] = 0u;
    __syncthreads();
    const int lo = args.lo, hi = args.hi;
    XcdBarrier bar; bar.bar = F0.ctl + CW_BAR + args.li * XCD_BAR_WORDS; bar.x = 0; bar.st = nullptr; bar.w = 0; bar.z = 0;
    if (hi - lo > 1) bar = xcd_barrier_post(F0.ctl + CW_BAR + args.li * XCD_BAR_WORDS, (volatile LAS unsigned*)(F0.lds + MISC_OFF) + 8);
    int step = 0;
#define STEP_BEGIN if (step >= lo && step < hi) { Frame F = F0; { int zv_, zs_; asm volatile("v_mov_b32 %0, 0" : "=v"(zv_)); asm volatile("s_mov_b32 %0, 0" : "=s"(zs_)); \
        F.zv = zv_; F.zs = zs_; F.lane = (int)__builtin_amdgcn_mbcnt_hi(~0u, __builtin_amdgcn_mbcnt_lo(~0u, (unsigned)zv_)); F.wave = F0.wave + zs_; F.tid = F.wave * 64 + F.lane; F.bx = F.bx + zs_; \
        F.vcu = F0.vcu + zs_; F.G = F0.G + zs_; F.lds = (LAS unsigned char*)lds + zs_; F.ws = F0.ws + zs_; F.ctl = F0.ctl + zs_; F.in = F0.in + zs_; F.out = F0.out + zs_; }
#ifdef PROBE_XBAR
#define STEP_END   if (step + 1 < hi) { unsigned zb_; asm volatile("v_mov_b32 %0, 0" : "=v"(zb_)); bar.z = zb_; xcd_barrier(bar); xcd_barrier(bar); } } ++step;
#else
#define STEP_END   if (step + 1 < hi) { unsigned zb_; asm volatile("v_mov_b32 %0, 0" : "=v"(zb_)); bar.z = zb_; xcd_barrier(bar); } } ++step;
#endif

    for (int layer = 0; layer < DEPTH; ++layer) {
        const int jj = layer >> 1;
        STEP_BEGIN
            p_convert(F, layer);
            p_norm<0>(F, layer == 0 ? F.in[0] : F.out, F.in[1] + (size_t)layer * DM, nullptr, 0);
        STEP_END
        for (int c = 0; c < NCHUNK; ++c) {
            STEP_BEGIN
                pg8::StaticOrder S; S.init(MC, NPROJ, F.G, F.bx, WGM_PROJ);
                pg8::EpiProj E{WSP(bf16, WS_P1), WSP(bf16, WS_G)};
                run_gemm(F, WSP(bf16, WS_HN) + (size_t)c * MC * DM, WSP(bf16, WS_WIN), MC, NPROJ, DM, S, E);
            STEP_END
            STEP_BEGIN
                p_prep(F);
            STEP_END
            STEP_BEGIN
                LAS int* tab = (LAS int*)(F.lds + TAB_OFF);
                __syncthreads(); if (F.tid < 16) tab[F.tid] = F.tid >> 3; __syncthreads();
                pg8::GroupedOrder S; S.so.init(2 * 2048, 512, F.G, F.bx); S.tile_e = tab; S.nN = 2;
                pg8::EpiF32 E{WSP(float, WS_UL), 512, 2};
                run_gemm(F, WSP(bf16, WS_KVC), WSP(bf16, WS_WC1), 2 * 2048, 512, DM, S, E);
                p_sgu2(F, layer);
                p_stick2(F, F.G > 64 ? 32 : 0);
            STEP_END
            STEP_BEGIN
                p_cmpfin(F, layer);
            STEP_END
            STEP_BEGIN
#ifdef OLD_NSA
                p_nsa(F);
#else
                p_nsa2(F);
#endif
            STEP_END
            STEP_BEGIN
                pg8::MergeOrder S; S.so.init(MC, DM, F.G, F.bx); S.nmt = MC / 256;
                pg8::EpiMerge E{WSP(bf16, WS_G), WSP(bf16, WS_MG), MC / 256};
                run_gemm(F, WSP(bf16, WS_Y), WSP(bf16, WS_WBR), 3 * MC, 3 * DM, 256, S, E);
            STEP_END
            STEP_BEGIN
                pg8::StaticOrder S; S.init(MC, DM, F.G, F.bx);
                const float* base = (layer == 0 ? F.in[0] : F.out) + (size_t)c * MC * DM;
                pg8::EpiResid E{base, F.out + (size_t)c * MC * DM, DM, 1.0f};
                run_gemm(F, WSP(bf16, WS_MG), WSP(bf16, WS_WOUT), MC, DM, DM, S, E);
            STEP_END
        }
        if ((layer & 1) == 0) {
            STEP_BEGIN
                p_norm<0>(F, F.out, F.in[11] + (size_t)layer * DM, nullptr, 0, Q8_HN, TILED_FFN1);
            STEP_END
            for (int c = 0; c < FFN_CHUNKS; ++c) {
                constexpr int MF = MTOK / FFN_CHUNKS;
                STEP_BEGIN
                    pg8::StaticOrder S; S.init(MF, NFF1, F.G, F.bx, WGM_FFN1);
                    pg8::EpiSwiGLU E{WSP(bf16, WS_HID), DFFP, nullptr, NFF1 / 256};
                    run_gemm(F, WSP(bf16, WS_HN) + (size_t)c * MF * DM, WSP(bf16, WS_WF1), MF, NFF1, DM, S, E, true, TILED_FFN1);
                STEP_END
                STEP_BEGIN
                    pg8::StaticOrder S; S.init(MF, DM, F.G, F.bx, WGM_FFN2);
                    pg8::EpiResid E{F.out + (size_t)c * MF * DM, F.out + (size_t)c * MF * DM, DM, 1.0f};
                    run_gemm(F, WSP(bf16, WS_HID), WSP(bf16, WS_WF2), MF, DM, DFFP, S, E);
                STEP_END
            }
        } else {
            STEP_BEGIN
                p_norm<1>(F, F.out, F.in[11] + (size_t)layer * DM, F.in[15] + (size_t)jj * DM * NEXP, jj, Q8_HN);
            STEP_END
#ifdef ABL_DENSE_MOE
            for (int e = 0; e < NEXP; ++e) {
                STEP_BEGIN
                    pg8::StaticOrder S; S.init(MTOK, NMOE1, F.G, F.bx);
                    pg8::EpiSwiGLU E{WSP(bf16, WS_SCR + 8 * MiB), DFE, WSP(float, WS_SCR + 4 * MiB) + (size_t)e * MTOK, NMOE1 / 256};
                    run_gemm(F, WSP(bf16, WS_HN), WSP(bf16, WS_WF1) + (size_t)e * NMOE1 * DM, MTOK, NMOE1, DM, S, E);
                STEP_END
                STEP_BEGIN
                    pg8::StaticOrder S; S.init(MTOK, DM, F.G, F.bx);
                    pg8::EpiResid E{F.out, F.out, DM, 1.0f};
                    run_gemm(F, WSP(bf16, WS_SCR + 8 * MiB), WSP(bf16, WS_WF2) + (size_t)e * DM * DFE, MTOK, DM, DFE, S, E);
                STEP_END
            }
#else
            STEP_BEGIN
                p_gather(F, jj, 0, 0);
            STEP_END
            for (int c = 0; c < NCHUNK; ++c)
                for (int r = 0; r < 2; ++r) {
                    STEP_BEGIN
                        const int T = moe_table(F, jj, c, r);
                        pg8::GroupedOrder S; S.so.init(T * 256, NMOE1, F.G, F.bx, WGM_MOE1); S.tile_e = (LAS int*)(F.lds + TAB_OFF); S.nN = NMOE1 / 256;
                        pg8::EpiSwiGLU E{WSP(bf16, WS_HIDM), DFE, WSP(float, WS_WSLOT) + (c * 2 + r) * SLOTS, NMOE1 / 256};
                        run_gemm(F, WSP(bf16, WS_XG), WSP(bf16, WS_WF1), T * 256, NMOE1, DM, S, E, false);
                    STEP_END
                    STEP_BEGIN
                        const int T = moe_table(F, jj, c, r);
                        pg8::GroupedOrder S; S.so.init(T * 256, DM, F.G, F.bx, WGM_MOE2); S.tile_e = (LAS int*)(F.lds + TAB_OFF); S.nN = DM / 256;
                        pg8::EpiScatter E{F.out, WSP(int, WS_TOKMAP) + (c * 2 + r) * SLOTS, DM / 256, 1.0f};
                        run_gemm(F, WSP(bf16, WS_HIDM), WSP(bf16, WS_WF2), T * 256, DM, DFE, S, E, false);
                        if (!F.rep && c * 2 + r < 3) p_gather(F, jj, (c * 2 + r + 1) >> 1, (c * 2 + r + 1) & 1, (T * (DM / 256)) % F.G);
                    STEP_END
                }
#endif
        }
    }
    STEP_BEGIN
        p_norm<2>(F, F.out, F.in[19], nullptr, 0);
    STEP_END
#undef STEP_BEGIN
#undef STEP_END
}

#ifndef MK_STEPS_PER_LAUNCH
#define MK_STEPS_PER_LAUNCH 1
#endif
extern "C" void kernel_launch(void* const* d_in, const int* in_sizes, int n_in, void* d_out, int out_size, void* d_ws, size_t ws_size, hipStream_t stream) {
    static int grid = 0;
    if (grid == 0) {
        if (n_in != 20 || in_sizes[0] != MTOK * DM || out_size != MTOK * DM || ws_size < WS_END) { fprintf(stderr, "kernel_launch: unexpected shapes (n_in %d, in0 %d, out %d, ws %zu)\n", n_in, n_in > 0 ? in_sizes[0] : -1, out_size, ws_size); grid = -1; return; }
        int dev = 0, cus = 0, per_cu = 0;
        if (hipGetDevice(&dev) != hipSuccess || hipDeviceGetAttribute(&cus, hipDeviceAttributeMultiprocessorCount, dev) != hipSuccess) { grid = -1; return; }
        if (hipFuncSetAttribute((const void*)mk_fwd, hipFuncAttributeMaxDynamicSharedMemorySize, LDS_BYTES) != hipSuccess) { fprintf(stderr, "kernel_launch: hipFuncSetAttribute failed\n"); grid = -1; return; }
        if (hipOccupancyMaxActiveBlocksPerMultiprocessor(&per_cu, (const void*)mk_fwd, NWAVES * 64, LDS_BYTES) != hipSuccess || per_cu < 1) fprintf(stderr, "kernel_launch: occupancy query reports %d\n", per_cu);
        (void)hipGetLastError();
        grid = cus;
    }
    if (grid < 0) return;
    if (hipMemsetAsync((char*)d_ws + WS_CTL, 0, CTL_ZERO_BYTES, stream) != hipSuccess) return;
    Args a{};
    for (int i = 0; i < 20; ++i) a.in[i] = (const float*)d_in[i];
    a.out = (float*)d_out; a.ws = (unsigned char*)d_ws; a.rep = 0;
    #ifdef ABL_DENSE_MOE
    constexpr int NSTEPS = 2 * (1 + NCHUNK * 8 + 3) + 2 * (1 + NCHUNK * 8 + 1 + NEXP * 2) + 1;
#else
    constexpr int NSTEPS = 2 * (1 + NCHUNK * 7 + 1 + 2 * FFN_CHUNKS) + 2 * (1 + NCHUNK * 7 + 2 + NCHUNK * 2 * 2) + 1;
#endif
    int li = 0;
#ifdef REPMASK
    static int kinds[256]; int ns = 0;
    for (int layer = 0; layer < DEPTH; ++layer) { kinds[ns++] = 0;
        for (int c = 0; c < NCHUNK; ++c) for (int q = 1; q <= 8; ++q) if (q != 5) kinds[ns++] = q;
        if ((layer & 1) == 0) { kinds[ns++] = 9; for (int c = 0; c < FFN_CHUNKS; ++c) { kinds[ns++] = 10; kinds[ns++] = 11; } }
        else { kinds[ns++] = 12; kinds[ns++] = 17; for (int c = 0; c < NCHUNK * 2; ++c) { kinds[ns++] = 14; kinds[ns++] = 13; } } }
    kinds[ns++] = 16;
    for (int s = 0; s < NSTEPS; ++s) { const int reps = ((REPMASK >> kinds[s]) & 1) ? 2 : 1;
        for (int r = 0; r < reps; ++r) { a.lo = s; a.hi = s + 1; a.li = 0; a.rep = r;
            hipLaunchKernelGGL(mk_fwd, dim3(grid), dim3(NWAVES * 64), LDS_BYTES, stream, a); } }
    (void)li;
#else
    for (int s = 0; s < NSTEPS; s += MK_STEPS_PER_LAUNCH) {
        a.lo = s; a.hi = (s + MK_STEPS_PER_LAUNCH < NSTEPS) ? s + MK_STEPS_PER_LAUNCH : NSTEPS; a.li = (MK_STEPS_PER_LAUNCH > 1) ? li : 0; ++li;
        hipLaunchKernelGGL(mk_fwd, dim3(grid), dim3(NWAVES * 64), LDS_BYTES, stream, a);
        if (hipPeekAtLastError() != hipSuccess) { fprintf(stderr, "kernel_launch: launch failed\n"); break; }
    }
#endif
}
```

```cpp
#define MK_STEPS_PER_LAUNCH 1000
#define PG8_WGM 4
#define FFN_CHUNKS 1
#include <hip/hip_runtime.h>
#include <cstdio>
#include <cstdint>
#include <cmath>
#ifndef PG8_WGM
#define PG8_WGM 8
#endif
namespace pg8 {
#define PG8_LAS __attribute__((address_space(3)))
typedef unsigned short bf16_t;
typedef short bf16x8 __attribute__((ext_vector_type(8)));
typedef float f32x4 __attribute__((ext_vector_type(4)));
typedef unsigned u32x4 __attribute__((ext_vector_type(4)));
constexpr int BM = 256, BK = 64, HALF = 128, HTB = HALF * BK * 2  , STAGE_BYTES = 8 * HTB, NXCD = 8, WGM = PG8_WGM;

__host__ __device__ __forceinline__ int lds_byte(int r, int c) { const int st = (r >> 4) * 2 + (c >> 5), rr = r & 15, cc = c & 31, ob = rr * 64 + cc * 2; return st * 1024 + (ob ^ (((ob >> 9) & 1) << 5)); }
__host__ __device__ __forceinline__ void stage_rc(int b, int& R, int& C) { const int st = b / 1024, sb = b % 1024, swz = sb ^ (((sb >> 9) & 1) << 5); R = (st >> 1) * 16 + swz / 64; C = (st & 1) * 32 + (swz % 64) / 2; }
__host__ __device__ __forceinline__ int perm32(int rho) { const int n = rho >> 4, i = rho & 15; return 8 * (i >> 2) + 4 * n + (i & 3); }

struct Unit { int pm, pn; };
struct Gemm { const bf16_t* A; const bf16_t* Bt; int M, N, K; int zv; int rot; int tiled; };

struct StaticOrder {
    int nM, nN, nwg, G, c, wgm;
    __host__ __device__ void init(int M, int N, int G_, int c_, int wgm_ = WGM) { nM = M / BM; nN = N / BM; nwg = nM * nN; G = G_; c = c_; wgm = wgm_; }
    __host__ __device__ bool next(int i, Unit& u) const {
        const long L = (long)i * G + c; if (L >= nwg) return false;
        int wgid = (int)L; { const int q = nwg / NXCD, r = nwg % NXCD, xcd = wgid % NXCD, off = wgid / NXCD; wgid = (xcd < r ? xcd * (q + 1) : r * (q + 1) + (xcd - r) * q) + off; }
        const int nig = wgm * nN, gid = wgid / nig, fm = gid * wgm, gsz = (nM - fm) < wgm ? (nM - fm) : wgm;
        u.pm = fm + ((wgid % nig) % gsz); u.pn = (wgid % nig) / gsz; return true;
    }
    __device__ __forceinline__ void a_ready(const Unit&) const {}
    __device__ __forceinline__ void done(const Unit&) const {}
};

__device__ __forceinline__ unsigned cvt_pk_bf16(float lo, float hi) { unsigned r; asm volatile("v_cvt_pk_bf16_f32 %0, %1, %2" : "=v"(r) : "v"(lo), "v"(hi)); return r; }
typedef float f32x2 __attribute__((ext_vector_type(2)));

__device__ __forceinline__ float fast_sigmoid(float x) { return __builtin_amdgcn_rcpf(1.0f + __builtin_amdgcn_exp2f(-1.4426950408889634f * x)); }
__device__ __forceinline__ float gelu_tanh(float x) {
    const float u2 = 1.5957691216057308f * (x + 0.044715f * x * x * x);
    return x * fast_sigmoid(u2);
}
__device__ __forceinline__ float bf_lo(unsigned u) { return __builtin_bit_cast(float, u << 16); }
__device__ __forceinline__ float bf_hi(unsigned u) { return __builtin_bit_cast(float, u & 0xffff0000u); }

#ifdef PG8_NT_OUT
#define PG8_STORE_OUT(p, v) __builtin_nontemporal_store((v), (p))
#else
#define PG8_STORE_OUT(p, v) (*(p) = (v))
#endif
struct EpiProj {
    static constexpr bool PERM = true, AFTER_DRAIN = false, MID = false; static constexpr int MID_TILES = 1; __device__ __forceinline__ void set_scale0() {}
    bf16_t* P1; bf16_t* G;
    __device__ __forceinline__ void operator()(const f32x4 (&acc)[2][2][4][2], const Unit& u, int wr, int wc, int fr, int fq) const {
        const int row0 = u.pm * BM + wr * 64 + fr;
        bf16_t* base; int ldc, colt, act0, act1;
        if (u.pn < 8) { base = P1; ldc = 2048; colt = u.pn * BM; act0 = (u.pn < 2) ? 1 : 0; act1 = (u.pn == 7) ? 2 : act0; }
        else { base = G; ldc = 3072; colt = (u.pn - 8) * BM; act0 = 2; act1 = 2; }
        const int col0 = colt + wc * 32 + 8 * fq;
#pragma unroll
        for (int ai = 0; ai < 2; ++ai)
#pragma unroll
            for (int m = 0; m < 4; ++m) { bf16_t* rowp = base + (size_t)(row0 + ai * HALF + m * 16) * ldc + col0;
#pragma unroll
                for (int bj = 0; bj < 2; ++bj) { f32x4 v0 = acc[ai][bj][m][0], v1 = acc[ai][bj][m][1]; const int act = bj ? act1 : act0;
                    if (act == 1) {
#pragma unroll
                        for (int e = 0; e < 4; ++e) { v0[e] = gelu_tanh(v0[e]); v1[e] = gelu_tanh(v1[e]); } }
                    else if (act == 2) {
#pragma unroll
                        for (int e = 0; e < 4; ++e) { v0[e] = fast_sigmoid(v0[e]); v1[e] = fast_sigmoid(v1[e]); } }
                    u32x4 w; w.x = cvt_pk_bf16(v0[0], v0[1]); w.y = cvt_pk_bf16(v0[2], v0[3]); w.z = cvt_pk_bf16(v1[0], v1[1]); w.w = cvt_pk_bf16(v1[2], v1[3]);
                    *(u32x4*)(rowp + bj * HALF) = w; } }
    }
};
struct EpiMerge {
    static constexpr bool PERM = true, AFTER_DRAIN = false, MID = false; static constexpr int MID_TILES = 1; __device__ __forceinline__ void set_scale0() {}
    const bf16_t* G; bf16_t* MG; int nmt;
    __device__ __forceinline__ void operator()(const f32x4 (&acc)[2][2][4][2], const Unit& u, int wr, int wc, int fr, int fq) const {
        const int i = u.pn >> 2, pn = u.pn & 3, pm = u.pm - i * nmt;
        const int row0 = pm * BM + wr * 64 + fr, col0 = pn * BM + wc * 32 + 8 * fq;
#pragma unroll
        for (int ai = 0; ai < 2; ++ai)
#pragma unroll
            for (int mp = 0; mp < 2; ++mp) {
                u32x4 g[4], o[4];
#pragma unroll
                for (int q = 0; q < 4; ++q) { const int m = 2 * mp + (q >> 1), bj = q & 1; const size_t row = (size_t)(row0 + ai * HALF + m * 16); const int col = col0 + bj * HALF;
                    g[q] = *(const u32x4*)(G + row * 3072 + i * 1024 + col);
                    if (i > 0) o[q] = *(const u32x4*)(MG + row * 1024 + col); else o[q] = (u32x4){0u, 0u, 0u, 0u}; }
#pragma unroll
                for (int q = 0; q < 4; ++q) { const int m = 2 * mp + (q >> 1), bj = q & 1; const size_t row = (size_t)(row0 + ai * HALF + m * 16); const int col = col0 + bj * HALF;
                    f32x4 v0 = acc[ai][bj][m][0], v1 = acc[ai][bj][m][1];
#ifdef ABL_BRANCH
                    if (i == ABL_BRANCH) { v0 = v0 * (float)ABL_SCALE; v1 = v1 * (float)ABL_SCALE; }
#endif
                    v0[0] = v0[0] * bf_lo(g[q].x) + bf_lo(o[q].x); v0[1] = v0[1] * bf_hi(g[q].x) + bf_hi(o[q].x); v0[2] = v0[2] * bf_lo(g[q].y) + bf_lo(o[q].y); v0[3] = v0[3] * bf_hi(g[q].y) + bf_hi(o[q].y);
                    v1[0] = v1[0] * bf_lo(g[q].z) + bf_lo(o[q].z); v1[1] = v1[1] * bf_hi(g[q].z) + bf_hi(o[q].z); v1[2] = v1[2] * bf_lo(g[q].w) + bf_lo(o[q].w); v1[3] = v1[3] * bf_hi(g[q].w) + bf_hi(o[q].w);
                    u32x4 w; w.x = cvt_pk_bf16(v0[0], v0[1]); w.y = cvt_pk_bf16(v0[2], v0[3]); w.z = cvt_pk_bf16(v1[0], v1[1]); w.w = cvt_pk_bf16(v1[2], v1[3]);
                    *(u32x4*)(MG + row * 1024 + col) = w; } }
    }
};
struct EpiResid {
    static constexpr bool PERM = false, AFTER_DRAIN = false, MID = false; static constexpr int MID_TILES = 1; __device__ __forceinline__ void set_scale0() { scale = 0.f; base = out; }
    const float* base; float* out; int ldc; float scale;
    __device__ __forceinline__ void operator()(const f32x4 (&acc)[2][2][4][2], const Unit& u, int wr, int wc, int fr, int fq) const {
        const int row0 = u.pm * BM + wr * 64 + fr, col0 = u.pn * BM + wc * 32 + 4 * fq;
#pragma unroll
        for (int ai = 0; ai < 2; ++ai)
#pragma unroll
            for (int mp = 0; mp < 2; ++mp) {
                f32x4 b[8];
#pragma unroll
                for (int q = 0; q < 8; ++q) { const int m = 2 * mp + (q >> 2), bj = (q >> 1) & 1, n = q & 1;
                    b[q] = *(const f32x4*)(base + (size_t)(row0 + ai * HALF + m * 16) * ldc + col0 + bj * HALF + n * 16); }
#pragma unroll
                for (int q = 0; q < 8; ++q) { const int m = 2 * mp + (q >> 2), bj = (q >> 1) & 1, n = q & 1;
                    *(f32x4*)(out + (size_t)(row0 + ai * HALF + m * 16) * ldc + col0 + bj * HALF + n * 16) = b[q] + acc[ai][bj][m][n] * scale; } }
    }
};
struct EpiF32 {
    static constexpr bool PERM = false, AFTER_DRAIN = false, MID = false; static constexpr int MID_TILES = 1; __device__ __forceinline__ void set_scale0() {}
    float* O; int ldc, nN;
    __device__ __forceinline__ void operator()(const f32x4 (&acc)[2][2][4][2], const Unit& u, int wr, int wc, int fr, int fq) const {
        const int row0 = u.pm * BM + wr * 64 + fr, col0 = (u.pn % nN) * BM + wc * 32 + 4 * fq;
#pragma unroll
        for (int ai = 0; ai < 2; ++ai)
#pragma unroll
            for (int m = 0; m < 4; ++m) { const size_t off = (size_t)(row0 + ai * HALF + m * 16) * ldc + col0;
#pragma unroll
                for (int bj = 0; bj < 2; ++bj)
#pragma unroll
                    for (int n = 0; n < 2; ++n) *(f32x4*)(O + off + bj * HALF + n * 16) = acc[ai][bj][m][n]; }
    }
};
#ifdef EMU_FP8_HID
__device__ __forceinline__ float Q8H(float x) { const int p = __builtin_amdgcn_cvt_pk_fp8_f32(x * 8.f, x * 8.f, 0, false); return __builtin_amdgcn_cvt_f32_fp8(p, 0) * 0.125f; }
#else
__device__ __forceinline__ float Q8H(float x) { return x; }
#endif
struct EpiSwiGLU {
    static constexpr bool PERM = true, AFTER_DRAIN = false, MID = false; static constexpr int MID_TILES = 1; __device__ __forceinline__ void set_scale0() {}
    bf16_t* H; int ldh; const float* rowscale; int nN; int rowmask = 0x7fffffff;
    __device__ __forceinline__ void operator()(const f32x4 (&acc)[2][2][4][2], const Unit& u, int wr, int wc, int fr, int fq) const {
        const int row0 = u.pm * BM + wr * 64 + fr, col0 = (u.pn % nN) * HALF + wc * 32 + 8 * fq;
        float scv[8];
#pragma unroll
        for (int q = 0; q < 8; ++q) scv[q] = rowscale ? rowscale[row0 + (q >> 2) * HALF + (q & 3) * 16] : 1.0f;
#pragma unroll
        for (int ai = 0; ai < 2; ++ai)
#pragma unroll
            for (int m = 0; m < 4; ++m) { const int row = row0 + ai * HALF + m * 16; const float sc = scv[ai * 4 + m];
                float h[8];
#pragma unroll
                for (int n = 0; n < 2; ++n)
#pragma unroll
                    for (int e = 0; e < 4; ++e) { const float g = acc[ai][0][m][n][e], up = acc[ai][1][m][n][e]; h[n * 4 + e] = Q8H(g * fast_sigmoid(g) * up * sc); }
                u32x4 w; w.x = cvt_pk_bf16(h[0], h[1]); w.y = cvt_pk_bf16(h[2], h[3]); w.z = cvt_pk_bf16(h[4], h[5]); w.w = cvt_pk_bf16(h[6], h[7]);
                PG8_STORE_OUT((u32x4*)(H + (size_t)(row & rowmask) * ldh + col0), w); }
    }
};
struct EpiScatter {
    static constexpr bool PERM = false, AFTER_DRAIN = false, MID = false; static constexpr int MID_TILES = 1; __device__ __forceinline__ void set_scale0() { scale = 0.f; }
    float* out; const int* tok; int nN; float scale;
    __device__ __forceinline__ void operator()(const f32x4 (&acc)[2][2][4][2], const Unit& u, int wr, int wc, int fr, int fq) const {
        const int row0 = u.pm * BM + wr * 64 + fr, col0 = (u.pn % nN) * BM + wc * 32 + 4 * fq;
        int tk[8];
#pragma unroll
        for (int q = 0; q < 8; ++q) tk[q] = tok[row0 + (q >> 2) * HALF + (q & 3) * 16];
#pragma unroll
        for (int ai = 0; ai < 2; ++ai)
#pragma unroll
            for (int mp = 0; mp < 2; ++mp) {
                f32x4 b[8];
#pragma unroll
                for (int q = 0; q < 8; ++q) { const int m = 2 * mp + (q >> 2), bj = (q >> 1) & 1, n = q & 1; const int t = tk[ai * 4 + m];
                    b[q] = *(const f32x4*)(out + (size_t)(t < 0 ? 0 : t) * 1024 + col0 + bj * HALF + n * 16); }
#pragma unroll
                for (int q = 0; q < 8; ++q) { const int m = 2 * mp + (q >> 2), bj = (q >> 1) & 1, n = q & 1; const int t = tk[ai * 4 + m];
#ifdef ABL_MOE
                    if (false)
#else
                    if (t >= 0)
#endif
                        *(f32x4*)(out + (size_t)t * 1024 + col0 + bj * HALF + n * 16) = b[q] + acc[ai][bj][m][n] * scale; } }
    }
};
struct GroupedOrder {
    StaticOrder so; const PG8_LAS int* tile_e; int nN;
    __device__ __forceinline__ bool next(int i, Unit& u) const { if (!so.next(i, u)) return false; u.pn += tile_e[u.pm] * nN; return true; }
    __device__ __forceinline__ void a_ready(const Unit&) const {}
    __device__ __forceinline__ void done(const Unit&) const {}
};
struct OffsetOrder {
    StaticOrder so; int pn_off;
    __device__ __forceinline__ bool next(int i, Unit& u) const { if (!so.next(i, u)) return false; u.pn += pn_off; return true; }
    __device__ __forceinline__ void a_ready(const Unit&) const {}
    __device__ __forceinline__ void done(const Unit&) const {}
};
struct ProbeOrder {
    StaticOrder so; int pm_mask;
    __device__ __forceinline__ bool next(int i, Unit& u) const { if (!so.next(i, u)) return false; u.pm &= pm_mask; return true; }
    __device__ __forceinline__ void a_ready(const Unit&) const {}
    __device__ __forceinline__ void done(const Unit&) const {}
};
struct MergeOrder {
    StaticOrder so; int nmt;
    __device__ __forceinline__ bool next(int i, Unit& u) const { const int b = i % 3; if (!so.next(i / 3, u)) return false; u.pm += b * nmt; u.pn += b * 4; return true; }
    __device__ __forceinline__ void a_ready(const Unit&) const {}
    __device__ __forceinline__ void done(const Unit&) const {}
};
template <class Epi, class Sched, bool ALIGN_EPI = false, bool SP2 = false>
__device__ __forceinline__ void gemm_phase(PG8_LAS unsigned char* lds, const Gemm g, const Sched& S, const Epi& E) {
    const int tid = g.zv  , wid = __builtin_amdgcn_readfirstlane(tid >> 6), lane = tid & 63, wr = wid >> 2, wc = wid & 3, fr = lane & 15, fq = lane >> 4;
    const int K = g.K, nt = K / BK;
    unsigned voffA[2], voffB[2];
#pragma unroll
    for (int i = 0; i < 2; ++i) { int R, C; stage_rc(tid * 16 + i * 8192, R, C); const int Rb = Epi::PERM ? ((R & ~31) + perm32(R & 31)) : R;
        const int pitch = g.tiled ? BK : K;
        voffA[i] = (unsigned)(R * pitch + C) * 2u; voffB[i] = (unsigned)(Rb * pitch + C) * 2u; }
    const size_t kstep = g.tiled ? (size_t)(BM * BK * 2) : (size_t)(BK * 2);
    const size_t hstep = g.tiled ? (size_t)(HALF * BK * 2) : (size_t)HALF * K * 2;
    const size_t tstep = (size_t)BM * K * 2;
    const unsigned ldsw = (unsigned)wid * 1024u;
    const int aoff = lds_byte(wr * 64 + fr, fq * 8), boff = lds_byte(wc * 32 + fr, fq * 8);
#define PG8_SA(b, h) (((b) * 2 + (h)) * HTB)
#define PG8_SB(b, h) ((4 + (b) * 2 + (h)) * HTB)
#define PG8_STAGE(bufoff, gbase, voff) do { _Pragma("unroll") for (int _i = 0; _i < 2; ++_i) \
        __builtin_amdgcn_global_load_lds((const unsigned*)((const char*)(gbase) + (voff)[_i]), (PG8_LAS unsigned*)(lds + (bufoff) + ldsw + _i * 8192), 16, 0, 0); } while (0)
#define PG8_LDA(dst, b, h) do { _Pragma("unroll") for (int m = 0; m < 4; ++m) _Pragma("unroll") for (int k = 0; k < 2; ++k) dst[m][k] = *(const PG8_LAS bf16x8*)(lds + PG8_SA(b, h) + aoff + m * 2048 + k * 1024); } while (0)
#define PG8_LDB(dst, b, h) do { _Pragma("unroll") for (int n = 0; n < 2; ++n) _Pragma("unroll") for (int k = 0; k < 2; ++k) dst[n][k] = *(const PG8_LAS bf16x8*)(lds + PG8_SB(b, h) + boff + n * 2048 + k * 1024); } while (0)
#define PG8_MMA(ai, bj, At, Bt) do { __builtin_amdgcn_s_setprio(1); _Pragma("unroll") for (int m = 0; m < 4; ++m) _Pragma("unroll") for (int n = 0; n < 2; ++n) _Pragma("unroll") for (int k = 0; k < 2; ++k) \
        acc[ai][bj][m][n] = __builtin_amdgcn_mfma_f32_16x16x32_bf16(Bt[n][k], At[m][k], acc[ai][bj][m][n], 0, 0, 0); __builtin_amdgcn_s_setprio(0); } while (0)
#define PG8_WAIT_V(n) asm volatile("s_waitcnt vmcnt(" #n ")" ::: "memory")
#define PG8_WAIT_L(n) asm volatile("s_waitcnt lgkmcnt(" #n ")" ::: "memory")
#define PG8_BAR __builtin_amdgcn_s_barrier()
#define PG8_SCHED __builtin_amdgcn_sched_barrier(0)
    Unit cur, nxt; int ui = 0;
    if (!S.next(0, cur)) return;
    f32x4 acc[2][2][4][2];
#pragma unroll
    for (int a = 0; a < 2; ++a)
#pragma unroll
        for (int b = 0; b < 2; ++b)
#pragma unroll
            for (int m = 0; m < 4; ++m)
#pragma unroll
                for (int n = 0; n < 2; ++n) acc[a][b][m][n] = (f32x4){0.f, 0.f, 0.f, 0.f};
    bf16x8 At[4][2], B0[2][2], B1[2][2];
    const char* cA = (const char*)g.A + (size_t)cur.pm * tstep; const char* cB = (const char*)g.Bt + (size_t)cur.pn * tstep;
    const int rot = g.rot; const size_t rofs = (size_t)rot * kstep; const char* pA = cA + rofs; const char* pB = cB + rofs;
#define PG8_KT(x) ((size_t)(((x) + rot >= nt) ? (x) + rot - nt : (x) + rot))
    S.a_ready(cur);
    if constexpr (SP2) {
        PG8_STAGE(PG8_SB(0, 0), pB, voffB); PG8_STAGE(PG8_SB(0, 1), pB + hstep, voffB); PG8_STAGE(PG8_SA(0, 0), pA, voffA); PG8_STAGE(PG8_SA(0, 1), pA + hstep, voffA);
        if (wr == 1) PG8_BAR;
        PG8_WAIT_V(2); PG8_BAR;
        PG8_STAGE(PG8_SB(1, 0), pB + kstep, voffB); PG8_STAGE(PG8_SA(1, 0), pA + kstep, voffA); PG8_STAGE(PG8_SB(1, 1), pB + hstep + kstep, voffB);
        PG8_WAIT_V(6); PG8_BAR;
    } else {
        PG8_STAGE(PG8_SB(0, 0), pB, voffB); PG8_STAGE(PG8_SA(0, 0), pA, voffA); PG8_STAGE(PG8_SB(0, 1), pB + hstep, voffB); PG8_STAGE(PG8_SA(0, 1), pA + hstep, voffA);
        if (wr == 1) PG8_BAR;
        PG8_WAIT_V(4); PG8_BAR;
        PG8_STAGE(PG8_SB(1, 0), pB + kstep, voffB); PG8_STAGE(PG8_SA(1, 0), pA + kstep, voffA); PG8_STAGE(PG8_SB(1, 1), pB + hstep + kstep, voffB);
        PG8_WAIT_V(6); PG8_BAR;
    }
    for (;;) {
        const bool has_next = S.next(ui + 1, nxt);
        const char* nA = has_next ? (const char*)g.A + (size_t)nxt.pm * tstep : cA; const char* nB = has_next ? (const char*)g.Bt + (size_t)nxt.pn * tstep : cB;
        for (int t = 0; t < nt; t += 2) {
            if constexpr (Epi::MID) { if (t != 0 && (t & (Epi::MID_TILES - 1)) == 0) E.mid(acc, cur, t / Epi::MID_TILES, wr, wc, fr, fq); }
            const bool last = (t == nt - 2);
            const char* a1 = cA + PG8_KT(t + 1) * kstep;
            const char* a2 = last ? nA + rofs : cA + PG8_KT(t + 2) * kstep; const char* b2 = last ? nB + rofs : cB + PG8_KT(t + 2) * kstep;
            const char* a3 = a2 + kstep; const char* b3 = b2 + kstep;
            if (last && has_next) S.a_ready(nxt);
            if constexpr (SP2) {
            PG8_LDB(B0, 0, 0); PG8_LDB(B1, 0, 1); PG8_SCHED; PG8_LDA(At, 0, 0); PG8_STAGE(PG8_SA(1, 1), a1 + hstep, voffA);
            PG8_WAIT_V(8); PG8_WAIT_L(0); PG8_BAR; PG8_MMA(0, 0, At, B0); PG8_MMA(0, 1, At, B1); PG8_BAR; PG8_SCHED;
            PG8_LDA(At, 0, 1); PG8_STAGE(PG8_SB(0, 0), b2, voffB); PG8_STAGE(PG8_SB(0, 1), b2 + hstep, voffB); PG8_STAGE(PG8_SA(0, 0), a2, voffA);
            PG8_WAIT_V(8); PG8_WAIT_L(0); PG8_BAR; PG8_MMA(1, 0, At, B0); PG8_MMA(1, 1, At, B1); PG8_BAR; PG8_SCHED;
            PG8_LDB(B0, 1, 0); PG8_LDB(B1, 1, 1); PG8_SCHED; PG8_LDA(At, 1, 0); PG8_STAGE(PG8_SA(0, 1), a2 + hstep, voffA);
            PG8_WAIT_V(8); PG8_WAIT_L(0); PG8_BAR; PG8_MMA(0, 0, At, B0); PG8_MMA(0, 1, At, B1); PG8_BAR; PG8_SCHED;
            PG8_LDA(At, 1, 1); PG8_STAGE(PG8_SB(1, 0), b3, voffB); PG8_STAGE(PG8_SB(1, 1), b3 + hstep, voffB); PG8_STAGE(PG8_SA(1, 0), a3, voffA);
            PG8_WAIT_V(8); PG8_WAIT_L(0); PG8_BAR; PG8_MMA(1, 0, At, B0); PG8_MMA(1, 1, At, B1); PG8_BAR; PG8_SCHED;
            } else {
            PG8_LDB(B0, 0, 0); PG8_SCHED; PG8_LDA(At, 0, 0); PG8_STAGE(PG8_SA(1, 1), a1 + hstep, voffA);
            PG8_WAIT_L(8); PG8_BAR; PG8_WAIT_L(0); PG8_MMA(0, 0, At, B0); PG8_BAR; PG8_SCHED;
            PG8_LDB(B1, 0, 1); PG8_STAGE(PG8_SB(0, 0), b2, voffB);
            PG8_BAR; PG8_WAIT_L(0); PG8_MMA(0, 1, At, B1); PG8_BAR;
            PG8_LDA(At, 0, 1); PG8_STAGE(PG8_SA(0, 0), a2, voffA);
            PG8_BAR; PG8_WAIT_L(0); PG8_MMA(1, 0, At, B0); PG8_BAR; PG8_SCHED;
            PG8_STAGE(PG8_SB(0, 1), b2 + hstep, voffB);
            PG8_WAIT_V(6); PG8_BAR; PG8_MMA(1, 1, At, B1); PG8_BAR;
            PG8_LDB(B0, 1, 0); PG8_SCHED; PG8_LDA(At, 1, 0); PG8_STAGE(PG8_SA(0, 1), a2 + hstep, voffA);
            PG8_WAIT_L(8); PG8_BAR; PG8_WAIT_L(0); PG8_MMA(0, 0, At, B0); PG8_BAR; PG8_SCHED;
            PG8_LDB(B1, 1, 1); PG8_STAGE(PG8_SB(1, 0), b3, voffB);
            PG8_BAR; PG8_WAIT_L(0); PG8_MMA(0, 1, At, B1); PG8_BAR;
            PG8_LDA(At, 1, 1); PG8_STAGE(PG8_SA(1, 0), a3, voffA);
            PG8_BAR; PG8_WAIT_L(0); PG8_MMA(1, 0, At, B0); PG8_BAR; PG8_SCHED;
            PG8_STAGE(PG8_SB(1, 1), b3 + hstep, voffB);
            PG8_WAIT_V(6); PG8_BAR; PG8_MMA(1, 1, At, B1); PG8_BAR;
            }
        }
        if constexpr (ALIGN_EPI) { if (wr == 0) PG8_BAR; }
        if constexpr (!Epi::AFTER_DRAIN) { E(acc, cur, wr, wc, fr, fq); S.done(cur); }
        if (!has_next) break;
#pragma unroll
        for (int a = 0; a < 2; ++a)
#pragma unroll
            for (int b = 0; b < 2; ++b)
#pragma unroll
                for (int m = 0; m < 4; ++m)
#pragma unroll
                    for (int n = 0; n < 2; ++n) acc[a][b][m][n] = (f32x4){0.f, 0.f, 0.f, 0.f};
        cur = nxt; cA = nA; cB = nB; ++ui;
        if constexpr (ALIGN_EPI) { if (wr == 1) PG8_BAR; }
    }
    PG8_WAIT_V(0);
    if constexpr (!ALIGN_EPI) { if (wr == 0) PG8_BAR; }
    PG8_BAR;
    if constexpr (Epi::AFTER_DRAIN) { E.fused(acc, cur, wr, wc, fr, fq, lds, wid, lane); S.done(cur); }
#undef PG8_KT
#undef PG8_SA
#undef PG8_SB
#undef PG8_STAGE
#undef PG8_LDA
#undef PG8_LDB
#undef PG8_MMA
#undef PG8_WAIT_V
#undef PG8_WAIT_L
#undef PG8_BAR
#undef PG8_SCHED
}
}

constexpr int NWAVES = 8;
constexpr int DM = 1024, BATCH = 16, SEQ = 4096, DEPTH = 4, MTOK = BATCH * SEQ;
constexpr int NCHUNK = 2, MC = MTOK / NCHUNK, BC = BATCH / NCHUNK;
constexpr int CIN = 5004, NPROJ = 5120, P1W = 2048, GWID = 3072;
constexpr int DFF = 2752, DFFP = 2816, NFF1 = 2 * DFFP;
constexpr int NEXP = 8, DFE = 3584, NMOE1 = 2 * DFE;
constexpr int SLOTS = MC + 2048;
constexpr float EPS = 1e-6f;
constexpr int C_U = 0, C_V = 256, C_SBQ = 512, C_SBK = 768, C_SBV = 1024, C_CQ = 1280, C_KCMP = 1536, C_VCMP = 1600, C_KSLC = 1664, C_VSLC = 1728, C_KWIN = 1792, C_VWIN = 1856, C_CG = 1920;

constexpr size_t MiB = 1u << 20;
constexpr size_t WS_CTL = 0, CTL_ZERO_BYTES = 1 * MiB;
constexpr size_t WS_ROPE = 1 * MiB;
constexpr size_t WS_BIAS1 = 1 * MiB + 512 * 1024;
constexpr size_t WS_WIN = 2 * MiB;
constexpr size_t WS_WBR = 12 * MiB;
constexpr size_t WS_WOUT = 14 * MiB;
constexpr size_t WS_WC1 = 16 * MiB;
constexpr size_t WS_WF1 = 18 * MiB;
constexpr size_t WS_WF2 = 130 * MiB;
constexpr size_t WS_HN = 186 * MiB;
constexpr size_t WS_SCR = 314 * MiB;
constexpr size_t WS_P1 = WS_SCR;
constexpr size_t WS_G = WS_P1 + 128 * MiB;
constexpr size_t WS_Y = WS_G + 192 * MiB;
constexpr size_t WS_MG = WS_Y + 48 * MiB;
constexpr size_t WS_KVC = WS_MG + 64 * MiB;
constexpr size_t WS_UL = WS_KVC + 8 * MiB;
constexpr size_t WS_KC = WS_UL + 8 * MiB;
constexpr size_t WS_VT = WS_KC + 1 * MiB;
constexpr size_t WS_KCT = WS_VT + 24 * MiB;
constexpr size_t WS_MIX_END = WS_KCT + 1 * MiB;
constexpr size_t WS_HID = WS_SCR;
constexpr size_t WS_ROUTE = WS_SCR;
constexpr size_t WS_TOKMAP = WS_SCR + 1 * MiB;
constexpr size_t WS_WSLOT = WS_SCR + 2 * MiB;
constexpr size_t WS_XG = WS_SCR + 4 * MiB;
constexpr size_t WS_HIDM = WS_XG + 68 * MiB;
constexpr size_t WS_END = 800 * MiB;
static_assert(WS_MIX_END <= WS_END && WS_HID + (size_t)MTOK * DFFP * 2 <= WS_END && WS_HIDM + (size_t)SLOTS * DFE * 2 <= WS_END, "d_ws map");
static_assert(WS_WF1 + (size_t)NEXP * NMOE1 * DM * 2 <= WS_WF2 && WS_WF2 + (size_t)NEXP * DM * DFE * 2 <= WS_HN, "weight map");
static_assert((size_t)4 * SLOTS * 4 <= 1 * MiB, "tokmap");
constexpr int CW_BAR = 4096;
constexpr int CW_CNT = 131072;
constexpr int CW_CUR = 131072 + 256;
constexpr int MAX_BAR_REGIONS = 32;
constexpr int RING_OFF = 0, RING_BYTES = 131072;
constexpr int LDSCTL_OFF = RING_BYTES, MISC_OFF = LDSCTL_OFF + 320;
constexpr int TAB_OFF = LDSCTL_OFF + 1024;
constexpr int LDS_BYTES = 147456;

#define GAS __attribute__((address_space(1)))
#define LAS __attribute__((address_space(3)))
typedef unsigned short bf16;
typedef unsigned v4u __attribute__((ext_vector_type(4)));
typedef unsigned v2u __attribute__((ext_vector_type(2)));
typedef float f32x4 __attribute__((ext_vector_type(4)));
typedef int v4i __attribute__((ext_vector_type(4)));
typedef __bf16 bf16x2_t __attribute__((ext_vector_type(2)));
#define LDS_WAIT() asm volatile("s_waitcnt lgkmcnt(0)" ::: "memory")
#define VM_WAIT() asm volatile("s_waitcnt vmcnt(0)" ::: "memory")
__device__ __forceinline__ unsigned f2bf(float f) { unsigned u = __builtin_bit_cast(unsigned, f); return (u + 0x7fffu + ((u >> 16) & 1u)) >> 16; }
__device__ __forceinline__ unsigned pk2(float lo, float hi) { return f2bf(lo) | (f2bf(hi) << 16); }
__device__ __forceinline__ float bflo(unsigned u) { return __builtin_bit_cast(float, u << 16); }
__device__ __forceinline__ float bfhi(unsigned u) { return __builtin_bit_cast(float, u & 0xffff0000u); }
__device__ __forceinline__ float bf1(bf16 h) { return __builtin_bit_cast(float, (unsigned)h << 16); }
__device__ __forceinline__ float dot2bf(unsigned a, unsigned b, float c) { return __builtin_amdgcn_fdot2_f32_bf16(__builtin_bit_cast(bf16x2_t, a), __builtin_bit_cast(bf16x2_t, b), c, false); }
#ifdef EMU_FP8
__device__ __forceinline__ float q8r(float x, float s) { const int p = __builtin_amdgcn_cvt_pk_fp8_f32(x * s, x * s, 0, false); return __builtin_amdgcn_cvt_f32_fp8(p, 0) * (1.0f / s); }
#else
__device__ __forceinline__ float q8r(float x, float) { return x; }
#endif
__device__ __forceinline__ float fexp(float x) { return __builtin_amdgcn_exp2f(1.4426950408889634f * x); }
template <int X> __device__ __forceinline__ float swz_xor(float v) { return __builtin_bit_cast(float, __builtin_amdgcn_ds_swizzle(__builtin_bit_cast(int, v), (X << 10) | 0x1f)); }
__device__ __forceinline__ float wave_sum(float v, int lane) {
#pragma unroll
    for (int o = 1; o < 64; o <<= 1) v += __builtin_bit_cast(float, __builtin_amdgcn_ds_bpermute((lane ^ o) << 2, __builtin_bit_cast(int, v)));
    return v;
}
__device__ __forceinline__ float rdlane(float v, int l) { return __builtin_bit_cast(float, __builtin_amdgcn_readlane(__builtin_bit_cast(int, v), l)); }
__device__ __forceinline__ int bperm(int srclane, int v) { return __builtin_amdgcn_ds_bpermute(srclane << 2, v); }
__constant__ double ROPE_INVF[8] = {1.0, 0.19392274474868576, 0.037606030930863933, 0.0072926647372171093, 0.0014142135623730950, 0.00027424817567620730, 5.3182958969449883e-05, 1.0313385377212460e-05};
#define XB_TMO      128
#define XB_XCNT(j)  (256  + 64 * (j))
#define XB_XSUB(j)  (1280 + 64 * (j))
#define XB_XGEN(j)  (2304 + 64 * (j))
#define XB_TOP      3328
#define XB_TOPGEN   3392
#define XCD_BAR_WORDS 3456
#define XB_SPIN_CAP (1u << 18)

__device__ __forceinline__ unsigned xb_ld(unsigned* p)              { return __hip_atomic_load(p, __ATOMIC_RELAXED, __HIP_MEMORY_SCOPE_AGENT); }
__device__ __forceinline__ unsigned xb_add(unsigned* p, unsigned v) { return __hip_atomic_fetch_add(p, v, __ATOMIC_RELAXED, __HIP_MEMORY_SCOPE_AGENT); }
__device__ __forceinline__ unsigned xb_xcc_id() { return (unsigned)__builtin_amdgcn_s_getreg((3 << 11) | 20) & 0xFu; }
#define XB_SPIN(cond, bar) do { unsigned _sp = 0; while (cond) { __builtin_amdgcn_s_sleep(1); \
    if ((++_sp & 255u) == 0u) { if (xb_ld(&(bar)[XB_TMO])) break; if (_sp > XB_SPIN_CAP) { atomicAdd(&(bar)[XB_TMO], 1u); break; } } } } while (0)

__device__ __forceinline__ bool xb_thread0_w(unsigned w, unsigned z) { return w == 0u && __builtin_amdgcn_mbcnt_hi(~0u, __builtin_amdgcn_mbcnt_lo(~0u, z)) == 0u; }
struct XcdBarrier {
    unsigned* bar; unsigned x; unsigned w, z;
    volatile LAS unsigned* st;
};

__device__ __forceinline__ XcdBarrier xcd_barrier_post(unsigned* bar, volatile LAS unsigned* st) {
    XcdBarrier b; b.bar = bar; b.x = xb_xcc_id(); b.st = st; b.w = (unsigned)__builtin_amdgcn_readfirstlane((int)(threadIdx.x >> 6)); b.z = 0u;
    if (xb_thread0_w(b.w, b.z)) (void)xb_add(&bar[XB_XCNT(b.x)], 1u);
    return b;
}
__device__ __forceinline__ void xcd_barrier_complete(unsigned* bar, unsigned x, unsigned& nloc, unsigned& nx) {
    const unsigned G = gridDim.x * gridDim.y * gridDim.z;
    unsigned sum, cnt, mine, sp = 0u;
    for (;;) {
        sum = 0u; cnt = 0u; mine = 0u;
#pragma unroll
        for (unsigned j = 0; j < 16; ++j) { const unsigned c = xb_ld(&bar[XB_XCNT(j)]); sum += c; cnt += (c > 0u) ? 1u : 0u; mine = (j == x) ? c : mine; }
        if (sum == G) break;
        __builtin_amdgcn_s_sleep(1);
        if ((++sp & 255u) == 0u) { if (xb_ld(&bar[XB_TMO])) break; if (sp > XB_SPIN_CAP) { atomicAdd(&bar[XB_TMO], 1u); break; } }
    }
    nloc = mine > 0u ? mine : 1u; nx = cnt > 0u ? cnt : 1u;
}

__device__ __forceinline__ void xcd_barrier(const XcdBarrier& b) {
    asm volatile("s_waitcnt vmcnt(0)" ::: "memory");
    __syncthreads();
    if (xb_thread0_w(b.w, b.z)) {
        unsigned* bar = b.bar;
        __builtin_amdgcn_s_waitcnt(0);
        unsigned nloc = b.st[0], nx = b.st[1];
        if (nloc == 0u) { xcd_barrier_complete(bar, b.x, nloc, nx); b.st[0] = nloc; b.st[1] = nx; }
        const unsigned old = xb_add(&bar[XB_XSUB(b.x)], 1u);
        const unsigned gen = old / nloc;
        if (old + 1u == (gen + 1u) * nloc) {
            __builtin_amdgcn_fence(__ATOMIC_RELEASE, "agent");
            asm volatile("s_waitcnt vmcnt(0)" ::: "memory");
            const unsigned og = xb_add(&bar[XB_TOP], 1u);
            const unsigned tg = og / nx;
            if (og + 1u == (tg + 1u) * nx) xb_add(&bar[XB_TOPGEN], 1u);
            else XB_SPIN(xb_ld(&bar[XB_TOPGEN]) == tg, bar);
            __builtin_amdgcn_fence(__ATOMIC_ACQUIRE, "agent");
            xb_add(&bar[XB_XGEN(b.x)], 1u);
            asm volatile("s_waitcnt vmcnt(0)" ::: "memory");
        } else {
            XB_SPIN(xb_ld(&bar[XB_XGEN(b.x)]) == gen, bar);
            __builtin_amdgcn_fence(__ATOMIC_ACQUIRE, "agent");
            asm volatile("s_waitcnt vmcnt(0)" ::: "memory");
        }
    }
    __syncthreads();
}

struct Frame {
    LAS unsigned char* lds;
    unsigned* ctl;
    int tid, lane, wave, vcu, G, bx, zv, zs, rep;
    unsigned char* ws;
    const float* const* in;
    float* out;
};
#define WSP(T, off) ((T*)(F.ws + (off)))
__device__ __forceinline__ size_t toff(int row, int k, int K) { return (size_t)(row >> 8) * 256 * K + (size_t)(k >> 6) * (256 * 64) + (size_t)(row & 255) * 64 + (k & 63); }

#ifndef TILED_FFN1
#define TILED_FFN1 0
#endif
#ifndef Q8_W1
#define Q8_W1 0.f
#define Q8_W2 0.f
#define Q8_HN 0.f
#define Q8_HID 0.f
#endif
__device__ __forceinline__ int map_row(int kind, int off, int n) { return kind == 0 ? n + off : (kind == 1 ? (n < 1932 ? n : n + 116) : ((n >> 7) * 256 + (n & 127) + off)); }
__device__ __forceinline__ void tr_item(const float* W, int ldw, int N, int ks, int n0, bf16* WT, int ldt, int kd, int kind, int off, LAS unsigned char* scr, int lane, float q8s = 0.f, int tiled = 0) {
    const int nq = (lane & 15) * 4, kq = lane >> 4;
    f32x4 x[16];
#pragma unroll
    for (int i = 0; i < 16; ++i) x[i] = (n0 + nq < N) ? *(const f32x4*)(W + (size_t)(ks + 4 * i + kq) * ldw + n0 + nq) : (f32x4){0.f, 0.f, 0.f, 0.f};
#pragma unroll
    for (int i = 0; i < 16; ++i) { const int k = 4 * i + kq;
#pragma unroll
        for (int c = 0; c < 4; ++c) { float wv = x[i][c]; if (q8s > 0.f) wv = q8r(wv, q8s); *(LAS bf16*)(scr + (nq + c) * 136 + k * 2) = (bf16)f2bf(wv); } }
    LDS_WAIT(); asm volatile("" ::: "memory");
    if (n0 + lane < N) { const LAS v2u* s = (const LAS v2u*)(scr + lane * 136); const int mr = map_row(kind, off, n0 + lane); bf16* dst = tiled ? WT + toff(mr, kd, ldt) : WT + (size_t)mr * ldt + kd;
#pragma unroll
        for (int q = 0; q < 8; ++q) { const v2u a = s[2 * q], b = s[2 * q + 1]; *(v4u*)(dst + 8 * q) = (v4u){a.x, a.y, b.x, b.y}; } }
    LDS_WAIT(); asm volatile("" ::: "memory");
}
__device__ __forceinline__ void conv(Frame& F, const float* W, size_t sW, int nb, int ldw, int N, int ks0, int K, bf16* WT, size_t sWT, int ldt, int kd0, int kind, int off, float q8s = 0.f, int tiled = 0) {
    LAS unsigned char* scr = F.lds + RING_OFF + F.wave * 16384;
    const int gw = F.vcu * NWAVES + F.wave, NGW = F.G * NWAVES;
    const int nblk = (N + 63) / 64, per = (K / 64) * nblk, total = per * nb;
    for (int it = gw; it < total; it += NGW) { const int b = it / per, r = it % per, kb = r / nblk, nbk = r % nblk;
        tr_item(W + (size_t)b * sW, ldw, N, ks0 + 64 * kb, 64 * nbk, WT + (size_t)b * sWT, ldt, kd0 + 64 * kb, kind, off, scr, F.lane, q8s, tiled); }
}
__device__ __forceinline__ void zero_block(Frame& F, bf16* WT, int ldt, int r0, int rows, int c0, int cols, int tiled = 0) {
    const int gt = (F.vcu * NWAVES + F.wave) * 64 + F.lane, NT = F.G * NWAVES * 64, cpr = cols / 8;
    for (int i = gt; i < rows * cpr; i += NT) { const int r = i / cpr, c = i % cpr; const unsigned z = (unsigned)F.zv; *(v4u*)(tiled ? WT + toff(r0 + r, c0 + 8 * c, ldt) : WT + (size_t)(r0 + r) * ldt + c0 + 8 * c) = (v4u){z, z, z, z}; }
}
__device__ __forceinline__ void p_convert(Frame& F, int layer) {
    const int j = layer >> 1;
    conv(F, F.in[2] + (size_t)layer * DM * CIN, 0, 1, CIN, CIN, 0, DM, WSP(bf16, WS_WIN), 0, DM, 0, 1, 0);
    zero_block(F, WSP(bf16, WS_WIN), DM, 1932, 116, 0, DM);
    conv(F, F.in[9] + (size_t)layer * 3 * 256 * DM, (size_t)256 * DM, 3, DM, DM, 0, 256, WSP(bf16, WS_WBR), (size_t)DM * 256, 256, 0, 0, 0);
    conv(F, F.in[10] + (size_t)layer * DM * DM, 0, 1, DM, DM, 0, DM, WSP(bf16, WS_WOUT), 0, DM, 0, 0, 0);
    conv(F, F.in[7] + (size_t)layer * 2 * 2048 * 256, (size_t)2048 * 256, 2, 256, 256, 0, 1024, WSP(bf16, WS_WC1), (size_t)512 * 1024, 1024, 0, 0, 0);
    conv(F, F.in[7] + (size_t)layer * 2 * 2048 * 256, (size_t)2048 * 256, 2, 256, 256, 1024, 1024, WSP(bf16, WS_WC1), (size_t)512 * 1024, 1024, 0, 0, 256);
    if ((layer & 1) == 0) {
        conv(F, F.in[12] + (size_t)j * DM * DFF, 0, 1, DFF, DFF, 0, DM, WSP(bf16, WS_WF1), 0, DM, 0, 2, 0, Q8_W1, TILED_FFN1);
        conv(F, F.in[13] + (size_t)j * DM * DFF, 0, 1, DFF, DFF, 0, DM, WSP(bf16, WS_WF1), 0, DM, 0, 2, 128, Q8_W1, TILED_FFN1);
        zero_block(F, WSP(bf16, WS_WF1), DM, 21 * 256 + 64, 64, 0, DM, TILED_FFN1);
        zero_block(F, WSP(bf16, WS_WF1), DM, 21 * 256 + 128 + 64, 64, 0, DM, TILED_FFN1);
        conv(F, F.in[14] + (size_t)j * DFF * DM, 0, 1, DM, DM, 0, DFF, WSP(bf16, WS_WF2), 0, DFFP, 0, 0, 0, Q8_W2);
        zero_block(F, WSP(bf16, WS_WF2), DFFP, 0, DM, DFF, DFFP - DFF);
    } else {
        conv(F, F.in[16] + (size_t)j * NEXP * DM * DFE, (size_t)DM * DFE, NEXP, DFE, DFE, 0, DM, WSP(bf16, WS_WF1), (size_t)NMOE1 * DM, DM, 0, 2, 0, Q8_W1);
        conv(F, F.in[17] + (size_t)j * NEXP * DM * DFE, (size_t)DM * DFE, NEXP, DFE, DFE, 0, DM, WSP(bf16, WS_WF1), (size_t)NMOE1 * DM, DM, 0, 2, 128, Q8_W1);
        conv(F, F.in[18] + (size_t)j * NEXP * DFE * DM, (size_t)DFE * DM, NEXP, DM, DM, 0, DFE, WSP(bf16, WS_WF2), (size_t)DM * DFE, DFE, 0, 0, 0, Q8_W2);
    }
    if (F.bx < 8) {
        __syncthreads();
        const int kv = F.bx >> 2, jj = (F.bx & 3) * 64 + F.lane;
        const float* pos = F.in[6] + (size_t)(layer * 2 + kv) * 2048; const float* w1 = F.in[7] + (size_t)(layer * 2 + kv) * 2048 * 256;
        float a = 0.f;
        float a1 = 0.f, a2 = 0.f, a3 = 0.f;
#pragma unroll 8
        for (int k = 0; k < 256; k += 4) { const int kk = F.wave * 256 + k;
            a += pos[kk] * w1[(size_t)kk * 256 + jj]; a1 += pos[kk + 1] * w1[(size_t)(kk + 1) * 256 + jj]; a2 += pos[kk + 2] * w1[(size_t)(kk + 2) * 256 + jj]; a3 += pos[kk + 3] * w1[(size_t)(kk + 3) * 256 + jj]; }
        a = (a + a1) + (a2 + a3);
        LAS float* red = (LAS float*)(F.lds + RING_OFF);
        red[F.wave * 64 + F.lane] = a;
        __syncthreads();
        if (F.wave == 0) { float s = 0.f;
#pragma unroll
            for (int w = 0; w < 8; ++w) s += red[w * 64 + F.lane];
            WSP(float, WS_BIAS1)[kv * 256 + jj] = s; }
        __syncthreads();
    }
    if (layer == 0) {
        const int gt = (F.vcu * NWAVES + F.wave) * 64 + F.lane, NT = F.G * NWAVES * 64;
        for (int idx = gt; idx < SEQ * 8; idx += NT) { const int pos = idx >> 3, i = idx & 7;
            const double invf = ROPE_INVF[i];
            double rev = (double)pos * invf * 0.15915494309189535; rev -= __builtin_floor(rev);
            WSP(float, WS_ROPE)[idx] = __builtin_amdgcn_cosf((float)rev); WSP(float, WS_ROPE)[SEQ * 8 + idx] = __builtin_amdgcn_sinf((float)rev); }
    }
}

template <int MODE> __device__ __forceinline__ void p_norm(Frame& F, const float* src, const float* g, const float* rw, int jmoe, float q8s = 0.f, int tiled = 0) {
    const int gw = F.vcu * NWAVES + F.wave, NGW = F.G * NWAVES, lane = F.lane;
    LAS int* hist = (LAS int*)(F.lds + TAB_OFF) + 192;
    if (MODE == 1) {
        if (F.tid < 32) hist[F.tid] = 0;
        const int gt = gw * 64 + lane, NT = NGW * 64; int* tm = WSP(int, WS_TOKMAP);
        for (int i = gt; i < 4 * SLOTS; i += NT) tm[i] = -1;
        for (int i = F.tid; i < DM * NEXP / 4; i += NWAVES * 64) *(LAS f32x4*)(F.lds + RING_OFF + 16 * i) = ((const f32x4*)rw)[i];
        __syncthreads();
    }
    f32x4 gv[4];
#pragma unroll
    for (int jx = 0; jx < 4; ++jx) gv[jx] = ((const f32x4*)g)[lane + 64 * jx];
    constexpr int ROWS = (MODE == 1) ? 2 : 4;
    for (int m0 = gw; m0 < MTOK; m0 += ROWS * NGW) {
        f32x4 v[ROWS][4]; float ss[ROWS];
#pragma unroll
        for (int u = 0; u < ROWS; ++u) { const int m = m0 + u * NGW; const f32x4* xr = (const f32x4*)(src + (size_t)(m < MTOK ? m : m0) * DM) + lane;
#pragma unroll
            for (int jx = 0; jx < 4; ++jx) v[u][jx] = xr[64 * jx]; }
#pragma unroll
        for (int u = 0; u < ROWS; ++u) { float s = 0.f;
#pragma unroll
            for (int jx = 0; jx < 4; ++jx) s += (v[u][jx].x * v[u][jx].x + v[u][jx].y * v[u][jx].y) + (v[u][jx].z * v[u][jx].z + v[u][jx].w * v[u][jx].w);
            ss[u] = s; }
#pragma unroll
        for (int o = 1; o < 64; o <<= 1) {
#pragma unroll
            for (int u = 0; u < ROWS; ++u) ss[u] += __builtin_bit_cast(float, __builtin_amdgcn_ds_bpermute((lane ^ o) << 2, __builtin_bit_cast(int, ss[u]))); }
        float lgall[MODE == 1 ? ROWS : 1][8];
        if (MODE == 1) {
            float rs[ROWS];
#pragma unroll
            for (int u = 0; u < ROWS; ++u) { rs[u] = 1.0f / sqrtf(ss[u] * (1.f / DM) + EPS);
#pragma unroll
                for (int e = 0; e < 8; ++e) lgall[u][e] = 0.f; }
#pragma unroll
            for (int jx = 0; jx < 4; ++jx) { const LAS f32x4* wr = (const LAS f32x4*)(F.lds + RING_OFF + (size_t)(4 * lane + 256 * jx) * 32);
#pragma unroll
                for (int r = 0; r < 4; ++r) { const f32x4 a = wr[2 * r], b = wr[2 * r + 1];
#pragma unroll
                    for (int u = 0; u < ROWS; ++u) { const float xv = v[u][jx][r] * rs[u] * gv[jx][r];
                        lgall[u][0] += xv * a.x; lgall[u][1] += xv * a.y; lgall[u][2] += xv * a.z; lgall[u][3] += xv * a.w; lgall[u][4] += xv * b.x; lgall[u][5] += xv * b.y; lgall[u][6] += xv * b.z; lgall[u][7] += xv * b.w; } } }
        }
#pragma unroll
        for (int u = 0; u < ROWS; ++u) { const int m = m0 + u * NGW; if (m >= MTOK) continue;
            const float rstd = 1.0f / sqrtf(ss[u] * (1.f / DM) + EPS);
#pragma unroll
            for (int jx = 0; jx < 4; ++jx) v[u][jx] = v[u][jx] * rstd * gv[jx];
            if (MODE == 2) {
                f32x4* o = (f32x4*)(F.out + (size_t)m * DM) + lane;
#pragma unroll
                for (int jx = 0; jx < 4; ++jx) o[64 * jx] = v[u][jx];
            } else {
                unsigned long long* o8 = (unsigned long long*)(WSP(bf16, WS_HN) + (size_t)m * DM) + lane;
#pragma unroll
                for (int jx = 0; jx < 4; ++jx) { f32x4 w = v[u][jx];
                    if (tiled) { *(unsigned long long*)(WSP(bf16, WS_HN) + toff(m, 4 * lane + 256 * jx, DM)) = (unsigned long long)pk2(w.x, w.y) | ((unsigned long long)pk2(w.z, w.w) << 32); continue; } if (q8s > 0.f) { w.x = q8r(w.x, q8s); w.y = q8r(w.y, q8s); w.z = q8r(w.z, q8s); w.w = q8r(w.w, q8s); }
                    o8[64 * jx] = (unsigned long long)pk2(w.x, w.y) | ((unsigned long long)pk2(w.z, w.w) << 32); }
            }
            if (MODE == 1) {
                float lg[8];
#pragma unroll
                for (int e = 0; e < 8; ++e) lg[e] = lgall[u][e];
                float h4[4], h2[2], h1;
                { const bool up = lane & 1;
#pragma unroll
                  for (int i = 0; i < 4; ++i) { const float keep = up ? lg[4 + i] : lg[i], send = up ? lg[i] : lg[4 + i]; h4[i] = keep + __builtin_bit_cast(float, bperm(lane ^ 1, __builtin_bit_cast(int, send))); } }
                { const bool up = lane & 2;
#pragma unroll
                  for (int i = 0; i < 2; ++i) { const float keep = up ? h4[2 + i] : h4[i], send = up ? h4[i] : h4[2 + i]; h2[i] = keep + __builtin_bit_cast(float, bperm(lane ^ 2, __builtin_bit_cast(int, send))); } }
                { const bool up = lane & 4; const float keep = up ? h2[1] : h2[0], send = up ? h2[0] : h2[1]; h1 = keep + __builtin_bit_cast(float, bperm(lane ^ 4, __builtin_bit_cast(int, send))); }
                h1 += __builtin_bit_cast(float, bperm(lane ^ 8, __builtin_bit_cast(int, h1))); h1 += __builtin_bit_cast(float, bperm(lane ^ 16, __builtin_bit_cast(int, h1))); h1 += __builtin_bit_cast(float, bperm(lane ^ 32, __builtin_bit_cast(int, h1)));
                lg[0] = rdlane(h1, 0); lg[1] = rdlane(h1, 4); lg[2] = rdlane(h1, 2); lg[3] = rdlane(h1, 6); lg[4] = rdlane(h1, 1); lg[5] = rdlane(h1, 5); lg[6] = rdlane(h1, 3); lg[7] = rdlane(h1, 7);
                int e0 = 0; float v0 = lg[0];
#pragma unroll
                for (int e = 1; e < 8; ++e) if (lg[e] > v0) { v0 = lg[e]; e0 = e; }
                int e1 = -1; float v1 = -INFINITY;
#pragma unroll
                for (int e = 0; e < 8; ++e) if (e != e0 && lg[e] > v1) { v1 = lg[e]; e1 = e; }
                const float w0 = 1.0f / (1.0f + fexp(v1 - v0)), w1 = 1.0f - w0;
                if (lane == 0) { WSP(v4i, WS_ROUTE)[m] = (v4i){e0, e1, __builtin_bit_cast(int, w0), __builtin_bit_cast(int, w1)};
                    const int c = m / MC; if (!F.rep) { atomicAdd((int*)&hist[(c * 2 + 0) * 8 + e0], 1); atomicAdd((int*)&hist[(c * 2 + 1) * 8 + e1], 1); } }
            }
        }
    }
    if (MODE == 1) {
        __syncthreads();
        if (F.tid < 32) { const int h = hist[F.tid]; if (h) atomicAdd(F.ctl + CW_CNT + jmoe * 32 + F.tid, (unsigned)h); }
    }
}

__device__ __forceinline__ void p_prep(Frame& F) {
    const int gw = F.vcu * NWAVES + F.wave, NGW = F.G * NWAVES, lane = F.lane;
    bf16* P1 = WSP(bf16, WS_P1); bf16* KVC = WSP(bf16, WS_KVC); const float* rope = WSP(float, WS_ROPE);
    const int vec = lane >> 3, ri = lane & 7; const int cb = vec < 4 ? C_CQ + vec * 64 : (vec == 4 ? C_KCMP : (vec == 5 ? C_KSLC : C_KWIN));
    for (int row0 = gw; row0 < MC; row0 += 4 * NGW) {
        float x1[4], x2[4], cc[4], ss[4]; bf16 kc48[4], vc64[4];
#pragma unroll
        for (int k = 0; k < 4; ++k) { const int row = row0 + k * NGW < MC ? row0 + k * NGW : row0; const bf16* p = P1 + (size_t)row * P1W; const int pos = row & (SEQ - 1);
            const int cl = lane < 56 ? cb + ri : C_CQ;
            x1[k] = bf1(p[cl]); x2[k] = bf1(p[cl + 8]); cc[k] = rope[pos * 8 + ri]; ss[k] = rope[SEQ * 8 + pos * 8 + ri];
            if (F.rep) { cc[k] = 1.f; ss[k] = 0.f; }
            kc48[k] = p[C_KCMP + 16 + (lane < 48 ? lane : 0)]; vc64[k] = p[C_VCMP + lane]; }
#pragma unroll
        for (int k = 0; k < 4; ++k) { const int row = row0 + k * NGW; if (row >= MC) continue; bf16* p = P1 + (size_t)row * P1W;
            if (lane < 56) { const bf16 o1 = (bf16)f2bf(x1[k] * cc[k] - x2[k] * ss[k]), o2 = (bf16)f2bf(x2[k] * cc[k] + x1[k] * ss[k]);
                p[cb + ri] = o1; p[cb + ri + 8] = o2;
                if (vec == 4) { KVC[(size_t)row * 64 + ri] = o1; KVC[(size_t)row * 64 + ri + 8] = o2; } }
            if (lane < 48) KVC[(size_t)row * 64 + 16 + lane] = kc48[k];
            KVC[(size_t)MC * 64 + (size_t)row * 64 + lane] = vc64[k]; }
    }
    bf16* VT = WSP(bf16, WS_VT);
    for (int it = gw; it < 6 * BC * 64; it += NGW) { const int which = it / (BC * 64), r = it % (BC * 64), b = r >> 6, blk = r & 63;
        const v4u* src = (const v4u*)(P1 + ((size_t)b * SEQ + blk * 64 + lane) * P1W + (which == 0 ? C_VSLC : (which == 1 ? C_VWIN : C_SBV + (which - 2) * 64)));
        bf16* dst = VT + ((size_t)(which * BC + b) * 64) * SEQ + blk * 64 + lane;
        v4u xs[8];
#pragma unroll
        for (int i = 0; i < 8; ++i) xs[i] = src[i];
#pragma unroll
        for (int i = 0; i < 8; ++i) { const v4u x = xs[i];
            dst[(size_t)(8 * i + 0) * SEQ] = (bf16)(x.x & 0xffffu); dst[(size_t)(8 * i + 1) * SEQ] = (bf16)(x.x >> 16);
            dst[(size_t)(8 * i + 2) * SEQ] = (bf16)(x.y & 0xffffu); dst[(size_t)(8 * i + 3) * SEQ] = (bf16)(x.y >> 16);
            dst[(size_t)(8 * i + 4) * SEQ] = (bf16)(x.z & 0xffffu); dst[(size_t)(8 * i + 5) * SEQ] = (bf16)(x.z >> 16);
            dst[(size_t)(8 * i + 6) * SEQ] = (bf16)(x.w & 0xffffu); dst[(size_t)(8 * i + 7) * SEQ] = (bf16)(x.w >> 16); }
    }
}
__device__ __forceinline__ void p_sgu(Frame& F, int layer) {
    LAS float* vn = (LAS float*)(F.lds + RING_OFF);
    const bf16* P1 = WSP(bf16, WS_P1); bf16* Ya = WSP(bf16, WS_Y);
    const float* gain = F.in[3] + (size_t)layer * 256; const float* sw = F.in[4] + (size_t)layer * 4 * 128 * 128; const float* sb = F.in[5] + (size_t)layer * 4 * 128;
    const int lane = F.lane, wave = F.wave;
    for (int item = F.vcu; item < MC / 128; item += F.G) {
        const size_t r0 = (size_t)item * 128;
        __syncthreads();
        for (int rr = 0; rr < 16; ++rr) { const int r = wave * 16 + rr; const v2u raw = *(const v2u*)(P1 + (r0 + r) * P1W + C_V + 4 * lane);
            const float a = bflo(raw.x), b = bfhi(raw.x), c = bflo(raw.y), d = bfhi(raw.y);
            const float rstd = 1.0f / sqrtf(wave_sum((a * a + b * b) + (c * c + d * d), lane) * (1.f / 256.f) + EPS);
            const f32x4 gg = ((const f32x4*)gain)[lane];
            *(LAS f32x4*)(vn + r * 256 + 4 * lane) = (f32x4){a * rstd * gg.x, b * rstd * gg.y, c * rstd * gg.z, d * rstd * gg.w}; }
        __syncthreads();
        const int g = wave & 3, half = wave >> 2;
        for (int i = 0; i < 64; ++i) { const int t = 2 * i + half;
            const float* wrow = sw + ((size_t)g * 128 + t) * 128;
            const float w_lo = wrow[lane], w_hi = wrow[64 + lane];
            float acc = 0.f;
            for (int s = 0; s <= t; ++s) { const float w = (s < 64) ? rdlane(w_lo, s) : rdlane(w_hi, s - 64); acc += w * vn[s * 256 + g * 64 + lane]; }
            const float u = bf1(P1[(r0 + t) * P1W + C_U + g * 64 + lane]);
#ifdef ABL_SGUMIX
            acc = 0.f;
#endif
            Ya[(r0 + t) * 256 + g * 64 + lane] = (bf16)f2bf(u * (acc + sb[g * 128 + t])); }
    }
    __syncthreads();
}

__device__ __forceinline__ void p_cmpfin(Frame& F, int layer) {
    const int gw = F.vcu * NWAVES + F.wave, NGW = F.G * NWAVES, lane = F.lane;
    const float* UL = WSP(float, WS_UL); const float* bias = WSP(float, WS_BIAS1); bf16* KC = WSP(bf16, WS_KC);
    LAS float* w2l = (LAS float*)(F.lds + RING_OFF);
    __syncthreads();
    { const f32x4* src = (const f32x4*)(F.in[8] + (size_t)layer * 2 * 256 * 64);
#pragma unroll 4
      for (int i = F.tid; i < 2 * 256 * 64 / 4; i += NWAVES * 64) *(LAS f32x4*)(w2l + 4 * i) = src[i]; }
    __syncthreads();
    for (int it = gw; it < 2 * BC * 255; it += NGW) { const int kv = it / (BC * 255), r = it % (BC * 255), b = r / 255, m = r % 255;
        const LAS float* w2 = w2l + kv * 256 * 64;
        const float* U = UL + (size_t)(kv * 2048 + b * 256 + m) * 512; const float* L = U + 512 + 256;
        float hv[4];
#pragma unroll
        for (int q = 0; q < 4; ++q) hv[q] = pg8::gelu_tanh(U[64 * q + lane] + L[64 * q + lane] + bias[kv * 256 + 64 * q + lane]);
        float acc0 = 0.f, acc1 = 0.f;
#pragma unroll
        for (int q = 0; q < 4; ++q)
#pragma unroll 8
            for (int jj = 0; jj < 64; jj += 2) { acc0 += rdlane(hv[q], jj) * w2[(64 * q + jj) * 64 + lane]; acc1 += rdlane(hv[q], jj + 1) * w2[(64 * q + jj + 1) * 64 + lane]; }
        const float acc = acc0 + acc1;
        KC[((size_t)(kv * BC + b) * 256 + m) * 64 + lane] = (bf16)f2bf(acc);
        if (kv == 1) { WSP(bf16, WS_KCT)[((size_t)b * 64 + lane) * 256 + m] = (bf16)f2bf(acc); if (m == 254) WSP(bf16, WS_KCT)[((size_t)b * 64 + lane) * 256 + 255] = (bf16)0; }
        else if (m == 254) KC[((size_t)b * 256 + 255) * 64 + lane] = (bf16)0; }
    __syncthreads();
}

__device__ __forceinline__ void p_stick(Frame& F) {
    const int gw = F.vcu * NWAVES + F.wave, NGW = F.G * NWAVES, lane = F.lane;
    const bf16* P1 = WSP(bf16, WS_P1); bf16* Yb = WSP(bf16, WS_Y) + (size_t)MC * 256;
    for (int item = gw; item < BC * 4 * 64; item += NGW) { const int tb = item & 63, h = (item >> 6) & 3, b = item >> 8;
        const int t = tb * 64 + lane; const size_t row = (size_t)b * SEQ + t;
        unsigned q[32];
        { const v4u* qp = (const v4u*)(P1 + row * P1W + C_SBQ + h * 64);
#pragma unroll
          for (int i = 0; i < 8; ++i) { const v4u x = qp[i]; q[4 * i] = x.x; q[4 * i + 1] = x.y; q[4 * i + 2] = x.z; q[4 * i + 3] = x.w; } }
        float o[64];
#pragma unroll
        for (int d = 0; d < 64; ++d) o[d] = 0.f;
        float R = 0.f;
        const bf16* kb = P1 + (size_t)b * SEQ * P1W + C_SBK + h * 64; const bf16* vb = P1 + (size_t)b * SEQ * P1W + C_SBV + h * 64;
        for (int s = t - 1; s >= 0; --s) {
            if (R < -100.f) break;
            const v4u* kp = (const v4u*)(kb + (size_t)s * P1W); const v4u* vp = (const v4u*)(vb + (size_t)s * P1W);
            float z0 = 0.f, z1 = 0.f;
#pragma unroll
            for (int i = 0; i < 8; ++i) { const v4u k = kp[i]; z0 = dot2bf(k.x, q[4 * i], z0); z1 = dot2bf(k.y, q[4 * i + 1], z1); z0 = dot2bf(k.z, q[4 * i + 2], z0); z1 = dot2bf(k.w, q[4 * i + 3], z1); }
            const float z = (z0 + z1) * 0.125f;
            const float tt = 0.6931471805599453f * __builtin_amdgcn_logf(1.0f + fexp(-__builtin_fabsf(z)));
            const float lb = fminf(z, 0.f) - tt, l1m = fminf(-z, 0.f) - tt;
            const float a = fexp(lb + R); R += l1m;
#pragma unroll
            for (int i = 0; i < 8; ++i) { const v4u v = vp[i];
                o[8 * i] += a * bflo(v.x); o[8 * i + 1] += a * bfhi(v.x); o[8 * i + 2] += a * bflo(v.y); o[8 * i + 3] += a * bfhi(v.y);
                o[8 * i + 4] += a * bflo(v.z); o[8 * i + 5] += a * bfhi(v.z); o[8 * i + 6] += a * bflo(v.w); o[8 * i + 7] += a * bfhi(v.w); }
        }
        v4u* op = (v4u*)(Yb + row * 256 + h * 64);
#pragma unroll
        for (int i = 0; i < 8; ++i) op[i] = (v4u){pk2(o[8 * i], o[8 * i + 1]), pk2(o[8 * i + 2], o[8 * i + 3]), pk2(o[8 * i + 4], o[8 * i + 5]), pk2(o[8 * i + 6], o[8 * i + 7])};
    }
}

struct Soft { float mx, l; };
__device__ __forceinline__ float dotq(const LAS v4u* ql, const bf16* kp_) {
    const v4u* kp = (const v4u*)kp_; float z0 = 0.f, z1 = 0.f;
#pragma unroll
    for (int i = 0; i < 8; ++i) { const v4u k = kp[i]; const v4u q = ql[i]; z0 = dot2bf(k.x, q.x, z0); z1 = dot2bf(k.y, q.y, z1); z0 = dot2bf(k.z, q.z, z0); z1 = dot2bf(k.w, q.w, z1); }
    return (z0 + z1) * 0.125f;
}
__device__ __forceinline__ void axpy_row(float p, const bf16* vp_, float (&o)[64]) {
    const v4u* vp = (const v4u*)vp_;
#pragma unroll
    for (int i = 0; i < 8; ++i) { const v4u v = vp[i];
        o[8 * i] += p * bflo(v.x); o[8 * i + 1] += p * bfhi(v.x); o[8 * i + 2] += p * bflo(v.y); o[8 * i + 3] += p * bfhi(v.y);
        o[8 * i + 4] += p * bflo(v.z); o[8 * i + 5] += p * bfhi(v.z); o[8 * i + 6] += p * bflo(v.w); o[8 * i + 7] += p * bfhi(v.w); }
}
__device__ __forceinline__ void nsa_step(const LAS v4u* ql, const bf16* kp_, const bf16* vp_, Soft& S, float (&o)[64]) {
    const float s = dotq(ql, kp_);
    if (s > S.mx) { const float sc = fexp(S.mx - s); S.l *= sc;
#pragma unroll
        for (int d = 0; d < 64; ++d) o[d] *= sc;
        S.mx = s; }
    const float p = fexp(s - S.mx); S.l += p;
    asm volatile("" ::: "memory");
    axpy_row(p, vp_, o);
}
__device__ __forceinline__ void nsa_accum(bf16* yrow, bool first, float sc, const float (&o)[64]) {
    v4u* op = (v4u*)yrow;
#pragma unroll
    for (int i = 0; i < 8; ++i) { v4u old = (v4u){0u, 0u, 0u, 0u}; if (!first) old = op[i];
        op[i] = (v4u){pk2(bflo(old.x) + sc * o[8 * i], bfhi(old.x) + sc * o[8 * i + 1]), pk2(bflo(old.y) + sc * o[8 * i + 2], bfhi(old.y) + sc * o[8 * i + 3]),
                      pk2(bflo(old.z) + sc * o[8 * i + 4], bfhi(old.z) + sc * o[8 * i + 5]), pk2(bflo(old.w) + sc * o[8 * i + 6], bfhi(old.w) + sc * o[8 * i + 7])}; }
}
__device__ __forceinline__ void p_nsa(Frame& F) {
    const int gw = F.vcu * NWAVES + F.wave, NGW = F.G * NWAVES, lane = F.lane;
    const bf16* P1 = WSP(bf16, WS_P1); const bf16* KC = WSP(bf16, WS_KC); bf16* Yc = WSP(bf16, WS_Y) + (size_t)2 * MC * 256;
    LAS float* imp = (LAS float*)(F.lds + RING_OFF + F.wave * 4096);
    LAS v4u* ql = (LAS v4u*)(F.lds + RING_OFF + 32768 + F.wave * 9216 + lane * 144);
    const int qi = lane >> 2, h = lane & 3;
    for (int item = gw; item < BC * 256; item += NGW) { const int b = item >> 8, tg = item & 255;
        const int t = tg * 16 + qi; const size_t row = (size_t)b * SEQ + t; const bf16* prow = P1 + row * P1W;
        { const v4u* qp = (const v4u*)(prow + C_CQ + h * 64);
#pragma unroll
          for (int i = 0; i < 8; ++i) ql[i] = qp[i]; }
        const float g0 = bf1(prow[C_CG + h * 3]), g1 = bf1(prow[C_CG + h * 3 + 1]), g2 = bf1(prow[C_CG + h * 3 + 2]);
        bf16* yrow = Yc + row * 256 + h * 64;
        float o[64];
        for (int i = lane; i < 1024; i += 64) imp[i] = 0.f;
        const int nv = t >= 31 ? ((t - 31) >> 4) + 1 : 0; const int nvmax = (tg * 16 + 15 >= 31) ? ((tg * 16 + 15 - 31) >> 4) + 1 : 0;
        const bf16* kc = KC + (size_t)(0 * BC + b) * 256 * 64; const bf16* vc = KC + (size_t)(1 * BC + b) * 256 * 64;
        { float mx = -INFINITY, l = 0.f;
          for (int m = 0; m < nvmax; ++m) { const float s = dotq(ql, kc + m * 64); if (m < nv) { if (s > mx) { l *= fexp(mx - s); mx = s; } l += fexp(s - mx); } }
          const float rl = l > 0.f ? 1.0f / l : 0.f;
#pragma unroll
          for (int d = 0; d < 64; ++d) o[d] = 0.f;
          for (int m = 0; m < nvmax; ++m) { const float s = dotq(ql, kc + m * 64); const float p = (m < nv) ? fexp(s - mx) * rl : 0.f;
              asm volatile("" ::: "memory");
              axpy_row(p, vc + m * 64, o);
              float P = p + __builtin_bit_cast(float, bperm(lane ^ 1, __builtin_bit_cast(int, p))); P += __builtin_bit_cast(float, bperm(lane ^ 2, __builtin_bit_cast(int, P)));
              if (h == 0) { const int j0 = m >> 2; const bool edge = (m & 3) == 3; imp[qi * 64 + j0] += edge ? 0.5f * P : P; if (edge) imp[qi * 64 + j0 + 1] += 0.5f * P; } }
          nsa_accum(yrow, true, g0, o); }
        unsigned long long mask = 0ull;
        { const int cur = t >> 6, nvb = cur + 1;
          if (h == 0) {
              if (nvb <= 16) mask = (1ull << nvb) - 1ull;
              else { mask = 1ull | (1ull << cur);
                  for (int r = 0; r < 14; ++r) { int best = -1; float bv = -1.f;
                      for (int j = 1; j < cur; ++j) { const float v = imp[qi * 64 + j]; if (!((mask >> j) & 1ull) && v > bv) { bv = v; best = j; } }
                      mask |= 1ull << best; } } }
          const unsigned mlo = (unsigned)bperm(lane & ~3, (int)(unsigned)mask), mhi = (unsigned)bperm(lane & ~3, (int)(unsigned)(mask >> 32));
          mask = ((unsigned long long)mhi << 32) | mlo; }
        { Soft S{-INFINITY, 0.f};
#pragma unroll
          for (int d = 0; d < 64; ++d) o[d] = 0.f;
          const bf16* kb = P1 + (size_t)b * SEQ * P1W + C_KSLC; const bf16* vb = P1 + (size_t)b * SEQ * P1W + C_VSLC;
          unsigned long long mm = mask;
          while (mm) { const int j = __builtin_ctzll(mm); mm &= mm - 1ull;
              for (int kk = 0; kk < 64; ++kk) { const int sp = j * 64 + kk; if (sp > t) break; nsa_step(ql, kb + (size_t)sp * P1W, vb + (size_t)sp * P1W, S, o); } }
          nsa_accum(yrow, false, g1 / S.l, o); }
        { Soft S{-INFINITY, 0.f};
#pragma unroll
          for (int d = 0; d < 64; ++d) o[d] = 0.f;
          const bf16* kb = P1 + (size_t)b * SEQ * P1W + C_KWIN; const bf16* vb = P1 + (size_t)b * SEQ * P1W + C_VWIN;
          for (int i = 0; i < 512; ++i) { const int sp = t - 511 + i; if (sp >= 0) nsa_step(ql, kb + (size_t)sp * P1W, vb + (size_t)sp * P1W, S, o); }
          nsa_accum(yrow, false, g2 / S.l, o); }
    }
}

__device__ __forceinline__ int moe_table(Frame& F, int jmoe, int c, int r) {
    LAS int* tab = (LAS int*)(F.lds + TAB_OFF);
    __syncthreads();
    if (F.tid < 8) tab[176 + F.tid] = (int)__hip_atomic_load(F.ctl + CW_CNT + jmoe * 32 + (c * 2 + r) * 8 + F.tid, __ATOMIC_RELAXED, __HIP_MEMORY_SCOPE_AGENT);
    __syncthreads();
    if (F.tid == 0) { int base = 0, T = 0;
        for (int e = 0; e < 8; ++e) { const int cnt = tab[176 + e];
            const int nt = (cnt + 255) >> 8; tab[160 + e] = base; for (int i = 0; i < nt && T + i < 160; ++i) tab[T + i] = e; T += nt; base += nt * 256; }
        tab[168] = T < 136 ? T : 136; }
    __syncthreads();
    return tab[168];
}
__device__ __forceinline__ void p_gather(Frame& F, int jmoe, int c, int r, int nbusy = 0) {
    if (F.bx < nbusy) return;
    moe_table(F, jmoe, c, r);
    LAS int* tab = (LAS int*)(F.lds + TAB_OFF); LAS int* cntw = tab + 256; LAS int* basew = tab + 320;
    const int lane = F.lane, wave = F.wave;
    const v4i* route = WSP(v4i, WS_ROUTE); int* tokmap = WSP(int, WS_TOKMAP) + (c * 2 + r) * SLOTS; float* wslot = WSP(float, WS_WSLOT) + (c * 2 + r) * SLOTS;
    const bf16* HN = WSP(bf16, WS_HN); bf16* XG = WSP(bf16, WS_XG);
    unsigned* cur = F.ctl + CW_CUR + jmoe * 32 + (c * 2 + r) * 8;
    for (int ch = F.bx - nbusy; ch < MC / 128; ch += F.G - nbusy) {
        const int m = c * MC + ch * 128 + wave * 16 + (lane & 15); const v4i rt = route[m];
        const int e = lane < 16 ? (r ? rt.y : rt.x) : -1; const float w = __builtin_bit_cast(float, r ? rt.w : rt.z);
        unsigned long long bal[8]; int mycnt = 0;
#pragma unroll
        for (int ee = 0; ee < 8; ++ee) { bal[ee] = __builtin_amdgcn_ballot_w64(e == ee); if (lane == ee) mycnt = __builtin_popcountll(bal[ee]); }
        __syncthreads();
        if (lane < 8) cntw[wave * 8 + lane] = mycnt;
        __syncthreads();
        if (wave == 0 && lane < 8) { int tot = 0;
#pragma unroll
            for (int w8 = 0; w8 < 8; ++w8) tot += cntw[w8 * 8 + lane];
            int base = tot > 0 ? (int)atomicAdd(cur + lane, (unsigned)tot) : 0;
#pragma unroll
            for (int w8 = 0; w8 < 8; ++w8) { basew[w8 * 8 + lane] = base; base += cntw[w8 * 8 + lane]; } }
        __syncthreads();
        int pos = 0;
#pragma unroll
        for (int ee = 0; ee < 8; ++ee) if (e == ee) pos = basew[wave * 8 + ee] + __builtin_popcountll(bal[ee] & ((1ull << lane) - 1ull));
        int slot = 0;
        if (lane < 16) { slot = tab[160 + e] + pos; tokmap[slot] = m; wslot[slot] = w; }
#pragma unroll
        for (int i0 = 0; i0 < 16; i0 += 4) { v4u x[8];
#pragma unroll
            for (int i = 0; i < 4; ++i) { const int mi = __builtin_amdgcn_readlane(m, i0 + i); const v4u* src = (const v4u*)(HN + (size_t)mi * DM); x[2 * i] = src[lane]; x[2 * i + 1] = src[64 + lane]; }
#pragma unroll
            for (int i = 0; i < 4; ++i) { const int si = __builtin_amdgcn_readlane(slot, i0 + i); v4u* dst = (v4u*)(XG + (size_t)si * DM); dst[lane] = x[2 * i]; dst[64 + lane] = x[2 * i + 1]; } }
    }
}

typedef float f32x16 __attribute__((ext_vector_type(16)));
typedef short bf16x8v __attribute__((ext_vector_type(8)));
typedef float f32x2v __attribute__((ext_vector_type(2)));
constexpr int NSA_K = 0, NSA_V = 8192, NSA_BUF = 17408, NSA_STAGE = 2 * NSA_BUF, NSA_IMP = 69632, NSA_CARRY = 86016, NSA_SEL = 103424, NSA_WSF = 103936;
constexpr int NSA_VP = 136;
constexpr float NSA_C2 = 0.125f * 1.4426950408889634f;
constexpr float NSA_DEFER = 8.0f / (0.125f * 1.4426950408889634f);
__device__ __forceinline__ unsigned cvtpk(float lo, float hi) { f32x2v v = {lo, hi}; bf16x2_t b = __builtin_convertvector(v, bf16x2_t); return __builtin_bit_cast(unsigned, b); }
__device__ __forceinline__ float partner32(float v, int lane) { return __builtin_bit_cast(float, __builtin_amdgcn_ds_bpermute((lane ^ 32) << 2, __builtin_bit_cast(int, v))); }
__device__ __forceinline__ void nsa_load(v4u& kx, v4u& vx, const bf16* Kg, int kp, const bf16* Vg, int vp, int tid) {
    kx = *(const v4u*)(Kg + (size_t)(tid & 63) * kp + (tid >> 6) * 8); vx = *(const v4u*)(Vg + (size_t)(tid >> 3) * vp + (tid & 7) * 8);
}
__device__ __forceinline__ void nsa_store(LAS unsigned char* lds, const v4u& kx, const v4u& vx, int tid) {
    *(LAS v4u*)(lds + NSA_K + (tid >> 6) * 1024 + (tid & 63) * 16) = kx; { LAS v2u* vd = (LAS v2u*)(lds + NSA_V + (tid >> 3) * NSA_VP + (tid & 7) * 16); vd[0] = (v2u){vx.x, vx.y}; vd[1] = (v2u){vx.z, vx.w}; }
}
__device__ __forceinline__ void nsa_qk(const LAS unsigned char* lds, const bf16x8v (&qr)[4], f32x16& p0, f32x16& p1, int r32, int hi) {
#pragma unroll
    for (int i = 0; i < 16; ++i) { p0[i] = 0.f; p1[i] = 0.f; }
#pragma unroll
    for (int d0 = 0; d0 < 4; ++d0) {
        const bf16x8v k0 = *(const LAS bf16x8v*)(lds + NSA_K + (2 * d0 + hi) * 1024 + r32 * 16);
        const bf16x8v k1 = *(const LAS bf16x8v*)(lds + NSA_K + (2 * d0 + hi) * 1024 + 512 + r32 * 16);
        p0 = __builtin_amdgcn_mfma_f32_32x32x16_bf16(k0, qr[d0], p0, 0, 0, 0);
        p1 = __builtin_amdgcn_mfma_f32_32x32x16_bf16(k1, qr[d0], p1, 0, 0, 0);
    }
}
__device__ __forceinline__ void nsa_mask(f32x16& p0, f32x16& p1, int hi, int hiL, int loL) {
#pragma unroll
    for (int i = 0; i < 16; ++i) { const int kk = (i & 3) + 8 * (i >> 2) + 4 * hi;
        if (!(kk <= hiL && kk > loL)) p0[i] = -INFINITY;
        if (!(kk + 32 <= hiL && kk + 32 > loL)) p1[i] = -INFINITY; }
}
__device__ __forceinline__ float nsa_max32(const f32x16& p0, const f32x16& p1) {
    float a = fmaxf(fmaxf(p0[0], p0[1]), p1[0]), b = fmaxf(fmaxf(p0[2], p0[3]), p1[1]); a = fmaxf(fmaxf(a, p1[2]), p1[3]);
#pragma unroll
    for (int i = 4; i < 16; i += 4) { a = fmaxf(fmaxf(a, p0[i]), p0[i + 1]); b = fmaxf(fmaxf(b, p0[i + 2]), p0[i + 3]); a = fmaxf(fmaxf(a, p1[i]), p1[i + 1]); b = fmaxf(fmaxf(b, p1[i + 2]), p1[i + 3]); }
    return fmaxf(a, b);
}
__device__ __forceinline__ void nsa_pv(const LAS unsigned char* lds, const f32x16& p0, const f32x16& p1, f32x16 (&o)[2], int r32, int hi) {
    bf16x8v pa[4];
#pragma unroll
    for (int s = 0; s < 2; ++s) {
        const v4u a = (v4u){cvtpk(p0[8 * s], p0[8 * s + 1]), cvtpk(p0[8 * s + 2], p0[8 * s + 3]), cvtpk(p0[8 * s + 4], p0[8 * s + 5]), cvtpk(p0[8 * s + 6], p0[8 * s + 7])};
        const v4u b = (v4u){cvtpk(p1[8 * s], p1[8 * s + 1]), cvtpk(p1[8 * s + 2], p1[8 * s + 3]), cvtpk(p1[8 * s + 4], p1[8 * s + 5]), cvtpk(p1[8 * s + 6], p1[8 * s + 7])};
        pa[s] = __builtin_bit_cast(bf16x8v, a); pa[2 + s] = __builtin_bit_cast(bf16x8v, b); }
#pragma unroll
    for (int db = 0; db < 2; ++db) { const LAS unsigned char* vrow = lds + NSA_V + (32 * db + r32) * NSA_VP;
#pragma unroll
        for (int ks = 0; ks < 4; ++ks) {
            const int kb = (ks >> 1) * 32 + (ks & 1) * 16 + 4 * hi;
            const v2u lo = *(const LAS v2u*)(vrow + kb * 2), hh = *(const LAS v2u*)(vrow + (kb + 8) * 2);
            const v4u vv = (v4u){lo.x, lo.y, hh.x, hh.y};
            o[db] = __builtin_amdgcn_mfma_f32_32x32x16_bf16(pa[ks], __builtin_bit_cast(bf16x8v, vv), o[db], 0, 0, 0); } }
}
__device__ __forceinline__ void nsa_rowscale(f32x16 (&o)[2], LAS float* wsf, float f, int r32, int hi) {
    if (hi == 0) wsf[r32] = f;
#pragma unroll
    for (int g = 0; g < 4; ++g) { const f32x4 w = *(const LAS f32x4*)(wsf + 8 * g + 4 * hi);
#pragma unroll
        for (int e = 0; e < 4; ++e) { o[0][4 * g + e] *= w[e]; o[1][4 * g + e] *= w[e]; } }
}
constexpr int NSA_ACC = 104960;
__device__ __forceinline__ void nsa_rowaccum(LAS unsigned char* acc, bool first, const f32x16 (&o)[2], LAS float* wsf, float f, int r32, int hi) {
    if (hi == 0) wsf[r32] = f;
#pragma unroll
    for (int g = 0; g < 4; ++g) { const f32x4 w = *(const LAS f32x4*)(wsf + 8 * g + 4 * hi);
#pragma unroll
        for (int e = 0; e < 4; ++e) { LAS bf16* p = (LAS bf16*)(acc + (8 * g + 4 * hi + e) * 128 + r32 * 2); const int i = 4 * g + e;
            float a = o[0][i] * w[e], b = o[1][i] * w[e];
            if (!first) { a += bf1(p[0]); b += bf1(p[32]); }
            p[0] = (bf16)f2bf(a); p[32] = (bf16)f2bf(b); } }
}
__device__ __forceinline__ void nsa_flush(const LAS unsigned char* acc, bf16* ytok  , int lane) {
    asm volatile("" ::: "memory");
#pragma unroll
    for (int ps = 0; ps < 4; ++ps) { const int row = ps * 8 + (lane >> 3), ch = lane & 7;
        const v4u v = *(const LAS v4u*)(acc + row * 128 + ch * 16);
        *(v4u*)(ytok + (size_t)(row >> 2) * 256 + (row & 3) * 64 + ch * 8) = v; }
}
__device__ __forceinline__ void nsa_softmax_pv(const LAS unsigned char* lds, f32x16& p0, f32x16& p1, float& m, float& l, f32x16 (&o)[2], LAS float* wsf, int lane, int r32, int hi, bool rowok) {
    float mt = nsa_max32(p0, p1); mt = rowok ? mt : -INFINITY; mt = fmaxf(mt, partner32(mt, lane));
    const float mn = fmaxf(m, mt);
    if (__builtin_amdgcn_ballot_w64(mn > m + NSA_DEFER) != 0ull) { const float f = __builtin_amdgcn_exp2f((m - mn) * NSA_C2); l *= f; nsa_rowscale(o, wsf, f, r32, hi); m = mn; }
    const float off = rowok ? -m * NSA_C2 : -INFINITY;
    float s = 0.f;
#pragma unroll
    for (int i = 0; i < 16; ++i) { p0[i] = __builtin_amdgcn_exp2f(__builtin_fmaf(p0[i], NSA_C2, off)); p1[i] = __builtin_amdgcn_exp2f(__builtin_fmaf(p1[i], NSA_C2, off)); s += p0[i] + p1[i]; }
    l += s;
    nsa_pv(lds, p0, p1, o, r32, hi);
}
__device__ __forceinline__ void p_nsa2(Frame& F) {
    const int tid = F.tid, lane = F.lane, wave = F.wave, r32 = lane & 31, hi = lane >> 5;
    LAS unsigned char* lds = F.lds + RING_OFF;
    LAS float* imp = (LAS float*)(lds + NSA_IMP); LAS float* carry = (LAS float*)(lds + NSA_CARRY);
    LAS unsigned long long* selm = (LAS unsigned long long*)(lds + NSA_SEL); LAS float* wsf = (LAS float*)(lds + NSA_WSF) + wave * 32;
    LAS unsigned char* acc = wave < 6 ? lds + NSA_ACC + wave * 4096 : F.lds + LDSCTL_OFF + 4096 + (wave - 6) * 4096;
    const bf16* P1 = WSP(bf16, WS_P1); const bf16* KC = WSP(bf16, WS_KC); const bf16* KCT = WSP(bf16, WS_KCT); const bf16* VT = WSP(bf16, WS_VT);
    bf16* Yc = WSP(bf16, WS_Y) + (size_t)2 * MC * 256;
    const int ql = r32 >> 2, h = r32 & 3, tq = 8 * wave + ql;
    int par = 0;
    for (int it = 0; it < 2; ++it) {
        for (int pair = F.vcu; pair < BC * 32; pair += F.G) {
            const int b = pair >> 5, sx = pair & 31, qb = it ? 63 - sx : sx;
            const int t = qb * 64 + tq; const size_t row = (size_t)b * SEQ + t; const bf16* prow = P1 + row * P1W;
            bf16x8v qr[4];
#pragma unroll
            for (int d0 = 0; d0 < 4; ++d0) qr[d0] = *(const bf16x8v*)(prow + C_CQ + h * 64 + d0 * 16 + hi * 8);
            const float g0 = bf1(prow[C_CG + h * 3]), g1 = bf1(prow[C_CG + h * 3 + 1]), g2 = bf1(prow[C_CG + h * 3 + 2]);
            f32x16 o[2], p0, p1;
            __syncthreads();
            for (int i = tid; i < 64 * 64; i += 512) imp[i] = 0.f;
            for (int i = tid; i < 64 * 68; i += 512) carry[i] = 0.f;
            const int nct = (4 * qb + 3 + 63) >> 6;
            const int mlim = t >= 31 ? ((t - 31) >> 4) : -1;
            const bf16* kcb = KC + (size_t)b * 256 * 64; const bf16* vcb = KCT + (size_t)b * 64 * 256;
            float m = -1e30f, l = 0.f;
            v4u kx, vx;
            nsa_load(kx, vx, kcb, 64, vcb, 256, tid);
            for (int ti = 0; ti < nct; ++ti) {
                LAS unsigned char* tb = lds + par * NSA_STAGE; par ^= 1;
                nsa_store(tb, kx, vx, tid); __syncthreads();
                { const int tn = ti + 1 < nct ? ti + 1 : 0; nsa_load(kx, vx, kcb + (size_t)tn * 64 * 64, 64, vcb + tn * 64, 256, tid); }
                nsa_qk(tb, qr, p0, p1, r32, hi); nsa_mask(p0, p1, hi, mlim - 64 * ti, -1);
                float mt = nsa_max32(p0, p1); mt = fmaxf(mt, partner32(mt, lane));
                const float mn = fmaxf(m, mt); l *= __builtin_amdgcn_exp2f((m - mn) * NSA_C2); m = mn;
                const float off = -m * NSA_C2; float s = 0.f;
#pragma unroll
                for (int i = 0; i < 16; ++i) s += __builtin_amdgcn_exp2f(__builtin_fmaf(p0[i], NSA_C2, off)) + __builtin_amdgcn_exp2f(__builtin_fmaf(p1[i], NSA_C2, off));
                l += s; }
            { const float lt = l + partner32(l, lane); const float rl = lt > 0.f ? 1.0f / lt : 0.f;
#pragma unroll
              for (int i = 0; i < 16; ++i) { o[0][i] = 0.f; o[1][i] = 0.f; }
              for (int ti = 0; ti < nct; ++ti) {
                  LAS unsigned char* tb = lds + par * NSA_STAGE; par ^= 1;
                  nsa_store(tb, kx, vx, tid); __syncthreads();
                  if (ti + 1 < nct) nsa_load(kx, vx, kcb + (size_t)(ti + 1) * 64 * 64, 64, vcb + (ti + 1) * 64, 256, tid);
                  nsa_qk(tb, qr, p0, p1, r32, hi); nsa_mask(p0, p1, hi, mlim - 64 * ti, -1);
                  { const float off = -m * NSA_C2;
#pragma unroll
                    for (int i = 0; i < 16; ++i) { p0[i] = __builtin_amdgcn_exp2f(__builtin_fmaf(p0[i], NSA_C2, off)) * rl; p1[i] = __builtin_amdgcn_exp2f(__builtin_fmaf(p1[i], NSA_C2, off)) * rl; } }
#pragma unroll
                  for (int kt = 0; kt < 2; ++kt)
#pragma unroll
                      for (int g = 0; g < 4; ++g) { const f32x16& pp = kt ? p1 : p0;
                          float A = pp[4 * g] + pp[4 * g + 1] + pp[4 * g + 2] + 0.5f * pp[4 * g + 3], B = 0.5f * pp[4 * g + 3];
                          A += __builtin_bit_cast(float, bperm(lane ^ 1, __builtin_bit_cast(int, A))); A += __builtin_bit_cast(float, bperm(lane ^ 2, __builtin_bit_cast(int, A)));
                          B += __builtin_bit_cast(float, bperm(lane ^ 1, __builtin_bit_cast(int, B))); B += __builtin_bit_cast(float, bperm(lane ^ 2, __builtin_bit_cast(int, B)));
                          if (h == 0) { const int j = 16 * ti + 8 * kt + 2 * g + hi; imp[tq * 64 + j] = A; carry[tq * 68 + j + 1] = B; } }
                  nsa_pv(tb, p0, p1, o, r32, hi); }
              nsa_rowaccum(acc, true, o, wsf, g0, r32, hi); }
            __syncthreads();
            { const int q = tid >> 3, sub = tid & 7; unsigned long long mask;
              if (qb + 1 <= 16) mask = (1ull << (qb + 1)) - 1ull;
              else { mask = 1ull | (1ull << qb);
                  unsigned long long key[8];
#pragma unroll
                  for (int i = 0; i < 8; ++i) { const int j = sub * 8 + i; const float v = imp[q * 64 + j] + carry[q * 68 + j];
                      key[i] = (j >= 1 && j < qb) ? (((unsigned long long)__builtin_bit_cast(unsigned, v) << 32) | (unsigned)(63 - j)) : 0ull; }
                  for (int r = 0; r < 14; ++r) { unsigned long long best = key[0];
#pragma unroll
                      for (int i = 1; i < 8; ++i) best = key[i] > best ? key[i] : best;
#pragma unroll
                      for (int x = 1; x < 8; x <<= 1) { const unsigned lo = (unsigned)bperm(lane ^ x, (int)(unsigned)best), hh = (unsigned)bperm(lane ^ x, (int)(unsigned)(best >> 32));
                          const unsigned long long other = ((unsigned long long)hh << 32) | lo; best = other > best ? other : best; }
                      const int jb = 63 - (int)(best & 63ull); mask |= 1ull << jb;
#pragma unroll
                      for (int i = 0; i < 8; ++i) if (sub * 8 + i == jb) key[i] = 0ull; } }
              if (sub == 0) selm[q] = mask; }
            __syncthreads();
            const unsigned long long mysel = selm[tq];
            { const bf16* kb = P1 + (size_t)b * SEQ * P1W + C_KSLC; const bf16* vb = VT + (size_t)(0 * BC + b) * 64 * SEQ;
              m = -1e30f; l = 0.f;
#pragma unroll
              for (int i = 0; i < 16; ++i) { o[0][i] = 0.f; o[1][i] = 0.f; }
              v4u kx2, vx2;
              nsa_load(kx, vx, kb, P1W, vb, SEQ, tid); if (qb >= 1) nsa_load(kx2, vx2, kb + (size_t)64 * P1W, P1W, vb + 64, SEQ, tid);
              for (int j = 0; j <= qb; j += 2) {
                  const bool two = j + 1 <= qb;
                  LAS unsigned char* tb = lds + par * NSA_STAGE; par ^= 1;
                  nsa_store(tb, kx, vx, tid); if (two) nsa_store(tb + NSA_BUF, kx2, vx2, tid);
                  __syncthreads();
                  if (j + 2 <= qb) nsa_load(kx, vx, kb + (size_t)(j + 2) * 64 * P1W, P1W, vb + (j + 2) * 64, SEQ, tid);
                  if (j + 3 <= qb) nsa_load(kx2, vx2, kb + (size_t)(j + 3) * 64 * P1W, P1W, vb + (j + 3) * 64, SEQ, tid);
                  { const bool rowsel = ((mysel >> j) & 1ull) != 0ull;
                    if (__builtin_amdgcn_ballot_w64(rowsel) != 0ull) {
                        nsa_qk(tb, qr, p0, p1, r32, hi); if (j == qb) nsa_mask(p0, p1, hi, tq, -1);
                        nsa_softmax_pv(tb, p0, p1, m, l, o, wsf, lane, r32, hi, rowsel); } }
                  if (two) { const bool rowsel = ((mysel >> (j + 1)) & 1ull) != 0ull;
                    if (__builtin_amdgcn_ballot_w64(rowsel) != 0ull) {
                        nsa_qk(tb + NSA_BUF, qr, p0, p1, r32, hi); if (j + 1 == qb) nsa_mask(p0, p1, hi, tq, -1);
                        nsa_softmax_pv(tb + NSA_BUF, p0, p1, m, l, o, wsf, lane, r32, hi, rowsel); } } }
              const float lt = l + partner32(l, lane);
              nsa_rowaccum(acc, false, o, wsf, lt > 0.f ? g1 / lt : 0.f, r32, hi); }
            { const bf16* kb = P1 + (size_t)b * SEQ * P1W + C_KWIN; const bf16* vb = VT + (size_t)(1 * BC + b) * 64 * SEQ;
              m = -1e30f; l = 0.f;
#pragma unroll
              for (int i = 0; i < 16; ++i) { o[0][i] = 0.f; o[1][i] = 0.f; }
              const int j0 = qb >= 8 ? qb - 8 : 0;
              nsa_load(kx, vx, kb + (size_t)j0 * 64 * P1W, P1W, vb + j0 * 64, SEQ, tid);
              for (int j = j0; j <= qb; ++j) {
                  LAS unsigned char* tb = lds + par * NSA_STAGE; par ^= 1;
                  nsa_store(tb, kx, vx, tid); __syncthreads();
                  if (j < qb) nsa_load(kx, vx, kb + (size_t)(j + 1) * 64 * P1W, P1W, vb + (j + 1) * 64, SEQ, tid);
                  nsa_qk(tb, qr, p0, p1, r32, hi); if (j == qb || j == qb - 8) nsa_mask(p0, p1, hi, j == qb ? tq : 63, j == qb - 8 ? tq : -1);
                  nsa_softmax_pv(tb, p0, p1, m, l, o, wsf, lane, r32, hi, true); }
              const float lt = l + partner32(l, lane);
              nsa_rowaccum(acc, false, o, wsf, lt > 0.f ? g2 / lt : 0.f, r32, hi);
              nsa_flush(acc, Yc + ((size_t)b * SEQ + qb * 64 + 8 * wave) * 256, lane); }
        }
    }
    __syncthreads();
}

constexpr int SB_HEAD_LDS = 17408;
constexpr int SB_FLAG = 4 * SB_HEAD_LDS;
constexpr float SB_LOG2E = 1.4426950408889634f, SB_STOP = -100.0f * 1.4426950408889634f;
__device__ __forceinline__ void p_stick2(Frame& F, int nbusy) {
    const int tid = F.tid, lane = F.lane, wave = F.wave, r32 = lane & 31, hi = lane >> 5, h = wave & 3, qh = wave >> 2;
    LAS unsigned char* lds = F.lds + RING_OFF; LAS unsigned char* hl = lds + h * SB_HEAD_LDS; LAS int* flag = (LAS int*)(lds + SB_FLAG);
    const bf16* P1 = WSP(bf16, WS_P1); const bf16* VT = WSP(bf16, WS_VT) + (size_t)2 * BC * 64 * SEQ;
    bf16* Yb = WSP(bf16, WS_Y) + (size_t)MC * 256;
    const int tq = 32 * qh + r32;
    if (F.bx >= nbusy)
        for (int item = F.bx - nbusy; item < BC * 64; item += F.G - nbusy) {
            const int b = item >> 6, qb = item & 63;
            const size_t row = (size_t)b * SEQ + qb * 64 + tq;
            bf16x8v qr[4];
#pragma unroll
            for (int d0 = 0; d0 < 4; ++d0) qr[d0] = *(const bf16x8v*)(P1 + row * P1W + C_SBQ + h * 64 + d0 * 16 + hi * 8);
            f32x16 o[2], p0, p1;
#pragma unroll
            for (int i = 0; i < 16; ++i) { o[0][i] = 0.f; o[1][i] = 0.f; }
            float R = 0.f;
            const int skey = tid & 63, sc = tid >> 6, sd = tid >> 3, skc = tid & 7;
            v4u kx[4], vx[4];
#define SB_LOAD(jj) do { const bf16* kg_ = P1 + ((size_t)b * SEQ + (jj) * 64 + skey) * P1W + C_SBK + sc * 8; \
                _Pragma("unroll") for (int hh = 0; hh < 4; ++hh) { kx[hh] = *(const v4u*)(kg_ + hh * 64); vx[hh] = *(const v4u*)(VT + ((size_t)(hh * BC + b) * 64 + sd) * SEQ + (jj) * 64 + skc * 8); } } while (0)
            SB_LOAD(qb);
            for (int j = qb; j >= 0; --j) {
                __syncthreads();
                if (j < qb) { int live = 0;
#pragma unroll
                    for (int w = 0; w < 8; ++w) live |= flag[w];
                    if (!live) break; }
#pragma unroll
                for (int hh = 0; hh < 4; ++hh) { *(LAS v4u*)(lds + hh * SB_HEAD_LDS + sc * 1024 + skey * 16) = kx[hh]; { LAS v2u* vd = (LAS v2u*)(lds + hh * SB_HEAD_LDS + NSA_V + sd * NSA_VP + skc * 16); vd[0] = (v2u){vx[hh].x, vx[hh].y}; vd[1] = (v2u){vx[hh].z, vx[hh].w}; } }
                __syncthreads();
                if (j > 0) SB_LOAD(j - 1);
                nsa_qk(hl, qr, p0, p1, r32, hi);
#pragma unroll
                for (int i = 0; i < 16; ++i) { p0[i] *= NSA_C2; p1[i] *= NSA_C2; }
                const int lim = (j == qb) ? tq : 64;
                float Town[8], Tp[8];
#pragma unroll
                for (int kt = 0; kt < 2; ++kt) { f32x16& pp = kt ? p1 : p0;
#pragma unroll
                    for (int g = 0; g < 4; ++g) { float L[4];
#pragma unroll
                        for (int e = 0; e < 4; ++e) { const int kk = 32 * kt + 8 * g + 4 * hi + e; const float z = pp[4 * g + e];
                            const float tt = __builtin_amdgcn_logf(1.0f + __builtin_amdgcn_exp2f(-__builtin_fabsf(z)));
                            const float lb = fminf(z, 0.f) - tt; const bool ok = kk < lim;
                            L[e] = ok ? lb - z : 0.f; pp[4 * g + e] = ok ? lb : -INFINITY; }
                        const float E2 = L[3], E1 = E2 + L[2], E0 = E1 + L[1];
                        pp[4 * g + 2] += E2; pp[4 * g + 1] += E1; pp[4 * g] += E0;
                        Town[4 * kt + g] = E0 + L[0]; } }
#pragma unroll
                for (int k = 0; k < 8; ++k) Tp[k] = partner32(Town[k], lane);
                float suf = R;
#pragma unroll
                for (int k = 7; k >= 0; --k) { const float add = suf + (hi == 0 ? Tp[k] : 0.f); f32x16& pp = (k >> 2) ? p1 : p0; const int g = k & 3;
#pragma unroll
                    for (int e = 0; e < 4; ++e) pp[4 * g + e] = __builtin_amdgcn_exp2f(pp[4 * g + e] + add);
                    suf += Town[k] + Tp[k]; }
                R = suf;
                nsa_pv(hl, p0, p1, o, r32, hi);
                const bool alive = R >= SB_STOP;
                const unsigned long long bal = __builtin_amdgcn_ballot_w64(alive);
                if (lane == 0) flag[wave] = bal != 0ull ? 1 : 0;
            }
            { bf16* dst = Yb + ((size_t)b * SEQ + qb * 64 + 32 * qh + 4 * hi) * 256 + h * 64 + r32;
#pragma unroll
              for (int i = 0; i < 16; ++i) { dst[((i & 3) + 8 * (i >> 2)) * 256] = (bf16)f2bf(o[0][i]); dst[((i & 3) + 8 * (i >> 2)) * 256 + 32] = (bf16)f2bf(o[1][i]); } }
        }
#undef SB_LOAD
    __syncthreads();
}

__device__ __forceinline__ void p_sgu2(Frame& F, int layer) {
    LAS unsigned char* vnT = F.lds + RING_OFF;
    const bf16* P1 = WSP(bf16, WS_P1); bf16* Ya = WSP(bf16, WS_Y);
    const float* gain = F.in[3] + (size_t)layer * 256; const float* sw = F.in[4] + (size_t)layer * 4 * 128 * 128; const float* sb = F.in[5] + (size_t)layer * 4 * 128;
    const int lane = F.lane, wave = F.wave, r32 = lane & 31, hi = lane >> 5, g = wave & 3, db = wave >> 2;
    for (int item = F.vcu; item < MC / 128; item += F.G) {
        const size_t r0 = (size_t)item * 128;
        __syncthreads();
        { const f32x4 gg = ((const f32x4*)gain)[lane];
          for (int rr = 0; rr < 16; rr += 2) { const int r = wave * 16 + rr;
              const v2u ra = *(const v2u*)(P1 + (r0 + r) * P1W + C_V + 4 * lane), rb = *(const v2u*)(P1 + (r0 + r + 1) * P1W + C_V + 4 * lane);
              const float a0 = bflo(ra.x), a1 = bfhi(ra.x), a2 = bflo(ra.y), a3 = bfhi(ra.y), b0 = bflo(rb.x), b1 = bfhi(rb.x), b2 = bflo(rb.y), b3 = bfhi(rb.y);
              const float sa = 1.0f / sqrtf(wave_sum((a0 * a0 + a1 * a1) + (a2 * a2 + a3 * a3), lane) * (1.f / 256.f) + EPS);
              const float sb_ = 1.0f / sqrtf(wave_sum((b0 * b0 + b1 * b1) + (b2 * b2 + b3 * b3), lane) * (1.f / 256.f) + EPS);
              LAS unsigned* q = (LAS unsigned*)(vnT + (4 * lane) * 272 + r * 2);
              q[0] = pk2(a0 * sa * gg.x, b0 * sb_ * gg.x); q[68] = pk2(a1 * sa * gg.y, b1 * sb_ * gg.y); q[136] = pk2(a2 * sa * gg.z, b2 * sb_ * gg.z); q[204] = pk2(a3 * sa * gg.w, b3 * sb_ * gg.w); } }
        __syncthreads();
        const int ch = g * 64 + db * 32 + r32;
        for (int tb = 0; tb < 4; ++tb) {
            f32x16 acc;
#pragma unroll
            for (int i = 0; i < 16; ++i) acc[i] = 0.f;
            const int t = 32 * tb + r32; const float* wrow = sw + ((size_t)g * 128 + t) * 128;
            f32x4 wq[8][2];
#pragma unroll
            for (int ks = 0; ks < 8; ++ks) if (ks < 2 * tb + 2) { wq[ks][0] = *(const f32x4*)(wrow + 16 * ks + 8 * hi); wq[ks][1] = *(const f32x4*)(wrow + 16 * ks + 8 * hi + 4); }
#pragma unroll
            for (int ks = 0; ks < 8; ++ks) if (ks < 2 * tb + 2) {
                const int s0 = 16 * ks + 8 * hi;
                const f32x4 w0 = wq[ks][0], w1 = wq[ks][1];
                const v4u a = (v4u){pk2(s0 <= t ? w0.x : 0.f, s0 + 1 <= t ? w0.y : 0.f), pk2(s0 + 2 <= t ? w0.z : 0.f, s0 + 3 <= t ? w0.w : 0.f),
                                    pk2(s0 + 4 <= t ? w1.x : 0.f, s0 + 5 <= t ? w1.y : 0.f), pk2(s0 + 6 <= t ? w1.z : 0.f, s0 + 7 <= t ? w1.w : 0.f)};
                const bf16x8v bfr = *(const LAS bf16x8v*)(vnT + ch * 272 + s0 * 2);
                acc = __builtin_amdgcn_mfma_f32_32x32x16_bf16(__builtin_bit_cast(bf16x8v, a), bfr, acc, 0, 0, 0); }
            float uu[16], bb[16];
#pragma unroll
            for (int i = 0; i < 16; ++i) { const int tt = 32 * tb + (i & 3) + 8 * (i >> 2) + 4 * hi; uu[i] = bf1(P1[(r0 + tt) * P1W + C_U + ch]); bb[i] = sb[g * 128 + tt]; }
#pragma unroll
            for (int i = 0; i < 16; ++i) { const int tt = 32 * tb + (i & 3) + 8 * (i >> 2) + 4 * hi;
                Ya[(r0 + tt) * 256 + ch] = (bf16)f2bf(uu[i] * (acc[i] + bb[i])); }
        }
    }
    __syncthreads();
}

struct Args { const float* in[20]; float* out; unsigned char* ws; int lo, hi, li, rep; };
#ifndef TILED_FFN1
#define TILED_FFN1 0
#endif
#ifndef PG8_ALIGN_EPI
#define PG8_ALIGN_EPI true
#endif
#ifndef PG8_SP2
#define PG8_SP2 true
#endif
#ifndef WGM_PROJ
#define WGM_PROJ PG8_WGM
#endif
#ifndef WGM_FFN1
#define WGM_FFN1 PG8_WGM
#endif
#ifndef WGM_FFN2
#define WGM_FFN2 PG8_WGM
#endif
#ifndef WGM_MOE1
#define WGM_MOE1 PG8_WGM
#endif
#ifndef WGM_MOE2
#define WGM_MOE2 PG8_WGM
#endif
#ifndef FFN_CHUNKS
#define FFN_CHUNKS 2
#endif
#ifndef REP_GEMM
#define REP_GEMM 1
#endif
#ifndef REP_STICK
#define REP_STICK 1
#endif
#ifndef REP_NSA
#define REP_NSA 1
#endif
#ifndef REP_SGU
#define REP_SGU 1
#endif
#ifndef REP_NORM
#define REP_NORM 1
#endif
template <class Epi, class Sched> __device__ __forceinline__ void run_gemm(Frame& F, const bf16* A, const bf16* Bt, int M, int N, int K, const Sched& S, Epi E, bool rotate = true, int tiled = 0) {
    const int nt_ = K / 64;
#ifdef PG8_KROT
    const int rot_ = rotate ? 2 * (((F.bx & 7) * (nt_ / 2)) / 8) : 0;
#else
    const int rot_ = 0;
#endif
    pg8::Gemm g{A, Bt, M, N, K + F.zs, F.tid, rot_ + F.zs, tiled + F.zs};
    if (F.rep) E.set_scale0();
    pg8::gemm_phase<Epi, Sched, PG8_ALIGN_EPI, PG8_SP2>(F.lds + RING_OFF, g, S, E);
}
__global__ void __launch_bounds__(NWAVES * 64, 2) mk_fwd(Args args) {
    extern __shared__ __attribute__((aligned(16))) unsigned char lds[];
    Frame F0;
    F0.lds = (LAS unsigned char*)lds;
    F0.tid = threadIdx.x; F0.lane = F0.tid & 63; F0.wave = __builtin_amdgcn_readfirstlane(F0.tid >> 6);
    F0.G = gridDim.x; F0.bx = blockIdx.x; F0.vcu = (F0.G % 8 == 0) ? (F0.bx % 8) * (F0.G / 8) + F0.bx / 8 : F0.bx; F0.zv = 0; F0.zs = 0;
    F0.rep = args.rep; F0.ws = args.ws; F0.ctl = (unsigned*)(args.ws + WS_CTL); F0.in = args.in; F0.out = args.out;
    for (int u = F0.tid; u < (LDS_BYTES - LDSCTL_OFF) / 4; u += NWAVES * 64) ((LAS unsigned*)(F0.lds + LDSCTL_OFF))[u] = 0u;
    __syncthreads();
    const int lo = args.lo, hi = args.hi;
    XcdBarrier bar; bar.bar = F0.ctl + CW_BAR + args.li * XCD_BAR_WORDS; bar.x = 0; bar.st = nullptr; bar.w = 0; bar.z = 0;
    if (hi - lo > 1) bar = xcd_barrier_post(F0.ctl + CW_BAR + args.li * XCD_BAR_WORDS, (volatile LAS unsigned*)(F0.lds + MISC_OFF) + 8);
    int step = 0;
#define STEP_BEGIN if (step >= lo && step < hi) { Frame F = F0; { int zv_, zs_; asm volatile("v_mov_b32 %0, 0" : "=v"(zv_)); asm volatile("s_mov_b32 %0, 0" : "=s"(zs_)); \
        F.zv = zv_; F.zs = zs_; F.lane = (int)__builtin_amdgcn_mbcnt_hi(~0u, __builtin_amdgcn_mbcnt_lo(~0u, (unsigned)zv_)); F.wave = F0.wave + zs_; F.tid = F.wave * 64 + F.lane; F.bx = F.bx + zs_; \
        F.vcu = F0.vcu + zs_; F.G = F0.G + zs_; F.lds = (LAS unsigned char*)lds + zs_; F.ws = F0.ws + zs_; F.ctl = F0.ctl + zs_; F.in = F0.in + zs_; F.out = F0.out + zs_; }
#ifdef PROBE_XBAR
#define STEP_END   if (step + 1 < hi) { unsigned zb_; asm volatile("v_mov_b32 %0, 0" : "=v"(zb_)); bar.z = zb_; xcd_barrier(bar); xcd_barrier(bar); } } ++step;
#else
#define STEP_END   if (step + 1 < hi) { unsigned zb_; asm volatile("v_mov_b32 %0, 0" : "=v"(zb_)); bar.z = zb_; xcd_barrier(bar); } } ++step;
#endif

    for (int layer = 0; layer < DEPTH; ++layer) {
        const int jj = layer >> 1;
        STEP_BEGIN
            p_convert(F, layer);
            p_norm<0>(F, layer == 0 ? F.in[0] : F.out, F.in[1] + (size_t)layer * DM, nullptr, 0);
        STEP_END
        for (int c = 0; c < NCHUNK; ++c) {
            STEP_BEGIN
                pg8::StaticOrder S; S.init(MC, NPROJ, F.G, F.bx, WGM_PROJ);
                pg8::EpiProj E{WSP(bf16, WS_P1), WSP(bf16, WS_G)};
                run_gemm(F, WSP(bf16, WS_HN) + (size_t)c * MC * DM, WSP(bf16, WS_WIN), MC, NPROJ, DM, S, E);
            STEP_END
            STEP_BEGIN
                p_prep(F);
            STEP_END
            STEP_BEGIN
                LAS int* tab = (LAS int*)(F.lds + TAB_OFF);
                __syncthreads(); if (F.tid < 16) tab[F.tid] = F.tid >> 3; __syncthreads();
                pg8::GroupedOrder S; S.so.init(2 * 2048, 512, F.G, F.bx); S.tile_e = tab; S.nN = 2;
                pg8::EpiF32 E{WSP(float, WS_UL), 512, 2};
                run_gemm(F, WSP(bf16, WS_KVC), WSP(bf16, WS_WC1), 2 * 2048, 512, DM, S, E);
                p_sgu2(F, layer);
                p_stick2(F, F.G > 64 ? 32 : 0);
            STEP_END
            STEP_BEGIN
                p_cmpfin(F, layer);
            STEP_END
            STEP_BEGIN
#ifdef OLD_NSA
                p_nsa(F);
#else
                p_nsa2(F);
#endif
            STEP_END
            STEP_BEGIN
                pg8::MergeOrder S; S.so.init(MC, DM, F.G, F.bx); S.nmt = MC / 256;
                pg8::EpiMerge E{WSP(bf16, WS_G), WSP(bf16, WS_MG), MC / 256};
                run_gemm(F, WSP(bf16, WS_Y), WSP(bf16, WS_WBR), 3 * MC, 3 * DM, 256, S, E);
            STEP_END
            STEP_BEGIN
                pg8::StaticOrder S; S.init(MC, DM, F.G, F.bx);
                const float* base = (layer == 0 ? F.in[0] : F.out) + (size_t)c * MC * DM;
                pg8::EpiResid E{base, F.out + (size_t)c * MC * DM, DM, 1.0f};
                run_gemm(F, WSP(bf16, WS_MG), WSP(bf16, WS_WOUT), MC, DM, DM, S, E);
            STEP_END
        }
        if ((layer & 1) == 0) {
            STEP_BEGIN
                p_norm<0>(F, F.out, F.in[11] + (size_t)layer * DM, nullptr, 0, Q8_HN, TILED_FFN1);
            STEP_END
            for (int c = 0; c < FFN_CHUNKS; ++c) {
                constexpr int MF = MTOK / FFN_CHUNKS;
                STEP_BEGIN
                    pg8::StaticOrder S; S.init(MF, NFF1, F.G, F.bx, WGM_FFN1);
                    pg8::EpiSwiGLU E{WSP(bf16, WS_HID), DFFP, nullptr, NFF1 / 256};
                    run_gemm(F, WSP(bf16, WS_HN) + (size_t)c * MF * DM, WSP(bf16, WS_WF1), MF, NFF1, DM, S, E, true, TILED_FFN1);
                STEP_END
                STEP_BEGIN
                    pg8::StaticOrder S; S.init(MF, DM, F.G, F.bx, WGM_FFN2);
                    pg8::EpiResid E{F.out + (size_t)c * MF * DM, F.out + (size_t)c * MF * DM, DM, 1.0f};
                    run_gemm(F, WSP(bf16, WS_HID), WSP(bf16, WS_WF2), MF, DM, DFFP, S, E);
                STEP_END
            }
        } else {
            STEP_BEGIN
                p_norm<1>(F, F.out, F.in[11] + (size_t)layer * DM, F.in[15] + (size_t)jj * DM * NEXP, jj, Q8_HN);
            STEP_END
#ifdef ABL_DENSE_MOE
            for (int e = 0; e < NEXP; ++e) {
                STEP_BEGIN
                    pg8::StaticOrder S; S.init(MTOK, NMOE1, F.G, F.bx);
                    pg8::EpiSwiGLU E{WSP(bf16, WS_SCR + 8 * MiB), DFE, WSP(float, WS_SCR + 4 * MiB) + (size_t)e * MTOK, NMOE1 / 256};
                    run_gemm(F, WSP(bf16, WS_HN), WSP(bf16, WS_WF1) + (size_t)e * NMOE1 * DM, MTOK, NMOE1, DM, S, E);
                STEP_END
                STEP_BEGIN
                    pg8::StaticOrder S; S.init(MTOK, DM, F.G, F.bx);
                    pg8::EpiResid E{F.out, F.out, DM, 1.0f};
                    run_gemm(F, WSP(bf16, WS_SCR + 8 * MiB), WSP(bf16, WS_WF2) + (size_t)e * DM * DFE, MTOK, DM, DFE, S, E);
                STEP_END
            }
#else
            STEP_BEGIN
                p_gather(F, jj, 0, 0);
            STEP_END
            for (int c = 0; c < NCHUNK; ++c)
                for (int r = 0; r < 2; ++r) {
                    STEP_BEGIN
                        const int T = moe_table(F, jj, c, r);
                        pg8::GroupedOrder S; S.so.init(T * 256, NMOE1, F.G, F.bx, WGM_MOE1); S.tile_e = (LAS int*)(F.lds + TAB_OFF); S.nN = NMOE1 / 256;
                        pg8::EpiSwiGLU E{WSP(bf16, WS_HIDM), DFE, WSP(float, WS_WSLOT) + (c * 2 + r) * SLOTS, NMOE1 / 256};
                        run_gemm(F, WSP(bf16, WS_XG), WSP(bf16, WS_WF1), T * 256, NMOE1, DM, S, E, false);
                    STEP_END
                    STEP_BEGIN
                        const int T = moe_table(F, jj, c, r);
                        pg8::GroupedOrder S; S.so.init(T * 256, DM, F.G, F.bx, WGM_MOE2); S.tile_e = (LAS int*)(F.lds + TAB_OFF); S.nN = DM / 256;
                        pg8::EpiScatter E{F.out, WSP(int, WS_TOKMAP) + (c * 2 + r) * SLOTS, DM / 256, 1.0f};
                        run_gemm(F, WSP(bf16, WS_HIDM), WSP(bf16, WS_WF2), T * 256, DM, DFE, S, E, false);
                        if (!F.rep && c * 2 + r < 3) p_gather(F, jj, (c * 2 + r + 1) >> 1, (c * 2 + r + 1) & 1, (T * (DM / 256)) % F.G);
                    STEP_END
                }
#endif
        }
    }
    STEP_BEGIN
        p_norm<2>(F, F.out, F.in[19], nullptr, 0);
    STEP_END
#undef STEP_BEGIN
#undef STEP_END
}

#ifndef MK_STEPS_PER_LAUNCH
#define MK_STEPS_PER_LAUNCH 1
#endif
extern "C" void kernel_launch(void* const* d_in, const int* in_sizes, int n_in, void* d_out, int out_size, void* d_ws, size_t ws_size, hipStream_t stream) {
    static int grid = 0;
    if (grid == 0) {
        if (n_in != 20 || in_sizes[0] != MTOK * DM || out_size != MTOK * DM || ws_size < WS_END) { fprintf(stderr, "kernel_launch: unexpected shapes (n_in %d, in0 %d, out %d, ws %zu)\n", n_in, n_in > 0 ? in_sizes[0] : -1, out_size, ws_size); grid = -1; return; }
        int dev = 0, cus = 0, per_cu = 0;
        if (hipGetDevice(&dev) != hipSuccess || hipDeviceGetAttribute(&cus, hipDeviceAttributeMultiprocessorCount, dev) != hipSuccess) { grid = -1; return; }
        if (hipFuncSetAttribute((const void*)mk_fwd, hipFuncAttributeMaxDynamicSharedMemorySize, LDS_BYTES) != hipSuccess) { fprintf(stderr, "kernel_launch: hipFuncSetAttribute failed\n"); grid = -1; return; }
        if (hipOccupancyMaxActiveBlocksPerMultiprocessor(&per_cu, (const void*)mk_fwd, NWAVES * 64, LDS_BYTES) != hipSuccess || per_cu < 1) fprintf(stderr, "kernel_launch: occupancy query reports %d\n", per_cu);
        (void)hipGetLastError();
        grid = cus;
    }
    if (grid < 0) return;
    if (hipMemsetAsync((char*)d_ws + WS_CTL, 0, CTL_ZERO_BYTES, stream) != hipSuccess) return;
    Args a{};
    for (int i = 0; i < 20; ++i) a.in[i] = (const float*)d_in[i];
    a.out = (float*)d_out; a.ws = (unsigned char*)d_ws; a.rep = 0;
    #ifdef ABL_DENSE_MOE
    constexpr int NSTEPS = 2 * (1 + NCHUNK * 8 + 3) + 2 * (1 + NCHUNK * 8 + 1 + NEXP * 2) + 1;
#else
    constexpr int NSTEPS = 2 * (1 + NCHUNK * 7 + 1 + 2 * FFN_CHUNKS) + 2 * (1 + NCHUNK * 7 + 2 + NCHUNK * 2 * 2) + 1;
#endif
    int li = 0;
#ifdef REPMASK
    static int kinds[256]; int ns = 0;
    for (int layer = 0; layer < DEPTH; ++layer) { kinds[ns++] = 0;
        for (int c = 0; c < NCHUNK; ++c) for (int q = 1; q <= 8; ++q) if (q != 5) kinds[ns++] = q;
        if ((layer & 1) == 0) { kinds[ns++] = 9; for (int c = 0; c < FFN_CHUNKS; ++c) { kinds[ns++] = 10; kinds[ns++] = 11; } }
        else { kinds[ns++] = 12; kinds[ns++] = 17; for (int c = 0; c < NCHUNK * 2; ++c) { kinds[ns++] = 14; kinds[ns++] = 13; } } }
    kinds[ns++] = 16;
    for (int s = 0; s < NSTEPS; ++s) { const int reps = ((REPMASK >> kinds[s]) & 1) ? 2 : 1;
        for (int r = 0; r < reps; ++r) { a.lo = s; a.hi = s + 1; a.li = 0; a.rep = r;
            hipLaunchKernelGGL(mk_fwd, dim3(grid), dim3(NWAVES * 64), LDS_BYTES, stream, a); } }
    (void)li;
#else
    for (int s = 0; s < NSTEPS; s += MK_STEPS_PER_LAUNCH) {
        a.lo = s; a.hi = (s + MK_STEPS_PER_LAUNCH < NSTEPS) ? s + MK_STEPS_PER_LAUNCH : NSTEPS; a.li = (MK_STEPS_PER_LAUNCH > 1) ? li : 0; ++li;
        hipLaunchKernelGGL(mk_fwd, dim3(grid), dim3(NWAVES * 64), LDS_BYTES, stream, a);
        if (hipPeekAtLastError() != hipSuccess) { fprintf(stderr, "kernel_launch: launch failed\n"); break; }
    }
#endif
}
```

```cpp
#define MK_STEPS_PER_LAUNCH 1000
#define PG8_WGM 4
#define FFN_CHUNKS 1
#include <hip/hip_runtime.h>
#include <cstdio>
#include <cstdint>
#include <cmath>
#ifndef PG8_AUX_A
#define PG8_AUX_A 0
#endif
#ifndef PG8_AUX_B
#define PG8_AUX_B 0
#endif
#ifndef PG8_WGM
#define PG8_WGM 8
#endif
namespace pg8 {
#define PG8_LAS __attribute__((address_space(3)))
typedef unsigned short bf16_t;
typedef short bf16x8 __attribute__((ext_vector_type(8)));
typedef float f32x4 __attribute__((ext_vector_type(4)));
typedef unsigned u32x4 __attribute__((ext_vector_type(4)));
constexpr int BM = 256, BK = 64, HALF = 128, HTB = HALF * BK * 2  , STAGE_BYTES = 8 * HTB, NXCD = 8, WGM = PG8_WGM;

__host__ __device__ __forceinline__ int lds_byte(int r, int c) { const int st = (r >> 4) * 2 + (c >> 5), rr = r & 15, cc = c & 31, ob = rr * 64 + cc * 2; return st * 1024 + (ob ^ (((ob >> 9) & 1) << 5)); }
__host__ __device__ __forceinline__ void stage_rc(int b, int& R, int& C) { const int st = b / 1024, sb = b % 1024, swz = sb ^ (((sb >> 9) & 1) << 5); R = (st >> 1) * 16 + swz / 64; C = (st & 1) * 32 + (swz % 64) / 2; }
__host__ __device__ __forceinline__ int perm32(int rho) { const int n = rho >> 4, i = rho & 15; return 8 * (i >> 2) + 4 * n + (i & 3); }

struct Unit { int pm, pn; };
struct Gemm { const bf16_t* A; const bf16_t* Bt; int M, N, K; int zv; int rot; int tiled; };

struct StaticOrder {
    int nM, nN, nwg, G, c, wgm;
    __host__ __device__ void init(int M, int N, int G_, int c_, int wgm_ = WGM) { nM = M / BM; nN = N / BM; nwg = nM * nN; G = G_; c = c_; wgm = wgm_; }
    __host__ __device__ bool next(int i, Unit& u) const {
        const long L = (long)i * G + c; if (L >= nwg) return false;
        int wgid = (int)L; { const int q = nwg / NXCD, r = nwg % NXCD, xcd = wgid % NXCD, off = wgid / NXCD; wgid = (xcd < r ? xcd * (q + 1) : r * (q + 1) + (xcd - r) * q) + off; }
        const int nig = wgm * nN, gid = wgid / nig, fm = gid * wgm, gsz = (nM - fm) < wgm ? (nM - fm) : wgm;
        u.pm = fm + ((wgid % nig) % gsz); u.pn = (wgid % nig) / gsz; return true;
    }
    __device__ __forceinline__ void a_ready(const Unit&) const {}
    __device__ __forceinline__ void done(const Unit&) const {}
};

__device__ __forceinline__ unsigned cvt_pk_bf16(float lo, float hi) { unsigned r; asm volatile("v_cvt_pk_bf16_f32 %0, %1, %2" : "=v"(r) : "v"(lo), "v"(hi)); return r; }
typedef float f32x2 __attribute__((ext_vector_type(2)));

__device__ __forceinline__ float fast_sigmoid(float x) { return __builtin_amdgcn_rcpf(1.0f + __builtin_amdgcn_exp2f(-1.4426950408889634f * x)); }
__device__ __forceinline__ float gelu_tanh(float x) {
    const float u2 = 1.5957691216057308f * (x + 0.044715f * x * x * x);
    return x * fast_sigmoid(u2);
}
__device__ __forceinline__ float bf_lo(unsigned u) { return __builtin_bit_cast(float, u << 16); }
__device__ __forceinline__ float bf_hi(unsigned u) { return __builtin_bit_cast(float, u & 0xffff0000u); }

#ifdef PG8_NT_OUT
#define PG8_STORE_OUT(p, v) __builtin_nontemporal_store((v), (p))
#else
#define PG8_STORE_OUT(p, v) (*(p) = (v))
#endif
struct EpiProj {
    static constexpr bool PERM = true, AFTER_DRAIN = false, MID = false; static constexpr int MID_TILES = 1; __device__ __forceinline__ void set_scale0() {}
    bf16_t* P1; bf16_t* G;
    __device__ __forceinline__ void operator()(const f32x4 (&acc)[2][2][4][2], const Unit& u, int wr, int wc, int fr, int fq) const {
        const int row0 = u.pm * BM + wr * 64 + fr;
        bf16_t* base; int ldc, colt, act0, act1;
        if (u.pn < 8) { base = P1; ldc = 2048; colt = u.pn * BM; act0 = (u.pn < 2) ? 1 : 0; act1 = (u.pn == 7) ? 2 : act0; }
        else { base = G; ldc = 3072; colt = (u.pn - 8) * BM; act0 = 2; act1 = 2; }
        const int col0 = colt + wc * 32 + 8 * fq;
#pragma unroll
        for (int ai = 0; ai < 2; ++ai)
#pragma unroll
            for (int m = 0; m < 4; ++m) { bf16_t* rowp = base + (size_t)(row0 + ai * HALF + m * 16) * ldc + col0;
#pragma unroll
                for (int bj = 0; bj < 2; ++bj) { f32x4 v0 = acc[ai][bj][m][0], v1 = acc[ai][bj][m][1]; const int act = bj ? act1 : act0;
                    if (act == 1) {
#pragma unroll
                        for (int e = 0; e < 4; ++e) { v0[e] = gelu_tanh(v0[e]); v1[e] = gelu_tanh(v1[e]); } }
                    else if (act == 2) {
#pragma unroll
                        for (int e = 0; e < 4; ++e) { v0[e] = fast_sigmoid(v0[e]); v1[e] = fast_sigmoid(v1[e]); } }
                    u32x4 w; w.x = cvt_pk_bf16(v0[0], v0[1]); w.y = cvt_pk_bf16(v0[2], v0[3]); w.z = cvt_pk_bf16(v1[0], v1[1]); w.w = cvt_pk_bf16(v1[2], v1[3]);
                    *(u32x4*)(rowp + bj * HALF) = w; } }
    }
};
struct EpiMerge {
    static constexpr bool PERM = true, AFTER_DRAIN = false, MID = false; static constexpr int MID_TILES = 1; __device__ __forceinline__ void set_scale0() {}
    const bf16_t* G; bf16_t* MG; int nmt;
    __device__ __forceinline__ void operator()(const f32x4 (&acc)[2][2][4][2], const Unit& u, int wr, int wc, int fr, int fq) const {
        const int i = u.pn >> 2, pn = u.pn & 3, pm = u.pm - i * nmt;
        const int row0 = pm * BM + wr * 64 + fr, col0 = pn * BM + wc * 32 + 8 * fq;
#pragma unroll
        for (int ai = 0; ai < 2; ++ai)
#pragma unroll
            for (int mp = 0; mp < 2; ++mp) {
                u32x4 g[4], o[4];
#pragma unroll
                for (int q = 0; q < 4; ++q) { const int m = 2 * mp + (q >> 1), bj = q & 1; const size_t row = (size_t)(row0 + ai * HALF + m * 16); const int col = col0 + bj * HALF;
                    g[q] = *(const u32x4*)(G + row * 3072 + i * 1024 + col);
                    if (i > 0) o[q] = *(const u32x4*)(MG + row * 1024 + col); else o[q] = (u32x4){0u, 0u, 0u, 0u}; }
#pragma unroll
                for (int q = 0; q < 4; ++q) { const int m = 2 * mp + (q >> 1), bj = q & 1; const size_t row = (size_t)(row0 + ai * HALF + m * 16); const int col = col0 + bj * HALF;
                    f32x4 v0 = acc[ai][bj][m][0], v1 = acc[ai][bj][m][1];
#ifdef ABL_BRANCH
                    if (i == ABL_BRANCH) { v0 = v0 * (float)ABL_SCALE; v1 = v1 * (float)ABL_SCALE; }
#endif
                    v0[0] = v0[0] * bf_lo(g[q].x) + bf_lo(o[q].x); v0[1] = v0[1] * bf_hi(g[q].x) + bf_hi(o[q].x); v0[2] = v0[2] * bf_lo(g[q].y) + bf_lo(o[q].y); v0[3] = v0[3] * bf_hi(g[q].y) + bf_hi(o[q].y);
                    v1[0] = v1[0] * bf_lo(g[q].z) + bf_lo(o[q].z); v1[1] = v1[1] * bf_hi(g[q].z) + bf_hi(o[q].z); v1[2] = v1[2] * bf_lo(g[q].w) + bf_lo(o[q].w); v1[3] = v1[3] * bf_hi(g[q].w) + bf_hi(o[q].w);
                    u32x4 w; w.x = cvt_pk_bf16(v0[0], v0[1]); w.y = cvt_pk_bf16(v0[2], v0[3]); w.z = cvt_pk_bf16(v1[0], v1[1]); w.w = cvt_pk_bf16(v1[2], v1[3]);
                    *(u32x4*)(MG + row * 1024 + col) = w; } }
    }
};
struct EpiResid {
    static constexpr bool PERM = false, AFTER_DRAIN = false, MID = false; static constexpr int MID_TILES = 1; __device__ __forceinline__ void set_scale0() { scale = 0.f; base = out; }
    const float* base; float* out; int ldc; float scale;
    __device__ __forceinline__ void operator()(const f32x4 (&acc)[2][2][4][2], const Unit& u, int wr, int wc, int fr, int fq) const {
        const int row0 = u.pm * BM + wr * 64 + fr, col0 = u.pn * BM + wc * 32 + 4 * fq;
#pragma unroll
        for (int ai = 0; ai < 2; ++ai)
#pragma unroll
            for (int mp = 0; mp < 2; ++mp) {
                f32x4 b[8];
#pragma unroll
                for (int q = 0; q < 8; ++q) { const int m = 2 * mp + (q >> 2), bj = (q >> 1) & 1, n = q & 1;
                    b[q] = *(const f32x4*)(base + (size_t)(row0 + ai * HALF + m * 16) * ldc + col0 + bj * HALF + n * 16); }
#pragma unroll
                for (int q = 0; q < 8; ++q) { const int m = 2 * mp + (q >> 2), bj = (q >> 1) & 1, n = q & 1;
                    *(f32x4*)(out + (size_t)(row0 + ai * HALF + m * 16) * ldc + col0 + bj * HALF + n * 16) = b[q] + acc[ai][bj][m][n] * scale; } }
    }
};
struct EpiF32 {
    static constexpr bool PERM = false, AFTER_DRAIN = false, MID = false; static constexpr int MID_TILES = 1; __device__ __forceinline__ void set_scale0() {}
    float* O; int ldc, nN;
    __device__ __forceinline__ void operator()(const f32x4 (&acc)[2][2][4][2], const Unit& u, int wr, int wc, int fr, int fq) const {
        const int row0 = u.pm * BM + wr * 64 + fr, col0 = (u.pn % nN) * BM + wc * 32 + 4 * fq;
#pragma unroll
        for (int ai = 0; ai < 2; ++ai)
#pragma unroll
            for (int m = 0; m < 4; ++m) { const size_t off = (size_t)(row0 + ai * HALF + m * 16) * ldc + col0;
#pragma unroll
                for (int bj = 0; bj < 2; ++bj)
#pragma unroll
                    for (int n = 0; n < 2; ++n) *(f32x4*)(O + off + bj * HALF + n * 16) = acc[ai][bj][m][n]; }
    }
};
#ifdef EMU_FP8_HID
__device__ __forceinline__ float Q8H(float x) { const int p = __builtin_amdgcn_cvt_pk_fp8_f32(x * 8.f, x * 8.f, 0, false); return __builtin_amdgcn_cvt_f32_fp8(p, 0) * 0.125f; }
#else
__device__ __forceinline__ float Q8H(float x) { return x; }
#endif
struct EpiSwiGLU {
    static constexpr bool PERM = true, AFTER_DRAIN = false, MID = false; static constexpr int MID_TILES = 1; __device__ __forceinline__ void set_scale0() {}
    bf16_t* H; int ldh; const float* rowscale; int nN; int rowmask = 0x7fffffff;
    __device__ __forceinline__ void operator()(const f32x4 (&acc)[2][2][4][2], const Unit& u, int wr, int wc, int fr, int fq) const {
        const int row0 = u.pm * BM + wr * 64 + fr, col0 = (u.pn % nN) * HALF + wc * 32 + 8 * fq;
        float scv[8];
#pragma unroll
        for (int q = 0; q < 8; ++q) scv[q] = rowscale ? rowscale[row0 + (q >> 2) * HALF + (q & 3) * 16] : 1.0f;
#pragma unroll
        for (int ai = 0; ai < 2; ++ai)
#pragma unroll
            for (int m = 0; m < 4; ++m) { const int row = row0 + ai * HALF + m * 16; const float sc = scv[ai * 4 + m];
                float h[8];
#pragma unroll
                for (int n = 0; n < 2; ++n)
#pragma unroll
                    for (int e = 0; e < 4; ++e) { const float g = acc[ai][0][m][n][e], up = acc[ai][1][m][n][e]; h[n * 4 + e] = Q8H(g * fast_sigmoid(g) * up * sc); }
                u32x4 w; w.x = cvt_pk_bf16(h[0], h[1]); w.y = cvt_pk_bf16(h[2], h[3]); w.z = cvt_pk_bf16(h[4], h[5]); w.w = cvt_pk_bf16(h[6], h[7]);
                PG8_STORE_OUT((u32x4*)(H + (size_t)(row & rowmask) * ldh + col0), w); }
    }
};
struct EpiScatter {
    static constexpr bool PERM = false, AFTER_DRAIN = false, MID = false; static constexpr int MID_TILES = 1; __device__ __forceinline__ void set_scale0() { scale = 0.f; }
    float* out; const int* tok; int nN; float scale;
    __device__ __forceinline__ void operator()(const f32x4 (&acc)[2][2][4][2], const Unit& u, int wr, int wc, int fr, int fq) const {
        const int row0 = u.pm * BM + wr * 64 + fr, col0 = (u.pn % nN) * BM + wc * 32 + 4 * fq;
        int tk[8];
#pragma unroll
        for (int q = 0; q < 8; ++q) tk[q] = tok[row0 + (q >> 2) * HALF + (q & 3) * 16];
#pragma unroll
        for (int ai = 0; ai < 2; ++ai)
#pragma unroll
            for (int mp = 0; mp < 2; ++mp) {
                f32x4 b[8];
#pragma unroll
                for (int q = 0; q < 8; ++q) { const int m = 2 * mp + (q >> 2), bj = (q >> 1) & 1, n = q & 1; const int t = tk[ai * 4 + m];
                    b[q] = *(const f32x4*)(out + (size_t)(t < 0 ? 0 : t) * 1024 + col0 + bj * HALF + n * 16); }
#pragma unroll
                for (int q = 0; q < 8; ++q) { const int m = 2 * mp + (q >> 2), bj = (q >> 1) & 1, n = q & 1; const int t = tk[ai * 4 + m];
#ifdef ABL_MOE
                    if (false)
#else
                    if (t >= 0)
#endif
                        *(f32x4*)(out + (size_t)t * 1024 + col0 + bj * HALF + n * 16) = b[q] + acc[ai][bj][m][n] * scale; } }
    }
};
struct GroupedOrder {
    StaticOrder so; const PG8_LAS int* tile_e; int nN;
    __device__ __forceinline__ bool next(int i, Unit& u) const { if (!so.next(i, u)) return false; u.pn += tile_e[u.pm] * nN; return true; }
    __device__ __forceinline__ void a_ready(const Unit&) const {}
    __device__ __forceinline__ void done(const Unit&) const {}
};
struct OffsetOrder {
    StaticOrder so; int pn_off;
    __device__ __forceinline__ bool next(int i, Unit& u) const { if (!so.next(i, u)) return false; u.pn += pn_off; return true; }
    __device__ __forceinline__ void a_ready(const Unit&) const {}
    __device__ __forceinline__ void done(const Unit&) const {}
};
struct ProbeOrder {
    StaticOrder so; int pm_mask;
    __device__ __forceinline__ bool next(int i, Unit& u) const { if (!so.next(i, u)) return false; u.pm &= pm_mask; return true; }
    __device__ __forceinline__ void a_ready(const Unit&) const {}
    __device__ __forceinline__ void done(const Unit&) const {}
};
struct MergeOrder {
    StaticOrder so; int nmt;
    __device__ __forceinline__ bool next(int i, Unit& u) const { const int b = i % 3; if (!so.next(i / 3, u)) return false; u.pm += b * nmt; u.pn += b * 4; return true; }
    __device__ __forceinline__ void a_ready(const Unit&) const {}
    __device__ __forceinline__ void done(const Unit&) const {}
};
template <class Epi, class Sched, bool ALIGN_EPI = false, bool SP2 = false>
__device__ __forceinline__ void gemm_phase(PG8_LAS unsigned char* lds, const Gemm g, const Sched& S, const Epi& E) {
    const int tid = g.zv  , wid = __builtin_amdgcn_readfirstlane(tid >> 6), lane = tid & 63, wr = wid >> 2, wc = wid & 3, fr = lane & 15, fq = lane >> 4;
    const int K = g.K, nt = K / BK;
    unsigned voffA[2], voffB[2];
#pragma unroll
    for (int i = 0; i < 2; ++i) { int R, C; stage_rc(tid * 16 + i * 8192, R, C); const int Rb = Epi::PERM ? ((R & ~31) + perm32(R & 31)) : R;
        const int pitch = g.tiled ? BK : K;
        voffA[i] = (unsigned)(R * pitch + C) * 2u; voffB[i] = (unsigned)(Rb * pitch + C) * 2u; }
    const size_t kstep = g.tiled ? (size_t)(BM * BK * 2) : (size_t)(BK * 2);
    const size_t hstep = g.tiled ? (size_t)(HALF * BK * 2) : (size_t)HALF * K * 2;
    const size_t tstep = (size_t)BM * K * 2;
    const unsigned ldsw = (unsigned)wid * 1024u;
    const int aoff = lds_byte(wr * 64 + fr, fq * 8), boff = lds_byte(wc * 32 + fr, fq * 8);
#define PG8_SA(b, h) (((b) * 2 + (h)) * HTB)
#define PG8_SB(b, h) ((4 + (b) * 2 + (h)) * HTB)
#define PG8_STAGE(bufoff, gbase, voff) do { _Pragma("unroll") for (int _i = 0; _i < 2; ++_i) \
        __builtin_amdgcn_global_load_lds((const unsigned*)((const char*)(gbase) + (voff)[_i]), (PG8_LAS unsigned*)(lds + (bufoff) + ldsw + _i * 8192), 16, 0, ((bufoff) < 4 * HTB) ? PG8_AUX_A : PG8_AUX_B); } while (0)
#define PG8_LDA(dst, b, h) do { _Pragma("unroll") for (int m = 0; m < 4; ++m) _Pragma("unroll") for (int k = 0; k < 2; ++k) dst[m][k] = *(const PG8_LAS bf16x8*)(lds + PG8_SA(b, h) + aoff + m * 2048 + k * 1024); } while (0)
#define PG8_LDB(dst, b, h) do { _Pragma("unroll") for (int n = 0; n < 2; ++n) _Pragma("unroll") for (int k = 0; k < 2; ++k) dst[n][k] = *(const PG8_LAS bf16x8*)(lds + PG8_SB(b, h) + boff + n * 2048 + k * 1024); } while (0)
#define PG8_MMA(ai, bj, At, Bt) do { __builtin_amdgcn_s_setprio(1); _Pragma("unroll") for (int m = 0; m < 4; ++m) _Pragma("unroll") for (int n = 0; n < 2; ++n) _Pragma("unroll") for (int k = 0; k < 2; ++k) \
        acc[ai][bj][m][n] = __builtin_amdgcn_mfma_f32_16x16x32_bf16(Bt[n][k], At[m][k], acc[ai][bj][m][n], 0, 0, 0); __builtin_amdgcn_s_setprio(0); } while (0)
#define PG8_WAIT_V(n) asm volatile("s_waitcnt vmcnt(" #n ")" ::: "memory")
#define PG8_WAIT_L(n) asm volatile("s_waitcnt lgkmcnt(" #n ")" ::: "memory")
#define PG8_BAR __builtin_amdgcn_s_barrier()
#define PG8_SCHED __builtin_amdgcn_sched_barrier(0)
    Unit cur, nxt; int ui = 0;
    if (!S.next(0, cur)) return;
    f32x4 acc[2][2][4][2];
#pragma unroll
    for (int a = 0; a < 2; ++a)
#pragma unroll
        for (int b = 0; b < 2; ++b)
#pragma unroll
            for (int m = 0; m < 4; ++m)
#pragma unroll
                for (int n = 0; n < 2; ++n) acc[a][b][m][n] = (f32x4){0.f, 0.f, 0.f, 0.f};
    bf16x8 At[4][2], B0[2][2], B1[2][2];
    const char* cA = (const char*)g.A + (size_t)cur.pm * tstep; const char* cB = (const char*)g.Bt + (size_t)cur.pn * tstep;
    const int rot = g.rot; const size_t rofs = (size_t)rot * kstep; const char* pA = cA + rofs; const char* pB = cB + rofs;
#define PG8_KT(x) ((size_t)(((x) + rot >= nt) ? (x) + rot - nt : (x) + rot))
    S.a_ready(cur);
    if constexpr (SP2) {
        PG8_STAGE(PG8_SB(0, 0), pB, voffB); PG8_STAGE(PG8_SB(0, 1), pB + hstep, voffB); PG8_STAGE(PG8_SA(0, 0), pA, voffA); PG8_STAGE(PG8_SA(0, 1), pA + hstep, voffA);
        if (wr == 1) PG8_BAR;
        PG8_WAIT_V(2); PG8_BAR;
        PG8_STAGE(PG8_SB(1, 0), pB + kstep, voffB); PG8_STAGE(PG8_SA(1, 0), pA + kstep, voffA); PG8_STAGE(PG8_SB(1, 1), pB + hstep + kstep, voffB);
        PG8_WAIT_V(6); PG8_BAR;
    } else {
        PG8_STAGE(PG8_SB(0, 0), pB, voffB); PG8_STAGE(PG8_SA(0, 0), pA, voffA); PG8_STAGE(PG8_SB(0, 1), pB + hstep, voffB); PG8_STAGE(PG8_SA(0, 1), pA + hstep, voffA);
        if (wr == 1) PG8_BAR;
        PG8_WAIT_V(4); PG8_BAR;
        PG8_STAGE(PG8_SB(1, 0), pB + kstep, voffB); PG8_STAGE(PG8_SA(1, 0), pA + kstep, voffA); PG8_STAGE(PG8_SB(1, 1), pB + hstep + kstep, voffB);
        PG8_WAIT_V(6); PG8_BAR;
    }
    for (;;) {
        const bool has_next = S.next(ui + 1, nxt);
        const char* nA = has_next ? (const char*)g.A + (size_t)nxt.pm * tstep : cA; const char* nB = has_next ? (const char*)g.Bt + (size_t)nxt.pn * tstep : cB;
        for (int t = 0; t < nt; t += 2) {
            if constexpr (Epi::MID) { if (t != 0 && (t & (Epi::MID_TILES - 1)) == 0) E.mid(acc, cur, t / Epi::MID_TILES, wr, wc, fr, fq); }
            const bool last = (t == nt - 2);
            const char* a1 = cA + PG8_KT(t + 1) * kstep;
            const char* a2 = last ? nA + rofs : cA + PG8_KT(t + 2) * kstep; const char* b2 = last ? nB + rofs : cB + PG8_KT(t + 2) * kstep;
            const char* a3 = a2 + kstep; const char* b3 = b2 + kstep;
            if (last && has_next) S.a_ready(nxt);
            if constexpr (SP2) {
            PG8_LDB(B0, 0, 0); PG8_LDB(B1, 0, 1); PG8_SCHED; PG8_LDA(At, 0, 0); PG8_STAGE(PG8_SA(1, 1), a1 + hstep, voffA);
            PG8_WAIT_V(8); PG8_WAIT_L(0); PG8_BAR; PG8_MMA(0, 0, At, B0); PG8_MMA(0, 1, At, B1); PG8_BAR; PG8_SCHED;
            PG8_LDA(At, 0, 1); PG8_STAGE(PG8_SB(0, 0), b2, voffB); PG8_STAGE(PG8_SB(0, 1), b2 + hstep, voffB); PG8_STAGE(PG8_SA(0, 0), a2, voffA);
            PG8_WAIT_V(8); PG8_WAIT_L(0); PG8_BAR; PG8_MMA(1, 0, At, B0); PG8_MMA(1, 1, At, B1); PG8_BAR; PG8_SCHED;
            PG8_LDB(B0, 1, 0); PG8_LDB(B1, 1, 1); PG8_SCHED; PG8_LDA(At, 1, 0); PG8_STAGE(PG8_SA(0, 1), a2 + hstep, voffA);
            PG8_WAIT_V(8); PG8_WAIT_L(0); PG8_BAR; PG8_MMA(0, 0, At, B0); PG8_MMA(0, 1, At, B1); PG8_BAR; PG8_SCHED;
            PG8_LDA(At, 1, 1); PG8_STAGE(PG8_SB(1, 0), b3, voffB); PG8_STAGE(PG8_SB(1, 1), b3 + hstep, voffB); PG8_STAGE(PG8_SA(1, 0), a3, voffA);
            PG8_WAIT_V(8); PG8_WAIT_L(0); PG8_BAR; PG8_MMA(1, 0, At, B0); PG8_MMA(1, 1, At, B1); PG8_BAR; PG8_SCHED;
            } else {
            PG8_LDB(B0, 0, 0); PG8_SCHED; PG8_LDA(At, 0, 0); PG8_STAGE(PG8_SA(1, 1), a1 + hstep, voffA);
            PG8_WAIT_L(8); PG8_BAR; PG8_WAIT_L(0); PG8_MMA(0, 0, At, B0); PG8_BAR; PG8_SCHED;
            PG8_LDB(B1, 0, 1); PG8_STAGE(PG8_SB(0, 0), b2, voffB);
            PG8_BAR; PG8_WAIT_L(0); PG8_MMA(0, 1, At, B1); PG8_BAR;
            PG8_LDA(At, 0, 1); PG8_STAGE(PG8_SA(0, 0), a2, voffA);
            PG8_BAR; PG8_WAIT_L(0); PG8_MMA(1, 0, At, B0); PG8_BAR; PG8_SCHED;
            PG8_STAGE(PG8_SB(0, 1), b2 + hstep, voffB);
            PG8_WAIT_V(6); PG8_BAR; PG8_MMA(1, 1, At, B1); PG8_BAR;
            PG8_LDB(B0, 1, 0); PG8_SCHED; PG8_LDA(At, 1, 0); PG8_STAGE(PG8_SA(0, 1), a2 + hstep, voffA);
            PG8_WAIT_L(8); PG8_BAR; PG8_WAIT_L(0); PG8_MMA(0, 0, At, B0); PG8_BAR; PG8_SCHED;
            PG8_LDB(B1, 1, 1); PG8_STAGE(PG8_SB(1, 0), b3, voffB);
            PG8_BAR; PG8_WAIT_L(0); PG8_MMA(0, 1, At, B1); PG8_BAR;
            PG8_LDA(At, 1, 1); PG8_STAGE(PG8_SA(1, 0), a3, voffA);
            PG8_BAR; PG8_WAIT_L(0); PG8_MMA(1, 0, At, B0); PG8_BAR; PG8_SCHED;
            PG8_STAGE(PG8_SB(1, 1), b3 + hstep, voffB);
            PG8_WAIT_V(6); PG8_BAR; PG8_MMA(1, 1, At, B1); PG8_BAR;
            }
        }
        if constexpr (ALIGN_EPI) { if (wr == 0) PG8_BAR; }
        if constexpr (!Epi::AFTER_DRAIN) { E(acc, cur, wr, wc, fr, fq); S.done(cur); }
        if (!has_next) break;
#pragma unroll
        for (int a = 0; a < 2; ++a)
#pragma unroll
            for (int b = 0; b < 2; ++b)
#pragma unroll
                for (int m = 0; m < 4; ++m)
#pragma unroll
                    for (int n = 0; n < 2; ++n) acc[a][b][m][n] = (f32x4){0.f, 0.f, 0.f, 0.f};
        cur = nxt; cA = nA; cB = nB; ++ui;
        if constexpr (ALIGN_EPI) { if (wr == 1) PG8_BAR; }
    }
    PG8_WAIT_V(0);
    if constexpr (!ALIGN_EPI) { if (wr == 0) PG8_BAR; }
    PG8_BAR;
    if constexpr (Epi::AFTER_DRAIN) { E.fused(acc, cur, wr, wc, fr, fq, lds, wid, lane); S.done(cur); }
#undef PG8_KT
#undef PG8_SA
#undef PG8_SB
#undef PG8_STAGE
#undef PG8_LDA
#undef PG8_LDB
#undef PG8_MMA
#undef PG8_WAIT_V
#undef PG8_WAIT_L
#undef PG8_BAR
#undef PG8_SCHED
}
}

constexpr int NWAVES = 8;
constexpr int DM = 1024, BATCH = 16, SEQ = 4096, DEPTH = 4, MTOK = BATCH * SEQ;
constexpr int NCHUNK = 2, MC = MTOK / NCHUNK, BC = BATCH / NCHUNK;
constexpr int CIN = 5004, NPROJ = 5120, P1W = 2048, GWID = 3072;
constexpr int DFF = 2752, DFFP = 2816, NFF1 = 2 * DFFP;
constexpr int NEXP = 8, DFE = 3584, NMOE1 = 2 * DFE;
constexpr int SLOTS = MC + 2048;
constexpr float EPS = 1e-6f;
constexpr int C_U = 0, C_V = 256, C_SBQ = 512, C_SBK = 768, C_SBV = 1024, C_CQ = 1280, C_KCMP = 1536, C_VCMP = 1600, C_KSLC = 1664, C_VSLC = 1728, C_KWIN = 1792, C_VWIN = 1856, C_CG = 1920;

constexpr size_t MiB = 1u << 20;
constexpr size_t WS_CTL = 0, CTL_ZERO_BYTES = 1 * MiB;
constexpr size_t WS_ROPE = 1 * MiB;
constexpr size_t WS_BIAS1 = 1 * MiB + 512 * 1024;
constexpr size_t WS_WIN = 2 * MiB;
constexpr size_t WS_WBR = 12 * MiB;
constexpr size_t WS_WOUT = 14 * MiB;
constexpr size_t WS_WC1 = 16 * MiB;
constexpr size_t WS_WF1 = 18 * MiB;
constexpr size_t WS_WF2 = 130 * MiB;
constexpr size_t WS_HN = 186 * MiB;
constexpr size_t WS_SCR = 314 * MiB;
constexpr size_t WS_P1 = WS_SCR;
constexpr size_t WS_G = WS_P1 + 128 * MiB;
constexpr size_t WS_Y = WS_G + 192 * MiB;
constexpr size_t WS_MG = WS_Y + 48 * MiB;
constexpr size_t WS_KVC = WS_MG + 64 * MiB;
constexpr size_t WS_UL = WS_KVC + 8 * MiB;
constexpr size_t WS_KC = WS_UL + 8 * MiB;
constexpr size_t WS_VT = WS_KC + 1 * MiB;
constexpr size_t WS_KCT = WS_VT + 24 * MiB;
constexpr size_t WS_MIX_END = WS_KCT + 1 * MiB;
constexpr size_t WS_HID = WS_SCR;
constexpr size_t WS_ROUTE = WS_SCR;
constexpr size_t WS_TOKMAP = WS_SCR + 1 * MiB;
constexpr size_t WS_WSLOT = WS_SCR + 2 * MiB;
constexpr size_t WS_XG = WS_SCR + 4 * MiB;
constexpr size_t WS_HIDM = WS_XG + 68 * MiB;
constexpr size_t WS_END = 800 * MiB;
static_assert(WS_MIX_END <= WS_END && WS_HID + (size_t)MTOK * DFFP * 2 <= WS_END && WS_HIDM + (size_t)SLOTS * DFE * 2 <= WS_END, "d_ws map");
static_assert(WS_WF1 + (size_t)NEXP * NMOE1 * DM * 2 <= WS_WF2 && WS_WF2 + (size_t)NEXP * DM * DFE * 2 <= WS_HN, "weight map");
static_assert((size_t)4 * SLOTS * 4 <= 1 * MiB, "tokmap");
constexpr int CW_BAR = 4096;
constexpr int CW_CNT = 131072;
constexpr int CW_CUR = 131072 + 256;
constexpr int MAX_BAR_REGIONS = 32;
constexpr int RING_OFF = 0, RING_BYTES = 131072;
constexpr int LDSCTL_OFF = RING_BYTES, MISC_OFF = LDSCTL_OFF + 320;
constexpr int TAB_OFF = LDSCTL_OFF + 1024;
constexpr int LDS_BYTES = 147456;

#define GAS __attribute__((address_space(1)))
#define LAS __attribute__((address_space(3)))
typedef unsigned short bf16;
typedef unsigned v4u __attribute__((ext_vector_type(4)));
typedef unsigned v2u __attribute__((ext_vector_type(2)));
typedef float f32x4 __attribute__((ext_vector_type(4)));
typedef int v4i __attribute__((ext_vector_type(4)));
typedef __bf16 bf16x2_t __attribute__((ext_vector_type(2)));
#define LDS_WAIT() asm volatile("s_waitcnt lgkmcnt(0)" ::: "memory")
#define VM_WAIT() asm volatile("s_waitcnt vmcnt(0)" ::: "memory")
__device__ __forceinline__ unsigned f2bf(float f) { unsigned u = __builtin_bit_cast(unsigned, f); return (u + 0x7fffu + ((u >> 16) & 1u)) >> 16; }
__device__ __forceinline__ unsigned pk2(float lo, float hi) { return f2bf(lo) | (f2bf(hi) << 16); }
__device__ __forceinline__ float bflo(unsigned u) { return __builtin_bit_cast(float, u << 16); }
__device__ __forceinline__ float bfhi(unsigned u) { return __builtin_bit_cast(float, u & 0xffff0000u); }
__device__ __forceinline__ float bf1(bf16 h) { return __builtin_bit_cast(float, (unsigned)h << 16); }
__device__ __forceinline__ float dot2bf(unsigned a, unsigned b, float c) { return __builtin_amdgcn_fdot2_f32_bf16(__builtin_bit_cast(bf16x2_t, a), __builtin_bit_cast(bf16x2_t, b), c, false); }
#ifdef EMU_FP8
__device__ __forceinline__ float q8r(float x, float s) { const int p = __builtin_amdgcn_cvt_pk_fp8_f32(x * s, x * s, 0, false); return __builtin_amdgcn_cvt_f32_fp8(p, 0) * (1.0f / s); }
#else
__device__ __forceinline__ float q8r(float x, float) { return x; }
#endif
__device__ __forceinline__ float fexp(float x) { return __builtin_amdgcn_exp2f(1.4426950408889634f * x); }
template <int X> __device__ __forceinline__ float swz_xor(float v) { return __builtin_bit_cast(float, __builtin_amdgcn_ds_swizzle(__builtin_bit_cast(int, v), (X << 10) | 0x1f)); }
__device__ __forceinline__ float wave_sum(float v, int lane) {
#pragma unroll
    for (int o = 1; o < 64; o <<= 1) v += __builtin_bit_cast(float, __builtin_amdgcn_ds_bpermute((lane ^ o) << 2, __builtin_bit_cast(int, v)));
    return v;
}
__device__ __forceinline__ float rdlane(float v, int l) { return __builtin_bit_cast(float, __builtin_amdgcn_readlane(__builtin_bit_cast(int, v), l)); }
__device__ __forceinline__ int bperm(int srclane, int v) { return __builtin_amdgcn_ds_bpermute(srclane << 2, v); }
__constant__ double ROPE_INVF[8] = {1.0, 0.19392274474868576, 0.037606030930863933, 0.0072926647372171093, 0.0014142135623730950, 0.00027424817567620730, 5.3182958969449883e-05, 1.0313385377212460e-05};
#define XB_TMO      128
#define XB_XCNT(j)  (256  + 64 * (j))
#define XB_XSUB(j)  (1280 + 64 * (j))
#define XB_XGEN(j)  (2304 + 64 * (j))
#define XB_TOP      3328
#define XB_TOPGEN   3392
#define XCD_BAR_WORDS 3456
#define XB_SPIN_CAP (1u << 18)

__device__ __forceinline__ unsigned xb_ld(unsigned* p)              { return __hip_atomic_load(p, __ATOMIC_RELAXED, __HIP_MEMORY_SCOPE_AGENT); }
__device__ __forceinline__ unsigned xb_add(unsigned* p, unsigned v) { return __hip_atomic_fetch_add(p, v, __ATOMIC_RELAXED, __HIP_MEMORY_SCOPE_AGENT); }
__device__ __forceinline__ unsigned xb_xcc_id() { return (unsigned)__builtin_amdgcn_s_getreg((3 << 11) | 20) & 0xFu; }
#define XB_SPIN(cond, bar) do { unsigned _sp = 0; while (cond) { __builtin_amdgcn_s_sleep(1); \
    if ((++_sp & 255u) == 0u) { if (xb_ld(&(bar)[XB_TMO])) break; if (_sp > XB_SPIN_CAP) { atomicAdd(&(bar)[XB_TMO], 1u); break; } } } } while (0)

__device__ __forceinline__ bool xb_thread0_w(unsigned w, unsigned z) { return w == 0u && __builtin_amdgcn_mbcnt_hi(~0u, __builtin_amdgcn_mbcnt_lo(~0u, z)) == 0u; }
struct XcdBarrier {
    unsigned* bar; unsigned x; unsigned w, z;
    volatile LAS unsigned* st;
};

__device__ __forceinline__ XcdBarrier xcd_barrier_post(unsigned* bar, volatile LAS unsigned* st) {
    XcdBarrier b; b.bar = bar; b.x = xb_xcc_id(); b.st = st; b.w = (unsigned)__builtin_amdgcn_readfirstlane((int)(threadIdx.x >> 6)); b.z = 0u;
    if (xb_thread0_w(b.w, b.z)) (void)xb_add(&bar[XB_XCNT(b.x)], 1u);
    return b;
}
__device__ __forceinline__ void xcd_barrier_complete(unsigned* bar, unsigned x, unsigned& nloc, unsigned& nx) {
    const unsigned G = gridDim.x * gridDim.y * gridDim.z;
    unsigned sum, cnt, mine, sp = 0u;
    for (;;) {
        sum = 0u; cnt = 0u; mine = 0u;
#pragma unroll
        for (unsigned j = 0; j < 16; ++j) { const unsigned c = xb_ld(&bar[XB_XCNT(j)]); sum += c; cnt += (c > 0u) ? 1u : 0u; mine = (j == x) ? c : mine; }
        if (sum == G) break;
        __builtin_amdgcn_s_sleep(1);
        if ((++sp & 255u) == 0u) { if (xb_ld(&bar[XB_TMO])) break; if (sp > XB_SPIN_CAP) { atomicAdd(&bar[XB_TMO], 1u); break; } }
    }
    nloc = mine > 0u ? mine : 1u; nx = cnt > 0u ? cnt : 1u;
}

__device__ __forceinline__ void xcd_barrier(const XcdBarrier& b) {
    asm volatile("s_waitcnt vmcnt(0)" ::: "memory");
    __syncthreads();
    if (xb_thread0_w(b.w, b.z)) {
        unsigned* bar = b.bar;
        __builtin_amdgcn_s_waitcnt(0);
        unsigned nloc = b.st[0], nx = b.st[1];
        if (nloc == 0u) { xcd_barrier_complete(bar, b.x, nloc, nx); b.st[0] = nloc; b.st[1] = nx; }
        const unsigned old = xb_add(&bar[XB_XSUB(b.x)], 1u);
        const unsigned gen = old / nloc;
        if (old + 1u == (gen + 1u) * nloc) {
            __builtin_amdgcn_fence(__ATOMIC_RELEASE, "agent");
            asm volatile("s_waitcnt vmcnt(0)" ::: "memory");
            const unsigned og = xb_add(&bar[XB_TOP], 1u);
            const unsigned tg = og / nx;
            if (og + 1u == (tg + 1u) * nx) xb_add(&bar[XB_TOPGEN], 1u);
            else XB_SPIN(xb_ld(&bar[XB_TOPGEN]) == tg, bar);
            __builtin_amdgcn_fence(__ATOMIC_ACQUIRE, "agent");
            xb_add(&bar[XB_XGEN(b.x)], 1u);
            asm volatile("s_waitcnt vmcnt(0)" ::: "memory");
        } else {
            XB_SPIN(xb_ld(&bar[XB_XGEN(b.x)]) == gen, bar);
            __builtin_amdgcn_fence(__ATOMIC_ACQUIRE, "agent");
            asm volatile("s_waitcnt vmcnt(0)" ::: "memory");
        }
    }
    __syncthreads();
}

struct Frame {
    LAS unsigned char* lds;
    unsigned* ctl;
    int tid, lane, wave, vcu, G, bx, zv, zs, rep;
    unsigned char* ws;
    const float* const* in;
    float* out;
};
#define WSP(T, off) ((T*)(F.ws + (off)))
__device__ __forceinline__ size_t toff(int row, int k, int K) { return (size_t)(row >> 8) * 256 * K + (size_t)(k >> 6) * (256 * 64) + (size_t)(row & 255) * 64 + (k & 63); }

#ifndef TILED_FFN1
#define TILED_FFN1 0
#endif
#ifndef Q8_W1
#define Q8_W1 0.f
#define Q8_W2 0.f
#define Q8_HN 0.f
#define Q8_HID 0.f
#endif
__device__ __forceinline__ int map_row(int kind, int off, int n) { return kind == 0 ? n + off : (kind == 1 ? (n < 1932 ? n : n + 116) : ((n >> 7) * 256 + (n & 127) + off)); }
__device__ __forceinline__ void tr_item(const float* W, int ldw, int N, int ks, int n0, bf16* WT, int ldt, int kd, int kind, int off, LAS unsigned char* scr, int lane, float q8s = 0.f, int tiled = 0) {
    const int nq = (lane & 15) * 4, kq = lane >> 4;
    f32x4 x[16];
#pragma unroll
    for (int i = 0; i < 16; ++i) x[i] = (n0 + nq < N) ? *(const f32x4*)(W + (size_t)(ks + 4 * i + kq) * ldw + n0 + nq) : (f32x4){0.f, 0.f, 0.f, 0.f};
#pragma unroll
    for (int i = 0; i < 16; ++i) { const int k = 4 * i + kq;
#pragma unroll
        for (int c = 0; c < 4; ++c) { float wv = x[i][c]; if (q8s > 0.f) wv = q8r(wv, q8s); *(LAS bf16*)(scr + (nq + c) * 136 + k * 2) = (bf16)f2bf(wv); } }
    LDS_WAIT(); asm volatile("" ::: "memory");
    if (n0 + lane < N) { const LAS v2u* s = (const LAS v2u*)(scr + lane * 136); const int mr = map_row(kind, off, n0 + lane); bf16* dst = tiled ? WT + toff(mr, kd, ldt) : WT + (size_t)mr * ldt + kd;
#pragma unroll
        for (int q = 0; q < 8; ++q) { const v2u a = s[2 * q], b = s[2 * q + 1]; *(v4u*)(dst + 8 * q) = (v4u){a.x, a.y, b.x, b.y}; } }
    LDS_WAIT(); asm volatile("" ::: "memory");
}
__device__ __forceinline__ void conv(Frame& F, const float* W, size_t sW, int nb, int ldw, int N, int ks0, int K, bf16* WT, size_t sWT, int ldt, int kd0, int kind, int off, float q8s = 0.f, int tiled = 0) {
    LAS unsigned char* scr = F.lds + RING_OFF + F.wave * 16384;
    const int gw = F.vcu * NWAVES + F.wave, NGW = F.G * NWAVES;
    const int nblk = (N + 63) / 64, per = (K / 64) * nblk, total = per * nb;
    for (int it = gw; it < total; it += NGW) { const int b = it / per, r = it % per, kb = r / nblk, nbk = r % nblk;
        tr_item(W + (size_t)b * sW, ldw, N, ks0 + 64 * kb, 64 * nbk, WT + (size_t)b * sWT, ldt, kd0 + 64 * kb, kind, off, scr, F.lane, q8s, tiled); }
}
__device__ __forceinline__ void zero_block(Frame& F, bf16* WT, int ldt, int r0, int rows, int c0, int cols, int tiled = 0) {
    const int gt = (F.vcu * NWAVES + F.wave) * 64 + F.lane, NT = F.G * NWAVES * 64, cpr = cols / 8;
    for (int i = gt; i < rows * cpr; i += NT) { const int r = i / cpr, c = i % cpr; const unsigned z = (unsigned)F.zv; *(v4u*)(tiled ? WT + toff(r0 + r, c0 + 8 * c, ldt) : WT + (size_t)(r0 + r) * ldt + c0 + 8 * c) = (v4u){z, z, z, z}; }
}
__device__ __forceinline__ void p_convert(Frame& F, int layer) {
    const int j = layer >> 1;
    conv(F, F.in[2] + (size_t)layer * DM * CIN, 0, 1, CIN, CIN, 0, DM, WSP(bf16, WS_WIN), 0, DM, 0, 1, 0);
    zero_block(F, WSP(bf16, WS_WIN), DM, 1932, 116, 0, DM);
    conv(F, F.in[9] + (size_t)layer * 3 * 256 * DM, (size_t)256 * DM, 3, DM, DM, 0, 256, WSP(bf16, WS_WBR), (size_t)DM * 256, 256, 0, 0, 0);
    conv(F, F.in[10] + (size_t)layer * DM * DM, 0, 1, DM, DM, 0, DM, WSP(bf16, WS_WOUT), 0, DM, 0, 0, 0);
    conv(F, F.in[7] + (size_t)layer * 2 * 2048 * 256, (size_t)2048 * 256, 2, 256, 256, 0, 1024, WSP(bf16, WS_WC1), (size_t)512 * 1024, 1024, 0, 0, 0);
    conv(F, F.in[7] + (size_t)layer * 2 * 2048 * 256, (size_t)2048 * 256, 2, 256, 256, 1024, 1024, WSP(bf16, WS_WC1), (size_t)512 * 1024, 1024, 0, 0, 256);
    if ((layer & 1) == 0) {
        conv(F, F.in[12] + (size_t)j * DM * DFF, 0, 1, DFF, DFF, 0, DM, WSP(bf16, WS_WF1), 0, DM, 0, 2, 0, Q8_W1, TILED_FFN1);
        conv(F, F.in[13] + (size_t)j * DM * DFF, 0, 1, DFF, DFF, 0, DM, WSP(bf16, WS_WF1), 0, DM, 0, 2, 128, Q8_W1, TILED_FFN1);
        zero_block(F, WSP(bf16, WS_WF1), DM, 21 * 256 + 64, 64, 0, DM, TILED_FFN1);
        zero_block(F, WSP(bf16, WS_WF1), DM, 21 * 256 + 128 + 64, 64, 0, DM, TILED_FFN1);
        conv(F, F.in[14] + (size_t)j * DFF * DM, 0, 1, DM, DM, 0, DFF, WSP(bf16, WS_WF2), 0, DFFP, 0, 0, 0, Q8_W2);
        zero_block(F, WSP(bf16, WS_WF2), DFFP, 0, DM, DFF, DFFP - DFF);
    } else {
        conv(F, F.in[16] + (size_t)j * NEXP * DM * DFE, (size_t)DM * DFE, NEXP, DFE, DFE, 0, DM, WSP(bf16, WS_WF1), (size_t)NMOE1 * DM, DM, 0, 2, 0, Q8_W1);
        conv(F, F.in[17] + (size_t)j * NEXP * DM * DFE, (size_t)DM * DFE, NEXP, DFE, DFE, 0, DM, WSP(bf16, WS_WF1), (size_t)NMOE1 * DM, DM, 0, 2, 128, Q8_W1);
        conv(F, F.in[18] + (size_t)j * NEXP * DFE * DM, (size_t)DFE * DM, NEXP, DM, DM, 0, DFE, WSP(bf16, WS_WF2), (size_t)DM * DFE, DFE, 0, 0, 0, Q8_W2);
    }
    if (F.bx < 8) {
        __syncthreads();
        const int kv = F.bx >> 2, jj = (F.bx & 3) * 64 + F.lane;
        const float* pos = F.in[6] + (size_t)(layer * 2 + kv) * 2048; const float* w1 = F.in[7] + (size_t)(layer * 2 + kv) * 2048 * 256;
        float a = 0.f;
        float a1 = 0.f, a2 = 0.f, a3 = 0.f;
#pragma unroll 8
        for (int k = 0; k < 256; k += 4) { const int kk = F.wave * 256 + k;
            a += pos[kk] * w1[(size_t)kk * 256 + jj]; a1 += pos[kk + 1] * w1[(size_t)(kk + 1) * 256 + jj]; a2 += pos[kk + 2] * w1[(size_t)(kk + 2) * 256 + jj]; a3 += pos[kk + 3] * w1[(size_t)(kk + 3) * 256 + jj]; }
        a = (a + a1) + (a2 + a3);
        LAS float* red = (LAS float*)(F.lds + RING_OFF);
        red[F.wave * 64 + F.lane] = a;
        __syncthreads();
        if (F.wave == 0) { float s = 0.f;
#pragma unroll
            for (int w = 0; w < 8; ++w) s += red[w * 64 + F.lane];
            WSP(float, WS_BIAS1)[kv * 256 + jj] = s; }
        __syncthreads();
    }
    if (layer == 0) {
        const int gt = (F.vcu * NWAVES + F.wave) * 64 + F.lane, NT = F.G * NWAVES * 64;
        for (int idx = gt; idx < SEQ * 8; idx += NT) { const int pos = idx >> 3, i = idx & 7;
            const double invf = ROPE_INVF[i];
            double rev = (double)pos * invf * 0.15915494309189535; rev -= __builtin_floor(rev);
            WSP(float, WS_ROPE)[idx] = __builtin_amdgcn_cosf((float)rev); WSP(float, WS_ROPE)[SEQ * 8 + idx] = __builtin_amdgcn_sinf((float)rev); }
    }
}

template <int MODE> __device__ __forceinline__ void p_norm(Frame& F, const float* src, const float* g, const float* rw, int jmoe, float q8s = 0.f, int tiled = 0) {
    const int gw = F.vcu * NWAVES + F.wave, NGW = F.G * NWAVES, lane = F.lane;
    LAS int* hist = (LAS int*)(F.lds + TAB_OFF) + 192;
    if (MODE == 1) {
        if (F.tid < 32) hist[F.tid] = 0;
        const int gt = gw * 64 + lane, NT = NGW * 64; int* tm = WSP(int, WS_TOKMAP);
        for (int i = gt; i < 4 * SLOTS; i += NT) tm[i] = -1;
        for (int i = F.tid; i < DM * NEXP / 4; i += NWAVES * 64) *(LAS f32x4*)(F.lds + RING_OFF + 16 * i) = ((const f32x4*)rw)[i];
        __syncthreads();
    }
    f32x4 gv[4];
#pragma unroll
    for (int jx = 0; jx < 4; ++jx) gv[jx] = ((const f32x4*)g)[lane + 64 * jx];
    constexpr int ROWS = (MODE == 1) ? 2 : 4;
    for (int m0 = gw; m0 < MTOK; m0 += ROWS * NGW) {
        f32x4 v[ROWS][4]; float ss[ROWS];
#pragma unroll
        for (int u = 0; u < ROWS; ++u) { const int m = m0 + u * NGW; const f32x4* xr = (const f32x4*)(src + (size_t)(m < MTOK ? m : m0) * DM) + lane;
#pragma unroll
            for (int jx = 0; jx < 4; ++jx) v[u][jx] = xr[64 * jx]; }
#pragma unroll
        for (int u = 0; u < ROWS; ++u) { float s = 0.f;
#pragma unroll
            for (int jx = 0; jx < 4; ++jx) s += (v[u][jx].x * v[u][jx].x + v[u][jx].y * v[u][jx].y) + (v[u][jx].z * v[u][jx].z + v[u][jx].w * v[u][jx].w);
            ss[u] = s; }
#pragma unroll
        for (int o = 1; o < 64; o <<= 1) {
#pragma unroll
            for (int u = 0; u < ROWS; ++u) ss[u] += __builtin_bit_cast(float, __builtin_amdgcn_ds_bpermute((lane ^ o) << 2, __builtin_bit_cast(int, ss[u]))); }
        float lgall[MODE == 1 ? ROWS : 1][8];
        if (MODE == 1) {
            float rs[ROWS];
#pragma unroll
            for (int u = 0; u < ROWS; ++u) { rs[u] = 1.0f / sqrtf(ss[u] * (1.f / DM) + EPS);
#pragma unroll
                for (int e = 0; e < 8; ++e) lgall[u][e] = 0.f; }
#pragma unroll
            for (int jx = 0; jx < 4; ++jx) { const LAS f32x4* wr = (const LAS f32x4*)(F.lds + RING_OFF + (size_t)(4 * lane + 256 * jx) * 32);
#pragma unroll
                for (int r = 0; r < 4; ++r) { const f32x4 a = wr[2 * r], b = wr[2 * r + 1];
#pragma unroll
                    for (int u = 0; u < ROWS; ++u) { const float xv = v[u][jx][r] * rs[u] * gv[jx][r];
                        lgall[u][0] += xv * a.x; lgall[u][1] += xv * a.y; lgall[u][2] += xv * a.z; lgall[u][3] += xv * a.w; lgall[u][4] += xv * b.x; lgall[u][5] += xv * b.y; lgall[u][6] += xv * b.z; lgall[u][7] += xv * b.w; } } }
        }
#pragma unroll
        for (int u = 0; u < ROWS; ++u) { const int m = m0 + u * NGW; if (m >= MTOK) continue;
            const float rstd = 1.0f / sqrtf(ss[u] * (1.f / DM) + EPS);
#pragma unroll
            for (int jx = 0; jx < 4; ++jx) v[u][jx] = v[u][jx] * rstd * gv[jx];
            if (MODE == 2) {
                f32x4* o = (f32x4*)(F.out + (size_t)m * DM) + lane;
#pragma unroll
                for (int jx = 0; jx < 4; ++jx) o[64 * jx] = v[u][jx];
            } else {
                unsigned long long* o8 = (unsigned long long*)(WSP(bf16, WS_HN) + (size_t)m * DM) + lane;
#pragma unroll
                for (int jx = 0; jx < 4; ++jx) { f32x4 w = v[u][jx];
                    if (tiled) { *(unsigned long long*)(WSP(bf16, WS_HN) + toff(m, 4 * lane + 256 * jx, DM)) = (unsigned long long)pk2(w.x, w.y) | ((unsigned long long)pk2(w.z, w.w) << 32); continue; } if (q8s > 0.f) { w.x = q8r(w.x, q8s); w.y = q8r(w.y, q8s); w.z = q8r(w.z, q8s); w.w = q8r(w.w, q8s); }
                    o8[64 * jx] = (unsigned long long)pk2(w.x, w.y) | ((unsigned long long)pk2(w.z, w.w) << 32); }
            }
            if (MODE == 1) {
                float lg[8];
#pragma unroll
                for (int e = 0; e < 8; ++e) lg[e] = lgall[u][e];
                float h4[4], h2[2], h1;
                { const bool up = lane & 1;
#pragma unroll
                  for (int i = 0; i < 4; ++i) { const float keep = up ? lg[4 + i] : lg[i], send = up ? lg[i] : lg[4 + i]; h4[i] = keep + __builtin_bit_cast(float, bperm(lane ^ 1, __builtin_bit_cast(int, send))); } }
                { const bool up = lane & 2;
#pragma unroll
                  for (int i = 0; i < 2; ++i) { const float keep = up ? h4[2 + i] : h4[i], send = up ? h4[i] : h4[2 + i]; h2[i] = keep + __builtin_bit_cast(float, bperm(lane ^ 2, __builtin_bit_cast(int, send))); } }
                { const bool up = lane & 4; const float keep = up ? h2[1] : h2[0], send = up ? h2[0] : h2[1]; h1 = keep + __builtin_bit_cast(float, bperm(lane ^ 4, __builtin_bit_cast(int, send))); }
                h1 += __builtin_bit_cast(float, bperm(lane ^ 8, __builtin_bit_cast(int, h1))); h1 += __builtin_bit_cast(float, bperm(lane ^ 16, __builtin_bit_cast(int, h1))); h1 += __builtin_bit_cast(float, bperm(lane ^ 32, __builtin_bit_cast(int, h1)));
                lg[0] = rdlane(h1, 0); lg[1] = rdlane(h1, 4); lg[2] = rdlane(h1, 2); lg[3] = rdlane(h1, 6); lg[4] = rdlane(h1, 1); lg[5] = rdlane(h1, 5); lg[6] = rdlane(h1, 3); lg[7] = rdlane(h1, 7);
                int e0 = 0; float v0 = lg[0];
#pragma unroll
                for (int e = 1; e < 8; ++e) if (lg[e] > v0) { v0 = lg[e]; e0 = e; }
                int e1 = -1; float v1 = -INFINITY;
#pragma unroll
                for (int e = 0; e < 8; ++e) if (e != e0 && lg[e] > v1) { v1 = lg[e]; e1 = e; }
                const float w0 = 1.0f / (1.0f + fexp(v1 - v0)), w1 = 1.0f - w0;
                if (lane == 0) { WSP(v4i, WS_ROUTE)[m] = (v4i){e0, e1, __builtin_bit_cast(int, w0), __builtin_bit_cast(int, w1)};
                    const int c = m / MC; if (!F.rep) { __hip_atomic_fetch_add(&hist[(c * 2 + 0) * 8 + e0], 1, __ATOMIC_RELAXED, __HIP_MEMORY_SCOPE_WORKGROUP); __hip_atomic_fetch_add(&hist[(c * 2 + 1) * 8 + e1], 1, __ATOMIC_RELAXED, __HIP_MEMORY_SCOPE_WORKGROUP); } }
            }
        }
    }
    if (MODE == 1) {
        __syncthreads();
        if (F.tid < 32) { const int h = hist[F.tid]; if (h) atomicAdd(F.ctl + CW_CNT + jmoe * 32 + F.tid, (unsigned)h); }
    }
}

__device__ __forceinline__ void p_prep(Frame& F) {
    const int gw = F.vcu * NWAVES + F.wave, NGW = F.G * NWAVES, lane = F.lane;
    bf16* P1 = WSP(bf16, WS_P1); bf16* KVC = WSP(bf16, WS_KVC); const float* rope = WSP(float, WS_ROPE);
    const int vec = lane >> 3, ri = lane & 7; const int cb = vec < 4 ? C_CQ + vec * 64 : (vec == 4 ? C_KCMP : (vec == 5 ? C_KSLC : C_KWIN));
    for (int row0 = gw; row0 < MC; row0 += 4 * NGW) {
        float x1[4], x2[4], cc[4], ss[4]; bf16 kc48[4], vc64[4];
#pragma unroll
        for (int k = 0; k < 4; ++k) { const int row = row0 + k * NGW < MC ? row0 + k * NGW : row0; const bf16* p = P1 + (size_t)row * P1W; const int pos = row & (SEQ - 1);
            const int cl = lane < 56 ? cb + ri : C_CQ;
            x1[k] = bf1(p[cl]); x2[k] = bf1(p[cl + 8]); cc[k] = rope[pos * 8 + ri]; ss[k] = rope[SEQ * 8 + pos * 8 + ri];
            if (F.rep) { cc[k] = 1.f; ss[k] = 0.f; }
            kc48[k] = p[C_KCMP + 16 + (lane < 48 ? lane : 0)]; vc64[k] = p[C_VCMP + lane]; }
#pragma unroll
        for (int k = 0; k < 4; ++k) { const int row = row0 + k * NGW; if (row >= MC) continue; bf16* p = P1 + (size_t)row * P1W;
            if (lane < 56) { const bf16 o1 = (bf16)f2bf(x1[k] * cc[k] - x2[k] * ss[k]), o2 = (bf16)f2bf(x2[k] * cc[k] + x1[k] * ss[k]);
                p[cb + ri] = o1; p[cb + ri + 8] = o2;
                if (vec == 4) { KVC[(size_t)row * 64 + ri] = o1; KVC[(size_t)row * 64 + ri + 8] = o2; } }
            if (lane < 48) KVC[(size_t)row * 64 + 16 + lane] = kc48[k];
            KVC[(size_t)MC * 64 + (size_t)row * 64 + lane] = vc64[k]; }
    }
    bf16* VT = WSP(bf16, WS_VT);
    for (int it = gw; it < 6 * BC * 64; it += NGW) { const int which = it / (BC * 64), r = it % (BC * 64), b = r >> 6, blk = r & 63;
        const v4u* src = (const v4u*)(P1 + ((size_t)b * SEQ + blk * 64 + lane) * P1W + (which == 0 ? C_VSLC : (which == 1 ? C_VWIN : C_SBV + (which - 2) * 64)));
        bf16* dst = VT + ((size_t)(which * BC + b) * 64) * SEQ + blk * 64 + lane;
        v4u xs[8];
#pragma unroll
        for (int i = 0; i < 8; ++i) xs[i] = src[i];
#pragma unroll
        for (int i = 0; i < 8; ++i) { const v4u x = xs[i];
            dst[(size_t)(8 * i + 0) * SEQ] = (bf16)(x.x & 0xffffu); dst[(size_t)(8 * i + 1) * SEQ] = (bf16)(x.x >> 16);
            dst[(size_t)(8 * i + 2) * SEQ] = (bf16)(x.y & 0xffffu); dst[(size_t)(8 * i + 3) * SEQ] = (bf16)(x.y >> 16);
            dst[(size_t)(8 * i + 4) * SEQ] = (bf16)(x.z & 0xffffu); dst[(size_t)(8 * i + 5) * SEQ] = (bf16)(x.z >> 16);
            dst[(size_t)(8 * i + 6) * SEQ] = (bf16)(x.w & 0xffffu); dst[(size_t)(8 * i + 7) * SEQ] = (bf16)(x.w >> 16); }
    }
}
__device__ __forceinline__ void p_sgu(Frame& F, int layer) {
    LAS float* vn = (LAS float*)(F.lds + RING_OFF);
    const bf16* P1 = WSP(bf16, WS_P1); bf16* Ya = WSP(bf16, WS_Y);
    const float* gain = F.in[3] + (size_t)layer * 256; const float* sw = F.in[4] + (size_t)layer * 4 * 128 * 128; const float* sb = F.in[5] + (size_t)layer * 4 * 128;
    const int lane = F.lane, wave = F.wave;
    for (int item = F.vcu; item < MC / 128; item += F.G) {
        const size_t r0 = (size_t)item * 128;
        __syncthreads();
        for (int rr = 0; rr < 16; ++rr) { const int r = wave * 16 + rr; const v2u raw = *(const v2u*)(P1 + (r0 + r) * P1W + C_V + 4 * lane);
            const float a = bflo(raw.x), b = bfhi(raw.x), c = bflo(raw.y), d = bfhi(raw.y);
            const float rstd = 1.0f / sqrtf(wave_sum((a * a + b * b) + (c * c + d * d), lane) * (1.f / 256.f) + EPS);
            const f32x4 gg = ((const f32x4*)gain)[lane];
            *(LAS f32x4*)(vn + r * 256 + 4 * lane) = (f32x4){a * rstd * gg.x, b * rstd * gg.y, c * rstd * gg.z, d * rstd * gg.w}; }
        __syncthreads();
        const int g = wave & 3, half = wave >> 2;
        for (int i = 0; i < 64; ++i) { const int t = 2 * i + half;
            const float* wrow = sw + ((size_t)g * 128 + t) * 128;
            const float w_lo = wrow[lane], w_hi = wrow[64 + lane];
            float acc = 0.f;
            for (int s = 0; s <= t; ++s) { const float w = (s < 64) ? rdlane(w_lo, s) : rdlane(w_hi, s - 64); acc += w * vn[s * 256 + g * 64 + lane]; }
            const float u = bf1(P1[(r0 + t) * P1W + C_U + g * 64 + lane]);
#ifdef ABL_SGUMIX
            acc = 0.f;
#endif
            Ya[(r0 + t) * 256 + g * 64 + lane] = (bf16)f2bf(u * (acc + sb[g * 128 + t])); }
    }
    __syncthreads();
}

__device__ __forceinline__ void p_cmpfin(Frame& F, int layer) {
    const int gw = F.vcu * NWAVES + F.wave, NGW = F.G * NWAVES, lane = F.lane;
    const float* UL = WSP(float, WS_UL); const float* bias = WSP(float, WS_BIAS1); bf16* KC = WSP(bf16, WS_KC);
    LAS float* w2l = (LAS float*)(F.lds + RING_OFF);
    __syncthreads();
    { const f32x4* src = (const f32x4*)(F.in[8] + (size_t)layer * 2 * 256 * 64);
#pragma unroll 4
      for (int i = F.tid; i < 2 * 256 * 64 / 4; i += NWAVES * 64) *(LAS f32x4*)(w2l + 4 * i) = src[i]; }
    __syncthreads();
    for (int it = gw; it < 2 * BC * 255; it += NGW) { const int kv = it / (BC * 255), r = it % (BC * 255), b = r / 255, m = r % 255;
        const LAS float* w2 = w2l + kv * 256 * 64;
        const float* U = UL + (size_t)(kv * 2048 + b * 256 + m) * 512; const float* L = U + 512 + 256;
        float hv[4];
#pragma unroll
        for (int q = 0; q < 4; ++q) hv[q] = pg8::gelu_tanh(U[64 * q + lane] + L[64 * q + lane] + bias[kv * 256 + 64 * q + lane]);
        float acc0 = 0.f, acc1 = 0.f;
#pragma unroll
        for (int q = 0; q < 4; ++q)
#pragma unroll 8
            for (int jj = 0; jj < 64; jj += 2) { acc0 += rdlane(hv[q], jj) * w2[(64 * q + jj) * 64 + lane]; acc1 += rdlane(hv[q], jj + 1) * w2[(64 * q + jj + 1) * 64 + lane]; }
        const float acc = acc0 + acc1;
        KC[((size_t)(kv * BC + b) * 256 + m) * 64 + lane] = (bf16)f2bf(acc);
        if (kv == 1) { WSP(bf16, WS_KCT)[((size_t)b * 64 + lane) * 256 + m] = (bf16)f2bf(acc); if (m == 254) WSP(bf16, WS_KCT)[((size_t)b * 64 + lane) * 256 + 255] = (bf16)0; }
        else if (m == 254) KC[((size_t)b * 256 + 255) * 64 + lane] = (bf16)0; }
    __syncthreads();
}

__device__ __forceinline__ void p_stick(Frame& F) {
    const int gw = F.vcu * NWAVES + F.wave, NGW = F.G * NWAVES, lane = F.lane;
    const bf16* P1 = WSP(bf16, WS_P1); bf16* Yb = WSP(bf16, WS_Y) + (size_t)MC * 256;
    for (int item = gw; item < BC * 4 * 64; item += NGW) { const int tb = item & 63, h = (item >> 6) & 3, b = item >> 8;
        const int t = tb * 64 + lane; const size_t row = (size_t)b * SEQ + t;
        unsigned q[32];
        { const v4u* qp = (const v4u*)(P1 + row * P1W + C_SBQ + h * 64);
#pragma unroll
          for (int i = 0; i < 8; ++i) { const v4u x = qp[i]; q[4 * i] = x.x; q[4 * i + 1] = x.y; q[4 * i + 2] = x.z; q[4 * i + 3] = x.w; } }
        float o[64];
#pragma unroll
        for (int d = 0; d < 64; ++d) o[d] = 0.f;
        float R = 0.f;
        const bf16* kb = P1 + (size_t)b * SEQ * P1W + C_SBK + h * 64; const bf16* vb = P1 + (size_t)b * SEQ * P1W + C_SBV + h * 64;
        for (int s = t - 1; s >= 0; --s) {
            if (R < -100.f) break;
            const v4u* kp = (const v4u*)(kb + (size_t)s * P1W); const v4u* vp = (const v4u*)(vb + (size_t)s * P1W);
            float z0 = 0.f, z1 = 0.f;
#pragma unroll
            for (int i = 0; i < 8; ++i) { const v4u k = kp[i]; z0 = dot2bf(k.x, q[4 * i], z0); z1 = dot2bf(k.y, q[4 * i + 1], z1); z0 = dot2bf(k.z, q[4 * i + 2], z0); z1 = dot2bf(k.w, q[4 * i + 3], z1); }
            const float z = (z0 + z1) * 0.125f;
            const float tt = 0.6931471805599453f * __builtin_amdgcn_logf(1.0f + fexp(-__builtin_fabsf(z)));
            const float lb = fminf(z, 0.f) - tt, l1m = fminf(-z, 0.f) - tt;
            const float a = fexp(lb + R); R += l1m;
#pragma unroll
            for (int i = 0; i < 8; ++i) { const v4u v = vp[i];
                o[8 * i] += a * bflo(v.x); o[8 * i + 1] += a * bfhi(v.x); o[8 * i + 2] += a * bflo(v.y); o[8 * i + 3] += a * bfhi(v.y);
                o[8 * i + 4] += a * bflo(v.z); o[8 * i + 5] += a * bfhi(v.z); o[8 * i + 6] += a * bflo(v.w); o[8 * i + 7] += a * bfhi(v.w); }
        }
        v4u* op = (v4u*)(Yb + row * 256 + h * 64);
#pragma unroll
        for (int i = 0; i < 8; ++i) op[i] = (v4u){pk2(o[8 * i], o[8 * i + 1]), pk2(o[8 * i + 2], o[8 * i + 3]), pk2(o[8 * i + 4], o[8 * i + 5]), pk2(o[8 * i + 6], o[8 * i + 7])};
    }
}

struct Soft { float mx, l; };
__device__ __forceinline__ float dotq(const LAS v4u* ql, const bf16* kp_) {
    const v4u* kp = (const v4u*)kp_; float z0 = 0.f, z1 = 0.f;
#pragma unroll
    for (int i = 0; i < 8; ++i) { const v4u k = kp[i]; const v4u q = ql[i]; z0 = dot2bf(k.x, q.x, z0); z1 = dot2bf(k.y, q.y, z1); z0 = dot2bf(k.z, q.z, z0); z1 = dot2bf(k.w, q.w, z1); }
    return (z0 + z1) * 0.125f;
}
__device__ __forceinline__ void axpy_row(float p, const bf16* vp_, float (&o)[64]) {
    const v4u* vp = (const v4u*)vp_;
#pragma unroll
    for (int i = 0; i < 8; ++i) { const v4u v = vp[i];
        o[8 * i] += p * bflo(v.x); o[8 * i + 1] += p * bfhi(v.x); o[8 * i + 2] += p * bflo(v.y); o[8 * i + 3] += p * bfhi(v.y);
        o[8 * i + 4] += p * bflo(v.z); o[8 * i + 5] += p * bfhi(v.z); o[8 * i + 6] += p * bflo(v.w); o[8 * i + 7] += p * bfhi(v.w); }
}
__device__ __forceinline__ void nsa_step(const LAS v4u* ql, const bf16* kp_, const bf16* vp_, Soft& S, float (&o)[64]) {
    const float s = dotq(ql, kp_);
    if (s > S.mx) { const float sc = fexp(S.mx - s); S.l *= sc;
#pragma unroll
        for (int d = 0; d < 64; ++d) o[d] *= sc;
        S.mx = s; }
    const float p = fexp(s - S.mx); S.l += p;
    asm volatile("" ::: "memory");
    axpy_row(p, vp_, o);
}
__device__ __forceinline__ void nsa_accum(bf16* yrow, bool first, float sc, const float (&o)[64]) {
    v4u* op = (v4u*)yrow;
#pragma unroll
    for (int i = 0; i < 8; ++i) { v4u old = (v4u){0u, 0u, 0u, 0u}; if (!first) old = op[i];
        op[i] = (v4u){pk2(bflo(old.x) + sc * o[8 * i], bfhi(old.x) + sc * o[8 * i + 1]), pk2(bflo(old.y) + sc * o[8 * i + 2], bfhi(old.y) + sc * o[8 * i + 3]),
                      pk2(bflo(old.z) + sc * o[8 * i + 4], bfhi(old.z) + sc * o[8 * i + 5]), pk2(bflo(old.w) + sc * o[8 * i + 6], bfhi(old.w) + sc * o[8 * i + 7])}; }
}
__device__ __forceinline__ void p_nsa(Frame& F) {
    const int gw = F.vcu * NWAVES + F.wave, NGW = F.G * NWAVES, lane = F.lane;
    const bf16* P1 = WSP(bf16, WS_P1); const bf16* KC = WSP(bf16, WS_KC); bf16* Yc = WSP(bf16, WS_Y) + (size_t)2 * MC * 256;
    LAS float* imp = (LAS float*)(F.lds + RING_OFF + F.wave * 4096);
    LAS v4u* ql = (LAS v4u*)(F.lds + RING_OFF + 32768 + F.wave * 9216 + lane * 144);
    const int qi = lane >> 2, h = lane & 3;
    for (int item = gw; item < BC * 256; item += NGW) { const int b = item >> 8, tg = item & 255;
        const int t = tg * 16 + qi; const size_t row = (size_t)b * SEQ + t; const bf16* prow = P1 + row * P1W;
        { const v4u* qp = (const v4u*)(prow + C_CQ + h * 64);
#pragma unroll
          for (int i = 0; i < 8; ++i) ql[i] = qp[i]; }
        const float g0 = bf1(prow[C_CG + h * 3]), g1 = bf1(prow[C_CG + h * 3 + 1]), g2 = bf1(prow[C_CG + h * 3 + 2]);
        bf16* yrow = Yc + row * 256 + h * 64;
        float o[64];
        for (int i = lane; i < 1024; i += 64) imp[i] = 0.f;
        const int nv = t >= 31 ? ((t - 31) >> 4) + 1 : 0; const int nvmax = (tg * 16 + 15 >= 31) ? ((tg * 16 + 15 - 31) >> 4) + 1 : 0;
        const bf16* kc = KC + (size_t)(0 * BC + b) * 256 * 64; const bf16* vc = KC + (size_t)(1 * BC + b) * 256 * 64;
        { float mx = -INFINITY, l = 0.f;
          for (int m = 0; m < nvmax; ++m) { const float s = dotq(ql, kc + m * 64); if (m < nv) { if (s > mx) { l *= fexp(mx - s); mx = s; } l += fexp(s - mx); } }
          const float rl = l > 0.f ? 1.0f / l : 0.f;
#pragma unroll
          for (int d = 0; d < 64; ++d) o[d] = 0.f;
          for (int m = 0; m < nvmax; ++m) { const float s = dotq(ql, kc + m * 64); const float p = (m < nv) ? fexp(s - mx) * rl : 0.f;
              asm volatile("" ::: "memory");
              axpy_row(p, vc + m * 64, o);
              float P = p + __builtin_bit_cast(float, bperm(lane ^ 1, __builtin_bit_cast(int, p))); P += __builtin_bit_cast(float, bperm(lane ^ 2, __builtin_bit_cast(int, P)));
              if (h == 0) { const int j0 = m >> 2; const bool edge = (m & 3) == 3; imp[qi * 64 + j0] += edge ? 0.5f * P : P; if (edge) imp[qi * 64 + j0 + 1] += 0.5f * P; } }
          nsa_accum(yrow, true, g0, o); }
        unsigned long long mask = 0ull;
        { const int cur = t >> 6, nvb = cur + 1;
          if (h == 0) {
              if (nvb <= 16) mask = (1ull << nvb) - 1ull;
              else { mask = 1ull | (1ull << cur);
                  for (int r = 0; r < 14; ++r) { int best = -1; float bv = -1.f;
                      for (int j = 1; j < cur; ++j) { const float v = imp[qi * 64 + j]; if (!((mask >> j) & 1ull) && v > bv) { bv = v; best = j; } }
                      mask |= 1ull << best; } } }
          const unsigned mlo = (unsigned)bperm(lane & ~3, (int)(unsigned)mask), mhi = (unsigned)bperm(lane & ~3, (int)(unsigned)(mask >> 32));
          mask = ((unsigned long long)mhi << 32) | mlo; }
        { Soft S{-INFINITY, 0.f};
#pragma unroll
          for (int d = 0; d < 64; ++d) o[d] = 0.f;
          const bf16* kb = P1 + (size_t)b * SEQ * P1W + C_KSLC; const bf16* vb = P1 + (size_t)b * SEQ * P1W + C_VSLC;
          unsigned long long mm = mask;
          while (mm) { const int j = __builtin_ctzll(mm); mm &= mm - 1ull;
              for (int kk = 0; kk < 64; ++kk) { const int sp = j * 64 + kk; if (sp > t) break; nsa_step(ql, kb + (size_t)sp * P1W, vb + (size_t)sp * P1W, S, o); } }
          nsa_accum(yrow, false, g1 / S.l, o); }
        { Soft S{-INFINITY, 0.f};
#pragma unroll
          for (int d = 0; d < 64; ++d) o[d] = 0.f;
          const bf16* kb = P1 + (size_t)b * SEQ * P1W + C_KWIN; const bf16* vb = P1 + (size_t)b * SEQ * P1W + C_VWIN;
          for (int i = 0; i < 512; ++i) { const int sp = t - 511 + i; if (sp >= 0) nsa_step(ql, kb + (size_t)sp * P1W, vb + (size_t)sp * P1W, S, o); }
          nsa_accum(yrow, false, g2 / S.l, o); }
    }
}

__device__ __forceinline__ int moe_table(Frame& F, int jmoe, int c, int r) {
    LAS int* tab = (LAS int*)(F.lds + TAB_OFF);
    __syncthreads();
    if (F.tid < 8) tab[176 + F.tid] = (int)__hip_atomic_load(F.ctl + CW_CNT + jmoe * 32 + (c * 2 + r) * 8 + F.tid, __ATOMIC_RELAXED, __HIP_MEMORY_SCOPE_AGENT);
    __syncthreads();
    if (F.tid == 0) { int base = 0, T = 0;
        for (int e = 0; e < 8; ++e) { const int cnt = tab[176 + e];
            const int nt = (cnt + 255) >> 8; tab[160 + e] = base; for (int i = 0; i < nt && T + i < 160; ++i) tab[T + i] = e; T += nt; base += nt * 256; }
        tab[168] = T < 136 ? T : 136; }
    __syncthreads();
    return tab[168];
}
__device__ __forceinline__ void p_gather(Frame& F, int jmoe, int c, int r, int nbusy = 0) {
    if (F.bx < nbusy) return;
    moe_table(F, jmoe, c, r);
    LAS int* tab = (LAS int*)(F.lds + TAB_OFF); LAS int* cntw = tab + 256; LAS int* basew = tab + 320;
    const int lane = F.lane, wave = F.wave;
    const v4i* route = WSP(v4i, WS_ROUTE); int* tokmap = WSP(int, WS_TOKMAP) + (c * 2 + r) * SLOTS; float* wslot = WSP(float, WS_WSLOT) + (c * 2 + r) * SLOTS;
    const bf16* HN = WSP(bf16, WS_HN); bf16* XG = WSP(bf16, WS_XG);
    unsigned* cur = F.ctl + CW_CUR + jmoe * 32 + (c * 2 + r) * 8;
    for (int ch = F.bx - nbusy; ch < MC / 128; ch += F.G - nbusy) {
        const int m = c * MC + ch * 128 + wave * 16 + (lane & 15); const v4i rt = route[m];
        const int e = lane < 16 ? (r ? rt.y : rt.x) : -1; const float w = __builtin_bit_cast(float, r ? rt.w : rt.z);
        unsigned long long bal[8]; int mycnt = 0;
#pragma unroll
        for (int ee = 0; ee < 8; ++ee) { bal[ee] = __builtin_amdgcn_ballot_w64(e == ee); if (lane == ee) mycnt = __builtin_popcountll(bal[ee]); }
        __syncthreads();
        if (lane < 8) cntw[wave * 8 + lane] = mycnt;
        __syncthreads();
        if (wave == 0 && lane < 8) { int tot = 0;
#pragma unroll
            for (int w8 = 0; w8 < 8; ++w8) tot += cntw[w8 * 8 + lane];
            int base = tot > 0 ? (int)atomicAdd(cur + lane, (unsigned)tot) : 0;
#pragma unroll
            for (int w8 = 0; w8 < 8; ++w8) { basew[w8 * 8 + lane] = base; base += cntw[w8 * 8 + lane]; } }
        __syncthreads();
        int pos = 0;
#pragma unroll
        for (int ee = 0; ee < 8; ++ee) if (e == ee) pos = basew[wave * 8 + ee] + __builtin_popcountll(bal[ee] & ((1ull << lane) - 1ull));
        int slot = 0;
        if (lane < 16) { slot = tab[160 + e] + pos; tokmap[slot] = m; wslot[slot] = w; }
#pragma unroll
        for (int i0 = 0; i0 < 16; i0 += 4) { v4u x[8];
#pragma unroll
            for (int i = 0; i < 4; ++i) { const int mi = __builtin_amdgcn_readlane(m, i0 + i); const v4u* src = (const v4u*)(HN + (size_t)mi * DM); x[2 * i] = src[lane]; x[2 * i + 1] = src[64 + lane]; }
#pragma unroll
            for (int i = 0; i < 4; ++i) { const int si = __builtin_amdgcn_readlane(slot, i0 + i); v4u* dst = (v4u*)(XG + (size_t)si * DM); dst[lane] = x[2 * i]; dst[64 + lane] = x[2 * i + 1]; } }
    }
}

typedef float f32x16 __attribute__((ext_vector_type(16)));
typedef short bf16x8v __attribute__((ext_vector_type(8)));
typedef float f32x2v __attribute__((ext_vector_type(2)));
constexpr int NSA_K = 0, NSA_V = 8192, NSA_BUF = 17408, NSA_STAGE = 2 * NSA_BUF, NSA_IMP = 69632, NSA_CARRY = 86016, NSA_SEL = 103424, NSA_WSF = 103936;
constexpr int NSA_VP = 136;
constexpr float NSA_C2 = 0.125f * 1.4426950408889634f;
constexpr float NSA_DEFER = 8.0f / (0.125f * 1.4426950408889634f);
__device__ __forceinline__ unsigned cvtpk(float lo, float hi) { f32x2v v = {lo, hi}; bf16x2_t b = __builtin_convertvector(v, bf16x2_t); return __builtin_bit_cast(unsigned, b); }
__device__ __forceinline__ float partner32(float v, int lane) { return __builtin_bit_cast(float, __builtin_amdgcn_ds_bpermute((lane ^ 32) << 2, __builtin_bit_cast(int, v))); }
__device__ __forceinline__ void nsa_load(v4u& kx, v4u& vx, const bf16* Kg, int kp, const bf16* Vg, int vp, int tid) {
    kx = *(const v4u*)(Kg + (size_t)(tid & 63) * kp + (tid >> 6) * 8); vx = *(const v4u*)(Vg + (size_t)(tid >> 3) * vp + (tid & 7) * 8);
}
__device__ __forceinline__ void nsa_store(LAS unsigned char* lds, const v4u& kx, const v4u& vx, int tid) {
    *(LAS v4u*)(lds + NSA_K + (tid >> 6) * 1024 + (tid & 63) * 16) = kx; { LAS v2u* vd = (LAS v2u*)(lds + NSA_V + (tid >> 3) * NSA_VP + (tid & 7) * 16); vd[0] = (v2u){vx.x, vx.y}; vd[1] = (v2u){vx.z, vx.w}; }
}
__device__ __forceinline__ void nsa_qk(const LAS unsigned char* lds, const bf16x8v (&qr)[4], f32x16& p0, f32x16& p1, int r32, int hi) {
#pragma unroll
    for (int i = 0; i < 16; ++i) { p0[i] = 0.f; p1[i] = 0.f; }
#pragma unroll
    for (int d0 = 0; d0 < 4; ++d0) {
        const bf16x8v k0 = *(const LAS bf16x8v*)(lds + NSA_K + (2 * d0 + hi) * 1024 + r32 * 16);
        const bf16x8v k1 = *(const LAS bf16x8v*)(lds + NSA_K + (2 * d0 + hi) * 1024 + 512 + r32 * 16);
        p0 = __builtin_amdgcn_mfma_f32_32x32x16_bf16(k0, qr[d0], p0, 0, 0, 0);
        p1 = __builtin_amdgcn_mfma_f32_32x32x16_bf16(k1, qr[d0], p1, 0, 0, 0);
    }
}
__device__ __forceinline__ void nsa_mask(f32x16& p0, f32x16& p1, int hi, int hiL, int loL) {
#pragma unroll
    for (int i = 0; i < 16; ++i) { const int kk = (i & 3) + 8 * (i >> 2) + 4 * hi;
        if (!(kk <= hiL && kk > loL)) p0[i] = -INFINITY;
        if (!(kk + 32 <= hiL && kk + 32 > loL)) p1[i] = -INFINITY; }
}
__device__ __forceinline__ float nsa_max32(const f32x16& p0, const f32x16& p1) {
    float a = fmaxf(fmaxf(p0[0], p0[1]), p1[0]), b = fmaxf(fmaxf(p0[2], p0[3]), p1[1]); a = fmaxf(fmaxf(a, p1[2]), p1[3]);
#pragma unroll
    for (int i = 4; i < 16; i += 4) { a = fmaxf(fmaxf(a, p0[i]), p0[i + 1]); b = fmaxf(fmaxf(b, p0[i + 2]), p0[i + 3]); a = fmaxf(fmaxf(a, p1[i]), p1[i + 1]); b = fmaxf(fmaxf(b, p1[i + 2]), p1[i + 3]); }
    return fmaxf(a, b);
}
__device__ __forceinline__ void nsa_pv(const LAS unsigned char* lds, const f32x16& p0, const f32x16& p1, f32x16 (&o)[2], int r32, int hi) {
    bf16x8v pa[4];
#pragma unroll
    for (int s = 0; s < 2; ++s) {
        const v4u a = (v4u){cvtpk(p0[8 * s], p0[8 * s + 1]), cvtpk(p0[8 * s + 2], p0[8 * s + 3]), cvtpk(p0[8 * s + 4], p0[8 * s + 5]), cvtpk(p0[8 * s + 6], p0[8 * s + 7])};
        const v4u b = (v4u){cvtpk(p1[8 * s], p1[8 * s + 1]), cvtpk(p1[8 * s + 2], p1[8 * s + 3]), cvtpk(p1[8 * s + 4], p1[8 * s + 5]), cvtpk(p1[8 * s + 6], p1[8 * s + 7])};
        pa[s] = __builtin_bit_cast(bf16x8v, a); pa[2 + s] = __builtin_bit_cast(bf16x8v, b); }
#pragma unroll
    for (int db = 0; db < 2; ++db) { const LAS unsigned char* vrow = lds + NSA_V + (32 * db + r32) * NSA_VP;
#pragma unroll
        for (int ks = 0; ks < 4; ++ks) {
            const int kb = (ks >> 1) * 32 + (ks & 1) * 16 + 4 * hi;
            const v2u lo = *(const LAS v2u*)(vrow + kb * 2), hh = *(const LAS v2u*)(vrow + (kb + 8) * 2);
            const v4u vv = (v4u){lo.x, lo.y, hh.x, hh.y};
            o[db] = __builtin_amdgcn_mfma_f32_32x32x16_bf16(pa[ks], __builtin_bit_cast(bf16x8v, vv), o[db], 0, 0, 0); } }
}
__device__ __forceinline__ void nsa_rowscale(f32x16 (&o)[2], LAS float* wsf, float f, int r32, int hi) {
    if (hi == 0) wsf[r32] = f;
#pragma unroll
    for (int g = 0; g < 4; ++g) { const f32x4 w = *(const LAS f32x4*)(wsf + 8 * g + 4 * hi);
#pragma unroll
        for (int e = 0; e < 4; ++e) { o[0][4 * g + e] *= w[e]; o[1][4 * g + e] *= w[e]; } }
}
constexpr int NSA_ACC = 104960;
__device__ __forceinline__ void nsa_rowaccum(LAS unsigned char* acc, bool first, const f32x16 (&o)[2], LAS float* wsf, float f, int r32, int hi) {
    if (hi == 0) wsf[r32] = f;
#pragma unroll
    for (int g = 0; g < 4; ++g) { const f32x4 w = *(const LAS f32x4*)(wsf + 8 * g + 4 * hi);
#pragma unroll
        for (int e = 0; e < 4; ++e) { LAS bf16* p = (LAS bf16*)(acc + (8 * g + 4 * hi + e) * 128 + r32 * 2); const int i = 4 * g + e;
            float a = o[0][i] * w[e], b = o[1][i] * w[e];
            if (!first) { a += bf1(p[0]); b += bf1(p[32]); }
            p[0] = (bf16)f2bf(a); p[32] = (bf16)f2bf(b); } }
}
__device__ __forceinline__ void nsa_flush(const LAS unsigned char* acc, bf16* ytok  , int lane) {
    asm volatile("" ::: "memory");
#pragma unroll
    for (int ps = 0; ps < 4; ++ps) { const int row = ps * 8 + (lane >> 3), ch = lane & 7;
        const v4u v = *(const LAS v4u*)(acc + row * 128 + ch * 16);
        *(v4u*)(ytok + (size_t)(row >> 2) * 256 + (row & 3) * 64 + ch * 8) = v; }
}
__device__ __forceinline__ void nsa_softmax_pv(const LAS unsigned char* lds, f32x16& p0, f32x16& p1, float& m, float& l, f32x16 (&o)[2], LAS float* wsf, int lane, int r32, int hi, bool rowok) {
    float mt = nsa_max32(p0, p1); mt = rowok ? mt : -INFINITY; mt = fmaxf(mt, partner32(mt, lane));
    const float mn = fmaxf(m, mt);
    if (__builtin_amdgcn_ballot_w64(mn > m + NSA_DEFER) != 0ull) { const float f = __builtin_amdgcn_exp2f((m - mn) * NSA_C2); l *= f; nsa_rowscale(o, wsf, f, r32, hi); m = mn; }
    const float off = rowok ? -m * NSA_C2 : -INFINITY;
    float s = 0.f;
#pragma unroll
    for (int i = 0; i < 16; ++i) { p0[i] = __builtin_amdgcn_exp2f(__builtin_fmaf(p0[i], NSA_C2, off)); p1[i] = __builtin_amdgcn_exp2f(__builtin_fmaf(p1[i], NSA_C2, off)); s += p0[i] + p1[i]; }
    l += s;
    nsa_pv(lds, p0, p1, o, r32, hi);
}
__device__ __forceinline__ void p_nsa2(Frame& F) {
    const int tid = F.tid, lane = F.lane, wave = F.wave, r32 = lane & 31, hi = lane >> 5;
    LAS unsigned char* lds = F.lds + RING_OFF;
    LAS float* imp = (LAS float*)(lds + NSA_IMP); LAS float* carry = (LAS float*)(lds + NSA_CARRY);
    LAS unsigned long long* selm = (LAS unsigned long long*)(lds + NSA_SEL); LAS float* wsf = (LAS float*)(lds + NSA_WSF) + wave * 32;
    LAS unsigned char* acc = wave < 6 ? lds + NSA_ACC + wave * 4096 : F.lds + LDSCTL_OFF + 4096 + (wave - 6) * 4096;
    const bf16* P1 = WSP(bf16, WS_P1); const bf16* KC = WSP(bf16, WS_KC); const bf16* KCT = WSP(bf16, WS_KCT); const bf16* VT = WSP(bf16, WS_VT);
    bf16* Yc = WSP(bf16, WS_Y) + (size_t)2 * MC * 256;
    const int ql = r32 >> 2, h = r32 & 3, tq = 8 * wave + ql;
    int par = 0;
    for (int it = 0; it < 2; ++it) {
        for (int pair = F.vcu; pair < BC * 32; pair += F.G) {
            const int b = pair >> 5, sx = pair & 31, qb = it ? 63 - sx : sx;
            const int t = qb * 64 + tq; const size_t row = (size_t)b * SEQ + t; const bf16* prow = P1 + row * P1W;
            bf16x8v qr[4];
#pragma unroll
            for (int d0 = 0; d0 < 4; ++d0) qr[d0] = *(const bf16x8v*)(prow + C_CQ + h * 64 + d0 * 16 + hi * 8);
            const float g0 = bf1(prow[C_CG + h * 3]), g1 = bf1(prow[C_CG + h * 3 + 1]), g2 = bf1(prow[C_CG + h * 3 + 2]);
            f32x16 o[2], p0, p1;
            __syncthreads();
            for (int i = tid; i < 64 * 64; i += 512) imp[i] = 0.f;
            for (int i = tid; i < 64 * 68; i += 512) carry[i] = 0.f;
            const int nct = (4 * qb + 3 + 63) >> 6;
            const int mlim = t >= 31 ? ((t - 31) >> 4) : -1;
            const bf16* kcb = KC + (size_t)b * 256 * 64; const bf16* vcb = KCT + (size_t)b * 64 * 256;
            float m = -1e30f, l = 0.f;
            v4u kx, vx;
            nsa_load(kx, vx, kcb, 64, vcb, 256, tid);
            for (int ti = 0; ti < nct; ++ti) {
                LAS unsigned char* tb = lds + par * NSA_STAGE; par ^= 1;
                nsa_store(tb, kx, vx, tid); __syncthreads();
                { const int tn = ti + 1 < nct ? ti + 1 : 0; nsa_load(kx, vx, kcb + (size_t)tn * 64 * 64, 64, vcb + tn * 64, 256, tid); }
                nsa_qk(tb, qr, p0, p1, r32, hi); nsa_mask(p0, p1, hi, mlim - 64 * ti, -1);
                float mt = nsa_max32(p0, p1); mt = fmaxf(mt, partner32(mt, lane));
                const float mn = fmaxf(m, mt); l *= __builtin_amdgcn_exp2f((m - mn) * NSA_C2); m = mn;
                const float off = -m * NSA_C2; float s = 0.f;
#pragma unroll
                for (int i = 0; i < 16; ++i) s += __builtin_amdgcn_exp2f(__builtin_fmaf(p0[i], NSA_C2, off)) + __builtin_amdgcn_exp2f(__builtin_fmaf(p1[i], NSA_C2, off));
                l += s; }
            { const float lt = l + partner32(l, lane); const float rl = lt > 0.f ? 1.0f / lt : 0.f;
#pragma unroll
              for (int i = 0; i < 16; ++i) { o[0][i] = 0.f; o[1][i] = 0.f; }
              for (int ti = 0; ti < nct; ++ti) {
                  LAS unsigned char* tb = lds + par * NSA_STAGE; par ^= 1;
                  nsa_store(tb, kx, vx, tid); __syncthreads();
                  if (ti + 1 < nct) nsa_load(kx, vx, kcb + (size_t)(ti + 1) * 64 * 64, 64, vcb + (ti + 1) * 64, 256, tid);
                  nsa_qk(tb, qr, p0, p1, r32, hi); nsa_mask(p0, p1, hi, mlim - 64 * ti, -1);
                  { const float off = -m * NSA_C2;
#pragma unroll
                    for (int i = 0; i < 16; ++i) { p0[i] = __builtin_amdgcn_exp2f(__builtin_fmaf(p0[i], NSA_C2, off)) * rl; p1[i] = __builtin_amdgcn_exp2f(__builtin_fmaf(p1[i], NSA_C2, off)) * rl; } }
#pragma unroll
                  for (int kt = 0; kt < 2; ++kt)
#pragma unroll
                      for (int g = 0; g < 4; ++g) { const f32x16& pp = kt ? p1 : p0;
                          float A = pp[4 * g] + pp[4 * g + 1] + pp[4 * g + 2] + 0.5f * pp[4 * g + 3], B = 0.5f * pp[4 * g + 3];
                          A += __builtin_bit_cast(float, bperm(lane ^ 1, __builtin_bit_cast(int, A))); A += __builtin_bit_cast(float, bperm(lane ^ 2, __builtin_bit_cast(int, A)));
                          B += __builtin_bit_cast(float, bperm(lane ^ 1, __builtin_bit_cast(int, B))); B += __builtin_bit_cast(float, bperm(lane ^ 2, __builtin_bit_cast(int, B)));
                          if (h == 0) { const int j = 16 * ti + 8 * kt + 2 * g + hi; imp[tq * 64 + j] = A; carry[tq * 68 + j + 1] = B; } }
                  nsa_pv(tb, p0, p1, o, r32, hi); }
              nsa_rowaccum(acc, true, o, wsf, g0, r32, hi); }
            __syncthreads();
            { const int q = tid >> 3, sub = tid & 7; unsigned long long mask;
              if (qb + 1 <= 16) mask = (1ull << (qb + 1)) - 1ull;
              else { mask = 1ull | (1ull << qb);
                  unsigned long long key[8];
#pragma unroll
                  for (int i = 0; i < 8; ++i) { const int j = sub * 8 + i; const float v = imp[q * 64 + j] + carry[q * 68 + j];
                      key[i] = (j >= 1 && j < qb) ? (((unsigned long long)__builtin_bit_cast(unsigned, v) << 32) | (unsigned)(63 - j)) : 0ull; }
                  for (int r = 0; r < 14; ++r) { unsigned long long best = key[0];
#pragma unroll
                      for (int i = 1; i < 8; ++i) best = key[i] > best ? key[i] : best;
#pragma unroll
                      for (int x = 1; x < 8; x <<= 1) { const unsigned lo = (unsigned)bperm(lane ^ x, (int)(unsigned)best), hh = (unsigned)bperm(lane ^ x, (int)(unsigned)(best >> 32));
                          const unsigned long long other = ((unsigned long long)hh << 32) | lo; best = other > best ? other : best; }
                      const int jb = 63 - (int)(best & 63ull); mask |= 1ull << jb;
#pragma unroll
                      for (int i = 0; i < 8; ++i) if (sub * 8 + i == jb) key[i] = 0ull; } }
              if (sub == 0) selm[q] = mask; }
            __syncthreads();
            const unsigned long long mysel = selm[tq];
            { const bf16* kb = P1 + (size_t)b * SEQ * P1W + C_KSLC; const bf16* vb = VT + (size_t)(0 * BC + b) * 64 * SEQ;
              m = -1e30f; l = 0.f;
#pragma unroll
              for (int i = 0; i < 16; ++i) { o[0][i] = 0.f; o[1][i] = 0.f; }
              v4u kx2, vx2;
              nsa_load(kx, vx, kb, P1W, vb, SEQ, tid); if (qb >= 1) nsa_load(kx2, vx2, kb + (size_t)64 * P1W, P1W, vb + 64, SEQ, tid);
              for (int j = 0; j <= qb; j += 2) {
                  const bool two = j + 1 <= qb;
                  LAS unsigned char* tb = lds + par * NSA_STAGE; par ^= 1;
                  nsa_store(tb, kx, vx, tid); if (two) nsa_store(tb + NSA_BUF, kx2, vx2, tid);
                  __syncthreads();
                  if (j + 2 <= qb) nsa_load(kx, vx, kb + (size_t)(j + 2) * 64 * P1W, P1W, vb + (j + 2) * 64, SEQ, tid);
                  if (j + 3 <= qb) nsa_load(kx2, vx2, kb + (size_t)(j + 3) * 64 * P1W, P1W, vb + (j + 3) * 64, SEQ, tid);
                  { const bool rowsel = ((mysel >> j) & 1ull) != 0ull;
                    if (__builtin_amdgcn_ballot_w64(rowsel) != 0ull) {
                        nsa_qk(tb, qr, p0, p1, r32, hi); if (j == qb) nsa_mask(p0, p1, hi, tq, -1);
                        nsa_softmax_pv(tb, p0, p1, m, l, o, wsf, lane, r32, hi, rowsel); } }
                  if (two) { const bool rowsel = ((mysel >> (j + 1)) & 1ull) != 0ull;
                    if (__builtin_amdgcn_ballot_w64(rowsel) != 0ull) {
                        nsa_qk(tb + NSA_BUF, qr, p0, p1, r32, hi); if (j + 1 == qb) nsa_mask(p0, p1, hi, tq, -1);
                        nsa_softmax_pv(tb + NSA_BUF, p0, p1, m, l, o, wsf, lane, r32, hi, rowsel); } } }
              const float lt = l + partner32(l, lane);
              nsa_rowaccum(acc, false, o, wsf, lt > 0.f ? g1 / lt : 0.f, r32, hi); }
            { const bf16* kb = P1 + (size_t)b * SEQ * P1W + C_KWIN; const bf16* vb = VT + (size_t)(1 * BC + b) * 64 * SEQ;
              m = -1e30f; l = 0.f;
#pragma unroll
              for (int i = 0; i < 16; ++i) { o[0][i] = 0.f; o[1][i] = 0.f; }
              const int j0 = qb >= 8 ? qb - 8 : 0;
              nsa_load(kx, vx, kb + (size_t)j0 * 64 * P1W, P1W, vb + j0 * 64, SEQ, tid);
              for (int j = j0; j <= qb; ++j) {
                  LAS unsigned char* tb = lds + par * NSA_STAGE; par ^= 1;
                  nsa_store(tb, kx, vx, tid); __syncthreads();
                  if (j < qb) nsa_load(kx, vx, kb + (size_t)(j + 1) * 64 * P1W, P1W, vb + (j + 1) * 64, SEQ, tid);
                  nsa_qk(tb, qr, p0, p1, r32, hi); if (j == qb || j == qb - 8) nsa_mask(p0, p1, hi, j == qb ? tq : 63, j == qb - 8 ? tq : -1);
                  nsa_softmax_pv(tb, p0, p1, m, l, o, wsf, lane, r32, hi, true); }
              const float lt = l + partner32(l, lane);
              nsa_rowaccum(acc, false, o, wsf, lt > 0.f ? g2 / lt : 0.f, r32, hi);
              nsa_flush(acc, Yc + ((size_t)b * SEQ + qb * 64 + 8 * wave) * 256, lane); }
        }
    }
    __syncthreads();
}

constexpr int SB_HEAD_LDS = 17408;
constexpr int SB_FLAG = 4 * SB_HEAD_LDS;
constexpr float SB_LOG2E = 1.4426950408889634f, SB_STOP = -100.0f * 1.4426950408889634f;
__device__ __forceinline__ void p_stick2(Frame& F, int nbusy) {
    const int tid = F.tid, lane = F.lane, wave = F.wave, r32 = lane & 31, hi = lane >> 5, h = wave & 3, qh = wave >> 2;
    LAS unsigned char* lds = F.lds + RING_OFF; LAS unsigned char* hl = lds + h * SB_HEAD_LDS; LAS int* flag = (LAS int*)(lds + SB_FLAG);
    const bf16* P1 = WSP(bf16, WS_P1); const bf16* VT = WSP(bf16, WS_VT) + (size_t)2 * BC * 64 * SEQ;
    bf16* Yb = WSP(bf16, WS_Y) + (size_t)MC * 256;
    const int tq = 32 * qh + r32;
    if (F.bx >= nbusy)
        for (int item = F.bx - nbusy; item < BC * 64; item += F.G - nbusy) {
            const int b = item >> 6, qb = item & 63;
            const size_t row = (size_t)b * SEQ + qb * 64 + tq;
            bf16x8v qr[4];
#pragma unroll
            for (int d0 = 0; d0 < 4; ++d0) qr[d0] = *(const bf16x8v*)(P1 + row * P1W + C_SBQ + h * 64 + d0 * 16 + hi * 8);
            f32x16 o[2], p0, p1;
#pragma unroll
            for (int i = 0; i < 16; ++i) { o[0][i] = 0.f; o[1][i] = 0.f; }
            float R = 0.f;
            const int skey = tid & 63, sc = tid >> 6, sd = tid >> 3, skc = tid & 7;
            v4u kx[4], vx[4];
#define SB_LOAD(jj) do { const bf16* kg_ = P1 + ((size_t)b * SEQ + (jj) * 64 + skey) * P1W + C_SBK + sc * 8; \
                _Pragma("unroll") for (int hh = 0; hh < 4; ++hh) { kx[hh] = *(const v4u*)(kg_ + hh * 64); vx[hh] = *(const v4u*)(VT + ((size_t)(hh * BC + b) * 64 + sd) * SEQ + (jj) * 64 + skc * 8); } } while (0)
            SB_LOAD(qb);
            for (int j = qb; j >= 0; --j) {
                __syncthreads();
                if (j < qb) { int live = 0;
#pragma unroll
                    for (int w = 0; w < 8; ++w) live |= flag[w];
                    if (!live) break; }
#pragma unroll
                for (int hh = 0; hh < 4; ++hh) { *(LAS v4u*)(lds + hh * SB_HEAD_LDS + sc * 1024 + skey * 16) = kx[hh]; { LAS v2u* vd = (LAS v2u*)(lds + hh * SB_HEAD_LDS + NSA_V + sd * NSA_VP + skc * 16); vd[0] = (v2u){vx[hh].x, vx[hh].y}; vd[1] = (v2u){vx[hh].z, vx[hh].w}; } }
                __syncthreads();
                if (j > 0) SB_LOAD(j - 1);
                nsa_qk(hl, qr, p0, p1, r32, hi);
#pragma unroll
                for (int i = 0; i < 16; ++i) { p0[i] *= NSA_C2; p1[i] *= NSA_C2; }
                const int lim = (j == qb) ? tq : 64;
                float Town[8], Tp[8];
#pragma unroll
                for (int kt = 0; kt < 2; ++kt) { f32x16& pp = kt ? p1 : p0;
#pragma unroll
                    for (int g = 0; g < 4; ++g) { float L[4];
#pragma unroll
                        for (int e = 0; e < 4; ++e) { const int kk = 32 * kt + 8 * g + 4 * hi + e; const float z = pp[4 * g + e];
                            const float tt = __builtin_amdgcn_logf(1.0f + __builtin_amdgcn_exp2f(-__builtin_fabsf(z)));
                            const float lb = fminf(z, 0.f) - tt; const bool ok = kk < lim;
                            L[e] = ok ? lb - z : 0.f; pp[4 * g + e] = ok ? lb : -INFINITY; }
                        const float E2 = L[3], E1 = E2 + L[2], E0 = E1 + L[1];
                        pp[4 * g + 2] += E2; pp[4 * g + 1] += E1; pp[4 * g] += E0;
                        Town[4 * kt + g] = E0 + L[0]; } }
#pragma unroll
                for (int k = 0; k < 8; ++k) Tp[k] = partner32(Town[k], lane);
                float suf = R;
#pragma unroll
                for (int k = 7; k >= 0; --k) { const float add = suf + (hi == 0 ? Tp[k] : 0.f); f32x16& pp = (k >> 2) ? p1 : p0; const int g = k & 3;
#pragma unroll
                    for (int e = 0; e < 4; ++e) pp[4 * g + e] = __builtin_amdgcn_exp2f(pp[4 * g + e] + add);
                    suf += Town[k] + Tp[k]; }
                R = suf;
                nsa_pv(hl, p0, p1, o, r32, hi);
                const bool alive = R >= SB_STOP;
                const unsigned long long bal = __builtin_amdgcn_ballot_w64(alive);
                if (lane == 0) flag[wave] = bal != 0ull ? 1 : 0;
            }
            { bf16* dst = Yb + ((size_t)b * SEQ + qb * 64 + 32 * qh + 4 * hi) * 256 + h * 64 + r32;
#pragma unroll
              for (int i = 0; i < 16; ++i) { dst[((i & 3) + 8 * (i >> 2)) * 256] = (bf16)f2bf(o[0][i]); dst[((i & 3) + 8 * (i >> 2)) * 256 + 32] = (bf16)f2bf(o[1][i]); } }
        }
#undef SB_LOAD
    __syncthreads();
}

__device__ __forceinline__ void p_sgu2(Frame& F, int layer) {
    LAS unsigned char* vnT = F.lds + RING_OFF;
    const bf16* P1 = WSP(bf16, WS_P1); bf16* Ya = WSP(bf16, WS_Y);
    const float* gain = F.in[3] + (size_t)layer * 256; const float* sw = F.in[4] + (size_t)layer * 4 * 128 * 128; const float* sb = F.in[5] + (size_t)layer * 4 * 128;
    const int lane = F.lane, wave = F.wave, r32 = lane & 31, hi = lane >> 5, g = wave & 3, db = wave >> 2;
    for (int item = F.vcu; item < MC / 128; item += F.G) {
        const size_t r0 = (size_t)item * 128;
        __syncthreads();
        { const f32x4 gg = ((const f32x4*)gain)[lane];
          for (int rr = 0; rr < 16; rr += 2) { const int r = wave * 16 + rr;
              const v2u ra = *(const v2u*)(P1 + (r0 + r) * P1W + C_V + 4 * lane), rb = *(const v2u*)(P1 + (r0 + r + 1) * P1W + C_V + 4 * lane);
              const float a0 = bflo(ra.x), a1 = bfhi(ra.x), a2 = bflo(ra.y), a3 = bfhi(ra.y), b0 = bflo(rb.x), b1 = bfhi(rb.x), b2 = bflo(rb.y), b3 = bfhi(rb.y);
              const float sa = 1.0f / sqrtf(wave_sum((a0 * a0 + a1 * a1) + (a2 * a2 + a3 * a3), lane) * (1.f / 256.f) + EPS);
              const float sb_ = 1.0f / sqrtf(wave_sum((b0 * b0 + b1 * b1) + (b2 * b2 + b3 * b3), lane) * (1.f / 256.f) + EPS);
              LAS unsigned* q = (LAS unsigned*)(vnT + (4 * lane) * 272 + r * 2);
              q[0] = pk2(a0 * sa * gg.x, b0 * sb_ * gg.x); q[68] = pk2(a1 * sa * gg.y, b1 * sb_ * gg.y); q[136] = pk2(a2 * sa * gg.z, b2 * sb_ * gg.z); q[204] = pk2(a3 * sa * gg.w, b3 * sb_ * gg.w); } }
        __syncthreads();
        const int ch = g * 64 + db * 32 + r32;
        for (int tb = 0; tb < 4; ++tb) {
            f32x16 acc;
#pragma unroll
            for (int i = 0; i < 16; ++i) acc[i] = 0.f;
            const int t = 32 * tb + r32; const float* wrow = sw + ((size_t)g * 128 + t) * 128;
            f32x4 wq[8][2];
#pragma unroll
            for (int ks = 0; ks < 8; ++ks) if (ks < 2 * tb + 2) { wq[ks][0] = *(const f32x4*)(wrow + 16 * ks + 8 * hi); wq[ks][1] = *(const f32x4*)(wrow + 16 * ks + 8 * hi + 4); }
#pragma unroll
            for (int ks = 0; ks < 8; ++ks) if (ks < 2 * tb + 2) {
                const int s0 = 16 * ks + 8 * hi;
                const f32x4 w0 = wq[ks][0], w1 = wq[ks][1];
                const v4u a = (v4u){pk2(s0 <= t ? w0.x : 0.f, s0 + 1 <= t ? w0.y : 0.f), pk2(s0 + 2 <= t ? w0.z : 0.f, s0 + 3 <= t ? w0.w : 0.f),
                                    pk2(s0 + 4 <= t ? w1.x : 0.f, s0 + 5 <= t ? w1.y : 0.f), pk2(s0 + 6 <= t ? w1.z : 0.f, s0 + 7 <= t ? w1.w : 0.f)};
                const bf16x8v bfr = *(const LAS bf16x8v*)(vnT + ch * 272 + s0 * 2);
                acc = __builtin_amdgcn_mfma_f32_32x32x16_bf16(__builtin_bit_cast(bf16x8v, a), bfr, acc, 0, 0, 0); }
            float uu[16], bb[16];
#pragma unroll
            for (int i = 0; i < 16; ++i) { const int tt = 32 * tb + (i & 3) + 8 * (i >> 2) + 4 * hi; uu[i] = bf1(P1[(r0 + tt) * P1W + C_U + ch]); bb[i] = sb[g * 128 + tt]; }
#pragma unroll
            for (int i = 0; i < 16; ++i) { const int tt = 32 * tb + (i & 3) + 8 * (i >> 2) + 4 * hi;
                Ya[(r0 + tt) * 256 + ch] = (bf16)f2bf(uu[i] * (acc[i] + bb[i])); }
        }
    }
    __syncthreads();
}

struct Args { const float* in[20]; float* out; unsigned char* ws; int lo, hi, li, rep; };
#ifndef TILED_FFN1
#define TILED_FFN1 0
#endif
#ifndef PG8_ALIGN_EPI
#define PG8_ALIGN_EPI true
#endif
#ifndef PG8_SP2
#define PG8_SP2 true
#endif
#ifndef WGM_PROJ
#define WGM_PROJ PG8_WGM
#endif
#ifndef WGM_FFN1
#define WGM_FFN1 PG8_WGM
#endif
#ifndef WGM_FFN2
#define WGM_FFN2 PG8_WGM
#endif
#ifndef WGM_MOE1
#define WGM_MOE1 PG8_WGM
#endif
#ifndef WGM_MOE2
#define WGM_MOE2 PG8_WGM
#endif
#ifndef FFN_CHUNKS
#define FFN_CHUNKS 2
#endif
#ifndef REP_GEMM
#define REP_GEMM 1
#endif
#ifndef REP_STICK
#define REP_STICK 1
#endif
#ifndef REP_NSA
#define REP_NSA 1
#endif
#ifndef REP_SGU
#define REP_SGU 1
#endif
#ifndef REP_NORM
#define REP_NORM 1
#endif
template <class Epi, class Sched> __device__ __forceinline__ void run_gemm(Frame& F, const bf16* A, const bf16* Bt, int M, int N, int K, const Sched& S, Epi E, bool rotate = true, int tiled = 0) {
    const int nt_ = K / 64;
#ifdef PG8_KROT
    const int rot_ = rotate ? 2 * (((F.bx & 7) * (nt_ / 2)) / 8) : 0;
#else
    const int rot_ = 0;
#endif
    pg8::Gemm g{A, Bt, M, N, K + F.zs, F.tid, rot_ + F.zs, tiled + F.zs};
    if (F.rep) E.set_scale0();
    pg8::gemm_phase<Epi, Sched, PG8_ALIGN_EPI, PG8_SP2>(F.lds + RING_OFF, g, S, E);
}
__global__ void __launch_bounds__(NWAVES * 64, 2) mk_fwd(Args args) {
    extern __shared__ __attribute__((aligned(16))) unsigned char lds[];
    Frame F0;
    F0.lds = (LAS unsigned char*)lds;
    F0.tid = threadIdx.x; F0.lane = F0.tid & 63; F0.wave = __builtin_amdgcn_readfirstlane(F0.tid >> 6);
    F0.G = gridDim.x; F0.bx = blockIdx.x; F0.vcu = (F0.G % 8 == 0) ? (F0.bx % 8) * (F0.G / 8) + F0.bx / 8 : F0.bx; F0.zv = 0; F0.zs = 0;
    F0.rep = args.rep; F0.ws = args.ws; F0.ctl = (unsigned*)(args.ws + WS_CTL); F0.in = args.in; F0.out = args.out;
    for (int u = F0.tid; u < (LDS_BYTES - LDSCTL_OFF) / 4; u += NWAVES * 64) ((LAS unsigned*)(F0.lds + LDSCTL_OFF))[u] = 0u;
    __syncthreads();
    const int lo = args.lo, hi = args.hi;
    XcdBarrier bar; bar.bar = F0.ctl + CW_BAR + args.li * XCD_BAR_WORDS; bar.x = 0; bar.st = nullptr; bar.w = 0; bar.z = 0;
    if (hi - lo > 1) bar = xcd_barrier_post(F0.ctl + CW_BAR + args.li * XCD_BAR_WORDS, (volatile LAS unsigned*)(F0.lds + MISC_OFF) + 8);
    int step = 0;
#define STEP_BEGIN if (step >= lo && step < hi) { Frame F = F0; { int zv_, zs_; asm volatile("v_mov_b32 %0, 0" : "=v"(zv_)); asm volatile("s_mov_b32 %0, 0" : "=s"(zs_)); \
        F.zv = zv_; F.zs = zs_; F.lane = (int)__builtin_amdgcn_mbcnt_hi(~0u, __builtin_amdgcn_mbcnt_lo(~0u, (unsigned)zv_)); F.wave = F0.wave + zs_; F.tid = F.wave * 64 + F.lane; F.bx = F.bx + zs_; \
        F.vcu = F0.vcu + zs_; F.G = F0.G + zs_; F.lds = (LAS unsigned char*)lds + zs_; F.ws = F0.ws + zs_; F.ctl = F0.ctl + zs_; F.in = F0.in + zs_; F.out = F0.out + zs_; }
#ifdef PROBE_XBAR
#define STEP_END   if (step + 1 < hi) { unsigned zb_; asm volatile("v_mov_b32 %0, 0" : "=v"(zb_)); bar.z = zb_; xcd_barrier(bar); xcd_barrier(bar); } } ++step;
#else
#define STEP_END   if (step + 1 < hi) { unsigned zb_; asm volatile("v_mov_b32 %0, 0" : "=v"(zb_)); bar.z = zb_; xcd_barrier(bar); } } ++step;
#endif

    for (int layer = 0; layer < DEPTH; ++layer) {
        const int jj = layer >> 1;
        STEP_BEGIN
            p_convert(F, layer);
            p_norm<0>(F, layer == 0 ? F.in[0] : F.out, F.in[1] + (size_t)layer * DM, nullptr, 0);
        STEP_END
        for (int c = 0; c < NCHUNK; ++c) {
            STEP_BEGIN
                pg8::StaticOrder S; S.init(MC, NPROJ, F.G, F.bx, WGM_PROJ);
                pg8::EpiProj E{WSP(bf16, WS_P1), WSP(bf16, WS_G)};
                run_gemm(F, WSP(bf16, WS_HN) + (size_t)c * MC * DM, WSP(bf16, WS_WIN), MC, NPROJ, DM, S, E);
            STEP_END
            STEP_BEGIN
                p_prep(F);
            STEP_END
            STEP_BEGIN
                LAS int* tab = (LAS int*)(F.lds + TAB_OFF);
                __syncthreads(); if (F.tid < 16) tab[F.tid] = F.tid >> 3; __syncthreads();
                pg8::GroupedOrder S; S.so.init(2 * 2048, 512, F.G, F.bx); S.tile_e = tab; S.nN = 2;
                pg8::EpiF32 E{WSP(float, WS_UL), 512, 2};
                run_gemm(F, WSP(bf16, WS_KVC), WSP(bf16, WS_WC1), 2 * 2048, 512, DM, S, E);
                p_sgu2(F, layer);
                p_stick2(F, F.G > 64 ? 32 : 0);
            STEP_END
            STEP_BEGIN
                p_cmpfin(F, layer);
            STEP_END
            STEP_BEGIN
#ifdef OLD_NSA
                p_nsa(F);
#else
                p_nsa2(F);
#endif
            STEP_END
            STEP_BEGIN
                pg8::MergeOrder S; S.so.init(MC, DM, F.G, F.bx); S.nmt = MC / 256;
                pg8::EpiMerge E{WSP(bf16, WS_G), WSP(bf16, WS_MG), MC / 256};
                run_gemm(F, WSP(bf16, WS_Y), WSP(bf16, WS_WBR), 3 * MC, 3 * DM, 256, S, E);
            STEP_END
            STEP_BEGIN
                pg8::StaticOrder S; S.init(MC, DM, F.G, F.bx);
                const float* base = (layer == 0 ? F.in[0] : F.out) + (size_t)c * MC * DM;
                pg8::EpiResid E{base, F.out + (size_t)c * MC * DM, DM, 1.0f};
                run_gemm(F, WSP(bf16, WS_MG), WSP(bf16, WS_WOUT), MC, DM, DM, S, E);
            STEP_END
        }
        if ((layer & 1) == 0) {
            STEP_BEGIN
                p_norm<0>(F, F.out, F.in[11] + (size_t)layer * DM, nullptr, 0, Q8_HN, TILED_FFN1);
            STEP_END
            for (int c = 0; c < FFN_CHUNKS; ++c) {
                constexpr int MF = MTOK / FFN_CHUNKS;
                STEP_BEGIN
                    pg8::StaticOrder S; S.init(MF, NFF1, F.G, F.bx, WGM_FFN1);
                    pg8::EpiSwiGLU E{WSP(bf16, WS_HID), DFFP, nullptr, NFF1 / 256};
                    run_gemm(F, WSP(bf16, WS_HN) + (size_t)c * MF * DM, WSP(bf16, WS_WF1), MF, NFF1, DM, S, E, true, TILED_FFN1);
                STEP_END
                STEP_BEGIN
                    pg8::StaticOrder S; S.init(MF, DM, F.G, F.bx, WGM_FFN2);
                    pg8::EpiResid E{F.out + (size_t)c * MF * DM, F.out + (size_t)c * MF * DM, DM, 1.0f};
                    run_gemm(F, WSP(bf16, WS_HID), WSP(bf16, WS_WF2), MF, DM, DFFP, S, E);
                STEP_END
            }
        } else {
            STEP_BEGIN
                p_norm<1>(F, F.out, F.in[11] + (size_t)layer * DM, F.in[15] + (size_t)jj * DM * NEXP, jj, Q8_HN);
            STEP_END
#ifdef ABL_DENSE_MOE
            for (int e = 0; e < NEXP; ++e) {
                STEP_BEGIN
                    pg8::StaticOrder S; S.init(MTOK, NMOE1, F.G, F.bx);
                    pg8::EpiSwiGLU E{WSP(bf16, WS_SCR + 8 * MiB), DFE, WSP(float, WS_SCR + 4 * MiB) + (size_t)e * MTOK, NMOE1 / 256};
                    run_gemm(F, WSP(bf16, WS_HN), WSP(bf16, WS_WF1) + (size_t)e * NMOE1 * DM, MTOK, NMOE1, DM, S, E);
                STEP_END
                STEP_BEGIN
                    pg8::StaticOrder S; S.init(MTOK, DM, F.G, F.bx);
                    pg8::EpiResid E{F.out, F.out, DM, 1.0f};
                    run_gemm(F, WSP(bf16, WS_SCR + 8 * MiB), WSP(bf16, WS_WF2) + (size_t)e * DM * DFE, MTOK, DM, DFE, S, E);
                STEP_END
            }
#else
            STEP_BEGIN
                p_gather(F, jj, 0, 0);
            STEP_END
            for (int c = 0; c < NCHUNK; ++c)
                for (int r = 0; r < 2; ++r) {
                    STEP_BEGIN
                        const int T = moe_table(F, jj, c, r);
                        pg8::GroupedOrder S; S.so.init(T * 256, NMOE1, F.G, F.bx, WGM_MOE1); S.tile_e = (LAS int*)(F.lds + TAB_OFF); S.nN = NMOE1 / 256;
                        pg8::EpiSwiGLU E{WSP(bf16, WS_HIDM), DFE, WSP(float, WS_WSLOT) + (c * 2 + r) * SLOTS, NMOE1 / 256};
                        run_gemm(F, WSP(bf16, WS_XG), WSP(bf16, WS_WF1), T * 256, NMOE1, DM, S, E, false);
                    STEP_END
                    STEP_BEGIN
                        const int T = moe_table(F, jj, c, r);
                        pg8::GroupedOrder S; S.so.init(T * 256, DM, F.G, F.bx, WGM_MOE2); S.tile_e = (LAS int*)(F.lds + TAB_OFF); S.nN = DM / 256;
                        pg8::EpiScatter E{F.out, WSP(int, WS_TOKMAP) + (c * 2 + r) * SLOTS, DM / 256, 1.0f};
                        run_gemm(F, WSP(bf16, WS_HIDM), WSP(bf16, WS_WF2), T * 256, DM, DFE, S, E, false);
                        if (!F.rep && c * 2 + r < 3) p_gather(F, jj, (c * 2 + r + 1) >> 1, (c * 2 + r + 1) & 1, (T * (DM / 256)) % F.G);
                    STEP_END
                }
#endif
        }
    }
    STEP_BEGIN
        p_norm<2>(F, F.out, F.in[19], nullptr, 0);
    STEP_END
#undef STEP_BEGIN
#undef STEP_END
}

#ifndef MK_STEPS_PER_LAUNCH
#define MK_STEPS_PER_LAUNCH 1
#endif
extern "C" void kernel_launch(void* const* d_in, const int* in_sizes, int n_in, void* d_out, int out_size, void* d_ws, size_t ws_size, hipStream_t stream) {
    static int grid = 0;
    if (grid == 0) {
        if (n_in != 20 || in_sizes[0] != MTOK * DM || out_size != MTOK * DM || ws_size < WS_END) { fprintf(stderr, "kernel_launch: unexpected shapes (n_in %d, in0 %d, out %d, ws %zu)\n", n_in, n_in > 0 ? in_sizes[0] : -1, out_size, ws_size); grid = -1; return; }
        int dev = 0, cus = 0, per_cu = 0;
        if (hipGetDevice(&dev) != hipSuccess || hipDeviceGetAttribute(&cus, hipDeviceAttributeMultiprocessorCount, dev) != hipSuccess) { grid = -1; return; }
        if (hipFuncSetAttribute((const void*)mk_fwd, hipFuncAttributeMaxDynamicSharedMemorySize, LDS_BYTES) != hipSuccess) { fprintf(stderr, "kernel_launch: hipFuncSetAttribute failed\n"); grid = -1; return; }
        if (hipOccupancyMaxActiveBlocksPerMultiprocessor(&per_cu, (const void*)mk_fwd, NWAVES * 64, LDS_BYTES) != hipSuccess || per_cu < 1) fprintf(stderr, "kernel_launch: occupancy query reports %d\n", per_cu);
        (void)hipGetLastError();
        grid = cus;
    }
    if (grid < 0) return;
    if (hipMemsetAsync((char*)d_ws + WS_CTL, 0, CTL_ZERO_BYTES, stream) != hipSuccess) return;
    Args a{};
    for (int i = 0; i < 20; ++i) a.in[i] = (const float*)d_in[i];
    a.out = (float*)d_out; a.ws = (unsigned char*)d_ws; a.rep = 0;
    #ifdef ABL_DENSE_MOE
    constexpr int NSTEPS = 2 * (1 + NCHUNK * 8 + 3) + 2 * (1 + NCHUNK * 8 + 1 + NEXP * 2) + 1;
#else
    constexpr int NSTEPS = 2 * (1 + NCHUNK * 7 + 1 + 2 * FFN_CHUNKS) + 2 * (1 + NCHUNK * 7 + 2 + NCHUNK * 2 * 2) + 1;
#endif
    int li = 0;
#ifdef REPMASK
    static int kinds[256]; int ns = 0;
    for (int layer = 0; layer < DEPTH; ++layer) { kinds[ns++] = 0;
        for (int c = 0; c < NCHUNK; ++c) for (int q = 1; q <= 8; ++q) if (q != 5) kinds[ns++] = q;
        if ((layer & 1) == 0) { kinds[ns++] = 9; for (int c = 0; c < FFN_CHUNKS; ++c) { kinds[ns++] = 10; kinds[ns++] = 11; } }
        else { kinds[ns++] = 12; kinds[ns++] = 17; for (int c = 0; c < NCHUNK * 2; ++c) { kinds[ns++] = 14; kinds[ns++] = 13; } } }
    kinds[ns++] = 16;
    for (int s = 0; s < NSTEPS; ++s) { const int reps = ((REPMASK >> kinds[s]) & 1) ? 2 : 1;
        for (int r = 0; r < reps; ++r) { a.lo = s; a.hi = s + 1; a.li = 0; a.rep = r;
            hipLaunchKernelGGL(mk_fwd, dim3(grid), dim3(NWAVES * 64), LDS_BYTES, stream, a); } }
    (void)li;
#else
    for (int s = 0; s < NSTEPS; s += MK_STEPS_PER_LAUNCH) {
        a.lo = s; a.hi = (s + MK_STEPS_PER_LAUNCH < NSTEPS) ? s + MK_STEPS_PER_LAUNCH : NSTEPS; a.li = (MK_STEPS_PER_LAUNCH > 1) ? li : 0; ++li;
        hipLaunchKernelGGL(mk_fwd, dim3(grid), dim3(NWAVES * 64), LDS_BYTES, stream, a);
        if (hipPeekAtLastError() != hipSuccess) { fprintf(stderr, "kernel_launch: launch failed\n"); break; }
    }
#endif
}
```

```cpp
#define MK_STEPS_PER_LAUNCH 1000
#define PG8_WGM 4
#define FFN_CHUNKS 1
#include <hip/hip_runtime.h>
#include <cstdio>
#include <cstdint>
#include <cmath>
#ifndef PG8_AUX_A
#define PG8_AUX_A 0
#endif
#ifndef PG8_AUX_B
#define PG8_AUX_B 0
#endif
#ifndef PG8_WGM
#define PG8_WGM 8
#endif
namespace pg8 {
#define PG8_LAS __attribute__((address_space(3)))
typedef unsigned short bf16_t;
typedef short bf16x8 __attribute__((ext_vector_type(8)));
typedef float f32x4 __attribute__((ext_vector_type(4)));
typedef unsigned u32x4 __attribute__((ext_vector_type(4)));
constexpr int BM = 256, BK = 64, HALF = 128, HTB = HALF * BK * 2  , STAGE_BYTES = 8 * HTB, NXCD = 8, WGM = PG8_WGM;

__host__ __device__ __forceinline__ int lds_byte(int r, int c) { const int st = (r >> 4) * 2 + (c >> 5), rr = r & 15, cc = c & 31, ob = rr * 64 + cc * 2; return st * 1024 + (ob ^ (((ob >> 9) & 1) << 5)); }
__host__ __device__ __forceinline__ void stage_rc(int b, int& R, int& C) { const int st = b / 1024, sb = b % 1024, swz = sb ^ (((sb >> 9) & 1) << 5); R = (st >> 1) * 16 + swz / 64; C = (st & 1) * 32 + (swz % 64) / 2; }
__host__ __device__ __forceinline__ int perm32(int rho) { const int n = rho >> 4, i = rho & 15; return 8 * (i >> 2) + 4 * n + (i & 3); }

struct Unit { int pm, pn; };
struct Gemm { const bf16_t* A; const bf16_t* Bt; int M, N, K; int zv; int rot; int tiled; int ld; };

struct StaticOrder {
    int nM, nN, nwg, G, c, wgm;
    __host__ __device__ __forceinline__ void init(int M, int N, int G_, int c_, int wgm_ = WGM) { nM = M / BM; nN = N / BM; nwg = nM * nN; G = G_; c = c_; wgm = wgm_; }
    __host__ __device__ __forceinline__ bool next(int i, Unit& u) const {
        const long L = (long)i * G + c; if (L >= nwg) return false;
        int wgid = (int)L; { const int q = nwg / NXCD, r = nwg % NXCD, xcd = wgid % NXCD, off = wgid / NXCD; wgid = (xcd < r ? xcd * (q + 1) : r * (q + 1) + (xcd - r) * q) + off; }
        const int nig = wgm * nN, gid = wgid / nig, fm = gid * wgm, gsz = (nM - fm) < wgm ? (nM - fm) : wgm;
        u.pm = fm + ((wgid % nig) % gsz); u.pn = (wgid % nig) / gsz; return true;
    }
    __device__ __forceinline__ void a_ready(const Unit&) const {}
    __device__ __forceinline__ void done(const Unit&) const {}
};

__device__ __forceinline__ unsigned cvt_pk_bf16(float lo, float hi) { unsigned r; asm volatile("v_cvt_pk_bf16_f32 %0, %1, %2" : "=v"(r) : "v"(lo), "v"(hi)); return r; }
typedef float f32x2 __attribute__((ext_vector_type(2)));

__device__ __forceinline__ float fast_sigmoid(float x) { return __builtin_amdgcn_rcpf(1.0f + __builtin_amdgcn_exp2f(-1.4426950408889634f * x)); }
__device__ __forceinline__ float gelu_tanh(float x) {
    const float u2 = 1.5957691216057308f * (x + 0.044715f * x * x * x);
    return x * fast_sigmoid(u2);
}
__device__ __forceinline__ float bf_lo(unsigned u) { return __builtin_bit_cast(float, u << 16); }
__device__ __forceinline__ float bf_hi(unsigned u) { return __builtin_bit_cast(float, u & 0xffff0000u); }

#ifdef PG8_NT_OUT
#define PG8_STORE_OUT(p, v) __builtin_nontemporal_store((v), (p))
#else
#define PG8_STORE_OUT(p, v) (*(p) = (v))
#endif
struct EpiProj {
    static constexpr bool PERM = true, AFTER_DRAIN = false, MID = false; static constexpr int MID_TILES = 1; __device__ __forceinline__ void set_scale0() {}
    bf16_t* P1; bf16_t* G;
    __device__ __forceinline__ void operator()(const f32x4 (&acc)[2][2][4][2], const Unit& u, int wr, int wc, int fr, int fq) const {
        const int row0 = u.pm * BM + wr * 64 + fr;
        bf16_t* base; int ldc, colt, act0, act1;
        if (u.pn < 8) { base = P1; ldc = 2048; colt = u.pn * BM; act0 = (u.pn < 2) ? 1 : 0; act1 = (u.pn == 7) ? 2 : act0; }
        else { base = G; ldc = 3072; colt = (u.pn - 8) * BM; act0 = 2; act1 = 2; }
        const int col0 = colt + wc * 32 + 8 * fq;
#pragma unroll
        for (int ai = 0; ai < 2; ++ai)
#pragma unroll
            for (int m = 0; m < 4; ++m) { bf16_t* rowp = base + (size_t)(row0 + ai * HALF + m * 16) * ldc + col0;
#pragma unroll
                for (int bj = 0; bj < 2; ++bj) { f32x4 v0 = acc[ai][bj][m][0], v1 = acc[ai][bj][m][1]; const int act = bj ? act1 : act0;
                    if (act == 1) {
#pragma unroll
                        for (int e = 0; e < 4; ++e) { v0[e] = gelu_tanh(v0[e]); v1[e] = gelu_tanh(v1[e]); } }
                    else if (act == 2) {
#pragma unroll
                        for (int e = 0; e < 4; ++e) { v0[e] = fast_sigmoid(v0[e]); v1[e] = fast_sigmoid(v1[e]); } }
                    u32x4 w; w.x = cvt_pk_bf16(v0[0], v0[1]); w.y = cvt_pk_bf16(v0[2], v0[3]); w.z = cvt_pk_bf16(v1[0], v1[1]); w.w = cvt_pk_bf16(v1[2], v1[3]);
                    *(u32x4*)(rowp + bj * HALF) = w; } }
    }
};
struct EpiMerge {
    static constexpr bool PERM = true, AFTER_DRAIN = false, MID = false; static constexpr int MID_TILES = 1; __device__ __forceinline__ void set_scale0() {}
    const bf16_t* G; bf16_t* MG; int nmt;
    __device__ __forceinline__ void operator()(const f32x4 (&acc)[2][2][4][2], const Unit& u, int wr, int wc, int fr, int fq) const {
        const int i = u.pn >> 2, pn = u.pn & 3, pm = u.pm - i * nmt;
        const int row0 = pm * BM + wr * 64 + fr, col0 = pn * BM + wc * 32 + 8 * fq;
#pragma unroll
        for (int ai = 0; ai < 2; ++ai)
#pragma unroll
            for (int mp = 0; mp < 2; ++mp) {
                u32x4 g[4], o[4];
#pragma unroll
                for (int q = 0; q < 4; ++q) { const int m = 2 * mp + (q >> 1), bj = q & 1; const size_t row = (size_t)(row0 + ai * HALF + m * 16); const int col = col0 + bj * HALF;
                    g[q] = *(const u32x4*)(G + row * 3072 + i * 1024 + col);
                    if (i > 0) o[q] = *(const u32x4*)(MG + row * 1024 + col); else o[q] = (u32x4){0u, 0u, 0u, 0u}; }
#pragma unroll
                for (int q = 0; q < 4; ++q) { const int m = 2 * mp + (q >> 1), bj = q & 1; const size_t row = (size_t)(row0 + ai * HALF + m * 16); const int col = col0 + bj * HALF;
                    f32x4 v0 = acc[ai][bj][m][0], v1 = acc[ai][bj][m][1];
#ifdef ABL_BRANCH
                    if (i == ABL_BRANCH) { v0 = v0 * (float)ABL_SCALE; v1 = v1 * (float)ABL_SCALE; }
#endif
                    v0[0] = v0[0] * bf_lo(g[q].x) + bf_lo(o[q].x); v0[1] = v0[1] * bf_hi(g[q].x) + bf_hi(o[q].x); v0[2] = v0[2] * bf_lo(g[q].y) + bf_lo(o[q].y); v0[3] = v0[3] * bf_hi(g[q].y) + bf_hi(o[q].y);
                    v1[0] = v1[0] * bf_lo(g[q].z) + bf_lo(o[q].z); v1[1] = v1[1] * bf_hi(g[q].z) + bf_hi(o[q].z); v1[2] = v1[2] * bf_lo(g[q].w) + bf_lo(o[q].w); v1[3] = v1[3] * bf_hi(g[q].w) + bf_hi(o[q].w);
                    u32x4 w; w.x = cvt_pk_bf16(v0[0], v0[1]); w.y = cvt_pk_bf16(v0[2], v0[3]); w.z = cvt_pk_bf16(v1[0], v1[1]); w.w = cvt_pk_bf16(v1[2], v1[3]);
                    *(u32x4*)(MG + row * 1024 + col) = w; } }
    }
};
struct EpiResid {
    static constexpr bool PERM = false, AFTER_DRAIN = false, MID = false; static constexpr int MID_TILES = 1; __device__ __forceinline__ void set_scale0() { scale = 0.f; base = out; }
    const float* base; float* out; int ldc; float scale;
    __device__ __forceinline__ void operator()(const f32x4 (&acc)[2][2][4][2], const Unit& u, int wr, int wc, int fr, int fq) const {
        const int row0 = u.pm * BM + wr * 64 + fr, col0 = u.pn * BM + wc * 32 + 4 * fq;
#pragma unroll
        for (int ai = 0; ai < 2; ++ai)
#pragma unroll
            for (int mp = 0; mp < 2; ++mp) {
                f32x4 b[8];
#pragma unroll
                for (int q = 0; q < 8; ++q) { const int m = 2 * mp + (q >> 2), bj = (q >> 1) & 1, n = q & 1;
                    b[q] = *(const f32x4*)(base + (size_t)(row0 + ai * HALF + m * 16) * ldc + col0 + bj * HALF + n * 16); }
#pragma unroll
                for (int q = 0; q < 8; ++q) { const int m = 2 * mp + (q >> 2), bj = (q >> 1) & 1, n = q & 1;
                    *(f32x4*)(out + (size_t)(row0 + ai * HALF + m * 16) * ldc + col0 + bj * HALF + n * 16) = b[q] + acc[ai][bj][m][n] * scale; } }
    }
};
struct EpiF32 {
    static constexpr bool PERM = false, AFTER_DRAIN = false, MID = false; static constexpr int MID_TILES = 1; __device__ __forceinline__ void set_scale0() {}
    float* O; int ldc, nN;
    __device__ __forceinline__ void operator()(const f32x4 (&acc)[2][2][4][2], const Unit& u, int wr, int wc, int fr, int fq) const {
        const int row0 = u.pm * BM + wr * 64 + fr, col0 = (u.pn % nN) * BM + wc * 32 + 4 * fq;
#pragma unroll
        for (int ai = 0; ai < 2; ++ai)
#pragma unroll
            for (int m = 0; m < 4; ++m) { const size_t off = (size_t)(row0 + ai * HALF + m * 16) * ldc + col0;
#pragma unroll
                for (int bj = 0; bj < 2; ++bj)
#pragma unroll
                    for (int n = 0; n < 2; ++n) *(f32x4*)(O + off + bj * HALF + n * 16) = acc[ai][bj][m][n]; }
    }
};
#ifdef EMU_FP8_HID
__device__ __forceinline__ float Q8H(float x) { const int p = __builtin_amdgcn_cvt_pk_fp8_f32(x * 8.f, x * 8.f, 0, false); return __builtin_amdgcn_cvt_f32_fp8(p, 0) * 0.125f; }
#else
__device__ __forceinline__ float Q8H(float x) { return x; }
#endif
struct EpiSwiGLU {
    static constexpr bool PERM = true, AFTER_DRAIN = false, MID = false; static constexpr int MID_TILES = 1; __device__ __forceinline__ void set_scale0() {}
    bf16_t* H; int ldh; const float* rowscale; int nN; int rowmask = 0x7fffffff;
    __device__ __forceinline__ void operator()(const f32x4 (&acc)[2][2][4][2], const Unit& u, int wr, int wc, int fr, int fq) const {
        const int row0 = u.pm * BM + wr * 64 + fr, col0 = (u.pn % nN) * HALF + wc * 32 + 8 * fq;
        float scv[8];
#pragma unroll
        for (int q = 0; q < 8; ++q) scv[q] = rowscale ? rowscale[row0 + (q >> 2) * HALF + (q & 3) * 16] : 1.0f;
#pragma unroll
        for (int ai = 0; ai < 2; ++ai)
#pragma unroll
            for (int m = 0; m < 4; ++m) { const int row = row0 + ai * HALF + m * 16; const float sc = scv[ai * 4 + m];
                float h[8];
#pragma unroll
                for (int n = 0; n < 2; ++n)
#pragma unroll
                    for (int e = 0; e < 4; ++e) { const float g = acc[ai][0][m][n][e], up = acc[ai][1][m][n][e]; h[n * 4 + e] = Q8H(g * fast_sigmoid(g) * up * sc); }
                u32x4 w; w.x = cvt_pk_bf16(h[0], h[1]); w.y = cvt_pk_bf16(h[2], h[3]); w.z = cvt_pk_bf16(h[4], h[5]); w.w = cvt_pk_bf16(h[6], h[7]);
                PG8_STORE_OUT((u32x4*)(H + (size_t)(row & rowmask) * ldh + col0), w); }
    }
};
struct EpiScatter {
    static constexpr bool PERM = false, AFTER_DRAIN = false, MID = false; static constexpr int MID_TILES = 1; __device__ __forceinline__ void set_scale0() { scale = 0.f; }
    float* out; const int* tok; int nN; float scale;
    __device__ __forceinline__ void operator()(const f32x4 (&acc)[2][2][4][2], const Unit& u, int wr, int wc, int fr, int fq) const {
        const int row0 = u.pm * BM + wr * 64 + fr, col0 = (u.pn % nN) * BM + wc * 32 + 4 * fq;
        int tk[8];
#pragma unroll
        for (int q = 0; q < 8; ++q) tk[q] = tok[row0 + (q >> 2) * HALF + (q & 3) * 16];
#pragma unroll
        for (int ai = 0; ai < 2; ++ai)
#pragma unroll
            for (int mp = 0; mp < 2; ++mp) {
                f32x4 b[8];
#pragma unroll
                for (int q = 0; q < 8; ++q) { const int m = 2 * mp + (q >> 2), bj = (q >> 1) & 1, n = q & 1; const int t = tk[ai * 4 + m];
                    b[q] = *(const f32x4*)(out + (size_t)(t < 0 ? 0 : t) * 1024 + col0 + bj * HALF + n * 16); }
#pragma unroll
                for (int q = 0; q < 8; ++q) { const int m = 2 * mp + (q >> 2), bj = (q >> 1) & 1, n = q & 1; const int t = tk[ai * 4 + m];
#ifdef ABL_MOE
                    if (false)
#else
                    if (t >= 0)
#endif
                        *(f32x4*)(out + (size_t)t * 1024 + col0 + bj * HALF + n * 16) = b[q] + acc[ai][bj][m][n] * scale; } }
    }
};
struct GroupedOrder {
    StaticOrder so; const PG8_LAS int* tile_e; int nN;
    __device__ __forceinline__ bool next(int i, Unit& u) const { if (!so.next(i, u)) return false; u.pn += tile_e[u.pm] * nN; return true; }
    __device__ __forceinline__ void a_ready(const Unit&) const {}
    __device__ __forceinline__ void done(const Unit&) const {}
};
struct LimitOrder {
    StaticOrder so; int limit;
    __device__ __forceinline__ bool next(int i, Unit& u) const { if ((long)i * so.G + so.c >= limit) return false; return so.next(i, u); }
    __device__ __forceinline__ void a_ready(const Unit&) const {}
    __device__ __forceinline__ void done(const Unit&) const {}
};
struct GroupedLimit {
    LimitOrder lo; const PG8_LAS int* tile_e; int nN;
    __device__ __forceinline__ bool next(int i, Unit& u) const { if (!lo.next(i, u)) return false; u.pn += tile_e[u.pm] * nN; return true; }
    __device__ __forceinline__ void a_ready(const Unit&) const {}
    __device__ __forceinline__ void done(const Unit&) const {}
};
struct SingleOrder {
    Unit un;
    __device__ __forceinline__ bool next(int i, Unit& u) const { if (i != 0) return false; u = un; return true; }
    __device__ __forceinline__ void a_ready(const Unit&) const {}
    __device__ __forceinline__ void done(const Unit&) const {}
};
struct EpiTile {
    static constexpr bool PERM = false, AFTER_DRAIN = false, MID = false; static constexpr int MID_TILES = 1; __device__ __forceinline__ void set_scale0() {}
    float* O;
    __device__ __forceinline__ void operator()(const f32x4 (&acc)[2][2][4][2], const Unit&, int wr, int wc, int fr, int fq) const {
#pragma unroll
        for (int ai = 0; ai < 2; ++ai)
#pragma unroll
            for (int m = 0; m < 4; ++m)
#pragma unroll
                for (int bj = 0; bj < 2; ++bj)
#pragma unroll
                    for (int n = 0; n < 2; ++n) *(f32x4*)(O + (size_t)(wr * 64 + fr + ai * HALF + m * 16) * 256 + wc * 32 + 4 * fq + bj * HALF + n * 16) = acc[ai][bj][m][n];
    }
};
struct OffsetOrder {
    StaticOrder so; int pn_off;
    __device__ __forceinline__ bool next(int i, Unit& u) const { if (!so.next(i, u)) return false; u.pn += pn_off; return true; }
    __device__ __forceinline__ void a_ready(const Unit&) const {}
    __device__ __forceinline__ void done(const Unit&) const {}
};
struct ProbeOrder {
    StaticOrder so; int pm_mask;
    __device__ __forceinline__ bool next(int i, Unit& u) const { if (!so.next(i, u)) return false; u.pm &= pm_mask; return true; }
    __device__ __forceinline__ void a_ready(const Unit&) const {}
    __device__ __forceinline__ void done(const Unit&) const {}
};
struct MergeOrder {
    StaticOrder so; int nmt;
    __device__ __forceinline__ bool next(int i, Unit& u) const { const int b = i % 3; if (!so.next(i / 3, u)) return false; u.pm += b * nmt; u.pn += b * 4; return true; }
    __device__ __forceinline__ void a_ready(const Unit&) const {}
    __device__ __forceinline__ void done(const Unit&) const {}
};
template <class Epi, class Sched, bool ALIGN_EPI = false, bool SP2 = false>
__device__ __forceinline__ void gemm_phase(PG8_LAS unsigned char* lds, const Gemm g, const Sched& S, const Epi& E) {
    const int tid = g.zv  , wid = __builtin_amdgcn_readfirstlane(tid >> 6), lane = tid & 63, wr = wid >> 2, wc = wid & 3, fr = lane & 15, fq = lane >> 4;
    const int K = g.K, nt = K / BK;
    unsigned voffA[2], voffB[2];
#pragma unroll
    for (int i = 0; i < 2; ++i) { int R, C; stage_rc(tid * 16 + i * 8192, R, C); const int Rb = Epi::PERM ? ((R & ~31) + perm32(R & 31)) : R;
        const int LD = g.ld ? g.ld : K;
        const int pitch = g.tiled ? BK : LD;
        voffA[i] = (unsigned)(R * pitch + C) * 2u; voffB[i] = (unsigned)(Rb * pitch + C) * 2u; }
    const size_t kstep = g.tiled ? (size_t)(BM * BK * 2) : (size_t)(BK * 2);
    const size_t hstep = g.tiled ? (size_t)(HALF * BK * 2) : (size_t)HALF * (g.ld ? g.ld : K) * 2;
    const size_t tstep = (size_t)BM * (g.ld ? g.ld : K) * 2;
    const unsigned ldsw = (unsigned)wid * 1024u;
    const int aoff = lds_byte(wr * 64 + fr, fq * 8), boff = lds_byte(wc * 32 + fr, fq * 8);
#define PG8_SA(b, h) (((b) * 2 + (h)) * HTB)
#define PG8_SB(b, h) ((4 + (b) * 2 + (h)) * HTB)
#define PG8_STAGE(bufoff, gbase, voff) do { _Pragma("unroll") for (int _i = 0; _i < 2; ++_i) \
        __builtin_amdgcn_global_load_lds((const unsigned*)((const char*)(gbase) + (voff)[_i]), (PG8_LAS unsigned*)(lds + (bufoff) + ldsw + _i * 8192), 16, 0, ((bufoff) < 4 * HTB) ? PG8_AUX_A : PG8_AUX_B); } while (0)
#define PG8_LDA(dst, b, h) do { _Pragma("unroll") for (int m = 0; m < 4; ++m) _Pragma("unroll") for (int k = 0; k < 2; ++k) dst[m][k] = *(const PG8_LAS bf16x8*)(lds + PG8_SA(b, h) + aoff + m * 2048 + k * 1024); } while (0)
#define PG8_LDB(dst, b, h) do { _Pragma("unroll") for (int n = 0; n < 2; ++n) _Pragma("unroll") for (int k = 0; k < 2; ++k) dst[n][k] = *(const PG8_LAS bf16x8*)(lds + PG8_SB(b, h) + boff + n * 2048 + k * 1024); } while (0)
#define PG8_MMA(ai, bj, At, Bt) do { __builtin_amdgcn_s_setprio(1); _Pragma("unroll") for (int m = 0; m < 4; ++m) _Pragma("unroll") for (int n = 0; n < 2; ++n) _Pragma("unroll") for (int k = 0; k < 2; ++k) \
        acc[ai][bj][m][n] = __builtin_amdgcn_mfma_f32_16x16x32_bf16(Bt[n][k], At[m][k], acc[ai][bj][m][n], 0, 0, 0); __builtin_amdgcn_s_setprio(0); } while (0)
#define PG8_WAIT_V(n) asm volatile("s_waitcnt vmcnt(" #n ")" ::: "memory")
#define PG8_WAIT_L(n) asm volatile("s_waitcnt lgkmcnt(" #n ")" ::: "memory")
#define PG8_BAR __builtin_amdgcn_s_barrier()
#define PG8_SCHED __builtin_amdgcn_sched_barrier(0)
    Unit cur, nxt; int ui = 0;
    if (!S.next(0, cur)) return;
    f32x4 acc[2][2][4][2];
#pragma unroll
    for (int a = 0; a < 2; ++a)
#pragma unroll
        for (int b = 0; b < 2; ++b)
#pragma unroll
            for (int m = 0; m < 4; ++m)
#pragma unroll
                for (int n = 0; n < 2; ++n) acc[a][b][m][n] = (f32x4){0.f, 0.f, 0.f, 0.f};
    bf16x8 At[4][2], B0[2][2], B1[2][2];
    const char* cA = (const char*)g.A + (size_t)cur.pm * tstep; const char* cB = (const char*)g.Bt + (size_t)cur.pn * tstep;
    const int rot = g.rot; const size_t rofs = (size_t)rot * kstep; const char* pA = cA + rofs; const char* pB = cB + rofs;
#define PG8_KT(x) ((size_t)(((x) + rot >= nt) ? (x) + rot - nt : (x) + rot))
    S.a_ready(cur);
    if constexpr (SP2) {
        PG8_STAGE(PG8_SB(0, 0), pB, voffB); PG8_STAGE(PG8_SB(0, 1), pB + hstep, voffB); PG8_STAGE(PG8_SA(0, 0), pA, voffA); PG8_STAGE(PG8_SA(0, 1), pA + hstep, voffA);
        if (wr == 1) PG8_BAR;
        PG8_WAIT_V(2); PG8_BAR;
        PG8_STAGE(PG8_SB(1, 0), pB + kstep, voffB); PG8_STAGE(PG8_SA(1, 0), pA + kstep, voffA); PG8_STAGE(PG8_SB(1, 1), pB + hstep + kstep, voffB);
        PG8_WAIT_V(6); PG8_BAR;
    } else {
        PG8_STAGE(PG8_SB(0, 0), pB, voffB); PG8_STAGE(PG8_SA(0, 0), pA, voffA); PG8_STAGE(PG8_SB(0, 1), pB + hstep, voffB); PG8_STAGE(PG8_SA(0, 1), pA + hstep, voffA);
        if (wr == 1) PG8_BAR;
        PG8_WAIT_V(4); PG8_BAR;
        PG8_STAGE(PG8_SB(1, 0), pB + kstep, voffB); PG8_STAGE(PG8_SA(1, 0), pA + kstep, voffA); PG8_STAGE(PG8_SB(1, 1), pB + hstep + kstep, voffB);
        PG8_WAIT_V(6); PG8_BAR;
    }
    for (;;) {
        const bool has_next = S.next(ui + 1, nxt);
        const char* nA = has_next ? (const char*)g.A + (size_t)nxt.pm * tstep : cA; const char* nB = has_next ? (const char*)g.Bt + (size_t)nxt.pn * tstep : cB;
        for (int t = 0; t < nt; t += 2) {
            if constexpr (Epi::MID) { if (t != 0 && (t & (Epi::MID_TILES - 1)) == 0) E.mid(acc, cur, t / Epi::MID_TILES, wr, wc, fr, fq); }
            const bool last = (t == nt - 2);
            const char* a1 = cA + PG8_KT(t + 1) * kstep;
            const char* a2 = last ? nA + rofs : cA + PG8_KT(t + 2) * kstep; const char* b2 = last ? nB + rofs : cB + PG8_KT(t + 2) * kstep;
            const char* a3 = a2 + kstep; const char* b3 = b2 + kstep;
            if (last && has_next) S.a_ready(nxt);
            if constexpr (SP2) {
            PG8_LDB(B0, 0, 0); PG8_LDB(B1, 0, 1); PG8_SCHED; PG8_LDA(At, 0, 0); PG8_STAGE(PG8_SA(1, 1), a1 + hstep, voffA);
            PG8_WAIT_V(8); PG8_WAIT_L(0); PG8_BAR; PG8_MMA(0, 0, At, B0); PG8_MMA(0, 1, At, B1); PG8_BAR; PG8_SCHED;
            PG8_LDA(At, 0, 1); PG8_STAGE(PG8_SB(0, 0), b2, voffB); PG8_STAGE(PG8_SB(0, 1), b2 + hstep, voffB); PG8_STAGE(PG8_SA(0, 0), a2, voffA);
            PG8_WAIT_V(8); PG8_WAIT_L(0); PG8_BAR; PG8_MMA(1, 0, At, B0); PG8_MMA(1, 1, At, B1); PG8_BAR; PG8_SCHED;
            PG8_LDB(B0, 1, 0); PG8_LDB(B1, 1, 1); PG8_SCHED; PG8_LDA(At, 1, 0); PG8_STAGE(PG8_SA(0, 1), a2 + hstep, voffA);
            PG8_WAIT_V(8); PG8_WAIT_L(0); PG8_BAR; PG8_MMA(0, 0, At, B0); PG8_MMA(0, 1, At, B1); PG8_BAR; PG8_SCHED;
            PG8_LDA(At, 1, 1); PG8_STAGE(PG8_SB(1, 0), b3, voffB); PG8_STAGE(PG8_SB(1, 1), b3 + hstep, voffB); PG8_STAGE(PG8_SA(1, 0), a3, voffA);
            PG8_WAIT_V(8); PG8_WAIT_L(0); PG8_BAR; PG8_MMA(1, 0, At, B0); PG8_MMA(1, 1, At, B1); PG8_BAR; PG8_SCHED;
            } else {
            PG8_LDB(B0, 0, 0); PG8_SCHED; PG8_LDA(At, 0, 0); PG8_STAGE(PG8_SA(1, 1), a1 + hstep, voffA);
            PG8_WAIT_L(8); PG8_BAR; PG8_WAIT_L(0); PG8_MMA(0, 0, At, B0); PG8_BAR; PG8_SCHED;
            PG8_LDB(B1, 0, 1); PG8_STAGE(PG8_SB(0, 0), b2, voffB);
            PG8_BAR; PG8_WAIT_L(0); PG8_MMA(0, 1, At, B1); PG8_BAR;
            PG8_LDA(At, 0, 1); PG8_STAGE(PG8_SA(0, 0), a2, voffA);
            PG8_BAR; PG8_WAIT_L(0); PG8_MMA(1, 0, At, B0); PG8_BAR; PG8_SCHED;
            PG8_STAGE(PG8_SB(0, 1), b2 + hstep, voffB);
            PG8_WAIT_V(6); PG8_BAR; PG8_MMA(1, 1, At, B1); PG8_BAR;
            PG8_LDB(B0, 1, 0); PG8_SCHED; PG8_LDA(At, 1, 0); PG8_STAGE(PG8_SA(0, 1), a2 + hstep, voffA);
            PG8_WAIT_L(8); PG8_BAR; PG8_WAIT_L(0); PG8_MMA(0, 0, At, B0); PG8_BAR; PG8_SCHED;
            PG8_LDB(B1, 1, 1); PG8_STAGE(PG8_SB(1, 0), b3, voffB);
            PG8_BAR; PG8_WAIT_L(0); PG8_MMA(0, 1, At, B1); PG8_BAR;
            PG8_LDA(At, 1, 1); PG8_STAGE(PG8_SA(1, 0), a3, voffA);
            PG8_BAR; PG8_WAIT_L(0); PG8_MMA(1, 0, At, B0); PG8_BAR; PG8_SCHED;
            PG8_STAGE(PG8_SB(1, 1), b3 + hstep, voffB);
            PG8_WAIT_V(6); PG8_BAR; PG8_MMA(1, 1, At, B1); PG8_BAR;
            }
        }
        if constexpr (ALIGN_EPI) { if (wr == 0) PG8_BAR; }
        if constexpr (!Epi::AFTER_DRAIN) { E(acc, cur, wr, wc, fr, fq); S.done(cur); }
        if (!has_next) break;
#pragma unroll
        for (int a = 0; a < 2; ++a)
#pragma unroll
            for (int b = 0; b < 2; ++b)
#pragma unroll
                for (int m = 0; m < 4; ++m)
#pragma unroll
                    for (int n = 0; n < 2; ++n) acc[a][b][m][n] = (f32x4){0.f, 0.f, 0.f, 0.f};
        cur = nxt; cA = nA; cB = nB; ++ui;
        if constexpr (ALIGN_EPI) { if (wr == 1) PG8_BAR; }
    }
    PG8_WAIT_V(0);
    if constexpr (!ALIGN_EPI) { if (wr == 0) PG8_BAR; }
    PG8_BAR;
    if constexpr (Epi::AFTER_DRAIN) { E.fused(acc, cur, wr, wc, fr, fq, lds, wid, lane); S.done(cur); }
#undef PG8_KT
#undef PG8_SA
#undef PG8_SB
#undef PG8_STAGE
#undef PG8_LDA
#undef PG8_LDB
#undef PG8_MMA
#undef PG8_WAIT_V
#undef PG8_WAIT_L
#undef PG8_BAR
#undef PG8_SCHED
}
}

constexpr int NWAVES = 8;
constexpr int DM = 1024, BATCH = 16, SEQ = 4096, DEPTH = 4, MTOK = BATCH * SEQ;
constexpr int NCHUNK = 2, MC = MTOK / NCHUNK, BC = BATCH / NCHUNK;
constexpr int CIN = 5004, NPROJ = 5120, P1W = 2048, GWID = 3072;
constexpr int DFF = 2752, DFFP = 2816, NFF1 = 2 * DFFP;
constexpr int NEXP = 8, DFE = 3584, NMOE1 = 2 * DFE;
constexpr int SLOTS = MC + 2048;
constexpr float EPS = 1e-6f;
constexpr int C_U = 0, C_V = 256, C_SBQ = 512, C_SBK = 768, C_SBV = 1024, C_CQ = 1280, C_KCMP = 1536, C_VCMP = 1600, C_KSLC = 1664, C_VSLC = 1728, C_KWIN = 1792, C_VWIN = 1856, C_CG = 1920;

constexpr size_t MiB = 1u << 20;
constexpr size_t WS_CTL = 0, CTL_ZERO_BYTES = 1 * MiB;
constexpr size_t WS_ROPE = 1 * MiB;
constexpr size_t WS_BIAS1 = 1 * MiB + 512 * 1024;
constexpr size_t WS_WIN = 2 * MiB;
constexpr size_t WS_WBR = 12 * MiB;
constexpr size_t WS_WOUT = 14 * MiB;
constexpr size_t WS_WC1 = 16 * MiB;
constexpr size_t WS_WF1 = 18 * MiB;
constexpr size_t WS_WF2 = 130 * MiB;
constexpr size_t WS_HN = 186 * MiB;
constexpr size_t WS_SCR = 314 * MiB;
constexpr size_t WS_P1 = WS_SCR;
constexpr size_t WS_G = WS_P1 + 128 * MiB;
constexpr size_t WS_Y = WS_G + 192 * MiB;
constexpr size_t WS_MG = WS_Y + 48 * MiB;
constexpr size_t WS_KVC = WS_MG + 64 * MiB;
constexpr size_t WS_UL = WS_KVC + 8 * MiB;
constexpr size_t WS_KC = WS_UL + 8 * MiB;
constexpr size_t WS_VT = WS_KC + 1 * MiB;
constexpr size_t WS_KCT = WS_VT + 24 * MiB;
constexpr size_t WS_MIX_END = WS_KCT + 1 * MiB;
constexpr size_t WS_HID = WS_SCR;
constexpr size_t WS_ROUTE = WS_SCR;
constexpr size_t WS_TOKMAP = WS_SCR + 1 * MiB;
constexpr size_t WS_WSLOT = WS_SCR + 2 * MiB;
constexpr size_t WS_CNT128 = WS_SCR + 3 * MiB;
constexpr size_t WS_XG = WS_SCR + 4 * MiB;
constexpr size_t WS_HIDM = WS_XG + 68 * MiB;
constexpr size_t WS_END = 800 * MiB;
static_assert(WS_MIX_END <= WS_END && WS_HID + (size_t)MTOK * DFFP * 2 <= WS_END && WS_HIDM + (size_t)SLOTS * DFE * 2 <= WS_END, "d_ws map");
static_assert(WS_WF1 + (size_t)NEXP * NMOE1 * DM * 2 <= WS_WF2 && WS_WF2 + (size_t)NEXP * DM * DFE * 2 <= WS_HN, "weight map");
static_assert((size_t)4 * SLOTS * 4 <= 1 * MiB, "tokmap");
constexpr int CW_BAR = 4096;
constexpr int CW_CNT = 131072;
constexpr int CW_CUR = 131072 + 256;
constexpr int MAX_BAR_REGIONS = 32;
constexpr int RING_OFF = 0, RING_BYTES = 131072;
constexpr int LDSCTL_OFF = RING_BYTES, MISC_OFF = LDSCTL_OFF + 320;
constexpr int TAB_OFF = LDSCTL_OFF + 1024;
constexpr int LDS_BYTES = 147456;

#define GAS __attribute__((address_space(1)))
#define LAS __attribute__((address_space(3)))
typedef unsigned short bf16;
typedef unsigned v4u __attribute__((ext_vector_type(4)));
typedef unsigned v2u __attribute__((ext_vector_type(2)));
typedef float f32x4 __attribute__((ext_vector_type(4)));
typedef int v4i __attribute__((ext_vector_type(4)));
typedef __bf16 bf16x2_t __attribute__((ext_vector_type(2)));
#define LDS_WAIT() asm volatile("s_waitcnt lgkmcnt(0)" ::: "memory")
#define VM_WAIT() asm volatile("s_waitcnt vmcnt(0)" ::: "memory")
__device__ __forceinline__ unsigned f2bf(float f) { unsigned u = __builtin_bit_cast(unsigned, f); return (u + 0x7fffu + ((u >> 16) & 1u)) >> 16; }
__device__ __forceinline__ unsigned pk2(float lo, float hi) { return f2bf(lo) | (f2bf(hi) << 16); }
__device__ __forceinline__ float bflo(unsigned u) { return __builtin_bit_cast(float, u << 16); }
__device__ __forceinline__ float bfhi(unsigned u) { return __builtin_bit_cast(float, u & 0xffff0000u); }
__device__ __forceinline__ float bf1(bf16 h) { return __builtin_bit_cast(float, (unsigned)h << 16); }
__device__ __forceinline__ float dot2bf(unsigned a, unsigned b, float c) { return __builtin_amdgcn_fdot2_f32_bf16(__builtin_bit_cast(bf16x2_t, a), __builtin_bit_cast(bf16x2_t, b), c, false); }
#ifdef EMU_FP8
__device__ __forceinline__ float q8r(float x, float s) { const int p = __builtin_amdgcn_cvt_pk_fp8_f32(x * s, x * s, 0, false); return __builtin_amdgcn_cvt_f32_fp8(p, 0) * (1.0f / s); }
#else
__device__ __forceinline__ float q8r(float x, float) { return x; }
#endif
__device__ __forceinline__ float fexp(float x) { return __builtin_amdgcn_exp2f(1.4426950408889634f * x); }
template <int X> __device__ __forceinline__ float swz_xor(float v) { return __builtin_bit_cast(float, __builtin_amdgcn_ds_swizzle(__builtin_bit_cast(int, v), (X << 10) | 0x1f)); }
__device__ __forceinline__ float wave_sum(float v, int lane) {
#pragma unroll
    for (int o = 1; o < 64; o <<= 1) v += __builtin_bit_cast(float, __builtin_amdgcn_ds_bpermute((lane ^ o) << 2, __builtin_bit_cast(int, v)));
    return v;
}
__device__ __forceinline__ float rdlane(float v, int l) { return __builtin_bit_cast(float, __builtin_amdgcn_readlane(__builtin_bit_cast(int, v), l)); }
__device__ __forceinline__ int bperm(int srclane, int v) { return __builtin_amdgcn_ds_bpermute(srclane << 2, v); }
__constant__ double ROPE_INVF[8] = {1.0, 0.19392274474868576, 0.037606030930863933, 0.0072926647372171093, 0.0014142135623730950, 0.00027424817567620730, 5.3182958969449883e-05, 1.0313385377212460e-05};
#define XB_TMO      128
#define XB_XCNT(j)  (256  + 64 * (j))
#define XB_XSUB(j)  (1280 + 64 * (j))
#define XB_XGEN(j)  (2304 + 64 * (j))
#define XB_TOP      3328
#define XB_TOPGEN   3392
#define XCD_BAR_WORDS 3456
#define XB_SPIN_CAP (1u << 18)

__device__ __forceinline__ unsigned xb_ld(unsigned* p)              { return __hip_atomic_load(p, __ATOMIC_RELAXED, __HIP_MEMORY_SCOPE_AGENT); }
__device__ __forceinline__ unsigned xb_add(unsigned* p, unsigned v) { return __hip_atomic_fetch_add(p, v, __ATOMIC_RELAXED, __HIP_MEMORY_SCOPE_AGENT); }
__device__ __forceinline__ unsigned xb_xcc_id() { return (unsigned)__builtin_amdgcn_s_getreg((3 << 11) | 20) & 0xFu; }
#define XB_SPIN(cond, bar) do { unsigned _sp = 0; while (cond) { __builtin_amdgcn_s_sleep(1); \
    if ((++_sp & 255u) == 0u) { if (xb_ld(&(bar)[XB_TMO])) break; if (_sp > XB_SPIN_CAP) { atomicAdd(&(bar)[XB_TMO], 1u); break; } } } } while (0)

__device__ __forceinline__ bool xb_thread0_w(unsigned w, unsigned z) { return w == 0u && __builtin_amdgcn_mbcnt_hi(~0u, __builtin_amdgcn_mbcnt_lo(~0u, z)) == 0u; }
struct XcdBarrier {
    unsigned* bar; unsigned x; unsigned w, z;
    volatile LAS unsigned* st;
};

__device__ __forceinline__ XcdBarrier xcd_barrier_post(unsigned* bar, volatile LAS unsigned* st) {
    XcdBarrier b; b.bar = bar; b.x = xb_xcc_id(); b.st = st; b.w = (unsigned)__builtin_amdgcn_readfirstlane((int)(threadIdx.x >> 6)); b.z = 0u;
    if (xb_thread0_w(b.w, b.z)) (void)xb_add(&bar[XB_XCNT(b.x)], 1u);
    return b;
}
__device__ __forceinline__ void xcd_barrier_complete(unsigned* bar, unsigned x, unsigned& nloc, unsigned& nx) {
    const unsigned G = gridDim.x * gridDim.y * gridDim.z;
    unsigned sum, cnt, mine, sp = 0u;
    for (;;) {
        sum = 0u; cnt = 0u; mine = 0u;
#pragma unroll
        for (unsigned j = 0; j < 16; ++j) { const unsigned c = xb_ld(&bar[XB_XCNT(j)]); sum += c; cnt += (c > 0u) ? 1u : 0u; mine = (j == x) ? c : mine; }
        if (sum == G) break;
        __builtin_amdgcn_s_sleep(1);
        if ((++sp & 255u) == 0u) { if (xb_ld(&bar[XB_TMO])) break; if (sp > XB_SPIN_CAP) { atomicAdd(&bar[XB_TMO], 1u); break; } }
    }
    nloc = mine > 0u ? mine : 1u; nx = cnt > 0u ? cnt : 1u;
}

__device__ __forceinline__ void xcd_barrier(const XcdBarrier& b) {
    asm volatile("s_waitcnt vmcnt(0)" ::: "memory");
    __syncthreads();
    if (xb_thread0_w(b.w, b.z)) {
        unsigned* bar = b.bar;
        __builtin_amdgcn_s_waitcnt(0);
        unsigned nloc = b.st[0], nx = b.st[1];
        if (nloc == 0u) { xcd_barrier_complete(bar, b.x, nloc, nx); b.st[0] = nloc; b.st[1] = nx; }
        const unsigned old = xb_add(&bar[XB_XSUB(b.x)], 1u);
        const unsigned gen = old / nloc;
        if (old + 1u == (gen + 1u) * nloc) {
            __builtin_amdgcn_fence(__ATOMIC_RELEASE, "agent");
            asm volatile("s_waitcnt vmcnt(0)" ::: "memory");
            const unsigned og = xb_add(&bar[XB_TOP], 1u);
            const unsigned tg = og / nx;
            if (og + 1u == (tg + 1u) * nx) xb_add(&bar[XB_TOPGEN], 1u);
            else XB_SPIN(xb_ld(&bar[XB_TOPGEN]) == tg, bar);
            __builtin_amdgcn_fence(__ATOMIC_ACQUIRE, "agent");
            xb_add(&bar[XB_XGEN(b.x)], 1u);
            asm volatile("s_waitcnt vmcnt(0)" ::: "memory");
        } else {
            XB_SPIN(xb_ld(&bar[XB_XGEN(b.x)]) == gen, bar);
            __builtin_amdgcn_fence(__ATOMIC_ACQUIRE, "agent");
            asm volatile("s_waitcnt vmcnt(0)" ::: "memory");
        }
    }
    __syncthreads();
}

struct Frame {
    LAS unsigned char* lds;
    unsigned* ctl;
    int tid, lane, wave, vcu, G, bx, zv, zs, rep;
    unsigned char* ws;
    const float* const* in;
    float* out;
};
#define WSP(T, off) ((T*)(F.ws + (off)))
__device__ __forceinline__ size_t toff(int row, int k, int K) { return (size_t)(row >> 8) * 256 * K + (size_t)(k >> 6) * (256 * 64) + (size_t)(row & 255) * 64 + (k & 63); }

#ifndef TILED_FFN1
#define TILED_FFN1 0
#endif
#ifndef Q8_W1
#define Q8_W1 0.f
#define Q8_W2 0.f
#define Q8_HN 0.f
#define Q8_HID 0.f
#endif
__device__ __forceinline__ int map_row(int kind, int off, int n) { return kind == 0 ? n + off : (kind == 1 ? (n < 1932 ? n : n + 116) : ((n >> 7) * 256 + (n & 127) + off)); }
__device__ __forceinline__ void tr_item(const float* W, int ldw, int N, int ks, int n0, bf16* WT, int ldt, int kd, int kind, int off, LAS unsigned char* scr, int lane, float q8s = 0.f, int tiled = 0) {
    const int nq = (lane & 15) * 4, kq = lane >> 4;
    f32x4 x[16];
#pragma unroll
    for (int i = 0; i < 16; ++i) x[i] = (n0 + nq < N) ? *(const f32x4*)(W + (size_t)(ks + 4 * i + kq) * ldw + n0 + nq) : (f32x4){0.f, 0.f, 0.f, 0.f};
#pragma unroll
    for (int i = 0; i < 16; ++i) { const int k = 4 * i + kq;
#pragma unroll
        for (int c = 0; c < 4; ++c) { float wv = x[i][c]; if (q8s > 0.f) wv = q8r(wv, q8s); *(LAS bf16*)(scr + (nq + c) * 136 + k * 2) = (bf16)f2bf(wv); } }
    LDS_WAIT(); asm volatile("" ::: "memory");
    if (n0 + lane < N) { const LAS v2u* s = (const LAS v2u*)(scr + lane * 136); const int mr = map_row(kind, off, n0 + lane); bf16* dst = tiled ? WT + toff(mr, kd, ldt) : WT + (size_t)mr * ldt + kd;
#pragma unroll
        for (int q = 0; q < 8; ++q) { const v2u a = s[2 * q], b = s[2 * q + 1]; *(v4u*)(dst + 8 * q) = (v4u){a.x, a.y, b.x, b.y}; } }
    LDS_WAIT(); asm volatile("" ::: "memory");
}
__device__ __forceinline__ void conv(Frame& F, const float* W, size_t sW, int nb, int ldw, int N, int ks0, int K, bf16* WT, size_t sWT, int ldt, int kd0, int kind, int off, float q8s = 0.f, int tiled = 0) {
    LAS unsigned char* scr = F.lds + RING_OFF + F.wave * 16384;
    const int gw = F.vcu * NWAVES + F.wave, NGW = F.G * NWAVES;
    const int nblk = (N + 63) / 64, per = (K / 64) * nblk, total = per * nb;
    for (int it = gw; it < total; it += NGW) { const int b = it / per, r = it % per, kb = r / nblk, nbk = r % nblk;
        tr_item(W + (size_t)b * sW, ldw, N, ks0 + 64 * kb, 64 * nbk, WT + (size_t)b * sWT, ldt, kd0 + 64 * kb, kind, off, scr, F.lane, q8s, tiled); }
}
__device__ __forceinline__ void zero_block(Frame& F, bf16* WT, int ldt, int r0, int rows, int c0, int cols, int tiled = 0) {
    const int gt = (F.vcu * NWAVES + F.wave) * 64 + F.lane, NT = F.G * NWAVES * 64, cpr = cols / 8;
    for (int i = gt; i < rows * cpr; i += NT) { const int r = i / cpr, c = i % cpr; const unsigned z = (unsigned)F.zv; *(v4u*)(tiled ? WT + toff(r0 + r, c0 + 8 * c, ldt) : WT + (size_t)(r0 + r) * ldt + c0 + 8 * c) = (v4u){z, z, z, z}; }
}
__device__ __forceinline__ void p_convert(Frame& F, int layer) {
    const int j = layer >> 1;
    conv(F, F.in[2] + (size_t)layer * DM * CIN, 0, 1, CIN, CIN, 0, DM, WSP(bf16, WS_WIN), 0, DM, 0, 1, 0);
    zero_block(F, WSP(bf16, WS_WIN), DM, 1932, 116, 0, DM);
    conv(F, F.in[9] + (size_t)layer * 3 * 256 * DM, (size_t)256 * DM, 3, DM, DM, 0, 256, WSP(bf16, WS_WBR), (size_t)DM * 256, 256, 0, 0, 0);
    conv(F, F.in[10] + (size_t)layer * DM * DM, 0, 1, DM, DM, 0, DM, WSP(bf16, WS_WOUT), 0, DM, 0, 0, 0);
    conv(F, F.in[7] + (size_t)layer * 2 * 2048 * 256, (size_t)2048 * 256, 2, 256, 256, 0, 1024, WSP(bf16, WS_WC1), (size_t)512 * 1024, 1024, 0, 0, 0);
    conv(F, F.in[7] + (size_t)layer * 2 * 2048 * 256, (size_t)2048 * 256, 2, 256, 256, 1024, 1024, WSP(bf16, WS_WC1), (size_t)512 * 1024, 1024, 0, 0, 256);
    if ((layer & 1) == 0) {
        conv(F, F.in[12] + (size_t)j * DM * DFF, 0, 1, DFF, DFF, 0, DM, WSP(bf16, WS_WF1), 0, DM, 0, 2, 0, Q8_W1, TILED_FFN1);
        conv(F, F.in[13] + (size_t)j * DM * DFF, 0, 1, DFF, DFF, 0, DM, WSP(bf16, WS_WF1), 0, DM, 0, 2, 128, Q8_W1, TILED_FFN1);
        zero_block(F, WSP(bf16, WS_WF1), DM, 21 * 256 + 64, 64, 0, DM, TILED_FFN1);
        zero_block(F, WSP(bf16, WS_WF1), DM, 21 * 256 + 128 + 64, 64, 0, DM, TILED_FFN1);
        conv(F, F.in[14] + (size_t)j * DFF * DM, 0, 1, DM, DM, 0, DFF, WSP(bf16, WS_WF2), 0, DFFP, 0, 0, 0, Q8_W2);
        zero_block(F, WSP(bf16, WS_WF2), DFFP, 0, DM, DFF, DFFP - DFF);
    } else {
        conv(F, F.in[16] + (size_t)j * NEXP * DM * DFE, (size_t)DM * DFE, NEXP, DFE, DFE, 0, DM, WSP(bf16, WS_WF1), (size_t)NMOE1 * DM, DM, 0, 2, 0, Q8_W1);
        conv(F, F.in[17] + (size_t)j * NEXP * DM * DFE, (size_t)DM * DFE, NEXP, DFE, DFE, 0, DM, WSP(bf16, WS_WF1), (size_t)NMOE1 * DM, DM, 0, 2, 128, Q8_W1);
        conv(F, F.in[18] + (size_t)j * NEXP * DFE * DM, (size_t)DFE * DM, NEXP, DM, DM, 0, DFE, WSP(bf16, WS_WF2), (size_t)DM * DFE, DFE, 0, 0, 0, Q8_W2);
    }
    if (F.bx < 8) {
        __syncthreads();
        const int kv = F.bx >> 2, jj = (F.bx & 3) * 64 + F.lane;
        const float* pos = F.in[6] + (size_t)(layer * 2 + kv) * 2048; const float* w1 = F.in[7] + (size_t)(layer * 2 + kv) * 2048 * 256;
        float a = 0.f;
        float a1 = 0.f, a2 = 0.f, a3 = 0.f;
#pragma unroll 8
        for (int k = 0; k < 256; k += 4) { const int kk = F.wave * 256 + k;
            a += pos[kk] * w1[(size_t)kk * 256 + jj]; a1 += pos[kk + 1] * w1[(size_t)(kk + 1) * 256 + jj]; a2 += pos[kk + 2] * w1[(size_t)(kk + 2) * 256 + jj]; a3 += pos[kk + 3] * w1[(size_t)(kk + 3) * 256 + jj]; }
        a = (a + a1) + (a2 + a3);
        LAS float* red = (LAS float*)(F.lds + RING_OFF);
        red[F.wave * 64 + F.lane] = a;
        __syncthreads();
        if (F.wave == 0) { float s = 0.f;
#pragma unroll
            for (int w = 0; w < 8; ++w) s += red[w * 64 + F.lane];
            WSP(float, WS_BIAS1)[kv * 256 + jj] = s; }
        __syncthreads();
    }
    if (layer == 0) {
        const int gt = (F.vcu * NWAVES + F.wave) * 64 + F.lane, NT = F.G * NWAVES * 64;
        for (int idx = gt; idx < SEQ * 8; idx += NT) { const int pos = idx >> 3, i = idx & 7;
            const double invf = ROPE_INVF[i];
            double rev = (double)pos * invf * 0.15915494309189535; rev -= __builtin_floor(rev);
            WSP(float, WS_ROPE)[idx] = __builtin_amdgcn_cosf((float)rev); WSP(float, WS_ROPE)[SEQ * 8 + idx] = __builtin_amdgcn_sinf((float)rev); }
    }
}

template <int MODE> __device__ __forceinline__ void p_norm(Frame& F, const float* src, const float* g, const float* rw, int jmoe, float q8s = 0.f, int tiled = 0) {
    const int gw = F.vcu * NWAVES + F.wave, NGW = F.G * NWAVES, lane = F.lane;
    LAS int* hist = (LAS int*)(F.lds + TAB_OFF) + 192;
    if (MODE == 1) {
        if (F.tid < 16) hist[F.tid] = 0;
        const int gt = gw * 64 + lane, NT = NGW * 64; int* tm = WSP(int, WS_TOKMAP);
        for (int i = gt; i < 4 * SLOTS; i += NT) tm[i] = -1;
        for (int i = F.tid; i < DM * NEXP / 4; i += NWAVES * 64) *(LAS f32x4*)(F.lds + RING_OFF + 16 * i) = ((const f32x4*)rw)[i];
        __syncthreads();
    }
    f32x4 gv[4];
#pragma unroll
    for (int jx = 0; jx < 4; ++jx) gv[jx] = ((const f32x4*)g)[lane + 64 * jx];
    constexpr int ROWS = (MODE == 1) ? 2 : 4;
    const int nit = (MODE == 1) ? ((MTOK / 128 - F.bx + F.G - 1) / F.G) * (16 / ROWS) : (MTOK - gw + ROWS * NGW - 1) / (ROWS * NGW);
    for (int itx = 0; itx < nit; ++itx) {
        const int chk = (MODE == 1) ? F.bx + (itx / (16 / ROWS)) * F.G : 0;
        const int m0 = (MODE == 1) ? chk * 128 + F.wave * 16 + (itx % (16 / ROWS)) * ROWS : gw + itx * ROWS * NGW;
        const int mstep = (MODE == 1) ? 1 : NGW;
        f32x4 v[ROWS][4]; float ss[ROWS];
#pragma unroll
        for (int u = 0; u < ROWS; ++u) { const int m = m0 + u * mstep; const f32x4* xr = (const f32x4*)(src + (size_t)(m < MTOK ? m : m0) * DM) + lane;
#pragma unroll
            for (int jx = 0; jx < 4; ++jx) v[u][jx] = xr[64 * jx]; }
#pragma unroll
        for (int u = 0; u < ROWS; ++u) { float s = 0.f;
#pragma unroll
            for (int jx = 0; jx < 4; ++jx) s += (v[u][jx].x * v[u][jx].x + v[u][jx].y * v[u][jx].y) + (v[u][jx].z * v[u][jx].z + v[u][jx].w * v[u][jx].w);
            ss[u] = s; }
#pragma unroll
        for (int o = 1; o < 64; o <<= 1) {
#pragma unroll
            for (int u = 0; u < ROWS; ++u) ss[u] += __builtin_bit_cast(float, __builtin_amdgcn_ds_bpermute((lane ^ o) << 2, __builtin_bit_cast(int, ss[u]))); }
        float lgall[MODE == 1 ? ROWS : 1][8];
        if (MODE == 1) {
            float rs[ROWS];
#pragma unroll
            for (int u = 0; u < ROWS; ++u) { rs[u] = 1.0f / sqrtf(ss[u] * (1.f / DM) + EPS);
#pragma unroll
                for (int e = 0; e < 8; ++e) lgall[u][e] = 0.f; }
#pragma unroll
            for (int jx = 0; jx < 4; ++jx) { const LAS f32x4* wr = (const LAS f32x4*)(F.lds + RING_OFF + (size_t)(4 * lane + 256 * jx) * 32);
#pragma unroll
                for (int r = 0; r < 4; ++r) { const f32x4 a = wr[2 * r], b = wr[2 * r + 1];
#pragma unroll
                    for (int u = 0; u < ROWS; ++u) { const float xv = v[u][jx][r] * rs[u] * gv[jx][r];
                        lgall[u][0] += xv * a.x; lgall[u][1] += xv * a.y; lgall[u][2] += xv * a.z; lgall[u][3] += xv * a.w; lgall[u][4] += xv * b.x; lgall[u][5] += xv * b.y; lgall[u][6] += xv * b.z; lgall[u][7] += xv * b.w; } } }
        }
#pragma unroll
        for (int u = 0; u < ROWS; ++u) { const int m = m0 + u * mstep; if (m >= MTOK) continue;
            const float rstd = 1.0f / sqrtf(ss[u] * (1.f / DM) + EPS);
#pragma unroll
            for (int jx = 0; jx < 4; ++jx) v[u][jx] = v[u][jx] * rstd * gv[jx];
            if (MODE == 2) {
                f32x4* o = (f32x4*)(F.out + (size_t)m * DM) + lane;
#pragma unroll
                for (int jx = 0; jx < 4; ++jx) o[64 * jx] = v[u][jx];
            } else {
                unsigned long long* o8 = (unsigned long long*)(WSP(bf16, WS_HN) + (size_t)m * DM) + lane;
#pragma unroll
                for (int jx = 0; jx < 4; ++jx) { f32x4 w = v[u][jx];
                    if (tiled) { *(unsigned long long*)(WSP(bf16, WS_HN) + toff(m, 4 * lane + 256 * jx, DM)) = (unsigned long long)pk2(w.x, w.y) | ((unsigned long long)pk2(w.z, w.w) << 32); continue; } if (q8s > 0.f) { w.x = q8r(w.x, q8s); w.y = q8r(w.y, q8s); w.z = q8r(w.z, q8s); w.w = q8r(w.w, q8s); }
                    o8[64 * jx] = (unsigned long long)pk2(w.x, w.y) | ((unsigned long long)pk2(w.z, w.w) << 32); }
            }
            if (MODE == 1) {
                float lg[8];
#pragma unroll
                for (int e = 0; e < 8; ++e) lg[e] = lgall[u][e];
                float h4[4], h2[2], h1;
                { const bool up = lane & 1;
#pragma unroll
                  for (int i = 0; i < 4; ++i) { const float keep = up ? lg[4 + i] : lg[i], send = up ? lg[i] : lg[4 + i]; h4[i] = keep + __builtin_bit_cast(float, bperm(lane ^ 1, __builtin_bit_cast(int, send))); } }
                { const bool up = lane & 2;
#pragma unroll
                  for (int i = 0; i < 2; ++i) { const float keep = up ? h4[2 + i] : h4[i], send = up ? h4[i] : h4[2 + i]; h2[i] = keep + __builtin_bit_cast(float, bperm(lane ^ 2, __builtin_bit_cast(int, send))); } }
                { const bool up = lane & 4; const float keep = up ? h2[1] : h2[0], send = up ? h2[0] : h2[1]; h1 = keep + __builtin_bit_cast(float, bperm(lane ^ 4, __builtin_bit_cast(int, send))); }
                h1 += __builtin_bit_cast(float, bperm(lane ^ 8, __builtin_bit_cast(int, h1))); h1 += __builtin_bit_cast(float, bperm(lane ^ 16, __builtin_bit_cast(int, h1))); h1 += __builtin_bit_cast(float, bperm(lane ^ 32, __builtin_bit_cast(int, h1)));
                lg[0] = rdlane(h1, 0); lg[1] = rdlane(h1, 4); lg[2] = rdlane(h1, 2); lg[3] = rdlane(h1, 6); lg[4] = rdlane(h1, 1); lg[5] = rdlane(h1, 5); lg[6] = rdlane(h1, 3); lg[7] = rdlane(h1, 7);
                int e0 = 0; float v0 = lg[0];
#pragma unroll
                for (int e = 1; e < 8; ++e) if (lg[e] > v0) { v0 = lg[e]; e0 = e; }
                int e1 = -1; float v1 = -INFINITY;
#pragma unroll
                for (int e = 0; e < 8; ++e) if (e != e0 && lg[e] > v1) { v1 = lg[e]; e1 = e; }
                const float w0 = 1.0f / (1.0f + fexp(v1 - v0)), w1 = 1.0f - w0;
                if (lane == 0) { WSP(v4i, WS_ROUTE)[m] = (v4i){e0, e1, __builtin_bit_cast(int, w0), __builtin_bit_cast(int, w1)};
                    __hip_atomic_fetch_add(&hist[e0], 1, __ATOMIC_RELAXED, __HIP_MEMORY_SCOPE_WORKGROUP); __hip_atomic_fetch_add(&hist[8 + e1], 1, __ATOMIC_RELAXED, __HIP_MEMORY_SCOPE_WORKGROUP); }
            }
        }
        if (MODE == 1 && (itx % (16 / ROWS)) == 16 / ROWS - 1) {
            __syncthreads();
            if (F.tid < 16) { WSP(int, WS_CNT128)[(size_t)chk * 16 + F.tid] = hist[F.tid]; hist[F.tid] = 0; }
            __syncthreads();
        }
    }
}

__device__ __forceinline__ void p_prep(Frame& F) {
    const int gw = F.vcu * NWAVES + F.wave, NGW = F.G * NWAVES, lane = F.lane;
    bf16* P1 = WSP(bf16, WS_P1); bf16* KVC = WSP(bf16, WS_KVC); const float* rope = WSP(float, WS_ROPE);
    const int vec = lane >> 3, ri = lane & 7; const int cb = vec < 4 ? C_CQ + vec * 64 : (vec == 4 ? C_KCMP : (vec == 5 ? C_KSLC : C_KWIN));
    for (int row0 = gw; row0 < MC; row0 += 4 * NGW) {
        float x1[4], x2[4], cc[4], ss[4]; bf16 kc48[4], vc64[4];
#pragma unroll
        for (int k = 0; k < 4; ++k) { const int row = row0 + k * NGW < MC ? row0 + k * NGW : row0; const bf16* p = P1 + (size_t)row * P1W; const int pos = row & (SEQ - 1);
            const int cl = lane < 56 ? cb + ri : C_CQ;
            x1[k] = bf1(p[cl]); x2[k] = bf1(p[cl + 8]); cc[k] = rope[pos * 8 + ri]; ss[k] = rope[SEQ * 8 + pos * 8 + ri];
            if (F.rep) { cc[k] = 1.f; ss[k] = 0.f; }
            kc48[k] = p[C_KCMP + 16 + (lane < 48 ? lane : 0)]; vc64[k] = p[C_VCMP + lane]; }
#pragma unroll
        for (int k = 0; k < 4; ++k) { const int row = row0 + k * NGW; if (row >= MC) continue; bf16* p = P1 + (size_t)row * P1W;
            if (lane < 56) { const bf16 o1 = (bf16)f2bf(x1[k] * cc[k] - x2[k] * ss[k]), o2 = (bf16)f2bf(x2[k] * cc[k] + x1[k] * ss[k]);
                p[cb + ri] = o1; p[cb + ri + 8] = o2;
                if (vec == 4) { KVC[(size_t)row * 64 + ri] = o1; KVC[(size_t)row * 64 + ri + 8] = o2; } }
            if (lane < 48) KVC[(size_t)row * 64 + 16 + lane] = kc48[k];
            KVC[(size_t)MC * 64 + (size_t)row * 64 + lane] = vc64[k]; }
    }
    bf16* VT = WSP(bf16, WS_VT);
    for (int it = gw; it < 6 * BC * 64; it += NGW) { const int which = it / (BC * 64), r = it % (BC * 64), b = r >> 6, blk = r & 63;
        const v4u* src = (const v4u*)(P1 + ((size_t)b * SEQ + blk * 64 + lane) * P1W + (which == 0 ? C_VSLC : (which == 1 ? C_VWIN : C_SBV + (which - 2) * 64)));
        bf16* dst = VT + ((size_t)(which * BC + b) * 64) * SEQ + blk * 64 + lane;
        v4u xs[8];
#pragma unroll
        for (int i = 0; i < 8; ++i) xs[i] = src[i];
#pragma unroll
        for (int i = 0; i < 8; ++i) { const v4u x = xs[i];
            dst[(size_t)(8 * i + 0) * SEQ] = (bf16)(x.x & 0xffffu); dst[(size_t)(8 * i + 1) * SEQ] = (bf16)(x.x >> 16);
            dst[(size_t)(8 * i + 2) * SEQ] = (bf16)(x.y & 0xffffu); dst[(size_t)(8 * i + 3) * SEQ] = (bf16)(x.y >> 16);
            dst[(size_t)(8 * i + 4) * SEQ] = (bf16)(x.z & 0xffffu); dst[(size_t)(8 * i + 5) * SEQ] = (bf16)(x.z >> 16);
            dst[(size_t)(8 * i + 6) * SEQ] = (bf16)(x.w & 0xffffu); dst[(size_t)(8 * i + 7) * SEQ] = (bf16)(x.w >> 16); }
    }
}
__device__ __forceinline__ void p_sgu(Frame& F, int layer) {
    LAS float* vn = (LAS float*)(F.lds + RING_OFF);
    const bf16* P1 = WSP(bf16, WS_P1); bf16* Ya = WSP(bf16, WS_Y);
    const float* gain = F.in[3] + (size_t)layer * 256; const float* sw = F.in[4] + (size_t)layer * 4 * 128 * 128; const float* sb = F.in[5] + (size_t)layer * 4 * 128;
    const int lane = F.lane, wave = F.wave;
    for (int item = F.vcu; item < MC / 128; item += F.G) {
        const size_t r0 = (size_t)item * 128;
        __syncthreads();
        for (int rr = 0; rr < 16; ++rr) { const int r = wave * 16 + rr; const v2u raw = *(const v2u*)(P1 + (r0 + r) * P1W + C_V + 4 * lane);
            const float a = bflo(raw.x), b = bfhi(raw.x), c = bflo(raw.y), d = bfhi(raw.y);
            const float rstd = 1.0f / sqrtf(wave_sum((a * a + b * b) + (c * c + d * d), lane) * (1.f / 256.f) + EPS);
            const f32x4 gg = ((const f32x4*)gain)[lane];
            *(LAS f32x4*)(vn + r * 256 + 4 * lane) = (f32x4){a * rstd * gg.x, b * rstd * gg.y, c * rstd * gg.z, d * rstd * gg.w}; }
        __syncthreads();
        const int g = wave & 3, half = wave >> 2;
        for (int i = 0; i < 64; ++i) { const int t = 2 * i + half;
            const float* wrow = sw + ((size_t)g * 128 + t) * 128;
            const float w_lo = wrow[lane], w_hi = wrow[64 + lane];
            float acc = 0.f;
            for (int s = 0; s <= t; ++s) { const float w = (s < 64) ? rdlane(w_lo, s) : rdlane(w_hi, s - 64); acc += w * vn[s * 256 + g * 64 + lane]; }
            const float u = bf1(P1[(r0 + t) * P1W + C_U + g * 64 + lane]);
#ifdef ABL_SGUMIX
            acc = 0.f;
#endif
            Ya[(r0 + t) * 256 + g * 64 + lane] = (bf16)f2bf(u * (acc + sb[g * 128 + t])); }
    }
    __syncthreads();
}

__device__ __forceinline__ void p_cmpfin(Frame& F, int layer) {
    const int gw = F.vcu * NWAVES + F.wave, NGW = F.G * NWAVES, lane = F.lane;
    const float* UL = WSP(float, WS_UL); const float* bias = WSP(float, WS_BIAS1); bf16* KC = WSP(bf16, WS_KC);
    LAS float* w2l = (LAS float*)(F.lds + RING_OFF);
    __syncthreads();
    { const f32x4* src = (const f32x4*)(F.in[8] + (size_t)layer * 2 * 256 * 64);
#pragma unroll 4
      for (int i = F.tid; i < 2 * 256 * 64 / 4; i += NWAVES * 64) *(LAS f32x4*)(w2l + 4 * i) = src[i]; }
    __syncthreads();
    for (int it = gw; it < 2 * BC * 255; it += NGW) { const int kv = it / (BC * 255), r = it % (BC * 255), b = r / 255, m = r % 255;
        const LAS float* w2 = w2l + kv * 256 * 64;
        const float* U = UL + (size_t)(kv * 2048 + b * 256 + m) * 512; const float* L = U + 512 + 256;
        float hv[4];
#pragma unroll
        for (int q = 0; q < 4; ++q) hv[q] = pg8::gelu_tanh(U[64 * q + lane] + L[64 * q + lane] + bias[kv * 256 + 64 * q + lane]);
        float acc0 = 0.f, acc1 = 0.f;
#pragma unroll
        for (int q = 0; q < 4; ++q)
#pragma unroll 8
            for (int jj = 0; jj < 64; jj += 2) { acc0 += rdlane(hv[q], jj) * w2[(64 * q + jj) * 64 + lane]; acc1 += rdlane(hv[q], jj + 1) * w2[(64 * q + jj + 1) * 64 + lane]; }
        const float acc = acc0 + acc1;
        KC[((size_t)(kv * BC + b) * 256 + m) * 64 + lane] = (bf16)f2bf(acc);
        if (kv == 1) { WSP(bf16, WS_KCT)[((size_t)b * 64 + lane) * 256 + m] = (bf16)f2bf(acc); if (m == 254) WSP(bf16, WS_KCT)[((size_t)b * 64 + lane) * 256 + 255] = (bf16)0; }
        else if (m == 254) KC[((size_t)b * 256 + 255) * 64 + lane] = (bf16)0; }
    __syncthreads();
}

__device__ __forceinline__ void p_stick(Frame& F) {
    const int gw = F.vcu * NWAVES + F.wave, NGW = F.G * NWAVES, lane = F.lane;
    const bf16* P1 = WSP(bf16, WS_P1); bf16* Yb = WSP(bf16, WS_Y) + (size_t)MC * 256;
    for (int item = gw; item < BC * 4 * 64; item += NGW) { const int tb = item & 63, h = (item >> 6) & 3, b = item >> 8;
        const int t = tb * 64 + lane; const size_t row = (size_t)b * SEQ + t;
        unsigned q[32];
        { const v4u* qp = (const v4u*)(P1 + row * P1W + C_SBQ + h * 64);
#pragma unroll
          for (int i = 0; i < 8; ++i) { const v4u x = qp[i]; q[4 * i] = x.x; q[4 * i + 1] = x.y; q[4 * i + 2] = x.z; q[4 * i + 3] = x.w; } }
        float o[64];
#pragma unroll
        for (int d = 0; d < 64; ++d) o[d] = 0.f;
        float R = 0.f;
        const bf16* kb = P1 + (size_t)b * SEQ * P1W + C_SBK + h * 64; const bf16* vb = P1 + (size_t)b * SEQ * P1W + C_SBV + h * 64;
        for (int s = t - 1; s >= 0; --s) {
            if (R < -100.f) break;
            const v4u* kp = (const v4u*)(kb + (size_t)s * P1W); const v4u* vp = (const v4u*)(vb + (size_t)s * P1W);
            float z0 = 0.f, z1 = 0.f;
#pragma unroll
            for (int i = 0; i < 8; ++i) { const v4u k = kp[i]; z0 = dot2bf(k.x, q[4 * i], z0); z1 = dot2bf(k.y, q[4 * i + 1], z1); z0 = dot2bf(k.z, q[4 * i + 2], z0); z1 = dot2bf(k.w, q[4 * i + 3], z1); }
            const float z = (z0 + z1) * 0.125f;
            const float tt = 0.6931471805599453f * __builtin_amdgcn_logf(1.0f + fexp(-__builtin_fabsf(z)));
            const float lb = fminf(z, 0.f) - tt, l1m = fminf(-z, 0.f) - tt;
            const float a = fexp(lb + R); R += l1m;
#pragma unroll
            for (int i = 0; i < 8; ++i) { const v4u v = vp[i];
                o[8 * i] += a * bflo(v.x); o[8 * i + 1] += a * bfhi(v.x); o[8 * i + 2] += a * bflo(v.y); o[8 * i + 3] += a * bfhi(v.y);
                o[8 * i + 4] += a * bflo(v.z); o[8 * i + 5] += a * bfhi(v.z); o[8 * i + 6] += a * bflo(v.w); o[8 * i + 7] += a * bfhi(v.w); }
        }
        v4u* op = (v4u*)(Yb + row * 256 + h * 64);
#pragma unroll
        for (int i = 0; i < 8; ++i) op[i] = (v4u){pk2(o[8 * i], o[8 * i + 1]), pk2(o[8 * i + 2], o[8 * i + 3]), pk2(o[8 * i + 4], o[8 * i + 5]), pk2(o[8 * i + 6], o[8 * i + 7])};
    }
}

struct Soft { float mx, l; };
__device__ __forceinline__ float dotq(const LAS v4u* ql, const bf16* kp_) {
    const v4u* kp = (const v4u*)kp_; float z0 = 0.f, z1 = 0.f;
#pragma unroll
    for (int i = 0; i < 8; ++i) { const v4u k = kp[i]; const v4u q = ql[i]; z0 = dot2bf(k.x, q.x, z0); z1 = dot2bf(k.y, q.y, z1); z0 = dot2bf(k.z, q.z, z0); z1 = dot2bf(k.w, q.w, z1); }
    return (z0 + z1) * 0.125f;
}
__device__ __forceinline__ void axpy_row(float p, const bf16* vp_, float (&o)[64]) {
    const v4u* vp = (const v4u*)vp_;
#pragma unroll
    for (int i = 0; i < 8; ++i) { const v4u v = vp[i];
        o[8 * i] += p * bflo(v.x); o[8 * i + 1] += p * bfhi(v.x); o[8 * i + 2] += p * bflo(v.y); o[8 * i + 3] += p * bfhi(v.y);
        o[8 * i + 4] += p * bflo(v.z); o[8 * i + 5] += p * bfhi(v.z); o[8 * i + 6] += p * bflo(v.w); o[8 * i + 7] += p * bfhi(v.w); }
}
__device__ __forceinline__ void nsa_step(const LAS v4u* ql, const bf16* kp_, const bf16* vp_, Soft& S, float (&o)[64]) {
    const float s = dotq(ql, kp_);
    if (s > S.mx) { const float sc = fexp(S.mx - s); S.l *= sc;
#pragma unroll
        for (int d = 0; d < 64; ++d) o[d] *= sc;
        S.mx = s; }
    const float p = fexp(s - S.mx); S.l += p;
    asm volatile("" ::: "memory");
    axpy_row(p, vp_, o);
}
__device__ __forceinline__ void nsa_accum(bf16* yrow, bool first, float sc, const float (&o)[64]) {
    v4u* op = (v4u*)yrow;
#pragma unroll
    for (int i = 0; i < 8; ++i) { v4u old = (v4u){0u, 0u, 0u, 0u}; if (!first) old = op[i];
        op[i] = (v4u){pk2(bflo(old.x) + sc * o[8 * i], bfhi(old.x) + sc * o[8 * i + 1]), pk2(bflo(old.y) + sc * o[8 * i + 2], bfhi(old.y) + sc * o[8 * i + 3]),
                      pk2(bflo(old.z) + sc * o[8 * i + 4], bfhi(old.z) + sc * o[8 * i + 5]), pk2(bflo(old.w) + sc * o[8 * i + 6], bfhi(old.w) + sc * o[8 * i + 7])}; }
}
__device__ __forceinline__ void p_nsa(Frame& F) {
    const int gw = F.vcu * NWAVES + F.wave, NGW = F.G * NWAVES, lane = F.lane;
    const bf16* P1 = WSP(bf16, WS_P1); const bf16* KC = WSP(bf16, WS_KC); bf16* Yc = WSP(bf16, WS_Y) + (size_t)2 * MC * 256;
    LAS float* imp = (LAS float*)(F.lds + RING_OFF + F.wave * 4096);
    LAS v4u* ql = (LAS v4u*)(F.lds + RING_OFF + 32768 + F.wave * 9216 + lane * 144);
    const int qi = lane >> 2, h = lane & 3;
    for (int item = gw; item < BC * 256; item += NGW) { const int b = item >> 8, tg = item & 255;
        const int t = tg * 16 + qi; const size_t row = (size_t)b * SEQ + t; const bf16* prow = P1 + row * P1W;
        { const v4u* qp = (const v4u*)(prow + C_CQ + h * 64);
#pragma unroll
          for (int i = 0; i < 8; ++i) ql[i] = qp[i]; }
        const float g0 = bf1(prow[C_CG + h * 3]), g1 = bf1(prow[C_CG + h * 3 + 1]), g2 = bf1(prow[C_CG + h * 3 + 2]);
        bf16* yrow = Yc + row * 256 + h * 64;
        float o[64];
        for (int i = lane; i < 1024; i += 64) imp[i] = 0.f;
        const int nv = t >= 31 ? ((t - 31) >> 4) + 1 : 0; const int nvmax = (tg * 16 + 15 >= 31) ? ((tg * 16 + 15 - 31) >> 4) + 1 : 0;
        const bf16* kc = KC + (size_t)(0 * BC + b) * 256 * 64; const bf16* vc = KC + (size_t)(1 * BC + b) * 256 * 64;
        { float mx = -INFINITY, l = 0.f;
          for (int m = 0; m < nvmax; ++m) { const float s = dotq(ql, kc + m * 64); if (m < nv) { if (s > mx) { l *= fexp(mx - s); mx = s; } l += fexp(s - mx); } }
          const float rl = l > 0.f ? 1.0f / l : 0.f;
#pragma unroll
          for (int d = 0; d < 64; ++d) o[d] = 0.f;
          for (int m = 0; m < nvmax; ++m) { const float s = dotq(ql, kc + m * 64); const float p = (m < nv) ? fexp(s - mx) * rl : 0.f;
              asm volatile("" ::: "memory");
              axpy_row(p, vc + m * 64, o);
              float P = p + __builtin_bit_cast(float, bperm(lane ^ 1, __builtin_bit_cast(int, p))); P += __builtin_bit_cast(float, bperm(lane ^ 2, __builtin_bit_cast(int, P)));
              if (h == 0) { const int j0 = m >> 2; const bool edge = (m & 3) == 3; imp[qi * 64 + j0] += edge ? 0.5f * P : P; if (edge) imp[qi * 64 + j0 + 1] += 0.5f * P; } }
          nsa_accum(yrow, true, g0, o); }
        unsigned long long mask = 0ull;
        { const int cur = t >> 6, nvb = cur + 1;
          if (h == 0) {
              if (nvb <= 16) mask = (1ull << nvb) - 1ull;
              else { mask = 1ull | (1ull << cur);
                  for (int r = 0; r < 14; ++r) { int best = -1; float bv = -1.f;
                      for (int j = 1; j < cur; ++j) { const float v = imp[qi * 64 + j]; if (!((mask >> j) & 1ull) && v > bv) { bv = v; best = j; } }
                      mask |= 1ull << best; } } }
          const unsigned mlo = (unsigned)bperm(lane & ~3, (int)(unsigned)mask), mhi = (unsigned)bperm(lane & ~3, (int)(unsigned)(mask >> 32));
          mask = ((unsigned long long)mhi << 32) | mlo; }
        { Soft S{-INFINITY, 0.f};
#pragma unroll
          for (int d = 0; d < 64; ++d) o[d] = 0.f;
          const bf16* kb = P1 + (size_t)b * SEQ * P1W + C_KSLC; const bf16* vb = P1 + (size_t)b * SEQ * P1W + C_VSLC;
          unsigned long long mm = mask;
          while (mm) { const int j = __builtin_ctzll(mm); mm &= mm - 1ull;
              for (int kk = 0; kk < 64; ++kk) { const int sp = j * 64 + kk; if (sp > t) break; nsa_step(ql, kb + (size_t)sp * P1W, vb + (size_t)sp * P1W, S, o); } }
          nsa_accum(yrow, false, g1 / S.l, o); }
        { Soft S{-INFINITY, 0.f};
#pragma unroll
          for (int d = 0; d < 64; ++d) o[d] = 0.f;
          const bf16* kb = P1 + (size_t)b * SEQ * P1W + C_KWIN; const bf16* vb = P1 + (size_t)b * SEQ * P1W + C_VWIN;
          for (int i = 0; i < 512; ++i) { const int sp = t - 511 + i; if (sp >= 0) nsa_step(ql, kb + (size_t)sp * P1W, vb + (size_t)sp * P1W, S, o); }
          nsa_accum(yrow, false, g2 / S.l, o); }
    }
}

__device__ __forceinline__ int moe_table(Frame& F, int jmoe, int c, int r, int kpre = 0) {
    LAS int* tab = (LAS int*)(F.lds + TAB_OFF); LAS int* arr = (LAS int*)(F.lds + LDSCTL_OFF + 4096);
    (void)jmoe;
    __syncthreads();
    if (F.tid < 256) { const v4i* s = (const v4i*)(WSP(int, WS_CNT128) + ((size_t)(c * 256 + F.tid) * 2 + r) * 8); const v4i a = s[0], b = s[1];
        *(LAS v4i*)(arr + F.tid * 8) = a; *(LAS v4i*)(arr + F.tid * 8 + 4) = b; }
    __syncthreads();
    if (F.tid < 8) { int tot = 0, pre = 0;
        for (int k = 0; k < 256; ++k) { const int x = arr[k * 8 + F.tid]; pre += (k < kpre) ? x : 0; tot += x; }
        tab[176 + F.tid] = tot; tab[184 + F.tid] = pre; }
    __syncthreads();
    if (F.tid == 0) { int base = 0, T = 0;
        for (int e = 0; e < 8; ++e) { const int cnt = tab[176 + e];
            const int nt = (cnt + 255) >> 8; tab[160 + e] = base; for (int i = 0; i < nt && T + i < 160; ++i) tab[T + i] = e; T += nt; base += nt * 256; }
        tab[168] = T < 136 ? T : 136; }
    __syncthreads();
    return tab[168];
}
__device__ __forceinline__ void p_gather(Frame& F, int jmoe, int c, int r, int nbusy = 0) {
    if (F.bx < nbusy) return;
    LAS int* tab = (LAS int*)(F.lds + TAB_OFF); LAS int* cntw = tab + 256; LAS int* basew = tab + 320;
    const int lane = F.lane, wave = F.wave;
    const v4i* route = WSP(v4i, WS_ROUTE); int* tokmap = WSP(int, WS_TOKMAP) + (c * 2 + r) * SLOTS; float* wslot = WSP(float, WS_WSLOT) + (c * 2 + r) * SLOTS;
    const bf16* HN = WSP(bf16, WS_HN); bf16* XG = WSP(bf16, WS_XG);
    for (int ch = F.bx - nbusy; ch < MC / 128; ch += F.G - nbusy) {
        moe_table(F, jmoe, c, r, ch);
        const int m = c * MC + ch * 128 + wave * 16 + (lane & 15); const v4i rt = route[m];
        const int e = lane < 16 ? (r ? rt.y : rt.x) : -1; const float w = __builtin_bit_cast(float, r ? rt.w : rt.z);
        unsigned long long bal[8]; int mycnt = 0;
#pragma unroll
        for (int ee = 0; ee < 8; ++ee) { bal[ee] = __builtin_amdgcn_ballot_w64(e == ee); if (lane == ee) mycnt = __builtin_popcountll(bal[ee]); }
        if (lane < 8) cntw[wave * 8 + lane] = mycnt;
        __syncthreads();
        if (wave == 0 && lane < 8) { int base = tab[184 + lane];
#pragma unroll
            for (int w8 = 0; w8 < 8; ++w8) { basew[w8 * 8 + lane] = base; base += cntw[w8 * 8 + lane]; } }
        __syncthreads();
        int pos = 0;
#pragma unroll
        for (int ee = 0; ee < 8; ++ee) if (e == ee) pos = basew[wave * 8 + ee] + __builtin_popcountll(bal[ee] & ((1ull << lane) - 1ull));
        int slot = 0;
        if (lane < 16) { slot = tab[160 + e] + pos; tokmap[slot] = m; wslot[slot] = w; }
#pragma unroll
        for (int i0 = 0; i0 < 16; i0 += 4) { v4u x[8];
#pragma unroll
            for (int i = 0; i < 4; ++i) { const int mi = __builtin_amdgcn_readlane(m, i0 + i); const v4u* src = (const v4u*)(HN + (size_t)mi * DM); x[2 * i] = src[lane]; x[2 * i + 1] = src[64 + lane]; }
#pragma unroll
            for (int i = 0; i < 4; ++i) { const int si = __builtin_amdgcn_readlane(slot, i0 + i); v4u* dst = (v4u*)(XG + (size_t)si * DM); dst[lane] = x[2 * i]; dst[64 + lane] = x[2 * i + 1]; } }
    }
}

typedef float f32x16 __attribute__((ext_vector_type(16)));
typedef short bf16x8v __attribute__((ext_vector_type(8)));
typedef float f32x2v __attribute__((ext_vector_type(2)));
constexpr int NSA_K = 0, NSA_V = 8192, NSA_BUF = 17408, NSA_STAGE = 2 * NSA_BUF, NSA_IMP = 69632, NSA_CARRY = 86016, NSA_SEL = 103424, NSA_WSF = 103936;
constexpr int NSA_VP = 136;
constexpr float NSA_C2 = 0.125f * 1.4426950408889634f;
constexpr float NSA_DEFER = 8.0f / (0.125f * 1.4426950408889634f);
__device__ __forceinline__ unsigned cvtpk(float lo, float hi) { f32x2v v = {lo, hi}; bf16x2_t b = __builtin_convertvector(v, bf16x2_t); return __builtin_bit_cast(unsigned, b); }
__device__ __forceinline__ float partner32(float v, int lane) { return __builtin_bit_cast(float, __builtin_amdgcn_ds_bpermute((lane ^ 32) << 2, __builtin_bit_cast(int, v))); }
__device__ __forceinline__ void nsa_load(v4u& kx, v4u& vx, const bf16* Kg, int kp, const bf16* Vg, int vp, int tid) {
    kx = *(const v4u*)(Kg + (size_t)(tid & 63) * kp + (tid >> 6) * 8); vx = *(const v4u*)(Vg + (size_t)(tid >> 3) * vp + (tid & 7) * 8);
}
__device__ __forceinline__ void nsa_store(LAS unsigned char* lds, const v4u& kx, const v4u& vx, int tid) {
    *(LAS v4u*)(lds + NSA_K + (tid >> 6) * 1024 + (tid & 63) * 16) = kx; { LAS v2u* vd = (LAS v2u*)(lds + NSA_V + (tid >> 3) * NSA_VP + (tid & 7) * 16); vd[0] = (v2u){vx.x, vx.y}; vd[1] = (v2u){vx.z, vx.w}; }
}
__device__ __forceinline__ void nsa_qk(const LAS unsigned char* lds, const bf16x8v (&qr)[4], f32x16& p0, f32x16& p1, int r32, int hi) {
#pragma unroll
    for (int i = 0; i < 16; ++i) { p0[i] = 0.f; p1[i] = 0.f; }
#pragma unroll
    for (int d0 = 0; d0 < 4; ++d0) {
        const bf16x8v k0 = *(const LAS bf16x8v*)(lds + NSA_K + (2 * d0 + hi) * 1024 + r32 * 16);
        const bf16x8v k1 = *(const LAS bf16x8v*)(lds + NSA_K + (2 * d0 + hi) * 1024 + 512 + r32 * 16);
        p0 = __builtin_amdgcn_mfma_f32_32x32x16_bf16(k0, qr[d0], p0, 0, 0, 0);
        p1 = __builtin_amdgcn_mfma_f32_32x32x16_bf16(k1, qr[d0], p1, 0, 0, 0);
    }
}
__device__ __forceinline__ void nsa_mask(f32x16& p0, f32x16& p1, int hi, int hiL, int loL) {
#pragma unroll
    for (int i = 0; i < 16; ++i) { const int kk = (i & 3) + 8 * (i >> 2) + 4 * hi;
        if (!(kk <= hiL && kk > loL)) p0[i] = -INFINITY;
        if (!(kk + 32 <= hiL && kk + 32 > loL)) p1[i] = -INFINITY; }
}
__device__ __forceinline__ float nsa_max32(const f32x16& p0, const f32x16& p1) {
    float a = fmaxf(fmaxf(p0[0], p0[1]), p1[0]), b = fmaxf(fmaxf(p0[2], p0[3]), p1[1]); a = fmaxf(fmaxf(a, p1[2]), p1[3]);
#pragma unroll
    for (int i = 4; i < 16; i += 4) { a = fmaxf(fmaxf(a, p0[i]), p0[i + 1]); b = fmaxf(fmaxf(b, p0[i + 2]), p0[i + 3]); a = fmaxf(fmaxf(a, p1[i]), p1[i + 1]); b = fmaxf(fmaxf(b, p1[i + 2]), p1[i + 3]); }
    return fmaxf(a, b);
}
__device__ __forceinline__ void nsa_pv(const LAS unsigned char* lds, const f32x16& p0, const f32x16& p1, f32x16 (&o)[2], int r32, int hi) {
    bf16x8v pa[4];
#pragma unroll
    for (int s = 0; s < 2; ++s) {
        const v4u a = (v4u){cvtpk(p0[8 * s], p0[8 * s + 1]), cvtpk(p0[8 * s + 2], p0[8 * s + 3]), cvtpk(p0[8 * s + 4], p0[8 * s + 5]), cvtpk(p0[8 * s + 6], p0[8 * s + 7])};
        const v4u b = (v4u){cvtpk(p1[8 * s], p1[8 * s + 1]), cvtpk(p1[8 * s + 2], p1[8 * s + 3]), cvtpk(p1[8 * s + 4], p1[8 * s + 5]), cvtpk(p1[8 * s + 6], p1[8 * s + 7])};
        pa[s] = __builtin_bit_cast(bf16x8v, a); pa[2 + s] = __builtin_bit_cast(bf16x8v, b); }
#pragma unroll
    for (int db = 0; db < 2; ++db) { const LAS unsigned char* vrow = lds + NSA_V + (32 * db + r32) * NSA_VP;
#pragma unroll
        for (int ks = 0; ks < 4; ++ks) {
            const int kb = (ks >> 1) * 32 + (ks & 1) * 16 + 4 * hi;
            const v2u lo = *(const LAS v2u*)(vrow + kb * 2), hh = *(const LAS v2u*)(vrow + (kb + 8) * 2);
            const v4u vv = (v4u){lo.x, lo.y, hh.x, hh.y};
            o[db] = __builtin_amdgcn_mfma_f32_32x32x16_bf16(pa[ks], __builtin_bit_cast(bf16x8v, vv), o[db], 0, 0, 0); } }
}
__device__ __forceinline__ void nsa_rowscale(f32x16 (&o)[2], LAS float* wsf, float f, int r32, int hi) {
    if (hi == 0) wsf[r32] = f;
#pragma unroll
    for (int g = 0; g < 4; ++g) { const f32x4 w = *(const LAS f32x4*)(wsf + 8 * g + 4 * hi);
#pragma unroll
        for (int e = 0; e < 4; ++e) { o[0][4 * g + e] *= w[e]; o[1][4 * g + e] *= w[e]; } }
}
constexpr int NSA_ACC = 104960;
__device__ __forceinline__ void nsa_rowaccum(LAS unsigned char* acc, bool first, const f32x16 (&o)[2], LAS float* wsf, float f, int r32, int hi) {
    if (hi == 0) wsf[r32] = f;
#pragma unroll
    for (int g = 0; g < 4; ++g) { const f32x4 w = *(const LAS f32x4*)(wsf + 8 * g + 4 * hi);
#pragma unroll
        for (int e = 0; e < 4; ++e) { LAS bf16* p = (LAS bf16*)(acc + (8 * g + 4 * hi + e) * 128 + r32 * 2); const int i = 4 * g + e;
            float a = o[0][i] * w[e], b = o[1][i] * w[e];
            if (!first) { a += bf1(p[0]); b += bf1(p[32]); }
            p[0] = (bf16)f2bf(a); p[32] = (bf16)f2bf(b); } }
}
__device__ __forceinline__ void nsa_flush(const LAS unsigned char* acc, bf16* ytok  , int lane) {
    asm volatile("" ::: "memory");
#pragma unroll
    for (int ps = 0; ps < 4; ++ps) { const int row = ps * 8 + (lane >> 3), ch = lane & 7;
        const v4u v = *(const LAS v4u*)(acc + row * 128 + ch * 16);
        *(v4u*)(ytok + (size_t)(row >> 2) * 256 + (row & 3) * 64 + ch * 8) = v; }
}
__device__ __forceinline__ void nsa_softmax_pv(const LAS unsigned char* lds, f32x16& p0, f32x16& p1, float& m, float& l, f32x16 (&o)[2], LAS float* wsf, int lane, int r32, int hi, bool rowok) {
    float mt = nsa_max32(p0, p1); mt = rowok ? mt : -INFINITY; mt = fmaxf(mt, partner32(mt, lane));
    const float mn = fmaxf(m, mt);
    if (__builtin_amdgcn_ballot_w64(mn > m + NSA_DEFER) != 0ull) { const float f = __builtin_amdgcn_exp2f((m - mn) * NSA_C2); l *= f; nsa_rowscale(o, wsf, f, r32, hi); m = mn; }
    const float off = rowok ? -m * NSA_C2 : -INFINITY;
    float s = 0.f;
#pragma unroll
    for (int i = 0; i < 16; ++i) { p0[i] = __builtin_amdgcn_exp2f(__builtin_fmaf(p0[i], NSA_C2, off)); p1[i] = __builtin_amdgcn_exp2f(__builtin_fmaf(p1[i], NSA_C2, off)); s += p0[i] + p1[i]; }
    l += s;
    nsa_pv(lds, p0, p1, o, r32, hi);
}
__device__ __forceinline__ void p_nsa2(Frame& F) {
    const int tid = F.tid, lane = F.lane, wave = F.wave, r32 = lane & 31, hi = lane >> 5;
    LAS unsigned char* lds = F.lds + RING_OFF;
    LAS float* imp = (LAS float*)(lds + NSA_IMP); LAS float* carry = (LAS float*)(lds + NSA_CARRY);
    LAS unsigned long long* selm = (LAS unsigned long long*)(lds + NSA_SEL); LAS float* wsf = (LAS float*)(lds + NSA_WSF) + wave * 32;
    LAS unsigned char* acc = wave < 6 ? lds + NSA_ACC + wave * 4096 : F.lds + LDSCTL_OFF + 4096 + (wave - 6) * 4096;
    const bf16* P1 = WSP(bf16, WS_P1); const bf16* KC = WSP(bf16, WS_KC); const bf16* KCT = WSP(bf16, WS_KCT); const bf16* VT = WSP(bf16, WS_VT);
    bf16* Yc = WSP(bf16, WS_Y) + (size_t)2 * MC * 256;
    const int ql = r32 >> 2, h = r32 & 3, tq = 8 * wave + ql;
    int par = 0;
    for (int it = 0; it < 2; ++it) {
        for (int pair = F.vcu; pair < BC * 32; pair += F.G) {
            const int b = pair >> 5, sx = pair & 31, qb = it ? 63 - sx : sx;
            const int t = qb * 64 + tq; const size_t row = (size_t)b * SEQ + t; const bf16* prow = P1 + row * P1W;
            bf16x8v qr[4];
#pragma unroll
            for (int d0 = 0; d0 < 4; ++d0) qr[d0] = *(const bf16x8v*)(prow + C_CQ + h * 64 + d0 * 16 + hi * 8);
            const float g0 = bf1(prow[C_CG + h * 3]), g1 = bf1(prow[C_CG + h * 3 + 1]), g2 = bf1(prow[C_CG + h * 3 + 2]);
            f32x16 o[2], p0, p1;
            __syncthreads();
            for (int i = tid; i < 64 * 64; i += 512) imp[i] = 0.f;
            for (int i = tid; i < 64 * 68; i += 512) carry[i] = 0.f;
            const int nct = (4 * qb + 3 + 63) >> 6;
            const int mlim = t >= 31 ? ((t - 31) >> 4) : -1;
            const bf16* kcb = KC + (size_t)b * 256 * 64; const bf16* vcb = KCT + (size_t)b * 64 * 256;
            float m = -1e30f, l = 0.f;
            v4u kx, vx;
            nsa_load(kx, vx, kcb, 64, vcb, 256, tid);
            for (int ti = 0; ti < nct; ++ti) {
                LAS unsigned char* tb = lds + par * NSA_STAGE; par ^= 1;
                nsa_store(tb, kx, vx, tid); __syncthreads();
                { const int tn = ti + 1 < nct ? ti + 1 : 0; nsa_load(kx, vx, kcb + (size_t)tn * 64 * 64, 64, vcb + tn * 64, 256, tid); }
                nsa_qk(tb, qr, p0, p1, r32, hi); nsa_mask(p0, p1, hi, mlim - 64 * ti, -1);
                float mt = nsa_max32(p0, p1); mt = fmaxf(mt, partner32(mt, lane));
                const float mn = fmaxf(m, mt); l *= __builtin_amdgcn_exp2f((m - mn) * NSA_C2); m = mn;
                const float off = -m * NSA_C2; float s = 0.f;
#pragma unroll
                for (int i = 0; i < 16; ++i) s += __builtin_amdgcn_exp2f(__builtin_fmaf(p0[i], NSA_C2, off)) + __builtin_amdgcn_exp2f(__builtin_fmaf(p1[i], NSA_C2, off));
                l += s; }
            { const float lt = l + partner32(l, lane); const float rl = lt > 0.f ? 1.0f / lt : 0.f;
#pragma unroll
              for (int i = 0; i < 16; ++i) { o[0][i] = 0.f; o[1][i] = 0.f; }
              for (int ti = 0; ti < nct; ++ti) {
                  LAS unsigned char* tb = lds + par * NSA_STAGE; par ^= 1;
                  nsa_store(tb, kx, vx, tid); __syncthreads();
                  if (ti + 1 < nct) nsa_load(kx, vx, kcb + (size_t)(ti + 1) * 64 * 64, 64, vcb + (ti + 1) * 64, 256, tid);
                  nsa_qk(tb, qr, p0, p1, r32, hi); nsa_mask(p0, p1, hi, mlim - 64 * ti, -1);
                  { const float off = -m * NSA_C2;
#pragma unroll
                    for (int i = 0; i < 16; ++i) { p0[i] = __builtin_amdgcn_exp2f(__builtin_fmaf(p0[i], NSA_C2, off)) * rl; p1[i] = __builtin_amdgcn_exp2f(__builtin_fmaf(p1[i], NSA_C2, off)) * rl; } }
#pragma unroll
                  for (int kt = 0; kt < 2; ++kt)
#pragma unroll
                      for (int g = 0; g < 4; ++g) { const f32x16& pp = kt ? p1 : p0;
                          float A = pp[4 * g] + pp[4 * g + 1] + pp[4 * g + 2] + 0.5f * pp[4 * g + 3], B = 0.5f * pp[4 * g + 3];
                          A += __builtin_bit_cast(float, bperm(lane ^ 1, __builtin_bit_cast(int, A))); A += __builtin_bit_cast(float, bperm(lane ^ 2, __builtin_bit_cast(int, A)));
                          B += __builtin_bit_cast(float, bperm(lane ^ 1, __builtin_bit_cast(int, B))); B += __builtin_bit_cast(float, bperm(lane ^ 2, __builtin_bit_cast(int, B)));
                          if (h == 0) { const int j = 16 * ti + 8 * kt + 2 * g + hi; imp[tq * 64 + j] = A; carry[tq * 68 + j + 1] = B; } }
                  nsa_pv(tb, p0, p1, o, r32, hi); }
              nsa_rowaccum(acc, true, o, wsf, g0, r32, hi); }
            __syncthreads();
            { const int q = tid >> 3, sub = tid & 7; unsigned long long mask;
              if (qb + 1 <= 16) mask = (1ull << (qb + 1)) - 1ull;
              else { mask = 1ull | (1ull << qb);
                  unsigned long long key[8];
#pragma unroll
                  for (int i = 0; i < 8; ++i) { const int j = sub * 8 + i; const float v = imp[q * 64 + j] + carry[q * 68 + j];
                      key[i] = (j >= 1 && j < qb) ? (((unsigned long long)__builtin_bit_cast(unsigned, v) << 32) | (unsigned)(63 - j)) : 0ull; }
                  for (int r = 0; r < 14; ++r) { unsigned long long best = key[0];
#pragma unroll
                      for (int i = 1; i < 8; ++i) best = key[i] > best ? key[i] : best;
#pragma unroll
                      for (int x = 1; x < 8; x <<= 1) { const unsigned lo = (unsigned)bperm(lane ^ x, (int)(unsigned)best), hh = (unsigned)bperm(lane ^ x, (int)(unsigned)(best >> 32));
                          const unsigned long long other = ((unsigned long long)hh << 32) | lo; best = other > best ? other : best; }
                      const int jb = 63 - (int)(best & 63ull); mask |= 1ull << jb;
#pragma unroll
                      for (int i = 0; i < 8; ++i) if (sub * 8 + i == jb) key[i] = 0ull; } }
              if (sub == 0) selm[q] = mask; }
            __syncthreads();
            const unsigned long long mysel = selm[tq];
            { const bf16* kb = P1 + (size_t)b * SEQ * P1W + C_KSLC; const bf16* vb = VT + (size_t)(0 * BC + b) * 64 * SEQ;
              m = -1e30f; l = 0.f;
#pragma unroll
              for (int i = 0; i < 16; ++i) { o[0][i] = 0.f; o[1][i] = 0.f; }
              v4u kx2, vx2;
              nsa_load(kx, vx, kb, P1W, vb, SEQ, tid); if (qb >= 1) nsa_load(kx2, vx2, kb + (size_t)64 * P1W, P1W, vb + 64, SEQ, tid);
              for (int j = 0; j <= qb; j += 2) {
                  const bool two = j + 1 <= qb;
                  LAS unsigned char* tb = lds + par * NSA_STAGE; par ^= 1;
                  nsa_store(tb, kx, vx, tid); if (two) nsa_store(tb + NSA_BUF, kx2, vx2, tid);
                  __syncthreads();
                  if (j + 2 <= qb) nsa_load(kx, vx, kb + (size_t)(j + 2) * 64 * P1W, P1W, vb + (j + 2) * 64, SEQ, tid);
                  if (j + 3 <= qb) nsa_load(kx2, vx2, kb + (size_t)(j + 3) * 64 * P1W, P1W, vb + (j + 3) * 64, SEQ, tid);
                  { const bool rowsel = ((mysel >> j) & 1ull) != 0ull;
                    if (__builtin_amdgcn_ballot_w64(rowsel) != 0ull) {
                        nsa_qk(tb, qr, p0, p1, r32, hi); if (j == qb) nsa_mask(p0, p1, hi, tq, -1);
                        nsa_softmax_pv(tb, p0, p1, m, l, o, wsf, lane, r32, hi, rowsel); } }
                  if (two) { const bool rowsel = ((mysel >> (j + 1)) & 1ull) != 0ull;
                    if (__builtin_amdgcn_ballot_w64(rowsel) != 0ull) {
                        nsa_qk(tb + NSA_BUF, qr, p0, p1, r32, hi); if (j + 1 == qb) nsa_mask(p0, p1, hi, tq, -1);
                        nsa_softmax_pv(tb + NSA_BUF, p0, p1, m, l, o, wsf, lane, r32, hi, rowsel); } } }
              const float lt = l + partner32(l, lane);
              nsa_rowaccum(acc, false, o, wsf, lt > 0.f ? g1 / lt : 0.f, r32, hi); }
            { const bf16* kb = P1 + (size_t)b * SEQ * P1W + C_KWIN; const bf16* vb = VT + (size_t)(1 * BC + b) * 64 * SEQ;
              m = -1e30f; l = 0.f;
#pragma unroll
              for (int i = 0; i < 16; ++i) { o[0][i] = 0.f; o[1][i] = 0.f; }
              const int j0 = qb >= 8 ? qb - 8 : 0;
              nsa_load(kx, vx, kb + (size_t)j0 * 64 * P1W, P1W, vb + j0 * 64, SEQ, tid);
              for (int j = j0; j <= qb; ++j) {
                  LAS unsigned char* tb = lds + par * NSA_STAGE; par ^= 1;
                  nsa_store(tb, kx, vx, tid); __syncthreads();
                  if (j < qb) nsa_load(kx, vx, kb + (size_t)(j + 1) * 64 * P1W, P1W, vb + (j + 1) * 64, SEQ, tid);
                  nsa_qk(tb, qr, p0, p1, r32, hi); if (j == qb || j == qb - 8) nsa_mask(p0, p1, hi, j == qb ? tq : 63, j == qb - 8 ? tq : -1);
                  nsa_softmax_pv(tb, p0, p1, m, l, o, wsf, lane, r32, hi, true); }
              const float lt = l + partner32(l, lane);
              nsa_rowaccum(acc, false, o, wsf, lt > 0.f ? g2 / lt : 0.f, r32, hi);
              nsa_flush(acc, Yc + ((size_t)b * SEQ + qb * 64 + 8 * wave) * 256, lane); }
        }
    }
    __syncthreads();
}

constexpr int SB_HEAD_LDS = 17408;
constexpr int SB_FLAG = 4 * SB_HEAD_LDS;
constexpr float SB_LOG2E = 1.4426950408889634f, SB_STOP = -100.0f * 1.4426950408889634f;
__device__ __forceinline__ void p_stick2(Frame& F, int nbusy) {
    const int tid = F.tid, lane = F.lane, wave = F.wave, r32 = lane & 31, hi = lane >> 5, h = wave & 3, qh = wave >> 2;
    LAS unsigned char* lds = F.lds + RING_OFF; LAS unsigned char* hl = lds + h * SB_HEAD_LDS; LAS int* flag = (LAS int*)(lds + SB_FLAG);
    const bf16* P1 = WSP(bf16, WS_P1); const bf16* VT = WSP(bf16, WS_VT) + (size_t)2 * BC * 64 * SEQ;
    bf16* Yb = WSP(bf16, WS_Y) + (size_t)MC * 256;
    const int tq = 32 * qh + r32;
    if (F.bx >= nbusy)
        for (int item = F.bx - nbusy; item < BC * 64; item += F.G - nbusy) {
            const int b = item >> 6, qb = item & 63;
            const size_t row = (size_t)b * SEQ + qb * 64 + tq;
            bf16x8v qr[4];
#pragma unroll
            for (int d0 = 0; d0 < 4; ++d0) qr[d0] = *(const bf16x8v*)(P1 + row * P1W + C_SBQ + h * 64 + d0 * 16 + hi * 8);
            f32x16 o[2], p0, p1;
#pragma unroll
            for (int i = 0; i < 16; ++i) { o[0][i] = 0.f; o[1][i] = 0.f; }
            float R = 0.f;
            const int skey = tid & 63, sc = tid >> 6, sd = tid >> 3, skc = tid & 7;
            v4u kx[4], vx[4];
#define SB_LOAD(jj) do { const bf16* kg_ = P1 + ((size_t)b * SEQ + (jj) * 64 + skey) * P1W + C_SBK + sc * 8; \
                _Pragma("unroll") for (int hh = 0; hh < 4; ++hh) { kx[hh] = *(const v4u*)(kg_ + hh * 64); vx[hh] = *(const v4u*)(VT + ((size_t)(hh * BC + b) * 64 + sd) * SEQ + (jj) * 64 + skc * 8); } } while (0)
            SB_LOAD(qb);
            for (int j = qb; j >= 0; --j) {
                __syncthreads();
                if (j < qb) { int live = 0;
#pragma unroll
                    for (int w = 0; w < 8; ++w) live |= flag[w];
                    if (!live) break; }
#pragma unroll
                for (int hh = 0; hh < 4; ++hh) { *(LAS v4u*)(lds + hh * SB_HEAD_LDS + sc * 1024 + skey * 16) = kx[hh]; { LAS v2u* vd = (LAS v2u*)(lds + hh * SB_HEAD_LDS + NSA_V + sd * NSA_VP + skc * 16); vd[0] = (v2u){vx[hh].x, vx[hh].y}; vd[1] = (v2u){vx[hh].z, vx[hh].w}; } }
                __syncthreads();
                if (j > 0) SB_LOAD(j - 1);
                nsa_qk(hl, qr, p0, p1, r32, hi);
#pragma unroll
                for (int i = 0; i < 16; ++i) { p0[i] *= NSA_C2; p1[i] *= NSA_C2; }
                const int lim = (j == qb) ? tq : 64;
                float Town[8], Tp[8];
#pragma unroll
                for (int kt = 0; kt < 2; ++kt) { f32x16& pp = kt ? p1 : p0;
#pragma unroll
                    for (int g = 0; g < 4; ++g) { float L[4];
#pragma unroll
                        for (int e = 0; e < 4; ++e) { const int kk = 32 * kt + 8 * g + 4 * hi + e; const float z = pp[4 * g + e];
                            const float tt = __builtin_amdgcn_logf(1.0f + __builtin_amdgcn_exp2f(-__builtin_fabsf(z)));
                            const float lb = fminf(z, 0.f) - tt; const bool ok = kk < lim;
                            L[e] = ok ? lb - z : 0.f; pp[4 * g + e] = ok ? lb : -INFINITY; }
                        const float E2 = L[3], E1 = E2 + L[2], E0 = E1 + L[1];
                        pp[4 * g + 2] += E2; pp[4 * g + 1] += E1; pp[4 * g] += E0;
                        Town[4 * kt + g] = E0 + L[0]; } }
#pragma unroll
                for (int k = 0; k < 8; ++k) Tp[k] = partner32(Town[k], lane);
                float suf = R;
#pragma unroll
                for (int k = 7; k >= 0; --k) { const float add = suf + (hi == 0 ? Tp[k] : 0.f); f32x16& pp = (k >> 2) ? p1 : p0; const int g = k & 3;
#pragma unroll
                    for (int e = 0; e < 4; ++e) pp[4 * g + e] = __builtin_amdgcn_exp2f(pp[4 * g + e] + add);
                    suf += Town[k] + Tp[k]; }
                R = suf;
                nsa_pv(hl, p0, p1, o, r32, hi);
                const bool alive = R >= SB_STOP;
                const unsigned long long bal = __builtin_amdgcn_ballot_w64(alive);
                if (lane == 0) flag[wave] = bal != 0ull ? 1 : 0;
            }
            { bf16* dst = Yb + ((size_t)b * SEQ + qb * 64 + 32 * qh + 4 * hi) * 256 + h * 64 + r32;
#pragma unroll
              for (int i = 0; i < 16; ++i) { dst[((i & 3) + 8 * (i >> 2)) * 256] = (bf16)f2bf(o[0][i]); dst[((i & 3) + 8 * (i >> 2)) * 256 + 32] = (bf16)f2bf(o[1][i]); } }
        }
#undef SB_LOAD
    __syncthreads();
}

__device__ __forceinline__ void p_sgu2(Frame& F, int layer) {
    LAS unsigned char* vnT = F.lds + RING_OFF;
    const bf16* P1 = WSP(bf16, WS_P1); bf16* Ya = WSP(bf16, WS_Y);
    const float* gain = F.in[3] + (size_t)layer * 256; const float* sw = F.in[4] + (size_t)layer * 4 * 128 * 128; const float* sb = F.in[5] + (size_t)layer * 4 * 128;
    const int lane = F.lane, wave = F.wave, r32 = lane & 31, hi = lane >> 5, g = wave & 3, db = wave >> 2;
    for (int item = F.vcu; item < MC / 128; item += F.G) {
        const size_t r0 = (size_t)item * 128;
        __syncthreads();
        { const f32x4 gg = ((const f32x4*)gain)[lane];
          for (int rr = 0; rr < 16; rr += 2) { const int r = wave * 16 + rr;
              const v2u ra = *(const v2u*)(P1 + (r0 + r) * P1W + C_V + 4 * lane), rb = *(const v2u*)(P1 + (r0 + r + 1) * P1W + C_V + 4 * lane);
              const float a0 = bflo(ra.x), a1 = bfhi(ra.x), a2 = bflo(ra.y), a3 = bfhi(ra.y), b0 = bflo(rb.x), b1 = bfhi(rb.x), b2 = bflo(rb.y), b3 = bfhi(rb.y);
              const float sa = 1.0f / sqrtf(wave_sum((a0 * a0 + a1 * a1) + (a2 * a2 + a3 * a3), lane) * (1.f / 256.f) + EPS);
              const float sb_ = 1.0f / sqrtf(wave_sum((b0 * b0 + b1 * b1) + (b2 * b2 + b3 * b3), lane) * (1.f / 256.f) + EPS);
              LAS unsigned* q = (LAS unsigned*)(vnT + (4 * lane) * 272 + r * 2);
              q[0] = pk2(a0 * sa * gg.x, b0 * sb_ * gg.x); q[68] = pk2(a1 * sa * gg.y, b1 * sb_ * gg.y); q[136] = pk2(a2 * sa * gg.z, b2 * sb_ * gg.z); q[204] = pk2(a3 * sa * gg.w, b3 * sb_ * gg.w); } }
        __syncthreads();
        const int ch = g * 64 + db * 32 + r32;
        for (int tb = 0; tb < 4; ++tb) {
            f32x16 acc;
#pragma unroll
            for (int i = 0; i < 16; ++i) acc[i] = 0.f;
            const int t = 32 * tb + r32; const float* wrow = sw + ((size_t)g * 128 + t) * 128;
            f32x4 wq[8][2];
#pragma unroll
            for (int ks = 0; ks < 8; ++ks) if (ks < 2 * tb + 2) { wq[ks][0] = *(const f32x4*)(wrow + 16 * ks + 8 * hi); wq[ks][1] = *(const f32x4*)(wrow + 16 * ks + 8 * hi + 4); }
#pragma unroll
            for (int ks = 0; ks < 8; ++ks) if (ks < 2 * tb + 2) {
                const int s0 = 16 * ks + 8 * hi;
                const f32x4 w0 = wq[ks][0], w1 = wq[ks][1];
                const v4u a = (v4u){pk2(s0 <= t ? w0.x : 0.f, s0 + 1 <= t ? w0.y : 0.f), pk2(s0 + 2 <= t ? w0.z : 0.f, s0 + 3 <= t ? w0.w : 0.f),
                                    pk2(s0 + 4 <= t ? w1.x : 0.f, s0 + 5 <= t ? w1.y : 0.f), pk2(s0 + 6 <= t ? w1.z : 0.f, s0 + 7 <= t ? w1.w : 0.f)};
                const bf16x8v bfr = *(const LAS bf16x8v*)(vnT + ch * 272 + s0 * 2);
                acc = __builtin_amdgcn_mfma_f32_32x32x16_bf16(__builtin_bit_cast(bf16x8v, a), bfr, acc, 0, 0, 0); }
            float uu[16], bb[16];
#pragma unroll
            for (int i = 0; i < 16; ++i) { const int tt = 32 * tb + (i & 3) + 8 * (i >> 2) + 4 * hi; uu[i] = bf1(P1[(r0 + tt) * P1W + C_U + ch]); bb[i] = sb[g * 128 + tt]; }
#pragma unroll
            for (int i = 0; i < 16; ++i) { const int tt = 32 * tb + (i & 3) + 8 * (i >> 2) + 4 * hi;
                Ya[(r0 + tt) * 256 + ch] = (bf16)f2bf(uu[i] * (acc[i] + bb[i])); }
        }
    }
    __syncthreads();
}

struct Args { const float* in[20]; float* out; unsigned char* ws; int lo, hi, li, rep; };
#ifndef TILED_FFN1
#define TILED_FFN1 0
#endif
#ifndef PG8_ALIGN_EPI
#define PG8_ALIGN_EPI true
#endif
#ifndef PG8_SP2
#define PG8_SP2 true
#endif
#ifndef WGM_PROJ
#define WGM_PROJ PG8_WGM
#endif
#ifndef WGM_FFN1
#define WGM_FFN1 PG8_WGM
#endif
#ifndef WGM_FFN2
#define WGM_FFN2 PG8_WGM
#endif
#ifndef WGM_MOE1
#define WGM_MOE1 PG8_WGM
#endif
#ifndef WGM_MOE2
#define WGM_MOE2 PG8_WGM
#endif
#ifndef FFN_CHUNKS
#define FFN_CHUNKS 2
#endif
#ifndef REP_GEMM
#define REP_GEMM 1
#endif
#ifndef REP_STICK
#define REP_STICK 1
#endif
#ifndef REP_NSA
#define REP_NSA 1
#endif
#ifndef REP_SGU
#define REP_SGU 1
#endif
#ifndef REP_NORM
#define REP_NORM 1
#endif
template <class Epi, class Sched> __device__ __forceinline__ void run_gemm(Frame& F, const bf16* A, const bf16* Bt, int M, int N, int K, const Sched& S, Epi E, bool rotate = true, int tiled = 0, int ld = 0) {
    const int nt_ = K / 64;
#ifdef PG8_KROT
    const int rot_ = rotate ? 2 * (((F.bx & 7) * (nt_ / 2)) / 8) : 0;
#else
    const int rot_ = 0;
#endif
    pg8::Gemm g{A, Bt, M, N, K + F.zs, F.tid, rot_ + F.zs, tiled + F.zs, ld + F.zs};
    if (F.rep) E.set_scale0();
    pg8::gemm_phase<Epi, Sched, PG8_ALIGN_EPI, PG8_SP2>(F.lds + RING_OFF, g, S, E);
}
__global__ void __launch_bounds__(NWAVES * 64, 2) mk_fwd(Args args) {
    extern __shared__ __attribute__((aligned(16))) unsigned char lds[];
    Frame F0;
    F0.lds = (LAS unsigned char*)lds;
    F0.tid = threadIdx.x; F0.lane = F0.tid & 63; F0.wave = __builtin_amdgcn_readfirstlane(F0.tid >> 6);
    F0.G = gridDim.x; F0.bx = blockIdx.x; F0.vcu = (F0.G % 8 == 0) ? (F0.bx % 8) * (F0.G / 8) + F0.bx / 8 : F0.bx; F0.zv = 0; F0.zs = 0;
    F0.rep = args.rep; F0.ws = args.ws; F0.ctl = (unsigned*)(args.ws + WS_CTL); F0.in = args.in; F0.out = args.out;
    for (int u = F0.tid; u < (LDS_BYTES - LDSCTL_OFF) / 4; u += NWAVES * 64) ((LAS unsigned*)(F0.lds + LDSCTL_OFF))[u] = 0u;
    __syncthreads();
    const int lo = args.lo, hi = args.hi;
    XcdBarrier bar; bar.bar = F0.ctl + CW_BAR + args.li * XCD_BAR_WORDS; bar.x = 0; bar.st = nullptr; bar.w = 0; bar.z = 0;
    if (hi - lo > 1) bar = xcd_barrier_post(F0.ctl + CW_BAR + args.li * XCD_BAR_WORDS, (volatile LAS unsigned*)(F0.lds + MISC_OFF) + 8);
    int step = 0;
#define STEP_BEGIN if (step >= lo && step < hi) { Frame F = F0; { int zv_, zs_; asm volatile("v_mov_b32 %0, 0" : "=v"(zv_)); asm volatile("s_mov_b32 %0, 0" : "=s"(zs_)); \
        F.zv = zv_; F.zs = zs_; F.lane = (int)__builtin_amdgcn_mbcnt_hi(~0u, __builtin_amdgcn_mbcnt_lo(~0u, (unsigned)zv_)); F.wave = F0.wave + zs_; F.tid = F.wave * 64 + F.lane; F.bx = F.bx + zs_; \
        F.vcu = F0.vcu + zs_; F.G = F0.G + zs_; F.lds = (LAS unsigned char*)lds + zs_; F.ws = F0.ws + zs_; F.ctl = F0.ctl + zs_; F.in = F0.in + zs_; F.out = F0.out + zs_; }
#ifdef PROBE_XBAR
#define STEP_END   if (step + 1 < hi) { unsigned zb_; asm volatile("v_mov_b32 %0, 0" : "=v"(zb_)); bar.z = zb_; xcd_barrier(bar); xcd_barrier(bar); } } ++step;
#else
#define STEP_END   if (step + 1 < hi) { unsigned zb_; asm volatile("v_mov_b32 %0, 0" : "=v"(zb_)); bar.z = zb_; xcd_barrier(bar); } } ++step;
#endif

    for (int layer = 0; layer < DEPTH; ++layer) {
        const int jj = layer >> 1;
        STEP_BEGIN
            p_convert(F, layer);
            p_norm<0>(F, layer == 0 ? F.in[0] : F.out, F.in[1] + (size_t)layer * DM, nullptr, 0);
        STEP_END
        for (int c = 0; c < NCHUNK; ++c) {
            STEP_BEGIN
                pg8::StaticOrder S; S.init(MC, NPROJ, F.G, F.bx, WGM_PROJ);
                pg8::EpiProj E{WSP(bf16, WS_P1), WSP(bf16, WS_G)};
                run_gemm(F, WSP(bf16, WS_HN) + (size_t)c * MC * DM, WSP(bf16, WS_WIN), MC, NPROJ, DM, S, E);
            STEP_END
            STEP_BEGIN
                p_prep(F);
            STEP_END
            STEP_BEGIN
                LAS int* tab = (LAS int*)(F.lds + TAB_OFF);
                __syncthreads(); if (F.tid < 16) tab[F.tid] = F.tid >> 3; __syncthreads();
                pg8::GroupedOrder S; S.so.init(2 * 2048, 512, F.G, F.bx); S.tile_e = tab; S.nN = 2;
                pg8::EpiF32 E{WSP(float, WS_UL), 512, 2};
                run_gemm(F, WSP(bf16, WS_KVC), WSP(bf16, WS_WC1), 2 * 2048, 512, DM, S, E);
                p_sgu2(F, layer);
                p_stick2(F, F.G > 64 ? 32 : 0);
            STEP_END
            STEP_BEGIN
                p_cmpfin(F, layer);
            STEP_END
            STEP_BEGIN
#ifdef OLD_NSA
                p_nsa(F);
#else
                p_nsa2(F);
#endif
            STEP_END
            STEP_BEGIN
                pg8::MergeOrder S; S.so.init(MC, DM, F.G, F.bx); S.nmt = MC / 256;
                pg8::EpiMerge E{WSP(bf16, WS_G), WSP(bf16, WS_MG), MC / 256};
                run_gemm(F, WSP(bf16, WS_Y), WSP(bf16, WS_WBR), 3 * MC, 3 * DM, 256, S, E);
            STEP_END
            STEP_BEGIN
                pg8::StaticOrder S; S.init(MC, DM, F.G, F.bx);
                const float* base = (layer == 0 ? F.in[0] : F.out) + (size_t)c * MC * DM;
                pg8::EpiResid E{base, F.out + (size_t)c * MC * DM, DM, 1.0f};
                run_gemm(F, WSP(bf16, WS_MG), WSP(bf16, WS_WOUT), MC, DM, DM, S, E);
            STEP_END
        }
        if ((layer & 1) == 0) {
            STEP_BEGIN
                p_norm<0>(F, F.out, F.in[11] + (size_t)layer * DM, nullptr, 0, Q8_HN, TILED_FFN1);
            STEP_END
            for (int c = 0; c < FFN_CHUNKS; ++c) {
                constexpr int MF = MTOK / FFN_CHUNKS;
                STEP_BEGIN
                    pg8::StaticOrder S; S.init(MF, NFF1, F.G, F.bx, WGM_FFN1);
                    pg8::EpiSwiGLU E{WSP(bf16, WS_HID), DFFP, nullptr, NFF1 / 256};
                    run_gemm(F, WSP(bf16, WS_HN) + (size_t)c * MF * DM, WSP(bf16, WS_WF1), MF, NFF1, DM, S, E, true, TILED_FFN1);
                STEP_END
                STEP_BEGIN
                    pg8::StaticOrder S; S.init(MF, DM, F.G, F.bx, WGM_FFN2);
                    pg8::EpiResid E{F.out + (size_t)c * MF * DM, F.out + (size_t)c * MF * DM, DM, 1.0f};
                    run_gemm(F, WSP(bf16, WS_HID), WSP(bf16, WS_WF2), MF, DM, DFFP, S, E);
                STEP_END
            }
        } else {
            STEP_BEGIN
                p_norm<1>(F, F.out, F.in[11] + (size_t)layer * DM, F.in[15] + (size_t)jj * DM * NEXP, jj, Q8_HN);
            STEP_END
#ifdef ABL_DENSE_MOE
            for (int e = 0; e < NEXP; ++e) {
                STEP_BEGIN
                    pg8::StaticOrder S; S.init(MTOK, NMOE1, F.G, F.bx);
                    pg8::EpiSwiGLU E{WSP(bf16, WS_SCR + 8 * MiB), DFE, WSP(float, WS_SCR + 4 * MiB) + (size_t)e * MTOK, NMOE1 / 256};
                    run_gemm(F, WSP(bf16, WS_HN), WSP(bf16, WS_WF1) + (size_t)e * NMOE1 * DM, MTOK, NMOE1, DM, S, E);
                STEP_END
                STEP_BEGIN
                    pg8::StaticOrder S; S.init(MTOK, DM, F.G, F.bx);
                    pg8::EpiResid E{F.out, F.out, DM, 1.0f};
                    run_gemm(F, WSP(bf16, WS_SCR + 8 * MiB), WSP(bf16, WS_WF2) + (size_t)e * DM * DFE, MTOK, DM, DFE, S, E);
                STEP_END
            }
#else
            STEP_BEGIN
                p_gather(F, jj, 0, 0);
            STEP_END
            for (int c = 0; c < NCHUNK; ++c)
                for (int r = 0; r < 2; ++r) {
                    STEP_BEGIN
                        const int T = moe_table(F, jj, c, r);
                        pg8::GroupedOrder S; S.so.init(T * 256, NMOE1, F.G, F.bx, WGM_MOE1); S.tile_e = (LAS int*)(F.lds + TAB_OFF); S.nN = NMOE1 / 256;
                        pg8::EpiSwiGLU E{WSP(bf16, WS_HIDM), DFE, WSP(float, WS_WSLOT) + (c * 2 + r) * SLOTS, NMOE1 / 256};
                        run_gemm(F, WSP(bf16, WS_XG), WSP(bf16, WS_WF1), T * 256, NMOE1, DM, S, E, false);
                    STEP_END
                    STEP_BEGIN
                        const int T = moe_table(F, jj, c, r);
                        const int nwg = T * (DM / 256), R = nwg % F.G, full = nwg - R;
                        const bool split = (hi - lo > 1) && R > 0 && 2 * R <= F.G && !F.rep;
                        int* tokm = WSP(int, WS_TOKMAP) + (c * 2 + r) * SLOTS; float* TB = WSP(float, WS_SCR + 320 * MiB);
                        { pg8::LimitOrder S; S.so.init(T * 256, DM, F.G, F.bx, WGM_MOE2); S.limit = split ? full : nwg;
                          pg8::GroupedLimit GS{S, (LAS int*)(F.lds + TAB_OFF), DM / 256};
                          pg8::EpiScatter E{F.out, tokm, DM / 256, 1.0f};
                          run_gemm(F, WSP(bf16, WS_HIDM), WSP(bf16, WS_WF2), T * 256, DM, DFE, GS, E, false); }
                        const bool more = c * 2 + r < 3;
                        if (split) {
                            if (F.bx < 2 * R) { const int Lx = full + (F.bx >> 1), kh = F.bx & 1;
                                pg8::StaticOrder so; so.init(T * 256, DM, F.G, Lx % F.G, WGM_MOE2); pg8::Unit un; so.next(Lx / F.G, un);
                                un.pn += ((LAS int*)(F.lds + TAB_OFF))[un.pm] * (DM / 256);
                                pg8::SingleOrder S1{un};
                                if (kh == 0) { pg8::EpiScatter E{F.out, tokm, DM / 256, 1.0f};
                                    run_gemm(F, WSP(bf16, WS_HIDM), WSP(bf16, WS_WF2), T * 256, DM, DFE / 2, S1, E, false, 0, DFE); }
                                else { pg8::EpiTile E{TB + (size_t)(Lx - full) * 65536};
                                    run_gemm(F, WSP(bf16, WS_HIDM) + DFE / 2, WSP(bf16, WS_WF2) + DFE / 2, T * 256, DM, DFE / 2, S1, E, false, 0, DFE); } }
                            if (more) p_gather(F, jj, (c * 2 + r + 1) >> 1, (c * 2 + r + 1) & 1, 2 * R);
                            { unsigned zb_; asm volatile("v_mov_b32 %0, 0" : "=v"(zb_)); bar.z = zb_; xcd_barrier(bar); }
                            for (int it = (F.vcu * NWAVES + F.wave); it < R * 256; it += F.G * NWAVES) { const int j = it >> 8, row = it & 255, Lx = full + j;
                                pg8::StaticOrder so; so.init(T * 256, DM, F.G, Lx % F.G, WGM_MOE2); pg8::Unit un; so.next(Lx / F.G, un);
                                const int t = tokm[un.pm * 256 + row];
                                if (t >= 0) { f32x4* hp = (f32x4*)(F.out + (size_t)t * DM + un.pn * 256) + F.lane; *hp = *hp + ((const f32x4*)(TB + (size_t)j * 65536 + row * 256))[F.lane]; } }
                        } else if (!F.rep && more) p_gather(F, jj, (c * 2 + r + 1) >> 1, (c * 2 + r + 1) & 1, R);
                    STEP_END
                }
#endif
        }
    }
    STEP_BEGIN
        p_norm<2>(F, F.out, F.in[19], nullptr, 0);
    STEP_END
#undef STEP_BEGIN
#undef STEP_END
}

#ifndef MK_STEPS_PER_LAUNCH
#define MK_STEPS_PER_LAUNCH 1
#endif
extern "C" void kernel_launch(void* const* d_in, const int* in_sizes, int n_in, void* d_out, int out_size, void* d_ws, size_t ws_size, hipStream_t stream) {
    static int grid = 0;
    if (grid == 0) {
        if (n_in != 20 || in_sizes[0] != MTOK * DM || out_size != MTOK * DM || ws_size < WS_END) { fprintf(stderr, "kernel_launch: unexpected shapes (n_in %d, in0 %d, out %d, ws %zu)\n", n_in, n_in > 0 ? in_sizes[0] : -1, out_size, ws_size); grid = -1; return; }
        int dev = 0, cus = 0, per_cu = 0;
        if (hipGetDevice(&dev) != hipSuccess || hipDeviceGetAttribute(&cus, hipDeviceAttributeMultiprocessorCount, dev) != hipSuccess) { grid = -1; return; }
        if (hipFuncSetAttribute((const void*)mk_fwd, hipFuncAttributeMaxDynamicSharedMemorySize, LDS_BYTES) != hipSuccess) { fprintf(stderr, "kernel_launch: hipFuncSetAttribute failed\n"); grid = -1; return; }
        if (hipOccupancyMaxActiveBlocksPerMultiprocessor(&per_cu, (const void*)mk_fwd, NWAVES * 64, LDS_BYTES) != hipSuccess || per_cu < 1) fprintf(stderr, "kernel_launch: occupancy query reports %d\n", per_cu);
        (void)hipGetLastError();
        grid = cus;
    }
    if (grid < 0) return;
    if (hipMemsetAsync((char*)d_ws + WS_CTL, 0, CTL_ZERO_BYTES, stream) != hipSuccess) return;
    Args a{};
    for (int i = 0; i < 20; ++i) a.in[i] = (const float*)d_in[i];
    a.out = (float*)d_out; a.ws = (unsigned char*)d_ws; a.rep = 0;
    #ifdef ABL_DENSE_MOE
    constexpr int NSTEPS = 2 * (1 + NCHUNK * 8 + 3) + 2 * (1 + NCHUNK * 8 + 1 + NEXP * 2) + 1;
#else
    constexpr int NSTEPS = 2 * (1 + NCHUNK * 7 + 1 + 2 * FFN_CHUNKS) + 2 * (1 + NCHUNK * 7 + 2 + NCHUNK * 2 * 2) + 1;
#endif
    int li = 0;
#ifdef REPMASK
    static int kinds[256]; int ns = 0;
    for (int layer = 0; layer < DEPTH; ++layer) { kinds[ns++] = 0;
        for (int c = 0; c < NCHUNK; ++c) for (int q = 1; q <= 8; ++q) if (q != 5) kinds[ns++] = q;
        if ((layer & 1) == 0) { kinds[ns++] = 9; for (int c = 0; c < FFN_CHUNKS; ++c) { kinds[ns++] = 10; kinds[ns++] = 11; } }
        else { kinds[ns++] = 12; kinds[ns++] = 17; for (int c = 0; c < NCHUNK * 2; ++c) { kinds[ns++] = 14; kinds[ns++] = 13; } } }
    kinds[ns++] = 16;
    for (int s = 0; s < NSTEPS; ++s) { const int reps = ((REPMASK >> kinds[s]) & 1) ? 2 : 1;
        for (int r = 0; r < reps; ++r) { a.lo = s; a.hi = s + 1; a.li = 0; a.rep = r;
            hipLaunchKernelGGL(mk_fwd, dim3(grid), dim3(NWAVES * 64), LDS_BYTES, stream, a); } }
    (void)li;
#else
    for (int s = 0; s < NSTEPS; s += MK_STEPS_PER_LAUNCH) {
        a.lo = s; a.hi = (s + MK_STEPS_PER_LAUNCH < NSTEPS) ? s + MK_STEPS_PER_LAUNCH : NSTEPS; a.li = (MK_STEPS_PER_LAUNCH > 1) ? li : 0; ++li;
        hipLaunchKernelGGL(mk_fwd, dim3(grid), dim3(NWAVES * 64), LDS_BYTES, stream, a);
        if (hipPeekAtLastError() != hipSuccess) { fprintf(stderr, "kernel_launch: launch failed\n"); break; }
    }
#endif
}
```

```cpp
#define MK_STEPS_PER_LAUNCH 1000
#define PG8_WGM 4
#define FFN_CHUNKS 1
#include <hip/hip_runtime.h>
#include <cstdio>
#include <cstdint>
#include <cmath>
#ifndef PG8_AUX_A
#define PG8_AUX_A 0
#endif
#ifndef PG8_AUX_B
#define PG8_AUX_B 0
#endif
#ifndef PG8_WGM
#define PG8_WGM 8
#endif
namespace pg8 {
#define PG8_LAS __attribute__((address_space(3)))
typedef unsigned short bf16_t;
typedef short bf16x8 __attribute__((ext_vector_type(8)));
typedef float f32x4 __attribute__((ext_vector_type(4)));
typedef unsigned u32x4 __attribute__((ext_vector_type(4)));
constexpr int BM = 256, BK = 64, HALF = 128, HTB = HALF * BK * 2  , STAGE_BYTES = 8 * HTB, NXCD = 8, WGM = PG8_WGM;

__host__ __device__ __forceinline__ int lds_byte(int r, int c) { const int st = (r >> 4) * 2 + (c >> 5), rr = r & 15, cc = c & 31, ob = rr * 64 + cc * 2; return st * 1024 + (ob ^ (((ob >> 9) & 1) << 5)); }
__host__ __device__ __forceinline__ void stage_rc(int b, int& R, int& C) { const int st = b / 1024, sb = b % 1024, swz = sb ^ (((sb >> 9) & 1) << 5); R = (st >> 1) * 16 + swz / 64; C = (st & 1) * 32 + (swz % 64) / 2; }
__host__ __device__ __forceinline__ int perm32(int rho) { const int n = rho >> 4, i = rho & 15; return 8 * (i >> 2) + 4 * n + (i & 3); }

struct Unit { int pm, pn; };
struct Gemm { const bf16_t* A; const bf16_t* Bt; int M, N, K; int zv; int rot; int tiled; int ld; };

struct StaticOrder {
    int nM, nN, nwg, G, c, wgm;
    __host__ __device__ __forceinline__ void init(int M, int N, int G_, int c_, int wgm_ = WGM) { nM = M / BM; nN = N / BM; nwg = nM * nN; G = G_; c = c_; wgm = wgm_; }
    __host__ __device__ __forceinline__ bool next(int i, Unit& u) const {
        const long L = (long)i * G + c; if (L >= nwg) return false;
        int wgid = (int)L; { const int q = nwg / NXCD, r = nwg % NXCD, xcd = wgid % NXCD, off = wgid / NXCD; wgid = (xcd < r ? xcd * (q + 1) : r * (q + 1) + (xcd - r) * q) + off; }
        const int nig = wgm * nN, gid = wgid / nig, fm = gid * wgm, gsz = (nM - fm) < wgm ? (nM - fm) : wgm;
        u.pm = fm + ((wgid % nig) % gsz); u.pn = (wgid % nig) / gsz; return true;
    }
    __device__ __forceinline__ void a_ready(const Unit&) const {}
    __device__ __forceinline__ void done(const Unit&) const {}
};

__device__ __forceinline__ unsigned cvt_pk_bf16(float lo, float hi) { unsigned r; asm volatile("v_cvt_pk_bf16_f32 %0, %1, %2" : "=v"(r) : "v"(lo), "v"(hi)); return r; }
typedef float f32x2 __attribute__((ext_vector_type(2)));

__device__ __forceinline__ float fast_sigmoid(float x) { return __builtin_amdgcn_rcpf(1.0f + __builtin_amdgcn_exp2f(-1.4426950408889634f * x)); }
__device__ __forceinline__ float gelu_tanh(float x) {
    const float u2 = 1.5957691216057308f * (x + 0.044715f * x * x * x);
    return x * fast_sigmoid(u2);
}
__device__ __forceinline__ float bf_lo(unsigned u) { return __builtin_bit_cast(float, u << 16); }
__device__ __forceinline__ float bf_hi(unsigned u) { return __builtin_bit_cast(float, u & 0xffff0000u); }

#ifdef PG8_NT_OUT
#define PG8_STORE_OUT(p, v) __builtin_nontemporal_store((v), (p))
#else
#define PG8_STORE_OUT(p, v) (*(p) = (v))
#endif
struct EpiProj {
    static constexpr bool PERM = true, AFTER_DRAIN = false, MID = false; static constexpr int MID_TILES = 1; __device__ __forceinline__ void set_scale0() {}
    bf16_t* P1; bf16_t* G;
    __device__ __forceinline__ void operator()(const f32x4 (&acc)[2][2][4][2], const Unit& u, int wr, int wc, int fr, int fq) const {
        const int row0 = u.pm * BM + wr * 64 + fr;
        bf16_t* base; int ldc, colt, act0, act1;
        if (u.pn < 8) { base = P1; ldc = 2048; colt = u.pn * BM; act0 = (u.pn < 2) ? 1 : 0; act1 = (u.pn == 7) ? 2 : act0; }
        else { base = G; ldc = 3072; colt = (u.pn - 8) * BM; act0 = 2; act1 = 2; }
        const int col0 = colt + wc * 32 + 8 * fq;
#pragma unroll
        for (int ai = 0; ai < 2; ++ai)
#pragma unroll
            for (int m = 0; m < 4; ++m) { bf16_t* rowp = base + (size_t)(row0 + ai * HALF + m * 16) * ldc + col0;
#pragma unroll
                for (int bj = 0; bj < 2; ++bj) { f32x4 v0 = acc[ai][bj][m][0], v1 = acc[ai][bj][m][1]; const int act = bj ? act1 : act0;
                    if (act == 1) {
#pragma unroll
                        for (int e = 0; e < 4; ++e) { v0[e] = gelu_tanh(v0[e]); v1[e] = gelu_tanh(v1[e]); } }
                    else if (act == 2) {
#pragma unroll
                        for (int e = 0; e < 4; ++e) { v0[e] = fast_sigmoid(v0[e]); v1[e] = fast_sigmoid(v1[e]); } }
                    u32x4 w; w.x = cvt_pk_bf16(v0[0], v0[1]); w.y = cvt_pk_bf16(v0[2], v0[3]); w.z = cvt_pk_bf16(v1[0], v1[1]); w.w = cvt_pk_bf16(v1[2], v1[3]);
                    *(u32x4*)(rowp + bj * HALF) = w; } }
    }
};
struct EpiMerge {
    static constexpr bool PERM = true, AFTER_DRAIN = false, MID = false; static constexpr int MID_TILES = 1; __device__ __forceinline__ void set_scale0() {}
    const bf16_t* G; bf16_t* MG; int nmt;
    __device__ __forceinline__ void operator()(const f32x4 (&acc)[2][2][4][2], const Unit& u, int wr, int wc, int fr, int fq) const {
        const int i = u.pn >> 2, pn = u.pn & 3, pm = u.pm - i * nmt;
        const int row0 = pm * BM + wr * 64 + fr, col0 = pn * BM + wc * 32 + 8 * fq;
#pragma unroll
        for (int ai = 0; ai < 2; ++ai)
#pragma unroll
            for (int mp = 0; mp < 2; ++mp) {
                u32x4 g[4], o[4];
#pragma unroll
                for (int q = 0; q < 4; ++q) { const int m = 2 * mp + (q >> 1), bj = q & 1; const size_t row = (size_t)(row0 + ai * HALF + m * 16); const int col = col0 + bj * HALF;
                    g[q] = *(const u32x4*)(G + row * 3072 + i * 1024 + col);
                    if (i > 0) o[q] = *(const u32x4*)(MG + row * 1024 + col); else o[q] = (u32x4){0u, 0u, 0u, 0u}; }
#pragma unroll
                for (int q = 0; q < 4; ++q) { const int m = 2 * mp + (q >> 1), bj = q & 1; const size_t row = (size_t)(row0 + ai * HALF + m * 16); const int col = col0 + bj * HALF;
                    f32x4 v0 = acc[ai][bj][m][0], v1 = acc[ai][bj][m][1];
#ifdef ABL_BRANCH
                    if (i == ABL_BRANCH) { v0 = v0 * (float)ABL_SCALE; v1 = v1 * (float)ABL_SCALE; }
#endif
                    v0[0] = v0[0] * bf_lo(g[q].x) + bf_lo(o[q].x); v0[1] = v0[1] * bf_hi(g[q].x) + bf_hi(o[q].x); v0[2] = v0[2] * bf_lo(g[q].y) + bf_lo(o[q].y); v0[3] = v0[3] * bf_hi(g[q].y) + bf_hi(o[q].y);
                    v1[0] = v1[0] * bf_lo(g[q].z) + bf_lo(o[q].z); v1[1] = v1[1] * bf_hi(g[q].z) + bf_hi(o[q].z); v1[2] = v1[2] * bf_lo(g[q].w) + bf_lo(o[q].w); v1[3] = v1[3] * bf_hi(g[q].w) + bf_hi(o[q].w);
                    u32x4 w; w.x = cvt_pk_bf16(v0[0], v0[1]); w.y = cvt_pk_bf16(v0[2], v0[3]); w.z = cvt_pk_bf16(v1[0], v1[1]); w.w = cvt_pk_bf16(v1[2], v1[3]);
                    *(u32x4*)(MG + row * 1024 + col) = w; } }
    }
};
struct EpiResid {
    static constexpr bool PERM = false, AFTER_DRAIN = false, MID = false; static constexpr int MID_TILES = 1; __device__ __forceinline__ void set_scale0() { scale = 0.f; base = out; }
    const float* base; float* out; int ldc; float scale;
    __device__ __forceinline__ void operator()(const f32x4 (&acc)[2][2][4][2], const Unit& u, int wr, int wc, int fr, int fq) const {
        const int row0 = u.pm * BM + wr * 64 + fr, col0 = u.pn * BM + wc * 32 + 4 * fq;
#pragma unroll
        for (int ai = 0; ai < 2; ++ai)
#pragma unroll
            for (int mp = 0; mp < 2; ++mp) {
                f32x4 b[8];
#pragma unroll
                for (int q = 0; q < 8; ++q) { const int m = 2 * mp + (q >> 2), bj = (q >> 1) & 1, n = q & 1;
                    b[q] = *(const f32x4*)(base + (size_t)(row0 + ai * HALF + m * 16) * ldc + col0 + bj * HALF + n * 16); }
#pragma unroll
                for (int q = 0; q < 8; ++q) { const int m = 2 * mp + (q >> 2), bj = (q >> 1) & 1, n = q & 1;
                    *(f32x4*)(out + (size_t)(row0 + ai * HALF + m * 16) * ldc + col0 + bj * HALF + n * 16) = b[q] + acc[ai][bj][m][n] * scale; } }
    }
};
struct EpiF32 {
    static constexpr bool PERM = false, AFTER_DRAIN = false, MID = false; static constexpr int MID_TILES = 1; __device__ __forceinline__ void set_scale0() {}
    float* O; int ldc, nN;
    __device__ __forceinline__ void operator()(const f32x4 (&acc)[2][2][4][2], const Unit& u, int wr, int wc, int fr, int fq) const {
        const int row0 = u.pm * BM + wr * 64 + fr, col0 = (u.pn % nN) * BM + wc * 32 + 4 * fq;
#pragma unroll
        for (int ai = 0; ai < 2; ++ai)
#pragma unroll
            for (int m = 0; m < 4; ++m) { const size_t off = (size_t)(row0 + ai * HALF + m * 16) * ldc + col0;
#pragma unroll
                for (int bj = 0; bj < 2; ++bj)
#pragma unroll
                    for (int n = 0; n < 2; ++n) *(f32x4*)(O + off + bj * HALF + n * 16) = acc[ai][bj][m][n]; }
    }
};
#ifdef EMU_FP8_HID
__device__ __forceinline__ float Q8H(float x) { const int p = __builtin_amdgcn_cvt_pk_fp8_f32(x * 8.f, x * 8.f, 0, false); return __builtin_amdgcn_cvt_f32_fp8(p, 0) * 0.125f; }
#else
__device__ __forceinline__ float Q8H(float x) { return x; }
#endif
struct EpiSwiGLU {
    static constexpr bool PERM = true, AFTER_DRAIN = false, MID = false; static constexpr int MID_TILES = 1; __device__ __forceinline__ void set_scale0() {}
    bf16_t* H; int ldh; const float* rowscale; int nN; int rowmask = 0x7fffffff;
    __device__ __forceinline__ void operator()(const f32x4 (&acc)[2][2][4][2], const Unit& u, int wr, int wc, int fr, int fq) const {
        const int row0 = u.pm * BM + wr * 64 + fr, col0 = (u.pn % nN) * HALF + wc * 32 + 8 * fq;
        float scv[8];
#pragma unroll
        for (int q = 0; q < 8; ++q) scv[q] = rowscale ? rowscale[row0 + (q >> 2) * HALF + (q & 3) * 16] : 1.0f;
#pragma unroll
        for (int ai = 0; ai < 2; ++ai)
#pragma unroll
            for (int m = 0; m < 4; ++m) { const int row = row0 + ai * HALF + m * 16; const float sc = scv[ai * 4 + m];
                float h[8];
#pragma unroll
                for (int n = 0; n < 2; ++n)
#pragma unroll
                    for (int e = 0; e < 4; ++e) { const float g = acc[ai][0][m][n][e], up = acc[ai][1][m][n][e]; h[n * 4 + e] = Q8H(g * fast_sigmoid(g) * up * sc); }
                u32x4 w; w.x = cvt_pk_bf16(h[0], h[1]); w.y = cvt_pk_bf16(h[2], h[3]); w.z = cvt_pk_bf16(h[4], h[5]); w.w = cvt_pk_bf16(h[6], h[7]);
                PG8_STORE_OUT((u32x4*)(H + (size_t)(row & rowmask) * ldh + col0), w); }
    }
};
struct EpiScatter {
    static constexpr bool PERM = false, AFTER_DRAIN = false, MID = false; static constexpr int MID_TILES = 1; __device__ __forceinline__ void set_scale0() { scale = 0.f; }
    float* out; const int* tok; int nN; float scale;
    __device__ __forceinline__ void operator()(const f32x4 (&acc)[2][2][4][2], const Unit& u, int wr, int wc, int fr, int fq) const {
        const int row0 = u.pm * BM + wr * 64 + fr, col0 = (u.pn % nN) * BM + wc * 32 + 4 * fq;
        int tk[8];
#pragma unroll
        for (int q = 0; q < 8; ++q) tk[q] = tok[row0 + (q >> 2) * HALF + (q & 3) * 16];
#pragma unroll
        for (int ai = 0; ai < 2; ++ai)
#pragma unroll
            for (int mp = 0; mp < 2; ++mp) {
                f32x4 b[8];
#pragma unroll
                for (int q = 0; q < 8; ++q) { const int m = 2 * mp + (q >> 2), bj = (q >> 1) & 1, n = q & 1; const int t = tk[ai * 4 + m];
                    b[q] = *(const f32x4*)(out + (size_t)(t < 0 ? 0 : t) * 1024 + col0 + bj * HALF + n * 16); }
#pragma unroll
                for (int q = 0; q < 8; ++q) { const int m = 2 * mp + (q >> 2), bj = (q >> 1) & 1, n = q & 1; const int t = tk[ai * 4 + m];
#ifdef ABL_MOE
                    if (false)
#else
                    if (t >= 0)
#endif
                        *(f32x4*)(out + (size_t)t * 1024 + col0 + bj * HALF + n * 16) = b[q] + acc[ai][bj][m][n] * scale; } }
    }
};
struct GroupedOrder {
    StaticOrder so; const PG8_LAS int* tile_e; int nN;
    __device__ __forceinline__ bool next(int i, Unit& u) const { if (!so.next(i, u)) return false; u.pn += tile_e[u.pm] * nN; return true; }
    __device__ __forceinline__ void a_ready(const Unit&) const {}
    __device__ __forceinline__ void done(const Unit&) const {}
};
struct LimitOrder {
    StaticOrder so; int limit;
    __device__ __forceinline__ bool next(int i, Unit& u) const { if ((long)i * so.G + so.c >= limit) return false; return so.next(i, u); }
    __device__ __forceinline__ void a_ready(const Unit&) const {}
    __device__ __forceinline__ void done(const Unit&) const {}
};
struct GroupedLimit {
    LimitOrder lo; const PG8_LAS int* tile_e; int nN;
    __device__ __forceinline__ bool next(int i, Unit& u) const { if (!lo.next(i, u)) return false; u.pn += tile_e[u.pm] * nN; return true; }
    __device__ __forceinline__ void a_ready(const Unit&) const {}
    __device__ __forceinline__ void done(const Unit&) const {}
};
struct SingleOrder {
    Unit un;
    __device__ __forceinline__ bool next(int i, Unit& u) const { if (i != 0) return false; u = un; return true; }
    __device__ __forceinline__ void a_ready(const Unit&) const {}
    __device__ __forceinline__ void done(const Unit&) const {}
};
struct EpiTile {
    static constexpr bool PERM = false, AFTER_DRAIN = false, MID = false; static constexpr int MID_TILES = 1; __device__ __forceinline__ void set_scale0() {}
    float* O;
    __device__ __forceinline__ void operator()(const f32x4 (&acc)[2][2][4][2], const Unit&, int wr, int wc, int fr, int fq) const {
#pragma unroll
        for (int ai = 0; ai < 2; ++ai)
#pragma unroll
            for (int m = 0; m < 4; ++m)
#pragma unroll
                for (int bj = 0; bj < 2; ++bj)
#pragma unroll
                    for (int n = 0; n < 2; ++n) *(f32x4*)(O + (size_t)(wr * 64 + fr + ai * HALF + m * 16) * 256 + wc * 32 + 4 * fq + bj * HALF + n * 16) = acc[ai][bj][m][n];
    }
};
struct OffsetOrder {
    StaticOrder so; int pn_off;
    __device__ __forceinline__ bool next(int i, Unit& u) const { if (!so.next(i, u)) return false; u.pn += pn_off; return true; }
    __device__ __forceinline__ void a_ready(const Unit&) const {}
    __device__ __forceinline__ void done(const Unit&) const {}
};
struct ProbeOrder {
    StaticOrder so; int pm_mask;
    __device__ __forceinline__ bool next(int i, Unit& u) const { if (!so.next(i, u)) return false; u.pm &= pm_mask; return true; }
    __device__ __forceinline__ void a_ready(const Unit&) const {}
    __device__ __forceinline__ void done(const Unit&) const {}
};
struct MergeOrder {
    StaticOrder so; int nmt;
    __device__ __forceinline__ bool next(int i, Unit& u) const { const int b = i % 3; if (!so.next(i / 3, u)) return false; u.pm += b * nmt; u.pn += b * 4; return true; }
    __device__ __forceinline__ void a_ready(const Unit&) const {}
    __device__ __forceinline__ void done(const Unit&) const {}
};
template <class Epi, class Sched, bool ALIGN_EPI = false, bool SP2 = false>
__device__ __forceinline__ void gemm_phase(PG8_LAS unsigned char* lds, const Gemm g, const Sched& S, const Epi& E) {
    const int tid = g.zv  , wid = __builtin_amdgcn_readfirstlane(tid >> 6), lane = tid & 63, wr = wid >> 2, wc = wid & 3, fr = lane & 15, fq = lane >> 4;
    const int K = g.K, nt = K / BK;
    unsigned voffA[2], voffB[2];
#pragma unroll
    for (int i = 0; i < 2; ++i) { int R, C; stage_rc(tid * 16 + i * 8192, R, C); const int Rb = Epi::PERM ? ((R & ~31) + perm32(R & 31)) : R;
        const int LD = g.ld ? g.ld : K;
        const int pitch = g.tiled ? BK : LD;
        voffA[i] = (unsigned)(R * pitch + C) * 2u; voffB[i] = (unsigned)(Rb * pitch + C) * 2u; }
    const size_t kstep = g.tiled ? (size_t)(BM * BK * 2) : (size_t)(BK * 2);
    const size_t hstep = g.tiled ? (size_t)(HALF * BK * 2) : (size_t)HALF * (g.ld ? g.ld : K) * 2;
    const size_t tstep = (size_t)BM * (g.ld ? g.ld : K) * 2;
    const unsigned ldsw = (unsigned)wid * 1024u;
    const int aoff = lds_byte(wr * 64 + fr, fq * 8), boff = lds_byte(wc * 32 + fr, fq * 8);
#define PG8_SA(b, h) (((b) * 2 + (h)) * HTB)
#define PG8_SB(b, h) ((4 + (b) * 2 + (h)) * HTB)
#define PG8_STAGE(bufoff, gbase, voff) do { _Pragma("unroll") for (int _i = 0; _i < 2; ++_i) \
        __builtin_amdgcn_global_load_lds((const unsigned*)((const char*)(gbase) + (voff)[_i]), (PG8_LAS unsigned*)(lds + (bufoff) + ldsw + _i * 8192), 16, 0, ((bufoff) < 4 * HTB) ? PG8_AUX_A : PG8_AUX_B); } while (0)
#define PG8_LDA(dst, b, h) do { _Pragma("unroll") for (int m = 0; m < 4; ++m) _Pragma("unroll") for (int k = 0; k < 2; ++k) dst[m][k] = *(const PG8_LAS bf16x8*)(lds + PG8_SA(b, h) + aoff + m * 2048 + k * 1024); } while (0)
#define PG8_LDB(dst, b, h) do { _Pragma("unroll") for (int n = 0; n < 2; ++n) _Pragma("unroll") for (int k = 0; k < 2; ++k) dst[n][k] = *(const PG8_LAS bf16x8*)(lds + PG8_SB(b, h) + boff + n * 2048 + k * 1024); } while (0)
#define PG8_MMA(ai, bj, At, Bt) do { __builtin_amdgcn_s_setprio(1); _Pragma("unroll") for (int m = 0; m < 4; ++m) _Pragma("unroll") for (int n = 0; n < 2; ++n) _Pragma("unroll") for (int k = 0; k < 2; ++k) \
        acc[ai][bj][m][n] = __builtin_amdgcn_mfma_f32_16x16x32_bf16(Bt[n][k], At[m][k], acc[ai][bj][m][n], 0, 0, 0); __builtin_amdgcn_s_setprio(0); } while (0)
#define PG8_WAIT_V(n) asm volatile("s_waitcnt vmcnt(" #n ")" ::: "memory")
#define PG8_WAIT_L(n) asm volatile("s_waitcnt lgkmcnt(" #n ")" ::: "memory")
#define PG8_BAR __builtin_amdgcn_s_barrier()
#define PG8_SCHED __builtin_amdgcn_sched_barrier(0)
    Unit cur, nxt; int ui = 0;
    if (!S.next(0, cur)) return;
    f32x4 acc[2][2][4][2];
#pragma unroll
    for (int a = 0; a < 2; ++a)
#pragma unroll
        for (int b = 0; b < 2; ++b)
#pragma unroll
            for (int m = 0; m < 4; ++m)
#pragma unroll
                for (int n = 0; n < 2; ++n) acc[a][b][m][n] = (f32x4){0.f, 0.f, 0.f, 0.f};
    bf16x8 At[4][2], B0[2][2], B1[2][2];
    const char* cA = (const char*)g.A + (size_t)cur.pm * tstep; const char* cB = (const char*)g.Bt + (size_t)cur.pn * tstep;
    const int rot = g.rot; const size_t rofs = (size_t)rot * kstep; const char* pA = cA + rofs; const char* pB = cB + rofs;
#define PG8_KT(x) ((size_t)(((x) + rot >= nt) ? (x) + rot - nt : (x) + rot))
    S.a_ready(cur);
    if constexpr (SP2) {
        PG8_STAGE(PG8_SB(0, 0), pB, voffB); PG8_STAGE(PG8_SB(0, 1), pB + hstep, voffB); PG8_STAGE(PG8_SA(0, 0), pA, voffA); PG8_STAGE(PG8_SA(0, 1), pA + hstep, voffA);
        if (wr == 1) PG8_BAR;
        PG8_WAIT_V(2); PG8_BAR;
        PG8_STAGE(PG8_SB(1, 0), pB + kstep, voffB); PG8_STAGE(PG8_SA(1, 0), pA + kstep, voffA); PG8_STAGE(PG8_SB(1, 1), pB + hstep + kstep, voffB);
        PG8_WAIT_V(6); PG8_BAR;
    } else {
        PG8_STAGE(PG8_SB(0, 0), pB, voffB); PG8_STAGE(PG8_SA(0, 0), pA, voffA); PG8_STAGE(PG8_SB(0, 1), pB + hstep, voffB); PG8_STAGE(PG8_SA(0, 1), pA + hstep, voffA);
        if (wr == 1) PG8_BAR;
        PG8_WAIT_V(4); PG8_BAR;
        PG8_STAGE(PG8_SB(1, 0), pB + kstep, voffB); PG8_STAGE(PG8_SA(1, 0), pA + kstep, voffA); PG8_STAGE(PG8_SB(1, 1), pB + hstep + kstep, voffB);
        PG8_WAIT_V(6); PG8_BAR;
    }
    for (;;) {
        const bool has_next = S.next(ui + 1, nxt);
        const char* nA = has_next ? (const char*)g.A + (size_t)nxt.pm * tstep : cA; const char* nB = has_next ? (const char*)g.Bt + (size_t)nxt.pn * tstep : cB;
        for (int t = 0; t < nt; t += 2) {
            if constexpr (Epi::MID) { if (t != 0 && (t & (Epi::MID_TILES - 1)) == 0) E.mid(acc, cur, t / Epi::MID_TILES, wr, wc, fr, fq); }
            const bool last = (t == nt - 2);
            const char* a1 = cA + PG8_KT(t + 1) * kstep;
            const char* a2 = last ? nA + rofs : cA + PG8_KT(t + 2) * kstep; const char* b2 = last ? nB + rofs : cB + PG8_KT(t + 2) * kstep;
            const char* a3 = a2 + kstep; const char* b3 = b2 + kstep;
            if (last && has_next) S.a_ready(nxt);
            if constexpr (SP2) {
            PG8_LDB(B0, 0, 0); PG8_LDB(B1, 0, 1); PG8_SCHED; PG8_LDA(At, 0, 0); PG8_STAGE(PG8_SA(1, 1), a1 + hstep, voffA);
            PG8_WAIT_V(8); PG8_WAIT_L(0); PG8_BAR; PG8_MMA(0, 0, At, B0); PG8_MMA(0, 1, At, B1); PG8_BAR; PG8_SCHED;
            PG8_LDA(At, 0, 1); PG8_STAGE(PG8_SB(0, 0), b2, voffB); PG8_STAGE(PG8_SB(0, 1), b2 + hstep, voffB); PG8_STAGE(PG8_SA(0, 0), a2, voffA);
            PG8_WAIT_V(8); PG8_WAIT_L(0); PG8_BAR; PG8_MMA(1, 0, At, B0); PG8_MMA(1, 1, At, B1); PG8_BAR; PG8_SCHED;
            PG8_LDB(B0, 1, 0); PG8_LDB(B1, 1, 1); PG8_SCHED; PG8_LDA(At, 1, 0); PG8_STAGE(PG8_SA(0, 1), a2 + hstep, voffA);
            PG8_WAIT_V(8); PG8_WAIT_L(0); PG8_BAR; PG8_MMA(0, 0, At, B0); PG8_MMA(0, 1, At, B1); PG8_BAR; PG8_SCHED;
            PG8_LDA(At, 1, 1); PG8_STAGE(PG8_SB(1, 0), b3, voffB); PG8_STAGE(PG8_SB(1, 1), b3 + hstep, voffB); PG8_STAGE(PG8_SA(1, 0), a3, voffA);
            PG8_WAIT_V(8); PG8_WAIT_L(0); PG8_BAR; PG8_MMA(1, 0, At, B0); PG8_MMA(1, 1, At, B1); PG8_BAR; PG8_SCHED;
            } else {
            PG8_LDB(B0, 0, 0); PG8_SCHED; PG8_LDA(At, 0, 0); PG8_STAGE(PG8_SA(1, 1), a1 + hstep, voffA);
            PG8_WAIT_L(8); PG8_BAR; PG8_WAIT_L(0); PG8_MMA(0, 0, At, B0); PG8_BAR; PG8_SCHED;
            PG8_LDB(B1, 0, 1); PG8_STAGE(PG8_SB(0, 0), b2, voffB);
            PG8_BAR; PG8_WAIT_L(0); PG8_MMA(0, 1, At, B1); PG8_BAR;
            PG8_LDA(At, 0, 1); PG8_STAGE(PG8_SA(0, 0), a2, voffA);
            PG8_BAR; PG8_WAIT_L(0); PG8_MMA(1, 0, At, B0); PG8_BAR; PG8_SCHED;
            PG8_STAGE(PG8_SB(0, 1), b2 + hstep, voffB);
            PG8_WAIT_V(6); PG8_BAR; PG8_MMA(1, 1, At, B1); PG8_BAR;
            PG8_LDB(B0, 1, 0); PG8_SCHED; PG8_LDA(At, 1, 0); PG8_STAGE(PG8_SA(0, 1), a2 + hstep, voffA);
            PG8_WAIT_L(8); PG8_BAR; PG8_WAIT_L(0); PG8_MMA(0, 0, At, B0); PG8_BAR; PG8_SCHED;
            PG8_LDB(B1, 1, 1); PG8_STAGE(PG8_SB(1, 0), b3, voffB);
            PG8_BAR; PG8_WAIT_L(0); PG8_MMA(0, 1, At, B1); PG8_BAR;
            PG8_LDA(At, 1, 1); PG8_STAGE(PG8_SA(1, 0), a3, voffA);
            PG8_BAR; PG8_WAIT_L(0); PG8_MMA(1, 0, At, B0); PG8_BAR; PG8_SCHED;
            PG8_STAGE(PG8_SB(1, 1), b3 + hstep, voffB);
            PG8_WAIT_V(6); PG8_BAR; PG8_MMA(1, 1, At, B1); PG8_BAR;
            }
        }
        if constexpr (ALIGN_EPI) { if (wr == 0) PG8_BAR; }
        if constexpr (!Epi::AFTER_DRAIN) { E(acc, cur, wr, wc, fr, fq); S.done(cur); }
        if (!has_next) break;
#pragma unroll
        for (int a = 0; a < 2; ++a)
#pragma unroll
            for (int b = 0; b < 2; ++b)
#pragma unroll
                for (int m = 0; m < 4; ++m)
#pragma unroll
                    for (int n = 0; n < 2; ++n) acc[a][b][m][n] = (f32x4){0.f, 0.f, 0.f, 0.f};
        cur = nxt; cA = nA; cB = nB; ++ui;
        if constexpr (ALIGN_EPI) { if (wr == 1) PG8_BAR; }
    }
    PG8_WAIT_V(0);
    if constexpr (!ALIGN_EPI) { if (wr == 0) PG8_BAR; }
    PG8_BAR;
    if constexpr (Epi::AFTER_DRAIN) { E.fused(acc, cur, wr, wc, fr, fq, lds, wid, lane); S.done(cur); }
#undef PG8_KT
#undef PG8_SA
#undef PG8_SB
#undef PG8_STAGE
#undef PG8_LDA
#undef PG8_LDB
#undef PG8_MMA
#undef PG8_WAIT_V
#undef PG8_WAIT_L
#undef PG8_BAR
#undef PG8_SCHED
}
}

constexpr int NWAVES = 8;
constexpr int DM = 1024, BATCH = 16, SEQ = 4096, DEPTH = 4, MTOK = BATCH * SEQ;
constexpr int NCHUNK = 2, MC = MTOK / NCHUNK, BC = BATCH / NCHUNK;
constexpr int CIN = 5004, NPROJ = 5120, P1W = 2048, GWID = 3072;
constexpr int DFF = 2752, DFFP = 2816, NFF1 = 2 * DFFP;
constexpr int NEXP = 8, DFE = 3584, NMOE1 = 2 * DFE;
constexpr int SLOTS = MC + 2048;
constexpr float EPS = 1e-6f;
constexpr int C_U = 0, C_V = 256, C_SBQ = 512, C_SBK = 768, C_SBV = 1024, C_CQ = 1280, C_KCMP = 1536, C_VCMP = 1600, C_KSLC = 1664, C_VSLC = 1728, C_KWIN = 1792, C_VWIN = 1856, C_CG = 1920;

constexpr size_t MiB = 1u << 20;
constexpr size_t WS_CTL = 0, CTL_ZERO_BYTES = 1 * MiB;
constexpr size_t WS_ROPE = 1 * MiB;
constexpr size_t WS_BIAS1 = 1 * MiB + 512 * 1024;
constexpr size_t WS_WIN = 2 * MiB;
constexpr size_t WS_WBR = 12 * MiB;
constexpr size_t WS_WOUT = 14 * MiB;
constexpr size_t WS_WC1 = 16 * MiB;
constexpr size_t WS_WF1 = 18 * MiB;
constexpr size_t WS_WF2 = 130 * MiB;
constexpr size_t WS_HN = 186 * MiB;
constexpr size_t WS_SCR = 314 * MiB;
constexpr size_t WS_P1 = WS_SCR;
constexpr size_t WS_G = WS_P1 + 128 * MiB;
constexpr size_t WS_Y = WS_G + 192 * MiB;
constexpr size_t WS_MG = WS_Y + 48 * MiB;
constexpr size_t WS_KVC = WS_MG + 64 * MiB;
constexpr size_t WS_UL = WS_KVC + 8 * MiB;
constexpr size_t WS_KC = WS_UL + 8 * MiB;
constexpr size_t WS_VT = WS_KC + 1 * MiB;
constexpr size_t WS_KCT = WS_VT + 24 * MiB;
constexpr size_t WS_MIX_END = WS_KCT + 1 * MiB;
constexpr size_t WS_HID = WS_SCR;
constexpr size_t WS_ROUTE = WS_SCR;
constexpr size_t WS_TOKMAP = WS_SCR + 1 * MiB;
constexpr size_t WS_WSLOT = WS_SCR + 2 * MiB;
constexpr size_t WS_CNT128 = WS_SCR + 3 * MiB;
constexpr size_t WS_XG = WS_SCR + 4 * MiB;
constexpr size_t WS_HIDM = WS_XG + 68 * MiB;
constexpr size_t WS_END = 800 * MiB;
static_assert(WS_MIX_END <= WS_END && WS_HID + (size_t)MTOK * DFFP * 2 <= WS_END && WS_HIDM + (size_t)SLOTS * DFE * 2 <= WS_END, "d_ws map");
static_assert(WS_WF1 + (size_t)NEXP * NMOE1 * DM * 2 <= WS_WF2 && WS_WF2 + (size_t)NEXP * DM * DFE * 2 <= WS_HN, "weight map");
static_assert((size_t)4 * SLOTS * 4 <= 1 * MiB, "tokmap");
constexpr int CW_BAR = 4096;
constexpr int CW_CNT = 131072;
constexpr int CW_CUR = 131072 + 256;
constexpr int MAX_BAR_REGIONS = 32;
constexpr int RING_OFF = 0, RING_BYTES = 131072;
constexpr int LDSCTL_OFF = RING_BYTES, MISC_OFF = LDSCTL_OFF + 320;
constexpr int TAB_OFF = LDSCTL_OFF + 1024;
constexpr int LDS_BYTES = 147456;

#define GAS __attribute__((address_space(1)))
#define LAS __attribute__((address_space(3)))
typedef unsigned short bf16;
typedef unsigned v4u __attribute__((ext_vector_type(4)));
typedef unsigned v2u __attribute__((ext_vector_type(2)));
typedef float f32x4 __attribute__((ext_vector_type(4)));
typedef int v4i __attribute__((ext_vector_type(4)));
typedef __bf16 bf16x2_t __attribute__((ext_vector_type(2)));
#define LDS_WAIT() asm volatile("s_waitcnt lgkmcnt(0)" ::: "memory")
#define VM_WAIT() asm volatile("s_waitcnt vmcnt(0)" ::: "memory")
__device__ __forceinline__ unsigned f2bf(float f) { unsigned u = __builtin_bit_cast(unsigned, f); return (u + 0x7fffu + ((u >> 16) & 1u)) >> 16; }
__device__ __forceinline__ unsigned pk2(float lo, float hi) { return f2bf(lo) | (f2bf(hi) << 16); }
__device__ __forceinline__ float bflo(unsigned u) { return __builtin_bit_cast(float, u << 16); }
__device__ __forceinline__ float bfhi(unsigned u) { return __builtin_bit_cast(float, u & 0xffff0000u); }
__device__ __forceinline__ float bf1(bf16 h) { return __builtin_bit_cast(float, (unsigned)h << 16); }
__device__ __forceinline__ float dot2bf(unsigned a, unsigned b, float c) { return __builtin_amdgcn_fdot2_f32_bf16(__builtin_bit_cast(bf16x2_t, a), __builtin_bit_cast(bf16x2_t, b), c, false); }
#ifdef EMU_FP8
__device__ __forceinline__ float q8r(float x, float s) { const int p = __builtin_amdgcn_cvt_pk_fp8_f32(x * s, x * s, 0, false); return __builtin_amdgcn_cvt_f32_fp8(p, 0) * (1.0f / s); }
#else
__device__ __forceinline__ float q8r(float x, float) { return x; }
#endif
__device__ __forceinline__ float fexp(float x) { return __builtin_amdgcn_exp2f(1.4426950408889634f * x); }
template <int X> __device__ __forceinline__ float swz_xor(float v) { return __builtin_bit_cast(float, __builtin_amdgcn_ds_swizzle(__builtin_bit_cast(int, v), (X << 10) | 0x1f)); }
__device__ __forceinline__ float wave_sum(float v, int lane) {
#pragma unroll
    for (int o = 1; o < 64; o <<= 1) v += __builtin_bit_cast(float, __builtin_amdgcn_ds_bpermute((lane ^ o) << 2, __builtin_bit_cast(int, v)));
    return v;
}
__device__ __forceinline__ float rdlane(float v, int l) { return __builtin_bit_cast(float, __builtin_amdgcn_readlane(__builtin_bit_cast(int, v), l)); }
__device__ __forceinline__ int bperm(int srclane, int v) { return __builtin_amdgcn_ds_bpermute(srclane << 2, v); }
__constant__ double ROPE_INVF[8] = {1.0, 0.19392274474868576, 0.037606030930863933, 0.0072926647372171093, 0.0014142135623730950, 0.00027424817567620730, 5.3182958969449883e-05, 1.0313385377212460e-05};
#define XB_TMO      128
#define XB_XCNT(j)  (256  + 64 * (j))
#define XB_XSUB(j)  (1280 + 64 * (j))
#define XB_XGEN(j)  (2304 + 64 * (j))
#define XB_TOP      3328
#define XB_TOPGEN   3392
#define XCD_BAR_WORDS 3456
#define XB_SPIN_CAP (1u << 18)

__device__ __forceinline__ unsigned xb_ld(unsigned* p)              { return __hip_atomic_load(p, __ATOMIC_RELAXED, __HIP_MEMORY_SCOPE_AGENT); }
__device__ __forceinline__ unsigned xb_add(unsigned* p, unsigned v) { return __hip_atomic_fetch_add(p, v, __ATOMIC_RELAXED, __HIP_MEMORY_SCOPE_AGENT); }
__device__ __forceinline__ unsigned xb_xcc_id() { return (unsigned)__builtin_amdgcn_s_getreg((3 << 11) | 20) & 0xFu; }
#define XB_SPIN(cond, bar) do { unsigned _sp = 0; while (cond) { __builtin_amdgcn_s_sleep(1); \
    if ((++_sp & 255u) == 0u) { if (xb_ld(&(bar)[XB_TMO])) break; if (_sp > XB_SPIN_CAP) { atomicAdd(&(bar)[XB_TMO], 1u); break; } } } } while (0)

__device__ __forceinline__ bool xb_thread0_w(unsigned w, unsigned z) { return w == 0u && __builtin_amdgcn_mbcnt_hi(~0u, __builtin_amdgcn_mbcnt_lo(~0u, z)) == 0u; }
struct XcdBarrier {
    unsigned* bar; unsigned x; unsigned w, z;
    volatile LAS unsigned* st;
};

__device__ __forceinline__ XcdBarrier xcd_barrier_post(unsigned* bar, volatile LAS unsigned* st) {
    XcdBarrier b; b.bar = bar; b.x = xb_xcc_id(); b.st = st; b.w = (unsigned)__builtin_amdgcn_readfirstlane((int)(threadIdx.x >> 6)); b.z = 0u;
    if (xb_thread0_w(b.w, b.z)) (void)xb_add(&bar[XB_XCNT(b.x)], 1u);
    return b;
}
__device__ __forceinline__ void xcd_barrier_complete(unsigned* bar, unsigned x, unsigned& nloc, unsigned& nx) {
    const unsigned G = gridDim.x * gridDim.y * gridDim.z;
    unsigned sum, cnt, mine, sp = 0u;
    for (;;) {
        sum = 0u; cnt = 0u; mine = 0u;
#pragma unroll
        for (unsigned j = 0; j < 16; ++j) { const unsigned c = xb_ld(&bar[XB_XCNT(j)]); sum += c; cnt += (c > 0u) ? 1u : 0u; mine = (j == x) ? c : mine; }
        if (sum == G) break;
        __builtin_amdgcn_s_sleep(1);
        if ((++sp & 255u) == 0u) { if (xb_ld(&bar[XB_TMO])) break; if (sp > XB_SPIN_CAP) { atomicAdd(&bar[XB_TMO], 1u); break; } }
    }
    nloc = mine > 0u ? mine : 1u; nx = cnt > 0u ? cnt : 1u;
}

__device__ __forceinline__ void xcd_barrier(const XcdBarrier& b) {
    asm volatile("s_waitcnt vmcnt(0)" ::: "memory");
    __syncthreads();
    if (xb_thread0_w(b.w, b.z)) {
        unsigned* bar = b.bar;
        __builtin_amdgcn_s_waitcnt(0);
        unsigned nloc = b.st[0], nx = b.st[1];
        if (nloc == 0u) { xcd_barrier_complete(bar, b.x, nloc, nx); b.st[0] = nloc; b.st[1] = nx; }
        const unsigned old = xb_add(&bar[XB_XSUB(b.x)], 1u);
        const unsigned gen = old / nloc;
        if (old + 1u == (gen + 1u) * nloc) {
            __builtin_amdgcn_fence(__ATOMIC_RELEASE, "agent");
            asm volatile("s_waitcnt vmcnt(0)" ::: "memory");
            const unsigned og = xb_add(&bar[XB_TOP], 1u);
            const unsigned tg = og / nx;
            if (og + 1u == (tg + 1u) * nx) xb_add(&bar[XB_TOPGEN], 1u);
            else XB_SPIN(xb_ld(&bar[XB_TOPGEN]) == tg, bar);
            __builtin_amdgcn_fence(__ATOMIC_ACQUIRE, "agent");
            xb_add(&bar[XB_XGEN(b.x)], 1u);
            asm volatile("s_waitcnt vmcnt(0)" ::: "memory");
        } else {
            XB_SPIN(xb_ld(&bar[XB_XGEN(b.x)]) == gen, bar);
            __builtin_amdgcn_fence(__ATOMIC_ACQUIRE, "agent");
            asm volatile("s_waitcnt vmcnt(0)" ::: "memory");
        }
    }
    __syncthreads();
}

struct Frame {
    LAS unsigned char* lds;
    unsigned* ctl;
    int tid, lane, wave, vcu, G, bx, zv, zs, rep;
    unsigned char* ws;
    const float* const* in;
    float* out;
};
#define WSP(T, off) ((T*)(F.ws + (off)))
__device__ __forceinline__ size_t toff(int row, int k, int K) { return (size_t)(row >> 8) * 256 * K + (size_t)(k >> 6) * (256 * 64) + (size_t)(row & 255) * 64 + (k & 63); }

#ifndef TILED_FFN1
#define TILED_FFN1 0
#endif
#ifndef Q8_W1
#define Q8_W1 0.f
#define Q8_W2 0.f
#define Q8_HN 0.f
#define Q8_HID 0.f
#endif
__device__ __forceinline__ int map_row(int kind, int off, int n) { return kind == 0 ? n + off : (kind == 1 ? (n < 1932 ? n : n + 116) : ((n >> 7) * 256 + (n & 127) + off)); }
__device__ __forceinline__ void tr_item(const float* W, int ldw, int N, int ks, int n0, bf16* WT, int ldt, int kd, int kind, int off, LAS unsigned char* scr, int lane, float q8s = 0.f, int tiled = 0) {
    const int nq = (lane & 15) * 4, kq = lane >> 4;
    f32x4 x[16];
#pragma unroll
    for (int i = 0; i < 16; ++i) x[i] = (n0 + nq < N) ? *(const f32x4*)(W + (size_t)(ks + 4 * i + kq) * ldw + n0 + nq) : (f32x4){0.f, 0.f, 0.f, 0.f};
#pragma unroll
    for (int i = 0; i < 16; ++i) { const int k = 4 * i + kq;
#pragma unroll
        for (int c = 0; c < 4; ++c) { float wv = x[i][c]; if (q8s > 0.f) wv = q8r(wv, q8s); *(LAS bf16*)(scr + (nq + c) * 136 + k * 2) = (bf16)f2bf(wv); } }
    LDS_WAIT(); asm volatile("" ::: "memory");
    if (n0 + lane < N) { const LAS v2u* s = (const LAS v2u*)(scr + lane * 136); const int mr = map_row(kind, off, n0 + lane); bf16* dst = tiled ? WT + toff(mr, kd, ldt) : WT + (size_t)mr * ldt + kd;
#pragma unroll
        for (int q = 0; q < 8; ++q) { const v2u a = s[2 * q], b = s[2 * q + 1]; *(v4u*)(dst + 8 * q) = (v4u){a.x, a.y, b.x, b.y}; } }
    LDS_WAIT(); asm volatile("" ::: "memory");
}
__device__ __forceinline__ void conv(Frame& F, const float* W, size_t sW, int nb, int ldw, int N, int ks0, int K, bf16* WT, size_t sWT, int ldt, int kd0, int kind, int off, float q8s = 0.f, int tiled = 0) {
    LAS unsigned char* scr = F.lds + RING_OFF + F.wave * 16384;
    const int gw = F.vcu * NWAVES + F.wave, NGW = F.G * NWAVES;
    const int nblk = (N + 63) / 64, per = (K / 64) * nblk, total = per * nb;
    for (int it = gw; it < total; it += NGW) { const int b = it / per, r = it % per, kb = r / nblk, nbk = r % nblk;
        tr_item(W + (size_t)b * sW, ldw, N, ks0 + 64 * kb, 64 * nbk, WT + (size_t)b * sWT, ldt, kd0 + 64 * kb, kind, off, scr, F.lane, q8s, tiled); }
}
__device__ __forceinline__ void zero_block(Frame& F, bf16* WT, int ldt, int r0, int rows, int c0, int cols, int tiled = 0) {
    const int gt = (F.vcu * NWAVES + F.wave) * 64 + F.lane, NT = F.G * NWAVES * 64, cpr = cols / 8;
    for (int i = gt; i < rows * cpr; i += NT) { const int r = i / cpr, c = i % cpr; const unsigned z = (unsigned)F.zv; *(v4u*)(tiled ? WT + toff(r0 + r, c0 + 8 * c, ldt) : WT + (size_t)(r0 + r) * ldt + c0 + 8 * c) = (v4u){z, z, z, z}; }
}
__device__ __forceinline__ void p_convert(Frame& F, int layer) {
    const int j = layer >> 1;
    conv(F, F.in[2] + (size_t)layer * DM * CIN, 0, 1, CIN, CIN, 0, DM, WSP(bf16, WS_WIN), 0, DM, 0, 1, 0);
    zero_block(F, WSP(bf16, WS_WIN), DM, 1932, 116, 0, DM);
    conv(F, F.in[9] + (size_t)layer * 3 * 256 * DM, (size_t)256 * DM, 3, DM, DM, 0, 256, WSP(bf16, WS_WBR), (size_t)DM * 256, 256, 0, 0, 0);
    conv(F, F.in[10] + (size_t)layer * DM * DM, 0, 1, DM, DM, 0, DM, WSP(bf16, WS_WOUT), 0, DM, 0, 0, 0);
    conv(F, F.in[7] + (size_t)layer * 2 * 2048 * 256, (size_t)2048 * 256, 2, 256, 256, 0, 1024, WSP(bf16, WS_WC1), (size_t)512 * 1024, 1024, 0, 0, 0);
    conv(F, F.in[7] + (size_t)layer * 2 * 2048 * 256, (size_t)2048 * 256, 2, 256, 256, 1024, 1024, WSP(bf16, WS_WC1), (size_t)512 * 1024, 1024, 0, 0, 256);
    if ((layer & 1) == 0) {
        conv(F, F.in[12] + (size_t)j * DM * DFF, 0, 1, DFF, DFF, 0, DM, WSP(bf16, WS_WF1), 0, DM, 0, 2, 0, Q8_W1, TILED_FFN1);
        conv(F, F.in[13] + (size_t)j * DM * DFF, 0, 1, DFF, DFF, 0, DM, WSP(bf16, WS_WF1), 0, DM, 0, 2, 128, Q8_W1, TILED_FFN1);
        zero_block(F, WSP(bf16, WS_WF1), DM, 21 * 256 + 64, 64, 0, DM, TILED_FFN1);
        zero_block(F, WSP(bf16, WS_WF1), DM, 21 * 256 + 128 + 64, 64, 0, DM, TILED_FFN1);
        conv(F, F.in[14] + (size_t)j * DFF * DM, 0, 1, DM, DM, 0, DFF, WSP(bf16, WS_WF2), 0, DFFP, 0, 0, 0, Q8_W2);
        zero_block(F, WSP(bf16, WS_WF2), DFFP, 0, DM, DFF, DFFP - DFF);
    } else {
        conv(F, F.in[16] + (size_t)j * NEXP * DM * DFE, (size_t)DM * DFE, NEXP, DFE, DFE, 0, DM, WSP(bf16, WS_WF1), (size_t)NMOE1 * DM, DM, 0, 2, 0, Q8_W1);
        conv(F, F.in[17] + (size_t)j * NEXP * DM * DFE, (size_t)DM * DFE, NEXP, DFE, DFE, 0, DM, WSP(bf16, WS_WF1), (size_t)NMOE1 * DM, DM, 0, 2, 128, Q8_W1);
        conv(F, F.in[18] + (size_t)j * NEXP * DFE * DM, (size_t)DFE * DM, NEXP, DM, DM, 0, DFE, WSP(bf16, WS_WF2), (size_t)DM * DFE, DFE, 0, 0, 0, Q8_W2);
    }
    if (F.bx < 8) {
        __syncthreads();
        const int kv = F.bx >> 2, jj = (F.bx & 3) * 64 + F.lane;
        const float* pos = F.in[6] + (size_t)(layer * 2 + kv) * 2048; const float* w1 = F.in[7] + (size_t)(layer * 2 + kv) * 2048 * 256;
        float a = 0.f;
        float a1 = 0.f, a2 = 0.f, a3 = 0.f;
#pragma unroll 8
        for (int k = 0; k < 256; k += 4) { const int kk = F.wave * 256 + k;
            a += pos[kk] * w1[(size_t)kk * 256 + jj]; a1 += pos[kk + 1] * w1[(size_t)(kk + 1) * 256 + jj]; a2 += pos[kk + 2] * w1[(size_t)(kk + 2) * 256 + jj]; a3 += pos[kk + 3] * w1[(size_t)(kk + 3) * 256 + jj]; }
        a = (a + a1) + (a2 + a3);
        LAS float* red = (LAS float*)(F.lds + RING_OFF);
        red[F.wave * 64 + F.lane] = a;
        __syncthreads();
        if (F.wave == 0) { float s = 0.f;
#pragma unroll
            for (int w = 0; w < 8; ++w) s += red[w * 64 + F.lane];
            WSP(float, WS_BIAS1)[kv * 256 + jj] = s; }
        __syncthreads();
    }
    if (layer == 0) {
        const int gt = (F.vcu * NWAVES + F.wave) * 64 + F.lane, NT = F.G * NWAVES * 64;
        for (int idx = gt; idx < SEQ * 8; idx += NT) { const int pos = idx >> 3, i = idx & 7;
            const double invf = ROPE_INVF[i];
            double rev = (double)pos * invf * 0.15915494309189535; rev -= __builtin_floor(rev);
            WSP(float, WS_ROPE)[idx] = __builtin_amdgcn_cosf((float)rev); WSP(float, WS_ROPE)[SEQ * 8 + idx] = __builtin_amdgcn_sinf((float)rev); }
    }
}

template <int MODE> __device__ __forceinline__ void p_norm(Frame& F, const float* src, const float* g, const float* rw, int jmoe, float q8s = 0.f, int tiled = 0) {
    const int gw = F.vcu * NWAVES + F.wave, NGW = F.G * NWAVES, lane = F.lane;
    LAS int* hist = (LAS int*)(F.lds + TAB_OFF) + 192;
    if (MODE == 1) {
        if (F.tid < 16) hist[F.tid] = 0;
        const int gt = gw * 64 + lane, NT = NGW * 64; int* tm = WSP(int, WS_TOKMAP);
        for (int i = gt; i < 4 * SLOTS; i += NT) tm[i] = -1;
        for (int i = F.tid; i < DM * NEXP / 4; i += NWAVES * 64) *(LAS f32x4*)(F.lds + RING_OFF + 16 * i) = ((const f32x4*)rw)[i];
        __syncthreads();
    }
    f32x4 gv[4];
#pragma unroll
    for (int jx = 0; jx < 4; ++jx) gv[jx] = ((const f32x4*)g)[lane + 64 * jx];
    constexpr int ROWS = (MODE == 1) ? 2 : 4;
    const int nit = (MODE == 1) ? ((MTOK / 128 - F.bx + F.G - 1) / F.G) * (16 / ROWS) : (MTOK - gw + ROWS * NGW - 1) / (ROWS * NGW);
    for (int itx = 0; itx < nit; ++itx) {
        const int chk = (MODE == 1) ? F.bx + (itx / (16 / ROWS)) * F.G : 0;
        const int m0 = (MODE == 1) ? chk * 128 + F.wave * 16 + (itx % (16 / ROWS)) * ROWS : gw + itx * ROWS * NGW;
        const int mstep = (MODE == 1) ? 1 : NGW;
        f32x4 v[ROWS][4]; float ss[ROWS];
#pragma unroll
        for (int u = 0; u < ROWS; ++u) { const int m = m0 + u * mstep; const f32x4* xr = (const f32x4*)(src + (size_t)(m < MTOK ? m : m0) * DM) + lane;
#pragma unroll
            for (int jx = 0; jx < 4; ++jx) v[u][jx] = xr[64 * jx]; }
#pragma unroll
        for (int u = 0; u < ROWS; ++u) { float s = 0.f;
#pragma unroll
            for (int jx = 0; jx < 4; ++jx) s += (v[u][jx].x * v[u][jx].x + v[u][jx].y * v[u][jx].y) + (v[u][jx].z * v[u][jx].z + v[u][jx].w * v[u][jx].w);
            ss[u] = s; }
#pragma unroll
        for (int o = 1; o < 64; o <<= 1) {
#pragma unroll
            for (int u = 0; u < ROWS; ++u) ss[u] += __builtin_bit_cast(float, __builtin_amdgcn_ds_bpermute((lane ^ o) << 2, __builtin_bit_cast(int, ss[u]))); }
        float lgall[MODE == 1 ? ROWS : 1][8];
        if (MODE == 1) {
            float rs[ROWS];
#pragma unroll
            for (int u = 0; u < ROWS; ++u) { rs[u] = 1.0f / sqrtf(ss[u] * (1.f / DM) + EPS);
#pragma unroll
                for (int e = 0; e < 8; ++e) lgall[u][e] = 0.f; }
#pragma unroll
            for (int jx = 0; jx < 4; ++jx) { const LAS f32x4* wr = (const LAS f32x4*)(F.lds + RING_OFF + (size_t)(4 * lane + 256 * jx) * 32);
#pragma unroll
                for (int r = 0; r < 4; ++r) { const f32x4 a = wr[2 * r], b = wr[2 * r + 1];
#pragma unroll
                    for (int u = 0; u < ROWS; ++u) { const float xv = v[u][jx][r] * rs[u] * gv[jx][r];
                        lgall[u][0] += xv * a.x; lgall[u][1] += xv * a.y; lgall[u][2] += xv * a.z; lgall[u][3] += xv * a.w; lgall[u][4] += xv * b.x; lgall[u][5] += xv * b.y; lgall[u][6] += xv * b.z; lgall[u][7] += xv * b.w; } } }
        }
#pragma unroll
        for (int u = 0; u < ROWS; ++u) { const int m = m0 + u * mstep; if (m >= MTOK) continue;
            const float rstd = 1.0f / sqrtf(ss[u] * (1.f / DM) + EPS);
#pragma unroll
            for (int jx = 0; jx < 4; ++jx) v[u][jx] = v[u][jx] * rstd * gv[jx];
            if (MODE == 2) {
                f32x4* o = (f32x4*)(F.out + (size_t)m * DM) + lane;
#pragma unroll
                for (int jx = 0; jx < 4; ++jx) o[64 * jx] = v[u][jx];
            } else {
                unsigned long long* o8 = (unsigned long long*)(WSP(bf16, WS_HN) + (size_t)m * DM) + lane;
#pragma unroll
                for (int jx = 0; jx < 4; ++jx) { f32x4 w = v[u][jx];
                    if (tiled) { *(unsigned long long*)(WSP(bf16, WS_HN) + toff(m, 4 * lane + 256 * jx, DM)) = (unsigned long long)pk2(w.x, w.y) | ((unsigned long long)pk2(w.z, w.w) << 32); continue; } if (q8s > 0.f) { w.x = q8r(w.x, q8s); w.y = q8r(w.y, q8s); w.z = q8r(w.z, q8s); w.w = q8r(w.w, q8s); }
                    o8[64 * jx] = (unsigned long long)pk2(w.x, w.y) | ((unsigned long long)pk2(w.z, w.w) << 32); }
            }
            if (MODE == 1) {
                float lg[8];
#pragma unroll
                for (int e = 0; e < 8; ++e) lg[e] = lgall[u][e];
                float h4[4], h2[2], h1;
                { const bool up = lane & 1;
#pragma unroll
                  for (int i = 0; i < 4; ++i) { const float keep = up ? lg[4 + i] : lg[i], send = up ? lg[i] : lg[4 + i]; h4[i] = keep + __builtin_bit_cast(float, bperm(lane ^ 1, __builtin_bit_cast(int, send))); } }
                { const bool up = lane & 2;
#pragma unroll
                  for (int i = 0; i < 2; ++i) { const float keep = up ? h4[2 + i] : h4[i], send = up ? h4[i] : h4[2 + i]; h2[i] = keep + __builtin_bit_cast(float, bperm(lane ^ 2, __builtin_bit_cast(int, send))); } }
                { const bool up = lane & 4; const float keep = up ? h2[1] : h2[0], send = up ? h2[0] : h2[1]; h1 = keep + __builtin_bit_cast(float, bperm(lane ^ 4, __builtin_bit_cast(int, send))); }
                h1 += __builtin_bit_cast(float, bperm(lane ^ 8, __builtin_bit_cast(int, h1))); h1 += __builtin_bit_cast(float, bperm(lane ^ 16, __builtin_bit_cast(int, h1))); h1 += __builtin_bit_cast(float, bperm(lane ^ 32, __builtin_bit_cast(int, h1)));
                lg[0] = rdlane(h1, 0); lg[1] = rdlane(h1, 4); lg[2] = rdlane(h1, 2); lg[3] = rdlane(h1, 6); lg[4] = rdlane(h1, 1); lg[5] = rdlane(h1, 5); lg[6] = rdlane(h1, 3); lg[7] = rdlane(h1, 7);
                int e0 = 0; float v0 = lg[0];
#pragma unroll
                for (int e = 1; e < 8; ++e) if (lg[e] > v0) { v0 = lg[e]; e0 = e; }
                int e1 = -1; float v1 = -INFINITY;
#pragma unroll
                for (int e = 0; e < 8; ++e) if (e != e0 && lg[e] > v1) { v1 = lg[e]; e1 = e; }
                const float w0 = 1.0f / (1.0f + fexp(v1 - v0)), w1 = 1.0f - w0;
                if (lane == 0) { WSP(v4i, WS_ROUTE)[m] = (v4i){e0, e1, __builtin_bit_cast(int, w0), __builtin_bit_cast(int, w1)};
                    __hip_atomic_fetch_add(&hist[e0], 1, __ATOMIC_RELAXED, __HIP_MEMORY_SCOPE_WORKGROUP); __hip_atomic_fetch_add(&hist[8 + e1], 1, __ATOMIC_RELAXED, __HIP_MEMORY_SCOPE_WORKGROUP); }
            }
        }
        if (MODE == 1 && (itx % (16 / ROWS)) == 16 / ROWS - 1) {
            __syncthreads();
            if (F.tid < 16) { WSP(int, WS_CNT128)[(size_t)chk * 16 + F.tid] = hist[F.tid]; hist[F.tid] = 0; }
            __syncthreads();
        }
    }
}

__device__ __forceinline__ void p_prep(Frame& F) {
    const int gw = F.vcu * NWAVES + F.wave, NGW = F.G * NWAVES, lane = F.lane;
    bf16* P1 = WSP(bf16, WS_P1); bf16* KVC = WSP(bf16, WS_KVC); const float* rope = WSP(float, WS_ROPE);
    const int vec = lane >> 3, ri = lane & 7; const int cb = vec < 4 ? C_CQ + vec * 64 : (vec == 4 ? C_KCMP : (vec == 5 ? C_KSLC : C_KWIN));
    for (int row0 = gw; row0 < MC; row0 += 4 * NGW) {
        float x1[4], x2[4], cc[4], ss[4]; bf16 kc48[4], vc64[4];
#pragma unroll
        for (int k = 0; k < 4; ++k) { const int row = row0 + k * NGW < MC ? row0 + k * NGW : row0; const bf16* p = P1 + (size_t)row * P1W; const int pos = row & (SEQ - 1);
            const int cl = lane < 56 ? cb + ri : C_CQ;
            x1[k] = bf1(p[cl]); x2[k] = bf1(p[cl + 8]); cc[k] = rope[pos * 8 + ri]; ss[k] = rope[SEQ * 8 + pos * 8 + ri];
            if (F.rep) { cc[k] = 1.f; ss[k] = 0.f; }
            kc48[k] = p[C_KCMP + 16 + (lane < 48 ? lane : 0)]; vc64[k] = p[C_VCMP + lane]; }
#pragma unroll
        for (int k = 0; k < 4; ++k) { const int row = row0 + k * NGW; if (row >= MC) continue; bf16* p = P1 + (size_t)row * P1W;
            if (lane < 56) { const bf16 o1 = (bf16)f2bf(x1[k] * cc[k] - x2[k] * ss[k]), o2 = (bf16)f2bf(x2[k] * cc[k] + x1[k] * ss[k]);
                p[cb + ri] = o1; p[cb + ri + 8] = o2;
                if (vec == 4) { KVC[(size_t)row * 64 + ri] = o1; KVC[(size_t)row * 64 + ri + 8] = o2; } }
            if (lane < 48) KVC[(size_t)row * 64 + 16 + lane] = kc48[k];
            KVC[(size_t)MC * 64 + (size_t)row * 64 + lane] = vc64[k]; }
    }
    bf16* VT = WSP(bf16, WS_VT);
    for (int it = gw; it < 6 * BC * 64; it += NGW) { const int which = it / (BC * 64), r = it % (BC * 64), b = r >> 6, blk = r & 63;
        const v4u* src = (const v4u*)(P1 + ((size_t)b * SEQ + blk * 64 + lane) * P1W + (which == 0 ? C_VSLC : (which == 1 ? C_VWIN : C_SBV + (which - 2) * 64)));
        bf16* dst = VT + ((size_t)(which * BC + b) * 64) * SEQ + blk * 64 + lane;
        v4u xs[8];
#pragma unroll
        for (int i = 0; i < 8; ++i) xs[i] = src[i];
#pragma unroll
        for (int i = 0; i < 8; ++i) { const v4u x = xs[i];
            dst[(size_t)(8 * i + 0) * SEQ] = (bf16)(x.x & 0xffffu); dst[(size_t)(8 * i + 1) * SEQ] = (bf16)(x.x >> 16);
            dst[(size_t)(8 * i + 2) * SEQ] = (bf16)(x.y & 0xffffu); dst[(size_t)(8 * i + 3) * SEQ] = (bf16)(x.y >> 16);
            dst[(size_t)(8 * i + 4) * SEQ] = (bf16)(x.z & 0xffffu); dst[(size_t)(8 * i + 5) * SEQ] = (bf16)(x.z >> 16);
            dst[(size_t)(8 * i + 6) * SEQ] = (bf16)(x.w & 0xffffu); dst[(size_t)(8 * i + 7) * SEQ] = (bf16)(x.w >> 16); }
    }
}
__device__ __forceinline__ void p_sgu(Frame& F, int layer) {
    LAS float* vn = (LAS float*)(F.lds + RING_OFF);
    const bf16* P1 = WSP(bf16, WS_P1); bf16* Ya = WSP(bf16, WS_Y);
    const float* gain = F.in[3] + (size_t)layer * 256; const float* sw = F.in[4] + (size_t)layer * 4 * 128 * 128; const float* sb = F.in[5] + (size_t)layer * 4 * 128;
    const int lane = F.lane, wave = F.wave;
    for (int item = F.vcu; item < MC / 128; item += F.G) {
        const size_t r0 = (size_t)item * 128;
        __syncthreads();
        for (int rr = 0; rr < 16; ++rr) { const int r = wave * 16 + rr; const v2u raw = *(const v2u*)(P1 + (r0 + r) * P1W + C_V + 4 * lane);
            const float a = bflo(raw.x), b = bfhi(raw.x), c = bflo(raw.y), d = bfhi(raw.y);
            const float rstd = 1.0f / sqrtf(wave_sum((a * a + b * b) + (c * c + d * d), lane) * (1.f / 256.f) + EPS);
            const f32x4 gg = ((const f32x4*)gain)[lane];
            *(LAS f32x4*)(vn + r * 256 + 4 * lane) = (f32x4){a * rstd * gg.x, b * rstd * gg.y, c * rstd * gg.z, d * rstd * gg.w}; }
        __syncthreads();
        const int g = wave & 3, half = wave >> 2;
        for (int i = 0; i < 64; ++i) { const int t = 2 * i + half;
            const float* wrow = sw + ((size_t)g * 128 + t) * 128;
            const float w_lo = wrow[lane], w_hi = wrow[64 + lane];
            float acc = 0.f;
            for (int s = 0; s <= t; ++s) { const float w = (s < 64) ? rdlane(w_lo, s) : rdlane(w_hi, s - 64); acc += w * vn[s * 256 + g * 64 + lane]; }
            const float u = bf1(P1[(r0 + t) * P1W + C_U + g * 64 + lane]);
#ifdef ABL_SGUMIX
            acc = 0.f;
#endif
            Ya[(r0 + t) * 256 + g * 64 + lane] = (bf16)f2bf(u * (acc + sb[g * 128 + t])); }
    }
    __syncthreads();
}

__device__ __forceinline__ void p_cmpfin(Frame& F, int layer) {
    const int gw = F.vcu * NWAVES + F.wave, NGW = F.G * NWAVES, lane = F.lane;
    const float* UL = WSP(float, WS_UL); const float* bias = WSP(float, WS_BIAS1); bf16* KC = WSP(bf16, WS_KC);
    LAS float* w2l = (LAS float*)(F.lds + RING_OFF);
    __syncthreads();
    { const f32x4* src = (const f32x4*)(F.in[8] + (size_t)layer * 2 * 256 * 64);
#pragma unroll 4
      for (int i = F.tid; i < 2 * 256 * 64 / 4; i += NWAVES * 64) *(LAS f32x4*)(w2l + 4 * i) = src[i]; }
    __syncthreads();
    for (int it = gw; it < 2 * BC * 255; it += NGW) { const int kv = it / (BC * 255), r = it % (BC * 255), b = r / 255, m = r % 255;
        const LAS float* w2 = w2l + kv * 256 * 64;
        const float* U = UL + (size_t)(kv * 2048 + b * 256 + m) * 512; const float* L = U + 512 + 256;
        float hv[4];
#pragma unroll
        for (int q = 0; q < 4; ++q) hv[q] = pg8::gelu_tanh(U[64 * q + lane] + L[64 * q + lane] + bias[kv * 256 + 64 * q + lane]);
        float acc0 = 0.f, acc1 = 0.f;
#pragma unroll
        for (int q = 0; q < 4; ++q)
#pragma unroll 8
            for (int jj = 0; jj < 64; jj += 2) { acc0 += rdlane(hv[q], jj) * w2[(64 * q + jj) * 64 + lane]; acc1 += rdlane(hv[q], jj + 1) * w2[(64 * q + jj + 1) * 64 + lane]; }
        const float acc = acc0 + acc1;
        KC[((size_t)(kv * BC + b) * 256 + m) * 64 + lane] = (bf16)f2bf(acc);
        if (kv == 1) { WSP(bf16, WS_KCT)[((size_t)b * 64 + lane) * 256 + m] = (bf16)f2bf(acc); if (m == 254) WSP(bf16, WS_KCT)[((size_t)b * 64 + lane) * 256 + 255] = (bf16)0; }
        else if (m == 254) KC[((size_t)b * 256 + 255) * 64 + lane] = (bf16)0; }
    __syncthreads();
}

__device__ __forceinline__ void p_stick(Frame& F) {
    const int gw = F.vcu * NWAVES + F.wave, NGW = F.G * NWAVES, lane = F.lane;
    const bf16* P1 = WSP(bf16, WS_P1); bf16* Yb = WSP(bf16, WS_Y) + (size_t)MC * 256;
    for (int item = gw; item < BC * 4 * 64; item += NGW) { const int tb = item & 63, h = (item >> 6) & 3, b = item >> 8;
        const int t = tb * 64 + lane; const size_t row = (size_t)b * SEQ + t;
        unsigned q[32];
        { const v4u* qp = (const v4u*)(P1 + row * P1W + C_SBQ + h * 64);
#pragma unroll
          for (int i = 0; i < 8; ++i) { const v4u x = qp[i]; q[4 * i] = x.x; q[4 * i + 1] = x.y; q[4 * i + 2] = x.z; q[4 * i + 3] = x.w; } }
        float o[64];
#pragma unroll
        for (int d = 0; d < 64; ++d) o[d] = 0.f;
        float R = 0.f;
        const bf16* kb = P1 + (size_t)b * SEQ * P1W + C_SBK + h * 64; const bf16* vb = P1 + (size_t)b * SEQ * P1W + C_SBV + h * 64;
        for (int s = t - 1; s >= 0; --s) {
            if (R < -100.f) break;
            const v4u* kp = (const v4u*)(kb + (size_t)s * P1W); const v4u* vp = (const v4u*)(vb + (size_t)s * P1W);
            float z0 = 0.f, z1 = 0.f;
#pragma unroll
            for (int i = 0; i < 8; ++i) { const v4u k = kp[i]; z0 = dot2bf(k.x, q[4 * i], z0); z1 = dot2bf(k.y, q[4 * i + 1], z1); z0 = dot2bf(k.z, q[4 * i + 2], z0); z1 = dot2bf(k.w, q[4 * i + 3], z1); }
            const float z = (z0 + z1) * 0.125f;
            const float tt = 0.6931471805599453f * __builtin_amdgcn_logf(1.0f + fexp(-__builtin_fabsf(z)));
            const float lb = fminf(z, 0.f) - tt, l1m = fminf(-z, 0.f) - tt;
            const float a = fexp(lb + R); R += l1m;
#pragma unroll
            for (int i = 0; i < 8; ++i) { const v4u v = vp[i];
                o[8 * i] += a * bflo(v.x); o[8 * i + 1] += a * bfhi(v.x); o[8 * i + 2] += a * bflo(v.y); o[8 * i + 3] += a * bfhi(v.y);
                o[8 * i + 4] += a * bflo(v.z); o[8 * i + 5] += a * bfhi(v.z); o[8 * i + 6] += a * bflo(v.w); o[8 * i + 7] += a * bfhi(v.w); }
        }
        v4u* op = (v4u*)(Yb + row * 256 + h * 64);
#pragma unroll
        for (int i = 0; i < 8; ++i) op[i] = (v4u){pk2(o[8 * i], o[8 * i + 1]), pk2(o[8 * i + 2], o[8 * i + 3]), pk2(o[8 * i + 4], o[8 * i + 5]), pk2(o[8 * i + 6], o[8 * i + 7])};
    }
}

struct Soft { float mx, l; };
__device__ __forceinline__ float dotq(const LAS v4u* ql, const bf16* kp_) {
    const v4u* kp = (const v4u*)kp_; float z0 = 0.f, z1 = 0.f;
#pragma unroll
    for (int i = 0; i < 8; ++i) { const v4u k = kp[i]; const v4u q = ql[i]; z0 = dot2bf(k.x, q.x, z0); z1 = dot2bf(k.y, q.y, z1); z0 = dot2bf(k.z, q.z, z0); z1 = dot2bf(k.w, q.w, z1); }
    return (z0 + z1) * 0.125f;
}
__device__ __forceinline__ void axpy_row(float p, const bf16* vp_, float (&o)[64]) {
    const v4u* vp = (const v4u*)vp_;
#pragma unroll
    for (int i = 0; i < 8; ++i) { const v4u v = vp[i];
        o[8 * i] += p * bflo(v.x); o[8 * i + 1] += p * bfhi(v.x); o[8 * i + 2] += p * bflo(v.y); o[8 * i + 3] += p * bfhi(v.y);
        o[8 * i + 4] += p * bflo(v.z); o[8 * i + 5] += p * bfhi(v.z); o[8 * i + 6] += p * bflo(v.w); o[8 * i + 7] += p * bfhi(v.w); }
}
__device__ __forceinline__ void nsa_step(const LAS v4u* ql, const bf16* kp_, const bf16* vp_, Soft& S, float (&o)[64]) {
    const float s = dotq(ql, kp_);
    if (s > S.mx) { const float sc = fexp(S.mx - s); S.l *= sc;
#pragma unroll
        for (int d = 0; d < 64; ++d) o[d] *= sc;
        S.mx = s; }
    const float p = fexp(s - S.mx); S.l += p;
    asm volatile("" ::: "memory");
    axpy_row(p, vp_, o);
}
__device__ __forceinline__ void nsa_accum(bf16* yrow, bool first, float sc, const float (&o)[64]) {
    v4u* op = (v4u*)yrow;
#pragma unroll
    for (int i = 0; i < 8; ++i) { v4u old = (v4u){0u, 0u, 0u, 0u}; if (!first) old = op[i];
        op[i] = (v4u){pk2(bflo(old.x) + sc * o[8 * i], bfhi(old.x) + sc * o[8 * i + 1]), pk2(bflo(old.y) + sc * o[8 * i + 2], bfhi(old.y) + sc * o[8 * i + 3]),
                      pk2(bflo(old.z) + sc * o[8 * i + 4], bfhi(old.z) + sc * o[8 * i + 5]), pk2(bflo(old.w) + sc * o[8 * i + 6], bfhi(old.w) + sc * o[8 * i + 7])}; }
}
__device__ __forceinline__ void p_nsa(Frame& F) {
    const int gw = F.vcu * NWAVES + F.wave, NGW = F.G * NWAVES, lane = F.lane;
    const bf16* P1 = WSP(bf16, WS_P1); const bf16* KC = WSP(bf16, WS_KC); bf16* Yc = WSP(bf16, WS_Y) + (size_t)2 * MC * 256;
    LAS float* imp = (LAS float*)(F.lds + RING_OFF + F.wave * 4096);
    LAS v4u* ql = (LAS v4u*)(F.lds + RING_OFF + 32768 + F.wave * 9216 + lane * 144);
    const int qi = lane >> 2, h = lane & 3;
    for (int item = gw; item < BC * 256; item += NGW) { const int b = item >> 8, tg = item & 255;
        const int t = tg * 16 + qi; const size_t row = (size_t)b * SEQ + t; const bf16* prow = P1 + row * P1W;
        { const v4u* qp = (const v4u*)(prow + C_CQ + h * 64);
#pragma unroll
          for (int i = 0; i < 8; ++i) ql[i] = qp[i]; }
        const float g0 = bf1(prow[C_CG + h * 3]), g1 = bf1(prow[C_CG + h * 3 + 1]), g2 = bf1(prow[C_CG + h * 3 + 2]);
        bf16* yrow = Yc + row * 256 + h * 64;
        float o[64];
        for (int i = lane; i < 1024; i += 64) imp[i] = 0.f;
        const int nv = t >= 31 ? ((t - 31) >> 4) + 1 : 0; const int nvmax = (tg * 16 + 15 >= 31) ? ((tg * 16 + 15 - 31) >> 4) + 1 : 0;
        const bf16* kc = KC + (size_t)(0 * BC + b) * 256 * 64; const bf16* vc = KC + (size_t)(1 * BC + b) * 256 * 64;
        { float mx = -INFINITY, l = 0.f;
          for (int m = 0; m < nvmax; ++m) { const float s = dotq(ql, kc + m * 64); if (m < nv) { if (s > mx) { l *= fexp(mx - s); mx = s; } l += fexp(s - mx); } }
          const float rl = l > 0.f ? 1.0f / l : 0.f;
#pragma unroll
          for (int d = 0; d < 64; ++d) o[d] = 0.f;
          for (int m = 0; m < nvmax; ++m) { const float s = dotq(ql, kc + m * 64); const float p = (m < nv) ? fexp(s - mx) * rl : 0.f;
              asm volatile("" ::: "memory");
              axpy_row(p, vc + m * 64, o);
              float P = p + __builtin_bit_cast(float, bperm(lane ^ 1, __builtin_bit_cast(int, p))); P += __builtin_bit_cast(float, bperm(lane ^ 2, __builtin_bit_cast(int, P)));
              if (h == 0) { const int j0 = m >> 2; const bool edge = (m & 3) == 3; imp[qi * 64 + j0] += edge ? 0.5f * P : P; if (edge) imp[qi * 64 + j0 + 1] += 0.5f * P; } }
          nsa_accum(yrow, true, g0, o); }
        unsigned long long mask = 0ull;
        { const int cur = t >> 6, nvb = cur + 1;
          if (h == 0) {
              if (nvb <= 16) mask = (1ull << nvb) - 1ull;
              else { mask = 1ull | (1ull << cur);
                  for (int r = 0; r < 14; ++r) { int best = -1; float bv = -1.f;
                      for (int j = 1; j < cur; ++j) { const float v = imp[qi * 64 + j]; if (!((mask >> j) & 1ull) && v > bv) { bv = v; best = j; } }
                      mask |= 1ull << best; } } }
          const unsigned mlo = (unsigned)bperm(lane & ~3, (int)(unsigned)mask), mhi = (unsigned)bperm(lane & ~3, (int)(unsigned)(mask >> 32));
          mask = ((unsigned long long)mhi << 32) | mlo; }
        { Soft S{-INFINITY, 0.f};
#pragma unroll
          for (int d = 0; d < 64; ++d) o[d] = 0.f;
          const bf16* kb = P1 + (size_t)b * SEQ * P1W + C_KSLC; const bf16* vb = P1 + (size_t)b * SEQ * P1W + C_VSLC;
          unsigned long long mm = mask;
          while (mm) { const int j = __builtin_ctzll(mm); mm &= mm - 1ull;
              for (int kk = 0; kk < 64; ++kk) { const int sp = j * 64 + kk; if (sp > t) break; nsa_step(ql, kb + (size_t)sp * P1W, vb + (size_t)sp * P1W, S, o); } }
          nsa_accum(yrow, false, g1 / S.l, o); }
        { Soft S{-INFINITY, 0.f};
#pragma unroll
          for (int d = 0; d < 64; ++d) o[d] = 0.f;
          const bf16* kb = P1 + (size_t)b * SEQ * P1W + C_KWIN; const bf16* vb = P1 + (size_t)b * SEQ * P1W + C_VWIN;
          for (int i = 0; i < 512; ++i) { const int sp = t - 511 + i; if (sp >= 0) nsa_step(ql, kb + (size_t)sp * P1W, vb + (size_t)sp * P1W, S, o); }
          nsa_accum(yrow, false, g2 / S.l, o); }
    }
}

__device__ __forceinline__ int moe_table(Frame& F, int jmoe, int c, int r, int kpre = 0) {
    LAS int* tab = (LAS int*)(F.lds + TAB_OFF); LAS int* arr = (LAS int*)(F.lds + LDSCTL_OFF + 4096);
    (void)jmoe;
    __syncthreads();
    if (F.tid < 256) { const v4i* s = (const v4i*)(WSP(int, WS_CNT128) + ((size_t)(c * 256 + F.tid) * 2 + r) * 8); const v4i a = s[0], b = s[1];
        *(LAS v4i*)(arr + F.tid * 8) = a; *(LAS v4i*)(arr + F.tid * 8 + 4) = b; }
    __syncthreads();
    if (F.tid < 8) { int tot = 0, pre = 0;
        for (int k = 0; k < 256; ++k) { const int x = arr[k * 8 + F.tid]; pre += (k < kpre) ? x : 0; tot += x; }
        tab[176 + F.tid] = tot; tab[184 + F.tid] = pre; }
    __syncthreads();
    if (F.tid == 0) { int base = 0, T = 0;
        for (int e = 0; e < 8; ++e) { const int cnt = tab[176 + e];
            const int nt = (cnt + 255) >> 8; tab[160 + e] = base; for (int i = 0; i < nt && T + i < 160; ++i) tab[T + i] = e; T += nt; base += nt * 256; }
        tab[168] = T < 136 ? T : 136; }
    __syncthreads();
    return tab[168];
}
__device__ __forceinline__ void p_gather(Frame& F, int jmoe, int c, int r, int nbusy = 0) {
    if (F.bx < nbusy) return;
    LAS int* tab = (LAS int*)(F.lds + TAB_OFF); LAS int* cntw = tab + 256; LAS int* basew = tab + 320;
    const int lane = F.lane, wave = F.wave;
    const v4i* route = WSP(v4i, WS_ROUTE); int* tokmap = WSP(int, WS_TOKMAP) + (c * 2 + r) * SLOTS; float* wslot = WSP(float, WS_WSLOT) + (c * 2 + r) * SLOTS;
    const bf16* HN = WSP(bf16, WS_HN); bf16* XG = WSP(bf16, WS_XG);
    for (int ch = F.bx - nbusy; ch < MC / 128; ch += F.G - nbusy) {
        moe_table(F, jmoe, c, r, ch);
        const int m = c * MC + ch * 128 + wave * 16 + (lane & 15); const v4i rt = route[m];
        const int e = lane < 16 ? (r ? rt.y : rt.x) : -1; const float w = __builtin_bit_cast(float, r ? rt.w : rt.z);
        unsigned long long bal[8]; int mycnt = 0;
#pragma unroll
        for (int ee = 0; ee < 8; ++ee) { bal[ee] = __builtin_amdgcn_ballot_w64(e == ee); if (lane == ee) mycnt = __builtin_popcountll(bal[ee]); }
        if (lane < 8) cntw[wave * 8 + lane] = mycnt;
        __syncthreads();
        if (wave == 0 && lane < 8) { int base = tab[184 + lane];
#pragma unroll
            for (int w8 = 0; w8 < 8; ++w8) { basew[w8 * 8 + lane] = base; base += cntw[w8 * 8 + lane]; } }
        __syncthreads();
        int pos = 0;
#pragma unroll
        for (int ee = 0; ee < 8; ++ee) if (e == ee) pos = basew[wave * 8 + ee] + __builtin_popcountll(bal[ee] & ((1ull << lane) - 1ull));
        int slot = 0;
        if (lane < 16) { slot = tab[160 + e] + pos; tokmap[slot] = m; wslot[slot] = w; }
#pragma unroll
        for (int i0 = 0; i0 < 16; i0 += 4) { v4u x[8];
#pragma unroll
            for (int i = 0; i < 4; ++i) { const int mi = __builtin_amdgcn_readlane(m, i0 + i); const v4u* src = (const v4u*)(HN + (size_t)mi * DM); x[2 * i] = src[lane]; x[2 * i + 1] = src[64 + lane]; }
#pragma unroll
            for (int i = 0; i < 4; ++i) { const int si = __builtin_amdgcn_readlane(slot, i0 + i); v4u* dst = (v4u*)(XG + (size_t)si * DM); dst[lane] = x[2 * i]; dst[64 + lane] = x[2 * i + 1]; } }
    }
}

typedef float f32x16 __attribute__((ext_vector_type(16)));
typedef short bf16x8v __attribute__((ext_vector_type(8)));
typedef float f32x2v __attribute__((ext_vector_type(2)));
constexpr int NSA_K = 0, NSA_V = 8192, NSA_BUF = 17408, NSA_STAGE = 2 * NSA_BUF, NSA_IMP = 69632, NSA_CARRY = 86016, NSA_SEL = 103424, NSA_WSF = 103936;
constexpr int NSA_VP = 136;
constexpr float NSA_C2 = 0.125f * 1.4426950408889634f;
constexpr float NSA_DEFER = 8.0f / (0.125f * 1.4426950408889634f);
__device__ __forceinline__ unsigned cvtpk(float lo, float hi) { f32x2v v = {lo, hi}; bf16x2_t b = __builtin_convertvector(v, bf16x2_t); return __builtin_bit_cast(unsigned, b); }
__device__ __forceinline__ float partner32(float v, int lane) { return __builtin_bit_cast(float, __builtin_amdgcn_ds_bpermute((lane ^ 32) << 2, __builtin_bit_cast(int, v))); }
__device__ __forceinline__ void nsa_load(v4u& kx, v4u& vx, const bf16* Kg, int kp, const bf16* Vg, int vp, int tid) {
    kx = *(const v4u*)(Kg + (size_t)(tid & 63) * kp + (tid >> 6) * 8); vx = *(const v4u*)(Vg + (size_t)(tid >> 3) * vp + (tid & 7) * 8);
}
__device__ __forceinline__ void nsa_store(LAS unsigned char* lds, const v4u& kx, const v4u& vx, int tid) {
    *(LAS v4u*)(lds + NSA_K + (tid >> 6) * 1024 + (tid & 63) * 16) = kx; { LAS v2u* vd = (LAS v2u*)(lds + NSA_V + (tid >> 3) * NSA_VP + (tid & 7) * 16); vd[0] = (v2u){vx.x, vx.y}; vd[1] = (v2u){vx.z, vx.w}; }
}
__device__ __forceinline__ void nsa_qk(const LAS unsigned char* lds, const bf16x8v (&qr)[4], f32x16& p0, f32x16& p1, int r32, int hi) {
#pragma unroll
    for (int i = 0; i < 16; ++i) { p0[i] = 0.f; p1[i] = 0.f; }
#pragma unroll
    for (int d0 = 0; d0 < 4; ++d0) {
        const bf16x8v k0 = *(const LAS bf16x8v*)(lds + NSA_K + (2 * d0 + hi) * 1024 + r32 * 16);
        const bf16x8v k1 = *(const LAS bf16x8v*)(lds + NSA_K + (2 * d0 + hi) * 1024 + 512 + r32 * 16);
        p0 = __builtin_amdgcn_mfma_f32_32x32x16_bf16(k0, qr[d0], p0, 0, 0, 0);
        p1 = __builtin_amdgcn_mfma_f32_32x32x16_bf16(k1, qr[d0], p1, 0, 0, 0);
    }
}
__device__ __forceinline__ void nsa_mask(f32x16& p0, f32x16& p1, int hi, int hiL, int loL) {
#pragma unroll
    for (int i = 0; i < 16; ++i) { const int kk = (i & 3) + 8 * (i >> 2) + 4 * hi;
        if (!(kk <= hiL && kk > loL)) p0[i] = -INFINITY;
        if (!(kk + 32 <= hiL && kk + 32 > loL)) p1[i] = -INFINITY; }
}
__device__ __forceinline__ float nsa_max32(const f32x16& p0, const f32x16& p1) {
    float a = fmaxf(fmaxf(p0[0], p0[1]), p1[0]), b = fmaxf(fmaxf(p0[2], p0[3]), p1[1]); a = fmaxf(fmaxf(a, p1[2]), p1[3]);
#pragma unroll
    for (int i = 4; i < 16; i += 4) { a = fmaxf(fmaxf(a, p0[i]), p0[i + 1]); b = fmaxf(fmaxf(b, p0[i + 2]), p0[i + 3]); a = fmaxf(fmaxf(a, p1[i]), p1[i + 1]); b = fmaxf(fmaxf(b, p1[i + 2]), p1[i + 3]); }
    return fmaxf(a, b);
}
__device__ __forceinline__ void nsa_pv(const LAS unsigned char* lds, const f32x16& p0, const f32x16& p1, f32x16 (&o)[2], int r32, int hi) {
    bf16x8v pa[4];
#pragma unroll
    for (int s = 0; s < 2; ++s) {
        const v4u a = (v4u){cvtpk(p0[8 * s], p0[8 * s + 1]), cvtpk(p0[8 * s + 2], p0[8 * s + 3]), cvtpk(p0[8 * s + 4], p0[8 * s + 5]), cvtpk(p0[8 * s + 6], p0[8 * s + 7])};
        const v4u b = (v4u){cvtpk(p1[8 * s], p1[8 * s + 1]), cvtpk(p1[8 * s + 2], p1[8 * s + 3]), cvtpk(p1[8 * s + 4], p1[8 * s + 5]), cvtpk(p1[8 * s + 6], p1[8 * s + 7])};
        pa[s] = __builtin_bit_cast(bf16x8v, a); pa[2 + s] = __builtin_bit_cast(bf16x8v, b); }
#pragma unroll
    for (int db = 0; db < 2; ++db) { const LAS unsigned char* vrow = lds + NSA_V + (32 * db + r32) * NSA_VP;
#pragma unroll
        for (int ks = 0; ks < 4; ++ks) {
            const int kb = (ks >> 1) * 32 + (ks & 1) * 16 + 4 * hi;
            const v2u lo = *(const LAS v2u*)(vrow + kb * 2), hh = *(const LAS v2u*)(vrow + (kb + 8) * 2);
            const v4u vv = (v4u){lo.x, lo.y, hh.x, hh.y};
            o[db] = __builtin_amdgcn_mfma_f32_32x32x16_bf16(pa[ks], __builtin_bit_cast(bf16x8v, vv), o[db], 0, 0, 0); } }
}
__device__ __forceinline__ void nsa_rowscale(f32x16 (&o)[2], LAS float* wsf, float f, int r32, int hi) {
    if (hi == 0) wsf[r32] = f;
#pragma unroll
    for (int g = 0; g < 4; ++g) { const f32x4 w = *(const LAS f32x4*)(wsf + 8 * g + 4 * hi);
#pragma unroll
        for (int e = 0; e < 4; ++e) { o[0][4 * g + e] *= w[e]; o[1][4 * g + e] *= w[e]; } }
}
constexpr int NSA_ACC = 104960;
__device__ __forceinline__ void nsa_rowaccum(LAS unsigned char* acc, bool first, const f32x16 (&o)[2], LAS float* wsf, float f, int r32, int hi) {
    if (hi == 0) wsf[r32] = f;
#pragma unroll
    for (int g = 0; g < 4; ++g) { const f32x4 w = *(const LAS f32x4*)(wsf + 8 * g + 4 * hi);
#pragma unroll
        for (int e = 0; e < 4; ++e) { LAS bf16* p = (LAS bf16*)(acc + (8 * g + 4 * hi + e) * 128 + r32 * 2); const int i = 4 * g + e;
            float a = o[0][i] * w[e], b = o[1][i] * w[e];
            if (!first) { a += bf1(p[0]); b += bf1(p[32]); }
            p[0] = (bf16)f2bf(a); p[32] = (bf16)f2bf(b); } }
}
__device__ __forceinline__ void nsa_flush(const LAS unsigned char* acc, bf16* ytok  , int lane) {
    asm volatile("" ::: "memory");
#pragma unroll
    for (int ps = 0; ps < 4; ++ps) { const int row = ps * 8 + (lane >> 3), ch = lane & 7;
        const v4u v = *(const LAS v4u*)(acc + row * 128 + ch * 16);
        *(v4u*)(ytok + (size_t)(row >> 2) * 256 + (row & 3) * 64 + ch * 8) = v; }
}
__device__ __forceinline__ void nsa_softmax_pv(const LAS unsigned char* lds, f32x16& p0, f32x16& p1, float& m, float& l, f32x16 (&o)[2], LAS float* wsf, int lane, int r32, int hi, bool rowok) {
    float mt = nsa_max32(p0, p1); mt = rowok ? mt : -INFINITY; mt = fmaxf(mt, partner32(mt, lane));
    const float mn = fmaxf(m, mt);
    if (__builtin_amdgcn_ballot_w64(mn > m + NSA_DEFER) != 0ull) { const float f = __builtin_amdgcn_exp2f((m - mn) * NSA_C2); l *= f; nsa_rowscale(o, wsf, f, r32, hi); m = mn; }
    const float off = rowok ? -m * NSA_C2 : -INFINITY;
    float s = 0.f;
#pragma unroll
    for (int i = 0; i < 16; ++i) { p0[i] = __builtin_amdgcn_exp2f(__builtin_fmaf(p0[i], NSA_C2, off)); p1[i] = __builtin_amdgcn_exp2f(__builtin_fmaf(p1[i], NSA_C2, off)); s += p0[i] + p1[i]; }
    l += s;
    nsa_pv(lds, p0, p1, o, r32, hi);
}
__device__ __forceinline__ void p_nsa2(Frame& F) {
    const int tid = F.tid, lane = F.lane, wave = F.wave, r32 = lane & 31, hi = lane >> 5;
    LAS unsigned char* lds = F.lds + RING_OFF;
    LAS float* imp = (LAS float*)(lds + NSA_IMP); LAS float* carry = (LAS float*)(lds + NSA_CARRY);
    LAS unsigned long long* selm = (LAS unsigned long long*)(lds + NSA_SEL); LAS float* wsf = (LAS float*)(lds + NSA_WSF) + wave * 32;
    LAS unsigned char* acc = wave < 6 ? lds + NSA_ACC + wave * 4096 : F.lds + LDSCTL_OFF + 4096 + (wave - 6) * 4096;
    const bf16* P1 = WSP(bf16, WS_P1); const bf16* KC = WSP(bf16, WS_KC); const bf16* KCT = WSP(bf16, WS_KCT); const bf16* VT = WSP(bf16, WS_VT);
    bf16* Yc = WSP(bf16, WS_Y) + (size_t)2 * MC * 256;
    const int ql = r32 >> 2, h = r32 & 3, tq = 8 * wave + ql;
    int par = 0;
    for (int it = 0; it < 2; ++it) {
        for (int pair = F.vcu; pair < BC * 32; pair += F.G) {
            const int b = pair >> 5, sx = pair & 31, qb = it ? 63 - sx : sx;
            const int t = qb * 64 + tq; const size_t row = (size_t)b * SEQ + t; const bf16* prow = P1 + row * P1W;
            bf16x8v qr[4];
#pragma unroll
            for (int d0 = 0; d0 < 4; ++d0) qr[d0] = *(const bf16x8v*)(prow + C_CQ + h * 64 + d0 * 16 + hi * 8);
            const float g0 = bf1(prow[C_CG + h * 3]), g1 = bf1(prow[C_CG + h * 3 + 1]), g2 = bf1(prow[C_CG + h * 3 + 2]);
            f32x16 o[2], p0, p1;
            __syncthreads();
            for (int i = tid; i < 64 * 64; i += 512) imp[i] = 0.f;
            for (int i = tid; i < 64 * 68; i += 512) carry[i] = 0.f;
            const int nct = (4 * qb + 3 + 63) >> 6;
            const int mlim = t >= 31 ? ((t - 31) >> 4) : -1;
            const bf16* kcb = KC + (size_t)b * 256 * 64; const bf16* vcb = KCT + (size_t)b * 64 * 256;
            float m = -1e30f, l = 0.f;
            v4u kx, vx;
            nsa_load(kx, vx, kcb, 64, vcb, 256, tid);
            for (int ti = 0; ti < nct; ++ti) {
                LAS unsigned char* tb = lds + par * NSA_STAGE; par ^= 1;
                nsa_store(tb, kx, vx, tid); __syncthreads();
                { const int tn = ti + 1 < nct ? ti + 1 : 0; nsa_load(kx, vx, kcb + (size_t)tn * 64 * 64, 64, vcb + tn * 64, 256, tid); }
                nsa_qk(tb, qr, p0, p1, r32, hi); nsa_mask(p0, p1, hi, mlim - 64 * ti, -1);
                float mt = nsa_max32(p0, p1); mt = fmaxf(mt, partner32(mt, lane));
                const float mn = fmaxf(m, mt); l *= __builtin_amdgcn_exp2f((m - mn) * NSA_C2); m = mn;
                const float off = -m * NSA_C2; float s = 0.f;
#pragma unroll
                for (int i = 0; i < 16; ++i) s += __builtin_amdgcn_exp2f(__builtin_fmaf(p0[i], NSA_C2, off)) + __builtin_amdgcn_exp2f(__builtin_fmaf(p1[i], NSA_C2, off));
                l += s; }
            { const float lt = l + partner32(l, lane); const float rl = lt > 0.f ? 1.0f / lt : 0.f;
#pragma unroll
              for (int i = 0; i < 16; ++i) { o[0][i] = 0.f; o[1][i] = 0.f; }
              for (int ti = 0; ti < nct; ++ti) {
                  LAS unsigned char* tb = lds + par * NSA_STAGE; par ^= 1;
                  nsa_store(tb, kx, vx, tid); __syncthreads();
                  if (ti + 1 < nct) nsa_load(kx, vx, kcb + (size_t)(ti + 1) * 64 * 64, 64, vcb + (ti + 1) * 64, 256, tid);
                  nsa_qk(tb, qr, p0, p1, r32, hi); nsa_mask(p0, p1, hi, mlim - 64 * ti, -1);
                  { const float off = -m * NSA_C2;
#pragma unroll
                    for (int i = 0; i < 16; ++i) { p0[i] = __builtin_amdgcn_exp2f(__builtin_fmaf(p0[i], NSA_C2, off)) * rl; p1[i] = __builtin_amdgcn_exp2f(__builtin_fmaf(p1[i], NSA_C2, off)) * rl; } }
#pragma unroll
                  for (int kt = 0; kt < 2; ++kt)
#pragma unroll
                      for (int g = 0; g < 4; ++g) { const f32x16& pp = kt ? p1 : p0;
                          float A = pp[4 * g] + pp[4 * g + 1] + pp[4 * g + 2] + 0.5f * pp[4 * g + 3], B = 0.5f * pp[4 * g + 3];
                          A += __builtin_bit_cast(float, bperm(lane ^ 1, __builtin_bit_cast(int, A))); A += __builtin_bit_cast(float, bperm(lane ^ 2, __builtin_bit_cast(int, A)));
                          B += __builtin_bit_cast(float, bperm(lane ^ 1, __builtin_bit_cast(int, B))); B += __builtin_bit_cast(float, bperm(lane ^ 2, __builtin_bit_cast(int, B)));
                          if (h == 0) { const int j = 16 * ti + 8 * kt + 2 * g + hi; imp[tq * 64 + j] = A; carry[tq * 68 + j + 1] = B; } }
                  nsa_pv(tb, p0, p1, o, r32, hi); }
              nsa_rowaccum(acc, true, o, wsf, g0, r32, hi); }
            __syncthreads();
            { const int q = tid >> 3, sub = tid & 7; unsigned long long mask;
              if (qb + 1 <= 16) mask = (1ull << (qb + 1)) - 1ull;
              else { mask = 1ull | (1ull << qb);
                  unsigned long long key[8];
#pragma unroll
                  for (int i = 0; i < 8; ++i) { const int j = sub * 8 + i; const float v = imp[q * 64 + j] + carry[q * 68 + j];
                      key[i] = (j >= 1 && j < qb) ? (((unsigned long long)__builtin_bit_cast(unsigned, v) << 32) | (unsigned)(63 - j)) : 0ull; }
                  for (int r = 0; r < 14; ++r) { unsigned long long best = key[0];
#pragma unroll
                      for (int i = 1; i < 8; ++i) best = key[i] > best ? key[i] : best;
#pragma unroll
                      for (int x = 1; x < 8; x <<= 1) { const unsigned lo = (unsigned)bperm(lane ^ x, (int)(unsigned)best), hh = (unsigned)bperm(lane ^ x, (int)(unsigned)(best >> 32));
                          const unsigned long long other = ((unsigned long long)hh << 32) | lo; best = other > best ? other : best; }
                      const int jb = 63 - (int)(best & 63ull); mask |= 1ull << jb;
#pragma unroll
                      for (int i = 0; i < 8; ++i) if (sub * 8 + i == jb) key[i] = 0ull; } }
              if (sub == 0) selm[q] = mask; }
            __syncthreads();
            const unsigned long long mysel = selm[tq];
            { const bf16* kb = P1 + (size_t)b * SEQ * P1W + C_KSLC; const bf16* vb = VT + (size_t)(0 * BC + b) * 64 * SEQ;
              m = -1e30f; l = 0.f;
#pragma unroll
              for (int i = 0; i < 16; ++i) { o[0][i] = 0.f; o[1][i] = 0.f; }
              v4u kx2, vx2;
              nsa_load(kx, vx, kb, P1W, vb, SEQ, tid); if (qb >= 1) nsa_load(kx2, vx2, kb + (size_t)64 * P1W, P1W, vb + 64, SEQ, tid);
              for (int j = 0; j <= qb; j += 2) {
                  const bool two = j + 1 <= qb;
                  LAS unsigned char* tb = lds + par * NSA_STAGE; par ^= 1;
                  nsa_store(tb, kx, vx, tid); if (two) nsa_store(tb + NSA_BUF, kx2, vx2, tid);
                  __syncthreads();
                  if (j + 2 <= qb) nsa_load(kx, vx, kb + (size_t)(j + 2) * 64 * P1W, P1W, vb + (j + 2) * 64, SEQ, tid);
                  if (j + 3 <= qb) nsa_load(kx2, vx2, kb + (size_t)(j + 3) * 64 * P1W, P1W, vb + (j + 3) * 64, SEQ, tid);
                  { const bool rowsel = ((mysel >> j) & 1ull) != 0ull;
                    if (__builtin_amdgcn_ballot_w64(rowsel) != 0ull) {
                        nsa_qk(tb, qr, p0, p1, r32, hi); if (j == qb) nsa_mask(p0, p1, hi, tq, -1);
                        nsa_softmax_pv(tb, p0, p1, m, l, o, wsf, lane, r32, hi, rowsel); } }
                  if (two) { const bool rowsel = ((mysel >> (j + 1)) & 1ull) != 0ull;
                    if (__builtin_amdgcn_ballot_w64(rowsel) != 0ull) {
                        nsa_qk(tb + NSA_BUF, qr, p0, p1, r32, hi); if (j + 1 == qb) nsa_mask(p0, p1, hi, tq, -1);
                        nsa_softmax_pv(tb + NSA_BUF, p0, p1, m, l, o, wsf, lane, r32, hi, rowsel); } } }
              const float lt = l + partner32(l, lane);
              nsa_rowaccum(acc, false, o, wsf, lt > 0.f ? g1 / lt : 0.f, r32, hi); }
            { const bf16* kb = P1 + (size_t)b * SEQ * P1W + C_KWIN; const bf16* vb = VT + (size_t)(1 * BC + b) * 64 * SEQ;
              m = -1e30f; l = 0.f;
#pragma unroll
              for (int i = 0; i < 16; ++i) { o[0][i] = 0.f; o[1][i] = 0.f; }
              const int j0 = qb >= 8 ? qb - 8 : 0;
              nsa_load(kx, vx, kb + (size_t)j0 * 64 * P1W, P1W, vb + j0 * 64, SEQ, tid);
              for (int j = j0; j <= qb; ++j) {
                  LAS unsigned char* tb = lds + par * NSA_STAGE; par ^= 1;
                  nsa_store(tb, kx, vx, tid); __syncthreads();
                  if (j < qb) nsa_load(kx, vx, kb + (size_t)(j + 1) * 64 * P1W, P1W, vb + (j + 1) * 64, SEQ, tid);
                  nsa_qk(tb, qr, p0, p1, r32, hi); if (j == qb || j == qb - 8) nsa_mask(p0, p1, hi, j == qb ? tq : 63, j == qb - 8 ? tq : -1);
                  nsa_softmax_pv(tb, p0, p1, m, l, o, wsf, lane, r32, hi, true); }
              const float lt = l + partner32(l, lane);
              nsa_rowaccum(acc, false, o, wsf, lt > 0.f ? g2 / lt : 0.f, r32, hi);
              nsa_flush(acc, Yc + ((size_t)b * SEQ + qb * 64 + 8 * wave) * 256, lane); }
        }
    }
    __syncthreads();
}

constexpr int SB_HEAD_LDS = 17408;
constexpr int SB_FLAG = 4 * SB_HEAD_LDS;
constexpr float SB_LOG2E = 1.4426950408889634f, SB_STOP = -100.0f * 1.4426950408889634f;
__device__ __forceinline__ void p_stick2(Frame& F, int nbusy) {
    const int tid = F.tid, lane = F.lane, wave = F.wave, r32 = lane & 31, hi = lane >> 5, h = wave & 3, qh = wave >> 2;
    LAS unsigned char* lds = F.lds + RING_OFF; LAS unsigned char* hl = lds + h * SB_HEAD_LDS; LAS int* flag = (LAS int*)(lds + SB_FLAG);
    const bf16* P1 = WSP(bf16, WS_P1); const bf16* VT = WSP(bf16, WS_VT) + (size_t)2 * BC * 64 * SEQ;
    bf16* Yb = WSP(bf16, WS_Y) + (size_t)MC * 256;
    const int tq = 32 * qh + r32;
    if (F.bx >= nbusy)
        for (int item = F.bx - nbusy; item < BC * 64; item += F.G - nbusy) {
            const int b = item >> 6, qb = item & 63;
            const size_t row = (size_t)b * SEQ + qb * 64 + tq;
            bf16x8v qr[4];
#pragma unroll
            for (int d0 = 0; d0 < 4; ++d0) qr[d0] = *(const bf16x8v*)(P1 + row * P1W + C_SBQ + h * 64 + d0 * 16 + hi * 8);
            f32x16 o[2], p0, p1;
#pragma unroll
            for (int i = 0; i < 16; ++i) { o[0][i] = 0.f; o[1][i] = 0.f; }
            float R = 0.f;
            const int skey = tid & 63, sc = tid >> 6, sd = tid >> 3, skc = tid & 7;
            v4u kx[4], vx[4];
#define SB_LOAD(jj) do { const bf16* kg_ = P1 + ((size_t)b * SEQ + (jj) * 64 + skey) * P1W + C_SBK + sc * 8; \
                _Pragma("unroll") for (int hh = 0; hh < 4; ++hh) { kx[hh] = *(const v4u*)(kg_ + hh * 64); vx[hh] = *(const v4u*)(VT + ((size_t)(hh * BC + b) * 64 + sd) * SEQ + (jj) * 64 + skc * 8); } } while (0)
            SB_LOAD(qb);
            for (int j = qb; j >= 0; --j) {
                __syncthreads();
                if (j < qb) { int live = 0;
#pragma unroll
                    for (int w = 0; w < 8; ++w) live |= flag[w];
                    if (!live) break; }
#pragma unroll
                for (int hh = 0; hh < 4; ++hh) { *(LAS v4u*)(lds + hh * SB_HEAD_LDS + sc * 1024 + skey * 16) = kx[hh]; { LAS v2u* vd = (LAS v2u*)(lds + hh * SB_HEAD_LDS + NSA_V + sd * NSA_VP + skc * 16); vd[0] = (v2u){vx[hh].x, vx[hh].y}; vd[1] = (v2u){vx[hh].z, vx[hh].w}; } }
                __syncthreads();
                if (j > 0) SB_LOAD(j - 1);
                nsa_qk(hl, qr, p0, p1, r32, hi);
#pragma unroll
                for (int i = 0; i < 16; ++i) { p0[i] *= NSA_C2; p1[i] *= NSA_C2; }
                const int lim = (j == qb) ? tq : 64;
                float Town[8], Tp[8];
#pragma unroll
                for (int kt = 0; kt < 2; ++kt) { f32x16& pp = kt ? p1 : p0;
#pragma unroll
                    for (int g = 0; g < 4; ++g) { float L[4];
#pragma unroll
                        for (int e = 0; e < 4; ++e) { const int kk = 32 * kt + 8 * g + 4 * hi + e; const float z = pp[4 * g + e];
                            const float tt = __builtin_amdgcn_logf(1.0f + __builtin_amdgcn_exp2f(-__builtin_fabsf(z)));
                            const float lb = fminf(z, 0.f) - tt; const bool ok = kk < lim;
                            L[e] = ok ? lb - z : 0.f; pp[4 * g + e] = ok ? lb : -INFINITY; }
                        const float E2 = L[3], E1 = E2 + L[2], E0 = E1 + L[1];
                        pp[4 * g + 2] += E2; pp[4 * g + 1] += E1; pp[4 * g] += E0;
                        Town[4 * kt + g] = E0 + L[0]; } }
#pragma unroll
                for (int k = 0; k < 8; ++k) Tp[k] = partner32(Town[k], lane);
                float suf = R;
#pragma unroll
                for (int k = 7; k >= 0; --k) { const float add = suf + (hi == 0 ? Tp[k] : 0.f); f32x16& pp = (k >> 2) ? p1 : p0; const int g = k & 3;
#pragma unroll
                    for (int e = 0; e < 4; ++e) pp[4 * g + e] = __builtin_amdgcn_exp2f(pp[4 * g + e] + add);
                    suf += Town[k] + Tp[k]; }
                R = suf;
                nsa_pv(hl, p0, p1, o, r32, hi);
                const bool alive = R >= SB_STOP;
                const unsigned long long bal = __builtin_amdgcn_ballot_w64(alive);
                if (lane == 0) flag[wave] = bal != 0ull ? 1 : 0;
            }
            { bf16* dst = Yb + ((size_t)b * SEQ + qb * 64 + 32 * qh + 4 * hi) * 256 + h * 64 + r32;
#pragma unroll
              for (int i = 0; i < 16; ++i) { dst[((i & 3) + 8 * (i >> 2)) * 256] = (bf16)f2bf(o[0][i]); dst[((i & 3) + 8 * (i >> 2)) * 256 + 32] = (bf16)f2bf(o[1][i]); } }
        }
#undef SB_LOAD
    __syncthreads();
}

__device__ __forceinline__ void p_sgu2(Frame& F, int layer) {
    LAS unsigned char* vnT = F.lds + RING_OFF;
    const bf16* P1 = WSP(bf16, WS_P1); bf16* Ya = WSP(bf16, WS_Y);
    const float* gain = F.in[3] + (size_t)layer * 256; const float* sw = F.in[4] + (size_t)layer * 4 * 128 * 128; const float* sb = F.in[5] + (size_t)layer * 4 * 128;
    const int lane = F.lane, wave = F.wave, r32 = lane & 31, hi = lane >> 5, g = wave & 3, db = wave >> 2;
    for (int item = F.vcu; item < MC / 128; item += F.G) {
        const size_t r0 = (size_t)item * 128;
        __syncthreads();
        { const f32x4 gg = ((const f32x4*)gain)[lane];
          for (int rr = 0; rr < 16; rr += 2) { const int r = wave * 16 + rr;
              const v2u ra = *(const v2u*)(P1 + (r0 + r) * P1W + C_V + 4 * lane), rb = *(const v2u*)(P1 + (r0 + r + 1) * P1W + C_V + 4 * lane);
              const float a0 = bflo(ra.x), a1 = bfhi(ra.x), a2 = bflo(ra.y), a3 = bfhi(ra.y), b0 = bflo(rb.x), b1 = bfhi(rb.x), b2 = bflo(rb.y), b3 = bfhi(rb.y);
              const float sa = 1.0f / sqrtf(wave_sum((a0 * a0 + a1 * a1) + (a2 * a2 + a3 * a3), lane) * (1.f / 256.f) + EPS);
              const float sb_ = 1.0f / sqrtf(wave_sum((b0 * b0 + b1 * b1) + (b2 * b2 + b3 * b3), lane) * (1.f / 256.f) + EPS);
              LAS unsigned* q = (LAS unsigned*)(vnT + (4 * lane) * 272 + r * 2);
              q[0] = pk2(a0 * sa * gg.x, b0 * sb_ * gg.x); q[68] = pk2(a1 * sa * gg.y, b1 * sb_ * gg.y); q[136] = pk2(a2 * sa * gg.z, b2 * sb_ * gg.z); q[204] = pk2(a3 * sa * gg.w, b3 * sb_ * gg.w); } }
        __syncthreads();
        const int ch = g * 64 + db * 32 + r32;
        for (int tb = 0; tb < 4; ++tb) {
            f32x16 acc;
#pragma unroll
            for (int i = 0; i < 16; ++i) acc[i] = 0.f;
            const int t = 32 * tb + r32; const float* wrow = sw + ((size_t)g * 128 + t) * 128;
            f32x4 wq[8][2];
#pragma unroll
            for (int ks = 0; ks < 8; ++ks) if (ks < 2 * tb + 2) { wq[ks][0] = *(const f32x4*)(wrow + 16 * ks + 8 * hi); wq[ks][1] = *(const f32x4*)(wrow + 16 * ks + 8 * hi + 4); }
#pragma unroll
            for (int ks = 0; ks < 8; ++ks) if (ks < 2 * tb + 2) {
                const int s0 = 16 * ks + 8 * hi;
                const f32x4 w0 = wq[ks][0], w1 = wq[ks][1];
                const v4u a = (v4u){pk2(s0 <= t ? w0.x : 0.f, s0 + 1 <= t ? w0.y : 0.f), pk2(s0 + 2 <= t ? w0.z : 0.f, s0 + 3 <= t ? w0.w : 0.f),
                                    pk2(s0 + 4 <= t ? w1.x : 0.f, s0 + 5 <= t ? w1.y : 0.f), pk2(s0 + 6 <= t ? w1.z : 0.f, s0 + 7 <= t ? w1.w : 0.f)};
                const bf16x8v bfr = *(const LAS bf16x8v*)(vnT + ch * 272 + s0 * 2);
                acc = __builtin_amdgcn_mfma_f32_32x32x16_bf16(__builtin_bit_cast(bf16x8v, a), bfr, acc, 0, 0, 0); }
            float uu[16], bb[16];
#pragma unroll
            for (int i = 0; i < 16; ++i) { const int tt = 32 * tb + (i & 3) + 8 * (i >> 2) + 4 * hi; uu[i] = bf1(P1[(r0 + tt) * P1W + C_U + ch]); bb[i] = sb[g * 128 + tt]; }
#pragma unroll
            for (int i = 0; i < 16; ++i) { const int tt = 32 * tb + (i & 3) + 8 * (i >> 2) + 4 * hi;
                Ya[(r0 + tt) * 256 + ch] = (bf16)f2bf(uu[i] * (acc[i] + bb[i])); }
        }
    }
    __syncthreads();
}

struct Args { const float* in[20]; float* out; unsigned char* ws; int lo, hi, li, rep; };
#ifndef TILED_FFN1
#define TILED_FFN1 0
#endif
#ifndef PG8_ALIGN_EPI
#define PG8_ALIGN_EPI true
#endif
#ifndef PG8_SP2
#define PG8_SP2 true
#endif
#ifndef WGM_PROJ
#define WGM_PROJ PG8_WGM
#endif
#ifndef WGM_FFN1
#define WGM_FFN1 PG8_WGM
#endif
#ifndef WGM_FFN2
#define WGM_FFN2 PG8_WGM
#endif
#ifndef WGM_MOE1
#define WGM_MOE1 PG8_WGM
#endif
#ifndef WGM_MOE2
#define WGM_MOE2 PG8_WGM
#endif
#ifndef FFN_CHUNKS
#define FFN_CHUNKS 2
#endif
#ifndef REP_GEMM
#define REP_GEMM 1
#endif
#ifndef REP_STICK
#define REP_STICK 1
#endif
#ifndef REP_NSA
#define REP_NSA 1
#endif
#ifndef REP_SGU
#define REP_SGU 1
#endif
#ifndef REP_NORM
#define REP_NORM 1
#endif
template <class Epi, class Sched> __device__ __forceinline__ void run_gemm(Frame& F, const bf16* A, const bf16* Bt, int M, int N, int K, const Sched& S, Epi E, bool rotate = true, int tiled = 0, int ld = 0) {
    const int nt_ = K / 64;
#ifdef PG8_KROT
    const int rot_ = rotate ? 2 * (((F.bx & 7) * (nt_ / 2)) / 8) : 0;
#else
    const int rot_ = 0;
#endif
    pg8::Gemm g{A, Bt, M, N, K + F.zs, F.tid, rot_ + F.zs, tiled + F.zs, ld + F.zs};
    if (F.rep) E.set_scale0();
    pg8::gemm_phase<Epi, Sched, PG8_ALIGN_EPI, PG8_SP2>(F.lds + RING_OFF, g, S, E);
}
__global__ void __launch_bounds__(NWAVES * 64, 2) mk_fwd(Args args) {
    extern __shared__ __attribute__((aligned(16))) unsigned char lds[];
    Frame F0;
    F0.lds = (LAS unsigned char*)lds;
    F0.tid = threadIdx.x; F0.lane = F0.tid & 63; F0.wave = __builtin_amdgcn_readfirstlane(F0.tid >> 6);
    F0.G = gridDim.x; F0.bx = blockIdx.x; F0.vcu = (F0.G % 8 == 0) ? (F0.bx % 8) * (F0.G / 8) + F0.bx / 8 : F0.bx; F0.zv = 0; F0.zs = 0;
    F0.rep = args.rep; F0.ws = args.ws; F0.ctl = (unsigned*)(args.ws + WS_CTL); F0.in = args.in; F0.out = args.out;
    for (int u = F0.tid; u < (LDS_BYTES - LDSCTL_OFF) / 4; u += NWAVES * 64) ((LAS unsigned*)(F0.lds + LDSCTL_OFF))[u] = 0u;
    __syncthreads();
    const int lo = args.lo, hi = args.hi;
    XcdBarrier bar; bar.bar = F0.ctl + CW_BAR + args.li * XCD_BAR_WORDS; bar.x = 0; bar.st = nullptr; bar.w = 0; bar.z = 0;
    if (hi - lo > 1) bar = xcd_barrier_post(F0.ctl + CW_BAR + args.li * XCD_BAR_WORDS, (volatile LAS unsigned*)(F0.lds + MISC_OFF) + 8);
    int step = 0;
#define STEP_BEGIN if (step >= lo && step < hi) { Frame F = F0; { int zv_, zs_; asm volatile("v_mov_b32 %0, 0" : "=v"(zv_)); asm volatile("s_mov_b32 %0, 0" : "=s"(zs_)); \
        F.zv = zv_; F.zs = zs_; F.lane = (int)__builtin_amdgcn_mbcnt_hi(~0u, __builtin_amdgcn_mbcnt_lo(~0u, (unsigned)zv_)); F.wave = F0.wave + zs_; F.tid = F.wave * 64 + F.lane; F.bx = F.bx + zs_; \
        F.vcu = F0.vcu + zs_; F.G = F0.G + zs_; F.lds = (LAS unsigned char*)lds + zs_; F.ws = F0.ws + zs_; F.ctl = F0.ctl + zs_; F.in = F0.in + zs_; F.out = F0.out + zs_; }
#ifdef PROBE_XBAR
#define STEP_END   if (step + 1 < hi) { unsigned zb_; asm volatile("v_mov_b32 %0, 0" : "=v"(zb_)); bar.z = zb_; xcd_barrier(bar); xcd_barrier(bar); } } ++step;
#else
#define STEP_END   if (step + 1 < hi) { unsigned zb_; asm volatile("v_mov_b32 %0, 0" : "=v"(zb_)); bar.z = zb_; xcd_barrier(bar); } } ++step;
#endif

    for (int layer = 0; layer < DEPTH; ++layer) {
        const int jj = layer >> 1;
        STEP_BEGIN
            p_convert(F, layer);
            p_norm<0>(F, layer == 0 ? F.in[0] : F.out, F.in[1] + (size_t)layer * DM, nullptr, 0);
        STEP_END
        for (int c = 0; c < NCHUNK; ++c) {
            STEP_BEGIN
                pg8::StaticOrder S; S.init(MC, NPROJ, F.G, F.bx, WGM_PROJ);
                pg8::EpiProj E{WSP(bf16, WS_P1), WSP(bf16, WS_G)};
                run_gemm(F, WSP(bf16, WS_HN) + (size_t)c * MC * DM, WSP(bf16, WS_WIN), MC, NPROJ, DM, S, E);
            STEP_END
            STEP_BEGIN
                p_prep(F);
            STEP_END
            STEP_BEGIN
                LAS int* tab = (LAS int*)(F.lds + TAB_OFF);
                __syncthreads(); if (F.tid < 16) tab[F.tid] = F.tid >> 3; __syncthreads();
                pg8::GroupedOrder S; S.so.init(2 * 2048, 512, F.G, F.bx); S.tile_e = tab; S.nN = 2;
                pg8::EpiF32 E{WSP(float, WS_UL), 512, 2};
                run_gemm(F, WSP(bf16, WS_KVC), WSP(bf16, WS_WC1), 2 * 2048, 512, DM, S, E);
                p_sgu2(F, layer);
                p_stick2(F, F.G > 64 ? 32 : 0);
            STEP_END
            STEP_BEGIN
                p_cmpfin(F, layer);
            STEP_END
            STEP_BEGIN
#ifdef OLD_NSA
                p_nsa(F);
#else
                p_nsa2(F);
#endif
            STEP_END
            STEP_BEGIN
                pg8::MergeOrder S; S.so.init(MC, DM, F.G, F.bx); S.nmt = MC / 256;
                pg8::EpiMerge E{WSP(bf16, WS_G), WSP(bf16, WS_MG), MC / 256};
                run_gemm(F, WSP(bf16, WS_Y), WSP(bf16, WS_WBR), 3 * MC, 3 * DM, 256, S, E);
            STEP_END
            STEP_BEGIN
                pg8::StaticOrder S; S.init(MC, DM, F.G, F.bx);
                const float* base = (layer == 0 ? F.in[0] : F.out) + (size_t)c * MC * DM;
                pg8::EpiResid E{base, F.out + (size_t)c * MC * DM, DM, 1.0f};
                run_gemm(F, WSP(bf16, WS_MG), WSP(bf16, WS_WOUT), MC, DM, DM, S, E);
            STEP_END
        }
        if ((layer & 1) == 0) {
            STEP_BEGIN
                p_norm<0>(F, F.out, F.in[11] + (size_t)layer * DM, nullptr, 0, Q8_HN, TILED_FFN1);
            STEP_END
            for (int c = 0; c < FFN_CHUNKS; ++c) {
                constexpr int MF = MTOK / FFN_CHUNKS;
                STEP_BEGIN
                    pg8::StaticOrder S; S.init(MF, NFF1, F.G, F.bx, WGM_FFN1);
                    pg8::EpiSwiGLU E{WSP(bf16, WS_HID), DFFP, nullptr, NFF1 / 256};
                    run_gemm(F, WSP(bf16, WS_HN) + (size_t)c * MF * DM, WSP(bf16, WS_WF1), MF, NFF1, DM, S, E, true, TILED_FFN1);
                STEP_END
                STEP_BEGIN
                    pg8::StaticOrder S; S.init(MF, DM, F.G, F.bx, WGM_FFN2);
                    pg8::EpiResid E{F.out + (size_t)c * MF * DM, F.out + (size_t)c * MF * DM, DM, 1.0f};
                    run_gemm(F, WSP(bf16, WS_HID), WSP(bf16, WS_WF2), MF, DM, DFFP, S, E);
                STEP_END
            }
        } else {
            STEP_BEGIN
                p_norm<1>(F, F.out, F.in[11] + (size_t)layer * DM, F.in[15] + (size_t)jj * DM * NEXP, jj, Q8_HN);
            STEP_END
#ifdef ABL_DENSE_MOE
            for (int e = 0; e < NEXP; ++e) {
                STEP_BEGIN
                    pg8::StaticOrder S; S.init(MTOK, NMOE1, F.G, F.bx);
                    pg8::EpiSwiGLU E{WSP(bf16, WS_SCR + 8 * MiB), DFE, WSP(float, WS_SCR + 4 * MiB) + (size_t)e * MTOK, NMOE1 / 256};
                    run_gemm(F, WSP(bf16, WS_HN), WSP(bf16, WS_WF1) + (size_t)e * NMOE1 * DM, MTOK, NMOE1, DM, S, E);
                STEP_END
                STEP_BEGIN
                    pg8::StaticOrder S; S.init(MTOK, DM, F.G, F.bx);
                    pg8::EpiResid E{F.out, F.out, DM, 1.0f};
                    run_gemm(F, WSP(bf16, WS_SCR + 8 * MiB), WSP(bf16, WS_WF2) + (size_t)e * DM * DFE, MTOK, DM, DFE, S, E);
                STEP_END
            }
#else
            STEP_BEGIN
                p_gather(F, jj, 0, 0);
            STEP_END
            for (int c = 0; c < NCHUNK; ++c)
                for (int r = 0; r < 2; ++r) {
                    STEP_BEGIN
                        const int T = moe_table(F, jj, c, r);
                        pg8::GroupedOrder S; S.so.init(T * 256, NMOE1, F.G, F.bx, WGM_MOE1); S.tile_e = (LAS int*)(F.lds + TAB_OFF); S.nN = NMOE1 / 256;
                        pg8::EpiSwiGLU E{WSP(bf16, WS_HIDM), DFE, WSP(float, WS_WSLOT) + (c * 2 + r) * SLOTS, NMOE1 / 256};
                        run_gemm(F, WSP(bf16, WS_XG), WSP(bf16, WS_WF1), T * 256, NMOE1, DM, S, E, false);
                    STEP_END
                    STEP_BEGIN
                        const int T = moe_table(F, jj, c, r);
                        const int nwg = T * (DM / 256), R = nwg % F.G, full = nwg - R;
                        const int NS = (4 * R <= F.G) ? 4 : 2;
                        const bool split = (hi - lo > 1) && R > 0 && NS * R <= F.G && !F.rep;
                        int* tokm = WSP(int, WS_TOKMAP) + (c * 2 + r) * SLOTS; float* TB = WSP(float, WS_SCR + 320 * MiB);
                        { pg8::LimitOrder S; S.so.init(T * 256, DM, F.G, F.bx, WGM_MOE2); S.limit = split ? full : nwg;
                          pg8::GroupedLimit GS{S, (LAS int*)(F.lds + TAB_OFF), DM / 256};
                          pg8::EpiScatter E{F.out, tokm, DM / 256, 1.0f};
                          run_gemm(F, WSP(bf16, WS_HIDM), WSP(bf16, WS_WF2), T * 256, DM, DFE, GS, E, false); }
                        const bool more = c * 2 + r < 3;
                        if (split) {
                            const int KP = DFE / NS;
                            if (F.bx < NS * R) { const int Lx = full + F.bx / NS, kp = F.bx % NS;
                                pg8::StaticOrder so; so.init(T * 256, DM, F.G, Lx % F.G, WGM_MOE2); pg8::Unit un; so.next(Lx / F.G, un);
                                un.pn += ((LAS int*)(F.lds + TAB_OFF))[un.pm] * (DM / 256);
                                pg8::SingleOrder S1{un};
                                if (kp == 0) { pg8::EpiScatter E{F.out, tokm, DM / 256, 1.0f};
                                    run_gemm(F, WSP(bf16, WS_HIDM), WSP(bf16, WS_WF2), T * 256, DM, KP, S1, E, false, 0, DFE); }
                                else { pg8::EpiTile E{TB + ((size_t)(Lx - full) * 3 + (kp - 1)) * 65536};
                                    run_gemm(F, WSP(bf16, WS_HIDM) + kp * KP, WSP(bf16, WS_WF2) + kp * KP, T * 256, DM, KP, S1, E, false, 0, DFE); } }
                            if (more) p_gather(F, jj, (c * 2 + r + 1) >> 1, (c * 2 + r + 1) & 1, NS * R);
                            { unsigned zb_; asm volatile("v_mov_b32 %0, 0" : "=v"(zb_)); bar.z = zb_; xcd_barrier(bar); }
                            for (int it = (F.vcu * NWAVES + F.wave); it < R * 256; it += F.G * NWAVES) { const int j = it >> 8, row = it & 255, Lx = full + j;
                                pg8::StaticOrder so; so.init(T * 256, DM, F.G, Lx % F.G, WGM_MOE2); pg8::Unit un; so.next(Lx / F.G, un);
                                const int t = tokm[un.pm * 256 + row];
                                if (t >= 0) { f32x4* hp = (f32x4*)(F.out + (size_t)t * DM + un.pn * 256) + F.lane; f32x4 a = *hp;
                                    for (int q = 0; q < NS - 1; ++q) a = a + ((const f32x4*)(TB + ((size_t)j * 3 + q) * 65536 + row * 256))[F.lane];
                                    *hp = a; } }
                        } else if (!F.rep && more) p_gather(F, jj, (c * 2 + r + 1) >> 1, (c * 2 + r + 1) & 1, R);
                    STEP_END
                }
#endif
        }
    }
    STEP_BEGIN
        p_norm<2>(F, F.out, F.in[19], nullptr, 0);
    STEP_END
#undef STEP_BEGIN
#undef STEP_END
}

#ifndef MK_STEPS_PER_LAUNCH
#define MK_STEPS_PER_LAUNCH 1
#endif
extern "C" void kernel_launch(void* const* d_in, const int* in_sizes, int n_in, void* d_out, int out_size, void* d_ws, size_t ws_size, hipStream_t stream) {
    static int grid = 0;
    if (grid == 0) {
        if (n_in != 20 || in_sizes[0] != MTOK * DM || out_size != MTOK * DM || ws_size < WS_END) { fprintf(stderr, "kernel_launch: unexpected shapes (n_in %d, in0 %d, out %d, ws %zu)\n", n_in, n_in > 0 ? in_sizes[0] : -1, out_size, ws_size); grid = -1; return; }
        int dev = 0, cus = 0, per_cu = 0;
        if (hipGetDevice(&dev) != hipSuccess || hipDeviceGetAttribute(&cus, hipDeviceAttributeMultiprocessorCount, dev) != hipSuccess) { grid = -1; return; }
        if (hipFuncSetAttribute((const void*)mk_fwd, hipFuncAttributeMaxDynamicSharedMemorySize, LDS_BYTES) != hipSuccess) { fprintf(stderr, "kernel_launch: hipFuncSetAttribute failed\n"); grid = -1; return; }
        if (hipOccupancyMaxActiveBlocksPerMultiprocessor(&per_cu, (const void*)mk_fwd, NWAVES * 64, LDS_BYTES) != hipSuccess || per_cu < 1) fprintf(stderr, "kernel_launch: occupancy query reports %d\n", per_cu);
        (void)hipGetLastError();
        grid = cus;
    }
    if (grid < 0) return;
    if (hipMemsetAsync((char*)d_ws + WS_CTL, 0, CTL_ZERO_BYTES, stream) != hipSuccess) return;
    Args a{};
    for (int i = 0; i < 20; ++i) a.in[i] = (const float*)d_in[i];
    a.out = (float*)d_out; a.ws = (unsigned char*)d_ws; a.rep = 0;
    #ifdef ABL_DENSE_MOE
    constexpr int NSTEPS = 2 * (1 + NCHUNK * 8 + 3) + 2 * (1 + NCHUNK * 8 + 1 + NEXP * 2) + 1;
#else
    constexpr int NSTEPS = 2 * (1 + NCHUNK * 7 + 1 + 2 * FFN_CHUNKS) + 2 * (1 + NCHUNK * 7 + 2 + NCHUNK * 2 * 2) + 1;
#endif
    int li = 0;
#ifdef REPMASK
    static int kinds[256]; int ns = 0;
    for (int layer = 0; layer < DEPTH; ++layer) { kinds[ns++] = 0;
        for (int c = 0; c < NCHUNK; ++c) for (int q = 1; q <= 8; ++q) if (q != 5) kinds[ns++] = q;
        if ((layer & 1) == 0) { kinds[ns++] = 9; for (int c = 0; c < FFN_CHUNKS; ++c) { kinds[ns++] = 10; kinds[ns++] = 11; } }
        else { kinds[ns++] = 12; kinds[ns++] = 17; for (int c = 0; c < NCHUNK * 2; ++c) { kinds[ns++] = 14; kinds[ns++] = 13; } } }
    kinds[ns++] = 16;
    for (int s = 0; s < NSTEPS; ++s) { const int reps = ((REPMASK >> kinds[s]) & 1) ? 2 : 1;
        for (int r = 0; r < reps; ++r) { a.lo = s; a.hi = s + 1; a.li = 0; a.rep = r;
            hipLaunchKernelGGL(mk_fwd, dim3(grid), dim3(NWAVES * 64), LDS_BYTES, stream, a); } }
    (void)li;
#else
    for (int s = 0; s < NSTEPS; s += MK_STEPS_PER_LAUNCH) {
        a.lo = s; a.hi = (s + MK_STEPS_PER_LAUNCH < NSTEPS) ? s + MK_STEPS_PER_LAUNCH : NSTEPS; a.li = (MK_STEPS_PER_LAUNCH > 1) ? li : 0; ++li;
        hipLaunchKernelGGL(mk_fwd, dim3(grid), dim3(NWAVES * 64), LDS_BYTES, stream, a);
        if (hipPeekAtLastError() != hipSuccess) { fprintf(stderr, "kernel_launch: launch failed\n"); break; }
    }
#endif
}
```

```cpp
#define MK_STEPS_PER_LAUNCH 1000
#define PG8_WGM 4
#define FFN_CHUNKS 1
#include <hip/hip_runtime.h>
#include <cstdio>
#include <cstdint>
#include <cmath>
#ifndef PG8_AUX_A
#define PG8_AUX_A 0
#endif
#ifndef PG8_AUX_B
#define PG8_AUX_B 0
#endif
#ifndef PG8_WGM
#define PG8_WGM 8
#endif
namespace pg8 {
#define PG8_LAS __attribute__((address_space(3)))
typedef unsigned short bf16_t;
typedef short bf16x8 __attribute__((ext_vector_type(8)));
typedef float f32x4 __attribute__((ext_vector_type(4)));
typedef unsigned u32x4 __attribute__((ext_vector_type(4)));
constexpr int BM = 256, BK = 64, HALF = 128, HTB = HALF * BK * 2  , STAGE_BYTES = 8 * HTB, NXCD = 8, WGM = PG8_WGM;

__host__ __device__ __forceinline__ int lds_byte(int r, int c) { const int st = (r >> 4) * 2 + (c >> 5), rr = r & 15, cc = c & 31, ob = rr * 64 + cc * 2; return st * 1024 + (ob ^ (((ob >> 9) & 1) << 5)); }
__host__ __device__ __forceinline__ void stage_rc(int b, int& R, int& C) { const int st = b / 1024, sb = b % 1024, swz = sb ^ (((sb >> 9) & 1) << 5); R = (st >> 1) * 16 + swz / 64; C = (st & 1) * 32 + (swz % 64) / 2; }
__host__ __device__ __forceinline__ int perm32(int rho) { const int n = rho >> 4, i = rho & 15; return 8 * (i >> 2) + 4 * n + (i & 3); }

struct Unit { int pm, pn; };
struct Gemm { const bf16_t* A; const bf16_t* Bt; int M, N, K; int zv; int rot; int tiled; int ld; };

struct StaticOrder {
    int nM, nN, nwg, G, c, wgm;
    __host__ __device__ __forceinline__ void init(int M, int N, int G_, int c_, int wgm_ = WGM) { nM = M / BM; nN = N / BM; nwg = nM * nN; G = G_; c = c_; wgm = wgm_; }
    __host__ __device__ __forceinline__ bool next(int i, Unit& u) const {
        const long L = (long)i * G + c; if (L >= nwg) return false;
        int wgid = (int)L; { const int q = nwg / NXCD, r = nwg % NXCD, xcd = wgid % NXCD, off = wgid / NXCD; wgid = (xcd < r ? xcd * (q + 1) : r * (q + 1) + (xcd - r) * q) + off; }
        const int nig = wgm * nN, gid = wgid / nig, fm = gid * wgm, gsz = (nM - fm) < wgm ? (nM - fm) : wgm;
        u.pm = fm + ((wgid % nig) % gsz); u.pn = (wgid % nig) / gsz; return true;
    }
    __device__ __forceinline__ void a_ready(const Unit&) const {}
    __device__ __forceinline__ void done(const Unit&) const {}
};

__device__ __forceinline__ unsigned cvt_pk_bf16(float lo, float hi) { unsigned r; asm volatile("v_cvt_pk_bf16_f32 %0, %1, %2" : "=v"(r) : "v"(lo), "v"(hi)); return r; }
typedef float f32x2 __attribute__((ext_vector_type(2)));

__device__ __forceinline__ float fast_sigmoid(float x) { return __builtin_amdgcn_rcpf(1.0f + __builtin_amdgcn_exp2f(-1.4426950408889634f * x)); }
__device__ __forceinline__ float gelu_tanh(float x) {
    const float u2 = 1.5957691216057308f * (x + 0.044715f * x * x * x);
    return x * fast_sigmoid(u2);
}
__device__ __forceinline__ float bf_lo(unsigned u) { return __builtin_bit_cast(float, u << 16); }
__device__ __forceinline__ float bf_hi(unsigned u) { return __builtin_bit_cast(float, u & 0xffff0000u); }

#ifdef PG8_NT_OUT
#define PG8_STORE_OUT(p, v) __builtin_nontemporal_store((v), (p))
#else
#define PG8_STORE_OUT(p, v) (*(p) = (v))
#endif
struct EpiProj {
    static constexpr bool PERM = true, AFTER_DRAIN = false, MID = false; static constexpr int MID_TILES = 1; __device__ __forceinline__ void set_scale0() {}
    bf16_t* P1; bf16_t* G;
    __device__ __forceinline__ void operator()(const f32x4 (&acc)[2][2][4][2], const Unit& u, int wr, int wc, int fr, int fq) const {
        const int row0 = u.pm * BM + wr * 64 + fr;
        bf16_t* base; int ldc, colt, act0, act1;
        if (u.pn < 8) { base = P1; ldc = 2048; colt = u.pn * BM; act0 = (u.pn < 2) ? 1 : 0; act1 = (u.pn == 7) ? 2 : act0; }
        else { base = G; ldc = 3072; colt = (u.pn - 8) * BM; act0 = 2; act1 = 2; }
        const int col0 = colt + wc * 32 + 8 * fq;
#pragma unroll
        for (int ai = 0; ai < 2; ++ai)
#pragma unroll
            for (int m = 0; m < 4; ++m) { bf16_t* rowp = base + (size_t)(row0 + ai * HALF + m * 16) * ldc + col0;
#pragma unroll
                for (int bj = 0; bj < 2; ++bj) { f32x4 v0 = acc[ai][bj][m][0], v1 = acc[ai][bj][m][1]; const int act = bj ? act1 : act0;
                    if (act == 1) {
#pragma unroll
                        for (int e = 0; e < 4; ++e) { v0[e] = gelu_tanh(v0[e]); v1[e] = gelu_tanh(v1[e]); } }
                    else if (act == 2) {
#pragma unroll
                        for (int e = 0; e < 4; ++e) { v0[e] = fast_sigmoid(v0[e]); v1[e] = fast_sigmoid(v1[e]); } }
                    u32x4 w; w.x = cvt_pk_bf16(v0[0], v0[1]); w.y = cvt_pk_bf16(v0[2], v0[3]); w.z = cvt_pk_bf16(v1[0], v1[1]); w.w = cvt_pk_bf16(v1[2], v1[3]);
                    *(u32x4*)(rowp + bj * HALF) = w; } }
    }
};
struct EpiMerge {
    static constexpr bool PERM = true, AFTER_DRAIN = false, MID = false; static constexpr int MID_TILES = 1; __device__ __forceinline__ void set_scale0() {}
    const bf16_t* G; bf16_t* MG; int nmt;
    __device__ __forceinline__ void operator()(const f32x4 (&acc)[2][2][4][2], const Unit& u, int wr, int wc, int fr, int fq) const {
        const int i = u.pn >> 2, pn = u.pn & 3, pm = u.pm - i * nmt;
        const int row0 = pm * BM + wr * 64 + fr, col0 = pn * BM + wc * 32 + 8 * fq;
#pragma unroll
        for (int ai = 0; ai < 2; ++ai)
#pragma unroll
            for (int mp = 0; mp < 2; ++mp) {
                u32x4 g[4], o[4];
#pragma unroll
                for (int q = 0; q < 4; ++q) { const int m = 2 * mp + (q >> 1), bj = q & 1; const size_t row = (size_t)(row0 + ai * HALF + m * 16); const int col = col0 + bj * HALF;
                    g[q] = *(const u32x4*)(G + row * 3072 + i * 1024 + col);
                    if (i > 0) o[q] = *(const u32x4*)(MG + row * 1024 + col); else o[q] = (u32x4){0u, 0u, 0u, 0u}; }
#pragma unroll
                for (int q = 0; q < 4; ++q) { const int m = 2 * mp + (q >> 1), bj = q & 1; const size_t row = (size_t)(row0 + ai * HALF + m * 16); const int col = col0 + bj * HALF;
                    f32x4 v0 = acc[ai][bj][m][0], v1 = acc[ai][bj][m][1];
#ifdef ABL_BRANCH
                    if (i == ABL_BRANCH) { v0 = v0 * (float)ABL_SCALE; v1 = v1 * (float)ABL_SCALE; }
#endif
                    v0[0] = v0[0] * bf_lo(g[q].x) + bf_lo(o[q].x); v0[1] = v0[1] * bf_hi(g[q].x) + bf_hi(o[q].x); v0[2] = v0[2] * bf_lo(g[q].y) + bf_lo(o[q].y); v0[3] = v0[3] * bf_hi(g[q].y) + bf_hi(o[q].y);
                    v1[0] = v1[0] * bf_lo(g[q].z) + bf_lo(o[q].z); v1[1] = v1[1] * bf_hi(g[q].z) + bf_hi(o[q].z); v1[2] = v1[2] * bf_lo(g[q].w) + bf_lo(o[q].w); v1[3] = v1[3] * bf_hi(g[q].w) + bf_hi(o[q].w);
                    u32x4 w; w.x = cvt_pk_bf16(v0[0], v0[1]); w.y = cvt_pk_bf16(v0[2], v0[3]); w.z = cvt_pk_bf16(v1[0], v1[1]); w.w = cvt_pk_bf16(v1[2], v1[3]);
                    *(u32x4*)(MG + row * 1024 + col) = w; } }
    }
};
struct EpiResid {
    static constexpr bool PERM = false, AFTER_DRAIN = false, MID = false; static constexpr int MID_TILES = 1; __device__ __forceinline__ void set_scale0() { scale = 0.f; base = out; }
    const float* base; float* out; int ldc; float scale;
    __device__ __forceinline__ void operator()(const f32x4 (&acc)[2][2][4][2], const Unit& u, int wr, int wc, int fr, int fq) const {
        const int row0 = u.pm * BM + wr * 64 + fr, col0 = u.pn * BM + wc * 32 + 4 * fq;
#pragma unroll
        for (int ai = 0; ai < 2; ++ai)
#pragma unroll
            for (int mp = 0; mp < 2; ++mp) {
                f32x4 b[8];
#pragma unroll
                for (int q = 0; q < 8; ++q) { const int m = 2 * mp + (q >> 2), bj = (q >> 1) & 1, n = q & 1;
                    b[q] = *(const f32x4*)(base + (size_t)(row0 + ai * HALF + m * 16) * ldc + col0 + bj * HALF + n * 16); }
#pragma unroll
                for (int q = 0; q < 8; ++q) { const int m = 2 * mp + (q >> 2), bj = (q >> 1) & 1, n = q & 1;
                    *(f32x4*)(out + (size_t)(row0 + ai * HALF + m * 16) * ldc + col0 + bj * HALF + n * 16) = b[q] + acc[ai][bj][m][n] * scale; } }
    }
};
struct EpiF32 {
    static constexpr bool PERM = false, AFTER_DRAIN = false, MID = false; static constexpr int MID_TILES = 1; __device__ __forceinline__ void set_scale0() {}
    float* O; int ldc, nN;
    __device__ __forceinline__ void operator()(const f32x4 (&acc)[2][2][4][2], const Unit& u, int wr, int wc, int fr, int fq) const {
        const int row0 = u.pm * BM + wr * 64 + fr, col0 = (u.pn % nN) * BM + wc * 32 + 4 * fq;
#pragma unroll
        for (int ai = 0; ai < 2; ++ai)
#pragma unroll
            for (int m = 0; m < 4; ++m) { const size_t off = (size_t)(row0 + ai * HALF + m * 16) * ldc + col0;
#pragma unroll
                for (int bj = 0; bj < 2; ++bj)
#pragma unroll
                    for (int n = 0; n < 2; ++n) *(f32x4*)(O + off + bj * HALF + n * 16) = acc[ai][bj][m][n]; }
    }
};
#ifdef EMU_FP8_HID
__device__ __forceinline__ float Q8H(float x) { const int p = __builtin_amdgcn_cvt_pk_fp8_f32(x * 8.f, x * 8.f, 0, false); return __builtin_amdgcn_cvt_f32_fp8(p, 0) * 0.125f; }
#else
__device__ __forceinline__ float Q8H(float x) { return x; }
#endif
struct EpiSwiGLU {
    static constexpr bool PERM = true, AFTER_DRAIN = false, MID = false; static constexpr int MID_TILES = 1; __device__ __forceinline__ void set_scale0() {}
    bf16_t* H; int ldh; const float* rowscale; int nN; int rowmask = 0x7fffffff;
    __device__ __forceinline__ void operator()(const f32x4 (&acc)[2][2][4][2], const Unit& u, int wr, int wc, int fr, int fq) const {
        const int row0 = u.pm * BM + wr * 64 + fr, col0 = (u.pn % nN) * HALF + wc * 32 + 8 * fq;
        float scv[8];
#pragma unroll
        for (int q = 0; q < 8; ++q) scv[q] = rowscale ? rowscale[row0 + (q >> 2) * HALF + (q & 3) * 16] : 1.0f;
#pragma unroll
        for (int ai = 0; ai < 2; ++ai)
#pragma unroll
            for (int m = 0; m < 4; ++m) { const int row = row0 + ai * HALF + m * 16; const float sc = scv[ai * 4 + m];
                float h[8];
#pragma unroll
                for (int n = 0; n < 2; ++n)
#pragma unroll
                    for (int e = 0; e < 4; ++e) { const float g = acc[ai][0][m][n][e], up = acc[ai][1][m][n][e]; h[n * 4 + e] = Q8H(g * fast_sigmoid(g) * up * sc); }
                u32x4 w; w.x = cvt_pk_bf16(h[0], h[1]); w.y = cvt_pk_bf16(h[2], h[3]); w.z = cvt_pk_bf16(h[4], h[5]); w.w = cvt_pk_bf16(h[6], h[7]);
                PG8_STORE_OUT((u32x4*)(H + (size_t)(row & rowmask) * ldh + col0), w); }
    }
};
struct EpiScatter {
    static constexpr bool PERM = false, AFTER_DRAIN = false, MID = false; static constexpr int MID_TILES = 1; __device__ __forceinline__ void set_scale0() { scale = 0.f; }
    float* out; const int* tok; int nN; float scale;
    __device__ __forceinline__ void operator()(const f32x4 (&acc)[2][2][4][2], const Unit& u, int wr, int wc, int fr, int fq) const {
        const int row0 = u.pm * BM + wr * 64 + fr, col0 = (u.pn % nN) * BM + wc * 32 + 4 * fq;
        int tk[8];
#pragma unroll
        for (int q = 0; q < 8; ++q) tk[q] = tok[row0 + (q >> 2) * HALF + (q & 3) * 16];
#pragma unroll
        for (int ai = 0; ai < 2; ++ai)
#pragma unroll
            for (int mp = 0; mp < 2; ++mp) {
                f32x4 b[8];
#pragma unroll
                for (int q = 0; q < 8; ++q) { const int m = 2 * mp + (q >> 2), bj = (q >> 1) & 1, n = q & 1; const int t = tk[ai * 4 + m];
                    b[q] = *(const f32x4*)(out + (size_t)(t < 0 ? 0 : t) * 1024 + col0 + bj * HALF + n * 16); }
#pragma unroll
                for (int q = 0; q < 8; ++q) { const int m = 2 * mp + (q >> 2), bj = (q >> 1) & 1, n = q & 1; const int t = tk[ai * 4 + m];
#ifdef ABL_MOE
                    if (false)
#else
                    if (t >= 0)
#endif
                        *(f32x4*)(out + (size_t)t * 1024 + col0 + bj * HALF + n * 16) = b[q] + acc[ai][bj][m][n] * scale; } }
    }
};
struct GroupedOrder {
    StaticOrder so; const PG8_LAS int* tile_e; int nN;
    __device__ __forceinline__ bool next(int i, Unit& u) const { if (!so.next(i, u)) return false; u.pn += tile_e[u.pm] * nN; return true; }
    __device__ __forceinline__ void a_ready(const Unit&) const {}
    __device__ __forceinline__ void done(const Unit&) const {}
};
struct LimitOrder {
    StaticOrder so; int limit;
    __device__ __forceinline__ bool next(int i, Unit& u) const { if ((long)i * so.G + so.c >= limit) return false; return so.next(i, u); }
    __device__ __forceinline__ void a_ready(const Unit&) const {}
    __device__ __forceinline__ void done(const Unit&) const {}
};
struct GroupedLimit {
    LimitOrder lo; const PG8_LAS int* tile_e; int nN;
    __device__ __forceinline__ bool next(int i, Unit& u) const { if (!lo.next(i, u)) return false; u.pn += tile_e[u.pm] * nN; return true; }
    __device__ __forceinline__ void a_ready(const Unit&) const {}
    __device__ __forceinline__ void done(const Unit&) const {}
};
struct SingleOrder {
    Unit un;
    __device__ __forceinline__ bool next(int i, Unit& u) const { if (i != 0) return false; u = un; return true; }
    __device__ __forceinline__ void a_ready(const Unit&) const {}
    __device__ __forceinline__ void done(const Unit&) const {}
};
struct EpiTile {
    static constexpr bool PERM = false, AFTER_DRAIN = false, MID = false; static constexpr int MID_TILES = 1; __device__ __forceinline__ void set_scale0() {}
    float* O;
    __device__ __forceinline__ void operator()(const f32x4 (&acc)[2][2][4][2], const Unit&, int wr, int wc, int fr, int fq) const {
#pragma unroll
        for (int ai = 0; ai < 2; ++ai)
#pragma unroll
            for (int m = 0; m < 4; ++m)
#pragma unroll
                for (int bj = 0; bj < 2; ++bj)
#pragma unroll
                    for (int n = 0; n < 2; ++n) *(f32x4*)(O + (size_t)(wr * 64 + fr + ai * HALF + m * 16) * 256 + wc * 32 + 4 * fq + bj * HALF + n * 16) = acc[ai][bj][m][n];
    }
};
struct OffsetOrder {
    StaticOrder so; int pn_off;
    __device__ __forceinline__ bool next(int i, Unit& u) const { if (!so.next(i, u)) return false; u.pn += pn_off; return true; }
    __device__ __forceinline__ void a_ready(const Unit&) const {}
    __device__ __forceinline__ void done(const Unit&) const {}
};
struct ProbeOrder {
    StaticOrder so; int pm_mask;
    __device__ __forceinline__ bool next(int i, Unit& u) const { if (!so.next(i, u)) return false; u.pm &= pm_mask; return true; }
    __device__ __forceinline__ void a_ready(const Unit&) const {}
    __device__ __forceinline__ void done(const Unit&) const {}
};
struct MergeOrder {
    StaticOrder so; int nmt;
    __device__ __forceinline__ bool next(int i, Unit& u) const { const int b = i % 3; if (!so.next(i / 3, u)) return false; u.pm += b * nmt; u.pn += b * 4; return true; }
    __device__ __forceinline__ void a_ready(const Unit&) const {}
    __device__ __forceinline__ void done(const Unit&) const {}
};
template <class Epi, class Sched, bool ALIGN_EPI = false, bool SP2 = false>
__device__ __forceinline__ void gemm_phase(PG8_LAS unsigned char* lds, const Gemm g, const Sched& S, const Epi& E) {
    const int tid = g.zv  , wid = __builtin_amdgcn_readfirstlane(tid >> 6), lane = tid & 63, wr = wid >> 2, wc = wid & 3, fr = lane & 15, fq = lane >> 4;
    const int K = g.K, nt = K / BK;
    unsigned voffA[2], voffB[2];
#pragma unroll
    for (int i = 0; i < 2; ++i) { int R, C; stage_rc(tid * 16 + i * 8192, R, C); const int Rb = Epi::PERM ? ((R & ~31) + perm32(R & 31)) : R;
        const int LD = g.ld ? g.ld : K;
        const int pitch = g.tiled ? BK : LD;
        voffA[i] = (unsigned)(R * pitch + C) * 2u; voffB[i] = (unsigned)(Rb * pitch + C) * 2u; }
    const size_t kstep = g.tiled ? (size_t)(BM * BK * 2) : (size_t)(BK * 2);
    const size_t hstep = g.tiled ? (size_t)(HALF * BK * 2) : (size_t)HALF * (g.ld ? g.ld : K) * 2;
    const size_t tstep = (size_t)BM * (g.ld ? g.ld : K) * 2;
    const unsigned ldsw = (unsigned)wid * 1024u;
    const int aoff = lds_byte(wr * 64 + fr, fq * 8), boff = lds_byte(wc * 32 + fr, fq * 8);
#define PG8_SA(b, h) (((b) * 2 + (h)) * HTB)
#define PG8_SB(b, h) ((4 + (b) * 2 + (h)) * HTB)
#define PG8_STAGE(bufoff, gbase, voff) do { _Pragma("unroll") for (int _i = 0; _i < 2; ++_i) \
        __builtin_amdgcn_global_load_lds((const unsigned*)((const char*)(gbase) + (voff)[_i]), (PG8_LAS unsigned*)(lds + (bufoff) + ldsw + _i * 8192), 16, 0, ((bufoff) < 4 * HTB) ? PG8_AUX_A : PG8_AUX_B); } while (0)
#define PG8_LDA(dst, b, h) do { _Pragma("unroll") for (int m = 0; m < 4; ++m) _Pragma("unroll") for (int k = 0; k < 2; ++k) dst[m][k] = *(const PG8_LAS bf16x8*)(lds + PG8_SA(b, h) + aoff + m * 2048 + k * 1024); } while (0)
#define PG8_LDB(dst, b, h) do { _Pragma("unroll") for (int n = 0; n < 2; ++n) _Pragma("unroll") for (int k = 0; k < 2; ++k) dst[n][k] = *(const PG8_LAS bf16x8*)(lds + PG8_SB(b, h) + boff + n * 2048 + k * 1024); } while (0)
#define PG8_MMA(ai, bj, At, Bt) do { __builtin_amdgcn_s_setprio(1); _Pragma("unroll") for (int m = 0; m < 4; ++m) _Pragma("unroll") for (int n = 0; n < 2; ++n) _Pragma("unroll") for (int k = 0; k < 2; ++k) \
        acc[ai][bj][m][n] = __builtin_amdgcn_mfma_f32_16x16x32_bf16(Bt[n][k], At[m][k], acc[ai][bj][m][n], 0, 0, 0); __builtin_amdgcn_s_setprio(0); } while (0)
#define PG8_WAIT_V(n) asm volatile("s_waitcnt vmcnt(" #n ")" ::: "memory")
#define PG8_WAIT_L(n) asm volatile("s_waitcnt lgkmcnt(" #n ")" ::: "memory")
#define PG8_BAR __builtin_amdgcn_s_barrier()
#define PG8_SCHED __builtin_amdgcn_sched_barrier(0)
    Unit cur, nxt; int ui = 0;
    if (!S.next(0, cur)) return;
    f32x4 acc[2][2][4][2];
#pragma unroll
    for (int a = 0; a < 2; ++a)
#pragma unroll
        for (int b = 0; b < 2; ++b)
#pragma unroll
            for (int m = 0; m < 4; ++m)
#pragma unroll
                for (int n = 0; n < 2; ++n) acc[a][b][m][n] = (f32x4){0.f, 0.f, 0.f, 0.f};
    bf16x8 At[4][2], B0[2][2], B1[2][2];
    const char* cA = (const char*)g.A + (size_t)cur.pm * tstep; const char* cB = (const char*)g.Bt + (size_t)cur.pn * tstep;
    const int rot = g.rot; const size_t rofs = (size_t)rot * kstep; const char* pA = cA + rofs; const char* pB = cB + rofs;
#define PG8_KT(x) ((size_t)(((x) + rot >= nt) ? (x) + rot - nt : (x) + rot))
    S.a_ready(cur);
    if constexpr (SP2) {
        PG8_STAGE(PG8_SB(0, 0), pB, voffB); PG8_STAGE(PG8_SB(0, 1), pB + hstep, voffB); PG8_STAGE(PG8_SA(0, 0), pA, voffA); PG8_STAGE(PG8_SA(0, 1), pA + hstep, voffA);
        if (wr == 1) PG8_BAR;
        PG8_WAIT_V(2); PG8_BAR;
        PG8_STAGE(PG8_SB(1, 0), pB + kstep, voffB); PG8_STAGE(PG8_SA(1, 0), pA + kstep, voffA); PG8_STAGE(PG8_SB(1, 1), pB + hstep + kstep, voffB);
        PG8_WAIT_V(6); PG8_BAR;
    } else {
        PG8_STAGE(PG8_SB(0, 0), pB, voffB); PG8_STAGE(PG8_SA(0, 0), pA, voffA); PG8_STAGE(PG8_SB(0, 1), pB + hstep, voffB); PG8_STAGE(PG8_SA(0, 1), pA + hstep, voffA);
        if (wr == 1) PG8_BAR;
        PG8_WAIT_V(4); PG8_BAR;
        PG8_STAGE(PG8_SB(1, 0), pB + kstep, voffB); PG8_STAGE(PG8_SA(1, 0), pA + kstep, voffA); PG8_STAGE(PG8_SB(1, 1), pB + hstep + kstep, voffB);
        PG8_WAIT_V(6); PG8_BAR;
    }
    for (;;) {
        const bool has_next = S.next(ui + 1, nxt);
        const char* nA = has_next ? (const char*)g.A + (size_t)nxt.pm * tstep : cA; const char* nB = has_next ? (const char*)g.Bt + (size_t)nxt.pn * tstep : cB;
        for (int t = 0; t < nt; t += 2) {
            if constexpr (Epi::MID) { if (t != 0 && (t & (Epi::MID_TILES - 1)) == 0) E.mid(acc, cur, t / Epi::MID_TILES, wr, wc, fr, fq); }
            const bool last = (t == nt - 2);
            const char* a1 = cA + PG8_KT(t + 1) * kstep;
            const char* a2 = last ? nA + rofs : cA + PG8_KT(t + 2) * kstep; const char* b2 = last ? nB + rofs : cB + PG8_KT(t + 2) * kstep;
            const char* a3 = a2 + kstep; const char* b3 = b2 + kstep;
            if (last && has_next) S.a_ready(nxt);
            if constexpr (SP2) {
            PG8_LDB(B0, 0, 0); PG8_LDB(B1, 0, 1); PG8_SCHED; PG8_LDA(At, 0, 0); PG8_STAGE(PG8_SA(1, 1), a1 + hstep, voffA);
            PG8_WAIT_V(8); PG8_WAIT_L(0); PG8_BAR; PG8_MMA(0, 0, At, B0); PG8_MMA(0, 1, At, B1); PG8_BAR; PG8_SCHED;
            PG8_LDA(At, 0, 1); PG8_STAGE(PG8_SB(0, 0), b2, voffB); PG8_STAGE(PG8_SB(0, 1), b2 + hstep, voffB); PG8_STAGE(PG8_SA(0, 0), a2, voffA);
            PG8_WAIT_V(8); PG8_WAIT_L(0); PG8_BAR; PG8_MMA(1, 0, At, B0); PG8_MMA(1, 1, At, B1); PG8_BAR; PG8_SCHED;
            PG8_LDB(B0, 1, 0); PG8_LDB(B1, 1, 1); PG8_SCHED; PG8_LDA(At, 1, 0); PG8_STAGE(PG8_SA(0, 1), a2 + hstep, voffA);
            PG8_WAIT_V(8); PG8_WAIT_L(0); PG8_BAR; PG8_MMA(0, 0, At, B0); PG8_MMA(0, 1, At, B1); PG8_BAR; PG8_SCHED;
            PG8_LDA(At, 1, 1); PG8_STAGE(PG8_SB(1, 0), b3, voffB); PG8_STAGE(PG8_SB(1, 1), b3 + hstep, voffB); PG8_STAGE(PG8_SA(1, 0), a3, voffA);
            PG8_WAIT_V(8); PG8_WAIT_L(0); PG8_BAR; PG8_MMA(1, 0, At, B0); PG8_MMA(1, 1, At, B1); PG8_BAR; PG8_SCHED;
            } else {
            PG8_LDB(B0, 0, 0); PG8_SCHED; PG8_LDA(At, 0, 0); PG8_STAGE(PG8_SA(1, 1), a1 + hstep, voffA);
            PG8_WAIT_L(8); PG8_BAR; PG8_WAIT_L(0); PG8_MMA(0, 0, At, B0); PG8_BAR; PG8_SCHED;
            PG8_LDB(B1, 0, 1); PG8_STAGE(PG8_SB(0, 0), b2, voffB);
            PG8_BAR; PG8_WAIT_L(0); PG8_MMA(0, 1, At, B1); PG8_BAR;
            PG8_LDA(At, 0, 1); PG8_STAGE(PG8_SA(0, 0), a2, voffA);
            PG8_BAR; PG8_WAIT_L(0); PG8_MMA(1, 0, At, B0); PG8_BAR; PG8_SCHED;
            PG8_STAGE(PG8_SB(0, 1), b2 + hstep, voffB);
            PG8_WAIT_V(6); PG8_BAR; PG8_MMA(1, 1, At, B1); PG8_BAR;
            PG8_LDB(B0, 1, 0); PG8_SCHED; PG8_LDA(At, 1, 0); PG8_STAGE(PG8_SA(0, 1), a2 + hstep, voffA);
            PG8_WAIT_L(8); PG8_BAR; PG8_WAIT_L(0); PG8_MMA(0, 0, At, B0); PG8_BAR; PG8_SCHED;
            PG8_LDB(B1, 1, 1); PG8_STAGE(PG8_SB(1, 0), b3, voffB);
            PG8_BAR; PG8_WAIT_L(0); PG8_MMA(0, 1, At, B1); PG8_BAR;
            PG8_LDA(At, 1, 1); PG8_STAGE(PG8_SA(1, 0), a3, voffA);
            PG8_BAR; PG8_WAIT_L(0); PG8_MMA(1, 0, At, B0); PG8_BAR; PG8_SCHED;
            PG8_STAGE(PG8_SB(1, 1), b3 + hstep, voffB);
            PG8_WAIT_V(6); PG8_BAR; PG8_MMA(1, 1, At, B1); PG8_BAR;
            }
        }
        if constexpr (ALIGN_EPI) { if (wr == 0) PG8_BAR; }
        if constexpr (!Epi::AFTER_DRAIN) { E(acc, cur, wr, wc, fr, fq); S.done(cur); }
        if (!has_next) break;
#pragma unroll
        for (int a = 0; a < 2; ++a)
#pragma unroll
            for (int b = 0; b < 2; ++b)
#pragma unroll
                for (int m = 0; m < 4; ++m)
#pragma unroll
                    for (int n = 0; n < 2; ++n) acc[a][b][m][n] = (f32x4){0.f, 0.f, 0.f, 0.f};
        cur = nxt; cA = nA; cB = nB; ++ui;
        if constexpr (ALIGN_EPI) { if (wr == 1) PG8_BAR; }
    }
    PG8_WAIT_V(0);
    if constexpr (!ALIGN_EPI) { if (wr == 0) PG8_BAR; }
    PG8_BAR;
    if constexpr (Epi::AFTER_DRAIN) { E.fused(acc, cur, wr, wc, fr, fq, lds, wid, lane); S.done(cur); }
#undef PG8_KT
#undef PG8_SA
#undef PG8_SB
#undef PG8_STAGE
#undef PG8_LDA
#undef PG8_LDB
#undef PG8_MMA
#undef PG8_WAIT_V
#undef PG8_WAIT_L
#undef PG8_BAR
#undef PG8_SCHED
}
}

constexpr int NWAVES = 8;
constexpr int DM = 1024, BATCH = 16, SEQ = 4096, DEPTH = 4, MTOK = BATCH * SEQ;
constexpr int NCHUNK = 2, MC = MTOK / NCHUNK, BC = BATCH / NCHUNK;
constexpr int CIN = 5004, NPROJ = 5120, P1W = 2048, GWID = 3072;
constexpr int DFF = 2752, DFFP = 2816, NFF1 = 2 * DFFP;
constexpr int NEXP = 8, DFE = 3584, NMOE1 = 2 * DFE;
constexpr int SLOTS = MC + 2048;
constexpr float EPS = 1e-6f;
constexpr int C_U = 0, C_V = 256, C_SBQ = 512, C_SBK = 768, C_SBV = 1024, C_CQ = 1280, C_KCMP = 1536, C_VCMP = 1600, C_KSLC = 1664, C_VSLC = 1728, C_KWIN = 1792, C_VWIN = 1856, C_CG = 1920;

constexpr size_t MiB = 1u << 20;
constexpr size_t WS_CTL = 0, CTL_ZERO_BYTES = 1 * MiB;
constexpr size_t WS_ROPE = 1 * MiB;
constexpr size_t WS_BIAS1 = 1 * MiB + 512 * 1024;
constexpr size_t WS_WIN = 2 * MiB;
constexpr size_t WS_WBR = 12 * MiB;
constexpr size_t WS_WOUT = 14 * MiB;
constexpr size_t WS_WC1 = 16 * MiB;
constexpr size_t WS_WF1 = 18 * MiB;
constexpr size_t WS_WF2 = 130 * MiB;
constexpr size_t WS_HN = 186 * MiB;
constexpr size_t WS_SCR = 314 * MiB;
constexpr size_t WS_P1 = WS_SCR;
constexpr size_t WS_G = WS_P1 + 128 * MiB;
constexpr size_t WS_Y = WS_G + 192 * MiB;
constexpr size_t WS_MG = WS_Y + 48 * MiB;
constexpr size_t WS_KVC = WS_MG + 64 * MiB;
constexpr size_t WS_UL = WS_KVC + 8 * MiB;
constexpr size_t WS_KC = WS_UL + 8 * MiB;
constexpr size_t WS_VT = WS_KC + 1 * MiB;
constexpr size_t WS_KCT = WS_VT + 24 * MiB;
constexpr size_t WS_MIX_END = WS_KCT + 1 * MiB;
constexpr size_t WS_HID = WS_SCR;
constexpr size_t WS_ROUTE = WS_SCR;
constexpr size_t WS_TOKMAP = WS_SCR + 1 * MiB;
constexpr size_t WS_WSLOT = WS_SCR + 2 * MiB;
constexpr size_t WS_CNT128 = WS_SCR + 3 * MiB;
constexpr size_t WS_XG = WS_SCR + 4 * MiB;
constexpr size_t WS_HIDM = WS_XG + 68 * MiB;
constexpr size_t WS_END = 800 * MiB;
static_assert(WS_MIX_END <= WS_END && WS_HID + (size_t)MTOK * DFFP * 2 <= WS_END && WS_HIDM + (size_t)SLOTS * DFE * 2 <= WS_END, "d_ws map");
static_assert(WS_WF1 + (size_t)NEXP * NMOE1 * DM * 2 <= WS_WF2 && WS_WF2 + (size_t)NEXP * DM * DFE * 2 <= WS_HN, "weight map");
static_assert((size_t)4 * SLOTS * 4 <= 1 * MiB, "tokmap");
constexpr int CW_BAR = 4096;
constexpr int CW_CNT = 131072;
constexpr int CW_CUR = 131072 + 256;
constexpr int MAX_BAR_REGIONS = 32;
constexpr int RING_OFF = 0, RING_BYTES = 131072;
constexpr int LDSCTL_OFF = RING_BYTES, MISC_OFF = LDSCTL_OFF + 320;
constexpr int TAB_OFF = LDSCTL_OFF + 1024;
constexpr int LDS_BYTES = 147456;

#define GAS __attribute__((address_space(1)))
#define LAS __attribute__((address_space(3)))
typedef unsigned short bf16;
typedef unsigned v4u __attribute__((ext_vector_type(4)));
typedef unsigned v2u __attribute__((ext_vector_type(2)));
typedef float f32x4 __attribute__((ext_vector_type(4)));
typedef int v4i __attribute__((ext_vector_type(4)));
typedef __bf16 bf16x2_t __attribute__((ext_vector_type(2)));
#define LDS_WAIT() asm volatile("s_waitcnt lgkmcnt(0)" ::: "memory")
#define VM_WAIT() asm volatile("s_waitcnt vmcnt(0)" ::: "memory")
__device__ __forceinline__ unsigned f2bf(float f) { unsigned u = __builtin_bit_cast(unsigned, f); return (u + 0x7fffu + ((u >> 16) & 1u)) >> 16; }
__device__ __forceinline__ unsigned pk2(float lo, float hi) { return f2bf(lo) | (f2bf(hi) << 16); }
__device__ __forceinline__ float bflo(unsigned u) { return __builtin_bit_cast(float, u << 16); }
__device__ __forceinline__ float bfhi(unsigned u) { return __builtin_bit_cast(float, u & 0xffff0000u); }
__device__ __forceinline__ float bf1(bf16 h) { return __builtin_bit_cast(float, (unsigned)h << 16); }
__device__ __forceinline__ float dot2bf(unsigned a, unsigned b, float c) { return __builtin_amdgcn_fdot2_f32_bf16(__builtin_bit_cast(bf16x2_t, a), __builtin_bit_cast(bf16x2_t, b), c, false); }
#ifdef EMU_FP8
__device__ __forceinline__ float q8r(float x, float s) { const int p = __builtin_amdgcn_cvt_pk_fp8_f32(x * s, x * s, 0, false); return __builtin_amdgcn_cvt_f32_fp8(p, 0) * (1.0f / s); }
#else
__device__ __forceinline__ float q8r(float x, float) { return x; }
#endif
__device__ __forceinline__ float fexp(float x) { return __builtin_amdgcn_exp2f(1.4426950408889634f * x); }
template <int X> __device__ __forceinline__ float swz_xor(float v) { return __builtin_bit_cast(float, __builtin_amdgcn_ds_swizzle(__builtin_bit_cast(int, v), (X << 10) | 0x1f)); }
__device__ __forceinline__ float wave_sum(float v, int lane) {
#pragma unroll
    for (int o = 1; o < 64; o <<= 1) v += __builtin_bit_cast(float, __builtin_amdgcn_ds_bpermute((lane ^ o) << 2, __builtin_bit_cast(int, v)));
    return v;
}
__device__ __forceinline__ float rdlane(float v, int l) { return __builtin_bit_cast(float, __builtin_amdgcn_readlane(__builtin_bit_cast(int, v), l)); }
__device__ __forceinline__ int bperm(int srclane, int v) { return __builtin_amdgcn_ds_bpermute(srclane << 2, v); }
__constant__ double ROPE_INVF[8] = {1.0, 0.19392274474868576, 0.037606030930863933, 0.0072926647372171093, 0.0014142135623730950, 0.00027424817567620730, 5.3182958969449883e-05, 1.0313385377212460e-05};
#define XB_TMO      128
#define XB_XCNT(j)  (256  + 64 * (j))
#define XB_XSUB(j)  (1280 + 64 * (j))
#define XB_XGEN(j)  (2304 + 64 * (j))
#define XB_TOP      3328
#define XB_TOPGEN   3392
#define XCD_BAR_WORDS 3456
#define XB_SPIN_CAP (1u << 18)

__device__ __forceinline__ unsigned xb_ld(unsigned* p)              { return __hip_atomic_load(p, __ATOMIC_RELAXED, __HIP_MEMORY_SCOPE_AGENT); }
__device__ __forceinline__ unsigned xb_add(unsigned* p, unsigned v) { return __hip_atomic_fetch_add(p, v, __ATOMIC_RELAXED, __HIP_MEMORY_SCOPE_AGENT); }
__device__ __forceinline__ unsigned xb_xcc_id() { return (unsigned)__builtin_amdgcn_s_getreg((3 << 11) | 20) & 0xFu; }
#define XB_SPIN(cond, bar) do { unsigned _sp = 0; while (cond) { __builtin_amdgcn_s_sleep(1); \
    if ((++_sp & 255u) == 0u) { if (xb_ld(&(bar)[XB_TMO])) break; if (_sp > XB_SPIN_CAP) { atomicAdd(&(bar)[XB_TMO], 1u); break; } } } } while (0)

__device__ __forceinline__ bool xb_thread0_w(unsigned w, unsigned z) { return w == 0u && __builtin_amdgcn_mbcnt_hi(~0u, __builtin_amdgcn_mbcnt_lo(~0u, z)) == 0u; }
struct XcdBarrier {
    unsigned* bar; unsigned x; unsigned w, z;
    volatile LAS unsigned* st;
};

__device__ __forceinline__ XcdBarrier xcd_barrier_post(unsigned* bar, volatile LAS unsigned* st) {
    XcdBarrier b; b.bar = bar; b.x = xb_xcc_id(); b.st = st; b.w = (unsigned)__builtin_amdgcn_readfirstlane((int)(threadIdx.x >> 6)); b.z = 0u;
    if (xb_thread0_w(b.w, b.z)) (void)xb_add(&bar[XB_XCNT(b.x)], 1u);
    return b;
}
__device__ __forceinline__ void xcd_barrier_complete(unsigned* bar, unsigned x, unsigned& nloc, unsigned& nx) {
    const unsigned G = gridDim.x * gridDim.y * gridDim.z;
    unsigned sum, cnt, mine, sp = 0u;
    for (;;) {
        sum = 0u; cnt = 0u; mine = 0u;
#pragma unroll
        for (unsigned j = 0; j < 16; ++j) { const unsigned c = xb_ld(&bar[XB_XCNT(j)]); sum += c; cnt += (c > 0u) ? 1u : 0u; mine = (j == x) ? c : mine; }
        if (sum == G) break;
        __builtin_amdgcn_s_sleep(1);
        if ((++sp & 255u) == 0u) { if (xb_ld(&bar[XB_TMO])) break; if (sp > XB_SPIN_CAP) { atomicAdd(&bar[XB_TMO], 1u); break; } }
    }
    nloc = mine > 0u ? mine : 1u; nx = cnt > 0u ? cnt : 1u;
}

__device__ __forceinline__ void xcd_barrier(const XcdBarrier& b) {
    asm volatile("s_waitcnt vmcnt(0)" ::: "memory");
    __syncthreads();
    if (xb_thread0_w(b.w, b.z)) {
        unsigned* bar = b.bar;
        __builtin_amdgcn_s_waitcnt(0);
        unsigned nloc = b.st[0], nx = b.st[1];
        if (nloc == 0u) { xcd_barrier_complete(bar, b.x, nloc, nx); b.st[0] = nloc; b.st[1] = nx; }
        const unsigned old = xb_add(&bar[XB_XSUB(b.x)], 1u);
        const unsigned gen = old / nloc;
        if (old + 1u == (gen + 1u) * nloc) {
            __builtin_amdgcn_fence(__ATOMIC_RELEASE, "agent");
            asm volatile("s_waitcnt vmcnt(0)" ::: "memory");
            const unsigned og = xb_add(&bar[XB_TOP], 1u);
            const unsigned tg = og / nx;
            if (og + 1u == (tg + 1u) * nx) xb_add(&bar[XB_TOPGEN], 1u);
            else XB_SPIN(xb_ld(&bar[XB_TOPGEN]) == tg, bar);
            __builtin_amdgcn_fence(__ATOMIC_ACQUIRE, "agent");
            xb_add(&bar[XB_XGEN(b.x)], 1u);
            asm volatile("s_waitcnt vmcnt(0)" ::: "memory");
        } else {
            XB_SPIN(xb_ld(&bar[XB_XGEN(b.x)]) == gen, bar);
            __builtin_amdgcn_fence(__ATOMIC_ACQUIRE, "agent");
            asm volatile("s_waitcnt vmcnt(0)" ::: "memory");
        }
    }
    __syncthreads();
}

struct Frame {
    LAS unsigned char* lds;
    unsigned* ctl;
    int tid, lane, wave, vcu, G, bx, zv, zs, rep;
    unsigned char* ws;
    const float* const* in;
    float* out;
};
#define WSP(T, off) ((T*)(F.ws + (off)))
__device__ __forceinline__ size_t toff(int row, int k, int K) { return (size_t)(row >> 8) * 256 * K + (size_t)(k >> 6) * (256 * 64) + (size_t)(row & 255) * 64 + (k & 63); }

#ifndef TILED_FFN1
#define TILED_FFN1 0
#endif
#ifndef Q8_W1
#define Q8_W1 0.f
#define Q8_W2 0.f
#define Q8_HN 0.f
#define Q8_HID 0.f
#endif
__device__ __forceinline__ int map_row(int kind, int off, int n) { return kind == 0 ? n + off : (kind == 1 ? (n < 1932 ? n : n + 116) : ((n >> 7) * 256 + (n & 127) + off)); }
__device__ __forceinline__ void tr_item(const float* W, int ldw, int N, int ks, int n0, bf16* WT, int ldt, int kd, int kind, int off, LAS unsigned char* scr, int lane, float q8s = 0.f, int tiled = 0) {
    const int nq = (lane & 15) * 4, kq = lane >> 4;
    f32x4 x[16];
#pragma unroll
    for (int i = 0; i < 16; ++i) x[i] = (n0 + nq < N) ? *(const f32x4*)(W + (size_t)(ks + 4 * i + kq) * ldw + n0 + nq) : (f32x4){0.f, 0.f, 0.f, 0.f};
#pragma unroll
    for (int i = 0; i < 16; ++i) { const int k = 4 * i + kq;
#pragma unroll
        for (int c = 0; c < 4; ++c) { float wv = x[i][c]; if (q8s > 0.f) wv = q8r(wv, q8s); *(LAS bf16*)(scr + (nq + c) * 136 + k * 2) = (bf16)f2bf(wv); } }
    LDS_WAIT(); asm volatile("" ::: "memory");
    if (n0 + lane < N) { const LAS v2u* s = (const LAS v2u*)(scr + lane * 136); const int mr = map_row(kind, off, n0 + lane); bf16* dst = tiled ? WT + toff(mr, kd, ldt) : WT + (size_t)mr * ldt + kd;
#pragma unroll
        for (int q = 0; q < 8; ++q) { const v2u a = s[2 * q], b = s[2 * q + 1]; *(v4u*)(dst + 8 * q) = (v4u){a.x, a.y, b.x, b.y}; } }
    LDS_WAIT(); asm volatile("" ::: "memory");
}
__device__ __forceinline__ void conv(Frame& F, const float* W, size_t sW, int nb, int ldw, int N, int ks0, int K, bf16* WT, size_t sWT, int ldt, int kd0, int kind, int off, float q8s = 0.f, int tiled = 0) {
    LAS unsigned char* scr = F.lds + RING_OFF + F.wave * 16384;
    const int gw = F.vcu * NWAVES + F.wave, NGW = F.G * NWAVES;
    const int nblk = (N + 63) / 64, per = (K / 64) * nblk, total = per * nb;
    for (int it = gw; it < total; it += NGW) { const int b = it / per, r = it % per, kb = r / nblk, nbk = r % nblk;
        tr_item(W + (size_t)b * sW, ldw, N, ks0 + 64 * kb, 64 * nbk, WT + (size_t)b * sWT, ldt, kd0 + 64 * kb, kind, off, scr, F.lane, q8s, tiled); }
}
__device__ __forceinline__ void zero_block(Frame& F, bf16* WT, int ldt, int r0, int rows, int c0, int cols, int tiled = 0) {
    const int gt = (F.vcu * NWAVES + F.wave) * 64 + F.lane, NT = F.G * NWAVES * 64, cpr = cols / 8;
    for (int i = gt; i < rows * cpr; i += NT) { const int r = i / cpr, c = i % cpr; const unsigned z = (unsigned)F.zv; *(v4u*)(tiled ? WT + toff(r0 + r, c0 + 8 * c, ldt) : WT + (size_t)(r0 + r) * ldt + c0 + 8 * c) = (v4u){z, z, z, z}; }
}
__device__ __forceinline__ void p_convert(Frame& F, int layer) {
    const int j = layer >> 1;
    conv(F, F.in[2] + (size_t)layer * DM * CIN, 0, 1, CIN, CIN, 0, DM, WSP(bf16, WS_WIN), 0, DM, 0, 1, 0);
    zero_block(F, WSP(bf16, WS_WIN), DM, 1932, 116, 0, DM);
    conv(F, F.in[9] + (size_t)layer * 3 * 256 * DM, (size_t)256 * DM, 3, DM, DM, 0, 256, WSP(bf16, WS_WBR), (size_t)DM * 256, 256, 0, 0, 0);
    conv(F, F.in[10] + (size_t)layer * DM * DM, 0, 1, DM, DM, 0, DM, WSP(bf16, WS_WOUT), 0, DM, 0, 0, 0);
    conv(F, F.in[7] + (size_t)layer * 2 * 2048 * 256, (size_t)2048 * 256, 2, 256, 256, 0, 1024, WSP(bf16, WS_WC1), (size_t)512 * 1024, 1024, 0, 0, 0);
    conv(F, F.in[7] + (size_t)layer * 2 * 2048 * 256, (size_t)2048 * 256, 2, 256, 256, 1024, 1024, WSP(bf16, WS_WC1), (size_t)512 * 1024, 1024, 0, 0, 256);
    if ((layer & 1) == 0) {
        conv(F, F.in[12] + (size_t)j * DM * DFF, 0, 1, DFF, DFF, 0, DM, WSP(bf16, WS_WF1), 0, DM, 0, 2, 0, Q8_W1, TILED_FFN1);
        conv(F, F.in[13] + (size_t)j * DM * DFF, 0, 1, DFF, DFF, 0, DM, WSP(bf16, WS_WF1), 0, DM, 0, 2, 128, Q8_W1, TILED_FFN1);
        zero_block(F, WSP(bf16, WS_WF1), DM, 21 * 256 + 64, 64, 0, DM, TILED_FFN1);
        zero_block(F, WSP(bf16, WS_WF1), DM, 21 * 256 + 128 + 64, 64, 0, DM, TILED_FFN1);
        conv(F, F.in[14] + (size_t)j * DFF * DM, 0, 1, DM, DM, 0, DFF, WSP(bf16, WS_WF2), 0, DFFP, 0, 0, 0, Q8_W2);
        zero_block(F, WSP(bf16, WS_WF2), DFFP, 0, DM, DFF, DFFP - DFF);
    } else {
        conv(F, F.in[16] + (size_t)j * NEXP * DM * DFE, (size_t)DM * DFE, NEXP, DFE, DFE, 0, DM, WSP(bf16, WS_WF1), (size_t)NMOE1 * DM, DM, 0, 2, 0, Q8_W1);
        conv(F, F.in[17] + (size_t)j * NEXP * DM * DFE, (size_t)DM * DFE, NEXP, DFE, DFE, 0, DM, WSP(bf16, WS_WF1), (size_t)NMOE1 * DM, DM, 0, 2, 128, Q8_W1);
        conv(F, F.in[18] + (size_t)j * NEXP * DFE * DM, (size_t)DFE * DM, NEXP, DM, DM, 0, DFE, WSP(bf16, WS_WF2), (size_t)DM * DFE, DFE, 0, 0, 0, Q8_W2);
    }
    if (F.bx < 8) {
        __syncthreads();
        const int kv = F.bx >> 2, jj = (F.bx & 3) * 64 + F.lane;
        const float* pos = F.in[6] + (size_t)(layer * 2 + kv) * 2048; const float* w1 = F.in[7] + (size_t)(layer * 2 + kv) * 2048 * 256;
        float a = 0.f;
        float a1 = 0.f, a2 = 0.f, a3 = 0.f;
#pragma unroll 8
        for (int k = 0; k < 256; k += 4) { const int kk = F.wave * 256 + k;
            a += pos[kk] * w1[(size_t)kk * 256 + jj]; a1 += pos[kk + 1] * w1[(size_t)(kk + 1) * 256 + jj]; a2 += pos[kk + 2] * w1[(size_t)(kk + 2) * 256 + jj]; a3 += pos[kk + 3] * w1[(size_t)(kk + 3) * 256 + jj]; }
        a = (a + a1) + (a2 + a3);
        LAS float* red = (LAS float*)(F.lds + RING_OFF);
        red[F.wave * 64 + F.lane] = a;
        __syncthreads();
        if (F.wave == 0) { float s = 0.f;
#pragma unroll
            for (int w = 0; w < 8; ++w) s += red[w * 64 + F.lane];
            WSP(float, WS_BIAS1)[kv * 256 + jj] = s; }
        __syncthreads();
    }
    if (layer == 0) {
        const int gt = (F.vcu * NWAVES + F.wave) * 64 + F.lane, NT = F.G * NWAVES * 64;
        for (int idx = gt; idx < SEQ * 8; idx += NT) { const int pos = idx >> 3, i = idx & 7;
            const double invf = ROPE_INVF[i];
            double rev = (double)pos * invf * 0.15915494309189535; rev -= __builtin_floor(rev);
            WSP(float, WS_ROPE)[idx] = __builtin_amdgcn_cosf((float)rev); WSP(float, WS_ROPE)[SEQ * 8 + idx] = __builtin_amdgcn_sinf((float)rev); }
    }
}

template <int MODE> __device__ __forceinline__ void p_norm(Frame& F, const float* src, const float* g, const float* rw, int jmoe, float q8s = 0.f, int tiled = 0) {
    const int gw = F.vcu * NWAVES + F.wave, NGW = F.G * NWAVES, lane = F.lane;
    LAS int* hist = (LAS int*)(F.lds + TAB_OFF) + 192;
    if (MODE == 1) {
        if (F.tid < 16) hist[F.tid] = 0;
        const int gt = gw * 64 + lane, NT = NGW * 64; int* tm = WSP(int, WS_TOKMAP);
        for (int i = gt; i < 4 * SLOTS; i += NT) tm[i] = -1;
        for (int i = F.tid; i < DM * NEXP / 4; i += NWAVES * 64) *(LAS f32x4*)(F.lds + RING_OFF + 16 * i) = ((const f32x4*)rw)[i];
        __syncthreads();
    }
    f32x4 gv[4];
#pragma unroll
    for (int jx = 0; jx < 4; ++jx) gv[jx] = ((const f32x4*)g)[lane + 64 * jx];
    constexpr int ROWS = (MODE == 1) ? 2 : 4;
    const int nit = (MODE == 1) ? ((MTOK / 128 - F.bx + F.G - 1) / F.G) * (16 / ROWS) : (MTOK - gw + ROWS * NGW - 1) / (ROWS * NGW);
    for (int itx = 0; itx < nit; ++itx) {
        const int chk = (MODE == 1) ? F.bx + (itx / (16 / ROWS)) * F.G : 0;
        const int m0 = (MODE == 1) ? chk * 128 + F.wave * 16 + (itx % (16 / ROWS)) * ROWS : gw + itx * ROWS * NGW;
        const int mstep = (MODE == 1) ? 1 : NGW;
        f32x4 v[ROWS][4]; float ss[ROWS];
#pragma unroll
        for (int u = 0; u < ROWS; ++u) { const int m = m0 + u * mstep; const f32x4* xr = (const f32x4*)(src + (size_t)(m < MTOK ? m : m0) * DM) + lane;
#pragma unroll
            for (int jx = 0; jx < 4; ++jx) v[u][jx] = xr[64 * jx]; }
#pragma unroll
        for (int u = 0; u < ROWS; ++u) { float s = 0.f;
#pragma unroll
            for (int jx = 0; jx < 4; ++jx) s += (v[u][jx].x * v[u][jx].x + v[u][jx].y * v[u][jx].y) + (v[u][jx].z * v[u][jx].z + v[u][jx].w * v[u][jx].w);
            ss[u] = s; }
#pragma unroll
        for (int o = 1; o < 64; o <<= 1) {
#pragma unroll
            for (int u = 0; u < ROWS; ++u) ss[u] += __builtin_bit_cast(float, __builtin_amdgcn_ds_bpermute((lane ^ o) << 2, __builtin_bit_cast(int, ss[u]))); }
        float lgall[MODE == 1 ? ROWS : 1][8];
        if (MODE == 1) {
            float rs[ROWS];
#pragma unroll
            for (int u = 0; u < ROWS; ++u) { rs[u] = 1.0f / sqrtf(ss[u] * (1.f / DM) + EPS);
#pragma unroll
                for (int e = 0; e < 8; ++e) lgall[u][e] = 0.f; }
#pragma unroll
            for (int jx = 0; jx < 4; ++jx) { const LAS f32x4* wr = (const LAS f32x4*)(F.lds + RING_OFF + (size_t)(4 * lane + 256 * jx) * 32);
#pragma unroll
                for (int r = 0; r < 4; ++r) { const f32x4 a = wr[2 * r], b = wr[2 * r + 1];
#pragma unroll
                    for (int u = 0; u < ROWS; ++u) { const float xv = v[u][jx][r] * rs[u] * gv[jx][r];
                        lgall[u][0] += xv * a.x; lgall[u][1] += xv * a.y; lgall[u][2] += xv * a.z; lgall[u][3] += xv * a.w; lgall[u][4] += xv * b.x; lgall[u][5] += xv * b.y; lgall[u][6] += xv * b.z; lgall[u][7] += xv * b.w; } } }
        }
#pragma unroll
        for (int u = 0; u < ROWS; ++u) { const int m = m0 + u * mstep; if (m >= MTOK) continue;
            const float rstd = 1.0f / sqrtf(ss[u] * (1.f / DM) + EPS);
#pragma unroll
            for (int jx = 0; jx < 4; ++jx) v[u][jx] = v[u][jx] * rstd * gv[jx];
            if (MODE == 2) {
                f32x4* o = (f32x4*)(F.out + (size_t)m * DM) + lane;
#pragma unroll
                for (int jx = 0; jx < 4; ++jx) o[64 * jx] = v[u][jx];
            } else {
                unsigned long long* o8 = (unsigned long long*)(WSP(bf16, WS_HN) + (size_t)m * DM) + lane;
#pragma unroll
                for (int jx = 0; jx < 4; ++jx) { f32x4 w = v[u][jx];
                    if (tiled) { *(unsigned long long*)(WSP(bf16, WS_HN) + toff(m, 4 * lane + 256 * jx, DM)) = (unsigned long long)pk2(w.x, w.y) | ((unsigned long long)pk2(w.z, w.w) << 32); continue; } if (q8s > 0.f) { w.x = q8r(w.x, q8s); w.y = q8r(w.y, q8s); w.z = q8r(w.z, q8s); w.w = q8r(w.w, q8s); }
                    o8[64 * jx] = (unsigned long long)pk2(w.x, w.y) | ((unsigned long long)pk2(w.z, w.w) << 32); }
            }
            if (MODE == 1) {
                float lg[8];
#pragma unroll
                for (int e = 0; e < 8; ++e) lg[e] = lgall[u][e];
                float h4[4], h2[2], h1;
                { const bool up = lane & 1;
#pragma unroll
                  for (int i = 0; i < 4; ++i) { const float keep = up ? lg[4 + i] : lg[i], send = up ? lg[i] : lg[4 + i]; h4[i] = keep + __builtin_bit_cast(float, bperm(lane ^ 1, __builtin_bit_cast(int, send))); } }
                { const bool up = lane & 2;
#pragma unroll
                  for (int i = 0; i < 2; ++i) { const float keep = up ? h4[2 + i] : h4[i], send = up ? h4[i] : h4[2 + i]; h2[i] = keep + __builtin_bit_cast(float, bperm(lane ^ 2, __builtin_bit_cast(int, send))); } }
                { const bool up = lane & 4; const float keep = up ? h2[1] : h2[0], send = up ? h2[0] : h2[1]; h1 = keep + __builtin_bit_cast(float, bperm(lane ^ 4, __builtin_bit_cast(int, send))); }
                h1 += __builtin_bit_cast(float, bperm(lane ^ 8, __builtin_bit_cast(int, h1))); h1 += __builtin_bit_cast(float, bperm(lane ^ 16, __builtin_bit_cast(int, h1))); h1 += __builtin_bit_cast(float, bperm(lane ^ 32, __builtin_bit_cast(int, h1)));
                lg[0] = rdlane(h1, 0); lg[1] = rdlane(h1, 4); lg[2] = rdlane(h1, 2); lg[3] = rdlane(h1, 6); lg[4] = rdlane(h1, 1); lg[5] = rdlane(h1, 5); lg[6] = rdlane(h1, 3); lg[7] = rdlane(h1, 7);
                int e0 = 0; float v0 = lg[0];
#pragma unroll
                for (int e = 1; e < 8; ++e) if (lg[e] > v0) { v0 = lg[e]; e0 = e; }
                int e1 = -1; float v1 = -INFINITY;
#pragma unroll
                for (int e = 0; e < 8; ++e) if (e != e0 && lg[e] > v1) { v1 = lg[e]; e1 = e; }
                const float w0 = 1.0f / (1.0f + fexp(v1 - v0)), w1 = 1.0f - w0;
                if (lane == 0) { WSP(v4i, WS_ROUTE)[m] = (v4i){e0, e1, __builtin_bit_cast(int, w0), __builtin_bit_cast(int, w1)};
                    __hip_atomic_fetch_add(&hist[e0], 1, __ATOMIC_RELAXED, __HIP_MEMORY_SCOPE_WORKGROUP); __hip_atomic_fetch_add(&hist[8 + e1], 1, __ATOMIC_RELAXED, __HIP_MEMORY_SCOPE_WORKGROUP); }
            }
        }
        if (MODE == 1 && (itx % (16 / ROWS)) == 16 / ROWS - 1) {
            __syncthreads();
            if (F.tid < 16) { WSP(int, WS_CNT128)[(size_t)chk * 16 + F.tid] = hist[F.tid]; hist[F.tid] = 0; }
            __syncthreads();
        }
    }
}

__device__ __forceinline__ void p_prep(Frame& F) {
    const int gw = F.vcu * NWAVES + F.wave, NGW = F.G * NWAVES, lane = F.lane;
    bf16* P1 = WSP(bf16, WS_P1); bf16* KVC = WSP(bf16, WS_KVC); const float* rope = WSP(float, WS_ROPE);
    const int vec = lane >> 3, ri = lane & 7; const int cb = vec < 4 ? C_CQ + vec * 64 : (vec == 4 ? C_KCMP : (vec == 5 ? C_KSLC : C_KWIN));
    for (int row0 = gw; row0 < MC; row0 += 4 * NGW) {
        float x1[4], x2[4], cc[4], ss[4]; bf16 kc48[4], vc64[4];
#pragma unroll
        for (int k = 0; k < 4; ++k) { const int row = row0 + k * NGW < MC ? row0 + k * NGW : row0; const bf16* p = P1 + (size_t)row * P1W; const int pos = row & (SEQ - 1);
            const int cl = lane < 56 ? cb + ri : C_CQ;
            x1[k] = bf1(p[cl]); x2[k] = bf1(p[cl + 8]); cc[k] = rope[pos * 8 + ri]; ss[k] = rope[SEQ * 8 + pos * 8 + ri];
            if (F.rep) { cc[k] = 1.f; ss[k] = 0.f; }
            kc48[k] = p[C_KCMP + 16 + (lane < 48 ? lane : 0)]; vc64[k] = p[C_VCMP + lane]; }
#pragma unroll
        for (int k = 0; k < 4; ++k) { const int row = row0 + k * NGW; if (row >= MC) continue; bf16* p = P1 + (size_t)row * P1W;
            if (lane < 56) { const bf16 o1 = (bf16)f2bf(x1[k] * cc[k] - x2[k] * ss[k]), o2 = (bf16)f2bf(x2[k] * cc[k] + x1[k] * ss[k]);
                p[cb + ri] = o1; p[cb + ri + 8] = o2;
                if (vec == 4) { KVC[(size_t)row * 64 + ri] = o1; KVC[(size_t)row * 64 + ri + 8] = o2; } }
            if (lane < 48) KVC[(size_t)row * 64 + 16 + lane] = kc48[k];
            KVC[(size_t)MC * 64 + (size_t)row * 64 + lane] = vc64[k]; }
    }
    bf16* VT = WSP(bf16, WS_VT);
    for (int it = gw; it < 6 * BC * 64; it += NGW) { const int which = it / (BC * 64), r = it % (BC * 64), b = r >> 6, blk = r & 63;
        const v4u* src = (const v4u*)(P1 + ((size_t)b * SEQ + blk * 64 + lane) * P1W + (which == 0 ? C_VSLC : (which == 1 ? C_VWIN : C_SBV + (which - 2) * 64)));
        bf16* dst = VT + ((size_t)(which * BC + b) * 64) * SEQ + blk * 64 + lane;
        v4u xs[8];
#pragma unroll
        for (int i = 0; i < 8; ++i) xs[i] = src[i];
#pragma unroll
        for (int i = 0; i < 8; ++i) { const v4u x = xs[i];
            dst[(size_t)(8 * i + 0) * SEQ] = (bf16)(x.x & 0xffffu); dst[(size_t)(8 * i + 1) * SEQ] = (bf16)(x.x >> 16);
            dst[(size_t)(8 * i + 2) * SEQ] = (bf16)(x.y & 0xffffu); dst[(size_t)(8 * i + 3) * SEQ] = (bf16)(x.y >> 16);
            dst[(size_t)(8 * i + 4) * SEQ] = (bf16)(x.z & 0xffffu); dst[(size_t)(8 * i + 5) * SEQ] = (bf16)(x.z >> 16);
            dst[(size_t)(8 * i + 6) * SEQ] = (bf16)(x.w & 0xffffu); dst[(size_t)(8 * i + 7) * SEQ] = (bf16)(x.w >> 16); }
    }
}
__device__ __forceinline__ void p_sgu(Frame& F, int layer) {
    LAS float* vn = (LAS float*)(F.lds + RING_OFF);
    const bf16* P1 = WSP(bf16, WS_P1); bf16* Ya = WSP(bf16, WS_Y);
    const float* gain = F.in[3] + (size_t)layer * 256; const float* sw = F.in[4] + (size_t)layer * 4 * 128 * 128; const float* sb = F.in[5] + (size_t)layer * 4 * 128;
    const int lane = F.lane, wave = F.wave;
    for (int item = F.vcu; item < MC / 128; item += F.G) {
        const size_t r0 = (size_t)item * 128;
        __syncthreads();
        for (int rr = 0; rr < 16; ++rr) { const int r = wave * 16 + rr; const v2u raw = *(const v2u*)(P1 + (r0 + r) * P1W + C_V + 4 * lane);
            const float a = bflo(raw.x), b = bfhi(raw.x), c = bflo(raw.y), d = bfhi(raw.y);
            const float rstd = 1.0f / sqrtf(wave_sum((a * a + b * b) + (c * c + d * d), lane) * (1.f / 256.f) + EPS);
            const f32x4 gg = ((const f32x4*)gain)[lane];
            *(LAS f32x4*)(vn + r * 256 + 4 * lane) = (f32x4){a * rstd * gg.x, b * rstd * gg.y, c * rstd * gg.z, d * rstd * gg.w}; }
        __syncthreads();
        const int g = wave & 3, half = wave >> 2;
        for (int i = 0; i < 64; ++i) { const int t = 2 * i + half;
            const float* wrow = sw + ((size_t)g * 128 + t) * 128;
            const float w_lo = wrow[lane], w_hi = wrow[64 + lane];
            float acc = 0.f;
            for (int s = 0; s <= t; ++s) { const float w = (s < 64) ? rdlane(w_lo, s) : rdlane(w_hi, s - 64); acc += w * vn[s * 256 + g * 64 + lane]; }
            const float u = bf1(P1[(r0 + t) * P1W + C_U + g * 64 + lane]);
#ifdef ABL_SGUMIX
            acc = 0.f;
#endif
            Ya[(r0 + t) * 256 + g * 64 + lane] = (bf16)f2bf(u * (acc + sb[g * 128 + t])); }
    }
    __syncthreads();
}

__device__ __forceinline__ void p_cmpfin(Frame& F, int layer) {
    const int gw = F.vcu * NWAVES + F.wave, NGW = F.G * NWAVES, lane = F.lane;
    const float* UL = WSP(float, WS_UL); const float* bias = WSP(float, WS_BIAS1); bf16* KC = WSP(bf16, WS_KC);
    LAS float* w2l = (LAS float*)(F.lds + RING_OFF);
    __syncthreads();
    { const f32x4* src = (const f32x4*)(F.in[8] + (size_t)layer * 2 * 256 * 64);
#pragma unroll 4
      for (int i = F.tid; i < 2 * 256 * 64 / 4; i += NWAVES * 64) *(LAS f32x4*)(w2l + 4 * i) = src[i]; }
    __syncthreads();
    for (int it = gw; it < 2 * BC * 255; it += NGW) { const int kv = it / (BC * 255), r = it % (BC * 255), b = r / 255, m = r % 255;
        const LAS float* w2 = w2l + kv * 256 * 64;
        const float* U = UL + (size_t)(kv * 2048 + b * 256 + m) * 512; const float* L = U + 512 + 256;
        float hv[4];
#pragma unroll
        for (int q = 0; q < 4; ++q) hv[q] = pg8::gelu_tanh(U[64 * q + lane] + L[64 * q + lane] + bias[kv * 256 + 64 * q + lane]);
        float acc0 = 0.f, acc1 = 0.f;
#pragma unroll
        for (int q = 0; q < 4; ++q)
#pragma unroll 8
            for (int jj = 0; jj < 64; jj += 2) { acc0 += rdlane(hv[q], jj) * w2[(64 * q + jj) * 64 + lane]; acc1 += rdlane(hv[q], jj + 1) * w2[(64 * q + jj + 1) * 64 + lane]; }
        const float acc = acc0 + acc1;
        KC[((size_t)(kv * BC + b) * 256 + m) * 64 + lane] = (bf16)f2bf(acc);
        if (kv == 1) { WSP(bf16, WS_KCT)[((size_t)b * 64 + lane) * 256 + m] = (bf16)f2bf(acc); if (m == 254) WSP(bf16, WS_KCT)[((size_t)b * 64 + lane) * 256 + 255] = (bf16)0; }
        else if (m == 254) KC[((size_t)b * 256 + 255) * 64 + lane] = (bf16)0; }
    __syncthreads();
}

__device__ __forceinline__ void p_stick(Frame& F) {
    const int gw = F.vcu * NWAVES + F.wave, NGW = F.G * NWAVES, lane = F.lane;
    const bf16* P1 = WSP(bf16, WS_P1); bf16* Yb = WSP(bf16, WS_Y) + (size_t)MC * 256;
    for (int item = gw; item < BC * 4 * 64; item += NGW) { const int tb = item & 63, h = (item >> 6) & 3, b = item >> 8;
        const int t = tb * 64 + lane; const size_t row = (size_t)b * SEQ + t;
        unsigned q[32];
        { const v4u* qp = (const v4u*)(P1 + row * P1W + C_SBQ + h * 64);
#pragma unroll
          for (int i = 0; i < 8; ++i) { const v4u x = qp[i]; q[4 * i] = x.x; q[4 * i + 1] = x.y; q[4 * i + 2] = x.z; q[4 * i + 3] = x.w; } }
        float o[64];
#pragma unroll
        for (int d = 0; d < 64; ++d) o[d] = 0.f;
        float R = 0.f;
        const bf16* kb = P1 + (size_t)b * SEQ * P1W + C_SBK + h * 64; const bf16* vb = P1 + (size_t)b * SEQ * P1W + C_SBV + h * 64;
        for (int s = t - 1; s >= 0; --s) {
            if (R < -100.f) break;
            const v4u* kp = (const v4u*)(kb + (size_t)s * P1W); const v4u* vp = (const v4u*)(vb + (size_t)s * P1W);
            float z0 = 0.f, z1 = 0.f;
#pragma unroll
            for (int i = 0; i < 8; ++i) { const v4u k = kp[i]; z0 = dot2bf(k.x, q[4 * i], z0); z1 = dot2bf(k.y, q[4 * i + 1], z1); z0 = dot2bf(k.z, q[4 * i + 2], z0); z1 = dot2bf(k.w, q[4 * i + 3], z1); }
            const float z = (z0 + z1) * 0.125f;
            const float tt = 0.6931471805599453f * __builtin_amdgcn_logf(1.0f + fexp(-__builtin_fabsf(z)));
            const float lb = fminf(z, 0.f) - tt, l1m = fminf(-z, 0.f) - tt;
            const float a = fexp(lb + R); R += l1m;
#pragma unroll
            for (int i = 0; i < 8; ++i) { const v4u v = vp[i];
                o[8 * i] += a * bflo(v.x); o[8 * i + 1] += a * bfhi(v.x); o[8 * i + 2] += a * bflo(v.y); o[8 * i + 3] += a * bfhi(v.y);
                o[8 * i + 4] += a * bflo(v.z); o[8 * i + 5] += a * bfhi(v.z); o[8 * i + 6] += a * bflo(v.w); o[8 * i + 7] += a * bfhi(v.w); }
        }
        v4u* op = (v4u*)(Yb + row * 256 + h * 64);
#pragma unroll
        for (int i = 0; i < 8; ++i) op[i] = (v4u){pk2(o[8 * i], o[8 * i + 1]), pk2(o[8 * i + 2], o[8 * i + 3]), pk2(o[8 * i + 4], o[8 * i + 5]), pk2(o[8 * i + 6], o[8 * i + 7])};
    }
}

struct Soft { float mx, l; };
__device__ __forceinline__ float dotq(const LAS v4u* ql, const bf16* kp_) {
    const v4u* kp = (const v4u*)kp_; float z0 = 0.f, z1 = 0.f;
#pragma unroll
    for (int i = 0; i < 8; ++i) { const v4u k = kp[i]; const v4u q = ql[i]; z0 = dot2bf(k.x, q.x, z0); z1 = dot2bf(k.y, q.y, z1); z0 = dot2bf(k.z, q.z, z0); z1 = dot2bf(k.w, q.w, z1); }
    return (z0 + z1) * 0.125f;
}
__device__ __forceinline__ void axpy_row(float p, const bf16* vp_, float (&o)[64]) {
    const v4u* vp = (const v4u*)vp_;
#pragma unroll
    for (int i = 0; i < 8; ++i) { const v4u v = vp[i];
        o[8 * i] += p * bflo(v.x); o[8 * i + 1] += p * bfhi(v.x); o[8 * i + 2] += p * bflo(v.y); o[8 * i + 3] += p * bfhi(v.y);
        o[8 * i + 4] += p * bflo(v.z); o[8 * i + 5] += p * bfhi(v.z); o[8 * i + 6] += p * bflo(v.w); o[8 * i + 7] += p * bfhi(v.w); }
}
__device__ __forceinline__ void nsa_step(const LAS v4u* ql, const bf16* kp_, const bf16* vp_, Soft& S, float (&o)[64]) {
    const float s = dotq(ql, kp_);
    if (s > S.mx) { const float sc = fexp(S.mx - s); S.l *= sc;
#pragma unroll
        for (int d = 0; d < 64; ++d) o[d] *= sc;
        S.mx = s; }
    const float p = fexp(s - S.mx); S.l += p;
    asm volatile("" ::: "memory");
    axpy_row(p, vp_, o);
}
__device__ __forceinline__ void nsa_accum(bf16* yrow, bool first, float sc, const float (&o)[64]) {
    v4u* op = (v4u*)yrow;
#pragma unroll
    for (int i = 0; i < 8; ++i) { v4u old = (v4u){0u, 0u, 0u, 0u}; if (!first) old = op[i];
        op[i] = (v4u){pk2(bflo(old.x) + sc * o[8 * i], bfhi(old.x) + sc * o[8 * i + 1]), pk2(bflo(old.y) + sc * o[8 * i + 2], bfhi(old.y) + sc * o[8 * i + 3]),
                      pk2(bflo(old.z) + sc * o[8 * i + 4], bfhi(old.z) + sc * o[8 * i + 5]), pk2(bflo(old.w) + sc * o[8 * i + 6], bfhi(old.w) + sc * o[8 * i + 7])}; }
}
__device__ __forceinline__ void p_nsa(Frame& F) {
    const int gw = F.vcu * NWAVES + F.wave, NGW = F.G * NWAVES, lane = F.lane;
    const bf16* P1 = WSP(bf16, WS_P1); const bf16* KC = WSP(bf16, WS_KC); bf16* Yc = WSP(bf16, WS_Y) + (size_t)2 * MC * 256;
    LAS float* imp = (LAS float*)(F.lds + RING_OFF + F.wave * 4096);
    LAS v4u* ql = (LAS v4u*)(F.lds + RING_OFF + 32768 + F.wave * 9216 + lane * 144);
    const int qi = lane >> 2, h = lane & 3;
    for (int item = gw; item < BC * 256; item += NGW) { const int b = item >> 8, tg = item & 255;
        const int t = tg * 16 + qi; const size_t row = (size_t)b * SEQ + t; const bf16* prow = P1 + row * P1W;
        { const v4u* qp = (const v4u*)(prow + C_CQ + h * 64);
#pragma unroll
          for (int i = 0; i < 8; ++i) ql[i] = qp[i]; }
        const float g0 = bf1(prow[C_CG + h * 3]), g1 = bf1(prow[C_CG + h * 3 + 1]), g2 = bf1(prow[C_CG + h * 3 + 2]);
        bf16* yrow = Yc + row * 256 + h * 64;
        float o[64];
        for (int i = lane; i < 1024; i += 64) imp[i] = 0.f;
        const int nv = t >= 31 ? ((t - 31) >> 4) + 1 : 0; const int nvmax = (tg * 16 + 15 >= 31) ? ((tg * 16 + 15 - 31) >> 4) + 1 : 0;
        const bf16* kc = KC + (size_t)(0 * BC + b) * 256 * 64; const bf16* vc = KC + (size_t)(1 * BC + b) * 256 * 64;
        { float mx = -INFINITY, l = 0.f;
          for (int m = 0; m < nvmax; ++m) { const float s = dotq(ql, kc + m * 64); if (m < nv) { if (s > mx) { l *= fexp(mx - s); mx = s; } l += fexp(s - mx); } }
          const float rl = l > 0.f ? 1.0f / l : 0.f;
#pragma unroll
          for (int d = 0; d < 64; ++d) o[d] = 0.f;
          for (int m = 0; m < nvmax; ++m) { const float s = dotq(ql, kc + m * 64); const float p = (m < nv) ? fexp(s - mx) * rl : 0.f;
              asm volatile("" ::: "memory");
              axpy_row(p, vc + m * 64, o);
              float P = p + __builtin_bit_cast(float, bperm(lane ^ 1, __builtin_bit_cast(int, p))); P += __builtin_bit_cast(float, bperm(lane ^ 2, __builtin_bit_cast(int, P)));
              if (h == 0) { const int j0 = m >> 2; const bool edge = (m & 3) == 3; imp[qi * 64 + j0] += edge ? 0.5f * P : P; if (edge) imp[qi * 64 + j0 + 1] += 0.5f * P; } }
          nsa_accum(yrow, true, g0, o); }
        unsigned long long mask = 0ull;
        { const int cur = t >> 6, nvb = cur + 1;
          if (h == 0) {
              if (nvb <= 16) mask = (1ull << nvb) - 1ull;
              else { mask = 1ull | (1ull << cur);
                  for (int r = 0; r < 14; ++r) { int best = -1; float bv = -1.f;
                      for (int j = 1; j < cur; ++j) { const float v = imp[qi * 64 + j]; if (!((mask >> j) & 1ull) && v > bv) { bv = v; best = j; } }
                      mask |= 1ull << best; } } }
          const unsigned mlo = (unsigned)bperm(lane & ~3, (int)(unsigned)mask), mhi = (unsigned)bperm(lane & ~3, (int)(unsigned)(mask >> 32));
          mask = ((unsigned long long)mhi << 32) | mlo; }
        { Soft S{-INFINITY, 0.f};
#pragma unroll
          for (int d = 0; d < 64; ++d) o[d] = 0.f;
          const bf16* kb = P1 + (size_t)b * SEQ * P1W + C_KSLC; const bf16* vb = P1 + (size_t)b * SEQ * P1W + C_VSLC;
          unsigned long long mm = mask;
          while (mm) { const int j = __builtin_ctzll(mm); mm &= mm - 1ull;
              for (int kk = 0; kk < 64; ++kk) { const int sp = j * 64 + kk; if (sp > t) break; nsa_step(ql, kb + (size_t)sp * P1W, vb + (size_t)sp * P1W, S, o); } }
          nsa_accum(yrow, false, g1 / S.l, o); }
        { Soft S{-INFINITY, 0.f};
#pragma unroll
          for (int d = 0; d < 64; ++d) o[d] = 0.f;
          const bf16* kb = P1 + (size_t)b * SEQ * P1W + C_KWIN; const bf16* vb = P1 + (size_t)b * SEQ * P1W + C_VWIN;
          for (int i = 0; i < 512; ++i) { const int sp = t - 511 + i; if (sp >= 0) nsa_step(ql, kb + (size_t)sp * P1W, vb + (size_t)sp * P1W, S, o); }
          nsa_accum(yrow, false, g2 / S.l, o); }
    }
}

__device__ __forceinline__ int moe_table(Frame& F, int jmoe, int c, int r, int kpre = 0) {
    LAS int* tab = (LAS int*)(F.lds + TAB_OFF); LAS int* arr = (LAS int*)(F.lds + LDSCTL_OFF + 4096);
    (void)jmoe;
    __syncthreads();
    if (F.tid < 256) { const v4i* s = (const v4i*)(WSP(int, WS_CNT128) + ((size_t)(c * 256 + F.tid) * 2 + r) * 8); const v4i a = s[0], b = s[1];
        *(LAS v4i*)(arr + F.tid * 8) = a; *(LAS v4i*)(arr + F.tid * 8 + 4) = b; }
    __syncthreads();
    if (F.tid < 8) { int tot = 0, pre = 0;
        for (int k = 0; k < 256; ++k) { const int x = arr[k * 8 + F.tid]; pre += (k < kpre) ? x : 0; tot += x; }
        tab[176 + F.tid] = tot; tab[184 + F.tid] = pre; }
    __syncthreads();
    if (F.tid == 0) { int base = 0, T = 0;
        for (int e = 0; e < 8; ++e) { const int cnt = tab[176 + e];
            const int nt = (cnt + 255) >> 8; tab[160 + e] = base; for (int i = 0; i < nt && T + i < 160; ++i) tab[T + i] = e; T += nt; base += nt * 256; }
        tab[168] = T < 136 ? T : 136; }
    __syncthreads();
    return tab[168];
}
__device__ __forceinline__ void p_gather(Frame& F, int jmoe, int c, int r, int nbusy = 0) {
    if (F.bx < nbusy) return;
    LAS int* tab = (LAS int*)(F.lds + TAB_OFF); LAS int* cntw = tab + 256; LAS int* basew = tab + 320;
    const int lane = F.lane, wave = F.wave;
    const v4i* route = WSP(v4i, WS_ROUTE); int* tokmap = WSP(int, WS_TOKMAP) + (c * 2 + r) * SLOTS; float* wslot = WSP(float, WS_WSLOT) + (c * 2 + r) * SLOTS;
    const bf16* HN = WSP(bf16, WS_HN); bf16* XG = WSP(bf16, WS_XG);
    for (int ch = F.bx - nbusy; ch < MC / 128; ch += F.G - nbusy) {
        moe_table(F, jmoe, c, r, ch);
        const int m = c * MC + ch * 128 + wave * 16 + (lane & 15); const v4i rt = route[m];
        const int e = lane < 16 ? (r ? rt.y : rt.x) : -1; const float w = __builtin_bit_cast(float, r ? rt.w : rt.z);
        unsigned long long bal[8]; int mycnt = 0;
#pragma unroll
        for (int ee = 0; ee < 8; ++ee) { bal[ee] = __builtin_amdgcn_ballot_w64(e == ee); if (lane == ee) mycnt = __builtin_popcountll(bal[ee]); }
        if (lane < 8) cntw[wave * 8 + lane] = mycnt;
        __syncthreads();
        if (wave == 0 && lane < 8) { int base = tab[184 + lane];
#pragma unroll
            for (int w8 = 0; w8 < 8; ++w8) { basew[w8 * 8 + lane] = base; base += cntw[w8 * 8 + lane]; } }
        __syncthreads();
        int pos = 0;
#pragma unroll
        for (int ee = 0; ee < 8; ++ee) if (e == ee) pos = basew[wave * 8 + ee] + __builtin_popcountll(bal[ee] & ((1ull << lane) - 1ull));
        int slot = 0;
        if (lane < 16) { slot = tab[160 + e] + pos; tokmap[slot] = m; wslot[slot] = w; }
#pragma unroll
        for (int i0 = 0; i0 < 16; i0 += 4) { v4u x[8];
#pragma unroll
            for (int i = 0; i < 4; ++i) { const int mi = __builtin_amdgcn_readlane(m, i0 + i); const v4u* src = (const v4u*)(HN + (size_t)mi * DM); x[2 * i] = src[lane]; x[2 * i + 1] = src[64 + lane]; }
#pragma unroll
            for (int i = 0; i < 4; ++i) { const int si = __builtin_amdgcn_readlane(slot, i0 + i); v4u* dst = (v4u*)(XG + (size_t)si * DM); dst[lane] = x[2 * i]; dst[64 + lane] = x[2 * i + 1]; } }
    }
}

typedef float f32x16 __attribute__((ext_vector_type(16)));
typedef short bf16x8v __attribute__((ext_vector_type(8)));
typedef float f32x2v __attribute__((ext_vector_type(2)));
constexpr int NSA_K = 0, NSA_V = 8192, NSA_BUF = 17408, NSA_STAGE = 2 * NSA_BUF, NSA_IMP = 69632, NSA_CARRY = 86016, NSA_SEL = 103424, NSA_WSF = 103936;
constexpr int NSA_VP = 136;
constexpr float NSA_C2 = 0.125f * 1.4426950408889634f;
constexpr float NSA_DEFER = 8.0f / (0.125f * 1.4426950408889634f);
__device__ __forceinline__ unsigned cvtpk(float lo, float hi) { f32x2v v = {lo, hi}; bf16x2_t b = __builtin_convertvector(v, bf16x2_t); return __builtin_bit_cast(unsigned, b); }
__device__ __forceinline__ float partner32(float v, int lane) { return __builtin_bit_cast(float, __builtin_amdgcn_ds_bpermute((lane ^ 32) << 2, __builtin_bit_cast(int, v))); }
__device__ __forceinline__ void nsa_load(v4u& kx, v4u& vx, const bf16* Kg, int kp, const bf16* Vg, int vp, int tid) {
    kx = *(const v4u*)(Kg + (size_t)(tid & 63) * kp + (tid >> 6) * 8); vx = *(const v4u*)(Vg + (size_t)(tid >> 3) * vp + (tid & 7) * 8);
}
__device__ __forceinline__ void nsa_store(LAS unsigned char* lds, const v4u& kx, const v4u& vx, int tid) {
    *(LAS v4u*)(lds + NSA_K + (tid >> 6) * 1024 + (tid & 63) * 16) = kx; { LAS v2u* vd = (LAS v2u*)(lds + NSA_V + (tid >> 3) * NSA_VP + (tid & 7) * 16); vd[0] = (v2u){vx.x, vx.y}; vd[1] = (v2u){vx.z, vx.w}; }
}
__device__ __forceinline__ void nsa_qk(const LAS unsigned char* lds, const bf16x8v (&qr)[4], f32x16& p0, f32x16& p1, int r32, int hi) {
    bf16x8v kf[8];
#pragma unroll
    for (int d0 = 0; d0 < 4; ++d0) {
        kf[2 * d0] = *(const LAS bf16x8v*)(lds + NSA_K + (2 * d0 + hi) * 1024 + r32 * 16);
        kf[2 * d0 + 1] = *(const LAS bf16x8v*)(lds + NSA_K + (2 * d0 + hi) * 1024 + 512 + r32 * 16); }
    __builtin_amdgcn_sched_barrier(0);
#pragma unroll
    for (int i = 0; i < 16; ++i) { p0[i] = 0.f; p1[i] = 0.f; }
#pragma unroll
    for (int d0 = 0; d0 < 4; ++d0) {
        p0 = __builtin_amdgcn_mfma_f32_32x32x16_bf16(kf[2 * d0], qr[d0], p0, 0, 0, 0);
        p1 = __builtin_amdgcn_mfma_f32_32x32x16_bf16(kf[2 * d0 + 1], qr[d0], p1, 0, 0, 0);
    }
}
__device__ __forceinline__ void nsa_mask(f32x16& p0, f32x16& p1, int hi, int hiL, int loL) {
    const int hl = hiL - 4 * hi, ll = loL - 4 * hi;
#pragma unroll
    for (int i = 0; i < 16; ++i) { const int c = (i & 3) + 8 * (i >> 2);
        if (!(c <= hl && c > ll)) p0[i] = -INFINITY;
        if (!(c + 32 <= hl && c + 32 > ll)) p1[i] = -INFINITY; }
}
__device__ __forceinline__ float nsa_max32(const f32x16& p0, const f32x16& p1) {
    float a = fmaxf(fmaxf(p0[0], p0[1]), p1[0]), b = fmaxf(fmaxf(p0[2], p0[3]), p1[1]); a = fmaxf(fmaxf(a, p1[2]), p1[3]);
#pragma unroll
    for (int i = 4; i < 16; i += 4) { a = fmaxf(fmaxf(a, p0[i]), p0[i + 1]); b = fmaxf(fmaxf(b, p0[i + 2]), p0[i + 3]); a = fmaxf(fmaxf(a, p1[i]), p1[i + 1]); b = fmaxf(fmaxf(b, p1[i + 2]), p1[i + 3]); }
    return fmaxf(a, b);
}
__device__ __forceinline__ void nsa_vload(const LAS unsigned char* lds, v4u (&vv)[8], int r32, int hi) {
#pragma unroll
    for (int db = 0; db < 2; ++db) { const LAS unsigned char* vrow = lds + NSA_V + (32 * db + r32) * NSA_VP;
#pragma unroll
        for (int ks = 0; ks < 4; ++ks) {
            const int kb = (ks >> 1) * 32 + (ks & 1) * 16 + 4 * hi;
            const v2u lo = *(const LAS v2u*)(vrow + kb * 2), hh = *(const LAS v2u*)(vrow + (kb + 8) * 2);
            vv[4 * db + ks] = (v4u){lo.x, lo.y, hh.x, hh.y}; } }
    __builtin_amdgcn_sched_barrier(0);
}
__device__ __forceinline__ void nsa_pv(const v4u (&vv)[8], const f32x16& p0, const f32x16& p1, f32x16 (&o)[2]) {
    bf16x8v pa[4];
#pragma unroll
    for (int s = 0; s < 2; ++s) {
        const v4u a = (v4u){cvtpk(p0[8 * s], p0[8 * s + 1]), cvtpk(p0[8 * s + 2], p0[8 * s + 3]), cvtpk(p0[8 * s + 4], p0[8 * s + 5]), cvtpk(p0[8 * s + 6], p0[8 * s + 7])};
        const v4u b = (v4u){cvtpk(p1[8 * s], p1[8 * s + 1]), cvtpk(p1[8 * s + 2], p1[8 * s + 3]), cvtpk(p1[8 * s + 4], p1[8 * s + 5]), cvtpk(p1[8 * s + 6], p1[8 * s + 7])};
        pa[s] = __builtin_bit_cast(bf16x8v, a); pa[2 + s] = __builtin_bit_cast(bf16x8v, b); }
#pragma unroll
    for (int ks = 0; ks < 4; ++ks)
#pragma unroll
        for (int db = 0; db < 2; ++db) o[db] = __builtin_amdgcn_mfma_f32_32x32x16_bf16(pa[ks], __builtin_bit_cast(bf16x8v, vv[4 * db + ks]), o[db], 0, 0, 0);
}
__device__ __forceinline__ void nsa_rowscale(f32x16 (&o)[2], LAS float* wsf, float f, int r32, int hi) {
    if (hi == 0) wsf[r32] = f;
#pragma unroll
    for (int g = 0; g < 4; ++g) { const f32x4 w = *(const LAS f32x4*)(wsf + 8 * g + 4 * hi);
#pragma unroll
        for (int e = 0; e < 4; ++e) { o[0][4 * g + e] *= w[e]; o[1][4 * g + e] *= w[e]; } }
}
constexpr int NSA_ACC = 104960;
__device__ __forceinline__ void nsa_rowaccum(LAS unsigned char* acc, bool first, const f32x16 (&o)[2], LAS float* wsf, float f, int r32, int hi) {
    if (hi == 0) wsf[r32] = f;
#pragma unroll
    for (int g = 0; g < 4; ++g) { const f32x4 w = *(const LAS f32x4*)(wsf + 8 * g + 4 * hi);
#pragma unroll
        for (int e = 0; e < 4; ++e) { LAS bf16* p = (LAS bf16*)(acc + (8 * g + 4 * hi + e) * 128 + r32 * 2); const int i = 4 * g + e;
            float a = o[0][i] * w[e], b = o[1][i] * w[e];
            if (!first) { a += bf1(p[0]); b += bf1(p[32]); }
            p[0] = (bf16)f2bf(a); p[32] = (bf16)f2bf(b); } }
}
__device__ __forceinline__ void nsa_flush(const LAS unsigned char* acc, bf16* ytok  , int lane) {
    asm volatile("" ::: "memory");
#pragma unroll
    for (int ps = 0; ps < 4; ++ps) { const int row = ps * 8 + (lane >> 3), ch = lane & 7;
        const v4u v = *(const LAS v4u*)(acc + row * 128 + ch * 16);
        *(v4u*)(ytok + (size_t)(row >> 2) * 256 + (row & 3) * 64 + ch * 8) = v; }
}
__device__ __forceinline__ void nsa_softmax_pv(const LAS unsigned char* lds, f32x16& p0, f32x16& p1, float& m, float& l, f32x16 (&o)[2], LAS float* wsf, int lane, int r32, int hi, bool rowok) {
    float mt = nsa_max32(p0, p1); mt = rowok ? mt : -INFINITY; mt = fmaxf(mt, partner32(mt, lane));
    const float mn = fmaxf(m, mt);
    if (__builtin_amdgcn_ballot_w64(mn > m + NSA_DEFER) != 0ull) { const float f = __builtin_amdgcn_exp2f((m - mn) * NSA_C2); l *= f; nsa_rowscale(o, wsf, f, r32, hi); m = mn; }
    const float off = rowok ? -m * NSA_C2 : -INFINITY;
    v4u vv[8]; nsa_vload(lds, vv, r32, hi);
    float s = 0.f;
#pragma unroll
    for (int i = 0; i < 16; ++i) { p0[i] = __builtin_amdgcn_exp2f(__builtin_fmaf(p0[i], NSA_C2, off)); p1[i] = __builtin_amdgcn_exp2f(__builtin_fmaf(p1[i], NSA_C2, off)); s += p0[i] + p1[i]; }
    l += s;
    nsa_pv(vv, p0, p1, o);
}
__device__ __forceinline__ void p_nsa2(Frame& F) {
    const int tid = F.tid, lane = F.lane, wave = F.wave, r32 = lane & 31, hi = lane >> 5;
    LAS unsigned char* lds = F.lds + RING_OFF;
    LAS float* imp = (LAS float*)(lds + NSA_IMP); LAS float* carry = (LAS float*)(lds + NSA_CARRY);
    LAS unsigned long long* selm = (LAS unsigned long long*)(lds + NSA_SEL); LAS float* wsf = (LAS float*)(lds + NSA_WSF) + wave * 32;
    LAS unsigned char* acc = wave < 6 ? lds + NSA_ACC + wave * 4096 : F.lds + LDSCTL_OFF + 4096 + (wave - 6) * 4096;
    const bf16* P1 = WSP(bf16, WS_P1); const bf16* KC = WSP(bf16, WS_KC); const bf16* KCT = WSP(bf16, WS_KCT); const bf16* VT = WSP(bf16, WS_VT);
    bf16* Yc = WSP(bf16, WS_Y) + (size_t)2 * MC * 256;
    const int ql = r32 >> 2, h = r32 & 3, tq = 8 * wave + ql;
    int par = 0;
    for (int it = 0; it < 2; ++it) {
        for (int pair = F.vcu; pair < BC * 32; pair += F.G) {
            const int b = pair >> 5, sx = pair & 31, qb = it ? 63 - sx : sx;
            const int t = qb * 64 + tq; const size_t row = (size_t)b * SEQ + t; const bf16* prow = P1 + row * P1W;
            bf16x8v qr[4];
#pragma unroll
            for (int d0 = 0; d0 < 4; ++d0) qr[d0] = *(const bf16x8v*)(prow + C_CQ + h * 64 + d0 * 16 + hi * 8);
            const float g0 = bf1(prow[C_CG + h * 3]), g1 = bf1(prow[C_CG + h * 3 + 1]), g2 = bf1(prow[C_CG + h * 3 + 2]);
            f32x16 o[2], p0, p1;
            __syncthreads();
            for (int i = tid; i < 64 * 64; i += 512) imp[i] = 0.f;
            for (int i = tid; i < 64 * 68; i += 512) carry[i] = 0.f;
            const int nct = (4 * qb + 3 + 63) >> 6;
            const int mlim = t >= 31 ? ((t - 31) >> 4) : -1;
            const bf16* kcb = KC + (size_t)b * 256 * 64; const bf16* vcb = KCT + (size_t)b * 64 * 256;
            float m = -1e30f, l = 0.f;
            v4u kx, vx;
            nsa_load(kx, vx, kcb, 64, vcb, 256, tid);
            for (int ti = 0; ti < nct; ++ti) {
                LAS unsigned char* tb = lds + par * NSA_STAGE; par ^= 1;
                nsa_store(tb, kx, vx, tid); __syncthreads();
                { const int tn = ti + 1 < nct ? ti + 1 : 0; nsa_load(kx, vx, kcb + (size_t)tn * 64 * 64, 64, vcb + tn * 64, 256, tid); }
                nsa_qk(tb, qr, p0, p1, r32, hi); nsa_mask(p0, p1, hi, mlim - 64 * ti, -1);
                float mt = nsa_max32(p0, p1); mt = fmaxf(mt, partner32(mt, lane));
                const float mn = fmaxf(m, mt); l *= __builtin_amdgcn_exp2f((m - mn) * NSA_C2); m = mn;
                const float off = -m * NSA_C2; float s = 0.f;
#pragma unroll
                for (int i = 0; i < 16; ++i) s += __builtin_amdgcn_exp2f(__builtin_fmaf(p0[i], NSA_C2, off)) + __builtin_amdgcn_exp2f(__builtin_fmaf(p1[i], NSA_C2, off));
                l += s; }
            { const float lt = l + partner32(l, lane); const float rl = lt > 0.f ? 1.0f / lt : 0.f;
#pragma unroll
              for (int i = 0; i < 16; ++i) { o[0][i] = 0.f; o[1][i] = 0.f; }
              for (int ti = 0; ti < nct; ++ti) {
                  LAS unsigned char* tb = lds + par * NSA_STAGE; par ^= 1;
                  nsa_store(tb, kx, vx, tid); __syncthreads();
                  if (ti + 1 < nct) nsa_load(kx, vx, kcb + (size_t)(ti + 1) * 64 * 64, 64, vcb + (ti + 1) * 64, 256, tid);
                  nsa_qk(tb, qr, p0, p1, r32, hi); nsa_mask(p0, p1, hi, mlim - 64 * ti, -1);
                  v4u vv[8]; nsa_vload(tb, vv, r32, hi);
                  { const float off = -m * NSA_C2;
#pragma unroll
                    for (int i = 0; i < 16; ++i) { p0[i] = __builtin_amdgcn_exp2f(__builtin_fmaf(p0[i], NSA_C2, off)) * rl; p1[i] = __builtin_amdgcn_exp2f(__builtin_fmaf(p1[i], NSA_C2, off)) * rl; } }
#pragma unroll
                  for (int kt = 0; kt < 2; ++kt)
#pragma unroll
                      for (int g = 0; g < 4; ++g) { const f32x16& pp = kt ? p1 : p0;
                          float A = pp[4 * g] + pp[4 * g + 1] + pp[4 * g + 2] + 0.5f * pp[4 * g + 3], B = 0.5f * pp[4 * g + 3];
                          A += __builtin_bit_cast(float, bperm(lane ^ 1, __builtin_bit_cast(int, A))); A += __builtin_bit_cast(float, bperm(lane ^ 2, __builtin_bit_cast(int, A)));
                          B += __builtin_bit_cast(float, bperm(lane ^ 1, __builtin_bit_cast(int, B))); B += __builtin_bit_cast(float, bperm(lane ^ 2, __builtin_bit_cast(int, B)));
                          if (h == 0) { const int j = 16 * ti + 8 * kt + 2 * g + hi; imp[tq * 64 + j] = A; carry[tq * 68 + j + 1] = B; } }
                  nsa_pv(vv, p0, p1, o); }
              nsa_rowaccum(acc, true, o, wsf, g0, r32, hi); }
            __syncthreads();
            { const int q = tid >> 3, sub = tid & 7; unsigned long long mask;
              if (qb + 1 <= 16) mask = (1ull << (qb + 1)) - 1ull;
              else { mask = 1ull | (1ull << qb);
                  unsigned long long key[8];
#pragma unroll
                  for (int i = 0; i < 8; ++i) { const int j = sub * 8 + i; const float v = imp[q * 64 + j] + carry[q * 68 + j];
                      key[i] = (j >= 1 && j < qb) ? (((unsigned long long)__builtin_bit_cast(unsigned, v) << 32) | (unsigned)(63 - j)) : 0ull; }
                  for (int r = 0; r < 14; ++r) { unsigned long long best = key[0];
#pragma unroll
                      for (int i = 1; i < 8; ++i) best = key[i] > best ? key[i] : best;
#pragma unroll
                      for (int x = 1; x < 8; x <<= 1) { const unsigned lo = (unsigned)bperm(lane ^ x, (int)(unsigned)best), hh = (unsigned)bperm(lane ^ x, (int)(unsigned)(best >> 32));
                          const unsigned long long other = ((unsigned long long)hh << 32) | lo; best = other > best ? other : best; }
                      const int jb = 63 - (int)(best & 63ull); mask |= 1ull << jb;
#pragma unroll
                      for (int i = 0; i < 8; ++i) if (sub * 8 + i == jb) key[i] = 0ull; } }
              if (sub == 0) selm[q] = mask; }
            __syncthreads();
            const unsigned long long mysel = selm[tq];
            { const bf16* kb = P1 + (size_t)b * SEQ * P1W + C_KSLC; const bf16* vb = VT + (size_t)(0 * BC + b) * 64 * SEQ;
              m = -1e30f; l = 0.f;
#pragma unroll
              for (int i = 0; i < 16; ++i) { o[0][i] = 0.f; o[1][i] = 0.f; }
              v4u kx2, vx2;
              nsa_load(kx, vx, kb, P1W, vb, SEQ, tid); if (qb >= 1) nsa_load(kx2, vx2, kb + (size_t)64 * P1W, P1W, vb + 64, SEQ, tid);
              for (int j = 0; j <= qb; j += 2) {
                  const bool two = j + 1 <= qb;
                  LAS unsigned char* tb = lds + par * NSA_STAGE; par ^= 1;
                  nsa_store(tb, kx, vx, tid); if (two) nsa_store(tb + NSA_BUF, kx2, vx2, tid);
                  __syncthreads();
                  if (j + 2 <= qb) nsa_load(kx, vx, kb + (size_t)(j + 2) * 64 * P1W, P1W, vb + (j + 2) * 64, SEQ, tid);
                  if (j + 3 <= qb) nsa_load(kx2, vx2, kb + (size_t)(j + 3) * 64 * P1W, P1W, vb + (j + 3) * 64, SEQ, tid);
                  { const bool rowsel = ((mysel >> j) & 1ull) != 0ull;
                    if (__builtin_amdgcn_ballot_w64(rowsel) != 0ull) {
                        nsa_qk(tb, qr, p0, p1, r32, hi); if (j == qb) nsa_mask(p0, p1, hi, tq, -1);
                        nsa_softmax_pv(tb, p0, p1, m, l, o, wsf, lane, r32, hi, rowsel); } }
                  if (two) { const bool rowsel = ((mysel >> (j + 1)) & 1ull) != 0ull;
                    if (__builtin_amdgcn_ballot_w64(rowsel) != 0ull) {
                        nsa_qk(tb + NSA_BUF, qr, p0, p1, r32, hi); if (j + 1 == qb) nsa_mask(p0, p1, hi, tq, -1);
                        nsa_softmax_pv(tb + NSA_BUF, p0, p1, m, l, o, wsf, lane, r32, hi, rowsel); } } }
              const float lt = l + partner32(l, lane);
              nsa_rowaccum(acc, false, o, wsf, lt > 0.f ? g1 / lt : 0.f, r32, hi); }
            { const bf16* kb = P1 + (size_t)b * SEQ * P1W + C_KWIN; const bf16* vb = VT + (size_t)(1 * BC + b) * 64 * SEQ;
              m = -1e30f; l = 0.f;
#pragma unroll
              for (int i = 0; i < 16; ++i) { o[0][i] = 0.f; o[1][i] = 0.f; }
              const int j0 = qb >= 8 ? qb - 8 : 0;
              nsa_load(kx, vx, kb + (size_t)j0 * 64 * P1W, P1W, vb + j0 * 64, SEQ, tid);
              for (int j = j0; j <= qb; ++j) {
                  LAS unsigned char* tb = lds + par * NSA_STAGE; par ^= 1;
                  nsa_store(tb, kx, vx, tid); __syncthreads();
                  if (j < qb) nsa_load(kx, vx, kb + (size_t)(j + 1) * 64 * P1W, P1W, vb + (j + 1) * 64, SEQ, tid);
                  nsa_qk(tb, qr, p0, p1, r32, hi); if (j == qb || j == qb - 8) nsa_mask(p0, p1, hi, j == qb ? tq : 63, j == qb - 8 ? tq : -1);
                  nsa_softmax_pv(tb, p0, p1, m, l, o, wsf, lane, r32, hi, true); }
              const float lt = l + partner32(l, lane);
              nsa_rowaccum(acc, false, o, wsf, lt > 0.f ? g2 / lt : 0.f, r32, hi);
              nsa_flush(acc, Yc + ((size_t)b * SEQ + qb * 64 + 8 * wave) * 256, lane); }
        }
    }
    __syncthreads();
}

constexpr int SB_HEAD_LDS = 17408;
constexpr int SB_FLAG = 4 * SB_HEAD_LDS;
constexpr float SB_LOG2E = 1.4426950408889634f, SB_STOP = -100.0f * 1.4426950408889634f;
__device__ __forceinline__ void p_stick2(Frame& F, int nbusy) {
    const int tid = F.tid, lane = F.lane, wave = F.wave, r32 = lane & 31, hi = lane >> 5, h = wave & 3, qh = wave >> 2;
    LAS unsigned char* lds = F.lds + RING_OFF; LAS unsigned char* hl = lds + h * SB_HEAD_LDS; LAS int* flag = (LAS int*)(lds + SB_FLAG);
    const bf16* P1 = WSP(bf16, WS_P1); const bf16* VT = WSP(bf16, WS_VT) + (size_t)2 * BC * 64 * SEQ;
    bf16* Yb = WSP(bf16, WS_Y) + (size_t)MC * 256;
    const int tq = 32 * qh + r32;
    if (F.bx >= nbusy)
        for (int item = F.bx - nbusy; item < BC * 64; item += F.G - nbusy) {
            const int b = item >> 6, qb = item & 63;
            const size_t row = (size_t)b * SEQ + qb * 64 + tq;
            bf16x8v qr[4];
#pragma unroll
            for (int d0 = 0; d0 < 4; ++d0) qr[d0] = *(const bf16x8v*)(P1 + row * P1W + C_SBQ + h * 64 + d0 * 16 + hi * 8);
            f32x16 o[2], p0, p1;
#pragma unroll
            for (int i = 0; i < 16; ++i) { o[0][i] = 0.f; o[1][i] = 0.f; }
            float R = 0.f;
            const int skey = tid & 63, sc = tid >> 6, sd = tid >> 3, skc = tid & 7;
            v4u kx[4], vx[4];
#define SB_LOAD(jj) do { const bf16* kg_ = P1 + ((size_t)b * SEQ + (jj) * 64 + skey) * P1W + C_SBK + sc * 8; \
                _Pragma("unroll") for (int hh = 0; hh < 4; ++hh) { kx[hh] = *(const v4u*)(kg_ + hh * 64); vx[hh] = *(const v4u*)(VT + ((size_t)(hh * BC + b) * 64 + sd) * SEQ + (jj) * 64 + skc * 8); } } while (0)
            SB_LOAD(qb);
            for (int j = qb; j >= 0; --j) {
                __syncthreads();
                if (j < qb) { int live = 0;
#pragma unroll
                    for (int w = 0; w < 8; ++w) live |= flag[w];
                    if (!live) break; }
#pragma unroll
                for (int hh = 0; hh < 4; ++hh) { *(LAS v4u*)(lds + hh * SB_HEAD_LDS + sc * 1024 + skey * 16) = kx[hh]; { LAS v2u* vd = (LAS v2u*)(lds + hh * SB_HEAD_LDS + NSA_V + sd * NSA_VP + skc * 16); vd[0] = (v2u){vx[hh].x, vx[hh].y}; vd[1] = (v2u){vx[hh].z, vx[hh].w}; } }
                __syncthreads();
                if (j > 0) SB_LOAD(j - 1);
                nsa_qk(hl, qr, p0, p1, r32, hi);
#pragma unroll
                for (int i = 0; i < 16; ++i) { p0[i] *= NSA_C2; p1[i] *= NSA_C2; }
                v4u vv[8]; nsa_vload(hl, vv, r32, hi);
                const int lim = ((j == qb) ? tq : 64) - 4 * hi;
                float Town[8], Tp[8];
#pragma unroll
                for (int kt = 0; kt < 2; ++kt) { f32x16& pp = kt ? p1 : p0;
#pragma unroll
                    for (int g = 0; g < 4; ++g) { float L[4];
#pragma unroll
                        for (int e = 0; e < 4; ++e) { const int kk = 32 * kt + 8 * g + e; const float z = pp[4 * g + e];
                            const float tt = __builtin_amdgcn_logf(1.0f + __builtin_amdgcn_exp2f(-__builtin_fabsf(z)));
                            const float lb = fminf(z, 0.f) - tt; const bool ok = kk < lim;
                            L[e] = ok ? lb - z : 0.f; pp[4 * g + e] = ok ? lb : -INFINITY; }
                        const float E2 = L[3], E1 = E2 + L[2], E0 = E1 + L[1];
                        pp[4 * g + 2] += E2; pp[4 * g + 1] += E1; pp[4 * g] += E0;
                        Town[4 * kt + g] = E0 + L[0]; } }
#pragma unroll
                for (int k = 0; k < 8; ++k) Tp[k] = partner32(Town[k], lane);
                float suf = R;
#pragma unroll
                for (int k = 7; k >= 0; --k) { const float add = suf + (hi == 0 ? Tp[k] : 0.f); f32x16& pp = (k >> 2) ? p1 : p0; const int g = k & 3;
#pragma unroll
                    for (int e = 0; e < 4; ++e) pp[4 * g + e] = __builtin_amdgcn_exp2f(pp[4 * g + e] + add);
                    suf += Town[k] + Tp[k]; }
                R = suf;
                nsa_pv(vv, p0, p1, o);
                const bool alive = R >= SB_STOP;
                const unsigned long long bal = __builtin_amdgcn_ballot_w64(alive);
                if (lane == 0) flag[wave] = bal != 0ull ? 1 : 0;
            }
            { bf16* dst = Yb + ((size_t)b * SEQ + qb * 64 + 32 * qh + 4 * hi) * 256 + h * 64 + r32;
#pragma unroll
              for (int i = 0; i < 16; ++i) { dst[((i & 3) + 8 * (i >> 2)) * 256] = (bf16)f2bf(o[0][i]); dst[((i & 3) + 8 * (i >> 2)) * 256 + 32] = (bf16)f2bf(o[1][i]); } }
        }
#undef SB_LOAD
    __syncthreads();
}

__device__ __forceinline__ void p_sgu2(Frame& F, int layer) {
    LAS unsigned char* vnT = F.lds + RING_OFF;
    const bf16* P1 = WSP(bf16, WS_P1); bf16* Ya = WSP(bf16, WS_Y);
    const float* gain = F.in[3] + (size_t)layer * 256; const float* sw = F.in[4] + (size_t)layer * 4 * 128 * 128; const float* sb = F.in[5] + (size_t)layer * 4 * 128;
    const int lane = F.lane, wave = F.wave, r32 = lane & 31, hi = lane >> 5, g = wave & 3, db = wave >> 2;
    for (int item = F.vcu; item < MC / 128; item += F.G) {
        const size_t r0 = (size_t)item * 128;
        __syncthreads();
        { const f32x4 gg = ((const f32x4*)gain)[lane];
          for (int rr = 0; rr < 16; rr += 2) { const int r = wave * 16 + rr;
              const v2u ra = *(const v2u*)(P1 + (r0 + r) * P1W + C_V + 4 * lane), rb = *(const v2u*)(P1 + (r0 + r + 1) * P1W + C_V + 4 * lane);
              const float a0 = bflo(ra.x), a1 = bfhi(ra.x), a2 = bflo(ra.y), a3 = bfhi(ra.y), b0 = bflo(rb.x), b1 = bfhi(rb.x), b2 = bflo(rb.y), b3 = bfhi(rb.y);
              const float sa = 1.0f / sqrtf(wave_sum((a0 * a0 + a1 * a1) + (a2 * a2 + a3 * a3), lane) * (1.f / 256.f) + EPS);
              const float sb_ = 1.0f / sqrtf(wave_sum((b0 * b0 + b1 * b1) + (b2 * b2 + b3 * b3), lane) * (1.f / 256.f) + EPS);
              LAS unsigned* q = (LAS unsigned*)(vnT + (4 * lane) * 272 + r * 2);
              q[0] = pk2(a0 * sa * gg.x, b0 * sb_ * gg.x); q[68] = pk2(a1 * sa * gg.y, b1 * sb_ * gg.y); q[136] = pk2(a2 * sa * gg.z, b2 * sb_ * gg.z); q[204] = pk2(a3 * sa * gg.w, b3 * sb_ * gg.w); } }
        __syncthreads();
        const int ch = g * 64 + db * 32 + r32;
        for (int tb = 0; tb < 4; ++tb) {
            f32x16 acc;
#pragma unroll
            for (int i = 0; i < 16; ++i) acc[i] = 0.f;
            const int t = 32 * tb + r32; const float* wrow = sw + ((size_t)g * 128 + t) * 128;
            f32x4 wq[8][2];
#pragma unroll
            for (int ks = 0; ks < 8; ++ks) if (ks < 2 * tb + 2) { wq[ks][0] = *(const f32x4*)(wrow + 16 * ks + 8 * hi); wq[ks][1] = *(const f32x4*)(wrow + 16 * ks + 8 * hi + 4); }
#pragma unroll
            for (int ks = 0; ks < 8; ++ks) if (ks < 2 * tb + 2) {
                const int s0 = 16 * ks + 8 * hi;
                const f32x4 w0 = wq[ks][0], w1 = wq[ks][1];
                const v4u a = (v4u){pk2(s0 <= t ? w0.x : 0.f, s0 + 1 <= t ? w0.y : 0.f), pk2(s0 + 2 <= t ? w0.z : 0.f, s0 + 3 <= t ? w0.w : 0.f),
                                    pk2(s0 + 4 <= t ? w1.x : 0.f, s0 + 5 <= t ? w1.y : 0.f), pk2(s0 + 6 <= t ? w1.z : 0.f, s0 + 7 <= t ? w1.w : 0.f)};
                const bf16x8v bfr = *(const LAS bf16x8v*)(vnT + ch * 272 + s0 * 2);
                acc = __builtin_amdgcn_mfma_f32_32x32x16_bf16(__builtin_bit_cast(bf16x8v, a), bfr, acc, 0, 0, 0); }
            float uu[16], bb[16];
#pragma unroll
            for (int i = 0; i < 16; ++i) { const int tt = 32 * tb + (i & 3) + 8 * (i >> 2) + 4 * hi; uu[i] = bf1(P1[(r0 + tt) * P1W + C_U + ch]); bb[i] = sb[g * 128 + tt]; }
#pragma unroll
            for (int i = 0; i < 16; ++i) { const int tt = 32 * tb + (i & 3) + 8 * (i >> 2) + 4 * hi;
                Ya[(r0 + tt) * 256 + ch] = (bf16)f2bf(uu[i] * (acc[i] + bb[i])); }
        }
    }
    __syncthreads();
}

struct Args { const float* in[20]; float* out; unsigned char* ws; int lo, hi, li, rep; };
#ifndef TILED_FFN1
#define TILED_FFN1 0
#endif
#ifndef PG8_ALIGN_EPI
#define PG8_ALIGN_EPI true
#endif
#ifndef PG8_SP2
#define PG8_SP2 true
#endif
#ifndef WGM_PROJ
#define WGM_PROJ PG8_WGM
#endif
#ifndef WGM_FFN1
#define WGM_FFN1 PG8_WGM
#endif
#ifndef WGM_FFN2
#define WGM_FFN2 PG8_WGM
#endif
#ifndef WGM_MOE1
#define WGM_MOE1 PG8_WGM
#endif
#ifndef WGM_MOE2
#define WGM_MOE2 PG8_WGM
#endif
#ifndef FFN_CHUNKS
#define FFN_CHUNKS 2
#endif
#ifndef REP_GEMM
#define REP_GEMM 1
#endif
#ifndef REP_STICK
#define REP_STICK 1
#endif
#ifndef REP_NSA
#define REP_NSA 1
#endif
#ifndef REP_SGU
#define REP_SGU 1
#endif
#ifndef REP_NORM
#define REP_NORM 1
#endif
template <class Epi, class Sched> __device__ __forceinline__ void run_gemm(Frame& F, const bf16* A, const bf16* Bt, int M, int N, int K, const Sched& S, Epi E, bool rotate = true, int tiled = 0, int ld = 0) {
    const int nt_ = K / 64;
#ifdef PG8_KROT
    const int rot_ = rotate ? 2 * (((F.bx & 7) * (nt_ / 2)) / 8) : 0;
#else
    const int rot_ = 0;
#endif
    pg8::Gemm g{A, Bt, M, N, K + F.zs, F.tid, rot_ + F.zs, tiled + F.zs, ld + F.zs};
    if (F.rep) E.set_scale0();
    pg8::gemm_phase<Epi, Sched, PG8_ALIGN_EPI, PG8_SP2>(F.lds + RING_OFF, g, S, E);
}
__global__ void __launch_bounds__(NWAVES * 64, 2) mk_fwd(Args args) {
    extern __shared__ __attribute__((aligned(16))) unsigned char lds[];
    Frame F0;
    F0.lds = (LAS unsigned char*)lds;
    F0.tid = threadIdx.x; F0.lane = F0.tid & 63; F0.wave = __builtin_amdgcn_readfirstlane(F0.tid >> 6);
    F0.G = gridDim.x; F0.bx = blockIdx.x; F0.vcu = (F0.G % 8 == 0) ? (F0.bx % 8) * (F0.G / 8) + F0.bx / 8 : F0.bx; F0.zv = 0; F0.zs = 0;
    F0.rep = args.rep; F0.ws = args.ws; F0.ctl = (unsigned*)(args.ws + WS_CTL); F0.in = args.in; F0.out = args.out;
    for (int u = F0.tid; u < (LDS_BYTES - LDSCTL_OFF) / 4; u += NWAVES * 64) ((LAS unsigned*)(F0.lds + LDSCTL_OFF))[u] = 0u;
    __syncthreads();
    const int lo = args.lo, hi = args.hi;
    XcdBarrier bar; bar.bar = F0.ctl + CW_BAR + args.li * XCD_BAR_WORDS; bar.x = 0; bar.st = nullptr; bar.w = 0; bar.z = 0;
    if (hi - lo > 1) bar = xcd_barrier_post(F0.ctl + CW_BAR + args.li * XCD_BAR_WORDS, (volatile LAS unsigned*)(F0.lds + MISC_OFF) + 8);
    int step = 0;
#define STEP_BEGIN if (step >= lo && step < hi) { Frame F = F0; { int zv_, zs_; asm volatile("v_mov_b32 %0, 0" : "=v"(zv_)); asm volatile("s_mov_b32 %0, 0" : "=s"(zs_)); \
        F.zv = zv_; F.zs = zs_; F.lane = (int)__builtin_amdgcn_mbcnt_hi(~0u, __builtin_amdgcn_mbcnt_lo(~0u, (unsigned)zv_)); F.wave = F0.wave + zs_; F.tid = F.wave * 64 + F.lane; F.bx = F.bx + zs_; \
        F.vcu = F0.vcu + zs_; F.G = F0.G + zs_; F.lds = (LAS unsigned char*)lds + zs_; F.ws = F0.ws + zs_; F.ctl = F0.ctl + zs_; F.in = F0.in + zs_; F.out = F0.out + zs_; }
#ifdef PROBE_XBAR
#define STEP_END   if (step + 1 < hi) { unsigned zb_; asm volatile("v_mov_b32 %0, 0" : "=v"(zb_)); bar.z = zb_; xcd_barrier(bar); xcd_barrier(bar); } } ++step;
#else
#define STEP_END   if (step + 1 < hi) { unsigned zb_; asm volatile("v_mov_b32 %0, 0" : "=v"(zb_)); bar.z = zb_; xcd_barrier(bar); } } ++step;
#endif

    for (int layer = 0; layer < DEPTH; ++layer) {
        const int jj = layer >> 1;
        STEP_BEGIN
            p_convert(F, layer);
            p_norm<0>(F, layer == 0 ? F.in[0] : F.out, F.in[1] + (size_t)layer * DM, nullptr, 0);
        STEP_END
        for (int c = 0; c < NCHUNK; ++c) {
            STEP_BEGIN
                pg8::StaticOrder S; S.init(MC, NPROJ, F.G, F.bx, WGM_PROJ);
                pg8::EpiProj E{WSP(bf16, WS_P1), WSP(bf16, WS_G)};
                run_gemm(F, WSP(bf16, WS_HN) + (size_t)c * MC * DM, WSP(bf16, WS_WIN), MC, NPROJ, DM, S, E);
            STEP_END
            STEP_BEGIN
                p_prep(F);
            STEP_END
            STEP_BEGIN
                LAS int* tab = (LAS int*)(F.lds + TAB_OFF);
                __syncthreads(); if (F.tid < 16) tab[F.tid] = F.tid >> 3; __syncthreads();
                pg8::GroupedOrder S; S.so.init(2 * 2048, 512, F.G, F.bx); S.tile_e = tab; S.nN = 2;
                pg8::EpiF32 E{WSP(float, WS_UL), 512, 2};
                run_gemm(F, WSP(bf16, WS_KVC), WSP(bf16, WS_WC1), 2 * 2048, 512, DM, S, E);
                p_sgu2(F, layer);
                p_stick2(F, F.G > 64 ? 32 : 0);
            STEP_END
            STEP_BEGIN
                p_cmpfin(F, layer);
            STEP_END
            STEP_BEGIN
#ifdef OLD_NSA
                p_nsa(F);
#else
                p_nsa2(F);
#endif
            STEP_END
            STEP_BEGIN
                pg8::MergeOrder S; S.so.init(MC, DM, F.G, F.bx); S.nmt = MC / 256;
                pg8::EpiMerge E{WSP(bf16, WS_G), WSP(bf16, WS_MG), MC / 256};
                run_gemm(F, WSP(bf16, WS_Y), WSP(bf16, WS_WBR), 3 * MC, 3 * DM, 256, S, E);
            STEP_END
            STEP_BEGIN
                pg8::StaticOrder S; S.init(MC, DM, F.G, F.bx);
                const float* base = (layer == 0 ? F.in[0] : F.out) + (size_t)c * MC * DM;
                pg8::EpiResid E{base, F.out + (size_t)c * MC * DM, DM, 1.0f};
                run_gemm(F, WSP(bf16, WS_MG), WSP(bf16, WS_WOUT), MC, DM, DM, S, E);
            STEP_END
        }
        if ((layer & 1) == 0) {
            STEP_BEGIN
                p_norm<0>(F, F.out, F.in[11] + (size_t)layer * DM, nullptr, 0, Q8_HN, TILED_FFN1);
            STEP_END
            for (int c = 0; c < FFN_CHUNKS; ++c) {
                constexpr int MF = MTOK / FFN_CHUNKS;
                STEP_BEGIN
                    pg8::StaticOrder S; S.init(MF, NFF1, F.G, F.bx, WGM_FFN1);
                    pg8::EpiSwiGLU E{WSP(bf16, WS_HID), DFFP, nullptr, NFF1 / 256};
                    run_gemm(F, WSP(bf16, WS_HN) + (size_t)c * MF * DM, WSP(bf16, WS_WF1), MF, NFF1, DM, S, E, true, TILED_FFN1);
                STEP_END
                STEP_BEGIN
                    pg8::StaticOrder S; S.init(MF, DM, F.G, F.bx, WGM_FFN2);
                    pg8::EpiResid E{F.out + (size_t)c * MF * DM, F.out + (size_t)c * MF * DM, DM, 1.0f};
                    run_gemm(F, WSP(bf16, WS_HID), WSP(bf16, WS_WF2), MF, DM, DFFP, S, E);
                STEP_END
            }
        } else {
            STEP_BEGIN
                p_norm<1>(F, F.out, F.in[11] + (size_t)layer * DM, F.in[15] + (size_t)jj * DM * NEXP, jj, Q8_HN);
            STEP_END
#ifdef ABL_DENSE_MOE
            for (int e = 0; e < NEXP; ++e) {
                STEP_BEGIN
                    pg8::StaticOrder S; S.init(MTOK, NMOE1, F.G, F.bx);
                    pg8::EpiSwiGLU E{WSP(bf16, WS_SCR + 8 * MiB), DFE, WSP(float, WS_SCR + 4 * MiB) + (size_t)e * MTOK, NMOE1 / 256};
                    run_gemm(F, WSP(bf16, WS_HN), WSP(bf16, WS_WF1) + (size_t)e * NMOE1 * DM, MTOK, NMOE1, DM, S, E);
                STEP_END
                STEP_BEGIN
                    pg8::StaticOrder S; S.init(MTOK, DM, F.G, F.bx);
                    pg8::EpiResid E{F.out, F.out, DM, 1.0f};
                    run_gemm(F, WSP(bf16, WS_SCR + 8 * MiB), WSP(bf16, WS_WF2) + (size_t)e * DM * DFE, MTOK, DM, DFE, S, E);
                STEP_END
            }
#else
            STEP_BEGIN
                p_gather(F, jj, 0, 0);
            STEP_END
            for (int c = 0; c < NCHUNK; ++c)
                for (int r = 0; r < 2; ++r) {
                    STEP_BEGIN
                        const int T = moe_table(F, jj, c, r);
                        pg8::GroupedOrder S; S.so.init(T * 256, NMOE1, F.G, F.bx, WGM_MOE1); S.tile_e = (LAS int*)(F.lds + TAB_OFF); S.nN = NMOE1 / 256;
                        pg8::EpiSwiGLU E{WSP(bf16, WS_HIDM), DFE, WSP(float, WS_WSLOT) + (c * 2 + r) * SLOTS, NMOE1 / 256};
                        run_gemm(F, WSP(bf16, WS_XG), WSP(bf16, WS_WF1), T * 256, NMOE1, DM, S, E, false);
                    STEP_END
                    STEP_BEGIN
                        const int T = moe_table(F, jj, c, r);
                        const int nwg = T * (DM / 256), R = nwg % F.G, full = nwg - R;
                        const int NS = (4 * R <= F.G) ? 4 : 2;
                        const bool split = (hi - lo > 1) && R > 0 && NS * R <= F.G && !F.rep;
                        int* tokm = WSP(int, WS_TOKMAP) + (c * 2 + r) * SLOTS; float* TB = WSP(float, WS_SCR + 320 * MiB);
                        { pg8::LimitOrder S; S.so.init(T * 256, DM, F.G, F.bx, WGM_MOE2); S.limit = split ? full : nwg;
                          pg8::GroupedLimit GS{S, (LAS int*)(F.lds + TAB_OFF), DM / 256};
                          pg8::EpiScatter E{F.out, tokm, DM / 256, 1.0f};
                          run_gemm(F, WSP(bf16, WS_HIDM), WSP(bf16, WS_WF2), T * 256, DM, DFE, GS, E, false); }
                        const bool more = c * 2 + r < 3;
                        if (split) {
                            const int KP = DFE / NS;
                            if (F.bx < NS * R) { const int Lx = full + F.bx / NS, kp = F.bx % NS;
                                pg8::StaticOrder so; so.init(T * 256, DM, F.G, Lx % F.G, WGM_MOE2); pg8::Unit un; so.next(Lx / F.G, un);
                                un.pn += ((LAS int*)(F.lds + TAB_OFF))[un.pm] * (DM / 256);
                                pg8::SingleOrder S1{un};
                                if (kp == 0) { pg8::EpiScatter E{F.out, tokm, DM / 256, 1.0f};
                                    run_gemm(F, WSP(bf16, WS_HIDM), WSP(bf16, WS_WF2), T * 256, DM, KP, S1, E, false, 0, DFE); }
                                else { pg8::EpiTile E{TB + ((size_t)(Lx - full) * 3 + (kp - 1)) * 65536};
                                    run_gemm(F, WSP(bf16, WS_HIDM) + kp * KP, WSP(bf16, WS_WF2) + kp * KP, T * 256, DM, KP, S1, E, false, 0, DFE); } }
                            if (more) p_gather(F, jj, (c * 2 + r + 1) >> 1, (c * 2 + r + 1) & 1, NS * R);
                            { unsigned zb_; asm volatile("v_mov_b32 %0, 0" : "=v"(zb_)); bar.z = zb_; xcd_barrier(bar); }
                            for (int it = (F.vcu * NWAVES + F.wave); it < R * 256; it += F.G * NWAVES) { const int j = it >> 8, row = it & 255, Lx = full + j;
                                pg8::StaticOrder so; so.init(T * 256, DM, F.G, Lx % F.G, WGM_MOE2); pg8::Unit un; so.next(Lx / F.G, un);
                                const int t = tokm[un.pm * 256 + row];
                                if (t >= 0) { f32x4* hp = (f32x4*)(F.out + (size_t)t * DM + un.pn * 256) + F.lane; f32x4 a = *hp;
                                    for (int q = 0; q < NS - 1; ++q) a = a + ((const f32x4*)(TB + ((size_t)j * 3 + q) * 65536 + row * 256))[F.lane];
                                    *hp = a; } }
                        } else if (!F.rep && more) p_gather(F, jj, (c * 2 + r + 1) >> 1, (c * 2 + r + 1) & 1, R);
                    STEP_END
                }
#endif
        }
    }
    STEP_BEGIN
        p_norm<2>(F, F.out, F.in[19], nullptr, 0);
    STEP_END
#undef STEP_BEGIN
#undef STEP_END
}

#ifndef MK_STEPS_PER_LAUNCH
#define MK_STEPS_PER_LAUNCH 1
#endif
extern "C" void kernel_launch(void* const* d_in, const int* in_sizes, int n_in, void* d_out, int out_size, void* d_ws, size_t ws_size, hipStream_t stream) {
    static int grid = 0;
    if (grid == 0) {
        if (n_in != 20 || in_sizes[0] != MTOK * DM || out_size != MTOK * DM || ws_size < WS_END) { fprintf(stderr, "kernel_launch: unexpected shapes (n_in %d, in0 %d, out %d, ws %zu)\n", n_in, n_in > 0 ? in_sizes[0] : -1, out_size, ws_size); grid = -1; return; }
        int dev = 0, cus = 0, per_cu = 0;
        if (hipGetDevice(&dev) != hipSuccess || hipDeviceGetAttribute(&cus, hipDeviceAttributeMultiprocessorCount, dev) != hipSuccess) { grid = -1; return; }
        if (hipFuncSetAttribute((const void*)mk_fwd, hipFuncAttributeMaxDynamicSharedMemorySize, LDS_BYTES) != hipSuccess) { fprintf(stderr, "kernel_launch: hipFuncSetAttribute failed\n"); grid = -1; return; }
        if (hipOccupancyMaxActiveBlocksPerMultiprocessor(&per_cu, (const void*)mk_fwd, NWAVES * 64, LDS_BYTES) != hipSuccess || per_cu < 1) fprintf(stderr, "kernel_launch: occupancy query reports %d\n", per_cu);
        (void)hipGetLastError();
        grid = cus;
    }
    if (grid < 0) return;
    if (hipMemsetAsync((char*)d_ws + WS_CTL, 0, CTL_ZERO_BYTES, stream) != hipSuccess) return;
    Args a{};
    for (int i = 0; i < 20; ++i) a.in[i] = (const float*)d_in[i];
    a.out = (float*)d_out; a.ws = (unsigned char*)d_ws; a.rep = 0;
    #ifdef ABL_DENSE_MOE
    constexpr int NSTEPS = 2 * (1 + NCHUNK * 8 + 3) + 2 * (1 + NCHUNK * 8 + 1 + NEXP * 2) + 1;
#else
    constexpr int NSTEPS = 2 * (1 + NCHUNK * 7 + 1 + 2 * FFN_CHUNKS) + 2 * (1 + NCHUNK * 7 + 2 + NCHUNK * 2 * 2) + 1;
#endif
    int li = 0;
#ifdef REPMASK
    static int kinds[256]; int ns = 0;
    for (int layer = 0; layer < DEPTH; ++layer) { kinds[ns++] = 0;
        for (int c = 0; c < NCHUNK; ++c) for (int q = 1; q <= 8; ++q) if (q != 5) kinds[ns++] = q;
        if ((layer & 1) == 0) { kinds[ns++] = 9; for (int c = 0; c < FFN_CHUNKS; ++c) { kinds[ns++] = 10; kinds[ns++] = 11; } }
        else { kinds[ns++] = 12; kinds[ns++] = 17; for (int c = 0; c < NCHUNK * 2; ++c) { kinds[ns++] = 14; kinds[ns++] = 13; } } }
    kinds[ns++] = 16;
    for (int s = 0; s < NSTEPS; ++s) { const int reps = ((REPMASK >> kinds[s]) & 1) ? 2 : 1;
        for (int r = 0; r < reps; ++r) { a.lo = s; a.hi = s + 1; a.li = 0; a.rep = r;
            hipLaunchKernelGGL(mk_fwd, dim3(grid), dim3(NWAVES * 64), LDS_BYTES, stream, a); } }
    (void)li;
#else
    for (int s = 0; s < NSTEPS; s += MK_STEPS_PER_LAUNCH) {
        a.lo = s; a.hi = (s + MK_STEPS_PER_LAUNCH < NSTEPS) ? s + MK_STEPS_PER_LAUNCH : NSTEPS; a.li = (MK_STEPS_PER_LAUNCH > 1) ? li : 0; ++li;
        hipLaunchKernelGGL(mk_fwd, dim3(grid), dim3(NWAVES * 64), LDS_BYTES, stream, a);
        if (hipPeekAtLastError() != hipSuccess) { fprintf(stderr, "kernel_launch: launch failed\n"); break; }
    }
#endif
}
```

```cpp
#define MK_STEPS_PER_LAUNCH 1000
#define PG8_WGM 4
#define FFN_CHUNKS 1
#include <hip/hip_runtime.h>
#include <cstdio>
#include <cstdint>
#include <cmath>
#ifndef PG8_AUX_A
#define PG8_AUX_A 0
#endif
#ifndef PG8_AUX_B
#define PG8_AUX_B 0
#endif
#ifndef PG8_WGM
#define PG8_WGM 8
#endif
namespace pg8 {
#define PG8_LAS __attribute__((address_space(3)))
typedef unsigned short bf16_t;
typedef short bf16x8 __attribute__((ext_vector_type(8)));
typedef float f32x4 __attribute__((ext_vector_type(4)));
typedef unsigned u32x4 __attribute__((ext_vector_type(4)));
constexpr int BM = 256, BK = 64, HALF = 128, HTB = HALF * BK * 2  , STAGE_BYTES = 8 * HTB, NXCD = 8, WGM = PG8_WGM;

__host__ __device__ __forceinline__ int lds_byte(int r, int c) { const int st = (r >> 4) * 2 + (c >> 5), rr = r & 15, cc = c & 31, ob = rr * 64 + cc * 2; return st * 1024 + (ob ^ (((ob >> 9) & 1) << 5)); }
__host__ __device__ __forceinline__ void stage_rc(int b, int& R, int& C) { const int st = b / 1024, sb = b % 1024, swz = sb ^ (((sb >> 9) & 1) << 5); R = (st >> 1) * 16 + swz / 64; C = (st & 1) * 32 + (swz % 64) / 2; }
__host__ __device__ __forceinline__ int perm32(int rho) { const int n = rho >> 4, i = rho & 15; return 8 * (i >> 2) + 4 * n + (i & 3); }

struct Unit { int pm, pn; };
struct Gemm { const bf16_t* A; const bf16_t* Bt; int M, N, K; int zv; int rot; int tiled; int ld; };

struct StaticOrder {
    int nM, nN, nwg, G, c, wgm;
    __host__ __device__ __forceinline__ void init(int M, int N, int G_, int c_, int wgm_ = WGM) { nM = M / BM; nN = N / BM; nwg = nM * nN; G = G_; c = c_; wgm = wgm_; }
    __host__ __device__ __forceinline__ bool next(int i, Unit& u) const {
        const long L = (long)i * G + c; if (L >= nwg) return false;
        int wgid = (int)L; { const int q = nwg / NXCD, r = nwg % NXCD, xcd = wgid % NXCD, off = wgid / NXCD; wgid = (xcd < r ? xcd * (q + 1) : r * (q + 1) + (xcd - r) * q) + off; }
        const int nig = wgm * nN, gid = wgid / nig, fm = gid * wgm, gsz = (nM - fm) < wgm ? (nM - fm) : wgm;
        u.pm = fm + ((wgid % nig) % gsz); u.pn = (wgid % nig) / gsz; return true;
    }
    __device__ __forceinline__ void a_ready(const Unit&) const {}
    __device__ __forceinline__ void done(const Unit&) const {}
};

__device__ __forceinline__ unsigned cvt_pk_bf16(float lo, float hi) { unsigned r; asm volatile("v_cvt_pk_bf16_f32 %0, %1, %2" : "=v"(r) : "v"(lo), "v"(hi)); return r; }
typedef float f32x2 __attribute__((ext_vector_type(2)));

__device__ __forceinline__ float fast_sigmoid(float x) { return __builtin_amdgcn_rcpf(1.0f + __builtin_amdgcn_exp2f(-1.4426950408889634f * x)); }
__device__ __forceinline__ float gelu_tanh(float x) {
    const float u2 = 1.5957691216057308f * (x + 0.044715f * x * x * x);
    return x * fast_sigmoid(u2);
}
__device__ __forceinline__ float bf_lo(unsigned u) { return __builtin_bit_cast(float, u << 16); }
__device__ __forceinline__ float bf_hi(unsigned u) { return __builtin_bit_cast(float, u & 0xffff0000u); }

#ifdef PG8_NT_OUT
#define PG8_STORE_OUT(p, v) __builtin_nontemporal_store((v), (p))
#else
#define PG8_STORE_OUT(p, v) (*(p) = (v))
#endif
struct EpiProj {
    static constexpr bool PERM = true, AFTER_DRAIN = false, MID = false; static constexpr int MID_TILES = 1; __device__ __forceinline__ void set_scale0() {}
    bf16_t* P1; bf16_t* G;
    __device__ __forceinline__ void operator()(const f32x4 (&acc)[2][2][4][2], const Unit& u, int wr, int wc, int fr, int fq) const {
        const int row0 = u.pm * BM + wr * 64 + fr;
        bf16_t* base; int ldc, colt, act0, act1;
        if (u.pn < 8) { base = P1; ldc = 2048; colt = u.pn * BM; act0 = (u.pn < 2) ? 1 : 0; act1 = (u.pn == 7) ? 2 : act0; }
        else { base = G; ldc = 3072; colt = (u.pn - 8) * BM; act0 = 2; act1 = 2; }
        const int col0 = colt + wc * 32 + 8 * fq;
#pragma unroll
        for (int ai = 0; ai < 2; ++ai)
#pragma unroll
            for (int m = 0; m < 4; ++m) { bf16_t* rowp = base + (size_t)(row0 + ai * HALF + m * 16) * ldc + col0;
#pragma unroll
                for (int bj = 0; bj < 2; ++bj) { f32x4 v0 = acc[ai][bj][m][0], v1 = acc[ai][bj][m][1]; const int act = bj ? act1 : act0;
                    if (act == 1) {
#pragma unroll
                        for (int e = 0; e < 4; ++e) { v0[e] = gelu_tanh(v0[e]); v1[e] = gelu_tanh(v1[e]); } }
                    else if (act == 2) {
#pragma unroll
                        for (int e = 0; e < 4; ++e) { v0[e] = fast_sigmoid(v0[e]); v1[e] = fast_sigmoid(v1[e]); } }
                    u32x4 w; w.x = cvt_pk_bf16(v0[0], v0[1]); w.y = cvt_pk_bf16(v0[2], v0[3]); w.z = cvt_pk_bf16(v1[0], v1[1]); w.w = cvt_pk_bf16(v1[2], v1[3]);
                    *(u32x4*)(rowp + bj * HALF) = w; } }
    }
};
struct EpiMerge {
    static constexpr bool PERM = true, AFTER_DRAIN = false, MID = false; static constexpr int MID_TILES = 1; __device__ __forceinline__ void set_scale0() {}
    const bf16_t* G; bf16_t* MG; int nmt;
    __device__ __forceinline__ void operator()(const f32x4 (&acc)[2][2][4][2], const Unit& u, int wr, int wc, int fr, int fq) const {
        const int i = u.pn >> 2, pn = u.pn & 3, pm = u.pm - i * nmt;
        const int row0 = pm * BM + wr * 64 + fr, col0 = pn * BM + wc * 32 + 8 * fq;
#pragma unroll
        for (int ai = 0; ai < 2; ++ai)
#pragma unroll
            for (int mp = 0; mp < 2; ++mp) {
                u32x4 g[4], o[4];
#pragma unroll
                for (int q = 0; q < 4; ++q) { const int m = 2 * mp + (q >> 1), bj = q & 1; const size_t row = (size_t)(row0 + ai * HALF + m * 16); const int col = col0 + bj * HALF;
                    g[q] = *(const u32x4*)(G + row * 3072 + i * 1024 + col);
                    if (i > 0) o[q] = *(const u32x4*)(MG + row * 1024 + col); else o[q] = (u32x4){0u, 0u, 0u, 0u}; }
#pragma unroll
                for (int q = 0; q < 4; ++q) { const int m = 2 * mp + (q >> 1), bj = q & 1; const size_t row = (size_t)(row0 + ai * HALF + m * 16); const int col = col0 + bj * HALF;
                    f32x4 v0 = acc[ai][bj][m][0], v1 = acc[ai][bj][m][1];
#ifdef ABL_BRANCH
                    if (i == ABL_BRANCH) { v0 = v0 * (float)ABL_SCALE; v1 = v1 * (float)ABL_SCALE; }
#endif
                    v0[0] = v0[0] * bf_lo(g[q].x) + bf_lo(o[q].x); v0[1] = v0[1] * bf_hi(g[q].x) + bf_hi(o[q].x); v0[2] = v0[2] * bf_lo(g[q].y) + bf_lo(o[q].y); v0[3] = v0[3] * bf_hi(g[q].y) + bf_hi(o[q].y);
                    v1[0] = v1[0] * bf_lo(g[q].z) + bf_lo(o[q].z); v1[1] = v1[1] * bf_hi(g[q].z) + bf_hi(o[q].z); v1[2] = v1[2] * bf_lo(g[q].w) + bf_lo(o[q].w); v1[3] = v1[3] * bf_hi(g[q].w) + bf_hi(o[q].w);
                    u32x4 w; w.x = cvt_pk_bf16(v0[0], v0[1]); w.y = cvt_pk_bf16(v0[2], v0[3]); w.z = cvt_pk_bf16(v1[0], v1[1]); w.w = cvt_pk_bf16(v1[2], v1[3]);
                    *(u32x4*)(MG + row * 1024 + col) = w; } }
    }
};
struct EpiResid {
    static constexpr bool PERM = false, AFTER_DRAIN = false, MID = false; static constexpr int MID_TILES = 1; __device__ __forceinline__ void set_scale0() { scale = 0.f; base = out; }
    const float* base; float* out; int ldc; float scale;
    __device__ __forceinline__ void operator()(const f32x4 (&acc)[2][2][4][2], const Unit& u, int wr, int wc, int fr, int fq) const {
        const int row0 = u.pm * BM + wr * 64 + fr, col0 = u.pn * BM + wc * 32 + 4 * fq;
#pragma unroll
        for (int ai = 0; ai < 2; ++ai)
#pragma unroll
            for (int mp = 0; mp < 2; ++mp) {
                f32x4 b[8];
#pragma unroll
                for (int q = 0; q < 8; ++q) { const int m = 2 * mp + (q >> 2), bj = (q >> 1) & 1, n = q & 1;
                    b[q] = *(const f32x4*)(base + (size_t)(row0 + ai * HALF + m * 16) * ldc + col0 + bj * HALF + n * 16); }
#pragma unroll
                for (int q = 0; q < 8; ++q) { const int m = 2 * mp + (q >> 2), bj = (q >> 1) & 1, n = q & 1;
                    *(f32x4*)(out + (size_t)(row0 + ai * HALF + m * 16) * ldc + col0 + bj * HALF + n * 16) = b[q] + acc[ai][bj][m][n] * scale; } }
    }
};
struct EpiF32 {
    static constexpr bool PERM = false, AFTER_DRAIN = false, MID = false; static constexpr int MID_TILES = 1; __device__ __forceinline__ void set_scale0() {}
    float* O; int ldc, nN;
    __device__ __forceinline__ void operator()(const f32x4 (&acc)[2][2][4][2], const Unit& u, int wr, int wc, int fr, int fq) const {
        const int row0 = u.pm * BM + wr * 64 + fr, col0 = (u.pn % nN) * BM + wc * 32 + 4 * fq;
#pragma unroll
        for (int ai = 0; ai < 2; ++ai)
#pragma unroll
            for (int m = 0; m < 4; ++m) { const size_t off = (size_t)(row0 + ai * HALF + m * 16) * ldc + col0;
#pragma unroll
                for (int bj = 0; bj < 2; ++bj)
#pragma unroll
                    for (int n = 0; n < 2; ++n) *(f32x4*)(O + off + bj * HALF + n * 16) = acc[ai][bj][m][n]; }
    }
};
#ifdef EMU_FP8_HID
__device__ __forceinline__ float Q8H(float x) { const int p = __builtin_amdgcn_cvt_pk_fp8_f32(x * 8.f, x * 8.f, 0, false); return __builtin_amdgcn_cvt_f32_fp8(p, 0) * 0.125f; }
#else
__device__ __forceinline__ float Q8H(float x) { return x; }
#endif
struct EpiSwiGLU {
    static constexpr bool PERM = true, AFTER_DRAIN = false, MID = false; static constexpr int MID_TILES = 1; __device__ __forceinline__ void set_scale0() {}
    bf16_t* H; int ldh; const float* rowscale; int nN; int rowmask = 0x7fffffff;
    __device__ __forceinline__ void operator()(const f32x4 (&acc)[2][2][4][2], const Unit& u, int wr, int wc, int fr, int fq) const {
        const int row0 = u.pm * BM + wr * 64 + fr, col0 = (u.pn % nN) * HALF + wc * 32 + 8 * fq;
        float scv[8];
#pragma unroll
        for (int q = 0; q < 8; ++q) scv[q] = rowscale ? rowscale[row0 + (q >> 2) * HALF + (q & 3) * 16] : 1.0f;
#pragma unroll
        for (int ai = 0; ai < 2; ++ai)
#pragma unroll
            for (int m = 0; m < 4; ++m) { const int row = row0 + ai * HALF + m * 16; const float sc = scv[ai * 4 + m];
                float h[8];
#pragma unroll
                for (int n = 0; n < 2; ++n)
#pragma unroll
                    for (int e = 0; e < 4; ++e) { const float g = acc[ai][0][m][n][e], up = acc[ai][1][m][n][e]; h[n * 4 + e] = Q8H(g * fast_sigmoid(g) * up * sc); }
                u32x4 w; w.x = cvt_pk_bf16(h[0], h[1]); w.y = cvt_pk_bf16(h[2], h[3]); w.z = cvt_pk_bf16(h[4], h[5]); w.w = cvt_pk_bf16(h[6], h[7]);
                PG8_STORE_OUT((u32x4*)(H + (size_t)(row & rowmask) * ldh + col0), w); }
    }
};
struct EpiScatter {
    static constexpr bool PERM = false, AFTER_DRAIN = false, MID = false; static constexpr int MID_TILES = 1; __device__ __forceinline__ void set_scale0() { scale = 0.f; }
    float* out; const int* tok; int nN; float scale;
    __device__ __forceinline__ void operator()(const f32x4 (&acc)[2][2][4][2], const Unit& u, int wr, int wc, int fr, int fq) const {
        const int row0 = u.pm * BM + wr * 64 + fr, col0 = (u.pn % nN) * BM + wc * 32 + 4 * fq;
        int tk[8];
#pragma unroll
        for (int q = 0; q < 8; ++q) tk[q] = tok[row0 + (q >> 2) * HALF + (q & 3) * 16];
#pragma unroll
        for (int ai = 0; ai < 2; ++ai)
#pragma unroll
            for (int mp = 0; mp < 2; ++mp) {
                f32x4 b[8];
#pragma unroll
                for (int q = 0; q < 8; ++q) { const int m = 2 * mp + (q >> 2), bj = (q >> 1) & 1, n = q & 1; const int t = tk[ai * 4 + m];
                    b[q] = *(const f32x4*)(out + (size_t)(t < 0 ? 0 : t) * 1024 + col0 + bj * HALF + n * 16); }
#pragma unroll
                for (int q = 0; q < 8; ++q) { const int m = 2 * mp + (q >> 2), bj = (q >> 1) & 1, n = q & 1; const int t = tk[ai * 4 + m];
#ifdef ABL_MOE
                    if (false)
#else
                    if (t >= 0)
#endif
                        *(f32x4*)(out + (size_t)t * 1024 + col0 + bj * HALF + n * 16) = b[q] + acc[ai][bj][m][n] * scale; } }
    }
};
struct GroupedOrder {
    StaticOrder so; const PG8_LAS int* tile_e; int nN;
    __device__ __forceinline__ bool next(int i, Unit& u) const { if (!so.next(i, u)) return false; u.pn += tile_e[u.pm] * nN; return true; }
    __device__ __forceinline__ void a_ready(const Unit&) const {}
    __device__ __forceinline__ void done(const Unit&) const {}
};
struct LimitOrder {
    StaticOrder so; int limit;
    __device__ __forceinline__ bool next(int i, Unit& u) const { if ((long)i * so.G + so.c >= limit) return false; return so.next(i, u); }
    __device__ __forceinline__ void a_ready(const Unit&) const {}
    __device__ __forceinline__ void done(const Unit&) const {}
};
struct GroupedLimit {
    LimitOrder lo; const PG8_LAS int* tile_e; int nN;
    __device__ __forceinline__ bool next(int i, Unit& u) const { if (!lo.next(i, u)) return false; u.pn += tile_e[u.pm] * nN; return true; }
    __device__ __forceinline__ void a_ready(const Unit&) const {}
    __device__ __forceinline__ void done(const Unit&) const {}
};
struct SingleOrder {
    Unit un;
    __device__ __forceinline__ bool next(int i, Unit& u) const { if (i != 0) return false; u = un; return true; }
    __device__ __forceinline__ void a_ready(const Unit&) const {}
    __device__ __forceinline__ void done(const Unit&) const {}
};
struct EpiTile {
    static constexpr bool PERM = false, AFTER_DRAIN = false, MID = false; static constexpr int MID_TILES = 1; __device__ __forceinline__ void set_scale0() {}
    float* O;
    __device__ __forceinline__ void operator()(const f32x4 (&acc)[2][2][4][2], const Unit&, int wr, int wc, int fr, int fq) const {
#pragma unroll
        for (int ai = 0; ai < 2; ++ai)
#pragma unroll
            for (int m = 0; m < 4; ++m)
#pragma unroll
                for (int bj = 0; bj < 2; ++bj)
#pragma unroll
                    for (int n = 0; n < 2; ++n) *(f32x4*)(O + (size_t)(wr * 64 + fr + ai * HALF + m * 16) * 256 + wc * 32 + 4 * fq + bj * HALF + n * 16) = acc[ai][bj][m][n];
    }
};
struct OffsetOrder {
    StaticOrder so; int pn_off;
    __device__ __forceinline__ bool next(int i, Unit& u) const { if (!so.next(i, u)) return false; u.pn += pn_off; return true; }
    __device__ __forceinline__ void a_ready(const Unit&) const {}
    __device__ __forceinline__ void done(const Unit&) const {}
};
struct ProbeOrder {
    StaticOrder so; int pm_mask;
    __device__ __forceinline__ bool next(int i, Unit& u) const { if (!so.next(i, u)) return false; u.pm &= pm_mask; return true; }
    __device__ __forceinline__ void a_ready(const Unit&) const {}
    __device__ __forceinline__ void done(const Unit&) const {}
};
struct MergeOrder {
    StaticOrder so; int nmt;
    __device__ __forceinline__ bool next(int i, Unit& u) const { const int b = i % 3; if (!so.next(i / 3, u)) return false; u.pm += b * nmt; u.pn += b * 4; return true; }
    __device__ __forceinline__ void a_ready(const Unit&) const {}
    __device__ __forceinline__ void done(const Unit&) const {}
};
template <class Epi, class Sched, bool ALIGN_EPI = false, bool SP2 = false>
__device__ __forceinline__ void gemm_phase(PG8_LAS unsigned char* lds, const Gemm g, const Sched& S, const Epi& E) {
    const int tid = g.zv  , wid = __builtin_amdgcn_readfirstlane(tid >> 6), lane = tid & 63, wr = wid >> 2, wc = wid & 3, fr = lane & 15, fq = lane >> 4;
    const int K = g.K, nt = K / BK;
    unsigned voffA[2], voffB[2];
#pragma unroll
    for (int i = 0; i < 2; ++i) { int R, C; stage_rc(tid * 16 + i * 8192, R, C); const int Rb = Epi::PERM ? ((R & ~31) + perm32(R & 31)) : R;
        const int LD = g.ld ? g.ld : K;
        const int pitch = g.tiled ? BK : LD;
        voffA[i] = (unsigned)(R * pitch + C) * 2u; voffB[i] = (unsigned)(Rb * pitch + C) * 2u; }
    const size_t kstep = g.tiled ? (size_t)(BM * BK * 2) : (size_t)(BK * 2);
    const size_t hstep = g.tiled ? (size_t)(HALF * BK * 2) : (size_t)HALF * (g.ld ? g.ld : K) * 2;
    const size_t tstep = (size_t)BM * (g.ld ? g.ld : K) * 2;
    const unsigned ldsw = (unsigned)wid * 1024u;
    const int aoff = lds_byte(wr * 64 + fr, fq * 8), boff = lds_byte(wc * 32 + fr, fq * 8);
#define PG8_SA(b, h) (((b) * 2 + (h)) * HTB)
#define PG8_SB(b, h) ((4 + (b) * 2 + (h)) * HTB)
#define PG8_STAGE(bufoff, gbase, voff) do { _Pragma("unroll") for (int _i = 0; _i < 2; ++_i) \
        __builtin_amdgcn_global_load_lds((const unsigned*)((const char*)(gbase) + (voff)[_i]), (PG8_LAS unsigned*)(lds + (bufoff) + ldsw + _i * 8192), 16, 0, ((bufoff) < 4 * HTB) ? PG8_AUX_A : PG8_AUX_B); } while (0)
#define PG8_LDA(dst, b, h) do { _Pragma("unroll") for (int m = 0; m < 4; ++m) _Pragma("unroll") for (int k = 0; k < 2; ++k) dst[m][k] = *(const PG8_LAS bf16x8*)(lds + PG8_SA(b, h) + aoff + m * 2048 + k * 1024); } while (0)
#define PG8_LDB(dst, b, h) do { _Pragma("unroll") for (int n = 0; n < 2; ++n) _Pragma("unroll") for (int k = 0; k < 2; ++k) dst[n][k] = *(const PG8_LAS bf16x8*)(lds + PG8_SB(b, h) + boff + n * 2048 + k * 1024); } while (0)
#define PG8_MMA(ai, bj, At, Bt) do { __builtin_amdgcn_s_setprio(1); _Pragma("unroll") for (int m = 0; m < 4; ++m) _Pragma("unroll") for (int n = 0; n < 2; ++n) _Pragma("unroll") for (int k = 0; k < 2; ++k) \
        acc[ai][bj][m][n] = __builtin_amdgcn_mfma_f32_16x16x32_bf16(Bt[n][k], At[m][k], acc[ai][bj][m][n], 0, 0, 0); __builtin_amdgcn_s_setprio(0); } while (0)
#define PG8_WAIT_V(n) asm volatile("s_waitcnt vmcnt(" #n ")" ::: "memory")
#define PG8_WAIT_L(n) asm volatile("s_waitcnt lgkmcnt(" #n ")" ::: "memory")
#define PG8_BAR __builtin_amdgcn_s_barrier()
#define PG8_SCHED __builtin_amdgcn_sched_barrier(0)
    Unit cur, nxt; int ui = 0;
    if (!S.next(0, cur)) return;
    f32x4 acc[2][2][4][2];
#pragma unroll
    for (int a = 0; a < 2; ++a)
#pragma unroll
        for (int b = 0; b < 2; ++b)
#pragma unroll
            for (int m = 0; m < 4; ++m)
#pragma unroll
                for (int n = 0; n < 2; ++n) acc[a][b][m][n] = (f32x4){0.f, 0.f, 0.f, 0.f};
    bf16x8 At[4][2], B0[2][2], B1[2][2];
    const char* cA = (const char*)g.A + (size_t)cur.pm * tstep; const char* cB = (const char*)g.Bt + (size_t)cur.pn * tstep;
    const int rot = g.rot; const size_t rofs = (size_t)rot * kstep; const char* pA = cA + rofs; const char* pB = cB + rofs;
#define PG8_KT(x) ((size_t)(((x) + rot >= nt) ? (x) + rot - nt : (x) + rot))
    S.a_ready(cur);
    if constexpr (SP2) {
        PG8_STAGE(PG8_SB(0, 0), pB, voffB); PG8_STAGE(PG8_SB(0, 1), pB + hstep, voffB); PG8_STAGE(PG8_SA(0, 0), pA, voffA); PG8_STAGE(PG8_SA(0, 1), pA + hstep, voffA);
        if (wr == 1) PG8_BAR;
        PG8_WAIT_V(2); PG8_BAR;
        PG8_STAGE(PG8_SB(1, 0), pB + kstep, voffB); PG8_STAGE(PG8_SA(1, 0), pA + kstep, voffA); PG8_STAGE(PG8_SB(1, 1), pB + hstep + kstep, voffB);
        PG8_WAIT_V(6); PG8_BAR;
    } else {
        PG8_STAGE(PG8_SB(0, 0), pB, voffB); PG8_STAGE(PG8_SA(0, 0), pA, voffA); PG8_STAGE(PG8_SB(0, 1), pB + hstep, voffB); PG8_STAGE(PG8_SA(0, 1), pA + hstep, voffA);
        if (wr == 1) PG8_BAR;
        PG8_WAIT_V(4); PG8_BAR;
        PG8_STAGE(PG8_SB(1, 0), pB + kstep, voffB); PG8_STAGE(PG8_SA(1, 0), pA + kstep, voffA); PG8_STAGE(PG8_SB(1, 1), pB + hstep + kstep, voffB);
        PG8_WAIT_V(6); PG8_BAR;
    }
    for (;;) {
        const bool has_next = S.next(ui + 1, nxt);
        const char* nA = has_next ? (const char*)g.A + (size_t)nxt.pm * tstep : cA; const char* nB = has_next ? (const char*)g.Bt + (size_t)nxt.pn * tstep : cB;
        for (int t = 0; t < nt; t += 2) {
            if constexpr (Epi::MID) { if (t != 0 && (t & (Epi::MID_TILES - 1)) == 0) E.mid(acc, cur, t / Epi::MID_TILES, wr, wc, fr, fq); }
            const bool last = (t == nt - 2);
            const char* a1 = cA + PG8_KT(t + 1) * kstep;
            const char* a2 = last ? nA + rofs : cA + PG8_KT(t + 2) * kstep; const char* b2 = last ? nB + rofs : cB + PG8_KT(t + 2) * kstep;
            const char* a3 = a2 + kstep; const char* b3 = b2 + kstep;
            if (last && has_next) S.a_ready(nxt);
            if constexpr (SP2) {
            PG8_LDB(B0, 0, 0); PG8_LDB(B1, 0, 1); PG8_SCHED; PG8_LDA(At, 0, 0); PG8_STAGE(PG8_SA(1, 1), a1 + hstep, voffA);
            PG8_WAIT_V(8); PG8_WAIT_L(0); PG8_BAR; PG8_MMA(0, 0, At, B0); PG8_MMA(0, 1, At, B1); PG8_BAR; PG8_SCHED;
            PG8_LDA(At, 0, 1); PG8_STAGE(PG8_SB(0, 0), b2, voffB); PG8_STAGE(PG8_SB(0, 1), b2 + hstep, voffB); PG8_STAGE(PG8_SA(0, 0), a2, voffA);
            PG8_WAIT_V(8); PG8_WAIT_L(0); PG8_BAR; PG8_MMA(1, 0, At, B0); PG8_MMA(1, 1, At, B1); PG8_BAR; PG8_SCHED;
            PG8_LDB(B0, 1, 0); PG8_LDB(B1, 1, 1); PG8_SCHED; PG8_LDA(At, 1, 0); PG8_STAGE(PG8_SA(0, 1), a2 + hstep, voffA);
            PG8_WAIT_V(8); PG8_WAIT_L(0); PG8_BAR; PG8_MMA(0, 0, At, B0); PG8_MMA(0, 1, At, B1); PG8_BAR; PG8_SCHED;
            PG8_LDA(At, 1, 1); PG8_STAGE(PG8_SB(1, 0), b3, voffB); PG8_STAGE(PG8_SB(1, 1), b3 + hstep, voffB); PG8_STAGE(PG8_SA(1, 0), a3, voffA);
            PG8_WAIT_V(8); PG8_WAIT_L(0); PG8_BAR; PG8_MMA(1, 0, At, B0); PG8_MMA(1, 1, At, B1); PG8_BAR; PG8_SCHED;
            } else {
            PG8_LDB(B0, 0, 0); PG8_SCHED; PG8_LDA(At, 0, 0); PG8_STAGE(PG8_SA(1, 1), a1 + hstep, voffA);
            PG8_WAIT_L(8); PG8_BAR; PG8_WAIT_L(0); PG8_MMA(0, 0, At, B0); PG8_BAR; PG8_SCHED;
            PG8_LDB(B1, 0, 1); PG8_STAGE(PG8_SB(0, 0), b2, voffB);
            PG8_BAR; PG8_WAIT_L(0); PG8_MMA(0, 1, At, B1); PG8_BAR;
            PG8_LDA(At, 0, 1); PG8_STAGE(PG8_SA(0, 0), a2, voffA);
            PG8_BAR; PG8_WAIT_L(0); PG8_MMA(1, 0, At, B0); PG8_BAR; PG8_SCHED;
            PG8_STAGE(PG8_SB(0, 1), b2 + hstep, voffB);
            PG8_WAIT_V(6); PG8_BAR; PG8_MMA(1, 1, At, B1); PG8_BAR;
            PG8_LDB(B0, 1, 0); PG8_SCHED; PG8_LDA(At, 1, 0); PG8_STAGE(PG8_SA(0, 1), a2 + hstep, voffA);
            PG8_WAIT_L(8); PG8_BAR; PG8_WAIT_L(0); PG8_MMA(0, 0, At, B0); PG8_BAR; PG8_SCHED;
            PG8_LDB(B1, 1, 1); PG8_STAGE(PG8_SB(1, 0), b3, voffB);
            PG8_BAR; PG8_WAIT_L(0); PG8_MMA(0, 1, At, B1); PG8_BAR;
            PG8_LDA(At, 1, 1); PG8_STAGE(PG8_SA(1, 0), a3, voffA);
            PG8_BAR; PG8_WAIT_L(0); PG8_MMA(1, 0, At, B0); PG8_BAR; PG8_SCHED;
            PG8_STAGE(PG8_SB(1, 1), b3 + hstep, voffB);
            PG8_WAIT_V(6); PG8_BAR; PG8_MMA(1, 1, At, B1); PG8_BAR;
            }
        }
        if constexpr (ALIGN_EPI) { if (wr == 0) PG8_BAR; }
        if constexpr (!Epi::AFTER_DRAIN) { E(acc, cur, wr, wc, fr, fq); S.done(cur); }
        if (!has_next) break;
#pragma unroll
        for (int a = 0; a < 2; ++a)
#pragma unroll
            for (int b = 0; b < 2; ++b)
#pragma unroll
                for (int m = 0; m < 4; ++m)
#pragma unroll
                    for (int n = 0; n < 2; ++n) acc[a][b][m][n] = (f32x4){0.f, 0.f, 0.f, 0.f};
        cur = nxt; cA = nA; cB = nB; ++ui;
        if constexpr (ALIGN_EPI) { if (wr == 1) PG8_BAR; }
    }
    PG8_WAIT_V(0);
    if constexpr (!ALIGN_EPI) { if (wr == 0) PG8_BAR; }
    PG8_BAR;
    if constexpr (Epi::AFTER_DRAIN) { E.fused(acc, cur, wr, wc, fr, fq, lds, wid, lane); S.done(cur); }
#undef PG8_KT
#undef PG8_SA
#undef PG8_SB
#undef PG8_STAGE
#undef PG8_LDA
#undef PG8_LDB
#undef PG8_MMA
#undef PG8_WAIT_V
#undef PG8_WAIT_L
#undef PG8_BAR
#undef PG8_SCHED
}
}

constexpr int NWAVES = 8;
constexpr int DM = 1024, BATCH = 16, SEQ = 4096, DEPTH = 4, MTOK = BATCH * SEQ;
constexpr int NCHUNK = 2, MC = MTOK / NCHUNK, BC = BATCH / NCHUNK;
constexpr int CIN = 5004, NPROJ = 5120, P1W = 2048, GWID = 3072;
constexpr int DFF = 2752, DFFP = 2816, NFF1 = 2 * DFFP;
constexpr int NEXP = 8, DFE = 3584, NMOE1 = 2 * DFE;
constexpr int SLOTS = MC + 2048;
constexpr float EPS = 1e-6f;
constexpr int C_U = 0, C_V = 256, C_SBQ = 512, C_SBK = 768, C_SBV = 1024, C_CQ = 1280, C_KCMP = 1536, C_VCMP = 1600, C_KSLC = 1664, C_VSLC = 1728, C_KWIN = 1792, C_VWIN = 1856, C_CG = 1920;

constexpr size_t MiB = 1u << 20;
constexpr size_t WS_CTL = 0, CTL_ZERO_BYTES = 1 * MiB;
constexpr size_t WS_ROPE = 1 * MiB;
constexpr size_t WS_BIAS1 = 1 * MiB + 512 * 1024;
constexpr size_t WS_WIN = 2 * MiB;
constexpr size_t WS_WBR = 12 * MiB;
constexpr size_t WS_WOUT = 14 * MiB;
constexpr size_t WS_WC1 = 16 * MiB;
constexpr size_t WS_WF1 = 18 * MiB;
constexpr size_t WS_WF2 = 130 * MiB;
constexpr size_t WS_HN = 186 * MiB;
constexpr size_t WS_SCR = 314 * MiB;
constexpr size_t WS_P1 = WS_SCR;
constexpr size_t WS_G = WS_P1 + 128 * MiB;
constexpr size_t WS_Y = WS_G + 192 * MiB;
constexpr size_t WS_MG = WS_Y + 48 * MiB;
constexpr size_t WS_KVC = WS_MG + 64 * MiB;
constexpr size_t WS_UL = WS_KVC + 8 * MiB;
constexpr size_t WS_KC = WS_UL + 8 * MiB;
constexpr size_t WS_VT = WS_KC + 1 * MiB;
constexpr size_t WS_KCT = WS_VT + 24 * MiB;
constexpr size_t WS_MIX_END = WS_KCT + 1 * MiB;
constexpr size_t WS_HID = WS_SCR;
constexpr size_t WS_ROUTE = WS_SCR;
constexpr size_t WS_TOKMAP = WS_SCR + 1 * MiB;
constexpr size_t WS_WSLOT = WS_SCR + 2 * MiB;
constexpr size_t WS_CNT128 = WS_SCR + 3 * MiB;
constexpr size_t WS_XG = WS_SCR + 4 * MiB;
constexpr size_t WS_HIDM = WS_XG + 68 * MiB;
constexpr size_t WS_END = 800 * MiB;
static_assert(WS_MIX_END <= WS_END && WS_HID + (size_t)MTOK * DFFP * 2 <= WS_END && WS_HIDM + (size_t)SLOTS * DFE * 2 <= WS_END, "d_ws map");
static_assert(WS_WF1 + (size_t)NEXP * NMOE1 * DM * 2 <= WS_WF2 && WS_WF2 + (size_t)NEXP * DM * DFE * 2 <= WS_HN, "weight map");
static_assert((size_t)4 * SLOTS * 4 <= 1 * MiB, "tokmap");
constexpr int CW_BAR = 4096;
constexpr int CW_CNT = 131072;
constexpr int CW_CUR = 131072 + 256;
constexpr int MAX_BAR_REGIONS = 32;
constexpr int RING_OFF = 0, RING_BYTES = 131072;
constexpr int LDSCTL_OFF = RING_BYTES, MISC_OFF = LDSCTL_OFF + 320;
constexpr int TAB_OFF = LDSCTL_OFF + 1024;
constexpr int LDS_BYTES = 147456;

#define GAS __attribute__((address_space(1)))
#define LAS __attribute__((address_space(3)))
typedef unsigned short bf16;
typedef unsigned v4u __attribute__((ext_vector_type(4)));
typedef unsigned v2u __attribute__((ext_vector_type(2)));
typedef float f32x4 __attribute__((ext_vector_type(4)));
typedef int v4i __attribute__((ext_vector_type(4)));
typedef __bf16 bf16x2_t __attribute__((ext_vector_type(2)));
#define LDS_WAIT() asm volatile("s_waitcnt lgkmcnt(0)" ::: "memory")
#define VM_WAIT() asm volatile("s_waitcnt vmcnt(0)" ::: "memory")
__device__ __forceinline__ unsigned f2bf(float f) { unsigned u = __builtin_bit_cast(unsigned, f); return (u + 0x7fffu + ((u >> 16) & 1u)) >> 16; }
__device__ __forceinline__ unsigned pk2(float lo, float hi) { return f2bf(lo) | (f2bf(hi) << 16); }
__device__ __forceinline__ float bflo(unsigned u) { return __builtin_bit_cast(float, u << 16); }
__device__ __forceinline__ float bfhi(unsigned u) { return __builtin_bit_cast(float, u & 0xffff0000u); }
__device__ __forceinline__ float bf1(bf16 h) { return __builtin_bit_cast(float, (unsigned)h << 16); }
__device__ __forceinline__ float dot2bf(unsigned a, unsigned b, float c) { return __builtin_amdgcn_fdot2_f32_bf16(__builtin_bit_cast(bf16x2_t, a), __builtin_bit_cast(bf16x2_t, b), c, false); }
#ifdef EMU_FP8
__device__ __forceinline__ float q8r(float x, float s) { const int p = __builtin_amdgcn_cvt_pk_fp8_f32(x * s, x * s, 0, false); return __builtin_amdgcn_cvt_f32_fp8(p, 0) * (1.0f / s); }
#else
__device__ __forceinline__ float q8r(float x, float) { return x; }
#endif
__device__ __forceinline__ float fexp(float x) { return __builtin_amdgcn_exp2f(1.4426950408889634f * x); }
template <int X> __device__ __forceinline__ float swz_xor(float v) { return __builtin_bit_cast(float, __builtin_amdgcn_ds_swizzle(__builtin_bit_cast(int, v), (X << 10) | 0x1f)); }
__device__ __forceinline__ float wave_sum(float v, int lane) {
#pragma unroll
    for (int o = 1; o < 64; o <<= 1) v += __builtin_bit_cast(float, __builtin_amdgcn_ds_bpermute((lane ^ o) << 2, __builtin_bit_cast(int, v)));
    return v;
}
__device__ __forceinline__ float rdlane(float v, int l) { return __builtin_bit_cast(float, __builtin_amdgcn_readlane(__builtin_bit_cast(int, v), l)); }
__device__ __forceinline__ int bperm(int srclane, int v) { return __builtin_amdgcn_ds_bpermute(srclane << 2, v); }
__constant__ double ROPE_INVF[8] = {1.0, 0.19392274474868576, 0.037606030930863933, 0.0072926647372171093, 0.0014142135623730950, 0.00027424817567620730, 5.3182958969449883e-05, 1.0313385377212460e-05};
#define XB_TMO      128
#define XB_XCNT(j)  (256  + 64 * (j))
#define XB_XSUB(j)  (1280 + 64 * (j))
#define XB_XGEN(j)  (2304 + 64 * (j))
#define XB_TOP      3328
#define XB_TOPGEN   3392
#define XCD_BAR_WORDS 3456
#define XB_SPIN_CAP (1u << 18)

__device__ __forceinline__ unsigned xb_ld(unsigned* p)              { return __hip_atomic_load(p, __ATOMIC_RELAXED, __HIP_MEMORY_SCOPE_AGENT); }
__device__ __forceinline__ unsigned xb_add(unsigned* p, unsigned v) { return __hip_atomic_fetch_add(p, v, __ATOMIC_RELAXED, __HIP_MEMORY_SCOPE_AGENT); }
__device__ __forceinline__ unsigned xb_xcc_id() { return (unsigned)__builtin_amdgcn_s_getreg((3 << 11) | 20) & 0xFu; }
#define XB_SPIN(cond, bar) do { unsigned _sp = 0; while (cond) { __builtin_amdgcn_s_sleep(1); \
    if ((++_sp & 255u) == 0u) { if (xb_ld(&(bar)[XB_TMO])) break; if (_sp > XB_SPIN_CAP) { atomicAdd(&(bar)[XB_TMO], 1u); break; } } } } while (0)

__device__ __forceinline__ bool xb_thread0_w(unsigned w, unsigned z) { return w == 0u && __builtin_amdgcn_mbcnt_hi(~0u, __builtin_amdgcn_mbcnt_lo(~0u, z)) == 0u; }
struct XcdBarrier {
    unsigned* bar; unsigned x; unsigned w, z;
    volatile LAS unsigned* st;
};

__device__ __forceinline__ XcdBarrier xcd_barrier_post(unsigned* bar, volatile LAS unsigned* st) {
    XcdBarrier b; b.bar = bar; b.x = xb_xcc_id(); b.st = st; b.w = (unsigned)__builtin_amdgcn_readfirstlane((int)(threadIdx.x >> 6)); b.z = 0u;
    if (xb_thread0_w(b.w, b.z)) (void)xb_add(&bar[XB_XCNT(b.x)], 1u);
    return b;
}
__device__ __forceinline__ void xcd_barrier_complete(unsigned* bar, unsigned x, unsigned& nloc, unsigned& nx) {
    const unsigned G = gridDim.x * gridDim.y * gridDim.z;
    unsigned sum, cnt, mine, sp = 0u;
    for (;;) {
        sum = 0u; cnt = 0u; mine = 0u;
#pragma unroll
        for (unsigned j = 0; j < 16; ++j) { const unsigned c = xb_ld(&bar[XB_XCNT(j)]); sum += c; cnt += (c > 0u) ? 1u : 0u; mine = (j == x) ? c : mine; }
        if (sum == G) break;
        __builtin_amdgcn_s_sleep(1);
        if ((++sp & 255u) == 0u) { if (xb_ld(&bar[XB_TMO])) break; if (sp > XB_SPIN_CAP) { atomicAdd(&bar[XB_TMO], 1u); break; } }
    }
    nloc = mine > 0u ? mine : 1u; nx = cnt > 0u ? cnt : 1u;
}

__device__ __forceinline__ void xcd_barrier(const XcdBarrier& b) {
    asm volatile("s_waitcnt vmcnt(0)" ::: "memory");
    __syncthreads();
    if (xb_thread0_w(b.w, b.z)) {
        unsigned* bar = b.bar;
        __builtin_amdgcn_s_waitcnt(0);
        unsigned nloc = b.st[0], nx = b.st[1];
        if (nloc == 0u) { xcd_barrier_complete(bar, b.x, nloc, nx); b.st[0] = nloc; b.st[1] = nx; }
        const unsigned old = xb_add(&bar[XB_XSUB(b.x)], 1u);
        const unsigned gen = old / nloc;
        if (old + 1u == (gen + 1u) * nloc) {
            __builtin_amdgcn_fence(__ATOMIC_RELEASE, "agent");
            asm volatile("s_waitcnt vmcnt(0)" ::: "memory");
            const unsigned og = xb_add(&bar[XB_TOP], 1u);
            const unsigned tg = og / nx;
            if (og + 1u == (tg + 1u) * nx) xb_add(&bar[XB_TOPGEN], 1u);
            else XB_SPIN(xb_ld(&bar[XB_TOPGEN]) == tg, bar);
            __builtin_amdgcn_fence(__ATOMIC_ACQUIRE, "agent");
            xb_add(&bar[XB_XGEN(b.x)], 1u);
            asm volatile("s_waitcnt vmcnt(0)" ::: "memory");
        } else {
            XB_SPIN(xb_ld(&bar[XB_XGEN(b.x)]) == gen, bar);
            __builtin_amdgcn_fence(__ATOMIC_ACQUIRE, "agent");
            asm volatile("s_waitcnt vmcnt(0)" ::: "memory");
        }
    }
    __syncthreads();
}

struct Frame {
    LAS unsigned char* lds;
    unsigned* ctl;
    int tid, lane, wave, vcu, G, bx, zv, zs, rep;
    unsigned char* ws;
    const float* const* in;
    float* out;
};
#define WSP(T, off) ((T*)(F.ws + (off)))
__device__ __forceinline__ size_t toff(int row, int k, int K) { return (size_t)(row >> 8) * 256 * K + (size_t)(k >> 6) * (256 * 64) + (size_t)(row & 255) * 64 + (k & 63); }

#ifndef TILED_FFN1
#define TILED_FFN1 0
#endif
#ifndef Q8_W1
#define Q8_W1 0.f
#define Q8_W2 0.f
#define Q8_HN 0.f
#define Q8_HID 0.f
#endif
__device__ __forceinline__ int map_row(int kind, int off, int n) { return kind == 0 ? n + off : (kind == 1 ? (n < 1932 ? n : n + 116) : ((n >> 7) * 256 + (n & 127) + off)); }
__device__ __forceinline__ void tr_item(const float* W, int ldw, int N, int ks, int n0, bf16* WT, int ldt, int kd, int kind, int off, LAS unsigned char* scr, int lane, float q8s = 0.f, int tiled = 0) {
    const int nq = (lane & 15) * 4, kq = lane >> 4;
    f32x4 x[16];
#pragma unroll
    for (int i = 0; i < 16; ++i) x[i] = (n0 + nq < N) ? *(const f32x4*)(W + (size_t)(ks + 4 * i + kq) * ldw + n0 + nq) : (f32x4){0.f, 0.f, 0.f, 0.f};
#pragma unroll
    for (int i = 0; i < 16; ++i) { const int k = 4 * i + kq;
#pragma unroll
        for (int c = 0; c < 4; ++c) { float wv = x[i][c]; if (q8s > 0.f) wv = q8r(wv, q8s); *(LAS bf16*)(scr + (nq + c) * 136 + k * 2) = (bf16)f2bf(wv); } }
    LDS_WAIT(); asm volatile("" ::: "memory");
    if (n0 + lane < N) { const LAS v2u* s = (const LAS v2u*)(scr + lane * 136); const int mr = map_row(kind, off, n0 + lane); bf16* dst = tiled ? WT + toff(mr, kd, ldt) : WT + (size_t)mr * ldt + kd;
#pragma unroll
        for (int q = 0; q < 8; ++q) { const v2u a = s[2 * q], b = s[2 * q + 1]; *(v4u*)(dst + 8 * q) = (v4u){a.x, a.y, b.x, b.y}; } }
    LDS_WAIT(); asm volatile("" ::: "memory");
}
__device__ __forceinline__ void conv(Frame& F, const float* W, size_t sW, int nb, int ldw, int N, int ks0, int K, bf16* WT, size_t sWT, int ldt, int kd0, int kind, int off, float q8s = 0.f, int tiled = 0) {
    LAS unsigned char* scr = F.lds + RING_OFF + F.wave * 16384;
    const int gw = F.vcu * NWAVES + F.wave, NGW = F.G * NWAVES;
    const int nblk = (N + 63) / 64, per = (K / 64) * nblk, total = per * nb;
    for (int it = gw; it < total; it += NGW) { const int b = it / per, r = it % per, kb = r / nblk, nbk = r % nblk;
        tr_item(W + (size_t)b * sW, ldw, N, ks0 + 64 * kb, 64 * nbk, WT + (size_t)b * sWT, ldt, kd0 + 64 * kb, kind, off, scr, F.lane, q8s, tiled); }
}
__device__ __forceinline__ void zero_block(Frame& F, bf16* WT, int ldt, int r0, int rows, int c0, int cols, int tiled = 0) {
    const int gt = (F.vcu * NWAVES + F.wave) * 64 + F.lane, NT = F.G * NWAVES * 64, cpr = cols / 8;
    for (int i = gt; i < rows * cpr; i += NT) { const int r = i / cpr, c = i % cpr; const unsigned z = (unsigned)F.zv; *(v4u*)(tiled ? WT + toff(r0 + r, c0 + 8 * c, ldt) : WT + (size_t)(r0 + r) * ldt + c0 + 8 * c) = (v4u){z, z, z, z}; }
}
__device__ __forceinline__ void p_convert(Frame& F, int layer) {
    const int j = layer >> 1;
    conv(F, F.in[2] + (size_t)layer * DM * CIN, 0, 1, CIN, CIN, 0, DM, WSP(bf16, WS_WIN), 0, DM, 0, 1, 0);
    zero_block(F, WSP(bf16, WS_WIN), DM, 1932, 116, 0, DM);
    conv(F, F.in[9] + (size_t)layer * 3 * 256 * DM, (size_t)256 * DM, 3, DM, DM, 0, 256, WSP(bf16, WS_WBR), (size_t)DM * 256, 256, 0, 0, 0);
    conv(F, F.in[10] + (size_t)layer * DM * DM, 0, 1, DM, DM, 0, DM, WSP(bf16, WS_WOUT), 0, DM, 0, 0, 0);
    conv(F, F.in[7] + (size_t)layer * 2 * 2048 * 256, (size_t)2048 * 256, 2, 256, 256, 0, 1024, WSP(bf16, WS_WC1), (size_t)512 * 1024, 1024, 0, 0, 0);
    conv(F, F.in[7] + (size_t)layer * 2 * 2048 * 256, (size_t)2048 * 256, 2, 256, 256, 1024, 1024, WSP(bf16, WS_WC1), (size_t)512 * 1024, 1024, 0, 0, 256);
    if ((layer & 1) == 0) {
        conv(F, F.in[12] + (size_t)j * DM * DFF, 0, 1, DFF, DFF, 0, DM, WSP(bf16, WS_WF1), 0, DM, 0, 2, 0, Q8_W1, TILED_FFN1);
        conv(F, F.in[13] + (size_t)j * DM * DFF, 0, 1, DFF, DFF, 0, DM, WSP(bf16, WS_WF1), 0, DM, 0, 2, 128, Q8_W1, TILED_FFN1);
        zero_block(F, WSP(bf16, WS_WF1), DM, 21 * 256 + 64, 64, 0, DM, TILED_FFN1);
        zero_block(F, WSP(bf16, WS_WF1), DM, 21 * 256 + 128 + 64, 64, 0, DM, TILED_FFN1);
        conv(F, F.in[14] + (size_t)j * DFF * DM, 0, 1, DM, DM, 0, DFF, WSP(bf16, WS_WF2), 0, DFFP, 0, 0, 0, Q8_W2);
        zero_block(F, WSP(bf16, WS_WF2), DFFP, 0, DM, DFF, DFFP - DFF);
    } else {
        conv(F, F.in[16] + (size_t)j * NEXP * DM * DFE, (size_t)DM * DFE, NEXP, DFE, DFE, 0, DM, WSP(bf16, WS_WF1), (size_t)NMOE1 * DM, DM, 0, 2, 0, Q8_W1);
        conv(F, F.in[17] + (size_t)j * NEXP * DM * DFE, (size_t)DM * DFE, NEXP, DFE, DFE, 0, DM, WSP(bf16, WS_WF1), (size_t)NMOE1 * DM, DM, 0, 2, 128, Q8_W1);
        conv(F, F.in[18] + (size_t)j * NEXP * DFE * DM, (size_t)DFE * DM, NEXP, DM, DM, 0, DFE, WSP(bf16, WS_WF2), (size_t)DM * DFE, DFE, 0, 0, 0, Q8_W2);
    }
    if (F.bx < 8) {
        __syncthreads();
        const int kv = F.bx >> 2, jj = (F.bx & 3) * 64 + F.lane;
        const float* pos = F.in[6] + (size_t)(layer * 2 + kv) * 2048; const float* w1 = F.in[7] + (size_t)(layer * 2 + kv) * 2048 * 256;
        float a = 0.f;
        float a1 = 0.f, a2 = 0.f, a3 = 0.f;
#pragma unroll 8
        for (int k = 0; k < 256; k += 4) { const int kk = F.wave * 256 + k;
            a += pos[kk] * w1[(size_t)kk * 256 + jj]; a1 += pos[kk + 1] * w1[(size_t)(kk + 1) * 256 + jj]; a2 += pos[kk + 2] * w1[(size_t)(kk + 2) * 256 + jj]; a3 += pos[kk + 3] * w1[(size_t)(kk + 3) * 256 + jj]; }
        a = (a + a1) + (a2 + a3);
        LAS float* red = (LAS float*)(F.lds + RING_OFF);
        red[F.wave * 64 + F.lane] = a;
        __syncthreads();
        if (F.wave == 0) { float s = 0.f;
#pragma unroll
            for (int w = 0; w < 8; ++w) s += red[w * 64 + F.lane];
            WSP(float, WS_BIAS1)[kv * 256 + jj] = s; }
        __syncthreads();
    }
    if (layer == 0) {
        const int gt = (F.vcu * NWAVES + F.wave) * 64 + F.lane, NT = F.G * NWAVES * 64;
        for (int idx = gt; idx < SEQ * 8; idx += NT) { const int pos = idx >> 3, i = idx & 7;
            const double invf = ROPE_INVF[i];
            double rev = (double)pos * invf * 0.15915494309189535; rev -= __builtin_floor(rev);
            WSP(float, WS_ROPE)[idx] = __builtin_amdgcn_cosf((float)rev); WSP(float, WS_ROPE)[SEQ * 8 + idx] = __builtin_amdgcn_sinf((float)rev); }
    }
}

template <int MODE> __device__ __forceinline__ void p_norm(Frame& F, const float* src, const float* g, const float* rw, int jmoe, float q8s = 0.f, int tiled = 0) {
    const int gw = F.vcu * NWAVES + F.wave, NGW = F.G * NWAVES, lane = F.lane;
    LAS int* hist = (LAS int*)(F.lds + TAB_OFF) + 192;
    if (MODE == 1) {
        if (F.tid < 16) hist[F.tid] = 0;
        const int gt = gw * 64 + lane, NT = NGW * 64; int* tm = WSP(int, WS_TOKMAP);
        for (int i = gt; i < 4 * SLOTS; i += NT) tm[i] = -1;
        for (int i = F.tid; i < DM * NEXP / 4; i += NWAVES * 64) { const int c = i >> 1, hf = i & 1;
            *(LAS f32x4*)(F.lds + RING_OFF + (((((c >> 8) * 4 + (c & 3)) * 2 + hf) * 64 + ((c & 255) >> 2)) * 16)) = ((const f32x4*)rw)[i]; }
        if (F.tid < DM / 4) *(LAS f32x4*)(F.lds + RING_OFF + 32768 + 16 * F.tid) = ((const f32x4*)g)[F.tid];
        __syncthreads();
    }
    f32x4 gv[4];
    if (MODE != 1) {
#pragma unroll
        for (int jx = 0; jx < 4; ++jx) gv[jx] = ((const f32x4*)g)[lane + 64 * jx]; }
    constexpr int ROWS = (MODE == 1) ? 2 : 4;
    const int nit = (MODE == 1) ? ((MTOK / 128 - F.bx + F.G - 1) / F.G) * (16 / ROWS) : (MTOK - gw + ROWS * NGW - 1) / (ROWS * NGW);
    f32x4 nv[MODE == 1 ? ROWS : 1][4];
    for (int itx = 0; itx < nit; ++itx) {
        const int chk = (MODE == 1) ? F.bx + (itx / (16 / ROWS)) * F.G : 0;
        const int m0 = (MODE == 1) ? chk * 128 + (itx % (16 / ROWS)) * (NWAVES * ROWS) + F.wave * ROWS : gw + itx * ROWS * NGW;
        const int mstep = (MODE == 1) ? 1 : NGW;
        f32x4 v[ROWS][4]; float ss[ROWS];
        if (MODE == 1) {
            if (itx == 0) {
#pragma unroll
                for (int u = 0; u < ROWS; ++u) { const f32x4* xr = (const f32x4*)(src + (size_t)(m0 + u) * DM) + lane;
#pragma unroll
                    for (int jx = 0; jx < 4; ++jx) nv[u][jx] = xr[64 * jx]; } }
#pragma unroll
            for (int u = 0; u < ROWS; ++u)
#pragma unroll
                for (int jx = 0; jx < 4; ++jx) v[u][jx] = nv[u][jx];
            if (itx + 1 < nit) { const int itn = itx + 1; const int mn = (F.bx + (itn / (16 / ROWS)) * F.G) * 128 + (itn % (16 / ROWS)) * (NWAVES * ROWS) + F.wave * ROWS;
#pragma unroll
                for (int u = 0; u < ROWS; ++u) { const f32x4* xr = (const f32x4*)(src + (size_t)(mn + u) * DM) + lane;
#pragma unroll
                    for (int jx = 0; jx < 4; ++jx) nv[u][jx] = xr[64 * jx]; } }
        } else {
#pragma unroll
        for (int u = 0; u < ROWS; ++u) { const int m = m0 + u * mstep; const f32x4* xr = (const f32x4*)(src + (size_t)(m < MTOK ? m : m0) * DM) + lane;
#pragma unroll
            for (int jx = 0; jx < 4; ++jx) v[u][jx] = xr[64 * jx]; }
        }
#pragma unroll
        for (int u = 0; u < ROWS; ++u) { float s = 0.f;
#pragma unroll
            for (int jx = 0; jx < 4; ++jx) s += (v[u][jx].x * v[u][jx].x + v[u][jx].y * v[u][jx].y) + (v[u][jx].z * v[u][jx].z + v[u][jx].w * v[u][jx].w);
            ss[u] = s; }
#pragma unroll
        for (int o = 1; o < 64; o <<= 1) {
#pragma unroll
            for (int u = 0; u < ROWS; ++u) ss[u] += __builtin_bit_cast(float, __builtin_amdgcn_ds_bpermute((lane ^ o) << 2, __builtin_bit_cast(int, ss[u]))); }
        float lgall[MODE == 1 ? ROWS : 1][8];
        if (MODE == 1) {
            float rs[ROWS];
#pragma unroll
            for (int u = 0; u < ROWS; ++u) { rs[u] = 1.0f / sqrtf(ss[u] * (1.f / DM) + EPS);
#pragma unroll
                for (int e = 0; e < 8; ++e) lgall[u][e] = 0.f; }
#pragma unroll
            for (int jx = 0; jx < 4; ++jx) { const f32x4 gl = *(const LAS f32x4*)(F.lds + RING_OFF + 32768 + 16 * (lane + 64 * jx));
#pragma unroll
                for (int u = 0; u < ROWS; ++u) v[u][jx] = v[u][jx] * rs[u] * gl; }
#pragma unroll
            for (int jx = 0; jx < 4; ++jx) { const LAS f32x4* wr = (const LAS f32x4*)(F.lds + RING_OFF + jx * 8192 + lane * 16);
#pragma unroll
                for (int r = 0; r < 4; ++r) { const f32x4 a = wr[128 * r], b = wr[128 * r + 64];
#pragma unroll
                    for (int u = 0; u < ROWS; ++u) { const float xv = v[u][jx][r];
                        lgall[u][0] += xv * a.x; lgall[u][1] += xv * a.y; lgall[u][2] += xv * a.z; lgall[u][3] += xv * a.w; lgall[u][4] += xv * b.x; lgall[u][5] += xv * b.y; lgall[u][6] += xv * b.z; lgall[u][7] += xv * b.w; } } }
        }
#pragma unroll
        for (int u = 0; u < ROWS; ++u) { const int m = m0 + u * mstep; if (m >= MTOK) continue;
            const float rstd = 1.0f / sqrtf(ss[u] * (1.f / DM) + EPS);
            if (MODE != 1) {
#pragma unroll
            for (int jx = 0; jx < 4; ++jx) v[u][jx] = v[u][jx] * rstd * gv[jx]; }
            if (MODE == 2) {
                f32x4* o = (f32x4*)(F.out + (size_t)m * DM) + lane;
#pragma unroll
                for (int jx = 0; jx < 4; ++jx) o[64 * jx] = v[u][jx];
            } else {
                unsigned long long* o8 = (unsigned long long*)(WSP(bf16, WS_HN) + (size_t)m * DM) + lane;
#pragma unroll
                for (int jx = 0; jx < 4; ++jx) { f32x4 w = v[u][jx];
                    if (tiled) { *(unsigned long long*)(WSP(bf16, WS_HN) + toff(m, 4 * lane + 256 * jx, DM)) = (unsigned long long)pk2(w.x, w.y) | ((unsigned long long)pk2(w.z, w.w) << 32); continue; } if (q8s > 0.f) { w.x = q8r(w.x, q8s); w.y = q8r(w.y, q8s); w.z = q8r(w.z, q8s); w.w = q8r(w.w, q8s); }
                    o8[64 * jx] = (unsigned long long)pk2(w.x, w.y) | ((unsigned long long)pk2(w.z, w.w) << 32); }
            }
            if (MODE == 1) {
                float lg[8];
#pragma unroll
                for (int e = 0; e < 8; ++e) lg[e] = lgall[u][e];
                float h4[4], h2[2], h1;
                { const bool up = lane & 1;
#pragma unroll
                  for (int i = 0; i < 4; ++i) { const float keep = up ? lg[4 + i] : lg[i], send = up ? lg[i] : lg[4 + i]; h4[i] = keep + __builtin_bit_cast(float, bperm(lane ^ 1, __builtin_bit_cast(int, send))); } }
                { const bool up = lane & 2;
#pragma unroll
                  for (int i = 0; i < 2; ++i) { const float keep = up ? h4[2 + i] : h4[i], send = up ? h4[i] : h4[2 + i]; h2[i] = keep + __builtin_bit_cast(float, bperm(lane ^ 2, __builtin_bit_cast(int, send))); } }
                { const bool up = lane & 4; const float keep = up ? h2[1] : h2[0], send = up ? h2[0] : h2[1]; h1 = keep + __builtin_bit_cast(float, bperm(lane ^ 4, __builtin_bit_cast(int, send))); }
                h1 += __builtin_bit_cast(float, bperm(lane ^ 8, __builtin_bit_cast(int, h1))); h1 += __builtin_bit_cast(float, bperm(lane ^ 16, __builtin_bit_cast(int, h1))); h1 += __builtin_bit_cast(float, bperm(lane ^ 32, __builtin_bit_cast(int, h1)));
                lg[0] = rdlane(h1, 0); lg[1] = rdlane(h1, 4); lg[2] = rdlane(h1, 2); lg[3] = rdlane(h1, 6); lg[4] = rdlane(h1, 1); lg[5] = rdlane(h1, 5); lg[6] = rdlane(h1, 3); lg[7] = rdlane(h1, 7);
                int e0 = 0; float v0 = lg[0];
#pragma unroll
                for (int e = 1; e < 8; ++e) if (lg[e] > v0) { v0 = lg[e]; e0 = e; }
                int e1 = -1; float v1 = -INFINITY;
#pragma unroll
                for (int e = 0; e < 8; ++e) if (e != e0 && lg[e] > v1) { v1 = lg[e]; e1 = e; }
                const float w0 = 1.0f / (1.0f + fexp(v1 - v0)), w1 = 1.0f - w0;
                if (lane == 0) { WSP(v4i, WS_ROUTE)[m] = (v4i){e0, e1, __builtin_bit_cast(int, w0), __builtin_bit_cast(int, w1)};
                    __hip_atomic_fetch_add(&hist[e0], 1, __ATOMIC_RELAXED, __HIP_MEMORY_SCOPE_WORKGROUP); __hip_atomic_fetch_add(&hist[8 + e1], 1, __ATOMIC_RELAXED, __HIP_MEMORY_SCOPE_WORKGROUP); }
            }
        }
        if (MODE == 1 && (itx % (16 / ROWS)) == 16 / ROWS - 1) {
            __syncthreads();
            if (F.tid < 16) { WSP(int, WS_CNT128)[(size_t)chk * 16 + F.tid] = hist[F.tid]; hist[F.tid] = 0; }
            __syncthreads();
        }
    }
}

__device__ __forceinline__ void p_prep(Frame& F) {
    const int gw = F.vcu * NWAVES + F.wave, NGW = F.G * NWAVES, lane = F.lane;
    bf16* P1 = WSP(bf16, WS_P1); bf16* KVC = WSP(bf16, WS_KVC); const float* rope = WSP(float, WS_ROPE);
    const int vec = lane >> 3, ri = lane & 7; const int cb = vec < 4 ? C_CQ + vec * 64 : (vec == 4 ? C_KCMP : (vec == 5 ? C_KSLC : C_KWIN));
    for (int row0 = gw; row0 < MC; row0 += 4 * NGW) {
        float x1[4], x2[4], cc[4], ss[4]; bf16 kc48[4], vc64[4];
#pragma unroll
        for (int k = 0; k < 4; ++k) { const int row = row0 + k * NGW < MC ? row0 + k * NGW : row0; const bf16* p = P1 + (size_t)row * P1W; const int pos = row & (SEQ - 1);
            const int cl = lane < 56 ? cb + ri : C_CQ;
            x1[k] = bf1(p[cl]); x2[k] = bf1(p[cl + 8]); cc[k] = rope[pos * 8 + ri]; ss[k] = rope[SEQ * 8 + pos * 8 + ri];
            if (F.rep) { cc[k] = 1.f; ss[k] = 0.f; }
            kc48[k] = p[C_KCMP + 16 + (lane < 48 ? lane : 0)]; vc64[k] = p[C_VCMP + lane]; }
#pragma unroll
        for (int k = 0; k < 4; ++k) { const int row = row0 + k * NGW; if (row >= MC) continue; bf16* p = P1 + (size_t)row * P1W;
            if (lane < 56) { const bf16 o1 = (bf16)f2bf(x1[k] * cc[k] - x2[k] * ss[k]), o2 = (bf16)f2bf(x2[k] * cc[k] + x1[k] * ss[k]);
                p[cb + ri] = o1; p[cb + ri + 8] = o2;
                if (vec == 4) { KVC[(size_t)row * 64 + ri] = o1; KVC[(size_t)row * 64 + ri + 8] = o2; } }
            if (lane < 48) KVC[(size_t)row * 64 + 16 + lane] = kc48[k];
            KVC[(size_t)MC * 64 + (size_t)row * 64 + lane] = vc64[k]; }
    }
    bf16* VT = WSP(bf16, WS_VT);
    for (int it = gw; it < 6 * BC * 64; it += NGW) { const int which = it / (BC * 64), r = it % (BC * 64), b = r >> 6, blk = r & 63;
        const v4u* src = (const v4u*)(P1 + ((size_t)b * SEQ + blk * 64 + lane) * P1W + (which == 0 ? C_VSLC : (which == 1 ? C_VWIN : C_SBV + (which - 2) * 64)));
        bf16* dst = VT + ((size_t)(which * BC + b) * 64) * SEQ + blk * 64 + lane;
        v4u xs[8];
#pragma unroll
        for (int i = 0; i < 8; ++i) xs[i] = src[i];
#pragma unroll
        for (int i = 0; i < 8; ++i) { const v4u x = xs[i];
            dst[(size_t)(8 * i + 0) * SEQ] = (bf16)(x.x & 0xffffu); dst[(size_t)(8 * i + 1) * SEQ] = (bf16)(x.x >> 16);
            dst[(size_t)(8 * i + 2) * SEQ] = (bf16)(x.y & 0xffffu); dst[(size_t)(8 * i + 3) * SEQ] = (bf16)(x.y >> 16);
            dst[(size_t)(8 * i + 4) * SEQ] = (bf16)(x.z & 0xffffu); dst[(size_t)(8 * i + 5) * SEQ] = (bf16)(x.z >> 16);
            dst[(size_t)(8 * i + 6) * SEQ] = (bf16)(x.w & 0xffffu); dst[(size_t)(8 * i + 7) * SEQ] = (bf16)(x.w >> 16); }
    }
}
__device__ __forceinline__ void p_sgu(Frame& F, int layer) {
    LAS float* vn = (LAS float*)(F.lds + RING_OFF);
    const bf16* P1 = WSP(bf16, WS_P1); bf16* Ya = WSP(bf16, WS_Y);
    const float* gain = F.in[3] + (size_t)layer * 256; const float* sw = F.in[4] + (size_t)layer * 4 * 128 * 128; const float* sb = F.in[5] + (size_t)layer * 4 * 128;
    const int lane = F.lane, wave = F.wave;
    for (int item = F.vcu; item < MC / 128; item += F.G) {
        const size_t r0 = (size_t)item * 128;
        __syncthreads();
        for (int rr = 0; rr < 16; ++rr) { const int r = wave * 16 + rr; const v2u raw = *(const v2u*)(P1 + (r0 + r) * P1W + C_V + 4 * lane);
            const float a = bflo(raw.x), b = bfhi(raw.x), c = bflo(raw.y), d = bfhi(raw.y);
            const float rstd = 1.0f / sqrtf(wave_sum((a * a + b * b) + (c * c + d * d), lane) * (1.f / 256.f) + EPS);
            const f32x4 gg = ((const f32x4*)gain)[lane];
            *(LAS f32x4*)(vn + r * 256 + 4 * lane) = (f32x4){a * rstd * gg.x, b * rstd * gg.y, c * rstd * gg.z, d * rstd * gg.w}; }
        __syncthreads();
        const int g = wave & 3, half = wave >> 2;
        for (int i = 0; i < 64; ++i) { const int t = 2 * i + half;
            const float* wrow = sw + ((size_t)g * 128 + t) * 128;
            const float w_lo = wrow[lane], w_hi = wrow[64 + lane];
            float acc = 0.f;
            for (int s = 0; s <= t; ++s) { const float w = (s < 64) ? rdlane(w_lo, s) : rdlane(w_hi, s - 64); acc += w * vn[s * 256 + g * 64 + lane]; }
            const float u = bf1(P1[(r0 + t) * P1W + C_U + g * 64 + lane]);
#ifdef ABL_SGUMIX
            acc = 0.f;
#endif
            Ya[(r0 + t) * 256 + g * 64 + lane] = (bf16)f2bf(u * (acc + sb[g * 128 + t])); }
    }
    __syncthreads();
}

__device__ __forceinline__ void p_cmpfin(Frame& F, int layer) {
    const int gw = F.vcu * NWAVES + F.wave, NGW = F.G * NWAVES, lane = F.lane;
    const float* UL = WSP(float, WS_UL); const float* bias = WSP(float, WS_BIAS1); bf16* KC = WSP(bf16, WS_KC);
    LAS float* w2l = (LAS float*)(F.lds + RING_OFF);
    __syncthreads();
    { const f32x4* src = (const f32x4*)(F.in[8] + (size_t)layer * 2 * 256 * 64);
#pragma unroll 4
      for (int i = F.tid; i < 2 * 256 * 64 / 4; i += NWAVES * 64) *(LAS f32x4*)(w2l + 4 * i) = src[i]; }
    __syncthreads();
    for (int it = gw; it < 2 * BC * 255; it += NGW) { const int kv = it / (BC * 255), r = it % (BC * 255), b = r / 255, m = r % 255;
        const LAS float* w2 = w2l + kv * 256 * 64;
        const float* U = UL + (size_t)(kv * 2048 + b * 256 + m) * 512; const float* L = U + 512 + 256;
        float hv[4];
#pragma unroll
        for (int q = 0; q < 4; ++q) hv[q] = pg8::gelu_tanh(U[64 * q + lane] + L[64 * q + lane] + bias[kv * 256 + 64 * q + lane]);
        float acc0 = 0.f, acc1 = 0.f;
#pragma unroll
        for (int q = 0; q < 4; ++q)
#pragma unroll 8
            for (int jj = 0; jj < 64; jj += 2) { acc0 += rdlane(hv[q], jj) * w2[(64 * q + jj) * 64 + lane]; acc1 += rdlane(hv[q], jj + 1) * w2[(64 * q + jj + 1) * 64 + lane]; }
        const float acc = acc0 + acc1;
        KC[((size_t)(kv * BC + b) * 256 + m) * 64 + lane] = (bf16)f2bf(acc);
        if (kv == 1) { WSP(bf16, WS_KCT)[((size_t)b * 64 + lane) * 256 + m] = (bf16)f2bf(acc); if (m == 254) WSP(bf16, WS_KCT)[((size_t)b * 64 + lane) * 256 + 255] = (bf16)0; }
        else if (m == 254) KC[((size_t)b * 256 + 255) * 64 + lane] = (bf16)0; }
    __syncthreads();
}

__device__ __forceinline__ void p_stick(Frame& F) {
    const int gw = F.vcu * NWAVES + F.wave, NGW = F.G * NWAVES, lane = F.lane;
    const bf16* P1 = WSP(bf16, WS_P1); bf16* Yb = WSP(bf16, WS_Y) + (size_t)MC * 256;
    for (int item = gw; item < BC * 4 * 64; item += NGW) { const int tb = item & 63, h = (item >> 6) & 3, b = item >> 8;
        const int t = tb * 64 + lane; const size_t row = (size_t)b * SEQ + t;
        unsigned q[32];
        { const v4u* qp = (const v4u*)(P1 + row * P1W + C_SBQ + h * 64);
#pragma unroll
          for (int i = 0; i < 8; ++i) { const v4u x = qp[i]; q[4 * i] = x.x; q[4 * i + 1] = x.y; q[4 * i + 2] = x.z; q[4 * i + 3] = x.w; } }
        float o[64];
#pragma unroll
        for (int d = 0; d < 64; ++d) o[d] = 0.f;
        float R = 0.f;
        const bf16* kb = P1 + (size_t)b * SEQ * P1W + C_SBK + h * 64; const bf16* vb = P1 + (size_t)b * SEQ * P1W + C_SBV + h * 64;
        for (int s = t - 1; s >= 0; --s) {
            if (R < -100.f) break;
            const v4u* kp = (const v4u*)(kb + (size_t)s * P1W); const v4u* vp = (const v4u*)(vb + (size_t)s * P1W);
            float z0 = 0.f, z1 = 0.f;
#pragma unroll
            for (int i = 0; i < 8; ++i) { const v4u k = kp[i]; z0 = dot2bf(k.x, q[4 * i], z0); z1 = dot2bf(k.y, q[4 * i + 1], z1); z0 = dot2bf(k.z, q[4 * i + 2], z0); z1 = dot2bf(k.w, q[4 * i + 3], z1); }
            const float z = (z0 + z1) * 0.125f;
            const float tt = 0.6931471805599453f * __builtin_amdgcn_logf(1.0f + fexp(-__builtin_fabsf(z)));
            const float lb = fminf(z, 0.f) - tt, l1m = fminf(-z, 0.f) - tt;
            const float a = fexp(lb + R); R += l1m;
#pragma unroll
            for (int i = 0; i < 8; ++i) { const v4u v = vp[i];
                o[8 * i] += a * bflo(v.x); o[8 * i + 1] += a * bfhi(v.x); o[8 * i + 2] += a * bflo(v.y); o[8 * i + 3] += a * bfhi(v.y);
                o[8 * i + 4] += a * bflo(v.z); o[8 * i + 5] += a * bfhi(v.z); o[8 * i + 6] += a * bflo(v.w); o[8 * i + 7] += a * bfhi(v.w); }
        }
        v4u* op = (v4u*)(Yb + row * 256 + h * 64);
#pragma unroll
        for (int i = 0; i < 8; ++i) op[i] = (v4u){pk2(o[8 * i], o[8 * i + 1]), pk2(o[8 * i + 2], o[8 * i + 3]), pk2(o[8 * i + 4], o[8 * i + 5]), pk2(o[8 * i + 6], o[8 * i + 7])};
    }
}

struct Soft { float mx, l; };
__device__ __forceinline__ float dotq(const LAS v4u* ql, const bf16* kp_) {
    const v4u* kp = (const v4u*)kp_; float z0 = 0.f, z1 = 0.f;
#pragma unroll
    for (int i = 0; i < 8; ++i) { const v4u k = kp[i]; const v4u q = ql[i]; z0 = dot2bf(k.x, q.x, z0); z1 = dot2bf(k.y, q.y, z1); z0 = dot2bf(k.z, q.z, z0); z1 = dot2bf(k.w, q.w, z1); }
    return (z0 + z1) * 0.125f;
}
__device__ __forceinline__ void axpy_row(float p, const bf16* vp_, float (&o)[64]) {
    const v4u* vp = (const v4u*)vp_;
#pragma unroll
    for (int i = 0; i < 8; ++i) { const v4u v = vp[i];
        o[8 * i] += p * bflo(v.x); o[8 * i + 1] += p * bfhi(v.x); o[8 * i + 2] += p * bflo(v.y); o[8 * i + 3] += p * bfhi(v.y);
        o[8 * i + 4] += p * bflo(v.z); o[8 * i + 5] += p * bfhi(v.z); o[8 * i + 6] += p * bflo(v.w); o[8 * i + 7] += p * bfhi(v.w); }
}
__device__ __forceinline__ void nsa_step(const LAS v4u* ql, const bf16* kp_, const bf16* vp_, Soft& S, float (&o)[64]) {
    const float s = dotq(ql, kp_);
    if (s > S.mx) { const float sc = fexp(S.mx - s); S.l *= sc;
#pragma unroll
        for (int d = 0; d < 64; ++d) o[d] *= sc;
        S.mx = s; }
    const float p = fexp(s - S.mx); S.l += p;
    asm volatile("" ::: "memory");
    axpy_row(p, vp_, o);
}
__device__ __forceinline__ void nsa_accum(bf16* yrow, bool first, float sc, const float (&o)[64]) {
    v4u* op = (v4u*)yrow;
#pragma unroll
    for (int i = 0; i < 8; ++i) { v4u old = (v4u){0u, 0u, 0u, 0u}; if (!first) old = op[i];
        op[i] = (v4u){pk2(bflo(old.x) + sc * o[8 * i], bfhi(old.x) + sc * o[8 * i + 1]), pk2(bflo(old.y) + sc * o[8 * i + 2], bfhi(old.y) + sc * o[8 * i + 3]),
                      pk2(bflo(old.z) + sc * o[8 * i + 4], bfhi(old.z) + sc * o[8 * i + 5]), pk2(bflo(old.w) + sc * o[8 * i + 6], bfhi(old.w) + sc * o[8 * i + 7])}; }
}
__device__ __forceinline__ void p_nsa(Frame& F) {
    const int gw = F.vcu * NWAVES + F.wave, NGW = F.G * NWAVES, lane = F.lane;
    const bf16* P1 = WSP(bf16, WS_P1); const bf16* KC = WSP(bf16, WS_KC); bf16* Yc = WSP(bf16, WS_Y) + (size_t)2 * MC * 256;
    LAS float* imp = (LAS float*)(F.lds + RING_OFF + F.wave * 4096);
    LAS v4u* ql = (LAS v4u*)(F.lds + RING_OFF + 32768 + F.wave * 9216 + lane * 144);
    const int qi = lane >> 2, h = lane & 3;
    for (int item = gw; item < BC * 256; item += NGW) { const int b = item >> 8, tg = item & 255;
        const int t = tg * 16 + qi; const size_t row = (size_t)b * SEQ + t; const bf16* prow = P1 + row * P1W;
        { const v4u* qp = (const v4u*)(prow + C_CQ + h * 64);
#pragma unroll
          for (int i = 0; i < 8; ++i) ql[i] = qp[i]; }
        const float g0 = bf1(prow[C_CG + h * 3]), g1 = bf1(prow[C_CG + h * 3 + 1]), g2 = bf1(prow[C_CG + h * 3 + 2]);
        bf16* yrow = Yc + row * 256 + h * 64;
        float o[64];
        for (int i = lane; i < 1024; i += 64) imp[i] = 0.f;
        const int nv = t >= 31 ? ((t - 31) >> 4) + 1 : 0; const int nvmax = (tg * 16 + 15 >= 31) ? ((tg * 16 + 15 - 31) >> 4) + 1 : 0;
        const bf16* kc = KC + (size_t)(0 * BC + b) * 256 * 64; const bf16* vc = KC + (size_t)(1 * BC + b) * 256 * 64;
        { float mx = -INFINITY, l = 0.f;
          for (int m = 0; m < nvmax; ++m) { const float s = dotq(ql, kc + m * 64); if (m < nv) { if (s > mx) { l *= fexp(mx - s); mx = s; } l += fexp(s - mx); } }
          const float rl = l > 0.f ? 1.0f / l : 0.f;
#pragma unroll
          for (int d = 0; d < 64; ++d) o[d] = 0.f;
          for (int m = 0; m < nvmax; ++m) { const float s = dotq(ql, kc + m * 64); const float p = (m < nv) ? fexp(s - mx) * rl : 0.f;
              asm volatile("" ::: "memory");
              axpy_row(p, vc + m * 64, o);
              float P = p + __builtin_bit_cast(float, bperm(lane ^ 1, __builtin_bit_cast(int, p))); P += __builtin_bit_cast(float, bperm(lane ^ 2, __builtin_bit_cast(int, P)));
              if (h == 0) { const int j0 = m >> 2; const bool edge = (m & 3) == 3; imp[qi * 64 + j0] += edge ? 0.5f * P : P; if (edge) imp[qi * 64 + j0 + 1] += 0.5f * P; } }
          nsa_accum(yrow, true, g0, o); }
        unsigned long long mask = 0ull;
        { const int cur = t >> 6, nvb = cur + 1;
          if (h == 0) {
              if (nvb <= 16) mask = (1ull << nvb) - 1ull;
              else { mask = 1ull | (1ull << cur);
                  for (int r = 0; r < 14; ++r) { int best = -1; float bv = -1.f;
                      for (int j = 1; j < cur; ++j) { const float v = imp[qi * 64 + j]; if (!((mask >> j) & 1ull) && v > bv) { bv = v; best = j; } }
                      mask |= 1ull << best; } } }
          const unsigned mlo = (unsigned)bperm(lane & ~3, (int)(unsigned)mask), mhi = (unsigned)bperm(lane & ~3, (int)(unsigned)(mask >> 32));
          mask = ((unsigned long long)mhi << 32) | mlo; }
        { Soft S{-INFINITY, 0.f};
#pragma unroll
          for (int d = 0; d < 64; ++d) o[d] = 0.f;
          const bf16* kb = P1 + (size_t)b * SEQ * P1W + C_KSLC; const bf16* vb = P1 + (size_t)b * SEQ * P1W + C_VSLC;
          unsigned long long mm = mask;
          while (mm) { const int j = __builtin_ctzll(mm); mm &= mm - 1ull;
              for (int kk = 0; kk < 64; ++kk) { const int sp = j * 64 + kk; if (sp > t) break; nsa_step(ql, kb + (size_t)sp * P1W, vb + (size_t)sp * P1W, S, o); } }
          nsa_accum(yrow, false, g1 / S.l, o); }
        { Soft S{-INFINITY, 0.f};
#pragma unroll
          for (int d = 0; d < 64; ++d) o[d] = 0.f;
          const bf16* kb = P1 + (size_t)b * SEQ * P1W + C_KWIN; const bf16* vb = P1 + (size_t)b * SEQ * P1W + C_VWIN;
          for (int i = 0; i < 512; ++i) { const int sp = t - 511 + i; if (sp >= 0) nsa_step(ql, kb + (size_t)sp * P1W, vb + (size_t)sp * P1W, S, o); }
          nsa_accum(yrow, false, g2 / S.l, o); }
    }
}

__device__ __forceinline__ int moe_table(Frame& F, int jmoe, int c, int r, int kpre = 0) {
    LAS int* tab = (LAS int*)(F.lds + TAB_OFF); LAS int* arr = (LAS int*)(F.lds + LDSCTL_OFF + 4096);
    (void)jmoe;
    __syncthreads();
    if (F.tid < 256) { const v4i* s = (const v4i*)(WSP(int, WS_CNT128) + ((size_t)(c * 256 + F.tid) * 2 + r) * 8); const v4i a = s[0], b = s[1];
        *(LAS v4i*)(arr + F.tid * 8) = a; *(LAS v4i*)(arr + F.tid * 8 + 4) = b; }
    __syncthreads();
    if (F.tid < 8) { int tot = 0, pre = 0;
        for (int k = 0; k < 256; ++k) { const int x = arr[k * 8 + F.tid]; pre += (k < kpre) ? x : 0; tot += x; }
        tab[176 + F.tid] = tot; tab[184 + F.tid] = pre; }
    __syncthreads();
    if (F.tid == 0) { int base = 0, T = 0;
        for (int e = 0; e < 8; ++e) { const int cnt = tab[176 + e];
            const int nt = (cnt + 255) >> 8; tab[160 + e] = base; for (int i = 0; i < nt && T + i < 160; ++i) tab[T + i] = e; T += nt; base += nt * 256; }
        tab[168] = T < 136 ? T : 136; }
    __syncthreads();
    return tab[168];
}
__device__ __forceinline__ void p_gather(Frame& F, int jmoe, int c, int r, int nbusy = 0) {
    if (F.bx < nbusy) return;
    LAS int* tab = (LAS int*)(F.lds + TAB_OFF); LAS int* cntw = tab + 256; LAS int* basew = tab + 320;
    const int lane = F.lane, wave = F.wave;
    const v4i* route = WSP(v4i, WS_ROUTE); int* tokmap = WSP(int, WS_TOKMAP) + (c * 2 + r) * SLOTS; float* wslot = WSP(float, WS_WSLOT) + (c * 2 + r) * SLOTS;
    const bf16* HN = WSP(bf16, WS_HN); bf16* XG = WSP(bf16, WS_XG);
    for (int ch = F.bx - nbusy; ch < MC / 128; ch += F.G - nbusy) {
        moe_table(F, jmoe, c, r, ch);
        const int m = c * MC + ch * 128 + wave * 16 + (lane & 15); const v4i rt = route[m];
        const int e = lane < 16 ? (r ? rt.y : rt.x) : -1; const float w = __builtin_bit_cast(float, r ? rt.w : rt.z);
        unsigned long long bal[8]; int mycnt = 0;
#pragma unroll
        for (int ee = 0; ee < 8; ++ee) { bal[ee] = __builtin_amdgcn_ballot_w64(e == ee); if (lane == ee) mycnt = __builtin_popcountll(bal[ee]); }
        if (lane < 8) cntw[wave * 8 + lane] = mycnt;
        __syncthreads();
        if (wave == 0 && lane < 8) { int base = tab[184 + lane];
#pragma unroll
            for (int w8 = 0; w8 < 8; ++w8) { basew[w8 * 8 + lane] = base; base += cntw[w8 * 8 + lane]; } }
        __syncthreads();
        int pos = 0;
#pragma unroll
        for (int ee = 0; ee < 8; ++ee) if (e == ee) pos = basew[wave * 8 + ee] + __builtin_popcountll(bal[ee] & ((1ull << lane) - 1ull));
        int slot = 0;
        if (lane < 16) { slot = tab[160 + e] + pos; tokmap[slot] = m; wslot[slot] = w; }
#pragma unroll
        for (int i0 = 0; i0 < 16; i0 += 4) { v4u x[8];
#pragma unroll
            for (int i = 0; i < 4; ++i) { const int mi = __builtin_amdgcn_readlane(m, i0 + i); const v4u* src = (const v4u*)(HN + (size_t)mi * DM); x[2 * i] = src[lane]; x[2 * i + 1] = src[64 + lane]; }
#pragma unroll
            for (int i = 0; i < 4; ++i) { const int si = __builtin_amdgcn_readlane(slot, i0 + i); v4u* dst = (v4u*)(XG + (size_t)si * DM); dst[lane] = x[2 * i]; dst[64 + lane] = x[2 * i + 1]; } }
    }
}

typedef float f32x16 __attribute__((ext_vector_type(16)));
typedef short bf16x8v __attribute__((ext_vector_type(8)));
typedef float f32x2v __attribute__((ext_vector_type(2)));
constexpr int NSA_K = 0, NSA_V = 8192, NSA_BUF = 17408, NSA_STAGE = 2 * NSA_BUF, NSA_IMP = 69632, NSA_CARRY = 86016, NSA_SEL = 103424, NSA_WSF = 103936;
constexpr int NSA_VP = 136;
constexpr float NSA_C2 = 0.125f * 1.4426950408889634f;
constexpr float NSA_DEFER = 8.0f / (0.125f * 1.4426950408889634f);
__device__ __forceinline__ unsigned cvtpk(float lo, float hi) { f32x2v v = {lo, hi}; bf16x2_t b = __builtin_convertvector(v, bf16x2_t); return __builtin_bit_cast(unsigned, b); }
__device__ __forceinline__ float partner32(float v, int lane) { return __builtin_bit_cast(float, __builtin_amdgcn_ds_bpermute((lane ^ 32) << 2, __builtin_bit_cast(int, v))); }
__device__ __forceinline__ void nsa_load(v4u& kx, v4u& vx, const bf16* Kg, int kp, const bf16* Vg, int vp, int tid) {
    kx = *(const v4u*)(Kg + (size_t)(tid & 63) * kp + (tid >> 6) * 8); vx = *(const v4u*)(Vg + (size_t)(tid >> 3) * vp + (tid & 7) * 8);
}
__device__ __forceinline__ void nsa_store(LAS unsigned char* lds, const v4u& kx, const v4u& vx, int tid) {
    *(LAS v4u*)(lds + NSA_K + (tid >> 6) * 1024 + (tid & 63) * 16) = kx; { LAS v2u* vd = (LAS v2u*)(lds + NSA_V + (tid >> 3) * NSA_VP + (tid & 7) * 16); vd[0] = (v2u){vx.x, vx.y}; vd[1] = (v2u){vx.z, vx.w}; }
}
__device__ __forceinline__ void nsa_qk(const LAS unsigned char* lds, const bf16x8v (&qr)[4], f32x16& p0, f32x16& p1, int r32, int hi) {
    bf16x8v kf[8];
#pragma unroll
    for (int d0 = 0; d0 < 4; ++d0) {
        kf[2 * d0] = *(const LAS bf16x8v*)(lds + NSA_K + (2 * d0 + hi) * 1024 + r32 * 16);
        kf[2 * d0 + 1] = *(const LAS bf16x8v*)(lds + NSA_K + (2 * d0 + hi) * 1024 + 512 + r32 * 16); }
    __builtin_amdgcn_sched_barrier(0);
#pragma unroll
    for (int i = 0; i < 16; ++i) { p0[i] = 0.f; p1[i] = 0.f; }
#pragma unroll
    for (int d0 = 0; d0 < 4; ++d0) {
        p0 = __builtin_amdgcn_mfma_f32_32x32x16_bf16(kf[2 * d0], qr[d0], p0, 0, 0, 0);
        p1 = __builtin_amdgcn_mfma_f32_32x32x16_bf16(kf[2 * d0 + 1], qr[d0], p1, 0, 0, 0);
    }
}
__device__ __forceinline__ void nsa_mask(f32x16& p0, f32x16& p1, int hi, int hiL, int loL) {
    const int hl = hiL - 4 * hi, ll = loL - 4 * hi;
#pragma unroll
    for (int i = 0; i < 16; ++i) { const int c = (i & 3) + 8 * (i >> 2);
        if (!(c <= hl && c > ll)) p0[i] = -INFINITY;
        if (!(c + 32 <= hl && c + 32 > ll)) p1[i] = -INFINITY; }
}
__device__ __forceinline__ float nsa_max32(const f32x16& p0, const f32x16& p1) {
    float a = fmaxf(fmaxf(p0[0], p0[1]), p1[0]), b = fmaxf(fmaxf(p0[2], p0[3]), p1[1]); a = fmaxf(fmaxf(a, p1[2]), p1[3]);
#pragma unroll
    for (int i = 4; i < 16; i += 4) { a = fmaxf(fmaxf(a, p0[i]), p0[i + 1]); b = fmaxf(fmaxf(b, p0[i + 2]), p0[i + 3]); a = fmaxf(fmaxf(a, p1[i]), p1[i + 1]); b = fmaxf(fmaxf(b, p1[i + 2]), p1[i + 3]); }
    return fmaxf(a, b);
}
__device__ __forceinline__ void nsa_vload(const LAS unsigned char* lds, v4u (&vv)[8], int r32, int hi) {
#pragma unroll
    for (int db = 0; db < 2; ++db) { const LAS unsigned char* vrow = lds + NSA_V + (32 * db + r32) * NSA_VP;
#pragma unroll
        for (int ks = 0; ks < 4; ++ks) {
            const int kb = (ks >> 1) * 32 + (ks & 1) * 16 + 4 * hi;
            const v2u lo = *(const LAS v2u*)(vrow + kb * 2), hh = *(const LAS v2u*)(vrow + (kb + 8) * 2);
            vv[4 * db + ks] = (v4u){lo.x, lo.y, hh.x, hh.y}; } }
    __builtin_amdgcn_sched_barrier(0);
}
__device__ __forceinline__ void nsa_pv(const v4u (&vv)[8], const f32x16& p0, const f32x16& p1, f32x16 (&o)[2]) {
    bf16x8v pa[4];
#pragma unroll
    for (int s = 0; s < 2; ++s) {
        const v4u a = (v4u){cvtpk(p0[8 * s], p0[8 * s + 1]), cvtpk(p0[8 * s + 2], p0[8 * s + 3]), cvtpk(p0[8 * s + 4], p0[8 * s + 5]), cvtpk(p0[8 * s + 6], p0[8 * s + 7])};
        const v4u b = (v4u){cvtpk(p1[8 * s], p1[8 * s + 1]), cvtpk(p1[8 * s + 2], p1[8 * s + 3]), cvtpk(p1[8 * s + 4], p1[8 * s + 5]), cvtpk(p1[8 * s + 6], p1[8 * s + 7])};
        pa[s] = __builtin_bit_cast(bf16x8v, a); pa[2 + s] = __builtin_bit_cast(bf16x8v, b); }
#pragma unroll
    for (int ks = 0; ks < 4; ++ks)
#pragma unroll
        for (int db = 0; db < 2; ++db) o[db] = __builtin_amdgcn_mfma_f32_32x32x16_bf16(pa[ks], __builtin_bit_cast(bf16x8v, vv[4 * db + ks]), o[db], 0, 0, 0);
}
__device__ __forceinline__ void nsa_rowscale(f32x16 (&o)[2], LAS float* wsf, float f, int r32, int hi) {
    if (hi == 0) wsf[r32] = f;
#pragma unroll
    for (int g = 0; g < 4; ++g) { const f32x4 w = *(const LAS f32x4*)(wsf + 8 * g + 4 * hi);
#pragma unroll
        for (int e = 0; e < 4; ++e) { o[0][4 * g + e] *= w[e]; o[1][4 * g + e] *= w[e]; } }
}
constexpr int NSA_ACC = 104960;
__device__ __forceinline__ void nsa_rowaccum(LAS unsigned char* acc, bool first, const f32x16 (&o)[2], LAS float* wsf, float f, int r32, int hi) {
    if (hi == 0) wsf[r32] = f;
#pragma unroll
    for (int g = 0; g < 4; ++g) { const f32x4 w = *(const LAS f32x4*)(wsf + 8 * g + 4 * hi);
#pragma unroll
        for (int e = 0; e < 4; ++e) { LAS bf16* p = (LAS bf16*)(acc + (8 * g + 4 * hi + e) * 128 + r32 * 2); const int i = 4 * g + e;
            float a = o[0][i] * w[e], b = o[1][i] * w[e];
            if (!first) { a += bf1(p[0]); b += bf1(p[32]); }
            p[0] = (bf16)f2bf(a); p[32] = (bf16)f2bf(b); } }
}
__device__ __forceinline__ void nsa_flush(const LAS unsigned char* acc, bf16* ytok  , int lane) {
    asm volatile("" ::: "memory");
#pragma unroll
    for (int ps = 0; ps < 4; ++ps) { const int row = ps * 8 + (lane >> 3), ch = lane & 7;
        const v4u v = *(const LAS v4u*)(acc + row * 128 + ch * 16);
        *(v4u*)(ytok + (size_t)(row >> 2) * 256 + (row & 3) * 64 + ch * 8) = v; }
}
__device__ __forceinline__ void nsa_softmax_pv(const LAS unsigned char* lds, f32x16& p0, f32x16& p1, float& m, float& l, f32x16 (&o)[2], LAS float* wsf, int lane, int r32, int hi, bool rowok) {
    float mt = nsa_max32(p0, p1); mt = rowok ? mt : -INFINITY; mt = fmaxf(mt, partner32(mt, lane));
    const float mn = fmaxf(m, mt);
    if (__builtin_amdgcn_ballot_w64(mn > m + NSA_DEFER) != 0ull) { const float f = __builtin_amdgcn_exp2f((m - mn) * NSA_C2); l *= f; nsa_rowscale(o, wsf, f, r32, hi); m = mn; }
    const float off = rowok ? -m * NSA_C2 : -INFINITY;
    v4u vv[8]; nsa_vload(lds, vv, r32, hi);
    float s = 0.f;
#pragma unroll
    for (int i = 0; i < 16; ++i) { p0[i] = __builtin_amdgcn_exp2f(__builtin_fmaf(p0[i], NSA_C2, off)); p1[i] = __builtin_amdgcn_exp2f(__builtin_fmaf(p1[i], NSA_C2, off)); s += p0[i] + p1[i]; }
    l += s;
    nsa_pv(vv, p0, p1, o);
}
__device__ __forceinline__ void p_nsa2(Frame& F) {
    const int tid = F.tid, lane = F.lane, wave = F.wave, r32 = lane & 31, hi = lane >> 5;
    LAS unsigned char* lds = F.lds + RING_OFF;
    LAS float* imp = (LAS float*)(lds + NSA_IMP); LAS float* carry = (LAS float*)(lds + NSA_CARRY);
    LAS unsigned long long* selm = (LAS unsigned long long*)(lds + NSA_SEL); LAS float* wsf = (LAS float*)(lds + NSA_WSF) + wave * 32;
    LAS unsigned char* acc = wave < 6 ? lds + NSA_ACC + wave * 4096 : F.lds + LDSCTL_OFF + 4096 + (wave - 6) * 4096;
    const bf16* P1 = WSP(bf16, WS_P1); const bf16* KC = WSP(bf16, WS_KC); const bf16* KCT = WSP(bf16, WS_KCT); const bf16* VT = WSP(bf16, WS_VT);
    bf16* Yc = WSP(bf16, WS_Y) + (size_t)2 * MC * 256;
    const int ql = r32 >> 2, h = r32 & 3, tq = 8 * wave + ql;
    int par = 0;
    for (int it = 0; it < 2; ++it) {
        for (int pair = F.vcu; pair < BC * 32; pair += F.G) {
            const int b = pair >> 5, sx = pair & 31, qb = it ? 63 - sx : sx;
            const int t = qb * 64 + tq; const size_t row = (size_t)b * SEQ + t; const bf16* prow = P1 + row * P1W;
            bf16x8v qr[4];
#pragma unroll
            for (int d0 = 0; d0 < 4; ++d0) qr[d0] = *(const bf16x8v*)(prow + C_CQ + h * 64 + d0 * 16 + hi * 8);
            const float g0 = bf1(prow[C_CG + h * 3]), g1 = bf1(prow[C_CG + h * 3 + 1]), g2 = bf1(prow[C_CG + h * 3 + 2]);
            f32x16 o[2], p0, p1;
            __syncthreads();
            for (int i = tid; i < 64 * 64; i += 512) imp[i] = 0.f;
            for (int i = tid; i < 64 * 68; i += 512) carry[i] = 0.f;
            const int nct = (4 * qb + 3 + 63) >> 6;
            const int mlim = t >= 31 ? ((t - 31) >> 4) : -1;
            const bf16* kcb = KC + (size_t)b * 256 * 64; const bf16* vcb = KCT + (size_t)b * 64 * 256;
            float m = -1e30f, l = 0.f;
            v4u kx, vx;
            nsa_load(kx, vx, kcb, 64, vcb, 256, tid);
            for (int ti = 0; ti < nct; ++ti) {
                LAS unsigned char* tb = lds + par * NSA_STAGE; par ^= 1;
                nsa_store(tb, kx, vx, tid); __syncthreads();
                { const int tn = ti + 1 < nct ? ti + 1 : 0; nsa_load(kx, vx, kcb + (size_t)tn * 64 * 64, 64, vcb + tn * 64, 256, tid); }
                nsa_qk(tb, qr, p0, p1, r32, hi); nsa_mask(p0, p1, hi, mlim - 64 * ti, -1);
                float mt = nsa_max32(p0, p1); mt = fmaxf(mt, partner32(mt, lane));
                const float mn = fmaxf(m, mt); l *= __builtin_amdgcn_exp2f((m - mn) * NSA_C2); m = mn;
                const float off = -m * NSA_C2; float s = 0.f;
#pragma unroll
                for (int i = 0; i < 16; ++i) s += __builtin_amdgcn_exp2f(__builtin_fmaf(p0[i], NSA_C2, off)) + __builtin_amdgcn_exp2f(__builtin_fmaf(p1[i], NSA_C2, off));
                l += s; }
            { const float lt = l + partner32(l, lane); const float rl = lt > 0.f ? 1.0f / lt : 0.f;
#pragma unroll
              for (int i = 0; i < 16; ++i) { o[0][i] = 0.f; o[1][i] = 0.f; }
              for (int ti = 0; ti < nct; ++ti) {
                  LAS unsigned char* tb = lds + par * NSA_STAGE; par ^= 1;
                  nsa_store(tb, kx, vx, tid); __syncthreads();
                  if (ti + 1 < nct) nsa_load(kx, vx, kcb + (size_t)(ti + 1) * 64 * 64, 64, vcb + (ti + 1) * 64, 256, tid);
                  nsa_qk(tb, qr, p0, p1, r32, hi); nsa_mask(p0, p1, hi, mlim - 64 * ti, -1);
                  v4u vv[8]; nsa_vload(tb, vv, r32, hi);
                  { const float off = -m * NSA_C2;
#pragma unroll
                    for (int i = 0; i < 16; ++i) { p0[i] = __builtin_amdgcn_exp2f(__builtin_fmaf(p0[i], NSA_C2, off)) * rl; p1[i] = __builtin_amdgcn_exp2f(__builtin_fmaf(p1[i], NSA_C2, off)) * rl; } }
#pragma unroll
                  for (int kt = 0; kt < 2; ++kt)
#pragma unroll
                      for (int g = 0; g < 4; ++g) { const f32x16& pp = kt ? p1 : p0;
                          float A = pp[4 * g] + pp[4 * g + 1] + pp[4 * g + 2] + 0.5f * pp[4 * g + 3], B = 0.5f * pp[4 * g + 3];
                          A += __builtin_bit_cast(float, bperm(lane ^ 1, __builtin_bit_cast(int, A))); A += __builtin_bit_cast(float, bperm(lane ^ 2, __builtin_bit_cast(int, A)));
                          B += __builtin_bit_cast(float, bperm(lane ^ 1, __builtin_bit_cast(int, B))); B += __builtin_bit_cast(float, bperm(lane ^ 2, __builtin_bit_cast(int, B)));
                          if (h == 0) { const int j = 16 * ti + 8 * kt + 2 * g + hi; imp[tq * 64 + j] = A; carry[tq * 68 + j + 1] = B; } }
                  nsa_pv(vv, p0, p1, o); }
              nsa_rowaccum(acc, true, o, wsf, g0, r32, hi); }
            __syncthreads();
            { const int q = tid >> 3, sub = tid & 7; unsigned long long mask;
              if (qb + 1 <= 16) mask = (1ull << (qb + 1)) - 1ull;
              else { mask = 1ull | (1ull << qb);
                  unsigned long long key[8];
#pragma unroll
                  for (int i = 0; i < 8; ++i) { const int j = sub * 8 + i; const float v = imp[q * 64 + j] + carry[q * 68 + j];
                      key[i] = (j >= 1 && j < qb) ? (((unsigned long long)__builtin_bit_cast(unsigned, v) << 32) | (unsigned)(63 - j)) : 0ull; }
                  for (int r = 0; r < 14; ++r) { unsigned long long best = key[0];
#pragma unroll
                      for (int i = 1; i < 8; ++i) best = key[i] > best ? key[i] : best;
#pragma unroll
                      for (int x = 1; x < 8; x <<= 1) { const unsigned lo = (unsigned)bperm(lane ^ x, (int)(unsigned)best), hh = (unsigned)bperm(lane ^ x, (int)(unsigned)(best >> 32));
                          const unsigned long long other = ((unsigned long long)hh << 32) | lo; best = other > best ? other : best; }
                      const int jb = 63 - (int)(best & 63ull); mask |= 1ull << jb;
#pragma unroll
                      for (int i = 0; i < 8; ++i) if (sub * 8 + i == jb) key[i] = 0ull; } }
              if (sub == 0) selm[q] = mask; }
            __syncthreads();
            const unsigned long long mysel = selm[tq];
#ifdef NSA_REP_SLC
            int nrep_slc; asm volatile("s_mov_b32 %0, %1" : "=s"(nrep_slc) : "i"(NSA_REP_SLC));
            for (int rep_ = 0; rep_ < nrep_slc; ++rep_)
#endif
            { const bf16* kb = P1 + (size_t)b * SEQ * P1W + C_KSLC; const bf16* vb = VT + (size_t)(0 * BC + b) * 64 * SEQ;
#ifdef NSA_REP_SLC
              if (rep_ + 1 < nrep_slc) __syncthreads();
#endif
              m = -1e30f; l = 0.f;
#pragma unroll
              for (int i = 0; i < 16; ++i) { o[0][i] = 0.f; o[1][i] = 0.f; }
              v4u kx2, vx2;
              nsa_load(kx, vx, kb, P1W, vb, SEQ, tid); if (qb >= 1) nsa_load(kx2, vx2, kb + (size_t)64 * P1W, P1W, vb + 64, SEQ, tid);
              for (int j = 0; j <= qb; j += 2) {
                  const bool two = j + 1 <= qb;
                  LAS unsigned char* tb = lds + par * NSA_STAGE; par ^= 1;
                  nsa_store(tb, kx, vx, tid); if (two) nsa_store(tb + NSA_BUF, kx2, vx2, tid);
                  __syncthreads();
                  if (j + 2 <= qb) nsa_load(kx, vx, kb + (size_t)(j + 2) * 64 * P1W, P1W, vb + (j + 2) * 64, SEQ, tid);
                  if (j + 3 <= qb) nsa_load(kx2, vx2, kb + (size_t)(j + 3) * 64 * P1W, P1W, vb + (j + 3) * 64, SEQ, tid);
                  { const bool rowsel = ((mysel >> j) & 1ull) != 0ull;
                    if (__builtin_amdgcn_ballot_w64(rowsel) != 0ull) {
                        nsa_qk(tb, qr, p0, p1, r32, hi); if (j == qb) nsa_mask(p0, p1, hi, tq, -1);
                        nsa_softmax_pv(tb, p0, p1, m, l, o, wsf, lane, r32, hi, rowsel); } }
                  if (two) { const bool rowsel = ((mysel >> (j + 1)) & 1ull) != 0ull;
                    if (__builtin_amdgcn_ballot_w64(rowsel) != 0ull) {
                        nsa_qk(tb + NSA_BUF, qr, p0, p1, r32, hi); if (j + 1 == qb) nsa_mask(p0, p1, hi, tq, -1);
                        nsa_softmax_pv(tb + NSA_BUF, p0, p1, m, l, o, wsf, lane, r32, hi, rowsel); } } }
              const float lt = l + partner32(l, lane);
#ifdef NSA_REP_SLC
              if (rep_ + 1 == nrep_slc)
#endif
              nsa_rowaccum(acc, false, o, wsf, lt > 0.f ? g1 / lt : 0.f, r32, hi); }
#ifdef NSA_REP_WIN
            int nrep_win; asm volatile("s_mov_b32 %0, %1" : "=s"(nrep_win) : "i"(NSA_REP_WIN));
            for (int rep_ = 0; rep_ < nrep_win; ++rep_)
#endif
            { const bf16* kb = P1 + (size_t)b * SEQ * P1W + C_KWIN; const bf16* vb = VT + (size_t)(1 * BC + b) * 64 * SEQ;
              m = -1e30f; l = 0.f;
#pragma unroll
              for (int i = 0; i < 16; ++i) { o[0][i] = 0.f; o[1][i] = 0.f; }
              const int j0 = qb >= 8 ? qb - 8 : 0;
              nsa_load(kx, vx, kb + (size_t)j0 * 64 * P1W, P1W, vb + j0 * 64, SEQ, tid);
              for (int j = j0; j <= qb; ++j) {
                  LAS unsigned char* tb = lds + par * NSA_STAGE; par ^= 1;
                  nsa_store(tb, kx, vx, tid); __syncthreads();
                  if (j < qb) nsa_load(kx, vx, kb + (size_t)(j + 1) * 64 * P1W, P1W, vb + (j + 1) * 64, SEQ, tid);
                  nsa_qk(tb, qr, p0, p1, r32, hi); if (j == qb || j == qb - 8) nsa_mask(p0, p1, hi, j == qb ? tq : 63, j == qb - 8 ? tq : -1);
                  nsa_softmax_pv(tb, p0, p1, m, l, o, wsf, lane, r32, hi, true); }
              const float lt = l + partner32(l, lane);
#ifdef NSA_REP_WIN
              if (rep_ + 1 == nrep_win) {
#endif
              nsa_rowaccum(acc, false, o, wsf, lt > 0.f ? g2 / lt : 0.f, r32, hi);
              nsa_flush(acc, Yc + ((size_t)b * SEQ + qb * 64 + 8 * wave) * 256, lane);
#ifdef NSA_REP_WIN
              }
#endif
            }
        }
    }
    __syncthreads();
}

constexpr int SB_HEAD_LDS = 17408;
constexpr int SB_FLAG = 4 * SB_HEAD_LDS;
constexpr float SB_LOG2E = 1.4426950408889634f, SB_STOP = -100.0f * 1.4426950408889634f;
__device__ __forceinline__ void p_stick2(Frame& F, int nbusy) {
    const int tid = F.tid, lane = F.lane, wave = F.wave, r32 = lane & 31, hi = lane >> 5, h = wave & 3, qh = wave >> 2;
    LAS unsigned char* lds = F.lds + RING_OFF; LAS unsigned char* hl = lds + h * SB_HEAD_LDS; LAS int* flag = (LAS int*)(lds + SB_FLAG);
    const bf16* P1 = WSP(bf16, WS_P1); const bf16* VT = WSP(bf16, WS_VT) + (size_t)2 * BC * 64 * SEQ;
    bf16* Yb = WSP(bf16, WS_Y) + (size_t)MC * 256;
    const int tq = 32 * qh + r32;
    if (F.bx >= nbusy)
        for (int item = F.bx - nbusy; item < BC * 64; item += F.G - nbusy) {
            const int b = item >> 6, qb = item & 63;
            const size_t row = (size_t)b * SEQ + qb * 64 + tq;
            bf16x8v qr[4];
#pragma unroll
            for (int d0 = 0; d0 < 4; ++d0) qr[d0] = *(const bf16x8v*)(P1 + row * P1W + C_SBQ + h * 64 + d0 * 16 + hi * 8);
            f32x16 o[2], p0, p1;
#pragma unroll
            for (int i = 0; i < 16; ++i) { o[0][i] = 0.f; o[1][i] = 0.f; }
            float R = 0.f;
            const int skey = tid & 63, sc = tid >> 6, sd = tid >> 3, skc = tid & 7;
            v4u kx[4], vx[4];
#define SB_LOAD(jj) do { const bf16* kg_ = P1 + ((size_t)b * SEQ + (jj) * 64 + skey) * P1W + C_SBK + sc * 8; \
                _Pragma("unroll") for (int hh = 0; hh < 4; ++hh) { kx[hh] = *(const v4u*)(kg_ + hh * 64); vx[hh] = *(const v4u*)(VT + ((size_t)(hh * BC + b) * 64 + sd) * SEQ + (jj) * 64 + skc * 8); } } while (0)
            SB_LOAD(qb);
            for (int j = qb; j >= 0; --j) {
                __syncthreads();
                if (j < qb) { int live = 0;
#pragma unroll
                    for (int w = 0; w < 8; ++w) live |= flag[w];
                    if (!live) break; }
#pragma unroll
                for (int hh = 0; hh < 4; ++hh) { *(LAS v4u*)(lds + hh * SB_HEAD_LDS + sc * 1024 + skey * 16) = kx[hh]; { LAS v2u* vd = (LAS v2u*)(lds + hh * SB_HEAD_LDS + NSA_V + sd * NSA_VP + skc * 16); vd[0] = (v2u){vx[hh].x, vx[hh].y}; vd[1] = (v2u){vx[hh].z, vx[hh].w}; } }
                __syncthreads();
                if (j > 0) SB_LOAD(j - 1);
                nsa_qk(hl, qr, p0, p1, r32, hi);
#pragma unroll
                for (int i = 0; i < 16; ++i) { p0[i] *= NSA_C2; p1[i] *= NSA_C2; }
                v4u vv[8]; nsa_vload(hl, vv, r32, hi);
                const int lim = ((j == qb) ? tq : 64) - 4 * hi;
                float Town[8], Tp[8];
#pragma unroll
                for (int kt = 0; kt < 2; ++kt) { f32x16& pp = kt ? p1 : p0;
#pragma unroll
                    for (int g = 0; g < 4; ++g) { float L[4];
#pragma unroll
                        for (int e = 0; e < 4; ++e) { const int kk = 32 * kt + 8 * g + e; const float z = pp[4 * g + e];
                            const float tt = __builtin_amdgcn_logf(1.0f + __builtin_amdgcn_exp2f(-__builtin_fabsf(z)));
                            const float lb = fminf(z, 0.f) - tt; const bool ok = kk < lim;
                            L[e] = ok ? lb - z : 0.f; pp[4 * g + e] = ok ? lb : -INFINITY; }
                        const float E2 = L[3], E1 = E2 + L[2], E0 = E1 + L[1];
                        pp[4 * g + 2] += E2; pp[4 * g + 1] += E1; pp[4 * g] += E0;
                        Town[4 * kt + g] = E0 + L[0]; } }
#pragma unroll
                for (int k = 0; k < 8; ++k) Tp[k] = partner32(Town[k], lane);
                float suf = R;
#pragma unroll
                for (int k = 7; k >= 0; --k) { const float add = suf + (hi == 0 ? Tp[k] : 0.f); f32x16& pp = (k >> 2) ? p1 : p0; const int g = k & 3;
#pragma unroll
                    for (int e = 0; e < 4; ++e) pp[4 * g + e] = __builtin_amdgcn_exp2f(pp[4 * g + e] + add);
                    suf += Town[k] + Tp[k]; }
                R = suf;
                nsa_pv(vv, p0, p1, o);
                const bool alive = R >= SB_STOP;
                const unsigned long long bal = __builtin_amdgcn_ballot_w64(alive);
                if (lane == 0) flag[wave] = bal != 0ull ? 1 : 0;
            }
            { bf16* dst = Yb + ((size_t)b * SEQ + qb * 64 + 32 * qh + 4 * hi) * 256 + h * 64 + r32;
#pragma unroll
              for (int i = 0; i < 16; ++i) { dst[((i & 3) + 8 * (i >> 2)) * 256] = (bf16)f2bf(o[0][i]); dst[((i & 3) + 8 * (i >> 2)) * 256 + 32] = (bf16)f2bf(o[1][i]); } }
        }
#undef SB_LOAD
    __syncthreads();
}

__device__ __forceinline__ void p_sgu2(Frame& F, int layer) {
    LAS unsigned char* vnT = F.lds + RING_OFF;
    const bf16* P1 = WSP(bf16, WS_P1); bf16* Ya = WSP(bf16, WS_Y);
    const float* gain = F.in[3] + (size_t)layer * 256; const float* sw = F.in[4] + (size_t)layer * 4 * 128 * 128; const float* sb = F.in[5] + (size_t)layer * 4 * 128;
    const int lane = F.lane, wave = F.wave, r32 = lane & 31, hi = lane >> 5, g = wave & 3, db = wave >> 2;
    for (int item = F.vcu; item < MC / 128; item += F.G) {
        const size_t r0 = (size_t)item * 128;
        __syncthreads();
        { const f32x4 gg = ((const f32x4*)gain)[lane];
          for (int rr = 0; rr < 16; rr += 2) { const int r = wave * 16 + rr;
              const v2u ra = *(const v2u*)(P1 + (r0 + r) * P1W + C_V + 4 * lane), rb = *(const v2u*)(P1 + (r0 + r + 1) * P1W + C_V + 4 * lane);
              const float a0 = bflo(ra.x), a1 = bfhi(ra.x), a2 = bflo(ra.y), a3 = bfhi(ra.y), b0 = bflo(rb.x), b1 = bfhi(rb.x), b2 = bflo(rb.y), b3 = bfhi(rb.y);
              const float sa = 1.0f / sqrtf(wave_sum((a0 * a0 + a1 * a1) + (a2 * a2 + a3 * a3), lane) * (1.f / 256.f) + EPS);
              const float sb_ = 1.0f / sqrtf(wave_sum((b0 * b0 + b1 * b1) + (b2 * b2 + b3 * b3), lane) * (1.f / 256.f) + EPS);
              LAS unsigned* q = (LAS unsigned*)(vnT + (4 * lane) * 272 + r * 2);
              q[0] = pk2(a0 * sa * gg.x, b0 * sb_ * gg.x); q[68] = pk2(a1 * sa * gg.y, b1 * sb_ * gg.y); q[136] = pk2(a2 * sa * gg.z, b2 * sb_ * gg.z); q[204] = pk2(a3 * sa * gg.w, b3 * sb_ * gg.w); } }
        __syncthreads();
        const int ch = g * 64 + db * 32 + r32;
        for (int tb = 0; tb < 4; ++tb) {
            f32x16 acc;
#pragma unroll
            for (int i = 0; i < 16; ++i) acc[i] = 0.f;
            const int t = 32 * tb + r32; const float* wrow = sw + ((size_t)g * 128 + t) * 128;
            f32x4 wq[8][2];
#pragma unroll
            for (int ks = 0; ks < 8; ++ks) if (ks < 2 * tb + 2) { wq[ks][0] = *(const f32x4*)(wrow + 16 * ks + 8 * hi); wq[ks][1] = *(const f32x4*)(wrow + 16 * ks + 8 * hi + 4); }
#pragma unroll
            for (int ks = 0; ks < 8; ++ks) if (ks < 2 * tb + 2) {
                const int s0 = 16 * ks + 8 * hi;
                const f32x4 w0 = wq[ks][0], w1 = wq[ks][1];
                const v4u a = (v4u){pk2(s0 <= t ? w0.x : 0.f, s0 + 1 <= t ? w0.y : 0.f), pk2(s0 + 2 <= t ? w0.z : 0.f, s0 + 3 <= t ? w0.w : 0.f),
                                    pk2(s0 + 4 <= t ? w1.x : 0.f, s0 + 5 <= t ? w1.y : 0.f), pk2(s0 + 6 <= t ? w1.z : 0.f, s0 + 7 <= t ? w1.w : 0.f)};
                const bf16x8v bfr = *(const LAS bf16x8v*)(vnT + ch * 272 + s0 * 2);
                acc = __builtin_amdgcn_mfma_f32_32x32x16_bf16(__builtin_bit_cast(bf16x8v, a), bfr, acc, 0, 0, 0); }
            float uu[16], bb[16];
#pragma unroll
            for (int i = 0; i < 16; ++i) { const int tt = 32 * tb + (i & 3) + 8 * (i >> 2) + 4 * hi; uu[i] = bf1(P1[(r0 + tt) * P1W + C_U + ch]); bb[i] = sb[g * 128 + tt]; }
#pragma unroll
            for (int i = 0; i < 16; ++i) { const int tt = 32 * tb + (i & 3) + 8 * (i >> 2) + 4 * hi;
                Ya[(r0 + tt) * 256 + ch] = (bf16)f2bf(uu[i] * (acc[i] + bb[i])); }
        }
    }
    __syncthreads();
}

struct Args { const float* in[20]; float* out; unsigned char* ws; int lo, hi, li, rep; };
#ifndef TILED_FFN1
#define TILED_FFN1 0
#endif
#ifndef PG8_ALIGN_EPI
#define PG8_ALIGN_EPI true
#endif
#ifndef PG8_SP2
#define PG8_SP2 true
#endif
#ifndef WGM_PROJ
#define WGM_PROJ PG8_WGM
#endif
#ifndef WGM_FFN1
#define WGM_FFN1 PG8_WGM
#endif
#ifndef WGM_FFN2
#define WGM_FFN2 PG8_WGM
#endif
#ifndef WGM_MOE1
#define WGM_MOE1 PG8_WGM
#endif
#ifndef WGM_MOE2
#define WGM_MOE2 PG8_WGM
#endif
#ifndef FFN_CHUNKS
#define FFN_CHUNKS 2
#endif
#ifndef REP_GEMM
#define REP_GEMM 1
#endif
#ifndef REP_STICK
#define REP_STICK 1
#endif
#ifndef REP_NSA
#define REP_NSA 1
#endif
#ifndef REP_SGU
#define REP_SGU 1
#endif
#ifndef REP_NORM
#define REP_NORM 1
#endif
template <class Epi, class Sched> __device__ __forceinline__ void run_gemm(Frame& F, const bf16* A, const bf16* Bt, int M, int N, int K, const Sched& S, Epi E, bool rotate = true, int tiled = 0, int ld = 0) {
    const int nt_ = K / 64;
#ifdef PG8_KROT
    const int rot_ = rotate ? 2 * (((F.bx & 7) * (nt_ / 2)) / 8) : 0;
#else
    const int rot_ = 0;
#endif
    pg8::Gemm g{A, Bt, M, N, K + F.zs, F.tid, rot_ + F.zs, tiled + F.zs, ld + F.zs};
    if (F.rep) E.set_scale0();
    pg8::gemm_phase<Epi, Sched, PG8_ALIGN_EPI, PG8_SP2>(F.lds + RING_OFF, g, S, E);
}
__global__ void __launch_bounds__(NWAVES * 64, 2) mk_fwd(Args args) {
    extern __shared__ __attribute__((aligned(16))) unsigned char lds[];
    Frame F0;
    F0.lds = (LAS unsigned char*)lds;
    F0.tid = threadIdx.x; F0.lane = F0.tid & 63; F0.wave = __builtin_amdgcn_readfirstlane(F0.tid >> 6);
    F0.G = gridDim.x; F0.bx = blockIdx.x; F0.vcu = (F0.G % 8 == 0) ? (F0.bx % 8) * (F0.G / 8) + F0.bx / 8 : F0.bx; F0.zv = 0; F0.zs = 0;
    F0.rep = args.rep; F0.ws = args.ws; F0.ctl = (unsigned*)(args.ws + WS_CTL); F0.in = args.in; F0.out = args.out;
    for (int u = F0.tid; u < (LDS_BYTES - LDSCTL_OFF) / 4; u += NWAVES * 64) ((LAS unsigned*)(F0.lds + LDSCTL_OFF))[u] = 0u;
    __syncthreads();
    const int lo = args.lo, hi = args.hi;
    XcdBarrier bar; bar.bar = F0.ctl + CW_BAR + args.li * XCD_BAR_WORDS; bar.x = 0; bar.st = nullptr; bar.w = 0; bar.z = 0;
    if (hi - lo > 1) bar = xcd_barrier_post(F0.ctl + CW_BAR + args.li * XCD_BAR_WORDS, (volatile LAS unsigned*)(F0.lds + MISC_OFF) + 8);
    int step = 0;
#define STEP_BEGIN if (step >= lo && step < hi) { Frame F = F0; { int zv_, zs_; asm volatile("v_mov_b32 %0, 0" : "=v"(zv_)); asm volatile("s_mov_b32 %0, 0" : "=s"(zs_)); \
        F.zv = zv_; F.zs = zs_; F.lane = (int)__builtin_amdgcn_mbcnt_hi(~0u, __builtin_amdgcn_mbcnt_lo(~0u, (unsigned)zv_)); F.wave = F0.wave + zs_; F.tid = F.wave * 64 + F.lane; F.bx = F.bx + zs_; \
        F.vcu = F0.vcu + zs_; F.G = F0.G + zs_; F.lds = (LAS unsigned char*)lds + zs_; F.ws = F0.ws + zs_; F.ctl = F0.ctl + zs_; F.in = F0.in + zs_; F.out = F0.out + zs_; }
#ifdef PROBE_XBAR
#define STEP_END   if (step + 1 < hi) { unsigned zb_; asm volatile("v_mov_b32 %0, 0" : "=v"(zb_)); bar.z = zb_; xcd_barrier(bar); xcd_barrier(bar); } } ++step;
#else
#define STEP_END   if (step + 1 < hi) { unsigned zb_; asm volatile("v_mov_b32 %0, 0" : "=v"(zb_)); bar.z = zb_; xcd_barrier(bar); } } ++step;
#endif

    for (int layer = 0; layer < DEPTH; ++layer) {
        const int jj = layer >> 1;
        STEP_BEGIN
            p_convert(F, layer);
            p_norm<0>(F, layer == 0 ? F.in[0] : F.out, F.in[1] + (size_t)layer * DM, nullptr, 0);
        STEP_END
        for (int c = 0; c < NCHUNK; ++c) {
            STEP_BEGIN
                pg8::StaticOrder S; S.init(MC, NPROJ, F.G, F.bx, WGM_PROJ);
                pg8::EpiProj E{WSP(bf16, WS_P1), WSP(bf16, WS_G)};
                run_gemm(F, WSP(bf16, WS_HN) + (size_t)c * MC * DM, WSP(bf16, WS_WIN), MC, NPROJ, DM, S, E);
            STEP_END
            STEP_BEGIN
                p_prep(F);
            STEP_END
            STEP_BEGIN
                LAS int* tab = (LAS int*)(F.lds + TAB_OFF);
                __syncthreads(); if (F.tid < 16) tab[F.tid] = F.tid >> 3; __syncthreads();
                pg8::GroupedOrder S; S.so.init(2 * 2048, 512, F.G, F.bx); S.tile_e = tab; S.nN = 2;
                pg8::EpiF32 E{WSP(float, WS_UL), 512, 2};
                run_gemm(F, WSP(bf16, WS_KVC), WSP(bf16, WS_WC1), 2 * 2048, 512, DM, S, E);
                p_sgu2(F, layer);
                p_stick2(F, F.G > 64 ? 32 : 0);
            STEP_END
            STEP_BEGIN
                p_cmpfin(F, layer);
            STEP_END
            STEP_BEGIN
#ifdef OLD_NSA
                p_nsa(F);
#else
                p_nsa2(F);
#endif
            STEP_END
            STEP_BEGIN
                pg8::MergeOrder S; S.so.init(MC, DM, F.G, F.bx); S.nmt = MC / 256;
                pg8::EpiMerge E{WSP(bf16, WS_G), WSP(bf16, WS_MG), MC / 256};
                run_gemm(F, WSP(bf16, WS_Y), WSP(bf16, WS_WBR), 3 * MC, 3 * DM, 256, S, E);
            STEP_END
            STEP_BEGIN
                pg8::StaticOrder S; S.init(MC, DM, F.G, F.bx);
                const float* base = (layer == 0 ? F.in[0] : F.out) + (size_t)c * MC * DM;
                pg8::EpiResid E{base, F.out + (size_t)c * MC * DM, DM, 1.0f};
                run_gemm(F, WSP(bf16, WS_MG), WSP(bf16, WS_WOUT), MC, DM, DM, S, E);
            STEP_END
        }
        if ((layer & 1) == 0) {
            STEP_BEGIN
                p_norm<0>(F, F.out, F.in[11] + (size_t)layer * DM, nullptr, 0, Q8_HN, TILED_FFN1);
            STEP_END
            for (int c = 0; c < FFN_CHUNKS; ++c) {
                constexpr int MF = MTOK / FFN_CHUNKS;
                STEP_BEGIN
                    pg8::StaticOrder S; S.init(MF, NFF1, F.G, F.bx, WGM_FFN1);
                    pg8::EpiSwiGLU E{WSP(bf16, WS_HID), DFFP, nullptr, NFF1 / 256};
                    run_gemm(F, WSP(bf16, WS_HN) + (size_t)c * MF * DM, WSP(bf16, WS_WF1), MF, NFF1, DM, S, E, true, TILED_FFN1);
                STEP_END
                STEP_BEGIN
                    pg8::StaticOrder S; S.init(MF, DM, F.G, F.bx, WGM_FFN2);
                    pg8::EpiResid E{F.out + (size_t)c * MF * DM, F.out + (size_t)c * MF * DM, DM, 1.0f};
                    run_gemm(F, WSP(bf16, WS_HID), WSP(bf16, WS_WF2), MF, DM, DFFP, S, E);
                STEP_END
            }
        } else {
            STEP_BEGIN
                p_norm<1>(F, F.out, F.in[11] + (size_t)layer * DM, F.in[15] + (size_t)jj * DM * NEXP, jj, Q8_HN);
            STEP_END
#ifdef ABL_DENSE_MOE
            for (int e = 0; e < NEXP; ++e) {
                STEP_BEGIN
                    pg8::StaticOrder S; S.init(MTOK, NMOE1, F.G, F.bx);
                    pg8::EpiSwiGLU E{WSP(bf16, WS_SCR + 8 * MiB), DFE, WSP(float, WS_SCR + 4 * MiB) + (size_t)e * MTOK, NMOE1 / 256};
                    run_gemm(F, WSP(bf16, WS_HN), WSP(bf16, WS_WF1) + (size_t)e * NMOE1 * DM, MTOK, NMOE1, DM, S, E);
                STEP_END
                STEP_BEGIN
                    pg8::StaticOrder S; S.init(MTOK, DM, F.G, F.bx);
                    pg8::EpiResid E{F.out, F.out, DM, 1.0f};
                    run_gemm(F, WSP(bf16, WS_SCR + 8 * MiB), WSP(bf16, WS_WF2) + (size_t)e * DM * DFE, MTOK, DM, DFE, S, E);
                STEP_END
            }
#else
            STEP_BEGIN
                p_gather(F, jj, 0, 0);
            STEP_END
            for (int c = 0; c < NCHUNK; ++c)
                for (int r = 0; r < 2; ++r) {
                    STEP_BEGIN
                        const int T = moe_table(F, jj, c, r);
                        pg8::GroupedOrder S; S.so.init(T * 256, NMOE1, F.G, F.bx, WGM_MOE1); S.tile_e = (LAS int*)(F.lds + TAB_OFF); S.nN = NMOE1 / 256;
                        pg8::EpiSwiGLU E{WSP(bf16, WS_HIDM), DFE, WSP(float, WS_WSLOT) + (c * 2 + r) * SLOTS, NMOE1 / 256};
                        run_gemm(F, WSP(bf16, WS_XG), WSP(bf16, WS_WF1), T * 256, NMOE1, DM, S, E, false);
                    STEP_END
                    STEP_BEGIN
                        const int T = moe_table(F, jj, c, r);
                        const int nwg = T * (DM / 256), R = nwg % F.G, full = nwg - R;
                        const int NS = (4 * R <= F.G) ? 4 : 2;
                        const bool split = (hi - lo > 1) && R > 0 && NS * R <= F.G && !F.rep;
                        int* tokm = WSP(int, WS_TOKMAP) + (c * 2 + r) * SLOTS; float* TB = WSP(float, WS_SCR + 320 * MiB);
                        { pg8::LimitOrder S; S.so.init(T * 256, DM, F.G, F.bx, WGM_MOE2); S.limit = split ? full : nwg;
                          pg8::GroupedLimit GS{S, (LAS int*)(F.lds + TAB_OFF), DM / 256};
                          pg8::EpiScatter E{F.out, tokm, DM / 256, 1.0f};
                          run_gemm(F, WSP(bf16, WS_HIDM), WSP(bf16, WS_WF2), T * 256, DM, DFE, GS, E, false); }
                        const bool more = c * 2 + r < 3;
                        if (split) {
                            const int KP = DFE / NS;
                            if (F.bx < NS * R) { const int Lx = full + F.bx / NS, kp = F.bx % NS;
                                pg8::StaticOrder so; so.init(T * 256, DM, F.G, Lx % F.G, WGM_MOE2); pg8::Unit un; so.next(Lx / F.G, un);
                                un.pn += ((LAS int*)(F.lds + TAB_OFF))[un.pm] * (DM / 256);
                                pg8::SingleOrder S1{un};
                                if (kp == 0) { pg8::EpiScatter E{F.out, tokm, DM / 256, 1.0f};
                                    run_gemm(F, WSP(bf16, WS_HIDM), WSP(bf16, WS_WF2), T * 256, DM, KP, S1, E, false, 0, DFE); }
                                else { pg8::EpiTile E{TB + ((size_t)(Lx - full) * 3 + (kp - 1)) * 65536};
                                    run_gemm(F, WSP(bf16, WS_HIDM) + kp * KP, WSP(bf16, WS_WF2) + kp * KP, T * 256, DM, KP, S1, E, false, 0, DFE); } }
                            if (more) p_gather(F, jj, (c * 2 + r + 1) >> 1, (c * 2 + r + 1) & 1, NS * R);
                            { unsigned zb_; asm volatile("v_mov_b32 %0, 0" : "=v"(zb_)); bar.z = zb_; xcd_barrier(bar); }
                            for (int it = (F.vcu * NWAVES + F.wave); it < R * 256; it += F.G * NWAVES) { const int j = it >> 8, row = it & 255, Lx = full + j;
                                pg8::StaticOrder so; so.init(T * 256, DM, F.G, Lx % F.G, WGM_MOE2); pg8::Unit un; so.next(Lx / F.G, un);
                                const int t = tokm[un.pm * 256 + row];
                                if (t >= 0) { f32x4* hp = (f32x4*)(F.out + (size_t)t * DM + un.pn * 256) + F.lane; f32x4 a = *hp;
                                    for (int q = 0; q < NS - 1; ++q) a = a + ((const f32x4*)(TB + ((size_t)j * 3 + q) * 65536 + row * 256))[F.lane];
                                    *hp = a; } }
                        } else if (!F.rep && more) p_gather(F, jj, (c * 2 + r + 1) >> 1, (c * 2 + r + 1) & 1, R);
                    STEP_END
                }
#endif
        }
    }
    STEP_BEGIN
        p_norm<2>(F, F.out, F.in[19], nullptr, 0);
    STEP_END
#undef STEP_BEGIN
#undef STEP_END
}

#ifndef MK_STEPS_PER_LAUNCH
#define MK_STEPS_PER_LAUNCH 1
#endif
extern "C" void kernel_launch(void* const* d_in, const int* in_sizes, int n_in, void* d_out, int out_size, void* d_ws, size_t ws_size, hipStream_t stream) {
    static int grid = 0;
    if (grid == 0) {
        if (n_in != 20 || in_sizes[0] != MTOK * DM || out_size != MTOK * DM || ws_size < WS_END) { fprintf(stderr, "kernel_launch: unexpected shapes (n_in %d, in0 %d, out %d, ws %zu)\n", n_in, n_in > 0 ? in_sizes[0] : -1, out_size, ws_size); grid = -1; return; }
        int dev = 0, cus = 0, per_cu = 0;
        if (hipGetDevice(&dev) != hipSuccess || hipDeviceGetAttribute(&cus, hipDeviceAttributeMultiprocessorCount, dev) != hipSuccess) { grid = -1; return; }
        if (hipFuncSetAttribute((const void*)mk_fwd, hipFuncAttributeMaxDynamicSharedMemorySize, LDS_BYTES) != hipSuccess) { fprintf(stderr, "kernel_launch: hipFuncSetAttribute failed\n"); grid = -1; return; }
        if (hipOccupancyMaxActiveBlocksPerMultiprocessor(&per_cu, (const void*)mk_fwd, NWAVES * 64, LDS_BYTES) != hipSuccess || per_cu < 1) fprintf(stderr, "kernel_launch: occupancy query reports %d\n", per_cu);
        (void)hipGetLastError();
        grid = cus;
    }
    if (grid < 0) return;
    if (hipMemsetAsync((char*)d_ws + WS_CTL, 0, CTL_ZERO_BYTES, stream) != hipSuccess) return;
    Args a{};
    for (int i = 0; i < 20; ++i) a.in[i] = (const float*)d_in[i];
    a.out = (float*)d_out; a.ws = (unsigned char*)d_ws; a.rep = 0;
    #ifdef ABL_DENSE_MOE
    constexpr int NSTEPS = 2 * (1 + NCHUNK * 8 + 3) + 2 * (1 + NCHUNK * 8 + 1 + NEXP * 2) + 1;
#else
    constexpr int NSTEPS = 2 * (1 + NCHUNK * 7 + 1 + 2 * FFN_CHUNKS) + 2 * (1 + NCHUNK * 7 + 2 + NCHUNK * 2 * 2) + 1;
#endif
    int li = 0;
#ifdef REPMASK
    static int kinds[256]; int ns = 0;
    for (int layer = 0; layer < DEPTH; ++layer) { kinds[ns++] = 0;
        for (int c = 0; c < NCHUNK; ++c) for (int q = 1; q <= 8; ++q) if (q != 5) kinds[ns++] = q;
        if ((layer & 1) == 0) { kinds[ns++] = 9; for (int c = 0; c < FFN_CHUNKS; ++c) { kinds[ns++] = 10; kinds[ns++] = 11; } }
        else { kinds[ns++] = 12; kinds[ns++] = 17; for (int c = 0; c < NCHUNK * 2; ++c) { kinds[ns++] = 14; kinds[ns++] = 13; } } }
    kinds[ns++] = 16;
    for (int s = 0; s < NSTEPS; ++s) { const int reps = ((REPMASK >> kinds[s]) & 1) ? 2 : 1;
        for (int r = 0; r < reps; ++r) { a.lo = s; a.hi = s + 1; a.li = 0; a.rep = r;
            hipLaunchKernelGGL(mk_fwd, dim3(grid), dim3(NWAVES * 64), LDS_BYTES, stream, a); } }
    (void)li;
#else
    for (int s = 0; s < NSTEPS; s += MK_STEPS_PER_LAUNCH) {
        a.lo = s; a.hi = (s + MK_STEPS_PER_LAUNCH < NSTEPS) ? s + MK_STEPS_PER_LAUNCH : NSTEPS; a.li = (MK_STEPS_PER_LAUNCH > 1) ? li : 0; ++li;
        hipLaunchKernelGGL(mk_fwd, dim3(grid), dim3(NWAVES * 64), LDS_BYTES, stream, a);
        if (hipPeekAtLastError() != hipSuccess) { fprintf(stderr, "kernel_launch: launch failed\n"); break; }
    }
#endif
}
```

```cpp
#define MK_STEPS_PER_LAUNCH 1000
#define PG8_WGM 4
#define FFN_CHUNKS 1
#include <hip/hip_runtime.h>
#include <cstdio>
#include <cstdint>
#include <cmath>
#ifndef PG8_AUX_A
#define PG8_AUX_A 0
#endif
#ifndef PG8_AUX_B
#define PG8_AUX_B 0
#endif
#ifndef PG8_WGM
#define PG8_WGM 8
#endif
namespace pg8 {
#define PG8_LAS __attribute__((address_space(3)))
typedef unsigned short bf16_t;
typedef short bf16x8 __attribute__((ext_vector_type(8)));
typedef float f32x4 __attribute__((ext_vector_type(4)));
typedef unsigned u32x4 __attribute__((ext_vector_type(4)));
constexpr int BM = 256, BK = 64, HALF = 128, HTB = HALF * BK * 2  , STAGE_BYTES = 8 * HTB, NXCD = 8, WGM = PG8_WGM;

__host__ __device__ __forceinline__ int lds_byte(int r, int c) { const int st = (r >> 4) * 2 + (c >> 5), rr = r & 15, cc = c & 31, ob = rr * 64 + cc * 2; return st * 1024 + (ob ^ (((ob >> 9) & 1) << 5)); }
__host__ __device__ __forceinline__ void stage_rc(int b, int& R, int& C) { const int st = b / 1024, sb = b % 1024, swz = sb ^ (((sb >> 9) & 1) << 5); R = (st >> 1) * 16 + swz / 64; C = (st & 1) * 32 + (swz % 64) / 2; }
__host__ __device__ __forceinline__ int perm32(int rho) { const int n = rho >> 4, i = rho & 15; return 8 * (i >> 2) + 4 * n + (i & 3); }

struct Unit { int pm, pn; };
struct Gemm { const bf16_t* A; const bf16_t* Bt; int M, N, K; int zv; int rot; int tiled; int ld; };

struct StaticOrder {
    int nM, nN, nwg, G, c, wgm;
    __host__ __device__ __forceinline__ void init(int M, int N, int G_, int c_, int wgm_ = WGM) { nM = M / BM; nN = N / BM; nwg = nM * nN; G = G_; c = c_; wgm = wgm_; }
    __host__ __device__ __forceinline__ bool next(int i, Unit& u) const {
        const long L = (long)i * G + c; if (L >= nwg) return false;
        int wgid = (int)L; { const int q = nwg / NXCD, r = nwg % NXCD, xcd = wgid % NXCD, off = wgid / NXCD; wgid = (xcd < r ? xcd * (q + 1) : r * (q + 1) + (xcd - r) * q) + off; }
        const int nig = wgm * nN, gid = wgid / nig, fm = gid * wgm, gsz = (nM - fm) < wgm ? (nM - fm) : wgm;
        u.pm = fm + ((wgid % nig) % gsz); u.pn = (wgid % nig) / gsz; return true;
    }
    __device__ __forceinline__ void a_ready(const Unit&) const {}
    __device__ __forceinline__ void done(const Unit&) const {}
};

__device__ __forceinline__ unsigned cvt_pk_bf16(float lo, float hi) { unsigned r; asm volatile("v_cvt_pk_bf16_f32 %0, %1, %2" : "=v"(r) : "v"(lo), "v"(hi)); return r; }
typedef float f32x2 __attribute__((ext_vector_type(2)));

__device__ __forceinline__ float fast_sigmoid(float x) { return __builtin_amdgcn_rcpf(1.0f + __builtin_amdgcn_exp2f(-1.4426950408889634f * x)); }
__device__ __forceinline__ float gelu_tanh(float x) {
    const float u2 = 1.5957691216057308f * (x + 0.044715f * x * x * x);
    return x * fast_sigmoid(u2);
}
__device__ __forceinline__ float bf_lo(unsigned u) { return __builtin_bit_cast(float, u << 16); }
__device__ __forceinline__ float bf_hi(unsigned u) { return __builtin_bit_cast(float, u & 0xffff0000u); }

#ifdef PG8_NT_OUT
#define PG8_STORE_OUT(p, v) __builtin_nontemporal_store((v), (p))
#else
#define PG8_STORE_OUT(p, v) (*(p) = (v))
#endif
struct EpiProj {
    static constexpr bool PERM = true, AFTER_DRAIN = false, MID = false; static constexpr int MID_TILES = 1; __device__ __forceinline__ void set_scale0() {}
    bf16_t* P1; bf16_t* G;
    __device__ __forceinline__ void operator()(const f32x4 (&acc)[2][2][4][2], const Unit& u, int wr, int wc, int fr, int fq) const {
        const int row0 = u.pm * BM + wr * 64 + fr;
        bf16_t* base; int ldc, colt, act0, act1;
        if (u.pn < 8) { base = P1; ldc = 2048; colt = u.pn * BM; act0 = (u.pn < 2) ? 1 : 0; act1 = (u.pn == 7) ? 2 : act0; }
        else { base = G; ldc = 3072; colt = (u.pn - 8) * BM; act0 = 2; act1 = 2; }
        const int col0 = colt + wc * 32 + 8 * fq;
#pragma unroll
        for (int ai = 0; ai < 2; ++ai)
#pragma unroll
            for (int m = 0; m < 4; ++m) { bf16_t* rowp = base + (size_t)(row0 + ai * HALF + m * 16) * ldc + col0;
#pragma unroll
                for (int bj = 0; bj < 2; ++bj) { f32x4 v0 = acc[ai][bj][m][0], v1 = acc[ai][bj][m][1]; const int act = bj ? act1 : act0;
                    if (act == 1) {
#pragma unroll
                        for (int e = 0; e < 4; ++e) { v0[e] = gelu_tanh(v0[e]); v1[e] = gelu_tanh(v1[e]); } }
                    else if (act == 2) {
#pragma unroll
                        for (int e = 0; e < 4; ++e) { v0[e] = fast_sigmoid(v0[e]); v1[e] = fast_sigmoid(v1[e]); } }
                    u32x4 w; w.x = cvt_pk_bf16(v0[0], v0[1]); w.y = cvt_pk_bf16(v0[2], v0[3]); w.z = cvt_pk_bf16(v1[0], v1[1]); w.w = cvt_pk_bf16(v1[2], v1[3]);
                    *(u32x4*)(rowp + bj * HALF) = w; } }
    }
};
struct EpiMerge {
    static constexpr bool PERM = true, AFTER_DRAIN = false, MID = false; static constexpr int MID_TILES = 1; __device__ __forceinline__ void set_scale0() {}
    const bf16_t* G; bf16_t* MG; int nmt;
    __device__ __forceinline__ void operator()(const f32x4 (&acc)[2][2][4][2], const Unit& u, int wr, int wc, int fr, int fq) const {
        const int i = u.pn >> 2, pn = u.pn & 3, pm = u.pm - i * nmt;
        const int row0 = pm * BM + wr * 64 + fr, col0 = pn * BM + wc * 32 + 8 * fq;
#pragma unroll
        for (int ai = 0; ai < 2; ++ai)
#pragma unroll
            for (int mp = 0; mp < 2; ++mp) {
                u32x4 g[4], o[4];
#pragma unroll
                for (int q = 0; q < 4; ++q) { const int m = 2 * mp + (q >> 1), bj = q & 1; const size_t row = (size_t)(row0 + ai * HALF + m * 16); const int col = col0 + bj * HALF;
                    g[q] = *(const u32x4*)(G + row * 3072 + i * 1024 + col);
                    if (i > 0) o[q] = *(const u32x4*)(MG + row * 1024 + col); else o[q] = (u32x4){0u, 0u, 0u, 0u}; }
#pragma unroll
                for (int q = 0; q < 4; ++q) { const int m = 2 * mp + (q >> 1), bj = q & 1; const size_t row = (size_t)(row0 + ai * HALF + m * 16); const int col = col0 + bj * HALF;
                    f32x4 v0 = acc[ai][bj][m][0], v1 = acc[ai][bj][m][1];
#ifdef ABL_BRANCH
                    if (i == ABL_BRANCH) { v0 = v0 * (float)ABL_SCALE; v1 = v1 * (float)ABL_SCALE; }
#endif
                    v0[0] = v0[0] * bf_lo(g[q].x) + bf_lo(o[q].x); v0[1] = v0[1] * bf_hi(g[q].x) + bf_hi(o[q].x); v0[2] = v0[2] * bf_lo(g[q].y) + bf_lo(o[q].y); v0[3] = v0[3] * bf_hi(g[q].y) + bf_hi(o[q].y);
                    v1[0] = v1[0] * bf_lo(g[q].z) + bf_lo(o[q].z); v1[1] = v1[1] * bf_hi(g[q].z) + bf_hi(o[q].z); v1[2] = v1[2] * bf_lo(g[q].w) + bf_lo(o[q].w); v1[3] = v1[3] * bf_hi(g[q].w) + bf_hi(o[q].w);
                    u32x4 w; w.x = cvt_pk_bf16(v0[0], v0[1]); w.y = cvt_pk_bf16(v0[2], v0[3]); w.z = cvt_pk_bf16(v1[0], v1[1]); w.w = cvt_pk_bf16(v1[2], v1[3]);
                    *(u32x4*)(MG + row * 1024 + col) = w; } }
    }
};
typedef unsigned u32x2 __attribute__((ext_vector_type(2)));
struct EpiResid {
    static constexpr bool PERM = false, AFTER_DRAIN = false, MID = false; static constexpr int MID_TILES = 1; __device__ __forceinline__ void set_scale0() { scale = 0.f; x32 = nullptr; }
    const float* x32; bf16_t* out; int ldc; float scale;
    __device__ __forceinline__ void operator()(const f32x4 (&acc)[2][2][4][2], const Unit& u, int wr, int wc, int fr, int fq) const {
        const int row0 = u.pm * BM + wr * 64 + fr, col0 = u.pn * BM + wc * 32 + 4 * fq;
#pragma unroll
        for (int ai = 0; ai < 2; ++ai)
#pragma unroll
            for (int mp = 0; mp < 2; ++mp) {
                f32x4 b[8];
                if (x32) {
#pragma unroll
                    for (int q = 0; q < 8; ++q) { const int m = 2 * mp + (q >> 2), bj = (q >> 1) & 1, n = q & 1;
                        b[q] = *(const f32x4*)(x32 + (size_t)(row0 + ai * HALF + m * 16) * ldc + col0 + bj * HALF + n * 16); }
                } else {
                    u32x2 t[8];
#pragma unroll
                    for (int q = 0; q < 8; ++q) { const int m = 2 * mp + (q >> 2), bj = (q >> 1) & 1, n = q & 1;
                        t[q] = *(const u32x2*)(out + (size_t)(row0 + ai * HALF + m * 16) * ldc + col0 + bj * HALF + n * 16); }
#pragma unroll
                    for (int q = 0; q < 8; ++q) b[q] = (f32x4){bf_lo(t[q].x), bf_hi(t[q].x), bf_lo(t[q].y), bf_hi(t[q].y)};
                }
#pragma unroll
                for (int q = 0; q < 8; ++q) { const int m = 2 * mp + (q >> 2), bj = (q >> 1) & 1, n = q & 1; const f32x4 r = b[q] + acc[ai][bj][m][n] * scale;
                    *(u32x2*)(out + (size_t)(row0 + ai * HALF + m * 16) * ldc + col0 + bj * HALF + n * 16) = (u32x2){cvt_pk_bf16(r.x, r.y), cvt_pk_bf16(r.z, r.w)}; } }
    }
};
struct EpiF32 {
    static constexpr bool PERM = false, AFTER_DRAIN = false, MID = false; static constexpr int MID_TILES = 1; __device__ __forceinline__ void set_scale0() {}
    float* O; int ldc, nN;
    __device__ __forceinline__ void operator()(const f32x4 (&acc)[2][2][4][2], const Unit& u, int wr, int wc, int fr, int fq) const {
        const int row0 = u.pm * BM + wr * 64 + fr, col0 = (u.pn % nN) * BM + wc * 32 + 4 * fq;
#pragma unroll
        for (int ai = 0; ai < 2; ++ai)
#pragma unroll
            for (int m = 0; m < 4; ++m) { const size_t off = (size_t)(row0 + ai * HALF + m * 16) * ldc + col0;
#pragma unroll
                for (int bj = 0; bj < 2; ++bj)
#pragma unroll
                    for (int n = 0; n < 2; ++n) *(f32x4*)(O + off + bj * HALF + n * 16) = acc[ai][bj][m][n]; }
    }
};
#ifdef EMU_FP8_HID
__device__ __forceinline__ float Q8H(float x) { const int p = __builtin_amdgcn_cvt_pk_fp8_f32(x * 8.f, x * 8.f, 0, false); return __builtin_amdgcn_cvt_f32_fp8(p, 0) * 0.125f; }
#else
__device__ __forceinline__ float Q8H(float x) { return x; }
#endif
struct EpiSwiGLU {
    static constexpr bool PERM = true, AFTER_DRAIN = false, MID = false; static constexpr int MID_TILES = 1; __device__ __forceinline__ void set_scale0() {}
    bf16_t* H; int ldh; const float* rowscale; int nN; int rowmask = 0x7fffffff;
    __device__ __forceinline__ void operator()(const f32x4 (&acc)[2][2][4][2], const Unit& u, int wr, int wc, int fr, int fq) const {
        const int row0 = u.pm * BM + wr * 64 + fr, col0 = (u.pn % nN) * HALF + wc * 32 + 8 * fq;
        float scv[8];
#pragma unroll
        for (int q = 0; q < 8; ++q) scv[q] = rowscale ? rowscale[row0 + (q >> 2) * HALF + (q & 3) * 16] : 1.0f;
#pragma unroll
        for (int ai = 0; ai < 2; ++ai)
#pragma unroll
            for (int m = 0; m < 4; ++m) { const int row = row0 + ai * HALF + m * 16; const float sc = scv[ai * 4 + m];
                float h[8];
#pragma unroll
                for (int n = 0; n < 2; ++n)
#pragma unroll
                    for (int e = 0; e < 4; ++e) { const float g = acc[ai][0][m][n][e], up = acc[ai][1][m][n][e]; h[n * 4 + e] = Q8H(g * fast_sigmoid(g) * up * sc); }
                u32x4 w; w.x = cvt_pk_bf16(h[0], h[1]); w.y = cvt_pk_bf16(h[2], h[3]); w.z = cvt_pk_bf16(h[4], h[5]); w.w = cvt_pk_bf16(h[6], h[7]);
                PG8_STORE_OUT((u32x4*)(H + (size_t)(row & rowmask) * ldh + col0), w); }
    }
};
struct EpiScatter {
    static constexpr bool PERM = false, AFTER_DRAIN = false, MID = false; static constexpr int MID_TILES = 1; __device__ __forceinline__ void set_scale0() { scale = 0.f; }
    bf16_t* out; const int* tok; int nN; float scale;
    __device__ __forceinline__ void operator()(const f32x4 (&acc)[2][2][4][2], const Unit& u, int wr, int wc, int fr, int fq) const {
        const int row0 = u.pm * BM + wr * 64 + fr, col0 = (u.pn % nN) * BM + wc * 32 + 4 * fq;
        int tk[8];
#pragma unroll
        for (int q = 0; q < 8; ++q) tk[q] = tok[row0 + (q >> 2) * HALF + (q & 3) * 16];
#pragma unroll
        for (int ai = 0; ai < 2; ++ai)
#pragma unroll
            for (int mp = 0; mp < 2; ++mp) {
                u32x2 b[8];
#pragma unroll
                for (int q = 0; q < 8; ++q) { const int m = 2 * mp + (q >> 2), bj = (q >> 1) & 1, n = q & 1; const int t = tk[ai * 4 + m];
                    b[q] = *(const u32x2*)(out + (size_t)(t < 0 ? 0 : t) * 1024 + col0 + bj * HALF + n * 16); }
#pragma unroll
                for (int q = 0; q < 8; ++q) { const int m = 2 * mp + (q >> 2), bj = (q >> 1) & 1, n = q & 1; const int t = tk[ai * 4 + m];
                    if (t >= 0) { const f32x4 r = (f32x4){bf_lo(b[q].x), bf_hi(b[q].x), bf_lo(b[q].y), bf_hi(b[q].y)} + acc[ai][bj][m][n] * scale;
                        *(u32x2*)(out + (size_t)t * 1024 + col0 + bj * HALF + n * 16) = (u32x2){cvt_pk_bf16(r.x, r.y), cvt_pk_bf16(r.z, r.w)}; } } }
    }
};
struct GroupedOrder {
    StaticOrder so; const PG8_LAS int* tile_e; int nN;
    __device__ __forceinline__ bool next(int i, Unit& u) const { if (!so.next(i, u)) return false; u.pn += tile_e[u.pm] * nN; return true; }
    __device__ __forceinline__ void a_ready(const Unit&) const {}
    __device__ __forceinline__ void done(const Unit&) const {}
};
struct LimitOrder {
    StaticOrder so; int limit;
    __device__ __forceinline__ bool next(int i, Unit& u) const { if ((long)i * so.G + so.c >= limit) return false; return so.next(i, u); }
    __device__ __forceinline__ void a_ready(const Unit&) const {}
    __device__ __forceinline__ void done(const Unit&) const {}
};
struct GroupedLimit {
    LimitOrder lo; const PG8_LAS int* tile_e; int nN;
    __device__ __forceinline__ bool next(int i, Unit& u) const { if (!lo.next(i, u)) return false; u.pn += tile_e[u.pm] * nN; return true; }
    __device__ __forceinline__ void a_ready(const Unit&) const {}
    __device__ __forceinline__ void done(const Unit&) const {}
};
struct SingleOrder {
    Unit un;
    __device__ __forceinline__ bool next(int i, Unit& u) const { if (i != 0) return false; u = un; return true; }
    __device__ __forceinline__ void a_ready(const Unit&) const {}
    __device__ __forceinline__ void done(const Unit&) const {}
};
struct EpiTile {
    static constexpr bool PERM = false, AFTER_DRAIN = false, MID = false; static constexpr int MID_TILES = 1; __device__ __forceinline__ void set_scale0() {}
    float* O;
    __device__ __forceinline__ void operator()(const f32x4 (&acc)[2][2][4][2], const Unit&, int wr, int wc, int fr, int fq) const {
#pragma unroll
        for (int ai = 0; ai < 2; ++ai)
#pragma unroll
            for (int m = 0; m < 4; ++m)
#pragma unroll
                for (int bj = 0; bj < 2; ++bj)
#pragma unroll
                    for (int n = 0; n < 2; ++n) *(f32x4*)(O + (size_t)(wr * 64 + fr + ai * HALF + m * 16) * 256 + wc * 32 + 4 * fq + bj * HALF + n * 16) = acc[ai][bj][m][n];
    }
};
struct OffsetOrder {
    StaticOrder so; int pn_off;
    __device__ __forceinline__ bool next(int i, Unit& u) const { if (!so.next(i, u)) return false; u.pn += pn_off; return true; }
    __device__ __forceinline__ void a_ready(const Unit&) const {}
    __device__ __forceinline__ void done(const Unit&) const {}
};
struct ProbeOrder {
    StaticOrder so; int pm_mask;
    __device__ __forceinline__ bool next(int i, Unit& u) const { if (!so.next(i, u)) return false; u.pm &= pm_mask; return true; }
    __device__ __forceinline__ void a_ready(const Unit&) const {}
    __device__ __forceinline__ void done(const Unit&) const {}
};
struct MergeOrder {
    StaticOrder so; int nmt;
    __device__ __forceinline__ bool next(int i, Unit& u) const { const int b = i % 3; if (!so.next(i / 3, u)) return false; u.pm += b * nmt; u.pn += b * 4; return true; }
    __device__ __forceinline__ void a_ready(const Unit&) const {}
    __device__ __forceinline__ void done(const Unit&) const {}
};
template <class Epi, class Sched, bool ALIGN_EPI = false, bool SP2 = false>
__device__ __forceinline__ void gemm_phase(PG8_LAS unsigned char* lds, const Gemm g, const Sched& S, const Epi& E) {
    const int tid = g.zv  , wid = __builtin_amdgcn_readfirstlane(tid >> 6), lane = tid & 63, wr = wid >> 2, wc = wid & 3, fr = lane & 15, fq = lane >> 4;
    const int K = g.K, nt = K / BK;
    unsigned voffA[2], voffB[2];
#pragma unroll
    for (int i = 0; i < 2; ++i) { int R, C; stage_rc(tid * 16 + i * 8192, R, C); const int Rb = Epi::PERM ? ((R & ~31) + perm32(R & 31)) : R;
        const int LD = g.ld ? g.ld : K;
        const int pitch = g.tiled ? BK : LD;
        voffA[i] = (unsigned)(R * pitch + C) * 2u; voffB[i] = (unsigned)(Rb * pitch + C) * 2u; }
    const size_t kstep = g.tiled ? (size_t)(BM * BK * 2) : (size_t)(BK * 2);
    const size_t hstep = g.tiled ? (size_t)(HALF * BK * 2) : (size_t)HALF * (g.ld ? g.ld : K) * 2;
    const size_t tstep = (size_t)BM * (g.ld ? g.ld : K) * 2;
    const unsigned ldsw = (unsigned)wid * 1024u;
    const int aoff = lds_byte(wr * 64 + fr, fq * 8), boff = lds_byte(wc * 32 + fr, fq * 8);
#define PG8_SA(b, h) (((b) * 2 + (h)) * HTB)
#define PG8_SB(b, h) ((4 + (b) * 2 + (h)) * HTB)
#define PG8_STAGE(bufoff, gbase, voff) do { _Pragma("unroll") for (int _i = 0; _i < 2; ++_i) \
        __builtin_amdgcn_global_load_lds((const unsigned*)((const char*)(gbase) + (voff)[_i]), (PG8_LAS unsigned*)(lds + (bufoff) + ldsw + _i * 8192), 16, 0, ((bufoff) < 4 * HTB) ? PG8_AUX_A : PG8_AUX_B); } while (0)
#define PG8_LDA(dst, b, h) do { _Pragma("unroll") for (int m = 0; m < 4; ++m) _Pragma("unroll") for (int k = 0; k < 2; ++k) dst[m][k] = *(const PG8_LAS bf16x8*)(lds + PG8_SA(b, h) + aoff + m * 2048 + k * 1024); } while (0)
#define PG8_LDB(dst, b, h) do { _Pragma("unroll") for (int n = 0; n < 2; ++n) _Pragma("unroll") for (int k = 0; k < 2; ++k) dst[n][k] = *(const PG8_LAS bf16x8*)(lds + PG8_SB(b, h) + boff + n * 2048 + k * 1024); } while (0)
#define PG8_MMA(ai, bj, At, Bt) do { __builtin_amdgcn_s_setprio(1); _Pragma("unroll") for (int m = 0; m < 4; ++m) _Pragma("unroll") for (int n = 0; n < 2; ++n) _Pragma("unroll") for (int k = 0; k < 2; ++k) \
        acc[ai][bj][m][n] = __builtin_amdgcn_mfma_f32_16x16x32_bf16(Bt[n][k], At[m][k], acc[ai][bj][m][n], 0, 0, 0); __builtin_amdgcn_s_setprio(0); } while (0)
#define PG8_WAIT_V(n) asm volatile("s_waitcnt vmcnt(" #n ")" ::: "memory")
#define PG8_WAIT_L(n) asm volatile("s_waitcnt lgkmcnt(" #n ")" ::: "memory")
#define PG8_BAR __builtin_amdgcn_s_barrier()
#define PG8_SCHED __builtin_amdgcn_sched_barrier(0)
    Unit cur, nxt; int ui = 0;
    if (!S.next(0, cur)) return;
    f32x4 acc[2][2][4][2];
#pragma unroll
    for (int a = 0; a < 2; ++a)
#pragma unroll
        for (int b = 0; b < 2; ++b)
#pragma unroll
            for (int m = 0; m < 4; ++m)
#pragma unroll
                for (int n = 0; n < 2; ++n) acc[a][b][m][n] = (f32x4){0.f, 0.f, 0.f, 0.f};
    bf16x8 At[4][2], B0[2][2], B1[2][2];
    const char* cA = (const char*)g.A + (size_t)cur.pm * tstep; const char* cB = (const char*)g.Bt + (size_t)cur.pn * tstep;
    const int rot = g.rot; const size_t rofs = (size_t)rot * kstep; const char* pA = cA + rofs; const char* pB = cB + rofs;
#define PG8_KT(x) ((size_t)(((x) + rot >= nt) ? (x) + rot - nt : (x) + rot))
    S.a_ready(cur);
    if constexpr (SP2) {
        PG8_STAGE(PG8_SB(0, 0), pB, voffB); PG8_STAGE(PG8_SB(0, 1), pB + hstep, voffB); PG8_STAGE(PG8_SA(0, 0), pA, voffA); PG8_STAGE(PG8_SA(0, 1), pA + hstep, voffA);
        if (wr == 1) PG8_BAR;
        PG8_WAIT_V(2); PG8_BAR;
        PG8_STAGE(PG8_SB(1, 0), pB + kstep, voffB); PG8_STAGE(PG8_SA(1, 0), pA + kstep, voffA); PG8_STAGE(PG8_SB(1, 1), pB + hstep + kstep, voffB);
        PG8_WAIT_V(6); PG8_BAR;
    } else {
        PG8_STAGE(PG8_SB(0, 0), pB, voffB); PG8_STAGE(PG8_SA(0, 0), pA, voffA); PG8_STAGE(PG8_SB(0, 1), pB + hstep, voffB); PG8_STAGE(PG8_SA(0, 1), pA + hstep, voffA);
        if (wr == 1) PG8_BAR;
        PG8_WAIT_V(4); PG8_BAR;
        PG8_STAGE(PG8_SB(1, 0), pB + kstep, voffB); PG8_STAGE(PG8_SA(1, 0), pA + kstep, voffA); PG8_STAGE(PG8_SB(1, 1), pB + hstep + kstep, voffB);
        PG8_WAIT_V(6); PG8_BAR;
    }
    for (;;) {
        const bool has_next = S.next(ui + 1, nxt);
        const char* nA = has_next ? (const char*)g.A + (size_t)nxt.pm * tstep : cA; const char* nB = has_next ? (const char*)g.Bt + (size_t)nxt.pn * tstep : cB;
        for (int t = 0; t < nt; t += 2) {
            if constexpr (Epi::MID) { if (t != 0 && (t & (Epi::MID_TILES - 1)) == 0) E.mid(acc, cur, t / Epi::MID_TILES, wr, wc, fr, fq); }
            const bool last = (t == nt - 2);
            const char* a1 = cA + PG8_KT(t + 1) * kstep;
            const char* a2 = last ? nA + rofs : cA + PG8_KT(t + 2) * kstep; const char* b2 = last ? nB + rofs : cB + PG8_KT(t + 2) * kstep;
            const char* a3 = a2 + kstep; const char* b3 = b2 + kstep;
            if (last && has_next) S.a_ready(nxt);
            if constexpr (SP2) {
            PG8_LDB(B0, 0, 0); PG8_LDB(B1, 0, 1); PG8_SCHED; PG8_LDA(At, 0, 0); PG8_STAGE(PG8_SA(1, 1), a1 + hstep, voffA);
            PG8_WAIT_V(8); PG8_WAIT_L(0); PG8_BAR; PG8_MMA(0, 0, At, B0); PG8_MMA(0, 1, At, B1); PG8_BAR; PG8_SCHED;
            PG8_LDA(At, 0, 1); PG8_STAGE(PG8_SB(0, 0), b2, voffB); PG8_STAGE(PG8_SB(0, 1), b2 + hstep, voffB); PG8_STAGE(PG8_SA(0, 0), a2, voffA);
            PG8_WAIT_V(8); PG8_WAIT_L(0); PG8_BAR; PG8_MMA(1, 0, At, B0); PG8_MMA(1, 1, At, B1); PG8_BAR; PG8_SCHED;
            PG8_LDB(B0, 1, 0); PG8_LDB(B1, 1, 1); PG8_SCHED; PG8_LDA(At, 1, 0); PG8_STAGE(PG8_SA(0, 1), a2 + hstep, voffA);
            PG8_WAIT_V(8); PG8_WAIT_L(0); PG8_BAR; PG8_MMA(0, 0, At, B0); PG8_MMA(0, 1, At, B1); PG8_BAR; PG8_SCHED;
            PG8_LDA(At, 1, 1); PG8_STAGE(PG8_SB(1, 0), b3, voffB); PG8_STAGE(PG8_SB(1, 1), b3 + hstep, voffB); PG8_STAGE(PG8_SA(1, 0), a3, voffA);
            PG8_WAIT_V(8); PG8_WAIT_L(0); PG8_BAR; PG8_MMA(1, 0, At, B0); PG8_MMA(1, 1, At, B1); PG8_BAR; PG8_SCHED;
            } else {
            PG8_LDB(B0, 0, 0); PG8_SCHED; PG8_LDA(At, 0, 0); PG8_STAGE(PG8_SA(1, 1), a1 + hstep, voffA);
            PG8_WAIT_L(8); PG8_BAR; PG8_WAIT_L(0); PG8_MMA(0, 0, At, B0); PG8_BAR; PG8_SCHED;
            PG8_LDB(B1, 0, 1); PG8_STAGE(PG8_SB(0, 0), b2, voffB);
            PG8_BAR; PG8_WAIT_L(0); PG8_MMA(0, 1, At, B1); PG8_BAR;
            PG8_LDA(At, 0, 1); PG8_STAGE(PG8_SA(0, 0), a2, voffA);
            PG8_BAR; PG8_WAIT_L(0); PG8_MMA(1, 0, At, B0); PG8_BAR; PG8_SCHED;
            PG8_STAGE(PG8_SB(0, 1), b2 + hstep, voffB);
            PG8_WAIT_V(6); PG8_BAR; PG8_MMA(1, 1, At, B1); PG8_BAR;
            PG8_LDB(B0, 1, 0); PG8_SCHED; PG8_LDA(At, 1, 0); PG8_STAGE(PG8_SA(0, 1), a2 + hstep, voffA);
            PG8_WAIT_L(8); PG8_BAR; PG8_WAIT_L(0); PG8_MMA(0, 0, At, B0); PG8_BAR; PG8_SCHED;
            PG8_LDB(B1, 1, 1); PG8_STAGE(PG8_SB(1, 0), b3, voffB);
            PG8_BAR; PG8_WAIT_L(0); PG8_MMA(0, 1, At, B1); PG8_BAR;
            PG8_LDA(At, 1, 1); PG8_STAGE(PG8_SA(1, 0), a3, voffA);
            PG8_BAR; PG8_WAIT_L(0); PG8_MMA(1, 0, At, B0); PG8_BAR; PG8_SCHED;
            PG8_STAGE(PG8_SB(1, 1), b3 + hstep, voffB);
            PG8_WAIT_V(6); PG8_BAR; PG8_MMA(1, 1, At, B1); PG8_BAR;
            }
        }
        if constexpr (ALIGN_EPI) { if (wr == 0) PG8_BAR; }
        if constexpr (!Epi::AFTER_DRAIN) { E(acc, cur, wr, wc, fr, fq); S.done(cur); }
        if (!has_next) break;
#pragma unroll
        for (int a = 0; a < 2; ++a)
#pragma unroll
            for (int b = 0; b < 2; ++b)
#pragma unroll
                for (int m = 0; m < 4; ++m)
#pragma unroll
                    for (int n = 0; n < 2; ++n) acc[a][b][m][n] = (f32x4){0.f, 0.f, 0.f, 0.f};
        cur = nxt; cA = nA; cB = nB; ++ui;
        if constexpr (ALIGN_EPI) { if (wr == 1) PG8_BAR; }
    }
    PG8_WAIT_V(0);
    if constexpr (!ALIGN_EPI) { if (wr == 0) PG8_BAR; }
    PG8_BAR;
    if constexpr (Epi::AFTER_DRAIN) { E.fused(acc, cur, wr, wc, fr, fq, lds, wid, lane); S.done(cur); }
#undef PG8_KT
#undef PG8_SA
#undef PG8_SB
#undef PG8_STAGE
#undef PG8_LDA
#undef PG8_LDB
#undef PG8_MMA
#undef PG8_WAIT_V
#undef PG8_WAIT_L
#undef PG8_BAR
#undef PG8_SCHED
}
}

constexpr int NWAVES = 8;
constexpr int DM = 1024, BATCH = 16, SEQ = 4096, DEPTH = 4, MTOK = BATCH * SEQ;
constexpr int NCHUNK = 2, MC = MTOK / NCHUNK, BC = BATCH / NCHUNK;
constexpr int CIN = 5004, NPROJ = 5120, P1W = 2048, GWID = 3072;
constexpr int DFF = 2752, DFFP = 2816, NFF1 = 2 * DFFP;
constexpr int NEXP = 8, DFE = 3584, NMOE1 = 2 * DFE;
constexpr int SLOTS = MC + 2048;
constexpr float EPS = 1e-6f;
constexpr int C_U = 0, C_V = 256, C_SBQ = 512, C_SBK = 768, C_SBV = 1024, C_CQ = 1280, C_KCMP = 1536, C_VCMP = 1600, C_KSLC = 1664, C_VSLC = 1728, C_KWIN = 1792, C_VWIN = 1856, C_CG = 1920;

constexpr size_t MiB = 1u << 20;
constexpr size_t WS_CTL = 0, CTL_ZERO_BYTES = 1 * MiB;
constexpr size_t WS_ROPE = 1 * MiB;
constexpr size_t WS_BIAS1 = 1 * MiB + 512 * 1024;
constexpr size_t WS_WIN = 2 * MiB;
constexpr size_t WS_WBR = 12 * MiB;
constexpr size_t WS_WOUT = 14 * MiB;
constexpr size_t WS_WC1 = 16 * MiB;
constexpr size_t WS_WF1 = 18 * MiB;
constexpr size_t WS_WF2 = 130 * MiB;
constexpr size_t WS_HN = 186 * MiB;
constexpr size_t WS_SCR = 314 * MiB;
constexpr size_t WS_P1 = WS_SCR;
constexpr size_t WS_G = WS_P1 + 128 * MiB;
constexpr size_t WS_Y = WS_G + 192 * MiB;
constexpr size_t WS_MG = WS_Y + 48 * MiB;
constexpr size_t WS_KVC = WS_MG + 64 * MiB;
constexpr size_t WS_UL = WS_KVC + 8 * MiB;
constexpr size_t WS_KC = WS_UL + 8 * MiB;
constexpr size_t WS_VT = WS_KC + 1 * MiB;
constexpr size_t WS_KCT = WS_VT + 24 * MiB;
constexpr size_t WS_MIX_END = WS_KCT + 1 * MiB;
constexpr size_t WS_HID = WS_SCR;
constexpr size_t WS_ROUTE = WS_SCR;
constexpr size_t WS_TOKMAP = WS_SCR + 1 * MiB;
constexpr size_t WS_WSLOT = WS_SCR + 2 * MiB;
constexpr size_t WS_CNT128 = WS_SCR + 3 * MiB;
constexpr size_t WS_XG = WS_SCR + 4 * MiB;
constexpr size_t WS_HIDM = WS_XG + 68 * MiB;
constexpr size_t WS_H = 800 * MiB;
constexpr size_t WS_END = 928 * MiB;
static_assert(WS_MIX_END <= WS_H && WS_HID + (size_t)MTOK * DFFP * 2 <= WS_H && WS_HIDM + (size_t)SLOTS * DFE * 2 <= WS_H, "d_ws map");
static_assert(WS_WF1 + (size_t)NEXP * NMOE1 * DM * 2 <= WS_WF2 && WS_WF2 + (size_t)NEXP * DM * DFE * 2 <= WS_HN, "weight map");
static_assert((size_t)4 * SLOTS * 4 <= 1 * MiB, "tokmap");
constexpr int CW_BAR = 4096;
constexpr int CW_CNT = 131072;
constexpr int CW_CUR = 131072 + 256;
constexpr int MAX_BAR_REGIONS = 32;
constexpr int RING_OFF = 0, RING_BYTES = 131072;
constexpr int LDSCTL_OFF = RING_BYTES, MISC_OFF = LDSCTL_OFF + 320;
constexpr int TAB_OFF = LDSCTL_OFF + 1024;
constexpr int LDS_BYTES = 147456;

#define GAS __attribute__((address_space(1)))
#define LAS __attribute__((address_space(3)))
typedef unsigned short bf16;
typedef unsigned v4u __attribute__((ext_vector_type(4)));
typedef unsigned v2u __attribute__((ext_vector_type(2)));
typedef float f32x4 __attribute__((ext_vector_type(4)));
typedef int v4i __attribute__((ext_vector_type(4)));
typedef __bf16 bf16x2_t __attribute__((ext_vector_type(2)));
#define LDS_WAIT() asm volatile("s_waitcnt lgkmcnt(0)" ::: "memory")
#define VM_WAIT() asm volatile("s_waitcnt vmcnt(0)" ::: "memory")
__device__ __forceinline__ unsigned f2bf(float f) { unsigned u = __builtin_bit_cast(unsigned, f); return (u + 0x7fffu + ((u >> 16) & 1u)) >> 16; }
__device__ __forceinline__ unsigned pk2(float lo, float hi) { return f2bf(lo) | (f2bf(hi) << 16); }
__device__ __forceinline__ float bflo(unsigned u) { return __builtin_bit_cast(float, u << 16); }
__device__ __forceinline__ float bfhi(unsigned u) { return __builtin_bit_cast(float, u & 0xffff0000u); }
__device__ __forceinline__ float bf1(bf16 h) { return __builtin_bit_cast(float, (unsigned)h << 16); }
__device__ __forceinline__ float dot2bf(unsigned a, unsigned b, float c) { return __builtin_amdgcn_fdot2_f32_bf16(__builtin_bit_cast(bf16x2_t, a), __builtin_bit_cast(bf16x2_t, b), c, false); }
#ifdef EMU_FP8
__device__ __forceinline__ float q8r(float x, float s) { const int p = __builtin_amdgcn_cvt_pk_fp8_f32(x * s, x * s, 0, false); return __builtin_amdgcn_cvt_f32_fp8(p, 0) * (1.0f / s); }
#else
__device__ __forceinline__ float q8r(float x, float) { return x; }
#endif
__device__ __forceinline__ float fexp(float x) { return __builtin_amdgcn_exp2f(1.4426950408889634f * x); }
template <int X> __device__ __forceinline__ float swz_xor(float v) { return __builtin_bit_cast(float, __builtin_amdgcn_ds_swizzle(__builtin_bit_cast(int, v), (X << 10) | 0x1f)); }
__device__ __forceinline__ float wave_sum(float v, int lane) {
#pragma unroll
    for (int o = 1; o < 64; o <<= 1) v += __builtin_bit_cast(float, __builtin_amdgcn_ds_bpermute((lane ^ o) << 2, __builtin_bit_cast(int, v)));
    return v;
}
__device__ __forceinline__ float rdlane(float v, int l) { return __builtin_bit_cast(float, __builtin_amdgcn_readlane(__builtin_bit_cast(int, v), l)); }
__device__ __forceinline__ int bperm(int srclane, int v) { return __builtin_amdgcn_ds_bpermute(srclane << 2, v); }
__constant__ double ROPE_INVF[8] = {1.0, 0.19392274474868576, 0.037606030930863933, 0.0072926647372171093, 0.0014142135623730950, 0.00027424817567620730, 5.3182958969449883e-05, 1.0313385377212460e-05};
#define XB_TMO      128
#define XB_XCNT(j)  (256  + 64 * (j))
#define XB_XSUB(j)  (1280 + 64 * (j))
#define XB_XGEN(j)  (2304 + 64 * (j))
#define XB_TOP      3328
#define XB_TOPGEN   3392
#define XCD_BAR_WORDS 3456
#define XB_SPIN_CAP (1u << 18)

__device__ __forceinline__ unsigned xb_ld(unsigned* p)              { return __hip_atomic_load(p, __ATOMIC_RELAXED, __HIP_MEMORY_SCOPE_AGENT); }
__device__ __forceinline__ unsigned xb_add(unsigned* p, unsigned v) { return __hip_atomic_fetch_add(p, v, __ATOMIC_RELAXED, __HIP_MEMORY_SCOPE_AGENT); }
__device__ __forceinline__ unsigned xb_xcc_id() { return (unsigned)__builtin_amdgcn_s_getreg((3 << 11) | 20) & 0xFu; }
#define XB_SPIN(cond, bar) do { unsigned _sp = 0; while (cond) { __builtin_amdgcn_s_sleep(1); \
    if ((++_sp & 255u) == 0u) { if (xb_ld(&(bar)[XB_TMO])) break; if (_sp > XB_SPIN_CAP) { atomicAdd(&(bar)[XB_TMO], 1u); break; } } } } while (0)

__device__ __forceinline__ bool xb_thread0_w(unsigned w, unsigned z) { return w == 0u && __builtin_amdgcn_mbcnt_hi(~0u, __builtin_amdgcn_mbcnt_lo(~0u, z)) == 0u; }
struct XcdBarrier {
    unsigned* bar; unsigned x; unsigned w, z;
    volatile LAS unsigned* st;
};

__device__ __forceinline__ XcdBarrier xcd_barrier_post(unsigned* bar, volatile LAS unsigned* st) {
    XcdBarrier b; b.bar = bar; b.x = xb_xcc_id(); b.st = st; b.w = (unsigned)__builtin_amdgcn_readfirstlane((int)(threadIdx.x >> 6)); b.z = 0u;
    if (xb_thread0_w(b.w, b.z)) (void)xb_add(&bar[XB_XCNT(b.x)], 1u);
    return b;
}
__device__ __forceinline__ void xcd_barrier_complete(unsigned* bar, unsigned x, unsigned& nloc, unsigned& nx) {
    const unsigned G = gridDim.x * gridDim.y * gridDim.z;
    unsigned sum, cnt, mine, sp = 0u;
    for (;;) {
        sum = 0u; cnt = 0u; mine = 0u;
#pragma unroll
        for (unsigned j = 0; j < 16; ++j) { const unsigned c = xb_ld(&bar[XB_XCNT(j)]); sum += c; cnt += (c > 0u) ? 1u : 0u; mine = (j == x) ? c : mine; }
        if (sum == G) break;
        __builtin_amdgcn_s_sleep(1);
        if ((++sp & 255u) == 0u) { if (xb_ld(&bar[XB_TMO])) break; if (sp > XB_SPIN_CAP) { atomicAdd(&bar[XB_TMO], 1u); break; } }
    }
    nloc = mine > 0u ? mine : 1u; nx = cnt > 0u ? cnt : 1u;
}

__device__ __forceinline__ void xcd_barrier(const XcdBarrier& b) {
    asm volatile("s_waitcnt vmcnt(0)" ::: "memory");
    __syncthreads();
    if (xb_thread0_w(b.w, b.z)) {
        unsigned* bar = b.bar;
        __builtin_amdgcn_s_waitcnt(0);
        unsigned nloc = b.st[0], nx = b.st[1];
        if (nloc == 0u) { xcd_barrier_complete(bar, b.x, nloc, nx); b.st[0] = nloc; b.st[1] = nx; }
        const unsigned old = xb_add(&bar[XB_XSUB(b.x)], 1u);
        const unsigned gen = old / nloc;
        if (old + 1u == (gen + 1u) * nloc) {
            __builtin_amdgcn_fence(__ATOMIC_RELEASE, "agent");
            asm volatile("s_waitcnt vmcnt(0)" ::: "memory");
            const unsigned og = xb_add(&bar[XB_TOP], 1u);
            const unsigned tg = og / nx;
            if (og + 1u == (tg + 1u) * nx) xb_add(&bar[XB_TOPGEN], 1u);
            else XB_SPIN(xb_ld(&bar[XB_TOPGEN]) == tg, bar);
            __builtin_amdgcn_fence(__ATOMIC_ACQUIRE, "agent");
            xb_add(&bar[XB_XGEN(b.x)], 1u);
            asm volatile("s_waitcnt vmcnt(0)" ::: "memory");
        } else {
            XB_SPIN(xb_ld(&bar[XB_XGEN(b.x)]) == gen, bar);
            __builtin_amdgcn_fence(__ATOMIC_ACQUIRE, "agent");
            asm volatile("s_waitcnt vmcnt(0)" ::: "memory");
        }
    }
    __syncthreads();
}

struct Frame {
    LAS unsigned char* lds;
    unsigned* ctl;
    int tid, lane, wave, vcu, G, bx, zv, zs, rep;
    unsigned char* ws;
    const float* const* in;
    float* out;
};
#define WSP(T, off) ((T*)(F.ws + (off)))
__device__ __forceinline__ size_t toff(int row, int k, int K) { return (size_t)(row >> 8) * 256 * K + (size_t)(k >> 6) * (256 * 64) + (size_t)(row & 255) * 64 + (k & 63); }

#ifndef TILED_FFN1
#define TILED_FFN1 0
#endif
#ifndef Q8_W1
#define Q8_W1 0.f
#define Q8_W2 0.f
#define Q8_HN 0.f
#define Q8_HID 0.f
#endif
__device__ __forceinline__ int map_row(int kind, int off, int n) { return kind == 0 ? n + off : (kind == 1 ? (n < 1932 ? n : n + 116) : ((n >> 7) * 256 + (n & 127) + off)); }
__device__ __forceinline__ void tr_item(const float* W, int ldw, int N, int ks, int n0, bf16* WT, int ldt, int kd, int kind, int off, LAS unsigned char* scr, int lane, float q8s = 0.f, int tiled = 0) {
    const int nq = (lane & 15) * 4, kq = lane >> 4;
    f32x4 x[16];
#pragma unroll
    for (int i = 0; i < 16; ++i) x[i] = (n0 + nq < N) ? *(const f32x4*)(W + (size_t)(ks + 4 * i + kq) * ldw + n0 + nq) : (f32x4){0.f, 0.f, 0.f, 0.f};
#pragma unroll
    for (int i = 0; i < 16; ++i) { const int k = 4 * i + kq;
#pragma unroll
        for (int c = 0; c < 4; ++c) { float wv = x[i][c]; if (q8s > 0.f) wv = q8r(wv, q8s); *(LAS bf16*)(scr + (nq + c) * 136 + k * 2) = (bf16)f2bf(wv); } }
    LDS_WAIT(); asm volatile("" ::: "memory");
    if (n0 + lane < N) { const LAS v2u* s = (const LAS v2u*)(scr + lane * 136); const int mr = map_row(kind, off, n0 + lane); bf16* dst = tiled ? WT + toff(mr, kd, ldt) : WT + (size_t)mr * ldt + kd;
#pragma unroll
        for (int q = 0; q < 8; ++q) { const v2u a = s[2 * q], b = s[2 * q + 1]; *(v4u*)(dst + 8 * q) = (v4u){a.x, a.y, b.x, b.y}; } }
    LDS_WAIT(); asm volatile("" ::: "memory");
}
__device__ __forceinline__ void conv(Frame& F, const float* W, size_t sW, int nb, int ldw, int N, int ks0, int K, bf16* WT, size_t sWT, int ldt, int kd0, int kind, int off, float q8s = 0.f, int tiled = 0) {
    LAS unsigned char* scr = F.lds + RING_OFF + F.wave * 16384;
    const int gw = F.vcu * NWAVES + F.wave, NGW = F.G * NWAVES;
    const int nblk = (N + 63) / 64, per = (K / 64) * nblk, total = per * nb;
    for (int it = gw; it < total; it += NGW) { const int b = it / per, r = it % per, kb = r / nblk, nbk = r % nblk;
        tr_item(W + (size_t)b * sW, ldw, N, ks0 + 64 * kb, 64 * nbk, WT + (size_t)b * sWT, ldt, kd0 + 64 * kb, kind, off, scr, F.lane, q8s, tiled); }
}
__device__ __forceinline__ void zero_block(Frame& F, bf16* WT, int ldt, int r0, int rows, int c0, int cols, int tiled = 0) {
    const int gt = (F.vcu * NWAVES + F.wave) * 64 + F.lane, NT = F.G * NWAVES * 64, cpr = cols / 8;
    for (int i = gt; i < rows * cpr; i += NT) { const int r = i / cpr, c = i % cpr; const unsigned z = (unsigned)F.zv; *(v4u*)(tiled ? WT + toff(r0 + r, c0 + 8 * c, ldt) : WT + (size_t)(r0 + r) * ldt + c0 + 8 * c) = (v4u){z, z, z, z}; }
}
__device__ __forceinline__ void p_convert(Frame& F, int layer) {
    const int j = layer >> 1;
    conv(F, F.in[2] + (size_t)layer * DM * CIN, 0, 1, CIN, CIN, 0, DM, WSP(bf16, WS_WIN), 0, DM, 0, 1, 0);
    zero_block(F, WSP(bf16, WS_WIN), DM, 1932, 116, 0, DM);
    conv(F, F.in[9] + (size_t)layer * 3 * 256 * DM, (size_t)256 * DM, 3, DM, DM, 0, 256, WSP(bf16, WS_WBR), (size_t)DM * 256, 256, 0, 0, 0);
    conv(F, F.in[10] + (size_t)layer * DM * DM, 0, 1, DM, DM, 0, DM, WSP(bf16, WS_WOUT), 0, DM, 0, 0, 0);
    conv(F, F.in[7] + (size_t)layer * 2 * 2048 * 256, (size_t)2048 * 256, 2, 256, 256, 0, 1024, WSP(bf16, WS_WC1), (size_t)512 * 1024, 1024, 0, 0, 0);
    conv(F, F.in[7] + (size_t)layer * 2 * 2048 * 256, (size_t)2048 * 256, 2, 256, 256, 1024, 1024, WSP(bf16, WS_WC1), (size_t)512 * 1024, 1024, 0, 0, 256);
    if ((layer & 1) == 0) {
        conv(F, F.in[12] + (size_t)j * DM * DFF, 0, 1, DFF, DFF, 0, DM, WSP(bf16, WS_WF1), 0, DM, 0, 2, 0, Q8_W1, TILED_FFN1);
        conv(F, F.in[13] + (size_t)j * DM * DFF, 0, 1, DFF, DFF, 0, DM, WSP(bf16, WS_WF1), 0, DM, 0, 2, 128, Q8_W1, TILED_FFN1);
        zero_block(F, WSP(bf16, WS_WF1), DM, 21 * 256 + 64, 64, 0, DM, TILED_FFN1);
        zero_block(F, WSP(bf16, WS_WF1), DM, 21 * 256 + 128 + 64, 64, 0, DM, TILED_FFN1);
        conv(F, F.in[14] + (size_t)j * DFF * DM, 0, 1, DM, DM, 0, DFF, WSP(bf16, WS_WF2), 0, DFFP, 0, 0, 0, Q8_W2);
        zero_block(F, WSP(bf16, WS_WF2), DFFP, 0, DM, DFF, DFFP - DFF);
    } else {
        conv(F, F.in[16] + (size_t)j * NEXP * DM * DFE, (size_t)DM * DFE, NEXP, DFE, DFE, 0, DM, WSP(bf16, WS_WF1), (size_t)NMOE1 * DM, DM, 0, 2, 0, Q8_W1);
        conv(F, F.in[17] + (size_t)j * NEXP * DM * DFE, (size_t)DM * DFE, NEXP, DFE, DFE, 0, DM, WSP(bf16, WS_WF1), (size_t)NMOE1 * DM, DM, 0, 2, 128, Q8_W1);
        conv(F, F.in[18] + (size_t)j * NEXP * DFE * DM, (size_t)DFE * DM, NEXP, DM, DM, 0, DFE, WSP(bf16, WS_WF2), (size_t)DM * DFE, DFE, 0, 0, 0, Q8_W2);
    }
    if (F.bx < 8) {
        __syncthreads();
        const int kv = F.bx >> 2, jj = (F.bx & 3) * 64 + F.lane;
        const float* pos = F.in[6] + (size_t)(layer * 2 + kv) * 2048; const float* w1 = F.in[7] + (size_t)(layer * 2 + kv) * 2048 * 256;
        float a = 0.f;
        float a1 = 0.f, a2 = 0.f, a3 = 0.f;
#pragma unroll 8
        for (int k = 0; k < 256; k += 4) { const int kk = F.wave * 256 + k;
            a += pos[kk] * w1[(size_t)kk * 256 + jj]; a1 += pos[kk + 1] * w1[(size_t)(kk + 1) * 256 + jj]; a2 += pos[kk + 2] * w1[(size_t)(kk + 2) * 256 + jj]; a3 += pos[kk + 3] * w1[(size_t)(kk + 3) * 256 + jj]; }
        a = (a + a1) + (a2 + a3);
        LAS float* red = (LAS float*)(F.lds + RING_OFF);
        red[F.wave * 64 + F.lane] = a;
        __syncthreads();
        if (F.wave == 0) { float s = 0.f;
#pragma unroll
            for (int w = 0; w < 8; ++w) s += red[w * 64 + F.lane];
            WSP(float, WS_BIAS1)[kv * 256 + jj] = s; }
        __syncthreads();
    }
    if (layer == 0) {
        const int gt = (F.vcu * NWAVES + F.wave) * 64 + F.lane, NT = F.G * NWAVES * 64;
        for (int idx = gt; idx < SEQ * 8; idx += NT) { const int pos = idx >> 3, i = idx & 7;
            const double invf = ROPE_INVF[i];
            double rev = (double)pos * invf * 0.15915494309189535; rev -= __builtin_floor(rev);
            WSP(float, WS_ROPE)[idx] = __builtin_amdgcn_cosf((float)rev); WSP(float, WS_ROPE)[SEQ * 8 + idx] = __builtin_amdgcn_sinf((float)rev); }
    }
}

template <bool S16> __device__ __forceinline__ f32x4 ld_row4(const void* src, size_t m, int lane, int jx) {
    if (S16) { const v2u t = ((const v2u*)((const bf16*)src + m * DM) + lane)[64 * jx]; return (f32x4){bflo(t.x), bfhi(t.x), bflo(t.y), bfhi(t.y)}; }
    return ((const f32x4*)((const float*)src + m * DM) + lane)[64 * jx];
}
template <int MODE, bool S16> __device__ __forceinline__ void p_norm(Frame& F, const void* src, const float* g, const float* rw, int jmoe, float q8s = 0.f, int tiled = 0) {
    const int gw = F.vcu * NWAVES + F.wave, NGW = F.G * NWAVES, lane = F.lane;
    LAS int* hist = (LAS int*)(F.lds + TAB_OFF) + 192;
    if (MODE == 1) {
        if (F.tid < 16) hist[F.tid] = 0;
        const int gt = gw * 64 + lane, NT = NGW * 64; int* tm = WSP(int, WS_TOKMAP);
        for (int i = gt; i < 4 * SLOTS; i += NT) tm[i] = -1;
        for (int i = F.tid; i < DM * NEXP / 4; i += NWAVES * 64) { const int c = i >> 1, hf = i & 1;
            *(LAS f32x4*)(F.lds + RING_OFF + (((((c >> 8) * 4 + (c & 3)) * 2 + hf) * 64 + ((c & 255) >> 2)) * 16)) = ((const f32x4*)rw)[i]; }
        if (F.tid < DM / 4) *(LAS f32x4*)(F.lds + RING_OFF + 32768 + 16 * F.tid) = ((const f32x4*)g)[F.tid];
        __syncthreads();
    }
    f32x4 gv[4];
    if (MODE != 1) {
#pragma unroll
        for (int jx = 0; jx < 4; ++jx) gv[jx] = ((const f32x4*)g)[lane + 64 * jx]; }
    constexpr int ROWS = (MODE == 1) ? 2 : 4;
    const int nit = (MODE == 1) ? ((MTOK / 128 - F.bx + F.G - 1) / F.G) * (16 / ROWS) : (MTOK - gw + ROWS * NGW - 1) / (ROWS * NGW);
    f32x4 nv[MODE == 1 ? ROWS : 1][4];
    for (int itx = 0; itx < nit; ++itx) {
        const int chk = (MODE == 1) ? F.bx + (itx / (16 / ROWS)) * F.G : 0;
        const int m0 = (MODE == 1) ? chk * 128 + (itx % (16 / ROWS)) * (NWAVES * ROWS) + F.wave * ROWS : gw + itx * ROWS * NGW;
        const int mstep = (MODE == 1) ? 1 : NGW;
        f32x4 v[ROWS][4]; float ss[ROWS];
        if (MODE == 1) {
            if (itx == 0) {
#pragma unroll
                for (int u = 0; u < ROWS; ++u) {
#pragma unroll
                    for (int jx = 0; jx < 4; ++jx) nv[u][jx] = ld_row4<S16>(src, (size_t)(m0 + u), lane, jx); } }
#pragma unroll
            for (int u = 0; u < ROWS; ++u)
#pragma unroll
                for (int jx = 0; jx < 4; ++jx) v[u][jx] = nv[u][jx];
            if (itx + 1 < nit) { const int itn = itx + 1; const int mn = (F.bx + (itn / (16 / ROWS)) * F.G) * 128 + (itn % (16 / ROWS)) * (NWAVES * ROWS) + F.wave * ROWS;
#pragma unroll
                for (int u = 0; u < ROWS; ++u) {
#pragma unroll
                    for (int jx = 0; jx < 4; ++jx) nv[u][jx] = ld_row4<S16>(src, (size_t)(mn + u), lane, jx); } }
        } else {
#pragma unroll
        for (int u = 0; u < ROWS; ++u) { const int m = m0 + u * mstep;
#pragma unroll
            for (int jx = 0; jx < 4; ++jx) v[u][jx] = ld_row4<S16>(src, (size_t)(m < MTOK ? m : m0), lane, jx); }
        }
#pragma unroll
        for (int u = 0; u < ROWS; ++u) { float s = 0.f;
#pragma unroll
            for (int jx = 0; jx < 4; ++jx) s += (v[u][jx].x * v[u][jx].x + v[u][jx].y * v[u][jx].y) + (v[u][jx].z * v[u][jx].z + v[u][jx].w * v[u][jx].w);
            ss[u] = s; }
#pragma unroll
        for (int o = 1; o < 64; o <<= 1) {
#pragma unroll
            for (int u = 0; u < ROWS; ++u) ss[u] += __builtin_bit_cast(float, __builtin_amdgcn_ds_bpermute((lane ^ o) << 2, __builtin_bit_cast(int, ss[u]))); }
        float lgall[MODE == 1 ? ROWS : 1][8];
        if (MODE == 1) {
            float rs[ROWS];
#pragma unroll
            for (int u = 0; u < ROWS; ++u) { rs[u] = 1.0f / sqrtf(ss[u] * (1.f / DM) + EPS);
#pragma unroll
                for (int e = 0; e < 8; ++e) lgall[u][e] = 0.f; }
#pragma unroll
            for (int jx = 0; jx < 4; ++jx) { const f32x4 gl = *(const LAS f32x4*)(F.lds + RING_OFF + 32768 + 16 * (lane + 64 * jx));
#pragma unroll
                for (int u = 0; u < ROWS; ++u) v[u][jx] = v[u][jx] * rs[u] * gl; }
#pragma unroll
            for (int jx = 0; jx < 4; ++jx) { const LAS f32x4* wr = (const LAS f32x4*)(F.lds + RING_OFF + jx * 8192 + lane * 16);
#pragma unroll
                for (int r = 0; r < 4; ++r) { const f32x4 a = wr[128 * r], b = wr[128 * r + 64];
#pragma unroll
                    for (int u = 0; u < ROWS; ++u) { const float xv = v[u][jx][r];
                        lgall[u][0] += xv * a.x; lgall[u][1] += xv * a.y; lgall[u][2] += xv * a.z; lgall[u][3] += xv * a.w; lgall[u][4] += xv * b.x; lgall[u][5] += xv * b.y; lgall[u][6] += xv * b.z; lgall[u][7] += xv * b.w; } } }
        }
#pragma unroll
        for (int u = 0; u < ROWS; ++u) { const int m = m0 + u * mstep; if (m >= MTOK) continue;
            const float rstd = 1.0f / sqrtf(ss[u] * (1.f / DM) + EPS);
            if (MODE != 1) {
#pragma unroll
            for (int jx = 0; jx < 4; ++jx) v[u][jx] = v[u][jx] * rstd * gv[jx]; }
            if (MODE == 2) {
                f32x4* o = (f32x4*)(F.out + (size_t)m * DM) + lane;
#pragma unroll
                for (int jx = 0; jx < 4; ++jx) o[64 * jx] = v[u][jx];
            } else {
                unsigned long long* o8 = (unsigned long long*)(WSP(bf16, WS_HN) + (size_t)m * DM) + lane;
#pragma unroll
                for (int jx = 0; jx < 4; ++jx) { f32x4 w = v[u][jx];
                    if (tiled) { *(unsigned long long*)(WSP(bf16, WS_HN) + toff(m, 4 * lane + 256 * jx, DM)) = (unsigned long long)pk2(w.x, w.y) | ((unsigned long long)pk2(w.z, w.w) << 32); continue; } if (q8s > 0.f) { w.x = q8r(w.x, q8s); w.y = q8r(w.y, q8s); w.z = q8r(w.z, q8s); w.w = q8r(w.w, q8s); }
                    o8[64 * jx] = (unsigned long long)pk2(w.x, w.y) | ((unsigned long long)pk2(w.z, w.w) << 32); }
            }
            if (MODE == 1) {
                float lg[8];
#pragma unroll
                for (int e = 0; e < 8; ++e) lg[e] = lgall[u][e];
                float h4[4], h2[2], h1;
                { const bool up = lane & 1;
#pragma unroll
                  for (int i = 0; i < 4; ++i) { const float keep = up ? lg[4 + i] : lg[i], send = up ? lg[i] : lg[4 + i]; h4[i] = keep + __builtin_bit_cast(float, bperm(lane ^ 1, __builtin_bit_cast(int, send))); } }
                { const bool up = lane & 2;
#pragma unroll
                  for (int i = 0; i < 2; ++i) { const float keep = up ? h4[2 + i] : h4[i], send = up ? h4[i] : h4[2 + i]; h2[i] = keep + __builtin_bit_cast(float, bperm(lane ^ 2, __builtin_bit_cast(int, send))); } }
                { const bool up = lane & 4; const float keep = up ? h2[1] : h2[0], send = up ? h2[0] : h2[1]; h1 = keep + __builtin_bit_cast(float, bperm(lane ^ 4, __builtin_bit_cast(int, send))); }
                h1 += __builtin_bit_cast(float, bperm(lane ^ 8, __builtin_bit_cast(int, h1))); h1 += __builtin_bit_cast(float, bperm(lane ^ 16, __builtin_bit_cast(int, h1))); h1 += __builtin_bit_cast(float, bperm(lane ^ 32, __builtin_bit_cast(int, h1)));
                lg[0] = rdlane(h1, 0); lg[1] = rdlane(h1, 4); lg[2] = rdlane(h1, 2); lg[3] = rdlane(h1, 6); lg[4] = rdlane(h1, 1); lg[5] = rdlane(h1, 5); lg[6] = rdlane(h1, 3); lg[7] = rdlane(h1, 7);
                int e0 = 0; float v0 = lg[0];
#pragma unroll
                for (int e = 1; e < 8; ++e) if (lg[e] > v0) { v0 = lg[e]; e0 = e; }
                int e1 = -1; float v1 = -INFINITY;
#pragma unroll
                for (int e = 0; e < 8; ++e) if (e != e0 && lg[e] > v1) { v1 = lg[e]; e1 = e; }
                const float w0 = 1.0f / (1.0f + fexp(v1 - v0)), w1 = 1.0f - w0;
                if (lane == 0) { WSP(v4i, WS_ROUTE)[m] = (v4i){e0, e1, __builtin_bit_cast(int, w0), __builtin_bit_cast(int, w1)};
                    __hip_atomic_fetch_add(&hist[e0], 1, __ATOMIC_RELAXED, __HIP_MEMORY_SCOPE_WORKGROUP); __hip_atomic_fetch_add(&hist[8 + e1], 1, __ATOMIC_RELAXED, __HIP_MEMORY_SCOPE_WORKGROUP); }
            }
        }
        if (MODE == 1 && (itx % (16 / ROWS)) == 16 / ROWS - 1) {
            __syncthreads();
            if (F.tid < 16) { WSP(int, WS_CNT128)[(size_t)chk * 16 + F.tid] = hist[F.tid]; hist[F.tid] = 0; }
            __syncthreads();
        }
    }
}

__device__ __forceinline__ void p_prep(Frame& F) {
    const int gw = F.vcu * NWAVES + F.wave, NGW = F.G * NWAVES, lane = F.lane;
    bf16* P1 = WSP(bf16, WS_P1); bf16* KVC = WSP(bf16, WS_KVC); const float* rope = WSP(float, WS_ROPE);
    const int vec = lane >> 3, ri = lane & 7; const int cb = vec < 4 ? C_CQ + vec * 64 : (vec == 4 ? C_KCMP : (vec == 5 ? C_KSLC : C_KWIN));
    for (int row0 = gw; row0 < MC; row0 += 4 * NGW) {
        float x1[4], x2[4], cc[4], ss[4]; bf16 kc48[4], vc64[4];
#pragma unroll
        for (int k = 0; k < 4; ++k) { const int row = row0 + k * NGW < MC ? row0 + k * NGW : row0; const bf16* p = P1 + (size_t)row * P1W; const int pos = row & (SEQ - 1);
            const int cl = lane < 56 ? cb + ri : C_CQ;
            x1[k] = bf1(p[cl]); x2[k] = bf1(p[cl + 8]); cc[k] = rope[pos * 8 + ri]; ss[k] = rope[SEQ * 8 + pos * 8 + ri];
            if (F.rep) { cc[k] = 1.f; ss[k] = 0.f; }
            kc48[k] = p[C_KCMP + 16 + (lane < 48 ? lane : 0)]; vc64[k] = p[C_VCMP + lane]; }
#pragma unroll
        for (int k = 0; k < 4; ++k) { const int row = row0 + k * NGW; if (row >= MC) continue; bf16* p = P1 + (size_t)row * P1W;
            if (lane < 56) { const bf16 o1 = (bf16)f2bf(x1[k] * cc[k] - x2[k] * ss[k]), o2 = (bf16)f2bf(x2[k] * cc[k] + x1[k] * ss[k]);
                p[cb + ri] = o1; p[cb + ri + 8] = o2;
                if (vec == 4) { KVC[(size_t)row * 64 + ri] = o1; KVC[(size_t)row * 64 + ri + 8] = o2; } }
            if (lane < 48) KVC[(size_t)row * 64 + 16 + lane] = kc48[k];
            KVC[(size_t)MC * 64 + (size_t)row * 64 + lane] = vc64[k]; }
    }
    bf16* VT = WSP(bf16, WS_VT);
    for (int it = gw; it < 6 * BC * 64; it += NGW) { const int which = it / (BC * 64), r = it % (BC * 64), b = r >> 6, blk = r & 63;
        const v4u* src = (const v4u*)(P1 + ((size_t)b * SEQ + blk * 64 + lane) * P1W + (which == 0 ? C_VSLC : (which == 1 ? C_VWIN : C_SBV + (which - 2) * 64)));
        bf16* dst = VT + ((size_t)(which * BC + b) * 64) * SEQ + blk * 64 + lane;
        v4u xs[8];
#pragma unroll
        for (int i = 0; i < 8; ++i) xs[i] = src[i];
#pragma unroll
        for (int i = 0; i < 8; ++i) { const v4u x = xs[i];
            dst[(size_t)(8 * i + 0) * SEQ] = (bf16)(x.x & 0xffffu); dst[(size_t)(8 * i + 1) * SEQ] = (bf16)(x.x >> 16);
            dst[(size_t)(8 * i + 2) * SEQ] = (bf16)(x.y & 0xffffu); dst[(size_t)(8 * i + 3) * SEQ] = (bf16)(x.y >> 16);
            dst[(size_t)(8 * i + 4) * SEQ] = (bf16)(x.z & 0xffffu); dst[(size_t)(8 * i + 5) * SEQ] = (bf16)(x.z >> 16);
            dst[(size_t)(8 * i + 6) * SEQ] = (bf16)(x.w & 0xffffu); dst[(size_t)(8 * i + 7) * SEQ] = (bf16)(x.w >> 16); }
    }
}
__device__ __forceinline__ void p_sgu(Frame& F, int layer) {
    LAS float* vn = (LAS float*)(F.lds + RING_OFF);
    const bf16* P1 = WSP(bf16, WS_P1); bf16* Ya = WSP(bf16, WS_Y);
    const float* gain = F.in[3] + (size_t)layer * 256; const float* sw = F.in[4] + (size_t)layer * 4 * 128 * 128; const float* sb = F.in[5] + (size_t)layer * 4 * 128;
    const int lane = F.lane, wave = F.wave;
    for (int item = F.vcu; item < MC / 128; item += F.G) {
        const size_t r0 = (size_t)item * 128;
        __syncthreads();
        for (int rr = 0; rr < 16; ++rr) { const int r = wave * 16 + rr; const v2u raw = *(const v2u*)(P1 + (r0 + r) * P1W + C_V + 4 * lane);
            const float a = bflo(raw.x), b = bfhi(raw.x), c = bflo(raw.y), d = bfhi(raw.y);
            const float rstd = 1.0f / sqrtf(wave_sum((a * a + b * b) + (c * c + d * d), lane) * (1.f / 256.f) + EPS);
            const f32x4 gg = ((const f32x4*)gain)[lane];
            *(LAS f32x4*)(vn + r * 256 + 4 * lane) = (f32x4){a * rstd * gg.x, b * rstd * gg.y, c * rstd * gg.z, d * rstd * gg.w}; }
        __syncthreads();
        const int g = wave & 3, half = wave >> 2;
        for (int i = 0; i < 64; ++i) { const int t = 2 * i + half;
            const float* wrow = sw + ((size_t)g * 128 + t) * 128;
            const float w_lo = wrow[lane], w_hi = wrow[64 + lane];
            float acc = 0.f;
            for (int s = 0; s <= t; ++s) { const float w = (s < 64) ? rdlane(w_lo, s) : rdlane(w_hi, s - 64); acc += w * vn[s * 256 + g * 64 + lane]; }
            const float u = bf1(P1[(r0 + t) * P1W + C_U + g * 64 + lane]);
#ifdef ABL_SGUMIX
            acc = 0.f;
#endif
            Ya[(r0 + t) * 256 + g * 64 + lane] = (bf16)f2bf(u * (acc + sb[g * 128 + t])); }
    }
    __syncthreads();
}

__device__ __forceinline__ void p_cmpfin(Frame& F, int layer) {
    const int gw = F.vcu * NWAVES + F.wave, NGW = F.G * NWAVES, lane = F.lane;
    const float* UL = WSP(float, WS_UL); const float* bias = WSP(float, WS_BIAS1); bf16* KC = WSP(bf16, WS_KC);
    LAS float* w2l = (LAS float*)(F.lds + RING_OFF);
    __syncthreads();
    { const f32x4* src = (const f32x4*)(F.in[8] + (size_t)layer * 2 * 256 * 64);
#pragma unroll 4
      for (int i = F.tid; i < 2 * 256 * 64 / 4; i += NWAVES * 64) *(LAS f32x4*)(w2l + 4 * i) = src[i]; }
    __syncthreads();
    for (int it = gw; it < 2 * BC * 255; it += NGW) { const int kv = it / (BC * 255), r = it % (BC * 255), b = r / 255, m = r % 255;
        const LAS float* w2 = w2l + kv * 256 * 64;
        const float* U = UL + (size_t)(kv * 2048 + b * 256 + m) * 512; const float* L = U + 512 + 256;
        float hv[4];
#pragma unroll
        for (int q = 0; q < 4; ++q) hv[q] = pg8::gelu_tanh(U[64 * q + lane] + L[64 * q + lane] + bias[kv * 256 + 64 * q + lane]);
        float acc0 = 0.f, acc1 = 0.f;
#pragma unroll
        for (int q = 0; q < 4; ++q)
#pragma unroll 8
            for (int jj = 0; jj < 64; jj += 2) { acc0 += rdlane(hv[q], jj) * w2[(64 * q + jj) * 64 + lane]; acc1 += rdlane(hv[q], jj + 1) * w2[(64 * q + jj + 1) * 64 + lane]; }
        const float acc = acc0 + acc1;
        KC[((size_t)(kv * BC + b) * 256 + m) * 64 + lane] = (bf16)f2bf(acc);
        if (kv == 1) { WSP(bf16, WS_KCT)[((size_t)b * 64 + lane) * 256 + m] = (bf16)f2bf(acc); if (m == 254) WSP(bf16, WS_KCT)[((size_t)b * 64 + lane) * 256 + 255] = (bf16)0; }
        else if (m == 254) KC[((size_t)b * 256 + 255) * 64 + lane] = (bf16)0; }
    __syncthreads();
}

__device__ __forceinline__ void p_stick(Frame& F) {
    const int gw = F.vcu * NWAVES + F.wave, NGW = F.G * NWAVES, lane = F.lane;
    const bf16* P1 = WSP(bf16, WS_P1); bf16* Yb = WSP(bf16, WS_Y) + (size_t)MC * 256;
    for (int item = gw; item < BC * 4 * 64; item += NGW) { const int tb = item & 63, h = (item >> 6) & 3, b = item >> 8;
        const int t = tb * 64 + lane; const size_t row = (size_t)b * SEQ + t;
        unsigned q[32];
        { const v4u* qp = (const v4u*)(P1 + row * P1W + C_SBQ + h * 64);
#pragma unroll
          for (int i = 0; i < 8; ++i) { const v4u x = qp[i]; q[4 * i] = x.x; q[4 * i + 1] = x.y; q[4 * i + 2] = x.z; q[4 * i + 3] = x.w; } }
        float o[64];
#pragma unroll
        for (int d = 0; d < 64; ++d) o[d] = 0.f;
        float R = 0.f;
        const bf16* kb = P1 + (size_t)b * SEQ * P1W + C_SBK + h * 64; const bf16* vb = P1 + (size_t)b * SEQ * P1W + C_SBV + h * 64;
        for (int s = t - 1; s >= 0; --s) {
            if (R < -100.f) break;
            const v4u* kp = (const v4u*)(kb + (size_t)s * P1W); const v4u* vp = (const v4u*)(vb + (size_t)s * P1W);
            float z0 = 0.f, z1 = 0.f;
#pragma unroll
            for (int i = 0; i < 8; ++i) { const v4u k = kp[i]; z0 = dot2bf(k.x, q[4 * i], z0); z1 = dot2bf(k.y, q[4 * i + 1], z1); z0 = dot2bf(k.z, q[4 * i + 2], z0); z1 = dot2bf(k.w, q[4 * i + 3], z1); }
            const float z = (z0 + z1) * 0.125f;
            const float tt = 0.6931471805599453f * __builtin_amdgcn_logf(1.0f + fexp(-__builtin_fabsf(z)));
            const float lb = fminf(z, 0.f) - tt, l1m = fminf(-z, 0.f) - tt;
            const float a = fexp(lb + R); R += l1m;
#pragma unroll
            for (int i = 0; i < 8; ++i) { const v4u v = vp[i];
                o[8 * i] += a * bflo(v.x); o[8 * i + 1] += a * bfhi(v.x); o[8 * i + 2] += a * bflo(v.y); o[8 * i + 3] += a * bfhi(v.y);
                o[8 * i + 4] += a * bflo(v.z); o[8 * i + 5] += a * bfhi(v.z); o[8 * i + 6] += a * bflo(v.w); o[8 * i + 7] += a * bfhi(v.w); }
        }
        v4u* op = (v4u*)(Yb + row * 256 + h * 64);
#pragma unroll
        for (int i = 0; i < 8; ++i) op[i] = (v4u){pk2(o[8 * i], o[8 * i + 1]), pk2(o[8 * i + 2], o[8 * i + 3]), pk2(o[8 * i + 4], o[8 * i + 5]), pk2(o[8 * i + 6], o[8 * i + 7])};
    }
}

struct Soft { float mx, l; };
__device__ __forceinline__ float dotq(const LAS v4u* ql, const bf16* kp_) {
    const v4u* kp = (const v4u*)kp_; float z0 = 0.f, z1 = 0.f;
#pragma unroll
    for (int i = 0; i < 8; ++i) { const v4u k = kp[i]; const v4u q = ql[i]; z0 = dot2bf(k.x, q.x, z0); z1 = dot2bf(k.y, q.y, z1); z0 = dot2bf(k.z, q.z, z0); z1 = dot2bf(k.w, q.w, z1); }
    return (z0 + z1) * 0.125f;
}
__device__ __forceinline__ void axpy_row(float p, const bf16* vp_, float (&o)[64]) {
    const v4u* vp = (const v4u*)vp_;
#pragma unroll
    for (int i = 0; i < 8; ++i) { const v4u v = vp[i];
        o[8 * i] += p * bflo(v.x); o[8 * i + 1] += p * bfhi(v.x); o[8 * i + 2] += p * bflo(v.y); o[8 * i + 3] += p * bfhi(v.y);
        o[8 * i + 4] += p * bflo(v.z); o[8 * i + 5] += p * bfhi(v.z); o[8 * i + 6] += p * bflo(v.w); o[8 * i + 7] += p * bfhi(v.w); }
}
__device__ __forceinline__ void nsa_step(const LAS v4u* ql, const bf16* kp_, const bf16* vp_, Soft& S, float (&o)[64]) {
    const float s = dotq(ql, kp_);
    if (s > S.mx) { const float sc = fexp(S.mx - s); S.l *= sc;
#pragma unroll
        for (int d = 0; d < 64; ++d) o[d] *= sc;
        S.mx = s; }
    const float p = fexp(s - S.mx); S.l += p;
    asm volatile("" ::: "memory");
    axpy_row(p, vp_, o);
}
__device__ __forceinline__ void nsa_accum(bf16* yrow, bool first, float sc, const float (&o)[64]) {
    v4u* op = (v4u*)yrow;
#pragma unroll
    for (int i = 0; i < 8; ++i) { v4u old = (v4u){0u, 0u, 0u, 0u}; if (!first) old = op[i];
        op[i] = (v4u){pk2(bflo(old.x) + sc * o[8 * i], bfhi(old.x) + sc * o[8 * i + 1]), pk2(bflo(old.y) + sc * o[8 * i + 2], bfhi(old.y) + sc * o[8 * i + 3]),
                      pk2(bflo(old.z) + sc * o[8 * i + 4], bfhi(old.z) + sc * o[8 * i + 5]), pk2(bflo(old.w) + sc * o[8 * i + 6], bfhi(old.w) + sc * o[8 * i + 7])}; }
}
__device__ __forceinline__ void p_nsa(Frame& F) {
    const int gw = F.vcu * NWAVES + F.wave, NGW = F.G * NWAVES, lane = F.lane;
    const bf16* P1 = WSP(bf16, WS_P1); const bf16* KC = WSP(bf16, WS_KC); bf16* Yc = WSP(bf16, WS_Y) + (size_t)2 * MC * 256;
    LAS float* imp = (LAS float*)(F.lds + RING_OFF + F.wave * 4096);
    LAS v4u* ql = (LAS v4u*)(F.lds + RING_OFF + 32768 + F.wave * 9216 + lane * 144);
    const int qi = lane >> 2, h = lane & 3;
    for (int item = gw; item < BC * 256; item += NGW) { const int b = item >> 8, tg = item & 255;
        const int t = tg * 16 + qi; const size_t row = (size_t)b * SEQ + t; const bf16* prow = P1 + row * P1W;
        { const v4u* qp = (const v4u*)(prow + C_CQ + h * 64);
#pragma unroll
          for (int i = 0; i < 8; ++i) ql[i] = qp[i]; }
        const float g0 = bf1(prow[C_CG + h * 3]), g1 = bf1(prow[C_CG + h * 3 + 1]), g2 = bf1(prow[C_CG + h * 3 + 2]);
        bf16* yrow = Yc + row * 256 + h * 64;
        float o[64];
        for (int i = lane; i < 1024; i += 64) imp[i] = 0.f;
        const int nv = t >= 31 ? ((t - 31) >> 4) + 1 : 0; const int nvmax = (tg * 16 + 15 >= 31) ? ((tg * 16 + 15 - 31) >> 4) + 1 : 0;
        const bf16* kc = KC + (size_t)(0 * BC + b) * 256 * 64; const bf16* vc = KC + (size_t)(1 * BC + b) * 256 * 64;
        { float mx = -INFINITY, l = 0.f;
          for (int m = 0; m < nvmax; ++m) { const float s = dotq(ql, kc + m * 64); if (m < nv) { if (s > mx) { l *= fexp(mx - s); mx = s; } l += fexp(s - mx); } }
          const float rl = l > 0.f ? 1.0f / l : 0.f;
#pragma unroll
          for (int d = 0; d < 64; ++d) o[d] = 0.f;
          for (int m = 0; m < nvmax; ++m) { const float s = dotq(ql, kc + m * 64); const float p = (m < nv) ? fexp(s - mx) * rl : 0.f;
              asm volatile("" ::: "memory");
              axpy_row(p, vc + m * 64, o);
              float P = p + __builtin_bit_cast(float, bperm(lane ^ 1, __builtin_bit_cast(int, p))); P += __builtin_bit_cast(float, bperm(lane ^ 2, __builtin_bit_cast(int, P)));
              if (h == 0) { const int j0 = m >> 2; const bool edge = (m & 3) == 3; imp[qi * 64 + j0] += edge ? 0.5f * P : P; if (edge) imp[qi * 64 + j0 + 1] += 0.5f * P; } }
          nsa_accum(yrow, true, g0, o); }
        unsigned long long mask = 0ull;
        { const int cur = t >> 6, nvb = cur + 1;
          if (h == 0) {
              if (nvb <= 16) mask = (1ull << nvb) - 1ull;
              else { mask = 1ull | (1ull << cur);
                  for (int r = 0; r < 14; ++r) { int best = -1; float bv = -1.f;
                      for (int j = 1; j < cur; ++j) { const float v = imp[qi * 64 + j]; if (!((mask >> j) & 1ull) && v > bv) { bv = v; best = j; } }
                      mask |= 1ull << best; } } }
          const unsigned mlo = (unsigned)bperm(lane & ~3, (int)(unsigned)mask), mhi = (unsigned)bperm(lane & ~3, (int)(unsigned)(mask >> 32));
          mask = ((unsigned long long)mhi << 32) | mlo; }
        { Soft S{-INFINITY, 0.f};
#pragma unroll
          for (int d = 0; d < 64; ++d) o[d] = 0.f;
          const bf16* kb = P1 + (size_t)b * SEQ * P1W + C_KSLC; const bf16* vb = P1 + (size_t)b * SEQ * P1W + C_VSLC;
          unsigned long long mm = mask;
          while (mm) { const int j = __builtin_ctzll(mm); mm &= mm - 1ull;
              for (int kk = 0; kk < 64; ++kk) { const int sp = j * 64 + kk; if (sp > t) break; nsa_step(ql, kb + (size_t)sp * P1W, vb + (size_t)sp * P1W, S, o); } }
          nsa_accum(yrow, false, g1 / S.l, o); }
        { Soft S{-INFINITY, 0.f};
#pragma unroll
          for (int d = 0; d < 64; ++d) o[d] = 0.f;
          const bf16* kb = P1 + (size_t)b * SEQ * P1W + C_KWIN; const bf16* vb = P1 + (size_t)b * SEQ * P1W + C_VWIN;
          for (int i = 0; i < 512; ++i) { const int sp = t - 511 + i; if (sp >= 0) nsa_step(ql, kb + (size_t)sp * P1W, vb + (size_t)sp * P1W, S, o); }
          nsa_accum(yrow, false, g2 / S.l, o); }
    }
}

__device__ __forceinline__ int moe_table(Frame& F, int jmoe, int c, int r, int kpre = 0) {
    LAS int* tab = (LAS int*)(F.lds + TAB_OFF); LAS int* arr = (LAS int*)(F.lds + LDSCTL_OFF + 4096);
    (void)jmoe;
    __syncthreads();
    if (F.tid < 256) { const v4i* s = (const v4i*)(WSP(int, WS_CNT128) + ((size_t)(c * 256 + F.tid) * 2 + r) * 8); const v4i a = s[0], b = s[1];
        *(LAS v4i*)(arr + F.tid * 8) = a; *(LAS v4i*)(arr + F.tid * 8 + 4) = b; }
    __syncthreads();
    if (F.tid < 8) { int tot = 0, pre = 0;
        for (int k = 0; k < 256; ++k) { const int x = arr[k * 8 + F.tid]; pre += (k < kpre) ? x : 0; tot += x; }
        tab[176 + F.tid] = tot; tab[184 + F.tid] = pre; }
    __syncthreads();
    if (F.tid == 0) { int base = 0, T = 0;
        for (int e = 0; e < 8; ++e) { const int cnt = tab[176 + e];
            const int nt = (cnt + 255) >> 8; tab[160 + e] = base; for (int i = 0; i < nt && T + i < 160; ++i) tab[T + i] = e; T += nt; base += nt * 256; }
        tab[168] = T < 136 ? T : 136; }
    __syncthreads();
    return tab[168];
}
__device__ __forceinline__ void p_gather(Frame& F, int jmoe, int c, int r, int nbusy = 0) {
    if (F.bx < nbusy) return;
    LAS int* tab = (LAS int*)(F.lds + TAB_OFF); LAS int* cntw = tab + 256; LAS int* basew = tab + 320;
    const int lane = F.lane, wave = F.wave;
    const v4i* route = WSP(v4i, WS_ROUTE); int* tokmap = WSP(int, WS_TOKMAP) + (c * 2 + r) * SLOTS; float* wslot = WSP(float, WS_WSLOT) + (c * 2 + r) * SLOTS;
    const bf16* HN = WSP(bf16, WS_HN); bf16* XG = WSP(bf16, WS_XG);
    for (int ch = F.bx - nbusy; ch < MC / 128; ch += F.G - nbusy) {
        moe_table(F, jmoe, c, r, ch);
        const int m = c * MC + ch * 128 + wave * 16 + (lane & 15); const v4i rt = route[m];
        const int e = lane < 16 ? (r ? rt.y : rt.x) : -1; const float w = __builtin_bit_cast(float, r ? rt.w : rt.z);
        unsigned long long bal[8]; int mycnt = 0;
#pragma unroll
        for (int ee = 0; ee < 8; ++ee) { bal[ee] = __builtin_amdgcn_ballot_w64(e == ee); if (lane == ee) mycnt = __builtin_popcountll(bal[ee]); }
        if (lane < 8) cntw[wave * 8 + lane] = mycnt;
        __syncthreads();
        if (wave == 0 && lane < 8) { int base = tab[184 + lane];
#pragma unroll
            for (int w8 = 0; w8 < 8; ++w8) { basew[w8 * 8 + lane] = base; base += cntw[w8 * 8 + lane]; } }
        __syncthreads();
        int pos = 0;
#pragma unroll
        for (int ee = 0; ee < 8; ++ee) if (e == ee) pos = basew[wave * 8 + ee] + __builtin_popcountll(bal[ee] & ((1ull << lane) - 1ull));
        int slot = 0;
        if (lane < 16) { slot = tab[160 + e] + pos; tokmap[slot] = m; wslot[slot] = w; }
#pragma unroll
        for (int i0 = 0; i0 < 16; i0 += 4) { v4u x[8];
#pragma unroll
            for (int i = 0; i < 4; ++i) { const int mi = __builtin_amdgcn_readlane(m, i0 + i); const v4u* src = (const v4u*)(HN + (size_t)mi * DM); x[2 * i] = src[lane]; x[2 * i + 1] = src[64 + lane]; }
#pragma unroll
            for (int i = 0; i < 4; ++i) { const int si = __builtin_amdgcn_readlane(slot, i0 + i); v4u* dst = (v4u*)(XG + (size_t)si * DM); dst[lane] = x[2 * i]; dst[64 + lane] = x[2 * i + 1]; } }
    }
}

typedef float f32x16 __attribute__((ext_vector_type(16)));
typedef short bf16x8v __attribute__((ext_vector_type(8)));
typedef float f32x2v __attribute__((ext_vector_type(2)));
constexpr int NSA_K = 0, NSA_V = 8192, NSA_BUF = 17408, NSA_STAGE = 2 * NSA_BUF, NSA_IMP = 69632, NSA_CARRY = 86016, NSA_SEL = 103424, NSA_WSF = 103936;
constexpr int NSA_VP = 136;
constexpr float NSA_C2 = 0.125f * 1.4426950408889634f;
constexpr float NSA_DEFER = 8.0f / (0.125f * 1.4426950408889634f);
__device__ __forceinline__ unsigned cvtpk(float lo, float hi) { f32x2v v = {lo, hi}; bf16x2_t b = __builtin_convertvector(v, bf16x2_t); return __builtin_bit_cast(unsigned, b); }
__device__ __forceinline__ float partner32(float v, int lane) { return __builtin_bit_cast(float, __builtin_amdgcn_ds_bpermute((lane ^ 32) << 2, __builtin_bit_cast(int, v))); }
__device__ __forceinline__ void nsa_load(v4u& kx, v4u& vx, const bf16* Kg, int kp, const bf16* Vg, int vp, int tid) {
    kx = *(const v4u*)(Kg + (size_t)(tid & 63) * kp + (tid >> 6) * 8); vx = *(const v4u*)(Vg + (size_t)(tid >> 3) * vp + (tid & 7) * 8);
}
__device__ __forceinline__ void nsa_store(LAS unsigned char* lds, const v4u& kx, const v4u& vx, int tid) {
    *(LAS v4u*)(lds + NSA_K + (tid >> 6) * 1024 + (tid & 63) * 16) = kx; { LAS v2u* vd = (LAS v2u*)(lds + NSA_V + (tid >> 3) * NSA_VP + (tid & 7) * 16); vd[0] = (v2u){vx.x, vx.y}; vd[1] = (v2u){vx.z, vx.w}; }
}
__device__ __forceinline__ void nsa_qk(const LAS unsigned char* lds, const bf16x8v (&qr)[4], f32x16& p0, f32x16& p1, int r32, int hi) {
    bf16x8v kf[8];
#pragma unroll
    for (int d0 = 0; d0 < 4; ++d0) {
        kf[2 * d0] = *(const LAS bf16x8v*)(lds + NSA_K + (2 * d0 + hi) * 1024 + r32 * 16);
        kf[2 * d0 + 1] = *(const LAS bf16x8v*)(lds + NSA_K + (2 * d0 + hi) * 1024 + 512 + r32 * 16); }
    __builtin_amdgcn_sched_barrier(0);
#pragma unroll
    for (int i = 0; i < 16; ++i) { p0[i] = 0.f; p1[i] = 0.f; }
#pragma unroll
    for (int d0 = 0; d0 < 4; ++d0) {
        p0 = __builtin_amdgcn_mfma_f32_32x32x16_bf16(kf[2 * d0], qr[d0], p0, 0, 0, 0);
        p1 = __builtin_amdgcn_mfma_f32_32x32x16_bf16(kf[2 * d0 + 1], qr[d0], p1, 0, 0, 0);
    }
}
__device__ __forceinline__ void nsa_mask(f32x16& p0, f32x16& p1, int hi, int hiL, int loL) {
    const int hl = hiL - 4 * hi, ll = loL - 4 * hi;
#pragma unroll
    for (int i = 0; i < 16; ++i) { const int c = (i & 3) + 8 * (i >> 2);
        if (!(c <= hl && c > ll)) p0[i] = -INFINITY;
        if (!(c + 32 <= hl && c + 32 > ll)) p1[i] = -INFINITY; }
}
__device__ __forceinline__ float nsa_max32(const f32x16& p0, const f32x16& p1) {
    float a = fmaxf(fmaxf(p0[0], p0[1]), p1[0]), b = fmaxf(fmaxf(p0[2], p0[3]), p1[1]); a = fmaxf(fmaxf(a, p1[2]), p1[3]);
#pragma unroll
    for (int i = 4; i < 16; i += 4) { a = fmaxf(fmaxf(a, p0[i]), p0[i + 1]); b = fmaxf(fmaxf(b, p0[i + 2]), p0[i + 3]); a = fmaxf(fmaxf(a, p1[i]), p1[i + 1]); b = fmaxf(fmaxf(b, p1[i + 2]), p1[i + 3]); }
    return fmaxf(a, b);
}
__device__ __forceinline__ void nsa_vload(const LAS unsigned char* lds, v4u (&vv)[8], int r32, int hi) {
#pragma unroll
    for (int db = 0; db < 2; ++db) { const LAS unsigned char* vrow = lds + NSA_V + (32 * db + r32) * NSA_VP;
#pragma unroll
        for (int ks = 0; ks < 4; ++ks) {
            const int kb = (ks >> 1) * 32 + (ks & 1) * 16 + 4 * hi;
            const v2u lo = *(const LAS v2u*)(vrow + kb * 2), hh = *(const LAS v2u*)(vrow + (kb + 8) * 2);
            vv[4 * db + ks] = (v4u){lo.x, lo.y, hh.x, hh.y}; } }
    __builtin_amdgcn_sched_barrier(0);
}
__device__ __forceinline__ void nsa_pv(const v4u (&vv)[8], const f32x16& p0, const f32x16& p1, f32x16 (&o)[2]) {
    bf16x8v pa[4];
#pragma unroll
    for (int s = 0; s < 2; ++s) {
        const v4u a = (v4u){cvtpk(p0[8 * s], p0[8 * s + 1]), cvtpk(p0[8 * s + 2], p0[8 * s + 3]), cvtpk(p0[8 * s + 4], p0[8 * s + 5]), cvtpk(p0[8 * s + 6], p0[8 * s + 7])};
        const v4u b = (v4u){cvtpk(p1[8 * s], p1[8 * s + 1]), cvtpk(p1[8 * s + 2], p1[8 * s + 3]), cvtpk(p1[8 * s + 4], p1[8 * s + 5]), cvtpk(p1[8 * s + 6], p1[8 * s + 7])};
        pa[s] = __builtin_bit_cast(bf16x8v, a); pa[2 + s] = __builtin_bit_cast(bf16x8v, b); }
#pragma unroll
    for (int ks = 0; ks < 4; ++ks)
#pragma unroll
        for (int db = 0; db < 2; ++db) o[db] = __builtin_amdgcn_mfma_f32_32x32x16_bf16(pa[ks], __builtin_bit_cast(bf16x8v, vv[4 * db + ks]), o[db], 0, 0, 0);
}
__device__ __forceinline__ void nsa_rowscale(f32x16 (&o)[2], LAS float* wsf, float f, int r32, int hi) {
    if (hi == 0) wsf[r32] = f;
#pragma unroll
    for (int g = 0; g < 4; ++g) { const f32x4 w = *(const LAS f32x4*)(wsf + 8 * g + 4 * hi);
#pragma unroll
        for (int e = 0; e < 4; ++e) { o[0][4 * g + e] *= w[e]; o[1][4 * g + e] *= w[e]; } }
}
constexpr int NSA_ACC = 104960;
__device__ __forceinline__ void nsa_rowaccum(LAS unsigned char* acc, bool first, const f32x16 (&o)[2], LAS float* wsf, float f, int r32, int hi) {
    if (hi == 0) wsf[r32] = f;
#pragma unroll
    for (int g = 0; g < 4; ++g) { const f32x4 w = *(const LAS f32x4*)(wsf + 8 * g + 4 * hi);
#pragma unroll
        for (int e = 0; e < 4; ++e) { LAS bf16* p = (LAS bf16*)(acc + (8 * g + 4 * hi + e) * 128 + r32 * 2); const int i = 4 * g + e;
            float a = o[0][i] * w[e], b = o[1][i] * w[e];
            if (!first) { a += bf1(p[0]); b += bf1(p[32]); }
            p[0] = (bf16)f2bf(a); p[32] = (bf16)f2bf(b); } }
}
__device__ __forceinline__ void nsa_flush(const LAS unsigned char* acc, bf16* ytok  , int lane) {
    asm volatile("" ::: "memory");
#pragma unroll
    for (int ps = 0; ps < 4; ++ps) { const int row = ps * 8 + (lane >> 3), ch = lane & 7;
        const v4u v = *(const LAS v4u*)(acc + row * 128 + ch * 16);
        *(v4u*)(ytok + (size_t)(row >> 2) * 256 + (row & 3) * 64 + ch * 8) = v; }
}
__device__ __forceinline__ void nsa_softmax_pv(const LAS unsigned char* lds, f32x16& p0, f32x16& p1, float& m, float& l, f32x16 (&o)[2], LAS float* wsf, int lane, int r32, int hi, bool rowok) {
    float mt = nsa_max32(p0, p1); mt = rowok ? mt : -INFINITY; mt = fmaxf(mt, partner32(mt, lane));
    const float mn = fmaxf(m, mt);
    if (__builtin_amdgcn_ballot_w64(mn > m + NSA_DEFER) != 0ull) { const float f = __builtin_amdgcn_exp2f((m - mn) * NSA_C2); l *= f; nsa_rowscale(o, wsf, f, r32, hi); m = mn; }
    const float off = rowok ? -m * NSA_C2 : -INFINITY;
    v4u vv[8]; nsa_vload(lds, vv, r32, hi);
    float s = 0.f;
#pragma unroll
    for (int i = 0; i < 16; ++i) { p0[i] = __builtin_amdgcn_exp2f(__builtin_fmaf(p0[i], NSA_C2, off)); p1[i] = __builtin_amdgcn_exp2f(__builtin_fmaf(p1[i], NSA_C2, off)); s += p0[i] + p1[i]; }
    l += s;
    nsa_pv(vv, p0, p1, o);
}
__device__ __forceinline__ void p_nsa2(Frame& F) {
    const int tid = F.tid, lane = F.lane, wave = F.wave, r32 = lane & 31, hi = lane >> 5;
    LAS unsigned char* lds = F.lds + RING_OFF;
    LAS float* imp = (LAS float*)(lds + NSA_IMP); LAS float* carry = (LAS float*)(lds + NSA_CARRY);
    LAS unsigned long long* selm = (LAS unsigned long long*)(lds + NSA_SEL); LAS float* wsf = (LAS float*)(lds + NSA_WSF) + wave * 32;
    LAS unsigned char* acc = wave < 6 ? lds + NSA_ACC + wave * 4096 : F.lds + LDSCTL_OFF + 4096 + (wave - 6) * 4096;
    const bf16* P1 = WSP(bf16, WS_P1); const bf16* KC = WSP(bf16, WS_KC); const bf16* KCT = WSP(bf16, WS_KCT); const bf16* VT = WSP(bf16, WS_VT);
    bf16* Yc = WSP(bf16, WS_Y) + (size_t)2 * MC * 256;
    const int ql = r32 >> 2, h = r32 & 3, tq = 8 * wave + ql;
    int par = 0;
    for (int it = 0; it < 2; ++it) {
        for (int pair = F.vcu; pair < BC * 32; pair += F.G) {
            const int b = pair >> 5, sx = pair & 31, qb = it ? 63 - sx : sx;
            const int t = qb * 64 + tq; const size_t row = (size_t)b * SEQ + t; const bf16* prow = P1 + row * P1W;
            bf16x8v qr[4];
#pragma unroll
            for (int d0 = 0; d0 < 4; ++d0) qr[d0] = *(const bf16x8v*)(prow + C_CQ + h * 64 + d0 * 16 + hi * 8);
            const float g0 = bf1(prow[C_CG + h * 3]), g1 = bf1(prow[C_CG + h * 3 + 1]), g2 = bf1(prow[C_CG + h * 3 + 2]);
            f32x16 o[2], p0, p1;
            __syncthreads();
            for (int i = tid; i < 64 * 64; i += 512) imp[i] = 0.f;
            for (int i = tid; i < 64 * 68; i += 512) carry[i] = 0.f;
            const int nct = (4 * qb + 3 + 63) >> 6;
            const int mlim = t >= 31 ? ((t - 31) >> 4) : -1;
            const bf16* kcb = KC + (size_t)b * 256 * 64; const bf16* vcb = KCT + (size_t)b * 64 * 256;
            float m = -1e30f, l = 0.f;
            v4u kx, vx;
            nsa_load(kx, vx, kcb, 64, vcb, 256, tid);
            for (int ti = 0; ti < nct; ++ti) {
                LAS unsigned char* tb = lds + par * NSA_STAGE; par ^= 1;
                nsa_store(tb, kx, vx, tid); __syncthreads();
                { const int tn = ti + 1 < nct ? ti + 1 : 0; nsa_load(kx, vx, kcb + (size_t)tn * 64 * 64, 64, vcb + tn * 64, 256, tid); }
                nsa_qk(tb, qr, p0, p1, r32, hi); nsa_mask(p0, p1, hi, mlim - 64 * ti, -1);
                float mt = nsa_max32(p0, p1); mt = fmaxf(mt, partner32(mt, lane));
                const float mn = fmaxf(m, mt); l *= __builtin_amdgcn_exp2f((m - mn) * NSA_C2); m = mn;
                const float off = -m * NSA_C2; float s = 0.f;
#pragma unroll
                for (int i = 0; i < 16; ++i) s += __builtin_amdgcn_exp2f(__builtin_fmaf(p0[i], NSA_C2, off)) + __builtin_amdgcn_exp2f(__builtin_fmaf(p1[i], NSA_C2, off));
                l += s; }
            { const float lt = l + partner32(l, lane); const float rl = lt > 0.f ? 1.0f / lt : 0.f;
#pragma unroll
              for (int i = 0; i < 16; ++i) { o[0][i] = 0.f; o[1][i] = 0.f; }
              for (int ti = 0; ti < nct; ++ti) {
                  LAS unsigned char* tb = lds + par * NSA_STAGE; par ^= 1;
                  nsa_store(tb, kx, vx, tid); __syncthreads();
                  if (ti + 1 < nct) nsa_load(kx, vx, kcb + (size_t)(ti + 1) * 64 * 64, 64, vcb + (ti + 1) * 64, 256, tid);
                  nsa_qk(tb, qr, p0, p1, r32, hi); nsa_mask(p0, p1, hi, mlim - 64 * ti, -1);
                  v4u vv[8]; nsa_vload(tb, vv, r32, hi);
                  { const float off = -m * NSA_C2;
#pragma unroll
                    for (int i = 0; i < 16; ++i) { p0[i] = __builtin_amdgcn_exp2f(__builtin_fmaf(p0[i], NSA_C2, off)) * rl; p1[i] = __builtin_amdgcn_exp2f(__builtin_fmaf(p1[i], NSA_C2, off)) * rl; } }
#pragma unroll
                  for (int kt = 0; kt < 2; ++kt)
#pragma unroll
                      for (int g = 0; g < 4; ++g) { const f32x16& pp = kt ? p1 : p0;
                          float A = pp[4 * g] + pp[4 * g + 1] + pp[4 * g + 2] + 0.5f * pp[4 * g + 3], B = 0.5f * pp[4 * g + 3];
                          A += __builtin_bit_cast(float, bperm(lane ^ 1, __builtin_bit_cast(int, A))); A += __builtin_bit_cast(float, bperm(lane ^ 2, __builtin_bit_cast(int, A)));
                          B += __builtin_bit_cast(float, bperm(lane ^ 1, __builtin_bit_cast(int, B))); B += __builtin_bit_cast(float, bperm(lane ^ 2, __builtin_bit_cast(int, B)));
                          if (h == 0) { const int j = 16 * ti + 8 * kt + 2 * g + hi; imp[tq * 64 + j] = A; carry[tq * 68 + j + 1] = B; } }
                  nsa_pv(vv, p0, p1, o); }
              nsa_rowaccum(acc, true, o, wsf, g0, r32, hi); }
            __syncthreads();
            { const int q = tid >> 3, sub = tid & 7; unsigned long long mask;
              if (qb + 1 <= 16) mask = (1ull << (qb + 1)) - 1ull;
              else { mask = 1ull | (1ull << qb);
                  unsigned long long key[8];
#pragma unroll
                  for (int i = 0; i < 8; ++i) { const int j = sub * 8 + i; const float v = imp[q * 64 + j] + carry[q * 68 + j];
                      key[i] = (j >= 1 && j < qb) ? (((unsigned long long)__builtin_bit_cast(unsigned, v) << 32) | (unsigned)(63 - j)) : 0ull; }
                  for (int r = 0; r < 14; ++r) { unsigned long long best = key[0];
#pragma unroll
                      for (int i = 1; i < 8; ++i) best = key[i] > best ? key[i] : best;
#pragma unroll
                      for (int x = 1; x < 8; x <<= 1) { const unsigned lo = (unsigned)bperm(lane ^ x, (int)(unsigned)best), hh = (unsigned)bperm(lane ^ x, (int)(unsigned)(best >> 32));
                          const unsigned long long other = ((unsigned long long)hh << 32) | lo; best = other > best ? other : best; }
                      const int jb = 63 - (int)(best & 63ull); mask |= 1ull << jb;
#pragma unroll
                      for (int i = 0; i < 8; ++i) if (sub * 8 + i == jb) key[i] = 0ull; } }
              if (sub == 0) selm[q] = mask; }
            __syncthreads();
            const unsigned long long mysel = selm[tq];
#ifdef NSA_REP_SLC
            int nrep_slc; asm volatile("s_mov_b32 %0, %1" : "=s"(nrep_slc) : "i"(NSA_REP_SLC));
            for (int rep_ = 0; rep_ < nrep_slc; ++rep_)
#endif
            { const bf16* kb = P1 + (size_t)b * SEQ * P1W + C_KSLC; const bf16* vb = VT + (size_t)(0 * BC + b) * 64 * SEQ;
#ifdef NSA_REP_SLC
              if (rep_ + 1 < nrep_slc) __syncthreads();
#endif
              m = -1e30f; l = 0.f;
#pragma unroll
              for (int i = 0; i < 16; ++i) { o[0][i] = 0.f; o[1][i] = 0.f; }
              v4u kx2, vx2;
              nsa_load(kx, vx, kb, P1W, vb, SEQ, tid); if (qb >= 1) nsa_load(kx2, vx2, kb + (size_t)64 * P1W, P1W, vb + 64, SEQ, tid);
              for (int j = 0; j <= qb; j += 2) {
                  const bool two = j + 1 <= qb;
                  LAS unsigned char* tb = lds + par * NSA_STAGE; par ^= 1;
                  nsa_store(tb, kx, vx, tid); if (two) nsa_store(tb + NSA_BUF, kx2, vx2, tid);
                  __syncthreads();
                  if (j + 2 <= qb) nsa_load(kx, vx, kb + (size_t)(j + 2) * 64 * P1W, P1W, vb + (j + 2) * 64, SEQ, tid);
                  if (j + 3 <= qb) nsa_load(kx2, vx2, kb + (size_t)(j + 3) * 64 * P1W, P1W, vb + (j + 3) * 64, SEQ, tid);
                  { const bool rowsel = ((mysel >> j) & 1ull) != 0ull;
                    if (__builtin_amdgcn_ballot_w64(rowsel) != 0ull) {
                        nsa_qk(tb, qr, p0, p1, r32, hi); if (j == qb) nsa_mask(p0, p1, hi, tq, -1);
                        nsa_softmax_pv(tb, p0, p1, m, l, o, wsf, lane, r32, hi, rowsel); } }
                  if (two) { const bool rowsel = ((mysel >> (j + 1)) & 1ull) != 0ull;
                    if (__builtin_amdgcn_ballot_w64(rowsel) != 0ull) {
                        nsa_qk(tb + NSA_BUF, qr, p0, p1, r32, hi); if (j + 1 == qb) nsa_mask(p0, p1, hi, tq, -1);
                        nsa_softmax_pv(tb + NSA_BUF, p0, p1, m, l, o, wsf, lane, r32, hi, rowsel); } } }
              const float lt = l + partner32(l, lane);
#ifdef NSA_REP_SLC
              if (rep_ + 1 == nrep_slc)
#endif
              nsa_rowaccum(acc, false, o, wsf, lt > 0.f ? g1 / lt : 0.f, r32, hi); }
#ifdef NSA_REP_WIN
            int nrep_win; asm volatile("s_mov_b32 %0, %1" : "=s"(nrep_win) : "i"(NSA_REP_WIN));
            for (int rep_ = 0; rep_ < nrep_win; ++rep_)
#endif
            { const bf16* kb = P1 + (size_t)b * SEQ * P1W + C_KWIN; const bf16* vb = VT + (size_t)(1 * BC + b) * 64 * SEQ;
              m = -1e30f; l = 0.f;
#pragma unroll
              for (int i = 0; i < 16; ++i) { o[0][i] = 0.f; o[1][i] = 0.f; }
              const int j0 = qb >= 8 ? qb - 8 : 0;
              nsa_load(kx, vx, kb + (size_t)j0 * 64 * P1W, P1W, vb + j0 * 64, SEQ, tid);
              for (int j = j0; j <= qb; ++j) {
                  LAS unsigned char* tb = lds + par * NSA_STAGE; par ^= 1;
                  nsa_store(tb, kx, vx, tid); __syncthreads();
                  if (j < qb) nsa_load(kx, vx, kb + (size_t)(j + 1) * 64 * P1W, P1W, vb + (j + 1) * 64, SEQ, tid);
                  nsa_qk(tb, qr, p0, p1, r32, hi); if (j == qb || j == qb - 8) nsa_mask(p0, p1, hi, j == qb ? tq : 63, j == qb - 8 ? tq : -1);
                  nsa_softmax_pv(tb, p0, p1, m, l, o, wsf, lane, r32, hi, true); }
              const float lt = l + partner32(l, lane);
#ifdef NSA_REP_WIN
              if (rep_ + 1 == nrep_win) {
#endif
              nsa_rowaccum(acc, false, o, wsf, lt > 0.f ? g2 / lt : 0.f, r32, hi);
              nsa_flush(acc, Yc + ((size_t)b * SEQ + qb * 64 + 8 * wave) * 256, lane);
#ifdef NSA_REP_WIN
              }
#endif
            }
        }
    }
    __syncthreads();
}

constexpr int SB_HEAD_LDS = 17408;
constexpr int SB_FLAG = 4 * SB_HEAD_LDS;
constexpr float SB_LOG2E = 1.4426950408889634f, SB_STOP = -100.0f * 1.4426950408889634f;
__device__ __forceinline__ void p_stick2(Frame& F, int nbusy) {
    const int tid = F.tid, lane = F.lane, wave = F.wave, r32 = lane & 31, hi = lane >> 5, h = wave & 3, qh = wave >> 2;
    LAS unsigned char* lds = F.lds + RING_OFF; LAS unsigned char* hl = lds + h * SB_HEAD_LDS; LAS int* flag = (LAS int*)(lds + SB_FLAG);
    const bf16* P1 = WSP(bf16, WS_P1); const bf16* VT = WSP(bf16, WS_VT) + (size_t)2 * BC * 64 * SEQ;
    bf16* Yb = WSP(bf16, WS_Y) + (size_t)MC * 256;
    const int tq = 32 * qh + r32;
    if (F.bx >= nbusy)
        for (int item = F.bx - nbusy; item < BC * 64; item += F.G - nbusy) {
            const int b = item >> 6, qb = item & 63;
            const size_t row = (size_t)b * SEQ + qb * 64 + tq;
            bf16x8v qr[4];
#pragma unroll
            for (int d0 = 0; d0 < 4; ++d0) qr[d0] = *(const bf16x8v*)(P1 + row * P1W + C_SBQ + h * 64 + d0 * 16 + hi * 8);
            f32x16 o[2], p0, p1;
#pragma unroll
            for (int i = 0; i < 16; ++i) { o[0][i] = 0.f; o[1][i] = 0.f; }
            float R = 0.f;
            const int skey = tid & 63, sc = tid >> 6, sd = tid >> 3, skc = tid & 7;
            v4u kx[4], vx[4];
#define SB_LOAD(jj) do { const bf16* kg_ = P1 + ((size_t)b * SEQ + (jj) * 64 + skey) * P1W + C_SBK + sc * 8; \
                _Pragma("unroll") for (int hh = 0; hh < 4; ++hh) { kx[hh] = *(const v4u*)(kg_ + hh * 64); vx[hh] = *(const v4u*)(VT + ((size_t)(hh * BC + b) * 64 + sd) * SEQ + (jj) * 64 + skc * 8); } } while (0)
            SB_LOAD(qb);
            for (int j = qb; j >= 0; --j) {
                __syncthreads();
                if (j < qb) { int live = 0;
#pragma unroll
                    for (int w = 0; w < 8; ++w) live |= flag[w];
                    if (!live) break; }
#pragma unroll
                for (int hh = 0; hh < 4; ++hh) { *(LAS v4u*)(lds + hh * SB_HEAD_LDS + sc * 1024 + skey * 16) = kx[hh]; { LAS v2u* vd = (LAS v2u*)(lds + hh * SB_HEAD_LDS + NSA_V + sd * NSA_VP + skc * 16); vd[0] = (v2u){vx[hh].x, vx[hh].y}; vd[1] = (v2u){vx[hh].z, vx[hh].w}; } }
                __syncthreads();
                if (j > 0) SB_LOAD(j - 1);
                nsa_qk(hl, qr, p0, p1, r32, hi);
#pragma unroll
                for (int i = 0; i < 16; ++i) { p0[i] *= NSA_C2; p1[i] *= NSA_C2; }
                v4u vv[8]; nsa_vload(hl, vv, r32, hi);
                const int lim = ((j == qb) ? tq : 64) - 4 * hi;
                float Town[8], Tp[8];
#pragma unroll
                for (int kt = 0; kt < 2; ++kt) { f32x16& pp = kt ? p1 : p0;
#pragma unroll
                    for (int g = 0; g < 4; ++g) { float L[4];
#pragma unroll
                        for (int e = 0; e < 4; ++e) { const int kk = 32 * kt + 8 * g + e; const float z = pp[4 * g + e];
                            const float tt = __builtin_amdgcn_logf(1.0f + __builtin_amdgcn_exp2f(-__builtin_fabsf(z)));
                            const float lb = fminf(z, 0.f) - tt; const bool ok = kk < lim;
                            L[e] = ok ? lb - z : 0.f; pp[4 * g + e] = ok ? lb : -INFINITY; }
                        const float E2 = L[3], E1 = E2 + L[2], E0 = E1 + L[1];
                        pp[4 * g + 2] += E2; pp[4 * g + 1] += E1; pp[4 * g] += E0;
                        Town[4 * kt + g] = E0 + L[0]; } }
#pragma unroll
                for (int k = 0; k < 8; ++k) Tp[k] = partner32(Town[k], lane);
                float suf = R;
#pragma unroll
                for (int k = 7; k >= 0; --k) { const float add = suf + (hi == 0 ? Tp[k] : 0.f); f32x16& pp = (k >> 2) ? p1 : p0; const int g = k & 3;
#pragma unroll
                    for (int e = 0; e < 4; ++e) pp[4 * g + e] = __builtin_amdgcn_exp2f(pp[4 * g + e] + add);
                    suf += Town[k] + Tp[k]; }
                R = suf;
                nsa_pv(vv, p0, p1, o);
                const bool alive = R >= SB_STOP;
                const unsigned long long bal = __builtin_amdgcn_ballot_w64(alive);
                if (lane == 0) flag[wave] = bal != 0ull ? 1 : 0;
            }
            { bf16* dst = Yb + ((size_t)b * SEQ + qb * 64 + 32 * qh + 4 * hi) * 256 + h * 64 + r32;
#pragma unroll
              for (int i = 0; i < 16; ++i) { dst[((i & 3) + 8 * (i >> 2)) * 256] = (bf16)f2bf(o[0][i]); dst[((i & 3) + 8 * (i >> 2)) * 256 + 32] = (bf16)f2bf(o[1][i]); } }
        }
#undef SB_LOAD
    __syncthreads();
}

__device__ __forceinline__ void p_sgu2(Frame& F, int layer) {
    LAS unsigned char* vnT = F.lds + RING_OFF;
    const bf16* P1 = WSP(bf16, WS_P1); bf16* Ya = WSP(bf16, WS_Y);
    const float* gain = F.in[3] + (size_t)layer * 256; const float* sw = F.in[4] + (size_t)layer * 4 * 128 * 128; const float* sb = F.in[5] + (size_t)layer * 4 * 128;
    const int lane = F.lane, wave = F.wave, r32 = lane & 31, hi = lane >> 5, g = wave & 3, db = wave >> 2;
    for (int item = F.vcu; item < MC / 128; item += F.G) {
        const size_t r0 = (size_t)item * 128;
        __syncthreads();
        { const f32x4 gg = ((const f32x4*)gain)[lane];
          for (int rr = 0; rr < 16; rr += 2) { const int r = wave * 16 + rr;
              const v2u ra = *(const v2u*)(P1 + (r0 + r) * P1W + C_V + 4 * lane), rb = *(const v2u*)(P1 + (r0 + r + 1) * P1W + C_V + 4 * lane);
              const float a0 = bflo(ra.x), a1 = bfhi(ra.x), a2 = bflo(ra.y), a3 = bfhi(ra.y), b0 = bflo(rb.x), b1 = bfhi(rb.x), b2 = bflo(rb.y), b3 = bfhi(rb.y);
              const float sa = 1.0f / sqrtf(wave_sum((a0 * a0 + a1 * a1) + (a2 * a2 + a3 * a3), lane) * (1.f / 256.f) + EPS);
              const float sb_ = 1.0f / sqrtf(wave_sum((b0 * b0 + b1 * b1) + (b2 * b2 + b3 * b3), lane) * (1.f / 256.f) + EPS);
              LAS unsigned* q = (LAS unsigned*)(vnT + (4 * lane) * 272 + r * 2);
              q[0] = pk2(a0 * sa * gg.x, b0 * sb_ * gg.x); q[68] = pk2(a1 * sa * gg.y, b1 * sb_ * gg.y); q[136] = pk2(a2 * sa * gg.z, b2 * sb_ * gg.z); q[204] = pk2(a3 * sa * gg.w, b3 * sb_ * gg.w); } }
        __syncthreads();
        const int ch = g * 64 + db * 32 + r32;
        for (int tb = 0; tb < 4; ++tb) {
            f32x16 acc;
#pragma unroll
            for (int i = 0; i < 16; ++i) acc[i] = 0.f;
            const int t = 32 * tb + r32; const float* wrow = sw + ((size_t)g * 128 + t) * 128;
            f32x4 wq[8][2];
#pragma unroll
            for (int ks = 0; ks < 8; ++ks) if (ks < 2 * tb + 2) { wq[ks][0] = *(const f32x4*)(wrow + 16 * ks + 8 * hi); wq[ks][1] = *(const f32x4*)(wrow + 16 * ks + 8 * hi + 4); }
#pragma unroll
            for (int ks = 0; ks < 8; ++ks) if (ks < 2 * tb + 2) {
                const int s0 = 16 * ks + 8 * hi;
                const f32x4 w0 = wq[ks][0], w1 = wq[ks][1];
                const v4u a = (v4u){pk2(s0 <= t ? w0.x : 0.f, s0 + 1 <= t ? w0.y : 0.f), pk2(s0 + 2 <= t ? w0.z : 0.f, s0 + 3 <= t ? w0.w : 0.f),
                                    pk2(s0 + 4 <= t ? w1.x : 0.f, s0 + 5 <= t ? w1.y : 0.f), pk2(s0 + 6 <= t ? w1.z : 0.f, s0 + 7 <= t ? w1.w : 0.f)};
                const bf16x8v bfr = *(const LAS bf16x8v*)(vnT + ch * 272 + s0 * 2);
                acc = __builtin_amdgcn_mfma_f32_32x32x16_bf16(__builtin_bit_cast(bf16x8v, a), bfr, acc, 0, 0, 0); }
            float uu[16], bb[16];
#pragma unroll
            for (int i = 0; i < 16; ++i) { const int tt = 32 * tb + (i & 3) + 8 * (i >> 2) + 4 * hi; uu[i] = bf1(P1[(r0 + tt) * P1W + C_U + ch]); bb[i] = sb[g * 128 + tt]; }
#pragma unroll
            for (int i = 0; i < 16; ++i) { const int tt = 32 * tb + (i & 3) + 8 * (i >> 2) + 4 * hi;
                Ya[(r0 + tt) * 256 + ch] = (bf16)f2bf(uu[i] * (acc[i] + bb[i])); }
        }
    }
    __syncthreads();
}

struct Args { const float* in[20]; float* out; unsigned char* ws; int lo, hi, li, rep; };
#ifndef TILED_FFN1
#define TILED_FFN1 0
#endif
#ifndef PG8_ALIGN_EPI
#define PG8_ALIGN_EPI true
#endif
#ifndef PG8_SP2
#define PG8_SP2 true
#endif
#ifndef WGM_PROJ
#define WGM_PROJ PG8_WGM
#endif
#ifndef WGM_FFN1
#define WGM_FFN1 PG8_WGM
#endif
#ifndef WGM_FFN2
#define WGM_FFN2 PG8_WGM
#endif
#ifndef WGM_MOE1
#define WGM_MOE1 PG8_WGM
#endif
#ifndef WGM_MOE2
#define WGM_MOE2 PG8_WGM
#endif
#ifndef FFN_CHUNKS
#define FFN_CHUNKS 2
#endif
#ifndef REP_GEMM
#define REP_GEMM 1
#endif
#ifndef REP_STICK
#define REP_STICK 1
#endif
#ifndef REP_NSA
#define REP_NSA 1
#endif
#ifndef REP_SGU
#define REP_SGU 1
#endif
#ifndef REP_NORM
#define REP_NORM 1
#endif
template <class Epi, class Sched> __device__ __forceinline__ void run_gemm(Frame& F, const bf16* A, const bf16* Bt, int M, int N, int K, const Sched& S, Epi E, bool rotate = true, int tiled = 0, int ld = 0) {
    const int nt_ = K / 64;
#ifdef PG8_KROT
    const int rot_ = rotate ? 2 * (((F.bx & 7) * (nt_ / 2)) / 8) : 0;
#else
    const int rot_ = 0;
#endif
    pg8::Gemm g{A, Bt, M, N, K + F.zs, F.tid, rot_ + F.zs, tiled + F.zs, ld + F.zs};
    if (F.rep) E.set_scale0();
    pg8::gemm_phase<Epi, Sched, PG8_ALIGN_EPI, PG8_SP2>(F.lds + RING_OFF, g, S, E);
}
__global__ void __launch_bounds__(NWAVES * 64, 2) mk_fwd(Args args) {
    extern __shared__ __attribute__((aligned(16))) unsigned char lds[];
    Frame F0;
    F0.lds = (LAS unsigned char*)lds;
    F0.tid = threadIdx.x; F0.lane = F0.tid & 63; F0.wave = __builtin_amdgcn_readfirstlane(F0.tid >> 6);
    F0.G = gridDim.x; F0.bx = blockIdx.x; F0.vcu = (F0.G % 8 == 0) ? (F0.bx % 8) * (F0.G / 8) + F0.bx / 8 : F0.bx; F0.zv = 0; F0.zs = 0;
    F0.rep = args.rep; F0.ws = args.ws; F0.ctl = (unsigned*)(args.ws + WS_CTL); F0.in = args.in; F0.out = args.out;
    for (int u = F0.tid; u < (LDS_BYTES - LDSCTL_OFF) / 4; u += NWAVES * 64) ((LAS unsigned*)(F0.lds + LDSCTL_OFF))[u] = 0u;
    __syncthreads();
    const int lo = args.lo, hi = args.hi;
    XcdBarrier bar; bar.bar = F0.ctl + CW_BAR + args.li * XCD_BAR_WORDS; bar.x = 0; bar.st = nullptr; bar.w = 0; bar.z = 0;
    if (hi - lo > 1) bar = xcd_barrier_post(F0.ctl + CW_BAR + args.li * XCD_BAR_WORDS, (volatile LAS unsigned*)(F0.lds + MISC_OFF) + 8);
    int step = 0;
#define STEP_BEGIN if (step >= lo && step < hi) { Frame F = F0; { int zv_, zs_; asm volatile("v_mov_b32 %0, 0" : "=v"(zv_)); asm volatile("s_mov_b32 %0, 0" : "=s"(zs_)); \
        F.zv = zv_; F.zs = zs_; F.lane = (int)__builtin_amdgcn_mbcnt_hi(~0u, __builtin_amdgcn_mbcnt_lo(~0u, (unsigned)zv_)); F.wave = F0.wave + zs_; F.tid = F.wave * 64 + F.lane; F.bx = F.bx + zs_; \
        F.vcu = F0.vcu + zs_; F.G = F0.G + zs_; F.lds = (LAS unsigned char*)lds + zs_; F.ws = F0.ws + zs_; F.ctl = F0.ctl + zs_; F.in = F0.in + zs_; F.out = F0.out + zs_; }
#ifdef PROBE_XBAR
#define STEP_END   if (step + 1 < hi) { unsigned zb_; asm volatile("v_mov_b32 %0, 0" : "=v"(zb_)); bar.z = zb_; xcd_barrier(bar); xcd_barrier(bar); } } ++step;
#else
#define STEP_END   if (step + 1 < hi) { unsigned zb_; asm volatile("v_mov_b32 %0, 0" : "=v"(zb_)); bar.z = zb_; xcd_barrier(bar); } } ++step;
#endif

    for (int layer = 0; layer < DEPTH; ++layer) {
        const int jj = layer >> 1;
        STEP_BEGIN
            p_convert(F, layer);
            if (layer == 0) p_norm<0, false>(F, F.in[0], F.in[1], nullptr, 0); else p_norm<0, true>(F, WSP(bf16, WS_H), F.in[1] + (size_t)layer * DM, nullptr, 0);
        STEP_END
        for (int c = 0; c < NCHUNK; ++c) {
            STEP_BEGIN
                pg8::StaticOrder S; S.init(MC, NPROJ, F.G, F.bx, WGM_PROJ);
                pg8::EpiProj E{WSP(bf16, WS_P1), WSP(bf16, WS_G)};
                run_gemm(F, WSP(bf16, WS_HN) + (size_t)c * MC * DM, WSP(bf16, WS_WIN), MC, NPROJ, DM, S, E);
            STEP_END
            STEP_BEGIN
                p_prep(F);
            STEP_END
            STEP_BEGIN
                LAS int* tab = (LAS int*)(F.lds + TAB_OFF);
                __syncthreads(); if (F.tid < 16) tab[F.tid] = F.tid >> 3; __syncthreads();
                pg8::GroupedOrder S; S.so.init(2 * 2048, 512, F.G, F.bx); S.tile_e = tab; S.nN = 2;
                pg8::EpiF32 E{WSP(float, WS_UL), 512, 2};
                run_gemm(F, WSP(bf16, WS_KVC), WSP(bf16, WS_WC1), 2 * 2048, 512, DM, S, E);
                p_sgu2(F, layer);
                p_stick2(F, F.G > 64 ? 32 : 0);
            STEP_END
            STEP_BEGIN
                p_cmpfin(F, layer);
            STEP_END
            STEP_BEGIN
#ifdef OLD_NSA
                p_nsa(F);
#else
                p_nsa2(F);
#endif
            STEP_END
            STEP_BEGIN
                pg8::MergeOrder S; S.so.init(MC, DM, F.G, F.bx); S.nmt = MC / 256;
                pg8::EpiMerge E{WSP(bf16, WS_G), WSP(bf16, WS_MG), MC / 256};
                run_gemm(F, WSP(bf16, WS_Y), WSP(bf16, WS_WBR), 3 * MC, 3 * DM, 256, S, E);
            STEP_END
            STEP_BEGIN
                pg8::StaticOrder S; S.init(MC, DM, F.G, F.bx);
                pg8::EpiResid E{layer == 0 ? F.in[0] + (size_t)c * MC * DM : nullptr, WSP(bf16, WS_H) + (size_t)c * MC * DM, DM, 1.0f};
                run_gemm(F, WSP(bf16, WS_MG), WSP(bf16, WS_WOUT), MC, DM, DM, S, E);
            STEP_END
        }
        if ((layer & 1) == 0) {
            STEP_BEGIN
                p_norm<0, true>(F, WSP(bf16, WS_H), F.in[11] + (size_t)layer * DM, nullptr, 0, Q8_HN, TILED_FFN1);
            STEP_END
            for (int c = 0; c < FFN_CHUNKS; ++c) {
                constexpr int MF = MTOK / FFN_CHUNKS;
                STEP_BEGIN
                    pg8::StaticOrder S; S.init(MF, NFF1, F.G, F.bx, WGM_FFN1);
                    pg8::EpiSwiGLU E{WSP(bf16, WS_HID), DFFP, nullptr, NFF1 / 256};
                    run_gemm(F, WSP(bf16, WS_HN) + (size_t)c * MF * DM, WSP(bf16, WS_WF1), MF, NFF1, DM, S, E, true, TILED_FFN1);
                STEP_END
                STEP_BEGIN
                    pg8::StaticOrder S; S.init(MF, DM, F.G, F.bx, WGM_FFN2);
                    pg8::EpiResid E{nullptr, WSP(bf16, WS_H) + (size_t)c * MF * DM, DM, 1.0f};
                    run_gemm(F, WSP(bf16, WS_HID), WSP(bf16, WS_WF2), MF, DM, DFFP, S, E);
                STEP_END
            }
        } else {
            STEP_BEGIN
                p_norm<1, true>(F, WSP(bf16, WS_H), F.in[11] + (size_t)layer * DM, F.in[15] + (size_t)jj * DM * NEXP, jj, Q8_HN);
            STEP_END
#ifdef ABL_DENSE_MOE
            for (int e = 0; e < NEXP; ++e) {
                STEP_BEGIN
                    pg8::StaticOrder S; S.init(MTOK, NMOE1, F.G, F.bx);
                    pg8::EpiSwiGLU E{WSP(bf16, WS_SCR + 8 * MiB), DFE, WSP(float, WS_SCR + 4 * MiB) + (size_t)e * MTOK, NMOE1 / 256};
                    run_gemm(F, WSP(bf16, WS_HN), WSP(bf16, WS_WF1) + (size_t)e * NMOE1 * DM, MTOK, NMOE1, DM, S, E);
                STEP_END
                STEP_BEGIN
                    pg8::StaticOrder S; S.init(MTOK, DM, F.G, F.bx);
                    pg8::EpiResid E{nullptr, WSP(bf16, WS_H), DM, 1.0f};
                    run_gemm(F, WSP(bf16, WS_SCR + 8 * MiB), WSP(bf16, WS_WF2) + (size_t)e * DM * DFE, MTOK, DM, DFE, S, E);
                STEP_END
            }
#else
            STEP_BEGIN
                p_gather(F, jj, 0, 0);
            STEP_END
            for (int c = 0; c < NCHUNK; ++c)
                for (int r = 0; r < 2; ++r) {
                    STEP_BEGIN
                        const int T = moe_table(F, jj, c, r);
                        pg8::GroupedOrder S; S.so.init(T * 256, NMOE1, F.G, F.bx, WGM_MOE1); S.tile_e = (LAS int*)(F.lds + TAB_OFF); S.nN = NMOE1 / 256;
                        pg8::EpiSwiGLU E{WSP(bf16, WS_HIDM), DFE, WSP(float, WS_WSLOT) + (c * 2 + r) * SLOTS, NMOE1 / 256};
                        run_gemm(F, WSP(bf16, WS_XG), WSP(bf16, WS_WF1), T * 256, NMOE1, DM, S, E, false);
                    STEP_END
                    STEP_BEGIN
                        const int T = moe_table(F, jj, c, r);
                        const int nwg = T * (DM / 256), R = nwg % F.G, full = nwg - R;
                        const int NS = (4 * R <= F.G) ? 4 : 2;
                        const bool split = (hi - lo > 1) && R > 0 && NS * R <= F.G && !F.rep;
                        int* tokm = WSP(int, WS_TOKMAP) + (c * 2 + r) * SLOTS; float* TB = WSP(float, WS_SCR + 320 * MiB);
                        { pg8::LimitOrder S; S.so.init(T * 256, DM, F.G, F.bx, WGM_MOE2); S.limit = split ? full : nwg;
                          pg8::GroupedLimit GS{S, (LAS int*)(F.lds + TAB_OFF), DM / 256};
                          pg8::EpiScatter E{WSP(bf16, WS_H), tokm, DM / 256, 1.0f};
                          run_gemm(F, WSP(bf16, WS_HIDM), WSP(bf16, WS_WF2), T * 256, DM, DFE, GS, E, false); }
                        const bool more = c * 2 + r < 3;
                        if (split) {
                            const int KP = DFE / NS;
                            if (F.bx < NS * R) { const int Lx = full + F.bx / NS, kp = F.bx % NS;
                                pg8::StaticOrder so; so.init(T * 256, DM, F.G, Lx % F.G, WGM_MOE2); pg8::Unit un; so.next(Lx / F.G, un);
                                un.pn += ((LAS int*)(F.lds + TAB_OFF))[un.pm] * (DM / 256);
                                pg8::SingleOrder S1{un};
                                if (kp == 0) { pg8::EpiScatter E{WSP(bf16, WS_H), tokm, DM / 256, 1.0f};
                                    run_gemm(F, WSP(bf16, WS_HIDM), WSP(bf16, WS_WF2), T * 256, DM, KP, S1, E, false, 0, DFE); }
                                else { pg8::EpiTile E{TB + ((size_t)(Lx - full) * 3 + (kp - 1)) * 65536};
                                    run_gemm(F, WSP(bf16, WS_HIDM) + kp * KP, WSP(bf16, WS_WF2) + kp * KP, T * 256, DM, KP, S1, E, false, 0, DFE); } }
                            if (more) p_gather(F, jj, (c * 2 + r + 1) >> 1, (c * 2 + r + 1) & 1, NS * R);
                            { unsigned zb_; asm volatile("v_mov_b32 %0, 0" : "=v"(zb_)); bar.z = zb_; xcd_barrier(bar); }
                            for (int it = (F.vcu * NWAVES + F.wave); it < R * 256; it += F.G * NWAVES) { const int j = it >> 8, row = it & 255, Lx = full + j;
                                pg8::StaticOrder so; so.init(T * 256, DM, F.G, Lx % F.G, WGM_MOE2); pg8::Unit un; so.next(Lx / F.G, un);
                                const int t = tokm[un.pm * 256 + row];
                                if (t >= 0) { v2u* hp = (v2u*)(WSP(bf16, WS_H) + (size_t)t * DM + un.pn * 256) + F.lane; const v2u hv = *hp; f32x4 a = (f32x4){bflo(hv.x), bfhi(hv.x), bflo(hv.y), bfhi(hv.y)};
                                    for (int q = 0; q < NS - 1; ++q) a = a + ((const f32x4*)(TB + ((size_t)j * 3 + q) * 65536 + row * 256))[F.lane];
                                    *hp = (v2u){pk2(a.x, a.y), pk2(a.z, a.w)}; } }
                        } else if (!F.rep && more) p_gather(F, jj, (c * 2 + r + 1) >> 1, (c * 2 + r + 1) & 1, R);
                    STEP_END
                }
#endif
        }
    }
    STEP_BEGIN
        p_norm<2, true>(F, WSP(bf16, WS_H), F.in[19], nullptr, 0);
    STEP_END
#undef STEP_BEGIN
#undef STEP_END
}

#ifndef MK_STEPS_PER_LAUNCH
#define MK_STEPS_PER_LAUNCH 1
#endif
extern "C" void kernel_launch(void* const* d_in, const int* in_sizes, int n_in, void* d_out, int out_size, void* d_ws, size_t ws_size, hipStream_t stream) {
    static int grid = 0;
    if (grid == 0) {
        if (n_in != 20 || in_sizes[0] != MTOK * DM || out_size != MTOK * DM || ws_size < WS_END) { fprintf(stderr, "kernel_launch: unexpected shapes (n_in %d, in0 %d, out %d, ws %zu)\n", n_in, n_in > 0 ? in_sizes[0] : -1, out_size, ws_size); grid = -1; return; }
        int dev = 0, cus = 0, per_cu = 0;
        if (hipGetDevice(&dev) != hipSuccess || hipDeviceGetAttribute(&cus, hipDeviceAttributeMultiprocessorCount, dev) != hipSuccess) { grid = -1; return; }
        if (hipFuncSetAttribute((const void*)mk_fwd, hipFuncAttributeMaxDynamicSharedMemorySize, LDS_BYTES) != hipSuccess) { fprintf(stderr, "kernel_launch: hipFuncSetAttribute failed\n"); grid = -1; return; }
        if (hipOccupancyMaxActiveBlocksPerMultiprocessor(&per_cu, (const void*)mk_fwd, NWAVES * 64, LDS_BYTES) != hipSuccess || per_cu < 1) fprintf(stderr, "kernel_launch: occupancy query reports %d\n", per_cu);
        (void)hipGetLastError();
        grid = cus;
    }
    if (grid < 0) return;
    if (hipMemsetAsync((char*)d_ws + WS_CTL, 0, CTL_ZERO_BYTES, stream) != hipSuccess) return;
    Args a{};
    for (int i = 0; i < 20; ++i) a.in[i] = (const float*)d_in[i];
    a.out = (float*)d_out; a.ws = (unsigned char*)d_ws; a.rep = 0;
    #ifdef ABL_DENSE_MOE
    constexpr int NSTEPS = 2 * (1 + NCHUNK * 8 + 3) + 2 * (1 + NCHUNK * 8 + 1 + NEXP * 2) + 1;
#else
    constexpr int NSTEPS = 2 * (1 + NCHUNK * 7 + 1 + 2 * FFN_CHUNKS) + 2 * (1 + NCHUNK * 7 + 2 + NCHUNK * 2 * 2) + 1;
#endif
    int li = 0;
#ifdef REPMASK
    static int kinds[256]; int ns = 0;
    for (int layer = 0; layer < DEPTH; ++layer) { kinds[ns++] = 0;
        for (int c = 0; c < NCHUNK; ++c) for (int q = 1; q <= 8; ++q) if (q != 5) kinds[ns++] = q;
        if ((layer & 1) == 0) { kinds[ns++] = 9; for (int c = 0; c < FFN_CHUNKS; ++c) { kinds[ns++] = 10; kinds[ns++] = 11; } }
        else { kinds[ns++] = 12; kinds[ns++] = 17; for (int c = 0; c < NCHUNK * 2; ++c) { kinds[ns++] = 14; kinds[ns++] = 13; } } }
    kinds[ns++] = 16;
    for (int s = 0; s < NSTEPS; ++s) { const int reps = ((REPMASK >> kinds[s]) & 1) ? 2 : 1;
        for (int r = 0; r < reps; ++r) { a.lo = s; a.hi = s + 1; a.li = 0; a.rep = r;
            hipLaunchKernelGGL(mk_fwd, dim3(grid), dim3(NWAVES * 64), LDS_BYTES, stream, a); } }
    (void)li;
#else
    for (int s = 0; s < NSTEPS; s += MK_STEPS_PER_LAUNCH) {
        a.lo = s; a.hi = (s + MK_STEPS_PER_LAUNCH < NSTEPS) ? s + MK_STEPS_PER_LAUNCH : NSTEPS; a.li = (MK_STEPS_PER_LAUNCH > 1) ? li : 0; ++li;
        hipLaunchKernelGGL(mk_fwd, dim3(grid), dim3(NWAVES * 64), LDS_BYTES, stream, a);
        if (hipPeekAtLastError() != hipSuccess) { fprintf(stderr, "kernel_launch: launch failed\n"); break; }
    }
#endif
}
```

```cpp
#define MK_STEPS_PER_LAUNCH 1000
#define PG8_WGM 4
#define FFN_CHUNKS 1
#include <hip/hip_runtime.h>
#include <cstdio>
#include <cstdint>
#include <cmath>
#ifndef PG8_AUX_A
#define PG8_AUX_A 0
#endif
#ifndef PG8_AUX_B
#define PG8_AUX_B 0
#endif
#ifndef PG8_WGM
#define PG8_WGM 8
#endif
namespace pg8 {
#define PG8_LAS __attribute__((address_space(3)))
typedef unsigned short bf16_t;
typedef short bf16x8 __attribute__((ext_vector_type(8)));
typedef float f32x4 __attribute__((ext_vector_type(4)));
typedef unsigned u32x4 __attribute__((ext_vector_type(4)));
constexpr int BM = 256, BK = 64, HALF = 128, HTB = HALF * BK * 2  , STAGE_BYTES = 8 * HTB, NXCD = 8, WGM = PG8_WGM;

__host__ __device__ __forceinline__ int lds_byte(int r, int c) { const int st = (r >> 4) * 2 + (c >> 5), rr = r & 15, cc = c & 31, ob = rr * 64 + cc * 2; return st * 1024 + (ob ^ (((ob >> 9) & 1) << 5)); }
__host__ __device__ __forceinline__ void stage_rc(int b, int& R, int& C) { const int st = b / 1024, sb = b % 1024, swz = sb ^ (((sb >> 9) & 1) << 5); R = (st >> 1) * 16 + swz / 64; C = (st & 1) * 32 + (swz % 64) / 2; }
__host__ __device__ __forceinline__ int perm32(int rho) { const int n = rho >> 4, i = rho & 15; return 8 * (i >> 2) + 4 * n + (i & 3); }

struct Unit { int pm, pn; };
struct Gemm { const bf16_t* A; const bf16_t* Bt; int M, N, K; int zv; int rot; int tiled; int ld; };

struct StaticOrder {
    int nM, nN, nwg, G, c, wgm;
    __host__ __device__ __forceinline__ void init(int M, int N, int G_, int c_, int wgm_ = WGM) { nM = M / BM; nN = N / BM; nwg = nM * nN; G = G_; c = c_; wgm = wgm_; }
    __host__ __device__ __forceinline__ bool next(int i, Unit& u) const {
        const long L = (long)i * G + c; if (L >= nwg) return false;
        int wgid = (int)L; { const int q = nwg / NXCD, r = nwg % NXCD, xcd = wgid % NXCD, off = wgid / NXCD; wgid = (xcd < r ? xcd * (q + 1) : r * (q + 1) + (xcd - r) * q) + off; }
        const int nig = wgm * nN, gid = wgid / nig, fm = gid * wgm, gsz = (nM - fm) < wgm ? (nM - fm) : wgm;
        u.pm = fm + ((wgid % nig) % gsz); u.pn = (wgid % nig) / gsz; return true;
    }
    __device__ __forceinline__ void a_ready(const Unit&) const {}
    __device__ __forceinline__ void done(const Unit&) const {}
};

__device__ __forceinline__ unsigned cvt_pk_bf16(float lo, float hi) { unsigned r; asm volatile("v_cvt_pk_bf16_f32 %0, %1, %2" : "=v"(r) : "v"(lo), "v"(hi)); return r; }
typedef float f32x2 __attribute__((ext_vector_type(2)));

__device__ __forceinline__ float fast_sigmoid(float x) { return __builtin_amdgcn_rcpf(1.0f + __builtin_amdgcn_exp2f(-1.4426950408889634f * x)); }
__device__ __forceinline__ float gelu_tanh(float x) {
    const float u2 = 1.5957691216057308f * (x + 0.044715f * x * x * x);
    return x * fast_sigmoid(u2);
}
__device__ __forceinline__ float bf_lo(unsigned u) { return __builtin_bit_cast(float, u << 16); }
__device__ __forceinline__ float bf_hi(unsigned u) { return __builtin_bit_cast(float, u & 0xffff0000u); }

#ifdef PG8_NT_OUT
#define PG8_STORE_OUT(p, v) __builtin_nontemporal_store((v), (p))
#else
#define PG8_STORE_OUT(p, v) (*(p) = (v))
#endif
struct EpiProj {
    static constexpr bool PERM = true, AFTER_DRAIN = false, MID = false; static constexpr int MID_TILES = 1; __device__ __forceinline__ void set_scale0() {}
    bf16_t* P1; bf16_t* G;
    __device__ __forceinline__ void operator()(const f32x4 (&acc)[2][2][4][2], const Unit& u, int wr, int wc, int fr, int fq) const {
        const int row0 = u.pm * BM + wr * 64 + fr;
        bf16_t* base; int ldc, colt, act0, act1;
        if (u.pn < 8) { base = P1; ldc = 2048; colt = u.pn * BM; act0 = (u.pn < 2) ? 1 : 0; act1 = (u.pn == 7) ? 2 : act0; }
        else { base = G; ldc = 3072; colt = (u.pn - 8) * BM; act0 = 2; act1 = 2; }
        const int col0 = colt + wc * 32 + 8 * fq;
#pragma unroll
        for (int ai = 0; ai < 2; ++ai)
#pragma unroll
            for (int m = 0; m < 4; ++m) { bf16_t* rowp = base + (size_t)(row0 + ai * HALF + m * 16) * ldc + col0;
#pragma unroll
                for (int bj = 0; bj < 2; ++bj) { f32x4 v0 = acc[ai][bj][m][0], v1 = acc[ai][bj][m][1]; const int act = bj ? act1 : act0;
                    if (act == 1) {
#pragma unroll
                        for (int e = 0; e < 4; ++e) { v0[e] = gelu_tanh(v0[e]); v1[e] = gelu_tanh(v1[e]); } }
                    else if (act == 2) {
#pragma unroll
                        for (int e = 0; e < 4; ++e) { v0[e] = fast_sigmoid(v0[e]); v1[e] = fast_sigmoid(v1[e]); } }
                    u32x4 w; w.x = cvt_pk_bf16(v0[0], v0[1]); w.y = cvt_pk_bf16(v0[2], v0[3]); w.z = cvt_pk_bf16(v1[0], v1[1]); w.w = cvt_pk_bf16(v1[2], v1[3]);
                    *(u32x4*)(rowp + bj * HALF) = w; } }
    }
};
struct EpiMerge {
    static constexpr bool PERM = true, AFTER_DRAIN = false, MID = false; static constexpr int MID_TILES = 1; __device__ __forceinline__ void set_scale0() {}
    const bf16_t* G; bf16_t* MG; int nmt;
    __device__ __forceinline__ void operator()(const f32x4 (&acc)[2][2][4][2], const Unit& u, int wr, int wc, int fr, int fq) const {
        const int i = u.pn >> 2, pn = u.pn & 3, pm = u.pm - i * nmt;
        const int row0 = pm * BM + wr * 64 + fr, col0 = pn * BM + wc * 32 + 8 * fq;
#pragma unroll
        for (int ai = 0; ai < 2; ++ai)
#pragma unroll
            for (int mp = 0; mp < 2; ++mp) {
                u32x4 g[4], o[4];
#pragma unroll
                for (int q = 0; q < 4; ++q) { const int m = 2 * mp + (q >> 1), bj = q & 1; const size_t row = (size_t)(row0 + ai * HALF + m * 16); const int col = col0 + bj * HALF;
                    g[q] = *(const u32x4*)(G + row * 3072 + i * 1024 + col);
                    if (i > 0) o[q] = *(const u32x4*)(MG + row * 1024 + col); else o[q] = (u32x4){0u, 0u, 0u, 0u}; }
#pragma unroll
                for (int q = 0; q < 4; ++q) { const int m = 2 * mp + (q >> 1), bj = q & 1; const size_t row = (size_t)(row0 + ai * HALF + m * 16); const int col = col0 + bj * HALF;
                    f32x4 v0 = acc[ai][bj][m][0], v1 = acc[ai][bj][m][1];
#ifdef ABL_BRANCH
                    if (i == ABL_BRANCH) { v0 = v0 * (float)ABL_SCALE; v1 = v1 * (float)ABL_SCALE; }
#endif
                    v0[0] = v0[0] * bf_lo(g[q].x) + bf_lo(o[q].x); v0[1] = v0[1] * bf_hi(g[q].x) + bf_hi(o[q].x); v0[2] = v0[2] * bf_lo(g[q].y) + bf_lo(o[q].y); v0[3] = v0[3] * bf_hi(g[q].y) + bf_hi(o[q].y);
                    v1[0] = v1[0] * bf_lo(g[q].z) + bf_lo(o[q].z); v1[1] = v1[1] * bf_hi(g[q].z) + bf_hi(o[q].z); v1[2] = v1[2] * bf_lo(g[q].w) + bf_lo(o[q].w); v1[3] = v1[3] * bf_hi(g[q].w) + bf_hi(o[q].w);
                    u32x4 w; w.x = cvt_pk_bf16(v0[0], v0[1]); w.y = cvt_pk_bf16(v0[2], v0[3]); w.z = cvt_pk_bf16(v1[0], v1[1]); w.w = cvt_pk_bf16(v1[2], v1[3]);
                    *(u32x4*)(MG + row * 1024 + col) = w; } }
    }
};
typedef unsigned u32x2 __attribute__((ext_vector_type(2)));
struct EpiResid {
    static constexpr bool PERM = false, AFTER_DRAIN = false, MID = false; static constexpr int MID_TILES = 1; __device__ __forceinline__ void set_scale0() { scale = 0.f; x32 = nullptr; }
    const float* x32; bf16_t* out; int ldc; float scale;
    __device__ __forceinline__ void operator()(const f32x4 (&acc)[2][2][4][2], const Unit& u, int wr, int wc, int fr, int fq) const {
        const int row0 = u.pm * BM + wr * 64 + fr, col0 = u.pn * BM + wc * 32 + 4 * fq;
#pragma unroll
        for (int ai = 0; ai < 2; ++ai)
#pragma unroll
            for (int mp = 0; mp < 2; ++mp) {
                f32x4 b[8];
                if (x32) {
#pragma unroll
                    for (int q = 0; q < 8; ++q) { const int m = 2 * mp + (q >> 2), bj = (q >> 1) & 1, n = q & 1;
                        b[q] = *(const f32x4*)(x32 + (size_t)(row0 + ai * HALF + m * 16) * ldc + col0 + bj * HALF + n * 16); }
                } else {
                    u32x2 t[8];
#pragma unroll
                    for (int q = 0; q < 8; ++q) { const int m = 2 * mp + (q >> 2), bj = (q >> 1) & 1, n = q & 1;
                        t[q] = *(const u32x2*)(out + (size_t)(row0 + ai * HALF + m * 16) * ldc + col0 + bj * HALF + n * 16); }
#pragma unroll
                    for (int q = 0; q < 8; ++q) b[q] = (f32x4){bf_lo(t[q].x), bf_hi(t[q].x), bf_lo(t[q].y), bf_hi(t[q].y)};
                }
#pragma unroll
                for (int q = 0; q < 8; ++q) { const int m = 2 * mp + (q >> 2), bj = (q >> 1) & 1, n = q & 1; const f32x4 r = b[q] + acc[ai][bj][m][n] * scale;
                    *(u32x2*)(out + (size_t)(row0 + ai * HALF + m * 16) * ldc + col0 + bj * HALF + n * 16) = (u32x2){cvt_pk_bf16(r.x, r.y), cvt_pk_bf16(r.z, r.w)}; } }
    }
};
struct EpiF32 {
    static constexpr bool PERM = false, AFTER_DRAIN = false, MID = false; static constexpr int MID_TILES = 1; __device__ __forceinline__ void set_scale0() {}
    float* O; int ldc, nN;
    __device__ __forceinline__ void operator()(const f32x4 (&acc)[2][2][4][2], const Unit& u, int wr, int wc, int fr, int fq) const {
        const int row0 = u.pm * BM + wr * 64 + fr, col0 = (u.pn % nN) * BM + wc * 32 + 4 * fq;
#pragma unroll
        for (int ai = 0; ai < 2; ++ai)
#pragma unroll
            for (int m = 0; m < 4; ++m) { const size_t off = (size_t)(row0 + ai * HALF + m * 16) * ldc + col0;
#pragma unroll
                for (int bj = 0; bj < 2; ++bj)
#pragma unroll
                    for (int n = 0; n < 2; ++n) *(f32x4*)(O + off + bj * HALF + n * 16) = acc[ai][bj][m][n]; }
    }
};
#ifdef EMU_FP8_HID
__device__ __forceinline__ float Q8H(float x) { const int p = __builtin_amdgcn_cvt_pk_fp8_f32(x * 8.f, x * 8.f, 0, false); return __builtin_amdgcn_cvt_f32_fp8(p, 0) * 0.125f; }
#else
__device__ __forceinline__ float Q8H(float x) { return x; }
#endif
struct EpiSwiGLU {
    static constexpr bool PERM = true, AFTER_DRAIN = false, MID = false; static constexpr int MID_TILES = 1; __device__ __forceinline__ void set_scale0() {}
    bf16_t* H; int ldh; const float* rowscale; int nN; int rowmask = 0x7fffffff;
    __device__ __forceinline__ void operator()(const f32x4 (&acc)[2][2][4][2], const Unit& u, int wr, int wc, int fr, int fq) const {
        const int row0 = u.pm * BM + wr * 64 + fr, col0 = (u.pn % nN) * HALF + wc * 32 + 8 * fq;
        float scv[8];
#pragma unroll
        for (int q = 0; q < 8; ++q) scv[q] = rowscale ? rowscale[row0 + (q >> 2) * HALF + (q & 3) * 16] : 1.0f;
#pragma unroll
        for (int ai = 0; ai < 2; ++ai)
#pragma unroll
            for (int m = 0; m < 4; ++m) { const int row = row0 + ai * HALF + m * 16; const float sc = scv[ai * 4 + m];
                float h[8];
#pragma unroll
                for (int n = 0; n < 2; ++n)
#pragma unroll
                    for (int e = 0; e < 4; ++e) { const float g = acc[ai][0][m][n][e], up = acc[ai][1][m][n][e]; h[n * 4 + e] = Q8H(g * fast_sigmoid(g) * up * sc); }
                u32x4 w; w.x = cvt_pk_bf16(h[0], h[1]); w.y = cvt_pk_bf16(h[2], h[3]); w.z = cvt_pk_bf16(h[4], h[5]); w.w = cvt_pk_bf16(h[6], h[7]);
                PG8_STORE_OUT((u32x4*)(H + (size_t)(row & rowmask) * ldh + col0), w); }
    }
};
struct EpiScatter {
    static constexpr bool PERM = false, AFTER_DRAIN = false, MID = false; static constexpr int MID_TILES = 1; __device__ __forceinline__ void set_scale0() { scale = 0.f; }
    bf16_t* out; const int* tok; int nN; float scale;
    __device__ __forceinline__ void operator()(const f32x4 (&acc)[2][2][4][2], const Unit& u, int wr, int wc, int fr, int fq) const {
        const int row0 = u.pm * BM + wr * 64 + fr, col0 = (u.pn % nN) * BM + wc * 32 + 4 * fq;
        int tk[8];
#pragma unroll
        for (int q = 0; q < 8; ++q) tk[q] = tok[row0 + (q >> 2) * HALF + (q & 3) * 16];
#pragma unroll
        for (int ai = 0; ai < 2; ++ai)
#pragma unroll
            for (int mp = 0; mp < 2; ++mp) {
                u32x2 b[8];
#pragma unroll
                for (int q = 0; q < 8; ++q) { const int m = 2 * mp + (q >> 2), bj = (q >> 1) & 1, n = q & 1; const int t = tk[ai * 4 + m];
                    b[q] = *(const u32x2*)(out + (size_t)(t < 0 ? 0 : t) * 1024 + col0 + bj * HALF + n * 16); }
#pragma unroll
                for (int q = 0; q < 8; ++q) { const int m = 2 * mp + (q >> 2), bj = (q >> 1) & 1, n = q & 1; const int t = tk[ai * 4 + m];
                    if (t >= 0) { const f32x4 r = (f32x4){bf_lo(b[q].x), bf_hi(b[q].x), bf_lo(b[q].y), bf_hi(b[q].y)} + acc[ai][bj][m][n] * scale;
                        *(u32x2*)(out + (size_t)t * 1024 + col0 + bj * HALF + n * 16) = (u32x2){cvt_pk_bf16(r.x, r.y), cvt_pk_bf16(r.z, r.w)}; } } }
    }
};
struct GroupedOrder {
    StaticOrder so; const PG8_LAS int* tile_e; int nN;
    __device__ __forceinline__ bool next(int i, Unit& u) const { if (!so.next(i, u)) return false; u.pn += tile_e[u.pm] * nN; return true; }
    __device__ __forceinline__ void a_ready(const Unit&) const {}
    __device__ __forceinline__ void done(const Unit&) const {}
};
struct LimitOrder {
    StaticOrder so; int limit;
    __device__ __forceinline__ bool next(int i, Unit& u) const { if ((long)i * so.G + so.c >= limit) return false; return so.next(i, u); }
    __device__ __forceinline__ void a_ready(const Unit&) const {}
    __device__ __forceinline__ void done(const Unit&) const {}
};
struct GroupedLimit {
    LimitOrder lo; const PG8_LAS int* tile_e; int nN;
    __device__ __forceinline__ bool next(int i, Unit& u) const { if (!lo.next(i, u)) return false; u.pn += tile_e[u.pm] * nN; return true; }
    __device__ __forceinline__ void a_ready(const Unit&) const {}
    __device__ __forceinline__ void done(const Unit&) const {}
};
struct SingleOrder {
    Unit un;
    __device__ __forceinline__ bool next(int i, Unit& u) const { if (i != 0) return false; u = un; return true; }
    __device__ __forceinline__ void a_ready(const Unit&) const {}
    __device__ __forceinline__ void done(const Unit&) const {}
};
struct EpiTile {
    static constexpr bool PERM = false, AFTER_DRAIN = false, MID = false; static constexpr int MID_TILES = 1; __device__ __forceinline__ void set_scale0() {}
    float* O;
    __device__ __forceinline__ void operator()(const f32x4 (&acc)[2][2][4][2], const Unit&, int wr, int wc, int fr, int fq) const {
#pragma unroll
        for (int ai = 0; ai < 2; ++ai)
#pragma unroll
            for (int m = 0; m < 4; ++m)
#pragma unroll
                for (int bj = 0; bj < 2; ++bj)
#pragma unroll
                    for (int n = 0; n < 2; ++n) *(f32x4*)(O + (size_t)(wr * 64 + fr + ai * HALF + m * 16) * 256 + wc * 32 + 4 * fq + bj * HALF + n * 16) = acc[ai][bj][m][n];
    }
};
struct OffsetOrder {
    StaticOrder so; int pn_off;
    __device__ __forceinline__ bool next(int i, Unit& u) const { if (!so.next(i, u)) return false; u.pn += pn_off; return true; }
    __device__ __forceinline__ void a_ready(const Unit&) const {}
    __device__ __forceinline__ void done(const Unit&) const {}
};
struct ProbeOrder {
    StaticOrder so; int pm_mask;
    __device__ __forceinline__ bool next(int i, Unit& u) const { if (!so.next(i, u)) return false; u.pm &= pm_mask; return true; }
    __device__ __forceinline__ void a_ready(const Unit&) const {}
    __device__ __forceinline__ void done(const Unit&) const {}
};
struct MergeOrder {
    StaticOrder so; int nmt;
    __device__ __forceinline__ bool next(int i, Unit& u) const { const int b = i % 3; if (!so.next(i / 3, u)) return false; u.pm += b * nmt; u.pn += b * 4; return true; }
    __device__ __forceinline__ void a_ready(const Unit&) const {}
    __device__ __forceinline__ void done(const Unit&) const {}
};
template <class Epi, class Sched, bool ALIGN_EPI = false, bool SP2 = false>
__device__ __forceinline__ void gemm_phase(PG8_LAS unsigned char* lds, const Gemm g, const Sched& S, const Epi& E) {
    const int tid = g.zv  , wid = __builtin_amdgcn_readfirstlane(tid >> 6), lane = tid & 63, wr = wid >> 2, wc = wid & 3, fr = lane & 15, fq = lane >> 4;
    const int K = g.K, nt = K / BK;
    unsigned voffA[2], voffB[2];
#pragma unroll
    for (int i = 0; i < 2; ++i) { int R, C; stage_rc(tid * 16 + i * 8192, R, C); const int Rb = Epi::PERM ? ((R & ~31) + perm32(R & 31)) : R;
        const int LD = g.ld ? g.ld : K;
        const int pitch = g.tiled ? BK : LD;
        voffA[i] = (unsigned)(R * pitch + C) * 2u; voffB[i] = (unsigned)(Rb * pitch + C) * 2u; }
    const size_t kstep = g.tiled ? (size_t)(BM * BK * 2) : (size_t)(BK * 2);
    const size_t hstep = g.tiled ? (size_t)(HALF * BK * 2) : (size_t)HALF * (g.ld ? g.ld : K) * 2;
    const size_t tstep = (size_t)BM * (g.ld ? g.ld : K) * 2;
    const unsigned ldsw = (unsigned)wid * 1024u;
    const int aoff = lds_byte(wr * 64 + fr, fq * 8), boff = lds_byte(wc * 32 + fr, fq * 8);
#define PG8_SA(b, h) (((b) * 2 + (h)) * HTB)
#define PG8_SB(b, h) ((4 + (b) * 2 + (h)) * HTB)
#define PG8_STAGE(bufoff, gbase, voff) do { _Pragma("unroll") for (int _i = 0; _i < 2; ++_i) \
        __builtin_amdgcn_global_load_lds((const unsigned*)((const char*)(gbase) + (voff)[_i]), (PG8_LAS unsigned*)(lds + (bufoff) + ldsw + _i * 8192), 16, 0, ((bufoff) < 4 * HTB) ? PG8_AUX_A : PG8_AUX_B); } while (0)
#define PG8_LDA(dst, b, h) do { _Pragma("unroll") for (int m = 0; m < 4; ++m) _Pragma("unroll") for (int k = 0; k < 2; ++k) dst[m][k] = *(const PG8_LAS bf16x8*)(lds + PG8_SA(b, h) + aoff + m * 2048 + k * 1024); } while (0)
#define PG8_LDB(dst, b, h) do { _Pragma("unroll") for (int n = 0; n < 2; ++n) _Pragma("unroll") for (int k = 0; k < 2; ++k) dst[n][k] = *(const PG8_LAS bf16x8*)(lds + PG8_SB(b, h) + boff + n * 2048 + k * 1024); } while (0)
#define PG8_MMA(ai, bj, At, Bt) do { __builtin_amdgcn_s_setprio(1); _Pragma("unroll") for (int m = 0; m < 4; ++m) _Pragma("unroll") for (int n = 0; n < 2; ++n) _Pragma("unroll") for (int k = 0; k < 2; ++k) \
        acc[ai][bj][m][n] = __builtin_amdgcn_mfma_f32_16x16x32_bf16(Bt[n][k], At[m][k], acc[ai][bj][m][n], 0, 0, 0); __builtin_amdgcn_s_setprio(0); } while (0)
#define PG8_WAIT_V(n) asm volatile("s_waitcnt vmcnt(" #n ")" ::: "memory")
#define PG8_WAIT_L(n) asm volatile("s_waitcnt lgkmcnt(" #n ")" ::: "memory")
#define PG8_BAR __builtin_amdgcn_s_barrier()
#define PG8_SCHED __builtin_amdgcn_sched_barrier(0)
    Unit cur, nxt; int ui = 0;
    if (!S.next(0, cur)) return;
    f32x4 acc[2][2][4][2];
#pragma unroll
    for (int a = 0; a < 2; ++a)
#pragma unroll
        for (int b = 0; b < 2; ++b)
#pragma unroll
            for (int m = 0; m < 4; ++m)
#pragma unroll
                for (int n = 0; n < 2; ++n) acc[a][b][m][n] = (f32x4){0.f, 0.f, 0.f, 0.f};
    bf16x8 At[4][2], B0[2][2], B1[2][2];
    const char* cA = (const char*)g.A + (size_t)cur.pm * tstep; const char* cB = (const char*)g.Bt + (size_t)cur.pn * tstep;
    const int rot = g.rot; const size_t rofs = (size_t)rot * kstep; const char* pA = cA + rofs; const char* pB = cB + rofs;
#define PG8_KT(x) ((size_t)(((x) + rot >= nt) ? (x) + rot - nt : (x) + rot))
    S.a_ready(cur);
    if constexpr (SP2) {
        PG8_STAGE(PG8_SB(0, 0), pB, voffB); PG8_STAGE(PG8_SB(0, 1), pB + hstep, voffB); PG8_STAGE(PG8_SA(0, 0), pA, voffA); PG8_STAGE(PG8_SA(0, 1), pA + hstep, voffA);
        if (wr == 1) PG8_BAR;
        PG8_WAIT_V(2); PG8_BAR;
        PG8_STAGE(PG8_SB(1, 0), pB + kstep, voffB); PG8_STAGE(PG8_SA(1, 0), pA + kstep, voffA); PG8_STAGE(PG8_SB(1, 1), pB + hstep + kstep, voffB);
        PG8_WAIT_V(6); PG8_BAR;
    } else {
        PG8_STAGE(PG8_SB(0, 0), pB, voffB); PG8_STAGE(PG8_SA(0, 0), pA, voffA); PG8_STAGE(PG8_SB(0, 1), pB + hstep, voffB); PG8_STAGE(PG8_SA(0, 1), pA + hstep, voffA);
        if (wr == 1) PG8_BAR;
        PG8_WAIT_V(4); PG8_BAR;
        PG8_STAGE(PG8_SB(1, 0), pB + kstep, voffB); PG8_STAGE(PG8_SA(1, 0), pA + kstep, voffA); PG8_STAGE(PG8_SB(1, 1), pB + hstep + kstep, voffB);
        PG8_WAIT_V(6); PG8_BAR;
    }
    for (;;) {
        const bool has_next = S.next(ui + 1, nxt);
        const char* nA = has_next ? (const char*)g.A + (size_t)nxt.pm * tstep : cA; const char* nB = has_next ? (const char*)g.Bt + (size_t)nxt.pn * tstep : cB;
        for (int t = 0; t < nt; t += 2) {
            if constexpr (Epi::MID) { if (t != 0 && (t & (Epi::MID_TILES - 1)) == 0) E.mid(acc, cur, t / Epi::MID_TILES, wr, wc, fr, fq); }
            const bool last = (t == nt - 2);
            const char* a1 = cA + PG8_KT(t + 1) * kstep;
            const char* a2 = last ? nA + rofs : cA + PG8_KT(t + 2) * kstep; const char* b2 = last ? nB + rofs : cB + PG8_KT(t + 2) * kstep;
            const char* a3 = a2 + kstep; const char* b3 = b2 + kstep;
            if (last && has_next) S.a_ready(nxt);
            if constexpr (SP2) {
            PG8_LDB(B0, 0, 0); PG8_LDB(B1, 0, 1); PG8_SCHED; PG8_LDA(At, 0, 0); PG8_STAGE(PG8_SA(1, 1), a1 + hstep, voffA);
            PG8_WAIT_V(8); PG8_WAIT_L(0); PG8_BAR; PG8_MMA(0, 0, At, B0); PG8_MMA(0, 1, At, B1); PG8_BAR; PG8_SCHED;
            PG8_LDA(At, 0, 1); PG8_STAGE(PG8_SB(0, 0), b2, voffB); PG8_STAGE(PG8_SB(0, 1), b2 + hstep, voffB); PG8_STAGE(PG8_SA(0, 0), a2, voffA);
            PG8_WAIT_V(8); PG8_WAIT_L(0); PG8_BAR; PG8_MMA(1, 0, At, B0); PG8_MMA(1, 1, At, B1); PG8_BAR; PG8_SCHED;
            PG8_LDB(B0, 1, 0); PG8_LDB(B1, 1, 1); PG8_SCHED; PG8_LDA(At, 1, 0); PG8_STAGE(PG8_SA(0, 1), a2 + hstep, voffA);
            PG8_WAIT_V(8); PG8_WAIT_L(0); PG8_BAR; PG8_MMA(0, 0, At, B0); PG8_MMA(0, 1, At, B1); PG8_BAR; PG8_SCHED;
            PG8_LDA(At, 1, 1); PG8_STAGE(PG8_SB(1, 0), b3, voffB); PG8_STAGE(PG8_SB(1, 1), b3 + hstep, voffB); PG8_STAGE(PG8_SA(1, 0), a3, voffA);
            PG8_WAIT_V(8); PG8_WAIT_L(0); PG8_BAR; PG8_MMA(1, 0, At, B0); PG8_MMA(1, 1, At, B1); PG8_BAR; PG8_SCHED;
            } else {
            PG8_LDB(B0, 0, 0); PG8_SCHED; PG8_LDA(At, 0, 0); PG8_STAGE(PG8_SA(1, 1), a1 + hstep, voffA);
            PG8_WAIT_L(8); PG8_BAR; PG8_WAIT_L(0); PG8_MMA(0, 0, At, B0); PG8_BAR; PG8_SCHED;
            PG8_LDB(B1, 0, 1); PG8_STAGE(PG8_SB(0, 0), b2, voffB);
            PG8_BAR; PG8_WAIT_L(0); PG8_MMA(0, 1, At, B1); PG8_BAR;
            PG8_LDA(At, 0, 1); PG8_STAGE(PG8_SA(0, 0), a2, voffA);
            PG8_BAR; PG8_WAIT_L(0); PG8_MMA(1, 0, At, B0); PG8_BAR; PG8_SCHED;
            PG8_STAGE(PG8_SB(0, 1), b2 + hstep, voffB);
            PG8_WAIT_V(6); PG8_BAR; PG8_MMA(1, 1, At, B1); PG8_BAR;
            PG8_LDB(B0, 1, 0); PG8_SCHED; PG8_LDA(At, 1, 0); PG8_STAGE(PG8_SA(0, 1), a2 + hstep, voffA);
            PG8_WAIT_L(8); PG8_BAR; PG8_WAIT_L(0); PG8_MMA(0, 0, At, B0); PG8_BAR; PG8_SCHED;
            PG8_LDB(B1, 1, 1); PG8_STAGE(PG8_SB(1, 0), b3, voffB);
            PG8_BAR; PG8_WAIT_L(0); PG8_MMA(0, 1, At, B1); PG8_BAR;
            PG8_LDA(At, 1, 1); PG8_STAGE(PG8_SA(1, 0), a3, voffA);
            PG8_BAR; PG8_WAIT_L(0); PG8_MMA(1, 0, At, B0); PG8_BAR; PG8_SCHED;
            PG8_STAGE(PG8_SB(1, 1), b3 + hstep, voffB);
            PG8_WAIT_V(6); PG8_BAR; PG8_MMA(1, 1, At, B1); PG8_BAR;
            }
        }
        if constexpr (ALIGN_EPI) { if (wr == 0) PG8_BAR; }
        if constexpr (!Epi::AFTER_DRAIN) { E(acc, cur, wr, wc, fr, fq); S.done(cur); }
        if (!has_next) break;
#pragma unroll
        for (int a = 0; a < 2; ++a)
#pragma unroll
            for (int b = 0; b < 2; ++b)
#pragma unroll
                for (int m = 0; m < 4; ++m)
#pragma unroll
                    for (int n = 0; n < 2; ++n) acc[a][b][m][n] = (f32x4){0.f, 0.f, 0.f, 0.f};
        cur = nxt; cA = nA; cB = nB; ++ui;
        if constexpr (ALIGN_EPI) { if (wr == 1) PG8_BAR; }
    }
    PG8_WAIT_V(0);
    if constexpr (!ALIGN_EPI) { if (wr == 0) PG8_BAR; }
    PG8_BAR;
    if constexpr (Epi::AFTER_DRAIN) { E.fused(acc, cur, wr, wc, fr, fq, lds, wid, lane); S.done(cur); }
#undef PG8_KT
#undef PG8_SA
#undef PG8_SB
#undef PG8_STAGE
#undef PG8_LDA
#undef PG8_LDB
#undef PG8_MMA
#undef PG8_WAIT_V
#undef PG8_WAIT_L
#undef PG8_BAR
#undef PG8_SCHED
}
}

constexpr int NWAVES = 8;
constexpr int DM = 1024, BATCH = 16, SEQ = 4096, DEPTH = 4, MTOK = BATCH * SEQ;
constexpr int NCHUNK = 2, MC = MTOK / NCHUNK, BC = BATCH / NCHUNK;
constexpr int CIN = 5004, NPROJ = 5120, P1W = 2048, GWID = 3072;
constexpr int DFF = 2752, DFFP = 2816, NFF1 = 2 * DFFP;
constexpr int NEXP = 8, DFE = 3584, NMOE1 = 2 * DFE;
constexpr int SLOTS = MC + 2048;
constexpr float EPS = 1e-6f;
constexpr int C_U = 0, C_V = 256, C_SBQ = 512, C_SBK = 768, C_SBV = 1024, C_CQ = 1280, C_KCMP = 1536, C_VCMP = 1600, C_KSLC = 1664, C_VSLC = 1728, C_KWIN = 1792, C_VWIN = 1856, C_CG = 1920;

constexpr size_t MiB = 1u << 20;
constexpr size_t WS_CTL = 0, CTL_ZERO_BYTES = 1 * MiB;
constexpr size_t WS_ROPE = 1 * MiB;
constexpr size_t WS_BIAS1 = 1 * MiB + 512 * 1024;
constexpr size_t WS_WIN = 2 * MiB;
constexpr size_t WS_WBR = 12 * MiB;
constexpr size_t WS_WOUT = 14 * MiB;
constexpr size_t WS_WC1 = 16 * MiB;
constexpr size_t WS_WF1 = 18 * MiB;
constexpr size_t WS_WF2 = 130 * MiB;
constexpr size_t WS_HN = 186 * MiB;
constexpr size_t WS_SCR = 314 * MiB;
constexpr size_t WS_P1 = WS_SCR;
constexpr size_t WS_G = WS_P1 + 128 * MiB;
constexpr size_t WS_Y = WS_G + 192 * MiB;
constexpr size_t WS_MG = WS_Y + 48 * MiB;
constexpr size_t WS_KVC = WS_MG + 64 * MiB;
constexpr size_t WS_UL = WS_KVC + 8 * MiB;
constexpr size_t WS_KC = WS_UL + 8 * MiB;
constexpr size_t WS_VT = WS_KC + 1 * MiB;
constexpr size_t WS_KCT = WS_VT + 24 * MiB;
constexpr size_t WS_MIX_END = WS_KCT + 1 * MiB;
constexpr size_t WS_HID = WS_SCR;
constexpr size_t WS_ROUTE = WS_SCR;
constexpr size_t WS_TOKMAP = WS_SCR + 1 * MiB;
constexpr size_t WS_WSLOT = WS_SCR + 2 * MiB;
constexpr size_t WS_CNT128 = WS_SCR + 3 * MiB;
constexpr size_t WS_XG = WS_SCR + 4 * MiB;
constexpr size_t WS_HIDM = WS_XG + 68 * MiB;
constexpr size_t WS_H = 800 * MiB;
constexpr size_t WS_END = 928 * MiB;
static_assert(WS_MIX_END <= WS_H && WS_HID + (size_t)MTOK * DFFP * 2 <= WS_H && WS_HIDM + (size_t)SLOTS * DFE * 2 <= WS_H, "d_ws map");
static_assert(WS_WF1 + (size_t)NEXP * NMOE1 * DM * 2 <= WS_WF2 && WS_WF2 + (size_t)NEXP * DM * DFE * 2 <= WS_HN, "weight map");
static_assert((size_t)4 * SLOTS * 4 <= 1 * MiB, "tokmap");
constexpr int CW_BAR = 4096;
constexpr int CW_CNT = 131072;
constexpr int CW_CUR = 131072 + 256;
constexpr int MAX_BAR_REGIONS = 32;
constexpr int RING_OFF = 0, RING_BYTES = 131072;
constexpr int LDSCTL_OFF = RING_BYTES, MISC_OFF = LDSCTL_OFF + 320;
constexpr int TAB_OFF = LDSCTL_OFF + 1024;
constexpr int LDS_BYTES = 147456;

#define GAS __attribute__((address_space(1)))
#define LAS __attribute__((address_space(3)))
typedef unsigned short bf16;
typedef unsigned v4u __attribute__((ext_vector_type(4)));
typedef unsigned v2u __attribute__((ext_vector_type(2)));
typedef float f32x4 __attribute__((ext_vector_type(4)));
typedef int v4i __attribute__((ext_vector_type(4)));
typedef __bf16 bf16x2_t __attribute__((ext_vector_type(2)));
#define LDS_WAIT() asm volatile("s_waitcnt lgkmcnt(0)" ::: "memory")
#define VM_WAIT() asm volatile("s_waitcnt vmcnt(0)" ::: "memory")
__device__ __forceinline__ unsigned f2bf(float f) { unsigned u = __builtin_bit_cast(unsigned, f); return (u + 0x7fffu + ((u >> 16) & 1u)) >> 16; }
__device__ __forceinline__ unsigned pk2(float lo, float hi) { return f2bf(lo) | (f2bf(hi) << 16); }
__device__ __forceinline__ float bflo(unsigned u) { return __builtin_bit_cast(float, u << 16); }
__device__ __forceinline__ float bfhi(unsigned u) { return __builtin_bit_cast(float, u & 0xffff0000u); }
__device__ __forceinline__ float bf1(bf16 h) { return __builtin_bit_cast(float, (unsigned)h << 16); }
__device__ __forceinline__ float dot2bf(unsigned a, unsigned b, float c) { return __builtin_amdgcn_fdot2_f32_bf16(__builtin_bit_cast(bf16x2_t, a), __builtin_bit_cast(bf16x2_t, b), c, false); }
#ifdef EMU_FP8
__device__ __forceinline__ float q8r(float x, float s) { const int p = __builtin_amdgcn_cvt_pk_fp8_f32(x * s, x * s, 0, false); return __builtin_amdgcn_cvt_f32_fp8(p, 0) * (1.0f / s); }
#else
__device__ __forceinline__ float q8r(float x, float) { return x; }
#endif
__device__ __forceinline__ float fexp(float x) { return __builtin_amdgcn_exp2f(1.4426950408889634f * x); }
template <int X> __device__ __forceinline__ float swz_xor(float v) { return __builtin_bit_cast(float, __builtin_amdgcn_ds_swizzle(__builtin_bit_cast(int, v), (X << 10) | 0x1f)); }
__device__ __forceinline__ float wave_sum(float v, int lane) {
#pragma unroll
    for (int o = 1; o < 64; o <<= 1) v += __builtin_bit_cast(float, __builtin_amdgcn_ds_bpermute((lane ^ o) << 2, __builtin_bit_cast(int, v)));
    return v;
}
__device__ __forceinline__ float rdlane(float v, int l) { return __builtin_bit_cast(float, __builtin_amdgcn_readlane(__builtin_bit_cast(int, v), l)); }
__device__ __forceinline__ int bperm(int srclane, int v) { return __builtin_amdgcn_ds_bpermute(srclane << 2, v); }
__constant__ double ROPE_INVF[8] = {1.0, 0.19392274474868576, 0.037606030930863933, 0.0072926647372171093, 0.0014142135623730950, 0.00027424817567620730, 5.3182958969449883e-05, 1.0313385377212460e-05};
#define XB_TMO      128
#define XB_XCNT(j)  (256  + 64 * (j))
#define XB_XSUB(j)  (1280 + 64 * (j))
#define XB_XGEN(j)  (2304 + 64 * (j))
#define XB_TOP      3328
#define XB_TOPGEN   3392
#define XCD_BAR_WORDS 3456
#define XB_SPIN_CAP (1u << 18)

__device__ __forceinline__ unsigned xb_ld(unsigned* p)              { return __hip_atomic_load(p, __ATOMIC_RELAXED, __HIP_MEMORY_SCOPE_AGENT); }
__device__ __forceinline__ unsigned xb_add(unsigned* p, unsigned v) { return __hip_atomic_fetch_add(p, v, __ATOMIC_RELAXED, __HIP_MEMORY_SCOPE_AGENT); }
__device__ __forceinline__ unsigned xb_xcc_id() { return (unsigned)__builtin_amdgcn_s_getreg((3 << 11) | 20) & 0xFu; }
#define XB_SPIN(cond, bar) do { unsigned _sp = 0; while (cond) { __builtin_amdgcn_s_sleep(1); \
    if ((++_sp & 255u) == 0u) { if (xb_ld(&(bar)[XB_TMO])) break; if (_sp > XB_SPIN_CAP) { atomicAdd(&(bar)[XB_TMO], 1u); break; } } } } while (0)

__device__ __forceinline__ bool xb_thread0_w(unsigned w, unsigned z) { return w == 0u && __builtin_amdgcn_mbcnt_hi(~0u, __builtin_amdgcn_mbcnt_lo(~0u, z)) == 0u; }
struct XcdBarrier {
    unsigned* bar; unsigned x; unsigned w, z;
    volatile LAS unsigned* st;
};

__device__ __forceinline__ XcdBarrier xcd_barrier_post(unsigned* bar, volatile LAS unsigned* st) {
    XcdBarrier b; b.bar = bar; b.x = xb_xcc_id(); b.st = st; b.w = (unsigned)__builtin_amdgcn_readfirstlane((int)(threadIdx.x >> 6)); b.z = 0u;
    if (xb_thread0_w(b.w, b.z)) (void)xb_add(&bar[XB_XCNT(b.x)], 1u);
    return b;
}
__device__ __forceinline__ void xcd_barrier_complete(unsigned* bar, unsigned x, unsigned& nloc, unsigned& nx) {
    const unsigned G = gridDim.x * gridDim.y * gridDim.z;
    unsigned sum, cnt, mine, sp = 0u;
    for (;;) {
        sum = 0u; cnt = 0u; mine = 0u;
#pragma unroll
        for (unsigned j = 0; j < 16; ++j) { const unsigned c = xb_ld(&bar[XB_XCNT(j)]); sum += c; cnt += (c > 0u) ? 1u : 0u; mine = (j == x) ? c : mine; }
        if (sum == G) break;
        __builtin_amdgcn_s_sleep(1);
        if ((++sp & 255u) == 0u) { if (xb_ld(&bar[XB_TMO])) break; if (sp > XB_SPIN_CAP) { atomicAdd(&bar[XB_TMO], 1u); break; } }
    }
    nloc = mine > 0u ? mine : 1u; nx = cnt > 0u ? cnt : 1u;
}

__device__ __forceinline__ void xcd_barrier(const XcdBarrier& b) {
    asm volatile("s_waitcnt vmcnt(0)" ::: "memory");
    __syncthreads();
    if (xb_thread0_w(b.w, b.z)) {
        unsigned* bar = b.bar;
        __builtin_amdgcn_s_waitcnt(0);
        unsigned nloc = b.st[0], nx = b.st[1];
        if (nloc == 0u) { xcd_barrier_complete(bar, b.x, nloc, nx); b.st[0] = nloc; b.st[1] = nx; }
        const unsigned old = xb_add(&bar[XB_XSUB(b.x)], 1u);
        const unsigned gen = old / nloc;
        if (old + 1u == (gen + 1u) * nloc) {
            __builtin_amdgcn_fence(__ATOMIC_RELEASE, "agent");
            asm volatile("s_waitcnt vmcnt(0)" ::: "memory");
            const unsigned og = xb_add(&bar[XB_TOP], 1u);
            const unsigned tg = og / nx;
            if (og + 1u == (tg + 1u) * nx) xb_add(&bar[XB_TOPGEN], 1u);
            else XB_SPIN(xb_ld(&bar[XB_TOPGEN]) == tg, bar);
            __builtin_amdgcn_fence(__ATOMIC_ACQUIRE, "agent");
            xb_add(&bar[XB_XGEN(b.x)], 1u);
            asm volatile("s_waitcnt vmcnt(0)" ::: "memory");
        } else {
            XB_SPIN(xb_ld(&bar[XB_XGEN(b.x)]) == gen, bar);
            __builtin_amdgcn_fence(__ATOMIC_ACQUIRE, "agent");
            asm volatile("s_waitcnt vmcnt(0)" ::: "memory");
        }
    }
    __syncthreads();
}

struct Frame {
    LAS unsigned char* lds;
    unsigned* ctl;
    int tid, lane, wave, vcu, G, bx, zv, zs, rep;
    unsigned char* ws;
    const float* const* in;
    float* out;
};
#define WSP(T, off) ((T*)(F.ws + (off)))
__device__ __forceinline__ size_t toff(int row, int k, int K) { return (size_t)(row >> 8) * 256 * K + (size_t)(k >> 6) * (256 * 64) + (size_t)(row & 255) * 64 + (k & 63); }

#ifndef TILED_FFN1
#define TILED_FFN1 0
#endif
#ifndef Q8_W1
#define Q8_W1 0.f
#define Q8_W2 0.f
#define Q8_HN 0.f
#define Q8_HID 0.f
#endif
__device__ __forceinline__ int map_row(int kind, int off, int n) { return kind == 0 ? n + off : (kind == 1 ? (n < 1932 ? n : n + 116) : ((n >> 7) * 256 + (n & 127) + off)); }
__device__ __forceinline__ void tr_item(const float* W, int ldw, int N, int ks, int n0, bf16* WT, int ldt, int kd, int kind, int off, LAS unsigned char* scr, int lane, float q8s = 0.f, int tiled = 0) {
    const int nq = (lane & 15) * 4, kq = lane >> 4;
    f32x4 x[16];
#pragma unroll
    for (int i = 0; i < 16; ++i) x[i] = (n0 + nq < N) ? *(const f32x4*)(W + (size_t)(ks + 4 * i + kq) * ldw + n0 + nq) : (f32x4){0.f, 0.f, 0.f, 0.f};
#pragma unroll
    for (int i = 0; i < 16; ++i) { const int k = 4 * i + kq;
#pragma unroll
        for (int c = 0; c < 4; ++c) { float wv = x[i][c]; if (q8s > 0.f) wv = q8r(wv, q8s); *(LAS bf16*)(scr + (nq + c) * 136 + k * 2) = (bf16)f2bf(wv); } }
    LDS_WAIT(); asm volatile("" ::: "memory");
    if (n0 + lane < N) { const LAS v2u* s = (const LAS v2u*)(scr + lane * 136); const int mr = map_row(kind, off, n0 + lane); bf16* dst = tiled ? WT + toff(mr, kd, ldt) : WT + (size_t)mr * ldt + kd;
#pragma unroll
        for (int q = 0; q < 8; ++q) { const v2u a = s[2 * q], b = s[2 * q + 1]; *(v4u*)(dst + 8 * q) = (v4u){a.x, a.y, b.x, b.y}; } }
    LDS_WAIT(); asm volatile("" ::: "memory");
}
__device__ __forceinline__ void conv(Frame& F, int& tb, const float* W, size_t sW, int nb, int ldw, int N, int ks0, int K, bf16* WT, size_t sWT, int ldt, int kd0, int kind, int off, float q8s = 0.f, int tiled = 0) {
    LAS unsigned char* scr = F.lds + RING_OFF + F.wave * 16384;
    const int gw = F.vcu * NWAVES + F.wave, NGW = F.G * NWAVES;
    const int nblk = (N + 63) / 64, per = (K / 64) * nblk, total = per * nb;
    int first = gw - tb; if (first < 0) first += NGW;
    for (int it = first; it < total; it += NGW) { const int b = it / per, r = it % per, kb = r / nblk, nbk = r % nblk;
        tr_item(W + (size_t)b * sW, ldw, N, ks0 + 64 * kb, 64 * nbk, WT + (size_t)b * sWT, ldt, kd0 + 64 * kb, kind, off, scr, F.lane, q8s, tiled); }
    tb = (tb + total) % NGW;
}
__device__ __forceinline__ void zero_block(Frame& F, bf16* WT, int ldt, int r0, int rows, int c0, int cols, int tiled = 0) {
    const int gt = (F.vcu * NWAVES + F.wave) * 64 + F.lane, NT = F.G * NWAVES * 64, cpr = cols / 8;
    for (int i = gt; i < rows * cpr; i += NT) { const int r = i / cpr, c = i % cpr; const unsigned z = (unsigned)F.zv; *(v4u*)(tiled ? WT + toff(r0 + r, c0 + 8 * c, ldt) : WT + (size_t)(r0 + r) * ldt + c0 + 8 * c) = (v4u){z, z, z, z}; }
}
__device__ __forceinline__ void p_convert(Frame& F, int layer) {
    const int j = layer >> 1; int tb = 0;
    conv(F, tb, F.in[2] + (size_t)layer * DM * CIN, 0, 1, CIN, CIN, 0, DM, WSP(bf16, WS_WIN), 0, DM, 0, 1, 0);
    zero_block(F, WSP(bf16, WS_WIN), DM, 1932, 116, 0, DM);
    conv(F, tb, F.in[9] + (size_t)layer * 3 * 256 * DM, (size_t)256 * DM, 3, DM, DM, 0, 256, WSP(bf16, WS_WBR), (size_t)DM * 256, 256, 0, 0, 0);
    conv(F, tb, F.in[10] + (size_t)layer * DM * DM, 0, 1, DM, DM, 0, DM, WSP(bf16, WS_WOUT), 0, DM, 0, 0, 0);
    conv(F, tb, F.in[7] + (size_t)layer * 2 * 2048 * 256, (size_t)2048 * 256, 2, 256, 256, 0, 1024, WSP(bf16, WS_WC1), (size_t)512 * 1024, 1024, 0, 0, 0);
    conv(F, tb, F.in[7] + (size_t)layer * 2 * 2048 * 256, (size_t)2048 * 256, 2, 256, 256, 1024, 1024, WSP(bf16, WS_WC1), (size_t)512 * 1024, 1024, 0, 0, 256);
    if ((layer & 1) == 0) {
        conv(F, tb, F.in[12] + (size_t)j * DM * DFF, 0, 1, DFF, DFF, 0, DM, WSP(bf16, WS_WF1), 0, DM, 0, 2, 0, Q8_W1, TILED_FFN1);
        conv(F, tb, F.in[13] + (size_t)j * DM * DFF, 0, 1, DFF, DFF, 0, DM, WSP(bf16, WS_WF1), 0, DM, 0, 2, 128, Q8_W1, TILED_FFN1);
        zero_block(F, WSP(bf16, WS_WF1), DM, 21 * 256 + 64, 64, 0, DM, TILED_FFN1);
        zero_block(F, WSP(bf16, WS_WF1), DM, 21 * 256 + 128 + 64, 64, 0, DM, TILED_FFN1);
        conv(F, tb, F.in[14] + (size_t)j * DFF * DM, 0, 1, DM, DM, 0, DFF, WSP(bf16, WS_WF2), 0, DFFP, 0, 0, 0, Q8_W2);
        zero_block(F, WSP(bf16, WS_WF2), DFFP, 0, DM, DFF, DFFP - DFF);
    } else {
        conv(F, tb, F.in[16] + (size_t)j * NEXP * DM * DFE, (size_t)DM * DFE, NEXP, DFE, DFE, 0, DM, WSP(bf16, WS_WF1), (size_t)NMOE1 * DM, DM, 0, 2, 0, Q8_W1);
        conv(F, tb, F.in[17] + (size_t)j * NEXP * DM * DFE, (size_t)DM * DFE, NEXP, DFE, DFE, 0, DM, WSP(bf16, WS_WF1), (size_t)NMOE1 * DM, DM, 0, 2, 128, Q8_W1);
        conv(F, tb, F.in[18] + (size_t)j * NEXP * DFE * DM, (size_t)DFE * DM, NEXP, DM, DM, 0, DFE, WSP(bf16, WS_WF2), (size_t)DM * DFE, DFE, 0, 0, 0, Q8_W2);
    }
    if (F.bx < 8) {
        __syncthreads();
        const int kv = F.bx >> 2, jj = (F.bx & 3) * 64 + F.lane;
        const float* pos = F.in[6] + (size_t)(layer * 2 + kv) * 2048; const float* w1 = F.in[7] + (size_t)(layer * 2 + kv) * 2048 * 256;
        float a = 0.f;
        float a1 = 0.f, a2 = 0.f, a3 = 0.f;
#pragma unroll 8
        for (int k = 0; k < 256; k += 4) { const int kk = F.wave * 256 + k;
            a += pos[kk] * w1[(size_t)kk * 256 + jj]; a1 += pos[kk + 1] * w1[(size_t)(kk + 1) * 256 + jj]; a2 += pos[kk + 2] * w1[(size_t)(kk + 2) * 256 + jj]; a3 += pos[kk + 3] * w1[(size_t)(kk + 3) * 256 + jj]; }
        a = (a + a1) + (a2 + a3);
        LAS float* red = (LAS float*)(F.lds + RING_OFF);
        red[F.wave * 64 + F.lane] = a;
        __syncthreads();
        if (F.wave == 0) { float s = 0.f;
#pragma unroll
            for (int w = 0; w < 8; ++w) s += red[w * 64 + F.lane];
            WSP(float, WS_BIAS1)[kv * 256 + jj] = s; }
        __syncthreads();
    }
    if (layer == 0) {
        const int gt = (F.vcu * NWAVES + F.wave) * 64 + F.lane, NT = F.G * NWAVES * 64;
        for (int idx = gt; idx < SEQ * 8; idx += NT) { const int pos = idx >> 3, i = idx & 7;
            const double invf = ROPE_INVF[i];
            double rev = (double)pos * invf * 0.15915494309189535; rev -= __builtin_floor(rev);
            WSP(float, WS_ROPE)[idx] = __builtin_amdgcn_cosf((float)rev); WSP(float, WS_ROPE)[SEQ * 8 + idx] = __builtin_amdgcn_sinf((float)rev); }
    }
}

template <bool S16> __device__ __forceinline__ f32x4 ld_row4(const void* src, size_t m, int lane, int jx) {
    if (S16) { const v2u t = ((const v2u*)((const bf16*)src + m * DM) + lane)[64 * jx]; return (f32x4){bflo(t.x), bfhi(t.x), bflo(t.y), bfhi(t.y)}; }
    return ((const f32x4*)((const float*)src + m * DM) + lane)[64 * jx];
}
template <int MODE, bool S16> __device__ __forceinline__ void p_norm(Frame& F, const void* src, const float* g, const float* rw, int jmoe, float q8s = 0.f, int tiled = 0) {
    const int gw = F.vcu * NWAVES + F.wave, NGW = F.G * NWAVES, lane = F.lane;
    LAS int* hist = (LAS int*)(F.lds + TAB_OFF) + 192;
    if (MODE == 1) {
        if (F.tid < 16) hist[F.tid] = 0;
        const int gt = gw * 64 + lane, NT = NGW * 64; int* tm = WSP(int, WS_TOKMAP);
        for (int i = gt; i < 4 * SLOTS; i += NT) tm[i] = -1;
        for (int i = F.tid; i < DM * NEXP / 4; i += NWAVES * 64) { const int c = i >> 1, hf = i & 1;
            *(LAS f32x4*)(F.lds + RING_OFF + (((((c >> 8) * 4 + (c & 3)) * 2 + hf) * 64 + ((c & 255) >> 2)) * 16)) = ((const f32x4*)rw)[i]; }
        if (F.tid < DM / 4) *(LAS f32x4*)(F.lds + RING_OFF + 32768 + 16 * F.tid) = ((const f32x4*)g)[F.tid];
        __syncthreads();
    }
    f32x4 gv[4];
    if (MODE != 1) {
#pragma unroll
        for (int jx = 0; jx < 4; ++jx) gv[jx] = ((const f32x4*)g)[lane + 64 * jx]; }
    constexpr int ROWS = (MODE == 1) ? 2 : 4;
    const int nit = (MODE == 1) ? ((MTOK / 128 - F.bx + F.G - 1) / F.G) * (16 / ROWS) : (MTOK - gw + ROWS * NGW - 1) / (ROWS * NGW);
    f32x4 nv[MODE == 1 ? ROWS : 1][4];
    for (int itx = 0; itx < nit; ++itx) {
        const int chk = (MODE == 1) ? F.bx + (itx / (16 / ROWS)) * F.G : 0;
        const int m0 = (MODE == 1) ? chk * 128 + (itx % (16 / ROWS)) * (NWAVES * ROWS) + F.wave * ROWS : gw + itx * ROWS * NGW;
        const int mstep = (MODE == 1) ? 1 : NGW;
        f32x4 v[ROWS][4]; float ss[ROWS];
        if (MODE == 1) {
            if (itx == 0) {
#pragma unroll
                for (int u = 0; u < ROWS; ++u) {
#pragma unroll
                    for (int jx = 0; jx < 4; ++jx) nv[u][jx] = ld_row4<S16>(src, (size_t)(m0 + u), lane, jx); } }
#pragma unroll
            for (int u = 0; u < ROWS; ++u)
#pragma unroll
                for (int jx = 0; jx < 4; ++jx) v[u][jx] = nv[u][jx];
            if (itx + 1 < nit) { const int itn = itx + 1; const int mn = (F.bx + (itn / (16 / ROWS)) * F.G) * 128 + (itn % (16 / ROWS)) * (NWAVES * ROWS) + F.wave * ROWS;
#pragma unroll
                for (int u = 0; u < ROWS; ++u) {
#pragma unroll
                    for (int jx = 0; jx < 4; ++jx) nv[u][jx] = ld_row4<S16>(src, (size_t)(mn + u), lane, jx); } }
        } else {
#pragma unroll
        for (int u = 0; u < ROWS; ++u) { const int m = m0 + u * mstep;
#pragma unroll
            for (int jx = 0; jx < 4; ++jx) v[u][jx] = ld_row4<S16>(src, (size_t)(m < MTOK ? m : m0), lane, jx); }
        }
#pragma unroll
        for (int u = 0; u < ROWS; ++u) { float s = 0.f;
#pragma unroll
            for (int jx = 0; jx < 4; ++jx) s += (v[u][jx].x * v[u][jx].x + v[u][jx].y * v[u][jx].y) + (v[u][jx].z * v[u][jx].z + v[u][jx].w * v[u][jx].w);
            ss[u] = s; }
#pragma unroll
        for (int o = 1; o < 64; o <<= 1) {
#pragma unroll
            for (int u = 0; u < ROWS; ++u) ss[u] += __builtin_bit_cast(float, __builtin_amdgcn_ds_bpermute((lane ^ o) << 2, __builtin_bit_cast(int, ss[u]))); }
        float lgall[MODE == 1 ? ROWS : 1][8];
        if (MODE == 1) {
            float rs[ROWS];
#pragma unroll
            for (int u = 0; u < ROWS; ++u) { rs[u] = 1.0f / sqrtf(ss[u] * (1.f / DM) + EPS);
#pragma unroll
                for (int e = 0; e < 8; ++e) lgall[u][e] = 0.f; }
#pragma unroll
            for (int jx = 0; jx < 4; ++jx) { const f32x4 gl = *(const LAS f32x4*)(F.lds + RING_OFF + 32768 + 16 * (lane + 64 * jx));
#pragma unroll
                for (int u = 0; u < ROWS; ++u) v[u][jx] = v[u][jx] * rs[u] * gl; }
#pragma unroll
            for (int jx = 0; jx < 4; ++jx) { const LAS f32x4* wr = (const LAS f32x4*)(F.lds + RING_OFF + jx * 8192 + lane * 16);
#pragma unroll
                for (int r = 0; r < 4; ++r) { const f32x4 a = wr[128 * r], b = wr[128 * r + 64];
#pragma unroll
                    for (int u = 0; u < ROWS; ++u) { const float xv = v[u][jx][r];
                        lgall[u][0] += xv * a.x; lgall[u][1] += xv * a.y; lgall[u][2] += xv * a.z; lgall[u][3] += xv * a.w; lgall[u][4] += xv * b.x; lgall[u][5] += xv * b.y; lgall[u][6] += xv * b.z; lgall[u][7] += xv * b.w; } } }
        }
#pragma unroll
        for (int u = 0; u < ROWS; ++u) { const int m = m0 + u * mstep; if (m >= MTOK) continue;
            const float rstd = 1.0f / sqrtf(ss[u] * (1.f / DM) + EPS);
            if (MODE != 1) {
#pragma unroll
            for (int jx = 0; jx < 4; ++jx) v[u][jx] = v[u][jx] * rstd * gv[jx]; }
            if (MODE == 2) {
                f32x4* o = (f32x4*)(F.out + (size_t)m * DM) + lane;
#pragma unroll
                for (int jx = 0; jx < 4; ++jx) o[64 * jx] = v[u][jx];
            } else {
                unsigned long long* o8 = (unsigned long long*)(WSP(bf16, WS_HN) + (size_t)m * DM) + lane;
#pragma unroll
                for (int jx = 0; jx < 4; ++jx) { f32x4 w = v[u][jx];
                    if (tiled) { *(unsigned long long*)(WSP(bf16, WS_HN) + toff(m, 4 * lane + 256 * jx, DM)) = (unsigned long long)pk2(w.x, w.y) | ((unsigned long long)pk2(w.z, w.w) << 32); continue; } if (q8s > 0.f) { w.x = q8r(w.x, q8s); w.y = q8r(w.y, q8s); w.z = q8r(w.z, q8s); w.w = q8r(w.w, q8s); }
                    o8[64 * jx] = (unsigned long long)pk2(w.x, w.y) | ((unsigned long long)pk2(w.z, w.w) << 32); }
            }
            if (MODE == 1) {
                float lg[8];
#pragma unroll
                for (int e = 0; e < 8; ++e) lg[e] = lgall[u][e];
                float h4[4], h2[2], h1;
                { const bool up = lane & 1;
#pragma unroll
                  for (int i = 0; i < 4; ++i) { const float keep = up ? lg[4 + i] : lg[i], send = up ? lg[i] : lg[4 + i]; h4[i] = keep + __builtin_bit_cast(float, bperm(lane ^ 1, __builtin_bit_cast(int, send))); } }
                { const bool up = lane & 2;
#pragma unroll
                  for (int i = 0; i < 2; ++i) { const float keep = up ? h4[2 + i] : h4[i], send = up ? h4[i] : h4[2 + i]; h2[i] = keep + __builtin_bit_cast(float, bperm(lane ^ 2, __builtin_bit_cast(int, send))); } }
                { const bool up = lane & 4; const float keep = up ? h2[1] : h2[0], send = up ? h2[0] : h2[1]; h1 = keep + __builtin_bit_cast(float, bperm(lane ^ 4, __builtin_bit_cast(int, send))); }
                h1 += __builtin_bit_cast(float, bperm(lane ^ 8, __builtin_bit_cast(int, h1))); h1 += __builtin_bit_cast(float, bperm(lane ^ 16, __builtin_bit_cast(int, h1))); h1 += __builtin_bit_cast(float, bperm(lane ^ 32, __builtin_bit_cast(int, h1)));
                lg[0] = rdlane(h1, 0); lg[1] = rdlane(h1, 4); lg[2] = rdlane(h1, 2); lg[3] = rdlane(h1, 6); lg[4] = rdlane(h1, 1); lg[5] = rdlane(h1, 5); lg[6] = rdlane(h1, 3); lg[7] = rdlane(h1, 7);
                int e0 = 0; float v0 = lg[0];
#pragma unroll
                for (int e = 1; e < 8; ++e) if (lg[e] > v0) { v0 = lg[e]; e0 = e; }
                int e1 = -1; float v1 = -INFINITY;
#pragma unroll
                for (int e = 0; e < 8; ++e) if (e != e0 && lg[e] > v1) { v1 = lg[e]; e1 = e; }
                const float w0 = 1.0f / (1.0f + fexp(v1 - v0)), w1 = 1.0f - w0;
                if (lane == 0) { WSP(v4i, WS_ROUTE)[m] = (v4i){e0, e1, __builtin_bit_cast(int, w0), __builtin_bit_cast(int, w1)};
                    __hip_atomic_fetch_add(&hist[e0], 1, __ATOMIC_RELAXED, __HIP_MEMORY_SCOPE_WORKGROUP); __hip_atomic_fetch_add(&hist[8 + e1], 1, __ATOMIC_RELAXED, __HIP_MEMORY_SCOPE_WORKGROUP); }
            }
        }
        if (MODE == 1 && (itx % (16 / ROWS)) == 16 / ROWS - 1) {
            __syncthreads();
            if (F.tid < 16) { WSP(int, WS_CNT128)[(size_t)chk * 16 + F.tid] = hist[F.tid]; hist[F.tid] = 0; }
            __syncthreads();
        }
    }
}

__device__ __forceinline__ void p_prep(Frame& F) {
    const int gw = F.vcu * NWAVES + F.wave, NGW = F.G * NWAVES, lane = F.lane;
    bf16* P1 = WSP(bf16, WS_P1); bf16* KVC = WSP(bf16, WS_KVC); const float* rope = WSP(float, WS_ROPE);
    const int vec = lane >> 3, ri = lane & 7; const int cb = vec < 4 ? C_CQ + vec * 64 : (vec == 4 ? C_KCMP : (vec == 5 ? C_KSLC : C_KWIN));
    for (int row0 = gw; row0 < MC; row0 += 4 * NGW) {
        float x1[4], x2[4], cc[4], ss[4]; bf16 kc48[4], vc64[4];
#pragma unroll
        for (int k = 0; k < 4; ++k) { const int row = row0 + k * NGW < MC ? row0 + k * NGW : row0; const bf16* p = P1 + (size_t)row * P1W; const int pos = row & (SEQ - 1);
            const int cl = lane < 56 ? cb + ri : C_CQ;
            x1[k] = bf1(p[cl]); x2[k] = bf1(p[cl + 8]); cc[k] = rope[pos * 8 + ri]; ss[k] = rope[SEQ * 8 + pos * 8 + ri];
            if (F.rep) { cc[k] = 1.f; ss[k] = 0.f; }
            kc48[k] = p[C_KCMP + 16 + (lane < 48 ? lane : 0)]; vc64[k] = p[C_VCMP + lane]; }
#pragma unroll
        for (int k = 0; k < 4; ++k) { const int row = row0 + k * NGW; if (row >= MC) continue; bf16* p = P1 + (size_t)row * P1W;
            if (lane < 56) { const bf16 o1 = (bf16)f2bf(x1[k] * cc[k] - x2[k] * ss[k]), o2 = (bf16)f2bf(x2[k] * cc[k] + x1[k] * ss[k]);
                p[cb + ri] = o1; p[cb + ri + 8] = o2;
                if (vec == 4) { KVC[(size_t)row * 64 + ri] = o1; KVC[(size_t)row * 64 + ri + 8] = o2; } }
            if (lane < 48) KVC[(size_t)row * 64 + 16 + lane] = kc48[k];
            KVC[(size_t)MC * 64 + (size_t)row * 64 + lane] = vc64[k]; }
    }
    bf16* VT = WSP(bf16, WS_VT);
    for (int it = gw; it < 6 * BC * 64; it += NGW) { const int which = it / (BC * 64), r = it % (BC * 64), b = r >> 6, blk = r & 63;
        const v4u* src = (const v4u*)(P1 + ((size_t)b * SEQ + blk * 64 + lane) * P1W + (which == 0 ? C_VSLC : (which == 1 ? C_VWIN : C_SBV + (which - 2) * 64)));
        bf16* dst = VT + ((size_t)(which * BC + b) * 64) * SEQ + blk * 64 + lane;
        v4u xs[8];
#pragma unroll
        for (int i = 0; i < 8; ++i) xs[i] = src[i];
#pragma unroll
        for (int i = 0; i < 8; ++i) { const v4u x = xs[i];
            dst[(size_t)(8 * i + 0) * SEQ] = (bf16)(x.x & 0xffffu); dst[(size_t)(8 * i + 1) * SEQ] = (bf16)(x.x >> 16);
            dst[(size_t)(8 * i + 2) * SEQ] = (bf16)(x.y & 0xffffu); dst[(size_t)(8 * i + 3) * SEQ] = (bf16)(x.y >> 16);
            dst[(size_t)(8 * i + 4) * SEQ] = (bf16)(x.z & 0xffffu); dst[(size_t)(8 * i + 5) * SEQ] = (bf16)(x.z >> 16);
            dst[(size_t)(8 * i + 6) * SEQ] = (bf16)(x.w & 0xffffu); dst[(size_t)(8 * i + 7) * SEQ] = (bf16)(x.w >> 16); }
    }
}
__device__ __forceinline__ void p_sgu(Frame& F, int layer) {
    LAS float* vn = (LAS float*)(F.lds + RING_OFF);
    const bf16* P1 = WSP(bf16, WS_P1); bf16* Ya = WSP(bf16, WS_Y);
    const float* gain = F.in[3] + (size_t)layer * 256; const float* sw = F.in[4] + (size_t)layer * 4 * 128 * 128; const float* sb = F.in[5] + (size_t)layer * 4 * 128;
    const int lane = F.lane, wave = F.wave;
    for (int item = F.vcu; item < MC / 128; item += F.G) {
        const size_t r0 = (size_t)item * 128;
        __syncthreads();
        for (int rr = 0; rr < 16; ++rr) { const int r = wave * 16 + rr; const v2u raw = *(const v2u*)(P1 + (r0 + r) * P1W + C_V + 4 * lane);
            const float a = bflo(raw.x), b = bfhi(raw.x), c = bflo(raw.y), d = bfhi(raw.y);
            const float rstd = 1.0f / sqrtf(wave_sum((a * a + b * b) + (c * c + d * d), lane) * (1.f / 256.f) + EPS);
            const f32x4 gg = ((const f32x4*)gain)[lane];
            *(LAS f32x4*)(vn + r * 256 + 4 * lane) = (f32x4){a * rstd * gg.x, b * rstd * gg.y, c * rstd * gg.z, d * rstd * gg.w}; }
        __syncthreads();
        const int g = wave & 3, half = wave >> 2;
        for (int i = 0; i < 64; ++i) { const int t = 2 * i + half;
            const float* wrow = sw + ((size_t)g * 128 + t) * 128;
            const float w_lo = wrow[lane], w_hi = wrow[64 + lane];
            float acc = 0.f;
            for (int s = 0; s <= t; ++s) { const float w = (s < 64) ? rdlane(w_lo, s) : rdlane(w_hi, s - 64); acc += w * vn[s * 256 + g * 64 + lane]; }
            const float u = bf1(P1[(r0 + t) * P1W + C_U + g * 64 + lane]);
#ifdef ABL_SGUMIX
            acc = 0.f;
#endif
            Ya[(r0 + t) * 256 + g * 64 + lane] = (bf16)f2bf(u * (acc + sb[g * 128 + t])); }
    }
    __syncthreads();
}

__device__ __forceinline__ void p_cmpfin(Frame& F, int layer) {
    const int gw = F.vcu * NWAVES + F.wave, NGW = F.G * NWAVES, lane = F.lane;
    const float* UL = WSP(float, WS_UL); const float* bias = WSP(float, WS_BIAS1); bf16* KC = WSP(bf16, WS_KC);
    LAS float* w2l = (LAS float*)(F.lds + RING_OFF);
    __syncthreads();
    { const f32x4* src = (const f32x4*)(F.in[8] + (size_t)layer * 2 * 256 * 64);
#pragma unroll 4
      for (int i = F.tid; i < 2 * 256 * 64 / 4; i += NWAVES * 64) *(LAS f32x4*)(w2l + 4 * i) = src[i]; }
    __syncthreads();
    for (int it = gw; it < 2 * BC * 255; it += NGW) { const int kv = it / (BC * 255), r = it % (BC * 255), b = r / 255, m = r % 255;
        const LAS float* w2 = w2l + kv * 256 * 64;
        const float* U = UL + (size_t)(kv * 2048 + b * 256 + m) * 512; const float* L = U + 512 + 256;
        float hv[4];
#pragma unroll
        for (int q = 0; q < 4; ++q) hv[q] = pg8::gelu_tanh(U[64 * q + lane] + L[64 * q + lane] + bias[kv * 256 + 64 * q + lane]);
        float acc0 = 0.f, acc1 = 0.f;
#pragma unroll
        for (int q = 0; q < 4; ++q)
#pragma unroll 8
            for (int jj = 0; jj < 64; jj += 2) { acc0 += rdlane(hv[q], jj) * w2[(64 * q + jj) * 64 + lane]; acc1 += rdlane(hv[q], jj + 1) * w2[(64 * q + jj + 1) * 64 + lane]; }
        const float acc = acc0 + acc1;
        KC[((size_t)(kv * BC + b) * 256 + m) * 64 + lane] = (bf16)f2bf(acc);
        if (kv == 1) { WSP(bf16, WS_KCT)[((size_t)b * 64 + lane) * 256 + m] = (bf16)f2bf(acc); if (m == 254) WSP(bf16, WS_KCT)[((size_t)b * 64 + lane) * 256 + 255] = (bf16)0; }
        else if (m == 254) KC[((size_t)b * 256 + 255) * 64 + lane] = (bf16)0; }
    __syncthreads();
}

__device__ __forceinline__ void p_stick(Frame& F) {
    const int gw = F.vcu * NWAVES + F.wave, NGW = F.G * NWAVES, lane = F.lane;
    const bf16* P1 = WSP(bf16, WS_P1); bf16* Yb = WSP(bf16, WS_Y) + (size_t)MC * 256;
    for (int item = gw; item < BC * 4 * 64; item += NGW) { const int tb = item & 63, h = (item >> 6) & 3, b = item >> 8;
        const int t = tb * 64 + lane; const size_t row = (size_t)b * SEQ + t;
        unsigned q[32];
        { const v4u* qp = (const v4u*)(P1 + row * P1W + C_SBQ + h * 64);
#pragma unroll
          for (int i = 0; i < 8; ++i) { const v4u x = qp[i]; q[4 * i] = x.x; q[4 * i + 1] = x.y; q[4 * i + 2] = x.z; q[4 * i + 3] = x.w; } }
        float o[64];
#pragma unroll
        for (int d = 0; d < 64; ++d) o[d] = 0.f;
        float R = 0.f;
        const bf16* kb = P1 + (size_t)b * SEQ * P1W + C_SBK + h * 64; const bf16* vb = P1 + (size_t)b * SEQ * P1W + C_SBV + h * 64;
        for (int s = t - 1; s >= 0; --s) {
            if (R < -100.f) break;
            const v4u* kp = (const v4u*)(kb + (size_t)s * P1W); const v4u* vp = (const v4u*)(vb + (size_t)s * P1W);
            float z0 = 0.f, z1 = 0.f;
#pragma unroll
            for (int i = 0; i < 8; ++i) { const v4u k = kp[i]; z0 = dot2bf(k.x, q[4 * i], z0); z1 = dot2bf(k.y, q[4 * i + 1], z1); z0 = dot2bf(k.z, q[4 * i + 2], z0); z1 = dot2bf(k.w, q[4 * i + 3], z1); }
            const float z = (z0 + z1) * 0.125f;
            const float tt = 0.6931471805599453f * __builtin_amdgcn_logf(1.0f + fexp(-__builtin_fabsf(z)));
            const float lb = fminf(z, 0.f) - tt, l1m = fminf(-z, 0.f) - tt;
            const float a = fexp(lb + R); R += l1m;
#pragma unroll
            for (int i = 0; i < 8; ++i) { const v4u v = vp[i];
                o[8 * i] += a * bflo(v.x); o[8 * i + 1] += a * bfhi(v.x); o[8 * i + 2] += a * bflo(v.y); o[8 * i + 3] += a * bfhi(v.y);
                o[8 * i + 4] += a * bflo(v.z); o[8 * i + 5] += a * bfhi(v.z); o[8 * i + 6] += a * bflo(v.w); o[8 * i + 7] += a * bfhi(v.w); }
        }
        v4u* op = (v4u*)(Yb + row * 256 + h * 64);
#pragma unroll
        for (int i = 0; i < 8; ++i) op[i] = (v4u){pk2(o[8 * i], o[8 * i + 1]), pk2(o[8 * i + 2], o[8 * i + 3]), pk2(o[8 * i + 4], o[8 * i + 5]), pk2(o[8 * i + 6], o[8 * i + 7])};
    }
}

struct Soft { float mx, l; };
__device__ __forceinline__ float dotq(const LAS v4u* ql, const bf16* kp_) {
    const v4u* kp = (const v4u*)kp_; float z0 = 0.f, z1 = 0.f;
#pragma unroll
    for (int i = 0; i < 8; ++i) { const v4u k = kp[i]; const v4u q = ql[i]; z0 = dot2bf(k.x, q.x, z0); z1 = dot2bf(k.y, q.y, z1); z0 = dot2bf(k.z, q.z, z0); z1 = dot2bf(k.w, q.w, z1); }
    return (z0 + z1) * 0.125f;
}
__device__ __forceinline__ void axpy_row(float p, const bf16* vp_, float (&o)[64]) {
    const v4u* vp = (const v4u*)vp_;
#pragma unroll
    for (int i = 0; i < 8; ++i) { const v4u v = vp[i];
        o[8 * i] += p * bflo(v.x); o[8 * i + 1] += p * bfhi(v.x); o[8 * i + 2] += p * bflo(v.y); o[8 * i + 3] += p * bfhi(v.y);
        o[8 * i + 4] += p * bflo(v.z); o[8 * i + 5] += p * bfhi(v.z); o[8 * i + 6] += p * bflo(v.w); o[8 * i + 7] += p * bfhi(v.w); }
}
__device__ __forceinline__ void nsa_step(const LAS v4u* ql, const bf16* kp_, const bf16* vp_, Soft& S, float (&o)[64]) {
    const float s = dotq(ql, kp_);
    if (s > S.mx) { const float sc = fexp(S.mx - s); S.l *= sc;
#pragma unroll
        for (int d = 0; d < 64; ++d) o[d] *= sc;
        S.mx = s; }
    const float p = fexp(s - S.mx); S.l += p;
    asm volatile("" ::: "memory");
    axpy_row(p, vp_, o);
}
__device__ __forceinline__ void nsa_accum(bf16* yrow, bool first, float sc, const float (&o)[64]) {
    v4u* op = (v4u*)yrow;
#pragma unroll
    for (int i = 0; i < 8; ++i) { v4u old = (v4u){0u, 0u, 0u, 0u}; if (!first) old = op[i];
        op[i] = (v4u){pk2(bflo(old.x) + sc * o[8 * i], bfhi(old.x) + sc * o[8 * i + 1]), pk2(bflo(old.y) + sc * o[8 * i + 2], bfhi(old.y) + sc * o[8 * i + 3]),
                      pk2(bflo(old.z) + sc * o[8 * i + 4], bfhi(old.z) + sc * o[8 * i + 5]), pk2(bflo(old.w) + sc * o[8 * i + 6], bfhi(old.w) + sc * o[8 * i + 7])}; }
}
__device__ __forceinline__ void p_nsa(Frame& F) {
    const int gw = F.vcu * NWAVES + F.wave, NGW = F.G * NWAVES, lane = F.lane;
    const bf16* P1 = WSP(bf16, WS_P1); const bf16* KC = WSP(bf16, WS_KC); bf16* Yc = WSP(bf16, WS_Y) + (size_t)2 * MC * 256;
    LAS float* imp = (LAS float*)(F.lds + RING_OFF + F.wave * 4096);
    LAS v4u* ql = (LAS v4u*)(F.lds + RING_OFF + 32768 + F.wave * 9216 + lane * 144);
    const int qi = lane >> 2, h = lane & 3;
    for (int item = gw; item < BC * 256; item += NGW) { const int b = item >> 8, tg = item & 255;
        const int t = tg * 16 + qi; const size_t row = (size_t)b * SEQ + t; const bf16* prow = P1 + row * P1W;
        { const v4u* qp = (const v4u*)(prow + C_CQ + h * 64);
#pragma unroll
          for (int i = 0; i < 8; ++i) ql[i] = qp[i]; }
        const float g0 = bf1(prow[C_CG + h * 3]), g1 = bf1(prow[C_CG + h * 3 + 1]), g2 = bf1(prow[C_CG + h * 3 + 2]);
        bf16* yrow = Yc + row * 256 + h * 64;
        float o[64];
        for (int i = lane; i < 1024; i += 64) imp[i] = 0.f;
        const int nv = t >= 31 ? ((t - 31) >> 4) + 1 : 0; const int nvmax = (tg * 16 + 15 >= 31) ? ((tg * 16 + 15 - 31) >> 4) + 1 : 0;
        const bf16* kc = KC + (size_t)(0 * BC + b) * 256 * 64; const bf16* vc = KC + (size_t)(1 * BC + b) * 256 * 64;
        { float mx = -INFINITY, l = 0.f;
          for (int m = 0; m < nvmax; ++m) { const float s = dotq(ql, kc + m * 64); if (m < nv) { if (s > mx) { l *= fexp(mx - s); mx = s; } l += fexp(s - mx); } }
          const float rl = l > 0.f ? 1.0f / l : 0.f;
#pragma unroll
          for (int d = 0; d < 64; ++d) o[d] = 0.f;
          for (int m = 0; m < nvmax; ++m) { const float s = dotq(ql, kc + m * 64); const float p = (m < nv) ? fexp(s - mx) * rl : 0.f;
              asm volatile("" ::: "memory");
              axpy_row(p, vc + m * 64, o);
              float P = p + __builtin_bit_cast(float, bperm(lane ^ 1, __builtin_bit_cast(int, p))); P += __builtin_bit_cast(float, bperm(lane ^ 2, __builtin_bit_cast(int, P)));
              if (h == 0) { const int j0 = m >> 2; const bool edge = (m & 3) == 3; imp[qi * 64 + j0] += edge ? 0.5f * P : P; if (edge) imp[qi * 64 + j0 + 1] += 0.5f * P; } }
          nsa_accum(yrow, true, g0, o); }
        unsigned long long mask = 0ull;
        { const int cur = t >> 6, nvb = cur + 1;
          if (h == 0) {
              if (nvb <= 16) mask = (1ull << nvb) - 1ull;
              else { mask = 1ull | (1ull << cur);
                  for (int r = 0; r < 14; ++r) { int best = -1; float bv = -1.f;
                      for (int j = 1; j < cur; ++j) { const float v = imp[qi * 64 + j]; if (!((mask >> j) & 1ull) && v > bv) { bv = v; best = j; } }
                      mask |= 1ull << best; } } }
          const unsigned mlo = (unsigned)bperm(lane & ~3, (int)(unsigned)mask), mhi = (unsigned)bperm(lane & ~3, (int)(unsigned)(mask >> 32));
          mask = ((unsigned long long)mhi << 32) | mlo; }
        { Soft S{-INFINITY, 0.f};
#pragma unroll
          for (int d = 0; d < 64; ++d) o[d] = 0.f;
          const bf16* kb = P1 + (size_t)b * SEQ * P1W + C_KSLC; const bf16* vb = P1 + (size_t)b * SEQ * P1W + C_VSLC;
          unsigned long long mm = mask;
          while (mm) { const int j = __builtin_ctzll(mm); mm &= mm - 1ull;
              for (int kk = 0; kk < 64; ++kk) { const int sp = j * 64 + kk; if (sp > t) break; nsa_step(ql, kb + (size_t)sp * P1W, vb + (size_t)sp * P1W, S, o); } }
          nsa_accum(yrow, false, g1 / S.l, o); }
        { Soft S{-INFINITY, 0.f};
#pragma unroll
          for (int d = 0; d < 64; ++d) o[d] = 0.f;
          const bf16* kb = P1 + (size_t)b * SEQ * P1W + C_KWIN; const bf16* vb = P1 + (size_t)b * SEQ * P1W + C_VWIN;
          for (int i = 0; i < 512; ++i) { const int sp = t - 511 + i; if (sp >= 0) nsa_step(ql, kb + (size_t)sp * P1W, vb + (size_t)sp * P1W, S, o); }
          nsa_accum(yrow, false, g2 / S.l, o); }
    }
}

__device__ __forceinline__ int moe_table(Frame& F, int jmoe, int c, int r, int kpre = 0) {
    LAS int* tab = (LAS int*)(F.lds + TAB_OFF); LAS int* arr = (LAS int*)(F.lds + LDSCTL_OFF + 4096);
    (void)jmoe;
    __syncthreads();
    if (F.tid < 256) { const v4i* s = (const v4i*)(WSP(int, WS_CNT128) + ((size_t)(c * 256 + F.tid) * 2 + r) * 8); const v4i a = s[0], b = s[1];
        *(LAS v4i*)(arr + F.tid * 8) = a; *(LAS v4i*)(arr + F.tid * 8 + 4) = b; }
    __syncthreads();
    if (F.tid < 8) { int tot = 0, pre = 0;
        for (int k = 0; k < 256; ++k) { const int x = arr[k * 8 + F.tid]; pre += (k < kpre) ? x : 0; tot += x; }
        tab[176 + F.tid] = tot; tab[184 + F.tid] = pre; }
    __syncthreads();
    if (F.tid == 0) { int base = 0, T = 0;
        for (int e = 0; e < 8; ++e) { const int cnt = tab[176 + e];
            const int nt = (cnt + 255) >> 8; tab[160 + e] = base; for (int i = 0; i < nt && T + i < 160; ++i) tab[T + i] = e; T += nt; base += nt * 256; }
        tab[168] = T < 136 ? T : 136; }
    __syncthreads();
    return tab[168];
}
__device__ __forceinline__ void p_gather(Frame& F, int jmoe, int c, int r, int nbusy = 0) {
    if (F.bx < nbusy) return;
    LAS int* tab = (LAS int*)(F.lds + TAB_OFF); LAS int* cntw = tab + 256; LAS int* basew = tab + 320;
    const int lane = F.lane, wave = F.wave;
    const v4i* route = WSP(v4i, WS_ROUTE); int* tokmap = WSP(int, WS_TOKMAP) + (c * 2 + r) * SLOTS; float* wslot = WSP(float, WS_WSLOT) + (c * 2 + r) * SLOTS;
    const bf16* HN = WSP(bf16, WS_HN); bf16* XG = WSP(bf16, WS_XG);
    for (int ch = F.bx - nbusy; ch < MC / 128; ch += F.G - nbusy) {
        moe_table(F, jmoe, c, r, ch);
        const int m = c * MC + ch * 128 + wave * 16 + (lane & 15); const v4i rt = route[m];
        const int e = lane < 16 ? (r ? rt.y : rt.x) : -1; const float w = __builtin_bit_cast(float, r ? rt.w : rt.z);
        unsigned long long bal[8]; int mycnt = 0;
#pragma unroll
        for (int ee = 0; ee < 8; ++ee) { bal[ee] = __builtin_amdgcn_ballot_w64(e == ee); if (lane == ee) mycnt = __builtin_popcountll(bal[ee]); }
        if (lane < 8) cntw[wave * 8 + lane] = mycnt;
        __syncthreads();
        if (wave == 0 && lane < 8) { int base = tab[184 + lane];
#pragma unroll
            for (int w8 = 0; w8 < 8; ++w8) { basew[w8 * 8 + lane] = base; base += cntw[w8 * 8 + lane]; } }
        __syncthreads();
        int pos = 0;
#pragma unroll
        for (int ee = 0; ee < 8; ++ee) if (e == ee) pos = basew[wave * 8 + ee] + __builtin_popcountll(bal[ee] & ((1ull << lane) - 1ull));
        int slot = 0;
        if (lane < 16) { slot = tab[160 + e] + pos; tokmap[slot] = m; wslot[slot] = w; }
#pragma unroll
        for (int i0 = 0; i0 < 16; i0 += 4) { v4u x[8];
#pragma unroll
            for (int i = 0; i < 4; ++i) { const int mi = __builtin_amdgcn_readlane(m, i0 + i); const v4u* src = (const v4u*)(HN + (size_t)mi * DM); x[2 * i] = src[lane]; x[2 * i + 1] = src[64 + lane]; }
#pragma unroll
            for (int i = 0; i < 4; ++i) { const int si = __builtin_amdgcn_readlane(slot, i0 + i); v4u* dst = (v4u*)(XG + (size_t)si * DM); dst[lane] = x[2 * i]; dst[64 + lane] = x[2 * i + 1]; } }
    }
}

typedef float f32x16 __attribute__((ext_vector_type(16)));
typedef short bf16x8v __attribute__((ext_vector_type(8)));
typedef float f32x2v __attribute__((ext_vector_type(2)));
constexpr int NSA_K = 0, NSA_V = 8192, NSA_BUF = 17408, NSA_STAGE = 2 * NSA_BUF, NSA_IMP = 69632, NSA_CARRY = 86016, NSA_SEL = 103424, NSA_WSF = 103936;
constexpr int NSA_VP = 136;
constexpr float NSA_C2 = 0.125f * 1.4426950408889634f;
constexpr float NSA_DEFER = 8.0f / (0.125f * 1.4426950408889634f);
__device__ __forceinline__ unsigned cvtpk(float lo, float hi) { f32x2v v = {lo, hi}; bf16x2_t b = __builtin_convertvector(v, bf16x2_t); return __builtin_bit_cast(unsigned, b); }
__device__ __forceinline__ float partner32(float v, int lane) { return __builtin_bit_cast(float, __builtin_amdgcn_ds_bpermute((lane ^ 32) << 2, __builtin_bit_cast(int, v))); }
__device__ __forceinline__ void nsa_load(v4u& kx, v4u& vx, const bf16* Kg, int kp, const bf16* Vg, int vp, int tid) {
    kx = *(const v4u*)(Kg + (size_t)(tid & 63) * kp + (tid >> 6) * 8); vx = *(const v4u*)(Vg + (size_t)(tid >> 3) * vp + (tid & 7) * 8);
}
__device__ __forceinline__ void nsa_store(LAS unsigned char* lds, const v4u& kx, const v4u& vx, int tid) {
    *(LAS v4u*)(lds + NSA_K + (tid >> 6) * 1024 + (tid & 63) * 16) = kx; { LAS v2u* vd = (LAS v2u*)(lds + NSA_V + (tid >> 3) * NSA_VP + (tid & 7) * 16); vd[0] = (v2u){vx.x, vx.y}; vd[1] = (v2u){vx.z, vx.w}; }
}
__device__ __forceinline__ void nsa_qk(const LAS unsigned char* lds, const bf16x8v (&qr)[4], f32x16& p0, f32x16& p1, int r32, int hi) {
    bf16x8v kf[8];
#pragma unroll
    for (int d0 = 0; d0 < 4; ++d0) {
        kf[2 * d0] = *(const LAS bf16x8v*)(lds + NSA_K + (2 * d0 + hi) * 1024 + r32 * 16);
        kf[2 * d0 + 1] = *(const LAS bf16x8v*)(lds + NSA_K + (2 * d0 + hi) * 1024 + 512 + r32 * 16); }
    __builtin_amdgcn_sched_barrier(0);
#pragma unroll
    for (int i = 0; i < 16; ++i) { p0[i] = 0.f; p1[i] = 0.f; }
#pragma unroll
    for (int d0 = 0; d0 < 4; ++d0) {
        p0 = __builtin_amdgcn_mfma_f32_32x32x16_bf16(kf[2 * d0], qr[d0], p0, 0, 0, 0);
        p1 = __builtin_amdgcn_mfma_f32_32x32x16_bf16(kf[2 * d0 + 1], qr[d0], p1, 0, 0, 0);
    }
}
__device__ __forceinline__ void nsa_mask(f32x16& p0, f32x16& p1, int hi, int hiL, int loL) {
    const int hl = hiL - 4 * hi, ll = loL - 4 * hi;
#pragma unroll
    for (int i = 0; i < 16; ++i) { const int c = (i & 3) + 8 * (i >> 2);
        if (!(c <= hl && c > ll)) p0[i] = -INFINITY;
        if (!(c + 32 <= hl && c + 32 > ll)) p1[i] = -INFINITY; }
}
__device__ __forceinline__ float nsa_max32(const f32x16& p0, const f32x16& p1) {
    float a = fmaxf(fmaxf(p0[0], p0[1]), p1[0]), b = fmaxf(fmaxf(p0[2], p0[3]), p1[1]); a = fmaxf(fmaxf(a, p1[2]), p1[3]);
#pragma unroll
    for (int i = 4; i < 16; i += 4) { a = fmaxf(fmaxf(a, p0[i]), p0[i + 1]); b = fmaxf(fmaxf(b, p0[i + 2]), p0[i + 3]); a = fmaxf(fmaxf(a, p1[i]), p1[i + 1]); b = fmaxf(fmaxf(b, p1[i + 2]), p1[i + 3]); }
    return fmaxf(a, b);
}
__device__ __forceinline__ void nsa_vload(const LAS unsigned char* lds, v4u (&vv)[8], int r32, int hi) {
#pragma unroll
    for (int db = 0; db < 2; ++db) { const LAS unsigned char* vrow = lds + NSA_V + (32 * db + r32) * NSA_VP;
#pragma unroll
        for (int ks = 0; ks < 4; ++ks) {
            const int kb = (ks >> 1) * 32 + (ks & 1) * 16 + 4 * hi;
            const v2u lo = *(const LAS v2u*)(vrow + kb * 2), hh = *(const LAS v2u*)(vrow + (kb + 8) * 2);
            vv[4 * db + ks] = (v4u){lo.x, lo.y, hh.x, hh.y}; } }
    __builtin_amdgcn_sched_barrier(0);
}
__device__ __forceinline__ void nsa_pv(const v4u (&vv)[8], const f32x16& p0, const f32x16& p1, f32x16 (&o)[2]) {
    bf16x8v pa[4];
#pragma unroll
    for (int s = 0; s < 2; ++s) {
        const v4u a = (v4u){cvtpk(p0[8 * s], p0[8 * s + 1]), cvtpk(p0[8 * s + 2], p0[8 * s + 3]), cvtpk(p0[8 * s + 4], p0[8 * s + 5]), cvtpk(p0[8 * s + 6], p0[8 * s + 7])};
        const v4u b = (v4u){cvtpk(p1[8 * s], p1[8 * s + 1]), cvtpk(p1[8 * s + 2], p1[8 * s + 3]), cvtpk(p1[8 * s + 4], p1[8 * s + 5]), cvtpk(p1[8 * s + 6], p1[8 * s + 7])};
        pa[s] = __builtin_bit_cast(bf16x8v, a); pa[2 + s] = __builtin_bit_cast(bf16x8v, b); }
#pragma unroll
    for (int ks = 0; ks < 4; ++ks)
#pragma unroll
        for (int db = 0; db < 2; ++db) o[db] = __builtin_amdgcn_mfma_f32_32x32x16_bf16(pa[ks], __builtin_bit_cast(bf16x8v, vv[4 * db + ks]), o[db], 0, 0, 0);
}
__device__ __forceinline__ void nsa_rowscale(f32x16 (&o)[2], LAS float* wsf, float f, int r32, int hi) {
    if (hi == 0) wsf[r32] = f;
#pragma unroll
    for (int g = 0; g < 4; ++g) { const f32x4 w = *(const LAS f32x4*)(wsf + 8 * g + 4 * hi);
#pragma unroll
        for (int e = 0; e < 4; ++e) { o[0][4 * g + e] *= w[e]; o[1][4 * g + e] *= w[e]; } }
}
constexpr int NSA_ACC = 104960;
__device__ __forceinline__ void nsa_rowaccum(LAS unsigned char* acc, bool first, const f32x16 (&o)[2], LAS float* wsf, float f, int r32, int hi) {
    if (hi == 0) wsf[r32] = f;
#pragma unroll
    for (int g = 0; g < 4; ++g) { const f32x4 w = *(const LAS f32x4*)(wsf + 8 * g + 4 * hi);
#pragma unroll
        for (int e = 0; e < 4; ++e) { LAS bf16* p = (LAS bf16*)(acc + (8 * g + 4 * hi + e) * 128 + r32 * 2); const int i = 4 * g + e;
            float a = o[0][i] * w[e], b = o[1][i] * w[e];
            if (!first) { a += bf1(p[0]); b += bf1(p[32]); }
            p[0] = (bf16)f2bf(a); p[32] = (bf16)f2bf(b); } }
}
__device__ __forceinline__ void nsa_flush(const LAS unsigned char* acc, bf16* ytok  , int lane) {
    asm volatile("" ::: "memory");
#pragma unroll
    for (int ps = 0; ps < 4; ++ps) { const int row = ps * 8 + (lane >> 3), ch = lane & 7;
        const v4u v = *(const LAS v4u*)(acc + row * 128 + ch * 16);
        *(v4u*)(ytok + (size_t)(row >> 2) * 256 + (row & 3) * 64 + ch * 8) = v; }
}
__device__ __forceinline__ void nsa_softmax_pv(const LAS unsigned char* lds, f32x16& p0, f32x16& p1, float& m, float& l, f32x16 (&o)[2], LAS float* wsf, int lane, int r32, int hi, bool rowok) {
    float mt = nsa_max32(p0, p1); mt = rowok ? mt : -INFINITY; mt = fmaxf(mt, partner32(mt, lane));
    const float mn = fmaxf(m, mt);
    if (__builtin_amdgcn_ballot_w64(mn > m + NSA_DEFER) != 0ull) { const float f = __builtin_amdgcn_exp2f((m - mn) * NSA_C2); l *= f; nsa_rowscale(o, wsf, f, r32, hi); m = mn; }
    const float off = rowok ? -m * NSA_C2 : -INFINITY;
    v4u vv[8]; nsa_vload(lds, vv, r32, hi);
    float s = 0.f;
#pragma unroll
    for (int i = 0; i < 16; ++i) { p0[i] = __builtin_amdgcn_exp2f(__builtin_fmaf(p0[i], NSA_C2, off)); p1[i] = __builtin_amdgcn_exp2f(__builtin_fmaf(p1[i], NSA_C2, off)); s += p0[i] + p1[i]; }
    l += s;
    nsa_pv(vv, p0, p1, o);
}
__device__ __forceinline__ void p_nsa2(Frame& F) {
    const int tid = F.tid, lane = F.lane, wave = F.wave, r32 = lane & 31, hi = lane >> 5;
    LAS unsigned char* lds = F.lds + RING_OFF;
    LAS float* imp = (LAS float*)(lds + NSA_IMP); LAS float* carry = (LAS float*)(lds + NSA_CARRY);
    LAS unsigned long long* selm = (LAS unsigned long long*)(lds + NSA_SEL); LAS float* wsf = (LAS float*)(lds + NSA_WSF) + wave * 32;
    LAS unsigned char* acc = wave < 6 ? lds + NSA_ACC + wave * 4096 : F.lds + LDSCTL_OFF + 4096 + (wave - 6) * 4096;
    const bf16* P1 = WSP(bf16, WS_P1); const bf16* KC = WSP(bf16, WS_KC); const bf16* KCT = WSP(bf16, WS_KCT); const bf16* VT = WSP(bf16, WS_VT);
    bf16* Yc = WSP(bf16, WS_Y) + (size_t)2 * MC * 256;
    const int ql = r32 >> 2, h = r32 & 3, tq = 8 * wave + ql;
    int par = 0;
    for (int it = 0; it < 2; ++it) {
        for (int pair = F.vcu; pair < BC * 32; pair += F.G) {
            const int b = pair >> 5, sx = pair & 31, qb = it ? 63 - sx : sx;
            const int t = qb * 64 + tq; const size_t row = (size_t)b * SEQ + t; const bf16* prow = P1 + row * P1W;
            bf16x8v qr[4];
#pragma unroll
            for (int d0 = 0; d0 < 4; ++d0) qr[d0] = *(const bf16x8v*)(prow + C_CQ + h * 64 + d0 * 16 + hi * 8);
            const float g0 = bf1(prow[C_CG + h * 3]), g1 = bf1(prow[C_CG + h * 3 + 1]), g2 = bf1(prow[C_CG + h * 3 + 2]);
            f32x16 o[2], p0, p1;
            __syncthreads();
            for (int i = tid; i < 64 * 64; i += 512) imp[i] = 0.f;
            for (int i = tid; i < 64 * 68; i += 512) carry[i] = 0.f;
            const int nct = (4 * qb + 3 + 63) >> 6;
            const int mlim = t >= 31 ? ((t - 31) >> 4) : -1;
            const bf16* kcb = KC + (size_t)b * 256 * 64; const bf16* vcb = KCT + (size_t)b * 64 * 256;
            float m = -1e30f, l = 0.f;
            v4u kx, vx;
            nsa_load(kx, vx, kcb, 64, vcb, 256, tid);
            for (int ti = 0; ti < nct; ++ti) {
                LAS unsigned char* tb = lds + par * NSA_STAGE; par ^= 1;
                nsa_store(tb, kx, vx, tid); __syncthreads();
                { const int tn = ti + 1 < nct ? ti + 1 : 0; nsa_load(kx, vx, kcb + (size_t)tn * 64 * 64, 64, vcb + tn * 64, 256, tid); }
                nsa_qk(tb, qr, p0, p1, r32, hi); nsa_mask(p0, p1, hi, mlim - 64 * ti, -1);
                float mt = nsa_max32(p0, p1); mt = fmaxf(mt, partner32(mt, lane));
                const float mn = fmaxf(m, mt); l *= __builtin_amdgcn_exp2f((m - mn) * NSA_C2); m = mn;
                const float off = -m * NSA_C2; float s = 0.f;
#pragma unroll
                for (int i = 0; i < 16; ++i) s += __builtin_amdgcn_exp2f(__builtin_fmaf(p0[i], NSA_C2, off)) + __builtin_amdgcn_exp2f(__builtin_fmaf(p1[i], NSA_C2, off));
                l += s; }
            { const float lt = l + partner32(l, lane); const float rl = lt > 0.f ? 1.0f / lt : 0.f;
#pragma unroll
              for (int i = 0; i < 16; ++i) { o[0][i] = 0.f; o[1][i] = 0.f; }
              for (int ti = 0; ti < nct; ++ti) {
                  LAS unsigned char* tb = lds + par * NSA_STAGE; par ^= 1;
                  nsa_store(tb, kx, vx, tid); __syncthreads();
                  if (ti + 1 < nct) nsa_load(kx, vx, kcb + (size_t)(ti + 1) * 64 * 64, 64, vcb + (ti + 1) * 64, 256, tid);
                  nsa_qk(tb, qr, p0, p1, r32, hi); nsa_mask(p0, p1, hi, mlim - 64 * ti, -1);
                  v4u vv[8]; nsa_vload(tb, vv, r32, hi);
                  { const float off = -m * NSA_C2;
#pragma unroll
                    for (int i = 0; i < 16; ++i) { p0[i] = __builtin_amdgcn_exp2f(__builtin_fmaf(p0[i], NSA_C2, off)) * rl; p1[i] = __builtin_amdgcn_exp2f(__builtin_fmaf(p1[i], NSA_C2, off)) * rl; } }
#pragma unroll
                  for (int kt = 0; kt < 2; ++kt)
#pragma unroll
                      for (int g = 0; g < 4; ++g) { const f32x16& pp = kt ? p1 : p0;
                          float A = pp[4 * g] + pp[4 * g + 1] + pp[4 * g + 2] + 0.5f * pp[4 * g + 3], B = 0.5f * pp[4 * g + 3];
                          A += __builtin_bit_cast(float, bperm(lane ^ 1, __builtin_bit_cast(int, A))); A += __builtin_bit_cast(float, bperm(lane ^ 2, __builtin_bit_cast(int, A)));
                          B += __builtin_bit_cast(float, bperm(lane ^ 1, __builtin_bit_cast(int, B))); B += __builtin_bit_cast(float, bperm(lane ^ 2, __builtin_bit_cast(int, B)));
                          if (h == 0) { const int j = 16 * ti + 8 * kt + 2 * g + hi; imp[tq * 64 + j] = A; carry[tq * 68 + j + 1] = B; } }
                  nsa_pv(vv, p0, p1, o); }
              nsa_rowaccum(acc, true, o, wsf, g0, r32, hi); }
            __syncthreads();
            { const int q = tid >> 3, sub = tid & 7; unsigned long long mask;
              if (qb + 1 <= 16) mask = (1ull << (qb + 1)) - 1ull;
              else { mask = 1ull | (1ull << qb);
                  unsigned long long key[8];
#pragma unroll
                  for (int i = 0; i < 8; ++i) { const int j = sub * 8 + i; const float v = imp[q * 64 + j] + carry[q * 68 + j];
                      key[i] = (j >= 1 && j < qb) ? (((unsigned long long)__builtin_bit_cast(unsigned, v) << 32) | (unsigned)(63 - j)) : 0ull; }
                  for (int r = 0; r < 14; ++r) { unsigned long long best = key[0];
#pragma unroll
                      for (int i = 1; i < 8; ++i) best = key[i] > best ? key[i] : best;
#pragma unroll
                      for (int x = 1; x < 8; x <<= 1) { const unsigned lo = (unsigned)bperm(lane ^ x, (int)(unsigned)best), hh = (unsigned)bperm(lane ^ x, (int)(unsigned)(best >> 32));
                          const unsigned long long other = ((unsigned long long)hh << 32) | lo; best = other > best ? other : best; }
                      const int jb = 63 - (int)(best & 63ull); mask |= 1ull << jb;
#pragma unroll
                      for (int i = 0; i < 8; ++i) if (sub * 8 + i == jb) key[i] = 0ull; } }
              if (sub == 0) selm[q] = mask; }
            __syncthreads();
            const unsigned long long mysel = selm[tq];
#ifdef NSA_REP_SLC
            int nrep_slc; asm volatile("s_mov_b32 %0, %1" : "=s"(nrep_slc) : "i"(NSA_REP_SLC));
            for (int rep_ = 0; rep_ < nrep_slc; ++rep_)
#endif
            { const bf16* kb = P1 + (size_t)b * SEQ * P1W + C_KSLC; const bf16* vb = VT + (size_t)(0 * BC + b) * 64 * SEQ;
#ifdef NSA_REP_SLC
              if (rep_ + 1 < nrep_slc) __syncthreads();
#endif
              m = -1e30f; l = 0.f;
#pragma unroll
              for (int i = 0; i < 16; ++i) { o[0][i] = 0.f; o[1][i] = 0.f; }
              v4u kx2, vx2;
              nsa_load(kx, vx, kb, P1W, vb, SEQ, tid); if (qb >= 1) nsa_load(kx2, vx2, kb + (size_t)64 * P1W, P1W, vb + 64, SEQ, tid);
              for (int j = 0; j <= qb; j += 2) {
                  const bool two = j + 1 <= qb;
                  LAS unsigned char* tb = lds + par * NSA_STAGE; par ^= 1;
                  nsa_store(tb, kx, vx, tid); if (two) nsa_store(tb + NSA_BUF, kx2, vx2, tid);
                  __syncthreads();
                  if (j + 2 <= qb) nsa_load(kx, vx, kb + (size_t)(j + 2) * 64 * P1W, P1W, vb + (j + 2) * 64, SEQ, tid);
                  if (j + 3 <= qb) nsa_load(kx2, vx2, kb + (size_t)(j + 3) * 64 * P1W, P1W, vb + (j + 3) * 64, SEQ, tid);
                  { const bool rowsel = ((mysel >> j) & 1ull) != 0ull;
                    if (__builtin_amdgcn_ballot_w64(rowsel) != 0ull) {
                        nsa_qk(tb, qr, p0, p1, r32, hi); if (j == qb) nsa_mask(p0, p1, hi, tq, -1);
                        nsa_softmax_pv(tb, p0, p1, m, l, o, wsf, lane, r32, hi, rowsel); } }
                  if (two) { const bool rowsel = ((mysel >> (j + 1)) & 1ull) != 0ull;
                    if (__builtin_amdgcn_ballot_w64(rowsel) != 0ull) {
                        nsa_qk(tb + NSA_BUF, qr, p0, p1, r32, hi); if (j + 1 == qb) nsa_mask(p0, p1, hi, tq, -1);
                        nsa_softmax_pv(tb + NSA_BUF, p0, p1, m, l, o, wsf, lane, r32, hi, rowsel); } } }
              const float lt = l + partner32(l, lane);
#ifdef NSA_REP_SLC
              if (rep_ + 1 == nrep_slc)
#endif
              nsa_rowaccum(acc, false, o, wsf, lt > 0.f ? g1 / lt : 0.f, r32, hi); }
#ifdef NSA_REP_WIN
            int nrep_win; asm volatile("s_mov_b32 %0, %1" : "=s"(nrep_win) : "i"(NSA_REP_WIN));
            for (int rep_ = 0; rep_ < nrep_win; ++rep_)
#endif
            { const bf16* kb = P1 + (size_t)b * SEQ * P1W + C_KWIN; const bf16* vb = VT + (size_t)(1 * BC + b) * 64 * SEQ;
              m = -1e30f; l = 0.f;
#pragma unroll
              for (int i = 0; i < 16; ++i) { o[0][i] = 0.f; o[1][i] = 0.f; }
              const int j0 = qb >= 8 ? qb - 8 : 0;
              nsa_load(kx, vx, kb + (size_t)j0 * 64 * P1W, P1W, vb + j0 * 64, SEQ, tid);
              for (int j = j0; j <= qb; ++j) {
                  LAS unsigned char* tb = lds + par * NSA_STAGE; par ^= 1;
                  nsa_store(tb, kx, vx, tid); __syncthreads();
                  if (j < qb) nsa_load(kx, vx, kb + (size_t)(j + 1) * 64 * P1W, P1W, vb + (j + 1) * 64, SEQ, tid);
                  nsa_qk(tb, qr, p0, p1, r32, hi); if (j == qb || j == qb - 8) nsa_mask(p0, p1, hi, j == qb ? tq : 63, j == qb - 8 ? tq : -1);
                  nsa_softmax_pv(tb, p0, p1, m, l, o, wsf, lane, r32, hi, true); }
              const float lt = l + partner32(l, lane);
#ifdef NSA_REP_WIN
              if (rep_ + 1 == nrep_win) {
#endif
              nsa_rowaccum(acc, false, o, wsf, lt > 0.f ? g2 / lt : 0.f, r32, hi);
              nsa_flush(acc, Yc + ((size_t)b * SEQ + qb * 64 + 8 * wave) * 256, lane);
#ifdef NSA_REP_WIN
              }
#endif
            }
        }
    }
    __syncthreads();
}

constexpr int SB_HEAD_LDS = 17408;
constexpr int SB_FLAG = 4 * SB_HEAD_LDS;
constexpr float SB_LOG2E = 1.4426950408889634f, SB_STOP = -100.0f * 1.4426950408889634f;
__device__ __forceinline__ void p_stick2(Frame& F, int nbusy) {
    const int tid = F.tid, lane = F.lane, wave = F.wave, r32 = lane & 31, hi = lane >> 5, h = wave & 3, qh = wave >> 2;
    LAS unsigned char* lds = F.lds + RING_OFF; LAS unsigned char* hl = lds + h * SB_HEAD_LDS; LAS int* flag = (LAS int*)(lds + SB_FLAG);
    const bf16* P1 = WSP(bf16, WS_P1); const bf16* VT = WSP(bf16, WS_VT) + (size_t)2 * BC * 64 * SEQ;
    bf16* Yb = WSP(bf16, WS_Y) + (size_t)MC * 256;
    const int tq = 32 * qh + r32;
    if (F.bx >= nbusy)
        for (int item = F.bx - nbusy; item < BC * 64; item += F.G - nbusy) {
            const int b = item >> 6, qb = item & 63;
            const size_t row = (size_t)b * SEQ + qb * 64 + tq;
            bf16x8v qr[4];
#pragma unroll
            for (int d0 = 0; d0 < 4; ++d0) qr[d0] = *(const bf16x8v*)(P1 + row * P1W + C_SBQ + h * 64 + d0 * 16 + hi * 8);
            f32x16 o[2], p0, p1;
#pragma unroll
            for (int i = 0; i < 16; ++i) { o[0][i] = 0.f; o[1][i] = 0.f; }
            float R = 0.f;
            const int skey = tid & 63, sc = tid >> 6, sd = tid >> 3, skc = tid & 7;
            v4u kx[4], vx[4];
#define SB_LOAD(jj) do { const bf16* kg_ = P1 + ((size_t)b * SEQ + (jj) * 64 + skey) * P1W + C_SBK + sc * 8; \
                _Pragma("unroll") for (int hh = 0; hh < 4; ++hh) { kx[hh] = *(const v4u*)(kg_ + hh * 64); vx[hh] = *(const v4u*)(VT + ((size_t)(hh * BC + b) * 64 + sd) * SEQ + (jj) * 64 + skc * 8); } } while (0)
            SB_LOAD(qb);
            for (int j = qb; j >= 0; --j) {
                __syncthreads();
                if (j < qb) { int live = 0;
#pragma unroll
                    for (int w = 0; w < 8; ++w) live |= flag[w];
                    if (!live) break; }
#pragma unroll
                for (int hh = 0; hh < 4; ++hh) { *(LAS v4u*)(lds + hh * SB_HEAD_LDS + sc * 1024 + skey * 16) = kx[hh]; { LAS v2u* vd = (LAS v2u*)(lds + hh * SB_HEAD_LDS + NSA_V + sd * NSA_VP + skc * 16); vd[0] = (v2u){vx[hh].x, vx[hh].y}; vd[1] = (v2u){vx[hh].z, vx[hh].w}; } }
                __syncthreads();
                if (j > 0) SB_LOAD(j - 1);
                nsa_qk(hl, qr, p0, p1, r32, hi);
#pragma unroll
                for (int i = 0; i < 16; ++i) { p0[i] *= NSA_C2; p1[i] *= NSA_C2; }
                v4u vv[8]; nsa_vload(hl, vv, r32, hi);
                const int lim = ((j == qb) ? tq : 64) - 4 * hi;
                float Town[8], Tp[8];
#pragma unroll
                for (int kt = 0; kt < 2; ++kt) { f32x16& pp = kt ? p1 : p0;
#pragma unroll
                    for (int g = 0; g < 4; ++g) { float L[4];
#pragma unroll
                        for (int e = 0; e < 4; ++e) { const int kk = 32 * kt + 8 * g + e; const float z = pp[4 * g + e];
                            const float tt = __builtin_amdgcn_logf(1.0f + __builtin_amdgcn_exp2f(-__builtin_fabsf(z)));
                            const float lb = fminf(z, 0.f) - tt; const bool ok = kk < lim;
                            L[e] = ok ? lb - z : 0.f; pp[4 * g + e] = ok ? lb : -INFINITY; }
                        const float E2 = L[3], E1 = E2 + L[2], E0 = E1 + L[1];
                        pp[4 * g + 2] += E2; pp[4 * g + 1] += E1; pp[4 * g] += E0;
                        Town[4 * kt + g] = E0 + L[0]; } }
#pragma unroll
                for (int k = 0; k < 8; ++k) Tp[k] = partner32(Town[k], lane);
                float suf = R;
#pragma unroll
                for (int k = 7; k >= 0; --k) { const float add = suf + (hi == 0 ? Tp[k] : 0.f); f32x16& pp = (k >> 2) ? p1 : p0; const int g = k & 3;
#pragma unroll
                    for (int e = 0; e < 4; ++e) pp[4 * g + e] = __builtin_amdgcn_exp2f(pp[4 * g + e] + add);
                    suf += Town[k] + Tp[k]; }
                R = suf;
                nsa_pv(vv, p0, p1, o);
                const bool alive = R >= SB_STOP;
                const unsigned long long bal = __builtin_amdgcn_ballot_w64(alive);
                if (lane == 0) flag[wave] = bal != 0ull ? 1 : 0;
            }
            { bf16* dst = Yb + ((size_t)b * SEQ + qb * 64 + 32 * qh + 4 * hi) * 256 + h * 64 + r32;
#pragma unroll
              for (int i = 0; i < 16; ++i) { dst[((i & 3) + 8 * (i >> 2)) * 256] = (bf16)f2bf(o[0][i]); dst[((i & 3) + 8 * (i >> 2)) * 256 + 32] = (bf16)f2bf(o[1][i]); } }
        }
#undef SB_LOAD
    __syncthreads();
}

__device__ __forceinline__ void p_sgu2(Frame& F, int layer) {
    LAS unsigned char* vnT = F.lds + RING_OFF;
    const bf16* P1 = WSP(bf16, WS_P1); bf16* Ya = WSP(bf16, WS_Y);
    const float* gain = F.in[3] + (size_t)layer * 256; const float* sw = F.in[4] + (size_t)layer * 4 * 128 * 128; const float* sb = F.in[5] + (size_t)layer * 4 * 128;
    const int lane = F.lane, wave = F.wave, r32 = lane & 31, hi = lane >> 5, g = wave & 3, db = wave >> 2;
    for (int item = F.vcu; item < MC / 128; item += F.G) {
        const size_t r0 = (size_t)item * 128;
        __syncthreads();
        { const f32x4 gg = ((const f32x4*)gain)[lane];
          for (int rr = 0; rr < 16; rr += 2) { const int r = wave * 16 + rr;
              const v2u ra = *(const v2u*)(P1 + (r0 + r) * P1W + C_V + 4 * lane), rb = *(const v2u*)(P1 + (r0 + r + 1) * P1W + C_V + 4 * lane);
              const float a0 = bflo(ra.x), a1 = bfhi(ra.x), a2 = bflo(ra.y), a3 = bfhi(ra.y), b0 = bflo(rb.x), b1 = bfhi(rb.x), b2 = bflo(rb.y), b3 = bfhi(rb.y);
              const float sa = 1.0f / sqrtf(wave_sum((a0 * a0 + a1 * a1) + (a2 * a2 + a3 * a3), lane) * (1.f / 256.f) + EPS);
              const float sb_ = 1.0f / sqrtf(wave_sum((b0 * b0 + b1 * b1) + (b2 * b2 + b3 * b3), lane) * (1.f / 256.f) + EPS);
              LAS unsigned* q = (LAS unsigned*)(vnT + (4 * lane) * 272 + r * 2);
              q[0] = pk2(a0 * sa * gg.x, b0 * sb_ * gg.x); q[68] = pk2(a1 * sa * gg.y, b1 * sb_ * gg.y); q[136] = pk2(a2 * sa * gg.z, b2 * sb_ * gg.z); q[204] = pk2(a3 * sa * gg.w, b3 * sb_ * gg.w); } }
        __syncthreads();
        const int ch = g * 64 + db * 32 + r32;
        for (int tb = 0; tb < 4; ++tb) {
            f32x16 acc;
#pragma unroll
            for (int i = 0; i < 16; ++i) acc[i] = 0.f;
            const int t = 32 * tb + r32; const float* wrow = sw + ((size_t)g * 128 + t) * 128;
            f32x4 wq[8][2];
#pragma unroll
            for (int ks = 0; ks < 8; ++ks) if (ks < 2 * tb + 2) { wq[ks][0] = *(const f32x4*)(wrow + 16 * ks + 8 * hi); wq[ks][1] = *(const f32x4*)(wrow + 16 * ks + 8 * hi + 4); }
#pragma unroll
            for (int ks = 0; ks < 8; ++ks) if (ks < 2 * tb + 2) {
                const int s0 = 16 * ks + 8 * hi;
                const f32x4 w0 = wq[ks][0], w1 = wq[ks][1];
                const v4u a = (v4u){pk2(s0 <= t ? w0.x : 0.f, s0 + 1 <= t ? w0.y : 0.f), pk2(s0 + 2 <= t ? w0.z : 0.f, s0 + 3 <= t ? w0.w : 0.f),
                                    pk2(s0 + 4 <= t ? w1.x : 0.f, s0 + 5 <= t ? w1.y : 0.f), pk2(s0 + 6 <= t ? w1.z : 0.f, s0 + 7 <= t ? w1.w : 0.f)};
                const bf16x8v bfr = *(const LAS bf16x8v*)(vnT + ch * 272 + s0 * 2);
                acc = __builtin_amdgcn_mfma_f32_32x32x16_bf16(__builtin_bit_cast(bf16x8v, a), bfr, acc, 0, 0, 0); }
            float uu[16], bb[16];
#pragma unroll
            for (int i = 0; i < 16; ++i) { const int tt = 32 * tb + (i & 3) + 8 * (i >> 2) + 4 * hi; uu[i] = bf1(P1[(r0 + tt) * P1W + C_U + ch]); bb[i] = sb[g * 128 + tt]; }
#pragma unroll
            for (int i = 0; i < 16; ++i) { const int tt = 32 * tb + (i & 3) + 8 * (i >> 2) + 4 * hi;
                Ya[(r0 + tt) * 256 + ch] = (bf16)f2bf(uu[i] * (acc[i] + bb[i])); }
        }
    }
    __syncthreads();
}

struct Args { const float* in[20]; float* out; unsigned char* ws; int lo, hi, li, rep; };
#ifndef TILED_FFN1
#define TILED_FFN1 0
#endif
#ifndef PG8_ALIGN_EPI
#define PG8_ALIGN_EPI true
#endif
#ifndef PG8_SP2
#define PG8_SP2 true
#endif
#ifndef WGM_PROJ
#define WGM_PROJ PG8_WGM
#endif
#ifndef WGM_FFN1
#define WGM_FFN1 PG8_WGM
#endif
#ifndef WGM_FFN2
#define WGM_FFN2 PG8_WGM
#endif
#ifndef WGM_MOE1
#define WGM_MOE1 PG8_WGM
#endif
#ifndef WGM_MOE2
#define WGM_MOE2 PG8_WGM
#endif
#ifndef FFN_CHUNKS
#define FFN_CHUNKS 2
#endif
#ifndef REP_GEMM
#define REP_GEMM 1
#endif
#ifndef REP_STICK
#define REP_STICK 1
#endif
#ifndef REP_NSA
#define REP_NSA 1
#endif
#ifndef REP_SGU
#define REP_SGU 1
#endif
#ifndef REP_NORM
#define REP_NORM 1
#endif
template <class Epi, class Sched> __device__ __forceinline__ void run_gemm(Frame& F, const bf16* A, const bf16* Bt, int M, int N, int K, const Sched& S, Epi E, bool rotate = true, int tiled = 0, int ld = 0) {
    const int nt_ = K / 64;
#ifdef PG8_KROT
    const int rot_ = rotate ? 2 * (((F.bx & 7) * (nt_ / 2)) / 8) : 0;
#else
    const int rot_ = 0;
#endif
    pg8::Gemm g{A, Bt, M, N, K + F.zs, F.tid, rot_ + F.zs, tiled + F.zs, ld + F.zs};
    if (F.rep) E.set_scale0();
    pg8::gemm_phase<Epi, Sched, PG8_ALIGN_EPI, PG8_SP2>(F.lds + RING_OFF, g, S, E);
}
__global__ void __launch_bounds__(NWAVES * 64, 2) mk_fwd(Args args) {
    extern __shared__ __attribute__((aligned(16))) unsigned char lds[];
    Frame F0;
    F0.lds = (LAS unsigned char*)lds;
    F0.tid = threadIdx.x; F0.lane = F0.tid & 63; F0.wave = __builtin_amdgcn_readfirstlane(F0.tid >> 6);
    F0.G = gridDim.x; F0.bx = blockIdx.x; F0.vcu = (F0.G % 8 == 0) ? (F0.bx % 8) * (F0.G / 8) + F0.bx / 8 : F0.bx; F0.zv = 0; F0.zs = 0;
    F0.rep = args.rep; F0.ws = args.ws; F0.ctl = (unsigned*)(args.ws + WS_CTL); F0.in = args.in; F0.out = args.out;
    for (int u = F0.tid; u < (LDS_BYTES - LDSCTL_OFF) / 4; u += NWAVES * 64) ((LAS unsigned*)(F0.lds + LDSCTL_OFF))[u] = 0u;
    __syncthreads();
    const int lo = args.lo, hi = args.hi;
    XcdBarrier bar; bar.bar = F0.ctl + CW_BAR + args.li * XCD_BAR_WORDS; bar.x = 0; bar.st = nullptr; bar.w = 0; bar.z = 0;
    if (hi - lo > 1) bar = xcd_barrier_post(F0.ctl + CW_BAR + args.li * XCD_BAR_WORDS, (volatile LAS unsigned*)(F0.lds + MISC_OFF) + 8);
    int step = 0;
#define STEP_BEGIN if (step >= lo && step < hi) { Frame F = F0; { int zv_, zs_; asm volatile("v_mov_b32 %0, 0" : "=v"(zv_)); asm volatile("s_mov_b32 %0, 0" : "=s"(zs_)); \
        F.zv = zv_; F.zs = zs_; F.lane = (int)__builtin_amdgcn_mbcnt_hi(~0u, __builtin_amdgcn_mbcnt_lo(~0u, (unsigned)zv_)); F.wave = F0.wave + zs_; F.tid = F.wave * 64 + F.lane; F.bx = F.bx + zs_; \
        F.vcu = F0.vcu + zs_; F.G = F0.G + zs_; F.lds = (LAS unsigned char*)lds + zs_; F.ws = F0.ws + zs_; F.ctl = F0.ctl + zs_; F.in = F0.in + zs_; F.out = F0.out + zs_; }
#ifdef PROBE_XBAR
#define STEP_END   if (step + 1 < hi) { unsigned zb_; asm volatile("v_mov_b32 %0, 0" : "=v"(zb_)); bar.z = zb_; xcd_barrier(bar); xcd_barrier(bar); } } ++step;
#else
#define STEP_END   if (step + 1 < hi) { unsigned zb_; asm volatile("v_mov_b32 %0, 0" : "=v"(zb_)); bar.z = zb_; xcd_barrier(bar); } } ++step;
#endif

    for (int layer = 0; layer < DEPTH; ++layer) {
        const int jj = layer >> 1;
        STEP_BEGIN
            p_convert(F, layer);
            if (layer == 0) p_norm<0, false>(F, F.in[0], F.in[1], nullptr, 0); else p_norm<0, true>(F, WSP(bf16, WS_H), F.in[1] + (size_t)layer * DM, nullptr, 0);
        STEP_END
        for (int c = 0; c < NCHUNK; ++c) {
            STEP_BEGIN
                pg8::StaticOrder S; S.init(MC, NPROJ, F.G, F.bx, WGM_PROJ);
                pg8::EpiProj E{WSP(bf16, WS_P1), WSP(bf16, WS_G)};
                run_gemm(F, WSP(bf16, WS_HN) + (size_t)c * MC * DM, WSP(bf16, WS_WIN), MC, NPROJ, DM, S, E);
            STEP_END
            STEP_BEGIN
                p_prep(F);
            STEP_END
            STEP_BEGIN
                LAS int* tab = (LAS int*)(F.lds + TAB_OFF);
                __syncthreads(); if (F.tid < 16) tab[F.tid] = F.tid >> 3; __syncthreads();
                pg8::GroupedOrder S; S.so.init(2 * 2048, 512, F.G, F.bx); S.tile_e = tab; S.nN = 2;
                pg8::EpiF32 E{WSP(float, WS_UL), 512, 2};
                run_gemm(F, WSP(bf16, WS_KVC), WSP(bf16, WS_WC1), 2 * 2048, 512, DM, S, E);
                p_sgu2(F, layer);
                p_stick2(F, F.G > 64 ? 32 : 0);
            STEP_END
            STEP_BEGIN
                p_cmpfin(F, layer);
            STEP_END
            STEP_BEGIN
#ifdef OLD_NSA
                p_nsa(F);
#else
                p_nsa2(F);
#endif
            STEP_END
            STEP_BEGIN
                pg8::MergeOrder S; S.so.init(MC, DM, F.G, F.bx); S.nmt = MC / 256;
                pg8::EpiMerge E{WSP(bf16, WS_G), WSP(bf16, WS_MG), MC / 256};
                run_gemm(F, WSP(bf16, WS_Y), WSP(bf16, WS_WBR), 3 * MC, 3 * DM, 256, S, E);
            STEP_END
            STEP_BEGIN
                pg8::StaticOrder S; S.init(MC, DM, F.G, F.bx);
                pg8::EpiResid E{layer == 0 ? F.in[0] + (size_t)c * MC * DM : nullptr, WSP(bf16, WS_H) + (size_t)c * MC * DM, DM, 1.0f};
                run_gemm(F, WSP(bf16, WS_MG), WSP(bf16, WS_WOUT), MC, DM, DM, S, E);
            STEP_END
        }
        if ((layer & 1) == 0) {
            STEP_BEGIN
                p_norm<0, true>(F, WSP(bf16, WS_H), F.in[11] + (size_t)layer * DM, nullptr, 0, Q8_HN, TILED_FFN1);
            STEP_END
            for (int c = 0; c < FFN_CHUNKS; ++c) {
                constexpr int MF = MTOK / FFN_CHUNKS;
                STEP_BEGIN
                    pg8::StaticOrder S; S.init(MF, NFF1, F.G, F.bx, WGM_FFN1);
                    pg8::EpiSwiGLU E{WSP(bf16, WS_HID), DFFP, nullptr, NFF1 / 256};
                    run_gemm(F, WSP(bf16, WS_HN) + (size_t)c * MF * DM, WSP(bf16, WS_WF1), MF, NFF1, DM, S, E, true, TILED_FFN1);
                STEP_END
                STEP_BEGIN
                    pg8::StaticOrder S; S.init(MF, DM, F.G, F.bx, WGM_FFN2);
                    pg8::EpiResid E{nullptr, WSP(bf16, WS_H) + (size_t)c * MF * DM, DM, 1.0f};
                    run_gemm(F, WSP(bf16, WS_HID), WSP(bf16, WS_WF2), MF, DM, DFFP, S, E);
                STEP_END
            }
        } else {
            STEP_BEGIN
                p_norm<1, true>(F, WSP(bf16, WS_H), F.in[11] + (size_t)layer * DM, F.in[15] + (size_t)jj * DM * NEXP, jj, Q8_HN);
            STEP_END
#ifdef ABL_DENSE_MOE
            for (int e = 0; e < NEXP; ++e) {
                STEP_BEGIN
                    pg8::StaticOrder S; S.init(MTOK, NMOE1, F.G, F.bx);
                    pg8::EpiSwiGLU E{WSP(bf16, WS_SCR + 8 * MiB), DFE, WSP(float, WS_SCR + 4 * MiB) + (size_t)e * MTOK, NMOE1 / 256};
                    run_gemm(F, WSP(bf16, WS_HN), WSP(bf16, WS_WF1) + (size_t)e * NMOE1 * DM, MTOK, NMOE1, DM, S, E);
                STEP_END
                STEP_BEGIN
                    pg8::StaticOrder S; S.init(MTOK, DM, F.G, F.bx);
                    pg8::EpiResid E{nullptr, WSP(bf16, WS_H), DM, 1.0f};
                    run_gemm(F, WSP(bf16, WS_SCR + 8 * MiB), WSP(bf16, WS_WF2) + (size_t)e * DM * DFE, MTOK, DM, DFE, S, E);
                STEP_END
            }
#else
            STEP_BEGIN
                p_gather(F, jj, 0, 0);
            STEP_END
            for (int c = 0; c < NCHUNK; ++c)
                for (int r = 0; r < 2; ++r) {
                    STEP_BEGIN
                        const int T = moe_table(F, jj, c, r);
                        pg8::GroupedOrder S; S.so.init(T * 256, NMOE1, F.G, F.bx, WGM_MOE1); S.tile_e = (LAS int*)(F.lds + TAB_OFF); S.nN = NMOE1 / 256;
                        pg8::EpiSwiGLU E{WSP(bf16, WS_HIDM), DFE, WSP(float, WS_WSLOT) + (c * 2 + r) * SLOTS, NMOE1 / 256};
                        run_gemm(F, WSP(bf16, WS_XG), WSP(bf16, WS_WF1), T * 256, NMOE1, DM, S, E, false);
                    STEP_END
                    STEP_BEGIN
                        const int T = moe_table(F, jj, c, r);
                        const int nwg = T * (DM / 256), R = nwg % F.G, full = nwg - R;
                        const int NS = (4 * R <= F.G) ? 4 : 2;
                        const bool split = (hi - lo > 1) && R > 0 && NS * R <= F.G && !F.rep;
                        int* tokm = WSP(int, WS_TOKMAP) + (c * 2 + r) * SLOTS; float* TB = WSP(float, WS_SCR + 320 * MiB);
                        { pg8::LimitOrder S; S.so.init(T * 256, DM, F.G, F.bx, WGM_MOE2); S.limit = split ? full : nwg;
                          pg8::GroupedLimit GS{S, (LAS int*)(F.lds + TAB_OFF), DM / 256};
                          pg8::EpiScatter E{WSP(bf16, WS_H), tokm, DM / 256, 1.0f};
                          run_gemm(F, WSP(bf16, WS_HIDM), WSP(bf16, WS_WF2), T * 256, DM, DFE, GS, E, false); }
                        const bool more = c * 2 + r < 3;
                        if (split) {
                            const int KP = DFE / NS;
                            if (F.bx < NS * R) { const int Lx = full + F.bx / NS, kp = F.bx % NS;
                                pg8::StaticOrder so; so.init(T * 256, DM, F.G, Lx % F.G, WGM_MOE2); pg8::Unit un; so.next(Lx / F.G, un);
                                un.pn += ((LAS int*)(F.lds + TAB_OFF))[un.pm] * (DM / 256);
                                pg8::SingleOrder S1{un};
                                if (kp == 0) { pg8::EpiScatter E{WSP(bf16, WS_H), tokm, DM / 256, 1.0f};
                                    run_gemm(F, WSP(bf16, WS_HIDM), WSP(bf16, WS_WF2), T * 256, DM, KP, S1, E, false, 0, DFE); }
                                else { pg8::EpiTile E{TB + ((size_t)(Lx - full) * 3 + (kp - 1)) * 65536};
                                    run_gemm(F, WSP(bf16, WS_HIDM) + kp * KP, WSP(bf16, WS_WF2) + kp * KP, T * 256, DM, KP, S1, E, false, 0, DFE); } }
                            if (more) p_gather(F, jj, (c * 2 + r + 1) >> 1, (c * 2 + r + 1) & 1, NS * R);
                            { unsigned zb_; asm volatile("v_mov_b32 %0, 0" : "=v"(zb_)); bar.z = zb_; xcd_barrier(bar); }
                            for (int it = (F.vcu * NWAVES + F.wave); it < R * 256; it += F.G * NWAVES) { const int j = it >> 8, row = it & 255, Lx = full + j;
                                pg8::StaticOrder so; so.init(T * 256, DM, F.G, Lx % F.G, WGM_MOE2); pg8::Unit un; so.next(Lx / F.G, un);
                                const int t = tokm[un.pm * 256 + row];
                                if (t >= 0) { v2u* hp = (v2u*)(WSP(bf16, WS_H) + (size_t)t * DM + un.pn * 256) + F.lane; const v2u hv = *hp; f32x4 a = (f32x4){bflo(hv.x), bfhi(hv.x), bflo(hv.y), bfhi(hv.y)};
                                    for (int q = 0; q < NS - 1; ++q) a = a + ((const f32x4*)(TB + ((size_t)j * 3 + q) * 65536 + row * 256))[F.lane];
                                    *hp = (v2u){pk2(a.x, a.y), pk2(a.z, a.w)}; } }
                        } else if (!F.rep && more) p_gather(F, jj, (c * 2 + r + 1) >> 1, (c * 2 + r + 1) & 1, R);
                    STEP_END
                }
#endif
        }
    }
    STEP_BEGIN
        p_norm<2, true>(F, WSP(bf16, WS_H), F.in[19], nullptr, 0);
    STEP_END
#undef STEP_BEGIN
#undef STEP_END
}

#ifndef MK_STEPS_PER_LAUNCH
#define MK_STEPS_PER_LAUNCH 1
#endif
extern "C" void kernel_launch(void* const* d_in, const int* in_sizes, int n_in, void* d_out, int out_size, void* d_ws, size_t ws_size, hipStream_t stream) {
    static int grid = 0;
    if (grid == 0) {
        if (n_in != 20 || in_sizes[0] != MTOK * DM || out_size != MTOK * DM || ws_size < WS_END) { fprintf(stderr, "kernel_launch: unexpected shapes (n_in %d, in0 %d, out %d, ws %zu)\n", n_in, n_in > 0 ? in_sizes[0] : -1, out_size, ws_size); grid = -1; return; }
        int dev = 0, cus = 0, per_cu = 0;
        if (hipGetDevice(&dev) != hipSuccess || hipDeviceGetAttribute(&cus, hipDeviceAttributeMultiprocessorCount, dev) != hipSuccess) { grid = -1; return; }
        if (hipFuncSetAttribute((const void*)mk_fwd, hipFuncAttributeMaxDynamicSharedMemorySize, LDS_BYTES) != hipSuccess) { fprintf(stderr, "kernel_launch: hipFuncSetAttribute failed\n"); grid = -1; return; }
        if (hipOccupancyMaxActiveBlocksPerMultiprocessor(&per_cu, (const void*)mk_fwd, NWAVES * 64, LDS_BYTES) != hipSuccess || per_cu < 1) fprintf(stderr, "kernel_launch: occupancy query reports %d\n", per_cu);
        (void)hipGetLastError();
        grid = cus;
    }
    if (grid < 0) return;
    if (hipMemsetAsync((char*)d_ws + WS_CTL, 0, CTL_ZERO_BYTES, stream) != hipSuccess) return;
    Args a{};
    for (int i = 0; i < 20; ++i) a.in[i] = (const float*)d_in[i];
    a.out = (float*)d_out; a.ws = (unsigned char*)d_ws; a.rep = 0;
    #ifdef ABL_DENSE_MOE
    constexpr int NSTEPS = 2 * (1 + NCHUNK * 8 + 3) + 2 * (1 + NCHUNK * 8 + 1 + NEXP * 2) + 1;
#else
    constexpr int NSTEPS = 2 * (1 + NCHUNK * 7 + 1 + 2 * FFN_CHUNKS) + 2 * (1 + NCHUNK * 7 + 2 + NCHUNK * 2 * 2) + 1;
#endif
    int li = 0;
#ifdef REPMASK
    static int kinds[256]; int ns = 0;
    for (int layer = 0; layer < DEPTH; ++layer) { kinds[ns++] = 0;
        for (int c = 0; c < NCHUNK; ++c) for (int q = 1; q <= 8; ++q) if (q != 5) kinds[ns++] = q;
        if ((layer & 1) == 0) { kinds[ns++] = 9; for (int c = 0; c < FFN_CHUNKS; ++c) { kinds[ns++] = 10; kinds[ns++] = 11; } }
        else { kinds[ns++] = 12; kinds[ns++] = 17; for (int c = 0; c < NCHUNK * 2; ++c) { kinds[ns++] = 14; kinds[ns++] = 13; } } }
    kinds[ns++] = 16;
    for (int s = 0; s < NSTEPS; ++s) { const int reps = ((REPMASK >> kinds[s]) & 1) ? 2 : 1;
        for (int r = 0; r < reps; ++r) { a.lo = s; a.hi = s + 1; a.li = 0; a.rep = r;
            hipLaunchKernelGGL(mk_fwd, dim3(grid), dim3(NWAVES * 64), LDS_BYTES, stream, a); } }
    (void)li;
#else
    for (int s = 0; s < NSTEPS; s += MK_STEPS_PER_LAUNCH) {
        a.lo = s; a.hi = (s + MK_STEPS_PER_LAUNCH < NSTEPS) ? s + MK_STEPS_PER_LAUNCH : NSTEPS; a.li = (MK_STEPS_PER_LAUNCH > 1) ? li : 0; ++li;
        hipLaunchKernelGGL(mk_fwd, dim3(grid), dim3(NWAVES * 64), LDS_BYTES, stream, a);
        if (hipPeekAtLastError() != hipSuccess) { fprintf(stderr, "kernel_launch: launch failed\n"); break; }
    }
#endif
}
```

```cpp
#define MK_STEPS_PER_LAUNCH 1000
#define PG8_WGM 4
#define FFN_CHUNKS 1
#include <hip/hip_runtime.h>
#include <cstdio>
#include <cstdint>
#include <cmath>
#ifndef PG8_AUX_A
#define PG8_AUX_A 0
#endif
#ifndef PG8_AUX_B
#define PG8_AUX_B 0
#endif
#ifndef PG8_WGM
#define PG8_WGM 8
#endif
namespace pg8 {
#define PG8_LAS __attribute__((address_space(3)))
typedef unsigned short bf16_t;
typedef short bf16x8 __attribute__((ext_vector_type(8)));
typedef float f32x4 __attribute__((ext_vector_type(4)));
typedef unsigned u32x4 __attribute__((ext_vector_type(4)));
constexpr int BM = 256, BK = 64, HALF = 128, HTB = HALF * BK * 2  , STAGE_BYTES = 8 * HTB, NXCD = 8, WGM = PG8_WGM;

__host__ __device__ __forceinline__ int lds_byte(int r, int c) { const int st = (r >> 4) * 2 + (c >> 5), rr = r & 15, cc = c & 31, ob = rr * 64 + cc * 2; return st * 1024 + (ob ^ (((ob >> 9) & 1) << 5)); }
__host__ __device__ __forceinline__ void stage_rc(int b, int& R, int& C) { const int st = b / 1024, sb = b % 1024, swz = sb ^ (((sb >> 9) & 1) << 5); R = (st >> 1) * 16 + swz / 64; C = (st & 1) * 32 + (swz % 64) / 2; }
__host__ __device__ __forceinline__ int perm32(int rho) { const int n = rho >> 4, i = rho & 15; return 8 * (i >> 2) + 4 * n + (i & 3); }

struct Unit { int pm, pn; };
struct Gemm { const bf16_t* A; const bf16_t* Bt; int M, N, K; int zv; int rot; int tiled; int ld; const int* gidx; };

struct StaticOrder {
    int nM, nN, nwg, G, c, wgm;
    __host__ __device__ __forceinline__ void init(int M, int N, int G_, int c_, int wgm_ = WGM) { nM = M / BM; nN = N / BM; nwg = nM * nN; G = G_; c = c_; wgm = wgm_; }
    __host__ __device__ __forceinline__ bool next(int i, Unit& u) const {
        const long L = (long)i * G + c; if (L >= nwg) return false;
        int wgid = (int)L; { const int q = nwg / NXCD, r = nwg % NXCD, xcd = wgid % NXCD, off = wgid / NXCD; wgid = (xcd < r ? xcd * (q + 1) : r * (q + 1) + (xcd - r) * q) + off; }
        const int nig = wgm * nN, gid = wgid / nig, fm = gid * wgm, gsz = (nM - fm) < wgm ? (nM - fm) : wgm;
        u.pm = fm + ((wgid % nig) % gsz); u.pn = (wgid % nig) / gsz; return true;
    }
    __device__ __forceinline__ void a_ready(const Unit&) const {}
    __device__ __forceinline__ void done(const Unit&) const {}
};

__device__ __forceinline__ unsigned cvt_pk_bf16(float lo, float hi) { unsigned r; asm volatile("v_cvt_pk_bf16_f32 %0, %1, %2" : "=v"(r) : "v"(lo), "v"(hi)); return r; }
typedef float f32x2 __attribute__((ext_vector_type(2)));

__device__ __forceinline__ float fast_sigmoid(float x) { return __builtin_amdgcn_rcpf(1.0f + __builtin_amdgcn_exp2f(-1.4426950408889634f * x)); }
__device__ __forceinline__ float gelu_tanh(float x) {
    const float u2 = 1.5957691216057308f * (x + 0.044715f * x * x * x);
    return x * fast_sigmoid(u2);
}
__device__ __forceinline__ float bf_lo(unsigned u) { return __builtin_bit_cast(float, u << 16); }
__device__ __forceinline__ float bf_hi(unsigned u) { return __builtin_bit_cast(float, u & 0xffff0000u); }

#ifdef PG8_NT_OUT
#define PG8_STORE_OUT(p, v) __builtin_nontemporal_store((v), (p))
#else
#define PG8_STORE_OUT(p, v) (*(p) = (v))
#endif
struct EpiProj {
    static constexpr bool PERM = true, AFTER_DRAIN = false, MID = false; static constexpr int MID_TILES = 1; __device__ __forceinline__ void set_scale0() {}
    bf16_t* P1; bf16_t* G;
    __device__ __forceinline__ void operator()(const f32x4 (&acc)[2][2][4][2], const Unit& u, int wr, int wc, int fr, int fq) const {
        const int row0 = u.pm * BM + wr * 64 + fr;
        bf16_t* base; int ldc, colt, act0, act1;
        if (u.pn < 8) { base = P1; ldc = 2048; colt = u.pn * BM; act0 = (u.pn < 2) ? 1 : 0; act1 = (u.pn == 7) ? 2 : act0; }
        else { base = G; ldc = 3072; colt = (u.pn - 8) * BM; act0 = 2; act1 = 2; }
        const int col0 = colt + wc * 32 + 8 * fq;
#pragma unroll
        for (int ai = 0; ai < 2; ++ai)
#pragma unroll
            for (int m = 0; m < 4; ++m) { bf16_t* rowp = base + (size_t)(row0 + ai * HALF + m * 16) * ldc + col0;
#pragma unroll
                for (int bj = 0; bj < 2; ++bj) { f32x4 v0 = acc[ai][bj][m][0], v1 = acc[ai][bj][m][1]; const int act = bj ? act1 : act0;
                    if (act == 1) {
#pragma unroll
                        for (int e = 0; e < 4; ++e) { v0[e] = gelu_tanh(v0[e]); v1[e] = gelu_tanh(v1[e]); } }
                    else if (act == 2) {
#pragma unroll
                        for (int e = 0; e < 4; ++e) { v0[e] = fast_sigmoid(v0[e]); v1[e] = fast_sigmoid(v1[e]); } }
                    u32x4 w; w.x = cvt_pk_bf16(v0[0], v0[1]); w.y = cvt_pk_bf16(v0[2], v0[3]); w.z = cvt_pk_bf16(v1[0], v1[1]); w.w = cvt_pk_bf16(v1[2], v1[3]);
                    *(u32x4*)(rowp + bj * HALF) = w; } }
    }
};
struct EpiMerge {
    static constexpr bool PERM = true, AFTER_DRAIN = false, MID = false; static constexpr int MID_TILES = 1; __device__ __forceinline__ void set_scale0() {}
    const bf16_t* G; bf16_t* MG; int nmt;
    __device__ __forceinline__ void operator()(const f32x4 (&acc)[2][2][4][2], const Unit& u, int wr, int wc, int fr, int fq) const {
        const int i = u.pn >> 2, pn = u.pn & 3, pm = u.pm - i * nmt;
        const int row0 = pm * BM + wr * 64 + fr, col0 = pn * BM + wc * 32 + 8 * fq;
#pragma unroll
        for (int ai = 0; ai < 2; ++ai)
#pragma unroll
            for (int mp = 0; mp < 2; ++mp) {
                u32x4 g[4], o[4];
#pragma unroll
                for (int q = 0; q < 4; ++q) { const int m = 2 * mp + (q >> 1), bj = q & 1; const size_t row = (size_t)(row0 + ai * HALF + m * 16); const int col = col0 + bj * HALF;
                    g[q] = *(const u32x4*)(G + row * 3072 + i * 1024 + col);
                    if (i > 0) o[q] = *(const u32x4*)(MG + row * 1024 + col); else o[q] = (u32x4){0u, 0u, 0u, 0u}; }
#pragma unroll
                for (int q = 0; q < 4; ++q) { const int m = 2 * mp + (q >> 1), bj = q & 1; const size_t row = (size_t)(row0 + ai * HALF + m * 16); const int col = col0 + bj * HALF;
                    f32x4 v0 = acc[ai][bj][m][0], v1 = acc[ai][bj][m][1];
#ifdef ABL_BRANCH
                    if (i == ABL_BRANCH) { v0 = v0 * (float)ABL_SCALE; v1 = v1 * (float)ABL_SCALE; }
#endif
                    v0[0] = v0[0] * bf_lo(g[q].x) + bf_lo(o[q].x); v0[1] = v0[1] * bf_hi(g[q].x) + bf_hi(o[q].x); v0[2] = v0[2] * bf_lo(g[q].y) + bf_lo(o[q].y); v0[3] = v0[3] * bf_hi(g[q].y) + bf_hi(o[q].y);
                    v1[0] = v1[0] * bf_lo(g[q].z) + bf_lo(o[q].z); v1[1] = v1[1] * bf_hi(g[q].z) + bf_hi(o[q].z); v1[2] = v1[2] * bf_lo(g[q].w) + bf_lo(o[q].w); v1[3] = v1[3] * bf_hi(g[q].w) + bf_hi(o[q].w);
                    u32x4 w; w.x = cvt_pk_bf16(v0[0], v0[1]); w.y = cvt_pk_bf16(v0[2], v0[3]); w.z = cvt_pk_bf16(v1[0], v1[1]); w.w = cvt_pk_bf16(v1[2], v1[3]);
                    *(u32x4*)(MG + row * 1024 + col) = w; } }
    }
};
typedef unsigned u32x2 __attribute__((ext_vector_type(2)));
struct EpiResid {
    static constexpr bool PERM = false, AFTER_DRAIN = false, MID = false; static constexpr int MID_TILES = 1; __device__ __forceinline__ void set_scale0() { scale = 0.f; x32 = nullptr; }
    const float* x32; bf16_t* out; int ldc; float scale;
    __device__ __forceinline__ void operator()(const f32x4 (&acc)[2][2][4][2], const Unit& u, int wr, int wc, int fr, int fq) const {
        const int row0 = u.pm * BM + wr * 64 + fr, col0 = u.pn * BM + wc * 32 + 4 * fq;
#pragma unroll
        for (int ai = 0; ai < 2; ++ai)
#pragma unroll
            for (int mp = 0; mp < 2; ++mp) {
                f32x4 b[8];
                if (x32) {
#pragma unroll
                    for (int q = 0; q < 8; ++q) { const int m = 2 * mp + (q >> 2), bj = (q >> 1) & 1, n = q & 1;
                        b[q] = *(const f32x4*)(x32 + (size_t)(row0 + ai * HALF + m * 16) * ldc + col0 + bj * HALF + n * 16); }
                } else {
                    u32x2 t[8];
#pragma unroll
                    for (int q = 0; q < 8; ++q) { const int m = 2 * mp + (q >> 2), bj = (q >> 1) & 1, n = q & 1;
                        t[q] = *(const u32x2*)(out + (size_t)(row0 + ai * HALF + m * 16) * ldc + col0 + bj * HALF + n * 16); }
#pragma unroll
                    for (int q = 0; q < 8; ++q) b[q] = (f32x4){bf_lo(t[q].x), bf_hi(t[q].x), bf_lo(t[q].y), bf_hi(t[q].y)};
                }
#pragma unroll
                for (int q = 0; q < 8; ++q) { const int m = 2 * mp + (q >> 2), bj = (q >> 1) & 1, n = q & 1; const f32x4 r = b[q] + acc[ai][bj][m][n] * scale;
                    *(u32x2*)(out + (size_t)(row0 + ai * HALF + m * 16) * ldc + col0 + bj * HALF + n * 16) = (u32x2){cvt_pk_bf16(r.x, r.y), cvt_pk_bf16(r.z, r.w)}; } }
    }
};
struct EpiF32 {
    static constexpr bool PERM = false, AFTER_DRAIN = false, MID = false; static constexpr int MID_TILES = 1; __device__ __forceinline__ void set_scale0() {}
    float* O; int ldc, nN;
    __device__ __forceinline__ void operator()(const f32x4 (&acc)[2][2][4][2], const Unit& u, int wr, int wc, int fr, int fq) const {
        const int row0 = u.pm * BM + wr * 64 + fr, col0 = (u.pn % nN) * BM + wc * 32 + 4 * fq;
#pragma unroll
        for (int ai = 0; ai < 2; ++ai)
#pragma unroll
            for (int m = 0; m < 4; ++m) { const size_t off = (size_t)(row0 + ai * HALF + m * 16) * ldc + col0;
#pragma unroll
                for (int bj = 0; bj < 2; ++bj)
#pragma unroll
                    for (int n = 0; n < 2; ++n) *(f32x4*)(O + off + bj * HALF + n * 16) = acc[ai][bj][m][n]; }
    }
};
#ifdef EMU_FP8_HID
__device__ __forceinline__ float Q8H(float x) { const int p = __builtin_amdgcn_cvt_pk_fp8_f32(x * 8.f, x * 8.f, 0, false); return __builtin_amdgcn_cvt_f32_fp8(p, 0) * 0.125f; }
#else
__device__ __forceinline__ float Q8H(float x) { return x; }
#endif
struct EpiSwiGLU {
    static constexpr bool PERM = true, AFTER_DRAIN = false, MID = false; static constexpr int MID_TILES = 1; __device__ __forceinline__ void set_scale0() {}
    bf16_t* H; int ldh; const float* rowscale; int nN; int rowmask = 0x7fffffff;
    __device__ __forceinline__ void operator()(const f32x4 (&acc)[2][2][4][2], const Unit& u, int wr, int wc, int fr, int fq) const {
        const int row0 = u.pm * BM + wr * 64 + fr, col0 = (u.pn % nN) * HALF + wc * 32 + 8 * fq;
        float scv[8];
#pragma unroll
        for (int q = 0; q < 8; ++q) scv[q] = rowscale ? rowscale[row0 + (q >> 2) * HALF + (q & 3) * 16] : 1.0f;
#pragma unroll
        for (int ai = 0; ai < 2; ++ai)
#pragma unroll
            for (int m = 0; m < 4; ++m) { const int row = row0 + ai * HALF + m * 16; const float sc = scv[ai * 4 + m];
                float h[8];
#pragma unroll
                for (int n = 0; n < 2; ++n)
#pragma unroll
                    for (int e = 0; e < 4; ++e) { const float g = acc[ai][0][m][n][e], up = acc[ai][1][m][n][e]; h[n * 4 + e] = Q8H(g * fast_sigmoid(g) * up * sc); }
                u32x4 w; w.x = cvt_pk_bf16(h[0], h[1]); w.y = cvt_pk_bf16(h[2], h[3]); w.z = cvt_pk_bf16(h[4], h[5]); w.w = cvt_pk_bf16(h[6], h[7]);
                PG8_STORE_OUT((u32x4*)(H + (size_t)(row & rowmask) * ldh + col0), w); }
    }
};
struct EpiScatter {
    static constexpr bool PERM = false, AFTER_DRAIN = false, MID = false; static constexpr int MID_TILES = 1; __device__ __forceinline__ void set_scale0() { scale = 0.f; }
    bf16_t* out; const int* tok; int nN; float scale;
    __device__ __forceinline__ void operator()(const f32x4 (&acc)[2][2][4][2], const Unit& u, int wr, int wc, int fr, int fq) const {
        const int row0 = u.pm * BM + wr * 64 + fr, col0 = (u.pn % nN) * BM + wc * 32 + 4 * fq;
        int tk[8];
#pragma unroll
        for (int q = 0; q < 8; ++q) tk[q] = tok[row0 + (q >> 2) * HALF + (q & 3) * 16];
#pragma unroll
        for (int ai = 0; ai < 2; ++ai)
#pragma unroll
            for (int mp = 0; mp < 2; ++mp) {
                u32x2 b[8];
#pragma unroll
                for (int q = 0; q < 8; ++q) { const int m = 2 * mp + (q >> 2), bj = (q >> 1) & 1, n = q & 1; const int t = tk[ai * 4 + m];
                    b[q] = *(const u32x2*)(out + (size_t)(t < 0 ? 0 : t) * 1024 + col0 + bj * HALF + n * 16); }
#pragma unroll
                for (int q = 0; q < 8; ++q) { const int m = 2 * mp + (q >> 2), bj = (q >> 1) & 1, n = q & 1; const int t = tk[ai * 4 + m];
                    if (t >= 0) { const f32x4 r = (f32x4){bf_lo(b[q].x), bf_hi(b[q].x), bf_lo(b[q].y), bf_hi(b[q].y)} + acc[ai][bj][m][n] * scale;
                        *(u32x2*)(out + (size_t)t * 1024 + col0 + bj * HALF + n * 16) = (u32x2){cvt_pk_bf16(r.x, r.y), cvt_pk_bf16(r.z, r.w)}; } } }
    }
};
struct GroupedOrder {
    StaticOrder so; const PG8_LAS int* tile_e; int nN;
    __device__ __forceinline__ bool next(int i, Unit& u) const { if (!so.next(i, u)) return false; u.pn += tile_e[u.pm] * nN; return true; }
    __device__ __forceinline__ void a_ready(const Unit&) const {}
    __device__ __forceinline__ void done(const Unit&) const {}
};
struct LimitOrder {
    StaticOrder so; int limit;
    __device__ __forceinline__ bool next(int i, Unit& u) const { if ((long)i * so.G + so.c >= limit) return false; return so.next(i, u); }
    __device__ __forceinline__ void a_ready(const Unit&) const {}
    __device__ __forceinline__ void done(const Unit&) const {}
};
struct GroupedLimit {
    LimitOrder lo; const PG8_LAS int* tile_e; int nN;
    __device__ __forceinline__ bool next(int i, Unit& u) const { if (!lo.next(i, u)) return false; u.pn += tile_e[u.pm] * nN; return true; }
    __device__ __forceinline__ void a_ready(const Unit&) const {}
    __device__ __forceinline__ void done(const Unit&) const {}
};
struct SingleOrder {
    Unit un;
    __device__ __forceinline__ bool next(int i, Unit& u) const { if (i != 0) return false; u = un; return true; }
    __device__ __forceinline__ void a_ready(const Unit&) const {}
    __device__ __forceinline__ void done(const Unit&) const {}
};
struct EpiTile {
    static constexpr bool PERM = false, AFTER_DRAIN = false, MID = false; static constexpr int MID_TILES = 1; __device__ __forceinline__ void set_scale0() {}
    float* O;
    __device__ __forceinline__ void operator()(const f32x4 (&acc)[2][2][4][2], const Unit&, int wr, int wc, int fr, int fq) const {
#pragma unroll
        for (int ai = 0; ai < 2; ++ai)
#pragma unroll
            for (int m = 0; m < 4; ++m)
#pragma unroll
                for (int bj = 0; bj < 2; ++bj)
#pragma unroll
                    for (int n = 0; n < 2; ++n) *(f32x4*)(O + (size_t)(wr * 64 + fr + ai * HALF + m * 16) * 256 + wc * 32 + 4 * fq + bj * HALF + n * 16) = acc[ai][bj][m][n];
    }
};
struct OffsetOrder {
    StaticOrder so; int pn_off;
    __device__ __forceinline__ bool next(int i, Unit& u) const { if (!so.next(i, u)) return false; u.pn += pn_off; return true; }
    __device__ __forceinline__ void a_ready(const Unit&) const {}
    __device__ __forceinline__ void done(const Unit&) const {}
};
struct ProbeOrder {
    StaticOrder so; int pm_mask;
    __device__ __forceinline__ bool next(int i, Unit& u) const { if (!so.next(i, u)) return false; u.pm &= pm_mask; return true; }
    __device__ __forceinline__ void a_ready(const Unit&) const {}
    __device__ __forceinline__ void done(const Unit&) const {}
};
struct MergeOrder {
    StaticOrder so; int nmt;
    __device__ __forceinline__ bool next(int i, Unit& u) const { const int b = i % 3; if (!so.next(i / 3, u)) return false; u.pm += b * nmt; u.pn += b * 4; return true; }
    __device__ __forceinline__ void a_ready(const Unit&) const {}
    __device__ __forceinline__ void done(const Unit&) const {}
};
template <class Epi, class Sched, bool ALIGN_EPI = false, bool SP2 = false, bool GATHER = false>
__device__ __forceinline__ void gemm_phase(PG8_LAS unsigned char* lds, const Gemm g, const Sched& S, const Epi& E) {
    const int tid = g.zv  , wid = __builtin_amdgcn_readfirstlane(tid >> 6), lane = tid & 63, wr = wid >> 2, wc = wid & 3, fr = lane & 15, fq = lane >> 4;
    const int K = g.K, nt = K / BK;
    unsigned voffA[2], voffB[2]; int gR = 0, gC = 0;
#pragma unroll
    for (int i = 0; i < 2; ++i) { int R, C; stage_rc(tid * 16 + i * 8192, R, C); const int Rb = Epi::PERM ? ((R & ~31) + perm32(R & 31)) : R;
        const int LD = g.ld ? g.ld : K;
        const int pitch = g.tiled ? BK : LD;
        voffA[i] = (unsigned)(R * pitch + C) * 2u; voffB[i] = (unsigned)(Rb * pitch + C) * 2u; if (i == 0) { gR = R; gC = C; } }
    const size_t kstep = g.tiled ? (size_t)(BM * BK * 2) : (size_t)(BK * 2);
    const size_t hstep = g.tiled ? (size_t)(HALF * BK * 2) : (size_t)HALF * (g.ld ? g.ld : K) * 2;
    const size_t tstep = (size_t)BM * (g.ld ? g.ld : K) * 2; const size_t tstepA = GATHER ? 0 : tstep, hstepA = GATHER ? 0 : hstep;
    const unsigned ldsw = (unsigned)wid * 1024u;
    const int aoff = lds_byte(wr * 64 + fr, fq * 8), boff = lds_byte(wc * 32 + fr, fq * 8);
#define PG8_SA(b, h) (((b) * 2 + (h)) * HTB)
#define PG8_SB(b, h) ((4 + (b) * 2 + (h)) * HTB)
#define PG8_STAGE(bufoff, gbase, voff) do { _Pragma("unroll") for (int _i = 0; _i < 2; ++_i) \
        __builtin_amdgcn_global_load_lds((const unsigned*)((const char*)(gbase) + (voff)[_i]), (PG8_LAS unsigned*)(lds + (bufoff) + ldsw + _i * 8192), 16, 0, ((bufoff) < 4 * HTB) ? PG8_AUX_A : PG8_AUX_B); } while (0)
#define PG8_LDA(dst, b, h) do { _Pragma("unroll") for (int m = 0; m < 4; ++m) _Pragma("unroll") for (int k = 0; k < 2; ++k) dst[m][k] = *(const PG8_LAS bf16x8*)(lds + PG8_SA(b, h) + aoff + m * 2048 + k * 1024); } while (0)
#define PG8_LDB(dst, b, h) do { _Pragma("unroll") for (int n = 0; n < 2; ++n) _Pragma("unroll") for (int k = 0; k < 2; ++k) dst[n][k] = *(const PG8_LAS bf16x8*)(lds + PG8_SB(b, h) + boff + n * 2048 + k * 1024); } while (0)
#define PG8_MMA(ai, bj, At, Bt) do { __builtin_amdgcn_s_setprio(1); _Pragma("unroll") for (int m = 0; m < 4; ++m) _Pragma("unroll") for (int n = 0; n < 2; ++n) _Pragma("unroll") for (int k = 0; k < 2; ++k) \
        acc[ai][bj][m][n] = __builtin_amdgcn_mfma_f32_16x16x32_bf16(Bt[n][k], At[m][k], acc[ai][bj][m][n], 0, 0, 0); __builtin_amdgcn_s_setprio(0); } while (0)
#define PG8_WAIT_V(n) asm volatile("s_waitcnt vmcnt(" #n ")" ::: "memory")
#define PG8_WAIT_L(n) asm volatile("s_waitcnt lgkmcnt(" #n ")" ::: "memory")
#define PG8_BAR __builtin_amdgcn_s_barrier()
#define PG8_SCHED __builtin_amdgcn_sched_barrier(0)
    Unit cur, nxt; int ui = 0;
    if (!S.next(0, cur)) return;
    f32x4 acc[2][2][4][2];
#pragma unroll
    for (int a = 0; a < 2; ++a)
#pragma unroll
        for (int b = 0; b < 2; ++b)
#pragma unroll
            for (int m = 0; m < 4; ++m)
#pragma unroll
                for (int n = 0; n < 2; ++n) acc[a][b][m][n] = (f32x4){0.f, 0.f, 0.f, 0.f};
    bf16x8 At[4][2], B0[2][2], B1[2][2];
    const char* cA = (const char*)g.A + (size_t)cur.pm * tstepA; const char* cB = (const char*)g.Bt + (size_t)cur.pn * tstep;
    const int rot = g.rot; const size_t rofs = (size_t)rot * kstep; const char* pA = cA + rofs; const char* pB = cB + rofs;
#define PG8_KT(x) ((size_t)(((x) + rot >= nt) ? (x) + rot - nt : (x) + rot))
    unsigned vC[2][2], vN[2][2];
#define PG8_GIDX(u, vv) do { _Pragma("unroll") for (int h_ = 0; h_ < 2; ++h_) _Pragma("unroll") for (int i_ = 0; i_ < 2; ++i_) { \
        if constexpr (GATHER) { const int t_ = g.gidx[(u).pm * BM + h_ * HALF + gR + 64 * i_]; vv[h_][i_] = (unsigned)((t_ < 0 ? 0 : t_) * (g.ld ? g.ld : K) + gC) * 2u; } else vv[h_][i_] = voffA[i_]; } } while (0)
    PG8_GIDX(cur, vC);
    S.a_ready(cur);
    if constexpr (SP2) {
        PG8_STAGE(PG8_SB(0, 0), pB, voffB); PG8_STAGE(PG8_SB(0, 1), pB + hstep, voffB); PG8_STAGE(PG8_SA(0, 0), pA, vC[0]); PG8_STAGE(PG8_SA(0, 1), pA + hstepA, vC[1]);
        if (wr == 1) PG8_BAR;
        PG8_WAIT_V(2); PG8_BAR;
        PG8_STAGE(PG8_SB(1, 0), pB + kstep, voffB); PG8_STAGE(PG8_SA(1, 0), pA + kstep, vC[0]); PG8_STAGE(PG8_SB(1, 1), pB + hstep + kstep, voffB);
        PG8_WAIT_V(6); PG8_BAR;
    } else {
        PG8_STAGE(PG8_SB(0, 0), pB, voffB); PG8_STAGE(PG8_SA(0, 0), pA, vC[0]); PG8_STAGE(PG8_SB(0, 1), pB + hstep, voffB); PG8_STAGE(PG8_SA(0, 1), pA + hstepA, vC[1]);
        if (wr == 1) PG8_BAR;
        PG8_WAIT_V(4); PG8_BAR;
        PG8_STAGE(PG8_SB(1, 0), pB + kstep, voffB); PG8_STAGE(PG8_SA(1, 0), pA + kstep, vC[0]); PG8_STAGE(PG8_SB(1, 1), pB + hstep + kstep, voffB);
        PG8_WAIT_V(6); PG8_BAR;
    }
    for (;;) {
        const bool has_next = S.next(ui + 1, nxt);
        if (has_next) PG8_GIDX(nxt, vN); else { vN[0][0] = vC[0][0]; vN[0][1] = vC[0][1]; vN[1][0] = vC[1][0]; vN[1][1] = vC[1][1]; }
        const char* nA = has_next ? (const char*)g.A + (size_t)nxt.pm * tstepA : cA; const char* nB = has_next ? (const char*)g.Bt + (size_t)nxt.pn * tstep : cB;
        for (int t = 0; t < nt; t += 2) {
            if constexpr (Epi::MID) { if (t != 0 && (t & (Epi::MID_TILES - 1)) == 0) E.mid(acc, cur, t / Epi::MID_TILES, wr, wc, fr, fq); }
            const bool last = (t == nt - 2);
            const char* a1 = cA + PG8_KT(t + 1) * kstep;
            const char* a2 = last ? nA + rofs : cA + PG8_KT(t + 2) * kstep; const char* b2 = last ? nB + rofs : cB + PG8_KT(t + 2) * kstep;
            const char* a3 = a2 + kstep; const char* b3 = b2 + kstep;
            if (last && has_next) S.a_ready(nxt);
            const unsigned v2h0[2] = {last ? vN[0][0] : vC[0][0], last ? vN[0][1] : vC[0][1]}, v2h1[2] = {last ? vN[1][0] : vC[1][0], last ? vN[1][1] : vC[1][1]};
            if constexpr (SP2) {
            PG8_LDB(B0, 0, 0); PG8_LDB(B1, 0, 1); PG8_SCHED; PG8_LDA(At, 0, 0); PG8_STAGE(PG8_SA(1, 1), a1 + hstepA, vC[1]);
            PG8_WAIT_V(8); PG8_WAIT_L(0); PG8_BAR; PG8_MMA(0, 0, At, B0); PG8_MMA(0, 1, At, B1); PG8_BAR; PG8_SCHED;
            PG8_LDA(At, 0, 1); PG8_STAGE(PG8_SB(0, 0), b2, voffB); PG8_STAGE(PG8_SB(0, 1), b2 + hstep, voffB); PG8_STAGE(PG8_SA(0, 0), a2, v2h0);
            PG8_WAIT_V(8); PG8_WAIT_L(0); PG8_BAR; PG8_MMA(1, 0, At, B0); PG8_MMA(1, 1, At, B1); PG8_BAR; PG8_SCHED;
            PG8_LDB(B0, 1, 0); PG8_LDB(B1, 1, 1); PG8_SCHED; PG8_LDA(At, 1, 0); PG8_STAGE(PG8_SA(0, 1), a2 + hstepA, v2h1);
            PG8_WAIT_V(8); PG8_WAIT_L(0); PG8_BAR; PG8_MMA(0, 0, At, B0); PG8_MMA(0, 1, At, B1); PG8_BAR; PG8_SCHED;
            PG8_LDA(At, 1, 1); PG8_STAGE(PG8_SB(1, 0), b3, voffB); PG8_STAGE(PG8_SB(1, 1), b3 + hstep, voffB); PG8_STAGE(PG8_SA(1, 0), a3, v2h0);
            PG8_WAIT_V(8); PG8_WAIT_L(0); PG8_BAR; PG8_MMA(1, 0, At, B0); PG8_MMA(1, 1, At, B1); PG8_BAR; PG8_SCHED;
            } else {
            PG8_LDB(B0, 0, 0); PG8_SCHED; PG8_LDA(At, 0, 0); PG8_STAGE(PG8_SA(1, 1), a1 + hstepA, vC[1]);
            PG8_WAIT_L(8); PG8_BAR; PG8_WAIT_L(0); PG8_MMA(0, 0, At, B0); PG8_BAR; PG8_SCHED;
            PG8_LDB(B1, 0, 1); PG8_STAGE(PG8_SB(0, 0), b2, voffB);
            PG8_BAR; PG8_WAIT_L(0); PG8_MMA(0, 1, At, B1); PG8_BAR;
            PG8_LDA(At, 0, 1); PG8_STAGE(PG8_SA(0, 0), a2, v2h0);
            PG8_BAR; PG8_WAIT_L(0); PG8_MMA(1, 0, At, B0); PG8_BAR; PG8_SCHED;
            PG8_STAGE(PG8_SB(0, 1), b2 + hstep, voffB);
            PG8_WAIT_V(6); PG8_BAR; PG8_MMA(1, 1, At, B1); PG8_BAR;
            PG8_LDB(B0, 1, 0); PG8_SCHED; PG8_LDA(At, 1, 0); PG8_STAGE(PG8_SA(0, 1), a2 + hstepA, v2h1);
            PG8_WAIT_L(8); PG8_BAR; PG8_WAIT_L(0); PG8_MMA(0, 0, At, B0); PG8_BAR; PG8_SCHED;
            PG8_LDB(B1, 1, 1); PG8_STAGE(PG8_SB(1, 0), b3, voffB);
            PG8_BAR; PG8_WAIT_L(0); PG8_MMA(0, 1, At, B1); PG8_BAR;
            PG8_LDA(At, 1, 1); PG8_STAGE(PG8_SA(1, 0), a3, v2h0);
            PG8_BAR; PG8_WAIT_L(0); PG8_MMA(1, 0, At, B0); PG8_BAR; PG8_SCHED;
            PG8_STAGE(PG8_SB(1, 1), b3 + hstep, voffB);
            PG8_WAIT_V(6); PG8_BAR; PG8_MMA(1, 1, At, B1); PG8_BAR;
            }
        }
        if constexpr (ALIGN_EPI) { if (wr == 0) PG8_BAR; }
        if constexpr (!Epi::AFTER_DRAIN) { E(acc, cur, wr, wc, fr, fq); S.done(cur); }
        if (!has_next) break;
#pragma unroll
        for (int a = 0; a < 2; ++a)
#pragma unroll
            for (int b = 0; b < 2; ++b)
#pragma unroll
                for (int m = 0; m < 4; ++m)
#pragma unroll
                    for (int n = 0; n < 2; ++n) acc[a][b][m][n] = (f32x4){0.f, 0.f, 0.f, 0.f};
        cur = nxt; cA = nA; cB = nB; ++ui; vC[0][0] = vN[0][0]; vC[0][1] = vN[0][1]; vC[1][0] = vN[1][0]; vC[1][1] = vN[1][1];
        if constexpr (ALIGN_EPI) { if (wr == 1) PG8_BAR; }
    }
    PG8_WAIT_V(0);
    if constexpr (!ALIGN_EPI) { if (wr == 0) PG8_BAR; }
    PG8_BAR;
    if constexpr (Epi::AFTER_DRAIN) { E.fused(acc, cur, wr, wc, fr, fq, lds, wid, lane); S.done(cur); }
#undef PG8_KT
#undef PG8_SA
#undef PG8_SB
#undef PG8_STAGE
#undef PG8_LDA
#undef PG8_LDB
#undef PG8_MMA
#undef PG8_WAIT_V
#undef PG8_WAIT_L
#undef PG8_BAR
#undef PG8_SCHED
}
}

constexpr int NWAVES = 8;
constexpr int DM = 1024, BATCH = 16, SEQ = 4096, DEPTH = 4, MTOK = BATCH * SEQ;
constexpr int NCHUNK = 2, MC = MTOK / NCHUNK, BC = BATCH / NCHUNK;
constexpr int CIN = 5004, NPROJ = 5120, P1W = 2048, GWID = 3072;
constexpr int DFF = 2752, DFFP = 2816, NFF1 = 2 * DFFP;
constexpr int NEXP = 8, DFE = 3584, NMOE1 = 2 * DFE;
constexpr int SLOTS = MC + 2048;
constexpr float EPS = 1e-6f;
constexpr int C_U = 0, C_V = 256, C_SBQ = 512, C_SBK = 768, C_SBV = 1024, C_CQ = 1280, C_KCMP = 1536, C_VCMP = 1600, C_KSLC = 1664, C_VSLC = 1728, C_KWIN = 1792, C_VWIN = 1856, C_CG = 1920;

constexpr size_t MiB = 1u << 20;
constexpr size_t WS_CTL = 0, CTL_ZERO_BYTES = 1 * MiB;
constexpr size_t WS_ROPE = 1 * MiB;
constexpr size_t WS_BIAS1 = 1 * MiB + 512 * 1024;
constexpr size_t WS_WIN = 2 * MiB;
constexpr size_t WS_WBR = 12 * MiB;
constexpr size_t WS_WOUT = 14 * MiB;
constexpr size_t WS_WC1 = 16 * MiB;
constexpr size_t WS_WF1 = 18 * MiB;
constexpr size_t WS_WF2 = 130 * MiB;
constexpr size_t WS_HN = 186 * MiB;
constexpr size_t WS_SCR = 314 * MiB;
constexpr size_t WS_P1 = WS_SCR;
constexpr size_t WS_G = WS_P1 + 128 * MiB;
constexpr size_t WS_Y = WS_G + 192 * MiB;
constexpr size_t WS_MG = WS_Y + 48 * MiB;
constexpr size_t WS_KVC = WS_MG + 64 * MiB;
constexpr size_t WS_UL = WS_KVC + 8 * MiB;
constexpr size_t WS_KC = WS_UL + 8 * MiB;
constexpr size_t WS_VT = WS_KC + 1 * MiB;
constexpr size_t WS_KCT = WS_VT + 24 * MiB;
constexpr size_t WS_MIX_END = WS_KCT + 1 * MiB;
constexpr size_t WS_HID = WS_SCR;
constexpr size_t WS_ROUTE = WS_SCR;
constexpr size_t WS_TOKMAP = WS_SCR + 1 * MiB;
constexpr size_t WS_WSLOT = WS_SCR + 2 * MiB;
constexpr size_t WS_CNT128 = WS_SCR + 3 * MiB;
constexpr size_t WS_XG = WS_SCR + 4 * MiB;
constexpr size_t WS_HIDM = WS_XG + 68 * MiB;
constexpr size_t WS_H = 800 * MiB;
constexpr size_t WS_END = 928 * MiB;
static_assert(WS_MIX_END <= WS_H && WS_HID + (size_t)MTOK * DFFP * 2 <= WS_H && WS_HIDM + (size_t)SLOTS * DFE * 2 <= WS_H, "d_ws map");
static_assert(WS_WF1 + (size_t)NEXP * NMOE1 * DM * 2 <= WS_WF2 && WS_WF2 + (size_t)NEXP * DM * DFE * 2 <= WS_HN, "weight map");
static_assert((size_t)4 * SLOTS * 4 <= 1 * MiB, "tokmap");
constexpr int CW_BAR = 4096;
constexpr int CW_CNT = 131072;
constexpr int CW_CUR = 131072 + 256;
constexpr int MAX_BAR_REGIONS = 32;
constexpr int RING_OFF = 0, RING_BYTES = 131072;
constexpr int LDSCTL_OFF = RING_BYTES, MISC_OFF = LDSCTL_OFF + 320;
constexpr int TAB_OFF = LDSCTL_OFF + 1024;
constexpr int LDS_BYTES = 147456;

#define GAS __attribute__((address_space(1)))
#define LAS __attribute__((address_space(3)))
typedef unsigned short bf16;
typedef unsigned v4u __attribute__((ext_vector_type(4)));
typedef unsigned v2u __attribute__((ext_vector_type(2)));
typedef float f32x4 __attribute__((ext_vector_type(4)));
typedef int v4i __attribute__((ext_vector_type(4)));
typedef __bf16 bf16x2_t __attribute__((ext_vector_type(2)));
#define LDS_WAIT() asm volatile("s_waitcnt lgkmcnt(0)" ::: "memory")
#define VM_WAIT() asm volatile("s_waitcnt vmcnt(0)" ::: "memory")
__device__ __forceinline__ unsigned f2bf(float f) { unsigned u = __builtin_bit_cast(unsigned, f); return (u + 0x7fffu + ((u >> 16) & 1u)) >> 16; }
__device__ __forceinline__ unsigned pk2(float lo, float hi) { return f2bf(lo) | (f2bf(hi) << 16); }
__device__ __forceinline__ float bflo(unsigned u) { return __builtin_bit_cast(float, u << 16); }
__device__ __forceinline__ float bfhi(unsigned u) { return __builtin_bit_cast(float, u & 0xffff0000u); }
__device__ __forceinline__ float bf1(bf16 h) { return __builtin_bit_cast(float, (unsigned)h << 16); }
__device__ __forceinline__ float dot2bf(unsigned a, unsigned b, float c) { return __builtin_amdgcn_fdot2_f32_bf16(__builtin_bit_cast(bf16x2_t, a), __builtin_bit_cast(bf16x2_t, b), c, false); }
#ifdef EMU_FP8
__device__ __forceinline__ float q8r(float x, float s) { const int p = __builtin_amdgcn_cvt_pk_fp8_f32(x * s, x * s, 0, false); return __builtin_amdgcn_cvt_f32_fp8(p, 0) * (1.0f / s); }
#else
__device__ __forceinline__ float q8r(float x, float) { return x; }
#endif
__device__ __forceinline__ float fexp(float x) { return __builtin_amdgcn_exp2f(1.4426950408889634f * x); }
template <int X> __device__ __forceinline__ float swz_xor(float v) { return __builtin_bit_cast(float, __builtin_amdgcn_ds_swizzle(__builtin_bit_cast(int, v), (X << 10) | 0x1f)); }
__device__ __forceinline__ float wave_sum(float v, int lane) {
#pragma unroll
    for (int o = 1; o < 64; o <<= 1) v += __builtin_bit_cast(float, __builtin_amdgcn_ds_bpermute((lane ^ o) << 2, __builtin_bit_cast(int, v)));
    return v;
}
__device__ __forceinline__ float rdlane(float v, int l) { return __builtin_bit_cast(float, __builtin_amdgcn_readlane(__builtin_bit_cast(int, v), l)); }
__device__ __forceinline__ int bperm(int srclane, int v) { return __builtin_amdgcn_ds_bpermute(srclane << 2, v); }
__constant__ double ROPE_INVF[8] = {1.0, 0.19392274474868576, 0.037606030930863933, 0.0072926647372171093, 0.0014142135623730950, 0.00027424817567620730, 5.3182958969449883e-05, 1.0313385377212460e-05};
#define XB_TMO      128
#define XB_XCNT(j)  (256  + 64 * (j))
#define XB_XSUB(j)  (1280 + 64 * (j))
#define XB_XGEN(j)  (2304 + 64 * (j))
#define XB_TOP      3328
#define XB_TOPGEN   3392
#define XCD_BAR_WORDS 3456
#define XB_SPIN_CAP (1u << 18)

__device__ __forceinline__ unsigned xb_ld(unsigned* p)              { return __hip_atomic_load(p, __ATOMIC_RELAXED, __HIP_MEMORY_SCOPE_AGENT); }
__device__ __forceinline__ unsigned xb_add(unsigned* p, unsigned v) { return __hip_atomic_fetch_add(p, v, __ATOMIC_RELAXED, __HIP_MEMORY_SCOPE_AGENT); }
__device__ __forceinline__ unsigned xb_xcc_id() { return (unsigned)__builtin_amdgcn_s_getreg((3 << 11) | 20) & 0xFu; }
#define XB_SPIN(cond, bar) do { unsigned _sp = 0; while (cond) { __builtin_amdgcn_s_sleep(1); \
    if ((++_sp & 255u) == 0u) { if (xb_ld(&(bar)[XB_TMO])) break; if (_sp > XB_SPIN_CAP) { atomicAdd(&(bar)[XB_TMO], 1u); break; } } } } while (0)

__device__ __forceinline__ bool xb_thread0_w(unsigned w, unsigned z) { return w == 0u && __builtin_amdgcn_mbcnt_hi(~0u, __builtin_amdgcn_mbcnt_lo(~0u, z)) == 0u; }
struct XcdBarrier {
    unsigned* bar; unsigned x; unsigned w, z;
    volatile LAS unsigned* st;
};

__device__ __forceinline__ XcdBarrier xcd_barrier_post(unsigned* bar, volatile LAS unsigned* st) {
    XcdBarrier b; b.bar = bar; b.x = xb_xcc_id(); b.st = st; b.w = (unsigned)__builtin_amdgcn_readfirstlane((int)(threadIdx.x >> 6)); b.z = 0u;
    if (xb_thread0_w(b.w, b.z)) (void)xb_add(&bar[XB_XCNT(b.x)], 1u);
    return b;
}
__device__ __forceinline__ void xcd_barrier_complete(unsigned* bar, unsigned x, unsigned& nloc, unsigned& nx) {
    const unsigned G = gridDim.x * gridDim.y * gridDim.z;
    unsigned sum, cnt, mine, sp = 0u;
    for (;;) {
        sum = 0u; cnt = 0u; mine = 0u;
#pragma unroll
        for (unsigned j = 0; j < 16; ++j) { const unsigned c = xb_ld(&bar[XB_XCNT(j)]); sum += c; cnt += (c > 0u) ? 1u : 0u; mine = (j == x) ? c : mine; }
        if (sum == G) break;
        __builtin_amdgcn_s_sleep(1);
        if ((++sp & 255u) == 0u) { if (xb_ld(&bar[XB_TMO])) break; if (sp > XB_SPIN_CAP) { atomicAdd(&bar[XB_TMO], 1u); break; } }
    }
    nloc = mine > 0u ? mine : 1u; nx = cnt > 0u ? cnt : 1u;
}

__device__ __forceinline__ void xcd_barrier(const XcdBarrier& b) {
    asm volatile("s_waitcnt vmcnt(0)" ::: "memory");
    __syncthreads();
    if (xb_thread0_w(b.w, b.z)) {
        unsigned* bar = b.bar;
        __builtin_amdgcn_s_waitcnt(0);
        unsigned nloc = b.st[0], nx = b.st[1];
        if (nloc == 0u) { xcd_barrier_complete(bar, b.x, nloc, nx); b.st[0] = nloc; b.st[1] = nx; }
        const unsigned old = xb_add(&bar[XB_XSUB(b.x)], 1u);
        const unsigned gen = old / nloc;
        if (old + 1u == (gen + 1u) * nloc) {
            __builtin_amdgcn_fence(__ATOMIC_RELEASE, "agent");
            asm volatile("s_waitcnt vmcnt(0)" ::: "memory");
            const unsigned og = xb_add(&bar[XB_TOP], 1u);
            const unsigned tg = og / nx;
            if (og + 1u == (tg + 1u) * nx) xb_add(&bar[XB_TOPGEN], 1u);
            else XB_SPIN(xb_ld(&bar[XB_TOPGEN]) == tg, bar);
            __builtin_amdgcn_fence(__ATOMIC_ACQUIRE, "agent");
            xb_add(&bar[XB_XGEN(b.x)], 1u);
            asm volatile("s_waitcnt vmcnt(0)" ::: "memory");
        } else {
            XB_SPIN(xb_ld(&bar[XB_XGEN(b.x)]) == gen, bar);
            __builtin_amdgcn_fence(__ATOMIC_ACQUIRE, "agent");
            asm volatile("s_waitcnt vmcnt(0)" ::: "memory");
        }
    }
    __syncthreads();
}

struct Frame {
    LAS unsigned char* lds;
    unsigned* ctl;
    int tid, lane, wave, vcu, G, bx, zv, zs, rep;
    unsigned char* ws;
    const float* const* in;
    float* out;
};
#define WSP(T, off) ((T*)(F.ws + (off)))
__device__ __forceinline__ size_t toff(int row, int k, int K) { return (size_t)(row >> 8) * 256 * K + (size_t)(k >> 6) * (256 * 64) + (size_t)(row & 255) * 64 + (k & 63); }

#ifndef TILED_FFN1
#define TILED_FFN1 0
#endif
#ifndef Q8_W1
#define Q8_W1 0.f
#define Q8_W2 0.f
#define Q8_HN 0.f
#define Q8_HID 0.f
#endif
__device__ __forceinline__ int map_row(int kind, int off, int n) { return kind == 0 ? n + off : (kind == 1 ? (n < 1932 ? n : n + 116) : ((n >> 7) * 256 + (n & 127) + off)); }
__device__ __forceinline__ void tr_item(const float* W, int ldw, int N, int ks, int n0, bf16* WT, int ldt, int kd, int kind, int off, LAS unsigned char* scr, int lane, float q8s = 0.f, int tiled = 0) {
    const int nq = (lane & 15) * 4, kq = lane >> 4;
    f32x4 x[16];
#pragma unroll
    for (int i = 0; i < 16; ++i) x[i] = (n0 + nq < N) ? *(const f32x4*)(W + (size_t)(ks + 4 * i + kq) * ldw + n0 + nq) : (f32x4){0.f, 0.f, 0.f, 0.f};
#pragma unroll
    for (int i = 0; i < 16; ++i) { const int k = 4 * i + kq;
#pragma unroll
        for (int c = 0; c < 4; ++c) { float wv = x[i][c]; if (q8s > 0.f) wv = q8r(wv, q8s); *(LAS bf16*)(scr + (nq + c) * 136 + k * 2) = (bf16)f2bf(wv); } }
    LDS_WAIT(); asm volatile("" ::: "memory");
    if (n0 + lane < N) { const LAS v2u* s = (const LAS v2u*)(scr + lane * 136); const int mr = map_row(kind, off, n0 + lane); bf16* dst = tiled ? WT + toff(mr, kd, ldt) : WT + (size_t)mr * ldt + kd;
#pragma unroll
        for (int q = 0; q < 8; ++q) { const v2u a = s[2 * q], b = s[2 * q + 1]; *(v4u*)(dst + 8 * q) = (v4u){a.x, a.y, b.x, b.y}; } }
    LDS_WAIT(); asm volatile("" ::: "memory");
}
__device__ __forceinline__ void conv(Frame& F, int& tb, const float* W, size_t sW, int nb, int ldw, int N, int ks0, int K, bf16* WT, size_t sWT, int ldt, int kd0, int kind, int off, float q8s = 0.f, int tiled = 0) {
    LAS unsigned char* scr = F.lds + RING_OFF + F.wave * 16384;
    const int gw = F.vcu * NWAVES + F.wave, NGW = F.G * NWAVES;
    const int nblk = (N + 63) / 64, per = (K / 64) * nblk, total = per * nb;
    int first = gw - tb; if (first < 0) first += NGW;
    for (int it = first; it < total; it += NGW) { const int b = it / per, r = it % per, kb = r / nblk, nbk = r % nblk;
        tr_item(W + (size_t)b * sW, ldw, N, ks0 + 64 * kb, 64 * nbk, WT + (size_t)b * sWT, ldt, kd0 + 64 * kb, kind, off, scr, F.lane, q8s, tiled); }
    tb = (tb + total) % NGW;
}
__device__ __forceinline__ void zero_block(Frame& F, bf16* WT, int ldt, int r0, int rows, int c0, int cols, int tiled = 0) {
    const int gt = (F.vcu * NWAVES + F.wave) * 64 + F.lane, NT = F.G * NWAVES * 64, cpr = cols / 8;
    for (int i = gt; i < rows * cpr; i += NT) { const int r = i / cpr, c = i % cpr; const unsigned z = (unsigned)F.zv; *(v4u*)(tiled ? WT + toff(r0 + r, c0 + 8 * c, ldt) : WT + (size_t)(r0 + r) * ldt + c0 + 8 * c) = (v4u){z, z, z, z}; }
}
__device__ __forceinline__ void p_convert(Frame& F, int layer) {
    const int j = layer >> 1; int tb = 0;
    conv(F, tb, F.in[2] + (size_t)layer * DM * CIN, 0, 1, CIN, CIN, 0, DM, WSP(bf16, WS_WIN), 0, DM, 0, 1, 0);
    zero_block(F, WSP(bf16, WS_WIN), DM, 1932, 116, 0, DM);
    conv(F, tb, F.in[9] + (size_t)layer * 3 * 256 * DM, (size_t)256 * DM, 3, DM, DM, 0, 256, WSP(bf16, WS_WBR), (size_t)DM * 256, 256, 0, 0, 0);
    conv(F, tb, F.in[10] + (size_t)layer * DM * DM, 0, 1, DM, DM, 0, DM, WSP(bf16, WS_WOUT), 0, DM, 0, 0, 0);
    conv(F, tb, F.in[7] + (size_t)layer * 2 * 2048 * 256, (size_t)2048 * 256, 2, 256, 256, 0, 1024, WSP(bf16, WS_WC1), (size_t)512 * 1024, 1024, 0, 0, 0);
    conv(F, tb, F.in[7] + (size_t)layer * 2 * 2048 * 256, (size_t)2048 * 256, 2, 256, 256, 1024, 1024, WSP(bf16, WS_WC1), (size_t)512 * 1024, 1024, 0, 0, 256);
    if ((layer & 1) == 0) {
        conv(F, tb, F.in[12] + (size_t)j * DM * DFF, 0, 1, DFF, DFF, 0, DM, WSP(bf16, WS_WF1), 0, DM, 0, 2, 0, Q8_W1, TILED_FFN1);
        conv(F, tb, F.in[13] + (size_t)j * DM * DFF, 0, 1, DFF, DFF, 0, DM, WSP(bf16, WS_WF1), 0, DM, 0, 2, 128, Q8_W1, TILED_FFN1);
        zero_block(F, WSP(bf16, WS_WF1), DM, 21 * 256 + 64, 64, 0, DM, TILED_FFN1);
        zero_block(F, WSP(bf16, WS_WF1), DM, 21 * 256 + 128 + 64, 64, 0, DM, TILED_FFN1);
        conv(F, tb, F.in[14] + (size_t)j * DFF * DM, 0, 1, DM, DM, 0, DFF, WSP(bf16, WS_WF2), 0, DFFP, 0, 0, 0, Q8_W2);
        zero_block(F, WSP(bf16, WS_WF2), DFFP, 0, DM, DFF, DFFP - DFF);
    } else {
        conv(F, tb, F.in[16] + (size_t)j * NEXP * DM * DFE, (size_t)DM * DFE, NEXP, DFE, DFE, 0, DM, WSP(bf16, WS_WF1), (size_t)NMOE1 * DM, DM, 0, 2, 0, Q8_W1);
        conv(F, tb, F.in[17] + (size_t)j * NEXP * DM * DFE, (size_t)DM * DFE, NEXP, DFE, DFE, 0, DM, WSP(bf16, WS_WF1), (size_t)NMOE1 * DM, DM, 0, 2, 128, Q8_W1);
        conv(F, tb, F.in[18] + (size_t)j * NEXP * DFE * DM, (size_t)DFE * DM, NEXP, DM, DM, 0, DFE, WSP(bf16, WS_WF2), (size_t)DM * DFE, DFE, 0, 0, 0, Q8_W2);
    }
    if (F.bx < 8) {
        __syncthreads();
        const int kv = F.bx >> 2, jj = (F.bx & 3) * 64 + F.lane;
        const float* pos = F.in[6] + (size_t)(layer * 2 + kv) * 2048; const float* w1 = F.in[7] + (size_t)(layer * 2 + kv) * 2048 * 256;
        float a = 0.f;
        float a1 = 0.f, a2 = 0.f, a3 = 0.f;
#pragma unroll 8
        for (int k = 0; k < 256; k += 4) { const int kk = F.wave * 256 + k;
            a += pos[kk] * w1[(size_t)kk * 256 + jj]; a1 += pos[kk + 1] * w1[(size_t)(kk + 1) * 256 + jj]; a2 += pos[kk + 2] * w1[(size_t)(kk + 2) * 256 + jj]; a3 += pos[kk + 3] * w1[(size_t)(kk + 3) * 256 + jj]; }
        a = (a + a1) + (a2 + a3);
        LAS float* red = (LAS float*)(F.lds + RING_OFF);
        red[F.wave * 64 + F.lane] = a;
        __syncthreads();
        if (F.wave == 0) { float s = 0.f;
#pragma unroll
            for (int w = 0; w < 8; ++w) s += red[w * 64 + F.lane];
            WSP(float, WS_BIAS1)[kv * 256 + jj] = s; }
        __syncthreads();
    }
    if (layer == 0) {
        const int gt = (F.vcu * NWAVES + F.wave) * 64 + F.lane, NT = F.G * NWAVES * 64;
        for (int idx = gt; idx < SEQ * 8; idx += NT) { const int pos = idx >> 3, i = idx & 7;
            const double invf = ROPE_INVF[i];
            double rev = (double)pos * invf * 0.15915494309189535; rev -= __builtin_floor(rev);
            WSP(float, WS_ROPE)[idx] = __builtin_amdgcn_cosf((float)rev); WSP(float, WS_ROPE)[SEQ * 8 + idx] = __builtin_amdgcn_sinf((float)rev); }
    }
}

template <bool S16> __device__ __forceinline__ f32x4 ld_row4(const void* src, size_t m, int lane, int jx) {
    if (S16) { const v2u t = ((const v2u*)((const bf16*)src + m * DM) + lane)[64 * jx]; return (f32x4){bflo(t.x), bfhi(t.x), bflo(t.y), bfhi(t.y)}; }
    return ((const f32x4*)((const float*)src + m * DM) + lane)[64 * jx];
}
template <int MODE, bool S16> __device__ __forceinline__ void p_norm(Frame& F, const void* src, const float* g, const float* rw, int jmoe, float q8s = 0.f, int tiled = 0) {
    const int gw = F.vcu * NWAVES + F.wave, NGW = F.G * NWAVES, lane = F.lane;
    LAS int* hist = (LAS int*)(F.lds + TAB_OFF) + 192;
    if (MODE == 1) {
        if (F.tid < 16) hist[F.tid] = 0;
        const int gt = gw * 64 + lane, NT = NGW * 64; int* tm = WSP(int, WS_TOKMAP);
        for (int i = gt; i < 4 * SLOTS; i += NT) tm[i] = -1;
        for (int i = F.tid; i < DM * NEXP / 4; i += NWAVES * 64) { const int c = i >> 1, hf = i & 1;
            *(LAS f32x4*)(F.lds + RING_OFF + (((((c >> 8) * 4 + (c & 3)) * 2 + hf) * 64 + ((c & 255) >> 2)) * 16)) = ((const f32x4*)rw)[i]; }
        if (F.tid < DM / 4) *(LAS f32x4*)(F.lds + RING_OFF + 32768 + 16 * F.tid) = ((const f32x4*)g)[F.tid];
        __syncthreads();
    }
    f32x4 gv[4];
    if (MODE != 1) {
#pragma unroll
        for (int jx = 0; jx < 4; ++jx) gv[jx] = ((const f32x4*)g)[lane + 64 * jx]; }
    constexpr int ROWS = (MODE == 1) ? 2 : 4;
    const int nit = (MODE == 1) ? ((MTOK / 128 - F.bx + F.G - 1) / F.G) * (16 / ROWS) : (MTOK - gw + ROWS * NGW - 1) / (ROWS * NGW);
    for (int itx = 0; itx < nit; ++itx) {
        const int chk = (MODE == 1) ? F.bx + (itx / (16 / ROWS)) * F.G : 0;
        const int m0 = (MODE == 1) ? chk * 128 + (itx % (16 / ROWS)) * (NWAVES * ROWS) + F.wave * ROWS : gw + itx * ROWS * NGW;
        const int mstep = (MODE == 1) ? 1 : NGW;
        f32x4 v[ROWS][4]; float ss[ROWS];
#pragma unroll
        for (int u = 0; u < ROWS; ++u) { const int m = m0 + u * mstep;
#pragma unroll
            for (int jx = 0; jx < 4; ++jx) v[u][jx] = ld_row4<S16>(src, (size_t)(m < MTOK ? m : m0), lane, jx); }
#pragma unroll
        for (int u = 0; u < ROWS; ++u) { float s = 0.f;
#pragma unroll
            for (int jx = 0; jx < 4; ++jx) s += (v[u][jx].x * v[u][jx].x + v[u][jx].y * v[u][jx].y) + (v[u][jx].z * v[u][jx].z + v[u][jx].w * v[u][jx].w);
            ss[u] = s; }
#pragma unroll
        for (int o = 1; o < 64; o <<= 1) {
#pragma unroll
            for (int u = 0; u < ROWS; ++u) ss[u] += __builtin_bit_cast(float, __builtin_amdgcn_ds_bpermute((lane ^ o) << 2, __builtin_bit_cast(int, ss[u]))); }
        float lgall[MODE == 1 ? ROWS : 1][8];
        if (MODE == 1) {
            float rs[ROWS];
#pragma unroll
            for (int u = 0; u < ROWS; ++u) { rs[u] = 1.0f / sqrtf(ss[u] * (1.f / DM) + EPS);
#pragma unroll
                for (int e = 0; e < 8; ++e) lgall[u][e] = 0.f; }
#pragma unroll
            for (int jx = 0; jx < 4; ++jx) { const f32x4 gl = *(const LAS f32x4*)(F.lds + RING_OFF + 32768 + 16 * (lane + 64 * jx));
#pragma unroll
                for (int u = 0; u < ROWS; ++u) v[u][jx] = v[u][jx] * rs[u] * gl; }
#pragma unroll
            for (int jx = 0; jx < 4; ++jx) { const LAS f32x4* wr = (const LAS f32x4*)(F.lds + RING_OFF + jx * 8192 + lane * 16);
#pragma unroll
                for (int r = 0; r < 4; ++r) { const f32x4 a = wr[128 * r], b = wr[128 * r + 64];
#pragma unroll
                    for (int u = 0; u < ROWS; ++u) { const float xv = v[u][jx][r];
                        lgall[u][0] += xv * a.x; lgall[u][1] += xv * a.y; lgall[u][2] += xv * a.z; lgall[u][3] += xv * a.w; lgall[u][4] += xv * b.x; lgall[u][5] += xv * b.y; lgall[u][6] += xv * b.z; lgall[u][7] += xv * b.w; } } }
        }
#pragma unroll
        for (int u = 0; u < ROWS; ++u) { const int m = m0 + u * mstep; if (m >= MTOK) continue;
            const float rstd = 1.0f / sqrtf(ss[u] * (1.f / DM) + EPS);
            if (MODE != 1) {
#pragma unroll
            for (int jx = 0; jx < 4; ++jx) v[u][jx] = v[u][jx] * rstd * gv[jx]; }
            if (MODE == 2) {
                f32x4* o = (f32x4*)(F.out + (size_t)m * DM) + lane;
#pragma unroll
                for (int jx = 0; jx < 4; ++jx) o[64 * jx] = v[u][jx];
            } else {
                unsigned long long* o8 = (unsigned long long*)(WSP(bf16, WS_HN) + (size_t)m * DM) + lane;
#pragma unroll
                for (int jx = 0; jx < 4; ++jx) { f32x4 w = v[u][jx];
                    if (tiled) { *(unsigned long long*)(WSP(bf16, WS_HN) + toff(m, 4 * lane + 256 * jx, DM)) = (unsigned long long)pk2(w.x, w.y) | ((unsigned long long)pk2(w.z, w.w) << 32); continue; } if (q8s > 0.f) { w.x = q8r(w.x, q8s); w.y = q8r(w.y, q8s); w.z = q8r(w.z, q8s); w.w = q8r(w.w, q8s); }
                    o8[64 * jx] = (unsigned long long)pk2(w.x, w.y) | ((unsigned long long)pk2(w.z, w.w) << 32); }
            }
            if (MODE == 1) {
                float lg[8];
#pragma unroll
                for (int e = 0; e < 8; ++e) lg[e] = lgall[u][e];
                float h4[4], h2[2], h1;
                { const bool up = lane & 1;
#pragma unroll
                  for (int i = 0; i < 4; ++i) { const float keep = up ? lg[4 + i] : lg[i], send = up ? lg[i] : lg[4 + i]; h4[i] = keep + __builtin_bit_cast(float, bperm(lane ^ 1, __builtin_bit_cast(int, send))); } }
                { const bool up = lane & 2;
#pragma unroll
                  for (int i = 0; i < 2; ++i) { const float keep = up ? h4[2 + i] : h4[i], send = up ? h4[i] : h4[2 + i]; h2[i] = keep + __builtin_bit_cast(float, bperm(lane ^ 2, __builtin_bit_cast(int, send))); } }
                { const bool up = lane & 4; const float keep = up ? h2[1] : h2[0], send = up ? h2[0] : h2[1]; h1 = keep + __builtin_bit_cast(float, bperm(lane ^ 4, __builtin_bit_cast(int, send))); }
                h1 += __builtin_bit_cast(float, bperm(lane ^ 8, __builtin_bit_cast(int, h1))); h1 += __builtin_bit_cast(float, bperm(lane ^ 16, __builtin_bit_cast(int, h1))); h1 += __builtin_bit_cast(float, bperm(lane ^ 32, __builtin_bit_cast(int, h1)));
                lg[0] = rdlane(h1, 0); lg[1] = rdlane(h1, 4); lg[2] = rdlane(h1, 2); lg[3] = rdlane(h1, 6); lg[4] = rdlane(h1, 1); lg[5] = rdlane(h1, 5); lg[6] = rdlane(h1, 3); lg[7] = rdlane(h1, 7);
                int e0 = 0; float v0 = lg[0];
#pragma unroll
                for (int e = 1; e < 8; ++e) if (lg[e] > v0) { v0 = lg[e]; e0 = e; }
                int e1 = -1; float v1 = -INFINITY;
#pragma unroll
                for (int e = 0; e < 8; ++e) if (e != e0 && lg[e] > v1) { v1 = lg[e]; e1 = e; }
                const float w0 = 1.0f / (1.0f + fexp(v1 - v0)), w1 = 1.0f - w0;
                if (lane == 0) { WSP(v4i, WS_ROUTE)[m] = (v4i){e0, e1, __builtin_bit_cast(int, w0), __builtin_bit_cast(int, w1)};
                    __hip_atomic_fetch_add(&hist[e0], 1, __ATOMIC_RELAXED, __HIP_MEMORY_SCOPE_WORKGROUP); __hip_atomic_fetch_add(&hist[8 + e1], 1, __ATOMIC_RELAXED, __HIP_MEMORY_SCOPE_WORKGROUP); }
            }
        }
        if (MODE == 1 && (itx % (16 / ROWS)) == 16 / ROWS - 1) {
            __syncthreads();
            if (F.tid < 16) { WSP(int, WS_CNT128)[(size_t)chk * 16 + F.tid] = hist[F.tid]; hist[F.tid] = 0; }
            __syncthreads();
        }
    }
}

__device__ __forceinline__ void p_prep(Frame& F) {
    const int gw = F.vcu * NWAVES + F.wave, NGW = F.G * NWAVES, lane = F.lane;
    bf16* P1 = WSP(bf16, WS_P1); bf16* KVC = WSP(bf16, WS_KVC); const float* rope = WSP(float, WS_ROPE);
    const int vec = lane >> 3, ri = lane & 7; const int cb = vec < 4 ? C_CQ + vec * 64 : (vec == 4 ? C_KCMP : (vec == 5 ? C_KSLC : C_KWIN));
    for (int row0 = gw; row0 < MC; row0 += 4 * NGW) {
        float x1[4], x2[4], cc[4], ss[4]; bf16 kc48[4], vc64[4];
#pragma unroll
        for (int k = 0; k < 4; ++k) { const int row = row0 + k * NGW < MC ? row0 + k * NGW : row0; const bf16* p = P1 + (size_t)row * P1W; const int pos = row & (SEQ - 1);
            const int cl = lane < 56 ? cb + ri : C_CQ;
            x1[k] = bf1(p[cl]); x2[k] = bf1(p[cl + 8]); cc[k] = rope[pos * 8 + ri]; ss[k] = rope[SEQ * 8 + pos * 8 + ri];
            if (F.rep) { cc[k] = 1.f; ss[k] = 0.f; }
            kc48[k] = p[C_KCMP + 16 + (lane < 48 ? lane : 0)]; vc64[k] = p[C_VCMP + lane]; }
#pragma unroll
        for (int k = 0; k < 4; ++k) { const int row = row0 + k * NGW; if (row >= MC) continue; bf16* p = P1 + (size_t)row * P1W;
            if (lane < 56) { const bf16 o1 = (bf16)f2bf(x1[k] * cc[k] - x2[k] * ss[k]), o2 = (bf16)f2bf(x2[k] * cc[k] + x1[k] * ss[k]);
                p[cb + ri] = o1; p[cb + ri + 8] = o2;
                if (vec == 4) { KVC[(size_t)row * 64 + ri] = o1; KVC[(size_t)row * 64 + ri + 8] = o2; } }
            if (lane < 48) KVC[(size_t)row * 64 + 16 + lane] = kc48[k];
            KVC[(size_t)MC * 64 + (size_t)row * 64 + lane] = vc64[k]; }
    }
    bf16* VT = WSP(bf16, WS_VT);
    for (int it = gw; it < 6 * BC * 64; it += NGW) { const int which = it / (BC * 64), r = it % (BC * 64), b = r >> 6, blk = r & 63;
        const v4u* src = (const v4u*)(P1 + ((size_t)b * SEQ + blk * 64 + lane) * P1W + (which == 0 ? C_VSLC : (which == 1 ? C_VWIN : C_SBV + (which - 2) * 64)));
        bf16* dst = VT + ((size_t)(which * BC + b) * 64) * SEQ + blk * 64 + lane;
        v4u xs[8];
#pragma unroll
        for (int i = 0; i < 8; ++i) xs[i] = src[i];
#pragma unroll
        for (int i = 0; i < 8; ++i) { const v4u x = xs[i];
            dst[(size_t)(8 * i + 0) * SEQ] = (bf16)(x.x & 0xffffu); dst[(size_t)(8 * i + 1) * SEQ] = (bf16)(x.x >> 16);
            dst[(size_t)(8 * i + 2) * SEQ] = (bf16)(x.y & 0xffffu); dst[(size_t)(8 * i + 3) * SEQ] = (bf16)(x.y >> 16);
            dst[(size_t)(8 * i + 4) * SEQ] = (bf16)(x.z & 0xffffu); dst[(size_t)(8 * i + 5) * SEQ] = (bf16)(x.z >> 16);
            dst[(size_t)(8 * i + 6) * SEQ] = (bf16)(x.w & 0xffffu); dst[(size_t)(8 * i + 7) * SEQ] = (bf16)(x.w >> 16); }
    }
}
__device__ __forceinline__ void p_sgu(Frame& F, int layer) {
    LAS float* vn = (LAS float*)(F.lds + RING_OFF);
    const bf16* P1 = WSP(bf16, WS_P1); bf16* Ya = WSP(bf16, WS_Y);
    const float* gain = F.in[3] + (size_t)layer * 256; const float* sw = F.in[4] + (size_t)layer * 4 * 128 * 128; const float* sb = F.in[5] + (size_t)layer * 4 * 128;
    const int lane = F.lane, wave = F.wave;
    for (int item = F.vcu; item < MC / 128; item += F.G) {
        const size_t r0 = (size_t)item * 128;
        __syncthreads();
        for (int rr = 0; rr < 16; ++rr) { const int r = wave * 16 + rr; const v2u raw = *(const v2u*)(P1 + (r0 + r) * P1W + C_V + 4 * lane);
            const float a = bflo(raw.x), b = bfhi(raw.x), c = bflo(raw.y), d = bfhi(raw.y);
            const float rstd = 1.0f / sqrtf(wave_sum((a * a + b * b) + (c * c + d * d), lane) * (1.f / 256.f) + EPS);
            const f32x4 gg = ((const f32x4*)gain)[lane];
            *(LAS f32x4*)(vn + r * 256 + 4 * lane) = (f32x4){a * rstd * gg.x, b * rstd * gg.y, c * rstd * gg.z, d * rstd * gg.w}; }
        __syncthreads();
        const int g = wave & 3, half = wave >> 2;
        for (int i = 0; i < 64; ++i) { const int t = 2 * i + half;
            const float* wrow = sw + ((size_t)g * 128 + t) * 128;
            const float w_lo = wrow[lane], w_hi = wrow[64 + lane];
            float acc = 0.f;
            for (int s = 0; s <= t; ++s) { const float w = (s < 64) ? rdlane(w_lo, s) : rdlane(w_hi, s - 64); acc += w * vn[s * 256 + g * 64 + lane]; }
            const float u = bf1(P1[(r0 + t) * P1W + C_U + g * 64 + lane]);
#ifdef ABL_SGUMIX
            acc = 0.f;
#endif
            Ya[(r0 + t) * 256 + g * 64 + lane] = (bf16)f2bf(u * (acc + sb[g * 128 + t])); }
    }
    __syncthreads();
}

__device__ __forceinline__ void p_cmpfin(Frame& F, int layer) {
    const int gw = F.vcu * NWAVES + F.wave, NGW = F.G * NWAVES, lane = F.lane;
    const float* UL = WSP(float, WS_UL); const float* bias = WSP(float, WS_BIAS1); bf16* KC = WSP(bf16, WS_KC);
    LAS float* w2l = (LAS float*)(F.lds + RING_OFF);
    __syncthreads();
    { const f32x4* src = (const f32x4*)(F.in[8] + (size_t)layer * 2 * 256 * 64);
#pragma unroll 4
      for (int i = F.tid; i < 2 * 256 * 64 / 4; i += NWAVES * 64) *(LAS f32x4*)(w2l + 4 * i) = src[i]; }
    __syncthreads();
    for (int it = gw; it < 2 * BC * 255; it += NGW) { const int kv = it / (BC * 255), r = it % (BC * 255), b = r / 255, m = r % 255;
        const LAS float* w2 = w2l + kv * 256 * 64;
        const float* U = UL + (size_t)(kv * 2048 + b * 256 + m) * 512; const float* L = U + 512 + 256;
        float hv[4];
#pragma unroll
        for (int q = 0; q < 4; ++q) hv[q] = pg8::gelu_tanh(U[64 * q + lane] + L[64 * q + lane] + bias[kv * 256 + 64 * q + lane]);
        float acc0 = 0.f, acc1 = 0.f;
#pragma unroll
        for (int q = 0; q < 4; ++q)
#pragma unroll 8
            for (int jj = 0; jj < 64; jj += 2) { acc0 += rdlane(hv[q], jj) * w2[(64 * q + jj) * 64 + lane]; acc1 += rdlane(hv[q], jj + 1) * w2[(64 * q + jj + 1) * 64 + lane]; }
        const float acc = acc0 + acc1;
        KC[((size_t)(kv * BC + b) * 256 + m) * 64 + lane] = (bf16)f2bf(acc);
        if (kv == 1) { WSP(bf16, WS_KCT)[((size_t)b * 64 + lane) * 256 + m] = (bf16)f2bf(acc); if (m == 254) WSP(bf16, WS_KCT)[((size_t)b * 64 + lane) * 256 + 255] = (bf16)0; }
        else if (m == 254) KC[((size_t)b * 256 + 255) * 64 + lane] = (bf16)0; }
    __syncthreads();
}

__device__ __forceinline__ void p_stick(Frame& F) {
    const int gw = F.vcu * NWAVES + F.wave, NGW = F.G * NWAVES, lane = F.lane;
    const bf16* P1 = WSP(bf16, WS_P1); bf16* Yb = WSP(bf16, WS_Y) + (size_t)MC * 256;
    for (int item = gw; item < BC * 4 * 64; item += NGW) { const int tb = item & 63, h = (item >> 6) & 3, b = item >> 8;
        const int t = tb * 64 + lane; const size_t row = (size_t)b * SEQ + t;
        unsigned q[32];
        { const v4u* qp = (const v4u*)(P1 + row * P1W + C_SBQ + h * 64);
#pragma unroll
          for (int i = 0; i < 8; ++i) { const v4u x = qp[i]; q[4 * i] = x.x; q[4 * i + 1] = x.y; q[4 * i + 2] = x.z; q[4 * i + 3] = x.w; } }
        float o[64];
#pragma unroll
        for (int d = 0; d < 64; ++d) o[d] = 0.f;
        float R = 0.f;
        const bf16* kb = P1 + (size_t)b * SEQ * P1W + C_SBK + h * 64; const bf16* vb = P1 + (size_t)b * SEQ * P1W + C_SBV + h * 64;
        for (int s = t - 1; s >= 0; --s) {
            if (R < -100.f) break;
            const v4u* kp = (const v4u*)(kb + (size_t)s * P1W); const v4u* vp = (const v4u*)(vb + (size_t)s * P1W);
            float z0 = 0.f, z1 = 0.f;
#pragma unroll
            for (int i = 0; i < 8; ++i) { const v4u k = kp[i]; z0 = dot2bf(k.x, q[4 * i], z0); z1 = dot2bf(k.y, q[4 * i + 1], z1); z0 = dot2bf(k.z, q[4 * i + 2], z0); z1 = dot2bf(k.w, q[4 * i + 3], z1); }
            const float z = (z0 + z1) * 0.125f;
            const float tt = 0.6931471805599453f * __builtin_amdgcn_logf(1.0f + fexp(-__builtin_fabsf(z)));
            const float lb = fminf(z, 0.f) - tt, l1m = fminf(-z, 0.f) - tt;
            const float a = fexp(lb + R); R += l1m;
#pragma unroll
            for (int i = 0; i < 8; ++i) { const v4u v = vp[i];
                o[8 * i] += a * bflo(v.x); o[8 * i + 1] += a * bfhi(v.x); o[8 * i + 2] += a * bflo(v.y); o[8 * i + 3] += a * bfhi(v.y);
                o[8 * i + 4] += a * bflo(v.z); o[8 * i + 5] += a * bfhi(v.z); o[8 * i + 6] += a * bflo(v.w); o[8 * i + 7] += a * bfhi(v.w); }
        }
        v4u* op = (v4u*)(Yb + row * 256 + h * 64);
#pragma unroll
        for (int i = 0; i < 8; ++i) op[i] = (v4u){pk2(o[8 * i], o[8 * i + 1]), pk2(o[8 * i + 2], o[8 * i + 3]), pk2(o[8 * i + 4], o[8 * i + 5]), pk2(o[8 * i + 6], o[8 * i + 7])};
    }
}

struct Soft { float mx, l; };
__device__ __forceinline__ float dotq(const LAS v4u* ql, const bf16* kp_) {
    const v4u* kp = (const v4u*)kp_; float z0 = 0.f, z1 = 0.f;
#pragma unroll
    for (int i = 0; i < 8; ++i) { const v4u k = kp[i]; const v4u q = ql[i]; z0 = dot2bf(k.x, q.x, z0); z1 = dot2bf(k.y, q.y, z1); z0 = dot2bf(k.z, q.z, z0); z1 = dot2bf(k.w, q.w, z1); }
    return (z0 + z1) * 0.125f;
}
__device__ __forceinline__ void axpy_row(float p, const bf16* vp_, float (&o)[64]) {
    const v4u* vp = (const v4u*)vp_;
#pragma unroll
    for (int i = 0; i < 8; ++i) { const v4u v = vp[i];
        o[8 * i] += p * bflo(v.x); o[8 * i + 1] += p * bfhi(v.x); o[8 * i + 2] += p * bflo(v.y); o[8 * i + 3] += p * bfhi(v.y);
        o[8 * i + 4] += p * bflo(v.z); o[8 * i + 5] += p * bfhi(v.z); o[8 * i + 6] += p * bflo(v.w); o[8 * i + 7] += p * bfhi(v.w); }
}
__device__ __forceinline__ void nsa_step(const LAS v4u* ql, const bf16* kp_, const bf16* vp_, Soft& S, float (&o)[64]) {
    const float s = dotq(ql, kp_);
    if (s > S.mx) { const float sc = fexp(S.mx - s); S.l *= sc;
#pragma unroll
        for (int d = 0; d < 64; ++d) o[d] *= sc;
        S.mx = s; }
    const float p = fexp(s - S.mx); S.l += p;
    asm volatile("" ::: "memory");
    axpy_row(p, vp_, o);
}
__device__ __forceinline__ void nsa_accum(bf16* yrow, bool first, float sc, const float (&o)[64]) {
    v4u* op = (v4u*)yrow;
#pragma unroll
    for (int i = 0; i < 8; ++i) { v4u old = (v4u){0u, 0u, 0u, 0u}; if (!first) old = op[i];
        op[i] = (v4u){pk2(bflo(old.x) + sc * o[8 * i], bfhi(old.x) + sc * o[8 * i + 1]), pk2(bflo(old.y) + sc * o[8 * i + 2], bfhi(old.y) + sc * o[8 * i + 3]),
                      pk2(bflo(old.z) + sc * o[8 * i + 4], bfhi(old.z) + sc * o[8 * i + 5]), pk2(bflo(old.w) + sc * o[8 * i + 6], bfhi(old.w) + sc * o[8 * i + 7])}; }
}
__device__ __forceinline__ void p_nsa(Frame& F) {
    const int gw = F.vcu * NWAVES + F.wave, NGW = F.G * NWAVES, lane = F.lane;
    const bf16* P1 = WSP(bf16, WS_P1); const bf16* KC = WSP(bf16, WS_KC); bf16* Yc = WSP(bf16, WS_Y) + (size_t)2 * MC * 256;
    LAS float* imp = (LAS float*)(F.lds + RING_OFF + F.wave * 4096);
    LAS v4u* ql = (LAS v4u*)(F.lds + RING_OFF + 32768 + F.wave * 9216 + lane * 144);
    const int qi = lane >> 2, h = lane & 3;
    for (int item = gw; item < BC * 256; item += NGW) { const int b = item >> 8, tg = item & 255;
        const int t = tg * 16 + qi; const size_t row = (size_t)b * SEQ + t; const bf16* prow = P1 + row * P1W;
        { const v4u* qp = (const v4u*)(prow + C_CQ + h * 64);
#pragma unroll
          for (int i = 0; i < 8; ++i) ql[i] = qp[i]; }
        const float g0 = bf1(prow[C_CG + h * 3]), g1 = bf1(prow[C_CG + h * 3 + 1]), g2 = bf1(prow[C_CG + h * 3 + 2]);
        bf16* yrow = Yc + row * 256 + h * 64;
        float o[64];
        for (int i = lane; i < 1024; i += 64) imp[i] = 0.f;
        const int nv = t >= 31 ? ((t - 31) >> 4) + 1 : 0; const int nvmax = (tg * 16 + 15 >= 31) ? ((tg * 16 + 15 - 31) >> 4) + 1 : 0;
        const bf16* kc = KC + (size_t)(0 * BC + b) * 256 * 64; const bf16* vc = KC + (size_t)(1 * BC + b) * 256 * 64;
        { float mx = -INFINITY, l = 0.f;
          for (int m = 0; m < nvmax; ++m) { const float s = dotq(ql, kc + m * 64); if (m < nv) { if (s > mx) { l *= fexp(mx - s); mx = s; } l += fexp(s - mx); } }
          const float rl = l > 0.f ? 1.0f / l : 0.f;
#pragma unroll
          for (int d = 0; d < 64; ++d) o[d] = 0.f;
          for (int m = 0; m < nvmax; ++m) { const float s = dotq(ql, kc + m * 64); const float p = (m < nv) ? fexp(s - mx) * rl : 0.f;
              asm volatile("" ::: "memory");
              axpy_row(p, vc + m * 64, o);
              float P = p + __builtin_bit_cast(float, bperm(lane ^ 1, __builtin_bit_cast(int, p))); P += __builtin_bit_cast(float, bperm(lane ^ 2, __builtin_bit_cast(int, P)));
              if (h == 0) { const int j0 = m >> 2; const bool edge = (m & 3) == 3; imp[qi * 64 + j0] += edge ? 0.5f * P : P; if (edge) imp[qi * 64 + j0 + 1] += 0.5f * P; } }
          nsa_accum(yrow, true, g0, o); }
        unsigned long long mask = 0ull;
        { const int cur = t >> 6, nvb = cur + 1;
          if (h == 0) {
              if (nvb <= 16) mask = (1ull << nvb) - 1ull;
              else { mask = 1ull | (1ull << cur);
                  for (int r = 0; r < 14; ++r) { int best = -1; float bv = -1.f;
                      for (int j = 1; j < cur; ++j) { const float v = imp[qi * 64 + j]; if (!((mask >> j) & 1ull) && v > bv) { bv = v; best = j; } }
                      mask |= 1ull << best; } } }
          const unsigned mlo = (unsigned)bperm(lane & ~3, (int)(unsigned)mask), mhi = (unsigned)bperm(lane & ~3, (int)(unsigned)(mask >> 32));
          mask = ((unsigned long long)mhi << 32) | mlo; }
        { Soft S{-INFINITY, 0.f};
#pragma unroll
          for (int d = 0; d < 64; ++d) o[d] = 0.f;
          const bf16* kb = P1 + (size_t)b * SEQ * P1W + C_KSLC; const bf16* vb = P1 + (size_t)b * SEQ * P1W + C_VSLC;
          unsigned long long mm = mask;
          while (mm) { const int j = __builtin_ctzll(mm); mm &= mm - 1ull;
              for (int kk = 0; kk < 64; ++kk) { const int sp = j * 64 + kk; if (sp > t) break; nsa_step(ql, kb + (size_t)sp * P1W, vb + (size_t)sp * P1W, S, o); } }
          nsa_accum(yrow, false, g1 / S.l, o); }
        { Soft S{-INFINITY, 0.f};
#pragma unroll
          for (int d = 0; d < 64; ++d) o[d] = 0.f;
          const bf16* kb = P1 + (size_t)b * SEQ * P1W + C_KWIN; const bf16* vb = P1 + (size_t)b * SEQ * P1W + C_VWIN;
          for (int i = 0; i < 512; ++i) { const int sp = t - 511 + i; if (sp >= 0) nsa_step(ql, kb + (size_t)sp * P1W, vb + (size_t)sp * P1W, S, o); }
          nsa_accum(yrow, false, g2 / S.l, o); }
    }
}

__device__ __forceinline__ int moe_table(Frame& F, int jmoe, int c, int r, int kpre = 0) {
    LAS int* tab = (LAS int*)(F.lds + TAB_OFF); LAS int* arr = (LAS int*)(F.lds + LDSCTL_OFF + 4096);
    (void)jmoe;
    __syncthreads();
    if (F.tid < 256) { const v4i* s = (const v4i*)(WSP(int, WS_CNT128) + ((size_t)(c * 256 + F.tid) * 2 + r) * 8); const v4i a = s[0], b = s[1];
        *(LAS v4i*)(arr + F.tid * 8) = a; *(LAS v4i*)(arr + F.tid * 8 + 4) = b; }
    __syncthreads();
    if (F.tid < 8) { int tot = 0, pre = 0;
        for (int k = 0; k < 256; ++k) { const int x = arr[k * 8 + F.tid]; pre += (k < kpre) ? x : 0; tot += x; }
        tab[176 + F.tid] = tot; tab[184 + F.tid] = pre; }
    __syncthreads();
    if (F.tid == 0) { int base = 0, T = 0;
        for (int e = 0; e < 8; ++e) { const int cnt = tab[176 + e];
            const int nt = (cnt + 255) >> 8; tab[160 + e] = base; for (int i = 0; i < nt && T + i < 160; ++i) tab[T + i] = e; T += nt; base += nt * 256; }
        tab[168] = T < 136 ? T : 136; }
    __syncthreads();
    return tab[168];
}
__device__ __forceinline__ void p_gather(Frame& F, int jmoe, int c, int r, int nbusy = 0) {
    if (F.bx < nbusy) return;
    LAS int* tab = (LAS int*)(F.lds + TAB_OFF); LAS int* cntw = tab + 256; LAS int* basew = tab + 320;
    const int lane = F.lane, wave = F.wave;
    const v4i* route = WSP(v4i, WS_ROUTE); int* tokmap = WSP(int, WS_TOKMAP) + (c * 2 + r) * SLOTS; float* wslot = WSP(float, WS_WSLOT) + (c * 2 + r) * SLOTS;
    for (int ch = F.bx - nbusy; ch < MC / 128; ch += F.G - nbusy) {
        moe_table(F, jmoe, c, r, ch);
        const int m = c * MC + ch * 128 + wave * 16 + (lane & 15); const v4i rt = route[m];
        const int e = lane < 16 ? (r ? rt.y : rt.x) : -1; const float w = __builtin_bit_cast(float, r ? rt.w : rt.z);
        unsigned long long bal[8]; int mycnt = 0;
#pragma unroll
        for (int ee = 0; ee < 8; ++ee) { bal[ee] = __builtin_amdgcn_ballot_w64(e == ee); if (lane == ee) mycnt = __builtin_popcountll(bal[ee]); }
        if (lane < 8) cntw[wave * 8 + lane] = mycnt;
        __syncthreads();
        if (wave == 0 && lane < 8) { int base = tab[184 + lane];
#pragma unroll
            for (int w8 = 0; w8 < 8; ++w8) { basew[w8 * 8 + lane] = base; base += cntw[w8 * 8 + lane]; } }
        __syncthreads();
        int pos = 0;
#pragma unroll
        for (int ee = 0; ee < 8; ++ee) if (e == ee) pos = basew[wave * 8 + ee] + __builtin_popcountll(bal[ee] & ((1ull << lane) - 1ull));
        int slot = 0;
        if (lane < 16) { slot = tab[160 + e] + pos; tokmap[slot] = m; wslot[slot] = w; }
    }
}

typedef float f32x16 __attribute__((ext_vector_type(16)));
typedef short bf16x8v __attribute__((ext_vector_type(8)));
typedef float f32x2v __attribute__((ext_vector_type(2)));
constexpr int NSA_K = 0, NSA_V = 8192, NSA_BUF = 17408, NSA_STAGE = 2 * NSA_BUF, NSA_IMP = 69632, NSA_CARRY = 86016, NSA_SEL = 103424, NSA_WSF = 103936;
constexpr int NSA_VP = 136;
constexpr float NSA_C2 = 0.125f * 1.4426950408889634f;
constexpr float NSA_DEFER = 8.0f / (0.125f * 1.4426950408889634f);
__device__ __forceinline__ unsigned cvtpk(float lo, float hi) { f32x2v v = {lo, hi}; bf16x2_t b = __builtin_convertvector(v, bf16x2_t); return __builtin_bit_cast(unsigned, b); }
__device__ __forceinline__ float partner32(float v, int lane) { return __builtin_bit_cast(float, __builtin_amdgcn_ds_bpermute((lane ^ 32) << 2, __builtin_bit_cast(int, v))); }
__device__ __forceinline__ void nsa_load(v4u& kx, v4u& vx, const bf16* Kg, int kp, const bf16* Vg, int vp, int tid) {
    kx = *(const v4u*)(Kg + (size_t)(tid & 63) * kp + (tid >> 6) * 8); vx = *(const v4u*)(Vg + (size_t)(tid >> 3) * vp + (tid & 7) * 8);
}
__device__ __forceinline__ void nsa_store(LAS unsigned char* lds, const v4u& kx, const v4u& vx, int tid) {
    *(LAS v4u*)(lds + NSA_K + (tid >> 6) * 1024 + (tid & 63) * 16) = kx; { LAS v2u* vd = (LAS v2u*)(lds + NSA_V + (tid >> 3) * NSA_VP + (tid & 7) * 16); vd[0] = (v2u){vx.x, vx.y}; vd[1] = (v2u){vx.z, vx.w}; }
}
__device__ __forceinline__ void nsa_qk(const LAS unsigned char* lds, const bf16x8v (&qr)[4], f32x16& p0, f32x16& p1, int r32, int hi) {
    bf16x8v kf[8];
#pragma unroll
    for (int d0 = 0; d0 < 4; ++d0) {
        kf[2 * d0] = *(const LAS bf16x8v*)(lds + NSA_K + (2 * d0 + hi) * 1024 + r32 * 16);
        kf[2 * d0 + 1] = *(const LAS bf16x8v*)(lds + NSA_K + (2 * d0 + hi) * 1024 + 512 + r32 * 16); }
    __builtin_amdgcn_sched_barrier(0);
#pragma unroll
    for (int i = 0; i < 16; ++i) { p0[i] = 0.f; p1[i] = 0.f; }
#pragma unroll
    for (int d0 = 0; d0 < 4; ++d0) {
        p0 = __builtin_amdgcn_mfma_f32_32x32x16_bf16(kf[2 * d0], qr[d0], p0, 0, 0, 0);
        p1 = __builtin_amdgcn_mfma_f32_32x32x16_bf16(kf[2 * d0 + 1], qr[d0], p1, 0, 0, 0);
    }
}
__device__ __forceinline__ void nsa_mask(f32x16& p0, f32x16& p1, int hi, int hiL, int loL) {
    const int hl = hiL - 4 * hi, ll = loL - 4 * hi;
#pragma unroll
    for (int i = 0; i < 16; ++i) { const int c = (i & 3) + 8 * (i >> 2);
        if (!(c <= hl && c > ll)) p0[i] = -INFINITY;
        if (!(c + 32 <= hl && c + 32 > ll)) p1[i] = -INFINITY; }
}
__device__ __forceinline__ float nsa_max32(const f32x16& p0, const f32x16& p1) {
    float a = fmaxf(fmaxf(p0[0], p0[1]), p1[0]), b = fmaxf(fmaxf(p0[2], p0[3]), p1[1]); a = fmaxf(fmaxf(a, p1[2]), p1[3]);
#pragma unroll
    for (int i = 4; i < 16; i += 4) { a = fmaxf(fmaxf(a, p0[i]), p0[i + 1]); b = fmaxf(fmaxf(b, p0[i + 2]), p0[i + 3]); a = fmaxf(fmaxf(a, p1[i]), p1[i + 1]); b = fmaxf(fmaxf(b, p1[i + 2]), p1[i + 3]); }
    return fmaxf(a, b);
}
__device__ __forceinline__ void nsa_vload(const LAS unsigned char* lds, v4u (&vv)[8], int r32, int hi) {
#pragma unroll
    for (int db = 0; db < 2; ++db) { const LAS unsigned char* vrow = lds + NSA_V + (32 * db + r32) * NSA_VP;
#pragma unroll
        for (int ks = 0; ks < 4; ++ks) {
            const int kb = (ks >> 1) * 32 + (ks & 1) * 16 + 4 * hi;
            const v2u lo = *(const LAS v2u*)(vrow + kb * 2), hh = *(const LAS v2u*)(vrow + (kb + 8) * 2);
            vv[4 * db + ks] = (v4u){lo.x, lo.y, hh.x, hh.y}; } }
    __builtin_amdgcn_sched_barrier(0);
}
__device__ __forceinline__ void nsa_pv(const v4u (&vv)[8], const f32x16& p0, const f32x16& p1, f32x16 (&o)[2]) {
    bf16x8v pa[4];
#pragma unroll
    for (int s = 0; s < 2; ++s) {
        const v4u a = (v4u){cvtpk(p0[8 * s], p0[8 * s + 1]), cvtpk(p0[8 * s + 2], p0[8 * s + 3]), cvtpk(p0[8 * s + 4], p0[8 * s + 5]), cvtpk(p0[8 * s + 6], p0[8 * s + 7])};
        const v4u b = (v4u){cvtpk(p1[8 * s], p1[8 * s + 1]), cvtpk(p1[8 * s + 2], p1[8 * s + 3]), cvtpk(p1[8 * s + 4], p1[8 * s + 5]), cvtpk(p1[8 * s + 6], p1[8 * s + 7])};
        pa[s] = __builtin_bit_cast(bf16x8v, a); pa[2 + s] = __builtin_bit_cast(bf16x8v, b); }
#pragma unroll
    for (int ks = 0; ks < 4; ++ks)
#pragma unroll
        for (int db = 0; db < 2; ++db) o[db] = __builtin_amdgcn_mfma_f32_32x32x16_bf16(pa[ks], __builtin_bit_cast(bf16x8v, vv[4 * db + ks]), o[db], 0, 0, 0);
}
__device__ __forceinline__ void nsa_rowscale(f32x16 (&o)[2], LAS float* wsf, float f, int r32, int hi) {
    if (hi == 0) wsf[r32] = f;
#pragma unroll
    for (int g = 0; g < 4; ++g) { const f32x4 w = *(const LAS f32x4*)(wsf + 8 * g + 4 * hi);
#pragma unroll
        for (int e = 0; e < 4; ++e) { o[0][4 * g + e] *= w[e]; o[1][4 * g + e] *= w[e]; } }
}
constexpr int NSA_ACC = 104960;
__device__ __forceinline__ void nsa_rowaccum(LAS unsigned char* acc, bool first, const f32x16 (&o)[2], LAS float* wsf, float f, int r32, int hi) {
    if (hi == 0) wsf[r32] = f;
#pragma unroll
    for (int g = 0; g < 4; ++g) { const f32x4 w = *(const LAS f32x4*)(wsf + 8 * g + 4 * hi);
#pragma unroll
        for (int e = 0; e < 4; ++e) { LAS bf16* p = (LAS bf16*)(acc + (8 * g + 4 * hi + e) * 128 + r32 * 2); const int i = 4 * g + e;
            float a = o[0][i] * w[e], b = o[1][i] * w[e];
            if (!first) { a += bf1(p[0]); b += bf1(p[32]); }
            p[0] = (bf16)f2bf(a); p[32] = (bf16)f2bf(b); } }
}
__device__ __forceinline__ void nsa_flush(const LAS unsigned char* acc, bf16* ytok  , int lane) {
    asm volatile("" ::: "memory");
    { int z_; asm volatile("v_mov_b32 %0, 0" : "=v"(z_)); lane += z_; }
#pragma unroll
    for (int ps = 0; ps < 4; ++ps) { const int row = ps * 8 + (lane >> 3), ch = lane & 7;
        const v4u v = *(const LAS v4u*)(acc + row * 128 + ch * 16);
        *(v4u*)((unsigned char*)ytok + (unsigned)(((row >> 2) * 256 + (row & 3) * 64 + ch * 8) * 2)) = v; }
}
__device__ __forceinline__ void nsa_softmax_pv(const LAS unsigned char* lds, f32x16& p0, f32x16& p1, float& m, float& l, f32x16 (&o)[2], LAS float* wsf, int lane, int r32, int hi, bool rowok) {
    float mt = nsa_max32(p0, p1); mt = rowok ? mt : -INFINITY; mt = fmaxf(mt, partner32(mt, lane));
    const float mn = fmaxf(m, mt);
    if (__builtin_amdgcn_ballot_w64(mn > m + NSA_DEFER) != 0ull) { const float f = __builtin_amdgcn_exp2f((m - mn) * NSA_C2); l *= f; nsa_rowscale(o, wsf, f, r32, hi); m = mn; }
    const float off = rowok ? -m * NSA_C2 : -INFINITY;
    v4u vv[8]; nsa_vload(lds, vv, r32, hi);
    float s = 0.f;
#pragma unroll
    for (int i = 0; i < 16; ++i) { p0[i] = __builtin_amdgcn_exp2f(__builtin_fmaf(p0[i], NSA_C2, off)); p1[i] = __builtin_amdgcn_exp2f(__builtin_fmaf(p1[i], NSA_C2, off)); s += p0[i] + p1[i]; }
    l += s;
    nsa_pv(vv, p0, p1, o);
}
__device__ __forceinline__ void p_nsa2(Frame& F) {
    const int tid = F.tid, lane = F.lane, wave = F.wave, r32 = lane & 31, hi = lane >> 5;
    LAS unsigned char* lds = F.lds + RING_OFF;
    LAS float* imp = (LAS float*)(lds + NSA_IMP); LAS float* carry = (LAS float*)(lds + NSA_CARRY);
    LAS unsigned long long* selm = (LAS unsigned long long*)(lds + NSA_SEL); LAS float* wsf = (LAS float*)(lds + NSA_WSF) + wave * 32;
    LAS unsigned char* acc = wave < 6 ? lds + NSA_ACC + wave * 4096 : F.lds + LDSCTL_OFF + 4096 + (wave - 6) * 4096;
    const bf16* P1 = WSP(bf16, WS_P1); const bf16* KC = WSP(bf16, WS_KC); const bf16* KCT = WSP(bf16, WS_KCT); const bf16* VT = WSP(bf16, WS_VT);
    bf16* Yc = WSP(bf16, WS_Y) + (size_t)2 * MC * 256;
    const int ql = r32 >> 2, h = r32 & 3, tq = 8 * wave + ql;
    int par = 0;
    for (int it = 0; it < 2; ++it) {
        for (int pair = F.vcu; pair < BC * 32; pair += F.G) {
            const int b = pair >> 5, sx = pair & 31, qb = it ? 63 - sx : sx;
            const int t = qb * 64 + tq; const size_t row = (size_t)b * SEQ + t; const bf16* prow = P1 + row * P1W;
            bf16x8v qr[4];
#pragma unroll
            for (int d0 = 0; d0 < 4; ++d0) qr[d0] = *(const bf16x8v*)(prow + C_CQ + h * 64 + d0 * 16 + hi * 8);
            const float g0 = bf1(prow[C_CG + h * 3]), g1 = bf1(prow[C_CG + h * 3 + 1]), g2 = bf1(prow[C_CG + h * 3 + 2]);
            f32x16 o[2], p0, p1;
            __syncthreads();
            for (int i = tid; i < 64 * 64; i += 512) imp[i] = 0.f;
            for (int i = tid; i < 64 * 68; i += 512) carry[i] = 0.f;
            const int nct = (4 * qb + 3 + 63) >> 6;
            const int mlim = t >= 31 ? ((t - 31) >> 4) : -1;
            const bf16* kcb = KC + (size_t)b * 256 * 64; const bf16* vcb = KCT + (size_t)b * 64 * 256;
            float m = -1e30f, l = 0.f;
            v4u kx, vx;
            nsa_load(kx, vx, kcb, 64, vcb, 256, tid);
            for (int ti = 0; ti < nct; ++ti) {
                LAS unsigned char* tb = lds + par * NSA_STAGE; par ^= 1;
                nsa_store(tb, kx, vx, tid); __syncthreads();
                { const int tn = ti + 1 < nct ? ti + 1 : 0; nsa_load(kx, vx, kcb + (size_t)tn * 64 * 64, 64, vcb + tn * 64, 256, tid); }
                nsa_qk(tb, qr, p0, p1, r32, hi); nsa_mask(p0, p1, hi, mlim - 64 * ti, -1);
                float mt = nsa_max32(p0, p1); mt = fmaxf(mt, partner32(mt, lane));
                const float mn = fmaxf(m, mt); l *= __builtin_amdgcn_exp2f((m - mn) * NSA_C2); m = mn;
                const float off = -m * NSA_C2; float s = 0.f;
#pragma unroll
                for (int i = 0; i < 16; ++i) s += __builtin_amdgcn_exp2f(__builtin_fmaf(p0[i], NSA_C2, off)) + __builtin_amdgcn_exp2f(__builtin_fmaf(p1[i], NSA_C2, off));
                l += s; }
            { const float lt = l + partner32(l, lane); const float rl = lt > 0.f ? 1.0f / lt : 0.f;
#pragma unroll
              for (int i = 0; i < 16; ++i) { o[0][i] = 0.f; o[1][i] = 0.f; }
              for (int ti = 0; ti < nct; ++ti) {
                  LAS unsigned char* tb = lds + par * NSA_STAGE; par ^= 1;
                  nsa_store(tb, kx, vx, tid); __syncthreads();
                  if (ti + 1 < nct) nsa_load(kx, vx, kcb + (size_t)(ti + 1) * 64 * 64, 64, vcb + (ti + 1) * 64, 256, tid);
                  nsa_qk(tb, qr, p0, p1, r32, hi); nsa_mask(p0, p1, hi, mlim - 64 * ti, -1);
                  v4u vv[8]; nsa_vload(tb, vv, r32, hi);
                  { const float off = -m * NSA_C2;
#pragma unroll
                    for (int i = 0; i < 16; ++i) { p0[i] = __builtin_amdgcn_exp2f(__builtin_fmaf(p0[i], NSA_C2, off)) * rl; p1[i] = __builtin_amdgcn_exp2f(__builtin_fmaf(p1[i], NSA_C2, off)) * rl; } }
#pragma unroll
                  for (int kt = 0; kt < 2; ++kt)
#pragma unroll
                      for (int g = 0; g < 4; ++g) { const f32x16& pp = kt ? p1 : p0;
                          float A = pp[4 * g] + pp[4 * g + 1] + pp[4 * g + 2] + 0.5f * pp[4 * g + 3], B = 0.5f * pp[4 * g + 3];
                          A += __builtin_bit_cast(float, bperm(lane ^ 1, __builtin_bit_cast(int, A))); A += __builtin_bit_cast(float, bperm(lane ^ 2, __builtin_bit_cast(int, A)));
                          B += __builtin_bit_cast(float, bperm(lane ^ 1, __builtin_bit_cast(int, B))); B += __builtin_bit_cast(float, bperm(lane ^ 2, __builtin_bit_cast(int, B)));
                          if (h == 0) { const int j = 16 * ti + 8 * kt + 2 * g + hi; imp[tq * 64 + j] = A; carry[tq * 68 + j + 1] = B; } }
                  nsa_pv(vv, p0, p1, o); }
              nsa_rowaccum(acc, true, o, wsf, g0, r32, hi); }
            __syncthreads();
            v4u kx2, vx2;
            { const bf16* kb = P1 + (size_t)b * SEQ * P1W + C_KSLC; const bf16* vb = VT + (size_t)(0 * BC + b) * 64 * SEQ;
              nsa_load(kx, vx, kb, P1W, vb, SEQ, tid); if (qb >= 1) nsa_load(kx2, vx2, kb + (size_t)64 * P1W, P1W, vb + 64, SEQ, tid); }
            { const int q = tid >> 3, sub = tid & 7; unsigned long long mask;
              if (qb + 1 <= 16) mask = (1ull << (qb + 1)) - 1ull;
              else { mask = 1ull | (1ull << qb);
                  unsigned long long key[8];
#pragma unroll
                  for (int i = 0; i < 8; ++i) { const int j = sub * 8 + i; const float v = imp[q * 64 + j] + carry[q * 68 + j];
                      key[i] = (j >= 1 && j < qb) ? (((unsigned long long)__builtin_bit_cast(unsigned, v) << 32) | (unsigned)(63 - j)) : 0ull; }
                  for (int r = 0; r < 14; ++r) { unsigned long long best = key[0];
#pragma unroll
                      for (int i = 1; i < 8; ++i) best = key[i] > best ? key[i] : best;
#define NSA_DPPMAX(ctrl) do { const unsigned lo_ = (unsigned)__builtin_amdgcn_update_dpp(0, (int)(unsigned)best, ctrl, 0xf, 0xf, false), hh_ = (unsigned)__builtin_amdgcn_update_dpp(0, (int)(unsigned)(best >> 32), ctrl, 0xf, 0xf, false); \
                          const unsigned long long other_ = ((unsigned long long)hh_ << 32) | lo_; best = other_ > best ? other_ : best; } while (0)
                      NSA_DPPMAX(0xB1); NSA_DPPMAX(0x4E); NSA_DPPMAX(0x141);
#undef NSA_DPPMAX
                      const int jb = 63 - (int)(best & 63ull); mask |= 1ull << jb;
#pragma unroll
                      for (int i = 0; i < 8; ++i) if (sub * 8 + i == jb) key[i] = 0ull; } }
              if (sub == 0) selm[q] = mask; }
            __syncthreads();
            const unsigned long long mysel = selm[tq];
            { const bf16* kb = P1 + (size_t)b * SEQ * P1W + C_KSLC; const bf16* vb = VT + (size_t)(0 * BC + b) * 64 * SEQ;
              m = -1e30f; l = 0.f;
#pragma unroll
              for (int i = 0; i < 16; ++i) { o[0][i] = 0.f; o[1][i] = 0.f; }
              for (int j = 0; j <= qb; j += 2) {
                  const bool two = j + 1 <= qb;
                  LAS unsigned char* tb = lds + par * NSA_STAGE; par ^= 1;
                  nsa_store(tb, kx, vx, tid); if (two) nsa_store(tb + NSA_BUF, kx2, vx2, tid);
                  __syncthreads();
                  if (j + 2 <= qb) nsa_load(kx, vx, kb + (size_t)(j + 2) * 64 * P1W, P1W, vb + (j + 2) * 64, SEQ, tid);
                  if (j + 3 <= qb) nsa_load(kx2, vx2, kb + (size_t)(j + 3) * 64 * P1W, P1W, vb + (j + 3) * 64, SEQ, tid);
                  if (j + 2 > qb) { const int jw = qb >= 8 ? qb - 8 : 0;
                      nsa_load(kx, vx, P1 + (size_t)b * SEQ * P1W + C_KWIN + (size_t)jw * 64 * P1W, P1W, VT + (size_t)(1 * BC + b) * 64 * SEQ + jw * 64, SEQ, tid); }
                  { const bool rowsel = ((mysel >> j) & 1ull) != 0ull;
                    if (__builtin_amdgcn_ballot_w64(rowsel) != 0ull) {
                        nsa_qk(tb, qr, p0, p1, r32, hi); if (j == qb) nsa_mask(p0, p1, hi, tq, -1);
                        nsa_softmax_pv(tb, p0, p1, m, l, o, wsf, lane, r32, hi, rowsel); } }
                  if (two) { const bool rowsel = ((mysel >> (j + 1)) & 1ull) != 0ull;
                    if (__builtin_amdgcn_ballot_w64(rowsel) != 0ull) {
                        nsa_qk(tb + NSA_BUF, qr, p0, p1, r32, hi); if (j + 1 == qb) nsa_mask(p0, p1, hi, tq, -1);
                        nsa_softmax_pv(tb + NSA_BUF, p0, p1, m, l, o, wsf, lane, r32, hi, rowsel); } } }
              const float lt = l + partner32(l, lane);
              nsa_rowaccum(acc, false, o, wsf, lt > 0.f ? g1 / lt : 0.f, r32, hi); }
            { const bf16* kb = P1 + (size_t)b * SEQ * P1W + C_KWIN; const bf16* vb = VT + (size_t)(1 * BC + b) * 64 * SEQ;
              m = -1e30f; l = 0.f;
#pragma unroll
              for (int i = 0; i < 16; ++i) { o[0][i] = 0.f; o[1][i] = 0.f; }
              const int j0 = qb >= 8 ? qb - 8 : 0;
              for (int j = j0; j <= qb; ++j) {
                  LAS unsigned char* tb = lds + par * NSA_STAGE; par ^= 1;
                  nsa_store(tb, kx, vx, tid); __syncthreads();
                  if (j < qb) nsa_load(kx, vx, kb + (size_t)(j + 1) * 64 * P1W, P1W, vb + (j + 1) * 64, SEQ, tid);
                  nsa_qk(tb, qr, p0, p1, r32, hi); if (j == qb || j == qb - 8) nsa_mask(p0, p1, hi, j == qb ? tq : 63, j == qb - 8 ? tq : -1);
                  nsa_softmax_pv(tb, p0, p1, m, l, o, wsf, lane, r32, hi, true); }
              const float lt = l + partner32(l, lane);
              nsa_rowaccum(acc, false, o, wsf, lt > 0.f ? g2 / lt : 0.f, r32, hi);
              nsa_flush(acc, Yc + ((size_t)b * SEQ + qb * 64 + 8 * wave) * 256, lane);
            }
        }
    }
    __syncthreads();
}

constexpr int SB_HEAD_LDS = 17408;
constexpr int SB_FLAG = 4 * SB_HEAD_LDS;
constexpr float SB_LOG2E = 1.4426950408889634f, SB_STOP = -100.0f * 1.4426950408889634f;
__device__ __forceinline__ void p_stick2(Frame& F, int nbusy) {
    const int tid = F.tid, lane = F.lane, wave = F.wave, r32 = lane & 31, hi = lane >> 5, h = wave & 3, qh = wave >> 2;
    LAS unsigned char* lds = F.lds + RING_OFF; LAS unsigned char* hl = lds + h * SB_HEAD_LDS; LAS int* flag = (LAS int*)(lds + SB_FLAG);
    const bf16* P1 = WSP(bf16, WS_P1); const bf16* VT = WSP(bf16, WS_VT) + (size_t)2 * BC * 64 * SEQ;
    bf16* Yb = WSP(bf16, WS_Y) + (size_t)MC * 256;
    const int tq = 32 * qh + r32;
    if (F.bx >= nbusy)
        for (int item = F.bx - nbusy; item < BC * 64; item += F.G - nbusy) {
            const int b = item >> 6, qb = item & 63;
            const size_t row = (size_t)b * SEQ + qb * 64 + tq;
            bf16x8v qr[4];
#pragma unroll
            for (int d0 = 0; d0 < 4; ++d0) qr[d0] = *(const bf16x8v*)(P1 + row * P1W + C_SBQ + h * 64 + d0 * 16 + hi * 8);
            f32x16 o[2], p0, p1;
#pragma unroll
            for (int i = 0; i < 16; ++i) { o[0][i] = 0.f; o[1][i] = 0.f; }
            float R = 0.f;
            const int skey = tid & 63, sc = tid >> 6, sd = tid >> 3, skc = tid & 7;
            v4u kx[4], vx[4];
#define SB_LOAD(jj) do { const bf16* kg_ = P1 + ((size_t)b * SEQ + (jj) * 64 + skey) * P1W + C_SBK + sc * 8; \
                _Pragma("unroll") for (int hh = 0; hh < 4; ++hh) { kx[hh] = *(const v4u*)(kg_ + hh * 64); vx[hh] = *(const v4u*)(VT + ((size_t)(hh * BC + b) * 64 + sd) * SEQ + (jj) * 64 + skc * 8); } } while (0)
            SB_LOAD(qb);
            for (int j = qb; j >= 0; --j) {
                __syncthreads();
                if (j < qb) { int live = 0;
#pragma unroll
                    for (int w = 0; w < 8; ++w) live |= flag[w];
                    if (!live) break; }
#pragma unroll
                for (int hh = 0; hh < 4; ++hh) { *(LAS v4u*)(lds + hh * SB_HEAD_LDS + sc * 1024 + skey * 16) = kx[hh]; { LAS v2u* vd = (LAS v2u*)(lds + hh * SB_HEAD_LDS + NSA_V + sd * NSA_VP + skc * 16); vd[0] = (v2u){vx[hh].x, vx[hh].y}; vd[1] = (v2u){vx[hh].z, vx[hh].w}; } }
                __syncthreads();
                if (j > 0) SB_LOAD(j - 1);
                nsa_qk(hl, qr, p0, p1, r32, hi);
#pragma unroll
                for (int i = 0; i < 16; ++i) { p0[i] *= NSA_C2; p1[i] *= NSA_C2; }
                v4u vv[8]; nsa_vload(hl, vv, r32, hi);
                const int lim = ((j == qb) ? tq : 64) - 4 * hi;
                float Town[8], Tp[8];
#pragma unroll
                for (int kt = 0; kt < 2; ++kt) { f32x16& pp = kt ? p1 : p0;
#pragma unroll
                    for (int g = 0; g < 4; ++g) { float L[4];
#pragma unroll
                        for (int e = 0; e < 4; ++e) { const int kk = 32 * kt + 8 * g + e; const float z = pp[4 * g + e];
                            const float tt = __builtin_amdgcn_logf(1.0f + __builtin_amdgcn_exp2f(-__builtin_fabsf(z)));
                            const float lb = fminf(z, 0.f) - tt; const bool ok = kk < lim;
                            L[e] = ok ? lb - z : 0.f; pp[4 * g + e] = ok ? lb : -INFINITY; }
                        const float E2 = L[3], E1 = E2 + L[2], E0 = E1 + L[1];
                        pp[4 * g + 2] += E2; pp[4 * g + 1] += E1; pp[4 * g] += E0;
                        Town[4 * kt + g] = E0 + L[0]; } }
#pragma unroll
                for (int k = 0; k < 8; ++k) Tp[k] = partner32(Town[k], lane);
                float suf = R;
#pragma unroll
                for (int k = 7; k >= 0; --k) { const float add = suf + (hi == 0 ? Tp[k] : 0.f); f32x16& pp = (k >> 2) ? p1 : p0; const int g = k & 3;
#pragma unroll
                    for (int e = 0; e < 4; ++e) pp[4 * g + e] = __builtin_amdgcn_exp2f(pp[4 * g + e] + add);
                    suf += Town[k] + Tp[k]; }
                R = suf;
                nsa_pv(vv, p0, p1, o);
                const bool alive = R >= SB_STOP;
                const unsigned long long bal = __builtin_amdgcn_ballot_w64(alive);
                if (lane == 0) flag[wave] = bal != 0ull ? 1 : 0;
            }
            { bf16* dst = Yb + ((size_t)b * SEQ + qb * 64 + 32 * qh + 4 * hi) * 256 + h * 64 + r32;
#pragma unroll
              for (int i = 0; i < 16; ++i) { dst[((i & 3) + 8 * (i >> 2)) * 256] = (bf16)f2bf(o[0][i]); dst[((i & 3) + 8 * (i >> 2)) * 256 + 32] = (bf16)f2bf(o[1][i]); } }
        }
#undef SB_LOAD
    __syncthreads();
}

__device__ __forceinline__ void p_sgu2(Frame& F, int layer) {
    LAS unsigned char* vnT = F.lds + RING_OFF;
    const bf16* P1 = WSP(bf16, WS_P1); bf16* Ya = WSP(bf16, WS_Y);
    const float* gain = F.in[3] + (size_t)layer * 256; const float* sw = F.in[4] + (size_t)layer * 4 * 128 * 128; const float* sb = F.in[5] + (size_t)layer * 4 * 128;
    const int lane = F.lane, wave = F.wave, r32 = lane & 31, hi = lane >> 5, g = wave & 3, db = wave >> 2;
    for (int item = F.vcu; item < MC / 128; item += F.G) {
        const size_t r0 = (size_t)item * 128;
        __syncthreads();
        { const f32x4 gg = ((const f32x4*)gain)[lane];
          for (int rr = 0; rr < 16; rr += 2) { const int r = wave * 16 + rr;
              const v2u ra = *(const v2u*)(P1 + (r0 + r) * P1W + C_V + 4 * lane), rb = *(const v2u*)(P1 + (r0 + r + 1) * P1W + C_V + 4 * lane);
              const float a0 = bflo(ra.x), a1 = bfhi(ra.x), a2 = bflo(ra.y), a3 = bfhi(ra.y), b0 = bflo(rb.x), b1 = bfhi(rb.x), b2 = bflo(rb.y), b3 = bfhi(rb.y);
              const float sa = 1.0f / sqrtf(wave_sum((a0 * a0 + a1 * a1) + (a2 * a2 + a3 * a3), lane) * (1.f / 256.f) + EPS);
              const float sb_ = 1.0f / sqrtf(wave_sum((b0 * b0 + b1 * b1) + (b2 * b2 + b3 * b3), lane) * (1.f / 256.f) + EPS);
              LAS unsigned* q = (LAS unsigned*)(vnT + (4 * lane) * 272 + r * 2);
              q[0] = pk2(a0 * sa * gg.x, b0 * sb_ * gg.x); q[68] = pk2(a1 * sa * gg.y, b1 * sb_ * gg.y); q[136] = pk2(a2 * sa * gg.z, b2 * sb_ * gg.z); q[204] = pk2(a3 * sa * gg.w, b3 * sb_ * gg.w); } }
        __syncthreads();
        const int ch = g * 64 + db * 32 + r32;
        for (int tb = 0; tb < 4; ++tb) {
            f32x16 acc;
#pragma unroll
            for (int i = 0; i < 16; ++i) acc[i] = 0.f;
            const int t = 32 * tb + r32; const float* wrow = sw + ((size_t)g * 128 + t) * 128;
            f32x4 wq[8][2];
#pragma unroll
            for (int ks = 0; ks < 8; ++ks) if (ks < 2 * tb + 2) { wq[ks][0] = *(const f32x4*)(wrow + 16 * ks + 8 * hi); wq[ks][1] = *(const f32x4*)(wrow + 16 * ks + 8 * hi + 4); }
#pragma unroll
            for (int ks = 0; ks < 8; ++ks) if (ks < 2 * tb + 2) {
                const int s0 = 16 * ks + 8 * hi;
                const f32x4 w0 = wq[ks][0], w1 = wq[ks][1];
                const v4u a = (v4u){pk2(s0 <= t ? w0.x : 0.f, s0 + 1 <= t ? w0.y : 0.f), pk2(s0 + 2 <= t ? w0.z : 0.f, s0 + 3 <= t ? w0.w : 0.f),
                                    pk2(s0 + 4 <= t ? w1.x : 0.f, s0 + 5 <= t ? w1.y : 0.f), pk2(s0 + 6 <= t ? w1.z : 0.f, s0 + 7 <= t ? w1.w : 0.f)};
                const bf16x8v bfr = *(const LAS bf16x8v*)(vnT + ch * 272 + s0 * 2);
                acc = __builtin_amdgcn_mfma_f32_32x32x16_bf16(__builtin_bit_cast(bf16x8v, a), bfr, acc, 0, 0, 0); }
            float uu[16], bb[16];
#pragma unroll
            for (int i = 0; i < 16; ++i) { const int tt = 32 * tb + (i & 3) + 8 * (i >> 2) + 4 * hi; uu[i] = bf1(P1[(r0 + tt) * P1W + C_U + ch]); bb[i] = sb[g * 128 + tt]; }
#pragma unroll
            for (int i = 0; i < 16; ++i) { const int tt = 32 * tb + (i & 3) + 8 * (i >> 2) + 4 * hi;
                Ya[(r0 + tt) * 256 + ch] = (bf16)f2bf(uu[i] * (acc[i] + bb[i])); }
        }
    }
    __syncthreads();
}

struct Args { const float* in[20]; float* out; unsigned char* ws; int lo, hi, li, rep; };
#ifndef TILED_FFN1
#define TILED_FFN1 0
#endif
#ifndef PG8_ALIGN_EPI
#define PG8_ALIGN_EPI true
#endif
#ifndef PG8_SP2
#define PG8_SP2 true
#endif
#ifndef WGM_PROJ
#define WGM_PROJ PG8_WGM
#endif
#ifndef WGM_FFN1
#define WGM_FFN1 PG8_WGM
#endif
#ifndef WGM_FFN2
#define WGM_FFN2 PG8_WGM
#endif
#ifndef WGM_MOE1
#define WGM_MOE1 PG8_WGM
#endif
#ifndef WGM_MOE2
#define WGM_MOE2 PG8_WGM
#endif
#ifndef FFN_CHUNKS
#define FFN_CHUNKS 2
#endif
#ifndef REP_GEMM
#define REP_GEMM 1
#endif
#ifndef REP_STICK
#define REP_STICK 1
#endif
#ifndef REP_NSA
#define REP_NSA 1
#endif
#ifndef REP_SGU
#define REP_SGU 1
#endif
#ifndef REP_NORM
#define REP_NORM 1
#endif
template <class Epi, class Sched> __device__ __forceinline__ void run_gemm(Frame& F, const bf16* A, const bf16* Bt, int M, int N, int K, const Sched& S, Epi E, bool rotate = true, int tiled = 0, int ld = 0) {
    const int nt_ = K / 64;
#ifdef PG8_KROT
    const int rot_ = rotate ? 2 * (((F.bx & 7) * (nt_ / 2)) / 8) : 0;
#else
    const int rot_ = 0;
#endif
    pg8::Gemm g{A, Bt, M, N, K + F.zs, F.tid, rot_ + F.zs, tiled + F.zs, ld + F.zs, nullptr};
    if (F.rep) E.set_scale0();
    pg8::gemm_phase<Epi, Sched, PG8_ALIGN_EPI, PG8_SP2>(F.lds + RING_OFF, g, S, E);
}
template <class Epi, class Sched> __device__ __forceinline__ void run_gemm_gather(Frame& F, const bf16* A, const int* gidx, const bf16* Bt, int M, int N, int K, const Sched& S, Epi E) {
    pg8::Gemm g{A, Bt, M, N, K + F.zs, F.tid, F.zs, F.zs, F.zs, gidx};
    if (F.rep) E.set_scale0();
    pg8::gemm_phase<Epi, Sched, PG8_ALIGN_EPI, PG8_SP2, true>(F.lds + RING_OFF, g, S, E);
}
__global__ void __launch_bounds__(NWAVES * 64, 2) mk_fwd(Args args) {
    extern __shared__ __attribute__((aligned(16))) unsigned char lds[];
    Frame F0;
    F0.lds = (LAS unsigned char*)lds;
    F0.tid = threadIdx.x; F0.lane = F0.tid & 63; F0.wave = __builtin_amdgcn_readfirstlane(F0.tid >> 6);
    F0.G = gridDim.x; F0.bx = blockIdx.x; F0.vcu = (F0.G % 8 == 0) ? (F0.bx % 8) * (F0.G / 8) + F0.bx / 8 : F0.bx; F0.zv = 0; F0.zs = 0;
    F0.rep = args.rep; F0.ws = args.ws; F0.ctl = (unsigned*)(args.ws + WS_CTL); F0.in = args.in; F0.out = args.out;
    for (int u = F0.tid; u < (LDS_BYTES - LDSCTL_OFF) / 4; u += NWAVES * 64) ((LAS unsigned*)(F0.lds + LDSCTL_OFF))[u] = 0u;
    __syncthreads();
    const int lo = args.lo, hi = args.hi;
    XcdBarrier bar; bar.bar = F0.ctl + CW_BAR + args.li * XCD_BAR_WORDS; bar.x = 0; bar.st = nullptr; bar.w = 0; bar.z = 0;
    if (hi - lo > 1) bar = xcd_barrier_post(F0.ctl + CW_BAR + args.li * XCD_BAR_WORDS, (volatile LAS unsigned*)(F0.lds + MISC_OFF) + 8);
    int step = 0;
#define STEP_BEGIN if (step >= lo && step < hi) { Frame F = F0; { int zv_, zs_; asm volatile("v_mov_b32 %0, 0" : "=v"(zv_)); asm volatile("s_mov_b32 %0, 0" : "=s"(zs_)); \
        F.zv = zv_; F.zs = zs_; F.lane = (int)__builtin_amdgcn_mbcnt_hi(~0u, __builtin_amdgcn_mbcnt_lo(~0u, (unsigned)zv_)); F.wave = F0.wave + zs_; F.tid = F.wave * 64 + F.lane; F.bx = F.bx + zs_; \
        F.vcu = F0.vcu + zs_; F.G = F0.G + zs_; F.lds = (LAS unsigned char*)lds + zs_; F.ws = F0.ws + zs_; F.ctl = F0.ctl + zs_; F.in = F0.in + zs_; F.out = F0.out + zs_; }
#ifdef PROBE_XBAR
#define STEP_END   if (step + 1 < hi) { unsigned zb_; asm volatile("v_mov_b32 %0, 0" : "=v"(zb_)); bar.z = zb_; xcd_barrier(bar); xcd_barrier(bar); } } ++step;
#else
#define STEP_END   if (step + 1 < hi) { unsigned zb_; asm volatile("v_mov_b32 %0, 0" : "=v"(zb_)); bar.z = zb_; xcd_barrier(bar); } } ++step;
#endif

    for (int layer = 0; layer < DEPTH; ++layer) {
        const int jj = layer >> 1;
        STEP_BEGIN
            p_convert(F, layer);
            if (layer == 0) p_norm<0, false>(F, F.in[0], F.in[1], nullptr, 0); else p_norm<0, true>(F, WSP(bf16, WS_H), F.in[1] + (size_t)layer * DM, nullptr, 0);
        STEP_END
        for (int c = 0; c < NCHUNK; ++c) {
            STEP_BEGIN
                pg8::StaticOrder S; S.init(MC, NPROJ, F.G, F.bx, WGM_PROJ);
                pg8::EpiProj E{WSP(bf16, WS_P1), WSP(bf16, WS_G)};
                run_gemm(F, WSP(bf16, WS_HN) + (size_t)c * MC * DM, WSP(bf16, WS_WIN), MC, NPROJ, DM, S, E);
            STEP_END
            STEP_BEGIN
                p_prep(F);
            STEP_END
            STEP_BEGIN
                LAS int* tab = (LAS int*)(F.lds + TAB_OFF);
                __syncthreads(); if (F.tid < 16) tab[F.tid] = F.tid >> 3; __syncthreads();
                pg8::GroupedOrder S; S.so.init(2 * 2048, 512, F.G, F.bx); S.tile_e = tab; S.nN = 2;
                pg8::EpiF32 E{WSP(float, WS_UL), 512, 2};
                run_gemm(F, WSP(bf16, WS_KVC), WSP(bf16, WS_WC1), 2 * 2048, 512, DM, S, E);
                p_sgu2(F, layer);
                p_stick2(F, F.G > 64 ? 32 : 0);
            STEP_END
            STEP_BEGIN
                p_cmpfin(F, layer);
            STEP_END
            STEP_BEGIN
#ifdef OLD_NSA
                p_nsa(F);
#else
                p_nsa2(F);
#endif
            STEP_END
            STEP_BEGIN
                pg8::MergeOrder S; S.so.init(MC, DM, F.G, F.bx); S.nmt = MC / 256;
                pg8::EpiMerge E{WSP(bf16, WS_G), WSP(bf16, WS_MG), MC / 256};
                run_gemm(F, WSP(bf16, WS_Y), WSP(bf16, WS_WBR), 3 * MC, 3 * DM, 256, S, E);
            STEP_END
            STEP_BEGIN
                pg8::StaticOrder S; S.init(MC, DM, F.G, F.bx);
                pg8::EpiResid E{layer == 0 ? F.in[0] + (size_t)c * MC * DM : nullptr, WSP(bf16, WS_H) + (size_t)c * MC * DM, DM, 1.0f};
                run_gemm(F, WSP(bf16, WS_MG), WSP(bf16, WS_WOUT), MC, DM, DM, S, E);
            STEP_END
        }
        if ((layer & 1) == 0) {
            STEP_BEGIN
                p_norm<0, true>(F, WSP(bf16, WS_H), F.in[11] + (size_t)layer * DM, nullptr, 0, Q8_HN, TILED_FFN1);
            STEP_END
            for (int c = 0; c < FFN_CHUNKS; ++c) {
                constexpr int MF = MTOK / FFN_CHUNKS;
                STEP_BEGIN
                    pg8::StaticOrder S; S.init(MF, NFF1, F.G, F.bx, WGM_FFN1);
                    pg8::EpiSwiGLU E{WSP(bf16, WS_HID), DFFP, nullptr, NFF1 / 256};
                    run_gemm(F, WSP(bf16, WS_HN) + (size_t)c * MF * DM, WSP(bf16, WS_WF1), MF, NFF1, DM, S, E, true, TILED_FFN1);
                STEP_END
                STEP_BEGIN
                    pg8::StaticOrder S; S.init(MF, DM, F.G, F.bx, WGM_FFN2);
                    pg8::EpiResid E{nullptr, WSP(bf16, WS_H) + (size_t)c * MF * DM, DM, 1.0f};
                    run_gemm(F, WSP(bf16, WS_HID), WSP(bf16, WS_WF2), MF, DM, DFFP, S, E);
                STEP_END
            }
        } else {
            STEP_BEGIN
                p_norm<1, true>(F, WSP(bf16, WS_H), F.in[11] + (size_t)layer * DM, F.in[15] + (size_t)jj * DM * NEXP, jj, Q8_HN);
            STEP_END
#ifdef ABL_DENSE_MOE
            for (int e = 0; e < NEXP; ++e) {
                STEP_BEGIN
                    pg8::StaticOrder S; S.init(MTOK, NMOE1, F.G, F.bx);
                    pg8::EpiSwiGLU E{WSP(bf16, WS_SCR + 8 * MiB), DFE, WSP(float, WS_SCR + 4 * MiB) + (size_t)e * MTOK, NMOE1 / 256};
                    run_gemm(F, WSP(bf16, WS_HN), WSP(bf16, WS_WF1) + (size_t)e * NMOE1 * DM, MTOK, NMOE1, DM, S, E);
                STEP_END
                STEP_BEGIN
                    pg8::StaticOrder S; S.init(MTOK, DM, F.G, F.bx);
                    pg8::EpiResid E{nullptr, WSP(bf16, WS_H), DM, 1.0f};
                    run_gemm(F, WSP(bf16, WS_SCR + 8 * MiB), WSP(bf16, WS_WF2) + (size_t)e * DM * DFE, MTOK, DM, DFE, S, E);
                STEP_END
            }
#else
            STEP_BEGIN
                p_gather(F, jj, 0, 0);
            STEP_END
            for (int c = 0; c < NCHUNK; ++c)
                for (int r = 0; r < 2; ++r) {
                    STEP_BEGIN
                        const int T = moe_table(F, jj, c, r);
                        pg8::GroupedOrder S; S.so.init(T * 256, NMOE1, F.G, F.bx, WGM_MOE1); S.tile_e = (LAS int*)(F.lds + TAB_OFF); S.nN = NMOE1 / 256;
                        pg8::EpiSwiGLU E{WSP(bf16, WS_HIDM), DFE, WSP(float, WS_WSLOT) + (c * 2 + r) * SLOTS, NMOE1 / 256};
                        run_gemm_gather(F, WSP(bf16, WS_HN), WSP(int, WS_TOKMAP) + (c * 2 + r) * SLOTS, WSP(bf16, WS_WF1), T * 256, NMOE1, DM, S, E);
                    STEP_END
                    STEP_BEGIN
                        const int T = moe_table(F, jj, c, r);
                        const int nwg = T * (DM / 256), R = nwg % F.G, full = nwg - R;
                        const int NS = (4 * R <= F.G) ? 4 : 2;
                        const bool split = (hi - lo > 1) && R > 0 && NS * R <= F.G && !F.rep;
                        int* tokm = WSP(int, WS_TOKMAP) + (c * 2 + r) * SLOTS; float* TB = WSP(float, WS_SCR + 320 * MiB);
                        { pg8::LimitOrder S; S.so.init(T * 256, DM, F.G, F.bx, WGM_MOE2); S.limit = split ? full : nwg;
                          pg8::GroupedLimit GS{S, (LAS int*)(F.lds + TAB_OFF), DM / 256};
                          pg8::EpiScatter E{WSP(bf16, WS_H), tokm, DM / 256, 1.0f};
                          run_gemm(F, WSP(bf16, WS_HIDM), WSP(bf16, WS_WF2), T * 256, DM, DFE, GS, E, false); }
                        const bool more = c * 2 + r < 3;
                        if (split) {
                            const int KP = DFE / NS;
                            if (F.bx < NS * R) { const int Lx = full + F.bx / NS, kp = F.bx % NS;
                                pg8::StaticOrder so; so.init(T * 256, DM, F.G, Lx % F.G, WGM_MOE2); pg8::Unit un; so.next(Lx / F.G, un);
                                un.pn += ((LAS int*)(F.lds + TAB_OFF))[un.pm] * (DM / 256);
                                pg8::SingleOrder S1{un};
                                if (kp == 0) { pg8::EpiScatter E{WSP(bf16, WS_H), tokm, DM / 256, 1.0f};
                                    run_gemm(F, WSP(bf16, WS_HIDM), WSP(bf16, WS_WF2), T * 256, DM, KP, S1, E, false, 0, DFE); }
                                else { pg8::EpiTile E{TB + ((size_t)(Lx - full) * 3 + (kp - 1)) * 65536};
                                    run_gemm(F, WSP(bf16, WS_HIDM) + kp * KP, WSP(bf16, WS_WF2) + kp * KP, T * 256, DM, KP, S1, E, false, 0, DFE); } }
                            if (more) p_gather(F, jj, (c * 2 + r + 1) >> 1, (c * 2 + r + 1) & 1, NS * R);
                            { unsigned zb_; asm volatile("v_mov_b32 %0, 0" : "=v"(zb_)); bar.z = zb_; xcd_barrier(bar); }
                            for (int it = (F.vcu * NWAVES + F.wave); it < R * 256; it += F.G * NWAVES) { const int j = it >> 8, row = it & 255, Lx = full + j;
                                pg8::StaticOrder so; so.init(T * 256, DM, F.G, Lx % F.G, WGM_MOE2); pg8::Unit un; so.next(Lx / F.G, un);
                                const int t = tokm[un.pm * 256 + row];
                                if (t >= 0) { v2u* hp = (v2u*)(WSP(bf16, WS_H) + (size_t)t * DM + un.pn * 256) + F.lane; const v2u hv = *hp; f32x4 a = (f32x4){bflo(hv.x), bfhi(hv.x), bflo(hv.y), bfhi(hv.y)};
                                    for (int q = 0; q < NS - 1; ++q) a = a + ((const f32x4*)(TB + ((size_t)j * 3 + q) * 65536 + row * 256))[F.lane];
                                    *hp = (v2u){pk2(a.x, a.y), pk2(a.z, a.w)}; } }
                        } else if (!F.rep && more) p_gather(F, jj, (c * 2 + r + 1) >> 1, (c * 2 + r + 1) & 1, R);
                    STEP_END
                }
#endif
        }
    }
    STEP_BEGIN
        p_norm<2, true>(F, WSP(bf16, WS_H), F.in[19], nullptr, 0);
    STEP_END
#undef STEP_BEGIN
#undef STEP_END
}

#ifndef MK_STEPS_PER_LAUNCH
#define MK_STEPS_PER_LAUNCH 1
#endif
extern "C" void kernel_launch(void* const* d_in, const int* in_sizes, int n_in, void* d_out, int out_size, void* d_ws, size_t ws_size, hipStream_t stream) {
    static int grid = 0;
    if (grid == 0) {
        if (n_in != 20 || in_sizes[0] != MTOK * DM || out_size != MTOK * DM || ws_size < WS_END) { fprintf(stderr, "kernel_launch: unexpected shapes (n_in %d, in0 %d, out %d, ws %zu)\n", n_in, n_in > 0 ? in_sizes[0] : -1, out_size, ws_size); grid = -1; return; }
        int dev = 0, cus = 0, per_cu = 0;
        if (hipGetDevice(&dev) != hipSuccess || hipDeviceGetAttribute(&cus, hipDeviceAttributeMultiprocessorCount, dev) != hipSuccess) { grid = -1; return; }
        if (hipFuncSetAttribute((const void*)mk_fwd, hipFuncAttributeMaxDynamicSharedMemorySize, LDS_BYTES) != hipSuccess) { fprintf(stderr, "kernel_launch: hipFuncSetAttribute failed\n"); grid = -1; return; }
        if (hipOccupancyMaxActiveBlocksPerMultiprocessor(&per_cu, (const void*)mk_fwd, NWAVES * 64, LDS_BYTES) != hipSuccess || per_cu < 1) fprintf(stderr, "kernel_launch: occupancy query reports %d\n", per_cu);
        (void)hipGetLastError();
        grid = cus;
    }
    if (grid < 0) return;
    if (hipMemsetAsync((char*)d_ws + WS_CTL, 0, CTL_ZERO_BYTES, stream) != hipSuccess) return;
    Args a{};
    for (int i = 0; i < 20; ++i) a.in[i] = (const float*)d_in[i];
    a.out = (float*)d_out; a.ws = (unsigned char*)d_ws; a.rep = 0;
    #ifdef ABL_DENSE_MOE
    constexpr int NSTEPS = 2 * (1 + NCHUNK * 8 + 3) + 2 * (1 + NCHUNK * 8 + 1 + NEXP * 2) + 1;
#else
    constexpr int NSTEPS = 2 * (1 + NCHUNK * 7 + 1 + 2 * FFN_CHUNKS) + 2 * (1 + NCHUNK * 7 + 2 + NCHUNK * 2 * 2) + 1;
#endif
    int li = 0;
#ifdef REPMASK
    static int kinds[256]; int ns = 0;
    for (int layer = 0; layer < DEPTH; ++layer) { kinds[ns++] = 0;
        for (int c = 0; c < NCHUNK; ++c) for (int q = 1; q <= 8; ++q) if (q != 5) kinds[ns++] = q;
        if ((layer & 1) == 0) { kinds[ns++] = 9; for (int c = 0; c < FFN_CHUNKS; ++c) { kinds[ns++] = 10; kinds[ns++] = 11; } }
        else { kinds[ns++] = 12; kinds[ns++] = 17; for (int c = 0; c < NCHUNK * 2; ++c) { kinds[ns++] = 14; kinds[ns++] = 13; } } }
    kinds[ns++] = 16;
    for (int s = 0; s < NSTEPS; ++s) { const int reps = ((REPMASK >> kinds[s]) & 1) ? 2 : 1;
        for (int r = 0; r < reps; ++r) { a.lo = s; a.hi = s + 1; a.li = 0; a.rep = r;
            hipLaunchKernelGGL(mk_fwd, dim3(grid), dim3(NWAVES * 64), LDS_BYTES, stream, a); } }
    (void)li;
#else
    for (int s = 0; s < NSTEPS; s += MK_STEPS_PER_LAUNCH) {
        a.lo = s; a.hi = (s + MK_STEPS_PER_LAUNCH < NSTEPS) ? s + MK_STEPS_PER_LAUNCH : NSTEPS; a.li = (MK_STEPS_PER_LAUNCH > 1) ? li : 0; ++li;
        hipLaunchKernelGGL(mk_fwd, dim3(grid), dim3(NWAVES * 64), LDS_BYTES, stream, a);
        if (hipPeekAtLastError() != hipSuccess) { fprintf(stderr, "kernel_launch: launch failed\n"); break; }
    }
#endif
}
```

```cpp
#define MK_STEPS_PER_LAUNCH 1000
#define PG8_WGM 4
#define FFN_CHUNKS 1
#include <hip/hip_runtime.h>
#include <cstdio>
#include <cstdint>
#include <cmath>
#ifndef PG8_AUX_A
#define PG8_AUX_A 0
#endif
#ifndef PG8_AUX_B
#define PG8_AUX_B 0
#endif
#ifndef PG8_WGM
#define PG8_WGM 8
#endif
namespace pg8 {
#define PG8_LAS __attribute__((address_space(3)))
typedef unsigned short bf16_t;
typedef short bf16x8 __attribute__((ext_vector_type(8)));
typedef float f32x4 __attribute__((ext_vector_type(4)));
typedef unsigned u32x4 __attribute__((ext_vector_type(4)));
constexpr int BM = 256, BK = 64, HALF = 128, HTB = HALF * BK * 2  , STAGE_BYTES = 8 * HTB, NXCD = 8, WGM = PG8_WGM;

__host__ __device__ __forceinline__ int lds_byte(int r, int c) { const int st = (r >> 4) * 2 + (c >> 5), rr = r & 15, cc = c & 31, ob = rr * 64 + cc * 2; return st * 1024 + (ob ^ (((ob >> 9) & 1) << 5)); }
__host__ __device__ __forceinline__ void stage_rc(int b, int& R, int& C) { const int st = b / 1024, sb = b % 1024, swz = sb ^ (((sb >> 9) & 1) << 5); R = (st >> 1) * 16 + swz / 64; C = (st & 1) * 32 + (swz % 64) / 2; }
__host__ __device__ __forceinline__ int perm32(int rho) { const int n = rho >> 4, i = rho & 15; return 8 * (i >> 2) + 4 * n + (i & 3); }

struct Unit { int pm, pn; };
struct Gemm { const bf16_t* A; const bf16_t* Bt; int M, N, K; int zv; int rot; int tiled; int ld; const int* gidx; };

struct StaticOrder {
    int nM, nN, nwg, G, c, wgm;
    __host__ __device__ __forceinline__ void init(int M, int N, int G_, int c_, int wgm_ = WGM) { nM = M / BM; nN = N / BM; nwg = nM * nN; G = G_; c = c_; wgm = wgm_; }
    __host__ __device__ __forceinline__ bool next(int i, Unit& u) const {
        const long L = (long)i * G + c; if (L >= nwg) return false;
        int wgid = (int)L; { const int q = nwg / NXCD, r = nwg % NXCD, xcd = wgid % NXCD, off = wgid / NXCD; wgid = (xcd < r ? xcd * (q + 1) : r * (q + 1) + (xcd - r) * q) + off; }
        const int nig = wgm * nN, gid = wgid / nig, fm = gid * wgm, gsz = (nM - fm) < wgm ? (nM - fm) : wgm;
        u.pm = fm + ((wgid % nig) % gsz); u.pn = (wgid % nig) / gsz; return true;
    }
    __device__ __forceinline__ void a_ready(const Unit&) const {}
    __device__ __forceinline__ void done(const Unit&) const {}
};

__device__ __forceinline__ unsigned cvt_pk_bf16(float lo, float hi) { unsigned r; asm volatile("v_cvt_pk_bf16_f32 %0, %1, %2" : "=v"(r) : "v"(lo), "v"(hi)); return r; }
typedef float f32x2 __attribute__((ext_vector_type(2)));

__device__ __forceinline__ float fast_sigmoid(float x) { return __builtin_amdgcn_rcpf(1.0f + __builtin_amdgcn_exp2f(-1.4426950408889634f * x)); }
__device__ __forceinline__ float gelu_tanh(float x) {
    const float u2 = 1.5957691216057308f * (x + 0.044715f * x * x * x);
    return x * fast_sigmoid(u2);
}
__device__ __forceinline__ float bf_lo(unsigned u) { return __builtin_bit_cast(float, u << 16); }
__device__ __forceinline__ float bf_hi(unsigned u) { return __builtin_bit_cast(float, u & 0xffff0000u); }

#ifdef PG8_NT_OUT
#define PG8_STORE_OUT(p, v) __builtin_nontemporal_store((v), (p))
#else
#define PG8_STORE_OUT(p, v) (*(p) = (v))
#endif
struct EpiProj {
    static constexpr bool PERM = true, AFTER_DRAIN = false, MID = false; static constexpr int MID_TILES = 1; __device__ __forceinline__ void set_scale0() {}
    bf16_t* P1; bf16_t* G;
    __device__ __forceinline__ void operator()(const f32x4 (&acc)[2][2][4][2], const Unit& u, int wr, int wc, int fr, int fq) const {
        const int row0 = u.pm * BM + wr * 64 + fr;
        bf16_t* base; int ldc, colt, act0, act1;
        if (u.pn < 8) { base = P1; ldc = 2048; colt = u.pn * BM; act0 = (u.pn < 2) ? 1 : 0; act1 = (u.pn == 7) ? 2 : act0; }
        else { base = G; ldc = 3072; colt = (u.pn - 8) * BM; act0 = 2; act1 = 2; }
        const int col0 = colt + wc * 32 + 8 * fq;
#pragma unroll
        for (int ai = 0; ai < 2; ++ai)
#pragma unroll
            for (int m = 0; m < 4; ++m) { bf16_t* rowp = base + (size_t)(row0 + ai * HALF + m * 16) * ldc + col0;
#pragma unroll
                for (int bj = 0; bj < 2; ++bj) { f32x4 v0 = acc[ai][bj][m][0], v1 = acc[ai][bj][m][1]; const int act = bj ? act1 : act0;
                    if (act == 1) {
#pragma unroll
                        for (int e = 0; e < 4; ++e) { v0[e] = gelu_tanh(v0[e]); v1[e] = gelu_tanh(v1[e]); } }
                    else if (act == 2) {
#pragma unroll
                        for (int e = 0; e < 4; ++e) { v0[e] = fast_sigmoid(v0[e]); v1[e] = fast_sigmoid(v1[e]); } }
                    u32x4 w; w.x = cvt_pk_bf16(v0[0], v0[1]); w.y = cvt_pk_bf16(v0[2], v0[3]); w.z = cvt_pk_bf16(v1[0], v1[1]); w.w = cvt_pk_bf16(v1[2], v1[3]);
                    *(u32x4*)(rowp + bj * HALF) = w; } }
    }
};
struct EpiMerge {
    static constexpr bool PERM = true, AFTER_DRAIN = false, MID = false; static constexpr int MID_TILES = 1; __device__ __forceinline__ void set_scale0() {}
    const bf16_t* G; bf16_t* MG; int nmt;
    __device__ __forceinline__ void operator()(const f32x4 (&acc)[2][2][4][2], const Unit& u, int wr, int wc, int fr, int fq) const {
        const int i = u.pn >> 2, pn = u.pn & 3, pm = u.pm - i * nmt;
        const int row0 = pm * BM + wr * 64 + fr, col0 = pn * BM + wc * 32 + 8 * fq;
#pragma unroll
        for (int ai = 0; ai < 2; ++ai)
#pragma unroll
            for (int mp = 0; mp < 2; ++mp) {
                u32x4 g[4], o[4];
#pragma unroll
                for (int q = 0; q < 4; ++q) { const int m = 2 * mp + (q >> 1), bj = q & 1; const size_t row = (size_t)(row0 + ai * HALF + m * 16); const int col = col0 + bj * HALF;
                    g[q] = *(const u32x4*)(G + row * 3072 + i * 1024 + col);
                    if (i > 0) o[q] = *(const u32x4*)(MG + row * 1024 + col); else o[q] = (u32x4){0u, 0u, 0u, 0u}; }
#pragma unroll
                for (int q = 0; q < 4; ++q) { const int m = 2 * mp + (q >> 1), bj = q & 1; const size_t row = (size_t)(row0 + ai * HALF + m * 16); const int col = col0 + bj * HALF;
                    f32x4 v0 = acc[ai][bj][m][0], v1 = acc[ai][bj][m][1];
#ifdef ABL_BRANCH
                    if (i == ABL_BRANCH) { v0 = v0 * (float)ABL_SCALE; v1 = v1 * (float)ABL_SCALE; }
#endif
                    v0[0] = v0[0] * bf_lo(g[q].x) + bf_lo(o[q].x); v0[1] = v0[1] * bf_hi(g[q].x) + bf_hi(o[q].x); v0[2] = v0[2] * bf_lo(g[q].y) + bf_lo(o[q].y); v0[3] = v0[3] * bf_hi(g[q].y) + bf_hi(o[q].y);
                    v1[0] = v1[0] * bf_lo(g[q].z) + bf_lo(o[q].z); v1[1] = v1[1] * bf_hi(g[q].z) + bf_hi(o[q].z); v1[2] = v1[2] * bf_lo(g[q].w) + bf_lo(o[q].w); v1[3] = v1[3] * bf_hi(g[q].w) + bf_hi(o[q].w);
                    u32x4 w; w.x = cvt_pk_bf16(v0[0], v0[1]); w.y = cvt_pk_bf16(v0[2], v0[3]); w.z = cvt_pk_bf16(v1[0], v1[1]); w.w = cvt_pk_bf16(v1[2], v1[3]);
                    *(u32x4*)(MG + row * 1024 + col) = w; } }
    }
};
typedef unsigned u32x2 __attribute__((ext_vector_type(2)));
struct EpiResid {
    static constexpr bool PERM = false, AFTER_DRAIN = false, MID = false; static constexpr int MID_TILES = 1; __device__ __forceinline__ void set_scale0() { scale = 0.f; x32 = nullptr; }
    const float* x32; bf16_t* out; int ldc; float scale;
    __device__ __forceinline__ void operator()(const f32x4 (&acc)[2][2][4][2], const Unit& u, int wr, int wc, int fr, int fq) const {
        const int row0 = u.pm * BM + wr * 64 + fr, col0 = u.pn * BM + wc * 32 + 4 * fq;
#pragma unroll
        for (int ai = 0; ai < 2; ++ai)
#pragma unroll
            for (int mp = 0; mp < 2; ++mp) {
                f32x4 b[8];
                if (x32) {
#pragma unroll
                    for (int q = 0; q < 8; ++q) { const int m = 2 * mp + (q >> 2), bj = (q >> 1) & 1, n = q & 1;
                        b[q] = *(const f32x4*)(x32 + (size_t)(row0 + ai * HALF + m * 16) * ldc + col0 + bj * HALF + n * 16); }
                } else {
                    u32x2 t[8];
#pragma unroll
                    for (int q = 0; q < 8; ++q) { const int m = 2 * mp + (q >> 2), bj = (q >> 1) & 1, n = q & 1;
                        t[q] = *(const u32x2*)(out + (size_t)(row0 + ai * HALF + m * 16) * ldc + col0 + bj * HALF + n * 16); }
#pragma unroll
                    for (int q = 0; q < 8; ++q) b[q] = (f32x4){bf_lo(t[q].x), bf_hi(t[q].x), bf_lo(t[q].y), bf_hi(t[q].y)};
                }
#pragma unroll
                for (int q = 0; q < 8; ++q) { const int m = 2 * mp + (q >> 2), bj = (q >> 1) & 1, n = q & 1; const f32x4 r = b[q] + acc[ai][bj][m][n] * scale;
                    *(u32x2*)(out + (size_t)(row0 + ai * HALF + m * 16) * ldc + col0 + bj * HALF + n * 16) = (u32x2){cvt_pk_bf16(r.x, r.y), cvt_pk_bf16(r.z, r.w)}; } }
    }
};
struct EpiF32 {
    static constexpr bool PERM = false, AFTER_DRAIN = false, MID = false; static constexpr int MID_TILES = 1; __device__ __forceinline__ void set_scale0() {}
    float* O; int ldc, nN;
    __device__ __forceinline__ void operator()(const f32x4 (&acc)[2][2][4][2], const Unit& u, int wr, int wc, int fr, int fq) const {
        const int row0 = u.pm * BM + wr * 64 + fr, col0 = (u.pn % nN) * BM + wc * 32 + 4 * fq;
#pragma unroll
        for (int ai = 0; ai < 2; ++ai)
#pragma unroll
            for (int m = 0; m < 4; ++m) { const size_t off = (size_t)(row0 + ai * HALF + m * 16) * ldc + col0;
#pragma unroll
                for (int bj = 0; bj < 2; ++bj)
#pragma unroll
                    for (int n = 0; n < 2; ++n) *(f32x4*)(O + off + bj * HALF + n * 16) = acc[ai][bj][m][n]; }
    }
};
#ifdef EMU_FP8_HID
__device__ __forceinline__ float Q8H(float x) { const int p = __builtin_amdgcn_cvt_pk_fp8_f32(x * 8.f, x * 8.f, 0, false); return __builtin_amdgcn_cvt_f32_fp8(p, 0) * 0.125f; }
#else
__device__ __forceinline__ float Q8H(float x) { return x; }
#endif
struct EpiSwiGLU {
    static constexpr bool PERM = true, AFTER_DRAIN = false, MID = false; static constexpr int MID_TILES = 1; __device__ __forceinline__ void set_scale0() {}
    bf16_t* H; int ldh; const float* rowscale; int nN; int rowmask = 0x7fffffff;
    __device__ __forceinline__ void operator()(const f32x4 (&acc)[2][2][4][2], const Unit& u, int wr, int wc, int fr, int fq) const {
        const int row0 = u.pm * BM + wr * 64 + fr, col0 = (u.pn % nN) * HALF + wc * 32 + 8 * fq;
        float scv[8];
#pragma unroll
        for (int q = 0; q < 8; ++q) scv[q] = rowscale ? rowscale[row0 + (q >> 2) * HALF + (q & 3) * 16] : 1.0f;
#pragma unroll
        for (int ai = 0; ai < 2; ++ai)
#pragma unroll
            for (int m = 0; m < 4; ++m) { const int row = row0 + ai * HALF + m * 16; const float sc = scv[ai * 4 + m];
                float h[8];
#pragma unroll
                for (int n = 0; n < 2; ++n)
#pragma unroll
                    for (int e = 0; e < 4; ++e) { const float g = acc[ai][0][m][n][e], up = acc[ai][1][m][n][e]; h[n * 4 + e] = Q8H(g * fast_sigmoid(g) * up * sc); }
                u32x4 w; w.x = cvt_pk_bf16(h[0], h[1]); w.y = cvt_pk_bf16(h[2], h[3]); w.z = cvt_pk_bf16(h[4], h[5]); w.w = cvt_pk_bf16(h[6], h[7]);
                PG8_STORE_OUT((u32x4*)(H + (size_t)(row & rowmask) * ldh + col0), w); }
    }
};
struct EpiScatter {
    static constexpr bool PERM = false, AFTER_DRAIN = false, MID = false; static constexpr int MID_TILES = 1; __device__ __forceinline__ void set_scale0() { scale = 0.f; }
    bf16_t* out; const int* tok; int nN; float scale;
    __device__ __forceinline__ void operator()(const f32x4 (&acc)[2][2][4][2], const Unit& u, int wr, int wc, int fr, int fq) const {
        const int row0 = u.pm * BM + wr * 64 + fr, col0 = (u.pn % nN) * BM + wc * 32 + 4 * fq;
        int tk[8];
#pragma unroll
        for (int q = 0; q < 8; ++q) tk[q] = tok[row0 + (q >> 2) * HALF + (q & 3) * 16];
#pragma unroll
        for (int ai = 0; ai < 2; ++ai)
#pragma unroll
            for (int mp = 0; mp < 2; ++mp) {
                u32x2 b[8];
#pragma unroll
                for (int q = 0; q < 8; ++q) { const int m = 2 * mp + (q >> 2), bj = (q >> 1) & 1, n = q & 1; const int t = tk[ai * 4 + m];
                    b[q] = *(const u32x2*)(out + (size_t)(t < 0 ? 0 : t) * 1024 + col0 + bj * HALF + n * 16); }
#pragma unroll
                for (int q = 0; q < 8; ++q) { const int m = 2 * mp + (q >> 2), bj = (q >> 1) & 1, n = q & 1; const int t = tk[ai * 4 + m];
                    if (t >= 0) { const f32x4 r = (f32x4){bf_lo(b[q].x), bf_hi(b[q].x), bf_lo(b[q].y), bf_hi(b[q].y)} + acc[ai][bj][m][n] * scale;
                        *(u32x2*)(out + (size_t)t * 1024 + col0 + bj * HALF + n * 16) = (u32x2){cvt_pk_bf16(r.x, r.y), cvt_pk_bf16(r.z, r.w)}; } } }
    }
};
struct GroupedOrder {
    StaticOrder so; const PG8_LAS int* tile_e; int nN;
    __device__ __forceinline__ bool next(int i, Unit& u) const { if (!so.next(i, u)) return false; u.pn += tile_e[u.pm] * nN; return true; }
    __device__ __forceinline__ void a_ready(const Unit&) const {}
    __device__ __forceinline__ void done(const Unit&) const {}
};
struct LimitOrder {
    StaticOrder so; int limit;
    __device__ __forceinline__ bool next(int i, Unit& u) const { if ((long)i * so.G + so.c >= limit) return false; return so.next(i, u); }
    __device__ __forceinline__ void a_ready(const Unit&) const {}
    __device__ __forceinline__ void done(const Unit&) const {}
};
struct GroupedLimit {
    LimitOrder lo; const PG8_LAS int* tile_e; int nN;
    __device__ __forceinline__ bool next(int i, Unit& u) const { if (!lo.next(i, u)) return false; u.pn += tile_e[u.pm] * nN; return true; }
    __device__ __forceinline__ void a_ready(const Unit&) const {}
    __device__ __forceinline__ void done(const Unit&) const {}
};
struct SingleOrder {
    Unit un;
    __device__ __forceinline__ bool next(int i, Unit& u) const { if (i != 0) return false; u = un; return true; }
    __device__ __forceinline__ void a_ready(const Unit&) const {}
    __device__ __forceinline__ void done(const Unit&) const {}
};
struct EpiTile {
    static constexpr bool PERM = false, AFTER_DRAIN = false, MID = false; static constexpr int MID_TILES = 1; __device__ __forceinline__ void set_scale0() {}
    float* O;
    __device__ __forceinline__ void operator()(const f32x4 (&acc)[2][2][4][2], const Unit&, int wr, int wc, int fr, int fq) const {
#pragma unroll
        for (int ai = 0; ai < 2; ++ai)
#pragma unroll
            for (int m = 0; m < 4; ++m)
#pragma unroll
                for (int bj = 0; bj < 2; ++bj)
#pragma unroll
                    for (int n = 0; n < 2; ++n) *(f32x4*)(O + (size_t)(wr * 64 + fr + ai * HALF + m * 16) * 256 + wc * 32 + 4 * fq + bj * HALF + n * 16) = acc[ai][bj][m][n];
    }
};
struct OffsetOrder {
    StaticOrder so; int pn_off;
    __device__ __forceinline__ bool next(int i, Unit& u) const { if (!so.next(i, u)) return false; u.pn += pn_off; return true; }
    __device__ __forceinline__ void a_ready(const Unit&) const {}
    __device__ __forceinline__ void done(const Unit&) const {}
};
struct ProbeOrder {
    StaticOrder so; int pm_mask;
    __device__ __forceinline__ bool next(int i, Unit& u) const { if (!so.next(i, u)) return false; u.pm &= pm_mask; return true; }
    __device__ __forceinline__ void a_ready(const Unit&) const {}
    __device__ __forceinline__ void done(const Unit&) const {}
};
struct MergeOrder {
    StaticOrder so; int nmt;
    __device__ __forceinline__ bool next(int i, Unit& u) const { const int b = i % 3; if (!so.next(i / 3, u)) return false; u.pm += b * nmt; u.pn += b * 4; return true; }
    __device__ __forceinline__ void a_ready(const Unit&) const {}
    __device__ __forceinline__ void done(const Unit&) const {}
};
template <class Epi, class Sched, bool ALIGN_EPI = false, bool SP2 = false, bool GATHER = false>
__device__ __forceinline__ void gemm_phase(PG8_LAS unsigned char* lds, const Gemm g, const Sched& S, const Epi& E) {
    const int tid = g.zv  , wid = __builtin_amdgcn_readfirstlane(tid >> 6), lane = tid & 63, wr = wid >> 2, wc = wid & 3, fr = lane & 15, fq = lane >> 4;
    const int K = g.K, nt = K / BK;
    unsigned voffA[2], voffB[2]; int gR = 0, gC = 0;
#pragma unroll
    for (int i = 0; i < 2; ++i) { int R, C; stage_rc(tid * 16 + i * 8192, R, C); const int Rb = Epi::PERM ? ((R & ~31) + perm32(R & 31)) : R;
        const int LD = g.ld ? g.ld : K;
        const int pitch = g.tiled ? BK : LD;
        voffA[i] = (unsigned)(R * pitch + C) * 2u; voffB[i] = (unsigned)(Rb * pitch + C) * 2u; if (i == 0) { gR = R; gC = C; } }
    const size_t kstep = g.tiled ? (size_t)(BM * BK * 2) : (size_t)(BK * 2);
    const size_t hstep = g.tiled ? (size_t)(HALF * BK * 2) : (size_t)HALF * (g.ld ? g.ld : K) * 2;
    const size_t tstep = (size_t)BM * (g.ld ? g.ld : K) * 2; const size_t tstepA = GATHER ? 0 : tstep, hstepA = GATHER ? 0 : hstep;
    const unsigned ldsw = (unsigned)wid * 1024u;
    const int aoff = lds_byte(wr * 64 + fr, fq * 8), boff = lds_byte(wc * 32 + fr, fq * 8);
#define PG8_SA(b, h) (((b) * 2 + (h)) * HTB)
#define PG8_SB(b, h) ((4 + (b) * 2 + (h)) * HTB)
#define PG8_STAGE(bufoff, gbase, voff) do { _Pragma("unroll") for (int _i = 0; _i < 2; ++_i) \
        __builtin_amdgcn_global_load_lds((const unsigned*)((const char*)(gbase) + (voff)[_i]), (PG8_LAS unsigned*)(lds + (bufoff) + ldsw + _i * 8192), 16, 0, ((bufoff) < 4 * HTB) ? PG8_AUX_A : PG8_AUX_B); } while (0)
#define PG8_LDA(dst, b, h) do { _Pragma("unroll") for (int m = 0; m < 4; ++m) _Pragma("unroll") for (int k = 0; k < 2; ++k) dst[m][k] = *(const PG8_LAS bf16x8*)(lds + PG8_SA(b, h) + aoff + m * 2048 + k * 1024); } while (0)
#define PG8_LDB(dst, b, h) do { _Pragma("unroll") for (int n = 0; n < 2; ++n) _Pragma("unroll") for (int k = 0; k < 2; ++k) dst[n][k] = *(const PG8_LAS bf16x8*)(lds + PG8_SB(b, h) + boff + n * 2048 + k * 1024); } while (0)
#define PG8_MMA(ai, bj, At, Bt) do { __builtin_amdgcn_s_setprio(1); _Pragma("unroll") for (int m = 0; m < 4; ++m) _Pragma("unroll") for (int n = 0; n < 2; ++n) _Pragma("unroll") for (int k = 0; k < 2; ++k) \
        acc[ai][bj][m][n] = __builtin_amdgcn_mfma_f32_16x16x32_bf16(Bt[n][k], At[m][k], acc[ai][bj][m][n], 0, 0, 0); __builtin_amdgcn_s_setprio(0); } while (0)
#define PG8_WAIT_V(n) asm volatile("s_waitcnt vmcnt(" #n ")" ::: "memory")
#define PG8_WAIT_L(n) asm volatile("s_waitcnt lgkmcnt(" #n ")" ::: "memory")
#define PG8_BAR __builtin_amdgcn_s_barrier()
#define PG8_SCHED __builtin_amdgcn_sched_barrier(0)
    Unit cur, nxt; int ui = 0;
    if (!S.next(0, cur)) return;
    f32x4 acc[2][2][4][2];
#pragma unroll
    for (int a = 0; a < 2; ++a)
#pragma unroll
        for (int b = 0; b < 2; ++b)
#pragma unroll
            for (int m = 0; m < 4; ++m)
#pragma unroll
                for (int n = 0; n < 2; ++n) acc[a][b][m][n] = (f32x4){0.f, 0.f, 0.f, 0.f};
    bf16x8 At[4][2], B0[2][2], B1[2][2];
    const char* cA = (const char*)g.A + (size_t)cur.pm * tstepA; const char* cB = (const char*)g.Bt + (size_t)cur.pn * tstep;
    const int rot = g.rot; const size_t rofs = (size_t)rot * kstep; const char* pA = cA + rofs; const char* pB = cB + rofs;
#define PG8_KT(x) ((size_t)(((x) + rot >= nt) ? (x) + rot - nt : (x) + rot))
    unsigned vC[2][2], vN[2][2];
#define PG8_GIDX(u, vv) do { _Pragma("unroll") for (int h_ = 0; h_ < 2; ++h_) _Pragma("unroll") for (int i_ = 0; i_ < 2; ++i_) { \
        if constexpr (GATHER) { const int t_ = g.gidx[(u).pm * BM + h_ * HALF + gR + 64 * i_]; vv[h_][i_] = (unsigned)((t_ < 0 ? 0 : t_) * (g.ld ? g.ld : K) + gC) * 2u; } else vv[h_][i_] = voffA[i_]; } } while (0)
    PG8_GIDX(cur, vC);
    S.a_ready(cur);
    if constexpr (SP2) {
        PG8_STAGE(PG8_SB(0, 0), pB, voffB); PG8_STAGE(PG8_SB(0, 1), pB + hstep, voffB); PG8_STAGE(PG8_SA(0, 0), pA, vC[0]); PG8_STAGE(PG8_SA(0, 1), pA + hstepA, vC[1]);
        if (wr == 1) PG8_BAR;
        PG8_WAIT_V(2); PG8_BAR;
        PG8_STAGE(PG8_SB(1, 0), pB + kstep, voffB); PG8_STAGE(PG8_SA(1, 0), pA + kstep, vC[0]); PG8_STAGE(PG8_SB(1, 1), pB + hstep + kstep, voffB);
        PG8_WAIT_V(6); PG8_BAR;
    } else {
        PG8_STAGE(PG8_SB(0, 0), pB, voffB); PG8_STAGE(PG8_SA(0, 0), pA, vC[0]); PG8_STAGE(PG8_SB(0, 1), pB + hstep, voffB); PG8_STAGE(PG8_SA(0, 1), pA + hstepA, vC[1]);
        if (wr == 1) PG8_BAR;
        PG8_WAIT_V(4); PG8_BAR;
        PG8_STAGE(PG8_SB(1, 0), pB + kstep, voffB); PG8_STAGE(PG8_SA(1, 0), pA + kstep, vC[0]); PG8_STAGE(PG8_SB(1, 1), pB + hstep + kstep, voffB);
        PG8_WAIT_V(6); PG8_BAR;
    }
    for (;;) {
        const bool has_next = S.next(ui + 1, nxt);
        if (has_next) PG8_GIDX(nxt, vN); else { vN[0][0] = vC[0][0]; vN[0][1] = vC[0][1]; vN[1][0] = vC[1][0]; vN[1][1] = vC[1][1]; }
        const char* nA = has_next ? (const char*)g.A + (size_t)nxt.pm * tstepA : cA; const char* nB = has_next ? (const char*)g.Bt + (size_t)nxt.pn * tstep : cB;
        for (int t = 0; t < nt; t += 2) {
            if constexpr (Epi::MID) { if (t != 0 && (t & (Epi::MID_TILES - 1)) == 0) E.mid(acc, cur, t / Epi::MID_TILES, wr, wc, fr, fq); }
            const bool last = (t == nt - 2);
            const char* a1 = cA + PG8_KT(t + 1) * kstep;
            const char* a2 = last ? nA + rofs : cA + PG8_KT(t + 2) * kstep; const char* b2 = last ? nB + rofs : cB + PG8_KT(t + 2) * kstep;
            const char* a3 = a2 + kstep; const char* b3 = b2 + kstep;
            if (last && has_next) S.a_ready(nxt);
            const unsigned v2h0[2] = {last ? vN[0][0] : vC[0][0], last ? vN[0][1] : vC[0][1]}, v2h1[2] = {last ? vN[1][0] : vC[1][0], last ? vN[1][1] : vC[1][1]};
            if constexpr (SP2) {
            PG8_LDB(B0, 0, 0); PG8_LDB(B1, 0, 1); PG8_SCHED; PG8_LDA(At, 0, 0); PG8_STAGE(PG8_SA(1, 1), a1 + hstepA, vC[1]);
            PG8_WAIT_V(8); PG8_WAIT_L(0); PG8_BAR; PG8_MMA(0, 0, At, B0); PG8_MMA(0, 1, At, B1); PG8_BAR; PG8_SCHED;
            PG8_LDA(At, 0, 1); PG8_STAGE(PG8_SB(0, 0), b2, voffB); PG8_STAGE(PG8_SB(0, 1), b2 + hstep, voffB); PG8_STAGE(PG8_SA(0, 0), a2, v2h0);
            PG8_WAIT_V(8); PG8_WAIT_L(0); PG8_BAR; PG8_MMA(1, 0, At, B0); PG8_MMA(1, 1, At, B1); PG8_BAR; PG8_SCHED;
            PG8_LDB(B0, 1, 0); PG8_LDB(B1, 1, 1); PG8_SCHED; PG8_LDA(At, 1, 0); PG8_STAGE(PG8_SA(0, 1), a2 + hstepA, v2h1);
            PG8_WAIT_V(8); PG8_WAIT_L(0); PG8_BAR; PG8_MMA(0, 0, At, B0); PG8_MMA(0, 1, At, B1); PG8_BAR; PG8_SCHED;
            PG8_LDA(At, 1, 1); PG8_STAGE(PG8_SB(1, 0), b3, voffB); PG8_STAGE(PG8_SB(1, 1), b3 + hstep, voffB); PG8_STAGE(PG8_SA(1, 0), a3, v2h0);
            PG8_WAIT_V(8); PG8_WAIT_L(0); PG8_BAR; PG8_MMA(1, 0, At, B0); PG8_MMA(1, 1, At, B1); PG8_BAR; PG8_SCHED;
            } else {
            PG8_LDB(B0, 0, 0); PG8_SCHED; PG8_LDA(At, 0, 0); PG8_STAGE(PG8_SA(1, 1), a1 + hstepA, vC[1]);
            PG8_WAIT_L(8); PG8_BAR; PG8_WAIT_L(0); PG8_MMA(0, 0, At, B0); PG8_BAR; PG8_SCHED;
            PG8_LDB(B1, 0, 1); PG8_STAGE(PG8_SB(0, 0), b2, voffB);
            PG8_BAR; PG8_WAIT_L(0); PG8_MMA(0, 1, At, B1); PG8_BAR;
            PG8_LDA(At, 0, 1); PG8_STAGE(PG8_SA(0, 0), a2, v2h0);
            PG8_BAR; PG8_WAIT_L(0); PG8_MMA(1, 0, At, B0); PG8_BAR; PG8_SCHED;
            PG8_STAGE(PG8_SB(0, 1), b2 + hstep, voffB);
            PG8_WAIT_V(6); PG8_BAR; PG8_MMA(1, 1, At, B1); PG8_BAR;
            PG8_LDB(B0, 1, 0); PG8_SCHED; PG8_LDA(At, 1, 0); PG8_STAGE(PG8_SA(0, 1), a2 + hstepA, v2h1);
            PG8_WAIT_L(8); PG8_BAR; PG8_WAIT_L(0); PG8_MMA(0, 0, At, B0); PG8_BAR; PG8_SCHED;
            PG8_LDB(B1, 1, 1); PG8_STAGE(PG8_SB(1, 0), b3, voffB);
            PG8_BAR; PG8_WAIT_L(0); PG8_MMA(0, 1, At, B1); PG8_BAR;
            PG8_LDA(At, 1, 1); PG8_STAGE(PG8_SA(1, 0), a3, v2h0);
            PG8_BAR; PG8_WAIT_L(0); PG8_MMA(1, 0, At, B0); PG8_BAR; PG8_SCHED;
            PG8_STAGE(PG8_SB(1, 1), b3 + hstep, voffB);
            PG8_WAIT_V(6); PG8_BAR; PG8_MMA(1, 1, At, B1); PG8_BAR;
            }
        }
        if constexpr (ALIGN_EPI) { if (wr == 0) PG8_BAR; }
        if constexpr (!Epi::AFTER_DRAIN) { E(acc, cur, wr, wc, fr, fq); S.done(cur); }
        if (!has_next) break;
#pragma unroll
        for (int a = 0; a < 2; ++a)
#pragma unroll
            for (int b = 0; b < 2; ++b)
#pragma unroll
                for (int m = 0; m < 4; ++m)
#pragma unroll
                    for (int n = 0; n < 2; ++n) acc[a][b][m][n] = (f32x4){0.f, 0.f, 0.f, 0.f};
        cur = nxt; cA = nA; cB = nB; ++ui; vC[0][0] = vN[0][0]; vC[0][1] = vN[0][1]; vC[1][0] = vN[1][0]; vC[1][1] = vN[1][1];
        if constexpr (ALIGN_EPI) { if (wr == 1) PG8_BAR; }
    }
    PG8_WAIT_V(0);
    if constexpr (!ALIGN_EPI) { if (wr == 0) PG8_BAR; }
    PG8_BAR;
    if constexpr (Epi::AFTER_DRAIN) { E.fused(acc, cur, wr, wc, fr, fq, lds, wid, lane); S.done(cur); }
#undef PG8_KT
#undef PG8_SA
#undef PG8_SB
#undef PG8_STAGE
#undef PG8_LDA
#undef PG8_LDB
#undef PG8_MMA
#undef PG8_WAIT_V
#undef PG8_WAIT_L
#undef PG8_BAR
#undef PG8_SCHED
}
}

constexpr int NWAVES = 8;
constexpr int DM = 1024, BATCH = 16, SEQ = 4096, DEPTH = 4, MTOK = BATCH * SEQ;
constexpr int NCHUNK = 2, MC = MTOK / NCHUNK, BC = BATCH / NCHUNK;
constexpr int CIN = 5004, NPROJ = 5120, P1W = 2048, GWID = 3072;
constexpr int DFF = 2752, DFFP = 2816, NFF1 = 2 * DFFP;
constexpr int NEXP = 8, DFE = 3584, NMOE1 = 2 * DFE;
constexpr int SLOTS = MC + 2048;
constexpr float EPS = 1e-6f;
constexpr int C_U = 0, C_V = 256, C_SBQ = 512, C_SBK = 768, C_SBV = 1024, C_CQ = 1280, C_KCMP = 1536, C_VCMP = 1600, C_KSLC = 1664, C_VSLC = 1728, C_KWIN = 1792, C_VWIN = 1856, C_CG = 1920;

constexpr size_t MiB = 1u << 20;
constexpr size_t WS_CTL = 0, CTL_ZERO_BYTES = 1 * MiB;
constexpr size_t WS_ROPE = 1 * MiB;
constexpr size_t WS_BIAS1 = 1 * MiB + 512 * 1024;
constexpr size_t WS_WIN = 2 * MiB;
constexpr size_t WS_WBR = 12 * MiB;
constexpr size_t WS_WOUT = 14 * MiB;
constexpr size_t WS_WC1 = 16 * MiB;
constexpr size_t WS_WF1 = 18 * MiB;
constexpr size_t WS_WF2 = 130 * MiB;
constexpr size_t WS_HN = 186 * MiB;
constexpr size_t WS_SCR = 314 * MiB;
constexpr size_t WS_P1 = WS_SCR;
constexpr size_t WS_G = WS_P1 + 128 * MiB;
constexpr size_t WS_Y = WS_G + 192 * MiB;
constexpr size_t WS_MG = WS_Y + 48 * MiB;
constexpr size_t WS_KVC = WS_MG + 64 * MiB;
constexpr size_t WS_UL = WS_KVC + 8 * MiB;
constexpr size_t WS_KC = WS_UL + 8 * MiB;
constexpr size_t WS_VT = WS_KC + 1 * MiB;
constexpr size_t WS_KCT = WS_VT + 24 * MiB;
constexpr size_t WS_MIX_END = WS_KCT + 1 * MiB;
constexpr size_t WS_HID = WS_SCR;
constexpr size_t WS_ROUTE = WS_SCR;
constexpr size_t WS_TOKMAP = WS_SCR + 1 * MiB;
constexpr size_t WS_WSLOT = WS_SCR + 2 * MiB;
constexpr size_t WS_CNT128 = WS_SCR + 3 * MiB;
constexpr size_t WS_HIDM = WS_SCR + 4 * MiB;
constexpr size_t WS_H = 800 * MiB;
constexpr size_t WS_TB = 928 * MiB;
constexpr size_t WS_END = 976 * MiB;
static_assert(WS_MIX_END <= WS_H && WS_HID + (size_t)MTOK * DFFP * 2 <= WS_H && WS_HIDM + (size_t)2 * SLOTS * DFE * 2 <= WS_H, "d_ws map");
static_assert(WS_WF1 + (size_t)NEXP * NMOE1 * DM * 2 <= WS_WF2 && WS_WF2 + (size_t)NEXP * DM * DFE * 2 <= WS_HN, "weight map");
static_assert((size_t)4 * SLOTS * 4 <= 1 * MiB, "tokmap");
constexpr int CW_BAR = 4096;
constexpr int CW_CNT = 131072;
constexpr int CW_CUR = 131072 + 256;
constexpr int MAX_BAR_REGIONS = 32;
constexpr int RING_OFF = 0, RING_BYTES = 131072;
constexpr int LDSCTL_OFF = RING_BYTES, MISC_OFF = LDSCTL_OFF + 320;
constexpr int TAB_OFF = LDSCTL_OFF + 1024;
constexpr int LDS_BYTES = 147456;

#define GAS __attribute__((address_space(1)))
#define LAS __attribute__((address_space(3)))
typedef unsigned short bf16;
typedef unsigned v4u __attribute__((ext_vector_type(4)));
typedef unsigned v2u __attribute__((ext_vector_type(2)));
typedef float f32x4 __attribute__((ext_vector_type(4)));
typedef int v4i __attribute__((ext_vector_type(4)));
typedef __bf16 bf16x2_t __attribute__((ext_vector_type(2)));
#define LDS_WAIT() asm volatile("s_waitcnt lgkmcnt(0)" ::: "memory")
#define VM_WAIT() asm volatile("s_waitcnt vmcnt(0)" ::: "memory")
__device__ __forceinline__ unsigned f2bf(float f) { unsigned u = __builtin_bit_cast(unsigned, f); return (u + 0x7fffu + ((u >> 16) & 1u)) >> 16; }
__device__ __forceinline__ unsigned pk2(float lo, float hi) { return f2bf(lo) | (f2bf(hi) << 16); }
__device__ __forceinline__ float bflo(unsigned u) { return __builtin_bit_cast(float, u << 16); }
__device__ __forceinline__ float bfhi(unsigned u) { return __builtin_bit_cast(float, u & 0xffff0000u); }
__device__ __forceinline__ float bf1(bf16 h) { return __builtin_bit_cast(float, (unsigned)h << 16); }
__device__ __forceinline__ float dot2bf(unsigned a, unsigned b, float c) { return __builtin_amdgcn_fdot2_f32_bf16(__builtin_bit_cast(bf16x2_t, a), __builtin_bit_cast(bf16x2_t, b), c, false); }
#ifdef EMU_FP8
__device__ __forceinline__ float q8r(float x, float s) { const int p = __builtin_amdgcn_cvt_pk_fp8_f32(x * s, x * s, 0, false); return __builtin_amdgcn_cvt_f32_fp8(p, 0) * (1.0f / s); }
#else
__device__ __forceinline__ float q8r(float x, float) { return x; }
#endif
__device__ __forceinline__ float fexp(float x) { return __builtin_amdgcn_exp2f(1.4426950408889634f * x); }
template <int X> __device__ __forceinline__ float swz_xor(float v) { return __builtin_bit_cast(float, __builtin_amdgcn_ds_swizzle(__builtin_bit_cast(int, v), (X << 10) | 0x1f)); }
__device__ __forceinline__ float wave_sum(float v, int lane) {
#pragma unroll
    for (int o = 1; o < 64; o <<= 1) v += __builtin_bit_cast(float, __builtin_amdgcn_ds_bpermute((lane ^ o) << 2, __builtin_bit_cast(int, v)));
    return v;
}
__device__ __forceinline__ float rdlane(float v, int l) { return __builtin_bit_cast(float, __builtin_amdgcn_readlane(__builtin_bit_cast(int, v), l)); }
__device__ __forceinline__ int bperm(int srclane, int v) { return __builtin_amdgcn_ds_bpermute(srclane << 2, v); }
__constant__ double ROPE_INVF[8] = {1.0, 0.19392274474868576, 0.037606030930863933, 0.0072926647372171093, 0.0014142135623730950, 0.00027424817567620730, 5.3182958969449883e-05, 1.0313385377212460e-05};
#define XB_TMO      128
#define XB_XCNT(j)  (256  + 64 * (j))
#define XB_XSUB(j)  (1280 + 64 * (j))
#define XB_XGEN(j)  (2304 + 64 * (j))
#define XB_TOP      3328
#define XB_TOPGEN   3392
#define XCD_BAR_WORDS 3456
#define XB_SPIN_CAP (1u << 18)

__device__ __forceinline__ unsigned xb_ld(unsigned* p)              { return __hip_atomic_load(p, __ATOMIC_RELAXED, __HIP_MEMORY_SCOPE_AGENT); }
__device__ __forceinline__ unsigned xb_add(unsigned* p, unsigned v) { return __hip_atomic_fetch_add(p, v, __ATOMIC_RELAXED, __HIP_MEMORY_SCOPE_AGENT); }
__device__ __forceinline__ unsigned xb_xcc_id() { return (unsigned)__builtin_amdgcn_s_getreg((3 << 11) | 20) & 0xFu; }
#define XB_SPIN(cond, bar) do { unsigned _sp = 0; while (cond) { __builtin_amdgcn_s_sleep(1); \
    if ((++_sp & 255u) == 0u) { if (xb_ld(&(bar)[XB_TMO])) break; if (_sp > XB_SPIN_CAP) { atomicAdd(&(bar)[XB_TMO], 1u); break; } } } } while (0)

__device__ __forceinline__ bool xb_thread0_w(unsigned w, unsigned z) { return w == 0u && __builtin_amdgcn_mbcnt_hi(~0u, __builtin_amdgcn_mbcnt_lo(~0u, z)) == 0u; }
struct XcdBarrier {
    unsigned* bar; unsigned x; unsigned w, z;
    volatile LAS unsigned* st;
};

__device__ __forceinline__ XcdBarrier xcd_barrier_post(unsigned* bar, volatile LAS unsigned* st) {
    XcdBarrier b; b.bar = bar; b.x = xb_xcc_id(); b.st = st; b.w = (unsigned)__builtin_amdgcn_readfirstlane((int)(threadIdx.x >> 6)); b.z = 0u;
    if (xb_thread0_w(b.w, b.z)) (void)xb_add(&bar[XB_XCNT(b.x)], 1u);
    return b;
}
__device__ __forceinline__ void xcd_barrier_complete(unsigned* bar, unsigned x, unsigned& nloc, unsigned& nx) {
    const unsigned G = gridDim.x * gridDim.y * gridDim.z;
    unsigned sum, cnt, mine, sp = 0u;
    for (;;) {
        sum = 0u; cnt = 0u; mine = 0u;
#pragma unroll
        for (unsigned j = 0; j < 16; ++j) { const unsigned c = xb_ld(&bar[XB_XCNT(j)]); sum += c; cnt += (c > 0u) ? 1u : 0u; mine = (j == x) ? c : mine; }
        if (sum == G) break;
        __builtin_amdgcn_s_sleep(1);
        if ((++sp & 255u) == 0u) { if (xb_ld(&bar[XB_TMO])) break; if (sp > XB_SPIN_CAP) { atomicAdd(&bar[XB_TMO], 1u); break; } }
    }
    nloc = mine > 0u ? mine : 1u; nx = cnt > 0u ? cnt : 1u;
}

__device__ __forceinline__ void xcd_barrier(const XcdBarrier& b) {
    asm volatile("s_waitcnt vmcnt(0)" ::: "memory");
    __syncthreads();
    if (xb_thread0_w(b.w, b.z)) {
        unsigned* bar = b.bar;
        __builtin_amdgcn_s_waitcnt(0);
        unsigned nloc = b.st[0], nx = b.st[1];
        if (nloc == 0u) { xcd_barrier_complete(bar, b.x, nloc, nx); b.st[0] = nloc; b.st[1] = nx; }
        const unsigned old = xb_add(&bar[XB_XSUB(b.x)], 1u);
        const unsigned gen = old / nloc;
        if (old + 1u == (gen + 1u) * nloc) {
            __builtin_amdgcn_fence(__ATOMIC_RELEASE, "agent");
            asm volatile("s_waitcnt vmcnt(0)" ::: "memory");
            const unsigned og = xb_add(&bar[XB_TOP], 1u);
            const unsigned tg = og / nx;
            if (og + 1u == (tg + 1u) * nx) xb_add(&bar[XB_TOPGEN], 1u);
            else XB_SPIN(xb_ld(&bar[XB_TOPGEN]) == tg, bar);
            __builtin_amdgcn_fence(__ATOMIC_ACQUIRE, "agent");
            xb_add(&bar[XB_XGEN(b.x)], 1u);
            asm volatile("s_waitcnt vmcnt(0)" ::: "memory");
        } else {
            XB_SPIN(xb_ld(&bar[XB_XGEN(b.x)]) == gen, bar);
            __builtin_amdgcn_fence(__ATOMIC_ACQUIRE, "agent");
            asm volatile("s_waitcnt vmcnt(0)" ::: "memory");
        }
    }
    __syncthreads();
}

struct Frame {
    LAS unsigned char* lds;
    unsigned* ctl;
    int tid, lane, wave, vcu, G, bx, zv, zs, rep;
    unsigned char* ws;
    const float* const* in;
    float* out;
};
#define WSP(T, off) ((T*)(F.ws + (off)))
__device__ __forceinline__ size_t toff(int row, int k, int K) { return (size_t)(row >> 8) * 256 * K + (size_t)(k >> 6) * (256 * 64) + (size_t)(row & 255) * 64 + (k & 63); }

#ifndef TILED_FFN1
#define TILED_FFN1 0
#endif
#ifndef Q8_W1
#define Q8_W1 0.f
#define Q8_W2 0.f
#define Q8_HN 0.f
#define Q8_HID 0.f
#endif
__device__ __forceinline__ int map_row(int kind, int off, int n) { return kind == 0 ? n + off : (kind == 1 ? (n < 1932 ? n : n + 116) : ((n >> 7) * 256 + (n & 127) + off)); }
__device__ __forceinline__ void tr_item(const float* W, int ldw, int N, int ks, int n0, bf16* WT, int ldt, int kd, int kind, int off, LAS unsigned char* scr, int lane, float q8s = 0.f, int tiled = 0) {
    const int nq = (lane & 15) * 4, kq = lane >> 4;
    f32x4 x[16];
#pragma unroll
    for (int i = 0; i < 16; ++i) x[i] = (n0 + nq < N) ? *(const f32x4*)(W + (size_t)(ks + 4 * i + kq) * ldw + n0 + nq) : (f32x4){0.f, 0.f, 0.f, 0.f};
#pragma unroll
    for (int i = 0; i < 16; ++i) { const int k = 4 * i + kq;
#pragma unroll
        for (int c = 0; c < 4; ++c) { float wv = x[i][c]; if (q8s > 0.f) wv = q8r(wv, q8s); *(LAS bf16*)(scr + (nq + c) * 136 + k * 2) = (bf16)f2bf(wv); } }
    LDS_WAIT(); asm volatile("" ::: "memory");
    if (n0 + lane < N) { const LAS v2u* s = (const LAS v2u*)(scr + lane * 136); const int mr = map_row(kind, off, n0 + lane); bf16* dst = tiled ? WT + toff(mr, kd, ldt) : WT + (size_t)mr * ldt + kd;
#pragma unroll
        for (int q = 0; q < 8; ++q) { const v2u a = s[2 * q], b = s[2 * q + 1]; *(v4u*)(dst + 8 * q) = (v4u){a.x, a.y, b.x, b.y}; } }
    LDS_WAIT(); asm volatile("" ::: "memory");
}
__device__ __forceinline__ void conv(Frame& F, int& tb, const float* W, size_t sW, int nb, int ldw, int N, int ks0, int K, bf16* WT, size_t sWT, int ldt, int kd0, int kind, int off, float q8s = 0.f, int tiled = 0) {
    LAS unsigned char* scr = F.lds + RING_OFF + F.wave * 16384;
    const int gw = F.vcu * NWAVES + F.wave, NGW = F.G * NWAVES;
    const int nblk = (N + 63) / 64, per = (K / 64) * nblk, total = per * nb;
    int first = gw - tb; if (first < 0) first += NGW;
    for (int it = first; it < total; it += NGW) { const int b = it / per, r = it % per, kb = r / nblk, nbk = r % nblk;
        tr_item(W + (size_t)b * sW, ldw, N, ks0 + 64 * kb, 64 * nbk, WT + (size_t)b * sWT, ldt, kd0 + 64 * kb, kind, off, scr, F.lane, q8s, tiled); }
    tb = (tb + total) % NGW;
}
__device__ __forceinline__ void zero_block(Frame& F, bf16* WT, int ldt, int r0, int rows, int c0, int cols, int tiled = 0) {
    const int gt = (F.vcu * NWAVES + F.wave) * 64 + F.lane, NT = F.G * NWAVES * 64, cpr = cols / 8;
    for (int i = gt; i < rows * cpr; i += NT) { const int r = i / cpr, c = i % cpr; const unsigned z = (unsigned)F.zv; *(v4u*)(tiled ? WT + toff(r0 + r, c0 + 8 * c, ldt) : WT + (size_t)(r0 + r) * ldt + c0 + 8 * c) = (v4u){z, z, z, z}; }
}
__device__ __forceinline__ void p_convert(Frame& F, int layer) {
    const int j = layer >> 1; int tb = 0;
    conv(F, tb, F.in[2] + (size_t)layer * DM * CIN, 0, 1, CIN, CIN, 0, DM, WSP(bf16, WS_WIN), 0, DM, 0, 1, 0);
    zero_block(F, WSP(bf16, WS_WIN), DM, 1932, 116, 0, DM);
    conv(F, tb, F.in[9] + (size_t)layer * 3 * 256 * DM, (size_t)256 * DM, 3, DM, DM, 0, 256, WSP(bf16, WS_WBR), (size_t)DM * 256, 256, 0, 0, 0);
    conv(F, tb, F.in[10] + (size_t)layer * DM * DM, 0, 1, DM, DM, 0, DM, WSP(bf16, WS_WOUT), 0, DM, 0, 0, 0);
    conv(F, tb, F.in[7] + (size_t)layer * 2 * 2048 * 256, (size_t)2048 * 256, 2, 256, 256, 0, 1024, WSP(bf16, WS_WC1), (size_t)512 * 1024, 1024, 0, 0, 0);
    conv(F, tb, F.in[7] + (size_t)layer * 2 * 2048 * 256, (size_t)2048 * 256, 2, 256, 256, 1024, 1024, WSP(bf16, WS_WC1), (size_t)512 * 1024, 1024, 0, 0, 256);
    if ((layer & 1) == 0) {
        conv(F, tb, F.in[12] + (size_t)j * DM * DFF, 0, 1, DFF, DFF, 0, DM, WSP(bf16, WS_WF1), 0, DM, 0, 2, 0, Q8_W1, TILED_FFN1);
        conv(F, tb, F.in[13] + (size_t)j * DM * DFF, 0, 1, DFF, DFF, 0, DM, WSP(bf16, WS_WF1), 0, DM, 0, 2, 128, Q8_W1, TILED_FFN1);
        zero_block(F, WSP(bf16, WS_WF1), DM, 21 * 256 + 64, 64, 0, DM, TILED_FFN1);
        zero_block(F, WSP(bf16, WS_WF1), DM, 21 * 256 + 128 + 64, 64, 0, DM, TILED_FFN1);
        conv(F, tb, F.in[14] + (size_t)j * DFF * DM, 0, 1, DM, DM, 0, DFF, WSP(bf16, WS_WF2), 0, DFFP, 0, 0, 0, Q8_W2);
        zero_block(F, WSP(bf16, WS_WF2), DFFP, 0, DM, DFF, DFFP - DFF);
    } else {
        conv(F, tb, F.in[16] + (size_t)j * NEXP * DM * DFE, (size_t)DM * DFE, NEXP, DFE, DFE, 0, DM, WSP(bf16, WS_WF1), (size_t)NMOE1 * DM, DM, 0, 2, 0, Q8_W1);
        conv(F, tb, F.in[17] + (size_t)j * NEXP * DM * DFE, (size_t)DM * DFE, NEXP, DFE, DFE, 0, DM, WSP(bf16, WS_WF1), (size_t)NMOE1 * DM, DM, 0, 2, 128, Q8_W1);
        conv(F, tb, F.in[18] + (size_t)j * NEXP * DFE * DM, (size_t)DFE * DM, NEXP, DM, DM, 0, DFE, WSP(bf16, WS_WF2), (size_t)DM * DFE, DFE, 0, 0, 0, Q8_W2);
    }
    if (F.bx < 8) {
        __syncthreads();
        const int kv = F.bx >> 2, jj = (F.bx & 3) * 64 + F.lane;
        const float* pos = F.in[6] + (size_t)(layer * 2 + kv) * 2048; const float* w1 = F.in[7] + (size_t)(layer * 2 + kv) * 2048 * 256;
        float a = 0.f;
        float a1 = 0.f, a2 = 0.f, a3 = 0.f;
#pragma unroll 8
        for (int k = 0; k < 256; k += 4) { const int kk = F.wave * 256 + k;
            a += pos[kk] * w1[(size_t)kk * 256 + jj]; a1 += pos[kk + 1] * w1[(size_t)(kk + 1) * 256 + jj]; a2 += pos[kk + 2] * w1[(size_t)(kk + 2) * 256 + jj]; a3 += pos[kk + 3] * w1[(size_t)(kk + 3) * 256 + jj]; }
        a = (a + a1) + (a2 + a3);
        LAS float* red = (LAS float*)(F.lds + RING_OFF);
        red[F.wave * 64 + F.lane] = a;
        __syncthreads();
        if (F.wave == 0) { float s = 0.f;
#pragma unroll
            for (int w = 0; w < 8; ++w) s += red[w * 64 + F.lane];
            WSP(float, WS_BIAS1)[kv * 256 + jj] = s; }
        __syncthreads();
    }
    if (layer == 0) {
        const int gt = (F.vcu * NWAVES + F.wave) * 64 + F.lane, NT = F.G * NWAVES * 64;
        for (int idx = gt; idx < SEQ * 8; idx += NT) { const int pos = idx >> 3, i = idx & 7;
            const double invf = ROPE_INVF[i];
            double rev = (double)pos * invf * 0.15915494309189535; rev -= __builtin_floor(rev);
            WSP(float, WS_ROPE)[idx] = __builtin_amdgcn_cosf((float)rev); WSP(float, WS_ROPE)[SEQ * 8 + idx] = __builtin_amdgcn_sinf((float)rev); }
    }
}

template <bool S16> __device__ __forceinline__ f32x4 ld_row4(const void* src, size_t m, int lane, int jx) {
    if (S16) { const v2u t = ((const v2u*)((const bf16*)src + m * DM) + lane)[64 * jx]; return (f32x4){bflo(t.x), bfhi(t.x), bflo(t.y), bfhi(t.y)}; }
    return ((const f32x4*)((const float*)src + m * DM) + lane)[64 * jx];
}
template <int MODE, bool S16> __device__ __forceinline__ void p_norm(Frame& F, const void* src, const float* g, const float* rw, int jmoe, float q8s = 0.f, int tiled = 0) {
    const int gw = F.vcu * NWAVES + F.wave, NGW = F.G * NWAVES, lane = F.lane;
    LAS int* hist = (LAS int*)(F.lds + TAB_OFF) + 192;
    if (MODE == 1) {
        if (F.tid < 16) hist[F.tid] = 0;
        const int gt = gw * 64 + lane, NT = NGW * 64; int* tm = WSP(int, WS_TOKMAP);
        for (int i = gt; i < 4 * SLOTS; i += NT) tm[i] = -1;
        for (int i = F.tid; i < DM * NEXP / 4; i += NWAVES * 64) { const int c = i >> 1, hf = i & 1;
            *(LAS f32x4*)(F.lds + RING_OFF + (((((c >> 8) * 4 + (c & 3)) * 2 + hf) * 64 + ((c & 255) >> 2)) * 16)) = ((const f32x4*)rw)[i]; }
        if (F.tid < DM / 4) *(LAS f32x4*)(F.lds + RING_OFF + 32768 + 16 * F.tid) = ((const f32x4*)g)[F.tid];
        __syncthreads();
    }
    f32x4 gv[4];
    if (MODE != 1) {
#pragma unroll
        for (int jx = 0; jx < 4; ++jx) gv[jx] = ((const f32x4*)g)[lane + 64 * jx]; }
    constexpr int ROWS = (MODE == 1) ? 2 : 4;
    const int nit = (MODE == 1) ? ((MTOK / 128 - F.bx + F.G - 1) / F.G) * (16 / ROWS) : (MTOK - gw + ROWS * NGW - 1) / (ROWS * NGW);
    for (int itx = 0; itx < nit; ++itx) {
        const int chk = (MODE == 1) ? F.bx + (itx / (16 / ROWS)) * F.G : 0;
        const int m0 = (MODE == 1) ? chk * 128 + (itx % (16 / ROWS)) * (NWAVES * ROWS) + F.wave * ROWS : gw + itx * ROWS * NGW;
        const int mstep = (MODE == 1) ? 1 : NGW;
        f32x4 v[ROWS][4]; float ss[ROWS];
#pragma unroll
        for (int u = 0; u < ROWS; ++u) { const int m = m0 + u * mstep;
#pragma unroll
            for (int jx = 0; jx < 4; ++jx) v[u][jx] = ld_row4<S16>(src, (size_t)(m < MTOK ? m : m0), lane, jx); }
#pragma unroll
        for (int u = 0; u < ROWS; ++u) { float s = 0.f;
#pragma unroll
            for (int jx = 0; jx < 4; ++jx) s += (v[u][jx].x * v[u][jx].x + v[u][jx].y * v[u][jx].y) + (v[u][jx].z * v[u][jx].z + v[u][jx].w * v[u][jx].w);
            ss[u] = s; }
#pragma unroll
        for (int o = 1; o < 64; o <<= 1) {
#pragma unroll
            for (int u = 0; u < ROWS; ++u) ss[u] += __builtin_bit_cast(float, __builtin_amdgcn_ds_bpermute((lane ^ o) << 2, __builtin_bit_cast(int, ss[u]))); }
        float lgall[MODE == 1 ? ROWS : 1][8];
        if (MODE == 1) {
            float rs[ROWS];
#pragma unroll
            for (int u = 0; u < ROWS; ++u) { rs[u] = 1.0f / sqrtf(ss[u] * (1.f / DM) + EPS);
#pragma unroll
                for (int e = 0; e < 8; ++e) lgall[u][e] = 0.f; }
#pragma unroll
            for (int jx = 0; jx < 4; ++jx) { const f32x4 gl = *(const LAS f32x4*)(F.lds + RING_OFF + 32768 + 16 * (lane + 64 * jx));
#pragma unroll
                for (int u = 0; u < ROWS; ++u) v[u][jx] = v[u][jx] * rs[u] * gl; }
#pragma unroll
            for (int jx = 0; jx < 4; ++jx) { const LAS f32x4* wr = (const LAS f32x4*)(F.lds + RING_OFF + jx * 8192 + lane * 16);
#pragma unroll
                for (int r = 0; r < 4; ++r) { const f32x4 a = wr[128 * r], b = wr[128 * r + 64];
#pragma unroll
                    for (int u = 0; u < ROWS; ++u) { const float xv = v[u][jx][r];
                        lgall[u][0] += xv * a.x; lgall[u][1] += xv * a.y; lgall[u][2] += xv * a.z; lgall[u][3] += xv * a.w; lgall[u][4] += xv * b.x; lgall[u][5] += xv * b.y; lgall[u][6] += xv * b.z; lgall[u][7] += xv * b.w; } } }
        }
#pragma unroll
        for (int u = 0; u < ROWS; ++u) { const int m = m0 + u * mstep; if (m >= MTOK) continue;
            const float rstd = 1.0f / sqrtf(ss[u] * (1.f / DM) + EPS);
            if (MODE != 1) {
#pragma unroll
            for (int jx = 0; jx < 4; ++jx) v[u][jx] = v[u][jx] * rstd * gv[jx]; }
            if (MODE == 2) {
                f32x4* o = (f32x4*)(F.out + (size_t)m * DM) + lane;
#pragma unroll
                for (int jx = 0; jx < 4; ++jx) o[64 * jx] = v[u][jx];
            } else {
                unsigned long long* o8 = (unsigned long long*)(WSP(bf16, WS_HN) + (size_t)m * DM) + lane;
#pragma unroll
                for (int jx = 0; jx < 4; ++jx) { f32x4 w = v[u][jx];
                    if (tiled) { *(unsigned long long*)(WSP(bf16, WS_HN) + toff(m, 4 * lane + 256 * jx, DM)) = (unsigned long long)pk2(w.x, w.y) | ((unsigned long long)pk2(w.z, w.w) << 32); continue; } if (q8s > 0.f) { w.x = q8r(w.x, q8s); w.y = q8r(w.y, q8s); w.z = q8r(w.z, q8s); w.w = q8r(w.w, q8s); }
                    o8[64 * jx] = (unsigned long long)pk2(w.x, w.y) | ((unsigned long long)pk2(w.z, w.w) << 32); }
            }
            if (MODE == 1) {
                float lg[8];
#pragma unroll
                for (int e = 0; e < 8; ++e) lg[e] = lgall[u][e];
                float h4[4], h2[2], h1;
                { const bool up = lane & 1;
#pragma unroll
                  for (int i = 0; i < 4; ++i) { const float keep = up ? lg[4 + i] : lg[i], send = up ? lg[i] : lg[4 + i]; h4[i] = keep + __builtin_bit_cast(float, bperm(lane ^ 1, __builtin_bit_cast(int, send))); } }
                { const bool up = lane & 2;
#pragma unroll
                  for (int i = 0; i < 2; ++i) { const float keep = up ? h4[2 + i] : h4[i], send = up ? h4[i] : h4[2 + i]; h2[i] = keep + __builtin_bit_cast(float, bperm(lane ^ 2, __builtin_bit_cast(int, send))); } }
                { const bool up = lane & 4; const float keep = up ? h2[1] : h2[0], send = up ? h2[0] : h2[1]; h1 = keep + __builtin_bit_cast(float, bperm(lane ^ 4, __builtin_bit_cast(int, send))); }
                h1 += __builtin_bit_cast(float, bperm(lane ^ 8, __builtin_bit_cast(int, h1))); h1 += __builtin_bit_cast(float, bperm(lane ^ 16, __builtin_bit_cast(int, h1))); h1 += __builtin_bit_cast(float, bperm(lane ^ 32, __builtin_bit_cast(int, h1)));
                lg[0] = rdlane(h1, 0); lg[1] = rdlane(h1, 4); lg[2] = rdlane(h1, 2); lg[3] = rdlane(h1, 6); lg[4] = rdlane(h1, 1); lg[5] = rdlane(h1, 5); lg[6] = rdlane(h1, 3); lg[7] = rdlane(h1, 7);
                int e0 = 0; float v0 = lg[0];
#pragma unroll
                for (int e = 1; e < 8; ++e) if (lg[e] > v0) { v0 = lg[e]; e0 = e; }
                int e1 = -1; float v1 = -INFINITY;
#pragma unroll
                for (int e = 0; e < 8; ++e) if (e != e0 && lg[e] > v1) { v1 = lg[e]; e1 = e; }
                const float w0 = 1.0f / (1.0f + fexp(v1 - v0)), w1 = 1.0f - w0;
                if (lane == 0) { WSP(v4i, WS_ROUTE)[m] = (v4i){e0, e1, __builtin_bit_cast(int, w0), __builtin_bit_cast(int, w1)};
                    __hip_atomic_fetch_add(&hist[e0], 1, __ATOMIC_RELAXED, __HIP_MEMORY_SCOPE_WORKGROUP); __hip_atomic_fetch_add(&hist[8 + e1], 1, __ATOMIC_RELAXED, __HIP_MEMORY_SCOPE_WORKGROUP); }
            }
        }
        if (MODE == 1 && (itx % (16 / ROWS)) == 16 / ROWS - 1) {
            __syncthreads();
            if (F.tid < 16) { WSP(int, WS_CNT128)[(size_t)chk * 16 + F.tid] = hist[F.tid]; hist[F.tid] = 0; }
            __syncthreads();
        }
    }
}

__device__ __forceinline__ void p_prep(Frame& F) {
    const int gw = F.vcu * NWAVES + F.wave, NGW = F.G * NWAVES, lane = F.lane;
    bf16* P1 = WSP(bf16, WS_P1); bf16* KVC = WSP(bf16, WS_KVC); const float* rope = WSP(float, WS_ROPE);
    const int vec = lane >> 3, ri = lane & 7; const int cb = vec < 4 ? C_CQ + vec * 64 : (vec == 4 ? C_KCMP : (vec == 5 ? C_KSLC : C_KWIN));
    for (int row0 = gw; row0 < MC; row0 += 4 * NGW) {
        float x1[4], x2[4], cc[4], ss[4]; bf16 kc48[4], vc64[4];
#pragma unroll
        for (int k = 0; k < 4; ++k) { const int row = row0 + k * NGW < MC ? row0 + k * NGW : row0; const bf16* p = P1 + (size_t)row * P1W; const int pos = row & (SEQ - 1);
            const int cl = lane < 56 ? cb + ri : C_CQ;
            x1[k] = bf1(p[cl]); x2[k] = bf1(p[cl + 8]); cc[k] = rope[pos * 8 + ri]; ss[k] = rope[SEQ * 8 + pos * 8 + ri];
            if (F.rep) { cc[k] = 1.f; ss[k] = 0.f; }
            kc48[k] = p[C_KCMP + 16 + (lane < 48 ? lane : 0)]; vc64[k] = p[C_VCMP + lane]; }
#pragma unroll
        for (int k = 0; k < 4; ++k) { const int row = row0 + k * NGW; if (row >= MC) continue; bf16* p = P1 + (size_t)row * P1W;
            if (lane < 56) { const bf16 o1 = (bf16)f2bf(x1[k] * cc[k] - x2[k] * ss[k]), o2 = (bf16)f2bf(x2[k] * cc[k] + x1[k] * ss[k]);
                p[cb + ri] = o1; p[cb + ri + 8] = o2;
                if (vec == 4) { KVC[(size_t)row * 64 + ri] = o1; KVC[(size_t)row * 64 + ri + 8] = o2; } }
            if (lane < 48) KVC[(size_t)row * 64 + 16 + lane] = kc48[k];
            KVC[(size_t)MC * 64 + (size_t)row * 64 + lane] = vc64[k]; }
    }
    bf16* VT = WSP(bf16, WS_VT);
    for (int it = gw; it < 6 * BC * 64; it += NGW) { const int which = it / (BC * 64), r = it % (BC * 64), b = r >> 6, blk = r & 63;
        const v4u* src = (const v4u*)(P1 + ((size_t)b * SEQ + blk * 64 + lane) * P1W + (which == 0 ? C_VSLC : (which == 1 ? C_VWIN : C_SBV + (which - 2) * 64)));
        bf16* dst = VT + ((size_t)(which * BC + b) * 64) * SEQ + blk * 64 + lane;
        v4u xs[8];
#pragma unroll
        for (int i = 0; i < 8; ++i) xs[i] = src[i];
#pragma unroll
        for (int i = 0; i < 8; ++i) { const v4u x = xs[i];
            dst[(size_t)(8 * i + 0) * SEQ] = (bf16)(x.x & 0xffffu); dst[(size_t)(8 * i + 1) * SEQ] = (bf16)(x.x >> 16);
            dst[(size_t)(8 * i + 2) * SEQ] = (bf16)(x.y & 0xffffu); dst[(size_t)(8 * i + 3) * SEQ] = (bf16)(x.y >> 16);
            dst[(size_t)(8 * i + 4) * SEQ] = (bf16)(x.z & 0xffffu); dst[(size_t)(8 * i + 5) * SEQ] = (bf16)(x.z >> 16);
            dst[(size_t)(8 * i + 6) * SEQ] = (bf16)(x.w & 0xffffu); dst[(size_t)(8 * i + 7) * SEQ] = (bf16)(x.w >> 16); }
    }
}
__device__ __forceinline__ void p_sgu(Frame& F, int layer) {
    LAS float* vn = (LAS float*)(F.lds + RING_OFF);
    const bf16* P1 = WSP(bf16, WS_P1); bf16* Ya = WSP(bf16, WS_Y);
    const float* gain = F.in[3] + (size_t)layer * 256; const float* sw = F.in[4] + (size_t)layer * 4 * 128 * 128; const float* sb = F.in[5] + (size_t)layer * 4 * 128;
    const int lane = F.lane, wave = F.wave;
    for (int item = F.vcu; item < MC / 128; item += F.G) {
        const size_t r0 = (size_t)item * 128;
        __syncthreads();
        for (int rr = 0; rr < 16; ++rr) { const int r = wave * 16 + rr; const v2u raw = *(const v2u*)(P1 + (r0 + r) * P1W + C_V + 4 * lane);
            const float a = bflo(raw.x), b = bfhi(raw.x), c = bflo(raw.y), d = bfhi(raw.y);
            const float rstd = 1.0f / sqrtf(wave_sum((a * a + b * b) + (c * c + d * d), lane) * (1.f / 256.f) + EPS);
            const f32x4 gg = ((const f32x4*)gain)[lane];
            *(LAS f32x4*)(vn + r * 256 + 4 * lane) = (f32x4){a * rstd * gg.x, b * rstd * gg.y, c * rstd * gg.z, d * rstd * gg.w}; }
        __syncthreads();
        const int g = wave & 3, half = wave >> 2;
        for (int i = 0; i < 64; ++i) { const int t = 2 * i + half;
            const float* wrow = sw + ((size_t)g * 128 + t) * 128;
            const float w_lo = wrow[lane], w_hi = wrow[64 + lane];
            float acc = 0.f;
            for (int s = 0; s <= t; ++s) { const float w = (s < 64) ? rdlane(w_lo, s) : rdlane(w_hi, s - 64); acc += w * vn[s * 256 + g * 64 + lane]; }
            const float u = bf1(P1[(r0 + t) * P1W + C_U + g * 64 + lane]);
#ifdef ABL_SGUMIX
            acc = 0.f;
#endif
            Ya[(r0 + t) * 256 + g * 64 + lane] = (bf16)f2bf(u * (acc + sb[g * 128 + t])); }
    }
    __syncthreads();
}

__device__ __forceinline__ void p_cmpfin(Frame& F, int layer) {
    const int gw = F.vcu * NWAVES + F.wave, NGW = F.G * NWAVES, lane = F.lane;
    const float* UL = WSP(float, WS_UL); const float* bias = WSP(float, WS_BIAS1); bf16* KC = WSP(bf16, WS_KC);
    LAS float* w2l = (LAS float*)(F.lds + RING_OFF);
    __syncthreads();
    { const f32x4* src = (const f32x4*)(F.in[8] + (size_t)layer * 2 * 256 * 64);
#pragma unroll 4
      for (int i = F.tid; i < 2 * 256 * 64 / 4; i += NWAVES * 64) *(LAS f32x4*)(w2l + 4 * i) = src[i]; }
    __syncthreads();
    for (int it = gw; it < 2 * BC * 255; it += NGW) { const int kv = it / (BC * 255), r = it % (BC * 255), b = r / 255, m = r % 255;
        const LAS float* w2 = w2l + kv * 256 * 64;
        const float* U = UL + (size_t)(kv * 2048 + b * 256 + m) * 512; const float* L = U + 512 + 256;
        float hv[4];
#pragma unroll
        for (int q = 0; q < 4; ++q) hv[q] = pg8::gelu_tanh(U[64 * q + lane] + L[64 * q + lane] + bias[kv * 256 + 64 * q + lane]);
        float acc0 = 0.f, acc1 = 0.f;
#pragma unroll
        for (int q = 0; q < 4; ++q)
#pragma unroll 8
            for (int jj = 0; jj < 64; jj += 2) { acc0 += rdlane(hv[q], jj) * w2[(64 * q + jj) * 64 + lane]; acc1 += rdlane(hv[q], jj + 1) * w2[(64 * q + jj + 1) * 64 + lane]; }
        const float acc = acc0 + acc1;
        KC[((size_t)(kv * BC + b) * 256 + m) * 64 + lane] = (bf16)f2bf(acc);
        if (kv == 1) { WSP(bf16, WS_KCT)[((size_t)b * 64 + lane) * 256 + m] = (bf16)f2bf(acc); if (m == 254) WSP(bf16, WS_KCT)[((size_t)b * 64 + lane) * 256 + 255] = (bf16)0; }
        else if (m == 254) KC[((size_t)b * 256 + 255) * 64 + lane] = (bf16)0; }
    __syncthreads();
}

__device__ __forceinline__ void p_stick(Frame& F) {
    const int gw = F.vcu * NWAVES + F.wave, NGW = F.G * NWAVES, lane = F.lane;
    const bf16* P1 = WSP(bf16, WS_P1); bf16* Yb = WSP(bf16, WS_Y) + (size_t)MC * 256;
    for (int item = gw; item < BC * 4 * 64; item += NGW) { const int tb = item & 63, h = (item >> 6) & 3, b = item >> 8;
        const int t = tb * 64 + lane; const size_t row = (size_t)b * SEQ + t;
        unsigned q[32];
        { const v4u* qp = (const v4u*)(P1 + row * P1W + C_SBQ + h * 64);
#pragma unroll
          for (int i = 0; i < 8; ++i) { const v4u x = qp[i]; q[4 * i] = x.x; q[4 * i + 1] = x.y; q[4 * i + 2] = x.z; q[4 * i + 3] = x.w; } }
        float o[64];
#pragma unroll
        for (int d = 0; d < 64; ++d) o[d] = 0.f;
        float R = 0.f;
        const bf16* kb = P1 + (size_t)b * SEQ * P1W + C_SBK + h * 64; const bf16* vb = P1 + (size_t)b * SEQ * P1W + C_SBV + h * 64;
        for (int s = t - 1; s >= 0; --s) {
            if (R < -100.f) break;
            const v4u* kp = (const v4u*)(kb + (size_t)s * P1W); const v4u* vp = (const v4u*)(vb + (size_t)s * P1W);
            float z0 = 0.f, z1 = 0.f;
#pragma unroll
            for (int i = 0; i < 8; ++i) { const v4u k = kp[i]; z0 = dot2bf(k.x, q[4 * i], z0); z1 = dot2bf(k.y, q[4 * i + 1], z1); z0 = dot2bf(k.z, q[4 * i + 2], z0); z1 = dot2bf(k.w, q[4 * i + 3], z1); }
            const float z = (z0 + z1) * 0.125f;
            const float tt = 0.6931471805599453f * __builtin_amdgcn_logf(1.0f + fexp(-__builtin_fabsf(z)));
            const float lb = fminf(z, 0.f) - tt, l1m = fminf(-z, 0.f) - tt;
            const float a = fexp(lb + R); R += l1m;
#pragma unroll
            for (int i = 0; i < 8; ++i) { const v4u v = vp[i];
                o[8 * i] += a * bflo(v.x); o[8 * i + 1] += a * bfhi(v.x); o[8 * i + 2] += a * bflo(v.y); o[8 * i + 3] += a * bfhi(v.y);
                o[8 * i + 4] += a * bflo(v.z); o[8 * i + 5] += a * bfhi(v.z); o[8 * i + 6] += a * bflo(v.w); o[8 * i + 7] += a * bfhi(v.w); }
        }
        v4u* op = (v4u*)(Yb + row * 256 + h * 64);
#pragma unroll
        for (int i = 0; i < 8; ++i) op[i] = (v4u){pk2(o[8 * i], o[8 * i + 1]), pk2(o[8 * i + 2], o[8 * i + 3]), pk2(o[8 * i + 4], o[8 * i + 5]), pk2(o[8 * i + 6], o[8 * i + 7])};
    }
}

struct Soft { float mx, l; };
__device__ __forceinline__ float dotq(const LAS v4u* ql, const bf16* kp_) {
    const v4u* kp = (const v4u*)kp_; float z0 = 0.f, z1 = 0.f;
#pragma unroll
    for (int i = 0; i < 8; ++i) { const v4u k = kp[i]; const v4u q = ql[i]; z0 = dot2bf(k.x, q.x, z0); z1 = dot2bf(k.y, q.y, z1); z0 = dot2bf(k.z, q.z, z0); z1 = dot2bf(k.w, q.w, z1); }
    return (z0 + z1) * 0.125f;
}
__device__ __forceinline__ void axpy_row(float p, const bf16* vp_, float (&o)[64]) {
    const v4u* vp = (const v4u*)vp_;
#pragma unroll
    for (int i = 0; i < 8; ++i) { const v4u v = vp[i];
        o[8 * i] += p * bflo(v.x); o[8 * i + 1] += p * bfhi(v.x); o[8 * i + 2] += p * bflo(v.y); o[8 * i + 3] += p * bfhi(v.y);
        o[8 * i + 4] += p * bflo(v.z); o[8 * i + 5] += p * bfhi(v.z); o[8 * i + 6] += p * bflo(v.w); o[8 * i + 7] += p * bfhi(v.w); }
}
__device__ __forceinline__ void nsa_step(const LAS v4u* ql, const bf16* kp_, const bf16* vp_, Soft& S, float (&o)[64]) {
    const float s = dotq(ql, kp_);
    if (s > S.mx) { const float sc = fexp(S.mx - s); S.l *= sc;
#pragma unroll
        for (int d = 0; d < 64; ++d) o[d] *= sc;
        S.mx = s; }
    const float p = fexp(s - S.mx); S.l += p;
    asm volatile("" ::: "memory");
    axpy_row(p, vp_, o);
}
__device__ __forceinline__ void nsa_accum(bf16* yrow, bool first, float sc, const float (&o)[64]) {
    v4u* op = (v4u*)yrow;
#pragma unroll
    for (int i = 0; i < 8; ++i) { v4u old = (v4u){0u, 0u, 0u, 0u}; if (!first) old = op[i];
        op[i] = (v4u){pk2(bflo(old.x) + sc * o[8 * i], bfhi(old.x) + sc * o[8 * i + 1]), pk2(bflo(old.y) + sc * o[8 * i + 2], bfhi(old.y) + sc * o[8 * i + 3]),
                      pk2(bflo(old.z) + sc * o[8 * i + 4], bfhi(old.z) + sc * o[8 * i + 5]), pk2(bflo(old.w) + sc * o[8 * i + 6], bfhi(old.w) + sc * o[8 * i + 7])}; }
}
__device__ __forceinline__ void p_nsa(Frame& F) {
    const int gw = F.vcu * NWAVES + F.wave, NGW = F.G * NWAVES, lane = F.lane;
    const bf16* P1 = WSP(bf16, WS_P1); const bf16* KC = WSP(bf16, WS_KC); bf16* Yc = WSP(bf16, WS_Y) + (size_t)2 * MC * 256;
    LAS float* imp = (LAS float*)(F.lds + RING_OFF + F.wave * 4096);
    LAS v4u* ql = (LAS v4u*)(F.lds + RING_OFF + 32768 + F.wave * 9216 + lane * 144);
    const int qi = lane >> 2, h = lane & 3;
    for (int item = gw; item < BC * 256; item += NGW) { const int b = item >> 8, tg = item & 255;
        const int t = tg * 16 + qi; const size_t row = (size_t)b * SEQ + t; const bf16* prow = P1 + row * P1W;
        { const v4u* qp = (const v4u*)(prow + C_CQ + h * 64);
#pragma unroll
          for (int i = 0; i < 8; ++i) ql[i] = qp[i]; }
        const float g0 = bf1(prow[C_CG + h * 3]), g1 = bf1(prow[C_CG + h * 3 + 1]), g2 = bf1(prow[C_CG + h * 3 + 2]);
        bf16* yrow = Yc + row * 256 + h * 64;
        float o[64];
        for (int i = lane; i < 1024; i += 64) imp[i] = 0.f;
        const int nv = t >= 31 ? ((t - 31) >> 4) + 1 : 0; const int nvmax = (tg * 16 + 15 >= 31) ? ((tg * 16 + 15 - 31) >> 4) + 1 : 0;
        const bf16* kc = KC + (size_t)(0 * BC + b) * 256 * 64; const bf16* vc = KC + (size_t)(1 * BC + b) * 256 * 64;
        { float mx = -INFINITY, l = 0.f;
          for (int m = 0; m < nvmax; ++m) { const float s = dotq(ql, kc + m * 64); if (m < nv) { if (s > mx) { l *= fexp(mx - s); mx = s; } l += fexp(s - mx); } }
          const float rl = l > 0.f ? 1.0f / l : 0.f;
#pragma unroll
          for (int d = 0; d < 64; ++d) o[d] = 0.f;
          for (int m = 0; m < nvmax; ++m) { const float s = dotq(ql, kc + m * 64); const float p = (m < nv) ? fexp(s - mx) * rl : 0.f;
              asm volatile("" ::: "memory");
              axpy_row(p, vc + m * 64, o);
              float P = p + __builtin_bit_cast(float, bperm(lane ^ 1, __builtin_bit_cast(int, p))); P += __builtin_bit_cast(float, bperm(lane ^ 2, __builtin_bit_cast(int, P)));
              if (h == 0) { const int j0 = m >> 2; const bool edge = (m & 3) == 3; imp[qi * 64 + j0] += edge ? 0.5f * P : P; if (edge) imp[qi * 64 + j0 + 1] += 0.5f * P; } }
          nsa_accum(yrow, true, g0, o); }
        unsigned long long mask = 0ull;
        { const int cur = t >> 6, nvb = cur + 1;
          if (h == 0) {
              if (nvb <= 16) mask = (1ull << nvb) - 1ull;
              else { mask = 1ull | (1ull << cur);
                  for (int r = 0; r < 14; ++r) { int best = -1; float bv = -1.f;
                      for (int j = 1; j < cur; ++j) { const float v = imp[qi * 64 + j]; if (!((mask >> j) & 1ull) && v > bv) { bv = v; best = j; } }
                      mask |= 1ull << best; } } }
          const unsigned mlo = (unsigned)bperm(lane & ~3, (int)(unsigned)mask), mhi = (unsigned)bperm(lane & ~3, (int)(unsigned)(mask >> 32));
          mask = ((unsigned long long)mhi << 32) | mlo; }
        { Soft S{-INFINITY, 0.f};
#pragma unroll
          for (int d = 0; d < 64; ++d) o[d] = 0.f;
          const bf16* kb = P1 + (size_t)b * SEQ * P1W + C_KSLC; const bf16* vb = P1 + (size_t)b * SEQ * P1W + C_VSLC;
          unsigned long long mm = mask;
          while (mm) { const int j = __builtin_ctzll(mm); mm &= mm - 1ull;
              for (int kk = 0; kk < 64; ++kk) { const int sp = j * 64 + kk; if (sp > t) break; nsa_step(ql, kb + (size_t)sp * P1W, vb + (size_t)sp * P1W, S, o); } }
          nsa_accum(yrow, false, g1 / S.l, o); }
        { Soft S{-INFINITY, 0.f};
#pragma unroll
          for (int d = 0; d < 64; ++d) o[d] = 0.f;
          const bf16* kb = P1 + (size_t)b * SEQ * P1W + C_KWIN; const bf16* vb = P1 + (size_t)b * SEQ * P1W + C_VWIN;
          for (int i = 0; i < 512; ++i) { const int sp = t - 511 + i; if (sp >= 0) nsa_step(ql, kb + (size_t)sp * P1W, vb + (size_t)sp * P1W, S, o); }
          nsa_accum(yrow, false, g2 / S.l, o); }
    }
}

__device__ __forceinline__ int moe_table(Frame& F, int jmoe, int c, int r, int kpre = 0) {
    LAS int* tab = (LAS int*)(F.lds + TAB_OFF); LAS int* arr = (LAS int*)(F.lds + LDSCTL_OFF + 4096);
    (void)jmoe;
    __syncthreads();
    if (F.tid < 256) { const v4i* s = (const v4i*)(WSP(int, WS_CNT128) + ((size_t)(c * 256 + F.tid) * 2 + r) * 8); const v4i a = s[0], b = s[1];
        *(LAS v4i*)(arr + F.tid * 8) = a; *(LAS v4i*)(arr + F.tid * 8 + 4) = b; }
    __syncthreads();
    if (F.tid < 8) { int tot = 0, pre = 0;
        for (int k = 0; k < 256; ++k) { const int x = arr[k * 8 + F.tid]; pre += (k < kpre) ? x : 0; tot += x; }
        tab[176 + F.tid] = tot; tab[184 + F.tid] = pre; }
    __syncthreads();
    if (F.tid == 0) { int base = 0, T = 0;
        for (int e = 0; e < 8; ++e) { const int cnt = tab[176 + e];
            const int nt = (cnt + 255) >> 8; tab[160 + e] = base; for (int i = 0; i < nt && T + i < 160; ++i) tab[T + i] = e; T += nt; base += nt * 256; }
        tab[168] = T < 136 ? T : 136; }
    __syncthreads();
    return tab[168];
}
__device__ __forceinline__ void p_gather(Frame& F, int jmoe, int c, int r, int nbusy = 0) {
    if (F.bx < nbusy) return;
    LAS int* tab = (LAS int*)(F.lds + TAB_OFF); LAS int* cntw = tab + 256; LAS int* basew = tab + 320;
    const int lane = F.lane, wave = F.wave;
    const v4i* route = WSP(v4i, WS_ROUTE); int* tokmap = WSP(int, WS_TOKMAP) + (c * 2 + r) * SLOTS; float* wslot = WSP(float, WS_WSLOT) + (c * 2 + r) * SLOTS;
    for (int ch = F.bx - nbusy; ch < MC / 128; ch += F.G - nbusy) {
        moe_table(F, jmoe, c, r, ch);
        const int m = c * MC + ch * 128 + wave * 16 + (lane & 15); const v4i rt = route[m];
        const int e = lane < 16 ? (r ? rt.y : rt.x) : -1; const float w = __builtin_bit_cast(float, r ? rt.w : rt.z);
        unsigned long long bal[8]; int mycnt = 0;
#pragma unroll
        for (int ee = 0; ee < 8; ++ee) { bal[ee] = __builtin_amdgcn_ballot_w64(e == ee); if (lane == ee) mycnt = __builtin_popcountll(bal[ee]); }
        if (lane < 8) cntw[wave * 8 + lane] = mycnt;
        __syncthreads();
        if (wave == 0 && lane < 8) { int base = tab[184 + lane];
#pragma unroll
            for (int w8 = 0; w8 < 8; ++w8) { basew[w8 * 8 + lane] = base; base += cntw[w8 * 8 + lane]; } }
        __syncthreads();
        int pos = 0;
#pragma unroll
        for (int ee = 0; ee < 8; ++ee) if (e == ee) pos = basew[wave * 8 + ee] + __builtin_popcountll(bal[ee] & ((1ull << lane) - 1ull));
        int slot = 0;
        if (lane < 16) { slot = tab[160 + e] + pos; tokmap[slot] = m; wslot[slot] = w; }
    }
}

typedef float f32x16 __attribute__((ext_vector_type(16)));
typedef short bf16x8v __attribute__((ext_vector_type(8)));
typedef float f32x2v __attribute__((ext_vector_type(2)));
constexpr int NSA_K = 0, NSA_V = 8192, NSA_BUF = 17408, NSA_STAGE = 2 * NSA_BUF, NSA_IMP = 69632, NSA_CARRY = 86016, NSA_SEL = 103424, NSA_WSF = 103936;
constexpr int NSA_VP = 136;
constexpr float NSA_C2 = 0.125f * 1.4426950408889634f;
constexpr float NSA_DEFER = 8.0f / (0.125f * 1.4426950408889634f);
__device__ __forceinline__ unsigned cvtpk(float lo, float hi) { f32x2v v = {lo, hi}; bf16x2_t b = __builtin_convertvector(v, bf16x2_t); return __builtin_bit_cast(unsigned, b); }
__device__ __forceinline__ float partner32(float v, int lane) { return __builtin_bit_cast(float, __builtin_amdgcn_ds_bpermute((lane ^ 32) << 2, __builtin_bit_cast(int, v))); }
__device__ __forceinline__ void nsa_load(v4u& kx, v4u& vx, const bf16* Kg, int kp, const bf16* Vg, int vp, int tid) {
    kx = *(const v4u*)(Kg + (size_t)(tid & 63) * kp + (tid >> 6) * 8); vx = *(const v4u*)(Vg + (size_t)(tid >> 3) * vp + (tid & 7) * 8);
}
__device__ __forceinline__ void nsa_store(LAS unsigned char* lds, const v4u& kx, const v4u& vx, int tid) {
    *(LAS v4u*)(lds + NSA_K + (tid >> 6) * 1024 + (tid & 63) * 16) = kx; { LAS v2u* vd = (LAS v2u*)(lds + NSA_V + (tid >> 3) * NSA_VP + (tid & 7) * 16); vd[0] = (v2u){vx.x, vx.y}; vd[1] = (v2u){vx.z, vx.w}; }
}
__device__ __forceinline__ void nsa_qk(const LAS unsigned char* lds, const bf16x8v (&qr)[4], f32x16& p0, f32x16& p1, int r32, int hi) {
    bf16x8v kf[8];
#pragma unroll
    for (int d0 = 0; d0 < 4; ++d0) {
        kf[2 * d0] = *(const LAS bf16x8v*)(lds + NSA_K + (2 * d0 + hi) * 1024 + r32 * 16);
        kf[2 * d0 + 1] = *(const LAS bf16x8v*)(lds + NSA_K + (2 * d0 + hi) * 1024 + 512 + r32 * 16); }
    __builtin_amdgcn_sched_barrier(0);
#pragma unroll
    for (int i = 0; i < 16; ++i) { p0[i] = 0.f; p1[i] = 0.f; }
#pragma unroll
    for (int d0 = 0; d0 < 4; ++d0) {
        p0 = __builtin_amdgcn_mfma_f32_32x32x16_bf16(kf[2 * d0], qr[d0], p0, 0, 0, 0);
        p1 = __builtin_amdgcn_mfma_f32_32x32x16_bf16(kf[2 * d0 + 1], qr[d0], p1, 0, 0, 0);
    }
}
__device__ __forceinline__ void nsa_mask(f32x16& p0, f32x16& p1, int hi, int hiL, int loL) {
    const int hl = hiL - 4 * hi, ll = loL - 4 * hi;
#pragma unroll
    for (int i = 0; i < 16; ++i) { const int c = (i & 3) + 8 * (i >> 2);
        if (!(c <= hl && c > ll)) p0[i] = -INFINITY;
        if (!(c + 32 <= hl && c + 32 > ll)) p1[i] = -INFINITY; }
}
__device__ __forceinline__ float nsa_max32(const f32x16& p0, const f32x16& p1) {
    float a = fmaxf(fmaxf(p0[0], p0[1]), p1[0]), b = fmaxf(fmaxf(p0[2], p0[3]), p1[1]); a = fmaxf(fmaxf(a, p1[2]), p1[3]);
#pragma unroll
    for (int i = 4; i < 16; i += 4) { a = fmaxf(fmaxf(a, p0[i]), p0[i + 1]); b = fmaxf(fmaxf(b, p0[i + 2]), p0[i + 3]); a = fmaxf(fmaxf(a, p1[i]), p1[i + 1]); b = fmaxf(fmaxf(b, p1[i + 2]), p1[i + 3]); }
    return fmaxf(a, b);
}
__device__ __forceinline__ void nsa_vload(const LAS unsigned char* lds, v4u (&vv)[8], int r32, int hi) {
#pragma unroll
    for (int db = 0; db < 2; ++db) { const LAS unsigned char* vrow = lds + NSA_V + (32 * db + r32) * NSA_VP;
#pragma unroll
        for (int ks = 0; ks < 4; ++ks) {
            const int kb = (ks >> 1) * 32 + (ks & 1) * 16 + 4 * hi;
            const v2u lo = *(const LAS v2u*)(vrow + kb * 2), hh = *(const LAS v2u*)(vrow + (kb + 8) * 2);
            vv[4 * db + ks] = (v4u){lo.x, lo.y, hh.x, hh.y}; } }
    __builtin_amdgcn_sched_barrier(0);
}
__device__ __forceinline__ void nsa_pv(const v4u (&vv)[8], const f32x16& p0, const f32x16& p1, f32x16 (&o)[2]) {
    bf16x8v pa[4];
#pragma unroll
    for (int s = 0; s < 2; ++s) {
        const v4u a = (v4u){cvtpk(p0[8 * s], p0[8 * s + 1]), cvtpk(p0[8 * s + 2], p0[8 * s + 3]), cvtpk(p0[8 * s + 4], p0[8 * s + 5]), cvtpk(p0[8 * s + 6], p0[8 * s + 7])};
        const v4u b = (v4u){cvtpk(p1[8 * s], p1[8 * s + 1]), cvtpk(p1[8 * s + 2], p1[8 * s + 3]), cvtpk(p1[8 * s + 4], p1[8 * s + 5]), cvtpk(p1[8 * s + 6], p1[8 * s + 7])};
        pa[s] = __builtin_bit_cast(bf16x8v, a); pa[2 + s] = __builtin_bit_cast(bf16x8v, b); }
#pragma unroll
    for (int ks = 0; ks < 4; ++ks)
#pragma unroll
        for (int db = 0; db < 2; ++db) o[db] = __builtin_amdgcn_mfma_f32_32x32x16_bf16(pa[ks], __builtin_bit_cast(bf16x8v, vv[4 * db + ks]), o[db], 0, 0, 0);
}
__device__ __forceinline__ void nsa_rowscale(f32x16 (&o)[2], LAS float* wsf, float f, int r32, int hi) {
    if (hi == 0) wsf[r32] = f;
#pragma unroll
    for (int g = 0; g < 4; ++g) { const f32x4 w = *(const LAS f32x4*)(wsf + 8 * g + 4 * hi);
#pragma unroll
        for (int e = 0; e < 4; ++e) { o[0][4 * g + e] *= w[e]; o[1][4 * g + e] *= w[e]; } }
}
constexpr int NSA_ACC = 104960;
__device__ __forceinline__ void nsa_rowaccum(LAS unsigned char* acc, bool first, const f32x16 (&o)[2], LAS float* wsf, float f, int r32, int hi) {
    if (hi == 0) wsf[r32] = f;
#pragma unroll
    for (int g = 0; g < 4; ++g) { const f32x4 w = *(const LAS f32x4*)(wsf + 8 * g + 4 * hi);
#pragma unroll
        for (int e = 0; e < 4; ++e) { LAS bf16* p = (LAS bf16*)(acc + (8 * g + 4 * hi + e) * 128 + r32 * 2); const int i = 4 * g + e;
            float a = o[0][i] * w[e], b = o[1][i] * w[e];
            if (!first) { a += bf1(p[0]); b += bf1(p[32]); }
            p[0] = (bf16)f2bf(a); p[32] = (bf16)f2bf(b); } }
}
__device__ __forceinline__ void nsa_flush(const LAS unsigned char* acc, bf16* ytok  , int lane) {
    asm volatile("" ::: "memory");
    { int z_; asm volatile("v_mov_b32 %0, 0" : "=v"(z_)); lane += z_; }
#pragma unroll
    for (int ps = 0; ps < 4; ++ps) { const int row = ps * 8 + (lane >> 3), ch = lane & 7;
        const v4u v = *(const LAS v4u*)(acc + row * 128 + ch * 16);
        *(v4u*)((unsigned char*)ytok + (unsigned)(((row >> 2) * 256 + (row & 3) * 64 + ch * 8) * 2)) = v; }
}
__device__ __forceinline__ void nsa_softmax_pv(const LAS unsigned char* lds, f32x16& p0, f32x16& p1, float& m, float& l, f32x16 (&o)[2], LAS float* wsf, int lane, int r32, int hi, bool rowok) {
    float mt = nsa_max32(p0, p1); mt = rowok ? mt : -INFINITY; mt = fmaxf(mt, partner32(mt, lane));
    const float mn = fmaxf(m, mt);
    if (__builtin_amdgcn_ballot_w64(mn > m + NSA_DEFER) != 0ull) { const float f = __builtin_amdgcn_exp2f((m - mn) * NSA_C2); l *= f; nsa_rowscale(o, wsf, f, r32, hi); m = mn; }
    const float off = rowok ? -m * NSA_C2 : -INFINITY;
    v4u vv[8]; nsa_vload(lds, vv, r32, hi);
    float s = 0.f;
#pragma unroll
    for (int i = 0; i < 16; ++i) { p0[i] = __builtin_amdgcn_exp2f(__builtin_fmaf(p0[i], NSA_C2, off)); p1[i] = __builtin_amdgcn_exp2f(__builtin_fmaf(p1[i], NSA_C2, off)); s += p0[i] + p1[i]; }
    l += s;
    nsa_pv(vv, p0, p1, o);
}
__device__ __forceinline__ void p_nsa2(Frame& F) {
    const int tid = F.tid, lane = F.lane, wave = F.wave, r32 = lane & 31, hi = lane >> 5;
    LAS unsigned char* lds = F.lds + RING_OFF;
    LAS float* imp = (LAS float*)(lds + NSA_IMP); LAS float* carry = (LAS float*)(lds + NSA_CARRY);
    LAS unsigned long long* selm = (LAS unsigned long long*)(lds + NSA_SEL); LAS float* wsf = (LAS float*)(lds + NSA_WSF) + wave * 32;
    LAS unsigned char* acc = wave < 6 ? lds + NSA_ACC + wave * 4096 : F.lds + LDSCTL_OFF + 4096 + (wave - 6) * 4096;
    const bf16* P1 = WSP(bf16, WS_P1); const bf16* KC = WSP(bf16, WS_KC); const bf16* KCT = WSP(bf16, WS_KCT); const bf16* VT = WSP(bf16, WS_VT);
    bf16* Yc = WSP(bf16, WS_Y) + (size_t)2 * MC * 256;
    const int ql = r32 >> 2, h = r32 & 3, tq = 8 * wave + ql;
    int par = 0;
    for (int it = 0; it < 2; ++it) {
        for (int pair = F.vcu; pair < BC * 32; pair += F.G) {
            const int b = pair >> 5, sx = pair & 31, qb = it ? 63 - sx : sx;
            const int t = qb * 64 + tq; const size_t row = (size_t)b * SEQ + t; const bf16* prow = P1 + row * P1W;
            bf16x8v qr[4];
#pragma unroll
            for (int d0 = 0; d0 < 4; ++d0) qr[d0] = *(const bf16x8v*)(prow + C_CQ + h * 64 + d0 * 16 + hi * 8);
            const float g0 = bf1(prow[C_CG + h * 3]), g1 = bf1(prow[C_CG + h * 3 + 1]), g2 = bf1(prow[C_CG + h * 3 + 2]);
            f32x16 o[2], p0, p1;
            __syncthreads();
            for (int i = tid; i < 64 * 64; i += 512) imp[i] = 0.f;
            for (int i = tid; i < 64 * 68; i += 512) carry[i] = 0.f;
            const int nct = (4 * qb + 3 + 63) >> 6;
            const int mlim = t >= 31 ? ((t - 31) >> 4) : -1;
            const bf16* kcb = KC + (size_t)b * 256 * 64; const bf16* vcb = KCT + (size_t)b * 64 * 256;
            float m = -1e30f, l = 0.f;
            v4u kx, vx;
            nsa_load(kx, vx, kcb, 64, vcb, 256, tid);
            for (int ti = 0; ti < nct; ++ti) {
                LAS unsigned char* tb = lds + par * NSA_STAGE; par ^= 1;
                nsa_store(tb, kx, vx, tid); __syncthreads();
                { const int tn = ti + 1 < nct ? ti + 1 : 0; nsa_load(kx, vx, kcb + (size_t)tn * 64 * 64, 64, vcb + tn * 64, 256, tid); }
                nsa_qk(tb, qr, p0, p1, r32, hi); nsa_mask(p0, p1, hi, mlim - 64 * ti, -1);
                float mt = nsa_max32(p0, p1); mt = fmaxf(mt, partner32(mt, lane));
                const float mn = fmaxf(m, mt); l *= __builtin_amdgcn_exp2f((m - mn) * NSA_C2); m = mn;
                const float off = -m * NSA_C2; float s = 0.f;
#pragma unroll
                for (int i = 0; i < 16; ++i) s += __builtin_amdgcn_exp2f(__builtin_fmaf(p0[i], NSA_C2, off)) + __builtin_amdgcn_exp2f(__builtin_fmaf(p1[i], NSA_C2, off));
                l += s; }
            { const float lt = l + partner32(l, lane); const float rl = lt > 0.f ? 1.0f / lt : 0.f;
#pragma unroll
              for (int i = 0; i < 16; ++i) { o[0][i] = 0.f; o[1][i] = 0.f; }
              for (int ti = 0; ti < nct; ++ti) {
                  LAS unsigned char* tb = lds + par * NSA_STAGE; par ^= 1;
                  nsa_store(tb, kx, vx, tid); __syncthreads();
                  if (ti + 1 < nct) nsa_load(kx, vx, kcb + (size_t)(ti + 1) * 64 * 64, 64, vcb + (ti + 1) * 64, 256, tid);
                  nsa_qk(tb, qr, p0, p1, r32, hi); nsa_mask(p0, p1, hi, mlim - 64 * ti, -1);
                  v4u vv[8]; nsa_vload(tb, vv, r32, hi);
                  { const float off = -m * NSA_C2;
#pragma unroll
                    for (int i = 0; i < 16; ++i) { p0[i] = __builtin_amdgcn_exp2f(__builtin_fmaf(p0[i], NSA_C2, off)) * rl; p1[i] = __builtin_amdgcn_exp2f(__builtin_fmaf(p1[i], NSA_C2, off)) * rl; } }
#pragma unroll
                  for (int kt = 0; kt < 2; ++kt)
#pragma unroll
                      for (int g = 0; g < 4; ++g) { const f32x16& pp = kt ? p1 : p0;
                          float A = pp[4 * g] + pp[4 * g + 1] + pp[4 * g + 2] + 0.5f * pp[4 * g + 3], B = 0.5f * pp[4 * g + 3];
                          A += __builtin_bit_cast(float, bperm(lane ^ 1, __builtin_bit_cast(int, A))); A += __builtin_bit_cast(float, bperm(lane ^ 2, __builtin_bit_cast(int, A)));
                          B += __builtin_bit_cast(float, bperm(lane ^ 1, __builtin_bit_cast(int, B))); B += __builtin_bit_cast(float, bperm(lane ^ 2, __builtin_bit_cast(int, B)));
                          if (h == 0) { const int j = 16 * ti + 8 * kt + 2 * g + hi; imp[tq * 64 + j] = A; carry[tq * 68 + j + 1] = B; } }
                  nsa_pv(vv, p0, p1, o); }
              nsa_rowaccum(acc, true, o, wsf, g0, r32, hi); }
            __syncthreads();
            v4u kx2, vx2;
            { const bf16* kb = P1 + (size_t)b * SEQ * P1W + C_KSLC; const bf16* vb = VT + (size_t)(0 * BC + b) * 64 * SEQ;
              nsa_load(kx, vx, kb, P1W, vb, SEQ, tid); if (qb >= 1) nsa_load(kx2, vx2, kb + (size_t)64 * P1W, P1W, vb + 64, SEQ, tid); }
            { const int q = tid >> 3, sub = tid & 7; unsigned long long mask;
              if (qb + 1 <= 16) mask = (1ull << (qb + 1)) - 1ull;
              else { mask = 1ull | (1ull << qb);
                  unsigned long long key[8];
#pragma unroll
                  for (int i = 0; i < 8; ++i) { const int j = sub * 8 + i; const float v = imp[q * 64 + j] + carry[q * 68 + j];
                      key[i] = (j >= 1 && j < qb) ? (((unsigned long long)__builtin_bit_cast(unsigned, v) << 32) | (unsigned)(63 - j)) : 0ull; }
                  for (int r = 0; r < 14; ++r) { unsigned long long best = key[0];
#pragma unroll
                      for (int i = 1; i < 8; ++i) best = key[i] > best ? key[i] : best;
#define NSA_DPPMAX(ctrl) do { const unsigned lo_ = (unsigned)__builtin_amdgcn_update_dpp(0, (int)(unsigned)best, ctrl, 0xf, 0xf, false), hh_ = (unsigned)__builtin_amdgcn_update_dpp(0, (int)(unsigned)(best >> 32), ctrl, 0xf, 0xf, false); \
                          const unsigned long long other_ = ((unsigned long long)hh_ << 32) | lo_; best = other_ > best ? other_ : best; } while (0)
                      NSA_DPPMAX(0xB1); NSA_DPPMAX(0x4E); NSA_DPPMAX(0x141);
#undef NSA_DPPMAX
                      const int jb = 63 - (int)(best & 63ull); mask |= 1ull << jb;
#pragma unroll
                      for (int i = 0; i < 8; ++i) if (sub * 8 + i == jb) key[i] = 0ull; } }
              if (sub == 0) selm[q] = mask; }
            __syncthreads();
            const unsigned long long mysel = selm[tq];
            { const bf16* kb = P1 + (size_t)b * SEQ * P1W + C_KSLC; const bf16* vb = VT + (size_t)(0 * BC + b) * 64 * SEQ;
              m = -1e30f; l = 0.f;
#pragma unroll
              for (int i = 0; i < 16; ++i) { o[0][i] = 0.f; o[1][i] = 0.f; }
              for (int j = 0; j <= qb; j += 2) {
                  const bool two = j + 1 <= qb;
                  LAS unsigned char* tb = lds + par * NSA_STAGE; par ^= 1;
                  nsa_store(tb, kx, vx, tid); if (two) nsa_store(tb + NSA_BUF, kx2, vx2, tid);
                  __syncthreads();
                  if (j + 2 <= qb) nsa_load(kx, vx, kb + (size_t)(j + 2) * 64 * P1W, P1W, vb + (j + 2) * 64, SEQ, tid);
                  if (j + 3 <= qb) nsa_load(kx2, vx2, kb + (size_t)(j + 3) * 64 * P1W, P1W, vb + (j + 3) * 64, SEQ, tid);
                  if (j + 2 > qb) { const int jw = qb >= 8 ? qb - 8 : 0;
                      nsa_load(kx, vx, P1 + (size_t)b * SEQ * P1W + C_KWIN + (size_t)jw * 64 * P1W, P1W, VT + (size_t)(1 * BC + b) * 64 * SEQ + jw * 64, SEQ, tid); }
                  { const bool rowsel = ((mysel >> j) & 1ull) != 0ull;
                    if (__builtin_amdgcn_ballot_w64(rowsel) != 0ull) {
                        nsa_qk(tb, qr, p0, p1, r32, hi); if (j == qb) nsa_mask(p0, p1, hi, tq, -1);
                        nsa_softmax_pv(tb, p0, p1, m, l, o, wsf, lane, r32, hi, rowsel); } }
                  if (two) { const bool rowsel = ((mysel >> (j + 1)) & 1ull) != 0ull;
                    if (__builtin_amdgcn_ballot_w64(rowsel) != 0ull) {
                        nsa_qk(tb + NSA_BUF, qr, p0, p1, r32, hi); if (j + 1 == qb) nsa_mask(p0, p1, hi, tq, -1);
                        nsa_softmax_pv(tb + NSA_BUF, p0, p1, m, l, o, wsf, lane, r32, hi, rowsel); } } }
              const float lt = l + partner32(l, lane);
              nsa_rowaccum(acc, false, o, wsf, lt > 0.f ? g1 / lt : 0.f, r32, hi); }
            { const bf16* kb = P1 + (size_t)b * SEQ * P1W + C_KWIN; const bf16* vb = VT + (size_t)(1 * BC + b) * 64 * SEQ;
              m = -1e30f; l = 0.f;
#pragma unroll
              for (int i = 0; i < 16; ++i) { o[0][i] = 0.f; o[1][i] = 0.f; }
              const int j0 = qb >= 8 ? qb - 8 : 0;
              for (int j = j0; j <= qb; ++j) {
                  LAS unsigned char* tb = lds + par * NSA_STAGE; par ^= 1;
                  nsa_store(tb, kx, vx, tid); __syncthreads();
                  if (j < qb) nsa_load(kx, vx, kb + (size_t)(j + 1) * 64 * P1W, P1W, vb + (j + 1) * 64, SEQ, tid);
                  nsa_qk(tb, qr, p0, p1, r32, hi); if (j == qb || j == qb - 8) nsa_mask(p0, p1, hi, j == qb ? tq : 63, j == qb - 8 ? tq : -1);
                  nsa_softmax_pv(tb, p0, p1, m, l, o, wsf, lane, r32, hi, true); }
              const float lt = l + partner32(l, lane);
              nsa_rowaccum(acc, false, o, wsf, lt > 0.f ? g2 / lt : 0.f, r32, hi);
              nsa_flush(acc, Yc + ((size_t)b * SEQ + qb * 64 + 8 * wave) * 256, lane);
            }
        }
    }
    __syncthreads();
}

constexpr int SB_HEAD_LDS = 17408;
constexpr int SB_FLAG = 4 * SB_HEAD_LDS;
constexpr float SB_LOG2E = 1.4426950408889634f, SB_STOP = -100.0f * 1.4426950408889634f;
__device__ __forceinline__ void p_stick2(Frame& F, int nbusy) {
    const int tid = F.tid, lane = F.lane, wave = F.wave, r32 = lane & 31, hi = lane >> 5, h = wave & 3, qh = wave >> 2;
    LAS unsigned char* lds = F.lds + RING_OFF; LAS unsigned char* hl = lds + h * SB_HEAD_LDS; LAS int* flag = (LAS int*)(lds + SB_FLAG);
    const bf16* P1 = WSP(bf16, WS_P1); const bf16* VT = WSP(bf16, WS_VT) + (size_t)2 * BC * 64 * SEQ;
    bf16* Yb = WSP(bf16, WS_Y) + (size_t)MC * 256;
    const int tq = 32 * qh + r32;
    if (F.bx >= nbusy)
        for (int item = F.bx - nbusy; item < BC * 64; item += F.G - nbusy) {
            const int b = item >> 6, qb = item & 63;
            const size_t row = (size_t)b * SEQ + qb * 64 + tq;
            bf16x8v qr[4];
#pragma unroll
            for (int d0 = 0; d0 < 4; ++d0) qr[d0] = *(const bf16x8v*)(P1 + row * P1W + C_SBQ + h * 64 + d0 * 16 + hi * 8);
            f32x16 o[2], p0, p1;
#pragma unroll
            for (int i = 0; i < 16; ++i) { o[0][i] = 0.f; o[1][i] = 0.f; }
            float R = 0.f;
            const int skey = tid & 63, sc = tid >> 6, sd = tid >> 3, skc = tid & 7;
            v4u kx[4], vx[4];
#define SB_LOAD(jj) do { const bf16* kg_ = P1 + ((size_t)b * SEQ + (jj) * 64 + skey) * P1W + C_SBK + sc * 8; \
                _Pragma("unroll") for (int hh = 0; hh < 4; ++hh) { kx[hh] = *(const v4u*)(kg_ + hh * 64); vx[hh] = *(const v4u*)(VT + ((size_t)(hh * BC + b) * 64 + sd) * SEQ + (jj) * 64 + skc * 8); } } while (0)
            SB_LOAD(qb);
            for (int j = qb; j >= 0; --j) {
                __syncthreads();
                if (j < qb) { int live = 0;
#pragma unroll
                    for (int w = 0; w < 8; ++w) live |= flag[w];
                    if (!live) break; }
#pragma unroll
                for (int hh = 0; hh < 4; ++hh) { *(LAS v4u*)(lds + hh * SB_HEAD_LDS + sc * 1024 + skey * 16) = kx[hh]; { LAS v2u* vd = (LAS v2u*)(lds + hh * SB_HEAD_LDS + NSA_V + sd * NSA_VP + skc * 16); vd[0] = (v2u){vx[hh].x, vx[hh].y}; vd[1] = (v2u){vx[hh].z, vx[hh].w}; } }
                __syncthreads();
                if (j > 0) SB_LOAD(j - 1);
                nsa_qk(hl, qr, p0, p1, r32, hi);
#pragma unroll
                for (int i = 0; i < 16; ++i) { p0[i] *= NSA_C2; p1[i] *= NSA_C2; }
                v4u vv[8]; nsa_vload(hl, vv, r32, hi);
                const int lim = ((j == qb) ? tq : 64) - 4 * hi;
                float Town[8], Tp[8];
#pragma unroll
                for (int kt = 0; kt < 2; ++kt) { f32x16& pp = kt ? p1 : p0;
#pragma unroll
                    for (int g = 0; g < 4; ++g) { float L[4];
#pragma unroll
                        for (int e = 0; e < 4; ++e) { const int kk = 32 * kt + 8 * g + e; const float z = pp[4 * g + e];
                            const float tt = __builtin_amdgcn_logf(1.0f + __builtin_amdgcn_exp2f(-__builtin_fabsf(z)));
                            const float lb = fminf(z, 0.f) - tt; const bool ok = kk < lim;
                            L[e] = ok ? lb - z : 0.f; pp[4 * g + e] = ok ? lb : -INFINITY; }
                        const float E2 = L[3], E1 = E2 + L[2], E0 = E1 + L[1];
                        pp[4 * g + 2] += E2; pp[4 * g + 1] += E1; pp[4 * g] += E0;
                        Town[4 * kt + g] = E0 + L[0]; } }
#pragma unroll
                for (int k = 0; k < 8; ++k) Tp[k] = partner32(Town[k], lane);
                float suf = R;
#pragma unroll
                for (int k = 7; k >= 0; --k) { const float add = suf + (hi == 0 ? Tp[k] : 0.f); f32x16& pp = (k >> 2) ? p1 : p0; const int g = k & 3;
#pragma unroll
                    for (int e = 0; e < 4; ++e) pp[4 * g + e] = __builtin_amdgcn_exp2f(pp[4 * g + e] + add);
                    suf += Town[k] + Tp[k]; }
                R = suf;
                nsa_pv(vv, p0, p1, o);
                const bool alive = R >= SB_STOP;
                const unsigned long long bal = __builtin_amdgcn_ballot_w64(alive);
                if (lane == 0) flag[wave] = bal != 0ull ? 1 : 0;
            }
            { bf16* dst = Yb + ((size_t)b * SEQ + qb * 64 + 32 * qh + 4 * hi) * 256 + h * 64 + r32;
#pragma unroll
              for (int i = 0; i < 16; ++i) { dst[((i & 3) + 8 * (i >> 2)) * 256] = (bf16)f2bf(o[0][i]); dst[((i & 3) + 8 * (i >> 2)) * 256 + 32] = (bf16)f2bf(o[1][i]); } }
        }
#undef SB_LOAD
    __syncthreads();
}

__device__ __forceinline__ void p_sgu2(Frame& F, int layer) {
    LAS unsigned char* vnT = F.lds + RING_OFF;
    const bf16* P1 = WSP(bf16, WS_P1); bf16* Ya = WSP(bf16, WS_Y);
    const float* gain = F.in[3] + (size_t)layer * 256; const float* sw = F.in[4] + (size_t)layer * 4 * 128 * 128; const float* sb = F.in[5] + (size_t)layer * 4 * 128;
    const int lane = F.lane, wave = F.wave, r32 = lane & 31, hi = lane >> 5, g = wave & 3, db = wave >> 2;
    for (int item = F.vcu; item < MC / 128; item += F.G) {
        const size_t r0 = (size_t)item * 128;
        __syncthreads();
        { const f32x4 gg = ((const f32x4*)gain)[lane];
          for (int rr = 0; rr < 16; rr += 2) { const int r = wave * 16 + rr;
              const v2u ra = *(const v2u*)(P1 + (r0 + r) * P1W + C_V + 4 * lane), rb = *(const v2u*)(P1 + (r0 + r + 1) * P1W + C_V + 4 * lane);
              const float a0 = bflo(ra.x), a1 = bfhi(ra.x), a2 = bflo(ra.y), a3 = bfhi(ra.y), b0 = bflo(rb.x), b1 = bfhi(rb.x), b2 = bflo(rb.y), b3 = bfhi(rb.y);
              const float sa = 1.0f / sqrtf(wave_sum((a0 * a0 + a1 * a1) + (a2 * a2 + a3 * a3), lane) * (1.f / 256.f) + EPS);
              const float sb_ = 1.0f / sqrtf(wave_sum((b0 * b0 + b1 * b1) + (b2 * b2 + b3 * b3), lane) * (1.f / 256.f) + EPS);
              LAS unsigned* q = (LAS unsigned*)(vnT + (4 * lane) * 272 + r * 2);
              q[0] = pk2(a0 * sa * gg.x, b0 * sb_ * gg.x); q[68] = pk2(a1 * sa * gg.y, b1 * sb_ * gg.y); q[136] = pk2(a2 * sa * gg.z, b2 * sb_ * gg.z); q[204] = pk2(a3 * sa * gg.w, b3 * sb_ * gg.w); } }
        __syncthreads();
        const int ch = g * 64 + db * 32 + r32;
        for (int tb = 0; tb < 4; ++tb) {
            f32x16 acc;
#pragma unroll
            for (int i = 0; i < 16; ++i) acc[i] = 0.f;
            const int t = 32 * tb + r32; const float* wrow = sw + ((size_t)g * 128 + t) * 128;
            f32x4 wq[8][2];
#pragma unroll
            for (int ks = 0; ks < 8; ++ks) if (ks < 2 * tb + 2) { wq[ks][0] = *(const f32x4*)(wrow + 16 * ks + 8 * hi); wq[ks][1] = *(const f32x4*)(wrow + 16 * ks + 8 * hi + 4); }
#pragma unroll
            for (int ks = 0; ks < 8; ++ks) if (ks < 2 * tb + 2) {
                const int s0 = 16 * ks + 8 * hi;
                const f32x4 w0 = wq[ks][0], w1 = wq[ks][1];
                const v4u a = (v4u){pk2(s0 <= t ? w0.x : 0.f, s0 + 1 <= t ? w0.y : 0.f), pk2(s0 + 2 <= t ? w0.z : 0.f, s0 + 3 <= t ? w0.w : 0.f),
                                    pk2(s0 + 4 <= t ? w1.x : 0.f, s0 + 5 <= t ? w1.y : 0.f), pk2(s0 + 6 <= t ? w1.z : 0.f, s0 + 7 <= t ? w1.w : 0.f)};
                const bf16x8v bfr = *(const LAS bf16x8v*)(vnT + ch * 272 + s0 * 2);
                acc = __builtin_amdgcn_mfma_f32_32x32x16_bf16(__builtin_bit_cast(bf16x8v, a), bfr, acc, 0, 0, 0); }
            float uu[16], bb[16];
#pragma unroll
            for (int i = 0; i < 16; ++i) { const int tt = 32 * tb + (i & 3) + 8 * (i >> 2) + 4 * hi; uu[i] = bf1(P1[(r0 + tt) * P1W + C_U + ch]); bb[i] = sb[g * 128 + tt]; }
#pragma unroll
            for (int i = 0; i < 16; ++i) { const int tt = 32 * tb + (i & 3) + 8 * (i >> 2) + 4 * hi;
                Ya[(r0 + tt) * 256 + ch] = (bf16)f2bf(uu[i] * (acc[i] + bb[i])); }
        }
    }
    __syncthreads();
}

struct Args { const float* in[20]; float* out; unsigned char* ws; int lo, hi, li, rep; };
#ifndef TILED_FFN1
#define TILED_FFN1 0
#endif
#ifndef PG8_ALIGN_EPI
#define PG8_ALIGN_EPI true
#endif
#ifndef PG8_SP2
#define PG8_SP2 true
#endif
#ifndef WGM_PROJ
#define WGM_PROJ PG8_WGM
#endif
#ifndef WGM_FFN1
#define WGM_FFN1 PG8_WGM
#endif
#ifndef WGM_FFN2
#define WGM_FFN2 PG8_WGM
#endif
#ifndef WGM_MOE1
#define WGM_MOE1 PG8_WGM
#endif
#ifndef WGM_MOE2
#define WGM_MOE2 PG8_WGM
#endif
#ifndef FFN_CHUNKS
#define FFN_CHUNKS 2
#endif
#ifndef REP_GEMM
#define REP_GEMM 1
#endif
#ifndef REP_STICK
#define REP_STICK 1
#endif
#ifndef REP_NSA
#define REP_NSA 1
#endif
#ifndef REP_SGU
#define REP_SGU 1
#endif
#ifndef REP_NORM
#define REP_NORM 1
#endif
template <class Epi, class Sched> __device__ __forceinline__ void run_gemm(Frame& F, const bf16* A, const bf16* Bt, int M, int N, int K, const Sched& S, Epi E, bool rotate = true, int tiled = 0, int ld = 0) {
    const int nt_ = K / 64;
#ifdef PG8_KROT
    const int rot_ = rotate ? 2 * (((F.bx & 7) * (nt_ / 2)) / 8) : 0;
#else
    const int rot_ = 0;
#endif
    pg8::Gemm g{A, Bt, M, N, K + F.zs, F.tid, rot_ + F.zs, tiled + F.zs, ld + F.zs, nullptr};
    if (F.rep) E.set_scale0();
    pg8::gemm_phase<Epi, Sched, PG8_ALIGN_EPI, PG8_SP2>(F.lds + RING_OFF, g, S, E);
}
template <class Epi, class Sched> __device__ __forceinline__ void run_gemm_gather(Frame& F, const bf16* A, const int* gidx, const bf16* Bt, int M, int N, int K, const Sched& S, Epi E) {
    pg8::Gemm g{A, Bt, M, N, K + F.zs, F.tid, F.zs, F.zs, F.zs, gidx};
    if (F.rep) E.set_scale0();
    pg8::gemm_phase<Epi, Sched, PG8_ALIGN_EPI, PG8_SP2, true>(F.lds + RING_OFF, g, S, E);
}
__global__ void __launch_bounds__(NWAVES * 64, 2) mk_fwd(Args args) {
    extern __shared__ __attribute__((aligned(16))) unsigned char lds[];
    Frame F0;
    F0.lds = (LAS unsigned char*)lds;
    F0.tid = threadIdx.x; F0.lane = F0.tid & 63; F0.wave = __builtin_amdgcn_readfirstlane(F0.tid >> 6);
    F0.G = gridDim.x; F0.bx = blockIdx.x; F0.vcu = (F0.G % 8 == 0) ? (F0.bx % 8) * (F0.G / 8) + F0.bx / 8 : F0.bx; F0.zv = 0; F0.zs = 0;
    F0.rep = args.rep; F0.ws = args.ws; F0.ctl = (unsigned*)(args.ws + WS_CTL); F0.in = args.in; F0.out = args.out;
    for (int u = F0.tid; u < (LDS_BYTES - LDSCTL_OFF) / 4; u += NWAVES * 64) ((LAS unsigned*)(F0.lds + LDSCTL_OFF))[u] = 0u;
    __syncthreads();
    const int lo = args.lo, hi = args.hi;
    XcdBarrier bar; bar.bar = F0.ctl + CW_BAR + args.li * XCD_BAR_WORDS; bar.x = 0; bar.st = nullptr; bar.w = 0; bar.z = 0;
    if (hi - lo > 1) bar = xcd_barrier_post(F0.ctl + CW_BAR + args.li * XCD_BAR_WORDS, (volatile LAS unsigned*)(F0.lds + MISC_OFF) + 8);
    int step = 0;
#define STEP_BEGIN if (step >= lo && step < hi) { Frame F = F0; { int zv_, zs_; asm volatile("v_mov_b32 %0, 0" : "=v"(zv_)); asm volatile("s_mov_b32 %0, 0" : "=s"(zs_)); \
        F.zv = zv_; F.zs = zs_; F.lane = (int)__builtin_amdgcn_mbcnt_hi(~0u, __builtin_amdgcn_mbcnt_lo(~0u, (unsigned)zv_)); F.wave = F0.wave + zs_; F.tid = F.wave * 64 + F.lane; F.bx = F.bx + zs_; \
        F.vcu = F0.vcu + zs_; F.G = F0.G + zs_; F.lds = (LAS unsigned char*)lds + zs_; F.ws = F0.ws + zs_; F.ctl = F0.ctl + zs_; F.in = F0.in + zs_; F.out = F0.out + zs_; }
#ifdef PROBE_XBAR
#define STEP_END   if (step + 1 < hi) { unsigned zb_; asm volatile("v_mov_b32 %0, 0" : "=v"(zb_)); bar.z = zb_; xcd_barrier(bar); xcd_barrier(bar); } } ++step;
#else
#define STEP_END   if (step + 1 < hi) { unsigned zb_; asm volatile("v_mov_b32 %0, 0" : "=v"(zb_)); bar.z = zb_; xcd_barrier(bar); } } ++step;
#endif

    for (int layer = 0; layer < DEPTH; ++layer) {
        const int jj = layer >> 1;
        STEP_BEGIN
            p_convert(F, layer);
            if (layer == 0) p_norm<0, false>(F, F.in[0], F.in[1], nullptr, 0); else p_norm<0, true>(F, WSP(bf16, WS_H), F.in[1] + (size_t)layer * DM, nullptr, 0);
        STEP_END
        for (int c = 0; c < NCHUNK; ++c) {
            STEP_BEGIN
                pg8::StaticOrder S; S.init(MC, NPROJ, F.G, F.bx, WGM_PROJ);
                pg8::EpiProj E{WSP(bf16, WS_P1), WSP(bf16, WS_G)};
                run_gemm(F, WSP(bf16, WS_HN) + (size_t)c * MC * DM, WSP(bf16, WS_WIN), MC, NPROJ, DM, S, E);
            STEP_END
            STEP_BEGIN
                p_prep(F);
            STEP_END
            STEP_BEGIN
                LAS int* tab = (LAS int*)(F.lds + TAB_OFF);
                __syncthreads(); if (F.tid < 16) tab[F.tid] = F.tid >> 3; __syncthreads();
                pg8::GroupedOrder S; S.so.init(2 * 2048, 512, F.G, F.bx); S.tile_e = tab; S.nN = 2;
                pg8::EpiF32 E{WSP(float, WS_UL), 512, 2};
                run_gemm(F, WSP(bf16, WS_KVC), WSP(bf16, WS_WC1), 2 * 2048, 512, DM, S, E);
                p_sgu2(F, layer);
                p_stick2(F, F.G > 64 ? 32 : 0);
            STEP_END
            STEP_BEGIN
                p_cmpfin(F, layer);
            STEP_END
            STEP_BEGIN
#ifdef OLD_NSA
                p_nsa(F);
#else
                p_nsa2(F);
#endif
            STEP_END
            STEP_BEGIN
                pg8::MergeOrder S; S.so.init(MC, DM, F.G, F.bx); S.nmt = MC / 256;
                pg8::EpiMerge E{WSP(bf16, WS_G), WSP(bf16, WS_MG), MC / 256};
                run_gemm(F, WSP(bf16, WS_Y), WSP(bf16, WS_WBR), 3 * MC, 3 * DM, 256, S, E);
            STEP_END
            STEP_BEGIN
                pg8::StaticOrder S; S.init(MC, DM, F.G, F.bx);
                pg8::EpiResid E{layer == 0 ? F.in[0] + (size_t)c * MC * DM : nullptr, WSP(bf16, WS_H) + (size_t)c * MC * DM, DM, 1.0f};
                run_gemm(F, WSP(bf16, WS_MG), WSP(bf16, WS_WOUT), MC, DM, DM, S, E);
            STEP_END
        }
        if ((layer & 1) == 0) {
            STEP_BEGIN
                p_norm<0, true>(F, WSP(bf16, WS_H), F.in[11] + (size_t)layer * DM, nullptr, 0, Q8_HN, TILED_FFN1);
            STEP_END
            for (int c = 0; c < FFN_CHUNKS; ++c) {
                constexpr int MF = MTOK / FFN_CHUNKS;
                STEP_BEGIN
                    pg8::StaticOrder S; S.init(MF, NFF1, F.G, F.bx, WGM_FFN1);
                    pg8::EpiSwiGLU E{WSP(bf16, WS_HID), DFFP, nullptr, NFF1 / 256};
                    run_gemm(F, WSP(bf16, WS_HN) + (size_t)c * MF * DM, WSP(bf16, WS_WF1), MF, NFF1, DM, S, E, true, TILED_FFN1);
                STEP_END
                STEP_BEGIN
                    pg8::StaticOrder S; S.init(MF, DM, F.G, F.bx, WGM_FFN2);
                    pg8::EpiResid E{nullptr, WSP(bf16, WS_H) + (size_t)c * MF * DM, DM, 1.0f};
                    run_gemm(F, WSP(bf16, WS_HID), WSP(bf16, WS_WF2), MF, DM, DFFP, S, E);
                STEP_END
            }
        } else {
            STEP_BEGIN
                p_norm<1, true>(F, WSP(bf16, WS_H), F.in[11] + (size_t)layer * DM, F.in[15] + (size_t)jj * DM * NEXP, jj, Q8_HN);
            STEP_END
#ifdef ABL_DENSE_MOE
            for (int e = 0; e < NEXP; ++e) {
                STEP_BEGIN
                    pg8::StaticOrder S; S.init(MTOK, NMOE1, F.G, F.bx);
                    pg8::EpiSwiGLU E{WSP(bf16, WS_SCR + 8 * MiB), DFE, WSP(float, WS_SCR + 4 * MiB) + (size_t)e * MTOK, NMOE1 / 256};
                    run_gemm(F, WSP(bf16, WS_HN), WSP(bf16, WS_WF1) + (size_t)e * NMOE1 * DM, MTOK, NMOE1, DM, S, E);
                STEP_END
                STEP_BEGIN
                    pg8::StaticOrder S; S.init(MTOK, DM, F.G, F.bx);
                    pg8::EpiResid E{nullptr, WSP(bf16, WS_H), DM, 1.0f};
                    run_gemm(F, WSP(bf16, WS_SCR + 8 * MiB), WSP(bf16, WS_WF2) + (size_t)e * DM * DFE, MTOK, DM, DFE, S, E);
                STEP_END
            }
#else
            STEP_BEGIN
                p_gather(F, jj, 0, 0); p_gather(F, jj, 0, 1);
            STEP_END
            for (int c = 0; c < NCHUNK; ++c) {
                STEP_BEGIN
                    int dealt = 0;
                    for (int r = 0; r < 2; ++r) {
                        const int T = moe_table(F, jj, c, r);
                        int cw = F.bx - dealt % F.G; if (cw < 0) cw += F.G;
                        pg8::GroupedOrder S; S.so.init(T * 256, NMOE1, F.G, cw, WGM_MOE1); S.tile_e = (LAS int*)(F.lds + TAB_OFF); S.nN = NMOE1 / 256;
                        pg8::EpiSwiGLU E{WSP(bf16, WS_HIDM) + (size_t)r * SLOTS * DFE, DFE, WSP(float, WS_WSLOT) + (c * 2 + r) * SLOTS, NMOE1 / 256};
                        run_gemm_gather(F, WSP(bf16, WS_HN), WSP(int, WS_TOKMAP) + (c * 2 + r) * SLOTS, WSP(bf16, WS_WF1), T * 256, NMOE1, DM, S, E);
                        dealt += T * (NMOE1 / 256);
                        __syncthreads();
                    }
                STEP_END
                for (int r = 0; r < 2; ++r) {
                    STEP_BEGIN
                        const int T = moe_table(F, jj, c, r);
                        const int nwg = T * (DM / 256), R = nwg % F.G, full = nwg - R;
                        const int NS = (4 * R <= F.G) ? 4 : 2;
                        const bool split = (hi - lo > 1) && R > 0 && NS * R <= F.G && !F.rep;
                        int* tokm = WSP(int, WS_TOKMAP) + (c * 2 + r) * SLOTS; float* TB = WSP(float, WS_TB); const bf16* HIDr = WSP(bf16, WS_HIDM) + (size_t)r * SLOTS * DFE;
                        { pg8::LimitOrder S; S.so.init(T * 256, DM, F.G, F.bx, WGM_MOE2); S.limit = split ? full : nwg;
                          pg8::GroupedLimit GS{S, (LAS int*)(F.lds + TAB_OFF), DM / 256};
                          pg8::EpiScatter E{WSP(bf16, WS_H), tokm, DM / 256, 1.0f};
                          run_gemm(F, HIDr, WSP(bf16, WS_WF2), T * 256, DM, DFE, GS, E, false); }
                        const bool more = r == 1 && c + 1 < NCHUNK;
                        if (split) {
                            const int KP = DFE / NS;
                            if (F.bx < NS * R) { const int Lx = full + F.bx / NS, kp = F.bx % NS;
                                pg8::StaticOrder so; so.init(T * 256, DM, F.G, Lx % F.G, WGM_MOE2); pg8::Unit un; so.next(Lx / F.G, un);
                                un.pn += ((LAS int*)(F.lds + TAB_OFF))[un.pm] * (DM / 256);
                                pg8::SingleOrder S1{un};
                                if (kp == 0) { pg8::EpiScatter E{WSP(bf16, WS_H), tokm, DM / 256, 1.0f};
                                    run_gemm(F, HIDr, WSP(bf16, WS_WF2), T * 256, DM, KP, S1, E, false, 0, DFE); }
                                else { pg8::EpiTile E{TB + ((size_t)(Lx - full) * 3 + (kp - 1)) * 65536};
                                    run_gemm(F, HIDr + kp * KP, WSP(bf16, WS_WF2) + kp * KP, T * 256, DM, KP, S1, E, false, 0, DFE); } }
                            if (more) { p_gather(F, jj, c + 1, 0, NS * R); p_gather(F, jj, c + 1, 1, NS * R); }
                            { unsigned zb_; asm volatile("v_mov_b32 %0, 0" : "=v"(zb_)); bar.z = zb_; xcd_barrier(bar); }
                            for (int it = (F.vcu * NWAVES + F.wave); it < R * 256; it += F.G * NWAVES) { const int j = it >> 8, row = it & 255, Lx = full + j;
                                pg8::StaticOrder so; so.init(T * 256, DM, F.G, Lx % F.G, WGM_MOE2); pg8::Unit un; so.next(Lx / F.G, un);
                                const int t = tokm[un.pm * 256 + row];
                                if (t >= 0) { v2u* hp = (v2u*)(WSP(bf16, WS_H) + (size_t)t * DM + un.pn * 256) + F.lane; const v2u hv = *hp; f32x4 a = (f32x4){bflo(hv.x), bfhi(hv.x), bflo(hv.y), bfhi(hv.y)};
                                    for (int q = 0; q < NS - 1; ++q) a = a + ((const f32x4*)(TB + ((size_t)j * 3 + q) * 65536 + row * 256))[F.lane];
                                    *hp = (v2u){pk2(a.x, a.y), pk2(a.z, a.w)}; } }
                        } else if (!F.rep && more) { p_gather(F, jj, c + 1, 0, R); p_gather(F, jj, c + 1, 1, R); }
                    STEP_END
                }
            }
#endif
        }
    }
    STEP_BEGIN
        p_norm<2, true>(F, WSP(bf16, WS_H), F.in[19], nullptr, 0);
    STEP_END
#undef STEP_BEGIN
#undef STEP_END
}

#ifndef MK_STEPS_PER_LAUNCH
#define MK_STEPS_PER_LAUNCH 1
#endif
extern "C" void kernel_launch(void* const* d_in, const int* in_sizes, int n_in, void* d_out, int out_size, void* d_ws, size_t ws_size, hipStream_t stream) {
    static int grid = 0;
    if (grid == 0) {
        if (n_in != 20 || in_sizes[0] != MTOK * DM || out_size != MTOK * DM || ws_size < WS_END) { fprintf(stderr, "kernel_launch: unexpected shapes (n_in %d, in0 %d, out %d, ws %zu)\n", n_in, n_in > 0 ? in_sizes[0] : -1, out_size, ws_size); grid = -1; return; }
        int dev = 0, cus = 0, per_cu = 0;
        if (hipGetDevice(&dev) != hipSuccess || hipDeviceGetAttribute(&cus, hipDeviceAttributeMultiprocessorCount, dev) != hipSuccess) { grid = -1; return; }
        if (hipFuncSetAttribute((const void*)mk_fwd, hipFuncAttributeMaxDynamicSharedMemorySize, LDS_BYTES) != hipSuccess) { fprintf(stderr, "kernel_launch: hipFuncSetAttribute failed\n"); grid = -1; return; }
        if (hipOccupancyMaxActiveBlocksPerMultiprocessor(&per_cu, (const void*)mk_fwd, NWAVES * 64, LDS_BYTES) != hipSuccess || per_cu < 1) fprintf(stderr, "kernel_launch: occupancy query reports %d\n", per_cu);
        (void)hipGetLastError();
        grid = cus;
    }
    if (grid < 0) return;
    if (hipMemsetAsync((char*)d_ws + WS_CTL, 0, CTL_ZERO_BYTES, stream) != hipSuccess) return;
    Args a{};
    for (int i = 0; i < 20; ++i) a.in[i] = (const float*)d_in[i];
    a.out = (float*)d_out; a.ws = (unsigned char*)d_ws; a.rep = 0;
    #ifdef ABL_DENSE_MOE
    constexpr int NSTEPS = 2 * (1 + NCHUNK * 8 + 3) + 2 * (1 + NCHUNK * 8 + 1 + NEXP * 2) + 1;
#else
    constexpr int NSTEPS = 2 * (1 + NCHUNK * 7 + 1 + 2 * FFN_CHUNKS) + 2 * (1 + NCHUNK * 7 + 2 + NCHUNK * 3) + 1;
#endif
    int li = 0;
#ifdef REPMASK
    static int kinds[256]; int ns = 0;
    for (int layer = 0; layer < DEPTH; ++layer) { kinds[ns++] = 0;
        for (int c = 0; c < NCHUNK; ++c) for (int q = 1; q <= 8; ++q) if (q != 5) kinds[ns++] = q;
        if ((layer & 1) == 0) { kinds[ns++] = 9; for (int c = 0; c < FFN_CHUNKS; ++c) { kinds[ns++] = 10; kinds[ns++] = 11; } }
        else { kinds[ns++] = 12; kinds[ns++] = 17; for (int c = 0; c < NCHUNK; ++c) { kinds[ns++] = 14; kinds[ns++] = 13; kinds[ns++] = 13; } } }
    kinds[ns++] = 16;
    for (int s = 0; s < NSTEPS; ++s) { const int reps = ((REPMASK >> kinds[s]) & 1) ? 2 : 1;
        for (int r = 0; r < reps; ++r) { a.lo = s; a.hi = s + 1; a.li = 0; a.rep = r;
            hipLaunchKernelGGL(mk_fwd, dim3(grid), dim3(NWAVES * 64), LDS_BYTES, stream, a); } }
    (void)li;
#else
    for (int s = 0; s < NSTEPS; s += MK_STEPS_PER_LAUNCH) {
        a.lo = s; a.hi = (s + MK_STEPS_PER_LAUNCH < NSTEPS) ? s + MK_STEPS_PER_LAUNCH : NSTEPS; a.li = (MK_STEPS_PER_LAUNCH > 1) ? li : 0; ++li;
        hipLaunchKernelGGL(mk_fwd, dim3(grid), dim3(NWAVES * 64), LDS_BYTES, stream, a);
        if (hipPeekAtLastError() != hipSuccess) { fprintf(stderr, "kernel_launch: launch failed\n"); break; }
    }
#endif
}
```

```cpp
#define MK_STEPS_PER_LAUNCH 1000
#define PG8_WGM 4
#define FFN_CHUNKS 1
#include <hip/hip_runtime.h>
#include <cstdio>
#include <cstdint>
#include <cmath>
#ifndef PG8_AUX_A
#define PG8_AUX_A 0
#endif
#ifndef PG8_AUX_B
#define PG8_AUX_B 0
#endif
#ifndef PG8_WGM
#define PG8_WGM 8
#endif
namespace pg8 {
#define PG8_LAS __attribute__((address_space(3)))
typedef unsigned short bf16_t;
typedef short bf16x8 __attribute__((ext_vector_type(8)));
typedef float f32x4 __attribute__((ext_vector_type(4)));
typedef unsigned u32x4 __attribute__((ext_vector_type(4)));
constexpr int BM = 256, BK = 64, HALF = 128, HTB = HALF * BK * 2  , STAGE_BYTES = 8 * HTB, NXCD = 8, WGM = PG8_WGM;

__host__ __device__ __forceinline__ int lds_byte(int r, int c) { const int st = (r >> 4) * 2 + (c >> 5), rr = r & 15, cc = c & 31, ob = rr * 64 + cc * 2; return st * 1024 + (ob ^ (((ob >> 9) & 1) << 5)); }
__host__ __device__ __forceinline__ void stage_rc(int b, int& R, int& C) { const int st = b / 1024, sb = b % 1024, swz = sb ^ (((sb >> 9) & 1) << 5); R = (st >> 1) * 16 + swz / 64; C = (st & 1) * 32 + (swz % 64) / 2; }
__host__ __device__ __forceinline__ int perm32(int rho) { const int n = rho >> 4, i = rho & 15; return 8 * (i >> 2) + 4 * n + (i & 3); }

struct Unit { int pm, pn; };
struct Gemm { const bf16_t* A; const bf16_t* Bt; int M, N, K; int zv; int rot; int tiled; int ld; const int* gidx; };

struct StaticOrder {
    int nM, nN, nwg, G, c, wgm;
    __host__ __device__ __forceinline__ void init(int M, int N, int G_, int c_, int wgm_ = WGM) { nM = M / BM; nN = N / BM; nwg = nM * nN; G = G_; c = c_; wgm = wgm_; }
    __host__ __device__ __forceinline__ bool next(int i, Unit& u) const {
        const long L = (long)i * G + c; if (L >= nwg) return false;
        int wgid = (int)L; { const int q = nwg / NXCD, r = nwg % NXCD, xcd = wgid % NXCD, off = wgid / NXCD; wgid = (xcd < r ? xcd * (q + 1) : r * (q + 1) + (xcd - r) * q) + off; }
        const int nig = wgm * nN, gid = wgid / nig, fm = gid * wgm, gsz = (nM - fm) < wgm ? (nM - fm) : wgm;
        u.pm = fm + ((wgid % nig) % gsz); u.pn = (wgid % nig) / gsz; return true;
    }
    __device__ __forceinline__ void a_ready(const Unit&) const {}
    __device__ __forceinline__ void done(const Unit&) const {}
};

__device__ __forceinline__ unsigned cvt_pk_bf16(float lo, float hi) { unsigned r; asm volatile("v_cvt_pk_bf16_f32 %0, %1, %2" : "=v"(r) : "v"(lo), "v"(hi)); return r; }
typedef float f32x2 __attribute__((ext_vector_type(2)));

__device__ __forceinline__ float fast_sigmoid(float x) { return __builtin_amdgcn_rcpf(1.0f + __builtin_amdgcn_exp2f(-1.4426950408889634f * x)); }
__device__ __forceinline__ float gelu_tanh(float x) {
    const float u2 = 1.5957691216057308f * (x + 0.044715f * x * x * x);
    return x * fast_sigmoid(u2);
}
__device__ __forceinline__ float bf_lo(unsigned u) { return __builtin_bit_cast(float, u << 16); }
__device__ __forceinline__ float bf_hi(unsigned u) { return __builtin_bit_cast(float, u & 0xffff0000u); }

#ifdef PG8_NT_OUT
#define PG8_STORE_OUT(p, v) __builtin_nontemporal_store((v), (p))
#else
#define PG8_STORE_OUT(p, v) (*(p) = (v))
#endif
struct EpiProj {
    static constexpr bool PERM = true, AFTER_DRAIN = false, MID = false; static constexpr int MID_TILES = 1; __device__ __forceinline__ void set_scale0() {}
    bf16_t* P1; bf16_t* G; const float* rstd;
    __device__ __forceinline__ void operator()(const f32x4 (&acc)[2][2][4][2], const Unit& u, int wr, int wc, int fr, int fq) const {
        const int row0 = u.pm * BM + wr * 64 + fr;
        float rsv[8];
#pragma unroll
        for (int q = 0; q < 8; ++q) rsv[q] = rstd[row0 + (q >> 2) * HALF + (q & 3) * 16];
        bf16_t* base; int ldc, colt, act0, act1;
        if (u.pn < 8) { base = P1; ldc = 2048; colt = u.pn * BM; act0 = (u.pn < 2) ? 1 : 0; act1 = (u.pn == 7) ? 2 : act0; }
        else { base = G; ldc = 3072; colt = (u.pn - 8) * BM; act0 = 2; act1 = 2; }
        const int col0 = colt + wc * 32 + 8 * fq;
#pragma unroll
        for (int ai = 0; ai < 2; ++ai)
#pragma unroll
            for (int m = 0; m < 4; ++m) { bf16_t* rowp = base + (size_t)(row0 + ai * HALF + m * 16) * ldc + col0;
#pragma unroll
                for (int bj = 0; bj < 2; ++bj) { f32x4 v0 = acc[ai][bj][m][0] * rsv[ai * 4 + m], v1 = acc[ai][bj][m][1] * rsv[ai * 4 + m]; const int act = bj ? act1 : act0;
                    if (act == 1) {
#pragma unroll
                        for (int e = 0; e < 4; ++e) { v0[e] = gelu_tanh(v0[e]); v1[e] = gelu_tanh(v1[e]); } }
                    else if (act == 2) {
#pragma unroll
                        for (int e = 0; e < 4; ++e) { v0[e] = fast_sigmoid(v0[e]); v1[e] = fast_sigmoid(v1[e]); } }
                    u32x4 w; w.x = cvt_pk_bf16(v0[0], v0[1]); w.y = cvt_pk_bf16(v0[2], v0[3]); w.z = cvt_pk_bf16(v1[0], v1[1]); w.w = cvt_pk_bf16(v1[2], v1[3]);
                    *(u32x4*)(rowp + bj * HALF) = w; } }
    }
};
struct EpiMerge {
    static constexpr bool PERM = true, AFTER_DRAIN = false, MID = false; static constexpr int MID_TILES = 1; __device__ __forceinline__ void set_scale0() {}
    const bf16_t* G; bf16_t* MG; int nmt;
    __device__ __forceinline__ void operator()(const f32x4 (&acc)[2][2][4][2], const Unit& u, int wr, int wc, int fr, int fq) const {
        const int i = u.pn >> 2, pn = u.pn & 3, pm = u.pm - i * nmt;
        const int row0 = pm * BM + wr * 64 + fr, col0 = pn * BM + wc * 32 + 8 * fq;
#pragma unroll
        for (int ai = 0; ai < 2; ++ai)
#pragma unroll
            for (int mp = 0; mp < 2; ++mp) {
                u32x4 g[4], o[4];
#pragma unroll
                for (int q = 0; q < 4; ++q) { const int m = 2 * mp + (q >> 1), bj = q & 1; const size_t row = (size_t)(row0 + ai * HALF + m * 16); const int col = col0 + bj * HALF;
                    g[q] = *(const u32x4*)(G + row * 3072 + i * 1024 + col);
                    if (i > 0) o[q] = *(const u32x4*)(MG + row * 1024 + col); else o[q] = (u32x4){0u, 0u, 0u, 0u}; }
#pragma unroll
                for (int q = 0; q < 4; ++q) { const int m = 2 * mp + (q >> 1), bj = q & 1; const size_t row = (size_t)(row0 + ai * HALF + m * 16); const int col = col0 + bj * HALF;
                    f32x4 v0 = acc[ai][bj][m][0], v1 = acc[ai][bj][m][1];
#ifdef ABL_BRANCH
                    if (i == ABL_BRANCH) { v0 = v0 * (float)ABL_SCALE; v1 = v1 * (float)ABL_SCALE; }
#endif
                    v0[0] = v0[0] * bf_lo(g[q].x) + bf_lo(o[q].x); v0[1] = v0[1] * bf_hi(g[q].x) + bf_hi(o[q].x); v0[2] = v0[2] * bf_lo(g[q].y) + bf_lo(o[q].y); v0[3] = v0[3] * bf_hi(g[q].y) + bf_hi(o[q].y);
                    v1[0] = v1[0] * bf_lo(g[q].z) + bf_lo(o[q].z); v1[1] = v1[1] * bf_hi(g[q].z) + bf_hi(o[q].z); v1[2] = v1[2] * bf_lo(g[q].w) + bf_lo(o[q].w); v1[3] = v1[3] * bf_hi(g[q].w) + bf_hi(o[q].w);
                    u32x4 w; w.x = cvt_pk_bf16(v0[0], v0[1]); w.y = cvt_pk_bf16(v0[2], v0[3]); w.z = cvt_pk_bf16(v1[0], v1[1]); w.w = cvt_pk_bf16(v1[2], v1[3]);
                    *(u32x4*)(MG + row * 1024 + col) = w; } }
    }
};
typedef unsigned u32x2 __attribute__((ext_vector_type(2)));
struct EpiResid {
    static constexpr bool PERM = false, AFTER_DRAIN = false, MID = false; static constexpr int MID_TILES = 1; __device__ __forceinline__ void set_scale0() { scale = 0.f; x32 = nullptr; }
    const float* x32; bf16_t* out; int ldc; float scale;
    __device__ __forceinline__ void operator()(const f32x4 (&acc)[2][2][4][2], const Unit& u, int wr, int wc, int fr, int fq) const {
        const int row0 = u.pm * BM + wr * 64 + fr, col0 = u.pn * BM + wc * 32 + 4 * fq;
#pragma unroll
        for (int ai = 0; ai < 2; ++ai)
#pragma unroll
            for (int mp = 0; mp < 2; ++mp) {
                f32x4 b[8];
                if (x32) {
#pragma unroll
                    for (int q = 0; q < 8; ++q) { const int m = 2 * mp + (q >> 2), bj = (q >> 1) & 1, n = q & 1;
                        b[q] = *(const f32x4*)(x32 + (size_t)(row0 + ai * HALF + m * 16) * ldc + col0 + bj * HALF + n * 16); }
                } else {
                    u32x2 t[8];
#pragma unroll
                    for (int q = 0; q < 8; ++q) { const int m = 2 * mp + (q >> 2), bj = (q >> 1) & 1, n = q & 1;
                        t[q] = *(const u32x2*)(out + (size_t)(row0 + ai * HALF + m * 16) * ldc + col0 + bj * HALF + n * 16); }
#pragma unroll
                    for (int q = 0; q < 8; ++q) b[q] = (f32x4){bf_lo(t[q].x), bf_hi(t[q].x), bf_lo(t[q].y), bf_hi(t[q].y)};
                }
#pragma unroll
                for (int q = 0; q < 8; ++q) { const int m = 2 * mp + (q >> 2), bj = (q >> 1) & 1, n = q & 1; const f32x4 r = b[q] + acc[ai][bj][m][n] * scale;
                    *(u32x2*)(out + (size_t)(row0 + ai * HALF + m * 16) * ldc + col0 + bj * HALF + n * 16) = (u32x2){cvt_pk_bf16(r.x, r.y), cvt_pk_bf16(r.z, r.w)}; } }
    }
};
struct EpiF32 {
    static constexpr bool PERM = false, AFTER_DRAIN = false, MID = false; static constexpr int MID_TILES = 1; __device__ __forceinline__ void set_scale0() {}
    float* O; int ldc, nN;
    __device__ __forceinline__ void operator()(const f32x4 (&acc)[2][2][4][2], const Unit& u, int wr, int wc, int fr, int fq) const {
        const int row0 = u.pm * BM + wr * 64 + fr, col0 = (u.pn % nN) * BM + wc * 32 + 4 * fq;
#pragma unroll
        for (int ai = 0; ai < 2; ++ai)
#pragma unroll
            for (int m = 0; m < 4; ++m) { const size_t off = (size_t)(row0 + ai * HALF + m * 16) * ldc + col0;
#pragma unroll
                for (int bj = 0; bj < 2; ++bj)
#pragma unroll
                    for (int n = 0; n < 2; ++n) *(f32x4*)(O + off + bj * HALF + n * 16) = acc[ai][bj][m][n]; }
    }
};
#ifdef EMU_FP8_HID
__device__ __forceinline__ float Q8H(float x) { const int p = __builtin_amdgcn_cvt_pk_fp8_f32(x * 8.f, x * 8.f, 0, false); return __builtin_amdgcn_cvt_f32_fp8(p, 0) * 0.125f; }
#else
__device__ __forceinline__ float Q8H(float x) { return x; }
#endif
struct EpiSwiGLU {
    static constexpr bool PERM = true, AFTER_DRAIN = false, MID = false; static constexpr int MID_TILES = 1; __device__ __forceinline__ void set_scale0() {}
    bf16_t* H; int ldh; const float* rowscale; int nN; const float* prescale; int rowmask = 0x7fffffff;
    __device__ __forceinline__ void operator()(const f32x4 (&acc)[2][2][4][2], const Unit& u, int wr, int wc, int fr, int fq) const {
        const int row0 = u.pm * BM + wr * 64 + fr, col0 = (u.pn % nN) * HALF + wc * 32 + 8 * fq;
        float scv[8];
#pragma unroll
        for (int q = 0; q < 8; ++q) scv[q] = rowscale ? rowscale[row0 + (q >> 2) * HALF + (q & 3) * 16] : 1.0f;
        float psv[8];
#pragma unroll
        for (int q = 0; q < 8; ++q) psv[q] = prescale[row0 + (q >> 2) * HALF + (q & 3) * 16];
#pragma unroll
        for (int ai = 0; ai < 2; ++ai)
#pragma unroll
            for (int m = 0; m < 4; ++m) { const int row = row0 + ai * HALF + m * 16; const float sc = scv[ai * 4 + m], ps = psv[ai * 4 + m];
                float h[8];
#pragma unroll
                for (int n = 0; n < 2; ++n)
#pragma unroll
                    for (int e = 0; e < 4; ++e) { const float g = acc[ai][0][m][n][e] * ps, up = acc[ai][1][m][n][e] * (ps * sc); h[n * 4 + e] = Q8H(g * fast_sigmoid(g) * up); }
                u32x4 w; w.x = cvt_pk_bf16(h[0], h[1]); w.y = cvt_pk_bf16(h[2], h[3]); w.z = cvt_pk_bf16(h[4], h[5]); w.w = cvt_pk_bf16(h[6], h[7]);
                PG8_STORE_OUT((u32x4*)(H + (size_t)(row & rowmask) * ldh + col0), w); }
    }
};
struct EpiScatter {
    static constexpr bool PERM = false, AFTER_DRAIN = false, MID = false; static constexpr int MID_TILES = 1; __device__ __forceinline__ void set_scale0() { scale = 0.f; }
    bf16_t* out; const int* tok; int nN; float scale;
    __device__ __forceinline__ void operator()(const f32x4 (&acc)[2][2][4][2], const Unit& u, int wr, int wc, int fr, int fq) const {
        const int row0 = u.pm * BM + wr * 64 + fr, col0 = (u.pn % nN) * BM + wc * 32 + 4 * fq;
        int tk[8];
#pragma unroll
        for (int q = 0; q < 8; ++q) tk[q] = tok[row0 + (q >> 2) * HALF + (q & 3) * 16];
#pragma unroll
        for (int ai = 0; ai < 2; ++ai)
#pragma unroll
            for (int mp = 0; mp < 2; ++mp) {
                u32x2 b[8];
#pragma unroll
                for (int q = 0; q < 8; ++q) { const int m = 2 * mp + (q >> 2), bj = (q >> 1) & 1, n = q & 1; const int t = tk[ai * 4 + m];
                    b[q] = *(const u32x2*)(out + (size_t)(t < 0 ? 0 : t) * 1024 + col0 + bj * HALF + n * 16); }
#pragma unroll
                for (int q = 0; q < 8; ++q) { const int m = 2 * mp + (q >> 2), bj = (q >> 1) & 1, n = q & 1; const int t = tk[ai * 4 + m];
                    if (t >= 0) { const f32x4 r = (f32x4){bf_lo(b[q].x), bf_hi(b[q].x), bf_lo(b[q].y), bf_hi(b[q].y)} + acc[ai][bj][m][n] * scale;
                        *(u32x2*)(out + (size_t)t * 1024 + col0 + bj * HALF + n * 16) = (u32x2){cvt_pk_bf16(r.x, r.y), cvt_pk_bf16(r.z, r.w)}; } } }
    }
};
struct GroupedOrder {
    StaticOrder so; const PG8_LAS int* tile_e; int nN;
    __device__ __forceinline__ bool next(int i, Unit& u) const { if (!so.next(i, u)) return false; u.pn += tile_e[u.pm] * nN; return true; }
    __device__ __forceinline__ void a_ready(const Unit&) const {}
    __device__ __forceinline__ void done(const Unit&) const {}
};
struct LimitOrder {
    StaticOrder so; int limit;
    __device__ __forceinline__ bool next(int i, Unit& u) const { if ((long)i * so.G + so.c >= limit) return false; return so.next(i, u); }
    __device__ __forceinline__ void a_ready(const Unit&) const {}
    __device__ __forceinline__ void done(const Unit&) const {}
};
struct GroupedLimit {
    LimitOrder lo; const PG8_LAS int* tile_e; int nN;
    __device__ __forceinline__ bool next(int i, Unit& u) const { if (!lo.next(i, u)) return false; u.pn += tile_e[u.pm] * nN; return true; }
    __device__ __forceinline__ void a_ready(const Unit&) const {}
    __device__ __forceinline__ void done(const Unit&) const {}
};
struct SingleOrder {
    Unit un;
    __device__ __forceinline__ bool next(int i, Unit& u) const { if (i != 0) return false; u = un; return true; }
    __device__ __forceinline__ void a_ready(const Unit&) const {}
    __device__ __forceinline__ void done(const Unit&) const {}
};
struct EpiTile {
    static constexpr bool PERM = false, AFTER_DRAIN = false, MID = false; static constexpr int MID_TILES = 1; __device__ __forceinline__ void set_scale0() {}
    float* O;
    __device__ __forceinline__ void operator()(const f32x4 (&acc)[2][2][4][2], const Unit&, int wr, int wc, int fr, int fq) const {
#pragma unroll
        for (int ai = 0; ai < 2; ++ai)
#pragma unroll
            for (int m = 0; m < 4; ++m)
#pragma unroll
                for (int bj = 0; bj < 2; ++bj)
#pragma unroll
                    for (int n = 0; n < 2; ++n) *(f32x4*)(O + (size_t)(wr * 64 + fr + ai * HALF + m * 16) * 256 + wc * 32 + 4 * fq + bj * HALF + n * 16) = acc[ai][bj][m][n];
    }
};
struct OffsetOrder {
    StaticOrder so; int pn_off;
    __device__ __forceinline__ bool next(int i, Unit& u) const { if (!so.next(i, u)) return false; u.pn += pn_off; return true; }
    __device__ __forceinline__ void a_ready(const Unit&) const {}
    __device__ __forceinline__ void done(const Unit&) const {}
};
struct ProbeOrder {
    StaticOrder so; int pm_mask;
    __device__ __forceinline__ bool next(int i, Unit& u) const { if (!so.next(i, u)) return false; u.pm &= pm_mask; return true; }
    __device__ __forceinline__ void a_ready(const Unit&) const {}
    __device__ __forceinline__ void done(const Unit&) const {}
};
struct MergeOrder {
    StaticOrder so; int nmt;
    __device__ __forceinline__ bool next(int i, Unit& u) const { const int b = i % 3; if (!so.next(i / 3, u)) return false; u.pm += b * nmt; u.pn += b * 4; return true; }
    __device__ __forceinline__ void a_ready(const Unit&) const {}
    __device__ __forceinline__ void done(const Unit&) const {}
};
template <class Epi, class Sched, bool ALIGN_EPI = false, bool SP2 = false, bool GATHER = false>
__device__ __forceinline__ void gemm_phase(PG8_LAS unsigned char* lds, const Gemm g, const Sched& S, const Epi& E) {
    const int tid = g.zv  , wid = __builtin_amdgcn_readfirstlane(tid >> 6), lane = tid & 63, wr = wid >> 2, wc = wid & 3, fr = lane & 15, fq = lane >> 4;
    const int K = g.K, nt = K / BK;
    unsigned voffA[2], voffB[2]; int gR = 0, gC = 0;
#pragma unroll
    for (int i = 0; i < 2; ++i) { int R, C; stage_rc(tid * 16 + i * 8192, R, C); const int Rb = Epi::PERM ? ((R & ~31) + perm32(R & 31)) : R;
        const int LD = g.ld ? g.ld : K;
        const int pitch = g.tiled ? BK : LD;
        voffA[i] = (unsigned)(R * pitch + C) * 2u; voffB[i] = (unsigned)(Rb * pitch + C) * 2u; if (i == 0) { gR = R; gC = C; } }
    const size_t kstep = g.tiled ? (size_t)(BM * BK * 2) : (size_t)(BK * 2);
    const size_t hstep = g.tiled ? (size_t)(HALF * BK * 2) : (size_t)HALF * (g.ld ? g.ld : K) * 2;
    const size_t tstep = (size_t)BM * (g.ld ? g.ld : K) * 2; const size_t tstepA = GATHER ? 0 : tstep, hstepA = GATHER ? 0 : hstep;
    const unsigned ldsw = (unsigned)wid * 1024u;
    const int aoff = lds_byte(wr * 64 + fr, fq * 8), boff = lds_byte(wc * 32 + fr, fq * 8);
#define PG8_SA(b, h) (((b) * 2 + (h)) * HTB)
#define PG8_SB(b, h) ((4 + (b) * 2 + (h)) * HTB)
#define PG8_STAGE(bufoff, gbase, voff) do { _Pragma("unroll") for (int _i = 0; _i < 2; ++_i) \
        __builtin_amdgcn_global_load_lds((const unsigned*)((const char*)(gbase) + (voff)[_i]), (PG8_LAS unsigned*)(lds + (bufoff) + ldsw + _i * 8192), 16, 0, ((bufoff) < 4 * HTB) ? PG8_AUX_A : PG8_AUX_B); } while (0)
#define PG8_LDA(dst, b, h) do { _Pragma("unroll") for (int m = 0; m < 4; ++m) _Pragma("unroll") for (int k = 0; k < 2; ++k) dst[m][k] = *(const PG8_LAS bf16x8*)(lds + PG8_SA(b, h) + aoff + m * 2048 + k * 1024); } while (0)
#define PG8_LDB(dst, b, h) do { _Pragma("unroll") for (int n = 0; n < 2; ++n) _Pragma("unroll") for (int k = 0; k < 2; ++k) dst[n][k] = *(const PG8_LAS bf16x8*)(lds + PG8_SB(b, h) + boff + n * 2048 + k * 1024); } while (0)
#define PG8_MMA(ai, bj, At, Bt) do { __builtin_amdgcn_s_setprio(1); _Pragma("unroll") for (int m = 0; m < 4; ++m) _Pragma("unroll") for (int n = 0; n < 2; ++n) _Pragma("unroll") for (int k = 0; k < 2; ++k) \
        acc[ai][bj][m][n] = __builtin_amdgcn_mfma_f32_16x16x32_bf16(Bt[n][k], At[m][k], acc[ai][bj][m][n], 0, 0, 0); __builtin_amdgcn_s_setprio(0); } while (0)
#define PG8_WAIT_V(n) asm volatile("s_waitcnt vmcnt(" #n ")" ::: "memory")
#define PG8_WAIT_L(n) asm volatile("s_waitcnt lgkmcnt(" #n ")" ::: "memory")
#define PG8_BAR __builtin_amdgcn_s_barrier()
#define PG8_SCHED __builtin_amdgcn_sched_barrier(0)
    Unit cur, nxt; int ui = 0;
    if (!S.next(0, cur)) return;
    f32x4 acc[2][2][4][2];
#pragma unroll
    for (int a = 0; a < 2; ++a)
#pragma unroll
        for (int b = 0; b < 2; ++b)
#pragma unroll
            for (int m = 0; m < 4; ++m)
#pragma unroll
                for (int n = 0; n < 2; ++n) acc[a][b][m][n] = (f32x4){0.f, 0.f, 0.f, 0.f};
    bf16x8 At[4][2], B0[2][2], B1[2][2];
    const char* cA = (const char*)g.A + (size_t)cur.pm * tstepA; const char* cB = (const char*)g.Bt + (size_t)cur.pn * tstep;
    const int rot = g.rot; const size_t rofs = (size_t)rot * kstep; const char* pA = cA + rofs; const char* pB = cB + rofs;
#define PG8_KT(x) ((size_t)(((x) + rot >= nt) ? (x) + rot - nt : (x) + rot))
    unsigned vC[2][2], vN[2][2];
#define PG8_GIDX(u, vv) do { _Pragma("unroll") for (int h_ = 0; h_ < 2; ++h_) _Pragma("unroll") for (int i_ = 0; i_ < 2; ++i_) { \
        if constexpr (GATHER) { const int t_ = g.gidx[(u).pm * BM + h_ * HALF + gR + 64 * i_]; vv[h_][i_] = (unsigned)((t_ < 0 ? 0 : t_) * (g.ld ? g.ld : K) + gC) * 2u; } else vv[h_][i_] = voffA[i_]; } } while (0)
    PG8_GIDX(cur, vC);
    S.a_ready(cur);
    if constexpr (SP2) {
        PG8_STAGE(PG8_SB(0, 0), pB, voffB); PG8_STAGE(PG8_SB(0, 1), pB + hstep, voffB); PG8_STAGE(PG8_SA(0, 0), pA, vC[0]); PG8_STAGE(PG8_SA(0, 1), pA + hstepA, vC[1]);
        if (wr == 1) PG8_BAR;
        PG8_WAIT_V(2); PG8_BAR;
        PG8_STAGE(PG8_SB(1, 0), pB + kstep, voffB); PG8_STAGE(PG8_SA(1, 0), pA + kstep, vC[0]); PG8_STAGE(PG8_SB(1, 1), pB + hstep + kstep, voffB);
        PG8_WAIT_V(6); PG8_BAR;
    } else {
        PG8_STAGE(PG8_SB(0, 0), pB, voffB); PG8_STAGE(PG8_SA(0, 0), pA, vC[0]); PG8_STAGE(PG8_SB(0, 1), pB + hstep, voffB); PG8_STAGE(PG8_SA(0, 1), pA + hstepA, vC[1]);
        if (wr == 1) PG8_BAR;
        PG8_WAIT_V(4); PG8_BAR;
        PG8_STAGE(PG8_SB(1, 0), pB + kstep, voffB); PG8_STAGE(PG8_SA(1, 0), pA + kstep, vC[0]); PG8_STAGE(PG8_SB(1, 1), pB + hstep + kstep, voffB);
        PG8_WAIT_V(6); PG8_BAR;
    }
    for (;;) {
        const bool has_next = S.next(ui + 1, nxt);
        if (has_next) PG8_GIDX(nxt, vN); else { vN[0][0] = vC[0][0]; vN[0][1] = vC[0][1]; vN[1][0] = vC[1][0]; vN[1][1] = vC[1][1]; }
        const char* nA = has_next ? (const char*)g.A + (size_t)nxt.pm * tstepA : cA; const char* nB = has_next ? (const char*)g.Bt + (size_t)nxt.pn * tstep : cB;
        for (int t = 0; t < nt; t += 2) {
            if constexpr (Epi::MID) { if (t != 0 && (t & (Epi::MID_TILES - 1)) == 0) E.mid(acc, cur, t / Epi::MID_TILES, wr, wc, fr, fq); }
            const bool last = (t == nt - 2);
            const char* a1 = cA + PG8_KT(t + 1) * kstep;
            const char* a2 = last ? nA + rofs : cA + PG8_KT(t + 2) * kstep; const char* b2 = last ? nB + rofs : cB + PG8_KT(t + 2) * kstep;
            const char* a3 = a2 + kstep; const char* b3 = b2 + kstep;
            if (last && has_next) S.a_ready(nxt);
            const unsigned v2h0[2] = {last ? vN[0][0] : vC[0][0], last ? vN[0][1] : vC[0][1]}, v2h1[2] = {last ? vN[1][0] : vC[1][0], last ? vN[1][1] : vC[1][1]};
            if constexpr (SP2) {
            PG8_LDB(B0, 0, 0); PG8_LDB(B1, 0, 1); PG8_SCHED; PG8_LDA(At, 0, 0); PG8_STAGE(PG8_SA(1, 1), a1 + hstepA, vC[1]);
            PG8_WAIT_V(8); PG8_WAIT_L(0); PG8_BAR; PG8_MMA(0, 0, At, B0); PG8_MMA(0, 1, At, B1); PG8_BAR; PG8_SCHED;
            PG8_LDA(At, 0, 1); PG8_STAGE(PG8_SB(0, 0), b2, voffB); PG8_STAGE(PG8_SB(0, 1), b2 + hstep, voffB); PG8_STAGE(PG8_SA(0, 0), a2, v2h0);
            PG8_WAIT_V(8); PG8_WAIT_L(0); PG8_BAR; PG8_MMA(1, 0, At, B0); PG8_MMA(1, 1, At, B1); PG8_BAR; PG8_SCHED;
            PG8_LDB(B0, 1, 0); PG8_LDB(B1, 1, 1); PG8_SCHED; PG8_LDA(At, 1, 0); PG8_STAGE(PG8_SA(0, 1), a2 + hstepA, v2h1);
            PG8_WAIT_V(8); PG8_WAIT_L(0); PG8_BAR; PG8_MMA(0, 0, At, B0); PG8_MMA(0, 1, At, B1); PG8_BAR; PG8_SCHED;
            PG8_LDA(At, 1, 1); PG8_STAGE(PG8_SB(1, 0), b3, voffB); PG8_STAGE(PG8_SB(1, 1), b3 + hstep, voffB); PG8_STAGE(PG8_SA(1, 0), a3, v2h0);
            PG8_WAIT_V(8); PG8_WAIT_L(0); PG8_BAR; PG8_MMA(1, 0, At, B0); PG8_MMA(1, 1, At, B1); PG8_BAR; PG8_SCHED;
            } else {
            PG8_LDB(B0, 0, 0); PG8_SCHED; PG8_LDA(At, 0, 0); PG8_STAGE(PG8_SA(1, 1), a1 + hstepA, vC[1]);
            PG8_WAIT_L(8); PG8_BAR; PG8_WAIT_L(0); PG8_MMA(0, 0, At, B0); PG8_BAR; PG8_SCHED;
            PG8_LDB(B1, 0, 1); PG8_STAGE(PG8_SB(0, 0), b2, voffB);
            PG8_BAR; PG8_WAIT_L(0); PG8_MMA(0, 1, At, B1); PG8_BAR;
            PG8_LDA(At, 0, 1); PG8_STAGE(PG8_SA(0, 0), a2, v2h0);
            PG8_BAR; PG8_WAIT_L(0); PG8_MMA(1, 0, At, B0); PG8_BAR; PG8_SCHED;
            PG8_STAGE(PG8_SB(0, 1), b2 + hstep, voffB);
            PG8_WAIT_V(6); PG8_BAR; PG8_MMA(1, 1, At, B1); PG8_BAR;
            PG8_LDB(B0, 1, 0); PG8_SCHED; PG8_LDA(At, 1, 0); PG8_STAGE(PG8_SA(0, 1), a2 + hstepA, v2h1);
            PG8_WAIT_L(8); PG8_BAR; PG8_WAIT_L(0); PG8_MMA(0, 0, At, B0); PG8_BAR; PG8_SCHED;
            PG8_LDB(B1, 1, 1); PG8_STAGE(PG8_SB(1, 0), b3, voffB);
            PG8_BAR; PG8_WAIT_L(0); PG8_MMA(0, 1, At, B1); PG8_BAR;
            PG8_LDA(At, 1, 1); PG8_STAGE(PG8_SA(1, 0), a3, v2h0);
            PG8_BAR; PG8_WAIT_L(0); PG8_MMA(1, 0, At, B0); PG8_BAR; PG8_SCHED;
            PG8_STAGE(PG8_SB(1, 1), b3 + hstep, voffB);
            PG8_WAIT_V(6); PG8_BAR; PG8_MMA(1, 1, At, B1); PG8_BAR;
            }
        }
        if constexpr (ALIGN_EPI) { if (wr == 0) PG8_BAR; }
        if constexpr (!Epi::AFTER_DRAIN) { E(acc, cur, wr, wc, fr, fq); S.done(cur); }
        if (!has_next) break;
#pragma unroll
        for (int a = 0; a < 2; ++a)
#pragma unroll
            for (int b = 0; b < 2; ++b)
#pragma unroll
                for (int m = 0; m < 4; ++m)
#pragma unroll
                    for (int n = 0; n < 2; ++n) acc[a][b][m][n] = (f32x4){0.f, 0.f, 0.f, 0.f};
        cur = nxt; cA = nA; cB = nB; ++ui; vC[0][0] = vN[0][0]; vC[0][1] = vN[0][1]; vC[1][0] = vN[1][0]; vC[1][1] = vN[1][1];
        if constexpr (ALIGN_EPI) { if (wr == 1) PG8_BAR; }
    }
    PG8_WAIT_V(0);
    if constexpr (!ALIGN_EPI) { if (wr == 0) PG8_BAR; }
    PG8_BAR;
    if constexpr (Epi::AFTER_DRAIN) { E.fused(acc, cur, wr, wc, fr, fq, lds, wid, lane); S.done(cur); }
#undef PG8_KT
#undef PG8_SA
#undef PG8_SB
#undef PG8_STAGE
#undef PG8_LDA
#undef PG8_LDB
#undef PG8_MMA
#undef PG8_WAIT_V
#undef PG8_WAIT_L
#undef PG8_BAR
#undef PG8_SCHED
}
}

constexpr int NWAVES = 8;
constexpr int DM = 1024, BATCH = 16, SEQ = 4096, DEPTH = 4, MTOK = BATCH * SEQ;
constexpr int NCHUNK = 2, MC = MTOK / NCHUNK, BC = BATCH / NCHUNK;
constexpr int CIN = 5004, NPROJ = 5120, P1W = 2048, GWID = 3072;
constexpr int DFF = 2752, DFFP = 2816, NFF1 = 2 * DFFP;
constexpr int NEXP = 8, DFE = 3584, NMOE1 = 2 * DFE;
constexpr int SLOTS = MC + 2048;
constexpr float EPS = 1e-6f;
constexpr int C_U = 0, C_V = 256, C_SBQ = 512, C_SBK = 768, C_SBV = 1024, C_CQ = 1280, C_KCMP = 1536, C_VCMP = 1600, C_KSLC = 1664, C_VSLC = 1728, C_KWIN = 1792, C_VWIN = 1856, C_CG = 1920;

constexpr size_t MiB = 1u << 20;
constexpr size_t WS_CTL = 0, CTL_ZERO_BYTES = 1 * MiB;
constexpr size_t WS_ROPE = 1 * MiB;
constexpr size_t WS_BIAS1 = 1 * MiB + 512 * 1024;
constexpr size_t WS_RSTD = WS_BIAS1 + 64 * 1024;
constexpr size_t WS_WIN = 2 * MiB;
constexpr size_t WS_WBR = 12 * MiB;
constexpr size_t WS_WOUT = 14 * MiB;
constexpr size_t WS_WC1 = 16 * MiB;
constexpr size_t WS_WF1 = 18 * MiB;
constexpr size_t WS_WF2 = 130 * MiB;
constexpr size_t WS_HN = 186 * MiB;
constexpr size_t WS_SCR = 314 * MiB;
constexpr size_t WS_P1 = WS_SCR;
constexpr size_t WS_G = WS_P1 + 128 * MiB;
constexpr size_t WS_Y = WS_G + 192 * MiB;
constexpr size_t WS_MG = WS_Y + 48 * MiB;
constexpr size_t WS_KVC = WS_MG + 64 * MiB;
constexpr size_t WS_UL = WS_KVC + 8 * MiB;
constexpr size_t WS_KC = WS_UL + 8 * MiB;
constexpr size_t WS_VT = WS_KC + 1 * MiB;
constexpr size_t WS_KCT = WS_VT + 24 * MiB;
constexpr size_t WS_MIX_END = WS_KCT + 1 * MiB;
constexpr size_t WS_HID = WS_SCR;
constexpr size_t WS_ROUTE = WS_SCR;
constexpr size_t WS_TOKMAP = WS_SCR + 1 * MiB;
constexpr size_t WS_WSLOT = WS_SCR + 2 * MiB;
constexpr size_t WS_RSLOT = WS_SCR + 3 * MiB + 64 * 1024;
constexpr size_t WS_CNT128 = WS_SCR + 3 * MiB;
constexpr size_t WS_HIDM = WS_SCR + 4 * MiB;
constexpr size_t WS_H = 800 * MiB;
constexpr size_t WS_TB = 928 * MiB;
constexpr size_t WS_END = 976 * MiB;
static_assert(WS_MIX_END <= WS_H && WS_HID + (size_t)MTOK * DFFP * 2 <= WS_H && WS_HIDM + (size_t)2 * SLOTS * DFE * 2 <= WS_H, "d_ws map");
static_assert(WS_WF1 + (size_t)NEXP * NMOE1 * DM * 2 <= WS_WF2 && WS_WF2 + (size_t)NEXP * DM * DFE * 2 <= WS_HN, "weight map");
static_assert((size_t)4 * SLOTS * 4 <= 1 * MiB, "tokmap");
constexpr int CW_BAR = 4096;
constexpr int CW_CNT = 131072;
constexpr int CW_CUR = 131072 + 256;
constexpr int MAX_BAR_REGIONS = 32;
constexpr int RING_OFF = 0, RING_BYTES = 131072;
constexpr int LDSCTL_OFF = RING_BYTES, MISC_OFF = LDSCTL_OFF + 320;
constexpr int TAB_OFF = LDSCTL_OFF + 1024;
constexpr int LDS_BYTES = 147456;

#define GAS __attribute__((address_space(1)))
#define LAS __attribute__((address_space(3)))
typedef unsigned short bf16;
typedef unsigned v4u __attribute__((ext_vector_type(4)));
typedef unsigned v2u __attribute__((ext_vector_type(2)));
typedef float f32x4 __attribute__((ext_vector_type(4)));
typedef int v4i __attribute__((ext_vector_type(4)));
typedef __bf16 bf16x2_t __attribute__((ext_vector_type(2)));
#define LDS_WAIT() asm volatile("s_waitcnt lgkmcnt(0)" ::: "memory")
#define VM_WAIT() asm volatile("s_waitcnt vmcnt(0)" ::: "memory")
__device__ __forceinline__ unsigned f2bf(float f) { unsigned u = __builtin_bit_cast(unsigned, f); return (u + 0x7fffu + ((u >> 16) & 1u)) >> 16; }
__device__ __forceinline__ unsigned pk2(float lo, float hi) { return f2bf(lo) | (f2bf(hi) << 16); }
__device__ __forceinline__ float bflo(unsigned u) { return __builtin_bit_cast(float, u << 16); }
__device__ __forceinline__ float bfhi(unsigned u) { return __builtin_bit_cast(float, u & 0xffff0000u); }
__device__ __forceinline__ float bf1(bf16 h) { return __builtin_bit_cast(float, (unsigned)h << 16); }
__device__ __forceinline__ float dot2bf(unsigned a, unsigned b, float c) { return __builtin_amdgcn_fdot2_f32_bf16(__builtin_bit_cast(bf16x2_t, a), __builtin_bit_cast(bf16x2_t, b), c, false); }
#ifdef EMU_FP8
__device__ __forceinline__ float q8r(float x, float s) { const int p = __builtin_amdgcn_cvt_pk_fp8_f32(x * s, x * s, 0, false); return __builtin_amdgcn_cvt_f32_fp8(p, 0) * (1.0f / s); }
#else
__device__ __forceinline__ float q8r(float x, float) { return x; }
#endif
__device__ __forceinline__ float fexp(float x) { return __builtin_amdgcn_exp2f(1.4426950408889634f * x); }
template <int X> __device__ __forceinline__ float swz_xor(float v) { return __builtin_bit_cast(float, __builtin_amdgcn_ds_swizzle(__builtin_bit_cast(int, v), (X << 10) | 0x1f)); }
__device__ __forceinline__ float wave_sum(float v, int lane) {
#pragma unroll
    for (int o = 1; o < 64; o <<= 1) v += __builtin_bit_cast(float, __builtin_amdgcn_ds_bpermute((lane ^ o) << 2, __builtin_bit_cast(int, v)));
    return v;
}
__device__ __forceinline__ float rdlane(float v, int l) { return __builtin_bit_cast(float, __builtin_amdgcn_readlane(__builtin_bit_cast(int, v), l)); }
__device__ __forceinline__ int bperm(int srclane, int v) { return __builtin_amdgcn_ds_bpermute(srclane << 2, v); }
__constant__ double ROPE_INVF[8] = {1.0, 0.19392274474868576, 0.037606030930863933, 0.0072926647372171093, 0.0014142135623730950, 0.00027424817567620730, 5.3182958969449883e-05, 1.0313385377212460e-05};
#define XB_TMO      128
#define XB_XCNT(j)  (256  + 64 * (j))
#define XB_XSUB(j)  (1280 + 64 * (j))
#define XB_XGEN(j)  (2304 + 64 * (j))
#define XB_TOP      3328
#define XB_TOPGEN   3392
#define XCD_BAR_WORDS 3456
#define XB_SPIN_CAP (1u << 18)

__device__ __forceinline__ unsigned xb_ld(unsigned* p)              { return __hip_atomic_load(p, __ATOMIC_RELAXED, __HIP_MEMORY_SCOPE_AGENT); }
__device__ __forceinline__ unsigned xb_add(unsigned* p, unsigned v) { return __hip_atomic_fetch_add(p, v, __ATOMIC_RELAXED, __HIP_MEMORY_SCOPE_AGENT); }
__device__ __forceinline__ unsigned xb_xcc_id() { return (unsigned)__builtin_amdgcn_s_getreg((3 << 11) | 20) & 0xFu; }
#define XB_SPIN(cond, bar) do { unsigned _sp = 0; while (cond) { __builtin_amdgcn_s_sleep(1); \
    if ((++_sp & 255u) == 0u) { if (xb_ld(&(bar)[XB_TMO])) break; if (_sp > XB_SPIN_CAP) { atomicAdd(&(bar)[XB_TMO], 1u); break; } } } } while (0)

__device__ __forceinline__ bool xb_thread0_w(unsigned w, unsigned z) { return w == 0u && __builtin_amdgcn_mbcnt_hi(~0u, __builtin_amdgcn_mbcnt_lo(~0u, z)) == 0u; }
struct XcdBarrier {
    unsigned* bar; unsigned x; unsigned w, z;
    volatile LAS unsigned* st;
};

__device__ __forceinline__ XcdBarrier xcd_barrier_post(unsigned* bar, volatile LAS unsigned* st) {
    XcdBarrier b; b.bar = bar; b.x = xb_xcc_id(); b.st = st; b.w = (unsigned)__builtin_amdgcn_readfirstlane((int)(threadIdx.x >> 6)); b.z = 0u;
    if (xb_thread0_w(b.w, b.z)) (void)xb_add(&bar[XB_XCNT(b.x)], 1u);
    return b;
}
__device__ __forceinline__ void xcd_barrier_complete(unsigned* bar, unsigned x, unsigned& nloc, unsigned& nx) {
    const unsigned G = gridDim.x * gridDim.y * gridDim.z;
    unsigned sum, cnt, mine, sp = 0u;
    for (;;) {
        sum = 0u; cnt = 0u; mine = 0u;
#pragma unroll
        for (unsigned j = 0; j < 16; ++j) { const unsigned c = xb_ld(&bar[XB_XCNT(j)]); sum += c; cnt += (c > 0u) ? 1u : 0u; mine = (j == x) ? c : mine; }
        if (sum == G) break;
        __builtin_amdgcn_s_sleep(1);
        if ((++sp & 255u) == 0u) { if (xb_ld(&bar[XB_TMO])) break; if (sp > XB_SPIN_CAP) { atomicAdd(&bar[XB_TMO], 1u); break; } }
    }
    nloc = mine > 0u ? mine : 1u; nx = cnt > 0u ? cnt : 1u;
}

__device__ __forceinline__ void xcd_barrier(const XcdBarrier& b) {
    asm volatile("s_waitcnt vmcnt(0)" ::: "memory");
    __syncthreads();
    if (xb_thread0_w(b.w, b.z)) {
        unsigned* bar = b.bar;
        __builtin_amdgcn_s_waitcnt(0);
        unsigned nloc = b.st[0], nx = b.st[1];
        if (nloc == 0u) { xcd_barrier_complete(bar, b.x, nloc, nx); b.st[0] = nloc; b.st[1] = nx; }
        const unsigned old = xb_add(&bar[XB_XSUB(b.x)], 1u);
        const unsigned gen = old / nloc;
        if (old + 1u == (gen + 1u) * nloc) {
            __builtin_amdgcn_fence(__ATOMIC_RELEASE, "agent");
            asm volatile("s_waitcnt vmcnt(0)" ::: "memory");
            const unsigned og = xb_add(&bar[XB_TOP], 1u);
            const unsigned tg = og / nx;
            if (og + 1u == (tg + 1u) * nx) xb_add(&bar[XB_TOPGEN], 1u);
            else XB_SPIN(xb_ld(&bar[XB_TOPGEN]) == tg, bar);
            __builtin_amdgcn_fence(__ATOMIC_ACQUIRE, "agent");
            xb_add(&bar[XB_XGEN(b.x)], 1u);
            asm volatile("s_waitcnt vmcnt(0)" ::: "memory");
        } else {
            XB_SPIN(xb_ld(&bar[XB_XGEN(b.x)]) == gen, bar);
            __builtin_amdgcn_fence(__ATOMIC_ACQUIRE, "agent");
            asm volatile("s_waitcnt vmcnt(0)" ::: "memory");
        }
    }
    __syncthreads();
}

struct Frame {
    LAS unsigned char* lds;
    unsigned* ctl;
    int tid, lane, wave, vcu, G, bx, zv, zs, rep;
    unsigned char* ws;
    const float* const* in;
    float* out;
};
#define WSP(T, off) ((T*)(F.ws + (off)))
__device__ __forceinline__ size_t toff(int row, int k, int K) { return (size_t)(row >> 8) * 256 * K + (size_t)(k >> 6) * (256 * 64) + (size_t)(row & 255) * 64 + (k & 63); }

#ifndef TILED_FFN1
#define TILED_FFN1 0
#endif
#ifndef Q8_W1
#define Q8_W1 0.f
#define Q8_W2 0.f
#define Q8_HN 0.f
#define Q8_HID 0.f
#endif
__device__ __forceinline__ int map_row(int kind, int off, int n) { return kind == 0 ? n + off : (kind == 1 ? (n < 1932 ? n : n + 116) : ((n >> 7) * 256 + (n & 127) + off)); }
__device__ __forceinline__ void tr_item(const float* W, int ldw, int N, int ks, int n0, bf16* WT, int ldt, int kd, int kind, int off, LAS unsigned char* scr, int lane, float q8s = 0.f, int tiled = 0, const float* gk = nullptr) {
    const int nq = (lane & 15) * 4, kq = lane >> 4;
    f32x4 x[16];
#pragma unroll
    for (int i = 0; i < 16; ++i) x[i] = (n0 + nq < N) ? *(const f32x4*)(W + (size_t)(ks + 4 * i + kq) * ldw + n0 + nq) : (f32x4){0.f, 0.f, 0.f, 0.f};
    if (gk) {
        float gs[16];
#pragma unroll
        for (int i = 0; i < 16; ++i) gs[i] = gk[ks + 4 * i + kq];
#pragma unroll
        for (int i = 0; i < 16; ++i) x[i] = x[i] * gs[i]; }
#pragma unroll
    for (int i = 0; i < 16; ++i) { const int k = 4 * i + kq;
#pragma unroll
        for (int c = 0; c < 4; ++c) { float wv = x[i][c]; if (q8s > 0.f) wv = q8r(wv, q8s); *(LAS bf16*)(scr + (nq + c) * 136 + k * 2) = (bf16)f2bf(wv); } }
    LDS_WAIT(); asm volatile("" ::: "memory");
    if (n0 + lane < N) { const LAS v2u* s = (const LAS v2u*)(scr + lane * 136); const int mr = map_row(kind, off, n0 + lane); bf16* dst = tiled ? WT + toff(mr, kd, ldt) : WT + (size_t)mr * ldt + kd;
#pragma unroll
        for (int q = 0; q < 8; ++q) { const v2u a = s[2 * q], b = s[2 * q + 1]; *(v4u*)(dst + 8 * q) = (v4u){a.x, a.y, b.x, b.y}; } }
    LDS_WAIT(); asm volatile("" ::: "memory");
}
__device__ __forceinline__ void conv(Frame& F, int& tb, const float* W, size_t sW, int nb, int ldw, int N, int ks0, int K, bf16* WT, size_t sWT, int ldt, int kd0, int kind, int off, float q8s = 0.f, int tiled = 0, const float* gk = nullptr) {
    LAS unsigned char* scr = F.lds + RING_OFF + F.wave * 16384;
    const int gw = F.vcu * NWAVES + F.wave, NGW = F.G * NWAVES;
    const int nblk = (N + 63) / 64, per = (K / 64) * nblk, total = per * nb;
    int first = gw - tb; if (first < 0) first += NGW;
    for (int it = first; it < total; it += NGW) { const int b = it / per, r = it % per, kb = r / nblk, nbk = r % nblk;
        tr_item(W + (size_t)b * sW, ldw, N, ks0 + 64 * kb, 64 * nbk, WT + (size_t)b * sWT, ldt, kd0 + 64 * kb, kind, off, scr, F.lane, q8s, tiled, gk); }
    tb = (tb + total) % NGW;
}
__device__ __forceinline__ void zero_block(Frame& F, bf16* WT, int ldt, int r0, int rows, int c0, int cols, int tiled = 0) {
    const int gt = (F.vcu * NWAVES + F.wave) * 64 + F.lane, NT = F.G * NWAVES * 64, cpr = cols / 8;
    for (int i = gt; i < rows * cpr; i += NT) { const int r = i / cpr, c = i % cpr; const unsigned z = (unsigned)F.zv; *(v4u*)(tiled ? WT + toff(r0 + r, c0 + 8 * c, ldt) : WT + (size_t)(r0 + r) * ldt + c0 + 8 * c) = (v4u){z, z, z, z}; }
}
__device__ __forceinline__ void p_convert(Frame& F, int layer) {
    const int j = layer >> 1; int tb = 0;
    conv(F, tb, F.in[2] + (size_t)layer * DM * CIN, 0, 1, CIN, CIN, 0, DM, WSP(bf16, WS_WIN), 0, DM, 0, 1, 0, 0.f, 0, F.in[1] + (size_t)layer * DM);
    zero_block(F, WSP(bf16, WS_WIN), DM, 1932, 116, 0, DM);
    conv(F, tb, F.in[9] + (size_t)layer * 3 * 256 * DM, (size_t)256 * DM, 3, DM, DM, 0, 256, WSP(bf16, WS_WBR), (size_t)DM * 256, 256, 0, 0, 0);
    conv(F, tb, F.in[10] + (size_t)layer * DM * DM, 0, 1, DM, DM, 0, DM, WSP(bf16, WS_WOUT), 0, DM, 0, 0, 0);
    conv(F, tb, F.in[7] + (size_t)layer * 2 * 2048 * 256, (size_t)2048 * 256, 2, 256, 256, 0, 1024, WSP(bf16, WS_WC1), (size_t)512 * 1024, 1024, 0, 0, 0);
    conv(F, tb, F.in[7] + (size_t)layer * 2 * 2048 * 256, (size_t)2048 * 256, 2, 256, 256, 1024, 1024, WSP(bf16, WS_WC1), (size_t)512 * 1024, 1024, 0, 0, 256);
    if ((layer & 1) == 0) {
        conv(F, tb, F.in[12] + (size_t)j * DM * DFF, 0, 1, DFF, DFF, 0, DM, WSP(bf16, WS_WF1), 0, DM, 0, 2, 0, Q8_W1, TILED_FFN1, F.in[11] + (size_t)layer * DM);
        conv(F, tb, F.in[13] + (size_t)j * DM * DFF, 0, 1, DFF, DFF, 0, DM, WSP(bf16, WS_WF1), 0, DM, 0, 2, 128, Q8_W1, TILED_FFN1, F.in[11] + (size_t)layer * DM);
        zero_block(F, WSP(bf16, WS_WF1), DM, 21 * 256 + 64, 64, 0, DM, TILED_FFN1);
        zero_block(F, WSP(bf16, WS_WF1), DM, 21 * 256 + 128 + 64, 64, 0, DM, TILED_FFN1);
        conv(F, tb, F.in[14] + (size_t)j * DFF * DM, 0, 1, DM, DM, 0, DFF, WSP(bf16, WS_WF2), 0, DFFP, 0, 0, 0, Q8_W2);
        zero_block(F, WSP(bf16, WS_WF2), DFFP, 0, DM, DFF, DFFP - DFF);
    } else {
        conv(F, tb, F.in[16] + (size_t)j * NEXP * DM * DFE, (size_t)DM * DFE, NEXP, DFE, DFE, 0, DM, WSP(bf16, WS_WF1), (size_t)NMOE1 * DM, DM, 0, 2, 0, Q8_W1, 0, F.in[11] + (size_t)layer * DM);
        conv(F, tb, F.in[17] + (size_t)j * NEXP * DM * DFE, (size_t)DM * DFE, NEXP, DFE, DFE, 0, DM, WSP(bf16, WS_WF1), (size_t)NMOE1 * DM, DM, 0, 2, 128, Q8_W1, 0, F.in[11] + (size_t)layer * DM);
        conv(F, tb, F.in[18] + (size_t)j * NEXP * DFE * DM, (size_t)DFE * DM, NEXP, DM, DM, 0, DFE, WSP(bf16, WS_WF2), (size_t)DM * DFE, DFE, 0, 0, 0, Q8_W2);
    }
    if (F.bx < 8) {
        __syncthreads();
        const int kv = F.bx >> 2, jj = (F.bx & 3) * 64 + F.lane;
        const float* pos = F.in[6] + (size_t)(layer * 2 + kv) * 2048; const float* w1 = F.in[7] + (size_t)(layer * 2 + kv) * 2048 * 256;
        float a = 0.f;
        float a1 = 0.f, a2 = 0.f, a3 = 0.f;
#pragma unroll 8
        for (int k = 0; k < 256; k += 4) { const int kk = F.wave * 256 + k;
            a += pos[kk] * w1[(size_t)kk * 256 + jj]; a1 += pos[kk + 1] * w1[(size_t)(kk + 1) * 256 + jj]; a2 += pos[kk + 2] * w1[(size_t)(kk + 2) * 256 + jj]; a3 += pos[kk + 3] * w1[(size_t)(kk + 3) * 256 + jj]; }
        a = (a + a1) + (a2 + a3);
        LAS float* red = (LAS float*)(F.lds + RING_OFF);
        red[F.wave * 64 + F.lane] = a;
        __syncthreads();
        if (F.wave == 0) { float s = 0.f;
#pragma unroll
            for (int w = 0; w < 8; ++w) s += red[w * 64 + F.lane];
            WSP(float, WS_BIAS1)[kv * 256 + jj] = s; }
        __syncthreads();
    }
    if (layer == 0) {
        const int gt = (F.vcu * NWAVES + F.wave) * 64 + F.lane, NT = F.G * NWAVES * 64;
        for (int idx = gt; idx < SEQ * 8; idx += NT) { const int pos = idx >> 3, i = idx & 7;
            const double invf = ROPE_INVF[i];
            double rev = (double)pos * invf * 0.15915494309189535; rev -= __builtin_floor(rev);
            WSP(float, WS_ROPE)[idx] = __builtin_amdgcn_cosf((float)rev); WSP(float, WS_ROPE)[SEQ * 8 + idx] = __builtin_amdgcn_sinf((float)rev); }
    }
}

template <bool S16> __device__ __forceinline__ f32x4 ld_row4(const void* src, size_t m, int lane, int jx) {
    if (S16) { const v2u t = ((const v2u*)((const bf16*)src + m * DM) + lane)[64 * jx]; return (f32x4){bflo(t.x), bfhi(t.x), bflo(t.y), bfhi(t.y)}; }
    return ((const f32x4*)((const float*)src + m * DM) + lane)[64 * jx];
}
template <int MODE, bool S16> __device__ __forceinline__ void p_norm(Frame& F, const void* src, const float* g, const float* rw, int jmoe, float q8s = 0.f, int tiled = 0) {
    const int gw = F.vcu * NWAVES + F.wave, NGW = F.G * NWAVES, lane = F.lane;
    LAS int* hist = (LAS int*)(F.lds + TAB_OFF) + 192;
    if (MODE == 1) {
        if (F.tid < 16) hist[F.tid] = 0;
        const int gt = gw * 64 + lane, NT = NGW * 64; int* tm = WSP(int, WS_TOKMAP);
        for (int i = gt; i < 4 * SLOTS; i += NT) tm[i] = -1;
        for (int i = F.tid; i < DM * NEXP / 4; i += NWAVES * 64) { const int c = i >> 1, hf = i & 1;
            *(LAS f32x4*)(F.lds + RING_OFF + (((((c >> 8) * 4 + (c & 3)) * 2 + hf) * 64 + ((c & 255) >> 2)) * 16)) = ((const f32x4*)rw)[i]; }
        if (F.tid < DM / 4) *(LAS f32x4*)(F.lds + RING_OFF + 32768 + 16 * F.tid) = ((const f32x4*)g)[F.tid];
        __syncthreads();
    }
    f32x4 gv[4];
    if (MODE != 1 && MODE != 3) {
#pragma unroll
        for (int jx = 0; jx < 4; ++jx) gv[jx] = ((const f32x4*)g)[lane + 64 * jx]; }
    constexpr int ROWS = (MODE == 1) ? 2 : 4;
    const int nit = (MODE == 1) ? ((MTOK / 128 - F.bx + F.G - 1) / F.G) * (16 / ROWS) : (MTOK - gw + ROWS * NGW - 1) / (ROWS * NGW);
    for (int itx = 0; itx < nit; ++itx) {
        const int chk = (MODE == 1) ? F.bx + (itx / (16 / ROWS)) * F.G : 0;
        const int m0 = (MODE == 1) ? chk * 128 + (itx % (16 / ROWS)) * (NWAVES * ROWS) + F.wave * ROWS : gw + itx * ROWS * NGW;
        const int mstep = (MODE == 1) ? 1 : NGW;
        f32x4 v[ROWS][4]; float ss[ROWS];
#pragma unroll
        for (int u = 0; u < ROWS; ++u) { const int m = m0 + u * mstep;
#pragma unroll
            for (int jx = 0; jx < 4; ++jx) v[u][jx] = ld_row4<S16>(src, (size_t)(m < MTOK ? m : m0), lane, jx); }
#pragma unroll
        for (int u = 0; u < ROWS; ++u) { float s = 0.f;
#pragma unroll
            for (int jx = 0; jx < 4; ++jx) s += (v[u][jx].x * v[u][jx].x + v[u][jx].y * v[u][jx].y) + (v[u][jx].z * v[u][jx].z + v[u][jx].w * v[u][jx].w);
            ss[u] = s; }
#pragma unroll
        for (int o = 1; o < 64; o <<= 1) {
#pragma unroll
            for (int u = 0; u < ROWS; ++u) ss[u] += __builtin_bit_cast(float, __builtin_amdgcn_ds_bpermute((lane ^ o) << 2, __builtin_bit_cast(int, ss[u]))); }
        float lgall[MODE == 1 ? ROWS : 1][8];
        if (MODE == 1) {
            float rs[ROWS];
#pragma unroll
            for (int u = 0; u < ROWS; ++u) { rs[u] = 1.0f / sqrtf(ss[u] * (1.f / DM) + EPS);
#pragma unroll
                for (int e = 0; e < 8; ++e) lgall[u][e] = 0.f; }
#pragma unroll
            for (int jx = 0; jx < 4; ++jx) { const f32x4 gl = *(const LAS f32x4*)(F.lds + RING_OFF + 32768 + 16 * (lane + 64 * jx));
#pragma unroll
                for (int u = 0; u < ROWS; ++u) v[u][jx] = v[u][jx] * rs[u] * gl; }
#pragma unroll
            for (int jx = 0; jx < 4; ++jx) { const LAS f32x4* wr = (const LAS f32x4*)(F.lds + RING_OFF + jx * 8192 + lane * 16);
#pragma unroll
                for (int r = 0; r < 4; ++r) { const f32x4 a = wr[128 * r], b = wr[128 * r + 64];
#pragma unroll
                    for (int u = 0; u < ROWS; ++u) { const float xv = v[u][jx][r];
                        lgall[u][0] += xv * a.x; lgall[u][1] += xv * a.y; lgall[u][2] += xv * a.z; lgall[u][3] += xv * a.w; lgall[u][4] += xv * b.x; lgall[u][5] += xv * b.y; lgall[u][6] += xv * b.z; lgall[u][7] += xv * b.w; } } }
        }
#pragma unroll
        for (int u = 0; u < ROWS; ++u) { const int m = m0 + u * mstep; if (m >= MTOK) continue;
            const float rstd = 1.0f / sqrtf(ss[u] * (1.f / DM) + EPS);
            if (MODE == 3 || MODE == 1) { if (lane == 0) WSP(float, WS_RSTD)[m] = rstd; }
            if (MODE == 3) {
                if (!S16) {
                    unsigned long long* o8 = (unsigned long long*)(WSP(bf16, WS_HN) + (size_t)m * DM) + lane;
#pragma unroll
                    for (int jx = 0; jx < 4; ++jx) { const f32x4 w = v[u][jx]; o8[64 * jx] = (unsigned long long)pk2(w.x, w.y) | ((unsigned long long)pk2(w.z, w.w) << 32); } }
                continue; }
            if (MODE != 1) {
#pragma unroll
            for (int jx = 0; jx < 4; ++jx) v[u][jx] = v[u][jx] * rstd * gv[jx]; }
            if (MODE == 2) {
                f32x4* o = (f32x4*)(F.out + (size_t)m * DM) + lane;
#pragma unroll
                for (int jx = 0; jx < 4; ++jx) o[64 * jx] = v[u][jx];
            } else if (MODE != 1) {
                unsigned long long* o8 = (unsigned long long*)(WSP(bf16, WS_HN) + (size_t)m * DM) + lane;
#pragma unroll
                for (int jx = 0; jx < 4; ++jx) { f32x4 w = v[u][jx];
                    if (tiled) { *(unsigned long long*)(WSP(bf16, WS_HN) + toff(m, 4 * lane + 256 * jx, DM)) = (unsigned long long)pk2(w.x, w.y) | ((unsigned long long)pk2(w.z, w.w) << 32); continue; } if (q8s > 0.f) { w.x = q8r(w.x, q8s); w.y = q8r(w.y, q8s); w.z = q8r(w.z, q8s); w.w = q8r(w.w, q8s); }
                    o8[64 * jx] = (unsigned long long)pk2(w.x, w.y) | ((unsigned long long)pk2(w.z, w.w) << 32); }
            }
            if (MODE == 1) {
                float lg[8];
#pragma unroll
                for (int e = 0; e < 8; ++e) lg[e] = lgall[u][e];
                float h4[4], h2[2], h1;
                { const bool up = lane & 1;
#pragma unroll
                  for (int i = 0; i < 4; ++i) { const float keep = up ? lg[4 + i] : lg[i], send = up ? lg[i] : lg[4 + i]; h4[i] = keep + __builtin_bit_cast(float, bperm(lane ^ 1, __builtin_bit_cast(int, send))); } }
                { const bool up = lane & 2;
#pragma unroll
                  for (int i = 0; i < 2; ++i) { const float keep = up ? h4[2 + i] : h4[i], send = up ? h4[i] : h4[2 + i]; h2[i] = keep + __builtin_bit_cast(float, bperm(lane ^ 2, __builtin_bit_cast(int, send))); } }
                { const bool up = lane & 4; const float keep = up ? h2[1] : h2[0], send = up ? h2[0] : h2[1]; h1 = keep + __builtin_bit_cast(float, bperm(lane ^ 4, __builtin_bit_cast(int, send))); }
                h1 += __builtin_bit_cast(float, bperm(lane ^ 8, __builtin_bit_cast(int, h1))); h1 += __builtin_bit_cast(float, bperm(lane ^ 16, __builtin_bit_cast(int, h1))); h1 += __builtin_bit_cast(float, bperm(lane ^ 32, __builtin_bit_cast(int, h1)));
                lg[0] = rdlane(h1, 0); lg[1] = rdlane(h1, 4); lg[2] = rdlane(h1, 2); lg[3] = rdlane(h1, 6); lg[4] = rdlane(h1, 1); lg[5] = rdlane(h1, 5); lg[6] = rdlane(h1, 3); lg[7] = rdlane(h1, 7);
                int e0 = 0; float v0 = lg[0];
#pragma unroll
                for (int e = 1; e < 8; ++e) if (lg[e] > v0) { v0 = lg[e]; e0 = e; }
                int e1 = -1; float v1 = -INFINITY;
#pragma unroll
                for (int e = 0; e < 8; ++e) if (e != e0 && lg[e] > v1) { v1 = lg[e]; e1 = e; }
                const float w0 = 1.0f / (1.0f + fexp(v1 - v0)), w1 = 1.0f - w0;
                if (lane == 0) { WSP(v4i, WS_ROUTE)[m] = (v4i){e0, e1, __builtin_bit_cast(int, w0), __builtin_bit_cast(int, w1)};
                    __hip_atomic_fetch_add(&hist[e0], 1, __ATOMIC_RELAXED, __HIP_MEMORY_SCOPE_WORKGROUP); __hip_atomic_fetch_add(&hist[8 + e1], 1, __ATOMIC_RELAXED, __HIP_MEMORY_SCOPE_WORKGROUP); }
            }
        }
        if (MODE == 1 && (itx % (16 / ROWS)) == 16 / ROWS - 1) {
            __syncthreads();
            if (F.tid < 16) { WSP(int, WS_CNT128)[(size_t)chk * 16 + F.tid] = hist[F.tid]; hist[F.tid] = 0; }
            __syncthreads();
        }
    }
}

__device__ __forceinline__ float dpp_row_sum(float v) {
    v += __builtin_bit_cast(float, __builtin_amdgcn_update_dpp(0, __builtin_bit_cast(int, v), 0xB1, 0xf, 0xf, false));
    v += __builtin_bit_cast(float, __builtin_amdgcn_update_dpp(0, __builtin_bit_cast(int, v), 0x4E, 0xf, 0xf, false));
    v += __builtin_bit_cast(float, __builtin_amdgcn_update_dpp(0, __builtin_bit_cast(int, v), 0x141, 0xf, 0xf, false));
    v += __builtin_bit_cast(float, __builtin_amdgcn_update_dpp(0, __builtin_bit_cast(int, v), 0x140, 0xf, 0xf, false));
    return v;
}
__device__ __forceinline__ void p_rstd(Frame& F) {
    const int gw = F.vcu * NWAVES + F.wave, NGW = F.G * NWAVES, lane = F.lane;
    const bf16* H = WSP(bf16, WS_H); float* rs = WSP(float, WS_RSTD);
    for (int m0 = gw * 8; m0 < MTOK; m0 += NGW * 8) {
        v4u x[8][2];
#pragma unroll
        for (int u = 0; u < 8; ++u) { const v4u* xr = (const v4u*)(H + (size_t)(m0 + u) * DM) + lane; x[u][0] = xr[0]; x[u][1] = xr[64]; }
        float ss[8];
#pragma unroll
        for (int u = 0; u < 8; ++u) { float s = 0.f;
#pragma unroll
            for (int h = 0; h < 2; ++h) { const v4u w = x[u][h];
                const float a0 = bflo(w.x), a1 = bfhi(w.x), a2 = bflo(w.y), a3 = bfhi(w.y), a4 = bflo(w.z), a5 = bfhi(w.z), a6 = bflo(w.w), a7 = bfhi(w.w);
                s += ((a0 * a0 + a1 * a1) + (a2 * a2 + a3 * a3)) + ((a4 * a4 + a5 * a5) + (a6 * a6 + a7 * a7)); }
            ss[u] = dpp_row_sum(s); }
        float myr = 0.f;
#pragma unroll
        for (int u = 0; u < 8; ++u) { const float t = (rdlane(ss[u], 0) + rdlane(ss[u], 16)) + (rdlane(ss[u], 32) + rdlane(ss[u], 48)); if (lane == u) myr = t; }
        if (lane < 8) rs[m0 + lane] = 1.0f / sqrtf(myr * (1.f / DM) + EPS);
    }
}
__device__ __forceinline__ void p_prep(Frame& F) {
    const int gw = F.vcu * NWAVES + F.wave, NGW = F.G * NWAVES, lane = F.lane;
    bf16* P1 = WSP(bf16, WS_P1); bf16* KVC = WSP(bf16, WS_KVC); const float* rope = WSP(float, WS_ROPE);
    const int vec = lane >> 3, ri = lane & 7; const int cb = vec < 4 ? C_CQ + vec * 64 : (vec == 4 ? C_KCMP : (vec == 5 ? C_KSLC : C_KWIN));
    for (int row0 = gw; row0 < MC; row0 += 4 * NGW) {
        float x1[4], x2[4], cc[4], ss[4]; bf16 kc48[4], vc64[4];
#pragma unroll
        for (int k = 0; k < 4; ++k) { const int row = row0 + k * NGW < MC ? row0 + k * NGW : row0; const bf16* p = P1 + (size_t)row * P1W; const int pos = row & (SEQ - 1);
            const int cl = lane < 56 ? cb + ri : C_CQ;
            x1[k] = bf1(p[cl]); x2[k] = bf1(p[cl + 8]); cc[k] = rope[pos * 8 + ri]; ss[k] = rope[SEQ * 8 + pos * 8 + ri];
            if (F.rep) { cc[k] = 1.f; ss[k] = 0.f; }
            kc48[k] = p[C_KCMP + 16 + (lane < 48 ? lane : 0)]; vc64[k] = p[C_VCMP + lane]; }
#pragma unroll
        for (int k = 0; k < 4; ++k) { const int row = row0 + k * NGW; if (row >= MC) continue; bf16* p = P1 + (size_t)row * P1W;
            if (lane < 56) { const bf16 o1 = (bf16)f2bf(x1[k] * cc[k] - x2[k] * ss[k]), o2 = (bf16)f2bf(x2[k] * cc[k] + x1[k] * ss[k]);
                p[cb + ri] = o1; p[cb + ri + 8] = o2;
                if (vec == 4) { KVC[(size_t)row * 64 + ri] = o1; KVC[(size_t)row * 64 + ri + 8] = o2; } }
            if (lane < 48) KVC[(size_t)row * 64 + 16 + lane] = kc48[k];
            KVC[(size_t)MC * 64 + (size_t)row * 64 + lane] = vc64[k]; }
    }
    bf16* VT = WSP(bf16, WS_VT);
    for (int it = gw; it < 6 * BC * 64; it += NGW) { const int which = it / (BC * 64), r = it % (BC * 64), b = r >> 6, blk = r & 63;
        const v4u* src = (const v4u*)(P1 + ((size_t)b * SEQ + blk * 64 + lane) * P1W + (which == 0 ? C_VSLC : (which == 1 ? C_VWIN : C_SBV + (which - 2) * 64)));
        bf16* dst = VT + ((size_t)(which * BC + b) * 64) * SEQ + blk * 64 + lane;
        v4u xs[8];
#pragma unroll
        for (int i = 0; i < 8; ++i) xs[i] = src[i];
#pragma unroll
        for (int i = 0; i < 8; ++i) { const v4u x = xs[i];
            dst[(size_t)(8 * i + 0) * SEQ] = (bf16)(x.x & 0xffffu); dst[(size_t)(8 * i + 1) * SEQ] = (bf16)(x.x >> 16);
            dst[(size_t)(8 * i + 2) * SEQ] = (bf16)(x.y & 0xffffu); dst[(size_t)(8 * i + 3) * SEQ] = (bf16)(x.y >> 16);
            dst[(size_t)(8 * i + 4) * SEQ] = (bf16)(x.z & 0xffffu); dst[(size_t)(8 * i + 5) * SEQ] = (bf16)(x.z >> 16);
            dst[(size_t)(8 * i + 6) * SEQ] = (bf16)(x.w & 0xffffu); dst[(size_t)(8 * i + 7) * SEQ] = (bf16)(x.w >> 16); }
    }
}
__device__ __forceinline__ void p_sgu(Frame& F, int layer) {
    LAS float* vn = (LAS float*)(F.lds + RING_OFF);
    const bf16* P1 = WSP(bf16, WS_P1); bf16* Ya = WSP(bf16, WS_Y);
    const float* gain = F.in[3] + (size_t)layer * 256; const float* sw = F.in[4] + (size_t)layer * 4 * 128 * 128; const float* sb = F.in[5] + (size_t)layer * 4 * 128;
    const int lane = F.lane, wave = F.wave;
    for (int item = F.vcu; item < MC / 128; item += F.G) {
        const size_t r0 = (size_t)item * 128;
        __syncthreads();
        for (int rr = 0; rr < 16; ++rr) { const int r = wave * 16 + rr; const v2u raw = *(const v2u*)(P1 + (r0 + r) * P1W + C_V + 4 * lane);
            const float a = bflo(raw.x), b = bfhi(raw.x), c = bflo(raw.y), d = bfhi(raw.y);
            const float rstd = 1.0f / sqrtf(wave_sum((a * a + b * b) + (c * c + d * d), lane) * (1.f / 256.f) + EPS);
            const f32x4 gg = ((const f32x4*)gain)[lane];
            *(LAS f32x4*)(vn + r * 256 + 4 * lane) = (f32x4){a * rstd * gg.x, b * rstd * gg.y, c * rstd * gg.z, d * rstd * gg.w}; }
        __syncthreads();
        const int g = wave & 3, half = wave >> 2;
        for (int i = 0; i < 64; ++i) { const int t = 2 * i + half;
            const float* wrow = sw + ((size_t)g * 128 + t) * 128;
            const float w_lo = wrow[lane], w_hi = wrow[64 + lane];
            float acc = 0.f;
            for (int s = 0; s <= t; ++s) { const float w = (s < 64) ? rdlane(w_lo, s) : rdlane(w_hi, s - 64); acc += w * vn[s * 256 + g * 64 + lane]; }
            const float u = bf1(P1[(r0 + t) * P1W + C_U + g * 64 + lane]);
#ifdef ABL_SGUMIX
            acc = 0.f;
#endif
            Ya[(r0 + t) * 256 + g * 64 + lane] = (bf16)f2bf(u * (acc + sb[g * 128 + t])); }
    }
    __syncthreads();
}

__device__ __forceinline__ void p_cmpfin(Frame& F, int layer) {
    const int gw = F.vcu * NWAVES + F.wave, NGW = F.G * NWAVES, lane = F.lane;
    const float* UL = WSP(float, WS_UL); const float* bias = WSP(float, WS_BIAS1); bf16* KC = WSP(bf16, WS_KC);
    LAS float* w2l = (LAS float*)(F.lds + RING_OFF);
    __syncthreads();
    { const f32x4* src = (const f32x4*)(F.in[8] + (size_t)layer * 2 * 256 * 64);
#pragma unroll 4
      for (int i = F.tid; i < 2 * 256 * 64 / 4; i += NWAVES * 64) *(LAS f32x4*)(w2l + 4 * i) = src[i]; }
    __syncthreads();
    for (int it = gw; it < 2 * BC * 255; it += NGW) { const int kv = it / (BC * 255), r = it % (BC * 255), b = r / 255, m = r % 255;
        const LAS float* w2 = w2l + kv * 256 * 64;
        const float* U = UL + (size_t)(kv * 2048 + b * 256 + m) * 512; const float* L = U + 512 + 256;
        float hv[4];
#pragma unroll
        for (int q = 0; q < 4; ++q) hv[q] = pg8::gelu_tanh(U[64 * q + lane] + L[64 * q + lane] + bias[kv * 256 + 64 * q + lane]);
        float acc0 = 0.f, acc1 = 0.f;
#pragma unroll
        for (int q = 0; q < 4; ++q)
#pragma unroll 8
            for (int jj = 0; jj < 64; jj += 2) { acc0 += rdlane(hv[q], jj) * w2[(64 * q + jj) * 64 + lane]; acc1 += rdlane(hv[q], jj + 1) * w2[(64 * q + jj + 1) * 64 + lane]; }
        const float acc = acc0 + acc1;
        KC[((size_t)(kv * BC + b) * 256 + m) * 64 + lane] = (bf16)f2bf(acc);
        if (kv == 1) { WSP(bf16, WS_KCT)[((size_t)b * 64 + lane) * 256 + m] = (bf16)f2bf(acc); if (m == 254) WSP(bf16, WS_KCT)[((size_t)b * 64 + lane) * 256 + 255] = (bf16)0; }
        else if (m == 254) KC[((size_t)b * 256 + 255) * 64 + lane] = (bf16)0; }
    __syncthreads();
}

__device__ __forceinline__ void p_stick(Frame& F) {
    const int gw = F.vcu * NWAVES + F.wave, NGW = F.G * NWAVES, lane = F.lane;
    const bf16* P1 = WSP(bf16, WS_P1); bf16* Yb = WSP(bf16, WS_Y) + (size_t)MC * 256;
    for (int item = gw; item < BC * 4 * 64; item += NGW) { const int tb = item & 63, h = (item >> 6) & 3, b = item >> 8;
        const int t = tb * 64 + lane; const size_t row = (size_t)b * SEQ + t;
        unsigned q[32];
        { const v4u* qp = (const v4u*)(P1 + row * P1W + C_SBQ + h * 64);
#pragma unroll
          for (int i = 0; i < 8; ++i) { const v4u x = qp[i]; q[4 * i] = x.x; q[4 * i + 1] = x.y; q[4 * i + 2] = x.z; q[4 * i + 3] = x.w; } }
        float o[64];
#pragma unroll
        for (int d = 0; d < 64; ++d) o[d] = 0.f;
        float R = 0.f;
        const bf16* kb = P1 + (size_t)b * SEQ * P1W + C_SBK + h * 64; const bf16* vb = P1 + (size_t)b * SEQ * P1W + C_SBV + h * 64;
        for (int s = t - 1; s >= 0; --s) {
            if (R < -100.f) break;
            const v4u* kp = (const v4u*)(kb + (size_t)s * P1W); const v4u* vp = (const v4u*)(vb + (size_t)s * P1W);
            float z0 = 0.f, z1 = 0.f;
#pragma unroll
            for (int i = 0; i < 8; ++i) { const v4u k = kp[i]; z0 = dot2bf(k.x, q[4 * i], z0); z1 = dot2bf(k.y, q[4 * i + 1], z1); z0 = dot2bf(k.z, q[4 * i + 2], z0); z1 = dot2bf(k.w, q[4 * i + 3], z1); }
            const float z = (z0 + z1) * 0.125f;
            const float tt = 0.6931471805599453f * __builtin_amdgcn_logf(1.0f + fexp(-__builtin_fabsf(z)));
            const float lb = fminf(z, 0.f) - tt, l1m = fminf(-z, 0.f) - tt;
            const float a = fexp(lb + R); R += l1m;
#pragma unroll
            for (int i = 0; i < 8; ++i) { const v4u v = vp[i];
                o[8 * i] += a * bflo(v.x); o[8 * i + 1] += a * bfhi(v.x); o[8 * i + 2] += a * bflo(v.y); o[8 * i + 3] += a * bfhi(v.y);
                o[8 * i + 4] += a * bflo(v.z); o[8 * i + 5] += a * bfhi(v.z); o[8 * i + 6] += a * bflo(v.w); o[8 * i + 7] += a * bfhi(v.w); }
        }
        v4u* op = (v4u*)(Yb + row * 256 + h * 64);
#pragma unroll
        for (int i = 0; i < 8; ++i) op[i] = (v4u){pk2(o[8 * i], o[8 * i + 1]), pk2(o[8 * i + 2], o[8 * i + 3]), pk2(o[8 * i + 4], o[8 * i + 5]), pk2(o[8 * i + 6], o[8 * i + 7])};
    }
}

struct Soft { float mx, l; };
__device__ __forceinline__ float dotq(const LAS v4u* ql, const bf16* kp_) {
    const v4u* kp = (const v4u*)kp_; float z0 = 0.f, z1 = 0.f;
#pragma unroll
    for (int i = 0; i < 8; ++i) { const v4u k = kp[i]; const v4u q = ql[i]; z0 = dot2bf(k.x, q.x, z0); z1 = dot2bf(k.y, q.y, z1); z0 = dot2bf(k.z, q.z, z0); z1 = dot2bf(k.w, q.w, z1); }
    return (z0 + z1) * 0.125f;
}
__device__ __forceinline__ void axpy_row(float p, const bf16* vp_, float (&o)[64]) {
    const v4u* vp = (const v4u*)vp_;
#pragma unroll
    for (int i = 0; i < 8; ++i) { const v4u v = vp[i];
        o[8 * i] += p * bflo(v.x); o[8 * i + 1] += p * bfhi(v.x); o[8 * i + 2] += p * bflo(v.y); o[8 * i + 3] += p * bfhi(v.y);
        o[8 * i + 4] += p * bflo(v.z); o[8 * i + 5] += p * bfhi(v.z); o[8 * i + 6] += p * bflo(v.w); o[8 * i + 7] += p * bfhi(v.w); }
}
__device__ __forceinline__ void nsa_step(const LAS v4u* ql, const bf16* kp_, const bf16* vp_, Soft& S, float (&o)[64]) {
    const float s = dotq(ql, kp_);
    if (s > S.mx) { const float sc = fexp(S.mx - s); S.l *= sc;
#pragma unroll
        for (int d = 0; d < 64; ++d) o[d] *= sc;
        S.mx = s; }
    const float p = fexp(s - S.mx); S.l += p;
    asm volatile("" ::: "memory");
    axpy_row(p, vp_, o);
}
__device__ __forceinline__ void nsa_accum(bf16* yrow, bool first, float sc, const float (&o)[64]) {
    v4u* op = (v4u*)yrow;
#pragma unroll
    for (int i = 0; i < 8; ++i) { v4u old = (v4u){0u, 0u, 0u, 0u}; if (!first) old = op[i];
        op[i] = (v4u){pk2(bflo(old.x) + sc * o[8 * i], bfhi(old.x) + sc * o[8 * i + 1]), pk2(bflo(old.y) + sc * o[8 * i + 2], bfhi(old.y) + sc * o[8 * i + 3]),
                      pk2(bflo(old.z) + sc * o[8 * i + 4], bfhi(old.z) + sc * o[8 * i + 5]), pk2(bflo(old.w) + sc * o[8 * i + 6], bfhi(old.w) + sc * o[8 * i + 7])}; }
}
__device__ __forceinline__ void p_nsa(Frame& F) {
    const int gw = F.vcu * NWAVES + F.wave, NGW = F.G * NWAVES, lane = F.lane;
    const bf16* P1 = WSP(bf16, WS_P1); const bf16* KC = WSP(bf16, WS_KC); bf16* Yc = WSP(bf16, WS_Y) + (size_t)2 * MC * 256;
    LAS float* imp = (LAS float*)(F.lds + RING_OFF + F.wave * 4096);
    LAS v4u* ql = (LAS v4u*)(F.lds + RING_OFF + 32768 + F.wave * 9216 + lane * 144);
    const int qi = lane >> 2, h = lane & 3;
    for (int item = gw; item < BC * 256; item += NGW) { const int b = item >> 8, tg = item & 255;
        const int t = tg * 16 + qi; const size_t row = (size_t)b * SEQ + t; const bf16* prow = P1 + row * P1W;
        { const v4u* qp = (const v4u*)(prow + C_CQ + h * 64);
#pragma unroll
          for (int i = 0; i < 8; ++i) ql[i] = qp[i]; }
        const float g0 = bf1(prow[C_CG + h * 3]), g1 = bf1(prow[C_CG + h * 3 + 1]), g2 = bf1(prow[C_CG + h * 3 + 2]);
        bf16* yrow = Yc + row * 256 + h * 64;
        float o[64];
        for (int i = lane; i < 1024; i += 64) imp[i] = 0.f;
        const int nv = t >= 31 ? ((t - 31) >> 4) + 1 : 0; const int nvmax = (tg * 16 + 15 >= 31) ? ((tg * 16 + 15 - 31) >> 4) + 1 : 0;
        const bf16* kc = KC + (size_t)(0 * BC + b) * 256 * 64; const bf16* vc = KC + (size_t)(1 * BC + b) * 256 * 64;
        { float mx = -INFINITY, l = 0.f;
          for (int m = 0; m < nvmax; ++m) { const float s = dotq(ql, kc + m * 64); if (m < nv) { if (s > mx) { l *= fexp(mx - s); mx = s; } l += fexp(s - mx); } }
          const float rl = l > 0.f ? 1.0f / l : 0.f;
#pragma unroll
          for (int d = 0; d < 64; ++d) o[d] = 0.f;
          for (int m = 0; m < nvmax; ++m) { const float s = dotq(ql, kc + m * 64); const float p = (m < nv) ? fexp(s - mx) * rl : 0.f;
              asm volatile("" ::: "memory");
              axpy_row(p, vc + m * 64, o);
              float P = p + __builtin_bit_cast(float, bperm(lane ^ 1, __builtin_bit_cast(int, p))); P += __builtin_bit_cast(float, bperm(lane ^ 2, __builtin_bit_cast(int, P)));
              if (h == 0) { const int j0 = m >> 2; const bool edge = (m & 3) == 3; imp[qi * 64 + j0] += edge ? 0.5f * P : P; if (edge) imp[qi * 64 + j0 + 1] += 0.5f * P; } }
          nsa_accum(yrow, true, g0, o); }
        unsigned long long mask = 0ull;
        { const int cur = t >> 6, nvb = cur + 1;
          if (h == 0) {
              if (nvb <= 16) mask = (1ull << nvb) - 1ull;
              else { mask = 1ull | (1ull << cur);
                  for (int r = 0; r < 14; ++r) { int best = -1; float bv = -1.f;
                      for (int j = 1; j < cur; ++j) { const float v = imp[qi * 64 + j]; if (!((mask >> j) & 1ull) && v > bv) { bv = v; best = j; } }
                      mask |= 1ull << best; } } }
          const unsigned mlo = (unsigned)bperm(lane & ~3, (int)(unsigned)mask), mhi = (unsigned)bperm(lane & ~3, (int)(unsigned)(mask >> 32));
          mask = ((unsigned long long)mhi << 32) | mlo; }
        { Soft S{-INFINITY, 0.f};
#pragma unroll
          for (int d = 0; d < 64; ++d) o[d] = 0.f;
          const bf16* kb = P1 + (size_t)b * SEQ * P1W + C_KSLC; const bf16* vb = P1 + (size_t)b * SEQ * P1W + C_VSLC;
          unsigned long long mm = mask;
          while (mm) { const int j = __builtin_ctzll(mm); mm &= mm - 1ull;
              for (int kk = 0; kk < 64; ++kk) { const int sp = j * 64 + kk; if (sp > t) break; nsa_step(ql, kb + (size_t)sp * P1W, vb + (size_t)sp * P1W, S, o); } }
          nsa_accum(yrow, false, g1 / S.l, o); }
        { Soft S{-INFINITY, 0.f};
#pragma unroll
          for (int d = 0; d < 64; ++d) o[d] = 0.f;
          const bf16* kb = P1 + (size_t)b * SEQ * P1W + C_KWIN; const bf16* vb = P1 + (size_t)b * SEQ * P1W + C_VWIN;
          for (int i = 0; i < 512; ++i) { const int sp = t - 511 + i; if (sp >= 0) nsa_step(ql, kb + (size_t)sp * P1W, vb + (size_t)sp * P1W, S, o); }
          nsa_accum(yrow, false, g2 / S.l, o); }
    }
}

__device__ __forceinline__ int moe_table(Frame& F, int jmoe, int c, int r, int kpre = 0) {
    LAS int* tab = (LAS int*)(F.lds + TAB_OFF); LAS int* arr = (LAS int*)(F.lds + LDSCTL_OFF + 4096);
    (void)jmoe;
    __syncthreads();
    if (F.tid < 256) { const v4i* s = (const v4i*)(WSP(int, WS_CNT128) + ((size_t)(c * 256 + F.tid) * 2 + r) * 8); const v4i a = s[0], b = s[1];
        *(LAS v4i*)(arr + F.tid * 8) = a; *(LAS v4i*)(arr + F.tid * 8 + 4) = b; }
    __syncthreads();
    if (F.tid < 8) { int tot = 0, pre = 0;
        for (int k = 0; k < 256; ++k) { const int x = arr[k * 8 + F.tid]; pre += (k < kpre) ? x : 0; tot += x; }
        tab[176 + F.tid] = tot; tab[184 + F.tid] = pre; }
    __syncthreads();
    if (F.tid == 0) { int base = 0, T = 0;
        for (int e = 0; e < 8; ++e) { const int cnt = tab[176 + e];
            const int nt = (cnt + 255) >> 8; tab[160 + e] = base; for (int i = 0; i < nt && T + i < 160; ++i) tab[T + i] = e; T += nt; base += nt * 256; }
        tab[168] = T < 136 ? T : 136; }
    __syncthreads();
    return tab[168];
}
__device__ __forceinline__ void p_gather(Frame& F, int jmoe, int c, int r, int nbusy = 0) {
    if (F.bx < nbusy) return;
    LAS int* tab = (LAS int*)(F.lds + TAB_OFF); LAS int* cntw = tab + 256; LAS int* basew = tab + 320;
    const int lane = F.lane, wave = F.wave;
    const v4i* route = WSP(v4i, WS_ROUTE); int* tokmap = WSP(int, WS_TOKMAP) + (c * 2 + r) * SLOTS; float* wslot = WSP(float, WS_WSLOT) + (c * 2 + r) * SLOTS; float* rslot = WSP(float, WS_RSLOT) + (c * 2 + r) * SLOTS;
    for (int ch = F.bx - nbusy; ch < MC / 128; ch += F.G - nbusy) {
        moe_table(F, jmoe, c, r, ch);
        const int m = c * MC + ch * 128 + wave * 16 + (lane & 15); const v4i rt = route[m];
        const int e = lane < 16 ? (r ? rt.y : rt.x) : -1; const float w = __builtin_bit_cast(float, r ? rt.w : rt.z);
        unsigned long long bal[8]; int mycnt = 0;
#pragma unroll
        for (int ee = 0; ee < 8; ++ee) { bal[ee] = __builtin_amdgcn_ballot_w64(e == ee); if (lane == ee) mycnt = __builtin_popcountll(bal[ee]); }
        if (lane < 8) cntw[wave * 8 + lane] = mycnt;
        __syncthreads();
        if (wave == 0 && lane < 8) { int base = tab[184 + lane];
#pragma unroll
            for (int w8 = 0; w8 < 8; ++w8) { basew[w8 * 8 + lane] = base; base += cntw[w8 * 8 + lane]; } }
        __syncthreads();
        int pos = 0;
#pragma unroll
        for (int ee = 0; ee < 8; ++ee) if (e == ee) pos = basew[wave * 8 + ee] + __builtin_popcountll(bal[ee] & ((1ull << lane) - 1ull));
        int slot = 0;
        if (lane < 16) { slot = tab[160 + e] + pos; tokmap[slot] = m; wslot[slot] = w; rslot[slot] = WSP(float, WS_RSTD)[m]; }
    }
}

typedef float f32x16 __attribute__((ext_vector_type(16)));
typedef short bf16x8v __attribute__((ext_vector_type(8)));
typedef float f32x2v __attribute__((ext_vector_type(2)));
constexpr int NSA_K = 0, NSA_V = 8192, NSA_BUF = 17408, NSA_STAGE = 2 * NSA_BUF, NSA_IMP = 69632, NSA_CARRY = 86016, NSA_SEL = 103424, NSA_WSF = 103936;
constexpr int NSA_VP = 136;
constexpr float NSA_C2 = 0.125f * 1.4426950408889634f;
constexpr float NSA_DEFER = 8.0f / (0.125f * 1.4426950408889634f);
__device__ __forceinline__ unsigned cvtpk(float lo, float hi) { f32x2v v = {lo, hi}; bf16x2_t b = __builtin_convertvector(v, bf16x2_t); return __builtin_bit_cast(unsigned, b); }
__device__ __forceinline__ float partner32(float v, int lane) { return __builtin_bit_cast(float, __builtin_amdgcn_ds_bpermute((lane ^ 32) << 2, __builtin_bit_cast(int, v))); }
__device__ __forceinline__ void nsa_load(v4u& kx, v4u& vx, const bf16* Kg, int kp, const bf16* Vg, int vp, int tid) {
    kx = *(const v4u*)(Kg + (size_t)(tid & 63) * kp + (tid >> 6) * 8); vx = *(const v4u*)(Vg + (size_t)(tid >> 3) * vp + (tid & 7) * 8);
}
__device__ __forceinline__ void nsa_store(LAS unsigned char* lds, const v4u& kx, const v4u& vx, int tid) {
    *(LAS v4u*)(lds + NSA_K + (tid >> 6) * 1024 + (tid & 63) * 16) = kx; { LAS v2u* vd = (LAS v2u*)(lds + NSA_V + (tid >> 3) * NSA_VP + (tid & 7) * 16); vd[0] = (v2u){vx.x, vx.y}; vd[1] = (v2u){vx.z, vx.w}; }
}
__device__ __forceinline__ void nsa_qk(const LAS unsigned char* lds, const bf16x8v (&qr)[4], f32x16& p0, f32x16& p1, int r32, int hi) {
    bf16x8v kf[8];
#pragma unroll
    for (int d0 = 0; d0 < 4; ++d0) {
        kf[2 * d0] = *(const LAS bf16x8v*)(lds + NSA_K + (2 * d0 + hi) * 1024 + r32 * 16);
        kf[2 * d0 + 1] = *(const LAS bf16x8v*)(lds + NSA_K + (2 * d0 + hi) * 1024 + 512 + r32 * 16); }
    __builtin_amdgcn_sched_barrier(0);
#pragma unroll
    for (int i = 0; i < 16; ++i) { p0[i] = 0.f; p1[i] = 0.f; }
#pragma unroll
    for (int d0 = 0; d0 < 4; ++d0) {
        p0 = __builtin_amdgcn_mfma_f32_32x32x16_bf16(kf[2 * d0], qr[d0], p0, 0, 0, 0);
        p1 = __builtin_amdgcn_mfma_f32_32x32x16_bf16(kf[2 * d0 + 1], qr[d0], p1, 0, 0, 0);
    }
}
__device__ __forceinline__ void nsa_mask(f32x16& p0, f32x16& p1, int hi, int hiL, int loL) {
    const int hl = hiL - 4 * hi, ll = loL - 4 * hi;
#pragma unroll
    for (int i = 0; i < 16; ++i) { const int c = (i & 3) + 8 * (i >> 2);
        if (!(c <= hl && c > ll)) p0[i] = -INFINITY;
        if (!(c + 32 <= hl && c + 32 > ll)) p1[i] = -INFINITY; }
}
__device__ __forceinline__ float nsa_max32(const f32x16& p0, const f32x16& p1) {
    float a = fmaxf(fmaxf(p0[0], p0[1]), p1[0]), b = fmaxf(fmaxf(p0[2], p0[3]), p1[1]); a = fmaxf(fmaxf(a, p1[2]), p1[3]);
#pragma unroll
    for (int i = 4; i < 16; i += 4) { a = fmaxf(fmaxf(a, p0[i]), p0[i + 1]); b = fmaxf(fmaxf(b, p0[i + 2]), p0[i + 3]); a = fmaxf(fmaxf(a, p1[i]), p1[i + 1]); b = fmaxf(fmaxf(b, p1[i + 2]), p1[i + 3]); }
    return fmaxf(a, b);
}
__device__ __forceinline__ void nsa_vload(const LAS unsigned char* lds, v4u (&vv)[8], int r32, int hi) {
#pragma unroll
    for (int db = 0; db < 2; ++db) { const LAS unsigned char* vrow = lds + NSA_V + (32 * db + r32) * NSA_VP;
#pragma unroll
        for (int ks = 0; ks < 4; ++ks) {
            const int kb = (ks >> 1) * 32 + (ks & 1) * 16 + 4 * hi;
            const v2u lo = *(const LAS v2u*)(vrow + kb * 2), hh = *(const LAS v2u*)(vrow + (kb + 8) * 2);
            vv[4 * db + ks] = (v4u){lo.x, lo.y, hh.x, hh.y}; } }
    __builtin_amdgcn_sched_barrier(0);
}
__device__ __forceinline__ void nsa_pv(const v4u (&vv)[8], const f32x16& p0, const f32x16& p1, f32x16 (&o)[2]) {
    bf16x8v pa[4];
#pragma unroll
    for (int s = 0; s < 2; ++s) {
        const v4u a = (v4u){cvtpk(p0[8 * s], p0[8 * s + 1]), cvtpk(p0[8 * s + 2], p0[8 * s + 3]), cvtpk(p0[8 * s + 4], p0[8 * s + 5]), cvtpk(p0[8 * s + 6], p0[8 * s + 7])};
        const v4u b = (v4u){cvtpk(p1[8 * s], p1[8 * s + 1]), cvtpk(p1[8 * s + 2], p1[8 * s + 3]), cvtpk(p1[8 * s + 4], p1[8 * s + 5]), cvtpk(p1[8 * s + 6], p1[8 * s + 7])};
        pa[s] = __builtin_bit_cast(bf16x8v, a); pa[2 + s] = __builtin_bit_cast(bf16x8v, b); }
#pragma unroll
    for (int ks = 0; ks < 4; ++ks)
#pragma unroll
        for (int db = 0; db < 2; ++db) o[db] = __builtin_amdgcn_mfma_f32_32x32x16_bf16(pa[ks], __builtin_bit_cast(bf16x8v, vv[4 * db + ks]), o[db], 0, 0, 0);
}
__device__ __forceinline__ void nsa_rowscale(f32x16 (&o)[2], LAS float* wsf, float f, int r32, int hi) {
    if (hi == 0) wsf[r32] = f;
#pragma unroll
    for (int g = 0; g < 4; ++g) { const f32x4 w = *(const LAS f32x4*)(wsf + 8 * g + 4 * hi);
#pragma unroll
        for (int e = 0; e < 4; ++e) { o[0][4 * g + e] *= w[e]; o[1][4 * g + e] *= w[e]; } }
}
constexpr int NSA_ACC = 104960;
__device__ __forceinline__ void nsa_rowaccum(LAS unsigned char* acc, bool first, const f32x16 (&o)[2], LAS float* wsf, float f, int r32, int hi) {
    if (hi == 0) wsf[r32] = f;
#pragma unroll
    for (int g = 0; g < 4; ++g) { const f32x4 w = *(const LAS f32x4*)(wsf + 8 * g + 4 * hi);
#pragma unroll
        for (int e = 0; e < 4; ++e) { LAS bf16* p = (LAS bf16*)(acc + (8 * g + 4 * hi + e) * 128 + r32 * 2); const int i = 4 * g + e;
            float a = o[0][i] * w[e], b = o[1][i] * w[e];
            if (!first) { a += bf1(p[0]); b += bf1(p[32]); }
            p[0] = (bf16)f2bf(a); p[32] = (bf16)f2bf(b); } }
}
__device__ __forceinline__ void nsa_flush(const LAS unsigned char* acc, bf16* ytok  , int lane) {
    asm volatile("" ::: "memory");
    { int z_; asm volatile("v_mov_b32 %0, 0" : "=v"(z_)); lane += z_; }
#pragma unroll
    for (int ps = 0; ps < 4; ++ps) { const int row = ps * 8 + (lane >> 3), ch = lane & 7;
        const v4u v = *(const LAS v4u*)(acc + row * 128 + ch * 16);
        *(v4u*)((unsigned char*)ytok + (unsigned)(((row >> 2) * 256 + (row & 3) * 64 + ch * 8) * 2)) = v; }
}
__device__ __forceinline__ void nsa_softmax_pv(const LAS unsigned char* lds, f32x16& p0, f32x16& p1, float& m, float& l, f32x16 (&o)[2], LAS float* wsf, int lane, int r32, int hi, bool rowok) {
    float mt = nsa_max32(p0, p1); mt = rowok ? mt : -INFINITY; mt = fmaxf(mt, partner32(mt, lane));
    const float mn = fmaxf(m, mt);
    if (__builtin_amdgcn_ballot_w64(mn > m + NSA_DEFER) != 0ull) { const float f = __builtin_amdgcn_exp2f((m - mn) * NSA_C2); l *= f; nsa_rowscale(o, wsf, f, r32, hi); m = mn; }
    const float off = rowok ? -m * NSA_C2 : -INFINITY;
    v4u vv[8]; nsa_vload(lds, vv, r32, hi);
    float s = 0.f;
#pragma unroll
    for (int i = 0; i < 16; ++i) { p0[i] = __builtin_amdgcn_exp2f(__builtin_fmaf(p0[i], NSA_C2, off)); p1[i] = __builtin_amdgcn_exp2f(__builtin_fmaf(p1[i], NSA_C2, off)); s += p0[i] + p1[i]; }
    l += s;
    nsa_pv(vv, p0, p1, o);
}
__device__ __forceinline__ void p_nsa2(Frame& F) {
    const int tid = F.tid, lane = F.lane, wave = F.wave, r32 = lane & 31, hi = lane >> 5;
    LAS unsigned char* lds = F.lds + RING_OFF;
    LAS float* imp = (LAS float*)(lds + NSA_IMP); LAS float* carry = (LAS float*)(lds + NSA_CARRY);
    LAS unsigned long long* selm = (LAS unsigned long long*)(lds + NSA_SEL); LAS float* wsf = (LAS float*)(lds + NSA_WSF) + wave * 32;
    LAS unsigned char* acc = wave < 6 ? lds + NSA_ACC + wave * 4096 : F.lds + LDSCTL_OFF + 4096 + (wave - 6) * 4096;
    const bf16* P1 = WSP(bf16, WS_P1); const bf16* KC = WSP(bf16, WS_KC); const bf16* KCT = WSP(bf16, WS_KCT); const bf16* VT = WSP(bf16, WS_VT);
    bf16* Yc = WSP(bf16, WS_Y) + (size_t)2 * MC * 256;
    const int ql = r32 >> 2, h = r32 & 3, tq = 8 * wave + ql;
    int par = 0;
    for (int it = 0; it < 2; ++it) {
        for (int pair = F.vcu; pair < BC * 32; pair += F.G) {
            const int b = pair >> 5, sx = pair & 31, qb = it ? 63 - sx : sx;
            const int t = qb * 64 + tq; const size_t row = (size_t)b * SEQ + t; const bf16* prow = P1 + row * P1W;
            bf16x8v qr[4];
#pragma unroll
            for (int d0 = 0; d0 < 4; ++d0) qr[d0] = *(const bf16x8v*)(prow + C_CQ + h * 64 + d0 * 16 + hi * 8);
            const float g0 = bf1(prow[C_CG + h * 3]), g1 = bf1(prow[C_CG + h * 3 + 1]), g2 = bf1(prow[C_CG + h * 3 + 2]);
            f32x16 o[2], p0, p1;
            __syncthreads();
            for (int i = tid; i < 64 * 64; i += 512) imp[i] = 0.f;
            for (int i = tid; i < 64 * 68; i += 512) carry[i] = 0.f;
            const int nct = (4 * qb + 3 + 63) >> 6;
            const int mlim = t >= 31 ? ((t - 31) >> 4) : -1;
            const bf16* kcb = KC + (size_t)b * 256 * 64; const bf16* vcb = KCT + (size_t)b * 64 * 256;
            float m = -1e30f, l = 0.f;
            v4u kx, vx;
            nsa_load(kx, vx, kcb, 64, vcb, 256, tid);
            for (int ti = 0; ti < nct; ++ti) {
                LAS unsigned char* tb = lds + par * NSA_STAGE; par ^= 1;
                nsa_store(tb, kx, vx, tid); __syncthreads();
                { const int tn = ti + 1 < nct ? ti + 1 : 0; nsa_load(kx, vx, kcb + (size_t)tn * 64 * 64, 64, vcb + tn * 64, 256, tid); }
                nsa_qk(tb, qr, p0, p1, r32, hi); nsa_mask(p0, p1, hi, mlim - 64 * ti, -1);
                float mt = nsa_max32(p0, p1); mt = fmaxf(mt, partner32(mt, lane));
                const float mn = fmaxf(m, mt); l *= __builtin_amdgcn_exp2f((m - mn) * NSA_C2); m = mn;
                const float off = -m * NSA_C2; float s = 0.f;
#pragma unroll
                for (int i = 0; i < 16; ++i) s += __builtin_amdgcn_exp2f(__builtin_fmaf(p0[i], NSA_C2, off)) + __builtin_amdgcn_exp2f(__builtin_fmaf(p1[i], NSA_C2, off));
                l += s; }
            { const float lt = l + partner32(l, lane); const float rl = lt > 0.f ? 1.0f / lt : 0.f;
#pragma unroll
              for (int i = 0; i < 16; ++i) { o[0][i] = 0.f; o[1][i] = 0.f; }
              for (int ti = 0; ti < nct; ++ti) {
                  LAS unsigned char* tb = lds + par * NSA_STAGE; par ^= 1;
                  nsa_store(tb, kx, vx, tid); __syncthreads();
                  if (ti + 1 < nct) nsa_load(kx, vx, kcb + (size_t)(ti + 1) * 64 * 64, 64, vcb + (ti + 1) * 64, 256, tid);
                  nsa_qk(tb, qr, p0, p1, r32, hi); nsa_mask(p0, p1, hi, mlim - 64 * ti, -1);
                  v4u vv[8]; nsa_vload(tb, vv, r32, hi);
                  { const float off = -m * NSA_C2;
#pragma unroll
                    for (int i = 0; i < 16; ++i) { p0[i] = __builtin_amdgcn_exp2f(__builtin_fmaf(p0[i], NSA_C2, off)) * rl; p1[i] = __builtin_amdgcn_exp2f(__builtin_fmaf(p1[i], NSA_C2, off)) * rl; } }
#pragma unroll
                  for (int kt = 0; kt < 2; ++kt)
#pragma unroll
                      for (int g = 0; g < 4; ++g) { const f32x16& pp = kt ? p1 : p0;
                          float A = pp[4 * g] + pp[4 * g + 1] + pp[4 * g + 2] + 0.5f * pp[4 * g + 3], B = 0.5f * pp[4 * g + 3];
                          A += __builtin_bit_cast(float, bperm(lane ^ 1, __builtin_bit_cast(int, A))); A += __builtin_bit_cast(float, bperm(lane ^ 2, __builtin_bit_cast(int, A)));
                          B += __builtin_bit_cast(float, bperm(lane ^ 1, __builtin_bit_cast(int, B))); B += __builtin_bit_cast(float, bperm(lane ^ 2, __builtin_bit_cast(int, B)));
                          if (h == 0) { const int j = 16 * ti + 8 * kt + 2 * g + hi; imp[tq * 64 + j] = A; carry[tq * 68 + j + 1] = B; } }
                  nsa_pv(vv, p0, p1, o); }
              nsa_rowaccum(acc, true, o, wsf, g0, r32, hi); }
            __syncthreads();
            v4u kx2, vx2;
            { const bf16* kb = P1 + (size_t)b * SEQ * P1W + C_KSLC; const bf16* vb = VT + (size_t)(0 * BC + b) * 64 * SEQ;
              nsa_load(kx, vx, kb, P1W, vb, SEQ, tid); if (qb >= 1) nsa_load(kx2, vx2, kb + (size_t)64 * P1W, P1W, vb + 64, SEQ, tid); }
            { const int q = tid >> 3, sub = tid & 7; unsigned long long mask;
              if (qb + 1 <= 16) mask = (1ull << (qb + 1)) - 1ull;
              else { mask = 1ull | (1ull << qb);
                  unsigned long long key[8];
#pragma unroll
                  for (int i = 0; i < 8; ++i) { const int j = sub * 8 + i; const float v = imp[q * 64 + j] + carry[q * 68 + j];
                      key[i] = (j >= 1 && j < qb) ? (((unsigned long long)__builtin_bit_cast(unsigned, v) << 32) | (unsigned)(63 - j)) : 0ull; }
                  for (int r = 0; r < 14; ++r) { unsigned long long best = key[0];
#pragma unroll
                      for (int i = 1; i < 8; ++i) best = key[i] > best ? key[i] : best;
#define NSA_DPPMAX(ctrl) do { const unsigned lo_ = (unsigned)__builtin_amdgcn_update_dpp(0, (int)(unsigned)best, ctrl, 0xf, 0xf, false), hh_ = (unsigned)__builtin_amdgcn_update_dpp(0, (int)(unsigned)(best >> 32), ctrl, 0xf, 0xf, false); \
                          const unsigned long long other_ = ((unsigned long long)hh_ << 32) | lo_; best = other_ > best ? other_ : best; } while (0)
                      NSA_DPPMAX(0xB1); NSA_DPPMAX(0x4E); NSA_DPPMAX(0x141);
#undef NSA_DPPMAX
                      const int jb = 63 - (int)(best & 63ull); mask |= 1ull << jb;
#pragma unroll
                      for (int i = 0; i < 8; ++i) if (sub * 8 + i == jb) key[i] = 0ull; } }
              if (sub == 0) selm[q] = mask; }
            __syncthreads();
            const unsigned long long mysel = selm[tq];
            { const bf16* kb = P1 + (size_t)b * SEQ * P1W + C_KSLC; const bf16* vb = VT + (size_t)(0 * BC + b) * 64 * SEQ;
              m = -1e30f; l = 0.f;
#pragma unroll
              for (int i = 0; i < 16; ++i) { o[0][i] = 0.f; o[1][i] = 0.f; }
              for (int j = 0; j <= qb; j += 2) {
                  const bool two = j + 1 <= qb;
                  LAS unsigned char* tb = lds + par * NSA_STAGE; par ^= 1;
                  nsa_store(tb, kx, vx, tid); if (two) nsa_store(tb + NSA_BUF, kx2, vx2, tid);
                  __syncthreads();
                  if (j + 2 <= qb) nsa_load(kx, vx, kb + (size_t)(j + 2) * 64 * P1W, P1W, vb + (j + 2) * 64, SEQ, tid);
                  if (j + 3 <= qb) nsa_load(kx2, vx2, kb + (size_t)(j + 3) * 64 * P1W, P1W, vb + (j + 3) * 64, SEQ, tid);
                  if (j + 2 > qb) { const int jw = qb >= 8 ? qb - 8 : 0;
                      nsa_load(kx, vx, P1 + (size_t)b * SEQ * P1W + C_KWIN + (size_t)jw * 64 * P1W, P1W, VT + (size_t)(1 * BC + b) * 64 * SEQ + jw * 64, SEQ, tid); }
                  { const bool rowsel = ((mysel >> j) & 1ull) != 0ull;
                    if (__builtin_amdgcn_ballot_w64(rowsel) != 0ull) {
                        nsa_qk(tb, qr, p0, p1, r32, hi); if (j == qb) nsa_mask(p0, p1, hi, tq, -1);
                        nsa_softmax_pv(tb, p0, p1, m, l, o, wsf, lane, r32, hi, rowsel); } }
                  if (two) { const bool rowsel = ((mysel >> (j + 1)) & 1ull) != 0ull;
                    if (__builtin_amdgcn_ballot_w64(rowsel) != 0ull) {
                        nsa_qk(tb + NSA_BUF, qr, p0, p1, r32, hi); if (j + 1 == qb) nsa_mask(p0, p1, hi, tq, -1);
                        nsa_softmax_pv(tb + NSA_BUF, p0, p1, m, l, o, wsf, lane, r32, hi, rowsel); } } }
              const float lt = l + partner32(l, lane);
              nsa_rowaccum(acc, false, o, wsf, lt > 0.f ? g1 / lt : 0.f, r32, hi); }
            { const bf16* kb = P1 + (size_t)b * SEQ * P1W + C_KWIN; const bf16* vb = VT + (size_t)(1 * BC + b) * 64 * SEQ;
              m = -1e30f; l = 0.f;
#pragma unroll
              for (int i = 0; i < 16; ++i) { o[0][i] = 0.f; o[1][i] = 0.f; }
              const int j0 = qb >= 8 ? qb - 8 : 0;
              for (int j = j0; j <= qb; ++j) {
                  LAS unsigned char* tb = lds + par * NSA_STAGE; par ^= 1;
                  nsa_store(tb, kx, vx, tid); __syncthreads();
                  if (j < qb) nsa_load(kx, vx, kb + (size_t)(j + 1) * 64 * P1W, P1W, vb + (j + 1) * 64, SEQ, tid);
                  nsa_qk(tb, qr, p0, p1, r32, hi); if (j == qb || j == qb - 8) nsa_mask(p0, p1, hi, j == qb ? tq : 63, j == qb - 8 ? tq : -1);
                  nsa_softmax_pv(tb, p0, p1, m, l, o, wsf, lane, r32, hi, true); }
              const float lt = l + partner32(l, lane);
              nsa_rowaccum(acc, false, o, wsf, lt > 0.f ? g2 / lt : 0.f, r32, hi);
              nsa_flush(acc, Yc + ((size_t)b * SEQ + qb * 64 + 8 * wave) * 256, lane);
            }
        }
    }
    __syncthreads();
}

constexpr int SB_HEAD_LDS = 17408;
constexpr int SB_FLAG = 4 * SB_HEAD_LDS;
constexpr float SB_LOG2E = 1.4426950408889634f, SB_STOP = -100.0f * 1.4426950408889634f;
__device__ __forceinline__ void p_stick2(Frame& F, int nbusy) {
    const int tid = F.tid, lane = F.lane, wave = F.wave, r32 = lane & 31, hi = lane >> 5, h = wave & 3, qh = wave >> 2;
    LAS unsigned char* lds = F.lds + RING_OFF; LAS unsigned char* hl = lds + h * SB_HEAD_LDS; LAS int* flag = (LAS int*)(lds + SB_FLAG);
    const bf16* P1 = WSP(bf16, WS_P1); const bf16* VT = WSP(bf16, WS_VT) + (size_t)2 * BC * 64 * SEQ;
    bf16* Yb = WSP(bf16, WS_Y) + (size_t)MC * 256;
    const int tq = 32 * qh + r32;
    if (F.bx >= nbusy)
        for (int item = F.bx - nbusy; item < BC * 64; item += F.G - nbusy) {
            const int b = item >> 6, qb = item & 63;
            const size_t row = (size_t)b * SEQ + qb * 64 + tq;
            bf16x8v qr[4];
#pragma unroll
            for (int d0 = 0; d0 < 4; ++d0) qr[d0] = *(const bf16x8v*)(P1 + row * P1W + C_SBQ + h * 64 + d0 * 16 + hi * 8);
            f32x16 o[2], p0, p1;
#pragma unroll
            for (int i = 0; i < 16; ++i) { o[0][i] = 0.f; o[1][i] = 0.f; }
            float R = 0.f;
            const int skey = tid & 63, sc = tid >> 6, sd = tid >> 3, skc = tid & 7;
            v4u kx[4], vx[4];
#define SB_LOAD(jj) do { const bf16* kg_ = P1 + ((size_t)b * SEQ + (jj) * 64 + skey) * P1W + C_SBK + sc * 8; \
                _Pragma("unroll") for (int hh = 0; hh < 4; ++hh) { kx[hh] = *(const v4u*)(kg_ + hh * 64); vx[hh] = *(const v4u*)(VT + ((size_t)(hh * BC + b) * 64 + sd) * SEQ + (jj) * 64 + skc * 8); } } while (0)
            SB_LOAD(qb);
            for (int j = qb; j >= 0; --j) {
                __syncthreads();
                if (j < qb) { int live = 0;
#pragma unroll
                    for (int w = 0; w < 8; ++w) live |= flag[w];
                    if (!live) break; }
#pragma unroll
                for (int hh = 0; hh < 4; ++hh) { *(LAS v4u*)(lds + hh * SB_HEAD_LDS + sc * 1024 + skey * 16) = kx[hh]; { LAS v2u* vd = (LAS v2u*)(lds + hh * SB_HEAD_LDS + NSA_V + sd * NSA_VP + skc * 16); vd[0] = (v2u){vx[hh].x, vx[hh].y}; vd[1] = (v2u){vx[hh].z, vx[hh].w}; } }
                __syncthreads();
                if (j > 0) SB_LOAD(j - 1);
                nsa_qk(hl, qr, p0, p1, r32, hi);
#pragma unroll
                for (int i = 0; i < 16; ++i) { p0[i] *= NSA_C2; p1[i] *= NSA_C2; }
                v4u vv[8]; nsa_vload(hl, vv, r32, hi);
                const int lim = ((j == qb) ? tq : 64) - 4 * hi;
                float Town[8], Tp[8];
#pragma unroll
                for (int kt = 0; kt < 2; ++kt) { f32x16& pp = kt ? p1 : p0;
#pragma unroll
                    for (int g = 0; g < 4; ++g) { float L[4];
#pragma unroll
                        for (int e = 0; e < 4; ++e) { const int kk = 32 * kt + 8 * g + e; const float z = pp[4 * g + e];
                            const float tt = __builtin_amdgcn_logf(1.0f + __builtin_amdgcn_exp2f(-__builtin_fabsf(z)));
                            const float lb = fminf(z, 0.f) - tt; const bool ok = kk < lim;
                            L[e] = ok ? lb - z : 0.f; pp[4 * g + e] = ok ? lb : -INFINITY; }
                        const float E2 = L[3], E1 = E2 + L[2], E0 = E1 + L[1];
                        pp[4 * g + 2] += E2; pp[4 * g + 1] += E1; pp[4 * g] += E0;
                        Town[4 * kt + g] = E0 + L[0]; } }
#pragma unroll
                for (int k = 0; k < 8; ++k) Tp[k] = partner32(Town[k], lane);
                float suf = R;
#pragma unroll
                for (int k = 7; k >= 0; --k) { const float add = suf + (hi == 0 ? Tp[k] : 0.f); f32x16& pp = (k >> 2) ? p1 : p0; const int g = k & 3;
#pragma unroll
                    for (int e = 0; e < 4; ++e) pp[4 * g + e] = __builtin_amdgcn_exp2f(pp[4 * g + e] + add);
                    suf += Town[k] + Tp[k]; }
                R = suf;
                nsa_pv(vv, p0, p1, o);
                const bool alive = R >= SB_STOP;
                const unsigned long long bal = __builtin_amdgcn_ballot_w64(alive);
                if (lane == 0) flag[wave] = bal != 0ull ? 1 : 0;
            }
            { bf16* dst = Yb + ((size_t)b * SEQ + qb * 64 + 32 * qh + 4 * hi) * 256 + h * 64 + r32;
#pragma unroll
              for (int i = 0; i < 16; ++i) { dst[((i & 3) + 8 * (i >> 2)) * 256] = (bf16)f2bf(o[0][i]); dst[((i & 3) + 8 * (i >> 2)) * 256 + 32] = (bf16)f2bf(o[1][i]); } }
        }
#undef SB_LOAD
    __syncthreads();
}

__device__ __forceinline__ void p_sgu2(Frame& F, int layer) {
    LAS unsigned char* vnT = F.lds + RING_OFF;
    const bf16* P1 = WSP(bf16, WS_P1); bf16* Ya = WSP(bf16, WS_Y);
    const float* gain = F.in[3] + (size_t)layer * 256; const float* sw = F.in[4] + (size_t)layer * 4 * 128 * 128; const float* sb = F.in[5] + (size_t)layer * 4 * 128;
    const int lane = F.lane, wave = F.wave, r32 = lane & 31, hi = lane >> 5, g = wave & 3, db = wave >> 2;
    for (int item = F.vcu; item < MC / 128; item += F.G) {
        const size_t r0 = (size_t)item * 128;
        __syncthreads();
        { const f32x4 gg = ((const f32x4*)gain)[lane];
          for (int rr = 0; rr < 16; rr += 2) { const int r = wave * 16 + rr;
              const v2u ra = *(const v2u*)(P1 + (r0 + r) * P1W + C_V + 4 * lane), rb = *(const v2u*)(P1 + (r0 + r + 1) * P1W + C_V + 4 * lane);
              const float a0 = bflo(ra.x), a1 = bfhi(ra.x), a2 = bflo(ra.y), a3 = bfhi(ra.y), b0 = bflo(rb.x), b1 = bfhi(rb.x), b2 = bflo(rb.y), b3 = bfhi(rb.y);
              const float sa = 1.0f / sqrtf(wave_sum((a0 * a0 + a1 * a1) + (a2 * a2 + a3 * a3), lane) * (1.f / 256.f) + EPS);
              const float sb_ = 1.0f / sqrtf(wave_sum((b0 * b0 + b1 * b1) + (b2 * b2 + b3 * b3), lane) * (1.f / 256.f) + EPS);
              LAS unsigned* q = (LAS unsigned*)(vnT + (4 * lane) * 272 + r * 2);
              q[0] = pk2(a0 * sa * gg.x, b0 * sb_ * gg.x); q[68] = pk2(a1 * sa * gg.y, b1 * sb_ * gg.y); q[136] = pk2(a2 * sa * gg.z, b2 * sb_ * gg.z); q[204] = pk2(a3 * sa * gg.w, b3 * sb_ * gg.w); } }
        __syncthreads();
        const int ch = g * 64 + db * 32 + r32;
        for (int tb = 0; tb < 4; ++tb) {
            f32x16 acc;
#pragma unroll
            for (int i = 0; i < 16; ++i) acc[i] = 0.f;
            const int t = 32 * tb + r32; const float* wrow = sw + ((size_t)g * 128 + t) * 128;
            f32x4 wq[8][2];
#pragma unroll
            for (int ks = 0; ks < 8; ++ks) if (ks < 2 * tb + 2) { wq[ks][0] = *(const f32x4*)(wrow + 16 * ks + 8 * hi); wq[ks][1] = *(const f32x4*)(wrow + 16 * ks + 8 * hi + 4); }
#pragma unroll
            for (int ks = 0; ks < 8; ++ks) if (ks < 2 * tb + 2) {
                const int s0 = 16 * ks + 8 * hi;
                const f32x4 w0 = wq[ks][0], w1 = wq[ks][1];
                const v4u a = (v4u){pk2(s0 <= t ? w0.x : 0.f, s0 + 1 <= t ? w0.y : 0.f), pk2(s0 + 2 <= t ? w0.z : 0.f, s0 + 3 <= t ? w0.w : 0.f),
                                    pk2(s0 + 4 <= t ? w1.x : 0.f, s0 + 5 <= t ? w1.y : 0.f), pk2(s0 + 6 <= t ? w1.z : 0.f, s0 + 7 <= t ? w1.w : 0.f)};
                const bf16x8v bfr = *(const LAS bf16x8v*)(vnT + ch * 272 + s0 * 2);
                acc = __builtin_amdgcn_mfma_f32_32x32x16_bf16(__builtin_bit_cast(bf16x8v, a), bfr, acc, 0, 0, 0); }
            float uu[16], bb[16];
#pragma unroll
            for (int i = 0; i < 16; ++i) { const int tt = 32 * tb + (i & 3) + 8 * (i >> 2) + 4 * hi; uu[i] = bf1(P1[(r0 + tt) * P1W + C_U + ch]); bb[i] = sb[g * 128 + tt]; }
#pragma unroll
            for (int i = 0; i < 16; ++i) { const int tt = 32 * tb + (i & 3) + 8 * (i >> 2) + 4 * hi;
                Ya[(r0 + tt) * 256 + ch] = (bf16)f2bf(uu[i] * (acc[i] + bb[i])); }
        }
    }
    __syncthreads();
}

struct Args { const float* in[20]; float* out; unsigned char* ws; int lo, hi, li, rep; };
#ifndef TILED_FFN1
#define TILED_FFN1 0
#endif
#ifndef PG8_ALIGN_EPI
#define PG8_ALIGN_EPI true
#endif
#ifndef PG8_SP2
#define PG8_SP2 true
#endif
#ifndef WGM_PROJ
#define WGM_PROJ PG8_WGM
#endif
#ifndef WGM_FFN1
#define WGM_FFN1 PG8_WGM
#endif
#ifndef WGM_FFN2
#define WGM_FFN2 PG8_WGM
#endif
#ifndef WGM_MOE1
#define WGM_MOE1 PG8_WGM
#endif
#ifndef WGM_MOE2
#define WGM_MOE2 PG8_WGM
#endif
#ifndef FFN_CHUNKS
#define FFN_CHUNKS 2
#endif
#ifndef REP_GEMM
#define REP_GEMM 1
#endif
#ifndef REP_STICK
#define REP_STICK 1
#endif
#ifndef REP_NSA
#define REP_NSA 1
#endif
#ifndef REP_SGU
#define REP_SGU 1
#endif
#ifndef REP_NORM
#define REP_NORM 1
#endif
template <class Epi, class Sched> __device__ __forceinline__ void run_gemm(Frame& F, const bf16* A, const bf16* Bt, int M, int N, int K, const Sched& S, Epi E, bool rotate = true, int tiled = 0, int ld = 0) {
    const int nt_ = K / 64;
#ifdef PG8_KROT
    const int rot_ = rotate ? 2 * (((F.bx & 7) * (nt_ / 2)) / 8) : 0;
#else
    const int rot_ = 0;
#endif
    pg8::Gemm g{A, Bt, M, N, K + F.zs, F.tid, rot_ + F.zs, tiled + F.zs, ld + F.zs, nullptr};
    if (F.rep) E.set_scale0();
    pg8::gemm_phase<Epi, Sched, PG8_ALIGN_EPI, PG8_SP2>(F.lds + RING_OFF, g, S, E);
}
template <class Epi, class Sched> __device__ __forceinline__ void run_gemm_gather(Frame& F, const bf16* A, const int* gidx, const bf16* Bt, int M, int N, int K, const Sched& S, Epi E) {
    pg8::Gemm g{A, Bt, M, N, K + F.zs, F.tid, F.zs, F.zs, F.zs, gidx};
    if (F.rep) E.set_scale0();
    pg8::gemm_phase<Epi, Sched, PG8_ALIGN_EPI, PG8_SP2, true>(F.lds + RING_OFF, g, S, E);
}
__global__ void __launch_bounds__(NWAVES * 64, 2) mk_fwd(Args args) {
    extern __shared__ __attribute__((aligned(16))) unsigned char lds[];
    Frame F0;
    F0.lds = (LAS unsigned char*)lds;
    F0.tid = threadIdx.x; F0.lane = F0.tid & 63; F0.wave = __builtin_amdgcn_readfirstlane(F0.tid >> 6);
    F0.G = gridDim.x; F0.bx = blockIdx.x; F0.vcu = (F0.G % 8 == 0) ? (F0.bx % 8) * (F0.G / 8) + F0.bx / 8 : F0.bx; F0.zv = 0; F0.zs = 0;
    F0.rep = args.rep; F0.ws = args.ws; F0.ctl = (unsigned*)(args.ws + WS_CTL); F0.in = args.in; F0.out = args.out;
    for (int u = F0.tid; u < (LDS_BYTES - LDSCTL_OFF) / 4; u += NWAVES * 64) ((LAS unsigned*)(F0.lds + LDSCTL_OFF))[u] = 0u;
    __syncthreads();
    const int lo = args.lo, hi = args.hi;
    XcdBarrier bar; bar.bar = F0.ctl + CW_BAR + args.li * XCD_BAR_WORDS; bar.x = 0; bar.st = nullptr; bar.w = 0; bar.z = 0;
    if (hi - lo > 1) bar = xcd_barrier_post(F0.ctl + CW_BAR + args.li * XCD_BAR_WORDS, (volatile LAS unsigned*)(F0.lds + MISC_OFF) + 8);
    int step = 0;
#define STEP_BEGIN if (step >= lo && step < hi) { Frame F = F0; { int zv_, zs_; asm volatile("v_mov_b32 %0, 0" : "=v"(zv_)); asm volatile("s_mov_b32 %0, 0" : "=s"(zs_)); \
        F.zv = zv_; F.zs = zs_; F.lane = (int)__builtin_amdgcn_mbcnt_hi(~0u, __builtin_amdgcn_mbcnt_lo(~0u, (unsigned)zv_)); F.wave = F0.wave + zs_; F.tid = F.wave * 64 + F.lane; F.bx = F.bx + zs_; \
        F.vcu = F0.vcu + zs_; F.G = F0.G + zs_; F.lds = (LAS unsigned char*)lds + zs_; F.ws = F0.ws + zs_; F.ctl = F0.ctl + zs_; F.in = F0.in + zs_; F.out = F0.out + zs_; }
#ifdef PROBE_XBAR
#define STEP_END   if (step + 1 < hi) { unsigned zb_; asm volatile("v_mov_b32 %0, 0" : "=v"(zb_)); bar.z = zb_; xcd_barrier(bar); xcd_barrier(bar); } } ++step;
#else
#define STEP_END   if (step + 1 < hi) { unsigned zb_; asm volatile("v_mov_b32 %0, 0" : "=v"(zb_)); bar.z = zb_; xcd_barrier(bar); } } ++step;
#endif

    for (int layer = 0; layer < DEPTH; ++layer) {
        const int jj = layer >> 1;
        STEP_BEGIN
            p_convert(F, layer);
            if (layer == 0) p_norm<3, false>(F, F.in[0], nullptr, nullptr, 0); else p_rstd(F);
        STEP_END
        for (int c = 0; c < NCHUNK; ++c) {
            STEP_BEGIN
                pg8::StaticOrder S; S.init(MC, NPROJ, F.G, F.bx, WGM_PROJ);
                pg8::EpiProj E{WSP(bf16, WS_P1), WSP(bf16, WS_G), WSP(float, WS_RSTD) + (size_t)c * MC};
                run_gemm(F, (layer == 0 ? WSP(bf16, WS_HN) : WSP(bf16, WS_H)) + (size_t)c * MC * DM, WSP(bf16, WS_WIN), MC, NPROJ, DM, S, E);
            STEP_END
            STEP_BEGIN
                p_prep(F);
            STEP_END
            STEP_BEGIN
                LAS int* tab = (LAS int*)(F.lds + TAB_OFF);
                __syncthreads(); if (F.tid < 16) tab[F.tid] = F.tid >> 3; __syncthreads();
                pg8::GroupedOrder S; S.so.init(2 * 2048, 512, F.G, F.bx); S.tile_e = tab; S.nN = 2;
                pg8::EpiF32 E{WSP(float, WS_UL), 512, 2};
                run_gemm(F, WSP(bf16, WS_KVC), WSP(bf16, WS_WC1), 2 * 2048, 512, DM, S, E);
                p_sgu2(F, layer);
                p_stick2(F, F.G > 64 ? 32 : 0);
            STEP_END
            STEP_BEGIN
                p_cmpfin(F, layer);
            STEP_END
            STEP_BEGIN
#ifdef OLD_NSA
                p_nsa(F);
#else
                p_nsa2(F);
#endif
            STEP_END
            STEP_BEGIN
                pg8::MergeOrder S; S.so.init(MC, DM, F.G, F.bx); S.nmt = MC / 256;
                pg8::EpiMerge E{WSP(bf16, WS_G), WSP(bf16, WS_MG), MC / 256};
                run_gemm(F, WSP(bf16, WS_Y), WSP(bf16, WS_WBR), 3 * MC, 3 * DM, 256, S, E);
            STEP_END
            STEP_BEGIN
                pg8::StaticOrder S; S.init(MC, DM, F.G, F.bx);
                pg8::EpiResid E{layer == 0 ? F.in[0] + (size_t)c * MC * DM : nullptr, WSP(bf16, WS_H) + (size_t)c * MC * DM, DM, 1.0f};
                run_gemm(F, WSP(bf16, WS_MG), WSP(bf16, WS_WOUT), MC, DM, DM, S, E);
            STEP_END
        }
        if ((layer & 1) == 0) {
            STEP_BEGIN
                p_rstd(F);
            STEP_END
            for (int c = 0; c < FFN_CHUNKS; ++c) {
                constexpr int MF = MTOK / FFN_CHUNKS;
                STEP_BEGIN
                    pg8::StaticOrder S; S.init(MF, NFF1, F.G, F.bx, WGM_FFN1);
                    pg8::EpiSwiGLU E{WSP(bf16, WS_HID), DFFP, nullptr, NFF1 / 256, WSP(float, WS_RSTD) + (size_t)c * MF};
                    run_gemm(F, WSP(bf16, WS_H) + (size_t)c * MF * DM, WSP(bf16, WS_WF1), MF, NFF1, DM, S, E, true, TILED_FFN1);
                STEP_END
                STEP_BEGIN
                    pg8::StaticOrder S; S.init(MF, DM, F.G, F.bx, WGM_FFN2);
                    pg8::EpiResid E{nullptr, WSP(bf16, WS_H) + (size_t)c * MF * DM, DM, 1.0f};
                    run_gemm(F, WSP(bf16, WS_HID), WSP(bf16, WS_WF2), MF, DM, DFFP, S, E);
                STEP_END
            }
        } else {
            STEP_BEGIN
                p_norm<1, true>(F, WSP(bf16, WS_H), F.in[11] + (size_t)layer * DM, F.in[15] + (size_t)jj * DM * NEXP, jj, Q8_HN);
            STEP_END
#ifdef ABL_DENSE_MOE
            for (int e = 0; e < NEXP; ++e) {
                STEP_BEGIN
                    pg8::StaticOrder S; S.init(MTOK, NMOE1, F.G, F.bx);
                    pg8::EpiSwiGLU E{WSP(bf16, WS_SCR + 8 * MiB), DFE, WSP(float, WS_SCR + 4 * MiB) + (size_t)e * MTOK, NMOE1 / 256, WSP(float, WS_RSTD)};
                    run_gemm(F, WSP(bf16, WS_HN), WSP(bf16, WS_WF1) + (size_t)e * NMOE1 * DM, MTOK, NMOE1, DM, S, E);
                STEP_END
                STEP_BEGIN
                    pg8::StaticOrder S; S.init(MTOK, DM, F.G, F.bx);
                    pg8::EpiResid E{nullptr, WSP(bf16, WS_H), DM, 1.0f};
                    run_gemm(F, WSP(bf16, WS_SCR + 8 * MiB), WSP(bf16, WS_WF2) + (size_t)e * DM * DFE, MTOK, DM, DFE, S, E);
                STEP_END
            }
#else
            STEP_BEGIN
                p_gather(F, jj, 0, 0); p_gather(F, jj, 0, 1);
            STEP_END
            for (int c = 0; c < NCHUNK; ++c) {
                STEP_BEGIN
                    int dealt = 0;
                    for (int r = 0; r < 2; ++r) {
                        const int T = moe_table(F, jj, c, r);
                        int cw = F.bx - dealt % F.G; if (cw < 0) cw += F.G;
                        pg8::GroupedOrder S; S.so.init(T * 256, NMOE1, F.G, cw, WGM_MOE1); S.tile_e = (LAS int*)(F.lds + TAB_OFF); S.nN = NMOE1 / 256;
                        pg8::EpiSwiGLU E{WSP(bf16, WS_HIDM) + (size_t)r * SLOTS * DFE, DFE, WSP(float, WS_WSLOT) + (c * 2 + r) * SLOTS, NMOE1 / 256, WSP(float, WS_RSLOT) + (c * 2 + r) * SLOTS};
                        run_gemm_gather(F, WSP(bf16, WS_H), WSP(int, WS_TOKMAP) + (c * 2 + r) * SLOTS, WSP(bf16, WS_WF1), T * 256, NMOE1, DM, S, E);
                        dealt += T * (NMOE1 / 256);
                        __syncthreads();
                    }
                STEP_END
                for (int r = 0; r < 2; ++r) {
                    STEP_BEGIN
                        const int T = moe_table(F, jj, c, r);
                        const int nwg = T * (DM / 256), R = nwg % F.G, full = nwg - R;
                        const int NS = (4 * R <= F.G) ? 4 : 2;
                        const bool split = (hi - lo > 1) && R > 0 && NS * R <= F.G && !F.rep;
                        int* tokm = WSP(int, WS_TOKMAP) + (c * 2 + r) * SLOTS; float* TB = WSP(float, WS_TB); const bf16* HIDr = WSP(bf16, WS_HIDM) + (size_t)r * SLOTS * DFE;
                        { pg8::LimitOrder S; S.so.init(T * 256, DM, F.G, F.bx, WGM_MOE2); S.limit = split ? full : nwg;
                          pg8::GroupedLimit GS{S, (LAS int*)(F.lds + TAB_OFF), DM / 256};
                          pg8::EpiScatter E{WSP(bf16, WS_H), tokm, DM / 256, 1.0f};
                          run_gemm(F, HIDr, WSP(bf16, WS_WF2), T * 256, DM, DFE, GS, E, false); }
                        const bool more = r == 1 && c + 1 < NCHUNK;
                        if (split) {
                            const int KP = DFE / NS;
                            if (F.bx < NS * R) { const int Lx = full + F.bx / NS, kp = F.bx % NS;
                                pg8::StaticOrder so; so.init(T * 256, DM, F.G, Lx % F.G, WGM_MOE2); pg8::Unit un; so.next(Lx / F.G, un);
                                un.pn += ((LAS int*)(F.lds + TAB_OFF))[un.pm] * (DM / 256);
                                pg8::SingleOrder S1{un};
                                if (kp == 0) { pg8::EpiScatter E{WSP(bf16, WS_H), tokm, DM / 256, 1.0f};
                                    run_gemm(F, HIDr, WSP(bf16, WS_WF2), T * 256, DM, KP, S1, E, false, 0, DFE); }
                                else { pg8::EpiTile E{TB + ((size_t)(Lx - full) * 3 + (kp - 1)) * 65536};
                                    run_gemm(F, HIDr + kp * KP, WSP(bf16, WS_WF2) + kp * KP, T * 256, DM, KP, S1, E, false, 0, DFE); } }
                            if (more) { p_gather(F, jj, c + 1, 0, NS * R); p_gather(F, jj, c + 1, 1, NS * R); }
                            { unsigned zb_; asm volatile("v_mov_b32 %0, 0" : "=v"(zb_)); bar.z = zb_; xcd_barrier(bar); }
                            for (int it = (F.vcu * NWAVES + F.wave); it < R * 256; it += F.G * NWAVES) { const int j = it >> 8, row = it & 255, Lx = full + j;
                                pg8::StaticOrder so; so.init(T * 256, DM, F.G, Lx % F.G, WGM_MOE2); pg8::Unit un; so.next(Lx / F.G, un);
                                const int t = tokm[un.pm * 256 + row];
                                if (t >= 0) { v2u* hp = (v2u*)(WSP(bf16, WS_H) + (size_t)t * DM + un.pn * 256) + F.lane; const v2u hv = *hp; f32x4 a = (f32x4){bflo(hv.x), bfhi(hv.x), bflo(hv.y), bfhi(hv.y)};
                                    for (int q = 0; q < NS - 1; ++q) a = a + ((const f32x4*)(TB + ((size_t)j * 3 + q) * 65536 + row * 256))[F.lane];
                                    *hp = (v2u){pk2(a.x, a.y), pk2(a.z, a.w)}; } }
                        } else if (!F.rep && more) { p_gather(F, jj, c + 1, 0, R); p_gather(F, jj, c + 1, 1, R); }
                    STEP_END
                }
            }
#endif
        }
    }
    STEP_BEGIN
        p_norm<2, true>(F, WSP(bf16, WS_H), F.in[19], nullptr, 0);
    STEP_END
#undef STEP_BEGIN
#undef STEP_END
}

#ifndef MK_STEPS_PER_LAUNCH
#define MK_STEPS_PER_LAUNCH 1
#endif
extern "C" void kernel_launch(void* const* d_in, const int* in_sizes, int n_in, void* d_out, int out_size, void* d_ws, size_t ws_size, hipStream_t stream) {
    static int grid = 0;
    if (grid == 0) {
        if (n_in != 20 || in_sizes[0] != MTOK * DM || out_size != MTOK * DM || ws_size < WS_END) { fprintf(stderr, "kernel_launch: unexpected shapes (n_in %d, in0 %d, out %d, ws %zu)\n", n_in, n_in > 0 ? in_sizes[0] : -1, out_size, ws_size); grid = -1; return; }
        int dev = 0, cus = 0, per_cu = 0;
        if (hipGetDevice(&dev) != hipSuccess || hipDeviceGetAttribute(&cus, hipDeviceAttributeMultiprocessorCount, dev) != hipSuccess) { grid = -1; return; }
        if (hipFuncSetAttribute((const void*)mk_fwd, hipFuncAttributeMaxDynamicSharedMemorySize, LDS_BYTES) != hipSuccess) { fprintf(stderr, "kernel_launch: hipFuncSetAttribute failed\n"); grid = -1; return; }
        if (hipOccupancyMaxActiveBlocksPerMultiprocessor(&per_cu, (const void*)mk_fwd, NWAVES * 64, LDS_BYTES) != hipSuccess || per_cu < 1) fprintf(stderr, "kernel_launch: occupancy query reports %d\n", per_cu);
        (void)hipGetLastError();
        grid = cus;
    }
    if (grid < 0) return;
    if (hipMemsetAsync((char*)d_ws + WS_CTL, 0, CTL_ZERO_BYTES, stream) != hipSuccess) return;
    Args a{};
    for (int i = 0; i < 20; ++i) a.in[i] = (const float*)d_in[i];
    a.out = (float*)d_out; a.ws = (unsigned char*)d_ws; a.rep = 0;
    #ifdef ABL_DENSE_MOE
    constexpr int NSTEPS = 2 * (1 + NCHUNK * 8 + 3) + 2 * (1 + NCHUNK * 8 + 1 + NEXP * 2) + 1;
#else
    constexpr int NSTEPS = 2 * (1 + NCHUNK * 7 + 1 + 2 * FFN_CHUNKS) + 2 * (1 + NCHUNK * 7 + 2 + NCHUNK * 3) + 1;
#endif
    int li = 0;
#ifdef REPMASK
    static int kinds[256]; int ns = 0;
    for (int layer = 0; layer < DEPTH; ++layer) { kinds[ns++] = 0;
        for (int c = 0; c < NCHUNK; ++c) for (int q = 1; q <= 8; ++q) if (q != 5) kinds[ns++] = q;
        if ((layer & 1) == 0) { kinds[ns++] = 9; for (int c = 0; c < FFN_CHUNKS; ++c) { kinds[ns++] = 10; kinds[ns++] = 11; } }
        else { kinds[ns++] = 12; kinds[ns++] = 17; for (int c = 0; c < NCHUNK; ++c) { kinds[ns++] = 14; kinds[ns++] = 13; kinds[ns++] = 13; } } }
    kinds[ns++] = 16;
    for (int s = 0; s < NSTEPS; ++s) { const int reps = ((REPMASK >> kinds[s]) & 1) ? 2 : 1;
        for (int r = 0; r < reps; ++r) { a.lo = s; a.hi = s + 1; a.li = 0; a.rep = r;
            hipLaunchKernelGGL(mk_fwd, dim3(grid), dim3(NWAVES * 64), LDS_BYTES, stream, a); } }
    (void)li;
#else
    for (int s = 0; s < NSTEPS; s += MK_STEPS_PER_LAUNCH) {
        a.lo = s; a.hi = (s + MK_STEPS_PER_LAUNCH < NSTEPS) ? s + MK_STEPS_PER_LAUNCH : NSTEPS; a.li = (MK_STEPS_PER_LAUNCH > 1) ? li : 0; ++li;
        hipLaunchKernelGGL(mk_fwd, dim3(grid), dim3(NWAVES * 64), LDS_BYTES, stream, a);
        if (hipPeekAtLastError() != hipSuccess) { fprintf(stderr, "kernel_launch: launch failed\n"); break; }
    }
#endif
}
```

```cpp
#define MK_STEPS_PER_LAUNCH 1000
#define PG8_WGM 4
#define FFN_CHUNKS 1
#include <hip/hip_runtime.h>
#include <cstdio>
#include <cstdint>
#include <cmath>
#ifndef PG8_AUX_A
#define PG8_AUX_A 0
#endif
#ifndef PG8_AUX_B
#define PG8_AUX_B 0
#endif
#ifndef PG8_WGM
#define PG8_WGM 8
#endif
namespace pg8 {
#define PG8_LAS __attribute__((address_space(3)))
typedef unsigned short bf16_t;
typedef short bf16x8 __attribute__((ext_vector_type(8)));
typedef float f32x4 __attribute__((ext_vector_type(4)));
typedef unsigned u32x4 __attribute__((ext_vector_type(4)));
constexpr int BM = 256, BK = 64, HALF = 128, HTB = HALF * BK * 2  , STAGE_BYTES = 8 * HTB, NXCD = 8, WGM = PG8_WGM;

__host__ __device__ __forceinline__ int lds_byte(int r, int c) { const int st = (r >> 4) * 2 + (c >> 5), rr = r & 15, cc = c & 31, ob = rr * 64 + cc * 2; return st * 1024 + (ob ^ (((ob >> 9) & 1) << 5)); }
__host__ __device__ __forceinline__ void stage_rc(int b, int& R, int& C) { const int st = b / 1024, sb = b % 1024, swz = sb ^ (((sb >> 9) & 1) << 5); R = (st >> 1) * 16 + swz / 64; C = (st & 1) * 32 + (swz % 64) / 2; }
__host__ __device__ __forceinline__ int perm32(int rho) { const int n = rho >> 4, i = rho & 15; return 8 * (i >> 2) + 4 * n + (i & 3); }

struct Unit { int pm, pn; };
struct Gemm { const bf16_t* A; const bf16_t* Bt; int M, N, K; int zv; int rot; int tiled; int ld; const int* gidx; };

struct StaticOrder {
    int nM, nN, nwg, G, c, wgm;
    __host__ __device__ __forceinline__ void init(int M, int N, int G_, int c_, int wgm_ = WGM) { nM = M / BM; nN = N / BM; nwg = nM * nN; G = G_; c = c_; wgm = wgm_; }
    __host__ __device__ __forceinline__ bool next(int i, Unit& u) const {
        const long L = (long)i * G + c; if (L >= nwg) return false;
        int wgid = (int)L; { const int q = nwg / NXCD, r = nwg % NXCD, xcd = wgid % NXCD, off = wgid / NXCD; wgid = (xcd < r ? xcd * (q + 1) : r * (q + 1) + (xcd - r) * q) + off; }
        const int nig = wgm * nN, gid = wgid / nig, fm = gid * wgm, gsz = (nM - fm) < wgm ? (nM - fm) : wgm;
        u.pm = fm + ((wgid % nig) % gsz); u.pn = (wgid % nig) / gsz; return true;
    }
    __device__ __forceinline__ void a_ready(const Unit&) const {}
    __device__ __forceinline__ void done(const Unit&) const {}
};

__device__ __forceinline__ unsigned cvt_pk_bf16(float lo, float hi) { unsigned r; asm volatile("v_cvt_pk_bf16_f32 %0, %1, %2" : "=v"(r) : "v"(lo), "v"(hi)); return r; }
typedef float f32x2 __attribute__((ext_vector_type(2)));

__device__ __forceinline__ float fast_sigmoid(float x) { return __builtin_amdgcn_rcpf(1.0f + __builtin_amdgcn_exp2f(-1.4426950408889634f * x)); }
__device__ __forceinline__ float gelu_tanh(float x) {
    const float u2 = 1.5957691216057308f * (x + 0.044715f * x * x * x);
    return x * fast_sigmoid(u2);
}
__device__ __forceinline__ float bf_lo(unsigned u) { return __builtin_bit_cast(float, u << 16); }
__device__ __forceinline__ float bf_hi(unsigned u) { return __builtin_bit_cast(float, u & 0xffff0000u); }

#ifdef PG8_NT_OUT
#define PG8_STORE_OUT(p, v) __builtin_nontemporal_store((v), (p))
#else
#define PG8_STORE_OUT(p, v) (*(p) = (v))
#endif
struct EpiProj {
    static constexpr bool PERM = true, AFTER_DRAIN = false, MID = false; static constexpr int MID_TILES = 1; __device__ __forceinline__ bool keep_acc(const Unit&) const { return false; } __device__ __forceinline__ void set_scale0() {}
    bf16_t* P1; bf16_t* G; const float* rstd;
    __device__ __forceinline__ void operator()(const f32x4 (&acc)[2][2][4][2], const Unit& u, int wr, int wc, int fr, int fq) const {
        const int row0 = u.pm * BM + wr * 64 + fr;
        float rsv[8];
#pragma unroll
        for (int q = 0; q < 8; ++q) rsv[q] = rstd[row0 + (q >> 2) * HALF + (q & 3) * 16];
        bf16_t* base; int ldc, colt, act0, act1;
        if (u.pn < 8) { base = P1; ldc = 2048; colt = u.pn * BM; act0 = (u.pn < 2) ? 1 : 0; act1 = (u.pn == 7) ? 2 : act0; }
        else { base = G; ldc = 3072; colt = (u.pn - 8) * BM; act0 = 2; act1 = 2; }
        const int col0 = colt + wc * 32 + 8 * fq;
#pragma unroll
        for (int ai = 0; ai < 2; ++ai)
#pragma unroll
            for (int m = 0; m < 4; ++m) { bf16_t* rowp = base + (size_t)(row0 + ai * HALF + m * 16) * ldc + col0;
#pragma unroll
                for (int bj = 0; bj < 2; ++bj) { f32x4 v0 = acc[ai][bj][m][0] * rsv[ai * 4 + m], v1 = acc[ai][bj][m][1] * rsv[ai * 4 + m]; const int act = bj ? act1 : act0;
                    if (act == 1) {
#pragma unroll
                        for (int e = 0; e < 4; ++e) { v0[e] = gelu_tanh(v0[e]); v1[e] = gelu_tanh(v1[e]); } }
                    else if (act == 2) {
#pragma unroll
                        for (int e = 0; e < 4; ++e) { v0[e] = fast_sigmoid(v0[e]); v1[e] = fast_sigmoid(v1[e]); } }
                    u32x4 w; w.x = cvt_pk_bf16(v0[0], v0[1]); w.y = cvt_pk_bf16(v0[2], v0[3]); w.z = cvt_pk_bf16(v1[0], v1[1]); w.w = cvt_pk_bf16(v1[2], v1[3]);
                    *(u32x4*)(rowp + bj * HALF) = w; } }
    }
};
struct EpiMerge {
    static constexpr bool PERM = true, AFTER_DRAIN = false, MID = false; static constexpr int MID_TILES = 1; __device__ __forceinline__ void set_scale0() {}
    const bf16_t* G; bf16_t* MG; int nmt;
    __device__ __forceinline__ bool keep_acc(const Unit& u) const { return (u.pn >> 2) < 2; }
    __device__ __forceinline__ void operator()(f32x4 (&acc)[2][2][4][2], const Unit& u, int wr, int wc, int fr, int fq) const {
        const int i = u.pn >> 2, pn = u.pn & 3, pm = u.pm - i * nmt;
        const int row0 = pm * BM + wr * 64 + fr, col0 = pn * BM + wc * 32 + 8 * fq;
#pragma unroll
        for (int ai = 0; ai < 2; ++ai)
#pragma unroll
            for (int mp = 0; mp < 2; ++mp) {
                u32x4 g[4], h[4];
#pragma unroll
                for (int q = 0; q < 4; ++q) { const int m = 2 * mp + (q >> 1), bj = q & 1; const size_t row = (size_t)(row0 + ai * HALF + m * 16); const int col = col0 + bj * HALF;
                    g[q] = *(const u32x4*)(G + row * 3072 + i * 1024 + col);
                    if (i < 2) h[q] = *(const u32x4*)(G + row * 3072 + (i + 1) * 1024 + col); else h[q] = (u32x4){0u, 0u, 0u, 0u}; }
#pragma unroll
                for (int q = 0; q < 4; ++q) { const int m = 2 * mp + (q >> 1), bj = q & 1; const size_t row = (size_t)(row0 + ai * HALF + m * 16); const int col = col0 + bj * HALF;
                    f32x4& v0 = acc[ai][bj][m][0]; f32x4& v1 = acc[ai][bj][m][1];
                    float f[8] = {bf_lo(g[q].x), bf_hi(g[q].x), bf_lo(g[q].y), bf_hi(g[q].y), bf_lo(g[q].z), bf_hi(g[q].z), bf_lo(g[q].w), bf_hi(g[q].w)};
                    if (i < 2) { const float d[8] = {bf_lo(h[q].x), bf_hi(h[q].x), bf_lo(h[q].y), bf_hi(h[q].y), bf_lo(h[q].z), bf_hi(h[q].z), bf_lo(h[q].w), bf_hi(h[q].w)};
#pragma unroll
                        for (int e = 0; e < 8; ++e) f[e] = fmaxf(f[e], 1e-20f) * __builtin_amdgcn_rcpf(fmaxf(d[e], 1e-20f)); }
                    else {
#pragma unroll
                        for (int e = 0; e < 8; ++e) f[e] = fmaxf(f[e], 1e-20f); }
                    v0[0] *= f[0]; v0[1] *= f[1]; v0[2] *= f[2]; v0[3] *= f[3]; v1[0] *= f[4]; v1[1] *= f[5]; v1[2] *= f[6]; v1[3] *= f[7];
                    if (i == 2) { u32x4 w; w.x = cvt_pk_bf16(v0[0], v0[1]); w.y = cvt_pk_bf16(v0[2], v0[3]); w.z = cvt_pk_bf16(v1[0], v1[1]); w.w = cvt_pk_bf16(v1[2], v1[3]);
                        *(u32x4*)(MG + row * 1024 + col) = w; } } }
    }
};
typedef unsigned u32x2 __attribute__((ext_vector_type(2)));
struct EpiResid {
    static constexpr bool PERM = false, AFTER_DRAIN = false, MID = false; static constexpr int MID_TILES = 1; __device__ __forceinline__ bool keep_acc(const Unit&) const { return false; } __device__ __forceinline__ void set_scale0() { scale = 0.f; x32 = nullptr; }
    const float* x32; bf16_t* out; int ldc; float scale;
    __device__ __forceinline__ void operator()(const f32x4 (&acc)[2][2][4][2], const Unit& u, int wr, int wc, int fr, int fq) const {
        const int row0 = u.pm * BM + wr * 64 + fr, col0 = u.pn * BM + wc * 32 + 4 * fq;
#pragma unroll
        for (int ai = 0; ai < 2; ++ai)
#pragma unroll
            for (int mp = 0; mp < 2; ++mp) {
                f32x4 b[8];
                if (x32) {
#pragma unroll
                    for (int q = 0; q < 8; ++q) { const int m = 2 * mp + (q >> 2), bj = (q >> 1) & 1, n = q & 1;
                        b[q] = *(const f32x4*)(x32 + (size_t)(row0 + ai * HALF + m * 16) * ldc + col0 + bj * HALF + n * 16); }
                } else {
                    u32x2 t[8];
#pragma unroll
                    for (int q = 0; q < 8; ++q) { const int m = 2 * mp + (q >> 2), bj = (q >> 1) & 1, n = q & 1;
                        t[q] = *(const u32x2*)(out + (size_t)(row0 + ai * HALF + m * 16) * ldc + col0 + bj * HALF + n * 16); }
#pragma unroll
                    for (int q = 0; q < 8; ++q) b[q] = (f32x4){bf_lo(t[q].x), bf_hi(t[q].x), bf_lo(t[q].y), bf_hi(t[q].y)};
                }
#pragma unroll
                for (int q = 0; q < 8; ++q) { const int m = 2 * mp + (q >> 2), bj = (q >> 1) & 1, n = q & 1; const f32x4 r = b[q] + acc[ai][bj][m][n] * scale;
                    *(u32x2*)(out + (size_t)(row0 + ai * HALF + m * 16) * ldc + col0 + bj * HALF + n * 16) = (u32x2){cvt_pk_bf16(r.x, r.y), cvt_pk_bf16(r.z, r.w)}; } }
    }
};
struct EpiF32 {
    static constexpr bool PERM = false, AFTER_DRAIN = false, MID = false; static constexpr int MID_TILES = 1; __device__ __forceinline__ bool keep_acc(const Unit&) const { return false; } __device__ __forceinline__ void set_scale0() {}
    float* O; int ldc, nN;
    __device__ __forceinline__ void operator()(const f32x4 (&acc)[2][2][4][2], const Unit& u, int wr, int wc, int fr, int fq) const {
        const int row0 = u.pm * BM + wr * 64 + fr, col0 = (u.pn % nN) * BM + wc * 32 + 4 * fq;
#pragma unroll
        for (int ai = 0; ai < 2; ++ai)
#pragma unroll
            for (int m = 0; m < 4; ++m) { const size_t off = (size_t)(row0 + ai * HALF + m * 16) * ldc + col0;
#pragma unroll
                for (int bj = 0; bj < 2; ++bj)
#pragma unroll
                    for (int n = 0; n < 2; ++n) *(f32x4*)(O + off + bj * HALF + n * 16) = acc[ai][bj][m][n]; }
    }
};
#ifdef EMU_FP8_HID
__device__ __forceinline__ float Q8H(float x) { const int p = __builtin_amdgcn_cvt_pk_fp8_f32(x * 8.f, x * 8.f, 0, false); return __builtin_amdgcn_cvt_f32_fp8(p, 0) * 0.125f; }
#else
__device__ __forceinline__ float Q8H(float x) { return x; }
#endif
struct EpiSwiGLU {
    static constexpr bool PERM = true, AFTER_DRAIN = false, MID = false; static constexpr int MID_TILES = 1; __device__ __forceinline__ bool keep_acc(const Unit&) const { return false; } __device__ __forceinline__ void set_scale0() {}
    bf16_t* H; int ldh; const float* rowscale; int nN; const float* prescale; int rowmask = 0x7fffffff;
    __device__ __forceinline__ void operator()(const f32x4 (&acc)[2][2][4][2], const Unit& u, int wr, int wc, int fr, int fq) const {
        const int row0 = u.pm * BM + wr * 64 + fr, col0 = (u.pn % nN) * HALF + wc * 32 + 8 * fq;
        float scv[8];
#pragma unroll
        for (int q = 0; q < 8; ++q) scv[q] = rowscale ? rowscale[row0 + (q >> 2) * HALF + (q & 3) * 16] : 1.0f;
        float psv[8];
#pragma unroll
        for (int q = 0; q < 8; ++q) psv[q] = prescale[row0 + (q >> 2) * HALF + (q & 3) * 16];
#pragma unroll
        for (int ai = 0; ai < 2; ++ai)
#pragma unroll
            for (int m = 0; m < 4; ++m) { const int row = row0 + ai * HALF + m * 16; const float sc = scv[ai * 4 + m], ps = psv[ai * 4 + m];
                float h[8];
#pragma unroll
                for (int n = 0; n < 2; ++n)
#pragma unroll
                    for (int e = 0; e < 4; ++e) { const float g = acc[ai][0][m][n][e] * ps, up = acc[ai][1][m][n][e] * (ps * sc); h[n * 4 + e] = Q8H(g * fast_sigmoid(g) * up); }
                u32x4 w; w.x = cvt_pk_bf16(h[0], h[1]); w.y = cvt_pk_bf16(h[2], h[3]); w.z = cvt_pk_bf16(h[4], h[5]); w.w = cvt_pk_bf16(h[6], h[7]);
                PG8_STORE_OUT((u32x4*)(H + (size_t)(row & rowmask) * ldh + col0), w); }
    }
};
struct EpiScatter {
    static constexpr bool PERM = false, AFTER_DRAIN = false, MID = false; static constexpr int MID_TILES = 1; __device__ __forceinline__ bool keep_acc(const Unit&) const { return false; } __device__ __forceinline__ void set_scale0() { scale = 0.f; }
    bf16_t* out; const int* tok; int nN; float scale;
    __device__ __forceinline__ void operator()(const f32x4 (&acc)[2][2][4][2], const Unit& u, int wr, int wc, int fr, int fq) const {
        const int row0 = u.pm * BM + wr * 64 + fr, col0 = (u.pn % nN) * BM + wc * 32 + 4 * fq;
        int tk[8];
#pragma unroll
        for (int q = 0; q < 8; ++q) tk[q] = tok[row0 + (q >> 2) * HALF + (q & 3) * 16];
#pragma unroll
        for (int ai = 0; ai < 2; ++ai)
#pragma unroll
            for (int mp = 0; mp < 2; ++mp) {
                u32x2 b[8];
#pragma unroll
                for (int q = 0; q < 8; ++q) { const int m = 2 * mp + (q >> 2), bj = (q >> 1) & 1, n = q & 1; const int t = tk[ai * 4 + m];
                    b[q] = *(const u32x2*)(out + (size_t)(t < 0 ? 0 : t) * 1024 + col0 + bj * HALF + n * 16); }
#pragma unroll
                for (int q = 0; q < 8; ++q) { const int m = 2 * mp + (q >> 2), bj = (q >> 1) & 1, n = q & 1; const int t = tk[ai * 4 + m];
                    if (t >= 0) { const f32x4 r = (f32x4){bf_lo(b[q].x), bf_hi(b[q].x), bf_lo(b[q].y), bf_hi(b[q].y)} + acc[ai][bj][m][n] * scale;
                        *(u32x2*)(out + (size_t)t * 1024 + col0 + bj * HALF + n * 16) = (u32x2){cvt_pk_bf16(r.x, r.y), cvt_pk_bf16(r.z, r.w)}; } } }
    }
};
struct GroupedOrder {
    StaticOrder so; const PG8_LAS int* tile_e; int nN;
    __device__ __forceinline__ bool next(int i, Unit& u) const { if (!so.next(i, u)) return false; u.pn += tile_e[u.pm] * nN; return true; }
    __device__ __forceinline__ void a_ready(const Unit&) const {}
    __device__ __forceinline__ void done(const Unit&) const {}
};
struct LimitOrder {
    StaticOrder so; int limit;
    __device__ __forceinline__ bool next(int i, Unit& u) const { if ((long)i * so.G + so.c >= limit) return false; return so.next(i, u); }
    __device__ __forceinline__ void a_ready(const Unit&) const {}
    __device__ __forceinline__ void done(const Unit&) const {}
};
struct GroupedLimit {
    LimitOrder lo; const PG8_LAS int* tile_e; int nN;
    __device__ __forceinline__ bool next(int i, Unit& u) const { if (!lo.next(i, u)) return false; u.pn += tile_e[u.pm] * nN; return true; }
    __device__ __forceinline__ void a_ready(const Unit&) const {}
    __device__ __forceinline__ void done(const Unit&) const {}
};
struct SingleOrder {
    Unit un;
    __device__ __forceinline__ bool next(int i, Unit& u) const { if (i != 0) return false; u = un; return true; }
    __device__ __forceinline__ void a_ready(const Unit&) const {}
    __device__ __forceinline__ void done(const Unit&) const {}
};
struct EpiTile {
    static constexpr bool PERM = false, AFTER_DRAIN = false, MID = false; static constexpr int MID_TILES = 1; __device__ __forceinline__ bool keep_acc(const Unit&) const { return false; } __device__ __forceinline__ void set_scale0() {}
    float* O;
    __device__ __forceinline__ void operator()(const f32x4 (&acc)[2][2][4][2], const Unit&, int wr, int wc, int fr, int fq) const {
#pragma unroll
        for (int ai = 0; ai < 2; ++ai)
#pragma unroll
            for (int m = 0; m < 4; ++m)
#pragma unroll
                for (int bj = 0; bj < 2; ++bj)
#pragma unroll
                    for (int n = 0; n < 2; ++n) *(f32x4*)(O + (size_t)(wr * 64 + fr + ai * HALF + m * 16) * 256 + wc * 32 + 4 * fq + bj * HALF + n * 16) = acc[ai][bj][m][n];
    }
};
struct OffsetOrder {
    StaticOrder so; int pn_off;
    __device__ __forceinline__ bool next(int i, Unit& u) const { if (!so.next(i, u)) return false; u.pn += pn_off; return true; }
    __device__ __forceinline__ void a_ready(const Unit&) const {}
    __device__ __forceinline__ void done(const Unit&) const {}
};
struct ProbeOrder {
    StaticOrder so; int pm_mask;
    __device__ __forceinline__ bool next(int i, Unit& u) const { if (!so.next(i, u)) return false; u.pm &= pm_mask; return true; }
    __device__ __forceinline__ void a_ready(const Unit&) const {}
    __device__ __forceinline__ void done(const Unit&) const {}
};
struct MergeOrder {
    StaticOrder so; int nmt;
    __device__ __forceinline__ bool next(int i, Unit& u) const { const int b = i % 3; if (!so.next(i / 3, u)) return false; u.pm += b * nmt; u.pn += b * 4; return true; }
    __device__ __forceinline__ void a_ready(const Unit&) const {}
    __device__ __forceinline__ void done(const Unit&) const {}
};
template <class Epi, class Sched, bool ALIGN_EPI = false, bool SP2 = false, bool GATHER = false>
__device__ __forceinline__ void gemm_phase(PG8_LAS unsigned char* lds, const Gemm g, const Sched& S, const Epi& E) {
    const int tid = g.zv  , wid = __builtin_amdgcn_readfirstlane(tid >> 6), lane = tid & 63, wr = wid >> 2, wc = wid & 3, fr = lane & 15, fq = lane >> 4;
    const int K = g.K, nt = K / BK;
    unsigned voffA[2], voffB[2]; int gR = 0, gC = 0;
#pragma unroll
    for (int i = 0; i < 2; ++i) { int R, C; stage_rc(tid * 16 + i * 8192, R, C); const int Rb = Epi::PERM ? ((R & ~31) + perm32(R & 31)) : R;
        const int LD = g.ld ? g.ld : K;
        const int pitch = g.tiled ? BK : LD;
        voffA[i] = (unsigned)(R * pitch + C) * 2u; voffB[i] = (unsigned)(Rb * pitch + C) * 2u; if (i == 0) { gR = R; gC = C; } }
    const size_t kstep = g.tiled ? (size_t)(BM * BK * 2) : (size_t)(BK * 2);
    const size_t hstep = g.tiled ? (size_t)(HALF * BK * 2) : (size_t)HALF * (g.ld ? g.ld : K) * 2;
    const size_t tstep = (size_t)BM * (g.ld ? g.ld : K) * 2; const size_t tstepA = GATHER ? 0 : tstep, hstepA = GATHER ? 0 : hstep;
    const unsigned ldsw = (unsigned)wid * 1024u;
    const int aoff = lds_byte(wr * 64 + fr, fq * 8), boff = lds_byte(wc * 32 + fr, fq * 8);
#define PG8_SA(b, h) (((b) * 2 + (h)) * HTB)
#define PG8_SB(b, h) ((4 + (b) * 2 + (h)) * HTB)
#define PG8_STAGE(bufoff, gbase, voff) do { _Pragma("unroll") for (int _i = 0; _i < 2; ++_i) \
        __builtin_amdgcn_global_load_lds((const unsigned*)((const char*)(gbase) + (voff)[_i]), (PG8_LAS unsigned*)(lds + (bufoff) + ldsw + _i * 8192), 16, 0, ((bufoff) < 4 * HTB) ? PG8_AUX_A : PG8_AUX_B); } while (0)
#define PG8_LDA(dst, b, h) do { _Pragma("unroll") for (int m = 0; m < 4; ++m) _Pragma("unroll") for (int k = 0; k < 2; ++k) dst[m][k] = *(const PG8_LAS bf16x8*)(lds + PG8_SA(b, h) + aoff + m * 2048 + k * 1024); } while (0)
#define PG8_LDB(dst, b, h) do { _Pragma("unroll") for (int n = 0; n < 2; ++n) _Pragma("unroll") for (int k = 0; k < 2; ++k) dst[n][k] = *(const PG8_LAS bf16x8*)(lds + PG8_SB(b, h) + boff + n * 2048 + k * 1024); } while (0)
#define PG8_MMA(ai, bj, At, Bt) do { __builtin_amdgcn_s_setprio(1); _Pragma("unroll") for (int m = 0; m < 4; ++m) _Pragma("unroll") for (int n = 0; n < 2; ++n) _Pragma("unroll") for (int k = 0; k < 2; ++k) \
        acc[ai][bj][m][n] = __builtin_amdgcn_mfma_f32_16x16x32_bf16(Bt[n][k], At[m][k], acc[ai][bj][m][n], 0, 0, 0); __builtin_amdgcn_s_setprio(0); } while (0)
#define PG8_WAIT_V(n) asm volatile("s_waitcnt vmcnt(" #n ")" ::: "memory")
#define PG8_WAIT_L(n) asm volatile("s_waitcnt lgkmcnt(" #n ")" ::: "memory")
#define PG8_BAR __builtin_amdgcn_s_barrier()
#define PG8_SCHED __builtin_amdgcn_sched_barrier(0)
    Unit cur, nxt; int ui = 0;
    if (!S.next(0, cur)) return;
    f32x4 acc[2][2][4][2];
#pragma unroll
    for (int a = 0; a < 2; ++a)
#pragma unroll
        for (int b = 0; b < 2; ++b)
#pragma unroll
            for (int m = 0; m < 4; ++m)
#pragma unroll
                for (int n = 0; n < 2; ++n) acc[a][b][m][n] = (f32x4){0.f, 0.f, 0.f, 0.f};
    bf16x8 At[4][2], B0[2][2], B1[2][2];
    const char* cA = (const char*)g.A + (size_t)cur.pm * tstepA; const char* cB = (const char*)g.Bt + (size_t)cur.pn * tstep;
    const int rot = g.rot; const size_t rofs = (size_t)rot * kstep; const char* pA = cA + rofs; const char* pB = cB + rofs;
#define PG8_KT(x) ((size_t)(((x) + rot >= nt) ? (x) + rot - nt : (x) + rot))
    unsigned vC[2][2], vN[2][2];
#define PG8_GIDX(u, vv) do { _Pragma("unroll") for (int h_ = 0; h_ < 2; ++h_) _Pragma("unroll") for (int i_ = 0; i_ < 2; ++i_) { \
        if constexpr (GATHER) { const int t_ = g.gidx[(u).pm * BM + h_ * HALF + gR + 64 * i_]; vv[h_][i_] = (unsigned)((t_ < 0 ? 0 : t_) * (g.ld ? g.ld : K) + gC) * 2u; } else vv[h_][i_] = voffA[i_]; } } while (0)
    PG8_GIDX(cur, vC);
    S.a_ready(cur);
    if constexpr (SP2) {
        PG8_STAGE(PG8_SB(0, 0), pB, voffB); PG8_STAGE(PG8_SB(0, 1), pB + hstep, voffB); PG8_STAGE(PG8_SA(0, 0), pA, vC[0]); PG8_STAGE(PG8_SA(0, 1), pA + hstepA, vC[1]);
        if (wr == 1) PG8_BAR;
        PG8_WAIT_V(2); PG8_BAR;
        PG8_STAGE(PG8_SB(1, 0), pB + kstep, voffB); PG8_STAGE(PG8_SA(1, 0), pA + kstep, vC[0]); PG8_STAGE(PG8_SB(1, 1), pB + hstep + kstep, voffB);
        PG8_WAIT_V(6); PG8_BAR;
    } else {
        PG8_STAGE(PG8_SB(0, 0), pB, voffB); PG8_STAGE(PG8_SA(0, 0), pA, vC[0]); PG8_STAGE(PG8_SB(0, 1), pB + hstep, voffB); PG8_STAGE(PG8_SA(0, 1), pA + hstepA, vC[1]);
        if (wr == 1) PG8_BAR;
        PG8_WAIT_V(4); PG8_BAR;
        PG8_STAGE(PG8_SB(1, 0), pB + kstep, voffB); PG8_STAGE(PG8_SA(1, 0), pA + kstep, vC[0]); PG8_STAGE(PG8_SB(1, 1), pB + hstep + kstep, voffB);
        PG8_WAIT_V(6); PG8_BAR;
    }
    for (;;) {
        const bool has_next = S.next(ui + 1, nxt);
        if (has_next) PG8_GIDX(nxt, vN); else { vN[0][0] = vC[0][0]; vN[0][1] = vC[0][1]; vN[1][0] = vC[1][0]; vN[1][1] = vC[1][1]; }
        const char* nA = has_next ? (const char*)g.A + (size_t)nxt.pm * tstepA : cA; const char* nB = has_next ? (const char*)g.Bt + (size_t)nxt.pn * tstep : cB;
        for (int t = 0; t < nt; t += 2) {
            if constexpr (Epi::MID) { if (t != 0 && (t & (Epi::MID_TILES - 1)) == 0) E.mid(acc, cur, t / Epi::MID_TILES, wr, wc, fr, fq); }
            const bool last = (t == nt - 2);
            const char* a1 = cA + PG8_KT(t + 1) * kstep;
            const char* a2 = last ? nA + rofs : cA + PG8_KT(t + 2) * kstep; const char* b2 = last ? nB + rofs : cB + PG8_KT(t + 2) * kstep;
            const char* a3 = a2 + kstep; const char* b3 = b2 + kstep;
            if (last && has_next) S.a_ready(nxt);
            const unsigned v2h0[2] = {last ? vN[0][0] : vC[0][0], last ? vN[0][1] : vC[0][1]}, v2h1[2] = {last ? vN[1][0] : vC[1][0], last ? vN[1][1] : vC[1][1]};
            if constexpr (SP2) {
            PG8_LDB(B0, 0, 0); PG8_LDB(B1, 0, 1); PG8_SCHED; PG8_LDA(At, 0, 0); PG8_STAGE(PG8_SA(1, 1), a1 + hstepA, vC[1]);
            PG8_WAIT_V(8); PG8_WAIT_L(0); PG8_BAR; PG8_MMA(0, 0, At, B0); PG8_MMA(0, 1, At, B1); PG8_BAR; PG8_SCHED;
            PG8_LDA(At, 0, 1); PG8_STAGE(PG8_SB(0, 0), b2, voffB); PG8_STAGE(PG8_SB(0, 1), b2 + hstep, voffB); PG8_STAGE(PG8_SA(0, 0), a2, v2h0);
            PG8_WAIT_V(8); PG8_WAIT_L(0); PG8_BAR; PG8_MMA(1, 0, At, B0); PG8_MMA(1, 1, At, B1); PG8_BAR; PG8_SCHED;
            PG8_LDB(B0, 1, 0); PG8_LDB(B1, 1, 1); PG8_SCHED; PG8_LDA(At, 1, 0); PG8_STAGE(PG8_SA(0, 1), a2 + hstepA, v2h1);
            PG8_WAIT_V(8); PG8_WAIT_L(0); PG8_BAR; PG8_MMA(0, 0, At, B0); PG8_MMA(0, 1, At, B1); PG8_BAR; PG8_SCHED;
            PG8_LDA(At, 1, 1); PG8_STAGE(PG8_SB(1, 0), b3, voffB); PG8_STAGE(PG8_SB(1, 1), b3 + hstep, voffB); PG8_STAGE(PG8_SA(1, 0), a3, v2h0);
            PG8_WAIT_V(8); PG8_WAIT_L(0); PG8_BAR; PG8_MMA(1, 0, At, B0); PG8_MMA(1, 1, At, B1); PG8_BAR; PG8_SCHED;
            } else {
            PG8_LDB(B0, 0, 0); PG8_SCHED; PG8_LDA(At, 0, 0); PG8_STAGE(PG8_SA(1, 1), a1 + hstepA, vC[1]);
            PG8_WAIT_L(8); PG8_BAR; PG8_WAIT_L(0); PG8_MMA(0, 0, At, B0); PG8_BAR; PG8_SCHED;
            PG8_LDB(B1, 0, 1); PG8_STAGE(PG8_SB(0, 0), b2, voffB);
            PG8_BAR; PG8_WAIT_L(0); PG8_MMA(0, 1, At, B1); PG8_BAR;
            PG8_LDA(At, 0, 1); PG8_STAGE(PG8_SA(0, 0), a2, v2h0);
            PG8_BAR; PG8_WAIT_L(0); PG8_MMA(1, 0, At, B0); PG8_BAR; PG8_SCHED;
            PG8_STAGE(PG8_SB(0, 1), b2 + hstep, voffB);
            PG8_WAIT_V(6); PG8_BAR; PG8_MMA(1, 1, At, B1); PG8_BAR;
            PG8_LDB(B0, 1, 0); PG8_SCHED; PG8_LDA(At, 1, 0); PG8_STAGE(PG8_SA(0, 1), a2 + hstepA, v2h1);
            PG8_WAIT_L(8); PG8_BAR; PG8_WAIT_L(0); PG8_MMA(0, 0, At, B0); PG8_BAR; PG8_SCHED;
            PG8_LDB(B1, 1, 1); PG8_STAGE(PG8_SB(1, 0), b3, voffB);
            PG8_BAR; PG8_WAIT_L(0); PG8_MMA(0, 1, At, B1); PG8_BAR;
            PG8_LDA(At, 1, 1); PG8_STAGE(PG8_SA(1, 0), a3, v2h0);
            PG8_BAR; PG8_WAIT_L(0); PG8_MMA(1, 0, At, B0); PG8_BAR; PG8_SCHED;
            PG8_STAGE(PG8_SB(1, 1), b3 + hstep, voffB);
            PG8_WAIT_V(6); PG8_BAR; PG8_MMA(1, 1, At, B1); PG8_BAR;
            }
        }
        if constexpr (ALIGN_EPI) { if (wr == 0) PG8_BAR; }
        if constexpr (!Epi::AFTER_DRAIN) { E(acc, cur, wr, wc, fr, fq); S.done(cur); }
        if (!has_next) break;
        if (!E.keep_acc(cur)) {
#pragma unroll
        for (int a = 0; a < 2; ++a)
#pragma unroll
            for (int b = 0; b < 2; ++b)
#pragma unroll
                for (int m = 0; m < 4; ++m)
#pragma unroll
                    for (int n = 0; n < 2; ++n) acc[a][b][m][n] = (f32x4){0.f, 0.f, 0.f, 0.f};
        }
        cur = nxt; cA = nA; cB = nB; ++ui; vC[0][0] = vN[0][0]; vC[0][1] = vN[0][1]; vC[1][0] = vN[1][0]; vC[1][1] = vN[1][1];
        if constexpr (ALIGN_EPI) { if (wr == 1) PG8_BAR; }
    }
    PG8_WAIT_V(0);
    if constexpr (!ALIGN_EPI) { if (wr == 0) PG8_BAR; }
    PG8_BAR;
    if constexpr (Epi::AFTER_DRAIN) { E.fused(acc, cur, wr, wc, fr, fq, lds, wid, lane); S.done(cur); }
#undef PG8_KT
#undef PG8_SA
#undef PG8_SB
#undef PG8_STAGE
#undef PG8_LDA
#undef PG8_LDB
#undef PG8_MMA
#undef PG8_WAIT_V
#undef PG8_WAIT_L
#undef PG8_BAR
#undef PG8_SCHED
}
}

constexpr int NWAVES = 8;
constexpr int DM = 1024, BATCH = 16, SEQ = 4096, DEPTH = 4, MTOK = BATCH * SEQ;
constexpr int NCHUNK = 2, MC = MTOK / NCHUNK, BC = BATCH / NCHUNK;
constexpr int CIN = 5004, NPROJ = 5120, P1W = 2048, GWID = 3072;
constexpr int DFF = 2752, DFFP = 2816, NFF1 = 2 * DFFP;
constexpr int NEXP = 8, DFE = 3584, NMOE1 = 2 * DFE;
constexpr int SLOTS = MC + 2048;
constexpr float EPS = 1e-6f;
constexpr int C_U = 0, C_V = 256, C_SBQ = 512, C_SBK = 768, C_SBV = 1024, C_CQ = 1280, C_KCMP = 1536, C_VCMP = 1600, C_KSLC = 1664, C_VSLC = 1728, C_KWIN = 1792, C_VWIN = 1856, C_CG = 1920;

constexpr size_t MiB = 1u << 20;
constexpr size_t WS_CTL = 0, CTL_ZERO_BYTES = 1 * MiB;
constexpr size_t WS_ROPE = 1 * MiB;
constexpr size_t WS_BIAS1 = 1 * MiB + 512 * 1024;
constexpr size_t WS_RSTD = WS_BIAS1 + 64 * 1024;
constexpr size_t WS_WIN = 2 * MiB;
constexpr size_t WS_WBR = 12 * MiB;
constexpr size_t WS_WOUT = 14 * MiB;
constexpr size_t WS_WC1 = 16 * MiB;
constexpr size_t WS_WF1 = 18 * MiB;
constexpr size_t WS_WF2 = 130 * MiB;
constexpr size_t WS_HN = 186 * MiB;
constexpr size_t WS_SCR = 314 * MiB;
constexpr size_t WS_P1 = WS_SCR;
constexpr size_t WS_G = WS_P1 + 128 * MiB;
constexpr size_t WS_Y = WS_G + 192 * MiB;
constexpr size_t WS_MG = WS_Y + 48 * MiB;
constexpr size_t WS_KVC = WS_MG + 64 * MiB;
constexpr size_t WS_UL = WS_KVC + 8 * MiB;
constexpr size_t WS_KC = WS_UL + 8 * MiB;
constexpr size_t WS_VT = WS_KC + 1 * MiB;
constexpr size_t WS_KCT = WS_VT + 24 * MiB;
constexpr size_t WS_MIX_END = WS_KCT + 1 * MiB;
constexpr size_t WS_HID = WS_SCR;
constexpr size_t WS_ROUTE = WS_SCR;
constexpr size_t WS_TOKMAP = WS_SCR + 1 * MiB;
constexpr size_t WS_WSLOT = WS_SCR + 2 * MiB;
constexpr size_t WS_RSLOT = WS_SCR + 3 * MiB + 64 * 1024;
constexpr size_t WS_CNT128 = WS_SCR + 3 * MiB;
constexpr size_t WS_HIDM = WS_SCR + 4 * MiB;
constexpr size_t WS_H = 800 * MiB;
constexpr size_t WS_TB = 928 * MiB;
constexpr size_t WS_END = 976 * MiB;
static_assert(WS_MIX_END <= WS_H && WS_HID + (size_t)MTOK * DFFP * 2 <= WS_H && WS_HIDM + (size_t)2 * SLOTS * DFE * 2 <= WS_H, "d_ws map");
static_assert(WS_WF1 + (size_t)NEXP * NMOE1 * DM * 2 <= WS_WF2 && WS_WF2 + (size_t)NEXP * DM * DFE * 2 <= WS_HN, "weight map");
static_assert((size_t)4 * SLOTS * 4 <= 1 * MiB, "tokmap");
constexpr int CW_BAR = 4096;
constexpr int CW_CNT = 131072;
constexpr int CW_CUR = 131072 + 256;
constexpr int MAX_BAR_REGIONS = 32;
constexpr int RING_OFF = 0, RING_BYTES = 131072;
constexpr int LDSCTL_OFF = RING_BYTES, MISC_OFF = LDSCTL_OFF + 320;
constexpr int TAB_OFF = LDSCTL_OFF + 1024;
constexpr int LDS_BYTES = 147456;

#define GAS __attribute__((address_space(1)))
#define LAS __attribute__((address_space(3)))
typedef unsigned short bf16;
typedef unsigned v4u __attribute__((ext_vector_type(4)));
typedef unsigned v2u __attribute__((ext_vector_type(2)));
typedef float f32x4 __attribute__((ext_vector_type(4)));
typedef int v4i __attribute__((ext_vector_type(4)));
typedef __bf16 bf16x2_t __attribute__((ext_vector_type(2)));
#define LDS_WAIT() asm volatile("s_waitcnt lgkmcnt(0)" ::: "memory")
#define VM_WAIT() asm volatile("s_waitcnt vmcnt(0)" ::: "memory")
__device__ __forceinline__ unsigned f2bf(float f) { unsigned u = __builtin_bit_cast(unsigned, f); return (u + 0x7fffu + ((u >> 16) & 1u)) >> 16; }
__device__ __forceinline__ unsigned pk2(float lo, float hi) { return f2bf(lo) | (f2bf(hi) << 16); }
__device__ __forceinline__ float bflo(unsigned u) { return __builtin_bit_cast(float, u << 16); }
__device__ __forceinline__ float bfhi(unsigned u) { return __builtin_bit_cast(float, u & 0xffff0000u); }
__device__ __forceinline__ float bf1(bf16 h) { return __builtin_bit_cast(float, (unsigned)h << 16); }
__device__ __forceinline__ float dot2bf(unsigned a, unsigned b, float c) { return __builtin_amdgcn_fdot2_f32_bf16(__builtin_bit_cast(bf16x2_t, a), __builtin_bit_cast(bf16x2_t, b), c, false); }
#ifdef EMU_FP8
__device__ __forceinline__ float q8r(float x, float s) { const int p = __builtin_amdgcn_cvt_pk_fp8_f32(x * s, x * s, 0, false); return __builtin_amdgcn_cvt_f32_fp8(p, 0) * (1.0f / s); }
#else
__device__ __forceinline__ float q8r(float x, float) { return x; }
#endif
__device__ __forceinline__ float fexp(float x) { return __builtin_amdgcn_exp2f(1.4426950408889634f * x); }
template <int X> __device__ __forceinline__ float swz_xor(float v) { return __builtin_bit_cast(float, __builtin_amdgcn_ds_swizzle(__builtin_bit_cast(int, v), (X << 10) | 0x1f)); }
__device__ __forceinline__ float wave_sum(float v, int lane) {
#pragma unroll
    for (int o = 1; o < 64; o <<= 1) v += __builtin_bit_cast(float, __builtin_amdgcn_ds_bpermute((lane ^ o) << 2, __builtin_bit_cast(int, v)));
    return v;
}
__device__ __forceinline__ float rdlane(float v, int l) { return __builtin_bit_cast(float, __builtin_amdgcn_readlane(__builtin_bit_cast(int, v), l)); }
__device__ __forceinline__ int bperm(int srclane, int v) { return __builtin_amdgcn_ds_bpermute(srclane << 2, v); }
__constant__ double ROPE_INVF[8] = {1.0, 0.19392274474868576, 0.037606030930863933, 0.0072926647372171093, 0.0014142135623730950, 0.00027424817567620730, 5.3182958969449883e-05, 1.0313385377212460e-05};
#define XB_TMO      128
#define XB_XCNT(j)  (256  + 64 * (j))
#define XB_XSUB(j)  (1280 + 64 * (j))
#define XB_XGEN(j)  (2304 + 64 * (j))
#define XB_TOP      3328
#define XB_TOPGEN   3392
#define XCD_BAR_WORDS 3456
#define XB_SPIN_CAP (1u << 18)

__device__ __forceinline__ unsigned xb_ld(unsigned* p)              { return __hip_atomic_load(p, __ATOMIC_RELAXED, __HIP_MEMORY_SCOPE_AGENT); }
__device__ __forceinline__ unsigned xb_add(unsigned* p, unsigned v) { return __hip_atomic_fetch_add(p, v, __ATOMIC_RELAXED, __HIP_MEMORY_SCOPE_AGENT); }
__device__ __forceinline__ unsigned xb_xcc_id() { return (unsigned)__builtin_amdgcn_s_getreg((3 << 11) | 20) & 0xFu; }
#define XB_SPIN(cond, bar) do { unsigned _sp = 0; while (cond) { __builtin_amdgcn_s_sleep(1); \
    if ((++_sp & 255u) == 0u) { if (xb_ld(&(bar)[XB_TMO])) break; if (_sp > XB_SPIN_CAP) { atomicAdd(&(bar)[XB_TMO], 1u); break; } } } } while (0)

__device__ __forceinline__ bool xb_thread0_w(unsigned w, unsigned z) { return w == 0u && __builtin_amdgcn_mbcnt_hi(~0u, __builtin_amdgcn_mbcnt_lo(~0u, z)) == 0u; }
struct XcdBarrier {
    unsigned* bar; unsigned x; unsigned w, z;
    volatile LAS unsigned* st;
};

__device__ __forceinline__ XcdBarrier xcd_barrier_post(unsigned* bar, volatile LAS unsigned* st) {
    XcdBarrier b; b.bar = bar; b.x = xb_xcc_id(); b.st = st; b.w = (unsigned)__builtin_amdgcn_readfirstlane((int)(threadIdx.x >> 6)); b.z = 0u;
    if (xb_thread0_w(b.w, b.z)) (void)xb_add(&bar[XB_XCNT(b.x)], 1u);
    return b;
}
__device__ __forceinline__ void xcd_barrier_complete(unsigned* bar, unsigned x, unsigned& nloc, unsigned& nx) {
    const unsigned G = gridDim.x * gridDim.y * gridDim.z;
    unsigned sum, cnt, mine, sp = 0u;
    for (;;) {
        sum = 0u; cnt = 0u; mine = 0u;
#pragma unroll
        for (unsigned j = 0; j < 16; ++j) { const unsigned c = xb_ld(&bar[XB_XCNT(j)]); sum += c; cnt += (c > 0u) ? 1u : 0u; mine = (j == x) ? c : mine; }
        if (sum == G) break;
        __builtin_amdgcn_s_sleep(1);
        if ((++sp & 255u) == 0u) { if (xb_ld(&bar[XB_TMO])) break; if (sp > XB_SPIN_CAP) { atomicAdd(&bar[XB_TMO], 1u); break; } }
    }
    nloc = mine > 0u ? mine : 1u; nx = cnt > 0u ? cnt : 1u;
}

__device__ __forceinline__ void xcd_barrier(const XcdBarrier& b) {
    asm volatile("s_waitcnt vmcnt(0)" ::: "memory");
    __syncthreads();
    if (xb_thread0_w(b.w, b.z)) {
        unsigned* bar = b.bar;
        __builtin_amdgcn_s_waitcnt(0);
        unsigned nloc = b.st[0], nx = b.st[1];
        if (nloc == 0u) { xcd_barrier_complete(bar, b.x, nloc, nx); b.st[0] = nloc; b.st[1] = nx; }
        const unsigned old = xb_add(&bar[XB_XSUB(b.x)], 1u);
        const unsigned gen = old / nloc;
        if (old + 1u == (gen + 1u) * nloc) {
            __builtin_amdgcn_fence(__ATOMIC_RELEASE, "agent");
            asm volatile("s_waitcnt vmcnt(0)" ::: "memory");
            const unsigned og = xb_add(&bar[XB_TOP], 1u);
            const unsigned tg = og / nx;
            if (og + 1u == (tg + 1u) * nx) xb_add(&bar[XB_TOPGEN], 1u);
            else XB_SPIN(xb_ld(&bar[XB_TOPGEN]) == tg, bar);
            __builtin_amdgcn_fence(__ATOMIC_ACQUIRE, "agent");
            xb_add(&bar[XB_XGEN(b.x)], 1u);
            asm volatile("s_waitcnt vmcnt(0)" ::: "memory");
        } else {
            XB_SPIN(xb_ld(&bar[XB_XGEN(b.x)]) == gen, bar);
            __builtin_amdgcn_fence(__ATOMIC_ACQUIRE, "agent");
            asm volatile("s_waitcnt vmcnt(0)" ::: "memory");
        }
    }
    __syncthreads();
}

struct Frame {
    LAS unsigned char* lds;
    unsigned* ctl;
    int tid, lane, wave, vcu, G, bx, zv, zs, rep;
    unsigned char* ws;
    const float* const* in;
    float* out;
};
#define WSP(T, off) ((T*)(F.ws + (off)))
__device__ __forceinline__ size_t toff(int row, int k, int K) { return (size_t)(row >> 8) * 256 * K + (size_t)(k >> 6) * (256 * 64) + (size_t)(row & 255) * 64 + (k & 63); }

#ifndef TILED_FFN1
#define TILED_FFN1 0
#endif
#ifndef Q8_W1
#define Q8_W1 0.f
#define Q8_W2 0.f
#define Q8_HN 0.f
#define Q8_HID 0.f
#endif
__device__ __forceinline__ int map_row(int kind, int off, int n) { return kind == 0 ? n + off : (kind == 1 ? (n < 1932 ? n : n + 116) : ((n >> 7) * 256 + (n & 127) + off)); }
__device__ __forceinline__ void tr_item(const float* W, int ldw, int N, int ks, int n0, bf16* WT, int ldt, int kd, int kind, int off, LAS unsigned char* scr, int lane, float q8s = 0.f, int tiled = 0, const float* gk = nullptr) {
    const int nq = (lane & 15) * 4, kq = lane >> 4;
    f32x4 x[16];
#pragma unroll
    for (int i = 0; i < 16; ++i) x[i] = (n0 + nq < N) ? *(const f32x4*)(W + (size_t)(ks + 4 * i + kq) * ldw + n0 + nq) : (f32x4){0.f, 0.f, 0.f, 0.f};
    if (gk) {
        float gs[16];
#pragma unroll
        for (int i = 0; i < 16; ++i) gs[i] = gk[ks + 4 * i + kq];
#pragma unroll
        for (int i = 0; i < 16; ++i) x[i] = x[i] * gs[i]; }
#pragma unroll
    for (int i = 0; i < 16; ++i) { const int k = 4 * i + kq;
#pragma unroll
        for (int c = 0; c < 4; ++c) { float wv = x[i][c]; if (q8s > 0.f) wv = q8r(wv, q8s); *(LAS bf16*)(scr + (nq + c) * 136 + k * 2) = (bf16)f2bf(wv); } }
    LDS_WAIT(); asm volatile("" ::: "memory");
    if (n0 + lane < N) { const LAS v2u* s = (const LAS v2u*)(scr + lane * 136); const int mr = map_row(kind, off, n0 + lane); bf16* dst = tiled ? WT + toff(mr, kd, ldt) : WT + (size_t)mr * ldt + kd;
#pragma unroll
        for (int q = 0; q < 8; ++q) { const v2u a = s[2 * q], b = s[2 * q + 1]; *(v4u*)(dst + 8 * q) = (v4u){a.x, a.y, b.x, b.y}; } }
    LDS_WAIT(); asm volatile("" ::: "memory");
}
__device__ __forceinline__ void conv(Frame& F, int& tb, const float* W, size_t sW, int nb, int ldw, int N, int ks0, int K, bf16* WT, size_t sWT, int ldt, int kd0, int kind, int off, float q8s = 0.f, int tiled = 0, const float* gk = nullptr) {
    LAS unsigned char* scr = F.lds + RING_OFF + F.wave * 16384;
    const int gw = F.vcu * NWAVES + F.wave, NGW = F.G * NWAVES;
    const int nblk = (N + 63) / 64, per = (K / 64) * nblk, total = per * nb;
    int first = gw - tb; if (first < 0) first += NGW;
    for (int it = first; it < total; it += NGW) { const int b = it / per, r = it % per, kb = r / nblk, nbk = r % nblk;
        tr_item(W + (size_t)b * sW, ldw, N, ks0 + 64 * kb, 64 * nbk, WT + (size_t)b * sWT, ldt, kd0 + 64 * kb, kind, off, scr, F.lane, q8s, tiled, gk); }
    tb = (tb + total) % NGW;
}
__device__ __forceinline__ void zero_block(Frame& F, bf16* WT, int ldt, int r0, int rows, int c0, int cols, int tiled = 0) {
    const int gt = (F.vcu * NWAVES + F.wave) * 64 + F.lane, NT = F.G * NWAVES * 64, cpr = cols / 8;
    for (int i = gt; i < rows * cpr; i += NT) { const int r = i / cpr, c = i % cpr; const unsigned z = (unsigned)F.zv; *(v4u*)(tiled ? WT + toff(r0 + r, c0 + 8 * c, ldt) : WT + (size_t)(r0 + r) * ldt + c0 + 8 * c) = (v4u){z, z, z, z}; }
}
__device__ __forceinline__ void p_convert(Frame& F, int layer) {
    const int j = layer >> 1; int tb = 0;
    conv(F, tb, F.in[2] + (size_t)layer * DM * CIN, 0, 1, CIN, CIN, 0, DM, WSP(bf16, WS_WIN), 0, DM, 0, 1, 0, 0.f, 0, F.in[1] + (size_t)layer * DM);
    zero_block(F, WSP(bf16, WS_WIN), DM, 1932, 116, 0, DM);
    conv(F, tb, F.in[9] + (size_t)layer * 3 * 256 * DM, (size_t)256 * DM, 3, DM, DM, 0, 256, WSP(bf16, WS_WBR), (size_t)DM * 256, 256, 0, 0, 0);
    conv(F, tb, F.in[10] + (size_t)layer * DM * DM, 0, 1, DM, DM, 0, DM, WSP(bf16, WS_WOUT), 0, DM, 0, 0, 0);
    conv(F, tb, F.in[7] + (size_t)layer * 2 * 2048 * 256, (size_t)2048 * 256, 2, 256, 256, 0, 1024, WSP(bf16, WS_WC1), (size_t)512 * 1024, 1024, 0, 0, 0);
    conv(F, tb, F.in[7] + (size_t)layer * 2 * 2048 * 256, (size_t)2048 * 256, 2, 256, 256, 1024, 1024, WSP(bf16, WS_WC1), (size_t)512 * 1024, 1024, 0, 0, 256);
    if ((layer & 1) == 0) {
        conv(F, tb, F.in[12] + (size_t)j * DM * DFF, 0, 1, DFF, DFF, 0, DM, WSP(bf16, WS_WF1), 0, DM, 0, 2, 0, Q8_W1, TILED_FFN1, F.in[11] + (size_t)layer * DM);
        conv(F, tb, F.in[13] + (size_t)j * DM * DFF, 0, 1, DFF, DFF, 0, DM, WSP(bf16, WS_WF1), 0, DM, 0, 2, 128, Q8_W1, TILED_FFN1, F.in[11] + (size_t)layer * DM);
        zero_block(F, WSP(bf16, WS_WF1), DM, 21 * 256 + 64, 64, 0, DM, TILED_FFN1);
        zero_block(F, WSP(bf16, WS_WF1), DM, 21 * 256 + 128 + 64, 64, 0, DM, TILED_FFN1);
        conv(F, tb, F.in[14] + (size_t)j * DFF * DM, 0, 1, DM, DM, 0, DFF, WSP(bf16, WS_WF2), 0, DFFP, 0, 0, 0, Q8_W2);
        zero_block(F, WSP(bf16, WS_WF2), DFFP, 0, DM, DFF, DFFP - DFF);
    } else {
        conv(F, tb, F.in[16] + (size_t)j * NEXP * DM * DFE, (size_t)DM * DFE, NEXP, DFE, DFE, 0, DM, WSP(bf16, WS_WF1), (size_t)NMOE1 * DM, DM, 0, 2, 0, Q8_W1, 0, F.in[11] + (size_t)layer * DM);
        conv(F, tb, F.in[17] + (size_t)j * NEXP * DM * DFE, (size_t)DM * DFE, NEXP, DFE, DFE, 0, DM, WSP(bf16, WS_WF1), (size_t)NMOE1 * DM, DM, 0, 2, 128, Q8_W1, 0, F.in[11] + (size_t)layer * DM);
        conv(F, tb, F.in[18] + (size_t)j * NEXP * DFE * DM, (size_t)DFE * DM, NEXP, DM, DM, 0, DFE, WSP(bf16, WS_WF2), (size_t)DM * DFE, DFE, 0, 0, 0, Q8_W2);
    }
    if (F.bx < 8) {
        __syncthreads();
        const int kv = F.bx >> 2, jj = (F.bx & 3) * 64 + F.lane;
        const float* pos = F.in[6] + (size_t)(layer * 2 + kv) * 2048; const float* w1 = F.in[7] + (size_t)(layer * 2 + kv) * 2048 * 256;
        float a = 0.f;
        float a1 = 0.f, a2 = 0.f, a3 = 0.f;
#pragma unroll 8
        for (int k = 0; k < 256; k += 4) { const int kk = F.wave * 256 + k;
            a += pos[kk] * w1[(size_t)kk * 256 + jj]; a1 += pos[kk + 1] * w1[(size_t)(kk + 1) * 256 + jj]; a2 += pos[kk + 2] * w1[(size_t)(kk + 2) * 256 + jj]; a3 += pos[kk + 3] * w1[(size_t)(kk + 3) * 256 + jj]; }
        a = (a + a1) + (a2 + a3);
        LAS float* red = (LAS float*)(F.lds + RING_OFF);
        red[F.wave * 64 + F.lane] = a;
        __syncthreads();
        if (F.wave == 0) { float s = 0.f;
#pragma unroll
            for (int w = 0; w < 8; ++w) s += red[w * 64 + F.lane];
            WSP(float, WS_BIAS1)[kv * 256 + jj] = s; }
        __syncthreads();
    }
    if (layer == 0) {
        const int gt = (F.vcu * NWAVES + F.wave) * 64 + F.lane, NT = F.G * NWAVES * 64;
        for (int idx = gt; idx < SEQ * 8; idx += NT) { const int pos = idx >> 3, i = idx & 7;
            const double invf = ROPE_INVF[i];
            double rev = (double)pos * invf * 0.15915494309189535; rev -= __builtin_floor(rev);
            WSP(float, WS_ROPE)[idx] = __builtin_amdgcn_cosf((float)rev); WSP(float, WS_ROPE)[SEQ * 8 + idx] = __builtin_amdgcn_sinf((float)rev); }
    }
}

template <bool S16> __device__ __forceinline__ f32x4 ld_row4(const void* src, size_t m, int lane, int jx) {
    if (S16) { const v2u t = ((const v2u*)((const bf16*)src + m * DM) + lane)[64 * jx]; return (f32x4){bflo(t.x), bfhi(t.x), bflo(t.y), bfhi(t.y)}; }
    return ((const f32x4*)((const float*)src + m * DM) + lane)[64 * jx];
}
template <int MODE, bool S16> __device__ __forceinline__ void p_norm(Frame& F, const void* src, const float* g, const float* rw, int jmoe, float q8s = 0.f, int tiled = 0) {
    const int gw = F.vcu * NWAVES + F.wave, NGW = F.G * NWAVES, lane = F.lane;
    LAS int* hist = (LAS int*)(F.lds + TAB_OFF) + 192;
    if (MODE == 1) {
        if (F.tid < 16) hist[F.tid] = 0;
        const int gt = gw * 64 + lane, NT = NGW * 64; int* tm = WSP(int, WS_TOKMAP);
        for (int i = gt; i < 4 * SLOTS; i += NT) tm[i] = -1;
        for (int i = F.tid; i < DM * NEXP / 4; i += NWAVES * 64) { const int c = i >> 1, hf = i & 1;
            *(LAS f32x4*)(F.lds + RING_OFF + (((((c >> 8) * 4 + (c & 3)) * 2 + hf) * 64 + ((c & 255) >> 2)) * 16)) = ((const f32x4*)rw)[i]; }
        if (F.tid < DM / 4) *(LAS f32x4*)(F.lds + RING_OFF + 32768 + 16 * F.tid) = ((const f32x4*)g)[F.tid];
        __syncthreads();
    }
    f32x4 gv[4];
    if (MODE != 1 && MODE != 3) {
#pragma unroll
        for (int jx = 0; jx < 4; ++jx) gv[jx] = ((const f32x4*)g)[lane + 64 * jx]; }
    constexpr int ROWS = (MODE == 1) ? 2 : 4;
    const int nit = (MODE == 1) ? ((MTOK / 128 - F.bx + F.G - 1) / F.G) * (16 / ROWS) : (MTOK - gw + ROWS * NGW - 1) / (ROWS * NGW);
    for (int itx = 0; itx < nit; ++itx) {
        const int chk = (MODE == 1) ? F.bx + (itx / (16 / ROWS)) * F.G : 0;
        const int m0 = (MODE == 1) ? chk * 128 + (itx % (16 / ROWS)) * (NWAVES * ROWS) + F.wave * ROWS : gw + itx * ROWS * NGW;
        const int mstep = (MODE == 1) ? 1 : NGW;
        f32x4 v[ROWS][4]; float ss[ROWS];
#pragma unroll
        for (int u = 0; u < ROWS; ++u) { const int m = m0 + u * mstep;
#pragma unroll
            for (int jx = 0; jx < 4; ++jx) v[u][jx] = ld_row4<S16>(src, (size_t)(m < MTOK ? m : m0), lane, jx); }
#pragma unroll
        for (int u = 0; u < ROWS; ++u) { float s = 0.f;
#pragma unroll
            for (int jx = 0; jx < 4; ++jx) s += (v[u][jx].x * v[u][jx].x + v[u][jx].y * v[u][jx].y) + (v[u][jx].z * v[u][jx].z + v[u][jx].w * v[u][jx].w);
            ss[u] = s; }
#pragma unroll
        for (int o = 1; o < 64; o <<= 1) {
#pragma unroll
            for (int u = 0; u < ROWS; ++u) ss[u] += __builtin_bit_cast(float, __builtin_amdgcn_ds_bpermute((lane ^ o) << 2, __builtin_bit_cast(int, ss[u]))); }
        float lgall[MODE == 1 ? ROWS : 1][8];
        if (MODE == 1) {
            float rs[ROWS];
#pragma unroll
            for (int u = 0; u < ROWS; ++u) { rs[u] = 1.0f / sqrtf(ss[u] * (1.f / DM) + EPS);
#pragma unroll
                for (int e = 0; e < 8; ++e) lgall[u][e] = 0.f; }
#pragma unroll
            for (int jx = 0; jx < 4; ++jx) { const f32x4 gl = *(const LAS f32x4*)(F.lds + RING_OFF + 32768 + 16 * (lane + 64 * jx));
#pragma unroll
                for (int u = 0; u < ROWS; ++u) v[u][jx] = v[u][jx] * rs[u] * gl; }
#pragma unroll
            for (int jx = 0; jx < 4; ++jx) { const LAS f32x4* wr = (const LAS f32x4*)(F.lds + RING_OFF + jx * 8192 + lane * 16);
#pragma unroll
                for (int r = 0; r < 4; ++r) { const f32x4 a = wr[128 * r], b = wr[128 * r + 64];
#pragma unroll
                    for (int u = 0; u < ROWS; ++u) { const float xv = v[u][jx][r];
                        lgall[u][0] += xv * a.x; lgall[u][1] += xv * a.y; lgall[u][2] += xv * a.z; lgall[u][3] += xv * a.w; lgall[u][4] += xv * b.x; lgall[u][5] += xv * b.y; lgall[u][6] += xv * b.z; lgall[u][7] += xv * b.w; } } }
        }
#pragma unroll
        for (int u = 0; u < ROWS; ++u) { const int m = m0 + u * mstep; if (m >= MTOK) continue;
            const float rstd = 1.0f / sqrtf(ss[u] * (1.f / DM) + EPS);
            if (MODE == 3 || MODE == 1) { if (lane == 0) WSP(float, WS_RSTD)[m] = rstd; }
            if (MODE == 3) {
                if (!S16) {
                    unsigned long long* o8 = (unsigned long long*)(WSP(bf16, WS_HN) + (size_t)m * DM) + lane;
#pragma unroll
                    for (int jx = 0; jx < 4; ++jx) { const f32x4 w = v[u][jx]; o8[64 * jx] = (unsigned long long)pk2(w.x, w.y) | ((unsigned long long)pk2(w.z, w.w) << 32); } }
                continue; }
            if (MODE != 1) {
#pragma unroll
            for (int jx = 0; jx < 4; ++jx) v[u][jx] = v[u][jx] * rstd * gv[jx]; }
            if (MODE == 2) {
                f32x4* o = (f32x4*)(F.out + (size_t)m * DM) + lane;
#pragma unroll
                for (int jx = 0; jx < 4; ++jx) o[64 * jx] = v[u][jx];
            } else if (MODE != 1) {
                unsigned long long* o8 = (unsigned long long*)(WSP(bf16, WS_HN) + (size_t)m * DM) + lane;
#pragma unroll
                for (int jx = 0; jx < 4; ++jx) { f32x4 w = v[u][jx];
                    if (tiled) { *(unsigned long long*)(WSP(bf16, WS_HN) + toff(m, 4 * lane + 256 * jx, DM)) = (unsigned long long)pk2(w.x, w.y) | ((unsigned long long)pk2(w.z, w.w) << 32); continue; } if (q8s > 0.f) { w.x = q8r(w.x, q8s); w.y = q8r(w.y, q8s); w.z = q8r(w.z, q8s); w.w = q8r(w.w, q8s); }
                    o8[64 * jx] = (unsigned long long)pk2(w.x, w.y) | ((unsigned long long)pk2(w.z, w.w) << 32); }
            }
            if (MODE == 1) {
                float lg[8];
#pragma unroll
                for (int e = 0; e < 8; ++e) lg[e] = lgall[u][e];
                float h4[4], h2[2], h1;
                { const bool up = lane & 1;
#pragma unroll
                  for (int i = 0; i < 4; ++i) { const float keep = up ? lg[4 + i] : lg[i], send = up ? lg[i] : lg[4 + i]; h4[i] = keep + __builtin_bit_cast(float, bperm(lane ^ 1, __builtin_bit_cast(int, send))); } }
                { const bool up = lane & 2;
#pragma unroll
                  for (int i = 0; i < 2; ++i) { const float keep = up ? h4[2 + i] : h4[i], send = up ? h4[i] : h4[2 + i]; h2[i] = keep + __builtin_bit_cast(float, bperm(lane ^ 2, __builtin_bit_cast(int, send))); } }
                { const bool up = lane & 4; const float keep = up ? h2[1] : h2[0], send = up ? h2[0] : h2[1]; h1 = keep + __builtin_bit_cast(float, bperm(lane ^ 4, __builtin_bit_cast(int, send))); }
                h1 += __builtin_bit_cast(float, bperm(lane ^ 8, __builtin_bit_cast(int, h1))); h1 += __builtin_bit_cast(float, bperm(lane ^ 16, __builtin_bit_cast(int, h1))); h1 += __builtin_bit_cast(float, bperm(lane ^ 32, __builtin_bit_cast(int, h1)));
                lg[0] = rdlane(h1, 0); lg[1] = rdlane(h1, 4); lg[2] = rdlane(h1, 2); lg[3] = rdlane(h1, 6); lg[4] = rdlane(h1, 1); lg[5] = rdlane(h1, 5); lg[6] = rdlane(h1, 3); lg[7] = rdlane(h1, 7);
                int e0 = 0; float v0 = lg[0];
#pragma unroll
                for (int e = 1; e < 8; ++e) if (lg[e] > v0) { v0 = lg[e]; e0 = e; }
                int e1 = -1; float v1 = -INFINITY;
#pragma unroll
                for (int e = 0; e < 8; ++e) if (e != e0 && lg[e] > v1) { v1 = lg[e]; e1 = e; }
                const float w0 = 1.0f / (1.0f + fexp(v1 - v0)), w1 = 1.0f - w0;
                if (lane == 0) { WSP(v4i, WS_ROUTE)[m] = (v4i){e0, e1, __builtin_bit_cast(int, w0), __builtin_bit_cast(int, w1)};
                    __hip_atomic_fetch_add(&hist[e0], 1, __ATOMIC_RELAXED, __HIP_MEMORY_SCOPE_WORKGROUP); __hip_atomic_fetch_add(&hist[8 + e1], 1, __ATOMIC_RELAXED, __HIP_MEMORY_SCOPE_WORKGROUP); }
            }
        }
        if (MODE == 1 && (itx % (16 / ROWS)) == 16 / ROWS - 1) {
            __syncthreads();
            if (F.tid < 16) { WSP(int, WS_CNT128)[(size_t)chk * 16 + F.tid] = hist[F.tid]; hist[F.tid] = 0; }
            __syncthreads();
        }
    }
}

__device__ __forceinline__ float dpp_row_sum(float v) {
    v += __builtin_bit_cast(float, __builtin_amdgcn_update_dpp(0, __builtin_bit_cast(int, v), 0xB1, 0xf, 0xf, false));
    v += __builtin_bit_cast(float, __builtin_amdgcn_update_dpp(0, __builtin_bit_cast(int, v), 0x4E, 0xf, 0xf, false));
    v += __builtin_bit_cast(float, __builtin_amdgcn_update_dpp(0, __builtin_bit_cast(int, v), 0x141, 0xf, 0xf, false));
    v += __builtin_bit_cast(float, __builtin_amdgcn_update_dpp(0, __builtin_bit_cast(int, v), 0x140, 0xf, 0xf, false));
    return v;
}
__device__ __forceinline__ void p_rstd(Frame& F) {
    const int gw = F.vcu * NWAVES + F.wave, NGW = F.G * NWAVES, lane = F.lane;
    const bf16* H = WSP(bf16, WS_H); float* rs = WSP(float, WS_RSTD);
    for (int m0 = gw * 8; m0 < MTOK; m0 += NGW * 8) {
        v4u x[8][2];
#pragma unroll
        for (int u = 0; u < 8; ++u) { const v4u* xr = (const v4u*)(H + (size_t)(m0 + u) * DM) + lane; x[u][0] = xr[0]; x[u][1] = xr[64]; }
        float ss[8];
#pragma unroll
        for (int u = 0; u < 8; ++u) { float s = 0.f;
#pragma unroll
            for (int h = 0; h < 2; ++h) { const v4u w = x[u][h];
                const float a0 = bflo(w.x), a1 = bfhi(w.x), a2 = bflo(w.y), a3 = bfhi(w.y), a4 = bflo(w.z), a5 = bfhi(w.z), a6 = bflo(w.w), a7 = bfhi(w.w);
                s += ((a0 * a0 + a1 * a1) + (a2 * a2 + a3 * a3)) + ((a4 * a4 + a5 * a5) + (a6 * a6 + a7 * a7)); }
            ss[u] = dpp_row_sum(s); }
        float myr = 0.f;
#pragma unroll
        for (int u = 0; u < 8; ++u) { const float t = (rdlane(ss[u], 0) + rdlane(ss[u], 16)) + (rdlane(ss[u], 32) + rdlane(ss[u], 48)); if (lane == u) myr = t; }
        if (lane < 8) rs[m0 + lane] = 1.0f / sqrtf(myr * (1.f / DM) + EPS);
    }
}
__device__ __forceinline__ void p_prep(Frame& F) {
    const int gw = F.vcu * NWAVES + F.wave, NGW = F.G * NWAVES, lane = F.lane;
    bf16* P1 = WSP(bf16, WS_P1); bf16* KVC = WSP(bf16, WS_KVC); const float* rope = WSP(float, WS_ROPE);
    const int vec = lane >> 3, ri = lane & 7; const int cb = vec < 4 ? C_CQ + vec * 64 : (vec == 4 ? C_KCMP : (vec == 5 ? C_KSLC : C_KWIN));
    for (int row0 = gw; row0 < MC; row0 += 4 * NGW) {
        float x1[4], x2[4], cc[4], ss[4]; bf16 kc48[4], vc64[4];
#pragma unroll
        for (int k = 0; k < 4; ++k) { const int row = row0 + k * NGW < MC ? row0 + k * NGW : row0; const bf16* p = P1 + (size_t)row * P1W; const int pos = row & (SEQ - 1);
            const int cl = lane < 56 ? cb + ri : C_CQ;
            x1[k] = bf1(p[cl]); x2[k] = bf1(p[cl + 8]); cc[k] = rope[pos * 8 + ri]; ss[k] = rope[SEQ * 8 + pos * 8 + ri];
            if (F.rep) { cc[k] = 1.f; ss[k] = 0.f; }
            kc48[k] = p[C_KCMP + 16 + (lane < 48 ? lane : 0)]; vc64[k] = p[C_VCMP + lane]; }
#pragma unroll
        for (int k = 0; k < 4; ++k) { const int row = row0 + k * NGW; if (row >= MC) continue; bf16* p = P1 + (size_t)row * P1W;
            if (lane < 56) { const bf16 o1 = (bf16)f2bf(x1[k] * cc[k] - x2[k] * ss[k]), o2 = (bf16)f2bf(x2[k] * cc[k] + x1[k] * ss[k]);
                p[cb + ri] = o1; p[cb + ri + 8] = o2;
                if (vec == 4) { KVC[(size_t)row * 64 + ri] = o1; KVC[(size_t)row * 64 + ri + 8] = o2; } }
            if (lane < 48) KVC[(size_t)row * 64 + 16 + lane] = kc48[k];
            KVC[(size_t)MC * 64 + (size_t)row * 64 + lane] = vc64[k]; }
    }
    bf16* VT = WSP(bf16, WS_VT);
    for (int it = gw; it < 6 * BC * 64; it += NGW) { const int which = it / (BC * 64), r = it % (BC * 64), b = r >> 6, blk = r & 63;
        const v4u* src = (const v4u*)(P1 + ((size_t)b * SEQ + blk * 64 + lane) * P1W + (which == 0 ? C_VSLC : (which == 1 ? C_VWIN : C_SBV + (which - 2) * 64)));
        bf16* dst = VT + ((size_t)(which * BC + b) * 64) * SEQ + blk * 64 + lane;
        v4u xs[8];
#pragma unroll
        for (int i = 0; i < 8; ++i) xs[i] = src[i];
#pragma unroll
        for (int i = 0; i < 8; ++i) { const v4u x = xs[i];
            dst[(size_t)(8 * i + 0) * SEQ] = (bf16)(x.x & 0xffffu); dst[(size_t)(8 * i + 1) * SEQ] = (bf16)(x.x >> 16);
            dst[(size_t)(8 * i + 2) * SEQ] = (bf16)(x.y & 0xffffu); dst[(size_t)(8 * i + 3) * SEQ] = (bf16)(x.y >> 16);
            dst[(size_t)(8 * i + 4) * SEQ] = (bf16)(x.z & 0xffffu); dst[(size_t)(8 * i + 5) * SEQ] = (bf16)(x.z >> 16);
            dst[(size_t)(8 * i + 6) * SEQ] = (bf16)(x.w & 0xffffu); dst[(size_t)(8 * i + 7) * SEQ] = (bf16)(x.w >> 16); }
    }
}
__device__ __forceinline__ void p_sgu(Frame& F, int layer) {
    LAS float* vn = (LAS float*)(F.lds + RING_OFF);
    const bf16* P1 = WSP(bf16, WS_P1); bf16* Ya = WSP(bf16, WS_Y);
    const float* gain = F.in[3] + (size_t)layer * 256; const float* sw = F.in[4] + (size_t)layer * 4 * 128 * 128; const float* sb = F.in[5] + (size_t)layer * 4 * 128;
    const int lane = F.lane, wave = F.wave;
    for (int item = F.vcu; item < MC / 128; item += F.G) {
        const size_t r0 = (size_t)item * 128;
        __syncthreads();
        for (int rr = 0; rr < 16; ++rr) { const int r = wave * 16 + rr; const v2u raw = *(const v2u*)(P1 + (r0 + r) * P1W + C_V + 4 * lane);
            const float a = bflo(raw.x), b = bfhi(raw.x), c = bflo(raw.y), d = bfhi(raw.y);
            const float rstd = 1.0f / sqrtf(wave_sum((a * a + b * b) + (c * c + d * d), lane) * (1.f / 256.f) + EPS);
            const f32x4 gg = ((const f32x4*)gain)[lane];
            *(LAS f32x4*)(vn + r * 256 + 4 * lane) = (f32x4){a * rstd * gg.x, b * rstd * gg.y, c * rstd * gg.z, d * rstd * gg.w}; }
        __syncthreads();
        const int g = wave & 3, half = wave >> 2;
        for (int i = 0; i < 64; ++i) { const int t = 2 * i + half;
            const float* wrow = sw + ((size_t)g * 128 + t) * 128;
            const float w_lo = wrow[lane], w_hi = wrow[64 + lane];
            float acc = 0.f;
            for (int s = 0; s <= t; ++s) { const float w = (s < 64) ? rdlane(w_lo, s) : rdlane(w_hi, s - 64); acc += w * vn[s * 256 + g * 64 + lane]; }
            const float u = bf1(P1[(r0 + t) * P1W + C_U + g * 64 + lane]);
#ifdef ABL_SGUMIX
            acc = 0.f;
#endif
            Ya[(r0 + t) * 256 + g * 64 + lane] = (bf16)f2bf(u * (acc + sb[g * 128 + t])); }
    }
    __syncthreads();
}

__device__ __forceinline__ void p_cmpfin(Frame& F, int layer) {
    const int gw = F.vcu * NWAVES + F.wave, NGW = F.G * NWAVES, lane = F.lane;
    const float* UL = WSP(float, WS_UL); const float* bias = WSP(float, WS_BIAS1); bf16* KC = WSP(bf16, WS_KC);
    LAS float* w2l = (LAS float*)(F.lds + RING_OFF);
    __syncthreads();
    { const f32x4* src = (const f32x4*)(F.in[8] + (size_t)layer * 2 * 256 * 64);
#pragma unroll 4
      for (int i = F.tid; i < 2 * 256 * 64 / 4; i += NWAVES * 64) *(LAS f32x4*)(w2l + 4 * i) = src[i]; }
    __syncthreads();
    for (int it = gw; it < 2 * BC * 255; it += NGW) { const int kv = it / (BC * 255), r = it % (BC * 255), b = r / 255, m = r % 255;
        const LAS float* w2 = w2l + kv * 256 * 64;
        const float* U = UL + (size_t)(kv * 2048 + b * 256 + m) * 512; const float* L = U + 512 + 256;
        float hv[4];
#pragma unroll
        for (int q = 0; q < 4; ++q) hv[q] = pg8::gelu_tanh(U[64 * q + lane] + L[64 * q + lane] + bias[kv * 256 + 64 * q + lane]);
        float acc0 = 0.f, acc1 = 0.f;
#pragma unroll
        for (int q = 0; q < 4; ++q)
#pragma unroll 8
            for (int jj = 0; jj < 64; jj += 2) { acc0 += rdlane(hv[q], jj) * w2[(64 * q + jj) * 64 + lane]; acc1 += rdlane(hv[q], jj + 1) * w2[(64 * q + jj + 1) * 64 + lane]; }
        const float acc = acc0 + acc1;
        KC[((size_t)(kv * BC + b) * 256 + m) * 64 + lane] = (bf16)f2bf(acc);
        if (kv == 1) { WSP(bf16, WS_KCT)[((size_t)b * 64 + lane) * 256 + m] = (bf16)f2bf(acc); if (m == 254) WSP(bf16, WS_KCT)[((size_t)b * 64 + lane) * 256 + 255] = (bf16)0; }
        else if (m == 254) KC[((size_t)b * 256 + 255) * 64 + lane] = (bf16)0; }
    __syncthreads();
}

__device__ __forceinline__ void p_stick(Frame& F) {
    const int gw = F.vcu * NWAVES + F.wave, NGW = F.G * NWAVES, lane = F.lane;
    const bf16* P1 = WSP(bf16, WS_P1); bf16* Yb = WSP(bf16, WS_Y) + (size_t)MC * 256;
    for (int item = gw; item < BC * 4 * 64; item += NGW) { const int tb = item & 63, h = (item >> 6) & 3, b = item >> 8;
        const int t = tb * 64 + lane; const size_t row = (size_t)b * SEQ + t;
        unsigned q[32];
        { const v4u* qp = (const v4u*)(P1 + row * P1W + C_SBQ + h * 64);
#pragma unroll
          for (int i = 0; i < 8; ++i) { const v4u x = qp[i]; q[4 * i] = x.x; q[4 * i + 1] = x.y; q[4 * i + 2] = x.z; q[4 * i + 3] = x.w; } }
        float o[64];
#pragma unroll
        for (int d = 0; d < 64; ++d) o[d] = 0.f;
        float R = 0.f;
        const bf16* kb = P1 + (size_t)b * SEQ * P1W + C_SBK + h * 64; const bf16* vb = P1 + (size_t)b * SEQ * P1W + C_SBV + h * 64;
        for (int s = t - 1; s >= 0; --s) {
            if (R < -100.f) break;
            const v4u* kp = (const v4u*)(kb + (size_t)s * P1W); const v4u* vp = (const v4u*)(vb + (size_t)s * P1W);
            float z0 = 0.f, z1 = 0.f;
#pragma unroll
            for (int i = 0; i < 8; ++i) { const v4u k = kp[i]; z0 = dot2bf(k.x, q[4 * i], z0); z1 = dot2bf(k.y, q[4 * i + 1], z1); z0 = dot2bf(k.z, q[4 * i + 2], z0); z1 = dot2bf(k.w, q[4 * i + 3], z1); }
            const float z = (z0 + z1) * 0.125f;
            const float tt = 0.6931471805599453f * __builtin_amdgcn_logf(1.0f + fexp(-__builtin_fabsf(z)));
            const float lb = fminf(z, 0.f) - tt, l1m = fminf(-z, 0.f) - tt;
            const float a = fexp(lb + R); R += l1m;
#pragma unroll
            for (int i = 0; i < 8; ++i) { const v4u v = vp[i];
                o[8 * i] += a * bflo(v.x); o[8 * i + 1] += a * bfhi(v.x); o[8 * i + 2] += a * bflo(v.y); o[8 * i + 3] += a * bfhi(v.y);
                o[8 * i + 4] += a * bflo(v.z); o[8 * i + 5] += a * bfhi(v.z); o[8 * i + 6] += a * bflo(v.w); o[8 * i + 7] += a * bfhi(v.w); }
        }
        v4u* op = (v4u*)(Yb + row * 256 + h * 64);
#pragma unroll
        for (int i = 0; i < 8; ++i) op[i] = (v4u){pk2(o[8 * i], o[8 * i + 1]), pk2(o[8 * i + 2], o[8 * i + 3]), pk2(o[8 * i + 4], o[8 * i + 5]), pk2(o[8 * i + 6], o[8 * i + 7])};
    }
}

struct Soft { float mx, l; };
__device__ __forceinline__ float dotq(const LAS v4u* ql, const bf16* kp_) {
    const v4u* kp = (const v4u*)kp_; float z0 = 0.f, z1 = 0.f;
#pragma unroll
    for (int i = 0; i < 8; ++i) { const v4u k = kp[i]; const v4u q = ql[i]; z0 = dot2bf(k.x, q.x, z0); z1 = dot2bf(k.y, q.y, z1); z0 = dot2bf(k.z, q.z, z0); z1 = dot2bf(k.w, q.w, z1); }
    return (z0 + z1) * 0.125f;
}
__device__ __forceinline__ void axpy_row(float p, const bf16* vp_, float (&o)[64]) {
    const v4u* vp = (const v4u*)vp_;
#pragma unroll
    for (int i = 0; i < 8; ++i) { const v4u v = vp[i];
        o[8 * i] += p * bflo(v.x); o[8 * i + 1] += p * bfhi(v.x); o[8 * i + 2] += p * bflo(v.y); o[8 * i + 3] += p * bfhi(v.y);
        o[8 * i + 4] += p * bflo(v.z); o[8 * i + 5] += p * bfhi(v.z); o[8 * i + 6] += p * bflo(v.w); o[8 * i + 7] += p * bfhi(v.w); }
}
__device__ __forceinline__ void nsa_step(const LAS v4u* ql, const bf16* kp_, const bf16* vp_, Soft& S, float (&o)[64]) {
    const float s = dotq(ql, kp_);
    if (s > S.mx) { const float sc = fexp(S.mx - s); S.l *= sc;
#pragma unroll
        for (int d = 0; d < 64; ++d) o[d] *= sc;
        S.mx = s; }
    const float p = fexp(s - S.mx); S.l += p;
    asm volatile("" ::: "memory");
    axpy_row(p, vp_, o);
}
__device__ __forceinline__ void nsa_accum(bf16* yrow, bool first, float sc, const float (&o)[64]) {
    v4u* op = (v4u*)yrow;
#pragma unroll
    for (int i = 0; i < 8; ++i) { v4u old = (v4u){0u, 0u, 0u, 0u}; if (!first) old = op[i];
        op[i] = (v4u){pk2(bflo(old.x) + sc * o[8 * i], bfhi(old.x) + sc * o[8 * i + 1]), pk2(bflo(old.y) + sc * o[8 * i + 2], bfhi(old.y) + sc * o[8 * i + 3]),
                      pk2(bflo(old.z) + sc * o[8 * i + 4], bfhi(old.z) + sc * o[8 * i + 5]), pk2(bflo(old.w) + sc * o[8 * i + 6], bfhi(old.w) + sc * o[8 * i + 7])}; }
}
__device__ __forceinline__ void p_nsa(Frame& F) {
    const int gw = F.vcu * NWAVES + F.wave, NGW = F.G * NWAVES, lane = F.lane;
    const bf16* P1 = WSP(bf16, WS_P1); const bf16* KC = WSP(bf16, WS_KC); bf16* Yc = WSP(bf16, WS_Y) + (size_t)2 * MC * 256;
    LAS float* imp = (LAS float*)(F.lds + RING_OFF + F.wave * 4096);
    LAS v4u* ql = (LAS v4u*)(F.lds + RING_OFF + 32768 + F.wave * 9216 + lane * 144);
    const int qi = lane >> 2, h = lane & 3;
    for (int item = gw; item < BC * 256; item += NGW) { const int b = item >> 8, tg = item & 255;
        const int t = tg * 16 + qi; const size_t row = (size_t)b * SEQ + t; const bf16* prow = P1 + row * P1W;
        { const v4u* qp = (const v4u*)(prow + C_CQ + h * 64);
#pragma unroll
          for (int i = 0; i < 8; ++i) ql[i] = qp[i]; }
        const float g0 = bf1(prow[C_CG + h * 3]), g1 = bf1(prow[C_CG + h * 3 + 1]), g2 = bf1(prow[C_CG + h * 3 + 2]);
        bf16* yrow = Yc + row * 256 + h * 64;
        float o[64];
        for (int i = lane; i < 1024; i += 64) imp[i] = 0.f;
        const int nv = t >= 31 ? ((t - 31) >> 4) + 1 : 0; const int nvmax = (tg * 16 + 15 >= 31) ? ((tg * 16 + 15 - 31) >> 4) + 1 : 0;
        const bf16* kc = KC + (size_t)(0 * BC + b) * 256 * 64; const bf16* vc = KC + (size_t)(1 * BC + b) * 256 * 64;
        { float mx = -INFINITY, l = 0.f;
          for (int m = 0; m < nvmax; ++m) { const float s = dotq(ql, kc + m * 64); if (m < nv) { if (s > mx) { l *= fexp(mx - s); mx = s; } l += fexp(s - mx); } }
          const float rl = l > 0.f ? 1.0f / l : 0.f;
#pragma unroll
          for (int d = 0; d < 64; ++d) o[d] = 0.f;
          for (int m = 0; m < nvmax; ++m) { const float s = dotq(ql, kc + m * 64); const float p = (m < nv) ? fexp(s - mx) * rl : 0.f;
              asm volatile("" ::: "memory");
              axpy_row(p, vc + m * 64, o);
              float P = p + __builtin_bit_cast(float, bperm(lane ^ 1, __builtin_bit_cast(int, p))); P += __builtin_bit_cast(float, bperm(lane ^ 2, __builtin_bit_cast(int, P)));
              if (h == 0) { const int j0 = m >> 2; const bool edge = (m & 3) == 3; imp[qi * 64 + j0] += edge ? 0.5f * P : P; if (edge) imp[qi * 64 + j0 + 1] += 0.5f * P; } }
          nsa_accum(yrow, true, g0, o); }
        unsigned long long mask = 0ull;
        { const int cur = t >> 6, nvb = cur + 1;
          if (h == 0) {
              if (nvb <= 16) mask = (1ull << nvb) - 1ull;
              else { mask = 1ull | (1ull << cur);
                  for (int r = 0; r < 14; ++r) { int best = -1; float bv = -1.f;
                      for (int j = 1; j < cur; ++j) { const float v = imp[qi * 64 + j]; if (!((mask >> j) & 1ull) && v > bv) { bv = v; best = j; } }
                      mask |= 1ull << best; } } }
          const unsigned mlo = (unsigned)bperm(lane & ~3, (int)(unsigned)mask), mhi = (unsigned)bperm(lane & ~3, (int)(unsigned)(mask >> 32));
          mask = ((unsigned long long)mhi << 32) | mlo; }
        { Soft S{-INFINITY, 0.f};
#pragma unroll
          for (int d = 0; d < 64; ++d) o[d] = 0.f;
          const bf16* kb = P1 + (size_t)b * SEQ * P1W + C_KSLC; const bf16* vb = P1 + (size_t)b * SEQ * P1W + C_VSLC;
          unsigned long long mm = mask;
          while (mm) { const int j = __builtin_ctzll(mm); mm &= mm - 1ull;
              for (int kk = 0; kk < 64; ++kk) { const int sp = j * 64 + kk; if (sp > t) break; nsa_step(ql, kb + (size_t)sp * P1W, vb + (size_t)sp * P1W, S, o); } }
          nsa_accum(yrow, false, g1 / S.l, o); }
        { Soft S{-INFINITY, 0.f};
#pragma unroll
          for (int d = 0; d < 64; ++d) o[d] = 0.f;
          const bf16* kb = P1 + (size_t)b * SEQ * P1W + C_KWIN; const bf16* vb = P1 + (size_t)b * SEQ * P1W + C_VWIN;
          for (int i = 0; i < 512; ++i) { const int sp = t - 511 + i; if (sp >= 0) nsa_step(ql, kb + (size_t)sp * P1W, vb + (size_t)sp * P1W, S, o); }
          nsa_accum(yrow, false, g2 / S.l, o); }
    }
}

__device__ __forceinline__ int moe_table(Frame& F, int jmoe, int c, int r, int kpre = 0) {
    LAS int* tab = (LAS int*)(F.lds + TAB_OFF); LAS int* arr = (LAS int*)(F.lds + LDSCTL_OFF + 4096);
    (void)jmoe;
    __syncthreads();
    if (F.tid < 256) { const v4i* s = (const v4i*)(WSP(int, WS_CNT128) + ((size_t)(c * 256 + F.tid) * 2 + r) * 8); const v4i a = s[0], b = s[1];
        *(LAS v4i*)(arr + F.tid * 8) = a; *(LAS v4i*)(arr + F.tid * 8 + 4) = b; }
    __syncthreads();
    if (F.tid < 8) { int tot = 0, pre = 0;
        for (int k = 0; k < 256; ++k) { const int x = arr[k * 8 + F.tid]; pre += (k < kpre) ? x : 0; tot += x; }
        tab[176 + F.tid] = tot; tab[184 + F.tid] = pre; }
    __syncthreads();
    if (F.tid == 0) { int base = 0, T = 0;
        for (int e = 0; e < 8; ++e) { const int cnt = tab[176 + e];
            const int nt = (cnt + 255) >> 8; tab[160 + e] = base; for (int i = 0; i < nt && T + i < 160; ++i) tab[T + i] = e; T += nt; base += nt * 256; }
        tab[168] = T < 136 ? T : 136; }
    __syncthreads();
    return tab[168];
}
__device__ __forceinline__ void p_gather(Frame& F, int jmoe, int c, int r, int nbusy = 0) {
    if (F.bx < nbusy) return;
    LAS int* tab = (LAS int*)(F.lds + TAB_OFF); LAS int* cntw = tab + 256; LAS int* basew = tab + 320;
    const int lane = F.lane, wave = F.wave;
    const v4i* route = WSP(v4i, WS_ROUTE); int* tokmap = WSP(int, WS_TOKMAP) + (c * 2 + r) * SLOTS; float* wslot = WSP(float, WS_WSLOT) + (c * 2 + r) * SLOTS; float* rslot = WSP(float, WS_RSLOT) + (c * 2 + r) * SLOTS;
    for (int ch = F.bx - nbusy; ch < MC / 128; ch += F.G - nbusy) {
        moe_table(F, jmoe, c, r, ch);
        const int m = c * MC + ch * 128 + wave * 16 + (lane & 15); const v4i rt = route[m];
        const int e = lane < 16 ? (r ? rt.y : rt.x) : -1; const float w = __builtin_bit_cast(float, r ? rt.w : rt.z);
        unsigned long long bal[8]; int mycnt = 0;
#pragma unroll
        for (int ee = 0; ee < 8; ++ee) { bal[ee] = __builtin_amdgcn_ballot_w64(e == ee); if (lane == ee) mycnt = __builtin_popcountll(bal[ee]); }
        if (lane < 8) cntw[wave * 8 + lane] = mycnt;
        __syncthreads();
        if (wave == 0 && lane < 8) { int base = tab[184 + lane];
#pragma unroll
            for (int w8 = 0; w8 < 8; ++w8) { basew[w8 * 8 + lane] = base; base += cntw[w8 * 8 + lane]; } }
        __syncthreads();
        int pos = 0;
#pragma unroll
        for (int ee = 0; ee < 8; ++ee) if (e == ee) pos = basew[wave * 8 + ee] + __builtin_popcountll(bal[ee] & ((1ull << lane) - 1ull));
        int slot = 0;
        if (lane < 16) { slot = tab[160 + e] + pos; tokmap[slot] = m; wslot[slot] = w; rslot[slot] = WSP(float, WS_RSTD)[m]; }
    }
}

typedef float f32x16 __attribute__((ext_vector_type(16)));
typedef short bf16x8v __attribute__((ext_vector_type(8)));
typedef float f32x2v __attribute__((ext_vector_type(2)));
constexpr int NSA_K = 0, NSA_V = 8192, NSA_BUF = 17408, NSA_STAGE = 2 * NSA_BUF, NSA_IMP = 69632, NSA_CARRY = 86016, NSA_SEL = 103424, NSA_WSF = 103936;
constexpr int NSA_VP = 136;
constexpr float NSA_C2 = 0.125f * 1.4426950408889634f;
constexpr float NSA_DEFER = 8.0f / (0.125f * 1.4426950408889634f);
__device__ __forceinline__ unsigned cvtpk(float lo, float hi) { f32x2v v = {lo, hi}; bf16x2_t b = __builtin_convertvector(v, bf16x2_t); return __builtin_bit_cast(unsigned, b); }
__device__ __forceinline__ float partner32(float v, int lane) { return __builtin_bit_cast(float, __builtin_amdgcn_ds_bpermute((lane ^ 32) << 2, __builtin_bit_cast(int, v))); }
__device__ __forceinline__ void nsa_load(v4u& kx, v4u& vx, const bf16* Kg, int kp, const bf16* Vg, int vp, int tid) {
    kx = *(const v4u*)(Kg + (size_t)(tid & 63) * kp + (tid >> 6) * 8); vx = *(const v4u*)(Vg + (size_t)(tid >> 3) * vp + (tid & 7) * 8);
}
__device__ __forceinline__ void nsa_store(LAS unsigned char* lds, const v4u& kx, const v4u& vx, int tid) {
    *(LAS v4u*)(lds + NSA_K + (tid >> 6) * 1024 + (tid & 63) * 16) = kx; { LAS v2u* vd = (LAS v2u*)(lds + NSA_V + (tid >> 3) * NSA_VP + (tid & 7) * 16); vd[0] = (v2u){vx.x, vx.y}; vd[1] = (v2u){vx.z, vx.w}; }
}
__device__ __forceinline__ void nsa_qk(const LAS unsigned char* lds, const bf16x8v (&qr)[4], f32x16& p0, f32x16& p1, int r32, int hi) {
    bf16x8v kf[8];
#pragma unroll
    for (int d0 = 0; d0 < 4; ++d0) {
        kf[2 * d0] = *(const LAS bf16x8v*)(lds + NSA_K + (2 * d0 + hi) * 1024 + r32 * 16);
        kf[2 * d0 + 1] = *(const LAS bf16x8v*)(lds + NSA_K + (2 * d0 + hi) * 1024 + 512 + r32 * 16); }
    __builtin_amdgcn_sched_barrier(0);
#pragma unroll
    for (int i = 0; i < 16; ++i) { p0[i] = 0.f; p1[i] = 0.f; }
#pragma unroll
    for (int d0 = 0; d0 < 4; ++d0) {
        p0 = __builtin_amdgcn_mfma_f32_32x32x16_bf16(kf[2 * d0], qr[d0], p0, 0, 0, 0);
        p1 = __builtin_amdgcn_mfma_f32_32x32x16_bf16(kf[2 * d0 + 1], qr[d0], p1, 0, 0, 0);
    }
}
__device__ __forceinline__ void nsa_mask(f32x16& p0, f32x16& p1, int hi, int hiL, int loL) {
    const int hl = hiL - 4 * hi, ll = loL - 4 * hi;
#pragma unroll
    for (int i = 0; i < 16; ++i) { const int c = (i & 3) + 8 * (i >> 2);
        if (!(c <= hl && c > ll)) p0[i] = -INFINITY;
        if (!(c + 32 <= hl && c + 32 > ll)) p1[i] = -INFINITY; }
}
__device__ __forceinline__ float nsa_max32(const f32x16& p0, const f32x16& p1) {
    float a = fmaxf(fmaxf(p0[0], p0[1]), p1[0]), b = fmaxf(fmaxf(p0[2], p0[3]), p1[1]); a = fmaxf(fmaxf(a, p1[2]), p1[3]);
#pragma unroll
    for (int i = 4; i < 16; i += 4) { a = fmaxf(fmaxf(a, p0[i]), p0[i + 1]); b = fmaxf(fmaxf(b, p0[i + 2]), p0[i + 3]); a = fmaxf(fmaxf(a, p1[i]), p1[i + 1]); b = fmaxf(fmaxf(b, p1[i + 2]), p1[i + 3]); }
    return fmaxf(a, b);
}
__device__ __forceinline__ void nsa_vload(const LAS unsigned char* lds, v4u (&vv)[8], int r32, int hi) {
#pragma unroll
    for (int db = 0; db < 2; ++db) { const LAS unsigned char* vrow = lds + NSA_V + (32 * db + r32) * NSA_VP;
#pragma unroll
        for (int ks = 0; ks < 4; ++ks) {
            const int kb = (ks >> 1) * 32 + (ks & 1) * 16 + 4 * hi;
            const v2u lo = *(const LAS v2u*)(vrow + kb * 2), hh = *(const LAS v2u*)(vrow + (kb + 8) * 2);
            vv[4 * db + ks] = (v4u){lo.x, lo.y, hh.x, hh.y}; } }
    __builtin_amdgcn_sched_barrier(0);
}
__device__ __forceinline__ void nsa_pv(const v4u (&vv)[8], const f32x16& p0, const f32x16& p1, f32x16 (&o)[2]) {
    bf16x8v pa[4];
#pragma unroll
    for (int s = 0; s < 2; ++s) {
        const v4u a = (v4u){cvtpk(p0[8 * s], p0[8 * s + 1]), cvtpk(p0[8 * s + 2], p0[8 * s + 3]), cvtpk(p0[8 * s + 4], p0[8 * s + 5]), cvtpk(p0[8 * s + 6], p0[8 * s + 7])};
        const v4u b = (v4u){cvtpk(p1[8 * s], p1[8 * s + 1]), cvtpk(p1[8 * s + 2], p1[8 * s + 3]), cvtpk(p1[8 * s + 4], p1[8 * s + 5]), cvtpk(p1[8 * s + 6], p1[8 * s + 7])};
        pa[s] = __builtin_bit_cast(bf16x8v, a); pa[2 + s] = __builtin_bit_cast(bf16x8v, b); }
#pragma unroll
    for (int ks = 0; ks < 4; ++ks)
#pragma unroll
        for (int db = 0; db < 2; ++db) o[db] = __builtin_amdgcn_mfma_f32_32x32x16_bf16(pa[ks], __builtin_bit_cast(bf16x8v, vv[4 * db + ks]), o[db], 0, 0, 0);
}
__device__ __forceinline__ void nsa_rowscale(f32x16 (&o)[2], LAS float* wsf, float f, int r32, int hi) {
    if (hi == 0) wsf[r32] = f;
#pragma unroll
    for (int g = 0; g < 4; ++g) { const f32x4 w = *(const LAS f32x4*)(wsf + 8 * g + 4 * hi);
#pragma unroll
        for (int e = 0; e < 4; ++e) { o[0][4 * g + e] *= w[e]; o[1][4 * g + e] *= w[e]; } }
}
constexpr int NSA_ACC = 104960;
__device__ __forceinline__ void nsa_rowaccum(LAS unsigned char* acc, bool first, const f32x16 (&o)[2], LAS float* wsf, float f, int r32, int hi) {
    if (hi == 0) wsf[r32] = f;
#pragma unroll
    for (int g = 0; g < 4; ++g) { const f32x4 w = *(const LAS f32x4*)(wsf + 8 * g + 4 * hi);
#pragma unroll
        for (int e = 0; e < 4; ++e) { LAS bf16* p = (LAS bf16*)(acc + (8 * g + 4 * hi + e) * 128 + r32 * 2); const int i = 4 * g + e;
            float a = o[0][i] * w[e], b = o[1][i] * w[e];
            if (!first) { a += bf1(p[0]); b += bf1(p[32]); }
            p[0] = (bf16)f2bf(a); p[32] = (bf16)f2bf(b); } }
}
__device__ __forceinline__ void nsa_flush(const LAS unsigned char* acc, bf16* ytok  , int lane) {
    asm volatile("" ::: "memory");
    { int z_; asm volatile("v_mov_b32 %0, 0" : "=v"(z_)); lane += z_; }
#pragma unroll
    for (int ps = 0; ps < 4; ++ps) { const int row = ps * 8 + (lane >> 3), ch = lane & 7;
        const v4u v = *(const LAS v4u*)(acc + row * 128 + ch * 16);
        *(v4u*)((unsigned char*)ytok + (unsigned)(((row >> 2) * 256 + (row & 3) * 64 + ch * 8) * 2)) = v; }
}
__device__ __forceinline__ void nsa_softmax_pv(const LAS unsigned char* lds, f32x16& p0, f32x16& p1, float& m, float& l, f32x16 (&o)[2], LAS float* wsf, int lane, int r32, int hi, bool rowok) {
    float mt = nsa_max32(p0, p1); mt = rowok ? mt : -INFINITY; mt = fmaxf(mt, partner32(mt, lane));
    const float mn = fmaxf(m, mt);
    if (__builtin_amdgcn_ballot_w64(mn > m + NSA_DEFER) != 0ull) { const float f = __builtin_amdgcn_exp2f((m - mn) * NSA_C2); l *= f; nsa_rowscale(o, wsf, f, r32, hi); m = mn; }
    const float off = rowok ? -m * NSA_C2 : -INFINITY;
    v4u vv[8]; nsa_vload(lds, vv, r32, hi);
    float s = 0.f;
#pragma unroll
    for (int i = 0; i < 16; ++i) { p0[i] = __builtin_amdgcn_exp2f(__builtin_fmaf(p0[i], NSA_C2, off)); p1[i] = __builtin_amdgcn_exp2f(__builtin_fmaf(p1[i], NSA_C2, off)); s += p0[i] + p1[i]; }
    l += s;
    nsa_pv(vv, p0, p1, o);
}
__device__ __forceinline__ void p_nsa2(Frame& F) {
    const int tid = F.tid, lane = F.lane, wave = F.wave, r32 = lane & 31, hi = lane >> 5;
    LAS unsigned char* lds = F.lds + RING_OFF;
    LAS float* imp = (LAS float*)(lds + NSA_IMP); LAS float* carry = (LAS float*)(lds + NSA_CARRY);
    LAS unsigned long long* selm = (LAS unsigned long long*)(lds + NSA_SEL); LAS float* wsf = (LAS float*)(lds + NSA_WSF) + wave * 32;
    LAS unsigned char* acc = wave < 6 ? lds + NSA_ACC + wave * 4096 : F.lds + LDSCTL_OFF + 4096 + (wave - 6) * 4096;
    const bf16* P1 = WSP(bf16, WS_P1); const bf16* KC = WSP(bf16, WS_KC); const bf16* KCT = WSP(bf16, WS_KCT); const bf16* VT = WSP(bf16, WS_VT);
    bf16* Yc = WSP(bf16, WS_Y) + (size_t)2 * MC * 256;
    const int ql = r32 >> 2, h = r32 & 3, tq = 8 * wave + ql;
    int par = 0;
    for (int it = 0; it < 2; ++it) {
        for (int pair = F.vcu; pair < BC * 32; pair += F.G) {
            const int b = pair >> 5, sx = pair & 31, qb = it ? 63 - sx : sx;
            const int t = qb * 64 + tq; const size_t row = (size_t)b * SEQ + t; const bf16* prow = P1 + row * P1W;
            bf16x8v qr[4];
#pragma unroll
            for (int d0 = 0; d0 < 4; ++d0) qr[d0] = *(const bf16x8v*)(prow + C_CQ + h * 64 + d0 * 16 + hi * 8);
            const float g0 = bf1(prow[C_CG + h * 3]), g1 = bf1(prow[C_CG + h * 3 + 1]), g2 = bf1(prow[C_CG + h * 3 + 2]);
            f32x16 o[2], p0, p1;
            __syncthreads();
            for (int i = tid; i < 64 * 64; i += 512) imp[i] = 0.f;
            for (int i = tid; i < 64 * 68; i += 512) carry[i] = 0.f;
            const int nct = (4 * qb + 3 + 63) >> 6;
            const int mlim = t >= 31 ? ((t - 31) >> 4) : -1;
            const bf16* kcb = KC + (size_t)b * 256 * 64; const bf16* vcb = KCT + (size_t)b * 64 * 256;
            float m = -1e30f, l = 0.f;
            v4u kx, vx;
            nsa_load(kx, vx, kcb, 64, vcb, 256, tid);
            for (int ti = 0; ti < nct; ++ti) {
                LAS unsigned char* tb = lds + par * NSA_STAGE; par ^= 1;
                nsa_store(tb, kx, vx, tid); __syncthreads();
                { const int tn = ti + 1 < nct ? ti + 1 : 0; nsa_load(kx, vx, kcb + (size_t)tn * 64 * 64, 64, vcb + tn * 64, 256, tid); }
                nsa_qk(tb, qr, p0, p1, r32, hi); nsa_mask(p0, p1, hi, mlim - 64 * ti, -1);
                float mt = nsa_max32(p0, p1); mt = fmaxf(mt, partner32(mt, lane));
                const float mn = fmaxf(m, mt); l *= __builtin_amdgcn_exp2f((m - mn) * NSA_C2); m = mn;
                const float off = -m * NSA_C2; float s = 0.f;
#pragma unroll
                for (int i = 0; i < 16; ++i) s += __builtin_amdgcn_exp2f(__builtin_fmaf(p0[i], NSA_C2, off)) + __builtin_amdgcn_exp2f(__builtin_fmaf(p1[i], NSA_C2, off));
                l += s; }
            { const float lt = l + partner32(l, lane); const float rl = lt > 0.f ? 1.0f / lt : 0.f;
#pragma unroll
              for (int i = 0; i < 16; ++i) { o[0][i] = 0.f; o[1][i] = 0.f; }
              for (int ti = 0; ti < nct; ++ti) {
                  LAS unsigned char* tb = lds + par * NSA_STAGE; par ^= 1;
                  nsa_store(tb, kx, vx, tid); __syncthreads();
                  if (ti + 1 < nct) nsa_load(kx, vx, kcb + (size_t)(ti + 1) * 64 * 64, 64, vcb + (ti + 1) * 64, 256, tid);
                  nsa_qk(tb, qr, p0, p1, r32, hi); nsa_mask(p0, p1, hi, mlim - 64 * ti, -1);
                  v4u vv[8]; nsa_vload(tb, vv, r32, hi);
                  { const float off = -m * NSA_C2;
#pragma unroll
                    for (int i = 0; i < 16; ++i) { p0[i] = __builtin_amdgcn_exp2f(__builtin_fmaf(p0[i], NSA_C2, off)) * rl; p1[i] = __builtin_amdgcn_exp2f(__builtin_fmaf(p1[i], NSA_C2, off)) * rl; } }
#pragma unroll
                  for (int kt = 0; kt < 2; ++kt)
#pragma unroll
                      for (int g = 0; g < 4; ++g) { const f32x16& pp = kt ? p1 : p0;
                          float A = pp[4 * g] + pp[4 * g + 1] + pp[4 * g + 2] + 0.5f * pp[4 * g + 3], B = 0.5f * pp[4 * g + 3];
                          A += __builtin_bit_cast(float, bperm(lane ^ 1, __builtin_bit_cast(int, A))); A += __builtin_bit_cast(float, bperm(lane ^ 2, __builtin_bit_cast(int, A)));
                          B += __builtin_bit_cast(float, bperm(lane ^ 1, __builtin_bit_cast(int, B))); B += __builtin_bit_cast(float, bperm(lane ^ 2, __builtin_bit_cast(int, B)));
                          if (h == 0) { const int j = 16 * ti + 8 * kt + 2 * g + hi; imp[tq * 64 + j] = A; carry[tq * 68 + j + 1] = B; } }
                  nsa_pv(vv, p0, p1, o); }
              nsa_rowaccum(acc, true, o, wsf, g0, r32, hi); }
            __syncthreads();
            v4u kx2, vx2;
            { const bf16* kb = P1 + (size_t)b * SEQ * P1W + C_KSLC; const bf16* vb = VT + (size_t)(0 * BC + b) * 64 * SEQ;
              nsa_load(kx, vx, kb, P1W, vb, SEQ, tid); if (qb >= 1) nsa_load(kx2, vx2, kb + (size_t)64 * P1W, P1W, vb + 64, SEQ, tid); }
            { const int q = tid >> 3, sub = tid & 7; unsigned long long mask;
              if (qb + 1 <= 16) mask = (1ull << (qb + 1)) - 1ull;
              else { mask = 1ull | (1ull << qb);
                  unsigned long long key[8];
#pragma unroll
                  for (int i = 0; i < 8; ++i) { const int j = sub * 8 + i; const float v = imp[q * 64 + j] + carry[q * 68 + j];
                      key[i] = (j >= 1 && j < qb) ? (((unsigned long long)__builtin_bit_cast(unsigned, v) << 32) | (unsigned)(63 - j)) : 0ull; }
                  for (int r = 0; r < 14; ++r) { unsigned long long best = key[0];
#pragma unroll
                      for (int i = 1; i < 8; ++i) best = key[i] > best ? key[i] : best;
#define NSA_DPPMAX(ctrl) do { const unsigned lo_ = (unsigned)__builtin_amdgcn_update_dpp(0, (int)(unsigned)best, ctrl, 0xf, 0xf, false), hh_ = (unsigned)__builtin_amdgcn_update_dpp(0, (int)(unsigned)(best >> 32), ctrl, 0xf, 0xf, false); \
                          const unsigned long long other_ = ((unsigned long long)hh_ << 32) | lo_; best = other_ > best ? other_ : best; } while (0)
                      NSA_DPPMAX(0xB1); NSA_DPPMAX(0x4E); NSA_DPPMAX(0x141);
#undef NSA_DPPMAX
                      const int jb = 63 - (int)(best & 63ull); mask |= 1ull << jb;
#pragma unroll
                      for (int i = 0; i < 8; ++i) if (sub * 8 + i == jb) key[i] = 0ull; } }
              if (sub == 0) selm[q] = mask; }
            __syncthreads();
            const unsigned long long mysel = selm[tq];
            { const bf16* kb = P1 + (size_t)b * SEQ * P1W + C_KSLC; const bf16* vb = VT + (size_t)(0 * BC + b) * 64 * SEQ;
              m = -1e30f; l = 0.f;
#pragma unroll
              for (int i = 0; i < 16; ++i) { o[0][i] = 0.f; o[1][i] = 0.f; }
              for (int j = 0; j <= qb; j += 2) {
                  const bool two = j + 1 <= qb;
                  LAS unsigned char* tb = lds + par * NSA_STAGE; par ^= 1;
                  nsa_store(tb, kx, vx, tid); if (two) nsa_store(tb + NSA_BUF, kx2, vx2, tid);
                  __syncthreads();
                  if (j + 2 <= qb) nsa_load(kx, vx, kb + (size_t)(j + 2) * 64 * P1W, P1W, vb + (j + 2) * 64, SEQ, tid);
                  if (j + 3 <= qb) nsa_load(kx2, vx2, kb + (size_t)(j + 3) * 64 * P1W, P1W, vb + (j + 3) * 64, SEQ, tid);
                  if (j + 2 > qb) { const int jw = qb >= 8 ? qb - 8 : 0;
                      nsa_load(kx, vx, P1 + (size_t)b * SEQ * P1W + C_KWIN + (size_t)jw * 64 * P1W, P1W, VT + (size_t)(1 * BC + b) * 64 * SEQ + jw * 64, SEQ, tid); }
                  { const bool rowsel = ((mysel >> j) & 1ull) != 0ull;
                    if (__builtin_amdgcn_ballot_w64(rowsel) != 0ull) {
                        nsa_qk(tb, qr, p0, p1, r32, hi); if (j == qb) nsa_mask(p0, p1, hi, tq, -1);
                        nsa_softmax_pv(tb, p0, p1, m, l, o, wsf, lane, r32, hi, rowsel); } }
                  if (two) { const bool rowsel = ((mysel >> (j + 1)) & 1ull) != 0ull;
                    if (__builtin_amdgcn_ballot_w64(rowsel) != 0ull) {
                        nsa_qk(tb + NSA_BUF, qr, p0, p1, r32, hi); if (j + 1 == qb) nsa_mask(p0, p1, hi, tq, -1);
                        nsa_softmax_pv(tb + NSA_BUF, p0, p1, m, l, o, wsf, lane, r32, hi, rowsel); } } }
              const float lt = l + partner32(l, lane);
              nsa_rowaccum(acc, false, o, wsf, lt > 0.f ? g1 / lt : 0.f, r32, hi); }
            { const bf16* kb = P1 + (size_t)b * SEQ * P1W + C_KWIN; const bf16* vb = VT + (size_t)(1 * BC + b) * 64 * SEQ;
              m = -1e30f; l = 0.f;
#pragma unroll
              for (int i = 0; i < 16; ++i) { o[0][i] = 0.f; o[1][i] = 0.f; }
              const int j0 = qb >= 8 ? qb - 8 : 0;
              for (int j = j0; j <= qb; ++j) {
                  LAS unsigned char* tb = lds + par * NSA_STAGE; par ^= 1;
                  nsa_store(tb, kx, vx, tid); __syncthreads();
                  if (j < qb) nsa_load(kx, vx, kb + (size_t)(j + 1) * 64 * P1W, P1W, vb + (j + 1) * 64, SEQ, tid);
                  nsa_qk(tb, qr, p0, p1, r32, hi); if (j == qb || j == qb - 8) nsa_mask(p0, p1, hi, j == qb ? tq : 63, j == qb - 8 ? tq : -1);
                  nsa_softmax_pv(tb, p0, p1, m, l, o, wsf, lane, r32, hi, true); }
              const float lt = l + partner32(l, lane);
              nsa_rowaccum(acc, false, o, wsf, lt > 0.f ? g2 / lt : 0.f, r32, hi);
              nsa_flush(acc, Yc + ((size_t)b * SEQ + qb * 64 + 8 * wave) * 256, lane);
            }
        }
    }
    __syncthreads();
}

constexpr int SB_HEAD_LDS = 17408;
constexpr int SB_FLAG = 4 * SB_HEAD_LDS;
constexpr float SB_LOG2E = 1.4426950408889634f, SB_STOP = -100.0f * 1.4426950408889634f;
__device__ __forceinline__ void p_stick2(Frame& F, int nbusy) {
    const int tid = F.tid, lane = F.lane, wave = F.wave, r32 = lane & 31, hi = lane >> 5, h = wave & 3, qh = wave >> 2;
    LAS unsigned char* lds = F.lds + RING_OFF; LAS unsigned char* hl = lds + h * SB_HEAD_LDS; LAS int* flag = (LAS int*)(lds + SB_FLAG);
    const bf16* P1 = WSP(bf16, WS_P1); const bf16* VT = WSP(bf16, WS_VT) + (size_t)2 * BC * 64 * SEQ;
    bf16* Yb = WSP(bf16, WS_Y) + (size_t)MC * 256;
    const int tq = 32 * qh + r32;
    if (F.bx >= nbusy)
        for (int item = F.bx - nbusy; item < BC * 64; item += F.G - nbusy) {
            const int b = item >> 6, qb = item & 63;
            const size_t row = (size_t)b * SEQ + qb * 64 + tq;
            bf16x8v qr[4];
#pragma unroll
            for (int d0 = 0; d0 < 4; ++d0) qr[d0] = *(const bf16x8v*)(P1 + row * P1W + C_SBQ + h * 64 + d0 * 16 + hi * 8);
            f32x16 o[2], p0, p1;
#pragma unroll
            for (int i = 0; i < 16; ++i) { o[0][i] = 0.f; o[1][i] = 0.f; }
            float R = 0.f;
            const int skey = tid & 63, sc = tid >> 6, sd = tid >> 3, skc = tid & 7;
            v4u kx[4], vx[4];
#define SB_LOAD(jj) do { const bf16* kg_ = P1 + ((size_t)b * SEQ + (jj) * 64 + skey) * P1W + C_SBK + sc * 8; \
                _Pragma("unroll") for (int hh = 0; hh < 4; ++hh) { kx[hh] = *(const v4u*)(kg_ + hh * 64); vx[hh] = *(const v4u*)(VT + ((size_t)(hh * BC + b) * 64 + sd) * SEQ + (jj) * 64 + skc * 8); } } while (0)
            SB_LOAD(qb);
            for (int j = qb; j >= 0; --j) {
                __syncthreads();
                if (j < qb) { int live = 0;
#pragma unroll
                    for (int w = 0; w < 8; ++w) live |= flag[w];
                    if (!live) break; }
#pragma unroll
                for (int hh = 0; hh < 4; ++hh) { *(LAS v4u*)(lds + hh * SB_HEAD_LDS + sc * 1024 + skey * 16) = kx[hh]; { LAS v2u* vd = (LAS v2u*)(lds + hh * SB_HEAD_LDS + NSA_V + sd * NSA_VP + skc * 16); vd[0] = (v2u){vx[hh].x, vx[hh].y}; vd[1] = (v2u){vx[hh].z, vx[hh].w}; } }
                __syncthreads();
                if (j > 0) SB_LOAD(j - 1);
                nsa_qk(hl, qr, p0, p1, r32, hi);
#pragma unroll
                for (int i = 0; i < 16; ++i) { p0[i] *= NSA_C2; p1[i] *= NSA_C2; }
                v4u vv[8]; nsa_vload(hl, vv, r32, hi);
                const int lim = ((j == qb) ? tq : 64) - 4 * hi;
                float Town[8], Tp[8];
#pragma unroll
                for (int kt = 0; kt < 2; ++kt) { f32x16& pp = kt ? p1 : p0;
#pragma unroll
                    for (int g = 0; g < 4; ++g) { float L[4];
#pragma unroll
                        for (int e = 0; e < 4; ++e) { const int kk = 32 * kt + 8 * g + e; const float z = pp[4 * g + e];
                            const float tt = __builtin_amdgcn_logf(1.0f + __builtin_amdgcn_exp2f(-__builtin_fabsf(z)));
                            const float lb = fminf(z, 0.f) - tt; const bool ok = kk < lim;
                            L[e] = ok ? lb - z : 0.f; pp[4 * g + e] = ok ? lb : -INFINITY; }
                        const float E2 = L[3], E1 = E2 + L[2], E0 = E1 + L[1];
                        pp[4 * g + 2] += E2; pp[4 * g + 1] += E1; pp[4 * g] += E0;
                        Town[4 * kt + g] = E0 + L[0]; } }
#pragma unroll
                for (int k = 0; k < 8; ++k) Tp[k] = partner32(Town[k], lane);
                float suf = R;
#pragma unroll
                for (int k = 7; k >= 0; --k) { const float add = suf + (hi == 0 ? Tp[k] : 0.f); f32x16& pp = (k >> 2) ? p1 : p0; const int g = k & 3;
#pragma unroll
                    for (int e = 0; e < 4; ++e) pp[4 * g + e] = __builtin_amdgcn_exp2f(pp[4 * g + e] + add);
                    suf += Town[k] + Tp[k]; }
                R = suf;
                nsa_pv(vv, p0, p1, o);
                const bool alive = R >= SB_STOP;
                const unsigned long long bal = __builtin_amdgcn_ballot_w64(alive);
                if (lane == 0) flag[wave] = bal != 0ull ? 1 : 0;
            }
            { bf16* dst = Yb + ((size_t)b * SEQ + qb * 64 + 32 * qh + 4 * hi) * 256 + h * 64 + r32;
#pragma unroll
              for (int i = 0; i < 16; ++i) { dst[((i & 3) + 8 * (i >> 2)) * 256] = (bf16)f2bf(o[0][i]); dst[((i & 3) + 8 * (i >> 2)) * 256 + 32] = (bf16)f2bf(o[1][i]); } }
        }
#undef SB_LOAD
    __syncthreads();
}

__device__ __forceinline__ void p_sgu2(Frame& F, int layer) {
    LAS unsigned char* vnT = F.lds + RING_OFF;
    const bf16* P1 = WSP(bf16, WS_P1); bf16* Ya = WSP(bf16, WS_Y);
    const float* gain = F.in[3] + (size_t)layer * 256; const float* sw = F.in[4] + (size_t)layer * 4 * 128 * 128; const float* sb = F.in[5] + (size_t)layer * 4 * 128;
    const int lane = F.lane, wave = F.wave, r32 = lane & 31, hi = lane >> 5, g = wave & 3, db = wave >> 2;
    for (int item = F.vcu; item < MC / 128; item += F.G) {
        const size_t r0 = (size_t)item * 128;
        __syncthreads();
        { const f32x4 gg = ((const f32x4*)gain)[lane];
          for (int rr = 0; rr < 16; rr += 2) { const int r = wave * 16 + rr;
              const v2u ra = *(const v2u*)(P1 + (r0 + r) * P1W + C_V + 4 * lane), rb = *(const v2u*)(P1 + (r0 + r + 1) * P1W + C_V + 4 * lane);
              const float a0 = bflo(ra.x), a1 = bfhi(ra.x), a2 = bflo(ra.y), a3 = bfhi(ra.y), b0 = bflo(rb.x), b1 = bfhi(rb.x), b2 = bflo(rb.y), b3 = bfhi(rb.y);
              const float sa = 1.0f / sqrtf(wave_sum((a0 * a0 + a1 * a1) + (a2 * a2 + a3 * a3), lane) * (1.f / 256.f) + EPS);
              const float sb_ = 1.0f / sqrtf(wave_sum((b0 * b0 + b1 * b1) + (b2 * b2 + b3 * b3), lane) * (1.f / 256.f) + EPS);
              LAS unsigned* q = (LAS unsigned*)(vnT + (4 * lane) * 272 + r * 2);
              q[0] = pk2(a0 * sa * gg.x, b0 * sb_ * gg.x); q[68] = pk2(a1 * sa * gg.y, b1 * sb_ * gg.y); q[136] = pk2(a2 * sa * gg.z, b2 * sb_ * gg.z); q[204] = pk2(a3 * sa * gg.w, b3 * sb_ * gg.w); } }
        __syncthreads();
        const int ch = g * 64 + db * 32 + r32;
        for (int tb = 0; tb < 4; ++tb) {
            f32x16 acc;
#pragma unroll
            for (int i = 0; i < 16; ++i) acc[i] = 0.f;
            const int t = 32 * tb + r32; const float* wrow = sw + ((size_t)g * 128 + t) * 128;
            f32x4 wq[8][2];
#pragma unroll
            for (int ks = 0; ks < 8; ++ks) if (ks < 2 * tb + 2) { wq[ks][0] = *(const f32x4*)(wrow + 16 * ks + 8 * hi); wq[ks][1] = *(const f32x4*)(wrow + 16 * ks + 8 * hi + 4); }
#pragma unroll
            for (int ks = 0; ks < 8; ++ks) if (ks < 2 * tb + 2) {
                const int s0 = 16 * ks + 8 * hi;
                const f32x4 w0 = wq[ks][0], w1 = wq[ks][1];
                const v4u a = (v4u){pk2(s0 <= t ? w0.x : 0.f, s0 + 1 <= t ? w0.y : 0.f), pk2(s0 + 2 <= t ? w0.z : 0.f, s0 + 3 <= t ? w0.w : 0.f),
                                    pk2(s0 + 4 <= t ? w1.x : 0.f, s0 + 5 <= t ? w1.y : 0.f), pk2(s0 + 6 <= t ? w1.z : 0.f, s0 + 7 <= t ? w1.w : 0.f)};
                const bf16x8v bfr = *(const LAS bf16x8v*)(vnT + ch * 272 + s0 * 2);
                acc = __builtin_amdgcn_mfma_f32_32x32x16_bf16(__builtin_bit_cast(bf16x8v, a), bfr, acc, 0, 0, 0); }
            float uu[16], bb[16];
#pragma unroll
            for (int i = 0; i < 16; ++i) { const int tt = 32 * tb + (i & 3) + 8 * (i >> 2) + 4 * hi; uu[i] = bf1(P1[(r0 + tt) * P1W + C_U + ch]); bb[i] = sb[g * 128 + tt]; }
#pragma unroll
            for (int i = 0; i < 16; ++i) { const int tt = 32 * tb + (i & 3) + 8 * (i >> 2) + 4 * hi;
                Ya[(r0 + tt) * 256 + ch] = (bf16)f2bf(uu[i] * (acc[i] + bb[i])); }
        }
    }
    __syncthreads();
}

struct Args { const float* in[20]; float* out; unsigned char* ws; int lo, hi, li, rep; };
#ifndef TILED_FFN1
#define TILED_FFN1 0
#endif
#ifndef PG8_ALIGN_EPI
#define PG8_ALIGN_EPI true
#endif
#ifndef PG8_SP2
#define PG8_SP2 true
#endif
#ifndef WGM_PROJ
#define WGM_PROJ PG8_WGM
#endif
#ifndef WGM_FFN1
#define WGM_FFN1 PG8_WGM
#endif
#ifndef WGM_FFN2
#define WGM_FFN2 PG8_WGM
#endif
#ifndef WGM_MOE1
#define WGM_MOE1 PG8_WGM
#endif
#ifndef WGM_MOE2
#define WGM_MOE2 PG8_WGM
#endif
#ifndef FFN_CHUNKS
#define FFN_CHUNKS 2
#endif
#ifndef REP_GEMM
#define REP_GEMM 1
#endif
#ifndef REP_STICK
#define REP_STICK 1
#endif
#ifndef REP_NSA
#define REP_NSA 1
#endif
#ifndef REP_SGU
#define REP_SGU 1
#endif
#ifndef REP_NORM
#define REP_NORM 1
#endif
template <class Epi, class Sched> __device__ __forceinline__ void run_gemm(Frame& F, const bf16* A, const bf16* Bt, int M, int N, int K, const Sched& S, Epi E, bool rotate = true, int tiled = 0, int ld = 0) {
    const int nt_ = K / 64;
#ifdef PG8_KROT
    const int rot_ = rotate ? 2 * (((F.bx & 7) * (nt_ / 2)) / 8) : 0;
#else
    const int rot_ = 0;
#endif
    pg8::Gemm g{A, Bt, M, N, K + F.zs, F.tid, rot_ + F.zs, tiled + F.zs, ld + F.zs, nullptr};
    if (F.rep) E.set_scale0();
    pg8::gemm_phase<Epi, Sched, PG8_ALIGN_EPI, PG8_SP2>(F.lds + RING_OFF, g, S, E);
}
template <class Epi, class Sched> __device__ __forceinline__ void run_gemm_gather(Frame& F, const bf16* A, const int* gidx, const bf16* Bt, int M, int N, int K, const Sched& S, Epi E) {
    pg8::Gemm g{A, Bt, M, N, K + F.zs, F.tid, F.zs, F.zs, F.zs, gidx};
    if (F.rep) E.set_scale0();
    pg8::gemm_phase<Epi, Sched, PG8_ALIGN_EPI, PG8_SP2, true>(F.lds + RING_OFF, g, S, E);
}
__global__ void __launch_bounds__(NWAVES * 64, 2) mk_fwd(Args args) {
    extern __shared__ __attribute__((aligned(16))) unsigned char lds[];
    Frame F0;
    F0.lds = (LAS unsigned char*)lds;
    F0.tid = threadIdx.x; F0.lane = F0.tid & 63; F0.wave = __builtin_amdgcn_readfirstlane(F0.tid >> 6);
    F0.G = gridDim.x; F0.bx = blockIdx.x; F0.vcu = (F0.G % 8 == 0) ? (F0.bx % 8) * (F0.G / 8) + F0.bx / 8 : F0.bx; F0.zv = 0; F0.zs = 0;
    F0.rep = args.rep; F0.ws = args.ws; F0.ctl = (unsigned*)(args.ws + WS_CTL); F0.in = args.in; F0.out = args.out;
    for (int u = F0.tid; u < (LDS_BYTES - LDSCTL_OFF) / 4; u += NWAVES * 64) ((LAS unsigned*)(F0.lds + LDSCTL_OFF))[u] = 0u;
    __syncthreads();
    const int lo = args.lo, hi = args.hi;
    XcdBarrier bar; bar.bar = F0.ctl + CW_BAR + args.li * XCD_BAR_WORDS; bar.x = 0; bar.st = nullptr; bar.w = 0; bar.z = 0;
    if (hi - lo > 1) bar = xcd_barrier_post(F0.ctl + CW_BAR + args.li * XCD_BAR_WORDS, (volatile LAS unsigned*)(F0.lds + MISC_OFF) + 8);
    int step = 0;
#define STEP_BEGIN if (step >= lo && step < hi) { Frame F = F0; { int zv_, zs_; asm volatile("v_mov_b32 %0, 0" : "=v"(zv_)); asm volatile("s_mov_b32 %0, 0" : "=s"(zs_)); \
        F.zv = zv_; F.zs = zs_; F.lane = (int)__builtin_amdgcn_mbcnt_hi(~0u, __builtin_amdgcn_mbcnt_lo(~0u, (unsigned)zv_)); F.wave = F0.wave + zs_; F.tid = F.wave * 64 + F.lane; F.bx = F.bx + zs_; \
        F.vcu = F0.vcu + zs_; F.G = F0.G + zs_; F.lds = (LAS unsigned char*)lds + zs_; F.ws = F0.ws + zs_; F.ctl = F0.ctl + zs_; F.in = F0.in + zs_; F.out = F0.out + zs_; }
#ifdef PROBE_XBAR
#define STEP_END   if (step + 1 < hi) { unsigned zb_; asm volatile("v_mov_b32 %0, 0" : "=v"(zb_)); bar.z = zb_; xcd_barrier(bar); xcd_barrier(bar); } } ++step;
#else
#define STEP_END   if (step + 1 < hi) { unsigned zb_; asm volatile("v_mov_b32 %0, 0" : "=v"(zb_)); bar.z = zb_; xcd_barrier(bar); } } ++step;
#endif

    for (int layer = 0; layer < DEPTH; ++layer) {
        const int jj = layer >> 1;
        STEP_BEGIN
            p_convert(F, layer);
            if (layer == 0) p_norm<3, false>(F, F.in[0], nullptr, nullptr, 0); else p_rstd(F);
        STEP_END
        for (int c = 0; c < NCHUNK; ++c) {
            STEP_BEGIN
                pg8::StaticOrder S; S.init(MC, NPROJ, F.G, F.bx, WGM_PROJ);
                pg8::EpiProj E{WSP(bf16, WS_P1), WSP(bf16, WS_G), WSP(float, WS_RSTD) + (size_t)c * MC};
                run_gemm(F, (layer == 0 ? WSP(bf16, WS_HN) : WSP(bf16, WS_H)) + (size_t)c * MC * DM, WSP(bf16, WS_WIN), MC, NPROJ, DM, S, E);
            STEP_END
            STEP_BEGIN
                p_prep(F);
            STEP_END
            STEP_BEGIN
                LAS int* tab = (LAS int*)(F.lds + TAB_OFF);
                __syncthreads(); if (F.tid < 16) tab[F.tid] = F.tid >> 3; __syncthreads();
                pg8::GroupedOrder S; S.so.init(2 * 2048, 512, F.G, F.bx); S.tile_e = tab; S.nN = 2;
                pg8::EpiF32 E{WSP(float, WS_UL), 512, 2};
                run_gemm(F, WSP(bf16, WS_KVC), WSP(bf16, WS_WC1), 2 * 2048, 512, DM, S, E);
                p_sgu2(F, layer);
                p_stick2(F, F.G > 64 ? 32 : 0);
            STEP_END
            STEP_BEGIN
                p_cmpfin(F, layer);
            STEP_END
            STEP_BEGIN
#ifdef OLD_NSA
                p_nsa(F);
#else
                p_nsa2(F);
#endif
            STEP_END
            STEP_BEGIN
                pg8::MergeOrder S; S.so.init(MC, DM, F.G, F.bx); S.nmt = MC / 256;
                pg8::EpiMerge E{WSP(bf16, WS_G), WSP(bf16, WS_MG), MC / 256};
                run_gemm(F, WSP(bf16, WS_Y), WSP(bf16, WS_WBR), 3 * MC, 3 * DM, 256, S, E);
            STEP_END
            STEP_BEGIN
                pg8::StaticOrder S; S.init(MC, DM, F.G, F.bx);
                pg8::EpiResid E{layer == 0 ? F.in[0] + (size_t)c * MC * DM : nullptr, WSP(bf16, WS_H) + (size_t)c * MC * DM, DM, 1.0f};
                run_gemm(F, WSP(bf16, WS_MG), WSP(bf16, WS_WOUT), MC, DM, DM, S, E);
            STEP_END
        }
        if ((layer & 1) == 0) {
            STEP_BEGIN
                p_rstd(F);
            STEP_END
            for (int c = 0; c < FFN_CHUNKS; ++c) {
                constexpr int MF = MTOK / FFN_CHUNKS;
                STEP_BEGIN
                    pg8::StaticOrder S; S.init(MF, NFF1, F.G, F.bx, WGM_FFN1);
                    pg8::EpiSwiGLU E{WSP(bf16, WS_HID), DFFP, nullptr, NFF1 / 256, WSP(float, WS_RSTD) + (size_t)c * MF};
                    run_gemm(F, WSP(bf16, WS_H) + (size_t)c * MF * DM, WSP(bf16, WS_WF1), MF, NFF1, DM, S, E, true, TILED_FFN1);
                STEP_END
                STEP_BEGIN
                    pg8::StaticOrder S; S.init(MF, DM, F.G, F.bx, WGM_FFN2);
                    pg8::EpiResid E{nullptr, WSP(bf16, WS_H) + (size_t)c * MF * DM, DM, 1.0f};
                    run_gemm(F, WSP(bf16, WS_HID), WSP(bf16, WS_WF2), MF, DM, DFFP, S, E);
                STEP_END
            }
        } else {
            STEP_BEGIN
                p_norm<1, true>(F, WSP(bf16, WS_H), F.in[11] + (size_t)layer * DM, F.in[15] + (size_t)jj * DM * NEXP, jj, Q8_HN);
            STEP_END
#ifdef ABL_DENSE_MOE
            for (int e = 0; e < NEXP; ++e) {
                STEP_BEGIN
                    pg8::StaticOrder S; S.init(MTOK, NMOE1, F.G, F.bx);
                    pg8::EpiSwiGLU E{WSP(bf16, WS_SCR + 8 * MiB), DFE, WSP(float, WS_SCR + 4 * MiB) + (size_t)e * MTOK, NMOE1 / 256, WSP(float, WS_RSTD)};
                    run_gemm(F, WSP(bf16, WS_HN), WSP(bf16, WS_WF1) + (size_t)e * NMOE1 * DM, MTOK, NMOE1, DM, S, E);
                STEP_END
                STEP_BEGIN
                    pg8::StaticOrder S; S.init(MTOK, DM, F.G, F.bx);
                    pg8::EpiResid E{nullptr, WSP(bf16, WS_H), DM, 1.0f};
                    run_gemm(F, WSP(bf16, WS_SCR + 8 * MiB), WSP(bf16, WS_WF2) + (size_t)e * DM * DFE, MTOK, DM, DFE, S, E);
                STEP_END
            }
#else
            STEP_BEGIN
                p_gather(F, jj, 0, 0); p_gather(F, jj, 0, 1);
            STEP_END
            for (int c = 0; c < NCHUNK; ++c) {
                STEP_BEGIN
                    int dealt = 0;
                    for (int r = 0; r < 2; ++r) {
                        const int T = moe_table(F, jj, c, r);
                        int cw = F.bx - dealt % F.G; if (cw < 0) cw += F.G;
                        pg8::GroupedOrder S; S.so.init(T * 256, NMOE1, F.G, cw, WGM_MOE1); S.tile_e = (LAS int*)(F.lds + TAB_OFF); S.nN = NMOE1 / 256;
                        pg8::EpiSwiGLU E{WSP(bf16, WS_HIDM) + (size_t)r * SLOTS * DFE, DFE, WSP(float, WS_WSLOT) + (c * 2 + r) * SLOTS, NMOE1 / 256, WSP(float, WS_RSLOT) + (c * 2 + r) * SLOTS};
                        run_gemm_gather(F, WSP(bf16, WS_H), WSP(int, WS_TOKMAP) + (c * 2 + r) * SLOTS, WSP(bf16, WS_WF1), T * 256, NMOE1, DM, S, E);
                        dealt += T * (NMOE1 / 256);
                        __syncthreads();
                    }
                STEP_END
                for (int r = 0; r < 2; ++r) {
                    STEP_BEGIN
                        const int T = moe_table(F, jj, c, r);
                        const int nwg = T * (DM / 256), R = nwg % F.G, full = nwg - R;
                        const int NS = (4 * R <= F.G) ? 4 : 2;
                        const bool split = (hi - lo > 1) && R > 0 && NS * R <= F.G && !F.rep;
                        int* tokm = WSP(int, WS_TOKMAP) + (c * 2 + r) * SLOTS; float* TB = WSP(float, WS_TB); const bf16* HIDr = WSP(bf16, WS_HIDM) + (size_t)r * SLOTS * DFE;
                        { pg8::LimitOrder S; S.so.init(T * 256, DM, F.G, F.bx, WGM_MOE2); S.limit = split ? full : nwg;
                          pg8::GroupedLimit GS{S, (LAS int*)(F.lds + TAB_OFF), DM / 256};
                          pg8::EpiScatter E{WSP(bf16, WS_H), tokm, DM / 256, 1.0f};
                          run_gemm(F, HIDr, WSP(bf16, WS_WF2), T * 256, DM, DFE, GS, E, false); }
                        const bool more = r == 1 && c + 1 < NCHUNK;
                        if (split) {
                            const int KP = DFE / NS;
                            if (F.bx < NS * R) { const int Lx = full + F.bx / NS, kp = F.bx % NS;
                                pg8::StaticOrder so; so.init(T * 256, DM, F.G, Lx % F.G, WGM_MOE2); pg8::Unit un; so.next(Lx / F.G, un);
                                un.pn += ((LAS int*)(F.lds + TAB_OFF))[un.pm] * (DM / 256);
                                pg8::SingleOrder S1{un};
                                if (kp == 0) { pg8::EpiScatter E{WSP(bf16, WS_H), tokm, DM / 256, 1.0f};
                                    run_gemm(F, HIDr, WSP(bf16, WS_WF2), T * 256, DM, KP, S1, E, false, 0, DFE); }
                                else { pg8::EpiTile E{TB + ((size_t)(Lx - full) * 3 + (kp - 1)) * 65536};
                                    run_gemm(F, HIDr + kp * KP, WSP(bf16, WS_WF2) + kp * KP, T * 256, DM, KP, S1, E, false, 0, DFE); } }
                            if (more) { p_gather(F, jj, c + 1, 0, NS * R); p_gather(F, jj, c + 1, 1, NS * R); }
                            { unsigned zb_; asm volatile("v_mov_b32 %0, 0" : "=v"(zb_)); bar.z = zb_; xcd_barrier(bar); }
                            for (int it = (F.vcu * NWAVES + F.wave); it < R * 256; it += F.G * NWAVES) { const int j = it >> 8, row = it & 255, Lx = full + j;
                                pg8::StaticOrder so; so.init(T * 256, DM, F.G, Lx % F.G, WGM_MOE2); pg8::Unit un; so.next(Lx / F.G, un);
                                const int t = tokm[un.pm * 256 + row];
                                if (t >= 0) { v2u* hp = (v2u*)(WSP(bf16, WS_H) + (size_t)t * DM + un.pn * 256) + F.lane; const v2u hv = *hp; f32x4 a = (f32x4){bflo(hv.x), bfhi(hv.x), bflo(hv.y), bfhi(hv.y)};
                                    for (int q = 0; q < NS - 1; ++q) a = a + ((const f32x4*)(TB + ((size_t)j * 3 + q) * 65536 + row * 256))[F.lane];
                                    *hp = (v2u){pk2(a.x, a.y), pk2(a.z, a.w)}; } }
                        } else if (!F.rep && more) { p_gather(F, jj, c + 1, 0, R); p_gather(F, jj, c + 1, 1, R); }
                    STEP_END
                }
            }
#endif
        }
    }
    STEP_BEGIN
        p_norm<2, true>(F, WSP(bf16, WS_H), F.in[19], nullptr, 0);
    STEP_END
#undef STEP_BEGIN
#undef STEP_END
}

#ifndef MK_STEPS_PER_LAUNCH
#define MK_STEPS_PER_LAUNCH 1
#endif
extern "C" void kernel_launch(void* const* d_in, const int* in_sizes, int n_in, void* d_out, int out_size, void* d_ws, size_t ws_size, hipStream_t stream) {
    static int grid = 0;
    if (grid == 0) {
        if (n_in != 20 || in_sizes[0] != MTOK * DM || out_size != MTOK * DM || ws_size < WS_END) { fprintf(stderr, "kernel_launch: unexpected shapes (n_in %d, in0 %d, out %d, ws %zu)\n", n_in, n_in > 0 ? in_sizes[0] : -1, out_size, ws_size); grid = -1; return; }
        int dev = 0, cus = 0, per_cu = 0;
        if (hipGetDevice(&dev) != hipSuccess || hipDeviceGetAttribute(&cus, hipDeviceAttributeMultiprocessorCount, dev) != hipSuccess) { grid = -1; return; }
        if (hipFuncSetAttribute((const void*)mk_fwd, hipFuncAttributeMaxDynamicSharedMemorySize, LDS_BYTES) != hipSuccess) { fprintf(stderr, "kernel_launch: hipFuncSetAttribute failed\n"); grid = -1; return; }
        if (hipOccupancyMaxActiveBlocksPerMultiprocessor(&per_cu, (const void*)mk_fwd, NWAVES * 64, LDS_BYTES) != hipSuccess || per_cu < 1) fprintf(stderr, "kernel_launch: occupancy query reports %d\n", per_cu);
        (void)hipGetLastError();
        grid = cus;
    }
    if (grid < 0) return;
    if (hipMemsetAsync((char*)d_ws + WS_CTL, 0, CTL_ZERO_BYTES, stream) != hipSuccess) return;
    Args a{};
    for (int i = 0; i < 20; ++i) a.in[i] = (const float*)d_in[i];
    a.out = (float*)d_out; a.ws = (unsigned char*)d_ws; a.rep = 0;
    #ifdef ABL_DENSE_MOE
    constexpr int NSTEPS = 2 * (1 + NCHUNK * 8 + 3) + 2 * (1 + NCHUNK * 8 + 1 + NEXP * 2) + 1;
#else
    constexpr int NSTEPS = 2 * (1 + NCHUNK * 7 + 1 + 2 * FFN_CHUNKS) + 2 * (1 + NCHUNK * 7 + 2 + NCHUNK * 3) + 1;
#endif
    int li = 0;
#ifdef REPMASK
    static int kinds[256]; int ns = 0;
    for (int layer = 0; layer < DEPTH; ++layer) { kinds[ns++] = 0;
        for (int c = 0; c < NCHUNK; ++c) for (int q = 1; q <= 8; ++q) if (q != 5) kinds[ns++] = q;
        if ((layer & 1) == 0) { kinds[ns++] = 9; for (int c = 0; c < FFN_CHUNKS; ++c) { kinds[ns++] = 10; kinds[ns++] = 11; } }
        else { kinds[ns++] = 12; kinds[ns++] = 17; for (int c = 0; c < NCHUNK; ++c) { kinds[ns++] = 14; kinds[ns++] = 13; kinds[ns++] = 13; } } }
    kinds[ns++] = 16;
    for (int s = 0; s < NSTEPS; ++s) { const int reps = ((REPMASK >> kinds[s]) & 1) ? 2 : 1;
        for (int r = 0; r < reps; ++r) { a.lo = s; a.hi = s + 1; a.li = 0; a.rep = r;
            hipLaunchKernelGGL(mk_fwd, dim3(grid), dim3(NWAVES * 64), LDS_BYTES, stream, a); } }
    (void)li;
#else
    for (int s = 0; s < NSTEPS; s += MK_STEPS_PER_LAUNCH) {
        a.lo = s; a.hi = (s + MK_STEPS_PER_LAUNCH < NSTEPS) ? s + MK_STEPS_PER_LAUNCH : NSTEPS; a.li = (MK_STEPS_PER_LAUNCH > 1) ? li : 0; ++li;
        hipLaunchKernelGGL(mk_fwd, dim3(grid), dim3(NWAVES * 64), LDS_BYTES, stream, a);
        if (hipPeekAtLastError() != hipSuccess) { fprintf(stderr, "kernel_launch: launch failed\n"); break; }
    }
#endif
}
```

```cpp
#define MK_STEPS_PER_LAUNCH 1000
#define PG8_WGM 4
#define FFN_CHUNKS 1
#define PG8_KROT 1
#include <hip/hip_runtime.h>
#include <cstdio>
#include <cstdint>
#include <cmath>
#ifndef PG8_AUX_A
#define PG8_AUX_A 0
#endif
#ifndef PG8_AUX_B
#define PG8_AUX_B 0
#endif
#ifndef PG8_WGM
#define PG8_WGM 8
#endif
namespace pg8 {
#define PG8_LAS __attribute__((address_space(3)))
typedef unsigned short bf16_t;
typedef short bf16x8 __attribute__((ext_vector_type(8)));
typedef float f32x4 __attribute__((ext_vector_type(4)));
typedef unsigned u32x4 __attribute__((ext_vector_type(4)));
constexpr int BM = 256, BK = 64, HALF = 128, HTB = HALF * BK * 2  , STAGE_BYTES = 8 * HTB, NXCD = 8, WGM = PG8_WGM;

__host__ __device__ __forceinline__ int lds_byte(int r, int c) { const int st = (r >> 4) * 2 + (c >> 5), rr = r & 15, cc = c & 31, ob = rr * 64 + cc * 2; return st * 1024 + (ob ^ (((ob >> 9) & 1) << 5)); }
__host__ __device__ __forceinline__ void stage_rc(int b, int& R, int& C) { const int st = b / 1024, sb = b % 1024, swz = sb ^ (((sb >> 9) & 1) << 5); R = (st >> 1) * 16 + swz / 64; C = (st & 1) * 32 + (swz % 64) / 2; }
__host__ __device__ __forceinline__ int perm32(int rho) { const int n = rho >> 4, i = rho & 15; return 8 * (i >> 2) + 4 * n + (i & 3); }

struct Unit { int pm, pn; };
struct Gemm { const bf16_t* A; const bf16_t* Bt; int M, N, K; int zv; int rot; int tiled; int ld; const int* gidx; };

struct StaticOrder {
    int nM, nN, nwg, G, c, wgm;
    __host__ __device__ __forceinline__ void init(int M, int N, int G_, int c_, int wgm_ = WGM) { nM = M / BM; nN = N / BM; nwg = nM * nN; G = G_; c = c_; wgm = wgm_; }
    __host__ __device__ __forceinline__ bool next(int i, Unit& u) const {
        const long L = (long)i * G + c; if (L >= nwg) return false;
        int wgid = (int)L; { const int q = nwg / NXCD, r = nwg % NXCD, xcd = wgid % NXCD, off = wgid / NXCD; wgid = (xcd < r ? xcd * (q + 1) : r * (q + 1) + (xcd - r) * q) + off; }
        const int nig = wgm * nN, gid = wgid / nig, fm = gid * wgm, gsz = (nM - fm) < wgm ? (nM - fm) : wgm;
        u.pm = fm + ((wgid % nig) % gsz); u.pn = (wgid % nig) / gsz; return true;
    }
    __device__ __forceinline__ void a_ready(const Unit&) const {}
    __device__ __forceinline__ void done(const Unit&) const {}
};

__device__ __forceinline__ unsigned cvt_pk_bf16(float lo, float hi) { unsigned r; asm volatile("v_cvt_pk_bf16_f32 %0, %1, %2" : "=v"(r) : "v"(lo), "v"(hi)); return r; }
typedef float f32x2 __attribute__((ext_vector_type(2)));

__device__ __forceinline__ float fast_sigmoid(float x) { return __builtin_amdgcn_rcpf(1.0f + __builtin_amdgcn_exp2f(-1.4426950408889634f * x)); }
__device__ __forceinline__ float gelu_tanh(float x) {
    const float u2 = 1.5957691216057308f * (x + 0.044715f * x * x * x);
    return x * fast_sigmoid(u2);
}
__device__ __forceinline__ float bf_lo(unsigned u) { return __builtin_bit_cast(float, u << 16); }
__device__ __forceinline__ float bf_hi(unsigned u) { return __builtin_bit_cast(float, u & 0xffff0000u); }

#ifdef PG8_NT_OUT
#define PG8_STORE_OUT(p, v) __builtin_nontemporal_store((v), (p))
#else
#define PG8_STORE_OUT(p, v) (*(p) = (v))
#endif
struct EpiProj {
    static constexpr bool PERM = true, AFTER_DRAIN = false, MID = false; static constexpr int MID_TILES = 1; __device__ __forceinline__ bool keep_acc(const Unit&) const { return false; } __device__ __forceinline__ void set_scale0() {}
    bf16_t* P1; bf16_t* G; const float* rstd;
    __device__ __forceinline__ void operator()(const f32x4 (&acc)[2][2][4][2], const Unit& u, int wr, int wc, int fr, int fq) const {
        const int row0 = u.pm * BM + wr * 64 + fr;
        float rsv[8];
#pragma unroll
        for (int q = 0; q < 8; ++q) rsv[q] = rstd[row0 + (q >> 2) * HALF + (q & 3) * 16];
        bf16_t* base; int ldc, colt, act0, act1;
        if (u.pn < 8) { base = P1; ldc = 2048; colt = u.pn * BM; act0 = (u.pn < 2) ? 1 : 0; act1 = (u.pn == 7) ? 2 : act0; }
        else { base = G; ldc = 3072; colt = (u.pn - 8) * BM; act0 = 2; act1 = 2; }
        const int col0 = colt + wc * 32 + 8 * fq;
#pragma unroll
        for (int ai = 0; ai < 2; ++ai)
#pragma unroll
            for (int m = 0; m < 4; ++m) { bf16_t* rowp = base + (size_t)(row0 + ai * HALF + m * 16) * ldc + col0;
#pragma unroll
                for (int bj = 0; bj < 2; ++bj) { f32x4 v0 = acc[ai][bj][m][0] * rsv[ai * 4 + m], v1 = acc[ai][bj][m][1] * rsv[ai * 4 + m]; const int act = bj ? act1 : act0;
                    if (act == 1) {
#pragma unroll
                        for (int e = 0; e < 4; ++e) { v0[e] = gelu_tanh(v0[e]); v1[e] = gelu_tanh(v1[e]); } }
                    else if (act == 2) {
#pragma unroll
                        for (int e = 0; e < 4; ++e) { v0[e] = fast_sigmoid(v0[e]); v1[e] = fast_sigmoid(v1[e]); } }
                    u32x4 w; w.x = cvt_pk_bf16(v0[0], v0[1]); w.y = cvt_pk_bf16(v0[2], v0[3]); w.z = cvt_pk_bf16(v1[0], v1[1]); w.w = cvt_pk_bf16(v1[2], v1[3]);
                    *(u32x4*)(rowp + bj * HALF) = w; } }
    }
};
struct EpiMerge {
    static constexpr bool PERM = true, AFTER_DRAIN = false, MID = false; static constexpr int MID_TILES = 1; __device__ __forceinline__ void set_scale0() {}
    const bf16_t* G; bf16_t* MG; int nmt;
    __device__ __forceinline__ bool keep_acc(const Unit& u) const { return (u.pn >> 2) < 2; }
    __device__ __forceinline__ void operator()(f32x4 (&acc)[2][2][4][2], const Unit& u, int wr, int wc, int fr, int fq) const {
        const int i = u.pn >> 2, pn = u.pn & 3, pm = u.pm - i * nmt;
        const int row0 = pm * BM + wr * 64 + fr, col0 = pn * BM + wc * 32 + 8 * fq;
#pragma unroll
        for (int ai = 0; ai < 2; ++ai)
#pragma unroll
            for (int mp = 0; mp < 2; ++mp) {
                u32x4 g[4], h[4];
#pragma unroll
                for (int q = 0; q < 4; ++q) { const int m = 2 * mp + (q >> 1), bj = q & 1; const size_t row = (size_t)(row0 + ai * HALF + m * 16); const int col = col0 + bj * HALF;
                    g[q] = *(const u32x4*)(G + row * 3072 + i * 1024 + col);
                    if (i < 2) h[q] = *(const u32x4*)(G + row * 3072 + (i + 1) * 1024 + col); else h[q] = (u32x4){0u, 0u, 0u, 0u}; }
#pragma unroll
                for (int q = 0; q < 4; ++q) { const int m = 2 * mp + (q >> 1), bj = q & 1; const size_t row = (size_t)(row0 + ai * HALF + m * 16); const int col = col0 + bj * HALF;
                    f32x4& v0 = acc[ai][bj][m][0]; f32x4& v1 = acc[ai][bj][m][1];
                    float f[8] = {bf_lo(g[q].x), bf_hi(g[q].x), bf_lo(g[q].y), bf_hi(g[q].y), bf_lo(g[q].z), bf_hi(g[q].z), bf_lo(g[q].w), bf_hi(g[q].w)};
                    if (i < 2) { const float d[8] = {bf_lo(h[q].x), bf_hi(h[q].x), bf_lo(h[q].y), bf_hi(h[q].y), bf_lo(h[q].z), bf_hi(h[q].z), bf_lo(h[q].w), bf_hi(h[q].w)};
#pragma unroll
                        for (int e = 0; e < 8; ++e) f[e] = fmaxf(f[e], 1e-20f) * __builtin_amdgcn_rcpf(fmaxf(d[e], 1e-20f)); }
                    else {
#pragma unroll
                        for (int e = 0; e < 8; ++e) f[e] = fmaxf(f[e], 1e-20f); }
                    v0[0] *= f[0]; v0[1] *= f[1]; v0[2] *= f[2]; v0[3] *= f[3]; v1[0] *= f[4]; v1[1] *= f[5]; v1[2] *= f[6]; v1[3] *= f[7];
                    if (i == 2) { u32x4 w; w.x = cvt_pk_bf16(v0[0], v0[1]); w.y = cvt_pk_bf16(v0[2], v0[3]); w.z = cvt_pk_bf16(v1[0], v1[1]); w.w = cvt_pk_bf16(v1[2], v1[3]);
                        *(u32x4*)(MG + row * 1024 + col) = w; } } }
    }
};
typedef unsigned u32x2 __attribute__((ext_vector_type(2)));
struct EpiResid {
    static constexpr bool PERM = false, AFTER_DRAIN = false, MID = false; static constexpr int MID_TILES = 1; __device__ __forceinline__ bool keep_acc(const Unit&) const { return false; } __device__ __forceinline__ void set_scale0() { scale = 0.f; x32 = nullptr; }
    const float* x32; bf16_t* out; int ldc; float scale;
    __device__ __forceinline__ void operator()(const f32x4 (&acc)[2][2][4][2], const Unit& u, int wr, int wc, int fr, int fq) const {
        const int row0 = u.pm * BM + wr * 64 + fr, col0 = u.pn * BM + wc * 32 + 4 * fq;
#pragma unroll
        for (int ai = 0; ai < 2; ++ai)
#pragma unroll
            for (int mp = 0; mp < 2; ++mp) {
                f32x4 b[8];
                if (x32) {
#pragma unroll
                    for (int q = 0; q < 8; ++q) { const int m = 2 * mp + (q >> 2), bj = (q >> 1) & 1, n = q & 1;
                        b[q] = *(const f32x4*)(x32 + (size_t)(row0 + ai * HALF + m * 16) * ldc + col0 + bj * HALF + n * 16); }
                } else {
                    u32x2 t[8];
#pragma unroll
                    for (int q = 0; q < 8; ++q) { const int m = 2 * mp + (q >> 2), bj = (q >> 1) & 1, n = q & 1;
                        t[q] = *(const u32x2*)(out + (size_t)(row0 + ai * HALF + m * 16) * ldc + col0 + bj * HALF + n * 16); }
#pragma unroll
                    for (int q = 0; q < 8; ++q) b[q] = (f32x4){bf_lo(t[q].x), bf_hi(t[q].x), bf_lo(t[q].y), bf_hi(t[q].y)};
                }
#pragma unroll
                for (int q = 0; q < 8; ++q) { const int m = 2 * mp + (q >> 2), bj = (q >> 1) & 1, n = q & 1; const f32x4 r = b[q] + acc[ai][bj][m][n] * scale;
                    *(u32x2*)(out + (size_t)(row0 + ai * HALF + m * 16) * ldc + col0 + bj * HALF + n * 16) = (u32x2){cvt_pk_bf16(r.x, r.y), cvt_pk_bf16(r.z, r.w)}; } }
    }
};
struct EpiF32 {
    static constexpr bool PERM = false, AFTER_DRAIN = false, MID = false; static constexpr int MID_TILES = 1; __device__ __forceinline__ bool keep_acc(const Unit&) const { return false; } __device__ __forceinline__ void set_scale0() {}
    float* O; int ldc, nN;
    __device__ __forceinline__ void operator()(const f32x4 (&acc)[2][2][4][2], const Unit& u, int wr, int wc, int fr, int fq) const {
        const int row0 = u.pm * BM + wr * 64 + fr, col0 = (u.pn % nN) * BM + wc * 32 + 4 * fq;
#pragma unroll
        for (int ai = 0; ai < 2; ++ai)
#pragma unroll
            for (int m = 0; m < 4; ++m) { const size_t off = (size_t)(row0 + ai * HALF + m * 16) * ldc + col0;
#pragma unroll
                for (int bj = 0; bj < 2; ++bj)
#pragma unroll
                    for (int n = 0; n < 2; ++n) *(f32x4*)(O + off + bj * HALF + n * 16) = acc[ai][bj][m][n]; }
    }
};
#ifdef EMU_FP8_HID
__device__ __forceinline__ float Q8H(float x) { const int p = __builtin_amdgcn_cvt_pk_fp8_f32(x * 8.f, x * 8.f, 0, false); return __builtin_amdgcn_cvt_f32_fp8(p, 0) * 0.125f; }
#else
__device__ __forceinline__ float Q8H(float x) { return x; }
#endif
struct EpiSwiGLU {
    static constexpr bool PERM = true, AFTER_DRAIN = false, MID = false; static constexpr int MID_TILES = 1; __device__ __forceinline__ bool keep_acc(const Unit&) const { return false; } __device__ __forceinline__ void set_scale0() {}
    bf16_t* H; int ldh; const float* rowscale; int nN; const float* prescale; int rowmask = 0x7fffffff;
    __device__ __forceinline__ void operator()(const f32x4 (&acc)[2][2][4][2], const Unit& u, int wr, int wc, int fr, int fq) const {
        const int row0 = u.pm * BM + wr * 64 + fr, col0 = (u.pn % nN) * HALF + wc * 32 + 8 * fq;
        float scv[8];
#pragma unroll
        for (int q = 0; q < 8; ++q) scv[q] = rowscale ? rowscale[row0 + (q >> 2) * HALF + (q & 3) * 16] : 1.0f;
        float psv[8];
#pragma unroll
        for (int q = 0; q < 8; ++q) psv[q] = prescale[row0 + (q >> 2) * HALF + (q & 3) * 16];
#pragma unroll
        for (int ai = 0; ai < 2; ++ai)
#pragma unroll
            for (int m = 0; m < 4; ++m) { const int row = row0 + ai * HALF + m * 16; const float sc = scv[ai * 4 + m], ps = psv[ai * 4 + m];
                float h[8];
#pragma unroll
                for (int n = 0; n < 2; ++n)
#pragma unroll
                    for (int e = 0; e < 4; ++e) { const float g = acc[ai][0][m][n][e] * ps, up = acc[ai][1][m][n][e] * (ps * sc); h[n * 4 + e] = Q8H(g * fast_sigmoid(g) * up); }
                u32x4 w; w.x = cvt_pk_bf16(h[0], h[1]); w.y = cvt_pk_bf16(h[2], h[3]); w.z = cvt_pk_bf16(h[4], h[5]); w.w = cvt_pk_bf16(h[6], h[7]);
                PG8_STORE_OUT((u32x4*)(H + (size_t)(row & rowmask) * ldh + col0), w); }
    }
};
struct EpiScatter {
    static constexpr bool PERM = false, AFTER_DRAIN = false, MID = false; static constexpr int MID_TILES = 1; __device__ __forceinline__ bool keep_acc(const Unit&) const { return false; } __device__ __forceinline__ void set_scale0() { scale = 0.f; }
    bf16_t* out; const int* tok; int nN; float scale;
    __device__ __forceinline__ void operator()(const f32x4 (&acc)[2][2][4][2], const Unit& u, int wr, int wc, int fr, int fq) const {
        const int row0 = u.pm * BM + wr * 64 + fr, col0 = (u.pn % nN) * BM + wc * 32 + 4 * fq;
        int tk[8];
#pragma unroll
        for (int q = 0; q < 8; ++q) tk[q] = tok[row0 + (q >> 2) * HALF + (q & 3) * 16];
#pragma unroll
        for (int ai = 0; ai < 2; ++ai)
#pragma unroll
            for (int mp = 0; mp < 2; ++mp) {
                u32x2 b[8];
#pragma unroll
                for (int q = 0; q < 8; ++q) { const int m = 2 * mp + (q >> 2), bj = (q >> 1) & 1, n = q & 1; const int t = tk[ai * 4 + m];
                    b[q] = *(const u32x2*)(out + (size_t)(t < 0 ? 0 : t) * 1024 + col0 + bj * HALF + n * 16); }
#pragma unroll
                for (int q = 0; q < 8; ++q) { const int m = 2 * mp + (q >> 2), bj = (q >> 1) & 1, n = q & 1; const int t = tk[ai * 4 + m];
                    if (t >= 0) { const f32x4 r = (f32x4){bf_lo(b[q].x), bf_hi(b[q].x), bf_lo(b[q].y), bf_hi(b[q].y)} + acc[ai][bj][m][n] * scale;
                        *(u32x2*)(out + (size_t)t * 1024 + col0 + bj * HALF + n * 16) = (u32x2){cvt_pk_bf16(r.x, r.y), cvt_pk_bf16(r.z, r.w)}; } } }
    }
};
struct GroupedOrder {
    StaticOrder so; const PG8_LAS int* tile_e; int nN;
    __device__ __forceinline__ bool next(int i, Unit& u) const { if (!so.next(i, u)) return false; u.pn += tile_e[u.pm] * nN; return true; }
    __device__ __forceinline__ void a_ready(const Unit&) const {}
    __device__ __forceinline__ void done(const Unit&) const {}
};
struct LimitOrder {
    StaticOrder so; int limit;
    __device__ __forceinline__ bool next(int i, Unit& u) const { if ((long)i * so.G + so.c >= limit) return false; return so.next(i, u); }
    __device__ __forceinline__ void a_ready(const Unit&) const {}
    __device__ __forceinline__ void done(const Unit&) const {}
};
struct GroupedLimit {
    LimitOrder lo; const PG8_LAS int* tile_e; int nN;
    __device__ __forceinline__ bool next(int i, Unit& u) const { if (!lo.next(i, u)) return false; u.pn += tile_e[u.pm] * nN; return true; }
    __device__ __forceinline__ void a_ready(const Unit&) const {}
    __device__ __forceinline__ void done(const Unit&) const {}
};
struct SingleOrder {
    Unit un;
    __device__ __forceinline__ bool next(int i, Unit& u) const { if (i != 0) return false; u = un; return true; }
    __device__ __forceinline__ void a_ready(const Unit&) const {}
    __device__ __forceinline__ void done(const Unit&) const {}
};
struct EpiTile {
    static constexpr bool PERM = false, AFTER_DRAIN = false, MID = false; static constexpr int MID_TILES = 1; __device__ __forceinline__ bool keep_acc(const Unit&) const { return false; } __device__ __forceinline__ void set_scale0() {}
    float* O;
    __device__ __forceinline__ void operator()(const f32x4 (&acc)[2][2][4][2], const Unit&, int wr, int wc, int fr, int fq) const {
#pragma unroll
        for (int ai = 0; ai < 2; ++ai)
#pragma unroll
            for (int m = 0; m < 4; ++m)
#pragma unroll
                for (int bj = 0; bj < 2; ++bj)
#pragma unroll
                    for (int n = 0; n < 2; ++n) *(f32x4*)(O + (size_t)(wr * 64 + fr + ai * HALF + m * 16) * 256 + wc * 32 + 4 * fq + bj * HALF + n * 16) = acc[ai][bj][m][n];
    }
};
struct OffsetOrder {
    StaticOrder so; int pn_off;
    __device__ __forceinline__ bool next(int i, Unit& u) const { if (!so.next(i, u)) return false; u.pn += pn_off; return true; }
    __device__ __forceinline__ void a_ready(const Unit&) const {}
    __device__ __forceinline__ void done(const Unit&) const {}
};
struct ProbeOrder {
    StaticOrder so; int pm_mask;
    __device__ __forceinline__ bool next(int i, Unit& u) const { if (!so.next(i, u)) return false; u.pm &= pm_mask; return true; }
    __device__ __forceinline__ void a_ready(const Unit&) const {}
    __device__ __forceinline__ void done(const Unit&) const {}
};
struct MergeOrder {
    StaticOrder so; int nmt;
    __device__ __forceinline__ bool next(int i, Unit& u) const { const int b = i % 3; if (!so.next(i / 3, u)) return false; u.pm += b * nmt; u.pn += b * 4; return true; }
    __device__ __forceinline__ void a_ready(const Unit&) const {}
    __device__ __forceinline__ void done(const Unit&) const {}
};
template <class Epi, class Sched, bool ALIGN_EPI = false, bool SP2 = false, bool GATHER = false>
__device__ __forceinline__ void gemm_phase(PG8_LAS unsigned char* lds, const Gemm g, const Sched& S, const Epi& E) {
    const int tid = g.zv  , wid = __builtin_amdgcn_readfirstlane(tid >> 6), lane = tid & 63, wr = wid >> 2, wc = wid & 3, fr = lane & 15, fq = lane >> 4;
    const int K = g.K, nt = K / BK;
    unsigned voffA[2], voffB[2]; int gR = 0, gC = 0;
#pragma unroll
    for (int i = 0; i < 2; ++i) { int R, C; stage_rc(tid * 16 + i * 8192, R, C); const int Rb = Epi::PERM ? ((R & ~31) + perm32(R & 31)) : R;
        const int LD = g.ld ? g.ld : K;
        const int pitch = g.tiled ? BK : LD;
        voffA[i] = (unsigned)(R * pitch + C) * 2u; voffB[i] = (unsigned)(Rb * pitch + C) * 2u; if (i == 0) { gR = R; gC = C; } }
    const size_t kstep = g.tiled ? (size_t)(BM * BK * 2) : (size_t)(BK * 2);
    const size_t hstep = g.tiled ? (size_t)(HALF * BK * 2) : (size_t)HALF * (g.ld ? g.ld : K) * 2;
    const size_t tstep = (size_t)BM * (g.ld ? g.ld : K) * 2; const size_t tstepA = GATHER ? 0 : tstep, hstepA = GATHER ? 0 : hstep;
    const unsigned ldsw = (unsigned)wid * 1024u;
    const int aoff = lds_byte(wr * 64 + fr, fq * 8), boff = lds_byte(wc * 32 + fr, fq * 8);
#define PG8_SA(b, h) (((b) * 2 + (h)) * HTB)
#define PG8_SB(b, h) ((4 + (b) * 2 + (h)) * HTB)
#define PG8_STAGE(bufoff, gbase, voff) do { _Pragma("unroll") for (int _i = 0; _i < 2; ++_i) \
        __builtin_amdgcn_global_load_lds((const unsigned*)((const char*)(gbase) + (voff)[_i]), (PG8_LAS unsigned*)(lds + (bufoff) + ldsw + _i * 8192), 16, 0, ((bufoff) < 4 * HTB) ? PG8_AUX_A : PG8_AUX_B); } while (0)
#define PG8_LDA(dst, b, h) do { _Pragma("unroll") for (int m = 0; m < 4; ++m) _Pragma("unroll") for (int k = 0; k < 2; ++k) dst[m][k] = *(const PG8_LAS bf16x8*)(lds + PG8_SA(b, h) + aoff + m * 2048 + k * 1024); } while (0)
#define PG8_LDB(dst, b, h) do { _Pragma("unroll") for (int n = 0; n < 2; ++n) _Pragma("unroll") for (int k = 0; k < 2; ++k) dst[n][k] = *(const PG8_LAS bf16x8*)(lds + PG8_SB(b, h) + boff + n * 2048 + k * 1024); } while (0)
#define PG8_MMA(ai, bj, At, Bt) do { __builtin_amdgcn_s_setprio(1); _Pragma("unroll") for (int m = 0; m < 4; ++m) _Pragma("unroll") for (int n = 0; n < 2; ++n) _Pragma("unroll") for (int k = 0; k < 2; ++k) \
        acc[ai][bj][m][n] = __builtin_amdgcn_mfma_f32_16x16x32_bf16(Bt[n][k], At[m][k], acc[ai][bj][m][n], 0, 0, 0); __builtin_amdgcn_s_setprio(0); } while (0)
#define PG8_WAIT_V(n) asm volatile("s_waitcnt vmcnt(" #n ")" ::: "memory")
#define PG8_WAIT_L(n) asm volatile("s_waitcnt lgkmcnt(" #n ")" ::: "memory")
#define PG8_BAR __builtin_amdgcn_s_barrier()
#define PG8_SCHED __builtin_amdgcn_sched_barrier(0)
    Unit cur, nxt; int ui = 0;
    if (!S.next(0, cur)) return;
    f32x4 acc[2][2][4][2];
#pragma unroll
    for (int a = 0; a < 2; ++a)
#pragma unroll
        for (int b = 0; b < 2; ++b)
#pragma unroll
            for (int m = 0; m < 4; ++m)
#pragma unroll
                for (int n = 0; n < 2; ++n) acc[a][b][m][n] = (f32x4){0.f, 0.f, 0.f, 0.f};
    bf16x8 At[4][2], B0[2][2], B1[2][2];
    const char* cA = (const char*)g.A + (size_t)cur.pm * tstepA; const char* cB = (const char*)g.Bt + (size_t)cur.pn * tstep;
    const int rot = g.rot; const size_t rofs = (size_t)rot * kstep; const char* pA = cA + rofs; const char* pB = cB + rofs;
#define PG8_KT(x) ((size_t)(((x) + rot >= nt) ? (x) + rot - nt : (x) + rot))
    unsigned vC[2][2], vN[2][2];
#define PG8_GIDX(u, vv) do { _Pragma("unroll") for (int h_ = 0; h_ < 2; ++h_) _Pragma("unroll") for (int i_ = 0; i_ < 2; ++i_) { \
        if constexpr (GATHER) { const int t_ = g.gidx[(u).pm * BM + h_ * HALF + gR + 64 * i_]; vv[h_][i_] = (unsigned)((t_ < 0 ? 0 : t_) * (g.ld ? g.ld : K) + gC) * 2u; } else vv[h_][i_] = voffA[i_]; } } while (0)
    PG8_GIDX(cur, vC);
    S.a_ready(cur);
    if constexpr (SP2) {
        PG8_STAGE(PG8_SB(0, 0), pB, voffB); PG8_STAGE(PG8_SB(0, 1), pB + hstep, voffB); PG8_STAGE(PG8_SA(0, 0), pA, vC[0]); PG8_STAGE(PG8_SA(0, 1), pA + hstepA, vC[1]);
        if (wr == 1) PG8_BAR;
        PG8_WAIT_V(2); PG8_BAR;
        PG8_STAGE(PG8_SB(1, 0), pB + kstep, voffB); PG8_STAGE(PG8_SA(1, 0), pA + kstep, vC[0]); PG8_STAGE(PG8_SB(1, 1), pB + hstep + kstep, voffB);
        PG8_WAIT_V(6); PG8_BAR;
    } else {
        PG8_STAGE(PG8_SB(0, 0), pB, voffB); PG8_STAGE(PG8_SA(0, 0), pA, vC[0]); PG8_STAGE(PG8_SB(0, 1), pB + hstep, voffB); PG8_STAGE(PG8_SA(0, 1), pA + hstepA, vC[1]);
        if (wr == 1) PG8_BAR;
        PG8_WAIT_V(4); PG8_BAR;
        PG8_STAGE(PG8_SB(1, 0), pB + kstep, voffB); PG8_STAGE(PG8_SA(1, 0), pA + kstep, vC[0]); PG8_STAGE(PG8_SB(1, 1), pB + hstep + kstep, voffB);
        PG8_WAIT_V(6); PG8_BAR;
    }
    for (;;) {
        const bool has_next = S.next(ui + 1, nxt);
        if (has_next) PG8_GIDX(nxt, vN); else { vN[0][0] = vC[0][0]; vN[0][1] = vC[0][1]; vN[1][0] = vC[1][0]; vN[1][1] = vC[1][1]; }
        const char* nA = has_next ? (const char*)g.A + (size_t)nxt.pm * tstepA : cA; const char* nB = has_next ? (const char*)g.Bt + (size_t)nxt.pn * tstep : cB;
        for (int t = 0; t < nt; t += 2) {
            if constexpr (Epi::MID) { if (t != 0 && (t & (Epi::MID_TILES - 1)) == 0) E.mid(acc, cur, t / Epi::MID_TILES, wr, wc, fr, fq); }
            const bool last = (t == nt - 2);
            const char* a1 = cA + PG8_KT(t + 1) * kstep;
            const char* a2 = last ? nA + rofs : cA + PG8_KT(t + 2) * kstep; const char* b2 = last ? nB + rofs : cB + PG8_KT(t + 2) * kstep;
            const char* a3 = a2 + kstep; const char* b3 = b2 + kstep;
            if (last && has_next) S.a_ready(nxt);
            const unsigned v2h0[2] = {last ? vN[0][0] : vC[0][0], last ? vN[0][1] : vC[0][1]}, v2h1[2] = {last ? vN[1][0] : vC[1][0], last ? vN[1][1] : vC[1][1]};
            if constexpr (SP2) {
            PG8_LDB(B0, 0, 0); PG8_LDB(B1, 0, 1); PG8_SCHED; PG8_LDA(At, 0, 0); PG8_STAGE(PG8_SA(1, 1), a1 + hstepA, vC[1]);
            PG8_WAIT_V(8); PG8_WAIT_L(0); PG8_BAR; PG8_MMA(0, 0, At, B0); PG8_MMA(0, 1, At, B1); PG8_BAR; PG8_SCHED;
            PG8_LDA(At, 0, 1); PG8_STAGE(PG8_SB(0, 0), b2, voffB); PG8_STAGE(PG8_SB(0, 1), b2 + hstep, voffB); PG8_STAGE(PG8_SA(0, 0), a2, v2h0);
            PG8_WAIT_V(8); PG8_WAIT_L(0); PG8_BAR; PG8_MMA(1, 0, At, B0); PG8_MMA(1, 1, At, B1); PG8_BAR; PG8_SCHED;
            PG8_LDB(B0, 1, 0); PG8_LDB(B1, 1, 1); PG8_SCHED; PG8_LDA(At, 1, 0); PG8_STAGE(PG8_SA(0, 1), a2 + hstepA, v2h1);
            PG8_WAIT_V(8); PG8_WAIT_L(0); PG8_BAR; PG8_MMA(0, 0, At, B0); PG8_MMA(0, 1, At, B1); PG8_BAR; PG8_SCHED;
            PG8_LDA(At, 1, 1); PG8_STAGE(PG8_SB(1, 0), b3, voffB); PG8_STAGE(PG8_SB(1, 1), b3 + hstep, voffB); PG8_STAGE(PG8_SA(1, 0), a3, v2h0);
            PG8_WAIT_V(8); PG8_WAIT_L(0); PG8_BAR; PG8_MMA(1, 0, At, B0); PG8_MMA(1, 1, At, B1); PG8_BAR; PG8_SCHED;
            } else {
            PG8_LDB(B0, 0, 0); PG8_SCHED; PG8_LDA(At, 0, 0); PG8_STAGE(PG8_SA(1, 1), a1 + hstepA, vC[1]);
            PG8_WAIT_L(8); PG8_BAR; PG8_WAIT_L(0); PG8_MMA(0, 0, At, B0); PG8_BAR; PG8_SCHED;
            PG8_LDB(B1, 0, 1); PG8_STAGE(PG8_SB(0, 0), b2, voffB);
            PG8_BAR; PG8_WAIT_L(0); PG8_MMA(0, 1, At, B1); PG8_BAR;
            PG8_LDA(At, 0, 1); PG8_STAGE(PG8_SA(0, 0), a2, v2h0);
            PG8_BAR; PG8_WAIT_L(0); PG8_MMA(1, 0, At, B0); PG8_BAR; PG8_SCHED;
            PG8_STAGE(PG8_SB(0, 1), b2 + hstep, voffB);
            PG8_WAIT_V(6); PG8_BAR; PG8_MMA(1, 1, At, B1); PG8_BAR;
            PG8_LDB(B0, 1, 0); PG8_SCHED; PG8_LDA(At, 1, 0); PG8_STAGE(PG8_SA(0, 1), a2 + hstepA, v2h1);
            PG8_WAIT_L(8); PG8_BAR; PG8_WAIT_L(0); PG8_MMA(0, 0, At, B0); PG8_BAR; PG8_SCHED;
            PG8_LDB(B1, 1, 1); PG8_STAGE(PG8_SB(1, 0), b3, voffB);
            PG8_BAR; PG8_WAIT_L(0); PG8_MMA(0, 1, At, B1); PG8_BAR;
            PG8_LDA(At, 1, 1); PG8_STAGE(PG8_SA(1, 0), a3, v2h0);
            PG8_BAR; PG8_WAIT_L(0); PG8_MMA(1, 0, At, B0); PG8_BAR; PG8_SCHED;
            PG8_STAGE(PG8_SB(1, 1), b3 + hstep, voffB);
            PG8_WAIT_V(6); PG8_BAR; PG8_MMA(1, 1, At, B1); PG8_BAR;
            }
        }
        if constexpr (ALIGN_EPI) { if (wr == 0) PG8_BAR; }
        if constexpr (!Epi::AFTER_DRAIN) { E(acc, cur, wr, wc, fr, fq); S.done(cur); }
        if (!has_next) break;
        if (!E.keep_acc(cur)) {
#pragma unroll
        for (int a = 0; a < 2; ++a)
#pragma unroll
            for (int b = 0; b < 2; ++b)
#pragma unroll
                for (int m = 0; m < 4; ++m)
#pragma unroll
                    for (int n = 0; n < 2; ++n) acc[a][b][m][n] = (f32x4){0.f, 0.f, 0.f, 0.f};
        }
        cur = nxt; cA = nA; cB = nB; ++ui; vC[0][0] = vN[0][0]; vC[0][1] = vN[0][1]; vC[1][0] = vN[1][0]; vC[1][1] = vN[1][1];
        if constexpr (ALIGN_EPI) { if (wr == 1) PG8_BAR; }
    }
    PG8_WAIT_V(0);
    if constexpr (!ALIGN_EPI) { if (wr == 0) PG8_BAR; }
    PG8_BAR;
    if constexpr (Epi::AFTER_DRAIN) { E.fused(acc, cur, wr, wc, fr, fq, lds, wid, lane); S.done(cur); }
#undef PG8_KT
#undef PG8_SA
#undef PG8_SB
#undef PG8_STAGE
#undef PG8_LDA
#undef PG8_LDB
#undef PG8_MMA
#undef PG8_WAIT_V
#undef PG8_WAIT_L
#undef PG8_BAR
#undef PG8_SCHED
}
}

constexpr int NWAVES = 8;
constexpr int DM = 1024, BATCH = 16, SEQ = 4096, DEPTH = 4, MTOK = BATCH * SEQ;
constexpr int NCHUNK = 2, MC = MTOK / NCHUNK, BC = BATCH / NCHUNK;
constexpr int CIN = 5004, NPROJ = 5120, P1W = 2048, GWID = 3072;
constexpr int DFF = 2752, DFFP = 2816, NFF1 = 2 * DFFP;
constexpr int NEXP = 8, DFE = 3584, NMOE1 = 2 * DFE;
constexpr int SLOTS = MC + 2048;
constexpr float EPS = 1e-6f;
constexpr int C_U = 0, C_V = 256, C_SBQ = 512, C_SBK = 768, C_SBV = 1024, C_CQ = 1280, C_KCMP = 1536, C_VCMP = 1600, C_KSLC = 1664, C_VSLC = 1728, C_KWIN = 1792, C_VWIN = 1856, C_CG = 1920;

constexpr size_t MiB = 1u << 20;
constexpr size_t WS_CTL = 0, CTL_ZERO_BYTES = 1 * MiB;
constexpr size_t WS_ROPE = 1 * MiB;
constexpr size_t WS_BIAS1 = 1 * MiB + 512 * 1024;
constexpr size_t WS_RSTD = WS_BIAS1 + 64 * 1024;
constexpr size_t WS_WIN = 2 * MiB;
constexpr size_t WS_WBR = 12 * MiB;
constexpr size_t WS_WOUT = 14 * MiB;
constexpr size_t WS_WC1 = 16 * MiB;
constexpr size_t WS_WF1 = 18 * MiB;
constexpr size_t WS_WF2 = 130 * MiB;
constexpr size_t WS_HN = 186 * MiB;
constexpr size_t WS_SCR = 314 * MiB;
constexpr size_t WS_P1 = WS_SCR;
constexpr size_t WS_G = WS_P1 + 128 * MiB;
constexpr size_t WS_Y = WS_G + 192 * MiB;
constexpr size_t WS_MG = WS_Y + 48 * MiB;
constexpr size_t WS_KVC = WS_MG + 64 * MiB;
constexpr size_t WS_UL = WS_KVC + 8 * MiB;
constexpr size_t WS_KC = WS_UL + 8 * MiB;
constexpr size_t WS_VT = WS_KC + 1 * MiB;
constexpr size_t WS_KCT = WS_VT + 24 * MiB;
constexpr size_t WS_MIX_END = WS_KCT + 1 * MiB;
constexpr size_t WS_HID = WS_SCR;
constexpr size_t WS_ROUTE = WS_SCR;
constexpr size_t WS_TOKMAP = WS_SCR + 1 * MiB;
constexpr size_t WS_WSLOT = WS_SCR + 2 * MiB;
constexpr size_t WS_RSLOT = WS_SCR + 3 * MiB + 64 * 1024;
constexpr size_t WS_CNT128 = WS_SCR + 3 * MiB;
constexpr size_t WS_HIDM = WS_SCR + 4 * MiB;
constexpr size_t WS_H = 800 * MiB;
constexpr size_t WS_TB = 928 * MiB;
constexpr size_t WS_END = 976 * MiB;
static_assert(WS_MIX_END <= WS_H && WS_HID + (size_t)MTOK * DFFP * 2 <= WS_H && WS_HIDM + (size_t)2 * SLOTS * DFE * 2 <= WS_H, "d_ws map");
static_assert(WS_WF1 + (size_t)NEXP * NMOE1 * DM * 2 <= WS_WF2 && WS_WF2 + (size_t)NEXP * DM * DFE * 2 <= WS_HN, "weight map");
static_assert((size_t)4 * SLOTS * 4 <= 1 * MiB, "tokmap");
constexpr int CW_BAR = 4096;
constexpr int CW_CNT = 131072;
constexpr int CW_CUR = 131072 + 256;
constexpr int MAX_BAR_REGIONS = 32;
constexpr int RING_OFF = 0, RING_BYTES = 131072;
constexpr int LDSCTL_OFF = RING_BYTES, MISC_OFF = LDSCTL_OFF + 320;
constexpr int TAB_OFF = LDSCTL_OFF + 1024;
constexpr int LDS_BYTES = 147456;

#define GAS __attribute__((address_space(1)))
#define LAS __attribute__((address_space(3)))
typedef unsigned short bf16;
typedef unsigned v4u __attribute__((ext_vector_type(4)));
typedef unsigned v2u __attribute__((ext_vector_type(2)));
typedef float f32x4 __attribute__((ext_vector_type(4)));
typedef int v4i __attribute__((ext_vector_type(4)));
typedef __bf16 bf16x2_t __attribute__((ext_vector_type(2)));
#define LDS_WAIT() asm volatile("s_waitcnt lgkmcnt(0)" ::: "memory")
#define VM_WAIT() asm volatile("s_waitcnt vmcnt(0)" ::: "memory")
__device__ __forceinline__ unsigned f2bf(float f) { unsigned u = __builtin_bit_cast(unsigned, f); return (u + 0x7fffu + ((u >> 16) & 1u)) >> 16; }
__device__ __forceinline__ unsigned pk2(float lo, float hi) { return f2bf(lo) | (f2bf(hi) << 16); }
__device__ __forceinline__ float bflo(unsigned u) { return __builtin_bit_cast(float, u << 16); }
__device__ __forceinline__ float bfhi(unsigned u) { return __builtin_bit_cast(float, u & 0xffff0000u); }
__device__ __forceinline__ float bf1(bf16 h) { return __builtin_bit_cast(float, (unsigned)h << 16); }
__device__ __forceinline__ float dot2bf(unsigned a, unsigned b, float c) { return __builtin_amdgcn_fdot2_f32_bf16(__builtin_bit_cast(bf16x2_t, a), __builtin_bit_cast(bf16x2_t, b), c, false); }
#ifdef EMU_FP8
__device__ __forceinline__ float q8r(float x, float s) { const int p = __builtin_amdgcn_cvt_pk_fp8_f32(x * s, x * s, 0, false); return __builtin_amdgcn_cvt_f32_fp8(p, 0) * (1.0f / s); }
#else
__device__ __forceinline__ float q8r(float x, float) { return x; }
#endif
__device__ __forceinline__ float fexp(float x) { return __builtin_amdgcn_exp2f(1.4426950408889634f * x); }
template <int X> __device__ __forceinline__ float swz_xor(float v) { return __builtin_bit_cast(float, __builtin_amdgcn_ds_swizzle(__builtin_bit_cast(int, v), (X << 10) | 0x1f)); }
__device__ __forceinline__ float wave_sum(float v, int lane) {
#pragma unroll
    for (int o = 1; o < 64; o <<= 1) v += __builtin_bit_cast(float, __builtin_amdgcn_ds_bpermute((lane ^ o) << 2, __builtin_bit_cast(int, v)));
    return v;
}
__device__ __forceinline__ float rdlane(float v, int l) { return __builtin_bit_cast(float, __builtin_amdgcn_readlane(__builtin_bit_cast(int, v), l)); }
__device__ __forceinline__ int bperm(int srclane, int v) { return __builtin_amdgcn_ds_bpermute(srclane << 2, v); }
__constant__ double ROPE_INVF[8] = {1.0, 0.19392274474868576, 0.037606030930863933, 0.0072926647372171093, 0.0014142135623730950, 0.00027424817567620730, 5.3182958969449883e-05, 1.0313385377212460e-05};
#define XB_TMO      128
#define XB_XCNT(j)  (256  + 64 * (j))
#define XB_XSUB(j)  (1280 + 64 * (j))
#define XB_XGEN(j)  (2304 + 64 * (j))
#define XB_TOP      3328
#define XB_TOPGEN   3392
#define XCD_BAR_WORDS 3456
#define XB_SPIN_CAP (1u << 18)

__device__ __forceinline__ unsigned xb_ld(unsigned* p)              { return __hip_atomic_load(p, __ATOMIC_RELAXED, __HIP_MEMORY_SCOPE_AGENT); }
__device__ __forceinline__ unsigned xb_add(unsigned* p, unsigned v) { return __hip_atomic_fetch_add(p, v, __ATOMIC_RELAXED, __HIP_MEMORY_SCOPE_AGENT); }
__device__ __forceinline__ unsigned xb_xcc_id() { return (unsigned)__builtin_amdgcn_s_getreg((3 << 11) | 20) & 0xFu; }
#define XB_SPIN(cond, bar) do { unsigned _sp = 0; while (cond) { __builtin_amdgcn_s_sleep(1); \
    if ((++_sp & 255u) == 0u) { if (xb_ld(&(bar)[XB_TMO])) break; if (_sp > XB_SPIN_CAP) { atomicAdd(&(bar)[XB_TMO], 1u); break; } } } } while (0)

__device__ __forceinline__ bool xb_thread0_w(unsigned w, unsigned z) { return w == 0u && __builtin_amdgcn_mbcnt_hi(~0u, __builtin_amdgcn_mbcnt_lo(~0u, z)) == 0u; }
struct XcdBarrier {
    unsigned* bar; unsigned x; unsigned w, z;
    volatile LAS unsigned* st;
};

__device__ __forceinline__ XcdBarrier xcd_barrier_post(unsigned* bar, volatile LAS unsigned* st) {
    XcdBarrier b; b.bar = bar; b.x = xb_xcc_id(); b.st = st; b.w = (unsigned)__builtin_amdgcn_readfirstlane((int)(threadIdx.x >> 6)); b.z = 0u;
    if (xb_thread0_w(b.w, b.z)) (void)xb_add(&bar[XB_XCNT(b.x)], 1u);
    return b;
}
__device__ __forceinline__ void xcd_barrier_complete(unsigned* bar, unsigned x, unsigned& nloc, unsigned& nx) {
    const unsigned G = gridDim.x * gridDim.y * gridDim.z;
    unsigned sum, cnt, mine, sp = 0u;
    for (;;) {
        sum = 0u; cnt = 0u; mine = 0u;
#pragma unroll
        for (unsigned j = 0; j < 16; ++j) { const unsigned c = xb_ld(&bar[XB_XCNT(j)]); sum += c; cnt += (c > 0u) ? 1u : 0u; mine = (j == x) ? c : mine; }
        if (sum == G) break;
        __builtin_amdgcn_s_sleep(1);
        if ((++sp & 255u) == 0u) { if (xb_ld(&bar[XB_TMO])) break; if (sp > XB_SPIN_CAP) { atomicAdd(&bar[XB_TMO], 1u); break; } }
    }
    nloc = mine > 0u ? mine : 1u; nx = cnt > 0u ? cnt : 1u;
}

__device__ __forceinline__ void xcd_barrier(const XcdBarrier& b) {
    asm volatile("s_waitcnt vmcnt(0)" ::: "memory");
    __syncthreads();
    if (xb_thread0_w(b.w, b.z)) {
        unsigned* bar = b.bar;
        __builtin_amdgcn_s_waitcnt(0);
        unsigned nloc = b.st[0], nx = b.st[1];
        if (nloc == 0u) { xcd_barrier_complete(bar, b.x, nloc, nx); b.st[0] = nloc; b.st[1] = nx; }
        const unsigned old = xb_add(&bar[XB_XSUB(b.x)], 1u);
        const unsigned gen = old / nloc;
        if (old + 1u == (gen + 1u) * nloc) {
            __builtin_amdgcn_fence(__ATOMIC_RELEASE, "agent");
            asm volatile("s_waitcnt vmcnt(0)" ::: "memory");
            const unsigned og = xb_add(&bar[XB_TOP], 1u);
            const unsigned tg = og / nx;
            if (og + 1u == (tg + 1u) * nx) xb_add(&bar[XB_TOPGEN], 1u);
            else XB_SPIN(xb_ld(&bar[XB_TOPGEN]) == tg, bar);
            __builtin_amdgcn_fence(__ATOMIC_ACQUIRE, "agent");
            xb_add(&bar[XB_XGEN(b.x)], 1u);
            asm volatile("s_waitcnt vmcnt(0)" ::: "memory");
        } else {
            XB_SPIN(xb_ld(&bar[XB_XGEN(b.x)]) == gen, bar);
            __builtin_amdgcn_fence(__ATOMIC_ACQUIRE, "agent");
            asm volatile("s_waitcnt vmcnt(0)" ::: "memory");
        }
    }
    __syncthreads();
}

struct Frame {
    LAS unsigned char* lds;
    unsigned* ctl;
    int tid, lane, wave, vcu, G, bx, zv, zs, rep;
    unsigned char* ws;
    const float* const* in;
    float* out;
};
#define WSP(T, off) ((T*)(F.ws + (off)))
__device__ __forceinline__ size_t toff(int row, int k, int K) { return (size_t)(row >> 8) * 256 * K + (size_t)(k >> 6) * (256 * 64) + (size_t)(row & 255) * 64 + (k & 63); }

#ifndef TILED_FFN1
#define TILED_FFN1 0
#endif
#ifndef Q8_W1
#define Q8_W1 0.f
#define Q8_W2 0.f
#define Q8_HN 0.f
#define Q8_HID 0.f
#endif
__device__ __forceinline__ int map_row(int kind, int off, int n) { return kind == 0 ? n + off : (kind == 1 ? (n < 1932 ? n : n + 116) : ((n >> 7) * 256 + (n & 127) + off)); }
__device__ __forceinline__ void tr_item(const float* W, int ldw, int N, int ks, int n0, bf16* WT, int ldt, int kd, int kind, int off, LAS unsigned char* scr, int lane, float q8s = 0.f, int tiled = 0, const float* gk = nullptr) {
    const int nq = (lane & 15) * 4, kq = lane >> 4;
    f32x4 x[16];
#pragma unroll
    for (int i = 0; i < 16; ++i) x[i] = (n0 + nq < N) ? *(const f32x4*)(W + (size_t)(ks + 4 * i + kq) * ldw + n0 + nq) : (f32x4){0.f, 0.f, 0.f, 0.f};
    if (gk) {
        float gs[16];
#pragma unroll
        for (int i = 0; i < 16; ++i) gs[i] = gk[ks + 4 * i + kq];
#pragma unroll
        for (int i = 0; i < 16; ++i) x[i] = x[i] * gs[i]; }
#pragma unroll
    for (int i = 0; i < 16; ++i) { const int k = 4 * i + kq;
#pragma unroll
        for (int c = 0; c < 4; ++c) { float wv = x[i][c]; if (q8s > 0.f) wv = q8r(wv, q8s); *(LAS bf16*)(scr + (nq + c) * 136 + k * 2) = (bf16)f2bf(wv); } }
    LDS_WAIT(); asm volatile("" ::: "memory");
    if (n0 + lane < N) { const LAS v2u* s = (const LAS v2u*)(scr + lane * 136); const int mr = map_row(kind, off, n0 + lane); bf16* dst = tiled ? WT + toff(mr, kd, ldt) : WT + (size_t)mr * ldt + kd;
#pragma unroll
        for (int q = 0; q < 8; ++q) { const v2u a = s[2 * q], b = s[2 * q + 1]; *(v4u*)(dst + 8 * q) = (v4u){a.x, a.y, b.x, b.y}; } }
    LDS_WAIT(); asm volatile("" ::: "memory");
}
__device__ __forceinline__ void conv(Frame& F, int& tb, const float* W, size_t sW, int nb, int ldw, int N, int ks0, int K, bf16* WT, size_t sWT, int ldt, int kd0, int kind, int off, float q8s = 0.f, int tiled = 0, const float* gk = nullptr) {
    LAS unsigned char* scr = F.lds + RING_OFF + F.wave * 16384;
    const int gw = F.vcu * NWAVES + F.wave, NGW = F.G * NWAVES;
    const int nblk = (N + 63) / 64, per = (K / 64) * nblk, total = per * nb;
    int first = gw - tb; if (first < 0) first += NGW;
    for (int it = first; it < total; it += NGW) { const int b = it / per, r = it % per, kb = r / nblk, nbk = r % nblk;
        tr_item(W + (size_t)b * sW, ldw, N, ks0 + 64 * kb, 64 * nbk, WT + (size_t)b * sWT, ldt, kd0 + 64 * kb, kind, off, scr, F.lane, q8s, tiled, gk); }
    tb = (tb + total) % NGW;
}
__device__ __forceinline__ void zero_block(Frame& F, bf16* WT, int ldt, int r0, int rows, int c0, int cols, int tiled = 0) {
    const int gt = (F.vcu * NWAVES + F.wave) * 64 + F.lane, NT = F.G * NWAVES * 64, cpr = cols / 8;
    for (int i = gt; i < rows * cpr; i += NT) { const int r = i / cpr, c = i % cpr; const unsigned z = (unsigned)F.zv; *(v4u*)(tiled ? WT + toff(r0 + r, c0 + 8 * c, ldt) : WT + (size_t)(r0 + r) * ldt + c0 + 8 * c) = (v4u){z, z, z, z}; }
}
__device__ __forceinline__ void p_convert(Frame& F, int layer) {
    const int j = layer >> 1; int tb = 0;
    conv(F, tb, F.in[2] + (size_t)layer * DM * CIN, 0, 1, CIN, CIN, 0, DM, WSP(bf16, WS_WIN), 0, DM, 0, 1, 0, 0.f, 0, F.in[1] + (size_t)layer * DM);
    zero_block(F, WSP(bf16, WS_WIN), DM, 1932, 116, 0, DM);
    conv(F, tb, F.in[9] + (size_t)layer * 3 * 256 * DM, (size_t)256 * DM, 3, DM, DM, 0, 256, WSP(bf16, WS_WBR), (size_t)DM * 256, 256, 0, 0, 0);
    conv(F, tb, F.in[10] + (size_t)layer * DM * DM, 0, 1, DM, DM, 0, DM, WSP(bf16, WS_WOUT), 0, DM, 0, 0, 0);
    conv(F, tb, F.in[7] + (size_t)layer * 2 * 2048 * 256, (size_t)2048 * 256, 2, 256, 256, 0, 1024, WSP(bf16, WS_WC1), (size_t)512 * 1024, 1024, 0, 0, 0);
    conv(F, tb, F.in[7] + (size_t)layer * 2 * 2048 * 256, (size_t)2048 * 256, 2, 256, 256, 1024, 1024, WSP(bf16, WS_WC1), (size_t)512 * 1024, 1024, 0, 0, 256);
    if ((layer & 1) == 0) {
        conv(F, tb, F.in[12] + (size_t)j * DM * DFF, 0, 1, DFF, DFF, 0, DM, WSP(bf16, WS_WF1), 0, DM, 0, 2, 0, Q8_W1, TILED_FFN1, F.in[11] + (size_t)layer * DM);
        conv(F, tb, F.in[13] + (size_t)j * DM * DFF, 0, 1, DFF, DFF, 0, DM, WSP(bf16, WS_WF1), 0, DM, 0, 2, 128, Q8_W1, TILED_FFN1, F.in[11] + (size_t)layer * DM);
        zero_block(F, WSP(bf16, WS_WF1), DM, 21 * 256 + 64, 64, 0, DM, TILED_FFN1);
        zero_block(F, WSP(bf16, WS_WF1), DM, 21 * 256 + 128 + 64, 64, 0, DM, TILED_FFN1);
        conv(F, tb, F.in[14] + (size_t)j * DFF * DM, 0, 1, DM, DM, 0, DFF, WSP(bf16, WS_WF2), 0, DFFP, 0, 0, 0, Q8_W2);
        zero_block(F, WSP(bf16, WS_WF2), DFFP, 0, DM, DFF, DFFP - DFF);
    } else {
        conv(F, tb, F.in[16] + (size_t)j * NEXP * DM * DFE, (size_t)DM * DFE, NEXP, DFE, DFE, 0, DM, WSP(bf16, WS_WF1), (size_t)NMOE1 * DM, DM, 0, 2, 0, Q8_W1, 0, F.in[11] + (size_t)layer * DM);
        conv(F, tb, F.in[17] + (size_t)j * NEXP * DM * DFE, (size_t)DM * DFE, NEXP, DFE, DFE, 0, DM, WSP(bf16, WS_WF1), (size_t)NMOE1 * DM, DM, 0, 2, 128, Q8_W1, 0, F.in[11] + (size_t)layer * DM);
        conv(F, tb, F.in[18] + (size_t)j * NEXP * DFE * DM, (size_t)DFE * DM, NEXP, DM, DM, 0, DFE, WSP(bf16, WS_WF2), (size_t)DM * DFE, DFE, 0, 0, 0, Q8_W2);
    }
    if (F.bx < 8) {
        __syncthreads();
        const int kv = F.bx >> 2, jj = (F.bx & 3) * 64 + F.lane;
        const float* pos = F.in[6] + (size_t)(layer * 2 + kv) * 2048; const float* w1 = F.in[7] + (size_t)(layer * 2 + kv) * 2048 * 256;
        float a = 0.f;
        float a1 = 0.f, a2 = 0.f, a3 = 0.f;
#pragma unroll 8
        for (int k = 0; k < 256; k += 4) { const int kk = F.wave * 256 + k;
            a += pos[kk] * w1[(size_t)kk * 256 + jj]; a1 += pos[kk + 1] * w1[(size_t)(kk + 1) * 256 + jj]; a2 += pos[kk + 2] * w1[(size_t)(kk + 2) * 256 + jj]; a3 += pos[kk + 3] * w1[(size_t)(kk + 3) * 256 + jj]; }
        a = (a + a1) + (a2 + a3);
        LAS float* red = (LAS float*)(F.lds + RING_OFF);
        red[F.wave * 64 + F.lane] = a;
        __syncthreads();
        if (F.wave == 0) { float s = 0.f;
#pragma unroll
            for (int w = 0; w < 8; ++w) s += red[w * 64 + F.lane];
            WSP(float, WS_BIAS1)[kv * 256 + jj] = s; }
        __syncthreads();
    }
    if (layer == 0) {
        const int gt = (F.vcu * NWAVES + F.wave) * 64 + F.lane, NT = F.G * NWAVES * 64;
        for (int idx = gt; idx < SEQ * 8; idx += NT) { const int pos = idx >> 3, i = idx & 7;
            const double invf = ROPE_INVF[i];
            double rev = (double)pos * invf * 0.15915494309189535; rev -= __builtin_floor(rev);
            WSP(float, WS_ROPE)[idx] = __builtin_amdgcn_cosf((float)rev); WSP(float, WS_ROPE)[SEQ * 8 + idx] = __builtin_amdgcn_sinf((float)rev); }
    }
}

template <bool S16> __device__ __forceinline__ f32x4 ld_row4(const void* src, size_t m, int lane, int jx) {
    if (S16) { const v2u t = ((const v2u*)((const bf16*)src + m * DM) + lane)[64 * jx]; return (f32x4){bflo(t.x), bfhi(t.x), bflo(t.y), bfhi(t.y)}; }
    return ((const f32x4*)((const float*)src + m * DM) + lane)[64 * jx];
}
template <int MODE, bool S16> __device__ __forceinline__ void p_norm(Frame& F, const void* src, const float* g, const float* rw, int jmoe, float q8s = 0.f, int tiled = 0) {
    const int gw = F.vcu * NWAVES + F.wave, NGW = F.G * NWAVES, lane = F.lane;
    LAS int* hist = (LAS int*)(F.lds + TAB_OFF) + 192;
    if (MODE == 1) {
        if (F.tid < 16) hist[F.tid] = 0;
        const int gt = gw * 64 + lane, NT = NGW * 64; int* tm = WSP(int, WS_TOKMAP);
        for (int i = gt; i < 4 * SLOTS; i += NT) tm[i] = -1;
        for (int i = F.tid; i < DM * NEXP / 4; i += NWAVES * 64) { const int c = i >> 1, hf = i & 1;
            *(LAS f32x4*)(F.lds + RING_OFF + (((((c >> 8) * 4 + (c & 3)) * 2 + hf) * 64 + ((c & 255) >> 2)) * 16)) = ((const f32x4*)rw)[i]; }
        if (F.tid < DM / 4) *(LAS f32x4*)(F.lds + RING_OFF + 32768 + 16 * F.tid) = ((const f32x4*)g)[F.tid];
        __syncthreads();
    }
    f32x4 gv[4];
    if (MODE != 1 && MODE != 3) {
#pragma unroll
        for (int jx = 0; jx < 4; ++jx) gv[jx] = ((const f32x4*)g)[lane + 64 * jx]; }
    constexpr int ROWS = (MODE == 1) ? 2 : 4;
    const int nit = (MODE == 1) ? ((MTOK / 128 - F.bx + F.G - 1) / F.G) * (16 / ROWS) : (MTOK - gw + ROWS * NGW - 1) / (ROWS * NGW);
    for (int itx = 0; itx < nit; ++itx) {
        const int chk = (MODE == 1) ? F.bx + (itx / (16 / ROWS)) * F.G : 0;
        const int m0 = (MODE == 1) ? chk * 128 + (itx % (16 / ROWS)) * (NWAVES * ROWS) + F.wave * ROWS : gw + itx * ROWS * NGW;
        const int mstep = (MODE == 1) ? 1 : NGW;
        f32x4 v[ROWS][4]; float ss[ROWS];
#pragma unroll
        for (int u = 0; u < ROWS; ++u) { const int m = m0 + u * mstep;
#pragma unroll
            for (int jx = 0; jx < 4; ++jx) v[u][jx] = ld_row4<S16>(src, (size_t)(m < MTOK ? m : m0), lane, jx); }
#pragma unroll
        for (int u = 0; u < ROWS; ++u) { float s = 0.f;
#pragma unroll
            for (int jx = 0; jx < 4; ++jx) s += (v[u][jx].x * v[u][jx].x + v[u][jx].y * v[u][jx].y) + (v[u][jx].z * v[u][jx].z + v[u][jx].w * v[u][jx].w);
            ss[u] = s; }
#pragma unroll
        for (int o = 1; o < 64; o <<= 1) {
#pragma unroll
            for (int u = 0; u < ROWS; ++u) ss[u] += __builtin_bit_cast(float, __builtin_amdgcn_ds_bpermute((lane ^ o) << 2, __builtin_bit_cast(int, ss[u]))); }
        float lgall[MODE == 1 ? ROWS : 1][8];
        if (MODE == 1) {
            float rs[ROWS];
#pragma unroll
            for (int u = 0; u < ROWS; ++u) { rs[u] = 1.0f / sqrtf(ss[u] * (1.f / DM) + EPS);
#pragma unroll
                for (int e = 0; e < 8; ++e) lgall[u][e] = 0.f; }
#pragma unroll
            for (int jx = 0; jx < 4; ++jx) { const f32x4 gl = *(const LAS f32x4*)(F.lds + RING_OFF + 32768 + 16 * (lane + 64 * jx));
#pragma unroll
                for (int u = 0; u < ROWS; ++u) v[u][jx] = v[u][jx] * rs[u] * gl; }
#pragma unroll
            for (int jx = 0; jx < 4; ++jx) { const LAS f32x4* wr = (const LAS f32x4*)(F.lds + RING_OFF + jx * 8192 + lane * 16);
#pragma unroll
                for (int r = 0; r < 4; ++r) { const f32x4 a = wr[128 * r], b = wr[128 * r + 64];
#pragma unroll
                    for (int u = 0; u < ROWS; ++u) { const float xv = v[u][jx][r];
                        lgall[u][0] += xv * a.x; lgall[u][1] += xv * a.y; lgall[u][2] += xv * a.z; lgall[u][3] += xv * a.w; lgall[u][4] += xv * b.x; lgall[u][5] += xv * b.y; lgall[u][6] += xv * b.z; lgall[u][7] += xv * b.w; } } }
        }
#pragma unroll
        for (int u = 0; u < ROWS; ++u) { const int m = m0 + u * mstep; if (m >= MTOK) continue;
            const float rstd = 1.0f / sqrtf(ss[u] * (1.f / DM) + EPS);
            if (MODE == 3 || MODE == 1) { if (lane == 0) WSP(float, WS_RSTD)[m] = rstd; }
            if (MODE == 3) {
                if (!S16) {
                    unsigned long long* o8 = (unsigned long long*)(WSP(bf16, WS_HN) + (size_t)m * DM) + lane;
#pragma unroll
                    for (int jx = 0; jx < 4; ++jx) { const f32x4 w = v[u][jx]; o8[64 * jx] = (unsigned long long)pk2(w.x, w.y) | ((unsigned long long)pk2(w.z, w.w) << 32); } }
                continue; }
            if (MODE != 1) {
#pragma unroll
            for (int jx = 0; jx < 4; ++jx) v[u][jx] = v[u][jx] * rstd * gv[jx]; }
            if (MODE == 2) {
                f32x4* o = (f32x4*)(F.out + (size_t)m * DM) + lane;
#pragma unroll
                for (int jx = 0; jx < 4; ++jx) o[64 * jx] = v[u][jx];
            } else if (MODE != 1) {
                unsigned long long* o8 = (unsigned long long*)(WSP(bf16, WS_HN) + (size_t)m * DM) + lane;
#pragma unroll
                for (int jx = 0; jx < 4; ++jx) { f32x4 w = v[u][jx];
                    if (tiled) { *(unsigned long long*)(WSP(bf16, WS_HN) + toff(m, 4 * lane + 256 * jx, DM)) = (unsigned long long)pk2(w.x, w.y) | ((unsigned long long)pk2(w.z, w.w) << 32); continue; } if (q8s > 0.f) { w.x = q8r(w.x, q8s); w.y = q8r(w.y, q8s); w.z = q8r(w.z, q8s); w.w = q8r(w.w, q8s); }
                    o8[64 * jx] = (unsigned long long)pk2(w.x, w.y) | ((unsigned long long)pk2(w.z, w.w) << 32); }
            }
            if (MODE == 1) {
                float lg[8];
#pragma unroll
                for (int e = 0; e < 8; ++e) lg[e] = lgall[u][e];
                float h4[4], h2[2], h1;
                { const bool up = lane & 1;
#pragma unroll
                  for (int i = 0; i < 4; ++i) { const float keep = up ? lg[4 + i] : lg[i], send = up ? lg[i] : lg[4 + i]; h4[i] = keep + __builtin_bit_cast(float, bperm(lane ^ 1, __builtin_bit_cast(int, send))); } }
                { const bool up = lane & 2;
#pragma unroll
                  for (int i = 0; i < 2; ++i) { const float keep = up ? h4[2 + i] : h4[i], send = up ? h4[i] : h4[2 + i]; h2[i] = keep + __builtin_bit_cast(float, bperm(lane ^ 2, __builtin_bit_cast(int, send))); } }
                { const bool up = lane & 4; const float keep = up ? h2[1] : h2[0], send = up ? h2[0] : h2[1]; h1 = keep + __builtin_bit_cast(float, bperm(lane ^ 4, __builtin_bit_cast(int, send))); }
                h1 += __builtin_bit_cast(float, bperm(lane ^ 8, __builtin_bit_cast(int, h1))); h1 += __builtin_bit_cast(float, bperm(lane ^ 16, __builtin_bit_cast(int, h1))); h1 += __builtin_bit_cast(float, bperm(lane ^ 32, __builtin_bit_cast(int, h1)));
                lg[0] = rdlane(h1, 0); lg[1] = rdlane(h1, 4); lg[2] = rdlane(h1, 2); lg[3] = rdlane(h1, 6); lg[4] = rdlane(h1, 1); lg[5] = rdlane(h1, 5); lg[6] = rdlane(h1, 3); lg[7] = rdlane(h1, 7);
                int e0 = 0; float v0 = lg[0];
#pragma unroll
                for (int e = 1; e < 8; ++e) if (lg[e] > v0) { v0 = lg[e]; e0 = e; }
                int e1 = -1; float v1 = -INFINITY;
#pragma unroll
                for (int e = 0; e < 8; ++e) if (e != e0 && lg[e] > v1) { v1 = lg[e]; e1 = e; }
                const float w0 = 1.0f / (1.0f + fexp(v1 - v0)), w1 = 1.0f - w0;
                if (lane == 0) { WSP(v4i, WS_ROUTE)[m] = (v4i){e0, e1, __builtin_bit_cast(int, w0), __builtin_bit_cast(int, w1)};
                    __hip_atomic_fetch_add(&hist[e0], 1, __ATOMIC_RELAXED, __HIP_MEMORY_SCOPE_WORKGROUP); __hip_atomic_fetch_add(&hist[8 + e1], 1, __ATOMIC_RELAXED, __HIP_MEMORY_SCOPE_WORKGROUP); }
            }
        }
        if (MODE == 1 && (itx % (16 / ROWS)) == 16 / ROWS - 1) {
            __syncthreads();
            if (F.tid < 16) { WSP(int, WS_CNT128)[(size_t)chk * 16 + F.tid] = hist[F.tid]; hist[F.tid] = 0; }
            __syncthreads();
        }
    }
}

__device__ __forceinline__ float dpp_row_sum(float v) {
    v += __builtin_bit_cast(float, __builtin_amdgcn_update_dpp(0, __builtin_bit_cast(int, v), 0xB1, 0xf, 0xf, false));
    v += __builtin_bit_cast(float, __builtin_amdgcn_update_dpp(0, __builtin_bit_cast(int, v), 0x4E, 0xf, 0xf, false));
    v += __builtin_bit_cast(float, __builtin_amdgcn_update_dpp(0, __builtin_bit_cast(int, v), 0x141, 0xf, 0xf, false));
    v += __builtin_bit_cast(float, __builtin_amdgcn_update_dpp(0, __builtin_bit_cast(int, v), 0x140, 0xf, 0xf, false));
    return v;
}
__device__ __forceinline__ void p_rstd(Frame& F) {
    const int gw = F.vcu * NWAVES + F.wave, NGW = F.G * NWAVES, lane = F.lane;
    const bf16* H = WSP(bf16, WS_H); float* rs = WSP(float, WS_RSTD);
    for (int m0 = gw * 8; m0 < MTOK; m0 += NGW * 8) {
        v4u x[8][2];
#pragma unroll
        for (int u = 0; u < 8; ++u) { const v4u* xr = (const v4u*)(H + (size_t)(m0 + u) * DM) + lane; x[u][0] = xr[0]; x[u][1] = xr[64]; }
        float ss[8];
#pragma unroll
        for (int u = 0; u < 8; ++u) { float s = 0.f;
#pragma unroll
            for (int h = 0; h < 2; ++h) { const v4u w = x[u][h];
                const float a0 = bflo(w.x), a1 = bfhi(w.x), a2 = bflo(w.y), a3 = bfhi(w.y), a4 = bflo(w.z), a5 = bfhi(w.z), a6 = bflo(w.w), a7 = bfhi(w.w);
                s += ((a0 * a0 + a1 * a1) + (a2 * a2 + a3 * a3)) + ((a4 * a4 + a5 * a5) + (a6 * a6 + a7 * a7)); }
            ss[u] = dpp_row_sum(s); }
        float myr = 0.f;
#pragma unroll
        for (int u = 0; u < 8; ++u) { const float t = (rdlane(ss[u], 0) + rdlane(ss[u], 16)) + (rdlane(ss[u], 32) + rdlane(ss[u], 48)); if (lane == u) myr = t; }
        if (lane < 8) rs[m0 + lane] = 1.0f / sqrtf(myr * (1.f / DM) + EPS);
    }
}
__device__ __forceinline__ void p_prep(Frame& F) {
    const int gw = F.vcu * NWAVES + F.wave, NGW = F.G * NWAVES, lane = F.lane;
    bf16* P1 = WSP(bf16, WS_P1); bf16* KVC = WSP(bf16, WS_KVC); const float* rope = WSP(float, WS_ROPE);
    const int vec = lane >> 3, ri = lane & 7; const int cb = vec < 4 ? C_CQ + vec * 64 : (vec == 4 ? C_KCMP : (vec == 5 ? C_KSLC : C_KWIN));
    for (int row0 = gw; row0 < MC; row0 += 4 * NGW) {
        float x1[4], x2[4], cc[4], ss[4]; bf16 kc48[4], vc64[4];
#pragma unroll
        for (int k = 0; k < 4; ++k) { const int row = row0 + k * NGW < MC ? row0 + k * NGW : row0; const bf16* p = P1 + (size_t)row * P1W; const int pos = row & (SEQ - 1);
            const int cl = lane < 56 ? cb + ri : C_CQ;
            x1[k] = bf1(p[cl]); x2[k] = bf1(p[cl + 8]); cc[k] = rope[pos * 8 + ri]; ss[k] = rope[SEQ * 8 + pos * 8 + ri];
            if (F.rep) { cc[k] = 1.f; ss[k] = 0.f; }
            kc48[k] = p[C_KCMP + 16 + (lane < 48 ? lane : 0)]; vc64[k] = p[C_VCMP + lane]; }
#pragma unroll
        for (int k = 0; k < 4; ++k) { const int row = row0 + k * NGW; if (row >= MC) continue; bf16* p = P1 + (size_t)row * P1W;
            if (lane < 56) { const bf16 o1 = (bf16)f2bf(x1[k] * cc[k] - x2[k] * ss[k]), o2 = (bf16)f2bf(x2[k] * cc[k] + x1[k] * ss[k]);
                p[cb + ri] = o1; p[cb + ri + 8] = o2;
                if (vec == 4) { KVC[(size_t)row * 64 + ri] = o1; KVC[(size_t)row * 64 + ri + 8] = o2; } }
            if (lane < 48) KVC[(size_t)row * 64 + 16 + lane] = kc48[k];
            KVC[(size_t)MC * 64 + (size_t)row * 64 + lane] = vc64[k]; }
    }
    bf16* VT = WSP(bf16, WS_VT);
    for (int it = gw; it < 6 * BC * 64; it += NGW) { const int which = it / (BC * 64), r = it % (BC * 64), b = r >> 6, blk = r & 63;
        const v4u* src = (const v4u*)(P1 + ((size_t)b * SEQ + blk * 64 + lane) * P1W + (which == 0 ? C_VSLC : (which == 1 ? C_VWIN : C_SBV + (which - 2) * 64)));
        bf16* dst = VT + ((size_t)(which * BC + b) * 64) * SEQ + blk * 64 + lane;
        v4u xs[8];
#pragma unroll
        for (int i = 0; i < 8; ++i) xs[i] = src[i];
#pragma unroll
        for (int i = 0; i < 8; ++i) { const v4u x = xs[i];
            dst[(size_t)(8 * i + 0) * SEQ] = (bf16)(x.x & 0xffffu); dst[(size_t)(8 * i + 1) * SEQ] = (bf16)(x.x >> 16);
            dst[(size_t)(8 * i + 2) * SEQ] = (bf16)(x.y & 0xffffu); dst[(size_t)(8 * i + 3) * SEQ] = (bf16)(x.y >> 16);
            dst[(size_t)(8 * i + 4) * SEQ] = (bf16)(x.z & 0xffffu); dst[(size_t)(8 * i + 5) * SEQ] = (bf16)(x.z >> 16);
            dst[(size_t)(8 * i + 6) * SEQ] = (bf16)(x.w & 0xffffu); dst[(size_t)(8 * i + 7) * SEQ] = (bf16)(x.w >> 16); }
    }
}
__device__ __forceinline__ void p_sgu(Frame& F, int layer) {
    LAS float* vn = (LAS float*)(F.lds + RING_OFF);
    const bf16* P1 = WSP(bf16, WS_P1); bf16* Ya = WSP(bf16, WS_Y);
    const float* gain = F.in[3] + (size_t)layer * 256; const float* sw = F.in[4] + (size_t)layer * 4 * 128 * 128; const float* sb = F.in[5] + (size_t)layer * 4 * 128;
    const int lane = F.lane, wave = F.wave;
    for (int item = F.vcu; item < MC / 128; item += F.G) {
        const size_t r0 = (size_t)item * 128;
        __syncthreads();
        for (int rr = 0; rr < 16; ++rr) { const int r = wave * 16 + rr; const v2u raw = *(const v2u*)(P1 + (r0 + r) * P1W + C_V + 4 * lane);
            const float a = bflo(raw.x), b = bfhi(raw.x), c = bflo(raw.y), d = bfhi(raw.y);
            const float rstd = 1.0f / sqrtf(wave_sum((a * a + b * b) + (c * c + d * d), lane) * (1.f / 256.f) + EPS);
            const f32x4 gg = ((const f32x4*)gain)[lane];
            *(LAS f32x4*)(vn + r * 256 + 4 * lane) = (f32x4){a * rstd * gg.x, b * rstd * gg.y, c * rstd * gg.z, d * rstd * gg.w}; }
        __syncthreads();
        const int g = wave & 3, half = wave >> 2;
        for (int i = 0; i < 64; ++i) { const int t = 2 * i + half;
            const float* wrow = sw + ((size_t)g * 128 + t) * 128;
            const float w_lo = wrow[lane], w_hi = wrow[64 + lane];
            float acc = 0.f;
            for (int s = 0; s <= t; ++s) { const float w = (s < 64) ? rdlane(w_lo, s) : rdlane(w_hi, s - 64); acc += w * vn[s * 256 + g * 64 + lane]; }
            const float u = bf1(P1[(r0 + t) * P1W + C_U + g * 64 + lane]);
#ifdef ABL_SGUMIX
            acc = 0.f;
#endif
            Ya[(r0 + t) * 256 + g * 64 + lane] = (bf16)f2bf(u * (acc + sb[g * 128 + t])); }
    }
    __syncthreads();
}

__device__ __forceinline__ void p_cmpfin(Frame& F, int layer) {
    const int gw = F.vcu * NWAVES + F.wave, NGW = F.G * NWAVES, lane = F.lane;
    const float* UL = WSP(float, WS_UL); const float* bias = WSP(float, WS_BIAS1); bf16* KC = WSP(bf16, WS_KC);
    LAS float* w2l = (LAS float*)(F.lds + RING_OFF);
    __syncthreads();
    { const f32x4* src = (const f32x4*)(F.in[8] + (size_t)layer * 2 * 256 * 64);
#pragma unroll 4
      for (int i = F.tid; i < 2 * 256 * 64 / 4; i += NWAVES * 64) *(LAS f32x4*)(w2l + 4 * i) = src[i]; }
    __syncthreads();
    for (int it = gw; it < 2 * BC * 255; it += NGW) { const int kv = it / (BC * 255), r = it % (BC * 255), b = r / 255, m = r % 255;
        const LAS float* w2 = w2l + kv * 256 * 64;
        const float* U = UL + (size_t)(kv * 2048 + b * 256 + m) * 512; const float* L = U + 512 + 256;
        float hv[4];
#pragma unroll
        for (int q = 0; q < 4; ++q) hv[q] = pg8::gelu_tanh(U[64 * q + lane] + L[64 * q + lane] + bias[kv * 256 + 64 * q + lane]);
        float acc0 = 0.f, acc1 = 0.f;
#pragma unroll
        for (int q = 0; q < 4; ++q)
#pragma unroll 8
            for (int jj = 0; jj < 64; jj += 2) { acc0 += rdlane(hv[q], jj) * w2[(64 * q + jj) * 64 + lane]; acc1 += rdlane(hv[q], jj + 1) * w2[(64 * q + jj + 1) * 64 + lane]; }
        const float acc = acc0 + acc1;
        KC[((size_t)(kv * BC + b) * 256 + m) * 64 + lane] = (bf16)f2bf(acc);
        if (kv == 1) { WSP(bf16, WS_KCT)[((size_t)b * 64 + lane) * 256 + m] = (bf16)f2bf(acc); if (m == 254) WSP(bf16, WS_KCT)[((size_t)b * 64 + lane) * 256 + 255] = (bf16)0; }
        else if (m == 254) KC[((size_t)b * 256 + 255) * 64 + lane] = (bf16)0; }
    __syncthreads();
}

__device__ __forceinline__ void p_stick(Frame& F) {
    const int gw = F.vcu * NWAVES + F.wave, NGW = F.G * NWAVES, lane = F.lane;
    const bf16* P1 = WSP(bf16, WS_P1); bf16* Yb = WSP(bf16, WS_Y) + (size_t)MC * 256;
    for (int item = gw; item < BC * 4 * 64; item += NGW) { const int tb = item & 63, h = (item >> 6) & 3, b = item >> 8;
        const int t = tb * 64 + lane; const size_t row = (size_t)b * SEQ + t;
        unsigned q[32];
        { const v4u* qp = (const v4u*)(P1 + row * P1W + C_SBQ + h * 64);
#pragma unroll
          for (int i = 0; i < 8; ++i) { const v4u x = qp[i]; q[4 * i] = x.x; q[4 * i + 1] = x.y; q[4 * i + 2] = x.z; q[4 * i + 3] = x.w; } }
        float o[64];
#pragma unroll
        for (int d = 0; d < 64; ++d) o[d] = 0.f;
        float R = 0.f;
        const bf16* kb = P1 + (size_t)b * SEQ * P1W + C_SBK + h * 64; const bf16* vb = P1 + (size_t)b * SEQ * P1W + C_SBV + h * 64;
        for (int s = t - 1; s >= 0; --s) {
            if (R < -100.f) break;
            const v4u* kp = (const v4u*)(kb + (size_t)s * P1W); const v4u* vp = (const v4u*)(vb + (size_t)s * P1W);
            float z0 = 0.f, z1 = 0.f;
#pragma unroll
            for (int i = 0; i < 8; ++i) { const v4u k = kp[i]; z0 = dot2bf(k.x, q[4 * i], z0); z1 = dot2bf(k.y, q[4 * i + 1], z1); z0 = dot2bf(k.z, q[4 * i + 2], z0); z1 = dot2bf(k.w, q[4 * i + 3], z1); }
            const float z = (z0 + z1) * 0.125f;
            const float tt = 0.6931471805599453f * __builtin_amdgcn_logf(1.0f + fexp(-__builtin_fabsf(z)));
            const float lb = fminf(z, 0.f) - tt, l1m = fminf(-z, 0.f) - tt;
            const float a = fexp(lb + R); R += l1m;
#pragma unroll
            for (int i = 0; i < 8; ++i) { const v4u v = vp[i];
                o[8 * i] += a * bflo(v.x); o[8 * i + 1] += a * bfhi(v.x); o[8 * i + 2] += a * bflo(v.y); o[8 * i + 3] += a * bfhi(v.y);
                o[8 * i + 4] += a * bflo(v.z); o[8 * i + 5] += a * bfhi(v.z); o[8 * i + 6] += a * bflo(v.w); o[8 * i + 7] += a * bfhi(v.w); }
        }
        v4u* op = (v4u*)(Yb + row * 256 + h * 64);
#pragma unroll
        for (int i = 0; i < 8; ++i) op[i] = (v4u){pk2(o[8 * i], o[8 * i + 1]), pk2(o[8 * i + 2], o[8 * i + 3]), pk2(o[8 * i + 4], o[8 * i + 5]), pk2(o[8 * i + 6], o[8 * i + 7])};
    }
}

struct Soft { float mx, l; };
__device__ __forceinline__ float dotq(const LAS v4u* ql, const bf16* kp_) {
    const v4u* kp = (const v4u*)kp_; float z0 = 0.f, z1 = 0.f;
#pragma unroll
    for (int i = 0; i < 8; ++i) { const v4u k = kp[i]; const v4u q = ql[i]; z0 = dot2bf(k.x, q.x, z0); z1 = dot2bf(k.y, q.y, z1); z0 = dot2bf(k.z, q.z, z0); z1 = dot2bf(k.w, q.w, z1); }
    return (z0 + z1) * 0.125f;
}
__device__ __forceinline__ void axpy_row(float p, const bf16* vp_, float (&o)[64]) {
    const v4u* vp = (const v4u*)vp_;
#pragma unroll
    for (int i = 0; i < 8; ++i) { const v4u v = vp[i];
        o[8 * i] += p * bflo(v.x); o[8 * i + 1] += p * bfhi(v.x); o[8 * i + 2] += p * bflo(v.y); o[8 * i + 3] += p * bfhi(v.y);
        o[8 * i + 4] += p * bflo(v.z); o[8 * i + 5] += p * bfhi(v.z); o[8 * i + 6] += p * bflo(v.w); o[8 * i + 7] += p * bfhi(v.w); }
}
__device__ __forceinline__ void nsa_step(const LAS v4u* ql, const bf16* kp_, const bf16* vp_, Soft& S, float (&o)[64]) {
    const float s = dotq(ql, kp_);
    if (s > S.mx) { const float sc = fexp(S.mx - s); S.l *= sc;
#pragma unroll
        for (int d = 0; d < 64; ++d) o[d] *= sc;
        S.mx = s; }
    const float p = fexp(s - S.mx); S.l += p;
    asm volatile("" ::: "memory");
    axpy_row(p, vp_, o);
}
__device__ __forceinline__ void nsa_accum(bf16* yrow, bool first, float sc, const float (&o)[64]) {
    v4u* op = (v4u*)yrow;
#pragma unroll
    for (int i = 0; i < 8; ++i) { v4u old = (v4u){0u, 0u, 0u, 0u}; if (!first) old = op[i];
        op[i] = (v4u){pk2(bflo(old.x) + sc * o[8 * i], bfhi(old.x) + sc * o[8 * i + 1]), pk2(bflo(old.y) + sc * o[8 * i + 2], bfhi(old.y) + sc * o[8 * i + 3]),
                      pk2(bflo(old.z) + sc * o[8 * i + 4], bfhi(old.z) + sc * o[8 * i + 5]), pk2(bflo(old.w) + sc * o[8 * i + 6], bfhi(old.w) + sc * o[8 * i + 7])}; }
}
__device__ __forceinline__ void p_nsa(Frame& F) {
    const int gw = F.vcu * NWAVES + F.wave, NGW = F.G * NWAVES, lane = F.lane;
    const bf16* P1 = WSP(bf16, WS_P1); const bf16* KC = WSP(bf16, WS_KC); bf16* Yc = WSP(bf16, WS_Y) + (size_t)2 * MC * 256;
    LAS float* imp = (LAS float*)(F.lds + RING_OFF + F.wave * 4096);
    LAS v4u* ql = (LAS v4u*)(F.lds + RING_OFF + 32768 + F.wave * 9216 + lane * 144);
    const int qi = lane >> 2, h = lane & 3;
    for (int item = gw; item < BC * 256; item += NGW) { const int b = item >> 8, tg = item & 255;
        const int t = tg * 16 + qi; const size_t row = (size_t)b * SEQ + t; const bf16* prow = P1 + row * P1W;
        { const v4u* qp = (const v4u*)(prow + C_CQ + h * 64);
#pragma unroll
          for (int i = 0; i < 8; ++i) ql[i] = qp[i]; }
        const float g0 = bf1(prow[C_CG + h * 3]), g1 = bf1(prow[C_CG + h * 3 + 1]), g2 = bf1(prow[C_CG + h * 3 + 2]);
        bf16* yrow = Yc + row * 256 + h * 64;
        float o[64];
        for (int i = lane; i < 1024; i += 64) imp[i] = 0.f;
        const int nv = t >= 31 ? ((t - 31) >> 4) + 1 : 0; const int nvmax = (tg * 16 + 15 >= 31) ? ((tg * 16 + 15 - 31) >> 4) + 1 : 0;
        const bf16* kc = KC + (size_t)(0 * BC + b) * 256 * 64; const bf16* vc = KC + (size_t)(1 * BC + b) * 256 * 64;
        { float mx = -INFINITY, l = 0.f;
          for (int m = 0; m < nvmax; ++m) { const float s = dotq(ql, kc + m * 64); if (m < nv) { if (s > mx) { l *= fexp(mx - s); mx = s; } l += fexp(s - mx); } }
          const float rl = l > 0.f ? 1.0f / l : 0.f;
#pragma unroll
          for (int d = 0; d < 64; ++d) o[d] = 0.f;
          for (int m = 0; m < nvmax; ++m) { const float s = dotq(ql, kc + m * 64); const float p = (m < nv) ? fexp(s - mx) * rl : 0.f;
              asm volatile("" ::: "memory");
              axpy_row(p, vc + m * 64, o);
              float P = p + __builtin_bit_cast(float, bperm(lane ^ 1, __builtin_bit_cast(int, p))); P += __builtin_bit_cast(float, bperm(lane ^ 2, __builtin_bit_cast(int, P)));
              if (h == 0) { const int j0 = m >> 2; const bool edge = (m & 3) == 3; imp[qi * 64 + j0] += edge ? 0.5f * P : P; if (edge) imp[qi * 64 + j0 + 1] += 0.5f * P; } }
          nsa_accum(yrow, true, g0, o); }
        unsigned long long mask = 0ull;
        { const int cur = t >> 6, nvb = cur + 1;
          if (h == 0) {
              if (nvb <= 16) mask = (1ull << nvb) - 1ull;
              else { mask = 1ull | (1ull << cur);
                  for (int r = 0; r < 14; ++r) { int best = -1; float bv = -1.f;
                      for (int j = 1; j < cur; ++j) { const float v = imp[qi * 64 + j]; if (!((mask >> j) & 1ull) && v > bv) { bv = v; best = j; } }
                      mask |= 1ull << best; } } }
          const unsigned mlo = (unsigned)bperm(lane & ~3, (int)(unsigned)mask), mhi = (unsigned)bperm(lane & ~3, (int)(unsigned)(mask >> 32));
          mask = ((unsigned long long)mhi << 32) | mlo; }
        { Soft S{-INFINITY, 0.f};
#pragma unroll
          for (int d = 0; d < 64; ++d) o[d] = 0.f;
          const bf16* kb = P1 + (size_t)b * SEQ * P1W + C_KSLC; const bf16* vb = P1 + (size_t)b * SEQ * P1W + C_VSLC;
          unsigned long long mm = mask;
          while (mm) { const int j = __builtin_ctzll(mm); mm &= mm - 1ull;
              for (int kk = 0; kk < 64; ++kk) { const int sp = j * 64 + kk; if (sp > t) break; nsa_step(ql, kb + (size_t)sp * P1W, vb + (size_t)sp * P1W, S, o); } }
          nsa_accum(yrow, false, g1 / S.l, o); }
        { Soft S{-INFINITY, 0.f};
#pragma unroll
          for (int d = 0; d < 64; ++d) o[d] = 0.f;
          const bf16* kb = P1 + (size_t)b * SEQ * P1W + C_KWIN; const bf16* vb = P1 + (size_t)b * SEQ * P1W + C_VWIN;
          for (int i = 0; i < 512; ++i) { const int sp = t - 511 + i; if (sp >= 0) nsa_step(ql, kb + (size_t)sp * P1W, vb + (size_t)sp * P1W, S, o); }
          nsa_accum(yrow, false, g2 / S.l, o); }
    }
}

__device__ __forceinline__ int moe_table(Frame& F, int jmoe, int c, int r, int kpre = 0) {
    LAS int* tab = (LAS int*)(F.lds + TAB_OFF); LAS int* arr = (LAS int*)(F.lds + LDSCTL_OFF + 4096);
    (void)jmoe;
    __syncthreads();
    if (F.tid < 256) { const v4i* s = (const v4i*)(WSP(int, WS_CNT128) + ((size_t)(c * 256 + F.tid) * 2 + r) * 8); const v4i a = s[0], b = s[1];
        *(LAS v4i*)(arr + F.tid * 8) = a; *(LAS v4i*)(arr + F.tid * 8 + 4) = b; }
    __syncthreads();
    if (F.tid < 8) { int tot = 0, pre = 0;
        for (int k = 0; k < 256; ++k) { const int x = arr[k * 8 + F.tid]; pre += (k < kpre) ? x : 0; tot += x; }
        tab[176 + F.tid] = tot; tab[184 + F.tid] = pre; }
    __syncthreads();
    if (F.tid == 0) { int base = 0, T = 0;
        for (int e = 0; e < 8; ++e) { const int cnt = tab[176 + e];
            const int nt = (cnt + 255) >> 8; tab[160 + e] = base; for (int i = 0; i < nt && T + i < 160; ++i) tab[T + i] = e; T += nt; base += nt * 256; }
        tab[168] = T < 136 ? T : 136; }
    __syncthreads();
    return tab[168];
}
__device__ __forceinline__ void p_gather(Frame& F, int jmoe, int c, int r, int nbusy = 0) {
    if (F.bx < nbusy) return;
    LAS int* tab = (LAS int*)(F.lds + TAB_OFF); LAS int* cntw = tab + 256; LAS int* basew = tab + 320;
    const int lane = F.lane, wave = F.wave;
    const v4i* route = WSP(v4i, WS_ROUTE); int* tokmap = WSP(int, WS_TOKMAP) + (c * 2 + r) * SLOTS; float* wslot = WSP(float, WS_WSLOT) + (c * 2 + r) * SLOTS; float* rslot = WSP(float, WS_RSLOT) + (c * 2 + r) * SLOTS;
    for (int ch = F.bx - nbusy; ch < MC / 128; ch += F.G - nbusy) {
        moe_table(F, jmoe, c, r, ch);
        const int m = c * MC + ch * 128 + wave * 16 + (lane & 15); const v4i rt = route[m];
        const int e = lane < 16 ? (r ? rt.y : rt.x) : -1; const float w = __builtin_bit_cast(float, r ? rt.w : rt.z);
        unsigned long long bal[8]; int mycnt = 0;
#pragma unroll
        for (int ee = 0; ee < 8; ++ee) { bal[ee] = __builtin_amdgcn_ballot_w64(e == ee); if (lane == ee) mycnt = __builtin_popcountll(bal[ee]); }
        if (lane < 8) cntw[wave * 8 + lane] = mycnt;
        __syncthreads();
        if (wave == 0 && lane < 8) { int base = tab[184 + lane];
#pragma unroll
            for (int w8 = 0; w8 < 8; ++w8) { basew[w8 * 8 + lane] = base; base += cntw[w8 * 8 + lane]; } }
        __syncthreads();
        int pos = 0;
#pragma unroll
        for (int ee = 0; ee < 8; ++ee) if (e == ee) pos = basew[wave * 8 + ee] + __builtin_popcountll(bal[ee] & ((1ull << lane) - 1ull));
        int slot = 0;
        if (lane < 16) { slot = tab[160 + e] + pos; tokmap[slot] = m; wslot[slot] = w; rslot[slot] = WSP(float, WS_RSTD)[m]; }
    }
}

typedef float f32x16 __attribute__((ext_vector_type(16)));
typedef short bf16x8v __attribute__((ext_vector_type(8)));
typedef float f32x2v __attribute__((ext_vector_type(2)));
constexpr int NSA_K = 0, NSA_V = 8192, NSA_BUF = 17408, NSA_STAGE = 2 * NSA_BUF, NSA_IMP = 69632, NSA_CARRY = 86016, NSA_SEL = 103424, NSA_WSF = 103936;
constexpr int NSA_VP = 136;
constexpr float NSA_C2 = 0.125f * 1.4426950408889634f;
constexpr float NSA_DEFER = 8.0f / (0.125f * 1.4426950408889634f);
__device__ __forceinline__ unsigned cvtpk(float lo, float hi) { f32x2v v = {lo, hi}; bf16x2_t b = __builtin_convertvector(v, bf16x2_t); return __builtin_bit_cast(unsigned, b); }
__device__ __forceinline__ float partner32(float v, int lane) { return __builtin_bit_cast(float, __builtin_amdgcn_ds_bpermute((lane ^ 32) << 2, __builtin_bit_cast(int, v))); }
__device__ __forceinline__ void nsa_load(v4u& kx, v4u& vx, const bf16* Kg, int kp, const bf16* Vg, int vp, int tid) {
    kx = *(const v4u*)(Kg + (size_t)(tid & 63) * kp + (tid >> 6) * 8); vx = *(const v4u*)(Vg + (size_t)(tid >> 3) * vp + (tid & 7) * 8);
}
__device__ __forceinline__ void nsa_store(LAS unsigned char* lds, const v4u& kx, const v4u& vx, int tid) {
    *(LAS v4u*)(lds + NSA_K + (tid >> 6) * 1024 + (tid & 63) * 16) = kx; { LAS v2u* vd = (LAS v2u*)(lds + NSA_V + (tid >> 3) * NSA_VP + (tid & 7) * 16); vd[0] = (v2u){vx.x, vx.y}; vd[1] = (v2u){vx.z, vx.w}; }
}
__device__ __forceinline__ void nsa_qk(const LAS unsigned char* lds, const bf16x8v (&qr)[4], f32x16& p0, f32x16& p1, int r32, int hi) {
    bf16x8v kf[8];
#pragma unroll
    for (int d0 = 0; d0 < 4; ++d0) {
        kf[2 * d0] = *(const LAS bf16x8v*)(lds + NSA_K + (2 * d0 + hi) * 1024 + r32 * 16);
        kf[2 * d0 + 1] = *(const LAS bf16x8v*)(lds + NSA_K + (2 * d0 + hi) * 1024 + 512 + r32 * 16); }
    __builtin_amdgcn_sched_barrier(0);
#pragma unroll
    for (int i = 0; i < 16; ++i) { p0[i] = 0.f; p1[i] = 0.f; }
#pragma unroll
    for (int d0 = 0; d0 < 4; ++d0) {
        p0 = __builtin_amdgcn_mfma_f32_32x32x16_bf16(kf[2 * d0], qr[d0], p0, 0, 0, 0);
        p1 = __builtin_amdgcn_mfma_f32_32x32x16_bf16(kf[2 * d0 + 1], qr[d0], p1, 0, 0, 0);
    }
}
__device__ __forceinline__ void nsa_mask(f32x16& p0, f32x16& p1, int hi, int hiL, int loL) {
    const int hl = hiL - 4 * hi, ll = loL - 4 * hi;
#pragma unroll
    for (int i = 0; i < 16; ++i) { const int c = (i & 3) + 8 * (i >> 2);
        if (!(c <= hl && c > ll)) p0[i] = -INFINITY;
        if (!(c + 32 <= hl && c + 32 > ll)) p1[i] = -INFINITY; }
}
__device__ __forceinline__ float nsa_max32(const f32x16& p0, const f32x16& p1) {
    float a = fmaxf(fmaxf(p0[0], p0[1]), p1[0]), b = fmaxf(fmaxf(p0[2], p0[3]), p1[1]); a = fmaxf(fmaxf(a, p1[2]), p1[3]);
#pragma unroll
    for (int i = 4; i < 16; i += 4) { a = fmaxf(fmaxf(a, p0[i]), p0[i + 1]); b = fmaxf(fmaxf(b, p0[i + 2]), p0[i + 3]); a = fmaxf(fmaxf(a, p1[i]), p1[i + 1]); b = fmaxf(fmaxf(b, p1[i + 2]), p1[i + 3]); }
    return fmaxf(a, b);
}
__device__ __forceinline__ void nsa_vload(const LAS unsigned char* lds, v4u (&vv)[8], int r32, int hi) {
#pragma unroll
    for (int db = 0; db < 2; ++db) { const LAS unsigned char* vrow = lds + NSA_V + (32 * db + r32) * NSA_VP;
#pragma unroll
        for (int ks = 0; ks < 4; ++ks) {
            const int kb = (ks >> 1) * 32 + (ks & 1) * 16 + 4 * hi;
            const v2u lo = *(const LAS v2u*)(vrow + kb * 2), hh = *(const LAS v2u*)(vrow + (kb + 8) * 2);
            vv[4 * db + ks] = (v4u){lo.x, lo.y, hh.x, hh.y}; } }
    __builtin_amdgcn_sched_barrier(0);
}
__device__ __forceinline__ void nsa_pv(const v4u (&vv)[8], const f32x16& p0, const f32x16& p1, f32x16 (&o)[2]) {
    bf16x8v pa[4];
#pragma unroll
    for (int s = 0; s < 2; ++s) {
        const v4u a = (v4u){cvtpk(p0[8 * s], p0[8 * s + 1]), cvtpk(p0[8 * s + 2], p0[8 * s + 3]), cvtpk(p0[8 * s + 4], p0[8 * s + 5]), cvtpk(p0[8 * s + 6], p0[8 * s + 7])};
        const v4u b = (v4u){cvtpk(p1[8 * s], p1[8 * s + 1]), cvtpk(p1[8 * s + 2], p1[8 * s + 3]), cvtpk(p1[8 * s + 4], p1[8 * s + 5]), cvtpk(p1[8 * s + 6], p1[8 * s + 7])};
        pa[s] = __builtin_bit_cast(bf16x8v, a); pa[2 + s] = __builtin_bit_cast(bf16x8v, b); }
#pragma unroll
    for (int ks = 0; ks < 4; ++ks)
#pragma unroll
        for (int db = 0; db < 2; ++db) o[db] = __builtin_amdgcn_mfma_f32_32x32x16_bf16(pa[ks], __builtin_bit_cast(bf16x8v, vv[4 * db + ks]), o[db], 0, 0, 0);
}
__device__ __forceinline__ void nsa_rowscale(f32x16 (&o)[2], LAS float* wsf, float f, int r32, int hi) {
    if (hi == 0) wsf[r32] = f;
#pragma unroll
    for (int g = 0; g < 4; ++g) { const f32x4 w = *(const LAS f32x4*)(wsf + 8 * g + 4 * hi);
#pragma unroll
        for (int e = 0; e < 4; ++e) { o[0][4 * g + e] *= w[e]; o[1][4 * g + e] *= w[e]; } }
}
constexpr int NSA_ACC = 104960;
__device__ __forceinline__ void nsa_rowaccum(LAS unsigned char* acc, bool first, const f32x16 (&o)[2], LAS float* wsf, float f, int r32, int hi) {
    if (hi == 0) wsf[r32] = f;
#pragma unroll
    for (int g = 0; g < 4; ++g) { const f32x4 w = *(const LAS f32x4*)(wsf + 8 * g + 4 * hi);
#pragma unroll
        for (int e = 0; e < 4; ++e) { LAS bf16* p = (LAS bf16*)(acc + (8 * g + 4 * hi + e) * 128 + r32 * 2); const int i = 4 * g + e;
            float a = o[0][i] * w[e], b = o[1][i] * w[e];
            if (!first) { a += bf1(p[0]); b += bf1(p[32]); }
            p[0] = (bf16)f2bf(a); p[32] = (bf16)f2bf(b); } }
}
__device__ __forceinline__ void nsa_flush(const LAS unsigned char* acc, bf16* ytok  , int lane) {
    asm volatile("" ::: "memory");
    { int z_; asm volatile("v_mov_b32 %0, 0" : "=v"(z_)); lane += z_; }
#pragma unroll
    for (int ps = 0; ps < 4; ++ps) { const int row = ps * 8 + (lane >> 3), ch = lane & 7;
        const v4u v = *(const LAS v4u*)(acc + row * 128 + ch * 16);
        *(v4u*)((unsigned char*)ytok + (unsigned)(((row >> 2) * 256 + (row & 3) * 64 + ch * 8) * 2)) = v; }
}
__device__ __forceinline__ void nsa_softmax_pv(const LAS unsigned char* lds, f32x16& p0, f32x16& p1, float& m, float& l, f32x16 (&o)[2], LAS float* wsf, int lane, int r32, int hi, bool rowok) {
    float mt = nsa_max32(p0, p1); mt = rowok ? mt : -INFINITY; mt = fmaxf(mt, partner32(mt, lane));
    const float mn = fmaxf(m, mt);
    if (__builtin_amdgcn_ballot_w64(mn > m + NSA_DEFER) != 0ull) { const float f = __builtin_amdgcn_exp2f((m - mn) * NSA_C2); l *= f; nsa_rowscale(o, wsf, f, r32, hi); m = mn; }
    const float off = rowok ? -m * NSA_C2 : -INFINITY;
    v4u vv[8]; nsa_vload(lds, vv, r32, hi);
    float s = 0.f;
#pragma unroll
    for (int i = 0; i < 16; ++i) { p0[i] = __builtin_amdgcn_exp2f(__builtin_fmaf(p0[i], NSA_C2, off)); p1[i] = __builtin_amdgcn_exp2f(__builtin_fmaf(p1[i], NSA_C2, off)); s += p0[i] + p1[i]; }
    l += s;
    nsa_pv(vv, p0, p1, o);
}
__device__ __forceinline__ void p_nsa2(Frame& F) {
    const int tid = F.tid, lane = F.lane, wave = F.wave, r32 = lane & 31, hi = lane >> 5;
    LAS unsigned char* lds = F.lds + RING_OFF;
    LAS float* imp = (LAS float*)(lds + NSA_IMP); LAS float* carry = (LAS float*)(lds + NSA_CARRY);
    LAS unsigned long long* selm = (LAS unsigned long long*)(lds + NSA_SEL); LAS float* wsf = (LAS float*)(lds + NSA_WSF) + wave * 32;
    LAS unsigned char* acc = wave < 6 ? lds + NSA_ACC + wave * 4096 : F.lds + LDSCTL_OFF + 4096 + (wave - 6) * 4096;
    const bf16* P1 = WSP(bf16, WS_P1); const bf16* KC = WSP(bf16, WS_KC); const bf16* KCT = WSP(bf16, WS_KCT); const bf16* VT = WSP(bf16, WS_VT);
    bf16* Yc = WSP(bf16, WS_Y) + (size_t)2 * MC * 256;
    const int ql = r32 >> 2, h = r32 & 3, tq = 8 * wave + ql;
    int par = 0;
    for (int it = 0; it < 2; ++it) {
        for (int pair = F.vcu; pair < BC * 32; pair += F.G) {
            const int b = pair >> 5, sx = pair & 31, qb = it ? 63 - sx : sx;
            const int t = qb * 64 + tq; const size_t row = (size_t)b * SEQ + t; const bf16* prow = P1 + row * P1W;
            bf16x8v qr[4];
#pragma unroll
            for (int d0 = 0; d0 < 4; ++d0) qr[d0] = *(const bf16x8v*)(prow + C_CQ + h * 64 + d0 * 16 + hi * 8);
            const float g0 = bf1(prow[C_CG + h * 3]), g1 = bf1(prow[C_CG + h * 3 + 1]), g2 = bf1(prow[C_CG + h * 3 + 2]);
            f32x16 o[2], p0, p1;
            __syncthreads();
            for (int i = tid; i < 64 * 64; i += 512) imp[i] = 0.f;
            for (int i = tid; i < 64 * 68; i += 512) carry[i] = 0.f;
            const int nct = (4 * qb + 3 + 63) >> 6;
            const int mlim = t >= 31 ? ((t - 31) >> 4) : -1;
            const bf16* kcb = KC + (size_t)b * 256 * 64; const bf16* vcb = KCT + (size_t)b * 64 * 256;
            float m = -1e30f, l = 0.f;
            v4u kx, vx;
            nsa_load(kx, vx, kcb, 64, vcb, 256, tid);
            for (int ti = 0; ti < nct; ++ti) {
                LAS unsigned char* tb = lds + par * NSA_STAGE; par ^= 1;
                nsa_store(tb, kx, vx, tid); __syncthreads();
                { const int tn = ti + 1 < nct ? ti + 1 : 0; nsa_load(kx, vx, kcb + (size_t)tn * 64 * 64, 64, vcb + tn * 64, 256, tid); }
                nsa_qk(tb, qr, p0, p1, r32, hi); nsa_mask(p0, p1, hi, mlim - 64 * ti, -1);
                float mt = nsa_max32(p0, p1); mt = fmaxf(mt, partner32(mt, lane));
                const float mn = fmaxf(m, mt); l *= __builtin_amdgcn_exp2f((m - mn) * NSA_C2); m = mn;
                const float off = -m * NSA_C2; float s = 0.f;
#pragma unroll
                for (int i = 0; i < 16; ++i) s += __builtin_amdgcn_exp2f(__builtin_fmaf(p0[i], NSA_C2, off)) + __builtin_amdgcn_exp2f(__builtin_fmaf(p1[i], NSA_C2, off));
                l += s; }
            { const float lt = l + partner32(l, lane); const float rl = lt > 0.f ? 1.0f / lt : 0.f;
#pragma unroll
              for (int i = 0; i < 16; ++i) { o[0][i] = 0.f; o[1][i] = 0.f; }
              for (int ti = 0; ti < nct; ++ti) {
                  LAS unsigned char* tb = lds + par * NSA_STAGE; par ^= 1;
                  nsa_store(tb, kx, vx, tid); __syncthreads();
                  if (ti + 1 < nct) nsa_load(kx, vx, kcb + (size_t)(ti + 1) * 64 * 64, 64, vcb + (ti + 1) * 64, 256, tid);
                  nsa_qk(tb, qr, p0, p1, r32, hi); nsa_mask(p0, p1, hi, mlim - 64 * ti, -1);
                  v4u vv[8]; nsa_vload(tb, vv, r32, hi);
                  { const float off = -m * NSA_C2;
#pragma unroll
                    for (int i = 0; i < 16; ++i) { p0[i] = __builtin_amdgcn_exp2f(__builtin_fmaf(p0[i], NSA_C2, off)) * rl; p1[i] = __builtin_amdgcn_exp2f(__builtin_fmaf(p1[i], NSA_C2, off)) * rl; } }
#pragma unroll
                  for (int kt = 0; kt < 2; ++kt)
#pragma unroll
                      for (int g = 0; g < 4; ++g) { const f32x16& pp = kt ? p1 : p0;
                          float A = pp[4 * g] + pp[4 * g + 1] + pp[4 * g + 2] + 0.5f * pp[4 * g + 3], B = 0.5f * pp[4 * g + 3];
                          A += __builtin_bit_cast(float, bperm(lane ^ 1, __builtin_bit_cast(int, A))); A += __builtin_bit_cast(float, bperm(lane ^ 2, __builtin_bit_cast(int, A)));
                          B += __builtin_bit_cast(float, bperm(lane ^ 1, __builtin_bit_cast(int, B))); B += __builtin_bit_cast(float, bperm(lane ^ 2, __builtin_bit_cast(int, B)));
                          if (h == 0) { const int j = 16 * ti + 8 * kt + 2 * g + hi; imp[tq * 64 + j] = A; carry[tq * 68 + j + 1] = B; } }
                  nsa_pv(vv, p0, p1, o); }
              nsa_rowaccum(acc, true, o, wsf, g0, r32, hi); }
            __syncthreads();
            v4u kx2, vx2;
            { const bf16* kb = P1 + (size_t)b * SEQ * P1W + C_KSLC; const bf16* vb = VT + (size_t)(0 * BC + b) * 64 * SEQ;
              nsa_load(kx, vx, kb, P1W, vb, SEQ, tid); if (qb >= 1) nsa_load(kx2, vx2, kb + (size_t)64 * P1W, P1W, vb + 64, SEQ, tid); }
            { const int q = tid >> 3, sub = tid & 7; unsigned long long mask;
              if (qb + 1 <= 16) mask = (1ull << (qb + 1)) - 1ull;
              else { mask = 1ull | (1ull << qb);
                  unsigned long long key[8];
#pragma unroll
                  for (int i = 0; i < 8; ++i) { const int j = sub * 8 + i; const float v = imp[q * 64 + j] + carry[q * 68 + j];
                      key[i] = (j >= 1 && j < qb) ? (((unsigned long long)__builtin_bit_cast(unsigned, v) << 32) | (unsigned)(63 - j)) : 0ull; }
                  for (int r = 0; r < 14; ++r) { unsigned long long best = key[0];
#pragma unroll
                      for (int i = 1; i < 8; ++i) best = key[i] > best ? key[i] : best;
#define NSA_DPPMAX(ctrl) do { const unsigned lo_ = (unsigned)__builtin_amdgcn_update_dpp(0, (int)(unsigned)best, ctrl, 0xf, 0xf, false), hh_ = (unsigned)__builtin_amdgcn_update_dpp(0, (int)(unsigned)(best >> 32), ctrl, 0xf, 0xf, false); \
                          const unsigned long long other_ = ((unsigned long long)hh_ << 32) | lo_; best = other_ > best ? other_ : best; } while (0)
                      NSA_DPPMAX(0xB1); NSA_DPPMAX(0x4E); NSA_DPPMAX(0x141);
#undef NSA_DPPMAX
                      const int jb = 63 - (int)(best & 63ull); mask |= 1ull << jb;
#pragma unroll
                      for (int i = 0; i < 8; ++i) if (sub * 8 + i == jb) key[i] = 0ull; } }
              if (sub == 0) selm[q] = mask; }
            __syncthreads();
            const unsigned long long mysel = selm[tq];
            { const bf16* kb = P1 + (size_t)b * SEQ * P1W + C_KSLC; const bf16* vb = VT + (size_t)(0 * BC + b) * 64 * SEQ;
              m = -1e30f; l = 0.f;
#pragma unroll
              for (int i = 0; i < 16; ++i) { o[0][i] = 0.f; o[1][i] = 0.f; }
              for (int j = 0; j <= qb; j += 2) {
                  const bool two = j + 1 <= qb;
                  LAS unsigned char* tb = lds + par * NSA_STAGE; par ^= 1;
                  nsa_store(tb, kx, vx, tid); if (two) nsa_store(tb + NSA_BUF, kx2, vx2, tid);
                  __syncthreads();
                  if (j + 2 <= qb) nsa_load(kx, vx, kb + (size_t)(j + 2) * 64 * P1W, P1W, vb + (j + 2) * 64, SEQ, tid);
                  if (j + 3 <= qb) nsa_load(kx2, vx2, kb + (size_t)(j + 3) * 64 * P1W, P1W, vb + (j + 3) * 64, SEQ, tid);
                  if (j + 2 > qb) { const int jw = qb >= 8 ? qb - 8 : 0;
                      nsa_load(kx, vx, P1 + (size_t)b * SEQ * P1W + C_KWIN + (size_t)jw * 64 * P1W, P1W, VT + (size_t)(1 * BC + b) * 64 * SEQ + jw * 64, SEQ, tid); }
                  { const bool rowsel = ((mysel >> j) & 1ull) != 0ull;
                    if (__builtin_amdgcn_ballot_w64(rowsel) != 0ull) {
                        nsa_qk(tb, qr, p0, p1, r32, hi); if (j == qb) nsa_mask(p0, p1, hi, tq, -1);
                        nsa_softmax_pv(tb, p0, p1, m, l, o, wsf, lane, r32, hi, rowsel); } }
                  if (two) { const bool rowsel = ((mysel >> (j + 1)) & 1ull) != 0ull;
                    if (__builtin_amdgcn_ballot_w64(rowsel) != 0ull) {
                        nsa_qk(tb + NSA_BUF, qr, p0, p1, r32, hi); if (j + 1 == qb) nsa_mask(p0, p1, hi, tq, -1);
                        nsa_softmax_pv(tb + NSA_BUF, p0, p1, m, l, o, wsf, lane, r32, hi, rowsel); } } }
              const float lt = l + partner32(l, lane);
              nsa_rowaccum(acc, false, o, wsf, lt > 0.f ? g1 / lt : 0.f, r32, hi); }
            { const bf16* kb = P1 + (size_t)b * SEQ * P1W + C_KWIN; const bf16* vb = VT + (size_t)(1 * BC + b) * 64 * SEQ;
              m = -1e30f; l = 0.f;
#pragma unroll
              for (int i = 0; i < 16; ++i) { o[0][i] = 0.f; o[1][i] = 0.f; }
              const int j0 = qb >= 8 ? qb - 8 : 0;
              for (int j = j0; j <= qb; ++j) {
                  LAS unsigned char* tb = lds + par * NSA_STAGE; par ^= 1;
                  nsa_store(tb, kx, vx, tid); __syncthreads();
                  if (j < qb) nsa_load(kx, vx, kb + (size_t)(j + 1) * 64 * P1W, P1W, vb + (j + 1) * 64, SEQ, tid);
                  nsa_qk(tb, qr, p0, p1, r32, hi); if (j == qb || j == qb - 8) nsa_mask(p0, p1, hi, j == qb ? tq : 63, j == qb - 8 ? tq : -1);
                  nsa_softmax_pv(tb, p0, p1, m, l, o, wsf, lane, r32, hi, true); }
              const float lt = l + partner32(l, lane);
              nsa_rowaccum(acc, false, o, wsf, lt > 0.f ? g2 / lt : 0.f, r32, hi);
              nsa_flush(acc, Yc + ((size_t)b * SEQ + qb * 64 + 8 * wave) * 256, lane);
            }
        }
    }
    __syncthreads();
}

constexpr int SB_HEAD_LDS = 17408;
constexpr int SB_FLAG = 4 * SB_HEAD_LDS;
constexpr float SB_LOG2E = 1.4426950408889634f, SB_STOP = -100.0f * 1.4426950408889634f;
__device__ __forceinline__ void p_stick2(Frame& F, int nbusy) {
    const int tid = F.tid, lane = F.lane, wave = F.wave, r32 = lane & 31, hi = lane >> 5, h = wave & 3, qh = wave >> 2;
    LAS unsigned char* lds = F.lds + RING_OFF; LAS unsigned char* hl = lds + h * SB_HEAD_LDS; LAS int* flag = (LAS int*)(lds + SB_FLAG);
    const bf16* P1 = WSP(bf16, WS_P1); const bf16* VT = WSP(bf16, WS_VT) + (size_t)2 * BC * 64 * SEQ;
    bf16* Yb = WSP(bf16, WS_Y) + (size_t)MC * 256;
    const int tq = 32 * qh + r32;
    if (F.bx >= nbusy)
        for (int item = F.bx - nbusy; item < BC * 64; item += F.G - nbusy) {
            const int b = item >> 6, qb = item & 63;
            const size_t row = (size_t)b * SEQ + qb * 64 + tq;
            bf16x8v qr[4];
#pragma unroll
            for (int d0 = 0; d0 < 4; ++d0) qr[d0] = *(const bf16x8v*)(P1 + row * P1W + C_SBQ + h * 64 + d0 * 16 + hi * 8);
            f32x16 o[2], p0, p1;
#pragma unroll
            for (int i = 0; i < 16; ++i) { o[0][i] = 0.f; o[1][i] = 0.f; }
            float R = 0.f;
            const int skey = tid & 63, sc = tid >> 6, sd = tid >> 3, skc = tid & 7;
            v4u kx[4], vx[4];
#define SB_LOAD(jj) do { const bf16* kg_ = P1 + ((size_t)b * SEQ + (jj) * 64 + skey) * P1W + C_SBK + sc * 8; \
                _Pragma("unroll") for (int hh = 0; hh < 4; ++hh) { kx[hh] = *(const v4u*)(kg_ + hh * 64); vx[hh] = *(const v4u*)(VT + ((size_t)(hh * BC + b) * 64 + sd) * SEQ + (jj) * 64 + skc * 8); } } while (0)
            SB_LOAD(qb);
            for (int j = qb; j >= 0; --j) {
                __syncthreads();
                if (j < qb) { int live = 0;
#pragma unroll
                    for (int w = 0; w < 8; ++w) live |= flag[w];
                    if (!live) break; }
#pragma unroll
                for (int hh = 0; hh < 4; ++hh) { *(LAS v4u*)(lds + hh * SB_HEAD_LDS + sc * 1024 + skey * 16) = kx[hh]; { LAS v2u* vd = (LAS v2u*)(lds + hh * SB_HEAD_LDS + NSA_V + sd * NSA_VP + skc * 16); vd[0] = (v2u){vx[hh].x, vx[hh].y}; vd[1] = (v2u){vx[hh].z, vx[hh].w}; } }
                __syncthreads();
                if (j > 0) SB_LOAD(j - 1);
                nsa_qk(hl, qr, p0, p1, r32, hi);
#pragma unroll
                for (int i = 0; i < 16; ++i) { p0[i] *= NSA_C2; p1[i] *= NSA_C2; }
                v4u vv[8]; nsa_vload(hl, vv, r32, hi);
                const int lim = ((j == qb) ? tq : 64) - 4 * hi;
                float Town[8], Tp[8];
#pragma unroll
                for (int kt = 0; kt < 2; ++kt) { f32x16& pp = kt ? p1 : p0;
#pragma unroll
                    for (int g = 0; g < 4; ++g) { float L[4];
#pragma unroll
                        for (int e = 0; e < 4; ++e) { const int kk = 32 * kt + 8 * g + e; const float z = pp[4 * g + e];
                            const float tt = __builtin_amdgcn_logf(1.0f + __builtin_amdgcn_exp2f(-__builtin_fabsf(z)));
                            const float lb = fminf(z, 0.f) - tt; const bool ok = kk < lim;
                            L[e] = ok ? lb - z : 0.f; pp[4 * g + e] = ok ? lb : -INFINITY; }
                        const float E2 = L[3], E1 = E2 + L[2], E0 = E1 + L[1];
                        pp[4 * g + 2] += E2; pp[4 * g + 1] += E1; pp[4 * g] += E0;
                        Town[4 * kt + g] = E0 + L[0]; } }
#pragma unroll
                for (int k = 0; k < 8; ++k) Tp[k] = partner32(Town[k], lane);
                float suf = R;
#pragma unroll
                for (int k = 7; k >= 0; --k) { const float add = suf + (hi == 0 ? Tp[k] : 0.f); f32x16& pp = (k >> 2) ? p1 : p0; const int g = k & 3;
#pragma unroll
                    for (int e = 0; e < 4; ++e) pp[4 * g + e] = __builtin_amdgcn_exp2f(pp[4 * g + e] + add);
                    suf += Town[k] + Tp[k]; }
                R = suf;
                nsa_pv(vv, p0, p1, o);
                const bool alive = R >= SB_STOP;
                const unsigned long long bal = __builtin_amdgcn_ballot_w64(alive);
                if (lane == 0) flag[wave] = bal != 0ull ? 1 : 0;
            }
            { bf16* dst = Yb + ((size_t)b * SEQ + qb * 64 + 32 * qh + 4 * hi) * 256 + h * 64 + r32;
#pragma unroll
              for (int i = 0; i < 16; ++i) { dst[((i & 3) + 8 * (i >> 2)) * 256] = (bf16)f2bf(o[0][i]); dst[((i & 3) + 8 * (i >> 2)) * 256 + 32] = (bf16)f2bf(o[1][i]); } }
        }
#undef SB_LOAD
    __syncthreads();
}

__device__ __forceinline__ void p_sgu2(Frame& F, int layer) {
    LAS unsigned char* vnT = F.lds + RING_OFF;
    const bf16* P1 = WSP(bf16, WS_P1); bf16* Ya = WSP(bf16, WS_Y);
    const float* gain = F.in[3] + (size_t)layer * 256; const float* sw = F.in[4] + (size_t)layer * 4 * 128 * 128; const float* sb = F.in[5] + (size_t)layer * 4 * 128;
    const int lane = F.lane, wave = F.wave, r32 = lane & 31, hi = lane >> 5, g = wave & 3, db = wave >> 2;
    for (int item = F.vcu; item < MC / 128; item += F.G) {
        const size_t r0 = (size_t)item * 128;
        __syncthreads();
        { const f32x4 gg = ((const f32x4*)gain)[lane];
          for (int rr = 0; rr < 16; rr += 2) { const int r = wave * 16 + rr;
              const v2u ra = *(const v2u*)(P1 + (r0 + r) * P1W + C_V + 4 * lane), rb = *(const v2u*)(P1 + (r0 + r + 1) * P1W + C_V + 4 * lane);
              const float a0 = bflo(ra.x), a1 = bfhi(ra.x), a2 = bflo(ra.y), a3 = bfhi(ra.y), b0 = bflo(rb.x), b1 = bfhi(rb.x), b2 = bflo(rb.y), b3 = bfhi(rb.y);
              const float sa = 1.0f / sqrtf(wave_sum((a0 * a0 + a1 * a1) + (a2 * a2 + a3 * a3), lane) * (1.f / 256.f) + EPS);
              const float sb_ = 1.0f / sqrtf(wave_sum((b0 * b0 + b1 * b1) + (b2 * b2 + b3 * b3), lane) * (1.f / 256.f) + EPS);
              LAS unsigned* q = (LAS unsigned*)(vnT + (4 * lane) * 272 + r * 2);
              q[0] = pk2(a0 * sa * gg.x, b0 * sb_ * gg.x); q[68] = pk2(a1 * sa * gg.y, b1 * sb_ * gg.y); q[136] = pk2(a2 * sa * gg.z, b2 * sb_ * gg.z); q[204] = pk2(a3 * sa * gg.w, b3 * sb_ * gg.w); } }
        __syncthreads();
        const int ch = g * 64 + db * 32 + r32;
        for (int tb = 0; tb < 4; ++tb) {
            f32x16 acc;
#pragma unroll
            for (int i = 0; i < 16; ++i) acc[i] = 0.f;
            const int t = 32 * tb + r32; const float* wrow = sw + ((size_t)g * 128 + t) * 128;
            f32x4 wq[8][2];
#pragma unroll
            for (int ks = 0; ks < 8; ++ks) if (ks < 2 * tb + 2) { wq[ks][0] = *(const f32x4*)(wrow + 16 * ks + 8 * hi); wq[ks][1] = *(const f32x4*)(wrow + 16 * ks + 8 * hi + 4); }
#pragma unroll
            for (int ks = 0; ks < 8; ++ks) if (ks < 2 * tb + 2) {
                const int s0 = 16 * ks + 8 * hi;
                const f32x4 w0 = wq[ks][0], w1 = wq[ks][1];
                const v4u a = (v4u){pk2(s0 <= t ? w0.x : 0.f, s0 + 1 <= t ? w0.y : 0.f), pk2(s0 + 2 <= t ? w0.z : 0.f, s0 + 3 <= t ? w0.w : 0.f),
                                    pk2(s0 + 4 <= t ? w1.x : 0.f, s0 + 5 <= t ? w1.y : 0.f), pk2(s0 + 6 <= t ? w1.z : 0.f, s0 + 7 <= t ? w1.w : 0.f)};
                const bf16x8v bfr = *(const LAS bf16x8v*)(vnT + ch * 272 + s0 * 2);
                acc = __builtin_amdgcn_mfma_f32_32x32x16_bf16(__builtin_bit_cast(bf16x8v, a), bfr, acc, 0, 0, 0); }
            float uu[16], bb[16];
#pragma unroll
            for (int i = 0; i < 16; ++i) { const int tt = 32 * tb + (i & 3) + 8 * (i >> 2) + 4 * hi; uu[i] = bf1(P1[(r0 + tt) * P1W + C_U + ch]); bb[i] = sb[g * 128 + tt]; }
#pragma unroll
            for (int i = 0; i < 16; ++i) { const int tt = 32 * tb + (i & 3) + 8 * (i >> 2) + 4 * hi;
                Ya[(r0 + tt) * 256 + ch] = (bf16)f2bf(uu[i] * (acc[i] + bb[i])); }
        }
    }
    __syncthreads();
}

struct Args { const float* in[20]; float* out; unsigned char* ws; int lo, hi, li, rep; };
#ifndef TILED_FFN1
#define TILED_FFN1 0
#endif
#ifndef PG8_ALIGN_EPI
#define PG8_ALIGN_EPI true
#endif
#ifndef PG8_SP2
#define PG8_SP2 true
#endif
#ifndef WGM_PROJ
#define WGM_PROJ PG8_WGM
#endif
#ifndef WGM_FFN1
#define WGM_FFN1 PG8_WGM
#endif
#ifndef WGM_FFN2
#define WGM_FFN2 PG8_WGM
#endif
#ifndef WGM_MOE1
#define WGM_MOE1 PG8_WGM
#endif
#ifndef WGM_MOE2
#define WGM_MOE2 PG8_WGM
#endif
#ifndef FFN_CHUNKS
#define FFN_CHUNKS 2
#endif
#ifndef REP_GEMM
#define REP_GEMM 1
#endif
#ifndef REP_STICK
#define REP_STICK 1
#endif
#ifndef REP_NSA
#define REP_NSA 1
#endif
#ifndef REP_SGU
#define REP_SGU 1
#endif
#ifndef REP_NORM
#define REP_NORM 1
#endif
template <class Epi, class Sched> __device__ __forceinline__ void run_gemm(Frame& F, const bf16* A, const bf16* Bt, int M, int N, int K, const Sched& S, Epi E, bool rotate = true, int tiled = 0, int ld = 0) {
    const int nt_ = K / 64;
#ifdef PG8_KROT
    const int rot_ = rotate ? 2 * (((F.bx & 7) * (nt_ / 2)) / 8) : 0;
#else
    const int rot_ = 0;
#endif
    pg8::Gemm g{A, Bt, M, N, K + F.zs, F.tid, rot_ + F.zs, tiled + F.zs, ld + F.zs, nullptr};
    if (F.rep) E.set_scale0();
    pg8::gemm_phase<Epi, Sched, PG8_ALIGN_EPI, PG8_SP2>(F.lds + RING_OFF, g, S, E);
}
template <class Epi, class Sched> __device__ __forceinline__ void run_gemm_gather(Frame& F, const bf16* A, const int* gidx, const bf16* Bt, int M, int N, int K, const Sched& S, Epi E) {
    const int nt_ = K / 64;
#ifdef PG8_KROT
    const int rot_ = 2 * (((F.bx & 7) * (nt_ / 2)) / 8);
#else
    const int rot_ = 0;
#endif
    pg8::Gemm g{A, Bt, M, N, K + F.zs, F.tid, rot_ + F.zs, F.zs, F.zs, gidx};
    if (F.rep) E.set_scale0();
    pg8::gemm_phase<Epi, Sched, PG8_ALIGN_EPI, PG8_SP2, true>(F.lds + RING_OFF, g, S, E);
}
__global__ void __launch_bounds__(NWAVES * 64, 2) mk_fwd(Args args) {
    extern __shared__ __attribute__((aligned(16))) unsigned char lds[];
    Frame F0;
    F0.lds = (LAS unsigned char*)lds;
    F0.tid = threadIdx.x; F0.lane = F0.tid & 63; F0.wave = __builtin_amdgcn_readfirstlane(F0.tid >> 6);
    F0.G = gridDim.x; F0.bx = blockIdx.x; F0.vcu = (F0.G % 8 == 0) ? (F0.bx % 8) * (F0.G / 8) + F0.bx / 8 : F0.bx; F0.zv = 0; F0.zs = 0;
    F0.rep = args.rep; F0.ws = args.ws; F0.ctl = (unsigned*)(args.ws + WS_CTL); F0.in = args.in; F0.out = args.out;
    for (int u = F0.tid; u < (LDS_BYTES - LDSCTL_OFF) / 4; u += NWAVES * 64) ((LAS unsigned*)(F0.lds + LDSCTL_OFF))[u] = 0u;
    __syncthreads();
    const int lo = args.lo, hi = args.hi;
    XcdBarrier bar; bar.bar = F0.ctl + CW_BAR + args.li * XCD_BAR_WORDS; bar.x = 0; bar.st = nullptr; bar.w = 0; bar.z = 0;
    if (hi - lo > 1) bar = xcd_barrier_post(F0.ctl + CW_BAR + args.li * XCD_BAR_WORDS, (volatile LAS unsigned*)(F0.lds + MISC_OFF) + 8);
    int step = 0;
#define STEP_BEGIN if (step >= lo && step < hi) { Frame F = F0; { int zv_, zs_; asm volatile("v_mov_b32 %0, 0" : "=v"(zv_)); asm volatile("s_mov_b32 %0, 0" : "=s"(zs_)); \
        F.zv = zv_; F.zs = zs_; F.lane = (int)__builtin_amdgcn_mbcnt_hi(~0u, __builtin_amdgcn_mbcnt_lo(~0u, (unsigned)zv_)); F.wave = F0.wave + zs_; F.tid = F.wave * 64 + F.lane; F.bx = F.bx + zs_; \
        F.vcu = F0.vcu + zs_; F.G = F0.G + zs_; F.lds = (LAS unsigned char*)lds + zs_; F.ws = F0.ws + zs_; F.ctl = F0.ctl + zs_; F.in = F0.in + zs_; F.out = F0.out + zs_; }
#ifdef PROBE_XBAR
#define STEP_END   if (step + 1 < hi) { unsigned zb_; asm volatile("v_mov_b32 %0, 0" : "=v"(zb_)); bar.z = zb_; xcd_barrier(bar); xcd_barrier(bar); } } ++step;
#else
#define STEP_END   if (step + 1 < hi) { unsigned zb_; asm volatile("v_mov_b32 %0, 0" : "=v"(zb_)); bar.z = zb_; xcd_barrier(bar); } } ++step;
#endif

    for (int layer = 0; layer < DEPTH; ++layer) {
        const int jj = layer >> 1;
        STEP_BEGIN
            p_convert(F, layer);
            if (layer == 0) p_norm<3, false>(F, F.in[0], nullptr, nullptr, 0); else p_rstd(F);
        STEP_END
        for (int c = 0; c < NCHUNK; ++c) {
            STEP_BEGIN
                pg8::StaticOrder S; S.init(MC, NPROJ, F.G, F.bx, WGM_PROJ);
                pg8::EpiProj E{WSP(bf16, WS_P1), WSP(bf16, WS_G), WSP(float, WS_RSTD) + (size_t)c * MC};
                run_gemm(F, (layer == 0 ? WSP(bf16, WS_HN) : WSP(bf16, WS_H)) + (size_t)c * MC * DM, WSP(bf16, WS_WIN), MC, NPROJ, DM, S, E);
            STEP_END
            STEP_BEGIN
                p_prep(F);
            STEP_END
            STEP_BEGIN
                LAS int* tab = (LAS int*)(F.lds + TAB_OFF);
                __syncthreads(); if (F.tid < 16) tab[F.tid] = F.tid >> 3; __syncthreads();
                pg8::GroupedOrder S; S.so.init(2 * 2048, 512, F.G, F.bx); S.tile_e = tab; S.nN = 2;
                pg8::EpiF32 E{WSP(float, WS_UL), 512, 2};
                run_gemm(F, WSP(bf16, WS_KVC), WSP(bf16, WS_WC1), 2 * 2048, 512, DM, S, E);
                p_sgu2(F, layer);
                p_stick2(F, F.G > 64 ? 32 : 0);
            STEP_END
            STEP_BEGIN
                p_cmpfin(F, layer);
            STEP_END
            STEP_BEGIN
#ifdef OLD_NSA
                p_nsa(F);
#else
                p_nsa2(F);
#endif
            STEP_END
            STEP_BEGIN
                pg8::MergeOrder S; S.so.init(MC, DM, F.G, F.bx); S.nmt = MC / 256;
                pg8::EpiMerge E{WSP(bf16, WS_G), WSP(bf16, WS_MG), MC / 256};
                run_gemm(F, WSP(bf16, WS_Y), WSP(bf16, WS_WBR), 3 * MC, 3 * DM, 256, S, E);
            STEP_END
            STEP_BEGIN
                pg8::StaticOrder S; S.init(MC, DM, F.G, F.bx);
                pg8::EpiResid E{layer == 0 ? F.in[0] + (size_t)c * MC * DM : nullptr, WSP(bf16, WS_H) + (size_t)c * MC * DM, DM, 1.0f};
                run_gemm(F, WSP(bf16, WS_MG), WSP(bf16, WS_WOUT), MC, DM, DM, S, E);
            STEP_END
        }
        if ((layer & 1) == 0) {
            STEP_BEGIN
                p_rstd(F);
            STEP_END
            for (int c = 0; c < FFN_CHUNKS; ++c) {
                constexpr int MF = MTOK / FFN_CHUNKS;
                STEP_BEGIN
                    pg8::StaticOrder S; S.init(MF, NFF1, F.G, F.bx, WGM_FFN1);
                    pg8::EpiSwiGLU E{WSP(bf16, WS_HID), DFFP, nullptr, NFF1 / 256, WSP(float, WS_RSTD) + (size_t)c * MF};
                    run_gemm(F, WSP(bf16, WS_H) + (size_t)c * MF * DM, WSP(bf16, WS_WF1), MF, NFF1, DM, S, E, true, TILED_FFN1);
                STEP_END
                STEP_BEGIN
                    pg8::StaticOrder S; S.init(MF, DM, F.G, F.bx, WGM_FFN2);
                    pg8::EpiResid E{nullptr, WSP(bf16, WS_H) + (size_t)c * MF * DM, DM, 1.0f};
                    run_gemm(F, WSP(bf16, WS_HID), WSP(bf16, WS_WF2), MF, DM, DFFP, S, E);
                STEP_END
            }
        } else {
            STEP_BEGIN
                p_norm<1, true>(F, WSP(bf16, WS_H), F.in[11] + (size_t)layer * DM, F.in[15] + (size_t)jj * DM * NEXP, jj, Q8_HN);
            STEP_END
#ifdef ABL_DENSE_MOE
            for (int e = 0; e < NEXP; ++e) {
                STEP_BEGIN
                    pg8::StaticOrder S; S.init(MTOK, NMOE1, F.G, F.bx);
                    pg8::EpiSwiGLU E{WSP(bf16, WS_SCR + 8 * MiB), DFE, WSP(float, WS_SCR + 4 * MiB) + (size_t)e * MTOK, NMOE1 / 256, WSP(float, WS_RSTD)};
                    run_gemm(F, WSP(bf16, WS_HN), WSP(bf16, WS_WF1) + (size_t)e * NMOE1 * DM, MTOK, NMOE1, DM, S, E);
                STEP_END
                STEP_BEGIN
                    pg8::StaticOrder S; S.init(MTOK, DM, F.G, F.bx);
                    pg8::EpiResid E{nullptr, WSP(bf16, WS_H), DM, 1.0f};
                    run_gemm(F, WSP(bf16, WS_SCR + 8 * MiB), WSP(bf16, WS_WF2) + (size_t)e * DM * DFE, MTOK, DM, DFE, S, E);
                STEP_END
            }
#else
            STEP_BEGIN
                p_gather(F, jj, 0, 0); p_gather(F, jj, 0, 1);
            STEP_END
            for (int c = 0; c < NCHUNK; ++c) {
                STEP_BEGIN
                    int dealt = 0;
                    for (int r = 0; r < 2; ++r) {
                        const int T = moe_table(F, jj, c, r);
                        int cw = F.bx - dealt % F.G; if (cw < 0) cw += F.G;
                        pg8::GroupedOrder S; S.so.init(T * 256, NMOE1, F.G, cw, WGM_MOE1); S.tile_e = (LAS int*)(F.lds + TAB_OFF); S.nN = NMOE1 / 256;
                        pg8::EpiSwiGLU E{WSP(bf16, WS_HIDM) + (size_t)r * SLOTS * DFE, DFE, WSP(float, WS_WSLOT) + (c * 2 + r) * SLOTS, NMOE1 / 256, WSP(float, WS_RSLOT) + (c * 2 + r) * SLOTS};
                        run_gemm_gather(F, WSP(bf16, WS_H), WSP(int, WS_TOKMAP) + (c * 2 + r) * SLOTS, WSP(bf16, WS_WF1), T * 256, NMOE1, DM, S, E);
                        dealt += T * (NMOE1 / 256);
                        __syncthreads();
                    }
                STEP_END
                for (int r = 0; r < 2; ++r) {
                    STEP_BEGIN
                        const int T = moe_table(F, jj, c, r);
                        const int nwg = T * (DM / 256), R = nwg % F.G, full = nwg - R;
                        const int NS = (4 * R <= F.G) ? 4 : 2;
                        const bool split = (hi - lo > 1) && R > 0 && NS * R <= F.G && !F.rep;
                        int* tokm = WSP(int, WS_TOKMAP) + (c * 2 + r) * SLOTS; float* TB = WSP(float, WS_TB); const bf16* HIDr = WSP(bf16, WS_HIDM) + (size_t)r * SLOTS * DFE;
                        { pg8::LimitOrder S; S.so.init(T * 256, DM, F.G, F.bx, WGM_MOE2); S.limit = split ? full : nwg;
                          pg8::GroupedLimit GS{S, (LAS int*)(F.lds + TAB_OFF), DM / 256};
                          pg8::EpiScatter E{WSP(bf16, WS_H), tokm, DM / 256, 1.0f};
                          run_gemm(F, HIDr, WSP(bf16, WS_WF2), T * 256, DM, DFE, GS, E, true); }
                        const bool more = r == 1 && c + 1 < NCHUNK;
                        if (split) {
                            const int KP = DFE / NS;
                            if (F.bx < NS * R) { const int Lx = full + F.bx / NS, kp = F.bx % NS;
                                pg8::StaticOrder so; so.init(T * 256, DM, F.G, Lx % F.G, WGM_MOE2); pg8::Unit un; so.next(Lx / F.G, un);
                                un.pn += ((LAS int*)(F.lds + TAB_OFF))[un.pm] * (DM / 256);
                                pg8::SingleOrder S1{un};
                                if (kp == 0) { pg8::EpiScatter E{WSP(bf16, WS_H), tokm, DM / 256, 1.0f};
                                    run_gemm(F, HIDr, WSP(bf16, WS_WF2), T * 256, DM, KP, S1, E, false, 0, DFE); }
                                else { pg8::EpiTile E{TB + ((size_t)(Lx - full) * 3 + (kp - 1)) * 65536};
                                    run_gemm(F, HIDr + kp * KP, WSP(bf16, WS_WF2) + kp * KP, T * 256, DM, KP, S1, E, false, 0, DFE); } }
                            if (more) { p_gather(F, jj, c + 1, 0, NS * R); p_gather(F, jj, c + 1, 1, NS * R); }
                            { unsigned zb_; asm volatile("v_mov_b32 %0, 0" : "=v"(zb_)); bar.z = zb_; xcd_barrier(bar); }
                            for (int it = (F.vcu * NWAVES + F.wave); it < R * 256; it += F.G * NWAVES) { const int j = it >> 8, row = it & 255, Lx = full + j;
                                pg8::StaticOrder so; so.init(T * 256, DM, F.G, Lx % F.G, WGM_MOE2); pg8::Unit un; so.next(Lx / F.G, un);
                                const int t = tokm[un.pm * 256 + row];
                                if (t >= 0) { v2u* hp = (v2u*)(WSP(bf16, WS_H) + (size_t)t * DM + un.pn * 256) + F.lane; const v2u hv = *hp; f32x4 a = (f32x4){bflo(hv.x), bfhi(hv.x), bflo(hv.y), bfhi(hv.y)};
                                    for (int q = 0; q < NS - 1; ++q) a = a + ((const f32x4*)(TB + ((size_t)j * 3 + q) * 65536 + row * 256))[F.lane];
                                    *hp = (v2u){pk2(a.x, a.y), pk2(a.z, a.w)}; } }
                        } else if (!F.rep && more) { p_gather(F, jj, c + 1, 0, R); p_gather(F, jj, c + 1, 1, R); }
                    STEP_END
                }
            }
#endif
        }
    }
    STEP_BEGIN
        p_norm<2, true>(F, WSP(bf16, WS_H), F.in[19], nullptr, 0);
    STEP_END
#undef STEP_BEGIN
#undef STEP_END
}

#ifndef MK_STEPS_PER_LAUNCH
#define MK_STEPS_PER_LAUNCH 1
#endif
extern "C" void kernel_launch(void* const* d_in, const int* in_sizes, int n_in, void* d_out, int out_size, void* d_ws, size_t ws_size, hipStream_t stream) {
    static int grid = 0;
    if (grid == 0) {
        if (n_in != 20 || in_sizes[0] != MTOK * DM || out_size != MTOK * DM || ws_size < WS_END) { fprintf(stderr, "kernel_launch: unexpected shapes (n_in %d, in0 %d, out %d, ws %zu)\n", n_in, n_in > 0 ? in_sizes[0] : -1, out_size, ws_size); grid = -1; return; }
        int dev = 0, cus = 0, per_cu = 0;
        if (hipGetDevice(&dev) != hipSuccess || hipDeviceGetAttribute(&cus, hipDeviceAttributeMultiprocessorCount, dev) != hipSuccess) { grid = -1; return; }
        if (hipFuncSetAttribute((const void*)mk_fwd, hipFuncAttributeMaxDynamicSharedMemorySize, LDS_BYTES) != hipSuccess) { fprintf(stderr, "kernel_launch: hipFuncSetAttribute failed\n"); grid = -1; return; }
        if (hipOccupancyMaxActiveBlocksPerMultiprocessor(&per_cu, (const void*)mk_fwd, NWAVES * 64, LDS_BYTES) != hipSuccess || per_cu < 1) fprintf(stderr, "kernel_launch: occupancy query reports %d\n", per_cu);
        (void)hipGetLastError();
        grid = cus;
    }
    if (grid < 0) return;
    if (hipMemsetAsync((char*)d_ws + WS_CTL, 0, CTL_ZERO_BYTES, stream) != hipSuccess) return;
    Args a{};
    for (int i = 0; i < 20; ++i) a.in[i] = (const float*)d_in[i];
    a.out = (float*)d_out; a.ws = (unsigned char*)d_ws; a.rep = 0;
    #ifdef ABL_DENSE_MOE
    constexpr int NSTEPS = 2 * (1 + NCHUNK * 8 + 3) + 2 * (1 + NCHUNK * 8 + 1 + NEXP * 2) + 1;
#else
    constexpr int NSTEPS = 2 * (1 + NCHUNK * 7 + 1 + 2 * FFN_CHUNKS) + 2 * (1 + NCHUNK * 7 + 2 + NCHUNK * 3) + 1;
#endif
    int li = 0;
#ifdef REPMASK
    static int kinds[256]; int ns = 0;
    for (int layer = 0; layer < DEPTH; ++layer) { kinds[ns++] = 0;
        for (int c = 0; c < NCHUNK; ++c) for (int q = 1; q <= 8; ++q) if (q != 5) kinds[ns++] = q;
        if ((layer & 1) == 0) { kinds[ns++] = 9; for (int c = 0; c < FFN_CHUNKS; ++c) { kinds[ns++] = 10; kinds[ns++] = 11; } }
        else { kinds[ns++] = 12; kinds[ns++] = 17; for (int c = 0; c < NCHUNK; ++c) { kinds[ns++] = 14; kinds[ns++] = 13; kinds[ns++] = 13; } } }
    kinds[ns++] = 16;
    for (int s = 0; s < NSTEPS; ++s) { const int reps = ((REPMASK >> kinds[s]) & 1) ? 2 : 1;
        for (int r = 0; r < reps; ++r) { a.lo = s; a.hi = s + 1; a.li = 0; a.rep = r;
            hipLaunchKernelGGL(mk_fwd, dim3(grid), dim3(NWAVES * 64), LDS_BYTES, stream, a); } }
    (void)li;
#else
    for (int s = 0; s < NSTEPS; s += MK_STEPS_PER_LAUNCH) {
        a.lo = s; a.hi = (s + MK_STEPS_PER_LAUNCH < NSTEPS) ? s + MK_STEPS_PER_LAUNCH : NSTEPS; a.li = (MK_STEPS_PER_LAUNCH > 1) ? li : 0; ++li;
        hipLaunchKernelGGL(mk_fwd, dim3(grid), dim3(NWAVES * 64), LDS_BYTES, stream, a);
        if (hipPeekAtLastError() != hipSuccess) { fprintf(stderr, "kernel_launch: launch failed\n"); break; }
    }
#endif
}
```

```cpp
#define MK_STEPS_PER_LAUNCH 1000
#define PG8_WGM 4
#define FFN_CHUNKS 1
#define PG8_KROT 1
#include <hip/hip_runtime.h>
#include <cstdio>
#include <cstdint>
#include <cmath>
#ifndef PG8_AUX_A
#define PG8_AUX_A 0
#endif
#ifndef PG8_AUX_B
#define PG8_AUX_B 0
#endif
#ifndef PG8_WGM
#define PG8_WGM 8
#endif
namespace pg8 {
#define PG8_LAS __attribute__((address_space(3)))
typedef unsigned short bf16_t;
typedef short bf16x8 __attribute__((ext_vector_type(8)));
typedef float f32x4 __attribute__((ext_vector_type(4)));
typedef unsigned u32x4 __attribute__((ext_vector_type(4)));
constexpr int BM = 256, BK = 64, HALF = 128, HTB = HALF * BK * 2  , STAGE_BYTES = 8 * HTB, NXCD = 8, WGM = PG8_WGM;

__host__ __device__ __forceinline__ int lds_byte(int r, int c) { const int st = (r >> 4) * 2 + (c >> 5), rr = r & 15, cc = c & 31, ob = rr * 64 + cc * 2; return st * 1024 + (ob ^ (((ob >> 9) & 1) << 5)); }
__host__ __device__ __forceinline__ void stage_rc(int b, int& R, int& C) { const int st = b / 1024, sb = b % 1024, swz = sb ^ (((sb >> 9) & 1) << 5); R = (st >> 1) * 16 + swz / 64; C = (st & 1) * 32 + (swz % 64) / 2; }
__host__ __device__ __forceinline__ int perm32(int rho) { const int n = rho >> 4, i = rho & 15; return 8 * (i >> 2) + 4 * n + (i & 3); }

struct Unit { int pm, pn; };
struct Gemm { const bf16_t* A; const bf16_t* Bt; int M, N, K; int zv; int rot; int tiled; int ld; const int* gidx; };

struct StaticOrder {
    int nM, nN, nwg, G, c, wgm;
    __host__ __device__ __forceinline__ void init(int M, int N, int G_, int c_, int wgm_ = WGM) { nM = M / BM; nN = N / BM; nwg = nM * nN; G = G_; c = c_; wgm = wgm_; }
    __host__ __device__ __forceinline__ bool next(int i, Unit& u) const {
        const long L = (long)i * G + c; if (L >= nwg) return false;
        int wgid = (int)L; { const int q = nwg / NXCD, r = nwg % NXCD, xcd = wgid % NXCD, off = wgid / NXCD; wgid = (xcd < r ? xcd * (q + 1) : r * (q + 1) + (xcd - r) * q) + off; }
        const int nig = wgm * nN, gid = wgid / nig, fm = gid * wgm, gsz = (nM - fm) < wgm ? (nM - fm) : wgm;
        u.pm = fm + ((wgid % nig) % gsz); u.pn = (wgid % nig) / gsz; return true;
    }
    __device__ __forceinline__ void a_ready(const Unit&) const {}
    __device__ __forceinline__ void done(const Unit&) const {}
};

__device__ __forceinline__ unsigned cvt_pk_bf16(float lo, float hi) { unsigned r; asm volatile("v_cvt_pk_bf16_f32 %0, %1, %2" : "=v"(r) : "v"(lo), "v"(hi)); return r; }
typedef float f32x2 __attribute__((ext_vector_type(2)));

__device__ __forceinline__ float fast_sigmoid(float x) { return __builtin_amdgcn_rcpf(1.0f + __builtin_amdgcn_exp2f(-1.4426950408889634f * x)); }
__device__ __forceinline__ float gelu_tanh(float x) {
    const float u2 = 1.5957691216057308f * (x + 0.044715f * x * x * x);
    return x * fast_sigmoid(u2);
}
__device__ __forceinline__ float bf_lo(unsigned u) { return __builtin_bit_cast(float, u << 16); }
__device__ __forceinline__ float bf_hi(unsigned u) { return __builtin_bit_cast(float, u & 0xffff0000u); }

#ifdef PG8_NT_OUT
#define PG8_STORE_OUT(p, v) __builtin_nontemporal_store((v), (p))
#else
#define PG8_STORE_OUT(p, v) (*(p) = (v))
#endif
struct EpiProj {
    static constexpr bool PERM = true, AFTER_DRAIN = false, MID = false; static constexpr int MID_TILES = 1; __device__ __forceinline__ bool keep_acc(const Unit&) const { return false; } __device__ __forceinline__ void set_scale0() {}
    bf16_t* P1; bf16_t* G; const float* rstd;
    __device__ __forceinline__ void operator()(const f32x4 (&acc)[2][2][4][2], const Unit& u, int wr, int wc, int fr, int fq) const {
        const int row0 = u.pm * BM + wr * 64 + fr;
        float rsv[8];
#pragma unroll
        for (int q = 0; q < 8; ++q) rsv[q] = rstd[row0 + (q >> 2) * HALF + (q & 3) * 16];
        bf16_t* base; int ldc, colt, act0, act1;
        if (u.pn < 8) { base = P1; ldc = 2048; colt = u.pn * BM; act0 = (u.pn < 2) ? 1 : 0; act1 = (u.pn == 7) ? 2 : act0; }
        else { base = G; ldc = 3072; colt = (u.pn - 8) * BM; act0 = 2; act1 = 2; }
        const int col0 = colt + wc * 32 + 8 * fq;
#pragma unroll
        for (int ai = 0; ai < 2; ++ai)
#pragma unroll
            for (int m = 0; m < 4; ++m) { bf16_t* rowp = base + (size_t)(row0 + ai * HALF + m * 16) * ldc + col0;
#pragma unroll
                for (int bj = 0; bj < 2; ++bj) { f32x4 v0 = acc[ai][bj][m][0] * rsv[ai * 4 + m], v1 = acc[ai][bj][m][1] * rsv[ai * 4 + m]; const int act = bj ? act1 : act0;
                    if (act == 1) {
#pragma unroll
                        for (int e = 0; e < 4; ++e) { v0[e] = gelu_tanh(v0[e]); v1[e] = gelu_tanh(v1[e]); } }
                    else if (act == 2) {
#pragma unroll
                        for (int e = 0; e < 4; ++e) { v0[e] = fast_sigmoid(v0[e]); v1[e] = fast_sigmoid(v1[e]); } }
                    u32x4 w; w.x = cvt_pk_bf16(v0[0], v0[1]); w.y = cvt_pk_bf16(v0[2], v0[3]); w.z = cvt_pk_bf16(v1[0], v1[1]); w.w = cvt_pk_bf16(v1[2], v1[3]);
                    *(u32x4*)(rowp + bj * HALF) = w; } }
    }
};
struct EpiMerge {
    static constexpr bool PERM = true, AFTER_DRAIN = false, MID = false; static constexpr int MID_TILES = 1; __device__ __forceinline__ void set_scale0() {}
    const bf16_t* G; bf16_t* MG; int nmt;
    __device__ __forceinline__ bool keep_acc(const Unit& u) const { return (u.pn >> 2) < 2; }
    __device__ __forceinline__ void operator()(f32x4 (&acc)[2][2][4][2], const Unit& u, int wr, int wc, int fr, int fq) const {
        const int i = u.pn >> 2, pn = u.pn & 3, pm = u.pm - i * nmt;
        const int row0 = pm * BM + wr * 64 + fr, col0 = pn * BM + wc * 32 + 8 * fq;
#pragma unroll
        for (int ai = 0; ai < 2; ++ai)
#pragma unroll
            for (int mp = 0; mp < 2; ++mp) {
                u32x4 g[4], h[4];
#pragma unroll
                for (int q = 0; q < 4; ++q) { const int m = 2 * mp + (q >> 1), bj = q & 1; const size_t row = (size_t)(row0 + ai * HALF + m * 16); const int col = col0 + bj * HALF;
                    g[q] = *(const u32x4*)(G + row * 3072 + i * 1024 + col);
                    if (i < 2) h[q] = *(const u32x4*)(G + row * 3072 + (i + 1) * 1024 + col); else h[q] = (u32x4){0u, 0u, 0u, 0u}; }
#pragma unroll
                for (int q = 0; q < 4; ++q) { const int m = 2 * mp + (q >> 1), bj = q & 1; const size_t row = (size_t)(row0 + ai * HALF + m * 16); const int col = col0 + bj * HALF;
                    f32x4& v0 = acc[ai][bj][m][0]; f32x4& v1 = acc[ai][bj][m][1];
                    float f[8] = {bf_lo(g[q].x), bf_hi(g[q].x), bf_lo(g[q].y), bf_hi(g[q].y), bf_lo(g[q].z), bf_hi(g[q].z), bf_lo(g[q].w), bf_hi(g[q].w)};
                    if (i < 2) { const float d[8] = {bf_lo(h[q].x), bf_hi(h[q].x), bf_lo(h[q].y), bf_hi(h[q].y), bf_lo(h[q].z), bf_hi(h[q].z), bf_lo(h[q].w), bf_hi(h[q].w)};
#pragma unroll
                        for (int e = 0; e < 8; ++e) f[e] = fmaxf(f[e], 1e-20f) * __builtin_amdgcn_rcpf(fmaxf(d[e], 1e-20f)); }
                    else {
#pragma unroll
                        for (int e = 0; e < 8; ++e) f[e] = fmaxf(f[e], 1e-20f); }
                    v0[0] *= f[0]; v0[1] *= f[1]; v0[2] *= f[2]; v0[3] *= f[3]; v1[0] *= f[4]; v1[1] *= f[5]; v1[2] *= f[6]; v1[3] *= f[7];
                    if (i == 2) { u32x4 w; w.x = cvt_pk_bf16(v0[0], v0[1]); w.y = cvt_pk_bf16(v0[2], v0[3]); w.z = cvt_pk_bf16(v1[0], v1[1]); w.w = cvt_pk_bf16(v1[2], v1[3]);
                        *(u32x4*)(MG + row * 1024 + col) = w; } } }
    }
};
typedef unsigned u32x2 __attribute__((ext_vector_type(2)));
struct EpiResid {
    static constexpr bool PERM = false, AFTER_DRAIN = false, MID = false; static constexpr int MID_TILES = 1; __device__ __forceinline__ bool keep_acc(const Unit&) const { return false; } __device__ __forceinline__ void set_scale0() { scale = 0.f; x32 = nullptr; }
    const float* x32; bf16_t* out; int ldc; float scale;
    __device__ __forceinline__ void operator()(const f32x4 (&acc)[2][2][4][2], const Unit& u, int wr, int wc, int fr, int fq) const {
        const int row0 = u.pm * BM + wr * 64 + fr, col0 = u.pn * BM + wc * 32 + 4 * fq;
#pragma unroll
        for (int ai = 0; ai < 2; ++ai)
#pragma unroll
            for (int mp = 0; mp < 2; ++mp) {
                f32x4 b[8];
                if (x32) {
#pragma unroll
                    for (int q = 0; q < 8; ++q) { const int m = 2 * mp + (q >> 2), bj = (q >> 1) & 1, n = q & 1;
                        b[q] = *(const f32x4*)(x32 + (size_t)(row0 + ai * HALF + m * 16) * ldc + col0 + bj * HALF + n * 16); }
                } else {
                    u32x2 t[8];
#pragma unroll
                    for (int q = 0; q < 8; ++q) { const int m = 2 * mp + (q >> 2), bj = (q >> 1) & 1, n = q & 1;
                        t[q] = *(const u32x2*)(out + (size_t)(row0 + ai * HALF + m * 16) * ldc + col0 + bj * HALF + n * 16); }
#pragma unroll
                    for (int q = 0; q < 8; ++q) b[q] = (f32x4){bf_lo(t[q].x), bf_hi(t[q].x), bf_lo(t[q].y), bf_hi(t[q].y)};
                }
#pragma unroll
                for (int q = 0; q < 8; ++q) { const int m = 2 * mp + (q >> 2), bj = (q >> 1) & 1, n = q & 1; const f32x4 r = b[q] + acc[ai][bj][m][n] * scale;
                    *(u32x2*)(out + (size_t)(row0 + ai * HALF + m * 16) * ldc + col0 + bj * HALF + n * 16) = (u32x2){cvt_pk_bf16(r.x, r.y), cvt_pk_bf16(r.z, r.w)}; } }
    }
};
struct EpiF32 {
    static constexpr bool PERM = false, AFTER_DRAIN = false, MID = false; static constexpr int MID_TILES = 1; __device__ __forceinline__ bool keep_acc(const Unit&) const { return false; } __device__ __forceinline__ void set_scale0() {}
    float* O; int ldc, nN;
    __device__ __forceinline__ void operator()(const f32x4 (&acc)[2][2][4][2], const Unit& u, int wr, int wc, int fr, int fq) const {
        const int row0 = u.pm * BM + wr * 64 + fr, col0 = (u.pn % nN) * BM + wc * 32 + 4 * fq;
#pragma unroll
        for (int ai = 0; ai < 2; ++ai)
#pragma unroll
            for (int m = 0; m < 4; ++m) { const size_t off = (size_t)(row0 + ai * HALF + m * 16) * ldc + col0;
#pragma unroll
                for (int bj = 0; bj < 2; ++bj)
#pragma unroll
                    for (int n = 0; n < 2; ++n) *(f32x4*)(O + off + bj * HALF + n * 16) = acc[ai][bj][m][n]; }
    }
};
#ifdef EMU_FP8_HID
__device__ __forceinline__ float Q8H(float x) { const int p = __builtin_amdgcn_cvt_pk_fp8_f32(x * 8.f, x * 8.f, 0, false); return __builtin_amdgcn_cvt_f32_fp8(p, 0) * 0.125f; }
#else
__device__ __forceinline__ float Q8H(float x) { return x; }
#endif
struct EpiSwiGLU {
    static constexpr bool PERM = true, AFTER_DRAIN = false, MID = false; static constexpr int MID_TILES = 1; __device__ __forceinline__ bool keep_acc(const Unit&) const { return false; } __device__ __forceinline__ void set_scale0() {}
    bf16_t* H; int ldh; const float* rowscale; int nN; const float* prescale; int rowmask = 0x7fffffff;
    __device__ __forceinline__ void operator()(const f32x4 (&acc)[2][2][4][2], const Unit& u, int wr, int wc, int fr, int fq) const {
        const int row0 = u.pm * BM + wr * 64 + fr, col0 = (u.pn % nN) * HALF + wc * 32 + 8 * fq;
        float scv[8];
#pragma unroll
        for (int q = 0; q < 8; ++q) scv[q] = rowscale ? rowscale[row0 + (q >> 2) * HALF + (q & 3) * 16] : 1.0f;
        float psv[8];
#pragma unroll
        for (int q = 0; q < 8; ++q) psv[q] = prescale[row0 + (q >> 2) * HALF + (q & 3) * 16];
#pragma unroll
        for (int ai = 0; ai < 2; ++ai)
#pragma unroll
            for (int m = 0; m < 4; ++m) { const int row = row0 + ai * HALF + m * 16; const float sc = scv[ai * 4 + m], ps = psv[ai * 4 + m];
                float h[8];
#pragma unroll
                for (int n = 0; n < 2; ++n)
#pragma unroll
                    for (int e = 0; e < 4; ++e) { const float g = acc[ai][0][m][n][e] * ps, up = acc[ai][1][m][n][e] * (ps * sc); h[n * 4 + e] = Q8H(g * fast_sigmoid(g) * up); }
                u32x4 w; w.x = cvt_pk_bf16(h[0], h[1]); w.y = cvt_pk_bf16(h[2], h[3]); w.z = cvt_pk_bf16(h[4], h[5]); w.w = cvt_pk_bf16(h[6], h[7]);
                PG8_STORE_OUT((u32x4*)(H + (size_t)(row & rowmask) * ldh + col0), w); }
    }
};
struct EpiScatter {
    static constexpr bool PERM = false, AFTER_DRAIN = false, MID = false; static constexpr int MID_TILES = 1; __device__ __forceinline__ bool keep_acc(const Unit&) const { return false; } __device__ __forceinline__ void set_scale0() { scale = 0.f; }
    bf16_t* out; const int* tok; int nN; float scale;
    __device__ __forceinline__ void operator()(const f32x4 (&acc)[2][2][4][2], const Unit& u, int wr, int wc, int fr, int fq) const {
        const int row0 = u.pm * BM + wr * 64 + fr, col0 = (u.pn % nN) * BM + wc * 32 + 4 * fq;
        int tk[8];
#pragma unroll
        for (int q = 0; q < 8; ++q) tk[q] = tok[row0 + (q >> 2) * HALF + (q & 3) * 16];
#pragma unroll
        for (int ai = 0; ai < 2; ++ai)
#pragma unroll
            for (int mp = 0; mp < 2; ++mp) {
                u32x2 b[8];
#pragma unroll
                for (int q = 0; q < 8; ++q) { const int m = 2 * mp + (q >> 2), bj = (q >> 1) & 1, n = q & 1; const int t = tk[ai * 4 + m];
                    b[q] = *(const u32x2*)(out + (size_t)(t < 0 ? 0 : t) * 1024 + col0 + bj * HALF + n * 16); }
#pragma unroll
                for (int q = 0; q < 8; ++q) { const int m = 2 * mp + (q >> 2), bj = (q >> 1) & 1, n = q & 1; const int t = tk[ai * 4 + m];
                    if (t >= 0) { const f32x4 r = (f32x4){bf_lo(b[q].x), bf_hi(b[q].x), bf_lo(b[q].y), bf_hi(b[q].y)} + acc[ai][bj][m][n] * scale;
                        *(u32x2*)(out + (size_t)t * 1024 + col0 + bj * HALF + n * 16) = (u32x2){cvt_pk_bf16(r.x, r.y), cvt_pk_bf16(r.z, r.w)}; } } }
    }
};
struct GroupedOrder {
    StaticOrder so; const PG8_LAS int* tile_e; int nN;
    __device__ __forceinline__ bool next(int i, Unit& u) const { if (!so.next(i, u)) return false; u.pn += tile_e[u.pm] * nN; return true; }
    __device__ __forceinline__ void a_ready(const Unit&) const {}
    __device__ __forceinline__ void done(const Unit&) const {}
};
struct LimitOrder {
    StaticOrder so; int limit;
    __device__ __forceinline__ bool next(int i, Unit& u) const { if ((long)i * so.G + so.c >= limit) return false; return so.next(i, u); }
    __device__ __forceinline__ void a_ready(const Unit&) const {}
    __device__ __forceinline__ void done(const Unit&) const {}
};
struct GroupedLimit {
    LimitOrder lo; const PG8_LAS int* tile_e; int nN;
    __device__ __forceinline__ bool next(int i, Unit& u) const { if (!lo.next(i, u)) return false; u.pn += tile_e[u.pm] * nN; return true; }
    __device__ __forceinline__ void a_ready(const Unit&) const {}
    __device__ __forceinline__ void done(const Unit&) const {}
};
struct SingleOrder {
    Unit un;
    __device__ __forceinline__ bool next(int i, Unit& u) const { if (i != 0) return false; u = un; return true; }
    __device__ __forceinline__ void a_ready(const Unit&) const {}
    __device__ __forceinline__ void done(const Unit&) const {}
};
struct EpiTile {
    static constexpr bool PERM = false, AFTER_DRAIN = false, MID = false; static constexpr int MID_TILES = 1; __device__ __forceinline__ bool keep_acc(const Unit&) const { return false; } __device__ __forceinline__ void set_scale0() {}
    float* O;
    __device__ __forceinline__ void operator()(const f32x4 (&acc)[2][2][4][2], const Unit&, int wr, int wc, int fr, int fq) const {
#pragma unroll
        for (int ai = 0; ai < 2; ++ai)
#pragma unroll
            for (int m = 0; m < 4; ++m)
#pragma unroll
                for (int bj = 0; bj < 2; ++bj)
#pragma unroll
                    for (int n = 0; n < 2; ++n) *(f32x4*)(O + (size_t)(wr * 64 + fr + ai * HALF + m * 16) * 256 + wc * 32 + 4 * fq + bj * HALF + n * 16) = acc[ai][bj][m][n];
    }
};
struct OffsetOrder {
    StaticOrder so; int pn_off;
    __device__ __forceinline__ bool next(int i, Unit& u) const { if (!so.next(i, u)) return false; u.pn += pn_off; return true; }
    __device__ __forceinline__ void a_ready(const Unit&) const {}
    __device__ __forceinline__ void done(const Unit&) const {}
};
struct ProbeOrder {
    StaticOrder so; int pm_mask;
    __device__ __forceinline__ bool next(int i, Unit& u) const { if (!so.next(i, u)) return false; u.pm &= pm_mask; return true; }
    __device__ __forceinline__ void a_ready(const Unit&) const {}
    __device__ __forceinline__ void done(const Unit&) const {}
};
struct MergeOrder {
    StaticOrder so; int nmt;
    __device__ __forceinline__ bool next(int i, Unit& u) const { const int b = i % 3; if (!so.next(i / 3, u)) return false; u.pm += b * nmt; u.pn += b * 4; return true; }
    __device__ __forceinline__ void a_ready(const Unit&) const {}
    __device__ __forceinline__ void done(const Unit&) const {}
};
template <class Epi, class Sched, bool ALIGN_EPI = false, bool SP2 = false, bool GATHER = false>
__device__ __forceinline__ void gemm_phase(PG8_LAS unsigned char* lds, const Gemm g, const Sched& S, const Epi& E) {
    const int tid = g.zv  , wid = __builtin_amdgcn_readfirstlane(tid >> 6), lane = tid & 63, wr = wid >> 2, wc = wid & 3, fr = lane & 15, fq = lane >> 4;
    const int K = g.K, nt = K / BK;
    unsigned voffA[2], voffB[2]; int gR = 0, gC = 0;
#pragma unroll
    for (int i = 0; i < 2; ++i) { int R, C; stage_rc(tid * 16 + i * 8192, R, C); const int Rb = Epi::PERM ? ((R & ~31) + perm32(R & 31)) : R;
        const int LD = g.ld ? g.ld : K;
        const int pitch = g.tiled ? BK : LD;
        voffA[i] = (unsigned)(R * pitch + C) * 2u; voffB[i] = (unsigned)(Rb * pitch + C) * 2u; if (i == 0) { gR = R; gC = C; } }
    const size_t kstep = g.tiled ? (size_t)(BM * BK * 2) : (size_t)(BK * 2);
    const size_t hstep = g.tiled ? (size_t)(HALF * BK * 2) : (size_t)HALF * (g.ld ? g.ld : K) * 2;
    const size_t tstep = (size_t)BM * (g.ld ? g.ld : K) * 2; const size_t tstepA = GATHER ? 0 : tstep, hstepA = GATHER ? 0 : hstep;
    const unsigned ldsw = (unsigned)wid * 1024u;
    const int aoff = lds_byte(wr * 64 + fr, fq * 8), boff = lds_byte(wc * 32 + fr, fq * 8);
#define PG8_SA(b, h) (((b) * 2 + (h)) * HTB)
#define PG8_SB(b, h) ((4 + (b) * 2 + (h)) * HTB)
#define PG8_STAGE(bufoff, gbase, voff) do { _Pragma("unroll") for (int _i = 0; _i < 2; ++_i) \
        __builtin_amdgcn_global_load_lds((const unsigned*)((const char*)(gbase) + (voff)[_i]), (PG8_LAS unsigned*)(lds + (bufoff) + ldsw + _i * 8192), 16, 0, ((bufoff) < 4 * HTB) ? PG8_AUX_A : PG8_AUX_B); } while (0)
#define PG8_LDA(dst, b, h) do { _Pragma("unroll") for (int m = 0; m < 4; ++m) _Pragma("unroll") for (int k = 0; k < 2; ++k) dst[m][k] = *(const PG8_LAS bf16x8*)(lds + PG8_SA(b, h) + aoff + m * 2048 + k * 1024); } while (0)
#define PG8_LDB(dst, b, h) do { _Pragma("unroll") for (int n = 0; n < 2; ++n) _Pragma("unroll") for (int k = 0; k < 2; ++k) dst[n][k] = *(const PG8_LAS bf16x8*)(lds + PG8_SB(b, h) + boff + n * 2048 + k * 1024); } while (0)
#define PG8_MMA(ai, bj, At, Bt) do { __builtin_amdgcn_s_setprio(1); _Pragma("unroll") for (int m = 0; m < 4; ++m) _Pragma("unroll") for (int n = 0; n < 2; ++n) _Pragma("unroll") for (int k = 0; k < 2; ++k) \
        acc[ai][bj][m][n] = __builtin_amdgcn_mfma_f32_16x16x32_bf16(Bt[n][k], At[m][k], acc[ai][bj][m][n], 0, 0, 0); __builtin_amdgcn_s_setprio(0); } while (0)
#define PG8_WAIT_V(n) asm volatile("s_waitcnt vmcnt(" #n ")" ::: "memory")
#define PG8_WAIT_L(n) asm volatile("s_waitcnt lgkmcnt(" #n ")" ::: "memory")
#define PG8_BAR __builtin_amdgcn_s_barrier()
#define PG8_SCHED __builtin_amdgcn_sched_barrier(0)
    Unit cur, nxt; int ui = 0;
    if (!S.next(0, cur)) return;
    f32x4 acc[2][2][4][2];
#pragma unroll
    for (int a = 0; a < 2; ++a)
#pragma unroll
        for (int b = 0; b < 2; ++b)
#pragma unroll
            for (int m = 0; m < 4; ++m)
#pragma unroll
                for (int n = 0; n < 2; ++n) acc[a][b][m][n] = (f32x4){0.f, 0.f, 0.f, 0.f};
    bf16x8 At[4][2], B0[2][2], B1[2][2];
    const char* cA = (const char*)g.A + (size_t)cur.pm * tstepA; const char* cB = (const char*)g.Bt + (size_t)cur.pn * tstep;
    const int rot = g.rot; const size_t rofs = (size_t)rot * kstep; const char* pA = cA + rofs; const char* pB = cB + rofs;
#define PG8_KT(x) ((size_t)(((x) + rot >= nt) ? (x) + rot - nt : (x) + rot))
    unsigned vC[2][2], vN[2][2];
#define PG8_GIDX(u, vv) do { _Pragma("unroll") for (int h_ = 0; h_ < 2; ++h_) _Pragma("unroll") for (int i_ = 0; i_ < 2; ++i_) { \
        if constexpr (GATHER) { const int t_ = g.gidx[(u).pm * BM + h_ * HALF + gR + 64 * i_]; vv[h_][i_] = (unsigned)((t_ < 0 ? 0 : t_) * (g.ld ? g.ld : K) + gC) * 2u; } else vv[h_][i_] = voffA[i_]; } } while (0)
    PG8_GIDX(cur, vC);
    S.a_ready(cur);
    if constexpr (SP2) {
        PG8_STAGE(PG8_SB(0, 0), pB, voffB); PG8_STAGE(PG8_SB(0, 1), pB + hstep, voffB); PG8_STAGE(PG8_SA(0, 0), pA, vC[0]); PG8_STAGE(PG8_SA(0, 1), pA + hstepA, vC[1]);
        if (wr == 1) PG8_BAR;
        PG8_WAIT_V(2); PG8_BAR;
        PG8_STAGE(PG8_SB(1, 0), pB + kstep, voffB); PG8_STAGE(PG8_SA(1, 0), pA + kstep, vC[0]); PG8_STAGE(PG8_SB(1, 1), pB + hstep + kstep, voffB);
        PG8_WAIT_V(6); PG8_BAR;
    } else {
        PG8_STAGE(PG8_SB(0, 0), pB, voffB); PG8_STAGE(PG8_SA(0, 0), pA, vC[0]); PG8_STAGE(PG8_SB(0, 1), pB + hstep, voffB); PG8_STAGE(PG8_SA(0, 1), pA + hstepA, vC[1]);
        if (wr == 1) PG8_BAR;
        PG8_WAIT_V(4); PG8_BAR;
        PG8_STAGE(PG8_SB(1, 0), pB + kstep, voffB); PG8_STAGE(PG8_SA(1, 0), pA + kstep, vC[0]); PG8_STAGE(PG8_SB(1, 1), pB + hstep + kstep, voffB);
        PG8_WAIT_V(6); PG8_BAR;
    }
    for (;;) {
        const bool has_next = S.next(ui + 1, nxt);
        if (has_next) PG8_GIDX(nxt, vN); else { vN[0][0] = vC[0][0]; vN[0][1] = vC[0][1]; vN[1][0] = vC[1][0]; vN[1][1] = vC[1][1]; }
        const char* nA = has_next ? (const char*)g.A + (size_t)nxt.pm * tstepA : cA; const char* nB = has_next ? (const char*)g.Bt + (size_t)nxt.pn * tstep : cB;
        for (int t = 0; t < nt; t += 2) {
            if constexpr (Epi::MID) { if (t != 0 && (t & (Epi::MID_TILES - 1)) == 0) E.mid(acc, cur, t / Epi::MID_TILES, wr, wc, fr, fq); }
            const bool last = (t == nt - 2);
            const char* a1 = cA + PG8_KT(t + 1) * kstep;
            const char* a2 = last ? nA + rofs : cA + PG8_KT(t + 2) * kstep; const char* b2 = last ? nB + rofs : cB + PG8_KT(t + 2) * kstep;
            const char* a3 = a2 + kstep; const char* b3 = b2 + kstep;
            if (last && has_next) S.a_ready(nxt);
            const unsigned v2h0[2] = {last ? vN[0][0] : vC[0][0], last ? vN[0][1] : vC[0][1]}, v2h1[2] = {last ? vN[1][0] : vC[1][0], last ? vN[1][1] : vC[1][1]};
            if constexpr (SP2) {
            PG8_LDB(B0, 0, 0); PG8_LDB(B1, 0, 1); PG8_SCHED; PG8_LDA(At, 0, 0); PG8_STAGE(PG8_SA(1, 1), a1 + hstepA, vC[1]);
            PG8_WAIT_V(8); PG8_WAIT_L(0); PG8_BAR; PG8_MMA(0, 0, At, B0); PG8_MMA(0, 1, At, B1); PG8_BAR; PG8_SCHED;
            PG8_LDA(At, 0, 1); PG8_STAGE(PG8_SB(0, 0), b2, voffB); PG8_STAGE(PG8_SB(0, 1), b2 + hstep, voffB); PG8_STAGE(PG8_SA(0, 0), a2, v2h0);
            PG8_WAIT_V(8); PG8_WAIT_L(0); PG8_BAR; PG8_MMA(1, 0, At, B0); PG8_MMA(1, 1, At, B1); PG8_BAR; PG8_SCHED;
            PG8_LDB(B0, 1, 0); PG8_LDB(B1, 1, 1); PG8_SCHED; PG8_LDA(At, 1, 0); PG8_STAGE(PG8_SA(0, 1), a2 + hstepA, v2h1);
            PG8_WAIT_V(8); PG8_WAIT_L(0); PG8_BAR; PG8_MMA(0, 0, At, B0); PG8_MMA(0, 1, At, B1); PG8_BAR; PG8_SCHED;
            PG8_LDA(At, 1, 1); PG8_STAGE(PG8_SB(1, 0), b3, voffB); PG8_STAGE(PG8_SB(1, 1), b3 + hstep, voffB); PG8_STAGE(PG8_SA(1, 0), a3, v2h0);
            PG8_WAIT_V(8); PG8_WAIT_L(0); PG8_BAR; PG8_MMA(1, 0, At, B0); PG8_MMA(1, 1, At, B1); PG8_BAR; PG8_SCHED;
            } else {
            PG8_LDB(B0, 0, 0); PG8_SCHED; PG8_LDA(At, 0, 0); PG8_STAGE(PG8_SA(1, 1), a1 + hstepA, vC[1]);
            PG8_WAIT_L(8); PG8_BAR; PG8_WAIT_L(0); PG8_MMA(0, 0, At, B0); PG8_BAR; PG8_SCHED;
            PG8_LDB(B1, 0, 1); PG8_STAGE(PG8_SB(0, 0), b2, voffB);
            PG8_BAR; PG8_WAIT_L(0); PG8_MMA(0, 1, At, B1); PG8_BAR;
            PG8_LDA(At, 0, 1); PG8_STAGE(PG8_SA(0, 0), a2, v2h0);
            PG8_BAR; PG8_WAIT_L(0); PG8_MMA(1, 0, At, B0); PG8_BAR; PG8_SCHED;
            PG8_STAGE(PG8_SB(0, 1), b2 + hstep, voffB);
            PG8_WAIT_V(6); PG8_BAR; PG8_MMA(1, 1, At, B1); PG8_BAR;
            PG8_LDB(B0, 1, 0); PG8_SCHED; PG8_LDA(At, 1, 0); PG8_STAGE(PG8_SA(0, 1), a2 + hstepA, v2h1);
            PG8_WAIT_L(8); PG8_BAR; PG8_WAIT_L(0); PG8_MMA(0, 0, At, B0); PG8_BAR; PG8_SCHED;
            PG8_LDB(B1, 1, 1); PG8_STAGE(PG8_SB(1, 0), b3, voffB);
            PG8_BAR; PG8_WAIT_L(0); PG8_MMA(0, 1, At, B1); PG8_BAR;
            PG8_LDA(At, 1, 1); PG8_STAGE(PG8_SA(1, 0), a3, v2h0);
            PG8_BAR; PG8_WAIT_L(0); PG8_MMA(1, 0, At, B0); PG8_BAR; PG8_SCHED;
            PG8_STAGE(PG8_SB(1, 1), b3 + hstep, voffB);
            PG8_WAIT_V(6); PG8_BAR; PG8_MMA(1, 1, At, B1); PG8_BAR;
            }
        }
        if constexpr (ALIGN_EPI) { if (wr == 0) PG8_BAR; }
        if constexpr (!Epi::AFTER_DRAIN) { E(acc, cur, wr, wc, fr, fq); S.done(cur); }
        if (!has_next) break;
        if (!E.keep_acc(cur)) {
#pragma unroll
        for (int a = 0; a < 2; ++a)
#pragma unroll
            for (int b = 0; b < 2; ++b)
#pragma unroll
                for (int m = 0; m < 4; ++m)
#pragma unroll
                    for (int n = 0; n < 2; ++n) acc[a][b][m][n] = (f32x4){0.f, 0.f, 0.f, 0.f};
        }
        cur = nxt; cA = nA; cB = nB; ++ui; vC[0][0] = vN[0][0]; vC[0][1] = vN[0][1]; vC[1][0] = vN[1][0]; vC[1][1] = vN[1][1];
        if constexpr (ALIGN_EPI) { if (wr == 1) PG8_BAR; }
    }
    PG8_WAIT_V(0);
    if constexpr (!ALIGN_EPI) { if (wr == 0) PG8_BAR; }
    PG8_BAR;
    if constexpr (Epi::AFTER_DRAIN) { E.fused(acc, cur, wr, wc, fr, fq, lds, wid, lane); S.done(cur); }
#undef PG8_KT
#undef PG8_SA
#undef PG8_SB
#undef PG8_STAGE
#undef PG8_LDA
#undef PG8_LDB
#undef PG8_MMA
#undef PG8_WAIT_V
#undef PG8_WAIT_L
#undef PG8_BAR
#undef PG8_SCHED
}
}

constexpr int NWAVES = 8;
constexpr int DM = 1024, BATCH = 16, SEQ = 4096, DEPTH = 4, MTOK = BATCH * SEQ;
constexpr int NCHUNK = 2, MC = MTOK / NCHUNK, BC = BATCH / NCHUNK;
constexpr int CIN = 5004, NPROJ = 5120, P1W = 2048, GWID = 3072;
constexpr int DFF = 2752, DFFP = 2816, NFF1 = 2 * DFFP;
constexpr int NEXP = 8, DFE = 3584, NMOE1 = 2 * DFE;
constexpr int SLOTS = MC + 2048;
constexpr float EPS = 1e-6f;
constexpr int C_U = 0, C_V = 256, C_SBQ = 512, C_SBK = 768, C_SBV = 1024, C_CQ = 1280, C_KCMP = 1536, C_VCMP = 1600, C_KSLC = 1664, C_VSLC = 1728, C_KWIN = 1792, C_VWIN = 1856, C_CG = 1920;

constexpr size_t MiB = 1u << 20;
constexpr size_t WS_CTL = 0, CTL_ZERO_BYTES = 1 * MiB;
constexpr size_t WS_ROPE = 1 * MiB;
constexpr size_t WS_BIAS1 = 1 * MiB + 512 * 1024;
constexpr size_t WS_RSTD = WS_BIAS1 + 64 * 1024;
constexpr size_t WS_WIN = 2 * MiB;
constexpr size_t WS_WBR = 12 * MiB;
constexpr size_t WS_WOUT = 14 * MiB;
constexpr size_t WS_WC1 = 16 * MiB;
constexpr size_t WS_WF1 = 18 * MiB;
constexpr size_t WS_WF2 = 130 * MiB;
constexpr size_t WS_HN = 186 * MiB;
constexpr size_t WS_SCR = 314 * MiB;
constexpr size_t WS_P1 = WS_SCR;
constexpr size_t WS_G = WS_P1 + 128 * MiB;
constexpr size_t WS_Y = WS_G + 192 * MiB;
constexpr size_t WS_MG = WS_Y + 48 * MiB;
constexpr size_t WS_KVC = WS_MG + 64 * MiB;
constexpr size_t WS_UL = WS_KVC + 8 * MiB;
constexpr size_t WS_KC = WS_UL + 8 * MiB;
constexpr size_t WS_VT = WS_KC + 1 * MiB;
constexpr size_t WS_KCT = WS_VT + 24 * MiB;
constexpr size_t WS_MIX_END = WS_KCT + 1 * MiB;
constexpr size_t WS_HID = WS_SCR;
constexpr size_t WS_ROUTE = WS_SCR;
constexpr size_t WS_TOKMAP = WS_SCR + 1 * MiB;
constexpr size_t WS_WSLOT = WS_SCR + 2 * MiB;
constexpr size_t WS_RSLOT = WS_SCR + 3 * MiB + 64 * 1024;
constexpr size_t WS_CNT128 = WS_SCR + 3 * MiB;
constexpr size_t WS_HIDM = WS_SCR + 4 * MiB;
constexpr size_t WS_H = 800 * MiB;
constexpr size_t WS_TB = 928 * MiB;
constexpr size_t WS_END = 976 * MiB;
static_assert(WS_MIX_END <= WS_H && WS_HID + (size_t)MTOK * DFFP * 2 <= WS_H && WS_HIDM + (size_t)2 * SLOTS * DFE * 2 <= WS_H, "d_ws map");
static_assert(WS_WF1 + (size_t)NEXP * NMOE1 * DM * 2 <= WS_WF2 && WS_WF2 + (size_t)NEXP * DM * DFE * 2 <= WS_HN, "weight map");
static_assert((size_t)4 * SLOTS * 4 <= 1 * MiB, "tokmap");
constexpr int CW_BAR = 4096;
constexpr int CW_CNT = 131072;
constexpr int CW_CUR = 131072 + 256;
constexpr int MAX_BAR_REGIONS = 32;
constexpr int RING_OFF = 0, RING_BYTES = 131072;
constexpr int LDSCTL_OFF = RING_BYTES, MISC_OFF = LDSCTL_OFF + 320;
constexpr int TAB_OFF = LDSCTL_OFF + 1024;
constexpr int LDS_BYTES = 147456;

#define GAS __attribute__((address_space(1)))
#define LAS __attribute__((address_space(3)))
typedef unsigned short bf16;
typedef unsigned v4u __attribute__((ext_vector_type(4)));
typedef unsigned v2u __attribute__((ext_vector_type(2)));
typedef float f32x4 __attribute__((ext_vector_type(4)));
typedef int v4i __attribute__((ext_vector_type(4)));
typedef __bf16 bf16x2_t __attribute__((ext_vector_type(2)));
#define LDS_WAIT() asm volatile("s_waitcnt lgkmcnt(0)" ::: "memory")
#define VM_WAIT() asm volatile("s_waitcnt vmcnt(0)" ::: "memory")
__device__ __forceinline__ unsigned f2bf(float f) { unsigned u = __builtin_bit_cast(unsigned, f); return (u + 0x7fffu + ((u >> 16) & 1u)) >> 16; }
__device__ __forceinline__ unsigned pk2(float lo, float hi) { return f2bf(lo) | (f2bf(hi) << 16); }
__device__ __forceinline__ float bflo(unsigned u) { return __builtin_bit_cast(float, u << 16); }
__device__ __forceinline__ float bfhi(unsigned u) { return __builtin_bit_cast(float, u & 0xffff0000u); }
__device__ __forceinline__ float bf1(bf16 h) { return __builtin_bit_cast(float, (unsigned)h << 16); }
__device__ __forceinline__ float dot2bf(unsigned a, unsigned b, float c) { return __builtin_amdgcn_fdot2_f32_bf16(__builtin_bit_cast(bf16x2_t, a), __builtin_bit_cast(bf16x2_t, b), c, false); }
#ifdef EMU_FP8
__device__ __forceinline__ float q8r(float x, float s) { const int p = __builtin_amdgcn_cvt_pk_fp8_f32(x * s, x * s, 0, false); return __builtin_amdgcn_cvt_f32_fp8(p, 0) * (1.0f / s); }
#else
__device__ __forceinline__ float q8r(float x, float) { return x; }
#endif
__device__ __forceinline__ float fexp(float x) { return __builtin_amdgcn_exp2f(1.4426950408889634f * x); }
template <int X> __device__ __forceinline__ float swz_xor(float v) { return __builtin_bit_cast(float, __builtin_amdgcn_ds_swizzle(__builtin_bit_cast(int, v), (X << 10) | 0x1f)); }
__device__ __forceinline__ float wave_sum(float v, int lane) {
#pragma unroll
    for (int o = 1; o < 64; o <<= 1) v += __builtin_bit_cast(float, __builtin_amdgcn_ds_bpermute((lane ^ o) << 2, __builtin_bit_cast(int, v)));
    return v;
}
__device__ __forceinline__ float rdlane(float v, int l) { return __builtin_bit_cast(float, __builtin_amdgcn_readlane(__builtin_bit_cast(int, v), l)); }
__device__ __forceinline__ int bperm(int srclane, int v) { return __builtin_amdgcn_ds_bpermute(srclane << 2, v); }
__constant__ double ROPE_INVF[8] = {1.0, 0.19392274474868576, 0.037606030930863933, 0.0072926647372171093, 0.0014142135623730950, 0.00027424817567620730, 5.3182958969449883e-05, 1.0313385377212460e-05};
#define XB_TMO      128
#define XB_XCNT(j)  (256  + 64 * (j))
#define XB_XSUB(j)  (1280 + 64 * (j))
#define XB_XGEN(j)  (2304 + 64 * (j))
#define XB_TOP      3328
#define XB_TOPGEN   3392
#define XCD_BAR_WORDS 3456
#define XB_SPIN_CAP (1u << 18)

__device__ __forceinline__ unsigned xb_ld(unsigned* p)              { return __hip_atomic_load(p, __ATOMIC_RELAXED, __HIP_MEMORY_SCOPE_AGENT); }
__device__ __forceinline__ unsigned xb_add(unsigned* p, unsigned v) { return __hip_atomic_fetch_add(p, v, __ATOMIC_RELAXED, __HIP_MEMORY_SCOPE_AGENT); }
__device__ __forceinline__ unsigned xb_xcc_id() { return (unsigned)__builtin_amdgcn_s_getreg((3 << 11) | 20) & 0xFu; }
#define XB_SPIN(cond, bar) do { unsigned _sp = 0; while (cond) { __builtin_amdgcn_s_sleep(1); \
    if ((++_sp & 255u) == 0u) { if (xb_ld(&(bar)[XB_TMO])) break; if (_sp > XB_SPIN_CAP) { atomicAdd(&(bar)[XB_TMO], 1u); break; } } } } while (0)

__device__ __forceinline__ bool xb_thread0_w(unsigned w, unsigned z) { return w == 0u && __builtin_amdgcn_mbcnt_hi(~0u, __builtin_amdgcn_mbcnt_lo(~0u, z)) == 0u; }
struct XcdBarrier {
    unsigned* bar; unsigned x; unsigned w, z;
    volatile LAS unsigned* st;
};

__device__ __forceinline__ XcdBarrier xcd_barrier_post(unsigned* bar, volatile LAS unsigned* st) {
    XcdBarrier b; b.bar = bar; b.x = xb_xcc_id(); b.st = st; b.w = (unsigned)__builtin_amdgcn_readfirstlane((int)(threadIdx.x >> 6)); b.z = 0u;
    if (xb_thread0_w(b.w, b.z)) (void)xb_add(&bar[XB_XCNT(b.x)], 1u);
    return b;
}
__device__ __forceinline__ void xcd_barrier_complete(unsigned* bar, unsigned x, unsigned& nloc, unsigned& nx) {
    const unsigned G = gridDim.x * gridDim.y * gridDim.z;
    unsigned sum, cnt, mine, sp = 0u;
    for (;;) {
        sum = 0u; cnt = 0u; mine = 0u;
#pragma unroll
        for (unsigned j = 0; j < 16; ++j) { const unsigned c = xb_ld(&bar[XB_XCNT(j)]); sum += c; cnt += (c > 0u) ? 1u : 0u; mine = (j == x) ? c : mine; }
        if (sum == G) break;
        __builtin_amdgcn_s_sleep(1);
        if ((++sp & 255u) == 0u) { if (xb_ld(&bar[XB_TMO])) break; if (sp > XB_SPIN_CAP) { atomicAdd(&bar[XB_TMO], 1u); break; } }
    }
    nloc = mine > 0u ? mine : 1u; nx = cnt > 0u ? cnt : 1u;
}

__device__ __forceinline__ void xcd_barrier(const XcdBarrier& b) {
    asm volatile("s_waitcnt vmcnt(0)" ::: "memory");
    __syncthreads();
    if (xb_thread0_w(b.w, b.z)) {
        unsigned* bar = b.bar;
        __builtin_amdgcn_s_waitcnt(0);
        unsigned nloc = b.st[0], nx = b.st[1];
        if (nloc == 0u) { xcd_barrier_complete(bar, b.x, nloc, nx); b.st[0] = nloc; b.st[1] = nx; }
        const unsigned old = xb_add(&bar[XB_XSUB(b.x)], 1u);
        const unsigned gen = old / nloc;
        if (old + 1u == (gen + 1u) * nloc) {
            __builtin_amdgcn_fence(__ATOMIC_RELEASE, "agent");
            asm volatile("s_waitcnt vmcnt(0)" ::: "memory");
            const unsigned og = xb_add(&bar[XB_TOP], 1u);
            const unsigned tg = og / nx;
            if (og + 1u == (tg + 1u) * nx) xb_add(&bar[XB_TOPGEN], 1u);
            else XB_SPIN(xb_ld(&bar[XB_TOPGEN]) == tg, bar);
            __builtin_amdgcn_fence(__ATOMIC_ACQUIRE, "agent");
            xb_add(&bar[XB_XGEN(b.x)], 1u);
            asm volatile("s_waitcnt vmcnt(0)" ::: "memory");
        } else {
            XB_SPIN(xb_ld(&bar[XB_XGEN(b.x)]) == gen, bar);
            __builtin_amdgcn_fence(__ATOMIC_ACQUIRE, "agent");
            asm volatile("s_waitcnt vmcnt(0)" ::: "memory");
        }
    }
    __syncthreads();
}

struct Frame {
    LAS unsigned char* lds;
    unsigned* ctl;
    int tid, lane, wave, vcu, G, bx, zv, zs, rep;
    unsigned char* ws;
    const float* const* in;
    float* out;
};
#define WSP(T, off) ((T*)(F.ws + (off)))
__device__ __forceinline__ size_t toff(int row, int k, int K) { return (size_t)(row >> 8) * 256 * K + (size_t)(k >> 6) * (256 * 64) + (size_t)(row & 255) * 64 + (k & 63); }

#ifndef TILED_FFN1
#define TILED_FFN1 0
#endif
#ifndef Q8_W1
#define Q8_W1 0.f
#define Q8_W2 0.f
#define Q8_HN 0.f
#define Q8_HID 0.f
#endif
__device__ __forceinline__ int map_row(int kind, int off, int n) { return kind == 0 ? n + off : (kind == 1 ? (n < 1932 ? n : n + 116) : ((n >> 7) * 256 + (n & 127) + off)); }
__device__ __forceinline__ void tr_item(const float* W, int ldw, int N, int ks, int n0, bf16* WT, int ldt, int kd, int kind, int off, LAS unsigned char* scr, int lane, float q8s = 0.f, int tiled = 0, const float* gk = nullptr) {
    const int nq = (lane & 15) * 4, kq = lane >> 4;
    f32x4 x[16];
#pragma unroll
    for (int i = 0; i < 16; ++i) x[i] = (n0 + nq < N) ? *(const f32x4*)(W + (size_t)(ks + 4 * i + kq) * ldw + n0 + nq) : (f32x4){0.f, 0.f, 0.f, 0.f};
    if (gk) {
        float gs[16];
#pragma unroll
        for (int i = 0; i < 16; ++i) gs[i] = gk[ks + 4 * i + kq];
#pragma unroll
        for (int i = 0; i < 16; ++i) x[i] = x[i] * gs[i]; }
#pragma unroll
    for (int i = 0; i < 16; ++i) { const int k = 4 * i + kq;
#pragma unroll
        for (int c = 0; c < 4; ++c) { float wv = x[i][c]; if (q8s > 0.f) wv = q8r(wv, q8s); *(LAS bf16*)(scr + (nq + c) * 136 + k * 2) = (bf16)f2bf(wv); } }
    LDS_WAIT(); asm volatile("" ::: "memory");
    if (n0 + lane < N) { const LAS v2u* s = (const LAS v2u*)(scr + lane * 136); const int mr = map_row(kind, off, n0 + lane); bf16* dst = tiled ? WT + toff(mr, kd, ldt) : WT + (size_t)mr * ldt + kd;
#pragma unroll
        for (int q = 0; q < 8; ++q) { const v2u a = s[2 * q], b = s[2 * q + 1]; *(v4u*)(dst + 8 * q) = (v4u){a.x, a.y, b.x, b.y}; } }
    LDS_WAIT(); asm volatile("" ::: "memory");
}
__device__ __forceinline__ void conv(Frame& F, int& tb, const float* W, size_t sW, int nb, int ldw, int N, int ks0, int K, bf16* WT, size_t sWT, int ldt, int kd0, int kind, int off, float q8s = 0.f, int tiled = 0, const float* gk = nullptr) {
    LAS unsigned char* scr = F.lds + RING_OFF + F.wave * 16384;
    const int gw = F.vcu * NWAVES + F.wave, NGW = F.G * NWAVES;
    const int nblk = (N + 63) / 64, per = (K / 64) * nblk, total = per * nb;
    int first = gw - tb; if (first < 0) first += NGW;
    for (int it = first; it < total; it += NGW) { const int b = it / per, r = it % per, kb = r / nblk, nbk = r % nblk;
        tr_item(W + (size_t)b * sW, ldw, N, ks0 + 64 * kb, 64 * nbk, WT + (size_t)b * sWT, ldt, kd0 + 64 * kb, kind, off, scr, F.lane, q8s, tiled, gk); }
    tb = (tb + total) % NGW;
}
__device__ __forceinline__ void zero_block(Frame& F, bf16* WT, int ldt, int r0, int rows, int c0, int cols, int tiled = 0) {
    const int gt = (F.vcu * NWAVES + F.wave) * 64 + F.lane, NT = F.G * NWAVES * 64, cpr = cols / 8;
    for (int i = gt; i < rows * cpr; i += NT) { const int r = i / cpr, c = i % cpr; const unsigned z = (unsigned)F.zv; *(v4u*)(tiled ? WT + toff(r0 + r, c0 + 8 * c, ldt) : WT + (size_t)(r0 + r) * ldt + c0 + 8 * c) = (v4u){z, z, z, z}; }
}
__device__ __forceinline__ void p_convert(Frame& F, int layer) {
    const int j = layer >> 1; int tb = 0;
    conv(F, tb, F.in[2] + (size_t)layer * DM * CIN, 0, 1, CIN, CIN, 0, DM, WSP(bf16, WS_WIN), 0, DM, 0, 1, 0, 0.f, 0, F.in[1] + (size_t)layer * DM);
    zero_block(F, WSP(bf16, WS_WIN), DM, 1932, 116, 0, DM);
    conv(F, tb, F.in[9] + (size_t)layer * 3 * 256 * DM, (size_t)256 * DM, 3, DM, DM, 0, 256, WSP(bf16, WS_WBR), (size_t)DM * 256, 256, 0, 0, 0);
    conv(F, tb, F.in[10] + (size_t)layer * DM * DM, 0, 1, DM, DM, 0, DM, WSP(bf16, WS_WOUT), 0, DM, 0, 0, 0);
    conv(F, tb, F.in[7] + (size_t)layer * 2 * 2048 * 256, (size_t)2048 * 256, 2, 256, 256, 0, 1024, WSP(bf16, WS_WC1), (size_t)512 * 1024, 1024, 0, 0, 0);
    conv(F, tb, F.in[7] + (size_t)layer * 2 * 2048 * 256, (size_t)2048 * 256, 2, 256, 256, 1024, 1024, WSP(bf16, WS_WC1), (size_t)512 * 1024, 1024, 0, 0, 256);
    if ((layer & 1) == 0) {
        conv(F, tb, F.in[12] + (size_t)j * DM * DFF, 0, 1, DFF, DFF, 0, DM, WSP(bf16, WS_WF1), 0, DM, 0, 2, 0, Q8_W1, TILED_FFN1, F.in[11] + (size_t)layer * DM);
        conv(F, tb, F.in[13] + (size_t)j * DM * DFF, 0, 1, DFF, DFF, 0, DM, WSP(bf16, WS_WF1), 0, DM, 0, 2, 128, Q8_W1, TILED_FFN1, F.in[11] + (size_t)layer * DM);
        zero_block(F, WSP(bf16, WS_WF1), DM, 21 * 256 + 64, 64, 0, DM, TILED_FFN1);
        zero_block(F, WSP(bf16, WS_WF1), DM, 21 * 256 + 128 + 64, 64, 0, DM, TILED_FFN1);
        conv(F, tb, F.in[14] + (size_t)j * DFF * DM, 0, 1, DM, DM, 0, DFF, WSP(bf16, WS_WF2), 0, DFFP, 0, 0, 0, Q8_W2);
        zero_block(F, WSP(bf16, WS_WF2), DFFP, 0, DM, DFF, DFFP - DFF);
    } else {
        conv(F, tb, F.in[16] + (size_t)j * NEXP * DM * DFE, (size_t)DM * DFE, NEXP, DFE, DFE, 0, DM, WSP(bf16, WS_WF1), (size_t)NMOE1 * DM, DM, 0, 2, 0, Q8_W1, 0, F.in[11] + (size_t)layer * DM);
        conv(F, tb, F.in[17] + (size_t)j * NEXP * DM * DFE, (size_t)DM * DFE, NEXP, DFE, DFE, 0, DM, WSP(bf16, WS_WF1), (size_t)NMOE1 * DM, DM, 0, 2, 128, Q8_W1, 0, F.in[11] + (size_t)layer * DM);
        conv(F, tb, F.in[18] + (size_t)j * NEXP * DFE * DM, (size_t)DFE * DM, NEXP, DM, DM, 0, DFE, WSP(bf16, WS_WF2), (size_t)DM * DFE, DFE, 0, 0, 0, Q8_W2);
    }
    if (F.bx < 8) {
        __syncthreads();
        const int kv = F.bx >> 2, jj = (F.bx & 3) * 64 + F.lane;
        const float* pos = F.in[6] + (size_t)(layer * 2 + kv) * 2048; const float* w1 = F.in[7] + (size_t)(layer * 2 + kv) * 2048 * 256;
        float a = 0.f;
        float a1 = 0.f, a2 = 0.f, a3 = 0.f;
#pragma unroll 8
        for (int k = 0; k < 256; k += 4) { const int kk = F.wave * 256 + k;
            a += pos[kk] * w1[(size_t)kk * 256 + jj]; a1 += pos[kk + 1] * w1[(size_t)(kk + 1) * 256 + jj]; a2 += pos[kk + 2] * w1[(size_t)(kk + 2) * 256 + jj]; a3 += pos[kk + 3] * w1[(size_t)(kk + 3) * 256 + jj]; }
        a = (a + a1) + (a2 + a3);
        LAS float* red = (LAS float*)(F.lds + RING_OFF);
        red[F.wave * 64 + F.lane] = a;
        __syncthreads();
        if (F.wave == 0) { float s = 0.f;
#pragma unroll
            for (int w = 0; w < 8; ++w) s += red[w * 64 + F.lane];
            WSP(float, WS_BIAS1)[kv * 256 + jj] = s; }
        __syncthreads();
    }
    if (layer == 0) {
        const int gt = (F.vcu * NWAVES + F.wave) * 64 + F.lane, NT = F.G * NWAVES * 64;
        for (int idx = gt; idx < SEQ * 8; idx += NT) { const int pos = idx >> 3, i = idx & 7;
            const double invf = ROPE_INVF[i];
            double rev = (double)pos * invf * 0.15915494309189535; rev -= __builtin_floor(rev);
            WSP(float, WS_ROPE)[idx] = __builtin_amdgcn_cosf((float)rev); WSP(float, WS_ROPE)[SEQ * 8 + idx] = __builtin_amdgcn_sinf((float)rev); }
    }
}

template <bool S16> __device__ __forceinline__ f32x4 ld_row4(const void* src, size_t m, int lane, int jx) {
    if (S16) { const v2u t = ((const v2u*)((const bf16*)src + m * DM) + lane)[64 * jx]; return (f32x4){bflo(t.x), bfhi(t.x), bflo(t.y), bfhi(t.y)}; }
    return ((const f32x4*)((const float*)src + m * DM) + lane)[64 * jx];
}
template <int MODE, bool S16> __device__ __forceinline__ void p_norm(Frame& F, const void* src, const float* g, const float* rw, int jmoe, float q8s = 0.f, int tiled = 0) {
    const int gw = F.vcu * NWAVES + F.wave, NGW = F.G * NWAVES, lane = F.lane;
    LAS int* hist = (LAS int*)(F.lds + TAB_OFF) + 192;
    if (MODE == 1) {
        if (F.tid < 16) hist[F.tid] = 0;
        const int gt = gw * 64 + lane, NT = NGW * 64; int* tm = WSP(int, WS_TOKMAP);
        for (int i = gt; i < 4 * SLOTS; i += NT) tm[i] = -1;
        for (int i = F.tid; i < DM * NEXP / 4; i += NWAVES * 64) { const int c = i >> 1, hf = i & 1;
            *(LAS f32x4*)(F.lds + RING_OFF + (((((c >> 8) * 4 + (c & 3)) * 2 + hf) * 64 + ((c & 255) >> 2)) * 16)) = ((const f32x4*)rw)[i]; }
        if (F.tid < DM / 4) *(LAS f32x4*)(F.lds + RING_OFF + 32768 + 16 * F.tid) = ((const f32x4*)g)[F.tid];
        __syncthreads();
    }
    f32x4 gv[4];
    if (MODE != 1 && MODE != 3) {
#pragma unroll
        for (int jx = 0; jx < 4; ++jx) gv[jx] = ((const f32x4*)g)[lane + 64 * jx]; }
    constexpr int ROWS = (MODE == 1) ? 2 : 4;
    const int nit = (MODE == 1) ? ((MTOK / 128 - F.bx + F.G - 1) / F.G) * (16 / ROWS) : (MTOK - gw + ROWS * NGW - 1) / (ROWS * NGW);
    for (int itx = 0; itx < nit; ++itx) {
        const int chk = (MODE == 1) ? F.bx + (itx / (16 / ROWS)) * F.G : 0;
        const int m0 = (MODE == 1) ? chk * 128 + (itx % (16 / ROWS)) * (NWAVES * ROWS) + F.wave * ROWS : gw + itx * ROWS * NGW;
        const int mstep = (MODE == 1) ? 1 : NGW;
        f32x4 v[ROWS][4]; float ss[ROWS];
#pragma unroll
        for (int u = 0; u < ROWS; ++u) { const int m = m0 + u * mstep;
#pragma unroll
            for (int jx = 0; jx < 4; ++jx) v[u][jx] = ld_row4<S16>(src, (size_t)(m < MTOK ? m : m0), lane, jx); }
#pragma unroll
        for (int u = 0; u < ROWS; ++u) { float s = 0.f;
#pragma unroll
            for (int jx = 0; jx < 4; ++jx) s += (v[u][jx].x * v[u][jx].x + v[u][jx].y * v[u][jx].y) + (v[u][jx].z * v[u][jx].z + v[u][jx].w * v[u][jx].w);
            ss[u] = s; }
#pragma unroll
        for (int o = 1; o < 64; o <<= 1) {
#pragma unroll
            for (int u = 0; u < ROWS; ++u) ss[u] += __builtin_bit_cast(float, __builtin_amdgcn_ds_bpermute((lane ^ o) << 2, __builtin_bit_cast(int, ss[u]))); }
        float lgall[MODE == 1 ? ROWS : 1][8];
        if (MODE == 1) {
            float rs[ROWS];
#pragma unroll
            for (int u = 0; u < ROWS; ++u) { rs[u] = 1.0f / sqrtf(ss[u] * (1.f / DM) + EPS);
#pragma unroll
                for (int e = 0; e < 8; ++e) lgall[u][e] = 0.f; }
#pragma unroll
            for (int jx = 0; jx < 4; ++jx) { const f32x4 gl = *(const LAS f32x4*)(F.lds + RING_OFF + 32768 + 16 * (lane + 64 * jx));
#pragma unroll
                for (int u = 0; u < ROWS; ++u) v[u][jx] = v[u][jx] * rs[u] * gl; }
#pragma unroll
            for (int jx = 0; jx < 4; ++jx) { const LAS f32x4* wr = (const LAS f32x4*)(F.lds + RING_OFF + jx * 8192 + lane * 16);
#pragma unroll
                for (int r = 0; r < 4; ++r) { const f32x4 a = wr[128 * r], b = wr[128 * r + 64];
#pragma unroll
                    for (int u = 0; u < ROWS; ++u) { const float xv = v[u][jx][r];
                        lgall[u][0] += xv * a.x; lgall[u][1] += xv * a.y; lgall[u][2] += xv * a.z; lgall[u][3] += xv * a.w; lgall[u][4] += xv * b.x; lgall[u][5] += xv * b.y; lgall[u][6] += xv * b.z; lgall[u][7] += xv * b.w; } } }
        }
#pragma unroll
        for (int u = 0; u < ROWS; ++u) { const int m = m0 + u * mstep; if (m >= MTOK) continue;
            const float rstd = 1.0f / sqrtf(ss[u] * (1.f / DM) + EPS);
            if (MODE == 3 || MODE == 1) { if (lane == 0) WSP(float, WS_RSTD)[m] = rstd; }
            if (MODE == 3) {
                if (!S16) {
                    unsigned long long* o8 = (unsigned long long*)(WSP(bf16, WS_HN) + (size_t)m * DM) + lane;
#pragma unroll
                    for (int jx = 0; jx < 4; ++jx) { const f32x4 w = v[u][jx]; o8[64 * jx] = (unsigned long long)pk2(w.x, w.y) | ((unsigned long long)pk2(w.z, w.w) << 32); } }
                continue; }
            if (MODE != 1) {
#pragma unroll
            for (int jx = 0; jx < 4; ++jx) v[u][jx] = v[u][jx] * rstd * gv[jx]; }
            if (MODE == 2) {
                f32x4* o = (f32x4*)(F.out + (size_t)m * DM) + lane;
#pragma unroll
                for (int jx = 0; jx < 4; ++jx) o[64 * jx] = v[u][jx];
            } else if (MODE != 1) {
                unsigned long long* o8 = (unsigned long long*)(WSP(bf16, WS_HN) + (size_t)m * DM) + lane;
#pragma unroll
                for (int jx = 0; jx < 4; ++jx) { f32x4 w = v[u][jx];
                    if (tiled) { *(unsigned long long*)(WSP(bf16, WS_HN) + toff(m, 4 * lane + 256 * jx, DM)) = (unsigned long long)pk2(w.x, w.y) | ((unsigned long long)pk2(w.z, w.w) << 32); continue; } if (q8s > 0.f) { w.x = q8r(w.x, q8s); w.y = q8r(w.y, q8s); w.z = q8r(w.z, q8s); w.w = q8r(w.w, q8s); }
                    o8[64 * jx] = (unsigned long long)pk2(w.x, w.y) | ((unsigned long long)pk2(w.z, w.w) << 32); }
            }
            if (MODE == 1) {
                float lg[8];
#pragma unroll
                for (int e = 0; e < 8; ++e) lg[e] = lgall[u][e];
                float h4[4], h2[2], h1;
                { const bool up = lane & 1;
#pragma unroll
                  for (int i = 0; i < 4; ++i) { const float keep = up ? lg[4 + i] : lg[i], send = up ? lg[i] : lg[4 + i]; h4[i] = keep + __builtin_bit_cast(float, bperm(lane ^ 1, __builtin_bit_cast(int, send))); } }
                { const bool up = lane & 2;
#pragma unroll
                  for (int i = 0; i < 2; ++i) { const float keep = up ? h4[2 + i] : h4[i], send = up ? h4[i] : h4[2 + i]; h2[i] = keep + __builtin_bit_cast(float, bperm(lane ^ 2, __builtin_bit_cast(int, send))); } }
                { const bool up = lane & 4; const float keep = up ? h2[1] : h2[0], send = up ? h2[0] : h2[1]; h1 = keep + __builtin_bit_cast(float, bperm(lane ^ 4, __builtin_bit_cast(int, send))); }
                h1 += __builtin_bit_cast(float, bperm(lane ^ 8, __builtin_bit_cast(int, h1))); h1 += __builtin_bit_cast(float, bperm(lane ^ 16, __builtin_bit_cast(int, h1))); h1 += __builtin_bit_cast(float, bperm(lane ^ 32, __builtin_bit_cast(int, h1)));
                lg[0] = rdlane(h1, 0); lg[1] = rdlane(h1, 4); lg[2] = rdlane(h1, 2); lg[3] = rdlane(h1, 6); lg[4] = rdlane(h1, 1); lg[5] = rdlane(h1, 5); lg[6] = rdlane(h1, 3); lg[7] = rdlane(h1, 7);
                int e0 = 0; float v0 = lg[0];
#pragma unroll
                for (int e = 1; e < 8; ++e) if (lg[e] > v0) { v0 = lg[e]; e0 = e; }
                int e1 = -1; float v1 = -INFINITY;
#pragma unroll
                for (int e = 0; e < 8; ++e) if (e != e0 && lg[e] > v1) { v1 = lg[e]; e1 = e; }
                const float w0 = 1.0f / (1.0f + fexp(v1 - v0)), w1 = 1.0f - w0;
                if (lane == 0) { WSP(v4i, WS_ROUTE)[m] = (v4i){e0, e1, __builtin_bit_cast(int, w0), __builtin_bit_cast(int, w1)};
                    __hip_atomic_fetch_add(&hist[e0], 1, __ATOMIC_RELAXED, __HIP_MEMORY_SCOPE_WORKGROUP); __hip_atomic_fetch_add(&hist[8 + e1], 1, __ATOMIC_RELAXED, __HIP_MEMORY_SCOPE_WORKGROUP); }
            }
        }
        if (MODE == 1 && (itx % (16 / ROWS)) == 16 / ROWS - 1) {
            __syncthreads();
            if (F.tid < 16) { WSP(int, WS_CNT128)[(size_t)chk * 16 + F.tid] = hist[F.tid]; hist[F.tid] = 0; }
            __syncthreads();
        }
    }
}

__device__ __forceinline__ float dpp_row_sum(float v) {
    v += __builtin_bit_cast(float, __builtin_amdgcn_update_dpp(0, __builtin_bit_cast(int, v), 0xB1, 0xf, 0xf, false));
    v += __builtin_bit_cast(float, __builtin_amdgcn_update_dpp(0, __builtin_bit_cast(int, v), 0x4E, 0xf, 0xf, false));
    v += __builtin_bit_cast(float, __builtin_amdgcn_update_dpp(0, __builtin_bit_cast(int, v), 0x141, 0xf, 0xf, false));
    v += __builtin_bit_cast(float, __builtin_amdgcn_update_dpp(0, __builtin_bit_cast(int, v), 0x140, 0xf, 0xf, false));
    return v;
}
__device__ __forceinline__ void p_rstd(Frame& F) {
    const int gw = F.vcu * NWAVES + F.wave, NGW = F.G * NWAVES, lane = F.lane;
    const bf16* H = WSP(bf16, WS_H); float* rs = WSP(float, WS_RSTD);
    for (int m0 = gw * 8; m0 < MTOK; m0 += NGW * 8) {
        v4u x[8][2];
#pragma unroll
        for (int u = 0; u < 8; ++u) { const v4u* xr = (const v4u*)(H + (size_t)(m0 + u) * DM) + lane; x[u][0] = xr[0]; x[u][1] = xr[64]; }
        float ss[8];
#pragma unroll
        for (int u = 0; u < 8; ++u) { float s = 0.f;
#pragma unroll
            for (int h = 0; h < 2; ++h) { const v4u w = x[u][h];
                const float a0 = bflo(w.x), a1 = bfhi(w.x), a2 = bflo(w.y), a3 = bfhi(w.y), a4 = bflo(w.z), a5 = bfhi(w.z), a6 = bflo(w.w), a7 = bfhi(w.w);
                s += ((a0 * a0 + a1 * a1) + (a2 * a2 + a3 * a3)) + ((a4 * a4 + a5 * a5) + (a6 * a6 + a7 * a7)); }
            ss[u] = dpp_row_sum(s); }
        float myr = 0.f;
#pragma unroll
        for (int u = 0; u < 8; ++u) { const float t = (rdlane(ss[u], 0) + rdlane(ss[u], 16)) + (rdlane(ss[u], 32) + rdlane(ss[u], 48)); if (lane == u) myr = t; }
        if (lane < 8) rs[m0 + lane] = 1.0f / sqrtf(myr * (1.f / DM) + EPS);
    }
}
__device__ __forceinline__ void p_prep(Frame& F) {
    const int gw = F.vcu * NWAVES + F.wave, NGW = F.G * NWAVES, lane = F.lane;
    bf16* P1 = WSP(bf16, WS_P1); bf16* KVC = WSP(bf16, WS_KVC); const float* rope = WSP(float, WS_ROPE);
    const int vec = lane >> 3, ri = lane & 7; const int cb = vec < 4 ? C_CQ + vec * 64 : (vec == 4 ? C_KCMP : (vec == 5 ? C_KSLC : C_KWIN));
    for (int row0 = gw; row0 < MC; row0 += 4 * NGW) {
        float x1[4], x2[4], cc[4], ss[4]; bf16 kc48[4], vc64[4];
#pragma unroll
        for (int k = 0; k < 4; ++k) { const int row = row0 + k * NGW < MC ? row0 + k * NGW : row0; const bf16* p = P1 + (size_t)row * P1W; const int pos = row & (SEQ - 1);
            const int cl = lane < 56 ? cb + ri : C_CQ;
            x1[k] = bf1(p[cl]); x2[k] = bf1(p[cl + 8]); cc[k] = rope[pos * 8 + ri]; ss[k] = rope[SEQ * 8 + pos * 8 + ri];
            if (F.rep) { cc[k] = 1.f; ss[k] = 0.f; }
            kc48[k] = p[C_KCMP + 16 + (lane < 48 ? lane : 0)]; vc64[k] = p[C_VCMP + lane]; }
#pragma unroll
        for (int k = 0; k < 4; ++k) { const int row = row0 + k * NGW; if (row >= MC) continue; bf16* p = P1 + (size_t)row * P1W;
            if (lane < 56) { const bf16 o1 = (bf16)f2bf(x1[k] * cc[k] - x2[k] * ss[k]), o2 = (bf16)f2bf(x2[k] * cc[k] + x1[k] * ss[k]);
                p[cb + ri] = o1; p[cb + ri + 8] = o2;
                if (vec == 4) { KVC[(size_t)row * 64 + ri] = o1; KVC[(size_t)row * 64 + ri + 8] = o2; } }
            if (lane < 48) KVC[(size_t)row * 64 + 16 + lane] = kc48[k];
            KVC[(size_t)MC * 64 + (size_t)row * 64 + lane] = vc64[k]; }
    }
    bf16* VT = WSP(bf16, WS_VT);
    for (int it = gw; it < 6 * BC * 64; it += NGW) { const int which = it / (BC * 64), r = it % (BC * 64), b = r >> 6, blk = r & 63;
        const v4u* src = (const v4u*)(P1 + ((size_t)b * SEQ + blk * 64 + lane) * P1W + (which == 0 ? C_VSLC : (which == 1 ? C_VWIN : C_SBV + (which - 2) * 64)));
        bf16* dst = VT + ((size_t)(which * BC + b) * 64) * SEQ + blk * 64 + lane;
        v4u xs[8];
#pragma unroll
        for (int i = 0; i < 8; ++i) xs[i] = src[i];
#pragma unroll
        for (int i = 0; i < 8; ++i) { const v4u x = xs[i];
            dst[(size_t)(8 * i + 0) * SEQ] = (bf16)(x.x & 0xffffu); dst[(size_t)(8 * i + 1) * SEQ] = (bf16)(x.x >> 16);
            dst[(size_t)(8 * i + 2) * SEQ] = (bf16)(x.y & 0xffffu); dst[(size_t)(8 * i + 3) * SEQ] = (bf16)(x.y >> 16);
            dst[(size_t)(8 * i + 4) * SEQ] = (bf16)(x.z & 0xffffu); dst[(size_t)(8 * i + 5) * SEQ] = (bf16)(x.z >> 16);
            dst[(size_t)(8 * i + 6) * SEQ] = (bf16)(x.w & 0xffffu); dst[(size_t)(8 * i + 7) * SEQ] = (bf16)(x.w >> 16); }
    }
}
__device__ __forceinline__ void p_sgu(Frame& F, int layer) {
    LAS float* vn = (LAS float*)(F.lds + RING_OFF);
    const bf16* P1 = WSP(bf16, WS_P1); bf16* Ya = WSP(bf16, WS_Y);
    const float* gain = F.in[3] + (size_t)layer * 256; const float* sw = F.in[4] + (size_t)layer * 4 * 128 * 128; const float* sb = F.in[5] + (size_t)layer * 4 * 128;
    const int lane = F.lane, wave = F.wave;
    for (int item = F.vcu; item < MC / 128; item += F.G) {
        const size_t r0 = (size_t)item * 128;
        __syncthreads();
        for (int rr = 0; rr < 16; ++rr) { const int r = wave * 16 + rr; const v2u raw = *(const v2u*)(P1 + (r0 + r) * P1W + C_V + 4 * lane);
            const float a = bflo(raw.x), b = bfhi(raw.x), c = bflo(raw.y), d = bfhi(raw.y);
            const float rstd = 1.0f / sqrtf(wave_sum((a * a + b * b) + (c * c + d * d), lane) * (1.f / 256.f) + EPS);
            const f32x4 gg = ((const f32x4*)gain)[lane];
            *(LAS f32x4*)(vn + r * 256 + 4 * lane) = (f32x4){a * rstd * gg.x, b * rstd * gg.y, c * rstd * gg.z, d * rstd * gg.w}; }
        __syncthreads();
        const int g = wave & 3, half = wave >> 2;
        for (int i = 0; i < 64; ++i) { const int t = 2 * i + half;
            const float* wrow = sw + ((size_t)g * 128 + t) * 128;
            const float w_lo = wrow[lane], w_hi = wrow[64 + lane];
            float acc = 0.f;
            for (int s = 0; s <= t; ++s) { const float w = (s < 64) ? rdlane(w_lo, s) : rdlane(w_hi, s - 64); acc += w * vn[s * 256 + g * 64 + lane]; }
            const float u = bf1(P1[(r0 + t) * P1W + C_U + g * 64 + lane]);
#ifdef ABL_SGUMIX
            acc = 0.f;
#endif
            Ya[(r0 + t) * 256 + g * 64 + lane] = (bf16)f2bf(u * (acc + sb[g * 128 + t])); }
    }
    __syncthreads();
}

__device__ __forceinline__ void p_cmpfin(Frame& F, int layer) {
    const int gw = F.vcu * NWAVES + F.wave, NGW = F.G * NWAVES, lane = F.lane;
    const float* UL = WSP(float, WS_UL); const float* bias = WSP(float, WS_BIAS1); bf16* KC = WSP(bf16, WS_KC);
    LAS float* w2l = (LAS float*)(F.lds + RING_OFF);
    __syncthreads();
    { const f32x4* src = (const f32x4*)(F.in[8] + (size_t)layer * 2 * 256 * 64);
#pragma unroll 4
      for (int i = F.tid; i < 2 * 256 * 64 / 4; i += NWAVES * 64) *(LAS f32x4*)(w2l + 4 * i) = src[i]; }
    __syncthreads();
    for (int it = gw; it < 2 * BC * 255; it += NGW) { const int kv = it / (BC * 255), r = it % (BC * 255), b = r / 255, m = r % 255;
        const LAS float* w2 = w2l + kv * 256 * 64;
        const float* U = UL + (size_t)(kv * 2048 + b * 256 + m) * 512; const float* L = U + 512 + 256;
        float hv[4];
#pragma unroll
        for (int q = 0; q < 4; ++q) hv[q] = pg8::gelu_tanh(U[64 * q + lane] + L[64 * q + lane] + bias[kv * 256 + 64 * q + lane]);
        float acc0 = 0.f, acc1 = 0.f;
#pragma unroll
        for (int q = 0; q < 4; ++q)
#pragma unroll 8
            for (int jj = 0; jj < 64; jj += 2) { acc0 += rdlane(hv[q], jj) * w2[(64 * q + jj) * 64 + lane]; acc1 += rdlane(hv[q], jj + 1) * w2[(64 * q + jj + 1) * 64 + lane]; }
        const float acc = acc0 + acc1;
        KC[((size_t)(kv * BC + b) * 256 + m) * 64 + lane] = (bf16)f2bf(acc);
        if (kv == 1) { WSP(bf16, WS_KCT)[((size_t)b * 64 + lane) * 256 + m] = (bf16)f2bf(acc); if (m == 254) WSP(bf16, WS_KCT)[((size_t)b * 64 + lane) * 256 + 255] = (bf16)0; }
        else if (m == 254) KC[((size_t)b * 256 + 255) * 64 + lane] = (bf16)0; }
    __syncthreads();
}

__device__ __forceinline__ void p_stick(Frame& F) {
    const int gw = F.vcu * NWAVES + F.wave, NGW = F.G * NWAVES, lane = F.lane;
    const bf16* P1 = WSP(bf16, WS_P1); bf16* Yb = WSP(bf16, WS_Y) + (size_t)MC * 256;
    for (int item = gw; item < BC * 4 * 64; item += NGW) { const int tb = item & 63, h = (item >> 6) & 3, b = item >> 8;
        const int t = tb * 64 + lane; const size_t row = (size_t)b * SEQ + t;
        unsigned q[32];
        { const v4u* qp = (const v4u*)(P1 + row * P1W + C_SBQ + h * 64);
#pragma unroll
          for (int i = 0; i < 8; ++i) { const v4u x = qp[i]; q[4 * i] = x.x; q[4 * i + 1] = x.y; q[4 * i + 2] = x.z; q[4 * i + 3] = x.w; } }
        float o[64];
#pragma unroll
        for (int d = 0; d < 64; ++d) o[d] = 0.f;
        float R = 0.f;
        const bf16* kb = P1 + (size_t)b * SEQ * P1W + C_SBK + h * 64; const bf16* vb = P1 + (size_t)b * SEQ * P1W + C_SBV + h * 64;
        for (int s = t - 1; s >= 0; --s) {
            if (R < -100.f) break;
            const v4u* kp = (const v4u*)(kb + (size_t)s * P1W); const v4u* vp = (const v4u*)(vb + (size_t)s * P1W);
            float z0 = 0.f, z1 = 0.f;
#pragma unroll
            for (int i = 0; i < 8; ++i) { const v4u k = kp[i]; z0 = dot2bf(k.x, q[4 * i], z0); z1 = dot2bf(k.y, q[4 * i + 1], z1); z0 = dot2bf(k.z, q[4 * i + 2], z0); z1 = dot2bf(k.w, q[4 * i + 3], z1); }
            const float z = (z0 + z1) * 0.125f;
            const float tt = 0.6931471805599453f * __builtin_amdgcn_logf(1.0f + fexp(-__builtin_fabsf(z)));
            const float lb = fminf(z, 0.f) - tt, l1m = fminf(-z, 0.f) - tt;
            const float a = fexp(lb + R); R += l1m;
#pragma unroll
            for (int i = 0; i < 8; ++i) { const v4u v = vp[i];
                o[8 * i] += a * bflo(v.x); o[8 * i + 1] += a * bfhi(v.x); o[8 * i + 2] += a * bflo(v.y); o[8 * i + 3] += a * bfhi(v.y);
                o[8 * i + 4] += a * bflo(v.z); o[8 * i + 5] += a * bfhi(v.z); o[8 * i + 6] += a * bflo(v.w); o[8 * i + 7] += a * bfhi(v.w); }
        }
        v4u* op = (v4u*)(Yb + row * 256 + h * 64);
#pragma unroll
        for (int i = 0; i < 8; ++i) op[i] = (v4u){pk2(o[8 * i], o[8 * i + 1]), pk2(o[8 * i + 2], o[8 * i + 3]), pk2(o[8 * i + 4], o[8 * i + 5]), pk2(o[8 * i + 6], o[8 * i + 7])};
    }
}

struct Soft { float mx, l; };
__device__ __forceinline__ float dotq(const LAS v4u* ql, const bf16* kp_) {
    const v4u* kp = (const v4u*)kp_; float z0 = 0.f, z1 = 0.f;
#pragma unroll
    for (int i = 0; i < 8; ++i) { const v4u k = kp[i]; const v4u q = ql[i]; z0 = dot2bf(k.x, q.x, z0); z1 = dot2bf(k.y, q.y, z1); z0 = dot2bf(k.z, q.z, z0); z1 = dot2bf(k.w, q.w, z1); }
    return (z0 + z1) * 0.125f;
}
__device__ __forceinline__ void axpy_row(float p, const bf16* vp_, float (&o)[64]) {
    const v4u* vp = (const v4u*)vp_;
#pragma unroll
    for (int i = 0; i < 8; ++i) { const v4u v = vp[i];
        o[8 * i] += p * bflo(v.x); o[8 * i + 1] += p * bfhi(v.x); o[8 * i + 2] += p * bflo(v.y); o[8 * i + 3] += p * bfhi(v.y);
        o[8 * i + 4] += p * bflo(v.z); o[8 * i + 5] += p * bfhi(v.z); o[8 * i + 6] += p * bflo(v.w); o[8 * i + 7] += p * bfhi(v.w); }
}
__device__ __forceinline__ void nsa_step(const LAS v4u* ql, const bf16* kp_, const bf16* vp_, Soft& S, float (&o)[64]) {
    const float s = dotq(ql, kp_);
    if (s > S.mx) { const float sc = fexp(S.mx - s); S.l *= sc;
#pragma unroll
        for (int d = 0; d < 64; ++d) o[d] *= sc;
        S.mx = s; }
    const float p = fexp(s - S.mx); S.l += p;
    asm volatile("" ::: "memory");
    axpy_row(p, vp_, o);
}
__device__ __forceinline__ void nsa_accum(bf16* yrow, bool first, float sc, const float (&o)[64]) {
    v4u* op = (v4u*)yrow;
#pragma unroll
    for (int i = 0; i < 8; ++i) { v4u old = (v4u){0u, 0u, 0u, 0u}; if (!first) old = op[i];
        op[i] = (v4u){pk2(bflo(old.x) + sc * o[8 * i], bfhi(old.x) + sc * o[8 * i + 1]), pk2(bflo(old.y) + sc * o[8 * i + 2], bfhi(old.y) + sc * o[8 * i + 3]),
                      pk2(bflo(old.z) + sc * o[8 * i + 4], bfhi(old.z) + sc * o[8 * i + 5]), pk2(bflo(old.w) + sc * o[8 * i + 6], bfhi(old.w) + sc * o[8 * i + 7])}; }
}
__device__ __forceinline__ void p_nsa(Frame& F) {
    const int gw = F.vcu * NWAVES + F.wave, NGW = F.G * NWAVES, lane = F.lane;
    const bf16* P1 = WSP(bf16, WS_P1); const bf16* KC = WSP(bf16, WS_KC); bf16* Yc = WSP(bf16, WS_Y) + (size_t)2 * MC * 256;
    LAS float* imp = (LAS float*)(F.lds + RING_OFF + F.wave * 4096);
    LAS v4u* ql = (LAS v4u*)(F.lds + RING_OFF + 32768 + F.wave * 9216 + lane * 144);
    const int qi = lane >> 2, h = lane & 3;
    for (int item = gw; item < BC * 256; item += NGW) { const int b = item >> 8, tg = item & 255;
        const int t = tg * 16 + qi; const size_t row = (size_t)b * SEQ + t; const bf16* prow = P1 + row * P1W;
        { const v4u* qp = (const v4u*)(prow + C_CQ + h * 64);
#pragma unroll
          for (int i = 0; i < 8; ++i) ql[i] = qp[i]; }
        const float g0 = bf1(prow[C_CG + h * 3]), g1 = bf1(prow[C_CG + h * 3 + 1]), g2 = bf1(prow[C_CG + h * 3 + 2]);
        bf16* yrow = Yc + row * 256 + h * 64;
        float o[64];
        for (int i = lane; i < 1024; i += 64) imp[i] = 0.f;
        const int nv = t >= 31 ? ((t - 31) >> 4) + 1 : 0; const int nvmax = (tg * 16 + 15 >= 31) ? ((tg * 16 + 15 - 31) >> 4) + 1 : 0;
        const bf16* kc = KC + (size_t)(0 * BC + b) * 256 * 64; const bf16* vc = KC + (size_t)(1 * BC + b) * 256 * 64;
        { float mx = -INFINITY, l = 0.f;
          for (int m = 0; m < nvmax; ++m) { const float s = dotq(ql, kc + m * 64); if (m < nv) { if (s > mx) { l *= fexp(mx - s); mx = s; } l += fexp(s - mx); } }
          const float rl = l > 0.f ? 1.0f / l : 0.f;
#pragma unroll
          for (int d = 0; d < 64; ++d) o[d] = 0.f;
          for (int m = 0; m < nvmax; ++m) { const float s = dotq(ql, kc + m * 64); const float p = (m < nv) ? fexp(s - mx) * rl : 0.f;
              asm volatile("" ::: "memory");
              axpy_row(p, vc + m * 64, o);
              float P = p + __builtin_bit_cast(float, bperm(lane ^ 1, __builtin_bit_cast(int, p))); P += __builtin_bit_cast(float, bperm(lane ^ 2, __builtin_bit_cast(int, P)));
              if (h == 0) { const int j0 = m >> 2; const bool edge = (m & 3) == 3; imp[qi * 64 + j0] += edge ? 0.5f * P : P; if (edge) imp[qi * 64 + j0 + 1] += 0.5f * P; } }
          nsa_accum(yrow, true, g0, o); }
        unsigned long long mask = 0ull;
        { const int cur = t >> 6, nvb = cur + 1;
          if (h == 0) {
              if (nvb <= 16) mask = (1ull << nvb) - 1ull;
              else { mask = 1ull | (1ull << cur);
                  for (int r = 0; r < 14; ++r) { int best = -1; float bv = -1.f;
                      for (int j = 1; j < cur; ++j) { const float v = imp[qi * 64 + j]; if (!((mask >> j) & 1ull) && v > bv) { bv = v; best = j; } }
                      mask |= 1ull << best; } } }
          const unsigned mlo = (unsigned)bperm(lane & ~3, (int)(unsigned)mask), mhi = (unsigned)bperm(lane & ~3, (int)(unsigned)(mask >> 32));
          mask = ((unsigned long long)mhi << 32) | mlo; }
        { Soft S{-INFINITY, 0.f};
#pragma unroll
          for (int d = 0; d < 64; ++d) o[d] = 0.f;
          const bf16* kb = P1 + (size_t)b * SEQ * P1W + C_KSLC; const bf16* vb = P1 + (size_t)b * SEQ * P1W + C_VSLC;
          unsigned long long mm = mask;
          while (mm) { const int j = __builtin_ctzll(mm); mm &= mm - 1ull;
              for (int kk = 0; kk < 64; ++kk) { const int sp = j * 64 + kk; if (sp > t) break; nsa_step(ql, kb + (size_t)sp * P1W, vb + (size_t)sp * P1W, S, o); } }
          nsa_accum(yrow, false, g1 / S.l, o); }
        { Soft S{-INFINITY, 0.f};
#pragma unroll
          for (int d = 0; d < 64; ++d) o[d] = 0.f;
          const bf16* kb = P1 + (size_t)b * SEQ * P1W + C_KWIN; const bf16* vb = P1 + (size_t)b * SEQ * P1W + C_VWIN;
          for (int i = 0; i < 512; ++i) { const int sp = t - 511 + i; if (sp >= 0) nsa_step(ql, kb + (size_t)sp * P1W, vb + (size_t)sp * P1W, S, o); }
          nsa_accum(yrow, false, g2 / S.l, o); }
    }
}

__device__ __forceinline__ int moe_table(Frame& F, int jmoe, int c, int r, int kpre = 0) {
    LAS int* tab = (LAS int*)(F.lds + TAB_OFF); LAS int* arr = (LAS int*)(F.lds + LDSCTL_OFF + 4096);
    (void)jmoe;
    __syncthreads();
    if (F.tid < 256) { const v4i* s = (const v4i*)(WSP(int, WS_CNT128) + ((size_t)(c * 256 + F.tid) * 2 + r) * 8); const v4i a = s[0], b = s[1];
        *(LAS v4i*)(arr + F.tid * 8) = a; *(LAS v4i*)(arr + F.tid * 8 + 4) = b; }
    __syncthreads();
    if (F.tid < 8) { int tot = 0, pre = 0;
        for (int k = 0; k < 256; ++k) { const int x = arr[k * 8 + F.tid]; pre += (k < kpre) ? x : 0; tot += x; }
        tab[176 + F.tid] = tot; tab[184 + F.tid] = pre; }
    __syncthreads();
    if (F.tid == 0) { int base = 0, T = 0;
        for (int e = 0; e < 8; ++e) { const int cnt = tab[176 + e];
            const int nt = (cnt + 255) >> 8; tab[160 + e] = base; for (int i = 0; i < nt && T + i < 160; ++i) tab[T + i] = e; T += nt; base += nt * 256; }
        tab[168] = T < 136 ? T : 136; }
    __syncthreads();
    return tab[168];
}
__device__ __forceinline__ void p_gather(Frame& F, int jmoe, int c, int r, int nbusy = 0) {
    if (F.bx < nbusy) return;
    LAS int* tab = (LAS int*)(F.lds + TAB_OFF); LAS int* cntw = tab + 256; LAS int* basew = tab + 320;
    const int lane = F.lane, wave = F.wave;
    const v4i* route = WSP(v4i, WS_ROUTE); int* tokmap = WSP(int, WS_TOKMAP) + (c * 2 + r) * SLOTS; float* wslot = WSP(float, WS_WSLOT) + (c * 2 + r) * SLOTS; float* rslot = WSP(float, WS_RSLOT) + (c * 2 + r) * SLOTS;
    for (int ch = F.bx - nbusy; ch < MC / 128; ch += F.G - nbusy) {
        moe_table(F, jmoe, c, r, ch);
        const int m = c * MC + ch * 128 + wave * 16 + (lane & 15); const v4i rt = route[m];
        const int e = lane < 16 ? (r ? rt.y : rt.x) : -1; const float w = __builtin_bit_cast(float, r ? rt.w : rt.z);
        unsigned long long bal[8]; int mycnt = 0;
#pragma unroll
        for (int ee = 0; ee < 8; ++ee) { bal[ee] = __builtin_amdgcn_ballot_w64(e == ee); if (lane == ee) mycnt = __builtin_popcountll(bal[ee]); }
        if (lane < 8) cntw[wave * 8 + lane] = mycnt;
        __syncthreads();
        if (wave == 0 && lane < 8) { int base = tab[184 + lane];
#pragma unroll
            for (int w8 = 0; w8 < 8; ++w8) { basew[w8 * 8 + lane] = base; base += cntw[w8 * 8 + lane]; } }
        __syncthreads();
        int pos = 0;
#pragma unroll
        for (int ee = 0; ee < 8; ++ee) if (e == ee) pos = basew[wave * 8 + ee] + __builtin_popcountll(bal[ee] & ((1ull << lane) - 1ull));
        int slot = 0;
        if (lane < 16) { slot = tab[160 + e] + pos; tokmap[slot] = m; wslot[slot] = w; rslot[slot] = WSP(float, WS_RSTD)[m]; }
    }
}

typedef float f32x16 __attribute__((ext_vector_type(16)));
typedef short bf16x8v __attribute__((ext_vector_type(8)));
typedef float f32x2v __attribute__((ext_vector_type(2)));
constexpr int NSA_K = 0, NSA_V = 8192, NSA_BUF = 17408, NSA_STAGE = 2 * NSA_BUF, NSA_IMP = 69632, NSA_CARRY = 86016, NSA_SEL = 103424, NSA_WSF = 103936;
constexpr int NSA_VP = 136;
constexpr float NSA_C2 = 0.125f * 1.4426950408889634f;
constexpr float NSA_DEFER = 8.0f / (0.125f * 1.4426950408889634f);
__device__ __forceinline__ unsigned cvtpk(float lo, float hi) { f32x2v v = {lo, hi}; bf16x2_t b = __builtin_convertvector(v, bf16x2_t); return __builtin_bit_cast(unsigned, b); }
__device__ __forceinline__ float partner32(float v, int lane) { return __builtin_bit_cast(float, __builtin_amdgcn_ds_bpermute((lane ^ 32) << 2, __builtin_bit_cast(int, v))); }
__device__ __forceinline__ void nsa_load(v4u& kx, v4u& vx, const bf16* Kg, int kp, const bf16* Vg, int vp, int tid) {
    kx = *(const v4u*)(Kg + (size_t)(tid & 63) * kp + (tid >> 6) * 8); vx = *(const v4u*)(Vg + (size_t)(tid >> 3) * vp + (tid & 7) * 8);
}
__device__ __forceinline__ void nsa_store(LAS unsigned char* lds, const v4u& kx, const v4u& vx, int tid) {
    *(LAS v4u*)(lds + NSA_K + (tid >> 6) * 1024 + (tid & 63) * 16) = kx; { LAS v2u* vd = (LAS v2u*)(lds + NSA_V + (tid >> 3) * NSA_VP + (tid & 7) * 16); vd[0] = (v2u){vx.x, vx.y}; vd[1] = (v2u){vx.z, vx.w}; }
}
__device__ __forceinline__ void nsa_qk(const LAS unsigned char* lds, const bf16x8v (&qr)[4], f32x16& p0, f32x16& p1, int r32, int hi) {
    bf16x8v kf[8];
#pragma unroll
    for (int d0 = 0; d0 < 4; ++d0) {
        kf[2 * d0] = *(const LAS bf16x8v*)(lds + NSA_K + (2 * d0 + hi) * 1024 + r32 * 16);
        kf[2 * d0 + 1] = *(const LAS bf16x8v*)(lds + NSA_K + (2 * d0 + hi) * 1024 + 512 + r32 * 16); }
    __builtin_amdgcn_sched_barrier(0);
#pragma unroll
    for (int i = 0; i < 16; ++i) { p0[i] = 0.f; p1[i] = 0.f; }
#pragma unroll
    for (int d0 = 0; d0 < 4; ++d0) {
        p0 = __builtin_amdgcn_mfma_f32_32x32x16_bf16(kf[2 * d0], qr[d0], p0, 0, 0, 0);
        p1 = __builtin_amdgcn_mfma_f32_32x32x16_bf16(kf[2 * d0 + 1], qr[d0], p1, 0, 0, 0);
    }
}
__device__ __forceinline__ void nsa_mask(f32x16& p0, f32x16& p1, int hi, int hiL, int loL) {
    const int hl = hiL - 4 * hi, ll = loL - 4 * hi;
#pragma unroll
    for (int i = 0; i < 16; ++i) { const int c = (i & 3) + 8 * (i >> 2);
        if (!(c <= hl && c > ll)) p0[i] = -INFINITY;
        if (!(c + 32 <= hl && c + 32 > ll)) p1[i] = -INFINITY; }
}
__device__ __forceinline__ float nsa_max32(const f32x16& p0, const f32x16& p1) {
    float a = fmaxf(fmaxf(p0[0], p0[1]), p1[0]), b = fmaxf(fmaxf(p0[2], p0[3]), p1[1]); a = fmaxf(fmaxf(a, p1[2]), p1[3]);
#pragma unroll
    for (int i = 4; i < 16; i += 4) { a = fmaxf(fmaxf(a, p0[i]), p0[i + 1]); b = fmaxf(fmaxf(b, p0[i + 2]), p0[i + 3]); a = fmaxf(fmaxf(a, p1[i]), p1[i + 1]); b = fmaxf(fmaxf(b, p1[i + 2]), p1[i + 3]); }
    return fmaxf(a, b);
}
__device__ __forceinline__ void nsa_vload(const LAS unsigned char* lds, v4u (&vv)[8], int r32, int hi) {
#pragma unroll
    for (int db = 0; db < 2; ++db) { const LAS unsigned char* vrow = lds + NSA_V + (32 * db + r32) * NSA_VP;
#pragma unroll
        for (int ks = 0; ks < 4; ++ks) {
            const int kb = (ks >> 1) * 32 + (ks & 1) * 16 + 4 * hi;
            const v2u lo = *(const LAS v2u*)(vrow + kb * 2), hh = *(const LAS v2u*)(vrow + (kb + 8) * 2);
            vv[4 * db + ks] = (v4u){lo.x, lo.y, hh.x, hh.y}; } }
    __builtin_amdgcn_sched_barrier(0);
}
__device__ __forceinline__ void nsa_pv(const v4u (&vv)[8], const f32x16& p0, const f32x16& p1, f32x16 (&o)[2]) {
    bf16x8v pa[4];
#pragma unroll
    for (int s = 0; s < 2; ++s) {
        const v4u a = (v4u){cvtpk(p0[8 * s], p0[8 * s + 1]), cvtpk(p0[8 * s + 2], p0[8 * s + 3]), cvtpk(p0[8 * s + 4], p0[8 * s + 5]), cvtpk(p0[8 * s + 6], p0[8 * s + 7])};
        const v4u b = (v4u){cvtpk(p1[8 * s], p1[8 * s + 1]), cvtpk(p1[8 * s + 2], p1[8 * s + 3]), cvtpk(p1[8 * s + 4], p1[8 * s + 5]), cvtpk(p1[8 * s + 6], p1[8 * s + 7])};
        pa[s] = __builtin_bit_cast(bf16x8v, a); pa[2 + s] = __builtin_bit_cast(bf16x8v, b); }
#pragma unroll
    for (int ks = 0; ks < 4; ++ks)
#pragma unroll
        for (int db = 0; db < 2; ++db) o[db] = __builtin_amdgcn_mfma_f32_32x32x16_bf16(pa[ks], __builtin_bit_cast(bf16x8v, vv[4 * db + ks]), o[db], 0, 0, 0);
}
__device__ __forceinline__ void nsa_rowscale(f32x16 (&o)[2], LAS float* wsf, float f, int r32, int hi) {
    if (hi == 0) wsf[r32] = f;
#pragma unroll
    for (int g = 0; g < 4; ++g) { const f32x4 w = *(const LAS f32x4*)(wsf + 8 * g + 4 * hi);
#pragma unroll
        for (int e = 0; e < 4; ++e) { o[0][4 * g + e] *= w[e]; o[1][4 * g + e] *= w[e]; } }
}
constexpr int NSA_ACC = 104960;
__device__ __forceinline__ void nsa_rowaccum(LAS unsigned char* acc, bool first, const f32x16 (&o)[2], LAS float* wsf, float f, int r32, int hi) {
    if (hi == 0) wsf[r32] = f;
#pragma unroll
    for (int g = 0; g < 4; ++g) { const f32x4 w = *(const LAS f32x4*)(wsf + 8 * g + 4 * hi);
#pragma unroll
        for (int e = 0; e < 4; ++e) { LAS bf16* p = (LAS bf16*)(acc + (8 * g + 4 * hi + e) * 128 + r32 * 2); const int i = 4 * g + e;
            float a = o[0][i] * w[e], b = o[1][i] * w[e];
            if (!first) { a += bf1(p[0]); b += bf1(p[32]); }
            p[0] = (bf16)f2bf(a); p[32] = (bf16)f2bf(b); } }
}
__device__ __forceinline__ void nsa_flush(const LAS unsigned char* acc, bf16* ytok  , int lane) {
    asm volatile("" ::: "memory");
    { int z_; asm volatile("v_mov_b32 %0, 0" : "=v"(z_)); lane += z_; }
#pragma unroll
    for (int ps = 0; ps < 4; ++ps) { const int row = ps * 8 + (lane >> 3), ch = lane & 7;
        const v4u v = *(const LAS v4u*)(acc + row * 128 + ch * 16);
        *(v4u*)((unsigned char*)ytok + (unsigned)(((row >> 2) * 256 + (row & 3) * 64 + ch * 8) * 2)) = v; }
}
__device__ __forceinline__ void nsa_softmax_pv(const LAS unsigned char* lds, f32x16& p0, f32x16& p1, float& m, float& l, f32x16 (&o)[2], LAS float* wsf, int lane, int r32, int hi, bool rowok) {
    float mt = nsa_max32(p0, p1); mt = rowok ? mt : -INFINITY; mt = fmaxf(mt, partner32(mt, lane));
    const float mn = fmaxf(m, mt);
    if (__builtin_amdgcn_ballot_w64(mn > m + NSA_DEFER) != 0ull) { const float f = __builtin_amdgcn_exp2f((m - mn) * NSA_C2); l *= f; nsa_rowscale(o, wsf, f, r32, hi); m = mn; }
    const float off = rowok ? -m * NSA_C2 : -INFINITY;
    v4u vv[8]; nsa_vload(lds, vv, r32, hi);
    float s = 0.f;
#pragma unroll
    for (int i = 0; i < 16; ++i) { p0[i] = __builtin_amdgcn_exp2f(__builtin_fmaf(p0[i], NSA_C2, off)); p1[i] = __builtin_amdgcn_exp2f(__builtin_fmaf(p1[i], NSA_C2, off)); s += p0[i] + p1[i]; }
    l += s;
    nsa_pv(vv, p0, p1, o);
}
__device__ __forceinline__ void p_nsa2(Frame& F) {
    const int tid = F.tid, lane = F.lane, wave = F.wave, r32 = lane & 31, hi = lane >> 5;
    LAS unsigned char* lds = F.lds + RING_OFF;
    LAS float* imp = (LAS float*)(lds + NSA_IMP); LAS float* carry = (LAS float*)(lds + NSA_CARRY);
    LAS unsigned long long* selm = (LAS unsigned long long*)(lds + NSA_SEL); LAS float* wsf = (LAS float*)(lds + NSA_WSF) + wave * 32;
    LAS unsigned char* acc = wave < 6 ? lds + NSA_ACC + wave * 4096 : F.lds + LDSCTL_OFF + 4096 + (wave - 6) * 4096;
    const bf16* P1 = WSP(bf16, WS_P1); const bf16* KC = WSP(bf16, WS_KC); const bf16* KCT = WSP(bf16, WS_KCT); const bf16* VT = WSP(bf16, WS_VT);
    bf16* Yc = WSP(bf16, WS_Y) + (size_t)2 * MC * 256;
    const int ql = r32 >> 2, h = r32 & 3, tq = 8 * wave + ql;
    int par = 0;
    for (int it = 0; it < 2; ++it) {
        for (int pair = F.vcu; pair < BC * 32; pair += F.G) {
            const int b = pair >> 5, sx = pair & 31, qb = it ? 63 - sx : sx;
            const int t = qb * 64 + tq; const size_t row = (size_t)b * SEQ + t; const bf16* prow = P1 + row * P1W;
            bf16x8v qr[4];
#pragma unroll
            for (int d0 = 0; d0 < 4; ++d0) qr[d0] = *(const bf16x8v*)(prow + C_CQ + h * 64 + d0 * 16 + hi * 8);
            const float g0 = bf1(prow[C_CG + h * 3]), g1 = bf1(prow[C_CG + h * 3 + 1]), g2 = bf1(prow[C_CG + h * 3 + 2]);
            f32x16 o[2], p0, p1;
            __syncthreads();
            for (int i = tid; i < 64 * 64; i += 512) imp[i] = 0.f;
            for (int i = tid; i < 64 * 68; i += 512) carry[i] = 0.f;
            const int nct = (4 * qb + 3 + 63) >> 6;
            const int mlim = t >= 31 ? ((t - 31) >> 4) : -1;
            const bf16* kcb = KC + (size_t)b * 256 * 64; const bf16* vcb = KCT + (size_t)b * 64 * 256;
            float m = -1e30f, l = 0.f;
            v4u kx, vx;
            nsa_load(kx, vx, kcb, 64, vcb, 256, tid);
            for (int ti = 0; ti < nct; ++ti) {
                LAS unsigned char* tb = lds + par * NSA_STAGE; par ^= 1;
                nsa_store(tb, kx, vx, tid); __syncthreads();
                { const int tn = ti + 1 < nct ? ti + 1 : 0; nsa_load(kx, vx, kcb + (size_t)tn * 64 * 64, 64, vcb + tn * 64, 256, tid); }
                nsa_qk(tb, qr, p0, p1, r32, hi); nsa_mask(p0, p1, hi, mlim - 64 * ti, -1);
                float mt = nsa_max32(p0, p1); mt = fmaxf(mt, partner32(mt, lane));
                const float mn = fmaxf(m, mt); l *= __builtin_amdgcn_exp2f((m - mn) * NSA_C2); m = mn;
                const float off = -m * NSA_C2; float s = 0.f;
#pragma unroll
                for (int i = 0; i < 16; ++i) s += __builtin_amdgcn_exp2f(__builtin_fmaf(p0[i], NSA_C2, off)) + __builtin_amdgcn_exp2f(__builtin_fmaf(p1[i], NSA_C2, off));
                l += s; }
            { const float lt = l + partner32(l, lane); const float rl = lt > 0.f ? 1.0f / lt : 0.f;
#pragma unroll
              for (int i = 0; i < 16; ++i) { o[0][i] = 0.f; o[1][i] = 0.f; }
              for (int ti = 0; ti < nct; ++ti) {
                  LAS unsigned char* tb = lds + par * NSA_STAGE; par ^= 1;
                  nsa_store(tb, kx, vx, tid); __syncthreads();
                  if (ti + 1 < nct) nsa_load(kx, vx, kcb + (size_t)(ti + 1) * 64 * 64, 64, vcb + (ti + 1) * 64, 256, tid);
                  nsa_qk(tb, qr, p0, p1, r32, hi); nsa_mask(p0, p1, hi, mlim - 64 * ti, -1);
                  v4u vv[8]; nsa_vload(tb, vv, r32, hi);
                  { const float off = -m * NSA_C2;
#pragma unroll
                    for (int i = 0; i < 16; ++i) { p0[i] = __builtin_amdgcn_exp2f(__builtin_fmaf(p0[i], NSA_C2, off)) * rl; p1[i] = __builtin_amdgcn_exp2f(__builtin_fmaf(p1[i], NSA_C2, off)) * rl; } }
#pragma unroll
                  for (int kt = 0; kt < 2; ++kt)
#pragma unroll
                      for (int g = 0; g < 4; ++g) { const f32x16& pp = kt ? p1 : p0;
                          float A = pp[4 * g] + pp[4 * g + 1] + pp[4 * g + 2] + 0.5f * pp[4 * g + 3], B = 0.5f * pp[4 * g + 3];
                          A += __builtin_bit_cast(float, bperm(lane ^ 1, __builtin_bit_cast(int, A))); A += __builtin_bit_cast(float, bperm(lane ^ 2, __builtin_bit_cast(int, A)));
                          B += __builtin_bit_cast(float, bperm(lane ^ 1, __builtin_bit_cast(int, B))); B += __builtin_bit_cast(float, bperm(lane ^ 2, __builtin_bit_cast(int, B)));
                          if (h == 0) { const int j = 16 * ti + 8 * kt + 2 * g + hi; imp[tq * 64 + j] = A; carry[tq * 68 + j + 1] = B; } }
                  nsa_pv(vv, p0, p1, o); }
              nsa_rowaccum(acc, true, o, wsf, g0, r32, hi); }
            __syncthreads();
            v4u kx2, vx2;
            { const bf16* kb = P1 + (size_t)b * SEQ * P1W + C_KSLC; const bf16* vb = VT + (size_t)(0 * BC + b) * 64 * SEQ;
              nsa_load(kx, vx, kb, P1W, vb, SEQ, tid); if (qb >= 1) nsa_load(kx2, vx2, kb + (size_t)64 * P1W, P1W, vb + 64, SEQ, tid); }
            { const int q = tid >> 3, sub = tid & 7; unsigned long long mask;
              if (qb + 1 <= 16) mask = (1ull << (qb + 1)) - 1ull;
              else { mask = 1ull | (1ull << qb);
                  unsigned long long key[8];
#pragma unroll
                  for (int i = 0; i < 8; ++i) { const int j = sub * 8 + i; const float v = imp[q * 64 + j] + carry[q * 68 + j];
                      key[i] = (j >= 1 && j < qb) ? (((unsigned long long)__builtin_bit_cast(unsigned, v) << 32) | (unsigned)(63 - j)) : 0ull; }
                  for (int r = 0; r < 14; ++r) { unsigned long long best = key[0];
#pragma unroll
                      for (int i = 1; i < 8; ++i) best = key[i] > best ? key[i] : best;
#define NSA_DPPMAX(ctrl) do { const unsigned lo_ = (unsigned)__builtin_amdgcn_update_dpp(0, (int)(unsigned)best, ctrl, 0xf, 0xf, false), hh_ = (unsigned)__builtin_amdgcn_update_dpp(0, (int)(unsigned)(best >> 32), ctrl, 0xf, 0xf, false); \
                          const unsigned long long other_ = ((unsigned long long)hh_ << 32) | lo_; best = other_ > best ? other_ : best; } while (0)
                      NSA_DPPMAX(0xB1); NSA_DPPMAX(0x4E); NSA_DPPMAX(0x141);
#undef NSA_DPPMAX
                      const int jb = 63 - (int)(best & 63ull); mask |= 1ull << jb;
#pragma unroll
                      for (int i = 0; i < 8; ++i) if (sub * 8 + i == jb) key[i] = 0ull; } }
              if (sub == 0) selm[q] = mask; }
            __syncthreads();
            const unsigned long long mysel = selm[tq];
            { const bf16* kb = P1 + (size_t)b * SEQ * P1W + C_KSLC; const bf16* vb = VT + (size_t)(0 * BC + b) * 64 * SEQ;
              m = -1e30f; l = 0.f;
#pragma unroll
              for (int i = 0; i < 16; ++i) { o[0][i] = 0.f; o[1][i] = 0.f; }
              for (int j = 0; j <= qb; j += 2) {
                  const bool two = j + 1 <= qb;
                  LAS unsigned char* tb = lds + par * NSA_STAGE; par ^= 1;
                  nsa_store(tb, kx, vx, tid); if (two) nsa_store(tb + NSA_BUF, kx2, vx2, tid);
                  __syncthreads();
                  if (j + 2 <= qb) nsa_load(kx, vx, kb + (size_t)(j + 2) * 64 * P1W, P1W, vb + (j + 2) * 64, SEQ, tid);
                  if (j + 3 <= qb) nsa_load(kx2, vx2, kb + (size_t)(j + 3) * 64 * P1W, P1W, vb + (j + 3) * 64, SEQ, tid);
                  if (j + 2 > qb) { const int jw = qb >= 8 ? qb - 8 : 0;
                      nsa_load(kx, vx, P1 + (size_t)b * SEQ * P1W + C_KWIN + (size_t)jw * 64 * P1W, P1W, VT + (size_t)(1 * BC + b) * 64 * SEQ + jw * 64, SEQ, tid); }
                  { const bool rowsel = ((mysel >> j) & 1ull) != 0ull;
                    if (__builtin_amdgcn_ballot_w64(rowsel) != 0ull) {
                        nsa_qk(tb, qr, p0, p1, r32, hi); if (j == qb) nsa_mask(p0, p1, hi, tq, -1);
                        nsa_softmax_pv(tb, p0, p1, m, l, o, wsf, lane, r32, hi, rowsel); } }
                  if (two) { const bool rowsel = ((mysel >> (j + 1)) & 1ull) != 0ull;
                    if (__builtin_amdgcn_ballot_w64(rowsel) != 0ull) {
                        nsa_qk(tb + NSA_BUF, qr, p0, p1, r32, hi); if (j + 1 == qb) nsa_mask(p0, p1, hi, tq, -1);
                        nsa_softmax_pv(tb + NSA_BUF, p0, p1, m, l, o, wsf, lane, r32, hi, rowsel); } } }
              const float lt = l + partner32(l, lane);
              nsa_rowaccum(acc, false, o, wsf, lt > 0.f ? g1 / lt : 0.f, r32, hi); }
            { const bf16* kb = P1 + (size_t)b * SEQ * P1W + C_KWIN; const bf16* vb = VT + (size_t)(1 * BC + b) * 64 * SEQ;
              m = -1e30f; l = 0.f;
#pragma unroll
              for (int i = 0; i < 16; ++i) { o[0][i] = 0.f; o[1][i] = 0.f; }
              const int j0 = qb >= 8 ? qb - 8 : 0;
              for (int j = j0; j <= qb; ++j) {
                  LAS unsigned char* tb = lds + par * NSA_STAGE; par ^= 1;
                  nsa_store(tb, kx, vx, tid); __syncthreads();
                  if (j < qb) nsa_load(kx, vx, kb + (size_t)(j + 1) * 64 * P1W, P1W, vb + (j + 1) * 64, SEQ, tid);
                  nsa_qk(tb, qr, p0, p1, r32, hi); if (j == qb || j == qb - 8) nsa_mask(p0, p1, hi, j == qb ? tq : 63, j == qb - 8 ? tq : -1);
                  nsa_softmax_pv(tb, p0, p1, m, l, o, wsf, lane, r32, hi, true); }
              const float lt = l + partner32(l, lane);
              nsa_rowaccum(acc, false, o, wsf, lt > 0.f ? g2 / lt : 0.f, r32, hi);
              nsa_flush(acc, Yc + ((size_t)b * SEQ + qb * 64 + 8 * wave) * 256, lane);
            }
        }
    }
    __syncthreads();
}

constexpr int SB_HEAD_LDS = 17408;
constexpr int SB_FLAG = 4 * SB_HEAD_LDS;
constexpr float SB_LOG2E = 1.4426950408889634f, SB_STOP = -100.0f * 1.4426950408889634f;
__device__ __forceinline__ void p_stick2(Frame& F, int nbusy) {
    const int tid = F.tid, lane = F.lane, wave = F.wave, r32 = lane & 31, hi = lane >> 5, h = wave & 3, qh = wave >> 2;
    LAS unsigned char* lds = F.lds + RING_OFF; LAS unsigned char* hl = lds + h * SB_HEAD_LDS; LAS int* flag = (LAS int*)(lds + SB_FLAG);
    const bf16* P1 = WSP(bf16, WS_P1); const bf16* VT = WSP(bf16, WS_VT) + (size_t)2 * BC * 64 * SEQ;
    bf16* Yb = WSP(bf16, WS_Y) + (size_t)MC * 256;
    const int tq = 32 * qh + r32;
    if (F.bx >= nbusy)
        for (int item = F.bx - nbusy; item < BC * 64; item += F.G - nbusy) {
            const int b = item >> 6, qb = item & 63;
            const size_t row = (size_t)b * SEQ + qb * 64 + tq;
            bf16x8v qr[4];
#pragma unroll
            for (int d0 = 0; d0 < 4; ++d0) qr[d0] = *(const bf16x8v*)(P1 + row * P1W + C_SBQ + h * 64 + d0 * 16 + hi * 8);
            f32x16 o[2], p0, p1;
#pragma unroll
            for (int i = 0; i < 16; ++i) { o[0][i] = 0.f; o[1][i] = 0.f; }
            float R = 0.f;
            const int skey = tid & 63, sc = tid >> 6, sd = tid >> 3, skc = tid & 7;
            v4u kx[4], vx[4];
#define SB_LOAD(jj) do { const bf16* kg_ = P1 + ((size_t)b * SEQ + (jj) * 64 + skey) * P1W + C_SBK + sc * 8; \
                _Pragma("unroll") for (int hh = 0; hh < 4; ++hh) { kx[hh] = *(const v4u*)(kg_ + hh * 64); vx[hh] = *(const v4u*)(VT + ((size_t)(hh * BC + b) * 64 + sd) * SEQ + (jj) * 64 + skc * 8); } } while (0)
            SB_LOAD(qb);
            for (int j = qb; j >= 0; --j) {
                __syncthreads();
                if (j < qb) { int live = 0;
#pragma unroll
                    for (int w = 0; w < 8; ++w) live |= flag[w];
                    if (!live) break; }
#pragma unroll
                for (int hh = 0; hh < 4; ++hh) { *(LAS v4u*)(lds + hh * SB_HEAD_LDS + sc * 1024 + skey * 16) = kx[hh]; { LAS v2u* vd = (LAS v2u*)(lds + hh * SB_HEAD_LDS + NSA_V + sd * NSA_VP + skc * 16); vd[0] = (v2u){vx[hh].x, vx[hh].y}; vd[1] = (v2u){vx[hh].z, vx[hh].w}; } }
                __syncthreads();
                if (j > 0) SB_LOAD(j - 1);
                nsa_qk(hl, qr, p0, p1, r32, hi);
#pragma unroll
                for (int i = 0; i < 16; ++i) { p0[i] *= NSA_C2; p1[i] *= NSA_C2; }
                v4u vv[8]; nsa_vload(hl, vv, r32, hi);
                const int lim = ((j == qb) ? tq : 64) - 4 * hi;
                float Town[8], Tp[8];
#pragma unroll
                for (int kt = 0; kt < 2; ++kt) { f32x16& pp = kt ? p1 : p0;
#pragma unroll
                    for (int g = 0; g < 4; ++g) { float L[4];
#pragma unroll
                        for (int e = 0; e < 4; ++e) { const int kk = 32 * kt + 8 * g + e; const float z = pp[4 * g + e];
                            const float tt = __builtin_amdgcn_logf(1.0f + __builtin_amdgcn_exp2f(-__builtin_fabsf(z)));
                            const float lb = fminf(z, 0.f) - tt; const bool ok = kk < lim;
                            L[e] = ok ? lb - z : 0.f; pp[4 * g + e] = ok ? lb : -INFINITY; }
                        const float E2 = L[3], E1 = E2 + L[2], E0 = E1 + L[1];
                        pp[4 * g + 2] += E2; pp[4 * g + 1] += E1; pp[4 * g] += E0;
                        Town[4 * kt + g] = E0 + L[0]; } }
#pragma unroll
                for (int k = 0; k < 8; ++k) Tp[k] = partner32(Town[k], lane);
                float suf = R;
#pragma unroll
                for (int k = 7; k >= 0; --k) { const float add = suf + (hi == 0 ? Tp[k] : 0.f); f32x16& pp = (k >> 2) ? p1 : p0; const int g = k & 3;
#pragma unroll
                    for (int e = 0; e < 4; ++e) pp[4 * g + e] = __builtin_amdgcn_exp2f(pp[4 * g + e] + add);
                    suf += Town[k] + Tp[k]; }
                R = suf;
                nsa_pv(vv, p0, p1, o);
                const bool alive = R >= SB_STOP;
                const unsigned long long bal = __builtin_amdgcn_ballot_w64(alive);
                if (lane == 0) flag[wave] = bal != 0ull ? 1 : 0;
            }
            { bf16* dst = Yb + ((size_t)b * SEQ + qb * 64 + 32 * qh + 4 * hi) * 256 + h * 64 + r32;
#pragma unroll
              for (int i = 0; i < 16; ++i) { dst[((i & 3) + 8 * (i >> 2)) * 256] = (bf16)f2bf(o[0][i]); dst[((i & 3) + 8 * (i >> 2)) * 256 + 32] = (bf16)f2bf(o[1][i]); } }
        }
#undef SB_LOAD
    __syncthreads();
}

__device__ __forceinline__ void p_sgu2(Frame& F, int layer) {
    LAS unsigned char* vnT = F.lds + RING_OFF;
    const bf16* P1 = WSP(bf16, WS_P1); bf16* Ya = WSP(bf16, WS_Y);
    const float* gain = F.in[3] + (size_t)layer * 256; const float* sw = F.in[4] + (size_t)layer * 4 * 128 * 128; const float* sb = F.in[5] + (size_t)layer * 4 * 128;
    const int lane = F.lane, wave = F.wave, r32 = lane & 31, hi = lane >> 5, g = wave & 3, db = wave >> 2;
    for (int item = F.vcu; item < MC / 128; item += F.G) {
        const size_t r0 = (size_t)item * 128;
        __syncthreads();
        { const f32x4 gg = ((const f32x4*)gain)[lane];
          for (int rr = 0; rr < 16; rr += 2) { const int r = wave * 16 + rr;
              const v2u ra = *(const v2u*)(P1 + (r0 + r) * P1W + C_V + 4 * lane), rb = *(const v2u*)(P1 + (r0 + r + 1) * P1W + C_V + 4 * lane);
              const float a0 = bflo(ra.x), a1 = bfhi(ra.x), a2 = bflo(ra.y), a3 = bfhi(ra.y), b0 = bflo(rb.x), b1 = bfhi(rb.x), b2 = bflo(rb.y), b3 = bfhi(rb.y);
              const float sa = 1.0f / sqrtf(wave_sum((a0 * a0 + a1 * a1) + (a2 * a2 + a3 * a3), lane) * (1.f / 256.f) + EPS);
              const float sb_ = 1.0f / sqrtf(wave_sum((b0 * b0 + b1 * b1) + (b2 * b2 + b3 * b3), lane) * (1.f / 256.f) + EPS);
              LAS unsigned* q = (LAS unsigned*)(vnT + (4 * lane) * 272 + r * 2);
              q[0] = pk2(a0 * sa * gg.x, b0 * sb_ * gg.x); q[68] = pk2(a1 * sa * gg.y, b1 * sb_ * gg.y); q[136] = pk2(a2 * sa * gg.z, b2 * sb_ * gg.z); q[204] = pk2(a3 * sa * gg.w, b3 * sb_ * gg.w); } }
        __syncthreads();
        const int ch = g * 64 + db * 32 + r32;
        for (int tb = 0; tb < 4; ++tb) {
            f32x16 acc;
#pragma unroll
            for (int i = 0; i < 16; ++i) acc[i] = 0.f;
            const int t = 32 * tb + r32; const float* wrow = sw + ((size_t)g * 128 + t) * 128;
            f32x4 wq[8][2];
#pragma unroll
            for (int ks = 0; ks < 8; ++ks) if (ks < 2 * tb + 2) { wq[ks][0] = *(const f32x4*)(wrow + 16 * ks + 8 * hi); wq[ks][1] = *(const f32x4*)(wrow + 16 * ks + 8 * hi + 4); }
#pragma unroll
            for (int ks = 0; ks < 8; ++ks) if (ks < 2 * tb + 2) {
                const int s0 = 16 * ks + 8 * hi;
                const f32x4 w0 = wq[ks][0], w1 = wq[ks][1];
                const v4u a = (v4u){pk2(s0 <= t ? w0.x : 0.f, s0 + 1 <= t ? w0.y : 0.f), pk2(s0 + 2 <= t ? w0.z : 0.f, s0 + 3 <= t ? w0.w : 0.f),
                                    pk2(s0 + 4 <= t ? w1.x : 0.f, s0 + 5 <= t ? w1.y : 0.f), pk2(s0 + 6 <= t ? w1.z : 0.f, s0 + 7 <= t ? w1.w : 0.f)};
                const bf16x8v bfr = *(const LAS bf16x8v*)(vnT + ch * 272 + s0 * 2);
                acc = __builtin_amdgcn_mfma_f32_32x32x16_bf16(__builtin_bit_cast(bf16x8v, a), bfr, acc, 0, 0, 0); }
            float uu[16], bb[16];
#pragma unroll
            for (int i = 0; i < 16; ++i) { const int tt = 32 * tb + (i & 3) + 8 * (i >> 2) + 4 * hi; uu[i] = bf1(P1[(r0 + tt) * P1W + C_U + ch]); bb[i] = sb[g * 128 + tt]; }
#pragma unroll
            for (int i = 0; i < 16; ++i) { const int tt = 32 * tb + (i & 3) + 8 * (i >> 2) + 4 * hi;
                Ya[(r0 + tt) * 256 + ch] = (bf16)f2bf(uu[i] * (acc[i] + bb[i])); }
        }
    }
    __syncthreads();
}

struct Args { const float* in[20]; float* out; unsigned char* ws; int lo, hi, li, rep; };
#ifndef TILED_FFN1
#define TILED_FFN1 0
#endif
#ifndef PG8_ALIGN_EPI
#define PG8_ALIGN_EPI true
#endif
#ifndef PG8_SP2
#define PG8_SP2 true
#endif
#ifndef WGM_PROJ
#define WGM_PROJ PG8_WGM
#endif
#ifndef WGM_FFN1
#define WGM_FFN1 PG8_WGM
#endif
#ifndef WGM_WOUT
#define WGM_WOUT PG8_WGM
#endif
#ifndef WGM_FFN2
#define WGM_FFN2 PG8_WGM
#endif
#ifndef WGM_MOE1
#define WGM_MOE1 PG8_WGM
#endif
#ifndef WGM_MOE2
#define WGM_MOE2 PG8_WGM
#endif
#ifndef FFN_CHUNKS
#define FFN_CHUNKS 2
#endif
#ifndef REP_GEMM
#define REP_GEMM 1
#endif
#ifndef REP_STICK
#define REP_STICK 1
#endif
#ifndef REP_NSA
#define REP_NSA 1
#endif
#ifndef REP_SGU
#define REP_SGU 1
#endif
#ifndef REP_NORM
#define REP_NORM 1
#endif
#ifndef PG8_ROTF
#define PG8_ROTF(bx, nt) (2 * ((((bx) & 7) * ((nt) / 2)) / 8))
#endif
template <class Epi, class Sched> __device__ __forceinline__ void run_gemm(Frame& F, const bf16* A, const bf16* Bt, int M, int N, int K, const Sched& S, Epi E, bool rotate = true, int tiled = 0, int ld = 0) {
    const int nt_ = K / 64;
#ifdef PG8_KROT
    const int rot_ = rotate ? PG8_ROTF(F.bx, nt_) : 0;
#else
    const int rot_ = 0;
#endif
    pg8::Gemm g{A, Bt, M, N, K + F.zs, F.tid, rot_ + F.zs, tiled + F.zs, ld + F.zs, nullptr};
    if (F.rep) E.set_scale0();
    pg8::gemm_phase<Epi, Sched, PG8_ALIGN_EPI, PG8_SP2>(F.lds + RING_OFF, g, S, E);
}
template <class Epi, class Sched> __device__ __forceinline__ void run_gemm_gather(Frame& F, const bf16* A, const int* gidx, const bf16* Bt, int M, int N, int K, const Sched& S, Epi E) {
    const int nt_ = K / 64;
#ifdef PG8_KROT
    const int rot_ = PG8_ROTF(F.bx, nt_);
#else
    const int rot_ = 0;
#endif
    pg8::Gemm g{A, Bt, M, N, K + F.zs, F.tid, rot_ + F.zs, F.zs, F.zs, gidx};
    if (F.rep) E.set_scale0();
    pg8::gemm_phase<Epi, Sched, PG8_ALIGN_EPI, PG8_SP2, true>(F.lds + RING_OFF, g, S, E);
}
__global__ void __launch_bounds__(NWAVES * 64, 2) mk_fwd(Args args) {
    extern __shared__ __attribute__((aligned(16))) unsigned char lds[];
    Frame F0;
    F0.lds = (LAS unsigned char*)lds;
    F0.tid = threadIdx.x; F0.lane = F0.tid & 63; F0.wave = __builtin_amdgcn_readfirstlane(F0.tid >> 6);
    F0.G = gridDim.x; F0.bx = blockIdx.x; F0.vcu = (F0.G % 8 == 0) ? (F0.bx % 8) * (F0.G / 8) + F0.bx / 8 : F0.bx; F0.zv = 0; F0.zs = 0;
    F0.rep = args.rep; F0.ws = args.ws; F0.ctl = (unsigned*)(args.ws + WS_CTL); F0.in = args.in; F0.out = args.out;
    for (int u = F0.tid; u < (LDS_BYTES - LDSCTL_OFF) / 4; u += NWAVES * 64) ((LAS unsigned*)(F0.lds + LDSCTL_OFF))[u] = 0u;
    __syncthreads();
    const int lo = args.lo, hi = args.hi;
    XcdBarrier bar; bar.bar = F0.ctl + CW_BAR + args.li * XCD_BAR_WORDS; bar.x = 0; bar.st = nullptr; bar.w = 0; bar.z = 0;
    if (hi - lo > 1) bar = xcd_barrier_post(F0.ctl + CW_BAR + args.li * XCD_BAR_WORDS, (volatile LAS unsigned*)(F0.lds + MISC_OFF) + 8);
    int step = 0;
#define STEP_BEGIN if (step >= lo && step < hi) { Frame F = F0; { int zv_, zs_; asm volatile("v_mov_b32 %0, 0" : "=v"(zv_)); asm volatile("s_mov_b32 %0, 0" : "=s"(zs_)); \
        F.zv = zv_; F.zs = zs_; F.lane = (int)__builtin_amdgcn_mbcnt_hi(~0u, __builtin_amdgcn_mbcnt_lo(~0u, (unsigned)zv_)); F.wave = F0.wave + zs_; F.tid = F.wave * 64 + F.lane; F.bx = F.bx + zs_; \
        F.vcu = F0.vcu + zs_; F.G = F0.G + zs_; F.lds = (LAS unsigned char*)lds + zs_; F.ws = F0.ws + zs_; F.ctl = F0.ctl + zs_; F.in = F0.in + zs_; F.out = F0.out + zs_; }
#ifdef PROBE_XBAR
#define STEP_END   if (step + 1 < hi) { unsigned zb_; asm volatile("v_mov_b32 %0, 0" : "=v"(zb_)); bar.z = zb_; xcd_barrier(bar); xcd_barrier(bar); } } ++step;
#else
#define STEP_END   if (step + 1 < hi) { unsigned zb_; asm volatile("v_mov_b32 %0, 0" : "=v"(zb_)); bar.z = zb_; xcd_barrier(bar); } } ++step;
#endif

    for (int layer = 0; layer < DEPTH; ++layer) {
        const int jj = layer >> 1;
        STEP_BEGIN
            p_convert(F, layer);
            if (layer == 0) p_norm<3, false>(F, F.in[0], nullptr, nullptr, 0); else p_rstd(F);
        STEP_END
        for (int c = 0; c < NCHUNK; ++c) {
            STEP_BEGIN
                pg8::StaticOrder S; S.init(MC, NPROJ, F.G, F.bx, WGM_PROJ);
                pg8::EpiProj E{WSP(bf16, WS_P1), WSP(bf16, WS_G), WSP(float, WS_RSTD) + (size_t)c * MC};
                run_gemm(F, (layer == 0 ? WSP(bf16, WS_HN) : WSP(bf16, WS_H)) + (size_t)c * MC * DM, WSP(bf16, WS_WIN), MC, NPROJ, DM, S, E);
            STEP_END
            STEP_BEGIN
                p_prep(F);
            STEP_END
            STEP_BEGIN
                LAS int* tab = (LAS int*)(F.lds + TAB_OFF);
                __syncthreads(); if (F.tid < 16) tab[F.tid] = F.tid >> 3; __syncthreads();
                pg8::GroupedOrder S; S.so.init(2 * 2048, 512, F.G, F.bx); S.tile_e = tab; S.nN = 2;
                pg8::EpiF32 E{WSP(float, WS_UL), 512, 2};
                run_gemm(F, WSP(bf16, WS_KVC), WSP(bf16, WS_WC1), 2 * 2048, 512, DM, S, E);
                p_sgu2(F, layer);
                p_stick2(F, F.G > 64 ? 32 : 0);
            STEP_END
            STEP_BEGIN
                p_cmpfin(F, layer);
            STEP_END
            STEP_BEGIN
#ifdef OLD_NSA
                p_nsa(F);
#else
                p_nsa2(F);
#endif
            STEP_END
            STEP_BEGIN
                pg8::MergeOrder S; S.so.init(MC, DM, F.G, F.bx); S.nmt = MC / 256;
                pg8::EpiMerge E{WSP(bf16, WS_G), WSP(bf16, WS_MG), MC / 256};
                run_gemm(F, WSP(bf16, WS_Y), WSP(bf16, WS_WBR), 3 * MC, 3 * DM, 256, S, E);
            STEP_END
            STEP_BEGIN
                pg8::StaticOrder S; S.init(MC, DM, F.G, F.bx, WGM_WOUT);
                pg8::EpiResid E{layer == 0 ? F.in[0] + (size_t)c * MC * DM : nullptr, WSP(bf16, WS_H) + (size_t)c * MC * DM, DM, 1.0f};
                run_gemm(F, WSP(bf16, WS_MG), WSP(bf16, WS_WOUT), MC, DM, DM, S, E);
            STEP_END
        }
        if ((layer & 1) == 0) {
            STEP_BEGIN
                p_rstd(F);
            STEP_END
            for (int c = 0; c < FFN_CHUNKS; ++c) {
                constexpr int MF = MTOK / FFN_CHUNKS;
                STEP_BEGIN
                    pg8::StaticOrder S; S.init(MF, NFF1, F.G, F.bx, WGM_FFN1);
                    pg8::EpiSwiGLU E{WSP(bf16, WS_HID), DFFP, nullptr, NFF1 / 256, WSP(float, WS_RSTD) + (size_t)c * MF};
                    run_gemm(F, WSP(bf16, WS_H) + (size_t)c * MF * DM, WSP(bf16, WS_WF1), MF, NFF1, DM, S, E, true, TILED_FFN1);
                STEP_END
                STEP_BEGIN
                    pg8::StaticOrder S; S.init(MF, DM, F.G, F.bx, WGM_FFN2);
                    pg8::EpiResid E{nullptr, WSP(bf16, WS_H) + (size_t)c * MF * DM, DM, 1.0f};
                    run_gemm(F, WSP(bf16, WS_HID), WSP(bf16, WS_WF2), MF, DM, DFFP, S, E);
                STEP_END
            }
        } else {
            STEP_BEGIN
                p_norm<1, true>(F, WSP(bf16, WS_H), F.in[11] + (size_t)layer * DM, F.in[15] + (size_t)jj * DM * NEXP, jj, Q8_HN);
            STEP_END
#ifdef ABL_DENSE_MOE
            for (int e = 0; e < NEXP; ++e) {
                STEP_BEGIN
                    pg8::StaticOrder S; S.init(MTOK, NMOE1, F.G, F.bx);
                    pg8::EpiSwiGLU E{WSP(bf16, WS_SCR + 8 * MiB), DFE, WSP(float, WS_SCR + 4 * MiB) + (size_t)e * MTOK, NMOE1 / 256, WSP(float, WS_RSTD)};
                    run_gemm(F, WSP(bf16, WS_HN), WSP(bf16, WS_WF1) + (size_t)e * NMOE1 * DM, MTOK, NMOE1, DM, S, E);
                STEP_END
                STEP_BEGIN
                    pg8::StaticOrder S; S.init(MTOK, DM, F.G, F.bx);
                    pg8::EpiResid E{nullptr, WSP(bf16, WS_H), DM, 1.0f};
                    run_gemm(F, WSP(bf16, WS_SCR + 8 * MiB), WSP(bf16, WS_WF2) + (size_t)e * DM * DFE, MTOK, DM, DFE, S, E);
                STEP_END
            }
#else
            STEP_BEGIN
                p_gather(F, jj, 0, 0); p_gather(F, jj, 0, 1);
            STEP_END
            for (int c = 0; c < NCHUNK; ++c) {
                STEP_BEGIN
                    int dealt = 0;
                    for (int r = 0; r < 2; ++r) {
                        const int T = moe_table(F, jj, c, r);
                        int cw = F.bx - dealt % F.G; if (cw < 0) cw += F.G;
                        pg8::GroupedOrder S; S.so.init(T * 256, NMOE1, F.G, cw, WGM_MOE1); S.tile_e = (LAS int*)(F.lds + TAB_OFF); S.nN = NMOE1 / 256;
                        pg8::EpiSwiGLU E{WSP(bf16, WS_HIDM) + (size_t)r * SLOTS * DFE, DFE, WSP(float, WS_WSLOT) + (c * 2 + r) * SLOTS, NMOE1 / 256, WSP(float, WS_RSLOT) + (c * 2 + r) * SLOTS};
                        run_gemm_gather(F, WSP(bf16, WS_H), WSP(int, WS_TOKMAP) + (c * 2 + r) * SLOTS, WSP(bf16, WS_WF1), T * 256, NMOE1, DM, S, E);
                        dealt += T * (NMOE1 / 256);
                        __syncthreads();
                    }
                STEP_END
                for (int r = 0; r < 2; ++r) {
                    STEP_BEGIN
                        const int T = moe_table(F, jj, c, r);
                        const int nwg = T * (DM / 256), R = nwg % F.G, full = nwg - R;
                        const int NS = (4 * R <= F.G) ? 4 : 2;
                        const bool split = (hi - lo > 1) && R > 0 && NS * R <= F.G && !F.rep;
                        int* tokm = WSP(int, WS_TOKMAP) + (c * 2 + r) * SLOTS; float* TB = WSP(float, WS_TB); const bf16* HIDr = WSP(bf16, WS_HIDM) + (size_t)r * SLOTS * DFE;
                        { pg8::LimitOrder S; S.so.init(T * 256, DM, F.G, F.bx, WGM_MOE2); S.limit = split ? full : nwg;
                          pg8::GroupedLimit GS{S, (LAS int*)(F.lds + TAB_OFF), DM / 256};
                          pg8::EpiScatter E{WSP(bf16, WS_H), tokm, DM / 256, 1.0f};
                          run_gemm(F, HIDr, WSP(bf16, WS_WF2), T * 256, DM, DFE, GS, E, true); }
                        const bool more = r == 1 && c + 1 < NCHUNK;
                        if (split) {
                            const int KP = DFE / NS;
                            if (F.bx < NS * R) { const int Lx = full + F.bx / NS, kp = F.bx % NS;
                                pg8::StaticOrder so; so.init(T * 256, DM, F.G, Lx % F.G, WGM_MOE2); pg8::Unit un; so.next(Lx / F.G, un);
                                un.pn += ((LAS int*)(F.lds + TAB_OFF))[un.pm] * (DM / 256);
                                pg8::SingleOrder S1{un};
                                if (kp == 0) { pg8::EpiScatter E{WSP(bf16, WS_H), tokm, DM / 256, 1.0f};
                                    run_gemm(F, HIDr, WSP(bf16, WS_WF2), T * 256, DM, KP, S1, E, false, 0, DFE); }
                                else { pg8::EpiTile E{TB + ((size_t)(Lx - full) * 3 + (kp - 1)) * 65536};
                                    run_gemm(F, HIDr + kp * KP, WSP(bf16, WS_WF2) + kp * KP, T * 256, DM, KP, S1, E, false, 0, DFE); } }
                            if (more) { p_gather(F, jj, c + 1, 0, NS * R); p_gather(F, jj, c + 1, 1, NS * R); }
                            { unsigned zb_; asm volatile("v_mov_b32 %0, 0" : "=v"(zb_)); bar.z = zb_; xcd_barrier(bar); }
                            for (int it = (F.vcu * NWAVES + F.wave); it < R * 256; it += F.G * NWAVES) { const int j = it >> 8, row = it & 255, Lx = full + j;
                                pg8::StaticOrder so; so.init(T * 256, DM, F.G, Lx % F.G, WGM_MOE2); pg8::Unit un; so.next(Lx / F.G, un);
                                const int t = tokm[un.pm * 256 + row];
                                if (t >= 0) { v2u* hp = (v2u*)(WSP(bf16, WS_H) + (size_t)t * DM + un.pn * 256) + F.lane; const v2u hv = *hp; f32x4 a = (f32x4){bflo(hv.x), bfhi(hv.x), bflo(hv.y), bfhi(hv.y)};
                                    for (int q = 0; q < NS - 1; ++q) a = a + ((const f32x4*)(TB + ((size_t)j * 3 + q) * 65536 + row * 256))[F.lane];
                                    *hp = (v2u){pk2(a.x, a.y), pk2(a.z, a.w)}; } }
                        } else if (!F.rep && more) { p_gather(F, jj, c + 1, 0, R); p_gather(F, jj, c + 1, 1, R); }
                    STEP_END
                }
            }
#endif
        }
    }
    STEP_BEGIN
        p_norm<2, true>(F, WSP(bf16, WS_H), F.in[19], nullptr, 0);
    STEP_END
#undef STEP_BEGIN
#undef STEP_END
}

#ifndef MK_STEPS_PER_LAUNCH
#define MK_STEPS_PER_LAUNCH 1
#endif
extern "C" void kernel_launch(void* const* d_in, const int* in_sizes, int n_in, void* d_out, int out_size, void* d_ws, size_t ws_size, hipStream_t stream) {
    static int grid = 0;
    if (grid == 0) {
        if (n_in != 20 || in_sizes[0] != MTOK * DM || out_size != MTOK * DM || ws_size < WS_END) { fprintf(stderr, "kernel_launch: unexpected shapes (n_in %d, in0 %d, out %d, ws %zu)\n", n_in, n_in > 0 ? in_sizes[0] : -1, out_size, ws_size); grid = -1; return; }
        int dev = 0, cus = 0, per_cu = 0;
        if (hipGetDevice(&dev) != hipSuccess || hipDeviceGetAttribute(&cus, hipDeviceAttributeMultiprocessorCount, dev) != hipSuccess) { grid = -1; return; }
        if (hipFuncSetAttribute((const void*)mk_fwd, hipFuncAttributeMaxDynamicSharedMemorySize, LDS_BYTES) != hipSuccess) { fprintf(stderr, "kernel_launch: hipFuncSetAttribute failed\n"); grid = -1; return; }
        if (hipOccupancyMaxActiveBlocksPerMultiprocessor(&per_cu, (const void*)mk_fwd, NWAVES * 64, LDS_BYTES) != hipSuccess || per_cu < 1) fprintf(stderr, "kernel_launch: occupancy query reports %d\n", per_cu);
        (void)hipGetLastError();
        grid = cus;
    }
    if (grid < 0) return;
    if (hipMemsetAsync((char*)d_ws + WS_CTL, 0, CTL_ZERO_BYTES, stream) != hipSuccess) return;
    Args a{};
    for (int i = 0; i < 20; ++i) a.in[i] = (const float*)d_in[i];
    a.out = (float*)d_out; a.ws = (unsigned char*)d_ws; a.rep = 0;
    #ifdef ABL_DENSE_MOE
    constexpr int NSTEPS = 2 * (1 + NCHUNK * 8 + 3) + 2 * (1 + NCHUNK * 8 + 1 + NEXP * 2) + 1;
#else
    constexpr int NSTEPS = 2 * (1 + NCHUNK * 7 + 1 + 2 * FFN_CHUNKS) + 2 * (1 + NCHUNK * 7 + 2 + NCHUNK * 3) + 1;
#endif
    int li = 0;
#ifdef REPMASK
    static int kinds[256]; int ns = 0;
    for (int layer = 0; layer < DEPTH; ++layer) { kinds[ns++] = 0;
        for (int c = 0; c < NCHUNK; ++c) for (int q = 1; q <= 8; ++q) if (q != 5) kinds[ns++] = q;
        if ((layer & 1) == 0) { kinds[ns++] = 9; for (int c = 0; c < FFN_CHUNKS; ++c) { kinds[ns++] = 10; kinds[ns++] = 11; } }
        else { kinds[ns++] = 12; kinds[ns++] = 17; for (int c = 0; c < NCHUNK; ++c) { kinds[ns++] = 14; kinds[ns++] = 13; kinds[ns++] = 13; } } }
    kinds[ns++] = 16;
    for (int s = 0; s < NSTEPS; ++s) { const int reps = ((REPMASK >> kinds[s]) & 1) ? 2 : 1;
        for (int r = 0; r < reps; ++r) { a.lo = s; a.hi = s + 1; a.li = 0; a.rep = r;
            hipLaunchKernelGGL(mk_fwd, dim3(grid), dim3(NWAVES * 64), LDS_BYTES, stream, a); } }
    (void)li;
#else
    for (int s = 0; s < NSTEPS; s += MK_STEPS_PER_LAUNCH) {
        a.lo = s; a.hi = (s + MK_STEPS_PER_LAUNCH < NSTEPS) ? s + MK_STEPS_PER_LAUNCH : NSTEPS; a.li = (MK_STEPS_PER_LAUNCH > 1) ? li : 0; ++li;
        hipLaunchKernelGGL(mk_fwd, dim3(grid), dim3(NWAVES * 64), LDS_BYTES, stream, a);
        if (hipPeekAtLastError() != hipSuccess) { fprintf(stderr, "kernel_launch: launch failed\n"); break; }
    }
#endif
}
```
